# Optimizing an MI355X kernel written in HIP

```python
import math
import jax, jax.numpy as jnp
from jax import lax
import numpy as np

D_MODEL = 1024
BATCH = 2
SEQ = 16384
DEPTH = 2

GRID_W = 64
CTX_LEN = 256
EPS = 1e-6

GROUP_W = D_MODEL // 4

MLA_HEADS = 4
MLA_NOPE = 64
MLA_ROPE = 32
MLA_V = GROUP_W // MLA_HEADS
MLA_Q_LORA = 256
MLA_KV_LORA = 128
MLA_SCALE = (MLA_NOPE + MLA_ROPE) ** -0.5
ROPE_THETA = 10000.0
Q_BLOCK = 128

HY_W = GROUP_W
HY_EMB = 33
HY_FFN = 64
HY_TARGET = 1e-2
HY_FAST_PCT = 0.3
HY_SLOW_PCT = 1.5

GLA_HEADS = 4
GLA_DK = 32
GLA_DV = GROUP_W // GLA_HEADS
GLA_LR = 16
GLA_TAU = 16.0
GLA_CHUNK = 64

FN_W = GROUP_W

N_EXPERTS = 32
TOP_K = 4
D_FF = D_MODEL
SWIGLU_ALPHA = 1.702
SWIGLU_LIMIT = 7.0
MOE_BLOCK = 128

IN_WIDTHS = (MLA_Q_LORA, MLA_KV_LORA, MLA_ROPE,
             3 * HY_W,
             GLA_HEADS * GLA_DK, GLA_HEADS * GLA_DK, GLA_HEADS * GLA_DV, 2 * GLA_LR, GLA_HEADS * GLA_DV,
             FN_W)
D_IN = sum(IN_WIDTHS)

kernel_name = "hybrid_mla_hyena_gla_fnet_moe_dit"


def _rms(x, g):
    xf = x.astype(jnp.float32)
    y = xf * lax.rsqrt(jnp.mean(xf * xf, axis=-1, keepdims=True) + EPS)
    return (y * g.astype(jnp.float32)).astype(x.dtype)


def _modulate(x, g, shift, scale):
    return _rms(x, g) * (1.0 + scale) + shift


def _axial_rope(rows):
    row = jnp.repeat(jnp.arange(rows, dtype=jnp.float32), GRID_W)
    col = jnp.tile(jnp.arange(GRID_W, dtype=jnp.float32), rows)
    n_freq = MLA_ROPE // 4
    inv = ROPE_THETA ** (-jnp.arange(n_freq, dtype=jnp.float32) / n_freq)
    ang = jnp.concatenate([row[:, None] * inv, col[:, None] * inv], axis=-1)
    return jnp.cos(ang), jnp.sin(ang)


def _rope(x, cos, sin):
    half = MLA_ROPE // 2
    x1, x2 = x[..., :half], x[..., half:]
    c, s = cos[:, None, :], sin[:, None, :]
    return jnp.concatenate([x1 * c - x2 * s, x2 * c + x1 * s], axis=-1)


def _mla_qkv(cq, ckv, kr, p, cos, sin):
    B, L, _ = cq.shape
    q = (_rms(cq, p['mla_q_g']) @ p['mla_w_uq']).reshape(B, L, MLA_HEADS, MLA_NOPE + MLA_ROPE)
    kv = (_rms(ckv, p['mla_kv_g']) @ p['mla_w_ukv']).reshape(B, L, MLA_HEADS, MLA_NOPE + MLA_V)
    q_nope, q_rope = q[..., :MLA_NOPE], q[..., MLA_NOPE:]
    k_nope, v = kv[..., :MLA_NOPE], kv[..., MLA_NOPE:]
    kr = kr[:, :, None, :]
    if cos is not None:
        q_rope = _rope(q_rope, cos, sin)
        kr = _rope(kr, cos, sin)
    q = jnp.concatenate([q_nope, q_rope], axis=-1)
    k = jnp.concatenate([k_nope, jnp.broadcast_to(kr, (B, L, MLA_HEADS, MLA_ROPE)).astype(k_nope.dtype)], axis=-1)
    return q, k, v


def _attend(q, k, v):
    s = jnp.einsum('bqhd,bkhd->bhqk', q, k).astype(jnp.float32) * MLA_SCALE
    w = jax.nn.softmax(s, axis=-1).astype(v.dtype)
    return jnp.einsum('bhqk,bkhd->bqhd', w, v)


def _attend_blocked(q, k, v):
    B, L, H, dq = q.shape
    nb = L // Q_BLOCK
    qb = q.reshape(B, nb, Q_BLOCK, H, dq).transpose(1, 0, 2, 3, 4)
    ob = lax.map(lambda qi: _attend(qi, k, v), qb)
    return ob.transpose(1, 0, 2, 3, 4).reshape(B, L, H, v.shape[-1])


def _short_conv(u, w, b):
    up = jnp.pad(u, ((0, 0), (1, 1), (0, 0)))
    return up[:, :-2] * w[0] + up[:, 1:-1] * w[1] + up[:, 2:] * w[2] + b


def _hyena_filter(L, p):
    t = jnp.linspace(0.0, 1.0, L, dtype=jnp.float32)[:, None]
    bands = (HY_EMB - 1) // 2
    f = jnp.linspace(1e-4, bands - 1, bands, dtype=jnp.float32)
    w = 2.0 * math.pi * jnp.arange(L, dtype=jnp.float32) / L
    fw = w[:, None] * f[None, :]
    z = jnp.concatenate([t, jnp.cos(fw), -jnp.sin(fw)], axis=-1)
    h = jnp.sin(p['hy_freq'] * (z @ p['hy_w1'] + p['hy_b1']))
    h = jnp.sin(p['hy_freq'] * (h @ p['hy_w2'] + p['hy_b2']))
    h = (h @ p['hy_w3']).astype(jnp.float32).reshape(L, 2, HY_W)
    max_decay = math.log(HY_TARGET) / HY_FAST_PCT
    min_decay = math.log(HY_TARGET) / HY_SLOW_PCT
    deltas = jnp.abs(jnp.linspace(min_decay, max_decay, HY_W, dtype=jnp.float32))
    h = h * jnp.exp(-t * deltas)[:, None, :]
    h_f, h_b = h[:, 0], h[:, 1]
    k2 = jnp.concatenate([h_f, jnp.zeros((1, HY_W), jnp.float32), h_b[1:][::-1]], axis=0)
    return k2 * lax.rsqrt(jnp.sum(k2 * k2, axis=0, keepdims=True))


def _hyena(z, p):
    L = z.shape[1]
    u = _short_conv(z, p['hy_conv_w'], p['hy_conv_b'])
    x0, x1, v = jnp.split(u, 3, axis=-1)
    k2 = _hyena_filter(L, p)
    vg = (v * x1).astype(jnp.float32)
    y = jnp.fft.irfft(jnp.fft.rfft(vg, n=2 * L, axis=1) * jnp.fft.rfft(k2, axis=0)[None], n=2 * L, axis=1)[:, :L]
    y = y + vg * p['hy_bias'].astype(jnp.float32)
    return y.astype(z.dtype) * x0


def _gla_scan(q, k, v, g, s0):
    B2, L, H, dk = q.shape
    n = L // GLA_CHUNK
    def chunks(a):
        return a.astype(jnp.float32).reshape(B2, n, GLA_CHUNK, H, a.shape[-1]).swapaxes(0, 1)
    mask = jnp.tril(jnp.ones((GLA_CHUNK, GLA_CHUNK), bool))[None, :, :, None, None]
    def step(S, inp):
        qc, kc, vc, gc = inp
        b = jnp.cumsum(gc, axis=1)
        o_inter = jnp.einsum('bchk,bhkv->bchv', qc * jnp.exp(b), S)
        diff = jnp.where(mask, b[:, :, None] - b[:, None, :], -jnp.inf)
        A = jnp.einsum('bihk,bjhk,bijhk->bhij', qc, kc, jnp.exp(diff))
        o_intra = jnp.einsum('bhij,bjhv->bihv', A, vc)
        b_last = b[:, -1]
        S_new = S * jnp.exp(b_last)[..., None] + jnp.einsum('bchk,bchv->bhkv', kc * jnp.exp(b_last[:, None] - b), vc)
        return S_new, o_inter + o_intra
    S, o = lax.scan(step, s0, (chunks(q), chunks(k), chunks(v), chunks(g)))
    return o.swapaxes(0, 1).reshape(B2, L, H, v.shape[-1]), S


def _gla_bidir(q, k, v, glr, p, s0):
    B, L, _ = q.shape
    q = q.reshape(B, L, GLA_HEADS, GLA_DK) * (GLA_DK ** -0.5)
    k = k.reshape(B, L, GLA_HEADS, GLA_DK)
    v = v.reshape(B, L, GLA_HEADS, GLA_DV)
    gl = glr.reshape(B, L, 2, GLA_LR)
    gk = jnp.einsum('bldr,drk->bldk', gl, p['gla_gk_w']) + p['gla_gk_b']
    g = (jax.nn.log_sigmoid(gk.astype(jnp.float32)) / GLA_TAU).reshape(B, L, 2, GLA_HEADS, GLA_DK)
    both = lambda a: jnp.concatenate([a, a[:, ::-1]], axis=0)
    g2 = jnp.concatenate([g[:, :, 0], g[:, ::-1, 1]], axis=0)
    o, s = _gla_scan(both(q), both(k), both(v), g2, s0)
    return o[:B] + o[B:, ::-1], s


def _fnet(z, w):
    y = jnp.fft.fft2(z.astype(jnp.float32), axes=(1, 2), norm='ortho').real
    return y.astype(z.dtype) @ w


def _mix_out(a, hy, o_gla, og, fn, p):
    B, L = hy.shape[:2]
    gA, gB, gC, gD = jnp.split(p['mix_g'], 4)
    a = _rms(a, gA.reshape(MLA_HEADS, MLA_V)).reshape(B, L, GROUP_W)
    hy = _rms(hy, gB)
    o = _rms(o_gla, gC.reshape(GLA_HEADS, GLA_DV)).reshape(B, L, GROUP_W) * jax.nn.silu(og)
    fn = _rms(fn, gD)
    y = jnp.concatenate([a, hy, o.astype(hy.dtype), fn], axis=-1)
    return y @ p['w_out']


def _moe(h, p):
    T, D = h.shape
    logits = (h @ p['router_w']).astype(jnp.float32) + p['router_b'].astype(jnp.float32)
    top_v, top_i = lax.top_k(logits, TOP_K)
    gates = jax.nn.softmax(top_v, axis=-1)
    n_assign = T * TOP_K
    e_flat = top_i.reshape(-1)
    tok_flat = jnp.arange(n_assign, dtype=jnp.int32) // TOP_K
    w_flat = gates.reshape(-1)
    order = jnp.argsort(e_flat)
    e_s, tok_s, w_s = e_flat[order], tok_flat[order], w_flat[order]
    counts = jnp.bincount(e_flat, length=N_EXPERTS)
    start = jnp.cumsum(counts) - counts
    padded = (counts + MOE_BLOCK - 1) // MOE_BLOCK * MOE_BLOCK
    pend = jnp.cumsum(padded)
    pstart = pend - padded
    dest = pstart[e_s] + (jnp.arange(n_assign, dtype=jnp.int32) - start[e_s])
    n_rows = ((n_assign + MOE_BLOCK - 1) // MOE_BLOCK + N_EXPERTS) * MOE_BLOCK
    n_blocks = n_rows // MOE_BLOCK
    row_tok = jnp.full((n_rows,), T, jnp.int32).at[dest].set(tok_s)
    row_w = jnp.zeros((n_rows,), jnp.float32).at[dest].set(w_s)
    blk_e = jnp.minimum(jnp.searchsorted(pend, jnp.arange(n_blocks, dtype=pend.dtype) * MOE_BLOCK, side='right'),
                        N_EXPERTS - 1).astype(jnp.int32)
    h_pad = jnp.concatenate([h, jnp.zeros((1, D), h.dtype)], axis=0)
    def expert_block(args):
        rows, ei = args
        xi = h_pad[rows]
        gu = xi @ p['moe_w_gu'][ei] + p['moe_b_gu'][ei]
        gate = jnp.minimum(gu[:, ::2], SWIGLU_LIMIT)
        up = jnp.clip(gu[:, 1::2], -SWIGLU_LIMIT, SWIGLU_LIMIT)
        glu = gate * jax.nn.sigmoid(gate * SWIGLU_ALPHA)
        return ((up + 1.0) * glu) @ p['moe_w_down'][ei] + p['moe_b_down'][ei]
    yb = lax.map(expert_block, (row_tok.reshape(n_blocks, MOE_BLOCK), blk_e)).reshape(n_rows, D)
    out = jnp.zeros((T + 1, D), yb.dtype).at[row_tok].add(yb * row_w[:, None].astype(yb.dtype))
    return out[:T]


def _layer(x_lat, x_ctx, mod_lat, mod_ctx, p, cos, sin, need_ctx_out):
    B, L, D = x_lat.shape
    Lc = x_ctx.shape[1]
    sh1, sc1, g1, sh2, sc2, g2 = jnp.split(mod_lat[:, None, :], 6, axis=-1)
    csh1, csc1, cg1, csh2, csc2, cg2 = jnp.split(mod_ctx, 6, axis=-1)
    idx = np.cumsum(IN_WIDTHS)[:-1].tolist()
    z_lat = _modulate(x_lat, p['norm1_g'], sh1, sc1) @ p['w_in']
    z_ctx = _modulate(x_ctx, p['norm1_g'], csh1, csc1) @ p['w_in']
    cq_l, ckv_l, kr_l, hy_l, gq_l, gk_l, gv_l, glr_l, og_l, fn_l = jnp.split(z_lat, idx, axis=-1)
    cq_c, ckv_c, kr_c, hy_c, gq_c, gk_c, gv_c, glr_c, og_c, fn_c = jnp.split(z_ctx, idx, axis=-1)
    q_l, k_l, v_l = _mla_qkv(cq_l, ckv_l, kr_l, p, cos, sin)
    q_c, k_c, v_c = _mla_qkv(cq_c, ckv_c, kr_c, p, None, None)
    a_l = _attend_blocked(q_l, jnp.concatenate([k_l, k_c], axis=1), jnp.concatenate([v_l, v_c], axis=1))
    s0 = jnp.zeros((2 * B, GLA_HEADS, GLA_DK, GLA_DV), jnp.float32)
    o_c, s_c = _gla_bidir(gq_c, gk_c, gv_c, glr_c, p, s0)
    o_l, _ = _gla_bidir(gq_l, gk_l, gv_l, glr_l, p, s_c)
    y_lat = _mix_out(a_l, _hyena(hy_l, p), o_l, og_l, _fnet(fn_l, p['fnet_w']), p)
    x_lat = x_lat + g1 * y_lat
    if need_ctx_out:
        a_c = _attend(q_c, k_c, v_c)
        y_ctx = _mix_out(a_c, _hyena(hy_c, p), o_c, og_c, _fnet(fn_c, p['fnet_w']), p)
        x_ctx = x_ctx + cg1 * y_ctx
        h2 = jnp.concatenate([_modulate(x_lat, p['norm2_g'], sh2, sc2).reshape(B * L, D),
                              _modulate(x_ctx, p['norm2_g'], csh2, csc2).reshape(B * Lc, D)], axis=0)
        f = _moe(h2, p)
        x_lat = x_lat + g2 * f[:B * L].reshape(B, L, D)
        x_ctx = x_ctx + cg2 * f[B * L:].reshape(B, Lc, D)
    else:
        f = _moe(_modulate(x_lat, p['norm2_g'], sh2, sc2).reshape(B * L, D), p)
        x_lat = x_lat + g2 * f.reshape(B, L, D)
    return x_lat, x_ctx


def setup_inputs(seed: int = 0) -> dict:
    key = jax.random.key(seed)
    ks = iter(jax.random.split(key, 40))
    def nrm(shape, s):
        return jax.random.normal(next(ks), shape, jnp.float32) * s
    def gain(shape):
        return 1.0 + nrm(shape, 0.02)
    Dd, E = D_MODEL, N_EXPERTS
    return {
        'x': nrm((BATCH, SEQ, Dd), 1.0),
        'c': nrm((BATCH, Dd), 1.0),
        'ctx': nrm((BATCH, CTX_LEN, Dd), 1.0),
        'c_ctx': nrm((Dd,), 1.0),
        'ada_w': nrm((DEPTH, Dd, 6 * Dd), 0.5 * Dd ** -0.5),
        'ada_b': nrm((DEPTH, 6 * Dd), 0.02),
        'norm1_g': gain((DEPTH, Dd)),
        'norm2_g': gain((DEPTH, Dd)),
        'w_in': nrm((DEPTH, Dd, D_IN), Dd ** -0.5),
        'mla_q_g': gain((DEPTH, MLA_Q_LORA)),
        'mla_w_uq': nrm((DEPTH, MLA_Q_LORA, MLA_HEADS * (MLA_NOPE + MLA_ROPE)), MLA_Q_LORA ** -0.5),
        'mla_kv_g': gain((DEPTH, MLA_KV_LORA)),
        'mla_w_ukv': nrm((DEPTH, MLA_KV_LORA, MLA_HEADS * (MLA_NOPE + MLA_V)), MLA_KV_LORA ** -0.5),
        'hy_conv_w': nrm((DEPTH, 3, 3 * HY_W), 3 ** -0.5),
        'hy_conv_b': nrm((DEPTH, 3 * HY_W), 0.02),
        'hy_w1': nrm((DEPTH, HY_EMB, HY_FFN), HY_EMB ** -0.5),
        'hy_b1': nrm((DEPTH, HY_FFN), 0.02),
        'hy_w2': nrm((DEPTH, HY_FFN, HY_FFN), HY_FFN ** -0.5),
        'hy_b2': nrm((DEPTH, HY_FFN), 0.02),
        'hy_w3': nrm((DEPTH, HY_FFN, 2 * HY_W), HY_FFN ** -0.5),
        'hy_freq': 1.0 + nrm((DEPTH, HY_FFN), 0.1),
        'hy_bias': nrm((DEPTH, HY_W), 1.0),
        'gla_gk_w': nrm((DEPTH, 2, GLA_LR, GLA_HEADS * GLA_DK), GLA_LR ** -0.5),
        'gla_gk_b': nrm((DEPTH, 2, GLA_HEADS * GLA_DK), 0.1),
        'fnet_w': nrm((DEPTH, FN_W, FN_W), FN_W ** -0.5),
        'mix_g': gain((DEPTH, 4 * GROUP_W)),
        'w_out': nrm((DEPTH, 4 * GROUP_W, Dd), (4 * GROUP_W) ** -0.5),
        'router_w': nrm((DEPTH, Dd, E), Dd ** -0.5),
        'router_b': nrm((DEPTH, E), 0.01),
        'moe_w_gu': nrm((DEPTH, E, Dd, 2 * D_FF), Dd ** -0.5),
        'moe_b_gu': nrm((DEPTH, E, 2 * D_FF), 0.02),
        'moe_w_down': nrm((DEPTH, E, D_FF, Dd), D_FF ** -0.5),
        'moe_b_down': nrm((DEPTH, E, Dd), 0.02),
        'final_g': gain((Dd,)),
    }


def reference(x, c, ctx, c_ctx, ada_w, ada_b, norm1_g, norm2_g, w_in, mla_q_g, mla_w_uq, mla_kv_g, mla_w_ukv,
              hy_conv_w, hy_conv_b, hy_w1, hy_b1, hy_w2, hy_b2, hy_w3, hy_freq, hy_bias, gla_gk_w, gla_gk_b,
              fnet_w, mix_g, w_out, router_w, router_b, moe_w_gu, moe_b_gu, moe_w_down, moe_b_down, final_g):
    n_lat = x.shape[1]
    rows = n_lat // GRID_W
    cos, sin = _axial_rope(rows)
    x_lat, x_ctx = x, ctx
    for i in range(DEPTH):
        p = {
            'norm1_g': norm1_g[i], 'norm2_g': norm2_g[i], 'w_in': w_in[i],
            'mla_q_g': mla_q_g[i], 'mla_w_uq': mla_w_uq[i], 'mla_kv_g': mla_kv_g[i], 'mla_w_ukv': mla_w_ukv[i],
            'hy_conv_w': hy_conv_w[i], 'hy_conv_b': hy_conv_b[i], 'hy_w1': hy_w1[i], 'hy_b1': hy_b1[i],
            'hy_w2': hy_w2[i], 'hy_b2': hy_b2[i], 'hy_w3': hy_w3[i], 'hy_freq': hy_freq[i], 'hy_bias': hy_bias[i],
            'gla_gk_w': gla_gk_w[i], 'gla_gk_b': gla_gk_b[i], 'fnet_w': fnet_w[i], 'mix_g': mix_g[i],
            'w_out': w_out[i], 'router_w': router_w[i], 'router_b': router_b[i],
            'moe_w_gu': moe_w_gu[i], 'moe_b_gu': moe_b_gu[i], 'moe_w_down': moe_w_down[i], 'moe_b_down': moe_b_down[i],
        }
        mod_lat = jax.nn.silu(c) @ ada_w[i] + ada_b[i]
        mod_ctx = jax.nn.silu(c_ctx) @ ada_w[i] + ada_b[i]
        x_lat, x_ctx = _layer(x_lat, x_ctx, mod_lat, mod_ctx, p, cos, sin, i < DEPTH - 1)
    return _rms(x_lat, final_g)
```

```cpp
#include <hip/hip_runtime.h>
#include <hip/hip_bf16.h>
#include <cstdio>
#include <cstdint>
#include <cstring>

typedef unsigned short u16;
using bf16x8 = __attribute__((ext_vector_type(8))) short;
using s16x4  = __attribute__((ext_vector_type(4))) short;
using f32x4  = __attribute__((ext_vector_type(4))) float;
using f32x16 = __attribute__((ext_vector_type(16))) float;
using u32x4  = __attribute__((ext_vector_type(4))) unsigned;
using u32x2  = __attribute__((ext_vector_type(2))) unsigned;

constexpr int DM = 1024, NB = 2, SEQ = 16384, LC = 256;
constexpr int TL = NB * SEQ;
constexpr int TC = NB * LC;
constexpr int TT = TL + TC;
constexpr int NIN = 2816;
constexpr int DIN0 = 2240;
constexpr int NE = 32, TOPK = 4, DFF = 1024;
constexpr int SKV = SEQ + LC;
constexpr int NTHR = 512;
constexpr float EPS = 1e-6f;
constexpr int ZG_W = 1152, ZG_GQ = 0, ZG_GK = 128, ZG_KR = 256, ZG_GV = 384, ZG_GP = 640, ZG_OG = 896;
constexpr int ZT_HY = 0, ZT_FR = 768, ZT_FI = 1024, ZT_R = 1280;
constexpr int NCH = 260;
constexpr int FM = 16384;
constexpr int HSP = FM / 2 + 1;

struct Params {
  const float *x, *c, *ctx, *c_ctx, *ada_w, *ada_b, *norm1_g, *norm2_g, *w_in, *mla_q_g, *mla_w_uq, *mla_kv_g, *mla_w_ukv,
      *hy_conv_w, *hy_conv_b, *hy_w1, *hy_b1, *hy_w2, *hy_b2, *hy_w3, *hy_freq, *hy_bias, *gla_gk_w, *gla_gk_b,
      *fnet_w, *mix_g, *w_out, *router_w, *router_b, *moe_w_gu, *moe_b_gu, *moe_w_down, *moe_b_down, *final_g;
  float* out;
  unsigned* bar;
  int* cnt;
  float* hssq;
  float* mod;
  float* ropec; float* ropes;
  float2* tw;
  u16* bt_in;
  u16* bt_q;
  u16* bt_kv;
  u16* bt_out;
  u16* bt_gu;
  u16* bt_dn;
  float* hfb;
  float* hfc;
  float4* hspec;
  u16* H;
  u16* zq;
  u16* zkv;
  float* zg;
  float* zt;
  u16* Q;
  u16* KV;
  u16* ymix;
  float* hyo;
  float* fno;
  float* glao;
  float* gds;
  float* gdv;
  float* gst;
  float* X;
  int* rtok;
  float* rw;
  int* tslot;
  u16* act;
  u16* yd;
};

__device__ __forceinline__ u16 f2bf(float f) {
  unsigned u = __float_as_uint(f); u += 0x7FFFu + ((u >> 16) & 1u); return (u16)(u >> 16);
}
__device__ __forceinline__ float bf2f(u16 h) { return __uint_as_float(((unsigned)h) << 16); }
__device__ __forceinline__ unsigned cvtpk(float lo, float hi) {
  unsigned r; asm volatile("v_cvt_pk_bf16_f32 %0, %1, %2" : "=v"(r) : "v"(lo), "v"(hi)); return r;
}
__device__ __forceinline__ float wave_sum(float v) {
#pragma unroll
  for (int o = 32; o > 0; o >>= 1) v += __shfl_xor(v, o, 64);
  return v;
}
__device__ __forceinline__ float silu_f(float x) { return x / (1.f + __expf(-x)); }
__device__ __forceinline__ float2 cmul(float2 a, float2 b) { return make_float2(a.x * b.x - a.y * b.y, a.x * b.y + a.y * b.x); }
__device__ __forceinline__ float2 cmulc(float2 a, float2 b) { return make_float2(a.x * b.x + a.y * b.y, a.y * b.x - a.x * b.y); }
__device__ __forceinline__ int modv(int tok) { return tok < TL ? (tok >> 14) : 2; }
__device__ __forceinline__ void phase_tables(const Params& p, int bid, int nb) {
  const int gt = bid * NTHR + threadIdx.x, gs = nb * NTHR;
  for (int i = gt; i < SEQ * 16; i += gs) {
    const int t = i >> 4, f = i & 15;
    const float pos = (f < 8) ? (float)(t >> 6) : (float)(t & 63);
    const float inv = powf(10000.f, -(float)(f & 7) / 8.f);
    float s, c; sincosf(pos * inv, &s, &c);
    p.ropec[i] = c; p.ropes[i] = s;
  }
  for (int i = gt; i < FM; i += gs) {
    float s, c; sincospif((float)i / 8192.f, &s, &c);
    p.tw[i] = make_float2(c, -s);
  }
  for (int i = gt; i < 64; i += gs) p.cnt[i] = 0;
  for (int i = gt; i < 768; i += gs) p.hssq[i] = 0.f;
}

__device__ __forceinline__ void phase_mod(const Params& p, int bid, int nb, char* lds) {
  float* red = (float*)lds;
  const int tid = threadIdx.x, part = tid >> 6, cl = tid & 63;
  for (int it = bid; it < 2 * 96; it += nb) {
    const int l = it / 96, n = (it % 96) * 64 + cl;
    const float* W = p.ada_w + (size_t)l * DM * 6144;
    float a0 = 0, a1 = 0, a2 = 0;
    for (int k = part * 128; k < part * 128 + 128; ++k) {
      const float w = W[(size_t)k * 6144 + n];
      a0 += silu_f(p.c[k]) * w; a1 += silu_f(p.c[DM + k]) * w; a2 += silu_f(p.c_ctx[k]) * w;
    }
    red[(part * 3 + 0) * 64 + cl] = a0; red[(part * 3 + 1) * 64 + cl] = a1; red[(part * 3 + 2) * 64 + cl] = a2;
    __syncthreads();
    if (tid < 192) {
      const int v = tid >> 6; float s = 0;
      for (int q = 0; q < 8; ++q) s += red[(q * 3 + v) * 64 + cl];
      p.mod[((size_t)l * 3 + v) * 6144 + n] = s + p.ada_b[(size_t)l * 6144 + n];
    }
    __syncthreads();
  }
}

__device__ __forceinline__ void phase_fold(const Params& p, int bid, int nb, char* lds) {
  float* wrow = (float*)lds;
  float* dre = wrow + 256;
  float* dim_ = dre + 256;
  float* glr = dim_ + 256;
  float* cst = glr + 32;
  float* snt = cst + 256;
  const int tid = threadIdx.x;
  if (tid < 256) { float s, c; sincospif((float)tid / 128.f, &s, &c); cst[tid] = c; snt[tid] = s; }
  __syncthreads();
  for (int it = bid; it < 2 * DM; it += nb) {
    const int l = it >> 10, k = it & 1023;
    const float* wr = p.w_in + ((size_t)l * DM + k) * DIN0;
    if (tid < 256) wrow[tid] = wr[1984 + tid];
    if (tid >= 256 && tid < 288) glr[tid - 256] = wr[1696 + tid - 256];
    __syncthreads();
    {
      const int kp = tid & 255; const bool im = tid >= 256;
      float s = 0;
      for (int c = 0; c < 256; ++c) { const int m = (c * kp) & 255; s += wrow[c] * (im ? -snt[m] : cst[m]); }
      if (im) dim_[kp] = s; else dre[kp] = s;
    }
    __syncthreads();
    {
      const int j = tid & 255; const bool im = tid >= 256;
      const float* Wf = p.fnet_w + (size_t)l * 65536;
      const float* d = im ? dim_ : dre;
      float s = 0;
      for (int kp = 0; kp < 256; ++kp) s += d[kp] * Wf[kp * 256 + j];
      p.bt_in[((size_t)l * NIN + (im ? 2560 : 2304) + j) * DM + k] = f2bf(s * 0.0625f);
    }
    if (tid < 256) {
      const int dir = tid >> 7, kk = tid & 127;
      const float* gw = p.gla_gk_w + ((size_t)l * 2 + dir) * 16 * 128;
      float s = 0;
      for (int r = 0; r < 16; ++r) s += glr[dir * 16 + r] * gw[r * 128 + kk];
      p.bt_in[((size_t)l * NIN + 1024 + tid) * DM + k] = f2bf(s);
    }
    __syncthreads();
  }
}

enum { MAP_ID = 0, MAP_IN = 1, MAP_UQ = 2, MAP_UKV = 3, MAP_GU = 4 };
__device__ __forceinline__ int colmap(int mt, int n) {
  switch (mt) {
    case MAP_ID: return n;
    case MAP_IN:
      if (n < 256) return n;
      if (n < 384) return 256 + (n - 256);
      if (n < 512) return 1184 + (n - 384);
      if (n < 640) return 1312 + (n - 512);
      if (n < 672) return 384 + (n - 640);
      if (n < 768) return -1;
      if (n < 1024) return 1440 + (n - 768);
      if (n < 1280) return -2;
      if (n < 1536) return 1728 + (n - 1280);
      if (n < 2304) return 416 + (n - 1536);
      return -2;
    case MAP_UQ:
      if (n < 256) return (n >> 6) * 96 + (n & 63);
      if (n < 384) return ((n - 256) >> 5) * 96 + 64 + ((n - 256) & 31);
      return -1;
    case MAP_UKV:
      if (n < 256) return (n >> 6) * 128 + (n & 63);
      return ((n - 256) >> 6) * 128 + 64 + ((n - 256) & 63);
    default: {
      const int grp = n >> 6, w = n & 63;
      return w < 32 ? 2 * (grp * 32 + w) : 2 * (grp * 32 + w - 32) + 1;
    }
  }
}
__device__ __forceinline__ void conv_matrix(const float* __restrict__ src, int ld, int K, int N, u16* __restrict__ dst, int mt,
                            const float* __restrict__ scale, int bid, int nb, char* lds) {
  float* tile = (float*)lds;
  const int tid = threadIdx.x, nkt = K >> 6, ntile = (N >> 6) * nkt;
  for (int t = bid; t < ntile; t += nb) {
    const int n0 = (t / nkt) << 6, k0 = (t % nkt) << 6;
    const int nn = tid & 63, sc = colmap(mt, n0 + nn);
#pragma unroll
    for (int i = 0; i < 8; ++i) {
      const int kk = (tid >> 6) + 8 * i;
      float v = 0.f;
      if (sc >= 0) { v = src[(size_t)(k0 + kk) * ld + sc]; if (scale) v *= scale[k0 + kk]; }
      tile[kk * 65 + nn] = v;
    }
    __syncthreads();
    {
      const int n2 = tid >> 3, ks = (tid & 7) * 8;
      const int sc2 = colmap(mt, n0 + n2);
      if (sc2 != -2) {
        u32x4 w;
        w[0] = cvtpk(tile[(ks + 0) * 65 + n2], tile[(ks + 1) * 65 + n2]);
        w[1] = cvtpk(tile[(ks + 2) * 65 + n2], tile[(ks + 3) * 65 + n2]);
        w[2] = cvtpk(tile[(ks + 4) * 65 + n2], tile[(ks + 5) * 65 + n2]);
        w[3] = cvtpk(tile[(ks + 6) * 65 + n2], tile[(ks + 7) * 65 + n2]);
        *(u32x4*)(dst + (size_t)(n0 + n2) * K + k0 + ks) = w;
      }
    }
    __syncthreads();
  }
}
__device__ __forceinline__ void phase_convert(const Params& p, int bid, int nb, char* lds) {
  for (int l = 0; l < 2; ++l) {
    conv_matrix(p.w_in + (size_t)l * DM * DIN0, DIN0, DM, NIN, p.bt_in + (size_t)l * NIN * DM, MAP_IN, nullptr, bid, nb, lds);
    conv_matrix(p.mla_w_uq + (size_t)l * 256 * 384, 384, 256, 512, p.bt_q + (size_t)l * 512 * 256, MAP_UQ, p.mla_q_g + l * 256, bid, nb, lds);
    conv_matrix(p.mla_w_ukv + (size_t)l * 128 * 512, 512, 128, 512, p.bt_kv + (size_t)l * 512 * 128, MAP_UKV, p.mla_kv_g + l * 128, bid, nb, lds);
    conv_matrix(p.w_out + (size_t)l * DM * DM, DM, DM, DM, p.bt_out + (size_t)l * DM * DM, MAP_ID, p.mix_g + l * DM, bid, nb, lds);
    for (int e = 0; e < NE; ++e) {
      conv_matrix(p.moe_w_gu + ((size_t)l * NE + e) * DM * 2048, 2048, DM, 2048, p.bt_gu + ((size_t)l * NE + e) * 2048 * DM, MAP_GU, nullptr, bid, nb, lds);
      conv_matrix(p.moe_w_down + ((size_t)l * NE + e) * DFF * DM, DM, DFF, DM, p.bt_dn + ((size_t)l * NE + e) * DM * DFF, MAP_ID, nullptr, bid, nb, lds);
    }
  }
}

__device__ __forceinline__ void phase_hy_mlp(const Params& p, int l, int Lf, float* __restrict__ hout  , float* __restrict__ ssq  ,
                             int bid, int nb, char* lds) {
  float* zf = (float*)lds;
  float* h1 = zf + 64 * 33;
  float* h2 = h1 + 64 * 64;
  const int tid = threadIdx.x;
  const float* w1 = p.hy_w1 + (size_t)l * 33 * 64; const float* b1 = p.hy_b1 + l * 64;
  const float* w2 = p.hy_w2 + (size_t)l * 64 * 64; const float* b2 = p.hy_b2 + l * 64;
  const float* w3 = p.hy_w3 + (size_t)l * 64 * 512; const float* fr = p.hy_freq + l * 64;
  float w3c[64];
#pragma unroll
  for (int k = 0; k < 64; ++k) w3c[k] = w3[k * 512 + tid];
  const int dir = tid >> 8, ch = tid & 255;
  const float maxd = logf(1e-2f) / 0.3f, mind = logf(1e-2f) / 1.5f;
  const float delta = fabsf(mind + (maxd - mind) * (float)ch / 255.f);
  float ssq_acc = 0.f;
  for (int it = bid; it < Lf / 64; it += nb) {
    const int t0 = it * 64;
    for (int i = tid; i < 64 * 33; i += NTHR) {
      const int tt = i / 33, f = i % 33, t = t0 + tt;
      float v;
      if (f == 0) v = (float)t / (float)(Lf - 1);
      else {
        const int j = (f - 1) & 15;
        const float fj = 1e-4f + (float)j * ((15.f - 1e-4f) / 15.f);
        const float w = 6.283185307179586f * (float)t / (float)Lf;
        v = (f <= 16) ? cosf(fj * w) : -sinf(fj * w);
      }
      zf[i] = v;
    }
    __syncthreads();
    for (int i = tid; i < 64 * 64; i += NTHR) {
      const int tt = i >> 6, o = i & 63; float s = b1[o];
      for (int f = 0; f < 33; ++f) s += zf[tt * 33 + f] * w1[f * 64 + o];
      h1[i] = sinf(fr[o] * s);
    }
    __syncthreads();
    for (int i = tid; i < 64 * 64; i += NTHR) {
      const int tt = i >> 6, o = i & 63; float s = b2[o];
      for (int f = 0; f < 64; ++f) s += h1[tt * 64 + f] * w2[f * 64 + o];
      h2[i] = sinf(fr[o] * s);
    }
    __syncthreads();
    float* orow = hout + ((size_t)dir * 256 + ch) * Lf + t0;
    for (int tt = 0; tt < 64; ++tt) {
      float s = 0;
#pragma unroll
      for (int k = 0; k < 64; ++k) s += h2[tt * 64 + k] * w3c[k];
      const int t = t0 + tt;
      s *= __expf(-((float)t / (float)(Lf - 1)) * delta);
      orow[tt] = s;
      if (dir == 0 || t > 0) ssq_acc += s * s;
    }
    __syncthreads();
  }
  atomicAdd(&ssq[ch], ssq_acc);
}

__device__ __forceinline__ int rev7(int k) {
  unsigned r = __brev((unsigned)k) >> 18;
  return (int)(((r & 0x2AAAu) >> 1) | ((r & 0x1555u) << 1));
}
__device__ __forceinline__ void fft_fwd(float2* s, const float2* __restrict__ tw) {
  const int tid = threadIdx.x;
#pragma unroll 1
  for (int st = 0; st < 7; ++st) {
    const int sh = 12 - 2 * st, q = 1 << sh;
#pragma unroll 4
    for (int u = tid; u < 4096; u += NTHR) {
      const int g = u >> sh, j = u & (q - 1), base = (g << (sh + 2)) + j;
      const float2 a0 = s[base], a1 = s[base + q], a2 = s[base + 2 * q], a3 = s[base + 3 * q];
      const int ti = j << (2 * st);
      const float2 w1 = tw[ti], w2 = tw[2 * ti], w3 = tw[3 * ti];
      const float2 b0 = make_float2(a0.x + a2.x, a0.y + a2.y), b1 = make_float2(a0.x - a2.x, a0.y - a2.y);
      const float2 b2 = make_float2(a1.x + a3.x, a1.y + a3.y), b3 = make_float2(a1.x - a3.x, a1.y - a3.y);
      s[base] = make_float2(b0.x + b2.x, b0.y + b2.y);
      s[base + q] = cmul(make_float2(b1.x + b3.y, b1.y - b3.x), w1);
      s[base + 2 * q] = cmul(make_float2(b0.x - b2.x, b0.y - b2.y), w2);
      s[base + 3 * q] = cmul(make_float2(b1.x - b3.y, b1.y + b3.x), w3);
    }
    __syncthreads();
  }
}
__device__ __forceinline__ void fft_inv(float2* s, const float2* __restrict__ tw) {
  const int tid = threadIdx.x;
#pragma unroll 1
  for (int st = 6; st >= 0; --st) {
    const int sh = 12 - 2 * st, q = 1 << sh;
#pragma unroll 4
    for (int u = tid; u < 4096; u += NTHR) {
      const int g = u >> sh, j = u & (q - 1), base = (g << (sh + 2)) + j;
      const int ti = j << (2 * st);
      const float2 t0 = s[base], t1 = cmulc(s[base + q], tw[ti]), t2 = cmulc(s[base + 2 * q], tw[2 * ti]), t3 = cmulc(s[base + 3 * q], tw[3 * ti]);
      const float2 b0 = make_float2(t0.x + t2.x, t0.y + t2.y), b1 = make_float2(t0.x - t2.x, t0.y - t2.y);
      const float2 b2 = make_float2(t1.x + t3.x, t1.y + t3.y), b3 = make_float2(t1.x - t3.x, t1.y - t3.y);
      s[base] = make_float2(b0.x + b2.x, b0.y + b2.y);
      s[base + q] = make_float2(b1.x - b3.y, b1.y + b3.x);
      s[base + 2 * q] = make_float2(b0.x - b2.x, b0.y - b2.y);
      s[base + 3 * q] = make_float2(b1.x + b3.y, b1.y - b3.x);
    }
    __syncthreads();
  }
}

__device__ __forceinline__ void phase_hy_filtfft(const Params& p, int bid, int nb, char* lds) {
  float2* s = (float2*)lds;
  const int tid = threadIdx.x;
  for (int it = bid; it < 512; it += nb) {
    const int l = it >> 8, ch = it & 255;
    const float* hf = p.hfb + (((size_t)l * 2 + 0) * 256 + ch) * SEQ;
    const float* hb = p.hfb + (((size_t)l * 2 + 1) * 256 + ch) * SEQ;
    for (int m = tid; m < FM; m += NTHR) {
      const int n0 = 2 * m, n1 = 2 * m + 1;
      const float a = (n0 < SEQ) ? hf[n0] : (n0 == SEQ ? 0.f : hb[2 * SEQ - n0]);
      const float b = (n1 < SEQ) ? hf[n1] : hb[2 * SEQ - n1];
      s[m] = make_float2(a, b);
    }
    __syncthreads();
    fft_fwd(s, p.tw);
    const float sc = rsqrtf(p.hssq[l * 256 + ch]) * (1.f / 16384.f);
    float4* out = p.hspec + ((size_t)l * 256 + ch) * HSP;
    for (int k = tid; k <= FM / 2; k += NTHR) {
      const float2 zk = s[rev7(k)], zm = s[rev7((FM - k) & (FM - 1))];
      const float er = 0.5f * (zk.x + zm.x), ei = 0.5f * (zk.y - zm.y);
      const float dr = 0.5f * (zk.x - zm.x), di = 0.5f * (zk.y + zm.y);
      out[k] = make_float4(er * sc, ei * sc, di * sc, -dr * sc);
    }
    __syncthreads();
  }
}
constexpr int G_TILE_B = 256 * 64 * 2;
constexpr int G_STAGE_B = 2 * G_TILE_B;
constexpr int GEMM_LDS = 2 * G_STAGE_B;

__device__ __forceinline__ int lds_byte2(int r, int c) {
  const int st = (r >> 4) * 2 + (c >> 5), ob = (r & 15) * 64 + (c & 31) * 2;
  return st * 1024 + (ob ^ (((ob >> 9) & 1) << 5));
}
__device__ __forceinline__ void stage_rc2(int b, int& R, int& C) {
  const int st = b >> 10, sb = b & 1023, swz = sb ^ (((sb >> 9) & 1) << 5);
  R = (st >> 1) * 16 + (swz >> 6);
  C = (st & 1) * 32 + ((swz & 63) >> 1);
}
__device__ __forceinline__ void gemm_stage_coords(int (&sR)[4], int (&sC)[4]) {
  const int wid = threadIdx.x >> 6, lane = threadIdx.x & 63;
#pragma unroll
  for (int i = 0; i < 4; ++i) stage_rc2(wid * 1024 + i * 8192 + lane * 16, sR[i], sC[i]);
}

#define WAIT_V0() asm volatile("s_waitcnt vmcnt(0)" ::: "memory")

__device__ __forceinline__ void gemm256_core(const u16* const (&ap)[4], const u16* const (&bp)[4], int nt, char* shm, f32x4 (&acc)[8][4]) {
  const int tid = threadIdx.x, wid = tid >> 6, lane = tid & 63, wr = wid >> 2, wc = wid & 3, fr = lane & 15, fq = lane >> 4;
#pragma unroll
  for (int m = 0; m < 8; ++m)
#pragma unroll
    for (int n = 0; n < 4; ++n) acc[m][n] = f32x4{0.f, 0.f, 0.f, 0.f};
#define G_SA(b) (shm + (b) * G_STAGE_B)
#define G_SB(b) (shm + (b) * G_STAGE_B + G_TILE_B)
#define G_STAGE(buf, kt) do { _Pragma("unroll") for (int i = 0; i < 4; ++i) {                                                   \
    __builtin_amdgcn_global_load_lds((const unsigned*)(ap[i] + (kt) * 64), (unsigned*)(G_SA(buf) + wid * 1024 + i * 8192), 16, 0, 0); \
    __builtin_amdgcn_global_load_lds((const unsigned*)(bp[i] + (kt) * 64), (unsigned*)(G_SB(buf) + wid * 1024 + i * 8192), 16, 0, 0); } } while (0)
  G_STAGE(0, 0); WAIT_V0(); __syncthreads();
#pragma unroll 1
  for (int t = 0; t < nt; ++t) {
    const int cur = t & 1;
    if (t + 1 < nt) G_STAGE(cur ^ 1, t + 1);
#pragma unroll
    for (int ks = 0; ks < 2; ++ks) {
      bf16x8 At[8], Bf[4];
#pragma unroll
      for (int m = 0; m < 8; ++m) At[m] = *(const bf16x8*)(G_SA(cur) + lds_byte2(wr * 128 + m * 16 + fr, ks * 32 + fq * 8));
#pragma unroll
      for (int n = 0; n < 4; ++n) Bf[n] = *(const bf16x8*)(G_SB(cur) + lds_byte2(wc * 64 + n * 16 + fr, ks * 32 + fq * 8));
#pragma unroll
      for (int m = 0; m < 8; ++m)
#pragma unroll
        for (int n = 0; n < 4; ++n) acc[m][n] = __builtin_amdgcn_mfma_f32_16x16x32_bf16(At[m], Bf[n], acc[m][n], 0, 0, 0);
      __builtin_amdgcn_sched_barrier(0);
    }
    WAIT_V0(); __syncthreads();
  }
#undef G_STAGE
}

__device__ __forceinline__ const float* resid_row(const Params& p, int layer_src, int tok) {
  if (layer_src == 0) return tok < TL ? p.x + (size_t)tok * DM : p.ctx + (size_t)(tok - TL) * DM;
  return p.X + (size_t)tok * DM;
}
__device__ __forceinline__ void load_row_comb(const Params& p, int src_layer, int lc, int tok, int lane, const int* pre  , float (&v)[16]) {
  const float* r = resid_row(p, src_layer, tok);
#pragma unroll
  for (int i = 0; i < 4; ++i) { const float4 a = *(const float4*)(r + lane * 4 + i * 256); v[4 * i] = a.x; v[4 * i + 1] = a.y; v[4 * i + 2] = a.z; v[4 * i + 3] = a.w; }
  if (lc >= 0) {
    const float* g2 = p.mod + ((size_t)lc * 3 + modv(tok)) * 6144 + 5 * DM;
    float s[16];
#pragma unroll
    for (int i = 0; i < 16; ++i) s[i] = 0.f;
#pragma unroll
    for (int k = 0; k < TOPK; ++k) {
      const int sl = p.tslot[tok * 4 + k];
      const size_t arow = (size_t)(pre[sl >> 20] + (sl & 0xFFFFF));
      const u16* y = p.yd + arow * DM;
#pragma unroll
      for (int i = 0; i < 4; ++i) {
        const u32x2 w = *(const u32x2*)(y + lane * 4 + i * 256);
        s[4 * i] += __uint_as_float(w[0] << 16); s[4 * i + 1] += __uint_as_float(w[0] & 0xFFFF0000u);
        s[4 * i + 2] += __uint_as_float(w[1] << 16); s[4 * i + 3] += __uint_as_float(w[1] & 0xFFFF0000u);
      }
    }
#pragma unroll
    for (int i = 0; i < 4; ++i) {
      const float4 g = *(const float4*)(g2 + lane * 4 + i * 256);
      v[4 * i] += g.x * s[4 * i]; v[4 * i + 1] += g.y * s[4 * i + 1]; v[4 * i + 2] += g.z * s[4 * i + 2]; v[4 * i + 3] += g.w * s[4 * i + 3];
    }
  }
}
__device__ __forceinline__ void expert_prefix(const int* cnt, int* pre) {
  if (threadIdx.x == 0) { int s = 0; for (int e = 0; e < NE; ++e) { pre[e] = s; s += cnt[e]; } pre[NE] = s; }
}

__device__ __forceinline__ void phase_norm1(const Params& p, int layer, int bid, int nb, char* lds) {
  int* pre = (int*)lds;
  const int lc = layer - 1;
  if (lc >= 0) { expert_prefix(p.cnt + lc * NE, pre); __syncthreads(); }
  const int wid = threadIdx.x >> 6, lane = threadIdx.x & 63;
  const float* gn = p.norm1_g + layer * DM;
  const int ntok = TT;
  for (int tok = bid * 8 + wid; tok < ntok; tok += nb * 8) {
    float v[16];
    load_row_comb(p, layer == 0 ? 0 : 1, lc, tok, lane, pre, v);
    if (lc >= 0) {
      float* xr = p.X + (size_t)tok * DM;
#pragma unroll
      for (int i = 0; i < 4; ++i) *(float4*)(xr + lane * 4 + i * 256) = make_float4(v[4 * i], v[4 * i + 1], v[4 * i + 2], v[4 * i + 3]);
    }
    float ss = 0;
#pragma unroll
    for (int i = 0; i < 16; ++i) ss += v[i] * v[i];
    ss = wave_sum(ss);
    const float rs = rsqrtf(ss * (1.f / DM) + EPS);
    const float* md = p.mod + ((size_t)layer * 3 + modv(tok)) * 6144;
    u16* h = p.H + (size_t)tok * DM;
#pragma unroll
    for (int i = 0; i < 4; ++i) {
      const int c = lane * 4 + i * 256;
      const float4 g = *(const float4*)(gn + c), sh = *(const float4*)(md + c), sc = *(const float4*)(md + DM + c);
      const float y0 = v[4 * i] * rs * g.x * (1.f + sc.x) + sh.x, y1 = v[4 * i + 1] * rs * g.y * (1.f + sc.y) + sh.y;
      const float y2 = v[4 * i + 2] * rs * g.z * (1.f + sc.z) + sh.z, y3 = v[4 * i + 3] * rs * g.w * (1.f + sc.w) + sh.w;
      u32x2 w; w[0] = cvtpk(y0, y1); w[1] = cvtpk(y2, y3);
      *(u32x2*)(h + c) = w;
    }
  }
}

__device__ __forceinline__ void phase_gemm_in(const Params& p, int layer, int bid, int nb, char* lds) {
  const int tid = threadIdx.x, wid = tid >> 6, lane = tid & 63, wr = wid >> 2, wc = wid & 3, fr = lane & 15, fq = lane >> 4;
  int sR[4], sC[4]; gemm_stage_coords(sR, sC);
  const u16* Bt = p.bt_in + (size_t)layer * NIN * DM;
  constexpr int nM = TT / 256, nN = NIN / 256;
  for (int t = bid; t < nM * nN; t += nb) {
    const int pm = t / nN, pn = t % nN, brow = pm * 256, bcol = pn * 256;
    const u16* ap[4]; const u16* bp[4];
#pragma unroll
    for (int i = 0; i < 4; ++i) { ap[i] = p.H + (size_t)(brow + sR[i]) * DM + sC[i]; bp[i] = Bt + (size_t)(bcol + sR[i]) * DM + sC[i]; }
    f32x4 acc[8][4];
    gemm256_core(ap, bp, DM / 64, lds, acc);
    const int cg = bcol + wc * 64;
    const int r0 = brow + wr * 128;
    if (cg < 384) {
      u16* dst = cg < 256 ? p.zq : p.zkv; const int ld = cg < 256 ? 256 : 128, c0 = cg < 256 ? cg : cg - 256;
#pragma unroll
      for (int m = 0; m < 8; ++m)
#pragma unroll
        for (int n = 0; n < 4; ++n)
#pragma unroll
          for (int j = 0; j < 4; ++j) dst[(size_t)(r0 + m * 16 + fq * 4 + j) * ld + c0 + n * 16 + fr] = f2bf(acc[m][n][j]);
    } else if (cg < 1536) {
      const int c0 = cg - 384;
#pragma unroll
      for (int m = 0; m < 8; ++m)
#pragma unroll
        for (int n = 0; n < 4; ++n)
#pragma unroll
          for (int j = 0; j < 4; ++j) p.zg[(size_t)(r0 + m * 16 + fq * 4 + j) * ZG_W + c0 + n * 16 + fr] = acc[m][n][j];
    } else {
      const int c0 = cg - 1536;
#pragma unroll
      for (int m = 0; m < 8; ++m)
#pragma unroll
        for (int n = 0; n < 4; ++n)
          *(float4*)(p.zt + (size_t)(c0 + n * 16 + fr) * TT + r0 + m * 16 + fq * 4) = make_float4(acc[m][n][0], acc[m][n][1], acc[m][n][2], acc[m][n][3]);
    }
  }
}

__device__ __forceinline__ size_t qkv_row(int tok, int h) {
  const int b = tok < TL ? (tok >> 14) : ((tok - TL) >> 8);
  const int s = tok < TL ? (tok & (SEQ - 1)) : SEQ + ((tok - TL) & (LC - 1));
  return ((size_t)(b * 4 + h)) * SKV + s;
}
template <bool ISQ>
__device__ __forceinline__ void qkv_tiles(const Params& p, int layer, int bid, int nb, char* lds) {
  const int tid = threadIdx.x, wid = tid >> 6, lane = tid & 63, wr = wid >> 2, wc = wid & 3, fr = lane & 15, fq = lane >> 4;
  float* rsv = (float*)(lds + 128 * 260 * 4);
  constexpr int nM = TT / 256;
  constexpr int K = ISQ ? 256 : 128;
  const u16* A = ISQ ? p.zq : p.zkv;
  const u16* Bt = ISQ ? p.bt_q + (size_t)layer * 512 * 256 : p.bt_kv + (size_t)layer * 512 * 128;
  for (int t = bid; t < 2 * nM; t += nb) {
    const int pm = t >> 1, pn = t & 1, brow = pm * 256;
    {
      const int r = tid >> 1, half = tid & 1, per = K / 2;
      const u16* row = A + (size_t)(brow + r) * K + half * per;
      float ss = 0;
      for (int i = 0; i < per; i += 8) {
        const u32x4 w = *(const u32x4*)(row + i);
#pragma unroll
        for (int q = 0; q < 4; ++q) { const float a = __uint_as_float(w[q] << 16), b = __uint_as_float(w[q] & 0xFFFF0000u); ss += a * a + b * b; }
      }
      ss += __shfl_xor(ss, 1, 64);
      if (half == 0) rsv[r] = rsqrtf(ss / (float)K + EPS);
    }
    f32x4 acc[8][4];
    {
      int sR[4], sC[4]; gemm_stage_coords(sR, sC);
      const u16* ap[4]; const u16* bp[4];
#pragma unroll
      for (int i = 0; i < 4; ++i) { ap[i] = A + (size_t)(brow + sR[i]) * K + sC[i]; bp[i] = Bt + (size_t)(pn * 256 + sR[i]) * K + sC[i]; }
      gemm256_core(ap, bp, K / 64, lds, acc);
    }
    float* et = (float*)lds;
#pragma unroll 1
    for (int half = 0; half < 2; ++half) {
      if (wr == half) {
#pragma unroll
        for (int m = 0; m < 8; ++m)
#pragma unroll
          for (int n = 0; n < 4; ++n)
#pragma unroll
            for (int j = 0; j < 4; ++j) et[(m * 16 + fq * 4 + j) * 260 + wc * 64 + n * 16 + fr] = acc[m][n][j];
      }
      __syncthreads();
      {
        const int rl = tid >> 2, ch = tid & 3, tok = brow + half * 128 + rl;
        const float rs = rsv[half * 128 + rl];
        const float* src = et + rl * 260;
        if (ISQ && pn == 1) {
          float x1[16], x2[16];
#pragma unroll
          for (int i = 0; i < 4; ++i) {
            const float4 a = *(const float4*)(src + ch * 32 + i * 4), b2 = *(const float4*)(src + ch * 32 + 16 + i * 4);
            x1[4 * i] = a.x * rs; x1[4 * i + 1] = a.y * rs; x1[4 * i + 2] = a.z * rs; x1[4 * i + 3] = a.w * rs;
            x2[4 * i] = b2.x * rs; x2[4 * i + 1] = b2.y * rs; x2[4 * i + 2] = b2.z * rs; x2[4 * i + 3] = b2.w * rs;
          }
          unsigned o1[8], o2[8];
          if (tok < TL) {
            const float* cp = p.ropec + (size_t)(tok & (SEQ - 1)) * 16; const float* sp = p.ropes + (size_t)(tok & (SEQ - 1)) * 16;
#pragma unroll
            for (int i = 0; i < 4; ++i) {
              const float4 c4 = *(const float4*)(cp + 4 * i), s4 = *(const float4*)(sp + 4 * i);
              const float cc[4] = {c4.x, c4.y, c4.z, c4.w}, sn[4] = {s4.x, s4.y, s4.z, s4.w};
              float y1[4], y2[4];
#pragma unroll
              for (int q = 0; q < 4; ++q) { y1[q] = x1[4 * i + q] * cc[q] - x2[4 * i + q] * sn[q]; y2[q] = x2[4 * i + q] * cc[q] + x1[4 * i + q] * sn[q]; }
              o1[2 * i] = cvtpk(y1[0], y1[1]); o1[2 * i + 1] = cvtpk(y1[2], y1[3]); o2[2 * i] = cvtpk(y2[0], y2[1]); o2[2 * i + 1] = cvtpk(y2[2], y2[3]);
            }
          } else {
#pragma unroll
            for (int i = 0; i < 8; ++i) { o1[i] = cvtpk(x1[2 * i], x1[2 * i + 1]); o2[i] = cvtpk(x2[2 * i], x2[2 * i + 1]); }
          }
          u16* q = p.Q + qkv_row(tok, ch) * 96 + 64;
          *(u32x4*)(q) = u32x4{o1[0], o1[1], o1[2], o1[3]}; *(u32x4*)(q + 8) = u32x4{o1[4], o1[5], o1[6], o1[7]};
          *(u32x4*)(q + 16) = u32x4{o2[0], o2[1], o2[2], o2[3]}; *(u32x4*)(q + 24) = u32x4{o2[4], o2[5], o2[6], o2[7]};
        } else {
          u16* d = ISQ ? p.Q + qkv_row(tok, ch) * 96 : p.KV + qkv_row(tok, ch) * 160 + (pn == 0 ? 0 : 96);
#pragma unroll
          for (int i = 0; i < 8; ++i) {
            const float4 a = *(const float4*)(src + ch * 64 + i * 8), b2 = *(const float4*)(src + ch * 64 + i * 8 + 4);
            *(u32x4*)(d + i * 8) = u32x4{cvtpk(a.x * rs, a.y * rs), cvtpk(a.z * rs, a.w * rs), cvtpk(b2.x * rs, b2.y * rs), cvtpk(b2.z * rs, b2.w * rs)};
          }
        }
      }
      __syncthreads();
    }
    __syncthreads();
  }
}
__device__ __forceinline__ void phase_qkv(const Params& p, int layer, int bid, int nb, char* lds) {
  const int tid = threadIdx.x;
  qkv_tiles<true>(p, layer, bid, nb, lds);
  qkv_tiles<false>(p, layer, bid, nb, lds);
  for (int i = bid * NTHR + tid; i < TT * 16; i += nb * NTHR) {
    const int tok = i >> 4, f = i & 15;
    const float x1 = p.zg[(size_t)tok * ZG_W + ZG_KR + f], x2 = p.zg[(size_t)tok * ZG_W + ZG_KR + 16 + f];
    float cs = 1.f, sn = 0.f;
    if (tok < TL) { const int tpos = tok & (SEQ - 1); cs = p.ropec[tpos * 16 + f]; sn = p.ropes[tpos * 16 + f]; }
    const u16 o1 = f2bf(x1 * cs - x2 * sn), o2 = f2bf(x2 * cs + x1 * sn);
#pragma unroll
    for (int h = 0; h < 4; ++h) { u16* kv = p.KV + qkv_row(tok, h) * 160 + 64; kv[f] = o1; kv[16 + f] = o2; }
  }
}
constexpr int A_KROW = 208;
constexpr int A_SHM_K = 64 * A_KROW;
constexpr int A_SHM_V = 64 * 64 * 2;
constexpr int A_OFF_K = 2 * A_SHM_V;
constexpr int A_OFF_W = A_OFF_K + 2 * A_SHM_K;
constexpr int ATTN_LDS = A_OFF_W + 8 * 64 * 4;
constexpr float A_SCALE = 0.10206207261596575f;
constexpr float A_THR = 8.f;
#define SBAR() __builtin_amdgcn_sched_barrier(0)
__device__ __forceinline__ int crow(int r, int hi) { return (r & 3) + 8 * (r >> 2) + 4 * hi; }

__device__ __forceinline__ void a_partialSM(f32x16& p0, f32x16& p1, float& m_reg, float& mn, float& alpha) {
  constexpr float C = A_SCALE * 1.4426950408889634f;
  float pmax = p0[0];
#pragma unroll
  for (int r = 1; r < 16; ++r) pmax = fmaxf(pmax, p0[r]);
#pragma unroll
  for (int r = 0; r < 16; ++r) pmax = fmaxf(pmax, p1[r]);
  { auto rr = __builtin_amdgcn_permlane32_swap(__float_as_uint(pmax), __float_as_uint(pmax), false, false);
    pmax = fmaxf(__uint_as_float(rr[0]), __uint_as_float(rr[1])); }
  if (__builtin_expect(__all(pmax - m_reg <= A_THR / A_SCALE), 1)) { mn = m_reg; alpha = 1.f; }
  else { mn = fmaxf(m_reg, pmax); alpha = __builtin_amdgcn_exp2f((m_reg - mn) * C); m_reg = mn; }
  const float mnC = -mn * C;
#pragma unroll
  for (int r = 0; r < 16; ++r) p0[r] = fmaf(p0[r], C, mnC);
#pragma unroll
  for (int r = 0; r < 16; ++r) p1[r] = fmaf(p1[r], C, mnC);
#pragma unroll
  for (int r = 0; r < 16; ++r) p0[r] = __builtin_amdgcn_exp2f(p0[r]);
}
__device__ __forceinline__ void a_finishSM(f32x16& p0, f32x16& p1, float alpha, float& l_reg, bf16x8& pa0, bf16x8& pa1, bf16x8& pa2, bf16x8& pa3) {
#pragma unroll
  for (int r = 0; r < 16; ++r) p1[r] = __builtin_amdgcn_exp2f(p1[r]);
  float ps = 0;
#pragma unroll
  for (int r = 0; r < 16; ++r) ps += p0[r];
#pragma unroll
  for (int r = 0; r < 16; ++r) ps += p1[r];
  { auto rr = __builtin_amdgcn_permlane32_swap(__float_as_uint(ps), __float_as_uint(ps), false, false);
    ps = __uint_as_float(rr[0]) + __uint_as_float(rr[1]); }
  l_reg = l_reg * alpha + ps;
#define PK4(P, BASE, OUT) do { unsigned a0 = cvtpk(P[BASE + 0], P[BASE + 1]), a1 = cvtpk(P[BASE + 2], P[BASE + 3]);   \
    unsigned b0 = cvtpk(P[BASE + 4], P[BASE + 5]), b1 = cvtpk(P[BASE + 6], P[BASE + 7]);                              \
    auto r0 = __builtin_amdgcn_permlane32_swap(a0, b0, false, false); auto r1 = __builtin_amdgcn_permlane32_swap(a1, b1, false, false); \
    u32x4 w = {r0[0], r1[0], r0[1], r1[1]}; OUT = *reinterpret_cast<bf16x8*>(&w); } while (0)
  PK4(p0, 0, pa0); PK4(p0, 8, pa1); PK4(p1, 0, pa2); PK4(p1, 8, pa3);
#undef PK4
}
__device__ __forceinline__ void a_qkt(f32x16& p0, f32x16& p1, const char* Ks, const bf16x8* qr, int r32, int hi) {
  p0 = f32x16{}; p1 = f32x16{};
#pragma unroll
  for (int d0 = 0; d0 < 6; ++d0) {
    const int cb = (d0 * 16 + hi * 8) * 2;
    const bf16x8 b0 = *reinterpret_cast<const bf16x8*>(Ks + r32 * A_KROW + cb);
    const bf16x8 b1 = *reinterpret_cast<const bf16x8*>(Ks + (32 + r32) * A_KROW + cb);
    p0 = __builtin_amdgcn_mfma_f32_32x32x16_bf16(b0, qr[d0], p0, 0, 0, 0);
    p1 = __builtin_amdgcn_mfma_f32_32x32x16_bf16(b1, qr[d0], p1, 0, 0, 0);
  }
}
__device__ __forceinline__ int a_v_st(int k, int c) { const int kk = (k & ~0xC) | ((k & 4) << 1) | ((k & 8) >> 1); return ((kk >> 3) * 2 + (c >> 5)) * 512 + ((kk & 7) * 32 + (c & 31)) * 2; }
__device__ __forceinline__ int a_v_rd_base(int lane) { return ((lane & 3) << 3) | (((lane >> 2) & 3) << 6) | (((lane >> 4) & 1) << 5) | (((lane >> 5) & 1) << 8); }
constexpr int a_v_rd_off(int d0, int ks, int half) { return d0 * 512 + ks * 2048 + half * 1024; }
template <int OFF> __device__ __forceinline__ s16x4 a_tr_read(int vb) {
  s16x4 r; asm volatile("ds_read_b64_tr_b16 %0, %1 offset:%2" : "=&v"(r) : "v"(vb), "i"(OFF) : "memory"); return r;
}
template <int D0> __device__ __forceinline__ void a_pv_one(f32x16& od, int vb, bf16x8 pa0, bf16x8 pa1, bf16x8 pa2, bf16x8 pa3) {
  const s16x4 l0 = a_tr_read<a_v_rd_off(D0, 0, 0)>(vb), h0 = a_tr_read<a_v_rd_off(D0, 0, 1)>(vb), l1 = a_tr_read<a_v_rd_off(D0, 1, 0)>(vb), h1 = a_tr_read<a_v_rd_off(D0, 1, 1)>(vb);
  const s16x4 l2 = a_tr_read<a_v_rd_off(D0, 2, 0)>(vb), h2 = a_tr_read<a_v_rd_off(D0, 2, 1)>(vb), l3 = a_tr_read<a_v_rd_off(D0, 3, 0)>(vb), h3 = a_tr_read<a_v_rd_off(D0, 3, 1)>(vb);
  asm volatile("s_waitcnt lgkmcnt(0)" ::: "memory"); SBAR();
#define PK(L, H) (bf16x8){L[0], L[1], L[2], L[3], H[0], H[1], H[2], H[3]}
  od = __builtin_amdgcn_mfma_f32_32x32x16_bf16(pa0, PK(l0, h0), od, 0, 0, 0);
  od = __builtin_amdgcn_mfma_f32_32x32x16_bf16(pa1, PK(l1, h1), od, 0, 0, 0);
  od = __builtin_amdgcn_mfma_f32_32x32x16_bf16(pa2, PK(l2, h2), od, 0, 0, 0);
  od = __builtin_amdgcn_mfma_f32_32x32x16_bf16(pa3, PK(l3, h3), od, 0, 0, 0);
#undef PK
}
__device__ __forceinline__ void a_pv(f32x16* o, int vb, bf16x8 pa0, bf16x8 pa1, bf16x8 pa2, bf16x8 pa3) {
  a_pv_one<0>(o[0], vb, pa0, pa1, pa2, pa3); a_pv_one<1>(o[1], vb, pa0, pa1, pa2, pa3);
}

__device__ __forceinline__ void attn_item(const u16* __restrict__ Qb, const u16* __restrict__ KVh, int seq, u16* __restrict__ yout  , char* lds) {
  const int tid = threadIdx.x, wid = tid >> 6, lane = tid & 63, r32 = lane & 31, hi = lane >> 5;
  char* V_lds = lds; char* K_lds = lds + A_OFF_K;
  float* ws = (float*)(lds + A_OFF_W) + wid * 64; float* li_l = ws; float* al_l = ws + 32;
  float m_reg = -1e30f, l_reg = 0; f32x16 o[2] = {}; bf16x8 qr[6];
  const u16* Qw = Qb + (size_t)(wid * 32 + r32) * 96 + hi * 8;
#pragma unroll
  for (int d0 = 0; d0 < 6; ++d0) qr[d0] = *reinterpret_cast<const bf16x8*>(Qw + d0 * 16);
  int lw[3], lsz[3];
#pragma unroll
  for (int i = 0; i < 3; ++i) {
    const int g = tid + i * 512, key = g / 20, cc = g % 20;
    lw[i] = cc < 12 ? (A_OFF_K + key * A_KROW + cc * 16) : a_v_st(key, (cc - 12) * 8);
    lsz[i] = cc < 12 ? A_SHM_K : A_SHM_V;
  }
  const bool third = wid < 4;
  const int vb0 = (int)(uintptr_t)V_lds + a_v_rd_base(lane);
  struct { bf16x8 g0, g1, g2; } sr_[2];
  const char* gsrc = (const char*)KVh + tid * 16;
#define SLOAD(i, k0) do { const char* s_ = gsrc + (size_t)(k0) * 320; sr_[i].g0 = *(const bf16x8*)(s_); sr_[i].g1 = *(const bf16x8*)(s_ + 8192); \
    if (third) sr_[i].g2 = *(const bf16x8*)(s_ + 16384); } while (0)
#define SWRITE(b, i) do { *(bf16x8*)(lds + lw[0] + (b) * lsz[0]) = sr_[i].g0; *(bf16x8*)(lds + lw[1] + (b) * lsz[1]) = sr_[i].g1; \
    if (third) *(bf16x8*)(lds + lw[2] + (b) * lsz[2]) = sr_[i].g2; } while (0)
#define SWAIT() do { if (third) asm volatile("s_waitcnt vmcnt(3)" ::: "memory"); else asm volatile("s_waitcnt vmcnt(2)" ::: "memory"); } while (0)
#define RESC(a) do { if (__any((a) < 1.f)) { if (hi == 0) al_l[r32] = (a); asm volatile("s_waitcnt lgkmcnt(0)" ::: "memory"); \
    _Pragma("unroll") for (int d = 0; d < 2; ++d) _Pragma("unroll") for (int r = 0; r < 16; ++r) o[d][r] *= al_l[crow(r, hi)]; } } while (0)
  f32x16 pA0, pA1, pB0, pB1; float mnA, mnB, alA, alB; bf16x8 pa0, pa1, pa2, pa3; const int NT = seq / 64;
  constexpr int SE = 0, SO = 1;
  SLOAD(SE, 0); asm volatile("s_waitcnt vmcnt(0)" ::: "memory"); SWRITE(0, SE); __syncthreads();
  a_qkt(pA0, pA1, K_lds, qr, r32, hi); a_partialSM(pA0, pA1, m_reg, mnA, alA);
  SLOAD(SO, 64); if (2 < NT) SLOAD(SE, 128);
  SWAIT(); SWRITE(1, SO); __syncthreads();
  for (int j = 1; j + 1 < NT; j += 2) {
    SBAR(); a_qkt(pB0, pB1, K_lds + A_SHM_K, qr, r32, hi);
    a_finishSM(pA0, pA1, alA, l_reg, pa0, pa1, pa2, pa3); SBAR();
    SLOAD(SO, (j + 2) * 64); SBAR();
    a_pv(o, vb0, pa0, pa1, pa2, pa3); a_partialSM(pB0, pB1, m_reg, mnB, alB);
    __syncthreads(); SWAIT(); SWRITE(0, SE);
    RESC(alB); __syncthreads();
    SBAR(); a_qkt(pA0, pA1, K_lds, qr, r32, hi);
    a_finishSM(pB0, pB1, alB, l_reg, pa0, pa1, pa2, pa3); SBAR();
    if (j + 3 < NT) SLOAD(SE, (j + 3) * 64); SBAR();
    a_pv(o, vb0 + A_SHM_V, pa0, pa1, pa2, pa3); a_partialSM(pA0, pA1, m_reg, mnA, alA);
    __syncthreads(); SWAIT(); SWRITE(1, SO);
    RESC(alA); __syncthreads();
  }
  SBAR(); a_qkt(pB0, pB1, K_lds + A_SHM_K, qr, r32, hi);
  a_finishSM(pA0, pA1, alA, l_reg, pa0, pa1, pa2, pa3); SBAR();
  a_pv(o, vb0, pa0, pa1, pa2, pa3); a_partialSM(pB0, pB1, m_reg, mnB, alB);
  __syncthreads(); RESC(alB);
  a_finishSM(pB0, pB1, alB, l_reg, pa0, pa1, pa2, pa3); SBAR();
  a_pv(o, vb0 + A_SHM_V, pa0, pa1, pa2, pa3);
  if (hi == 0) li_l[r32] = l_reg; asm volatile("s_waitcnt lgkmcnt(0)" ::: "memory");
#pragma unroll
  for (int r = 0; r < 16; ++r) {
    const int orow = crow(r, hi);
    const float rl = __builtin_amdgcn_rcpf(li_l[orow]);
    const float v0 = o[0][r] * rl, v1 = o[1][r] * rl;
    float ss = v0 * v0 + v1 * v1;
#pragma unroll
    for (int off = 16; off > 0; off >>= 1) ss += __shfl_xor(ss, off, 64);
    const float rs = rsqrtf(ss * (1.f / 64.f) + EPS);
    u16* dst = yout + (size_t)(wid * 32 + orow) * DM;
    dst[r32] = f2bf(v0 * rs); dst[32 + r32] = f2bf(v1 * rs);
  }
  __syncthreads();
#undef SLOAD
#undef SWRITE
#undef SWAIT
#undef RESC
}

__device__ __forceinline__ void phase_attn(const Params& p, int layer, int bid, int nb, char* lds) {
  const int nitems = 512 + (layer == 0 ? 8 : 0);
  for (int it = bid; it < nitems; it += nb) {
    int b, h, q0, k0, seq, tok0;
    if (it < 512) { const int qb = it & 63; h = (it >> 6) & 3; b = it >> 8; q0 = qb * 256; k0 = 0; seq = SKV; tok0 = b * SEQ + qb * 256; }
    else { const int i2 = it - 512; h = i2 & 3; b = i2 >> 2; q0 = SEQ; k0 = SEQ; seq = LC; tok0 = TL + b * LC; }
    const size_t base = (size_t)(b * 4 + h) * SKV;
    attn_item(p.Q + (base + q0) * 96, p.KV + (base + k0) * 160, seq, p.ymix + (size_t)tok0 * DM + h * 64, lds);
  }
}
__device__ __forceinline__ float hy_sconv(const float* __restrict__ row, int t, int Ls, float w0, float w1, float w2, float bb) {
  const float zm = t > 0 ? row[t - 1] : 0.f, z0 = row[t], zp = t + 1 < Ls ? row[t + 1] : 0.f;
  return w0 * zm + w1 * z0 + w2 * zp + bb;
}
__device__ __forceinline__ void hyena_item(const Params& p, int layer, int b, int ch, char* lds) {
  float2* s = (float2*)lds;
  const int tid = threadIdx.x;
  const float* cw = p.hy_conv_w + (size_t)layer * 3 * 768; const float* cb = p.hy_conv_b + (size_t)layer * 768;
  const float* r0 = p.zt + (size_t)(ZT_HY + ch) * TT + (size_t)b * SEQ;
  const float* r1 = p.zt + (size_t)(ZT_HY + 256 + ch) * TT + (size_t)b * SEQ;
  const float* r2 = p.zt + (size_t)(ZT_HY + 512 + ch) * TT + (size_t)b * SEQ;
  const float a0 = cw[ch], a1 = cw[768 + ch], a2 = cw[1536 + ch], ab = cb[ch];
  const float b0 = cw[256 + ch], b1 = cw[768 + 256 + ch], b2 = cw[1536 + 256 + ch], bb = cb[256 + ch];
  const float c0 = cw[512 + ch], c1 = cw[768 + 512 + ch], c2 = cw[1536 + 512 + ch], cbb = cb[512 + ch];
  for (int m = tid; m < FM; m += NTHR) {
    float2 z = make_float2(0.f, 0.f);
    if (m < SEQ / 2) {
      const int t = 2 * m;
      z.x = hy_sconv(r2, t, SEQ, c0, c1, c2, cbb) * hy_sconv(r1, t, SEQ, b0, b1, b2, bb);
      z.y = hy_sconv(r2, t + 1, SEQ, c0, c1, c2, cbb) * hy_sconv(r1, t + 1, SEQ, b0, b1, b2, bb);
    }
    s[m] = z;
  }
  __syncthreads();
  fft_fwd(s, p.tw);
  const float4* hs = p.hspec + ((size_t)layer * 256 + ch) * HSP;
  for (int k = tid; k <= FM / 2; k += NTHR) {
    const int pk = rev7(k), pm = rev7((FM - k) & (FM - 1));
    const float2 zk = s[pk], zm = s[pm];
    const float4 h = hs[k];
    const float2 He = make_float2(h.x, h.y), Ho = make_float2(h.z, h.w);
    const float2 Xe = make_float2(0.5f * (zk.x + zm.x), 0.5f * (zk.y - zm.y));
    const float2 Xo = make_float2(0.5f * (zk.y + zm.y), -0.5f * (zk.x - zm.x));
    const float2 t1 = cmul(p.tw[k], cmul(Xo, Ho));
    const float2 e1 = cmul(Xe, He);
    const float2 Ye = make_float2(e1.x + t1.x, e1.y + t1.y);
    const float2 o1 = cmul(Xe, Ho), o2 = cmul(Xo, He);
    const float2 Yo = make_float2(o1.x + o2.x, o1.y + o2.y);
    s[pk] = make_float2(Ye.x - Yo.y, Ye.y + Yo.x);
    if (pm != pk) s[pm] = make_float2(Ye.x + Yo.y, -Ye.y + Yo.x);
  }
  __syncthreads();
  fft_inv(s, p.tw);
  const float hb = p.hy_bias[layer * 256 + ch];
  float* orow = p.hyo + (size_t)ch * TT + (size_t)b * SEQ;
  for (int m = tid; m < SEQ / 2; m += NTHR) {
    const int t = 2 * m;
    const float2 y = s[m];
    const float vg0 = hy_sconv(r2, t, SEQ, c0, c1, c2, cbb) * hy_sconv(r1, t, SEQ, b0, b1, b2, bb);
    const float vg1 = hy_sconv(r2, t + 1, SEQ, c0, c1, c2, cbb) * hy_sconv(r1, t + 1, SEQ, b0, b1, b2, bb);
    const float x00 = hy_sconv(r0, t, SEQ, a0, a1, a2, ab), x01 = hy_sconv(r0, t + 1, SEQ, a0, a1, a2, ab);
    *(float2*)(orow + t) = make_float2((y.x + vg0 * hb) * x00, (y.y + vg1 * hb) * x01);
  }
  __syncthreads();
}
__device__ __forceinline__ void fnet_item(const Params& p, int b, int j, char* lds) {
  float2* s = (float2*)lds;
  const int tid = threadIdx.x;
  const float* rr = p.zt + (size_t)(ZT_FR + j) * TT + (size_t)b * SEQ;
  const float* ri = p.zt + (size_t)(ZT_FI + j) * TT + (size_t)b * SEQ;
  for (int m = tid; m < FM; m += NTHR) s[m] = make_float2(rr[m], ri[m]);
  __syncthreads();
  fft_fwd(s, p.tw);
  float* orow = p.fno + (size_t)j * TT + (size_t)b * SEQ;
  for (int k = tid; k < FM; k += NTHR) orow[k] = s[rev7(k)].x * (1.f / 128.f);
  __syncthreads();
}
__device__ __forceinline__ void hyena_ctx_item(const Params& p, int b, int ch, char* lds) {
  float* vg = (float*)lds;
  float* x0 = vg + 256;
  float* hf = x0 + 256;
  float* hbk = hf + 256;
  const int tid = threadIdx.x;
  const float* cw = p.hy_conv_w; const float* cb = p.hy_conv_b;
  const size_t off = (size_t)TL + (size_t)b * LC;
  const float* r0 = p.zt + (size_t)(ZT_HY + ch) * TT + off;
  const float* r1 = p.zt + (size_t)(ZT_HY + 256 + ch) * TT + off;
  const float* r2 = p.zt + (size_t)(ZT_HY + 512 + ch) * TT + off;
  if (tid < 256) {
    const int t = tid;
    vg[t] = hy_sconv(r2, t, LC, cw[512 + ch], cw[768 + 512 + ch], cw[1536 + 512 + ch], cb[512 + ch]) *
            hy_sconv(r1, t, LC, cw[256 + ch], cw[768 + 256 + ch], cw[1536 + 256 + ch], cb[256 + ch]);
    x0[t] = hy_sconv(r0, t, LC, cw[ch], cw[768 + ch], cw[1536 + ch], cb[ch]);
    hf[t] = p.hfc[(size_t)ch * LC + t]; hbk[t] = p.hfc[(size_t)(256 + ch) * LC + t];
  }
  __syncthreads();
  if (tid < 256) {
    const int t = tid; float y = 0;
    for (int q = 0; q <= t; ++q) y += hf[t - q] * vg[q];
    for (int q = t + 1; q < LC; ++q) y += hbk[q - t] * vg[q];
    y *= rsqrtf(p.hssq[512 + ch]);
    p.hyo[(size_t)ch * TT + off + t] = (y + vg[t] * p.hy_bias[ch]) * x0[t];
  }
  __syncthreads();
}
__device__ __forceinline__ void fnet_ctx_item(const Params& p, int b, int j, char* lds) {
  float* ur = (float*)lds; float* ui = ur + 256; float* cst = ui + 256; float* snt = cst + 256;
  const int tid = threadIdx.x;
  const size_t off = (size_t)TL + (size_t)b * LC;
  if (tid < 256) {
    ur[tid] = p.zt[(size_t)(ZT_FR + j) * TT + off + tid]; ui[tid] = p.zt[(size_t)(ZT_FI + j) * TT + off + tid];
    float sn, cs; sincospif((float)tid / 128.f, &sn, &cs); cst[tid] = cs; snt[tid] = sn;
  }
  __syncthreads();
  if (tid < 256) {
    const int k = tid; float y = 0;
    for (int l = 0; l < 256; ++l) { const int m = (l * k) & 255; y += cst[m] * ur[l] + snt[m] * ui[l]; }
    p.fno[(size_t)j * TT + off + k] = y * 0.0625f;
  }
  __syncthreads();
}
__device__ __forceinline__ void phase_fftmix(const Params& p, int layer, int bid, int nb, char* lds) {
  const int nitems = layer == 0 ? 2048 : 1024;
  for (int it = bid; it < nitems; it += nb) {
    const int k = it & 511, b = k >> 8, c = k & 255;
    if (it < 512) hyena_item(p, layer, b, c, lds);
    else if (it < 1024) fnet_item(p, b, c, lds);
    else if (it < 1536) hyena_ctx_item(p, b, c, lds);
    else fnet_ctx_item(p, b, c, lds);
  }
}
__device__ __forceinline__ int gla_tok0(int b, int pc) { return pc < 4 ? TL + b * LC + pc * 64 : b * SEQ + (pc - 4) * 64; }
__device__ __forceinline__ int gla_chain_chunk(int pc, int dir) {
  if (dir == 0) return pc;
  return pc < 4 ? 3 - pc : 4 + 255 - (pc - 4);
}
struct GlaLds { float* kq; float* q; float* v; float* cb; };
__device__ __forceinline__ void gla_load(const Params& p, int layer, int tok0, int h, bool need_q, const GlaLds& L) {
  const int tid = threadIdx.x;
  for (int i = tid; i < 64 * 32; i += NTHR) {
    const int r = i >> 5, c = i & 31;
    const float* zr = p.zg + (size_t)(tok0 + r) * ZG_W;
    L.kq[r * 33 + c] = zr[ZG_GK + h * 32 + c];
    if (need_q) L.q[r * 33 + c] = zr[ZG_GQ + h * 32 + c] * 0.17677669529663687f;
  }
  for (int i = tid; i < 64 * 64; i += NTHR) {
    const int r = i >> 6, c = i & 63;
    L.v[r * 65 + c] = p.zg[(size_t)(tok0 + r) * ZG_W + ZG_GV + h * 64 + c];
  }
  const float* gb = p.gla_gk_b + (size_t)layer * 256;
  for (int i = tid; i < 2 * 64 * 32; i += NTHR) {
    const int dir = i >> 11, r = (i >> 5) & 63, c = i & 31;
    const int pos = dir ? 63 - r : r;
    const float x = p.zg[(size_t)(tok0 + pos) * ZG_W + ZG_GP + dir * 128 + h * 32 + c] + gb[dir * 128 + h * 32 + c];
    L.cb[(dir * 64 + r) * 33 + c] = (fminf(x, 0.f) - log1pf(__expf(-fabsf(x)))) * (1.f / 16.f);
  }
  __syncthreads();
  if (tid < 64) {
    const int dir = tid >> 5, c = tid & 31; float acc = 0;
    for (int r = 0; r < 64; ++r) { acc += L.cb[(dir * 64 + r) * 33 + c]; L.cb[(dir * 64 + r) * 33 + c] = acc; }
  }
  __syncthreads();
}
__device__ __forceinline__ GlaLds gla_lds(char* lds) {
  GlaLds L; L.kq = (float*)lds; L.q = L.kq + 64 * 33; L.v = L.q + 64 * 33; L.cb = L.v + 64 * 65; return L;
}
__device__ __forceinline__ void phase_gla_a(const Params& p, int layer, int bid, int nb, char* lds) {
  const GlaLds L = gla_lds(lds);
  const int tid = threadIdx.x;
  for (int it = bid; it < 2 * NCH * 4; it += nb) {
    const int h = it & 3, pc = (it >> 2) % NCH, b = it / (4 * NCH);
    const int tok0 = gla_tok0(b, pc);
    gla_load(p, layer, tok0, h, false, L);
    const int dir = tid >> 8, kk = (tid >> 3) & 31, v0 = (tid & 7) * 8;
    const float bl = L.cb[(dir * 64 + 63) * 33 + kk];
    float acc[8];
#pragma unroll
    for (int j = 0; j < 8; ++j) acc[j] = 0.f;
    for (int i = 0; i < 64; ++i) {
      const int pos = dir ? 63 - i : i;
      const float w = L.kq[pos * 33 + kk] * __expf(bl - L.cb[(dir * 64 + i) * 33 + kk]);
#pragma unroll
      for (int j = 0; j < 8; ++j) acc[j] += w * L.v[pos * 65 + v0 + j];
    }
    const int chain = (dir * 2 + b) * 4 + h, cc = gla_chain_chunk(pc, dir);
    float* ds = p.gds + ((size_t)chain * NCH + cc) * 2048 + kk * 64 + v0;
    *(float4*)ds = make_float4(acc[0], acc[1], acc[2], acc[3]); *(float4*)(ds + 4) = make_float4(acc[4], acc[5], acc[6], acc[7]);
    if ((tid & 7) == 0) p.gdv[((size_t)chain * NCH + cc) * 32 + kk] = __expf(bl);
    __syncthreads();
  }
}
__device__ __forceinline__ void phase_gla_b(const Params& p, int bid, int nb) {
  for (int e = bid * NTHR + threadIdx.x; e < 16 * 2048; e += nb * NTHR) {
    const int chain = e >> 11, kv = e & 2047, kk = kv >> 6;
    const float* ds = p.gds + (size_t)chain * NCH * 2048 + kv;
    const float* dv = p.gdv + (size_t)chain * NCH * 32 + kk;
    float* st = p.gst + (size_t)chain * NCH * 2048 + kv;
    float S = 0.f;
#pragma unroll 4
    for (int n = 0; n < NCH; ++n) {
      st[(size_t)n * 2048] = S;
      S = S * dv[n * 32] + ds[(size_t)n * 2048];
    }
  }
}
__device__ __forceinline__ void phase_gla_c(const Params& p, int layer, int bid, int nb, char* lds) {
  const GlaLds L = gla_lds(lds);
  float* Am = L.cb + 2 * 64 * 33;
  float* Ss = Am + 2 * 64 * 65;
  float* ob = Ss + 2 * 32 * 65;
  const int tid = threadIdx.x;
  const int nitem = layer == 0 ? 2 * NCH * 4 : 2 * NCH * 4;
  for (int it = bid; it < nitem; it += nb) {
    const int h = it & 3, pc = (it >> 2) % NCH, b = it / (4 * NCH);
    if (layer == 1 && pc < 4) continue;
    const int tok0 = gla_tok0(b, pc);
    gla_load(p, layer, tok0, h, true, L);
    for (int i = tid; i < 2 * 2048; i += NTHR) {
      const int dir = i >> 11, kv = i & 2047;
      const int chain = (dir * 2 + b) * 4 + h, cc = gla_chain_chunk(pc, dir);
      Ss[(dir * 32 + (kv >> 6)) * 65 + (kv & 63)] = p.gst[((size_t)chain * NCH + cc) * 2048 + kv];
    }
    for (int e = tid; e < 2 * 64 * 64; e += NTHR) {
      const int dir = e >> 12, i = (e >> 6) & 63, j = e & 63;
      float a = 0.f;
      if (j <= i) {
        const int pi = dir ? 63 - i : i, pj = dir ? 63 - j : j;
        for (int k = 0; k < 32; ++k) a += L.q[pi * 33 + k] * L.kq[pj * 33 + k] * __expf(L.cb[(dir * 64 + i) * 33 + k] - L.cb[(dir * 64 + j) * 33 + k]);
      }
      Am[(dir * 64 + i) * 65 + j] = a;
    }
    __syncthreads();
    {
      const int dir = tid >> 8, i = (tid >> 2) & 63, v0 = (tid & 3) * 16;
      const int pi = dir ? 63 - i : i;
      float acc[16];
#pragma unroll
      for (int j = 0; j < 16; ++j) acc[j] = 0.f;
      for (int k = 0; k < 32; ++k) {
        const float w = L.q[pi * 33 + k] * __expf(L.cb[(dir * 64 + i) * 33 + k]);
#pragma unroll
        for (int j = 0; j < 16; ++j) acc[j] += w * Ss[(dir * 32 + k) * 65 + v0 + j];
      }
      for (int jj = 0; jj <= i; ++jj) {
        const float w = Am[(dir * 64 + i) * 65 + jj]; const int pj = dir ? 63 - jj : jj;
#pragma unroll
        for (int j = 0; j < 16; ++j) acc[j] += w * L.v[pj * 65 + v0 + j];
      }
      if (dir == 1) {
#pragma unroll
        for (int j = 0; j < 16; ++j) ob[pi * 65 + v0 + j] = acc[j];
      }
      __syncthreads();
      if (dir == 0) {
        float* o = p.glao + (size_t)(tok0 + pi) * 256 + h * 64 + v0;
#pragma unroll
        for (int j = 0; j < 16; j += 4)
          *(float4*)(o + j) = make_float4(acc[j] + ob[pi * 65 + v0 + j], acc[j + 1] + ob[pi * 65 + v0 + j + 1], acc[j + 2] + ob[pi * 65 + v0 + j + 2], acc[j + 3] + ob[pi * 65 + v0 + j + 3]);
      }
    }
    __syncthreads();
  }
}

__device__ __forceinline__ void phase_mix(const Params& p, int layer, int bid, int nb, char* lds) {
  float* part = (float*)lds;
  u16* tile = (u16*)(lds + 4096);
  const int tid = threadIdx.x, wid = tid >> 6, lane = tid & 63;
  const int ntok = layer == 0 ? TT : TL;
  for (int it = bid; it < ntok / 64; it += nb) {
    const int tok0 = it * 64;
    float vh[32], vf[32]; float sh = 0, sf = 0;
#pragma unroll
    for (int c = 0; c < 32; ++c) {
      vh[c] = p.hyo[(size_t)(wid * 32 + c) * TT + tok0 + lane]; vf[c] = p.fno[(size_t)(wid * 32 + c) * TT + tok0 + lane];
      sh += vh[c] * vh[c]; sf += vf[c] * vf[c];
    }
    part[(0 * 8 + wid) * 64 + lane] = sh; part[(1 * 8 + wid) * 64 + lane] = sf;
    __syncthreads();
    float th = 0, tf = 0;
#pragma unroll
    for (int q = 0; q < 8; ++q) { th += part[(0 * 8 + q) * 64 + lane]; tf += part[(1 * 8 + q) * 64 + lane]; }
    const float rh = rsqrtf(th * (1.f / 256.f) + EPS), rf = rsqrtf(tf * (1.f / 256.f) + EPS);
#pragma unroll
    for (int c = 0; c < 32; ++c) { tile[lane * 520 + wid * 32 + c] = f2bf(vh[c] * rh); tile[lane * 520 + 256 + wid * 32 + c] = f2bf(vf[c] * rf); }
    __syncthreads();
    for (int g = tid; g < 64 * 64; g += NTHR) {
      const int tl = g >> 6, cg = g & 63;
      const u32x4 w = *(const u32x4*)(tile + tl * 520 + cg * 8);
      *(u32x4*)(p.ymix + (size_t)(tok0 + tl) * DM + (cg < 32 ? 256 + cg * 8 : 768 + (cg - 32) * 8)) = w;
    }
    for (int tl = wid * 8; tl < wid * 8 + 8; ++tl) {
      const int tok = tok0 + tl;
      const float4 o = *(const float4*)(p.glao + (size_t)tok * 256 + lane * 4);
      float ss = o.x * o.x + o.y * o.y + o.z * o.z + o.w * o.w;
#pragma unroll
      for (int off = 8; off > 0; off >>= 1) ss += __shfl_xor(ss, off, 64);
      const float rs = rsqrtf(ss * (1.f / 64.f) + EPS);
      const float4 g = *(const float4*)(p.zg + (size_t)tok * ZG_W + ZG_OG + lane * 4);
      u32x2 w; w[0] = cvtpk(o.x * rs * silu_f(g.x), o.y * rs * silu_f(g.y)); w[1] = cvtpk(o.z * rs * silu_f(g.z), o.w * rs * silu_f(g.w));
      *(u32x2*)(p.ymix + (size_t)tok * DM + 512 + lane * 4) = w;
    }
    __syncthreads();
  }
}

__device__ __forceinline__ void phase_gemm_out(const Params& p, int layer, int bid, int nb, char* lds) {
  const int tid = threadIdx.x, wid = tid >> 6, lane = tid & 63, wr = wid >> 2, wc = wid & 3, fr = lane & 15, fq = lane >> 4;
  int sR[4], sC[4]; gemm_stage_coords(sR, sC);
  const u16* Bt = p.bt_out + (size_t)layer * DM * DM;
  const int nM = (layer == 0 ? TT : TL) / 256; constexpr int nN = DM / 256;
  for (int t = bid; t < nM * nN; t += nb) {
    const int pm = t / nN, pn = t % nN, brow = pm * 256, bcol = pn * 256;
    const u16* ap[4]; const u16* bp[4];
#pragma unroll
    for (int i = 0; i < 4; ++i) { ap[i] = p.ymix + (size_t)(brow + sR[i]) * DM + sC[i]; bp[i] = Bt + (size_t)(bcol + sR[i]) * DM + sC[i]; }
    f32x4 acc[8][4];
    gemm256_core(ap, bp, DM / 64, lds, acc);
    const float* g1 = p.mod + ((size_t)layer * 3 + modv(brow)) * 6144 + 2 * DM;
#pragma unroll
    for (int m = 0; m < 8; ++m)
#pragma unroll
      for (int j = 0; j < 4; ++j) {
        const int tok = brow + wr * 128 + m * 16 + fq * 4 + j;
        const float* xr = resid_row(p, layer == 0 ? 0 : 1, tok);
        float* xo = p.X + (size_t)tok * DM;
#pragma unroll
        for (int n = 0; n < 4; ++n) { const int c = bcol + wc * 64 + n * 16 + fr; xo[c] = xr[c] + g1[c] * acc[m][n][j]; }
      }
  }
}

__device__ __forceinline__ void phase_norm2_router(const Params& p, int layer, int bid, int nb, char* lds) {
  float* rwl = (float*)lds;
  int* lcnt = (int*)(lds + 131072);
  int* lbase = lcnt + 32;
  int* ent = lbase + 32;
  float* entw = (float*)(ent + 2 * 1024);
  const int tid = threadIdx.x, wid = tid >> 6, lane = tid & 63;
  const int ntok = layer == 0 ? TT : TL;
  const float* rw = p.router_w + (size_t)layer * DM * NE;
  for (int i = tid; i < DM * NE / 4; i += NTHR) {
    const int k = i >> 3, q4 = i & 7;
    ((float4*)rwl)[q4 * 1024 + ((k & 3) * 256 + (k >> 2))] = ((const float4*)rw)[i];
  }
  if (tid < 32) lcnt[tid] = 0;
  __syncthreads();
  const float* gn = p.norm2_g + layer * DM; const float* rb = p.router_b + layer * NE;
  const int per = (ntok + nb - 1) / nb, t_beg = bid * per, t_end = min(ntok, t_beg + per);
  for (int tok = t_beg + wid; tok < t_end; tok += 8) {
    const float* xr = p.X + (size_t)tok * DM;
    float v[16];
#pragma unroll
    for (int i = 0; i < 4; ++i) { const float4 a = *(const float4*)(xr + lane * 4 + i * 256); v[4 * i] = a.x; v[4 * i + 1] = a.y; v[4 * i + 2] = a.z; v[4 * i + 3] = a.w; }
    float ss = 0;
#pragma unroll
    for (int i = 0; i < 16; ++i) ss += v[i] * v[i];
    ss = wave_sum(ss);
    const float rs = rsqrtf(ss * (1.f / DM) + EPS);
    const float* md = p.mod + ((size_t)layer * 3 + modv(tok)) * 6144 + 3 * DM;
    u16* h = p.H + (size_t)tok * DM;
#pragma unroll
    for (int i = 0; i < 4; ++i) {
      const int c = lane * 4 + i * 256;
      const float4 g = *(const float4*)(gn + c), sh = *(const float4*)(md + c), sc = *(const float4*)(md + DM + c);
      v[4 * i] = v[4 * i] * rs * g.x * (1.f + sc.x) + sh.x; v[4 * i + 1] = v[4 * i + 1] * rs * g.y * (1.f + sc.y) + sh.y;
      v[4 * i + 2] = v[4 * i + 2] * rs * g.z * (1.f + sc.z) + sh.z; v[4 * i + 3] = v[4 * i + 3] * rs * g.w * (1.f + sc.w) + sh.w;
      u32x2 w; w[0] = cvtpk(v[4 * i], v[4 * i + 1]); w[1] = cvtpk(v[4 * i + 2], v[4 * i + 3]);
      *(u32x2*)(h + c) = w;
    }
    float lg[32];
#pragma unroll
    for (int e = 0; e < 32; ++e) lg[e] = 0.f;
#pragma unroll
    for (int i = 0; i < 16; ++i) {
      const float4* wr4 = (const float4*)rwl + ((i & 3) * 256 + (i >> 2) * 64 + lane);
#pragma unroll
      for (int q = 0; q < 8; ++q) { const float4 w = wr4[q * 1024]; lg[4 * q] += v[i] * w.x; lg[4 * q + 1] += v[i] * w.y; lg[4 * q + 2] += v[i] * w.z; lg[4 * q + 3] += v[i] * w.w; }
    }
#pragma unroll
    for (int e = 0; e < 32; ++e) lg[e] = wave_sum(lg[e]) + rb[e];
    if (lane == 0) {
      int ids[4]; float vals[4]; unsigned used = 0;
#pragma unroll
      for (int k = 0; k < 4; ++k) {
        float best = -3.4e38f; int bi = 0;
#pragma unroll
        for (int e = 0; e < 32; ++e) { const bool ok = !((used >> e) & 1u) && lg[e] > best; best = ok ? lg[e] : best; bi = ok ? e : bi; }
        used |= 1u << bi; ids[k] = bi; vals[k] = best;
      }
      const float mx = vals[0];
      float ex[4], sum = 0;
#pragma unroll
      for (int k = 0; k < 4; ++k) { ex[k] = __expf(vals[k] - mx); sum += ex[k]; }
      const float inv = 1.f / sum;
#pragma unroll
      for (int k = 0; k < 4; ++k) {
        const int lp = atomicAdd(&lcnt[ids[k]], 1);
        const int slot = (tok - t_beg) * 4 + k;
        ent[2 * slot] = tok * 4 + k; ent[2 * slot + 1] = (ids[k] << 20) | lp; entw[slot] = ex[k] * inv;
      }
    }
  }
  __syncthreads();
  if (tid < 32) lbase[tid] = atomicAdd(&p.cnt[layer * NE + tid], lcnt[tid]);
  __syncthreads();
  const int nas = (t_end > t_beg ? (t_end - t_beg) : 0) * 4;
  for (int s = tid; s < nas; s += NTHR) {
    const int tk = ent[2 * s], el = ent[2 * s + 1], e = el >> 20, pos = lbase[e] + (el & 0xFFFFF);
    p.rtok[(size_t)e * TT + pos] = tk >> 2; p.rw[(size_t)e * TT + pos] = entw[s];
    p.tslot[tk] = (e << 20) | pos;
  }
}

__device__ __forceinline__ bool moe_find(const int* cnt, int w, int ntn, int& e, int& mt, int& nt_, int& pre) {
  int acc = 0, rows = 0;
  for (int ee = 0; ee < NE; ++ee) {
    const int c = cnt[ee], tiles = ((c + 255) >> 8) * ntn;
    if (w < acc + tiles) { const int r = w - acc; e = ee; mt = r / ntn; nt_ = r % ntn; pre = rows; return true; }
    acc += tiles; rows += c;
  }
  return false;
}
__device__ __forceinline__ void phase_moe_gu(const Params& p, int layer, int bid, int nb, char* lds) {
  const int tid = threadIdx.x, wid = tid >> 6, lane = tid & 63, wr = wid >> 2, wc = wid & 3, fr = lane & 15, fq = lane >> 4;
  int sR[4], sC[4]; gemm_stage_coords(sR, sC);
  int* scnt = (int*)(lds + GEMM_LDS);
  if (tid < NE) scnt[tid] = p.cnt[layer * NE + tid];
  __syncthreads();
  for (int w = bid;; w += nb) {
    int e, mt, pn, pre;
    if (!moe_find(scnt, w, 8, e, mt, pn, pre)) break;
    const int ce = scnt[e];
    const u16* Bt = p.bt_gu + ((size_t)layer * NE + e) * 2048 * DM;
    const u16* ap[4]; const u16* bp[4];
#pragma unroll
    for (int i = 0; i < 4; ++i) {
      const int r = min(mt * 256 + sR[i], ce - 1);
      ap[i] = p.H + (size_t)p.rtok[(size_t)e * TT + r] * DM + sC[i];
      bp[i] = Bt + (size_t)(pn * 256 + sR[i]) * DM + sC[i];
    }
    f32x4 acc[8][4];
    gemm256_core(ap, bp, DM / 64, lds, acc);
    const int jb = (pn * 256 + wc * 64) >> 1;
    const float* bg = p.moe_b_gu + ((size_t)layer * NE + e) * 2048;
#pragma unroll
    for (int n = 0; n < 2; ++n) {
      const int j = jb + n * 16 + fr;
      const float bgate = bg[2 * j], bup = bg[2 * j + 1];
#pragma unroll
      for (int m = 0; m < 8; ++m)
#pragma unroll
        for (int jj = 0; jj < 4; ++jj) {
          const int r = mt * 256 + wr * 128 + m * 16 + fq * 4 + jj;
          if (r < ce) {
            const float gate = fminf(acc[m][n][jj] + bgate, 7.f);
            const float up = fminf(fmaxf(acc[m][n + 2][jj] + bup, -7.f), 7.f);
            const float glu = gate / (1.f + __expf(-1.702f * gate));
            p.act[(size_t)(pre + r) * DFF + j] = f2bf((up + 1.f) * glu);
          }
        }
    }
  }
}
__device__ __forceinline__ void phase_moe_dn(const Params& p, int layer, int bid, int nb, char* lds) {
  const int tid = threadIdx.x, wid = tid >> 6, lane = tid & 63, wr = wid >> 2, wc = wid & 3, fr = lane & 15, fq = lane >> 4;
  int sR[4], sC[4]; gemm_stage_coords(sR, sC);
  int* scnt = (int*)(lds + GEMM_LDS);
  if (tid < NE) scnt[tid] = p.cnt[layer * NE + tid];
  __syncthreads();
  for (int w = bid;; w += nb) {
    int e, mt, pn, pre;
    if (!moe_find(scnt, w, 4, e, mt, pn, pre)) break;
    const int ce = scnt[e];
    const u16* Bt = p.bt_dn + ((size_t)layer * NE + e) * DM * DFF;
    const u16* ap[4]; const u16* bp[4];
#pragma unroll
    for (int i = 0; i < 4; ++i) {
      const int r = min(mt * 256 + sR[i], ce - 1);
      ap[i] = p.act + (size_t)(pre + r) * DFF + sC[i];
      bp[i] = Bt + (size_t)(pn * 256 + sR[i]) * DFF + sC[i];
    }
    f32x4 acc[8][4];
    gemm256_core(ap, bp, DFF / 64, lds, acc);
    const float* bd = p.moe_b_down + ((size_t)layer * NE + e) * DM;
#pragma unroll
    for (int m = 0; m < 8; ++m)
#pragma unroll
      for (int jj = 0; jj < 4; ++jj) {
        const int r = mt * 256 + wr * 128 + m * 16 + fq * 4 + jj;
        if (r < ce) {
          const float wgt = p.rw[(size_t)e * TT + r];
          u16* y = p.yd + (size_t)(pre + r) * DM;
#pragma unroll
          for (int n = 0; n < 4; ++n) { const int c = pn * 256 + wc * 64 + n * 16 + fr; y[c] = f2bf((acc[m][n][jj] + bd[c]) * wgt); }
        }
      }
  }
}

__device__ __forceinline__ void phase_final(const Params& p, int bid, int nb, char* lds) {
  int* pre = (int*)lds;
  expert_prefix(p.cnt + NE, pre); __syncthreads();
  const int wid = threadIdx.x >> 6, lane = threadIdx.x & 63;
  for (int tok = bid * 8 + wid; tok < TL; tok += nb * 8) {
    float v[16];
    load_row_comb(p, 1, 1, tok, lane, pre, v);
    float ss = 0;
#pragma unroll
    for (int i = 0; i < 16; ++i) ss += v[i] * v[i];
    ss = wave_sum(ss);
    const float rs = rsqrtf(ss * (1.f / DM) + EPS);
    float* o = p.out + (size_t)tok * DM;
#pragma unroll
    for (int i = 0; i < 4; ++i) {
      const int c = lane * 4 + i * 256;
      const float4 g = *(const float4*)(p.final_g + c);
      *(float4*)(o + c) = make_float4(v[4 * i] * rs * g.x, v[4 * i + 1] * rs * g.y, v[4 * i + 2] * rs * g.z, v[4 * i + 3] * rs * g.w);
    }
  }
}
constexpr int LDS_BYTES = 147456;
enum { PH_TABLES = 0, PH_MOD, PH_FOLD, PH_CONVERT, PH_HYMLP, PH_HYFILT, PH_NORM1, PH_GEMM_IN, PH_QKV, PH_ATTN, PH_FFTMIX,
       PH_GLA_A, PH_GLA_B, PH_GLA_C, PH_MIX, PH_GEMM_OUT, PH_NORM2, PH_MOE_GU, PH_MOE_DN, PH_FINAL };

template <int PH>
__global__ void __launch_bounds__(NTHR, 2) k_phase(Params p, int layer) {
  extern __shared__ __attribute__((aligned(1024))) char lds[];
  const int bid = blockIdx.x, nb = gridDim.x;
  if constexpr (PH == PH_TABLES) phase_tables(p, bid, nb);
  else if constexpr (PH == PH_MOD) phase_mod(p, bid, nb, lds);
  else if constexpr (PH == PH_FOLD) phase_fold(p, bid, nb, lds);
  else if constexpr (PH == PH_CONVERT) phase_convert(p, bid, nb, lds);
  else if constexpr (PH == PH_HYMLP) {
    if (layer < 2) phase_hy_mlp(p, layer, SEQ, p.hfb + (size_t)layer * 2 * 256 * SEQ, p.hssq + layer * 256, bid, nb, lds);
    else phase_hy_mlp(p, 0, LC, p.hfc, p.hssq + 512, bid, nb, lds);
  }
  else if constexpr (PH == PH_HYFILT) phase_hy_filtfft(p, bid, nb, lds);
  else if constexpr (PH == PH_NORM1) phase_norm1(p, layer, bid, nb, lds);
  else if constexpr (PH == PH_GEMM_IN) phase_gemm_in(p, layer, bid, nb, lds);
  else if constexpr (PH == PH_QKV) phase_qkv(p, layer, bid, nb, lds);
  else if constexpr (PH == PH_ATTN) phase_attn(p, layer, bid, nb, lds);
  else if constexpr (PH == PH_FFTMIX) phase_fftmix(p, layer, bid, nb, lds);
  else if constexpr (PH == PH_GLA_A) phase_gla_a(p, layer, bid, nb, lds);
  else if constexpr (PH == PH_GLA_B) phase_gla_b(p, bid, nb);
  else if constexpr (PH == PH_GLA_C) phase_gla_c(p, layer, bid, nb, lds);
  else if constexpr (PH == PH_MIX) phase_mix(p, layer, bid, nb, lds);
  else if constexpr (PH == PH_GEMM_OUT) phase_gemm_out(p, layer, bid, nb, lds);
  else if constexpr (PH == PH_NORM2) phase_norm2_router(p, layer, bid, nb, lds);
  else if constexpr (PH == PH_MOE_GU) phase_moe_gu(p, layer, bid, nb, lds);
  else if constexpr (PH == PH_MOE_DN) phase_moe_dn(p, layer, bid, nb, lds);
  else if constexpr (PH == PH_FINAL) phase_final(p, bid, nb, lds);
}

static size_t carve(char*& cur, size_t bytes) { char* r = cur; cur += (bytes + 1023) & ~(size_t)1023; return (size_t)(uintptr_t)r; }
#define CARVE(T, field, n) p.field = (T*)carve(cur, (size_t)(n) * sizeof(T))

template <int PH> static void launch_phase(const Params& p, int layer, hipStream_t stream) {
  static bool attr = false;
  if (!attr) { hipFuncSetAttribute((const void*)k_phase<PH>, hipFuncAttributeMaxDynamicSharedMemorySize, LDS_BYTES); attr = true; }
  hipLaunchKernelGGL(k_phase<PH>, dim3(256), dim3(NTHR), LDS_BYTES, stream, p, layer);
}

extern "C" void kernel_launch(void* const* d_in, const int* in_sizes, int n_in, void* d_out, int out_size, void* d_ws, size_t ws_size, hipStream_t stream) {
  Params p; memset(&p, 0, sizeof(p));
  const float** ins = (const float**)&p;
  for (int i = 0; i < 34; ++i) ins[i] = (const float*)d_in[i];
  p.out = (float*)d_out;
  char* cur = (char*)d_ws;
  CARVE(unsigned, bar, 4096);
  CARVE(int, cnt, 64);
  CARVE(float, hssq, 768);
  CARVE(float, mod, 2 * 3 * 6144);
  CARVE(float, ropec, SEQ * 16); CARVE(float, ropes, SEQ * 16);
  CARVE(float2, tw, FM);
  CARVE(u16, bt_in, (size_t)2 * NIN * DM);
  CARVE(u16, bt_q, 2 * 512 * 256); CARVE(u16, bt_kv, 2 * 512 * 128);
  CARVE(u16, bt_out, (size_t)2 * DM * DM);
  CARVE(u16, bt_gu, (size_t)2 * NE * 2048 * DM); CARVE(u16, bt_dn, (size_t)2 * NE * DM * DFF);
  CARVE(float, hfb, (size_t)2 * 2 * 256 * SEQ); CARVE(float, hfc, 2 * 256 * LC);
  CARVE(float4, hspec, (size_t)2 * 256 * HSP);
  CARVE(u16, H, (size_t)TT * DM);
  CARVE(u16, zq, (size_t)TT * 256); CARVE(u16, zkv, (size_t)TT * 128);
  CARVE(float, zg, (size_t)TT * ZG_W); CARVE(float, zt, (size_t)ZT_R * TT);
  CARVE(u16, Q, (size_t)2 * 4 * SKV * 96); CARVE(u16, KV, (size_t)2 * 4 * SKV * 160);
  CARVE(u16, ymix, (size_t)TT * DM);
  CARVE(float, hyo, (size_t)256 * TT); CARVE(float, fno, (size_t)256 * TT); CARVE(float, glao, (size_t)TT * 256);
  CARVE(float, gds, (size_t)16 * NCH * 2048); CARVE(float, gdv, (size_t)16 * NCH * 32); CARVE(float, gst, (size_t)16 * NCH * 2048);
  CARVE(float, X, (size_t)TT * DM);
  CARVE(int, rtok, (size_t)NE * TT); CARVE(float, rw, (size_t)NE * TT); CARVE(int, tslot, (size_t)TT * 4);
  CARVE(u16, act, (size_t)TT * 4 * DFF); CARVE(u16, yd, (size_t)TT * 4 * DM);
  if ((size_t)(cur - (char*)d_ws) > ws_size) { fprintf(stderr, "workspace too small: need %zu have %zu\n", (size_t)(cur - (char*)d_ws), ws_size); return; }

  launch_phase<PH_TABLES>(p, 0, stream);
  launch_phase<PH_MOD>(p, 0, stream);
  launch_phase<PH_FOLD>(p, 0, stream);
  launch_phase<PH_CONVERT>(p, 0, stream);
  launch_phase<PH_HYMLP>(p, 0, stream); launch_phase<PH_HYMLP>(p, 1, stream); launch_phase<PH_HYMLP>(p, 2, stream);
  launch_phase<PH_HYFILT>(p, 0, stream);
  for (int l = 0; l < 2; ++l) {
    launch_phase<PH_NORM1>(p, l, stream);
    launch_phase<PH_GEMM_IN>(p, l, stream);
    launch_phase<PH_QKV>(p, l, stream);
    launch_phase<PH_ATTN>(p, l, stream);
    launch_phase<PH_FFTMIX>(p, l, stream);
    launch_phase<PH_GLA_A>(p, l, stream);
    launch_phase<PH_GLA_B>(p, l, stream);
    launch_phase<PH_GLA_C>(p, l, stream);
    launch_phase<PH_MIX>(p, l, stream);
    launch_phase<PH_GEMM_OUT>(p, l, stream);
    launch_phase<PH_NORM2>(p, l, stream);
    launch_phase<PH_MOE_GU>(p, l, stream);
    launch_phase<PH_MOE_DN>(p, l, stream);
  }
  launch_phase<PH_FINAL>(p, 0, stream);
}
```

```cpp
#include <hip/hip_runtime.h>
#include <hip/hip_bf16.h>
#include <cstdio>
#include <cstdint>
#include <cstring>

typedef unsigned short u16;
using bf16x8 = __attribute__((ext_vector_type(8))) short;
using s16x4  = __attribute__((ext_vector_type(4))) short;
using f32x4  = __attribute__((ext_vector_type(4))) float;
using f32x16 = __attribute__((ext_vector_type(16))) float;
using u32x4  = __attribute__((ext_vector_type(4))) unsigned;
using u32x2  = __attribute__((ext_vector_type(2))) unsigned;

constexpr int DM = 1024, NB = 2, SEQ = 16384, LC = 256;
constexpr int TL = NB * SEQ;
constexpr int TC = NB * LC;
constexpr int TT = TL + TC;
constexpr int NIN = 2816;
constexpr int DIN0 = 2240;
constexpr int NE = 32, TOPK = 4, DFF = 1024;
constexpr int SKV = SEQ + LC;
constexpr int NTHR = 512;
constexpr float EPS = 1e-6f;
constexpr int ZG_W = 1152, ZG_GQ = 0, ZG_GK = 128, ZG_KR = 256, ZG_GV = 384, ZG_GP = 640, ZG_OG = 896;
constexpr int ZT_HY = 0, ZT_FR = 768, ZT_FI = 1024, ZT_R = 1280;
constexpr int NCH = 260;
constexpr int FM = 16384;
constexpr int HSP = FM / 2 + 1;

constexpr size_t ws_al(size_t b) { return (b + 1023) & ~(size_t)1023; }
constexpr size_t OFF_bar = 0;
constexpr size_t OFF_cnt = OFF_bar + ws_al((size_t)(4096) * sizeof(unsigned));
constexpr size_t OFF_hssq = OFF_cnt + ws_al((size_t)(64) * sizeof(int));
constexpr size_t OFF_mod = OFF_hssq + ws_al((size_t)(768) * sizeof(float));
constexpr size_t OFF_ropec = OFF_mod + ws_al((size_t)(2 * 3 * 6144) * sizeof(float));
constexpr size_t OFF_ropes = OFF_ropec + ws_al((size_t)(SEQ * 16) * sizeof(float));
constexpr size_t OFF_tw = OFF_ropes + ws_al((size_t)(SEQ * 16) * sizeof(float));
constexpr size_t OFF_bt_in = OFF_tw + ws_al((size_t)(FM) * sizeof(float2));
constexpr size_t OFF_bt_q = OFF_bt_in + ws_al((size_t)((size_t)2 * NIN * DM) * sizeof(u16));
constexpr size_t OFF_bt_kv = OFF_bt_q + ws_al((size_t)(2 * 512 * 256) * sizeof(u16));
constexpr size_t OFF_bt_out = OFF_bt_kv + ws_al((size_t)(2 * 512 * 128) * sizeof(u16));
constexpr size_t OFF_bt_gu = OFF_bt_out + ws_al((size_t)((size_t)2 * DM * DM) * sizeof(u16));
constexpr size_t OFF_bt_dn = OFF_bt_gu + ws_al((size_t)((size_t)2 * NE * 2048 * DM) * sizeof(u16));
constexpr size_t OFF_hfb = OFF_bt_dn + ws_al((size_t)((size_t)2 * NE * DM * DFF) * sizeof(u16));
constexpr size_t OFF_hfc = OFF_hfb + ws_al((size_t)((size_t)2 * 2 * 256 * SEQ) * sizeof(float));
constexpr size_t OFF_hspec = OFF_hfc + ws_al((size_t)(2 * 256 * LC) * sizeof(float));
constexpr size_t OFF_H = OFF_hspec + ws_al((size_t)((size_t)2 * 256 * HSP) * sizeof(float4));
constexpr size_t OFF_zq = OFF_H + ws_al((size_t)((size_t)TT * DM) * sizeof(u16));
constexpr size_t OFF_zkv = OFF_zq + ws_al((size_t)((size_t)TT * 256) * sizeof(u16));
constexpr size_t OFF_zg = OFF_zkv + ws_al((size_t)((size_t)TT * 128) * sizeof(u16));
constexpr size_t OFF_zt = OFF_zg + ws_al((size_t)((size_t)TT * ZG_W) * sizeof(float));
constexpr size_t OFF_Q = OFF_zt + ws_al((size_t)((size_t)ZT_R * TT) * sizeof(float));
constexpr size_t OFF_KV = OFF_Q + ws_al((size_t)((size_t)2 * 4 * SKV * 96) * sizeof(u16));
constexpr size_t OFF_ymix = OFF_KV + ws_al((size_t)((size_t)2 * 4 * SKV * 160) * sizeof(u16));
constexpr size_t OFF_hyo = OFF_ymix + ws_al((size_t)((size_t)TT * DM) * sizeof(u16));
constexpr size_t OFF_fno = OFF_hyo + ws_al((size_t)((size_t)256 * TT) * sizeof(float));
constexpr size_t OFF_glao = OFF_fno + ws_al((size_t)((size_t)256 * TT) * sizeof(float));
constexpr size_t OFF_gds = OFF_glao + ws_al((size_t)((size_t)TT * 256) * sizeof(float));
constexpr size_t OFF_gdv = OFF_gds + ws_al((size_t)((size_t)16 * NCH * 2048) * sizeof(float));
constexpr size_t OFF_gst = OFF_gdv + ws_al((size_t)((size_t)16 * NCH * 32) * sizeof(float));
constexpr size_t OFF_X = OFF_gst + ws_al((size_t)((size_t)16 * NCH * 2048) * sizeof(float));
constexpr size_t OFF_rtok = OFF_X + ws_al((size_t)((size_t)TT * DM) * sizeof(float));
constexpr size_t OFF_rw = OFF_rtok + ws_al((size_t)((size_t)NE * TT) * sizeof(int));
constexpr size_t OFF_tslot = OFF_rw + ws_al((size_t)((size_t)NE * TT) * sizeof(float));
constexpr size_t OFF_act = OFF_tslot + ws_al((size_t)((size_t)TT * 4) * sizeof(int));
constexpr size_t OFF_yd = OFF_act + ws_al((size_t)((size_t)TT * 4 * DFF) * sizeof(u16));
constexpr size_t WS_TOTAL = OFF_yd + ws_al((size_t)((size_t)TT * 4 * DM) * sizeof(u16));
struct Params {
  const float *x, *c, *ctx, *c_ctx, *ada_w, *ada_b, *norm1_g, *norm2_g, *w_in, *mla_q_g, *mla_w_uq, *mla_kv_g, *mla_w_ukv,
      *hy_conv_w, *hy_conv_b, *hy_w1, *hy_b1, *hy_w2, *hy_b2, *hy_w3, *hy_freq, *hy_bias, *gla_gk_w, *gla_gk_b,
      *fnet_w, *mix_g, *w_out, *router_w, *router_b, *moe_w_gu, *moe_b_gu, *moe_w_down, *moe_b_down, *final_g;
  float* out;
  char* ws;
  __device__ __host__ __forceinline__ unsigned* bar() const { return (unsigned*)(ws + OFF_bar); }
  __device__ __host__ __forceinline__ int* cnt() const { return (int*)(ws + OFF_cnt); }
  __device__ __host__ __forceinline__ float* hssq() const { return (float*)(ws + OFF_hssq); }
  __device__ __host__ __forceinline__ float* mod() const { return (float*)(ws + OFF_mod); }
  __device__ __host__ __forceinline__ float* ropec() const { return (float*)(ws + OFF_ropec); }
  __device__ __host__ __forceinline__ float* ropes() const { return (float*)(ws + OFF_ropes); }
  __device__ __host__ __forceinline__ float2* tw() const { return (float2*)(ws + OFF_tw); }
  __device__ __host__ __forceinline__ u16* bt_in() const { return (u16*)(ws + OFF_bt_in); }
  __device__ __host__ __forceinline__ u16* bt_q() const { return (u16*)(ws + OFF_bt_q); }
  __device__ __host__ __forceinline__ u16* bt_kv() const { return (u16*)(ws + OFF_bt_kv); }
  __device__ __host__ __forceinline__ u16* bt_out() const { return (u16*)(ws + OFF_bt_out); }
  __device__ __host__ __forceinline__ u16* bt_gu() const { return (u16*)(ws + OFF_bt_gu); }
  __device__ __host__ __forceinline__ u16* bt_dn() const { return (u16*)(ws + OFF_bt_dn); }
  __device__ __host__ __forceinline__ float* hfb() const { return (float*)(ws + OFF_hfb); }
  __device__ __host__ __forceinline__ float* hfc() const { return (float*)(ws + OFF_hfc); }
  __device__ __host__ __forceinline__ float4* hspec() const { return (float4*)(ws + OFF_hspec); }
  __device__ __host__ __forceinline__ u16* H() const { return (u16*)(ws + OFF_H); }
  __device__ __host__ __forceinline__ u16* zq() const { return (u16*)(ws + OFF_zq); }
  __device__ __host__ __forceinline__ u16* zkv() const { return (u16*)(ws + OFF_zkv); }
  __device__ __host__ __forceinline__ float* zg() const { return (float*)(ws + OFF_zg); }
  __device__ __host__ __forceinline__ float* zt() const { return (float*)(ws + OFF_zt); }
  __device__ __host__ __forceinline__ u16* Q() const { return (u16*)(ws + OFF_Q); }
  __device__ __host__ __forceinline__ u16* KV() const { return (u16*)(ws + OFF_KV); }
  __device__ __host__ __forceinline__ u16* ymix() const { return (u16*)(ws + OFF_ymix); }
  __device__ __host__ __forceinline__ float* hyo() const { return (float*)(ws + OFF_hyo); }
  __device__ __host__ __forceinline__ float* fno() const { return (float*)(ws + OFF_fno); }
  __device__ __host__ __forceinline__ float* glao() const { return (float*)(ws + OFF_glao); }
  __device__ __host__ __forceinline__ float* gds() const { return (float*)(ws + OFF_gds); }
  __device__ __host__ __forceinline__ float* gdv() const { return (float*)(ws + OFF_gdv); }
  __device__ __host__ __forceinline__ float* gst() const { return (float*)(ws + OFF_gst); }
  __device__ __host__ __forceinline__ float* X() const { return (float*)(ws + OFF_X); }
  __device__ __host__ __forceinline__ int* rtok() const { return (int*)(ws + OFF_rtok); }
  __device__ __host__ __forceinline__ float* rw() const { return (float*)(ws + OFF_rw); }
  __device__ __host__ __forceinline__ int* tslot() const { return (int*)(ws + OFF_tslot); }
  __device__ __host__ __forceinline__ u16* act() const { return (u16*)(ws + OFF_act); }
  __device__ __host__ __forceinline__ u16* yd() const { return (u16*)(ws + OFF_yd); }
};


__device__ __forceinline__ u16 f2bf(float f) {
  unsigned u = __float_as_uint(f); u += 0x7FFFu + ((u >> 16) & 1u); return (u16)(u >> 16);
}
__device__ __forceinline__ float bf2f(u16 h) { return __uint_as_float(((unsigned)h) << 16); }
__device__ __forceinline__ unsigned cvtpk(float lo, float hi) {
  unsigned r; asm volatile("v_cvt_pk_bf16_f32 %0, %1, %2" : "=v"(r) : "v"(lo), "v"(hi)); return r;
}
__device__ __forceinline__ float wave_sum(float v) {
#pragma unroll
  for (int o = 32; o > 0; o >>= 1) v += __shfl_xor(v, o, 64);
  return v;
}
__device__ __forceinline__ int ltid() { int t = threadIdx.x; asm volatile("" : "+v"(t)); return t; }
__device__ __forceinline__ float silu_f(float x) { return x / (1.f + __expf(-x)); }
__device__ __forceinline__ float2 cmul(float2 a, float2 b) { return make_float2(a.x * b.x - a.y * b.y, a.x * b.y + a.y * b.x); }
__device__ __forceinline__ float2 cmulc(float2 a, float2 b) { return make_float2(a.x * b.x + a.y * b.y, a.y * b.x - a.x * b.y); }
__device__ __forceinline__ int modv(int tok) { return tok < TL ? (tok >> 14) : 2; }
__device__ __forceinline__ void phase_tables(const Params& p, int bid, int nb) {
  const int gt = bid * NTHR + ltid(), gs = nb * NTHR;
  for (int i = gt; i < SEQ * 16; i += gs) {
    const int t = i >> 4, f = i & 15;
    const float pos = (f < 8) ? (float)(t >> 6) : (float)(t & 63);
    const float inv = powf(10000.f, -(float)(f & 7) / 8.f);
    float s, c; sincosf(pos * inv, &s, &c);
    p.ropec()[i] = c; p.ropes()[i] = s;
  }
  for (int i = gt; i < FM; i += gs) {
    float s, c; sincospif((float)i / 8192.f, &s, &c);
    p.tw()[i] = make_float2(c, -s);
  }
}

__device__ __forceinline__ void phase_mod(const Params& p, int bid, int nb, char* lds) {
  float* red = (float*)lds;
  const int tid = ltid(), part = tid >> 6, cl = tid & 63;
  for (int it = bid; it < 2 * 96; it += nb) {
    const int l = it / 96, n = (it % 96) * 64 + cl;
    const float* W = p.ada_w + (size_t)l * DM * 6144;
    float a0 = 0, a1 = 0, a2 = 0;
    for (int k = part * 128; k < part * 128 + 128; ++k) {
      const float w = W[(size_t)k * 6144 + n];
      a0 += silu_f(p.c[k]) * w; a1 += silu_f(p.c[DM + k]) * w; a2 += silu_f(p.c_ctx[k]) * w;
    }
    red[(part * 3 + 0) * 64 + cl] = a0; red[(part * 3 + 1) * 64 + cl] = a1; red[(part * 3 + 2) * 64 + cl] = a2;
    __syncthreads();
    if (tid < 192) {
      const int v = tid >> 6; float s = 0;
      for (int q = 0; q < 8; ++q) s += red[(q * 3 + v) * 64 + cl];
      p.mod()[((size_t)l * 3 + v) * 6144 + n] = s + p.ada_b[(size_t)l * 6144 + n];
    }
    __syncthreads();
  }
}

__device__ __forceinline__ void phase_fold(const Params& p, int bid, int nb, char* lds) {
  float* wrow = (float*)lds;
  float* dre = wrow + 256;
  float* dim_ = dre + 256;
  float* glr = dim_ + 256;
  float* cst = glr + 32;
  float* snt = cst + 256;
  const int tid = ltid();
  if (tid < 256) { float s, c; sincospif((float)tid / 128.f, &s, &c); cst[tid] = c; snt[tid] = s; }
  __syncthreads();
  for (int it = bid; it < 2 * DM; it += nb) {
    const int l = it >> 10, k = it & 1023;
    const float* wr = p.w_in + ((size_t)l * DM + k) * DIN0;
    if (tid < 256) wrow[tid] = wr[1984 + tid];
    if (tid >= 256 && tid < 288) glr[tid - 256] = wr[1696 + tid - 256];
    __syncthreads();
    {
      const int kp = tid & 255; const bool im = tid >= 256;
      float s = 0;
      for (int c = 0; c < 256; ++c) { const int m = (c * kp) & 255; s += wrow[c] * (im ? -snt[m] : cst[m]); }
      if (im) dim_[kp] = s; else dre[kp] = s;
    }
    __syncthreads();
    {
      const int j = tid & 255; const bool im = tid >= 256;
      const float* Wf = p.fnet_w + (size_t)l * 65536;
      const float* d = im ? dim_ : dre;
      float s = 0;
      for (int kp = 0; kp < 256; ++kp) s += d[kp] * Wf[kp * 256 + j];
      p.bt_in()[((size_t)l * NIN + (im ? 2560 : 2304) + j) * DM + k] = f2bf(s * 0.0625f);
    }
    if (tid < 256) {
      const int dir = tid >> 7, kk = tid & 127;
      const float* gw = p.gla_gk_w + ((size_t)l * 2 + dir) * 16 * 128;
      float s = 0;
      for (int r = 0; r < 16; ++r) s += glr[dir * 16 + r] * gw[r * 128 + kk];
      p.bt_in()[((size_t)l * NIN + 1024 + tid) * DM + k] = f2bf(s);
    }
    __syncthreads();
  }
}

enum { MAP_ID = 0, MAP_IN = 1, MAP_UQ = 2, MAP_UKV = 3, MAP_GU = 4 };
__device__ __forceinline__ int colmap(int mt, int n) {
  switch (mt) {
    case MAP_ID: return n;
    case MAP_IN:
      if (n < 256) return n;
      if (n < 384) return 256 + (n - 256);
      if (n < 512) return 1184 + (n - 384);
      if (n < 640) return 1312 + (n - 512);
      if (n < 672) return 384 + (n - 640);
      if (n < 768) return -1;
      if (n < 1024) return 1440 + (n - 768);
      if (n < 1280) return -2;
      if (n < 1536) return 1728 + (n - 1280);
      if (n < 2304) return 416 + (n - 1536);
      return -2;
    case MAP_UQ:
      if (n < 256) return (n >> 6) * 96 + (n & 63);
      if (n < 384) return ((n - 256) >> 5) * 96 + 64 + ((n - 256) & 31);
      return -1;
    case MAP_UKV:
      if (n < 256) return (n >> 6) * 128 + (n & 63);
      return ((n - 256) >> 6) * 128 + 64 + ((n - 256) & 63);
    default: {
      const int grp = n >> 6, w = n & 63;
      return w < 32 ? 2 * (grp * 32 + w) : 2 * (grp * 32 + w - 32) + 1;
    }
  }
}
__device__ __forceinline__ void conv_matrix(const float* __restrict__ src, int ld, int K, int N, u16* __restrict__ dst, int mt,
                            const float* __restrict__ scale, int bid, int nb, char* lds) {
  float* tile = (float*)lds;
  const int tid = ltid(), nkt = K >> 6, ntile = (N >> 6) * nkt;
  for (int t = bid; t < ntile; t += nb) {
    const int n0 = (t / nkt) << 6, k0 = (t % nkt) << 6;
    const int nn = tid & 63, sc = colmap(mt, n0 + nn);
#pragma unroll
    for (int i = 0; i < 8; ++i) {
      const int kk = (tid >> 6) + 8 * i;
      float v = 0.f;
      if (sc >= 0) { v = src[(size_t)(k0 + kk) * ld + sc]; if (scale) v *= scale[k0 + kk]; }
      tile[kk * 65 + nn] = v;
    }
    __syncthreads();
    {
      const int n2 = tid >> 3, ks = (tid & 7) * 8;
      const int sc2 = colmap(mt, n0 + n2);
      if (sc2 != -2) {
        u32x4 w;
        w[0] = cvtpk(tile[(ks + 0) * 65 + n2], tile[(ks + 1) * 65 + n2]);
        w[1] = cvtpk(tile[(ks + 2) * 65 + n2], tile[(ks + 3) * 65 + n2]);
        w[2] = cvtpk(tile[(ks + 4) * 65 + n2], tile[(ks + 5) * 65 + n2]);
        w[3] = cvtpk(tile[(ks + 6) * 65 + n2], tile[(ks + 7) * 65 + n2]);
        *(u32x4*)(dst + (size_t)(n0 + n2) * K + k0 + ks) = w;
      }
    }
    __syncthreads();
  }
}
__device__ __forceinline__ void phase_convert(const Params& p, int bid, int nb, char* lds) {
  for (int l = 0; l < 2; ++l) {
    conv_matrix(p.w_in + (size_t)l * DM * DIN0, DIN0, DM, NIN, p.bt_in() + (size_t)l * NIN * DM, MAP_IN, nullptr, bid, nb, lds);
    conv_matrix(p.mla_w_uq + (size_t)l * 256 * 384, 384, 256, 512, p.bt_q() + (size_t)l * 512 * 256, MAP_UQ, p.mla_q_g + l * 256, bid, nb, lds);
    conv_matrix(p.mla_w_ukv + (size_t)l * 128 * 512, 512, 128, 512, p.bt_kv() + (size_t)l * 512 * 128, MAP_UKV, p.mla_kv_g + l * 128, bid, nb, lds);
    conv_matrix(p.w_out + (size_t)l * DM * DM, DM, DM, DM, p.bt_out() + (size_t)l * DM * DM, MAP_ID, p.mix_g + l * DM, bid, nb, lds);
    for (int e = 0; e < NE; ++e) {
      conv_matrix(p.moe_w_gu + ((size_t)l * NE + e) * DM * 2048, 2048, DM, 2048, p.bt_gu() + ((size_t)l * NE + e) * 2048 * DM, MAP_GU, nullptr, bid, nb, lds);
      conv_matrix(p.moe_w_down + ((size_t)l * NE + e) * DFF * DM, DM, DFF, DM, p.bt_dn() + ((size_t)l * NE + e) * DM * DFF, MAP_ID, nullptr, bid, nb, lds);
    }
  }
}

__device__ __forceinline__ void phase_hy_mlp(const Params& p, int l, int Lf, float* __restrict__ hout  , float* __restrict__ ssq  ,
                             int bid, int nb, char* lds) {
  float* zf = (float*)lds;
  float* h1 = zf + 64 * 33;
  float* h2 = h1 + 64 * 64;
  const int tid = ltid();
  const float* w1 = p.hy_w1 + (size_t)l * 33 * 64; const float* b1 = p.hy_b1 + l * 64;
  const float* w2 = p.hy_w2 + (size_t)l * 64 * 64; const float* b2 = p.hy_b2 + l * 64;
  const float* w3 = p.hy_w3 + (size_t)l * 64 * 512; const float* fr = p.hy_freq + l * 64;
  float w3c[64];
#pragma unroll
  for (int k = 0; k < 64; ++k) w3c[k] = w3[k * 512 + tid];
  const int dir = tid >> 8, ch = tid & 255;
  const float maxd = logf(1e-2f) / 0.3f, mind = logf(1e-2f) / 1.5f;
  const float delta = fabsf(mind + (maxd - mind) * (float)ch / 255.f);
  float ssq_acc = 0.f;
  for (int it = bid; it < Lf / 64; it += nb) {
    const int t0 = it * 64;
    for (int i = tid; i < 64 * 33; i += NTHR) {
      const int tt = i / 33, f = i % 33, t = t0 + tt;
      float v;
      if (f == 0) v = (float)t / (float)(Lf - 1);
      else {
        const int j = (f - 1) & 15;
        const float fj = 1e-4f + (float)j * ((15.f - 1e-4f) / 15.f);
        const float w = 6.283185307179586f * (float)t / (float)Lf;
        v = (f <= 16) ? cosf(fj * w) : -sinf(fj * w);
      }
      zf[i] = v;
    }
    __syncthreads();
    for (int i = tid; i < 64 * 64; i += NTHR) {
      const int tt = i >> 6, o = i & 63; float s = b1[o];
      for (int f = 0; f < 33; ++f) s += zf[tt * 33 + f] * w1[f * 64 + o];
      h1[i] = sinf(fr[o] * s);
    }
    __syncthreads();
    for (int i = tid; i < 64 * 64; i += NTHR) {
      const int tt = i >> 6, o = i & 63; float s = b2[o];
      for (int f = 0; f < 64; ++f) s += h1[tt * 64 + f] * w2[f * 64 + o];
      h2[i] = sinf(fr[o] * s);
    }
    __syncthreads();
    float* orow = hout + ((size_t)dir * 256 + ch) * Lf + t0;
    for (int tt = 0; tt < 64; ++tt) {
      float s = 0;
#pragma unroll
      for (int k = 0; k < 64; ++k) s += h2[tt * 64 + k] * w3c[k];
      const int t = t0 + tt;
      s *= __expf(-((float)t / (float)(Lf - 1)) * delta);
      orow[tt] = s;
      if (dir == 0 || t > 0) ssq_acc += s * s;
    }
    __syncthreads();
  }
  atomicAdd(&ssq[ch], ssq_acc);
}

__device__ __forceinline__ int rev7(int k) {
  unsigned r = __brev((unsigned)k) >> 18;
  return (int)(((r & 0x2AAAu) >> 1) | ((r & 0x1555u) << 1));
}
__device__ __forceinline__ void fft_fwd(float2* s, const float2* __restrict__ tw) {
  const int tid = ltid();
#pragma unroll 1
  for (int st = 0; st < 7; ++st) {
    const int sh = 12 - 2 * st, q = 1 << sh;
#pragma unroll 4
    for (int u = tid; u < 4096; u += NTHR) {
      const int g = u >> sh, j = u & (q - 1), base = (g << (sh + 2)) + j;
      const float2 a0 = s[base], a1 = s[base + q], a2 = s[base + 2 * q], a3 = s[base + 3 * q];
      const int ti = j << (2 * st);
      const float2 w1 = tw[ti], w2 = tw[2 * ti], w3 = tw[3 * ti];
      const float2 b0 = make_float2(a0.x + a2.x, a0.y + a2.y), b1 = make_float2(a0.x - a2.x, a0.y - a2.y);
      const float2 b2 = make_float2(a1.x + a3.x, a1.y + a3.y), b3 = make_float2(a1.x - a3.x, a1.y - a3.y);
      s[base] = make_float2(b0.x + b2.x, b0.y + b2.y);
      s[base + q] = cmul(make_float2(b1.x + b3.y, b1.y - b3.x), w1);
      s[base + 2 * q] = cmul(make_float2(b0.x - b2.x, b0.y - b2.y), w2);
      s[base + 3 * q] = cmul(make_float2(b1.x - b3.y, b1.y + b3.x), w3);
    }
    __syncthreads();
  }
}
__device__ __forceinline__ void fft_inv(float2* s, const float2* __restrict__ tw) {
  const int tid = ltid();
#pragma unroll 1
  for (int st = 6; st >= 0; --st) {
    const int sh = 12 - 2 * st, q = 1 << sh;
#pragma unroll 4
    for (int u = tid; u < 4096; u += NTHR) {
      const int g = u >> sh, j = u & (q - 1), base = (g << (sh + 2)) + j;
      const int ti = j << (2 * st);
      const float2 t0 = s[base], t1 = cmulc(s[base + q], tw[ti]), t2 = cmulc(s[base + 2 * q], tw[2 * ti]), t3 = cmulc(s[base + 3 * q], tw[3 * ti]);
      const float2 b0 = make_float2(t0.x + t2.x, t0.y + t2.y), b1 = make_float2(t0.x - t2.x, t0.y - t2.y);
      const float2 b2 = make_float2(t1.x + t3.x, t1.y + t3.y), b3 = make_float2(t1.x - t3.x, t1.y - t3.y);
      s[base] = make_float2(b0.x + b2.x, b0.y + b2.y);
      s[base + q] = make_float2(b1.x - b3.y, b1.y + b3.x);
      s[base + 2 * q] = make_float2(b0.x - b2.x, b0.y - b2.y);
      s[base + 3 * q] = make_float2(b1.x + b3.y, b1.y - b3.x);
    }
    __syncthreads();
  }
}

__device__ __forceinline__ void phase_hy_filtfft(const Params& p, int bid, int nb, char* lds) {
  float2* s = (float2*)lds;
  const int tid = ltid();
  for (int it = bid; it < 512; it += nb) {
    const int l = it >> 8, ch = it & 255;
    const float* hf = p.hfb() + (((size_t)l * 2 + 0) * 256 + ch) * SEQ;
    const float* hb = p.hfb() + (((size_t)l * 2 + 1) * 256 + ch) * SEQ;
    for (int m = tid; m < FM; m += NTHR) {
      const int n0 = 2 * m, n1 = 2 * m + 1;
      const float a = (n0 < SEQ) ? hf[n0] : (n0 == SEQ ? 0.f : hb[2 * SEQ - n0]);
      const float b = (n1 < SEQ) ? hf[n1] : hb[2 * SEQ - n1];
      s[m] = make_float2(a, b);
    }
    __syncthreads();
    fft_fwd(s, p.tw());
    const float sc = rsqrtf(p.hssq()[l * 256 + ch]) * (1.f / 16384.f);
    float4* out = p.hspec() + ((size_t)l * 256 + ch) * HSP;
    for (int k = tid; k <= FM / 2; k += NTHR) {
      const float2 zk = s[rev7(k)], zm = s[rev7((FM - k) & (FM - 1))];
      const float er = 0.5f * (zk.x + zm.x), ei = 0.5f * (zk.y - zm.y);
      const float dr = 0.5f * (zk.x - zm.x), di = 0.5f * (zk.y + zm.y);
      out[k] = make_float4(er * sc, ei * sc, di * sc, -dr * sc);
    }
    __syncthreads();
  }
}
constexpr int G_TILE_B = 256 * 64 * 2;
constexpr int G_STAGE_B = 2 * G_TILE_B;
constexpr int GEMM_LDS = 2 * G_STAGE_B;

__device__ __forceinline__ int lds_byte2(int r, int c) {
  const int st = (r >> 4) * 2 + (c >> 5), ob = (r & 15) * 64 + (c & 31) * 2;
  return st * 1024 + (ob ^ (((ob >> 9) & 1) << 5));
}
__device__ __forceinline__ void stage_rc2(int b, int& R, int& C) {
  const int st = b >> 10, sb = b & 1023, swz = sb ^ (((sb >> 9) & 1) << 5);
  R = (st >> 1) * 16 + (swz >> 6);
  C = (st & 1) * 32 + ((swz & 63) >> 1);
}
__device__ __forceinline__ void gemm_stage_coords(int (&sR)[4], int (&sC)[4]) {
  const int wid = ltid() >> 6, lane = ltid() & 63;
#pragma unroll
  for (int i = 0; i < 4; ++i) stage_rc2(wid * 1024 + i * 8192 + lane * 16, sR[i], sC[i]);
}

#define WAIT_V0() asm volatile("s_waitcnt vmcnt(0)" ::: "memory")

__device__ __forceinline__ void gemm256_core(const u16* const (&ap)[4], const u16* const (&bp)[4], int nt, char* shm, f32x4 (&acc)[8][4]) {
  const int tid = ltid(), wid = tid >> 6, lane = tid & 63, wr = wid >> 2, wc = wid & 3, fr = lane & 15, fq = lane >> 4;
#pragma unroll
  for (int m = 0; m < 8; ++m)
#pragma unroll
    for (int n = 0; n < 4; ++n) acc[m][n] = f32x4{0.f, 0.f, 0.f, 0.f};
#define G_SA(b) (shm + (b) * G_STAGE_B)
#define G_SB(b) (shm + (b) * G_STAGE_B + G_TILE_B)
#define G_STAGE(buf, kt) do { _Pragma("unroll") for (int i = 0; i < 4; ++i) {                                                   \
    __builtin_amdgcn_global_load_lds((const unsigned*)(ap[i] + (kt) * 64), (unsigned*)(G_SA(buf) + wid * 1024 + i * 8192), 16, 0, 0); \
    __builtin_amdgcn_global_load_lds((const unsigned*)(bp[i] + (kt) * 64), (unsigned*)(G_SB(buf) + wid * 1024 + i * 8192), 16, 0, 0); } } while (0)
  G_STAGE(0, 0); WAIT_V0(); __syncthreads();
#pragma unroll 1
  for (int t = 0; t < nt; ++t) {
    const int cur = t & 1;
    if (t + 1 < nt) G_STAGE(cur ^ 1, t + 1);
#pragma unroll
    for (int ks = 0; ks < 2; ++ks) {
      bf16x8 At[8], Bf[4];
#pragma unroll
      for (int m = 0; m < 8; ++m) At[m] = *(const bf16x8*)(G_SA(cur) + lds_byte2(wr * 128 + m * 16 + fr, ks * 32 + fq * 8));
#pragma unroll
      for (int n = 0; n < 4; ++n) Bf[n] = *(const bf16x8*)(G_SB(cur) + lds_byte2(wc * 64 + n * 16 + fr, ks * 32 + fq * 8));
#pragma unroll
      for (int m = 0; m < 8; ++m)
#pragma unroll
        for (int n = 0; n < 4; ++n) acc[m][n] = __builtin_amdgcn_mfma_f32_16x16x32_bf16(At[m], Bf[n], acc[m][n], 0, 0, 0);
      __builtin_amdgcn_sched_barrier(0);
    }
    WAIT_V0(); __syncthreads();
  }
#undef G_STAGE
}

__device__ __forceinline__ const float* resid_row(const Params& p, int layer_src, int tok) {
  if (layer_src == 0) return tok < TL ? p.x + (size_t)tok * DM : p.ctx + (size_t)(tok - TL) * DM;
  return p.X() + (size_t)tok * DM;
}
__device__ __forceinline__ void load_row_comb(const Params& p, int src_layer, int lc, int tok, int lane, const int* pre  , float (&v)[16]) {
  const float* r = resid_row(p, src_layer, tok);
#pragma unroll
  for (int i = 0; i < 4; ++i) { const float4 a = *(const float4*)(r + lane * 4 + i * 256); v[4 * i] = a.x; v[4 * i + 1] = a.y; v[4 * i + 2] = a.z; v[4 * i + 3] = a.w; }
  if (lc >= 0) {
    const float* g2 = p.mod() + ((size_t)lc * 3 + modv(tok)) * 6144 + 5 * DM;
    float s[16];
#pragma unroll
    for (int i = 0; i < 16; ++i) s[i] = 0.f;
#pragma unroll
    for (int k = 0; k < TOPK; ++k) {
      const int sl = p.tslot()[tok * 4 + k];
      const size_t arow = (size_t)(pre[sl >> 20] + (sl & 0xFFFFF));
      const u16* y = p.yd() + arow * DM;
#pragma unroll
      for (int i = 0; i < 4; ++i) {
        const u32x2 w = *(const u32x2*)(y + lane * 4 + i * 256);
        s[4 * i] += __uint_as_float(w[0] << 16); s[4 * i + 1] += __uint_as_float(w[0] & 0xFFFF0000u);
        s[4 * i + 2] += __uint_as_float(w[1] << 16); s[4 * i + 3] += __uint_as_float(w[1] & 0xFFFF0000u);
      }
    }
#pragma unroll
    for (int i = 0; i < 4; ++i) {
      const float4 g = *(const float4*)(g2 + lane * 4 + i * 256);
      v[4 * i] += g.x * s[4 * i]; v[4 * i + 1] += g.y * s[4 * i + 1]; v[4 * i + 2] += g.z * s[4 * i + 2]; v[4 * i + 3] += g.w * s[4 * i + 3];
    }
  }
}
__device__ __forceinline__ void expert_prefix(const int* cnt, int* pre) {
  if (ltid() == 0) { int s = 0; for (int e = 0; e < NE; ++e) { pre[e] = s; s += cnt[e]; } pre[NE] = s; }
}

__device__ __forceinline__ void phase_norm1(const Params& p, int layer, int bid, int nb, char* lds) {
  int* pre = (int*)lds;
  const int lc = layer - 1;
  if (lc >= 0) { expert_prefix(p.cnt() + lc * NE, pre); __syncthreads(); }
  const int wid = ltid() >> 6, lane = ltid() & 63;
  const float* gn = p.norm1_g + layer * DM;
  const int ntok = TT;
  for (int tok = bid * 8 + wid; tok < ntok; tok += nb * 8) {
    float v[16];
    load_row_comb(p, layer == 0 ? 0 : 1, lc, tok, lane, pre, v);
    if (lc >= 0) {
      float* xr = p.X() + (size_t)tok * DM;
#pragma unroll
      for (int i = 0; i < 4; ++i) *(float4*)(xr + lane * 4 + i * 256) = make_float4(v[4 * i], v[4 * i + 1], v[4 * i + 2], v[4 * i + 3]);
    }
    float ss = 0;
#pragma unroll
    for (int i = 0; i < 16; ++i) ss += v[i] * v[i];
    ss = wave_sum(ss);
    const float rs = rsqrtf(ss * (1.f / DM) + EPS);
    const float* md = p.mod() + ((size_t)layer * 3 + modv(tok)) * 6144;
    u16* h = p.H() + (size_t)tok * DM;
#pragma unroll
    for (int i = 0; i < 4; ++i) {
      const int c = lane * 4 + i * 256;
      const float4 g = *(const float4*)(gn + c), sh = *(const float4*)(md + c), sc = *(const float4*)(md + DM + c);
      const float y0 = v[4 * i] * rs * g.x * (1.f + sc.x) + sh.x, y1 = v[4 * i + 1] * rs * g.y * (1.f + sc.y) + sh.y;
      const float y2 = v[4 * i + 2] * rs * g.z * (1.f + sc.z) + sh.z, y3 = v[4 * i + 3] * rs * g.w * (1.f + sc.w) + sh.w;
      u32x2 w; w[0] = cvtpk(y0, y1); w[1] = cvtpk(y2, y3);
      *(u32x2*)(h + c) = w;
    }
  }
}

__device__ __forceinline__ void phase_gemm_in(const Params& p, int layer, int bid, int nb, char* lds) {
  const int tid = ltid(), wid = tid >> 6, lane = tid & 63, wr = wid >> 2, wc = wid & 3, fr = lane & 15, fq = lane >> 4;
  int sR[4], sC[4]; gemm_stage_coords(sR, sC);
  const u16* Bt = p.bt_in() + (size_t)layer * NIN * DM;
  constexpr int nM = TT / 256, nN = NIN / 256;
  for (int t = bid; t < nM * nN; t += nb) {
    const int pm = t / nN, pn = t % nN, brow = pm * 256, bcol = pn * 256;
    const u16* ap[4]; const u16* bp[4];
#pragma unroll
    for (int i = 0; i < 4; ++i) { ap[i] = p.H() + (size_t)(brow + sR[i]) * DM + sC[i]; bp[i] = Bt + (size_t)(bcol + sR[i]) * DM + sC[i]; }
    f32x4 acc[8][4];
    gemm256_core(ap, bp, DM / 64, lds, acc);
    const int cg = bcol + wc * 64;
    const int r0 = brow + wr * 128;
    if (cg < 384) {
      u16* dst = cg < 256 ? p.zq() : p.zkv(); const int ld = cg < 256 ? 256 : 128, c0 = cg < 256 ? cg : cg - 256;
#pragma unroll
      for (int m = 0; m < 8; ++m)
#pragma unroll
        for (int n = 0; n < 4; ++n)
#pragma unroll
          for (int j = 0; j < 4; ++j) dst[(size_t)(r0 + m * 16 + fq * 4 + j) * ld + c0 + n * 16 + fr] = f2bf(acc[m][n][j]);
    } else if (cg < 1536) {
      const int c0 = cg - 384;
#pragma unroll
      for (int m = 0; m < 8; ++m)
#pragma unroll
        for (int n = 0; n < 4; ++n)
#pragma unroll
          for (int j = 0; j < 4; ++j) p.zg()[(size_t)(r0 + m * 16 + fq * 4 + j) * ZG_W + c0 + n * 16 + fr] = acc[m][n][j];
    } else {
      const int c0 = cg - 1536;
#pragma unroll
      for (int m = 0; m < 8; ++m)
#pragma unroll
        for (int n = 0; n < 4; ++n)
          *(float4*)(p.zt() + (size_t)(c0 + n * 16 + fr) * TT + r0 + m * 16 + fq * 4) = make_float4(acc[m][n][0], acc[m][n][1], acc[m][n][2], acc[m][n][3]);
    }
  }
}

__device__ __forceinline__ size_t qkv_row(int tok, int h) {
  const int b = tok < TL ? (tok >> 14) : ((tok - TL) >> 8);
  const int s = tok < TL ? (tok & (SEQ - 1)) : SEQ + ((tok - TL) & (LC - 1));
  return ((size_t)(b * 4 + h)) * SKV + s;
}
template <bool ISQ>
__device__ __forceinline__ void qkv_tiles(const Params& p, int layer, int bid, int nb, char* lds) {
  const int tid = ltid(), wid = tid >> 6, lane = tid & 63, wr = wid >> 2, wc = wid & 3, fr = lane & 15, fq = lane >> 4;
  float* rsv = (float*)(lds + 128 * 260 * 4);
  constexpr int nM = TT / 256;
  constexpr int K = ISQ ? 256 : 128;
  const u16* A = ISQ ? p.zq() : p.zkv();
  const u16* Bt = ISQ ? p.bt_q() + (size_t)layer * 512 * 256 : p.bt_kv() + (size_t)layer * 512 * 128;
  for (int t = bid; t < 2 * nM; t += nb) {
    const int pm = t >> 1, pn = t & 1, brow = pm * 256;
    {
      const int r = tid >> 1, half = tid & 1, per = K / 2;
      const u16* row = A + (size_t)(brow + r) * K + half * per;
      float ss = 0;
      for (int i = 0; i < per; i += 8) {
        const u32x4 w = *(const u32x4*)(row + i);
#pragma unroll
        for (int q = 0; q < 4; ++q) { const float a = __uint_as_float(w[q] << 16), b = __uint_as_float(w[q] & 0xFFFF0000u); ss += a * a + b * b; }
      }
      ss += __shfl_xor(ss, 1, 64);
      if (half == 0) rsv[r] = rsqrtf(ss / (float)K + EPS);
    }
    f32x4 acc[8][4];
    {
      int sR[4], sC[4]; gemm_stage_coords(sR, sC);
      const u16* ap[4]; const u16* bp[4];
#pragma unroll
      for (int i = 0; i < 4; ++i) { ap[i] = A + (size_t)(brow + sR[i]) * K + sC[i]; bp[i] = Bt + (size_t)(pn * 256 + sR[i]) * K + sC[i]; }
      gemm256_core(ap, bp, K / 64, lds, acc);
    }
    float* et = (float*)lds;
#pragma unroll 1
    for (int half = 0; half < 2; ++half) {
      if (wr == half) {
#pragma unroll
        for (int m = 0; m < 8; ++m)
#pragma unroll
          for (int n = 0; n < 4; ++n)
#pragma unroll
            for (int j = 0; j < 4; ++j) et[(m * 16 + fq * 4 + j) * 260 + wc * 64 + n * 16 + fr] = acc[m][n][j];
      }
      __syncthreads();
      {
        const int rl = tid >> 2, ch = tid & 3, tok = brow + half * 128 + rl;
        const float rs = rsv[half * 128 + rl];
        const float* src = et + rl * 260;
        if (ISQ && pn == 1) {
          float x1[16], x2[16];
#pragma unroll
          for (int i = 0; i < 4; ++i) {
            const float4 a = *(const float4*)(src + ch * 32 + i * 4), b2 = *(const float4*)(src + ch * 32 + 16 + i * 4);
            x1[4 * i] = a.x * rs; x1[4 * i + 1] = a.y * rs; x1[4 * i + 2] = a.z * rs; x1[4 * i + 3] = a.w * rs;
            x2[4 * i] = b2.x * rs; x2[4 * i + 1] = b2.y * rs; x2[4 * i + 2] = b2.z * rs; x2[4 * i + 3] = b2.w * rs;
          }
          unsigned o1[8], o2[8];
          if (tok < TL) {
            const float* cp = p.ropec() + (size_t)(tok & (SEQ - 1)) * 16; const float* sp = p.ropes() + (size_t)(tok & (SEQ - 1)) * 16;
#pragma unroll
            for (int i = 0; i < 4; ++i) {
              const float4 c4 = *(const float4*)(cp + 4 * i), s4 = *(const float4*)(sp + 4 * i);
              const float cc[4] = {c4.x, c4.y, c4.z, c4.w}, sn[4] = {s4.x, s4.y, s4.z, s4.w};
              float y1[4], y2[4];
#pragma unroll
              for (int q = 0; q < 4; ++q) { y1[q] = x1[4 * i + q] * cc[q] - x2[4 * i + q] * sn[q]; y2[q] = x2[4 * i + q] * cc[q] + x1[4 * i + q] * sn[q]; }
              o1[2 * i] = cvtpk(y1[0], y1[1]); o1[2 * i + 1] = cvtpk(y1[2], y1[3]); o2[2 * i] = cvtpk(y2[0], y2[1]); o2[2 * i + 1] = cvtpk(y2[2], y2[3]);
            }
          } else {
#pragma unroll
            for (int i = 0; i < 8; ++i) { o1[i] = cvtpk(x1[2 * i], x1[2 * i + 1]); o2[i] = cvtpk(x2[2 * i], x2[2 * i + 1]); }
          }
          u16* q = p.Q() + qkv_row(tok, ch) * 96 + 64;
          *(u32x4*)(q) = u32x4{o1[0], o1[1], o1[2], o1[3]}; *(u32x4*)(q + 8) = u32x4{o1[4], o1[5], o1[6], o1[7]};
          *(u32x4*)(q + 16) = u32x4{o2[0], o2[1], o2[2], o2[3]}; *(u32x4*)(q + 24) = u32x4{o2[4], o2[5], o2[6], o2[7]};
        } else {
          u16* d = ISQ ? p.Q() + qkv_row(tok, ch) * 96 : p.KV() + qkv_row(tok, ch) * 160 + (pn == 0 ? 0 : 96);
#pragma unroll
          for (int i = 0; i < 8; ++i) {
            const float4 a = *(const float4*)(src + ch * 64 + i * 8), b2 = *(const float4*)(src + ch * 64 + i * 8 + 4);
            *(u32x4*)(d + i * 8) = u32x4{cvtpk(a.x * rs, a.y * rs), cvtpk(a.z * rs, a.w * rs), cvtpk(b2.x * rs, b2.y * rs), cvtpk(b2.z * rs, b2.w * rs)};
          }
        }
      }
      __syncthreads();
    }
    __syncthreads();
  }
}
__device__ __forceinline__ void phase_qkv(const Params& p, int layer, int bid, int nb, char* lds) {
  const int tid = ltid();
  qkv_tiles<true>(p, layer, bid, nb, lds);
  qkv_tiles<false>(p, layer, bid, nb, lds);
  for (int i = bid * NTHR + tid; i < TT * 16; i += nb * NTHR) {
    const int tok = i >> 4, f = i & 15;
    const float x1 = p.zg()[(size_t)tok * ZG_W + ZG_KR + f], x2 = p.zg()[(size_t)tok * ZG_W + ZG_KR + 16 + f];
    float cs = 1.f, sn = 0.f;
    if (tok < TL) { const int tpos = tok & (SEQ - 1); cs = p.ropec()[tpos * 16 + f]; sn = p.ropes()[tpos * 16 + f]; }
    const u16 o1 = f2bf(x1 * cs - x2 * sn), o2 = f2bf(x2 * cs + x1 * sn);
#pragma unroll
    for (int h = 0; h < 4; ++h) { u16* kv = p.KV() + qkv_row(tok, h) * 160 + 64; kv[f] = o1; kv[16 + f] = o2; }
  }
}
constexpr int A_KROW = 208;
constexpr int A_SHM_K = 64 * A_KROW;
constexpr int A_SHM_V = 64 * 64 * 2;
constexpr int A_OFF_K = 2 * A_SHM_V;
constexpr int A_OFF_W = A_OFF_K + 2 * A_SHM_K;
constexpr int ATTN_LDS = A_OFF_W + 8 * 64 * 4;
constexpr float A_SCALE = 0.10206207261596575f;
constexpr float A_THR = 8.f;
#define SBAR() __builtin_amdgcn_sched_barrier(0)
__device__ __forceinline__ int crow(int r, int hi) { return (r & 3) + 8 * (r >> 2) + 4 * hi; }

__device__ __forceinline__ void a_partialSM(f32x16& p0, f32x16& p1, float& m_reg, float& mn, float& alpha) {
  constexpr float C = A_SCALE * 1.4426950408889634f;
  float pmax = p0[0];
#pragma unroll
  for (int r = 1; r < 16; ++r) pmax = fmaxf(pmax, p0[r]);
#pragma unroll
  for (int r = 0; r < 16; ++r) pmax = fmaxf(pmax, p1[r]);
  { auto rr = __builtin_amdgcn_permlane32_swap(__float_as_uint(pmax), __float_as_uint(pmax), false, false);
    pmax = fmaxf(__uint_as_float(rr[0]), __uint_as_float(rr[1])); }
  if (__builtin_expect(__all(pmax - m_reg <= A_THR / A_SCALE), 1)) { mn = m_reg; alpha = 1.f; }
  else { mn = fmaxf(m_reg, pmax); alpha = __builtin_amdgcn_exp2f((m_reg - mn) * C); m_reg = mn; }
  const float mnC = -mn * C;
#pragma unroll
  for (int r = 0; r < 16; ++r) p0[r] = fmaf(p0[r], C, mnC);
#pragma unroll
  for (int r = 0; r < 16; ++r) p1[r] = fmaf(p1[r], C, mnC);
#pragma unroll
  for (int r = 0; r < 16; ++r) p0[r] = __builtin_amdgcn_exp2f(p0[r]);
}
__device__ __forceinline__ void a_finishSM(f32x16& p0, f32x16& p1, float alpha, float& l_reg, bf16x8& pa0, bf16x8& pa1, bf16x8& pa2, bf16x8& pa3) {
#pragma unroll
  for (int r = 0; r < 16; ++r) p1[r] = __builtin_amdgcn_exp2f(p1[r]);
  float ps = 0;
#pragma unroll
  for (int r = 0; r < 16; ++r) ps += p0[r];
#pragma unroll
  for (int r = 0; r < 16; ++r) ps += p1[r];
  { auto rr = __builtin_amdgcn_permlane32_swap(__float_as_uint(ps), __float_as_uint(ps), false, false);
    ps = __uint_as_float(rr[0]) + __uint_as_float(rr[1]); }
  l_reg = l_reg * alpha + ps;
#define PK4(P, BASE, OUT) do { unsigned a0 = cvtpk(P[BASE + 0], P[BASE + 1]), a1 = cvtpk(P[BASE + 2], P[BASE + 3]);   \
    unsigned b0 = cvtpk(P[BASE + 4], P[BASE + 5]), b1 = cvtpk(P[BASE + 6], P[BASE + 7]);                              \
    auto r0 = __builtin_amdgcn_permlane32_swap(a0, b0, false, false); auto r1 = __builtin_amdgcn_permlane32_swap(a1, b1, false, false); \
    u32x4 w = {r0[0], r1[0], r0[1], r1[1]}; OUT = *reinterpret_cast<bf16x8*>(&w); } while (0)
  PK4(p0, 0, pa0); PK4(p0, 8, pa1); PK4(p1, 0, pa2); PK4(p1, 8, pa3);
#undef PK4
}
__device__ __forceinline__ void a_qkt(f32x16& p0, f32x16& p1, const char* Ks, const bf16x8* qr, int r32, int hi) {
  p0 = f32x16{}; p1 = f32x16{};
#pragma unroll
  for (int d0 = 0; d0 < 6; ++d0) {
    const int cb = (d0 * 16 + hi * 8) * 2;
    const bf16x8 b0 = *reinterpret_cast<const bf16x8*>(Ks + r32 * A_KROW + cb);
    const bf16x8 b1 = *reinterpret_cast<const bf16x8*>(Ks + (32 + r32) * A_KROW + cb);
    p0 = __builtin_amdgcn_mfma_f32_32x32x16_bf16(b0, qr[d0], p0, 0, 0, 0);
    p1 = __builtin_amdgcn_mfma_f32_32x32x16_bf16(b1, qr[d0], p1, 0, 0, 0);
  }
}
__device__ __forceinline__ int a_v_st(int k, int c) { const int kk = (k & ~0xC) | ((k & 4) << 1) | ((k & 8) >> 1); return ((kk >> 3) * 2 + (c >> 5)) * 512 + ((kk & 7) * 32 + (c & 31)) * 2; }
__device__ __forceinline__ int a_v_rd_base(int lane) { return ((lane & 3) << 3) | (((lane >> 2) & 3) << 6) | (((lane >> 4) & 1) << 5) | (((lane >> 5) & 1) << 8); }
constexpr int a_v_rd_off(int d0, int ks, int half) { return d0 * 512 + ks * 2048 + half * 1024; }
template <int OFF> __device__ __forceinline__ s16x4 a_tr_read(int vb) {
  s16x4 r; asm volatile("ds_read_b64_tr_b16 %0, %1 offset:%2" : "=&v"(r) : "v"(vb), "i"(OFF) : "memory"); return r;
}
template <int D0> __device__ __forceinline__ void a_pv_one(f32x16& od, int vb, bf16x8 pa0, bf16x8 pa1, bf16x8 pa2, bf16x8 pa3) {
  const s16x4 l0 = a_tr_read<a_v_rd_off(D0, 0, 0)>(vb), h0 = a_tr_read<a_v_rd_off(D0, 0, 1)>(vb), l1 = a_tr_read<a_v_rd_off(D0, 1, 0)>(vb), h1 = a_tr_read<a_v_rd_off(D0, 1, 1)>(vb);
  const s16x4 l2 = a_tr_read<a_v_rd_off(D0, 2, 0)>(vb), h2 = a_tr_read<a_v_rd_off(D0, 2, 1)>(vb), l3 = a_tr_read<a_v_rd_off(D0, 3, 0)>(vb), h3 = a_tr_read<a_v_rd_off(D0, 3, 1)>(vb);
  asm volatile("s_waitcnt lgkmcnt(0)" ::: "memory"); SBAR();
#define PK(L, H) (bf16x8){L[0], L[1], L[2], L[3], H[0], H[1], H[2], H[3]}
  od = __builtin_amdgcn_mfma_f32_32x32x16_bf16(pa0, PK(l0, h0), od, 0, 0, 0);
  od = __builtin_amdgcn_mfma_f32_32x32x16_bf16(pa1, PK(l1, h1), od, 0, 0, 0);
  od = __builtin_amdgcn_mfma_f32_32x32x16_bf16(pa2, PK(l2, h2), od, 0, 0, 0);
  od = __builtin_amdgcn_mfma_f32_32x32x16_bf16(pa3, PK(l3, h3), od, 0, 0, 0);
#undef PK
}
__device__ __forceinline__ void a_pv(f32x16* o, int vb, bf16x8 pa0, bf16x8 pa1, bf16x8 pa2, bf16x8 pa3) {
  a_pv_one<0>(o[0], vb, pa0, pa1, pa2, pa3); a_pv_one<1>(o[1], vb, pa0, pa1, pa2, pa3);
}

__device__ __forceinline__ void attn_item(const u16* __restrict__ Qb, const u16* __restrict__ KVh, int seq, u16* __restrict__ yout  , char* lds) {
  const int tid = ltid(), wid = tid >> 6, lane = tid & 63, r32 = lane & 31, hi = lane >> 5;
  char* V_lds = lds; char* K_lds = lds + A_OFF_K;
  float* ws = (float*)(lds + A_OFF_W) + wid * 64; float* li_l = ws; float* al_l = ws + 32;
  float m_reg = -1e30f, l_reg = 0; f32x16 o[2] = {}; bf16x8 qr[6];
  const u16* Qw = Qb + (size_t)(wid * 32 + r32) * 96 + hi * 8;
#pragma unroll
  for (int d0 = 0; d0 < 6; ++d0) qr[d0] = *reinterpret_cast<const bf16x8*>(Qw + d0 * 16);
  int lw[3], lsz[3];
#pragma unroll
  for (int i = 0; i < 3; ++i) {
    const int g = tid + i * 512, key = g / 20, cc = g % 20;
    lw[i] = cc < 12 ? (A_OFF_K + key * A_KROW + cc * 16) : a_v_st(key, (cc - 12) * 8);
    lsz[i] = cc < 12 ? A_SHM_K : A_SHM_V;
  }
  const bool third = wid < 4;
  const int vb0 = (int)(uintptr_t)V_lds + a_v_rd_base(lane);
  struct { bf16x8 g0, g1, g2; } sr_[2];
  const char* gsrc = (const char*)KVh + tid * 16;
#define SLOAD(i, k0) do { const char* s_ = gsrc + (size_t)(k0) * 320; sr_[i].g0 = *(const bf16x8*)(s_); sr_[i].g1 = *(const bf16x8*)(s_ + 8192); \
    if (third) sr_[i].g2 = *(const bf16x8*)(s_ + 16384); } while (0)
#define SWRITE(b, i) do { *(bf16x8*)(lds + lw[0] + (b) * lsz[0]) = sr_[i].g0; *(bf16x8*)(lds + lw[1] + (b) * lsz[1]) = sr_[i].g1; \
    if (third) *(bf16x8*)(lds + lw[2] + (b) * lsz[2]) = sr_[i].g2; } while (0)
#define SWAIT() do { if (third) asm volatile("s_waitcnt vmcnt(3)" ::: "memory"); else asm volatile("s_waitcnt vmcnt(2)" ::: "memory"); } while (0)
#define RESC(a) do { if (__any((a) < 1.f)) { if (hi == 0) al_l[r32] = (a); asm volatile("s_waitcnt lgkmcnt(0)" ::: "memory"); \
    _Pragma("unroll") for (int d = 0; d < 2; ++d) _Pragma("unroll") for (int r = 0; r < 16; ++r) o[d][r] *= al_l[crow(r, hi)]; } } while (0)
  f32x16 pA0, pA1, pB0, pB1; float mnA, mnB, alA, alB; bf16x8 pa0, pa1, pa2, pa3; const int NT = seq / 64;
  constexpr int SE = 0, SO = 1;
  SLOAD(SE, 0); asm volatile("s_waitcnt vmcnt(0)" ::: "memory"); SWRITE(0, SE); __syncthreads();
  a_qkt(pA0, pA1, K_lds, qr, r32, hi); a_partialSM(pA0, pA1, m_reg, mnA, alA);
  SLOAD(SO, 64); if (2 < NT) SLOAD(SE, 128);
  SWAIT(); SWRITE(1, SO); __syncthreads();
  for (int j = 1; j + 1 < NT; j += 2) {
    SBAR(); a_qkt(pB0, pB1, K_lds + A_SHM_K, qr, r32, hi);
    a_finishSM(pA0, pA1, alA, l_reg, pa0, pa1, pa2, pa3); SBAR();
    SLOAD(SO, (j + 2) * 64); SBAR();
    a_pv(o, vb0, pa0, pa1, pa2, pa3); a_partialSM(pB0, pB1, m_reg, mnB, alB);
    __syncthreads(); SWAIT(); SWRITE(0, SE);
    RESC(alB); __syncthreads();
    SBAR(); a_qkt(pA0, pA1, K_lds, qr, r32, hi);
    a_finishSM(pB0, pB1, alB, l_reg, pa0, pa1, pa2, pa3); SBAR();
    if (j + 3 < NT) SLOAD(SE, (j + 3) * 64); SBAR();
    a_pv(o, vb0 + A_SHM_V, pa0, pa1, pa2, pa3); a_partialSM(pA0, pA1, m_reg, mnA, alA);
    __syncthreads(); SWAIT(); SWRITE(1, SO);
    RESC(alA); __syncthreads();
  }
  SBAR(); a_qkt(pB0, pB1, K_lds + A_SHM_K, qr, r32, hi);
  a_finishSM(pA0, pA1, alA, l_reg, pa0, pa1, pa2, pa3); SBAR();
  a_pv(o, vb0, pa0, pa1, pa2, pa3); a_partialSM(pB0, pB1, m_reg, mnB, alB);
  __syncthreads(); RESC(alB);
  a_finishSM(pB0, pB1, alB, l_reg, pa0, pa1, pa2, pa3); SBAR();
  a_pv(o, vb0 + A_SHM_V, pa0, pa1, pa2, pa3);
  if (hi == 0) li_l[r32] = l_reg; asm volatile("s_waitcnt lgkmcnt(0)" ::: "memory");
#pragma unroll
  for (int r = 0; r < 16; ++r) {
    const int orow = crow(r, hi);
    const float rl = __builtin_amdgcn_rcpf(li_l[orow]);
    const float v0 = o[0][r] * rl, v1 = o[1][r] * rl;
    float ss = v0 * v0 + v1 * v1;
#pragma unroll
    for (int off = 16; off > 0; off >>= 1) ss += __shfl_xor(ss, off, 64);
    const float rs = rsqrtf(ss * (1.f / 64.f) + EPS);
    u16* dst = yout + (size_t)(wid * 32 + orow) * DM;
    dst[r32] = f2bf(v0 * rs); dst[32 + r32] = f2bf(v1 * rs);
  }
  __syncthreads();
#undef SLOAD
#undef SWRITE
#undef SWAIT
#undef RESC
}

__device__ __forceinline__ void phase_attn(const Params& p, int layer, int bid, int nb, char* lds) {
  const int nitems = 512 + (layer == 0 ? 8 : 0);
  for (int it = bid; it < nitems; it += nb) {
    int b, h, q0, k0, seq, tok0;
    if (it < 512) { const int qb = it & 63; h = (it >> 6) & 3; b = it >> 8; q0 = qb * 256; k0 = 0; seq = SKV; tok0 = b * SEQ + qb * 256; }
    else { const int i2 = it - 512; h = i2 & 3; b = i2 >> 2; q0 = SEQ; k0 = SEQ; seq = LC; tok0 = TL + b * LC; }
    const size_t base = (size_t)(b * 4 + h) * SKV;
    attn_item(p.Q() + (base + q0) * 96, p.KV() + (base + k0) * 160, seq, p.ymix() + (size_t)tok0 * DM + h * 64, lds);
  }
}
__device__ __forceinline__ float hy_sconv(const float* __restrict__ row, int t, int Ls, float w0, float w1, float w2, float bb) {
  const float zm = t > 0 ? row[t - 1] : 0.f, z0 = row[t], zp = t + 1 < Ls ? row[t + 1] : 0.f;
  return w0 * zm + w1 * z0 + w2 * zp + bb;
}
__device__ __forceinline__ void hyena_item(const Params& p, int layer, int b, int ch, char* lds) {
  float2* s = (float2*)lds;
  const int tid = ltid();
  const float* cw = p.hy_conv_w + (size_t)layer * 3 * 768; const float* cb = p.hy_conv_b + (size_t)layer * 768;
  const float* r0 = p.zt() + (size_t)(ZT_HY + ch) * TT + (size_t)b * SEQ;
  const float* r1 = p.zt() + (size_t)(ZT_HY + 256 + ch) * TT + (size_t)b * SEQ;
  const float* r2 = p.zt() + (size_t)(ZT_HY + 512 + ch) * TT + (size_t)b * SEQ;
  const float a0 = cw[ch], a1 = cw[768 + ch], a2 = cw[1536 + ch], ab = cb[ch];
  const float b0 = cw[256 + ch], b1 = cw[768 + 256 + ch], b2 = cw[1536 + 256 + ch], bb = cb[256 + ch];
  const float c0 = cw[512 + ch], c1 = cw[768 + 512 + ch], c2 = cw[1536 + 512 + ch], cbb = cb[512 + ch];
  for (int m = tid; m < FM; m += NTHR) {
    float2 z = make_float2(0.f, 0.f);
    if (m < SEQ / 2) {
      const int t = 2 * m;
      z.x = hy_sconv(r2, t, SEQ, c0, c1, c2, cbb) * hy_sconv(r1, t, SEQ, b0, b1, b2, bb);
      z.y = hy_sconv(r2, t + 1, SEQ, c0, c1, c2, cbb) * hy_sconv(r1, t + 1, SEQ, b0, b1, b2, bb);
    }
    s[m] = z;
  }
  __syncthreads();
  fft_fwd(s, p.tw());
  const float4* hs = p.hspec() + ((size_t)layer * 256 + ch) * HSP;
  for (int k = tid; k <= FM / 2; k += NTHR) {
    const int pk = rev7(k), pm = rev7((FM - k) & (FM - 1));
    const float2 zk = s[pk], zm = s[pm];
    const float4 h = hs[k];
    const float2 He = make_float2(h.x, h.y), Ho = make_float2(h.z, h.w);
    const float2 Xe = make_float2(0.5f * (zk.x + zm.x), 0.5f * (zk.y - zm.y));
    const float2 Xo = make_float2(0.5f * (zk.y + zm.y), -0.5f * (zk.x - zm.x));
    const float2 t1 = cmul(p.tw()[k], cmul(Xo, Ho));
    const float2 e1 = cmul(Xe, He);
    const float2 Ye = make_float2(e1.x + t1.x, e1.y + t1.y);
    const float2 o1 = cmul(Xe, Ho), o2 = cmul(Xo, He);
    const float2 Yo = make_float2(o1.x + o2.x, o1.y + o2.y);
    s[pk] = make_float2(Ye.x - Yo.y, Ye.y + Yo.x);
    if (pm != pk) s[pm] = make_float2(Ye.x + Yo.y, -Ye.y + Yo.x);
  }
  __syncthreads();
  fft_inv(s, p.tw());
  const float hb = p.hy_bias[layer * 256 + ch];
  float* orow = p.hyo() + (size_t)ch * TT + (size_t)b * SEQ;
  for (int m = tid; m < SEQ / 2; m += NTHR) {
    const int t = 2 * m;
    const float2 y = s[m];
    const float vg0 = hy_sconv(r2, t, SEQ, c0, c1, c2, cbb) * hy_sconv(r1, t, SEQ, b0, b1, b2, bb);
    const float vg1 = hy_sconv(r2, t + 1, SEQ, c0, c1, c2, cbb) * hy_sconv(r1, t + 1, SEQ, b0, b1, b2, bb);
    const float x00 = hy_sconv(r0, t, SEQ, a0, a1, a2, ab), x01 = hy_sconv(r0, t + 1, SEQ, a0, a1, a2, ab);
    *(float2*)(orow + t) = make_float2((y.x + vg0 * hb) * x00, (y.y + vg1 * hb) * x01);
  }
  __syncthreads();
}
__device__ __forceinline__ void fnet_item(const Params& p, int b, int j, char* lds) {
  float2* s = (float2*)lds;
  const int tid = ltid();
  const float* rr = p.zt() + (size_t)(ZT_FR + j) * TT + (size_t)b * SEQ;
  const float* ri = p.zt() + (size_t)(ZT_FI + j) * TT + (size_t)b * SEQ;
  for (int m = tid; m < FM; m += NTHR) s[m] = make_float2(rr[m], ri[m]);
  __syncthreads();
  fft_fwd(s, p.tw());
  float* orow = p.fno() + (size_t)j * TT + (size_t)b * SEQ;
  for (int k = tid; k < FM; k += NTHR) orow[k] = s[rev7(k)].x * (1.f / 128.f);
  __syncthreads();
}
__device__ __forceinline__ void hyena_ctx_item(const Params& p, int b, int ch, char* lds) {
  float* vg = (float*)lds;
  float* x0 = vg + 256;
  float* hf = x0 + 256;
  float* hbk = hf + 256;
  const int tid = ltid();
  const float* cw = p.hy_conv_w; const float* cb = p.hy_conv_b;
  const size_t off = (size_t)TL + (size_t)b * LC;
  const float* r0 = p.zt() + (size_t)(ZT_HY + ch) * TT + off;
  const float* r1 = p.zt() + (size_t)(ZT_HY + 256 + ch) * TT + off;
  const float* r2 = p.zt() + (size_t)(ZT_HY + 512 + ch) * TT + off;
  if (tid < 256) {
    const int t = tid;
    vg[t] = hy_sconv(r2, t, LC, cw[512 + ch], cw[768 + 512 + ch], cw[1536 + 512 + ch], cb[512 + ch]) *
            hy_sconv(r1, t, LC, cw[256 + ch], cw[768 + 256 + ch], cw[1536 + 256 + ch], cb[256 + ch]);
    x0[t] = hy_sconv(r0, t, LC, cw[ch], cw[768 + ch], cw[1536 + ch], cb[ch]);
    hf[t] = p.hfc()[(size_t)ch * LC + t]; hbk[t] = p.hfc()[(size_t)(256 + ch) * LC + t];
  }
  __syncthreads();
  if (tid < 256) {
    const int t = tid; float y = 0;
    for (int q = 0; q <= t; ++q) y += hf[t - q] * vg[q];
    for (int q = t + 1; q < LC; ++q) y += hbk[q - t] * vg[q];
    y *= rsqrtf(p.hssq()[512 + ch]);
    p.hyo()[(size_t)ch * TT + off + t] = (y + vg[t] * p.hy_bias[ch]) * x0[t];
  }
  __syncthreads();
}
__device__ __forceinline__ void fnet_ctx_item(const Params& p, int b, int j, char* lds) {
  float* ur = (float*)lds; float* ui = ur + 256; float* cst = ui + 256; float* snt = cst + 256;
  const int tid = ltid();
  const size_t off = (size_t)TL + (size_t)b * LC;
  if (tid < 256) {
    ur[tid] = p.zt()[(size_t)(ZT_FR + j) * TT + off + tid]; ui[tid] = p.zt()[(size_t)(ZT_FI + j) * TT + off + tid];
    float sn, cs; sincospif((float)tid / 128.f, &sn, &cs); cst[tid] = cs; snt[tid] = sn;
  }
  __syncthreads();
  if (tid < 256) {
    const int k = tid; float y = 0;
    for (int l = 0; l < 256; ++l) { const int m = (l * k) & 255; y += cst[m] * ur[l] + snt[m] * ui[l]; }
    p.fno()[(size_t)j * TT + off + k] = y * 0.0625f;
  }
  __syncthreads();
}
__device__ __forceinline__ void phase_fftmix(const Params& p, int layer, int bid, int nb, char* lds) {
  const int nitems = layer == 0 ? 2048 : 1024;
  for (int it = bid; it < nitems; it += nb) {
    const int k = it & 511, b = k >> 8, c = k & 255;
    if (it < 512) hyena_item(p, layer, b, c, lds);
    else if (it < 1024) fnet_item(p, b, c, lds);
    else if (it < 1536) hyena_ctx_item(p, b, c, lds);
    else fnet_ctx_item(p, b, c, lds);
  }
}
__device__ __forceinline__ int gla_tok0(int b, int pc) { return pc < 4 ? TL + b * LC + pc * 64 : b * SEQ + (pc - 4) * 64; }
__device__ __forceinline__ int gla_chain_chunk(int pc, int dir) {
  if (dir == 0) return pc;
  return pc < 4 ? 3 - pc : 4 + 255 - (pc - 4);
}
struct GlaLds { float* kq; float* q; float* v; float* cb; };
__device__ __forceinline__ void gla_load(const Params& p, int layer, int tok0, int h, bool need_q, const GlaLds& L) {
  const int tid = ltid();
  for (int i = tid; i < 64 * 32; i += NTHR) {
    const int r = i >> 5, c = i & 31;
    const float* zr = p.zg() + (size_t)(tok0 + r) * ZG_W;
    L.kq[r * 33 + c] = zr[ZG_GK + h * 32 + c];
    if (need_q) L.q[r * 33 + c] = zr[ZG_GQ + h * 32 + c] * 0.17677669529663687f;
  }
  for (int i = tid; i < 64 * 64; i += NTHR) {
    const int r = i >> 6, c = i & 63;
    L.v[r * 65 + c] = p.zg()[(size_t)(tok0 + r) * ZG_W + ZG_GV + h * 64 + c];
  }
  const float* gb = p.gla_gk_b + (size_t)layer * 256;
  for (int i = tid; i < 2 * 64 * 32; i += NTHR) {
    const int dir = i >> 11, r = (i >> 5) & 63, c = i & 31;
    const int pos = dir ? 63 - r : r;
    const float x = p.zg()[(size_t)(tok0 + pos) * ZG_W + ZG_GP + dir * 128 + h * 32 + c] + gb[dir * 128 + h * 32 + c];
    L.cb[(dir * 64 + r) * 33 + c] = (fminf(x, 0.f) - log1pf(__expf(-fabsf(x)))) * (1.f / 16.f);
  }
  __syncthreads();
  if (tid < 64) {
    const int dir = tid >> 5, c = tid & 31; float acc = 0;
    for (int r = 0; r < 64; ++r) { acc += L.cb[(dir * 64 + r) * 33 + c]; L.cb[(dir * 64 + r) * 33 + c] = acc; }
  }
  __syncthreads();
}
__device__ __forceinline__ GlaLds gla_lds(char* lds) {
  GlaLds L; L.kq = (float*)lds; L.q = L.kq + 64 * 33; L.v = L.q + 64 * 33; L.cb = L.v + 64 * 65; return L;
}
__device__ __forceinline__ void phase_gla_a(const Params& p, int layer, int bid, int nb, char* lds) {
  const GlaLds L = gla_lds(lds);
  const int tid = ltid();
  for (int it = bid; it < 2 * NCH * 4; it += nb) {
    const int h = it & 3, pc = (it >> 2) % NCH, b = it / (4 * NCH);
    const int tok0 = gla_tok0(b, pc);
    gla_load(p, layer, tok0, h, false, L);
    const int dir = tid >> 8, kk = (tid >> 3) & 31, v0 = (tid & 7) * 8;
    const float bl = L.cb[(dir * 64 + 63) * 33 + kk];
    float acc[8];
#pragma unroll
    for (int j = 0; j < 8; ++j) acc[j] = 0.f;
    for (int i = 0; i < 64; ++i) {
      const int pos = dir ? 63 - i : i;
      const float w = L.kq[pos * 33 + kk] * __expf(bl - L.cb[(dir * 64 + i) * 33 + kk]);
#pragma unroll
      for (int j = 0; j < 8; ++j) acc[j] += w * L.v[pos * 65 + v0 + j];
    }
    const int chain = (dir * 2 + b) * 4 + h, cc = gla_chain_chunk(pc, dir);
    float* ds = p.gds() + ((size_t)chain * NCH + cc) * 2048 + kk * 64 + v0;
    *(float4*)ds = make_float4(acc[0], acc[1], acc[2], acc[3]); *(float4*)(ds + 4) = make_float4(acc[4], acc[5], acc[6], acc[7]);
    if ((tid & 7) == 0) p.gdv()[((size_t)chain * NCH + cc) * 32 + kk] = __expf(bl);
    __syncthreads();
  }
}
__device__ __forceinline__ void phase_gla_b(const Params& p, int bid, int nb) {
  for (int e = bid * NTHR + ltid(); e < 16 * 2048; e += nb * NTHR) {
    const int chain = e >> 11, kv = e & 2047, kk = kv >> 6;
    const float* ds = p.gds() + (size_t)chain * NCH * 2048 + kv;
    const float* dv = p.gdv() + (size_t)chain * NCH * 32 + kk;
    float* st = p.gst() + (size_t)chain * NCH * 2048 + kv;
    float S = 0.f;
#pragma unroll 4
    for (int n = 0; n < NCH; ++n) {
      st[(size_t)n * 2048] = S;
      S = S * dv[n * 32] + ds[(size_t)n * 2048];
    }
  }
}
__device__ __forceinline__ void phase_gla_c(const Params& p, int layer, int bid, int nb, char* lds) {
  const GlaLds L = gla_lds(lds);
  float* Am = L.cb + 2 * 64 * 33;
  float* Ss = Am + 2 * 64 * 65;
  float* ob = Ss + 2 * 32 * 65;
  const int tid = ltid();
  const int nitem = layer == 0 ? 2 * NCH * 4 : 2 * NCH * 4;
  for (int it = bid; it < nitem; it += nb) {
    const int h = it & 3, pc = (it >> 2) % NCH, b = it / (4 * NCH);
    if (layer == 1 && pc < 4) continue;
    const int tok0 = gla_tok0(b, pc);
    gla_load(p, layer, tok0, h, true, L);
    for (int i = tid; i < 2 * 2048; i += NTHR) {
      const int dir = i >> 11, kv = i & 2047;
      const int chain = (dir * 2 + b) * 4 + h, cc = gla_chain_chunk(pc, dir);
      Ss[(dir * 32 + (kv >> 6)) * 65 + (kv & 63)] = p.gst()[((size_t)chain * NCH + cc) * 2048 + kv];
    }
    for (int e = tid; e < 2 * 64 * 64; e += NTHR) {
      const int dir = e >> 12, i = (e >> 6) & 63, j = e & 63;
      float a = 0.f;
      if (j <= i) {
        const int pi = dir ? 63 - i : i, pj = dir ? 63 - j : j;
        for (int k = 0; k < 32; ++k) a += L.q[pi * 33 + k] * L.kq[pj * 33 + k] * __expf(L.cb[(dir * 64 + i) * 33 + k] - L.cb[(dir * 64 + j) * 33 + k]);
      }
      Am[(dir * 64 + i) * 65 + j] = a;
    }
    __syncthreads();
    {
      const int dir = tid >> 8, i = (tid >> 2) & 63, v0 = (tid & 3) * 16;
      const int pi = dir ? 63 - i : i;
      float acc[16];
#pragma unroll
      for (int j = 0; j < 16; ++j) acc[j] = 0.f;
      for (int k = 0; k < 32; ++k) {
        const float w = L.q[pi * 33 + k] * __expf(L.cb[(dir * 64 + i) * 33 + k]);
#pragma unroll
        for (int j = 0; j < 16; ++j) acc[j] += w * Ss[(dir * 32 + k) * 65 + v0 + j];
      }
      for (int jj = 0; jj <= i; ++jj) {
        const float w = Am[(dir * 64 + i) * 65 + jj]; const int pj = dir ? 63 - jj : jj;
#pragma unroll
        for (int j = 0; j < 16; ++j) acc[j] += w * L.v[pj * 65 + v0 + j];
      }
      if (dir == 1) {
#pragma unroll
        for (int j = 0; j < 16; ++j) ob[pi * 65 + v0 + j] = acc[j];
      }
      __syncthreads();
      if (dir == 0) {
        float* o = p.glao() + (size_t)(tok0 + pi) * 256 + h * 64 + v0;
#pragma unroll
        for (int j = 0; j < 16; j += 4)
          *(float4*)(o + j) = make_float4(acc[j] + ob[pi * 65 + v0 + j], acc[j + 1] + ob[pi * 65 + v0 + j + 1], acc[j + 2] + ob[pi * 65 + v0 + j + 2], acc[j + 3] + ob[pi * 65 + v0 + j + 3]);
      }
    }
    __syncthreads();
  }
}

__device__ __forceinline__ void phase_mix(const Params& p, int layer, int bid, int nb, char* lds) {
  float* part = (float*)lds;
  u16* tile = (u16*)(lds + 4096);
  const int tid = ltid(), wid = tid >> 6, lane = tid & 63;
  const int ntok = layer == 0 ? TT : TL;
  for (int it = bid; it < ntok / 64; it += nb) {
    const int tok0 = it * 64;
    float vh[32], vf[32]; float sh = 0, sf = 0;
#pragma unroll
    for (int c = 0; c < 32; ++c) {
      vh[c] = p.hyo()[(size_t)(wid * 32 + c) * TT + tok0 + lane]; vf[c] = p.fno()[(size_t)(wid * 32 + c) * TT + tok0 + lane];
      sh += vh[c] * vh[c]; sf += vf[c] * vf[c];
    }
    part[(0 * 8 + wid) * 64 + lane] = sh; part[(1 * 8 + wid) * 64 + lane] = sf;
    __syncthreads();
    float th = 0, tf = 0;
#pragma unroll
    for (int q = 0; q < 8; ++q) { th += part[(0 * 8 + q) * 64 + lane]; tf += part[(1 * 8 + q) * 64 + lane]; }
    const float rh = rsqrtf(th * (1.f / 256.f) + EPS), rf = rsqrtf(tf * (1.f / 256.f) + EPS);
#pragma unroll
    for (int c = 0; c < 32; ++c) { tile[lane * 520 + wid * 32 + c] = f2bf(vh[c] * rh); tile[lane * 520 + 256 + wid * 32 + c] = f2bf(vf[c] * rf); }
    __syncthreads();
    for (int g = tid; g < 64 * 64; g += NTHR) {
      const int tl = g >> 6, cg = g & 63;
      const u32x4 w = *(const u32x4*)(tile + tl * 520 + cg * 8);
      *(u32x4*)(p.ymix() + (size_t)(tok0 + tl) * DM + (cg < 32 ? 256 + cg * 8 : 768 + (cg - 32) * 8)) = w;
    }
    for (int tl = wid * 8; tl < wid * 8 + 8; ++tl) {
      const int tok = tok0 + tl;
      const float4 o = *(const float4*)(p.glao() + (size_t)tok * 256 + lane * 4);
      float ss = o.x * o.x + o.y * o.y + o.z * o.z + o.w * o.w;
#pragma unroll
      for (int off = 8; off > 0; off >>= 1) ss += __shfl_xor(ss, off, 64);
      const float rs = rsqrtf(ss * (1.f / 64.f) + EPS);
      const float4 g = *(const float4*)(p.zg() + (size_t)tok * ZG_W + ZG_OG + lane * 4);
      u32x2 w; w[0] = cvtpk(o.x * rs * silu_f(g.x), o.y * rs * silu_f(g.y)); w[1] = cvtpk(o.z * rs * silu_f(g.z), o.w * rs * silu_f(g.w));
      *(u32x2*)(p.ymix() + (size_t)tok * DM + 512 + lane * 4) = w;
    }
    __syncthreads();
  }
}

__device__ __forceinline__ void phase_gemm_out(const Params& p, int layer, int bid, int nb, char* lds) {
  const int tid = ltid(), wid = tid >> 6, lane = tid & 63, wr = wid >> 2, wc = wid & 3, fr = lane & 15, fq = lane >> 4;
  int sR[4], sC[4]; gemm_stage_coords(sR, sC);
  const u16* Bt = p.bt_out() + (size_t)layer * DM * DM;
  const int nM = (layer == 0 ? TT : TL) / 256; constexpr int nN = DM / 256;
  for (int t = bid; t < nM * nN; t += nb) {
    const int pm = t / nN, pn = t % nN, brow = pm * 256, bcol = pn * 256;
    const u16* ap[4]; const u16* bp[4];
#pragma unroll
    for (int i = 0; i < 4; ++i) { ap[i] = p.ymix() + (size_t)(brow + sR[i]) * DM + sC[i]; bp[i] = Bt + (size_t)(bcol + sR[i]) * DM + sC[i]; }
    f32x4 acc[8][4];
    gemm256_core(ap, bp, DM / 64, lds, acc);
    const float* g1 = p.mod() + ((size_t)layer * 3 + modv(brow)) * 6144 + 2 * DM;
#pragma unroll
    for (int m = 0; m < 8; ++m)
#pragma unroll
      for (int j = 0; j < 4; ++j) {
        const int tok = brow + wr * 128 + m * 16 + fq * 4 + j;
        const float* xr = resid_row(p, layer == 0 ? 0 : 1, tok);
        float* xo = p.X() + (size_t)tok * DM;
#pragma unroll
        for (int n = 0; n < 4; ++n) { const int c = bcol + wc * 64 + n * 16 + fr; xo[c] = xr[c] + g1[c] * acc[m][n][j]; }
      }
  }
}

__device__ __forceinline__ void phase_norm2_router(const Params& p, int layer, int bid, int nb, char* lds) {
  float* rwl = (float*)lds;
  int* lcnt = (int*)(lds + 131072);
  int* lbase = lcnt + 32;
  int* ent = lbase + 32;
  float* entw = (float*)(ent + 2 * 1024);
  const int tid = ltid(), wid = tid >> 6, lane = tid & 63;
  const int ntok = layer == 0 ? TT : TL;
  const float* rw = p.router_w + (size_t)layer * DM * NE;
  for (int i = tid; i < DM * NE / 4; i += NTHR) {
    const int k = i >> 3, q4 = i & 7;
    ((float4*)rwl)[q4 * 1024 + ((k & 3) * 256 + (k >> 2))] = ((const float4*)rw)[i];
  }
  if (tid < 32) lcnt[tid] = 0;
  __syncthreads();
  const float* gn = p.norm2_g + layer * DM; const float* rb = p.router_b + layer * NE;
  const int per = (ntok + nb - 1) / nb, t_beg = bid * per, t_end = min(ntok, t_beg + per);
  for (int tok = t_beg + wid; tok < t_end; tok += 8) {
    const float* xr = p.X() + (size_t)tok * DM;
    float v[16];
#pragma unroll
    for (int i = 0; i < 4; ++i) { const float4 a = *(const float4*)(xr + lane * 4 + i * 256); v[4 * i] = a.x; v[4 * i + 1] = a.y; v[4 * i + 2] = a.z; v[4 * i + 3] = a.w; }
    float ss = 0;
#pragma unroll
    for (int i = 0; i < 16; ++i) ss += v[i] * v[i];
    ss = wave_sum(ss);
    const float rs = rsqrtf(ss * (1.f / DM) + EPS);
    const float* md = p.mod() + ((size_t)layer * 3 + modv(tok)) * 6144 + 3 * DM;
    u16* h = p.H() + (size_t)tok * DM;
#pragma unroll
    for (int i = 0; i < 4; ++i) {
      const int c = lane * 4 + i * 256;
      const float4 g = *(const float4*)(gn + c), sh = *(const float4*)(md + c), sc = *(const float4*)(md + DM + c);
      v[4 * i] = v[4 * i] * rs * g.x * (1.f + sc.x) + sh.x; v[4 * i + 1] = v[4 * i + 1] * rs * g.y * (1.f + sc.y) + sh.y;
      v[4 * i + 2] = v[4 * i + 2] * rs * g.z * (1.f + sc.z) + sh.z; v[4 * i + 3] = v[4 * i + 3] * rs * g.w * (1.f + sc.w) + sh.w;
      u32x2 w; w[0] = cvtpk(v[4 * i], v[4 * i + 1]); w[1] = cvtpk(v[4 * i + 2], v[4 * i + 3]);
      *(u32x2*)(h + c) = w;
    }
    float lg[32];
#pragma unroll
    for (int e = 0; e < 32; ++e) lg[e] = 0.f;
#pragma unroll
    for (int i = 0; i < 16; ++i) {
      const float4* wr4 = (const float4*)rwl + ((i & 3) * 256 + (i >> 2) * 64 + lane);
#pragma unroll
      for (int q = 0; q < 8; ++q) { const float4 w = wr4[q * 1024]; lg[4 * q] += v[i] * w.x; lg[4 * q + 1] += v[i] * w.y; lg[4 * q + 2] += v[i] * w.z; lg[4 * q + 3] += v[i] * w.w; }
    }
#pragma unroll
    for (int e = 0; e < 32; ++e) lg[e] = wave_sum(lg[e]) + rb[e];
    if (lane == 0) {
      int ids[4]; float vals[4]; unsigned used = 0;
#pragma unroll
      for (int k = 0; k < 4; ++k) {
        float best = -3.4e38f; int bi = 0;
#pragma unroll
        for (int e = 0; e < 32; ++e) { const bool ok = !((used >> e) & 1u) && lg[e] > best; best = ok ? lg[e] : best; bi = ok ? e : bi; }
        used |= 1u << bi; ids[k] = bi; vals[k] = best;
      }
      const float mx = vals[0];
      float ex[4], sum = 0;
#pragma unroll
      for (int k = 0; k < 4; ++k) { ex[k] = __expf(vals[k] - mx); sum += ex[k]; }
      const float inv = 1.f / sum;
#pragma unroll
      for (int k = 0; k < 4; ++k) {
        const int lp = atomicAdd(&lcnt[ids[k]], 1);
        const int slot = (tok - t_beg) * 4 + k;
        ent[2 * slot] = tok * 4 + k; ent[2 * slot + 1] = (ids[k] << 20) | lp; entw[slot] = ex[k] * inv;
      }
    }
  }
  __syncthreads();
  if (tid < 32) lbase[tid] = atomicAdd(&p.cnt()[layer * NE + tid], lcnt[tid]);
  __syncthreads();
  const int nas = (t_end > t_beg ? (t_end - t_beg) : 0) * 4;
  for (int s = tid; s < nas; s += NTHR) {
    const int tk = ent[2 * s], el = ent[2 * s + 1], e = el >> 20, pos = lbase[e] + (el & 0xFFFFF);
    p.rtok()[(size_t)e * TT + pos] = tk >> 2; p.rw()[(size_t)e * TT + pos] = entw[s];
    p.tslot()[tk] = (e << 20) | pos;
  }
}

__device__ __forceinline__ bool moe_find(const int* cnt, int w, int ntn, int& e, int& mt, int& nt_, int& pre) {
  int acc = 0, rows = 0;
  for (int ee = 0; ee < NE; ++ee) {
    const int c = cnt[ee], tiles = ((c + 255) >> 8) * ntn;
    if (w < acc + tiles) { const int r = w - acc; e = ee; mt = r / ntn; nt_ = r % ntn; pre = rows; return true; }
    acc += tiles; rows += c;
  }
  return false;
}
__device__ __forceinline__ void phase_moe_gu(const Params& p, int layer, int bid, int nb, char* lds) {
  const int tid = ltid(), wid = tid >> 6, lane = tid & 63, wr = wid >> 2, wc = wid & 3, fr = lane & 15, fq = lane >> 4;
  int sR[4], sC[4]; gemm_stage_coords(sR, sC);
  int* scnt = (int*)(lds + GEMM_LDS);
  if (tid < NE) scnt[tid] = p.cnt()[layer * NE + tid];
  __syncthreads();
  for (int w = bid;; w += nb) {
    int e, mt, pn, pre;
    if (!moe_find(scnt, w, 8, e, mt, pn, pre)) break;
    const int ce = scnt[e];
    const u16* Bt = p.bt_gu() + ((size_t)layer * NE + e) * 2048 * DM;
    const u16* ap[4]; const u16* bp[4];
#pragma unroll
    for (int i = 0; i < 4; ++i) {
      const int r = min(mt * 256 + sR[i], ce - 1);
      ap[i] = p.H() + (size_t)p.rtok()[(size_t)e * TT + r] * DM + sC[i];
      bp[i] = Bt + (size_t)(pn * 256 + sR[i]) * DM + sC[i];
    }
    f32x4 acc[8][4];
    gemm256_core(ap, bp, DM / 64, lds, acc);
    const int jb = (pn * 256 + wc * 64) >> 1;
    const float* bg = p.moe_b_gu + ((size_t)layer * NE + e) * 2048;
#pragma unroll
    for (int n = 0; n < 2; ++n) {
      const int j = jb + n * 16 + fr;
      const float bgate = bg[2 * j], bup = bg[2 * j + 1];
#pragma unroll
      for (int m = 0; m < 8; ++m)
#pragma unroll
        for (int jj = 0; jj < 4; ++jj) {
          const int r = mt * 256 + wr * 128 + m * 16 + fq * 4 + jj;
          if (r < ce) {
            const float gate = fminf(acc[m][n][jj] + bgate, 7.f);
            const float up = fminf(fmaxf(acc[m][n + 2][jj] + bup, -7.f), 7.f);
            const float glu = gate / (1.f + __expf(-1.702f * gate));
            p.act()[(size_t)(pre + r) * DFF + j] = f2bf((up + 1.f) * glu);
          }
        }
    }
  }
}
__device__ __forceinline__ void phase_moe_dn(const Params& p, int layer, int bid, int nb, char* lds) {
  const int tid = ltid(), wid = tid >> 6, lane = tid & 63, wr = wid >> 2, wc = wid & 3, fr = lane & 15, fq = lane >> 4;
  int sR[4], sC[4]; gemm_stage_coords(sR, sC);
  int* scnt = (int*)(lds + GEMM_LDS);
  if (tid < NE) scnt[tid] = p.cnt()[layer * NE + tid];
  __syncthreads();
  for (int w = bid;; w += nb) {
    int e, mt, pn, pre;
    if (!moe_find(scnt, w, 4, e, mt, pn, pre)) break;
    const int ce = scnt[e];
    const u16* Bt = p.bt_dn() + ((size_t)layer * NE + e) * DM * DFF;
    const u16* ap[4]; const u16* bp[4];
#pragma unroll
    for (int i = 0; i < 4; ++i) {
      const int r = min(mt * 256 + sR[i], ce - 1);
      ap[i] = p.act() + (size_t)(pre + r) * DFF + sC[i];
      bp[i] = Bt + (size_t)(pn * 256 + sR[i]) * DFF + sC[i];
    }
    f32x4 acc[8][4];
    gemm256_core(ap, bp, DFF / 64, lds, acc);
    const float* bd = p.moe_b_down + ((size_t)layer * NE + e) * DM;
#pragma unroll
    for (int m = 0; m < 8; ++m)
#pragma unroll
      for (int jj = 0; jj < 4; ++jj) {
        const int r = mt * 256 + wr * 128 + m * 16 + fq * 4 + jj;
        if (r < ce) {
          const float wgt = p.rw()[(size_t)e * TT + r];
          u16* y = p.yd() + (size_t)(pre + r) * DM;
#pragma unroll
          for (int n = 0; n < 4; ++n) { const int c = pn * 256 + wc * 64 + n * 16 + fr; y[c] = f2bf((acc[m][n][jj] + bd[c]) * wgt); }
        }
      }
  }
}

__device__ __forceinline__ void phase_final(const Params& p, int bid, int nb, char* lds) {
  int* pre = (int*)lds;
  expert_prefix(p.cnt() + NE, pre); __syncthreads();
  const int wid = ltid() >> 6, lane = ltid() & 63;
  for (int tok = bid * 8 + wid; tok < TL; tok += nb * 8) {
    float v[16];
    load_row_comb(p, 1, 1, tok, lane, pre, v);
    float ss = 0;
#pragma unroll
    for (int i = 0; i < 16; ++i) ss += v[i] * v[i];
    ss = wave_sum(ss);
    const float rs = rsqrtf(ss * (1.f / DM) + EPS);
    float* o = p.out + (size_t)tok * DM;
#pragma unroll
    for (int i = 0; i < 4; ++i) {
      const int c = lane * 4 + i * 256;
      const float4 g = *(const float4*)(p.final_g + c);
      *(float4*)(o + c) = make_float4(v[4 * i] * rs * g.x, v[4 * i + 1] * rs * g.y, v[4 * i + 2] * rs * g.z, v[4 * i + 3] * rs * g.w);
    }
  }
}

#define XB_TMO      128
#define XB_XCNT(j)  (256  + 64 * (j))
#define XB_XSUB(j)  (1280 + 64 * (j))
#define XB_XGEN(j)  (2304 + 64 * (j))
#define XB_TOP      3328
#define XB_TOPGEN   3392
#define XCD_BAR_WORDS 3456
#define XB_SPIN_CAP (1u << 18)
#define LAS __attribute__((address_space(3)))

__device__ __forceinline__ unsigned xb_ld(unsigned* p)              { return __hip_atomic_load(p, __ATOMIC_RELAXED, __HIP_MEMORY_SCOPE_AGENT); }
__device__ __forceinline__ unsigned xb_add(unsigned* p, unsigned v) { return __hip_atomic_fetch_add(p, v, __ATOMIC_RELAXED, __HIP_MEMORY_SCOPE_AGENT); }
__device__ __forceinline__ unsigned xb_xcc_id() { return (unsigned)__builtin_amdgcn_s_getreg((3 << 11) | 20) & 0xFu; }
#define XB_SPIN(cond, bar) do { unsigned _sp = 0; while (cond) { __builtin_amdgcn_s_sleep(1); \
    if ((++_sp & 255u) == 0u) { if (xb_ld(&(bar)[XB_TMO])) break; if (_sp > XB_SPIN_CAP) { atomicAdd(&(bar)[XB_TMO], 1u); break; } } } } while (0)

struct XcdBarrier {
    unsigned* bar; unsigned x;
    volatile LAS unsigned* st;
};

__device__ __forceinline__ XcdBarrier xcd_barrier_post(unsigned* bar, volatile LAS unsigned* st) {
    XcdBarrier b; b.bar = bar; b.x = xb_xcc_id(); b.st = st;
    if (threadIdx.x == 0) (void)xb_add(&bar[XB_XCNT(b.x)], 1u);
    return b;
}
__device__ __forceinline__ void xcd_barrier_complete(unsigned* bar, unsigned x, unsigned& nloc, unsigned& nx) {
    const unsigned G = gridDim.x * gridDim.y * gridDim.z;
    unsigned sum, cnt, mine, sp = 0u;
    for (;;) {
        sum = 0u; cnt = 0u; mine = 0u;
#pragma unroll
        for (unsigned j = 0; j < 16; ++j) { const unsigned c = xb_ld(&bar[XB_XCNT(j)]); sum += c; cnt += (c > 0u) ? 1u : 0u; mine = (j == x) ? c : mine; }
        if (sum == G) break;
        __builtin_amdgcn_s_sleep(1);
        if ((++sp & 255u) == 0u) { if (xb_ld(&bar[XB_TMO])) break; if (sp > XB_SPIN_CAP) { atomicAdd(&bar[XB_TMO], 1u); break; } }
    }
    nloc = mine > 0u ? mine : 1u; nx = cnt > 0u ? cnt : 1u;
}

__device__ __forceinline__ void xcd_barrier(const XcdBarrier& b) {
    asm volatile("s_waitcnt vmcnt(0)" ::: "memory");
    __syncthreads();
    if (threadIdx.x == 0) {
        unsigned* bar = b.bar;
        __builtin_amdgcn_s_waitcnt(0);
        unsigned nloc = b.st[0], nx = b.st[1];
        if (nloc == 0u) { xcd_barrier_complete(bar, b.x, nloc, nx); b.st[0] = nloc; b.st[1] = nx; }
        const unsigned old = xb_add(&bar[XB_XSUB(b.x)], 1u);
        const unsigned gen = old / nloc;
        if (old + 1u == (gen + 1u) * nloc) {
            __builtin_amdgcn_fence(__ATOMIC_RELEASE, "agent");
            asm volatile("s_waitcnt vmcnt(0)" ::: "memory");
            const unsigned og = xb_add(&bar[XB_TOP], 1u);
            const unsigned tg = og / nx;
            if (og + 1u == (tg + 1u) * nx) xb_add(&bar[XB_TOPGEN], 1u);
            else XB_SPIN(xb_ld(&bar[XB_TOPGEN]) == tg, bar);
            __builtin_amdgcn_fence(__ATOMIC_ACQUIRE, "agent");
            xb_add(&bar[XB_XGEN(b.x)], 1u);
            asm volatile("s_waitcnt vmcnt(0)" ::: "memory");
        } else {
            XB_SPIN(xb_ld(&bar[XB_XGEN(b.x)]) == gen, bar);
            __builtin_amdgcn_fence(__ATOMIC_ACQUIRE, "agent");
            asm volatile("s_waitcnt vmcnt(0)" ::: "memory");
        }
    }
    __syncthreads();
}

constexpr int LDS_MAIN = 147456;
constexpr int LDS_BYTES = LDS_MAIN + 1024;
enum { PH_TABLES = 0, PH_MOD, PH_FOLD, PH_CONVERT, PH_HYMLP, PH_HYFILT, PH_NORM1, PH_GEMM_IN, PH_QKV, PH_ATTN, PH_FFTMIX,
       PH_GLA_A, PH_GLA_B, PH_GLA_C, PH_MIX, PH_GEMM_OUT, PH_NORM2, PH_MOE_GU, PH_MOE_DN, PH_FINAL };

template <int PH>
__global__ void __launch_bounds__(NTHR, 2) k_phase(Params p, int layer) {
  extern __shared__ __attribute__((aligned(1024))) char lds[];
  const int bid = blockIdx.x, nb = gridDim.x;
  if constexpr (PH == PH_TABLES) phase_tables(p, bid, nb);
  else if constexpr (PH == PH_MOD) phase_mod(p, bid, nb, lds);
  else if constexpr (PH == PH_FOLD) phase_fold(p, bid, nb, lds);
  else if constexpr (PH == PH_CONVERT) phase_convert(p, bid, nb, lds);
  else if constexpr (PH == PH_HYMLP) {
    if (layer < 2) phase_hy_mlp(p, layer, SEQ, p.hfb() + (size_t)layer * 2 * 256 * SEQ, p.hssq() + layer * 256, bid, nb, lds);
    else phase_hy_mlp(p, 0, LC, p.hfc(), p.hssq() + 512, bid, nb, lds);
  }
  else if constexpr (PH == PH_HYFILT) phase_hy_filtfft(p, bid, nb, lds);
  else if constexpr (PH == PH_NORM1) phase_norm1(p, layer, bid, nb, lds);
  else if constexpr (PH == PH_GEMM_IN) phase_gemm_in(p, layer, bid, nb, lds);
  else if constexpr (PH == PH_QKV) phase_qkv(p, layer, bid, nb, lds);
  else if constexpr (PH == PH_ATTN) phase_attn(p, layer, bid, nb, lds);
  else if constexpr (PH == PH_FFTMIX) phase_fftmix(p, layer, bid, nb, lds);
  else if constexpr (PH == PH_GLA_A) phase_gla_a(p, layer, bid, nb, lds);
  else if constexpr (PH == PH_GLA_B) phase_gla_b(p, bid, nb);
  else if constexpr (PH == PH_GLA_C) phase_gla_c(p, layer, bid, nb, lds);
  else if constexpr (PH == PH_MIX) phase_mix(p, layer, bid, nb, lds);
  else if constexpr (PH == PH_GEMM_OUT) phase_gemm_out(p, layer, bid, nb, lds);
  else if constexpr (PH == PH_NORM2) phase_norm2_router(p, layer, bid, nb, lds);
  else if constexpr (PH == PH_MOE_GU) phase_moe_gu(p, layer, bid, nb, lds);
  else if constexpr (PH == PH_MOE_DN) phase_moe_dn(p, layer, bid, nb, lds);
  else if constexpr (PH == PH_FINAL) phase_final(p, bid, nb, lds);
}


#ifndef MK_LAUNCHES
#define MK_LAUNCHES 1
#endif
__global__ void __launch_bounds__(NTHR, 2) k_mega(Params p) {
  extern __shared__ __attribute__((aligned(1024))) char lds[];
  const int bid = blockIdx.x, nb = gridDim.x;
  if (threadIdx.x == 0) *(uint4*)(lds + LDS_MAIN) = make_uint4(0u, 0u, 0u, 0u);
  __syncthreads();
  XcdBarrier bar = xcd_barrier_post(p.bar(), (volatile LAS unsigned*)(lds + LDS_MAIN));
  phase_tables(p, bid, nb);
  phase_mod(p, bid, nb, lds);
  phase_fold(p, bid, nb, lds);
  phase_convert(p, bid, nb, lds);
  phase_hy_mlp(p, 0, SEQ, p.hfb(), p.hssq(), bid, nb, lds);
  phase_hy_mlp(p, 1, SEQ, p.hfb() + (size_t)2 * 256 * SEQ, p.hssq() + 256, bid, nb, lds);
  phase_hy_mlp(p, 0, LC, p.hfc(), p.hssq() + 512, bid, nb, lds);
  xcd_barrier(bar);
  phase_hy_filtfft(p, bid, nb, lds);
#define MK_LAYER(l) do { \
  phase_norm1(p, l, bid, nb, lds); \
  xcd_barrier(bar); \
  phase_gemm_in(p, l, bid, nb, lds); \
  xcd_barrier(bar); \
  phase_qkv(p, l, bid, nb, lds); \
  phase_gla_a(p, l, bid, nb, lds); \
  xcd_barrier(bar); \
  phase_attn(p, l, bid, nb, lds); \
  phase_fftmix(p, l, bid, nb, lds); \
  phase_gla_b(p, bid, nb); \
  xcd_barrier(bar); \
  phase_gla_c(p, l, bid, nb, lds); \
  xcd_barrier(bar); \
  phase_mix(p, l, bid, nb, lds); \
  xcd_barrier(bar); \
  phase_gemm_out(p, l, bid, nb, lds); \
  xcd_barrier(bar); \
  phase_norm2_router(p, l, bid, nb, lds); \
  xcd_barrier(bar); \
  phase_moe_gu(p, l, bid, nb, lds); \
  xcd_barrier(bar); \
  phase_moe_dn(p, l, bid, nb, lds); \
  xcd_barrier(bar); \
  } while (0)
  MK_LAYER(0);
  MK_LAYER(1);
#undef MK_LAYER
  phase_final(p, bid, nb, lds);
}
static size_t carve(char*& cur, size_t bytes) { char* r = cur; cur += (bytes + 1023) & ~(size_t)1023; return (size_t)(uintptr_t)r; }
#define CARVE(T, field, n) p.field = (T*)carve(cur, (size_t)(n) * sizeof(T))

template <int PH> static void launch_phase(const Params& p, int layer, hipStream_t stream) {
  static bool attr = false;
  if (!attr) { hipFuncSetAttribute((const void*)k_phase<PH>, hipFuncAttributeMaxDynamicSharedMemorySize, LDS_BYTES); attr = true; }
  hipLaunchKernelGGL(k_phase<PH>, dim3(256), dim3(NTHR), LDS_BYTES, stream, p, layer);
}

extern "C" void kernel_launch(void* const* d_in, const int* in_sizes, int n_in, void* d_out, int out_size, void* d_ws, size_t ws_size, hipStream_t stream) {
  Params p; memset(&p, 0, sizeof(p));
  const float** ins = (const float**)&p;
  for (int i = 0; i < 34; ++i) ins[i] = (const float*)d_in[i];
  p.out = (float*)d_out;
  p.ws = (char*)d_ws;
  if (WS_TOTAL > ws_size) { fprintf(stderr, "workspace too small: need %zu have %zu\n", (size_t)WS_TOTAL, ws_size); return; }
  hipMemsetAsync(p.bar(), 0, OFF_mod - OFF_bar, stream);
  static int grid = 0;
  if (!grid) {
    int dev = 0, cus = 0, per_cu = 0;
    hipGetDevice(&dev);
    hipDeviceGetAttribute(&cus, hipDeviceAttributeMultiprocessorCount, dev);
    hipFuncSetAttribute((const void*)k_mega, hipFuncAttributeMaxDynamicSharedMemorySize, LDS_BYTES);
    hipOccupancyMaxActiveBlocksPerMultiprocessor(&per_cu, (const void*)k_mega, NTHR, LDS_BYTES);
    grid = cus * (per_cu < 1 ? per_cu : 1);
    if (grid != 256) fprintf(stderr, "unexpected grid %d (cus %d per_cu %d)\n", grid, cus, per_cu);
  }
  hipLaunchKernelGGL(k_mega, dim3(grid), dim3(NTHR), LDS_BYTES, stream, p);
}
```

```cpp
#include <hip/hip_runtime.h>
#include <hip/hip_bf16.h>
#include <cstdio>
#include <cstdint>
#include <cstring>

typedef unsigned short u16;
using bf16x8 = __attribute__((ext_vector_type(8))) short;
using s16x4  = __attribute__((ext_vector_type(4))) short;
using f32x4  = __attribute__((ext_vector_type(4))) float;
using f32x16 = __attribute__((ext_vector_type(16))) float;
using u32x4  = __attribute__((ext_vector_type(4))) unsigned;
using u32x2  = __attribute__((ext_vector_type(2))) unsigned;

constexpr int DM = 1024, NB = 2, SEQ = 16384, LC = 256;
constexpr int TL = NB * SEQ;
constexpr int TC = NB * LC;
constexpr int TT = TL + TC;
constexpr int NIN = 2816;
constexpr int DIN0 = 2240;
constexpr int NE = 32, TOPK = 4, DFF = 1024;
constexpr int SKV = SEQ + LC;
constexpr int NTHR = 512;
constexpr float EPS = 1e-6f;
constexpr int ZG_W = 1152, ZG_GQ = 0, ZG_GK = 128, ZG_KR = 256, ZG_GV = 384, ZG_GP = 640, ZG_OG = 896;
constexpr int ZT_HY = 0, ZT_FR = 768, ZT_FI = 1024, ZT_R = 1280;
constexpr int NCH = 260;
constexpr int FM = 16384;
constexpr int HSP = FM / 2 + 1;

constexpr size_t ws_al(size_t b) { return (b + 1023) & ~(size_t)1023; }
constexpr size_t OFF_bar = 0;
constexpr size_t OFF_cnt = OFF_bar + ws_al((size_t)(4096) * sizeof(unsigned));
constexpr size_t OFF_hssq = OFF_cnt + ws_al((size_t)(64) * sizeof(int));
constexpr size_t OFF_mod = OFF_hssq + ws_al((size_t)(768) * sizeof(float));
constexpr size_t OFF_ropec = OFF_mod + ws_al((size_t)(2 * 3 * 6144) * sizeof(float));
constexpr size_t OFF_ropes = OFF_ropec + ws_al((size_t)(SEQ * 16) * sizeof(float));
constexpr size_t OFF_tw = OFF_ropes + ws_al((size_t)(SEQ * 16) * sizeof(float));
constexpr size_t OFF_bt_in = OFF_tw + ws_al((size_t)(FM) * sizeof(float2));
constexpr size_t OFF_bt_qkv = OFF_bt_in + ws_al((size_t)((size_t)2 * NIN * DM) * sizeof(u16));
constexpr size_t OFF_bt_out = OFF_bt_qkv + ws_al((size_t)(2 * 1024 * 384) * sizeof(u16));
constexpr size_t OFF_bt_gu = OFF_bt_out + ws_al((size_t)((size_t)2 * DM * DM) * sizeof(u16));
constexpr size_t OFF_bt_dn = OFF_bt_gu + ws_al((size_t)((size_t)2 * NE * 2048 * DM) * sizeof(u16));
constexpr size_t OFF_hfb = OFF_bt_dn + ws_al((size_t)((size_t)2 * NE * DM * DFF) * sizeof(u16));
constexpr size_t OFF_hfc = OFF_hfb + ws_al((size_t)((size_t)2 * 2 * 256 * SEQ) * sizeof(float));
constexpr size_t OFF_hspec = OFF_hfc + ws_al((size_t)(2 * 256 * LC) * sizeof(float));
constexpr size_t OFF_H = OFF_hspec + ws_al((size_t)((size_t)2 * 256 * HSP) * sizeof(float4));
constexpr size_t OFF_zqkv = OFF_H + ws_al((size_t)((size_t)TT * DM) * sizeof(u16));
constexpr size_t OFF_zg = OFF_zqkv + ws_al((size_t)((size_t)TT * 384) * sizeof(u16));
constexpr size_t OFF_zt = OFF_zg + ws_al((size_t)((size_t)TT * ZG_W) * sizeof(float));
constexpr size_t OFF_Q = OFF_zt + ws_al((size_t)((size_t)ZT_R * TT) * sizeof(float));
constexpr size_t OFF_KV = OFF_Q + ws_al((size_t)((size_t)2 * 4 * SKV * 96) * sizeof(u16));
constexpr size_t OFF_ymix = OFF_KV + ws_al((size_t)((size_t)2 * 4 * SKV * 160) * sizeof(u16));
constexpr size_t OFF_hyo = OFF_ymix + ws_al((size_t)((size_t)TT * DM) * sizeof(u16));
constexpr size_t OFF_fno = OFF_hyo + ws_al((size_t)((size_t)256 * TT) * sizeof(float));
constexpr size_t OFF_glao = OFF_fno + ws_al((size_t)((size_t)256 * TT) * sizeof(float));
constexpr size_t OFF_gds = OFF_glao + ws_al((size_t)((size_t)TT * 256) * sizeof(float));
constexpr size_t OFF_gdv = OFF_gds + ws_al((size_t)((size_t)16 * NCH * 2048) * sizeof(float));
constexpr size_t OFF_gst = OFF_gdv + ws_al((size_t)((size_t)16 * NCH * 32) * sizeof(float));
constexpr size_t OFF_X = OFF_gst + ws_al((size_t)((size_t)16 * NCH * 2048) * sizeof(float));
constexpr size_t OFF_rtok = OFF_X + ws_al((size_t)((size_t)TT * DM) * sizeof(float));
constexpr size_t OFF_rw = OFF_rtok + ws_al((size_t)((size_t)NE * TT) * sizeof(int));
constexpr size_t OFF_tslot = OFF_rw + ws_al((size_t)((size_t)NE * TT) * sizeof(float));
constexpr size_t OFF_act = OFF_tslot + ws_al((size_t)((size_t)TT * 4) * sizeof(int));
constexpr size_t OFF_yd = OFF_act + ws_al((size_t)((size_t)TT * 4 * DFF) * sizeof(u16));
constexpr size_t WS_TOTAL = OFF_yd + ws_al((size_t)((size_t)TT * 4 * DM) * sizeof(u16));
struct Params {
  const float *x, *c, *ctx, *c_ctx, *ada_w, *ada_b, *norm1_g, *norm2_g, *w_in, *mla_q_g, *mla_w_uq, *mla_kv_g, *mla_w_ukv,
      *hy_conv_w, *hy_conv_b, *hy_w1, *hy_b1, *hy_w2, *hy_b2, *hy_w3, *hy_freq, *hy_bias, *gla_gk_w, *gla_gk_b,
      *fnet_w, *mix_g, *w_out, *router_w, *router_b, *moe_w_gu, *moe_b_gu, *moe_w_down, *moe_b_down, *final_g;
  float* out;
  char* ws;
  __device__ __host__ __forceinline__ unsigned* bar() const { return (unsigned*)(ws + OFF_bar); }
  __device__ __host__ __forceinline__ int* cnt() const { return (int*)(ws + OFF_cnt); }
  __device__ __host__ __forceinline__ float* hssq() const { return (float*)(ws + OFF_hssq); }
  __device__ __host__ __forceinline__ float* mod() const { return (float*)(ws + OFF_mod); }
  __device__ __host__ __forceinline__ float* ropec() const { return (float*)(ws + OFF_ropec); }
  __device__ __host__ __forceinline__ float* ropes() const { return (float*)(ws + OFF_ropes); }
  __device__ __host__ __forceinline__ float2* tw() const { return (float2*)(ws + OFF_tw); }
  __device__ __host__ __forceinline__ u16* bt_in() const { return (u16*)(ws + OFF_bt_in); }
  __device__ __host__ __forceinline__ u16* bt_qkv() const { return (u16*)(ws + OFF_bt_qkv); }
  __device__ __host__ __forceinline__ u16* bt_out() const { return (u16*)(ws + OFF_bt_out); }
  __device__ __host__ __forceinline__ u16* bt_gu() const { return (u16*)(ws + OFF_bt_gu); }
  __device__ __host__ __forceinline__ u16* bt_dn() const { return (u16*)(ws + OFF_bt_dn); }
  __device__ __host__ __forceinline__ float* hfb() const { return (float*)(ws + OFF_hfb); }
  __device__ __host__ __forceinline__ float* hfc() const { return (float*)(ws + OFF_hfc); }
  __device__ __host__ __forceinline__ float4* hspec() const { return (float4*)(ws + OFF_hspec); }
  __device__ __host__ __forceinline__ u16* H() const { return (u16*)(ws + OFF_H); }
  __device__ __host__ __forceinline__ u16* zqkv() const { return (u16*)(ws + OFF_zqkv); }
  __device__ __host__ __forceinline__ float* zg() const { return (float*)(ws + OFF_zg); }
  __device__ __host__ __forceinline__ float* zt() const { return (float*)(ws + OFF_zt); }
  __device__ __host__ __forceinline__ u16* Q() const { return (u16*)(ws + OFF_Q); }
  __device__ __host__ __forceinline__ u16* KV() const { return (u16*)(ws + OFF_KV); }
  __device__ __host__ __forceinline__ u16* ymix() const { return (u16*)(ws + OFF_ymix); }
  __device__ __host__ __forceinline__ float* hyo() const { return (float*)(ws + OFF_hyo); }
  __device__ __host__ __forceinline__ float* fno() const { return (float*)(ws + OFF_fno); }
  __device__ __host__ __forceinline__ float* glao() const { return (float*)(ws + OFF_glao); }
  __device__ __host__ __forceinline__ float* gds() const { return (float*)(ws + OFF_gds); }
  __device__ __host__ __forceinline__ float* gdv() const { return (float*)(ws + OFF_gdv); }
  __device__ __host__ __forceinline__ float* gst() const { return (float*)(ws + OFF_gst); }
  __device__ __host__ __forceinline__ float* X() const { return (float*)(ws + OFF_X); }
  __device__ __host__ __forceinline__ int* rtok() const { return (int*)(ws + OFF_rtok); }
  __device__ __host__ __forceinline__ float* rw() const { return (float*)(ws + OFF_rw); }
  __device__ __host__ __forceinline__ int* tslot() const { return (int*)(ws + OFF_tslot); }
  __device__ __host__ __forceinline__ u16* act() const { return (u16*)(ws + OFF_act); }
  __device__ __host__ __forceinline__ u16* yd() const { return (u16*)(ws + OFF_yd); }
};


__device__ __forceinline__ u16 f2bf(float f) {
  unsigned u = __float_as_uint(f); u += 0x7FFFu + ((u >> 16) & 1u); return (u16)(u >> 16);
}
__device__ __forceinline__ float bf2f(u16 h) { return __uint_as_float(((unsigned)h) << 16); }
__device__ __forceinline__ unsigned cvtpk(float lo, float hi) {
  unsigned r; asm volatile("v_cvt_pk_bf16_f32 %0, %1, %2" : "=v"(r) : "v"(lo), "v"(hi)); return r;
}
__device__ __forceinline__ float wave_sum(float v) {
#pragma unroll
  for (int o = 32; o > 0; o >>= 1) v += __shfl_xor(v, o, 64);
  return v;
}
__device__ __forceinline__ int ltid() { int t = threadIdx.x; asm volatile("" : "+v"(t)); return t; }
__device__ __forceinline__ float silu_f(float x) { return x / (1.f + __expf(-x)); }
__device__ __forceinline__ float2 cmul(float2 a, float2 b) { return make_float2(a.x * b.x - a.y * b.y, a.x * b.y + a.y * b.x); }
__device__ __forceinline__ float2 cmulc(float2 a, float2 b) { return make_float2(a.x * b.x + a.y * b.y, a.y * b.x - a.x * b.y); }
__device__ __forceinline__ int modv(int tok) { return tok < TL ? (tok >> 14) : 2; }
__device__ __forceinline__ void phase_tables(const Params& p, int bid, int nb) {
  const int gt = bid * NTHR + ltid(), gs = nb * NTHR;
  for (int i = gt; i < SEQ * 16; i += gs) {
    const int t = i >> 4, f = i & 15;
    const float pos = (f < 8) ? (float)(t >> 6) : (float)(t & 63);
    const float inv = powf(10000.f, -(float)(f & 7) / 8.f);
    float s, c; sincosf(pos * inv, &s, &c);
    p.ropec()[i] = c; p.ropes()[i] = s;
  }
  for (int i = gt; i < FM; i += gs) {
    float s, c; sincospif((float)i / 8192.f, &s, &c);
    p.tw()[i] = make_float2(c, -s);
  }
}

__device__ __forceinline__ void phase_mod(const Params& p, int bid, int nb, char* lds) {
  float* red = (float*)lds;
  const int tid = ltid(), part = tid >> 6, cl = tid & 63;
  for (int it = bid; it < 2 * 96; it += nb) {
    const int l = it / 96, n = (it % 96) * 64 + cl;
    const float* W = p.ada_w + (size_t)l * DM * 6144;
    float a0 = 0, a1 = 0, a2 = 0;
    for (int k = part * 128; k < part * 128 + 128; ++k) {
      const float w = W[(size_t)k * 6144 + n];
      a0 += silu_f(p.c[k]) * w; a1 += silu_f(p.c[DM + k]) * w; a2 += silu_f(p.c_ctx[k]) * w;
    }
    red[(part * 3 + 0) * 64 + cl] = a0; red[(part * 3 + 1) * 64 + cl] = a1; red[(part * 3 + 2) * 64 + cl] = a2;
    __syncthreads();
    if (tid < 192) {
      const int v = tid >> 6; float s = 0;
      for (int q = 0; q < 8; ++q) s += red[(q * 3 + v) * 64 + cl];
      p.mod()[((size_t)l * 3 + v) * 6144 + n] = s + p.ada_b[(size_t)l * 6144 + n];
    }
    __syncthreads();
  }
}

__device__ __forceinline__ void phase_fold(const Params& p, int bid, int nb, char* lds) {
  float* wrow = (float*)lds;
  float* dre = wrow + 256;
  float* dim_ = dre + 256;
  float* glr = dim_ + 256;
  float* cst = glr + 32;
  float* snt = cst + 256;
  const int tid = ltid();
  if (tid < 256) { float s, c; sincospif((float)tid / 128.f, &s, &c); cst[tid] = c; snt[tid] = s; }
  __syncthreads();
  for (int it = bid; it < 2 * DM; it += nb) {
    const int l = it >> 10, k = it & 1023;
    const float* wr = p.w_in + ((size_t)l * DM + k) * DIN0;
    if (tid < 256) wrow[tid] = wr[1984 + tid];
    if (tid >= 256 && tid < 288) glr[tid - 256] = wr[1696 + tid - 256];
    __syncthreads();
    {
      const int kp = tid & 255; const bool im = tid >= 256;
      float s = 0;
      for (int c = 0; c < 256; ++c) { const int m = (c * kp) & 255; s += wrow[c] * (im ? -snt[m] : cst[m]); }
      if (im) dim_[kp] = s; else dre[kp] = s;
    }
    __syncthreads();
    {
      const int j = tid & 255; const bool im = tid >= 256;
      const float* Wf = p.fnet_w + (size_t)l * 65536;
      const float* d = im ? dim_ : dre;
      float s = 0;
      for (int kp = 0; kp < 256; ++kp) s += d[kp] * Wf[kp * 256 + j];
      p.bt_in()[((size_t)l * NIN + (im ? 2560 : 2304) + j) * DM + k] = f2bf(s * 0.0625f);
    }
    if (tid < 256) {
      const int dir = tid >> 7, kk = tid & 127;
      const float* gw = p.gla_gk_w + ((size_t)l * 2 + dir) * 16 * 128;
      float s = 0;
      for (int r = 0; r < 16; ++r) s += glr[dir * 16 + r] * gw[r * 128 + kk];
      p.bt_in()[((size_t)l * NIN + 1024 + tid) * DM + k] = f2bf(s);
    }
    __syncthreads();
  }
}

enum { MAP_ID = 0, MAP_IN = 1, MAP_UQ = 2, MAP_UKV = 3, MAP_GU = 4 };
__device__ __forceinline__ int colmap(int mt, int n) {
  switch (mt) {
    case MAP_ID: return n;
    case MAP_IN:
      if (n < 256) return n;
      if (n < 384) return 256 + (n - 256);
      if (n < 512) return 1184 + (n - 384);
      if (n < 640) return 1312 + (n - 512);
      if (n < 672) return 384 + (n - 640);
      if (n < 768) return -1;
      if (n < 1024) return 1440 + (n - 768);
      if (n < 1280) return -2;
      if (n < 1536) return 1728 + (n - 1280);
      if (n < 2304) return 416 + (n - 1536);
      return -2;
    case MAP_UQ:
      if (n < 256) return (n >> 6) * 96 + (n & 63);
      if (n < 384) return ((n - 256) >> 5) * 96 + 64 + ((n - 256) & 31);
      return -1;
    case MAP_UKV:
      if (n < 256) return (n >> 6) * 128 + (n & 63);
      return ((n - 256) >> 6) * 128 + 64 + ((n - 256) & 63);
    default: {
      const int pn = n >> 8, w = n & 255;
      return w < 128 ? 2 * (pn * 128 + w) : 2 * (pn * 128 + w - 128) + 1;
    }
  }
}
__device__ __forceinline__ void conv_matrix(const float* __restrict__ src, int ld, int K, int N, u16* __restrict__ dst, int mt,
                            const float* __restrict__ scale, int bid, int nb, char* lds) {
  float* tile = (float*)lds;
  const int tid = ltid(), nkt = K >> 6, ntile = (N >> 6) * nkt;
  for (int t = bid; t < ntile; t += nb) {
    const int n0 = (t / nkt) << 6, k0 = (t % nkt) << 6;
    const int nn = tid & 63, sc = colmap(mt, n0 + nn);
#pragma unroll
    for (int i = 0; i < 8; ++i) {
      const int kk = (tid >> 6) + 8 * i;
      float v = 0.f;
      if (sc >= 0) { v = src[(size_t)(k0 + kk) * ld + sc]; if (scale) v *= scale[k0 + kk]; }
      tile[kk * 65 + nn] = v;
    }
    __syncthreads();
    {
      const int n2 = tid >> 3, ks = (tid & 7) * 8;
      const int sc2 = colmap(mt, n0 + n2);
      if (sc2 != -2) {
        u32x4 w;
        w[0] = cvtpk(tile[(ks + 0) * 65 + n2], tile[(ks + 1) * 65 + n2]);
        w[1] = cvtpk(tile[(ks + 2) * 65 + n2], tile[(ks + 3) * 65 + n2]);
        w[2] = cvtpk(tile[(ks + 4) * 65 + n2], tile[(ks + 5) * 65 + n2]);
        w[3] = cvtpk(tile[(ks + 6) * 65 + n2], tile[(ks + 7) * 65 + n2]);
        *(u32x4*)(dst + (size_t)(n0 + n2) * K + k0 + ks) = w;
      }
    }
    __syncthreads();
  }
}
__device__ __forceinline__ void phase_convert(const Params& p, int bid, int nb, char* lds) {
  for (int l = 0; l < 2; ++l) {
    conv_matrix(p.w_in + (size_t)l * DM * DIN0, DIN0, DM, NIN, p.bt_in() + (size_t)l * NIN * DM, MAP_IN, nullptr, bid, nb, lds);
    {
      const float* wq = p.mla_w_uq + (size_t)l * 256 * 384; const float* wkv = p.mla_w_ukv + (size_t)l * 128 * 512;
      const float* gq = p.mla_q_g + l * 256; const float* gkv = p.mla_kv_g + l * 128;
      u16* dst = p.bt_qkv() + (size_t)l * 1024 * 384;
      for (int i = bid * NTHR + ltid(); i < 1024 * 384; i += nb * NTHR) {
        const int n = i / 384, k = i % 384; float v = 0.f;
        if (n < 512) { const int sc = colmap(MAP_UQ, n); if (k < 256 && sc >= 0) v = gq[k] * wq[k * 384 + sc]; }
        else { if (k >= 256) v = gkv[k - 256] * wkv[(k - 256) * 512 + colmap(MAP_UKV, n - 512)]; }
        dst[i] = f2bf(v);
      }
    }
    conv_matrix(p.w_out + (size_t)l * DM * DM, DM, DM, DM, p.bt_out() + (size_t)l * DM * DM, MAP_ID, p.mix_g + l * DM, bid, nb, lds);
    for (int e = 0; e < NE; ++e) {
      conv_matrix(p.moe_w_gu + ((size_t)l * NE + e) * DM * 2048, 2048, DM, 2048, p.bt_gu() + ((size_t)l * NE + e) * 2048 * DM, MAP_GU, nullptr, bid, nb, lds);
      conv_matrix(p.moe_w_down + ((size_t)l * NE + e) * DFF * DM, DM, DFF, DM, p.bt_dn() + ((size_t)l * NE + e) * DM * DFF, MAP_ID, nullptr, bid, nb, lds);
    }
  }
}

__device__ __forceinline__ void phase_hy_mlp(const Params& p, int l, int Lf, float* __restrict__ hout  , float* __restrict__ ssq  ,
                             int bid, int nb, char* lds) {
  float* zf = (float*)lds;
  float* h1 = zf + 64 * 33;
  float* h2 = h1 + 64 * 64;
  const int tid = ltid();
  const float* w1 = p.hy_w1 + (size_t)l * 33 * 64; const float* b1 = p.hy_b1 + l * 64;
  const float* w2 = p.hy_w2 + (size_t)l * 64 * 64; const float* b2 = p.hy_b2 + l * 64;
  const float* w3 = p.hy_w3 + (size_t)l * 64 * 512; const float* fr = p.hy_freq + l * 64;
  float w3c[64];
#pragma unroll
  for (int k = 0; k < 64; ++k) w3c[k] = w3[k * 512 + tid];
  const int dir = tid >> 8, ch = tid & 255;
  const float maxd = logf(1e-2f) / 0.3f, mind = logf(1e-2f) / 1.5f;
  const float delta = fabsf(mind + (maxd - mind) * (float)ch / 255.f);
  float ssq_acc = 0.f;
  for (int it = bid; it < Lf / 64; it += nb) {
    const int t0 = it * 64;
    for (int i = tid; i < 64 * 33; i += NTHR) {
      const int tt = i / 33, f = i % 33, t = t0 + tt;
      float v;
      if (f == 0) v = (float)t / (float)(Lf - 1);
      else {
        const int j = (f - 1) & 15;
        const float fj = 1e-4f + (float)j * ((15.f - 1e-4f) / 15.f);
        const float w = 6.283185307179586f * (float)t / (float)Lf;
        v = (f <= 16) ? cosf(fj * w) : -sinf(fj * w);
      }
      zf[i] = v;
    }
    __syncthreads();
    for (int i = tid; i < 64 * 64; i += NTHR) {
      const int tt = i >> 6, o = i & 63; float s = b1[o];
      for (int f = 0; f < 33; ++f) s += zf[tt * 33 + f] * w1[f * 64 + o];
      h1[i] = sinf(fr[o] * s);
    }
    __syncthreads();
    for (int i = tid; i < 64 * 64; i += NTHR) {
      const int tt = i >> 6, o = i & 63; float s = b2[o];
      for (int f = 0; f < 64; ++f) s += h1[tt * 64 + f] * w2[f * 64 + o];
      h2[i] = sinf(fr[o] * s);
    }
    __syncthreads();
    float* orow = hout + ((size_t)dir * 256 + ch) * Lf + t0;
    for (int tt = 0; tt < 64; ++tt) {
      float s = 0;
#pragma unroll
      for (int k = 0; k < 64; ++k) s += h2[tt * 64 + k] * w3c[k];
      const int t = t0 + tt;
      s *= __expf(-((float)t / (float)(Lf - 1)) * delta);
      orow[tt] = s;
      if (dir == 0 || t > 0) ssq_acc += s * s;
    }
    __syncthreads();
  }
  atomicAdd(&ssq[ch], ssq_acc);
}

__device__ __forceinline__ int rev7(int k) {
  unsigned r = __brev((unsigned)k) >> 18;
  return (int)(((r & 0x2AAAu) >> 1) | ((r & 0x1555u) << 1));
}
__device__ __forceinline__ void fft_fwd(float2* s, const float2* __restrict__ tw) {
  const int tid = ltid();
#pragma unroll 1
  for (int st = 0; st < 7; ++st) {
    const int sh = 12 - 2 * st, q = 1 << sh;
#pragma unroll 4
    for (int u = tid; u < 4096; u += NTHR) {
      const int g = u >> sh, j = u & (q - 1), base = (g << (sh + 2)) + j;
      const float2 a0 = s[base], a1 = s[base + q], a2 = s[base + 2 * q], a3 = s[base + 3 * q];
      const int ti = j << (2 * st);
      const float2 w1 = tw[ti], w2 = tw[2 * ti], w3 = tw[3 * ti];
      const float2 b0 = make_float2(a0.x + a2.x, a0.y + a2.y), b1 = make_float2(a0.x - a2.x, a0.y - a2.y);
      const float2 b2 = make_float2(a1.x + a3.x, a1.y + a3.y), b3 = make_float2(a1.x - a3.x, a1.y - a3.y);
      s[base] = make_float2(b0.x + b2.x, b0.y + b2.y);
      s[base + q] = cmul(make_float2(b1.x + b3.y, b1.y - b3.x), w1);
      s[base + 2 * q] = cmul(make_float2(b0.x - b2.x, b0.y - b2.y), w2);
      s[base + 3 * q] = cmul(make_float2(b1.x - b3.y, b1.y + b3.x), w3);
    }
    __syncthreads();
  }
}
__device__ __forceinline__ void fft_inv(float2* s, const float2* __restrict__ tw) {
  const int tid = ltid();
#pragma unroll 1
  for (int st = 6; st >= 0; --st) {
    const int sh = 12 - 2 * st, q = 1 << sh;
#pragma unroll 4
    for (int u = tid; u < 4096; u += NTHR) {
      const int g = u >> sh, j = u & (q - 1), base = (g << (sh + 2)) + j;
      const int ti = j << (2 * st);
      const float2 t0 = s[base], t1 = cmulc(s[base + q], tw[ti]), t2 = cmulc(s[base + 2 * q], tw[2 * ti]), t3 = cmulc(s[base + 3 * q], tw[3 * ti]);
      const float2 b0 = make_float2(t0.x + t2.x, t0.y + t2.y), b1 = make_float2(t0.x - t2.x, t0.y - t2.y);
      const float2 b2 = make_float2(t1.x + t3.x, t1.y + t3.y), b3 = make_float2(t1.x - t3.x, t1.y - t3.y);
      s[base] = make_float2(b0.x + b2.x, b0.y + b2.y);
      s[base + q] = make_float2(b1.x - b3.y, b1.y + b3.x);
      s[base + 2 * q] = make_float2(b0.x - b2.x, b0.y - b2.y);
      s[base + 3 * q] = make_float2(b1.x + b3.y, b1.y - b3.x);
    }
    __syncthreads();
  }
}

__device__ __forceinline__ void phase_hy_filtfft(const Params& p, int bid, int nb, char* lds) {
  float2* s = (float2*)lds;
  const int tid = ltid();
  for (int it = bid; it < 512; it += nb) {
    const int l = it >> 8, ch = it & 255;
    const float* hf = p.hfb() + (((size_t)l * 2 + 0) * 256 + ch) * SEQ;
    const float* hb = p.hfb() + (((size_t)l * 2 + 1) * 256 + ch) * SEQ;
    for (int m = tid; m < FM; m += NTHR) {
      const int n0 = 2 * m, n1 = 2 * m + 1;
      const float a = (n0 < SEQ) ? hf[n0] : (n0 == SEQ ? 0.f : hb[2 * SEQ - n0]);
      const float b = (n1 < SEQ) ? hf[n1] : hb[2 * SEQ - n1];
      s[m] = make_float2(a, b);
    }
    __syncthreads();
    fft_fwd(s, p.tw());
    const float sc = rsqrtf(p.hssq()[l * 256 + ch]) * (1.f / 16384.f);
    float4* out = p.hspec() + ((size_t)l * 256 + ch) * HSP;
    for (int k = tid; k <= FM / 2; k += NTHR) {
      const float2 zk = s[rev7(k)], zm = s[rev7((FM - k) & (FM - 1))];
      const float er = 0.5f * (zk.x + zm.x), ei = 0.5f * (zk.y - zm.y);
      const float dr = 0.5f * (zk.x - zm.x), di = 0.5f * (zk.y + zm.y);
      out[k] = make_float4(er * sc, ei * sc, di * sc, -dr * sc);
    }
    __syncthreads();
  }
}
constexpr int G_TILE_B = 256 * 64 * 2;
constexpr int G_STAGE_B = 2 * G_TILE_B;
constexpr int GEMM_LDS = 2 * G_STAGE_B;

__device__ __forceinline__ int lds_byte2(int r, int c) {
  const int st = (r >> 4) * 2 + (c >> 5), ob = (r & 15) * 64 + (c & 31) * 2;
  return st * 1024 + (ob ^ (((ob >> 9) & 1) << 5));
}
__device__ __forceinline__ void stage_rc2(int b, int& R, int& C) {
  const int st = b >> 10, sb = b & 1023, swz = sb ^ (((sb >> 9) & 1) << 5);
  R = (st >> 1) * 16 + (swz >> 6);
  C = (st & 1) * 32 + ((swz & 63) >> 1);
}
__device__ __forceinline__ void gemm_stage_coords(int (&sR)[4], int (&sC)[4]) {
  const int wid = ltid() >> 6, lane = ltid() & 63;
#pragma unroll
  for (int i = 0; i < 4; ++i) stage_rc2(wid * 1024 + i * 8192 + lane * 16, sR[i], sC[i]);
}

#define WAIT_V0() asm volatile("s_waitcnt vmcnt(0)" ::: "memory")

__device__ __forceinline__ void gemm256_core(const u16* const (&ap)[4], const u16* const (&bp)[4], int nt, char* shm, f32x4 (&acc)[8][4]) {
  const int tid = ltid(), wid = tid >> 6, lane = tid & 63, wr = wid >> 2, wc = wid & 3, fr = lane & 15, fq = lane >> 4;
#pragma unroll
  for (int m = 0; m < 8; ++m)
#pragma unroll
    for (int n = 0; n < 4; ++n) acc[m][n] = f32x4{0.f, 0.f, 0.f, 0.f};
#define G_SA(b) (shm + (b) * G_STAGE_B)
#define G_SB(b) (shm + (b) * G_STAGE_B + G_TILE_B)
#define G_STAGE(buf, kt) do { _Pragma("unroll") for (int i = 0; i < 4; ++i) {                                                   \
    __builtin_amdgcn_global_load_lds((const unsigned*)(ap[i] + (kt) * 64), (unsigned*)(G_SA(buf) + wid * 1024 + i * 8192), 16, 0, 0); \
    __builtin_amdgcn_global_load_lds((const unsigned*)(bp[i] + (kt) * 64), (unsigned*)(G_SB(buf) + wid * 1024 + i * 8192), 16, 0, 0); } } while (0)
  G_STAGE(0, 0); WAIT_V0(); __syncthreads();
#pragma unroll 1
  for (int t = 0; t < nt; ++t) {
    const int cur = t & 1;
    if (t + 1 < nt) G_STAGE(cur ^ 1, t + 1);
#pragma unroll
    for (int ks = 0; ks < 2; ++ks) {
      bf16x8 At[8], Bf[4];
#pragma unroll
      for (int m = 0; m < 8; ++m) At[m] = *(const bf16x8*)(G_SA(cur) + lds_byte2(wr * 128 + m * 16 + fr, ks * 32 + fq * 8));
#pragma unroll
      for (int n = 0; n < 4; ++n) Bf[n] = *(const bf16x8*)(G_SB(cur) + lds_byte2(wc * 64 + n * 16 + fr, ks * 32 + fq * 8));
#pragma unroll
      for (int m = 0; m < 8; ++m)
#pragma unroll
        for (int n = 0; n < 4; ++n) acc[m][n] = __builtin_amdgcn_mfma_f32_16x16x32_bf16(At[m], Bf[n], acc[m][n], 0, 0, 0);
      __builtin_amdgcn_sched_barrier(0);
    }
    WAIT_V0(); __syncthreads();
  }
#undef G_STAGE
}

#define LAS3 __attribute__((address_space(3)))
constexpr int G8_HTB = 128 * 64 * 2;
__device__ __forceinline__ int g8_perm32(int rho) { const int n = rho >> 4, i = rho & 15; return 8 * (i >> 2) + 4 * n + (i & 3); }
__device__ __forceinline__ int g8_lds_byte(int r, int c) { const int st = (r >> 4) * 2 + (c >> 5), rr = r & 15, cc = c & 31, ob = rr * 64 + cc * 2; return st * 1024 + (ob ^ (((ob >> 9) & 1) << 5)); }
__device__ __forceinline__ void g8_stage_rc(int b, int& R, int& C) { const int st = b / 1024, sb = b % 1024, swz = sb ^ (((sb >> 9) & 1) << 5); R = (st >> 1) * 16 + swz / 64; C = (st & 1) * 32 + (swz % 64) / 2; }
struct G8Unit { int pm, pn, e, ce, pre; };

template <class Sched, class Epi>
__device__ __forceinline__ void gemm8_phase(char* lds_g, const char* Abase, const int K, const Sched& S, const Epi& E) {
    LAS3 unsigned char* lds = (LAS3 unsigned char*)lds_g;
    const int tid = ltid(), wid = __builtin_amdgcn_readfirstlane(tid >> 6), lane = tid & 63, wr = wid >> 2, wc = wid & 3, fr = lane & 15, fq = lane >> 4;
    const int nt = K / 64;
    int sRr[2], sCc[2]; unsigned voffB[2];
#pragma unroll
    for (int i = 0; i < 2; ++i) { g8_stage_rc(tid * 16 + i * 8192, sRr[i], sCc[i]); const int Rb = (sRr[i] & ~31) + g8_perm32(sRr[i] & 31); voffB[i] = (unsigned)(Rb * K + sCc[i]) * 2u; }
    const size_t kstep = 128;
    const size_t hstepB = (size_t)128 * K * 2;
    const unsigned ldsw = (unsigned)wid * 1024u;
    const int aoff = g8_lds_byte(wr * 64 + fr, fq * 8), boff = g8_lds_byte(wc * 32 + fr, fq * 8);
#define G8_SA(b, h) (((b) * 2 + (h)) * G8_HTB)
#define G8_SB(b, h) ((4 + (b) * 2 + (h)) * G8_HTB)
#define G8_STAGE_B(bufoff, gbase) do { _Pragma("unroll") for (int _i = 0; _i < 2; ++_i) \
        __builtin_amdgcn_global_load_lds((const unsigned*)((const char*)(gbase) + voffB[_i]), (LAS3 unsigned*)(lds + (bufoff) + ldsw + _i * 8192), 16, 0, 0); } while (0)
#define G8_STAGE_A(bufoff, o0, o1) do { \
        __builtin_amdgcn_global_load_lds((const unsigned*)(Abase + (o0)), (LAS3 unsigned*)(lds + (bufoff) + ldsw), 16, 0, 0); \
        __builtin_amdgcn_global_load_lds((const unsigned*)(Abase + (o1)), (LAS3 unsigned*)(lds + (bufoff) + ldsw + 8192), 16, 0, 0); } while (0)
#define G8_LDA(dst, b, h) do { _Pragma("unroll") for (int m = 0; m < 4; ++m) _Pragma("unroll") for (int k = 0; k < 2; ++k) dst[m][k] = *(const LAS3 bf16x8*)(lds + G8_SA(b, h) + aoff + m * 2048 + k * 1024); } while (0)
#define G8_LDB(dst, b, h) do { _Pragma("unroll") for (int n = 0; n < 2; ++n) _Pragma("unroll") for (int k = 0; k < 2; ++k) dst[n][k] = *(const LAS3 bf16x8*)(lds + G8_SB(b, h) + boff + n * 2048 + k * 1024); } while (0)
#define G8_MMA(ai, bj, At, Bt) do { __builtin_amdgcn_s_setprio(1); _Pragma("unroll") for (int m = 0; m < 4; ++m) _Pragma("unroll") for (int n = 0; n < 2; ++n) _Pragma("unroll") for (int k = 0; k < 2; ++k) \
        acc[ai][bj][m][n] = __builtin_amdgcn_mfma_f32_16x16x32_bf16(Bt[n][k], At[m][k], acc[ai][bj][m][n], 0, 0, 0); __builtin_amdgcn_s_setprio(0); } while (0)
#define G8_WAIT_V(n) asm volatile("s_waitcnt vmcnt(" #n ")" ::: "memory")
#define G8_WAIT_L(n) asm volatile("s_waitcnt lgkmcnt(" #n ")" ::: "memory")
#define G8_BAR __builtin_amdgcn_s_barrier()
#define G8_SCHED __builtin_amdgcn_sched_barrier(0)
    G8Unit cur, nxt; int ui = 0;
    if (!S.next(0, cur)) return;
    f32x4 acc[2][2][4][2];
#pragma unroll
    for (int a = 0; a < 2; ++a)
#pragma unroll
        for (int b = 0; b < 2; ++b)
#pragma unroll
            for (int m = 0; m < 4; ++m)
#pragma unroll
                for (int n = 0; n < 2; ++n) acc[a][b][m][n] = (f32x4){0.f, 0.f, 0.f, 0.f};
    bf16x8 At[4][2], B0[2][2], B1[2][2];
    unsigned va[2][2], vn[2][2];
#pragma unroll
    for (int h = 0; h < 2; ++h)
#pragma unroll
        for (int i = 0; i < 2; ++i) va[h][i] = S.a_off(cur, h * 128 + sRr[i]) + (unsigned)sCc[i] * 2u;
    const char* cB = S.b_ptr(cur);
    G8_STAGE_B(G8_SB(0, 0), cB); G8_STAGE_A(G8_SA(0, 0), va[0][0], va[0][1]); G8_STAGE_B(G8_SB(0, 1), cB + hstepB); G8_STAGE_A(G8_SA(0, 1), va[1][0], va[1][1]);
    if (wr == 1) G8_BAR;
    G8_WAIT_V(4); G8_BAR;
    G8_STAGE_B(G8_SB(1, 0), cB + kstep); G8_STAGE_A(G8_SA(1, 0), va[0][0] + kstep, va[0][1] + kstep); G8_STAGE_B(G8_SB(1, 1), cB + hstepB + kstep);
    G8_WAIT_V(6); G8_BAR;
    for (;;) {
        const bool has_next = S.next(ui + 1, nxt);
        const char* nB = cB;
#pragma unroll
        for (int h = 0; h < 2; ++h)
#pragma unroll
            for (int i = 0; i < 2; ++i) vn[h][i] = va[h][i];
        if (has_next) {
            nB = S.b_ptr(nxt);
#pragma unroll
            for (int h = 0; h < 2; ++h)
#pragma unroll
                for (int i = 0; i < 2; ++i) vn[h][i] = S.a_off(nxt, h * 128 + sRr[i]) + (unsigned)sCc[i] * 2u;
        }
#pragma unroll 1
        for (int t = 0; t < nt; t += 2) {
            const bool last = (t == nt - 2);
            const unsigned k1 = (unsigned)(t + 1) * 128u;
            const unsigned k2 = last ? 0u : (unsigned)(t + 2) * 128u;
            const unsigned a2_00 = (last ? vn[0][0] : va[0][0]) + k2, a2_01 = (last ? vn[0][1] : va[0][1]) + k2;
            const unsigned a2_10 = (last ? vn[1][0] : va[1][0]) + k2, a2_11 = (last ? vn[1][1] : va[1][1]) + k2;
            const char* b2 = (last ? nB : cB) + k2; const char* b3 = b2 + kstep;
            G8_LDB(B0, 0, 0); G8_SCHED; G8_LDA(At, 0, 0); G8_STAGE_A(G8_SA(1, 1), va[1][0] + k1, va[1][1] + k1);
            G8_WAIT_L(8); G8_BAR; G8_WAIT_L(0); G8_MMA(0, 0, At, B0); G8_BAR; G8_SCHED;
            G8_LDB(B1, 0, 1); G8_STAGE_B(G8_SB(0, 0), b2);
            G8_BAR; G8_WAIT_L(0); G8_MMA(0, 1, At, B1); G8_BAR;
            G8_LDA(At, 0, 1); G8_STAGE_A(G8_SA(0, 0), a2_00, a2_01);
            G8_BAR; G8_WAIT_L(0); G8_MMA(1, 0, At, B0); G8_BAR; G8_SCHED;
            G8_STAGE_B(G8_SB(0, 1), b2 + hstepB);
            G8_WAIT_V(6); G8_BAR; G8_MMA(1, 1, At, B1); G8_BAR;
            G8_LDB(B0, 1, 0); G8_SCHED; G8_LDA(At, 1, 0); G8_STAGE_A(G8_SA(0, 1), a2_10, a2_11);
            G8_WAIT_L(8); G8_BAR; G8_WAIT_L(0); G8_MMA(0, 0, At, B0); G8_BAR; G8_SCHED;
            G8_LDB(B1, 1, 1); G8_STAGE_B(G8_SB(1, 0), b3);
            G8_BAR; G8_WAIT_L(0); G8_MMA(0, 1, At, B1); G8_BAR;
            G8_LDA(At, 1, 1); G8_STAGE_A(G8_SA(1, 0), a2_00 + 128u, a2_01 + 128u);
            G8_BAR; G8_WAIT_L(0); G8_MMA(1, 0, At, B0); G8_BAR; G8_SCHED;
            G8_STAGE_B(G8_SB(1, 1), b3 + hstepB);
            G8_WAIT_V(6); G8_BAR; G8_MMA(1, 1, At, B1); G8_BAR;
        }
        E(acc, cur, wr, wc, fr, fq);
        if (!has_next) break;
#pragma unroll
        for (int a = 0; a < 2; ++a)
#pragma unroll
            for (int b = 0; b < 2; ++b)
#pragma unroll
                for (int m = 0; m < 4; ++m)
#pragma unroll
                    for (int n = 0; n < 2; ++n) acc[a][b][m][n] = (f32x4){0.f, 0.f, 0.f, 0.f};
        cur = nxt; cB = nB; ++ui;
#pragma unroll
        for (int h = 0; h < 2; ++h)
#pragma unroll
            for (int i = 0; i < 2; ++i) va[h][i] = vn[h][i];
    }
    G8_WAIT_V(0);
    if (wr == 0) G8_BAR;
    G8_BAR;
#undef G8_SA
#undef G8_SB
#undef G8_STAGE_A
#undef G8_STAGE_B
#undef G8_LDA
#undef G8_LDB
#undef G8_MMA
#undef G8_WAIT_V
#undef G8_WAIT_L
#undef G8_BAR
#undef G8_SCHED
}
struct G8Plain {
    int nM, nN, K, G, c; const char* Bt;
    __device__ __forceinline__ bool next(int i, G8Unit& u) const {
        const int L = (i * 8 + (c & 7)) * (G >> 3) + (c >> 3); if (L >= nM * nN) return false;
        const int nig = 8 * nN, gid = L / nig, fm = gid * 8, gsz = (nM - fm) < 8 ? (nM - fm) : 8;
        u.pm = fm + ((L % nig) % gsz); u.pn = (L % nig) / gsz; u.e = 0; u.ce = 256; u.pre = 0; return true;
    }
    __device__ __forceinline__ unsigned a_off(const G8Unit& u, int row) const { return (unsigned)((u.pm * 256 + row) * K) * 2u; }
    __device__ __forceinline__ const char* b_ptr(const G8Unit& u) const { return Bt + (size_t)u.pn * 256 * K * 2; }
};

__device__ __forceinline__ const float* resid_row(const Params& p, int layer_src, int tok) {
  if (layer_src == 0) return tok < TL ? p.x + (size_t)tok * DM : p.ctx + (size_t)(tok - TL) * DM;
  return p.X() + (size_t)tok * DM;
}
__device__ __forceinline__ void load_row_comb(const Params& p, int src_layer, int lc, int tok, int lane, const int* pre  , float (&v)[16]) {
  const float* r = resid_row(p, src_layer, tok);
#pragma unroll
  for (int i = 0; i < 4; ++i) { const float4 a = *(const float4*)(r + lane * 4 + i * 256); v[4 * i] = a.x; v[4 * i + 1] = a.y; v[4 * i + 2] = a.z; v[4 * i + 3] = a.w; }
  if (lc >= 0) {
    const float* g2 = p.mod() + ((size_t)lc * 3 + modv(tok)) * 6144 + 5 * DM;
    float s[16];
#pragma unroll
    for (int i = 0; i < 16; ++i) s[i] = 0.f;
#pragma unroll
    for (int k = 0; k < TOPK; ++k) {
      const int sl = p.tslot()[tok * 4 + k];
      const size_t arow = (size_t)(pre[sl >> 20] + (sl & 0xFFFFF));
      const u16* y = p.yd() + arow * DM;
#pragma unroll
      for (int i = 0; i < 4; ++i) {
        const u32x2 w = *(const u32x2*)(y + lane * 4 + i * 256);
        s[4 * i] += __uint_as_float(w[0] << 16); s[4 * i + 1] += __uint_as_float(w[0] & 0xFFFF0000u);
        s[4 * i + 2] += __uint_as_float(w[1] << 16); s[4 * i + 3] += __uint_as_float(w[1] & 0xFFFF0000u);
      }
    }
#pragma unroll
    for (int i = 0; i < 4; ++i) {
      const float4 g = *(const float4*)(g2 + lane * 4 + i * 256);
      v[4 * i] += g.x * s[4 * i]; v[4 * i + 1] += g.y * s[4 * i + 1]; v[4 * i + 2] += g.z * s[4 * i + 2]; v[4 * i + 3] += g.w * s[4 * i + 3];
    }
  }
}
__device__ __forceinline__ void expert_prefix(const int* cnt, int* pre) {
  if (ltid() == 0) { int s = 0; for (int e = 0; e < NE; ++e) { pre[e] = s; s += cnt[e]; } pre[NE] = s; }
}

__device__ __forceinline__ void phase_norm1(const Params& p, int layer, int bid, int nb, char* lds) {
  int* pre = (int*)lds;
  const int lc = layer - 1;
  if (lc >= 0) { expert_prefix(p.cnt() + lc * NE, pre); __syncthreads(); }
  const int wid = ltid() >> 6, lane = ltid() & 63;
  const float* gn = p.norm1_g + layer * DM;
  const int ntok = TT;
  for (int tok = bid * 8 + wid; tok < ntok; tok += nb * 8) {
    float v[16];
    load_row_comb(p, layer == 0 ? 0 : 1, lc, tok, lane, pre, v);
    if (lc >= 0) {
      float* xr = p.X() + (size_t)tok * DM;
#pragma unroll
      for (int i = 0; i < 4; ++i) *(float4*)(xr + lane * 4 + i * 256) = make_float4(v[4 * i], v[4 * i + 1], v[4 * i + 2], v[4 * i + 3]);
    }
    float ss = 0;
#pragma unroll
    for (int i = 0; i < 16; ++i) ss += v[i] * v[i];
    ss = wave_sum(ss);
    const float rs = rsqrtf(ss * (1.f / DM) + EPS);
    const float* md = p.mod() + ((size_t)layer * 3 + modv(tok)) * 6144;
    u16* h = p.H() + (size_t)tok * DM;
#pragma unroll
    for (int i = 0; i < 4; ++i) {
      const int c = lane * 4 + i * 256;
      const float4 g = *(const float4*)(gn + c), sh = *(const float4*)(md + c), sc = *(const float4*)(md + DM + c);
      const float y0 = v[4 * i] * rs * g.x * (1.f + sc.x) + sh.x, y1 = v[4 * i + 1] * rs * g.y * (1.f + sc.y) + sh.y;
      const float y2 = v[4 * i + 2] * rs * g.z * (1.f + sc.z) + sh.z, y3 = v[4 * i + 3] * rs * g.w * (1.f + sc.w) + sh.w;
      u32x2 w; w[0] = cvtpk(y0, y1); w[1] = cvtpk(y2, y3);
      *(u32x2*)(h + c) = w;
    }
  }
}

struct EpiIn {
  u16* zqkv; float* zg; float* zt;
  __device__ __forceinline__ void operator()(const f32x4 (&acc)[2][2][4][2], const G8Unit& u, int wr, int wc, int fr, int fq) const {
#pragma unroll
    for (int bj = 0; bj < 2; ++bj) {
      const int c32 = u.pn * 256 + bj * 128 + wc * 32, c0 = c32 + 8 * fq;
      if (c32 < 384) {
#pragma unroll
        for (int ai = 0; ai < 2; ++ai)
#pragma unroll
          for (int m = 0; m < 4; ++m) {
            const int row = u.pm * 256 + ai * 128 + wr * 64 + m * 16 + fr;
            const f32x4 a = acc[ai][bj][m][0], b = acc[ai][bj][m][1];
            *(u32x4*)(zqkv + (size_t)row * 384 + c0) = u32x4{cvtpk(a[0], a[1]), cvtpk(a[2], a[3]), cvtpk(b[0], b[1]), cvtpk(b[2], b[3])};
          }
      } else if (c32 < 1536) {
#pragma unroll
        for (int ai = 0; ai < 2; ++ai)
#pragma unroll
          for (int m = 0; m < 4; ++m) {
            const int row = u.pm * 256 + ai * 128 + wr * 64 + m * 16 + fr;
            float* d = zg + (size_t)row * ZG_W + (c0 - 384);
            *(f32x4*)d = acc[ai][bj][m][0]; *(f32x4*)(d + 4) = acc[ai][bj][m][1];
          }
      } else {
#pragma unroll
        for (int ai = 0; ai < 2; ++ai)
#pragma unroll
          for (int m = 0; m < 4; ++m) {
            const int row = u.pm * 256 + ai * 128 + wr * 64 + m * 16 + fr;
#pragma unroll
            for (int n = 0; n < 2; ++n)
#pragma unroll
              for (int j = 0; j < 4; ++j) zt[(size_t)(c0 - 1536 + 4 * n + j) * TT + row] = acc[ai][bj][m][n][j];
          }
      }
    }
  }
};
__device__ __forceinline__ void phase_gemm_in(const Params& p, int layer, int bid, int nb, char* lds) {
  G8Plain S; S.nM = TT / 256; S.nN = NIN / 256; S.K = DM; S.G = nb; S.c = bid; S.Bt = (const char*)(p.bt_in() + (size_t)layer * NIN * DM);
  EpiIn E; E.zqkv = p.zqkv(); E.zg = p.zg(); E.zt = p.zt();
  gemm8_phase(lds, (const char*)p.H(), DM, S, E);
}

__device__ __forceinline__ size_t qkv_row(int tok, int h) {
  const int b = tok < TL ? (tok >> 14) : ((tok - TL) >> 8);
  const int s = tok < TL ? (tok & (SEQ - 1)) : SEQ + ((tok - TL) & (LC - 1));
  return ((size_t)(b * 4 + h)) * SKV + s;
}
struct EpiQkv {
  const u16* zqkv; u16* Q; u16* KV; const float* ropec; const float* ropes; float* rsl;
  __device__ __forceinline__ void operator()(const f32x4 (&acc)[2][2][4][2], const G8Unit& u, int wr, int wc, int fr, int fq) const {
    const int tid = ltid();
    {
      const int r = tid >> 1, half = tid & 1;
      const u16* row = zqkv + (size_t)(u.pm * 256 + r) * 384;
      float sq = 0, sk = 0;
#pragma unroll
      for (int i = 0; i < 16; ++i) {
        const u32x4 w = *(const u32x4*)(row + half * 128 + i * 8);
#pragma unroll
        for (int q = 0; q < 4; ++q) { const float a = __uint_as_float(w[q] << 16), b = __uint_as_float(w[q] & 0xFFFF0000u); sq += a * a + b * b; }
      }
#pragma unroll
      for (int i = 0; i < 8; ++i) {
        const u32x4 w = *(const u32x4*)(row + 256 + half * 64 + i * 8);
#pragma unroll
        for (int q = 0; q < 4; ++q) { const float a = __uint_as_float(w[q] << 16), b = __uint_as_float(w[q] & 0xFFFF0000u); sk += a * a + b * b; }
      }
      sq += __shfl_xor(sq, 1, 64); sk += __shfl_xor(sk, 1, 64);
      if (half == 0) { rsl[r] = rsqrtf(sq * (1.f / 256.f) + EPS); rsl[256 + r] = rsqrtf(sk * (1.f / 128.f) + EPS); }
    }
    asm volatile("s_waitcnt lgkmcnt(0)" ::: "memory"); __builtin_amdgcn_s_barrier(); __builtin_amdgcn_s_barrier(); asm volatile("" ::: "memory");
    const float* rsp = rsl + (u.pn >= 2 ? 256 : 0);
#pragma unroll
    for (int ai = 0; ai < 2; ++ai)
#pragma unroll
      for (int m = 0; m < 4; ++m) {
        const int rl = ai * 128 + wr * 64 + m * 16 + fr, tok = u.pm * 256 + rl;
        const float rs = rsp[rl];
        if (u.pn == 1) {
          f32x4 a = acc[ai][0][m][0] * rs, b = acc[ai][0][m][1] * rs;
          f32x4 pa, pb;
#pragma unroll
          for (int j = 0; j < 4; ++j) { pa[j] = __shfl_xor(a[j], 32, 64); pb[j] = __shfl_xor(b[j], 32, 64); }
          f32x4 ca = {1.f, 1.f, 1.f, 1.f}, cb = ca, sa = {0.f, 0.f, 0.f, 0.f}, sb = sa;
          if (tok < TL) {
            const float* cp = ropec + (size_t)(tok & (SEQ - 1)) * 16 + 8 * (fq & 1); const float* sp = ropes + (size_t)(tok & (SEQ - 1)) * 16 + 8 * (fq & 1);
            ca = *(const f32x4*)cp; cb = *(const f32x4*)(cp + 4); sa = *(const f32x4*)sp; sb = *(const f32x4*)(sp + 4);
          }
          const float sg = fq < 2 ? -1.f : 1.f;
          a = a * ca + pa * sa * sg; b = b * cb + pb * sb * sg;
          *(u32x4*)(Q + qkv_row(tok, wc) * 96 + 64 + 8 * fq) = u32x4{cvtpk(a[0], a[1]), cvtpk(a[2], a[3]), cvtpk(b[0], b[1]), cvtpk(b[2], b[3])};
        } else {
#pragma unroll
          for (int bj = 0; bj < 2; ++bj) {
            const int c = bj * 128 + wc * 32 + 8 * fq, h = c >> 6, d = c & 63;
            const f32x4 a = acc[ai][bj][m][0] * rs, b = acc[ai][bj][m][1] * rs;
            u16* dst = u.pn == 0 ? Q + qkv_row(tok, h) * 96 + d : KV + qkv_row(tok, h) * 160 + (u.pn == 2 ? 0 : 96) + d;
            *(u32x4*)dst = u32x4{cvtpk(a[0], a[1]), cvtpk(a[2], a[3]), cvtpk(b[0], b[1]), cvtpk(b[2], b[3])};
          }
        }
      }
  }
};
__device__ __forceinline__ void phase_qkv(const Params& p, int layer, int bid, int nb, char* lds) {
  const int tid = ltid();
  {
    G8Plain S; S.nM = TT / 256; S.nN = 4; S.K = 384; S.G = nb; S.c = bid; S.Bt = (const char*)(p.bt_qkv() + (size_t)layer * 1024 * 384);
    EpiQkv E; E.zqkv = p.zqkv(); E.Q = p.Q(); E.KV = p.KV(); E.ropec = p.ropec(); E.ropes = p.ropes(); E.rsl = (float*)(lds + 131072);
    gemm8_phase(lds, (const char*)p.zqkv(), 384, S, E);
  }
  for (int i = bid * NTHR + tid; i < TT * 16; i += nb * NTHR) {
    const int tok = i >> 4, f = i & 15;
    const float x1 = p.zg()[(size_t)tok * ZG_W + ZG_KR + f], x2 = p.zg()[(size_t)tok * ZG_W + ZG_KR + 16 + f];
    float cs = 1.f, sn = 0.f;
    if (tok < TL) { const int tpos = tok & (SEQ - 1); cs = p.ropec()[tpos * 16 + f]; sn = p.ropes()[tpos * 16 + f]; }
    const u16 o1 = f2bf(x1 * cs - x2 * sn), o2 = f2bf(x2 * cs + x1 * sn);
#pragma unroll
    for (int h = 0; h < 4; ++h) { u16* kv = p.KV() + qkv_row(tok, h) * 160 + 64; kv[f] = o1; kv[16 + f] = o2; }
  }
}
constexpr int A_KROW = 208;
constexpr int A_SHM_K = 64 * A_KROW;
constexpr int A_SHM_V = 64 * 64 * 2;
constexpr int A_OFF_K = 2 * A_SHM_V;
constexpr int A_OFF_W = A_OFF_K + 2 * A_SHM_K;
constexpr int ATTN_LDS = A_OFF_W + 8 * 64 * 4;
constexpr float A_SCALE = 0.10206207261596575f;
constexpr float A_THR = 8.f;
#define SBAR() __builtin_amdgcn_sched_barrier(0)
__device__ __forceinline__ int crow(int r, int hi) { return (r & 3) + 8 * (r >> 2) + 4 * hi; }

__device__ __forceinline__ void a_partialSM(f32x16& p0, f32x16& p1, float& m_reg, float& mn, float& alpha) {
  constexpr float C = A_SCALE * 1.4426950408889634f;
  float pmax = p0[0];
#pragma unroll
  for (int r = 1; r < 16; ++r) pmax = fmaxf(pmax, p0[r]);
#pragma unroll
  for (int r = 0; r < 16; ++r) pmax = fmaxf(pmax, p1[r]);
  { auto rr = __builtin_amdgcn_permlane32_swap(__float_as_uint(pmax), __float_as_uint(pmax), false, false);
    pmax = fmaxf(__uint_as_float(rr[0]), __uint_as_float(rr[1])); }
  if (__builtin_expect(__all(pmax - m_reg <= A_THR / A_SCALE), 1)) { mn = m_reg; alpha = 1.f; }
  else { mn = fmaxf(m_reg, pmax); alpha = __builtin_amdgcn_exp2f((m_reg - mn) * C); m_reg = mn; }
  const float mnC = -mn * C;
#pragma unroll
  for (int r = 0; r < 16; ++r) p0[r] = fmaf(p0[r], C, mnC);
#pragma unroll
  for (int r = 0; r < 16; ++r) p1[r] = fmaf(p1[r], C, mnC);
#pragma unroll
  for (int r = 0; r < 16; ++r) p0[r] = __builtin_amdgcn_exp2f(p0[r]);
}
__device__ __forceinline__ void a_finishSM(f32x16& p0, f32x16& p1, float alpha, float& l_reg, bf16x8& pa0, bf16x8& pa1, bf16x8& pa2, bf16x8& pa3) {
#pragma unroll
  for (int r = 0; r < 16; ++r) p1[r] = __builtin_amdgcn_exp2f(p1[r]);
  float ps = 0;
#pragma unroll
  for (int r = 0; r < 16; ++r) ps += p0[r];
#pragma unroll
  for (int r = 0; r < 16; ++r) ps += p1[r];
  { auto rr = __builtin_amdgcn_permlane32_swap(__float_as_uint(ps), __float_as_uint(ps), false, false);
    ps = __uint_as_float(rr[0]) + __uint_as_float(rr[1]); }
  l_reg = l_reg * alpha + ps;
#define PK4(P, BASE, OUT) do { unsigned a0 = cvtpk(P[BASE + 0], P[BASE + 1]), a1 = cvtpk(P[BASE + 2], P[BASE + 3]);   \
    unsigned b0 = cvtpk(P[BASE + 4], P[BASE + 5]), b1 = cvtpk(P[BASE + 6], P[BASE + 7]);                              \
    auto r0 = __builtin_amdgcn_permlane32_swap(a0, b0, false, false); auto r1 = __builtin_amdgcn_permlane32_swap(a1, b1, false, false); \
    u32x4 w = {r0[0], r1[0], r0[1], r1[1]}; OUT = *reinterpret_cast<bf16x8*>(&w); } while (0)
  PK4(p0, 0, pa0); PK4(p0, 8, pa1); PK4(p1, 0, pa2); PK4(p1, 8, pa3);
#undef PK4
}
__device__ __forceinline__ void a_qkt(f32x16& p0, f32x16& p1, const char* Ks, const bf16x8* qr, int r32, int hi) {
  p0 = f32x16{}; p1 = f32x16{};
#pragma unroll
  for (int d0 = 0; d0 < 6; ++d0) {
    const int cb = (d0 * 16 + hi * 8) * 2;
    const bf16x8 b0 = *reinterpret_cast<const bf16x8*>(Ks + r32 * A_KROW + cb);
    const bf16x8 b1 = *reinterpret_cast<const bf16x8*>(Ks + (32 + r32) * A_KROW + cb);
    p0 = __builtin_amdgcn_mfma_f32_32x32x16_bf16(b0, qr[d0], p0, 0, 0, 0);
    p1 = __builtin_amdgcn_mfma_f32_32x32x16_bf16(b1, qr[d0], p1, 0, 0, 0);
  }
}
__device__ __forceinline__ int a_v_st(int k, int c) { const int kk = (k & ~0xC) | ((k & 4) << 1) | ((k & 8) >> 1); return ((kk >> 3) * 2 + (c >> 5)) * 512 + ((kk & 7) * 32 + (c & 31)) * 2; }
__device__ __forceinline__ int a_v_rd_base(int lane) { return ((lane & 3) << 3) | (((lane >> 2) & 3) << 6) | (((lane >> 4) & 1) << 5) | (((lane >> 5) & 1) << 8); }
constexpr int a_v_rd_off(int d0, int ks, int half) { return d0 * 512 + ks * 2048 + half * 1024; }
template <int OFF> __device__ __forceinline__ s16x4 a_tr_read(int vb) {
  s16x4 r; asm volatile("ds_read_b64_tr_b16 %0, %1 offset:%2" : "=&v"(r) : "v"(vb), "i"(OFF) : "memory"); return r;
}
template <int D0> __device__ __forceinline__ void a_pv_one(f32x16& od, int vb, bf16x8 pa0, bf16x8 pa1, bf16x8 pa2, bf16x8 pa3) {
  const s16x4 l0 = a_tr_read<a_v_rd_off(D0, 0, 0)>(vb), h0 = a_tr_read<a_v_rd_off(D0, 0, 1)>(vb), l1 = a_tr_read<a_v_rd_off(D0, 1, 0)>(vb), h1 = a_tr_read<a_v_rd_off(D0, 1, 1)>(vb);
  const s16x4 l2 = a_tr_read<a_v_rd_off(D0, 2, 0)>(vb), h2 = a_tr_read<a_v_rd_off(D0, 2, 1)>(vb), l3 = a_tr_read<a_v_rd_off(D0, 3, 0)>(vb), h3 = a_tr_read<a_v_rd_off(D0, 3, 1)>(vb);
  asm volatile("s_waitcnt lgkmcnt(0)" ::: "memory"); SBAR();
#define PK(L, H) (bf16x8){L[0], L[1], L[2], L[3], H[0], H[1], H[2], H[3]}
  od = __builtin_amdgcn_mfma_f32_32x32x16_bf16(pa0, PK(l0, h0), od, 0, 0, 0);
  od = __builtin_amdgcn_mfma_f32_32x32x16_bf16(pa1, PK(l1, h1), od, 0, 0, 0);
  od = __builtin_amdgcn_mfma_f32_32x32x16_bf16(pa2, PK(l2, h2), od, 0, 0, 0);
  od = __builtin_amdgcn_mfma_f32_32x32x16_bf16(pa3, PK(l3, h3), od, 0, 0, 0);
#undef PK
}
__device__ __forceinline__ void a_pv(f32x16* o, int vb, bf16x8 pa0, bf16x8 pa1, bf16x8 pa2, bf16x8 pa3) {
  a_pv_one<0>(o[0], vb, pa0, pa1, pa2, pa3); a_pv_one<1>(o[1], vb, pa0, pa1, pa2, pa3);
}

__device__ __forceinline__ void attn_item(const u16* __restrict__ Qb, const u16* __restrict__ KVh, int seq, u16* __restrict__ yout  , char* lds) {
  const int tid = ltid(), wid = tid >> 6, lane = tid & 63, r32 = lane & 31, hi = lane >> 5;
  char* V_lds = lds; char* K_lds = lds + A_OFF_K;
  float* ws = (float*)(lds + A_OFF_W) + wid * 64; float* li_l = ws; float* al_l = ws + 32;
  float m_reg = -1e30f, l_reg = 0; f32x16 o[2] = {}; bf16x8 qr[6];
  const u16* Qw = Qb + (size_t)(wid * 32 + r32) * 96 + hi * 8;
#pragma unroll
  for (int d0 = 0; d0 < 6; ++d0) qr[d0] = *reinterpret_cast<const bf16x8*>(Qw + d0 * 16);
  int lw[3], lsz[3];
#pragma unroll
  for (int i = 0; i < 3; ++i) {
    const int g = tid + i * 512, key = g / 20, cc = g % 20;
    lw[i] = cc < 12 ? (A_OFF_K + key * A_KROW + cc * 16) : a_v_st(key, (cc - 12) * 8);
    lsz[i] = cc < 12 ? A_SHM_K : A_SHM_V;
  }
  const bool third = wid < 4;
  const int vb0 = (int)(uintptr_t)V_lds + a_v_rd_base(lane);
  struct { bf16x8 g0, g1, g2; } sr_[2];
  const char* gsrc = (const char*)KVh + tid * 16;
#define SLOAD(i, k0) do { const char* s_ = gsrc + (size_t)(k0) * 320; sr_[i].g0 = *(const bf16x8*)(s_); sr_[i].g1 = *(const bf16x8*)(s_ + 8192); \
    if (third) sr_[i].g2 = *(const bf16x8*)(s_ + 16384); } while (0)
#define SWRITE(b, i) do { *(bf16x8*)(lds + lw[0] + (b) * lsz[0]) = sr_[i].g0; *(bf16x8*)(lds + lw[1] + (b) * lsz[1]) = sr_[i].g1; \
    if (third) *(bf16x8*)(lds + lw[2] + (b) * lsz[2]) = sr_[i].g2; } while (0)
#define SWAIT() do { if (third) asm volatile("s_waitcnt vmcnt(3)" ::: "memory"); else asm volatile("s_waitcnt vmcnt(2)" ::: "memory"); } while (0)
#define RESC(a) do { if (__any((a) < 1.f)) { if (hi == 0) al_l[r32] = (a); asm volatile("s_waitcnt lgkmcnt(0)" ::: "memory"); \
    _Pragma("unroll") for (int d = 0; d < 2; ++d) _Pragma("unroll") for (int r = 0; r < 16; ++r) o[d][r] *= al_l[crow(r, hi)]; } } while (0)
  f32x16 pA0, pA1, pB0, pB1; float mnA, mnB, alA, alB; bf16x8 pa0, pa1, pa2, pa3; const int NT = seq / 64;
  constexpr int SE = 0, SO = 1;
  SLOAD(SE, 0); asm volatile("s_waitcnt vmcnt(0)" ::: "memory"); SWRITE(0, SE); __syncthreads();
  a_qkt(pA0, pA1, K_lds, qr, r32, hi); a_partialSM(pA0, pA1, m_reg, mnA, alA);
  SLOAD(SO, 64); if (2 < NT) SLOAD(SE, 128);
  SWAIT(); SWRITE(1, SO); __syncthreads();
  for (int j = 1; j + 1 < NT; j += 2) {
    SBAR(); a_qkt(pB0, pB1, K_lds + A_SHM_K, qr, r32, hi);
    a_finishSM(pA0, pA1, alA, l_reg, pa0, pa1, pa2, pa3); SBAR();
    SLOAD(SO, (j + 2) * 64); SBAR();
    a_pv(o, vb0, pa0, pa1, pa2, pa3); a_partialSM(pB0, pB1, m_reg, mnB, alB);
    __syncthreads(); SWAIT(); SWRITE(0, SE);
    RESC(alB); __syncthreads();
    SBAR(); a_qkt(pA0, pA1, K_lds, qr, r32, hi);
    a_finishSM(pB0, pB1, alB, l_reg, pa0, pa1, pa2, pa3); SBAR();
    if (j + 3 < NT) SLOAD(SE, (j + 3) * 64); SBAR();
    a_pv(o, vb0 + A_SHM_V, pa0, pa1, pa2, pa3); a_partialSM(pA0, pA1, m_reg, mnA, alA);
    __syncthreads(); SWAIT(); SWRITE(1, SO);
    RESC(alA); __syncthreads();
  }
  SBAR(); a_qkt(pB0, pB1, K_lds + A_SHM_K, qr, r32, hi);
  a_finishSM(pA0, pA1, alA, l_reg, pa0, pa1, pa2, pa3); SBAR();
  a_pv(o, vb0, pa0, pa1, pa2, pa3); a_partialSM(pB0, pB1, m_reg, mnB, alB);
  __syncthreads(); RESC(alB);
  a_finishSM(pB0, pB1, alB, l_reg, pa0, pa1, pa2, pa3); SBAR();
  a_pv(o, vb0 + A_SHM_V, pa0, pa1, pa2, pa3);
  if (hi == 0) li_l[r32] = l_reg; asm volatile("s_waitcnt lgkmcnt(0)" ::: "memory");
#pragma unroll
  for (int r = 0; r < 16; ++r) {
    const int orow = crow(r, hi);
    const float rl = __builtin_amdgcn_rcpf(li_l[orow]);
    const float v0 = o[0][r] * rl, v1 = o[1][r] * rl;
    float ss = v0 * v0 + v1 * v1;
#pragma unroll
    for (int off = 16; off > 0; off >>= 1) ss += __shfl_xor(ss, off, 64);
    const float rs = rsqrtf(ss * (1.f / 64.f) + EPS);
    u16* dst = yout + (size_t)(wid * 32 + orow) * DM;
    dst[r32] = f2bf(v0 * rs); dst[32 + r32] = f2bf(v1 * rs);
  }
  __syncthreads();
#undef SLOAD
#undef SWRITE
#undef SWAIT
#undef RESC
}

__device__ __forceinline__ void phase_attn(const Params& p, int layer, int bid, int nb, char* lds) {
  const int nitems = 512 + (layer == 0 ? 8 : 0);
  for (int it = bid; it < nitems; it += nb) {
    int b, h, q0, k0, seq, tok0;
    if (it < 512) { const int qb = it & 63; h = (it >> 6) & 3; b = it >> 8; q0 = qb * 256; k0 = 0; seq = SKV; tok0 = b * SEQ + qb * 256; }
    else { const int i2 = it - 512; h = i2 & 3; b = i2 >> 2; q0 = SEQ; k0 = SEQ; seq = LC; tok0 = TL + b * LC; }
    const size_t base = (size_t)(b * 4 + h) * SKV;
    attn_item(p.Q() + (base + q0) * 96, p.KV() + (base + k0) * 160, seq, p.ymix() + (size_t)tok0 * DM + h * 64, lds);
  }
}
__device__ __forceinline__ float hy_sconv(const float* __restrict__ row, int t, int Ls, float w0, float w1, float w2, float bb) {
  const float zm = t > 0 ? row[t - 1] : 0.f, z0 = row[t], zp = t + 1 < Ls ? row[t + 1] : 0.f;
  return w0 * zm + w1 * z0 + w2 * zp + bb;
}
__device__ __forceinline__ void hyena_item(const Params& p, int layer, int b, int ch, char* lds) {
  float2* s = (float2*)lds;
  const int tid = ltid();
  const float* cw = p.hy_conv_w + (size_t)layer * 3 * 768; const float* cb = p.hy_conv_b + (size_t)layer * 768;
  const float* r0 = p.zt() + (size_t)(ZT_HY + ch) * TT + (size_t)b * SEQ;
  const float* r1 = p.zt() + (size_t)(ZT_HY + 256 + ch) * TT + (size_t)b * SEQ;
  const float* r2 = p.zt() + (size_t)(ZT_HY + 512 + ch) * TT + (size_t)b * SEQ;
  const float a0 = cw[ch], a1 = cw[768 + ch], a2 = cw[1536 + ch], ab = cb[ch];
  const float b0 = cw[256 + ch], b1 = cw[768 + 256 + ch], b2 = cw[1536 + 256 + ch], bb = cb[256 + ch];
  const float c0 = cw[512 + ch], c1 = cw[768 + 512 + ch], c2 = cw[1536 + 512 + ch], cbb = cb[512 + ch];
  for (int m = tid; m < FM; m += NTHR) {
    float2 z = make_float2(0.f, 0.f);
    if (m < SEQ / 2) {
      const int t = 2 * m;
      z.x = hy_sconv(r2, t, SEQ, c0, c1, c2, cbb) * hy_sconv(r1, t, SEQ, b0, b1, b2, bb);
      z.y = hy_sconv(r2, t + 1, SEQ, c0, c1, c2, cbb) * hy_sconv(r1, t + 1, SEQ, b0, b1, b2, bb);
    }
    s[m] = z;
  }
  __syncthreads();
  fft_fwd(s, p.tw());
  const float4* hs = p.hspec() + ((size_t)layer * 256 + ch) * HSP;
  for (int k = tid; k <= FM / 2; k += NTHR) {
    const int pk = rev7(k), pm = rev7((FM - k) & (FM - 1));
    const float2 zk = s[pk], zm = s[pm];
    const float4 h = hs[k];
    const float2 He = make_float2(h.x, h.y), Ho = make_float2(h.z, h.w);
    const float2 Xe = make_float2(0.5f * (zk.x + zm.x), 0.5f * (zk.y - zm.y));
    const float2 Xo = make_float2(0.5f * (zk.y + zm.y), -0.5f * (zk.x - zm.x));
    const float2 t1 = cmul(p.tw()[k], cmul(Xo, Ho));
    const float2 e1 = cmul(Xe, He);
    const float2 Ye = make_float2(e1.x + t1.x, e1.y + t1.y);
    const float2 o1 = cmul(Xe, Ho), o2 = cmul(Xo, He);
    const float2 Yo = make_float2(o1.x + o2.x, o1.y + o2.y);
    s[pk] = make_float2(Ye.x - Yo.y, Ye.y + Yo.x);
    if (pm != pk) s[pm] = make_float2(Ye.x + Yo.y, -Ye.y + Yo.x);
  }
  __syncthreads();
  fft_inv(s, p.tw());
  const float hb = p.hy_bias[layer * 256 + ch];
  float* orow = p.hyo() + (size_t)ch * TT + (size_t)b * SEQ;
  for (int m = tid; m < SEQ / 2; m += NTHR) {
    const int t = 2 * m;
    const float2 y = s[m];
    const float vg0 = hy_sconv(r2, t, SEQ, c0, c1, c2, cbb) * hy_sconv(r1, t, SEQ, b0, b1, b2, bb);
    const float vg1 = hy_sconv(r2, t + 1, SEQ, c0, c1, c2, cbb) * hy_sconv(r1, t + 1, SEQ, b0, b1, b2, bb);
    const float x00 = hy_sconv(r0, t, SEQ, a0, a1, a2, ab), x01 = hy_sconv(r0, t + 1, SEQ, a0, a1, a2, ab);
    *(float2*)(orow + t) = make_float2((y.x + vg0 * hb) * x00, (y.y + vg1 * hb) * x01);
  }
  __syncthreads();
}
__device__ __forceinline__ void fnet_item(const Params& p, int b, int j, char* lds) {
  float2* s = (float2*)lds;
  const int tid = ltid();
  const float* rr = p.zt() + (size_t)(ZT_FR + j) * TT + (size_t)b * SEQ;
  const float* ri = p.zt() + (size_t)(ZT_FI + j) * TT + (size_t)b * SEQ;
  for (int m = tid; m < FM; m += NTHR) s[m] = make_float2(rr[m], ri[m]);
  __syncthreads();
  fft_fwd(s, p.tw());
  float* orow = p.fno() + (size_t)j * TT + (size_t)b * SEQ;
  for (int k = tid; k < FM; k += NTHR) orow[k] = s[rev7(k)].x * (1.f / 128.f);
  __syncthreads();
}
__device__ __forceinline__ void hyena_ctx_item(const Params& p, int b, int ch, char* lds) {
  float* vg = (float*)lds;
  float* x0 = vg + 256;
  float* hf = x0 + 256;
  float* hbk = hf + 256;
  const int tid = ltid();
  const float* cw = p.hy_conv_w; const float* cb = p.hy_conv_b;
  const size_t off = (size_t)TL + (size_t)b * LC;
  const float* r0 = p.zt() + (size_t)(ZT_HY + ch) * TT + off;
  const float* r1 = p.zt() + (size_t)(ZT_HY + 256 + ch) * TT + off;
  const float* r2 = p.zt() + (size_t)(ZT_HY + 512 + ch) * TT + off;
  if (tid < 256) {
    const int t = tid;
    vg[t] = hy_sconv(r2, t, LC, cw[512 + ch], cw[768 + 512 + ch], cw[1536 + 512 + ch], cb[512 + ch]) *
            hy_sconv(r1, t, LC, cw[256 + ch], cw[768 + 256 + ch], cw[1536 + 256 + ch], cb[256 + ch]);
    x0[t] = hy_sconv(r0, t, LC, cw[ch], cw[768 + ch], cw[1536 + ch], cb[ch]);
    hf[t] = p.hfc()[(size_t)ch * LC + t]; hbk[t] = p.hfc()[(size_t)(256 + ch) * LC + t];
  }
  __syncthreads();
  if (tid < 256) {
    const int t = tid; float y = 0;
    for (int q = 0; q <= t; ++q) y += hf[t - q] * vg[q];
    for (int q = t + 1; q < LC; ++q) y += hbk[q - t] * vg[q];
    y *= rsqrtf(p.hssq()[512 + ch]);
    p.hyo()[(size_t)ch * TT + off + t] = (y + vg[t] * p.hy_bias[ch]) * x0[t];
  }
  __syncthreads();
}
__device__ __forceinline__ void fnet_ctx_item(const Params& p, int b, int j, char* lds) {
  float* ur = (float*)lds; float* ui = ur + 256; float* cst = ui + 256; float* snt = cst + 256;
  const int tid = ltid();
  const size_t off = (size_t)TL + (size_t)b * LC;
  if (tid < 256) {
    ur[tid] = p.zt()[(size_t)(ZT_FR + j) * TT + off + tid]; ui[tid] = p.zt()[(size_t)(ZT_FI + j) * TT + off + tid];
    float sn, cs; sincospif((float)tid / 128.f, &sn, &cs); cst[tid] = cs; snt[tid] = sn;
  }
  __syncthreads();
  if (tid < 256) {
    const int k = tid; float y = 0;
    for (int l = 0; l < 256; ++l) { const int m = (l * k) & 255; y += cst[m] * ur[l] + snt[m] * ui[l]; }
    p.fno()[(size_t)j * TT + off + k] = y * 0.0625f;
  }
  __syncthreads();
}
__device__ __forceinline__ void phase_fftmix(const Params& p, int layer, int bid, int nb, char* lds) {
  const int nitems = layer == 0 ? 2048 : 1024;
  for (int it = bid; it < nitems; it += nb) {
    const int k = it & 511, b = k >> 8, c = k & 255;
    if (it < 512) hyena_item(p, layer, b, c, lds);
    else if (it < 1024) fnet_item(p, b, c, lds);
    else if (it < 1536) hyena_ctx_item(p, b, c, lds);
    else fnet_ctx_item(p, b, c, lds);
  }
}
constexpr int GLG = 17, NGRP = 16;
__device__ __forceinline__ int gla_chain_tok(int dir, int b, int n, int i) {
  const int base = n < 4 ? TL + b * LC : b * SEQ, len = n < 4 ? LC : SEQ, m = n < 4 ? n : n - 4;
  return dir == 0 ? base + 64 * m + i : base + (len - 1) - (64 * m + i);
}
__device__ __forceinline__ float logsig16(float x) { return (fminf(x, 0.f) - log1pf(__expf(-fabsf(x)))) * (1.f / 16.f); }
__device__ __forceinline__ float wave_scan_incl(float v, int lane) {
#pragma unroll
  for (int o = 1; o < 64; o <<= 1) { const float t = __shfl_up(v, o, 64); if (lane >= o) v += t; }
  return v;
}
__device__ __forceinline__ void phase_gla_a(const Params& p, int layer, int bid, int nb, char* lds) {
  float* kl = (float*)lds;
  float* gl = kl + 64 * 33;
  float* vl = gl + 64 * 33;
  const int tid = ltid(), wid = tid >> 6, lane = tid & 63;
  const float* gb = p.gla_gk_b + (size_t)layer * 256;
  for (int it = bid; it < 16 * NGRP; it += nb) {
    const int chain = it >> 4, g = it & 15, dir = chain >> 3, b = (chain >> 2) & 1, h = chain & 3;
    const int n0 = g * GLG, n1 = min(n0 + GLG, NCH);
    const int kk = tid >> 4, v0 = (tid & 15) * 4;
    float st[4] = {0.f, 0.f, 0.f, 0.f}; float dcum = 1.f;
    for (int n = n0; n < n1; ++n) {
      {
        const int i = tid >> 3, c4 = (tid & 7) * 4;
        const float* zr = p.zg() + (size_t)gla_chain_tok(dir, b, n, i) * ZG_W;
        const float4 k4 = *(const float4*)(zr + ZG_GK + h * 32 + c4);
        const float4 g4 = *(const float4*)(zr + ZG_GP + dir * 128 + h * 32 + c4);
        const float4 bb = *(const float4*)(gb + dir * 128 + h * 32 + c4);
        const float4 va = *(const float4*)(zr + ZG_GV + h * 64 + c4 * 2), vb = *(const float4*)(zr + ZG_GV + h * 64 + c4 * 2 + 4);
        kl[i * 33 + c4] = k4.x; kl[i * 33 + c4 + 1] = k4.y; kl[i * 33 + c4 + 2] = k4.z; kl[i * 33 + c4 + 3] = k4.w;
        gl[i * 33 + c4] = logsig16(g4.x + bb.x); gl[i * 33 + c4 + 1] = logsig16(g4.y + bb.y); gl[i * 33 + c4 + 2] = logsig16(g4.z + bb.z); gl[i * 33 + c4 + 3] = logsig16(g4.w + bb.w);
        *(float4*)(vl + i * 68 + c4 * 2) = va; *(float4*)(vl + i * 68 + c4 * 2 + 4) = vb;
      }
      __syncthreads();
#pragma unroll
      for (int q = 0; q < 4; ++q) { const int c = wid * 4 + q; gl[lane * 33 + c] = wave_scan_incl(gl[lane * 33 + c], lane); }
      __syncthreads();
      {
        float* lp = p.gds() + ((size_t)chain * NCH + n) * 2048 + kk * 64 + v0;
        *(float4*)lp = make_float4(st[0], st[1], st[2], st[3]);
        if ((tid & 15) == 0) p.gdv()[((size_t)chain * NCH + n) * 32 + kk] = dcum;
        const float bl = gl[63 * 33 + kk];
        float acc[4] = {0.f, 0.f, 0.f, 0.f};
#pragma unroll 8
        for (int i = 0; i < 64; ++i) {
          const float w = kl[i * 33 + kk] * __expf(bl - gl[i * 33 + kk]);
          const float4 vv = *(const float4*)(vl + i * 68 + v0);
          acc[0] += w * vv.x; acc[1] += w * vv.y; acc[2] += w * vv.z; acc[3] += w * vv.w;
        }
        const float d = __expf(bl);
#pragma unroll
        for (int j = 0; j < 4; ++j) st[j] = st[j] * d + acc[j];
        dcum *= d;
      }
      __syncthreads();
    }
    float* at = p.gst() + ((size_t)chain * NGRP + g) * 2048 + kk * 64 + v0;
    *(float4*)at = make_float4(st[0], st[1], st[2], st[3]);
    if ((tid & 15) == 0) p.gst()[(size_t)16 * NGRP * 2048 + ((size_t)chain * NGRP + g) * 32 + kk] = dcum;
  }
}

constexpr int GC_QP = 33792, GC_KP = GC_QP + 10240, GC_VT = GC_KP + 10240, GC_ST = GC_VT + 18432, GC_AX = GC_ST + 10240;
__device__ __forceinline__ void phase_gla_c(const Params& p, int layer, int bid, int nb, char* lds) {
  float* gl = (float*)lds;
  float* qraw = gl + 2 * 64 * 33;
  float* kraw = qraw + 64 * 33;
  float* Of = (float*)lds;
  char* Qp = lds + GC_QP;
  char* Kp = lds + GC_KP;
  char* VT = lds + GC_VT;
  char* ST = lds + GC_ST;
  const int tid = ltid(), wid = tid >> 6, lane = tid & 63, r32 = lane & 31, hi = lane >> 5;
  char* Ax = lds + GC_AX + wid * 4608;
  const float* gb = p.gla_gk_b + (size_t)layer * 256;
  const int pc_lo = layer == 0 ? 0 : 4, npc = NCH - pc_lo, nitem = 8 * npc;
  const int per = (nitem + nb - 1) / nb, q_beg = bid * per, q_end = min(nitem, q_beg + per);
  const int sdir = tid >> 8, sk = (tid >> 3) & 31, sv0 = (tid & 7) * 8;
  float G[8]; int g_cached = -1, bh_cached = -1;
  for (int qi = q_beg; qi < q_end; ++qi) {
    const int bh = qi / npc, pc = pc_lo + qi % npc, b = bh >> 2, h = bh & 3;
    const int tok0 = pc < 4 ? TL + b * LC + pc * 64 : b * SEQ + (pc - 4) * 64;
    {
      const int pos = tid >> 3, c4 = (tid & 7) * 4;
      const float* zr = p.zg() + (size_t)(tok0 + pos) * ZG_W;
      const float4 q4 = *(const float4*)(zr + ZG_GQ + h * 32 + c4), k4 = *(const float4*)(zr + ZG_GK + h * 32 + c4);
      const float sc = 0.17677669529663687f;
      qraw[pos * 33 + c4] = q4.x * sc; qraw[pos * 33 + c4 + 1] = q4.y * sc; qraw[pos * 33 + c4 + 2] = q4.z * sc; qraw[pos * 33 + c4 + 3] = q4.w * sc;
      kraw[pos * 33 + c4] = k4.x; kraw[pos * 33 + c4 + 1] = k4.y; kraw[pos * 33 + c4 + 2] = k4.z; kraw[pos * 33 + c4 + 3] = k4.w;
#pragma unroll
      for (int d = 0; d < 2; ++d) {
        const float4 g4 = *(const float4*)(zr + ZG_GP + d * 128 + h * 32 + c4), bb = *(const float4*)(gb + d * 128 + h * 32 + c4);
        const int i = d ? 63 - pos : pos;
        float* gd = gl + (d * 64 + i) * 33 + c4;
        gd[0] = logsig16(g4.x + bb.x); gd[1] = logsig16(g4.y + bb.y); gd[2] = logsig16(g4.z + bb.z); gd[3] = logsig16(g4.w + bb.w);
      }
      const float4 va = *(const float4*)(zr + ZG_GV + h * 64 + c4 * 2), vb = *(const float4*)(zr + ZG_GV + h * 64 + c4 * 2 + 4);
      const float vv[8] = {va.x, va.y, va.z, va.w, vb.x, vb.y, vb.z, vb.w};
#pragma unroll
      for (int j = 0; j < 8; ++j) {
        const u16 hv = f2bf(vv[j]); const int v = c4 * 2 + j;
        *(u16*)(VT + (0 * 64 + v) * 144 + pos * 2) = hv; *(u16*)(VT + (1 * 64 + v) * 144 + (63 - pos) * 2) = hv;
      }
    }
    __syncthreads();
#pragma unroll
    for (int q = 0; q < 8; ++q) { const int col = wid * 8 + q, d = col >> 5, c = col & 31; float* gp = gl + (d * 64 + lane) * 33 + c; *gp = wave_scan_incl(*gp, lane); }
    __syncthreads();
    {
#pragma unroll
      for (int e = 0; e < 2; ++e) {
        const int idx = tid + e * 512, d = idx >> 9, i = (idx >> 3) & 63, c4 = (idx & 7) * 4, pos = d ? 63 - i : i;
        float qo[4], ko[4];
#pragma unroll
        for (int j = 0; j < 4; ++j) {
          const float bi = gl[(d * 64 + i) * 33 + c4 + j], bm = gl[(d * 64 + 31) * 33 + c4 + j];
          qo[j] = qraw[pos * 33 + c4 + j] * __expf(bi - bm); ko[j] = kraw[pos * 33 + c4 + j] * __expf(bm - bi);
        }
        *(u32x2*)(Qp + (d * 64 + i) * 80 + c4 * 2) = u32x2{cvtpk(qo[0], qo[1]), cvtpk(qo[2], qo[3])};
        *(u32x2*)(Kp + (d * 64 + i) * 80 + c4 * 2) = u32x2{cvtpk(ko[0], ko[1]), cvtpk(ko[2], ko[3])};
      }
      const int chain = sdir * 8 + b * 4 + h;
      const int n = sdir == 0 ? pc : (pc < 4 ? 3 - pc : 4 + 255 - (pc - 4)), g = n / GLG;
      if (g != g_cached || bh != bh_cached) {
#pragma unroll
        for (int j = 0; j < 8; ++j) G[j] = 0.f;
        const float* at = p.gst() + (size_t)chain * NGRP * 2048 + sk * 64 + sv0;
        const float* dt = p.gst() + (size_t)16 * NGRP * 2048 + (size_t)chain * NGRP * 32 + sk;
        for (int gg = 0; gg < g; ++gg) {
          const float4 a0 = *(const float4*)(at + (size_t)gg * 2048), a1 = *(const float4*)(at + (size_t)gg * 2048 + 4); const float dd = dt[gg * 32];
          G[0] = G[0] * dd + a0.x; G[1] = G[1] * dd + a0.y; G[2] = G[2] * dd + a0.z; G[3] = G[3] * dd + a0.w;
          G[4] = G[4] * dd + a1.x; G[5] = G[5] * dd + a1.y; G[6] = G[6] * dd + a1.z; G[7] = G[7] * dd + a1.w;
        }
        g_cached = g; bh_cached = bh;
      }
      const float* lp = p.gds() + ((size_t)chain * NCH + n) * 2048 + sk * 64 + sv0;
      const float4 l0 = *(const float4*)lp, l1 = *(const float4*)(lp + 4);
      const float dp = p.gdv()[((size_t)chain * NCH + n) * 32 + sk];
      const float em = __expf(gl[(sdir * 64 + 31) * 33 + sk]);
      const float sv[8] = {l0.x + dp * G[0], l0.y + dp * G[1], l0.z + dp * G[2], l0.w + dp * G[3], l1.x + dp * G[4], l1.y + dp * G[5], l1.z + dp * G[6], l1.w + dp * G[7]};
#pragma unroll
      for (int j = 0; j < 8; ++j) *(u16*)(ST + (sdir * 64 + sv0 + j) * 80 + sk * 2) = f2bf(sv[j] * em);
    }
    __syncthreads();
    {
      const int d = wid >> 2, ib = (wid >> 1) & 1, vb = wid & 1;
      const char* Qd = Qp + d * 64 * 80; const char* Kd = Kp + d * 64 * 80; const char* Vd = VT + d * 64 * 144; const char* Sd = ST + d * 64 * 80;
      bf16x8 qf[2];
#pragma unroll
      for (int s2 = 0; s2 < 2; ++s2) qf[s2] = *(const bf16x8*)(Qd + (ib * 32 + r32) * 80 + (16 * s2 + 8 * hi) * 2);
#pragma unroll
      for (int jb = 0; jb < 2; ++jb) {
        if (jb <= ib) {
          f32x16 x = {};
#pragma unroll
          for (int s2 = 0; s2 < 2; ++s2) {
            const bf16x8 kf = *(const bf16x8*)(Kd + (jb * 32 + r32) * 80 + (16 * s2 + 8 * hi) * 2);
            x = __builtin_amdgcn_mfma_f32_32x32x16_bf16(qf[s2], kf, x, 0, 0, 0);
          }
#pragma unroll
          for (int r = 0; r < 16; ++r) {
            const int il = crow(r, hi), i = ib * 32 + il, j = jb * 32 + r32;
            *(u16*)(Ax + il * 144 + j * 2) = f2bf(j <= i ? x[r] : 0.f);
          }
        }
      }
      asm volatile("s_waitcnt lgkmcnt(0)" ::: "memory");
      f32x16 o = {};
#pragma unroll
      for (int s4 = 0; s4 < 4; ++s4) {
        if (s4 < 2 * (ib + 1)) {
          const bf16x8 af = *(const bf16x8*)(Ax + r32 * 144 + (16 * s4 + 8 * hi) * 2);
          const bf16x8 vf = *(const bf16x8*)(Vd + (vb * 32 + r32) * 144 + (16 * s4 + 8 * hi) * 2);
          o = __builtin_amdgcn_mfma_f32_32x32x16_bf16(af, vf, o, 0, 0, 0);
        }
      }
#pragma unroll
      for (int s2 = 0; s2 < 2; ++s2) {
        const bf16x8 sf = *(const bf16x8*)(Sd + (vb * 32 + r32) * 80 + (16 * s2 + 8 * hi) * 2);
        o = __builtin_amdgcn_mfma_f32_32x32x16_bf16(qf[s2], sf, o, 0, 0, 0);
      }
#pragma unroll
      for (int r = 0; r < 16; ++r) {
        const int i = ib * 32 + crow(r, hi), pos = d ? 63 - i : i;
        Of[(d * 64 + pos) * 65 + vb * 32 + r32] = o[r];
      }
    }
    __syncthreads();
    {
      const int pos = tid >> 3, v0 = (tid & 7) * 8;
      float* op = p.glao() + (size_t)(tok0 + pos) * 256 + h * 64 + v0;
      float r8[8];
#pragma unroll
      for (int j = 0; j < 8; ++j) r8[j] = Of[pos * 65 + v0 + j] + Of[(64 + pos) * 65 + v0 + j];
      *(float4*)op = make_float4(r8[0], r8[1], r8[2], r8[3]); *(float4*)(op + 4) = make_float4(r8[4], r8[5], r8[6], r8[7]);
    }
    __syncthreads();
  }
}

__device__ __forceinline__ void phase_mix(const Params& p, int layer, int bid, int nb, char* lds) {
  float* part = (float*)lds;
  u16* tile = (u16*)(lds + 4096);
  const int tid = ltid(), wid = tid >> 6, lane = tid & 63;
  const int ntok = layer == 0 ? TT : TL;
  for (int it = bid; it < ntok / 64; it += nb) {
    const int tok0 = it * 64;
    float vh[32], vf[32]; float sh = 0, sf = 0;
#pragma unroll
    for (int c = 0; c < 32; ++c) {
      vh[c] = p.hyo()[(size_t)(wid * 32 + c) * TT + tok0 + lane]; vf[c] = p.fno()[(size_t)(wid * 32 + c) * TT + tok0 + lane];
      sh += vh[c] * vh[c]; sf += vf[c] * vf[c];
    }
    part[(0 * 8 + wid) * 64 + lane] = sh; part[(1 * 8 + wid) * 64 + lane] = sf;
    __syncthreads();
    float th = 0, tf = 0;
#pragma unroll
    for (int q = 0; q < 8; ++q) { th += part[(0 * 8 + q) * 64 + lane]; tf += part[(1 * 8 + q) * 64 + lane]; }
    const float rh = rsqrtf(th * (1.f / 256.f) + EPS), rf = rsqrtf(tf * (1.f / 256.f) + EPS);
#pragma unroll
    for (int c = 0; c < 32; ++c) { tile[lane * 520 + wid * 32 + c] = f2bf(vh[c] * rh); tile[lane * 520 + 256 + wid * 32 + c] = f2bf(vf[c] * rf); }
    __syncthreads();
    for (int g = tid; g < 64 * 64; g += NTHR) {
      const int tl = g >> 6, cg = g & 63;
      const u32x4 w = *(const u32x4*)(tile + tl * 520 + cg * 8);
      *(u32x4*)(p.ymix() + (size_t)(tok0 + tl) * DM + (cg < 32 ? 256 + cg * 8 : 768 + (cg - 32) * 8)) = w;
    }
    for (int tl = wid * 8; tl < wid * 8 + 8; ++tl) {
      const int tok = tok0 + tl;
      const float4 o = *(const float4*)(p.glao() + (size_t)tok * 256 + lane * 4);
      float ss = o.x * o.x + o.y * o.y + o.z * o.z + o.w * o.w;
#pragma unroll
      for (int off = 8; off > 0; off >>= 1) ss += __shfl_xor(ss, off, 64);
      const float rs = rsqrtf(ss * (1.f / 64.f) + EPS);
      const float4 g = *(const float4*)(p.zg() + (size_t)tok * ZG_W + ZG_OG + lane * 4);
      u32x2 w; w[0] = cvtpk(o.x * rs * silu_f(g.x), o.y * rs * silu_f(g.y)); w[1] = cvtpk(o.z * rs * silu_f(g.z), o.w * rs * silu_f(g.w));
      *(u32x2*)(p.ymix() + (size_t)tok * DM + 512 + lane * 4) = w;
    }
    __syncthreads();
  }
}

struct EpiOut {
  const Params* pp; int layer;
  __device__ __forceinline__ void operator()(const f32x4 (&acc)[2][2][4][2], const G8Unit& u, int wr, int wc, int fr, int fq) const {
    const Params& p = *pp;
    const float* g1 = p.mod() + ((size_t)layer * 3 + modv(u.pm * 256)) * 6144 + 2 * DM;
#pragma unroll
    for (int bj = 0; bj < 2; ++bj) {
      const int c0 = u.pn * 256 + bj * 128 + wc * 32 + 8 * fq;
      const f32x4 ga = *(const f32x4*)(g1 + c0), gb = *(const f32x4*)(g1 + c0 + 4);
#pragma unroll
      for (int ai = 0; ai < 2; ++ai)
#pragma unroll
        for (int m = 0; m < 4; ++m) {
          const int tok = u.pm * 256 + ai * 128 + wr * 64 + m * 16 + fr;
          const float* xr = resid_row(p, layer == 0 ? 0 : 1, tok) + c0;
          float* xo = p.X() + (size_t)tok * DM + c0;
          const f32x4 xa = *(const f32x4*)xr, xb = *(const f32x4*)(xr + 4);
          *(f32x4*)xo = xa + ga * acc[ai][bj][m][0]; *(f32x4*)(xo + 4) = xb + gb * acc[ai][bj][m][1];
        }
    }
  }
};
__device__ __forceinline__ void phase_gemm_out(const Params& p, int layer, int bid, int nb, char* lds) {
  G8Plain S; S.nM = (layer == 0 ? TT : TL) / 256; S.nN = DM / 256; S.K = DM; S.G = nb; S.c = bid; S.Bt = (const char*)(p.bt_out() + (size_t)layer * DM * DM);
  EpiOut E; E.pp = &p; E.layer = layer;
  gemm8_phase(lds, (const char*)p.ymix(), DM, S, E);
}

__device__ __forceinline__ void phase_norm2_router(const Params& p, int layer, int bid, int nb, char* lds) {
  float* rwl = (float*)lds;
  int* lcnt = (int*)(lds + 131072);
  int* lbase = lcnt + 32;
  int* ent = lbase + 32;
  float* entw = (float*)(ent + 2 * 1024);
  const int tid = ltid(), wid = tid >> 6, lane = tid & 63;
  const int ntok = layer == 0 ? TT : TL;
  const float* rw = p.router_w + (size_t)layer * DM * NE;
  for (int i = tid; i < DM * NE / 4; i += NTHR) {
    const int k = i >> 3, q4 = i & 7;
    ((float4*)rwl)[q4 * 1024 + ((k & 3) * 256 + (k >> 2))] = ((const float4*)rw)[i];
  }
  if (tid < 32) lcnt[tid] = 0;
  __syncthreads();
  const float* gn = p.norm2_g + layer * DM; const float* rb = p.router_b + layer * NE;
  const int per = (ntok + nb - 1) / nb, t_beg = bid * per, t_end = min(ntok, t_beg + per);
  for (int tok = t_beg + wid; tok < t_end; tok += 8) {
    const float* xr = p.X() + (size_t)tok * DM;
    float v[16];
#pragma unroll
    for (int i = 0; i < 4; ++i) { const float4 a = *(const float4*)(xr + lane * 4 + i * 256); v[4 * i] = a.x; v[4 * i + 1] = a.y; v[4 * i + 2] = a.z; v[4 * i + 3] = a.w; }
    float ss = 0;
#pragma unroll
    for (int i = 0; i < 16; ++i) ss += v[i] * v[i];
    ss = wave_sum(ss);
    const float rs = rsqrtf(ss * (1.f / DM) + EPS);
    const float* md = p.mod() + ((size_t)layer * 3 + modv(tok)) * 6144 + 3 * DM;
    u16* h = p.H() + (size_t)tok * DM;
#pragma unroll
    for (int i = 0; i < 4; ++i) {
      const int c = lane * 4 + i * 256;
      const float4 g = *(const float4*)(gn + c), sh = *(const float4*)(md + c), sc = *(const float4*)(md + DM + c);
      v[4 * i] = v[4 * i] * rs * g.x * (1.f + sc.x) + sh.x; v[4 * i + 1] = v[4 * i + 1] * rs * g.y * (1.f + sc.y) + sh.y;
      v[4 * i + 2] = v[4 * i + 2] * rs * g.z * (1.f + sc.z) + sh.z; v[4 * i + 3] = v[4 * i + 3] * rs * g.w * (1.f + sc.w) + sh.w;
      u32x2 w; w[0] = cvtpk(v[4 * i], v[4 * i + 1]); w[1] = cvtpk(v[4 * i + 2], v[4 * i + 3]);
      *(u32x2*)(h + c) = w;
    }
    float lg[32];
#pragma unroll
    for (int e = 0; e < 32; ++e) lg[e] = 0.f;
#pragma unroll
    for (int i = 0; i < 16; ++i) {
      const float4* wr4 = (const float4*)rwl + ((i & 3) * 256 + (i >> 2) * 64 + lane);
#pragma unroll
      for (int q = 0; q < 8; ++q) { const float4 w = wr4[q * 1024]; lg[4 * q] += v[i] * w.x; lg[4 * q + 1] += v[i] * w.y; lg[4 * q + 2] += v[i] * w.z; lg[4 * q + 3] += v[i] * w.w; }
    }
#pragma unroll
    for (int e = 0; e < 32; ++e) lg[e] = wave_sum(lg[e]) + rb[e];
    if (lane == 0) {
      int ids[4]; float vals[4]; unsigned used = 0;
#pragma unroll
      for (int k = 0; k < 4; ++k) {
        float best = -3.4e38f; int bi = 0;
#pragma unroll
        for (int e = 0; e < 32; ++e) { const bool ok = !((used >> e) & 1u) && lg[e] > best; best = ok ? lg[e] : best; bi = ok ? e : bi; }
        used |= 1u << bi; ids[k] = bi; vals[k] = best;
      }
      const float mx = vals[0];
      float ex[4], sum = 0;
#pragma unroll
      for (int k = 0; k < 4; ++k) { ex[k] = __expf(vals[k] - mx); sum += ex[k]; }
      const float inv = 1.f / sum;
#pragma unroll
      for (int k = 0; k < 4; ++k) {
        const int lp = atomicAdd(&lcnt[ids[k]], 1);
        const int slot = (tok - t_beg) * 4 + k;
        ent[2 * slot] = tok * 4 + k; ent[2 * slot + 1] = (ids[k] << 20) | lp; entw[slot] = ex[k] * inv;
      }
    }
  }
  __syncthreads();
  if (tid < 32) lbase[tid] = atomicAdd(&p.cnt()[layer * NE + tid], lcnt[tid]);
  __syncthreads();
  const int nas = (t_end > t_beg ? (t_end - t_beg) : 0) * 4;
  for (int s = tid; s < nas; s += NTHR) {
    const int tk = ent[2 * s], el = ent[2 * s + 1], e = el >> 20, pos = lbase[e] + (el & 0xFFFFF);
    p.rtok()[(size_t)e * TT + pos] = tk >> 2; p.rw()[(size_t)e * TT + pos] = entw[s];
    p.tslot()[tk] = (e << 20) | pos;
  }
}

struct G8Moe {
  const int* cnt;
  int ntn, K, G, c; const char* Bt; size_t bstride;
  const int* rtok;
  __device__ __forceinline__ bool next(int i, G8Unit& u) const {
    const int w = (i * 8 + (c & 7)) * (G >> 3) + (c >> 3); int acc = 0, rows = 0;
    for (int ee = 0; ee < NE; ++ee) {
      const int cc = cnt[ee], tiles = ((cc + 255) >> 8) * ntn;
      if (w < acc + tiles) { const int r = w - acc; u.e = ee; u.pm = r / ntn; u.pn = r % ntn; u.ce = cc; u.pre = rows; return true; }
      acc += tiles; rows += cc;
    }
    return false;
  }
  __device__ __forceinline__ unsigned a_off(const G8Unit& u, int row) const {
    const int r = min(u.pm * 256 + row, u.ce - 1);
    const int arow = rtok ? rtok[(size_t)u.e * TT + r] : u.pre + r;
    return (unsigned)arow * (unsigned)(K * 2);
  }
  __device__ __forceinline__ const char* b_ptr(const G8Unit& u) const { return Bt + (size_t)u.e * bstride + (size_t)u.pn * 256 * K * 2; }
};
struct EpiGu {
  const float* bgl; u16* act;
  __device__ __forceinline__ void operator()(const f32x4 (&acc)[2][2][4][2], const G8Unit& u, int wr, int wc, int fr, int fq) const {
    const int j0 = u.pn * 128 + wc * 32 + 8 * fq;
    const float* bg = bgl + (size_t)u.e * 2048 + 2 * j0;
    float bgt[8], bup[8];
#pragma unroll
    for (int q = 0; q < 4; ++q) { const f32x4 t = *(const f32x4*)(bg + 4 * q); bgt[2 * q] = t[0]; bup[2 * q] = t[1]; bgt[2 * q + 1] = t[2]; bup[2 * q + 1] = t[3]; }
#pragma unroll
    for (int ai = 0; ai < 2; ++ai)
#pragma unroll
      for (int m = 0; m < 4; ++m) {
        const int r = u.pm * 256 + ai * 128 + wr * 64 + m * 16 + fr;
        if (r < u.ce) {
          float o[8];
#pragma unroll
          for (int n = 0; n < 2; ++n)
#pragma unroll
            for (int j = 0; j < 4; ++j) {
              const float gate = fminf(acc[ai][0][m][n][j] + bgt[4 * n + j], 7.f);
              const float up = fminf(fmaxf(acc[ai][1][m][n][j] + bup[4 * n + j], -7.f), 7.f);
              o[4 * n + j] = (up + 1.f) * gate * __builtin_amdgcn_rcpf(1.f + __expf(-1.702f * gate));
            }
          *(u32x4*)(act + (size_t)(u.pre + r) * DFF + j0) = u32x4{cvtpk(o[0], o[1]), cvtpk(o[2], o[3]), cvtpk(o[4], o[5]), cvtpk(o[6], o[7])};
        }
      }
  }
};
struct EpiDn {
  const float* bdl; const float* rw; u16* yd;
  __device__ __forceinline__ void operator()(const f32x4 (&acc)[2][2][4][2], const G8Unit& u, int wr, int wc, int fr, int fq) const {
#pragma unroll
    for (int bj = 0; bj < 2; ++bj) {
      const int c0 = u.pn * 256 + bj * 128 + wc * 32 + 8 * fq;
      const f32x4 ba = *(const f32x4*)(bdl + (size_t)u.e * DM + c0), bb = *(const f32x4*)(bdl + (size_t)u.e * DM + c0 + 4);
#pragma unroll
      for (int ai = 0; ai < 2; ++ai)
#pragma unroll
        for (int m = 0; m < 4; ++m) {
          const int r = u.pm * 256 + ai * 128 + wr * 64 + m * 16 + fr;
          if (r < u.ce) {
            const float wgt = rw[(size_t)u.e * TT + r];
            const f32x4 a = (acc[ai][bj][m][0] + ba) * wgt, b = (acc[ai][bj][m][1] + bb) * wgt;
            *(u32x4*)(yd + (size_t)(u.pre + r) * DM + c0) = u32x4{cvtpk(a[0], a[1]), cvtpk(a[2], a[3]), cvtpk(b[0], b[1]), cvtpk(b[2], b[3])};
          }
        }
    }
  }
};
__device__ __forceinline__ void phase_moe_gu(const Params& p, int layer, int bid, int nb, char* lds) {
  int* scnt = (int*)(lds + 131072);
  if (ltid() < NE) scnt[ltid()] = p.cnt()[layer * NE + ltid()];
  __syncthreads();
  G8Moe S; S.cnt = scnt; S.ntn = 8; S.K = DM; S.G = nb; S.c = bid; S.Bt = (const char*)(p.bt_gu() + (size_t)layer * NE * 2048 * DM); S.bstride = (size_t)2048 * DM * 2; S.rtok = p.rtok();
  EpiGu E; E.bgl = p.moe_b_gu + (size_t)layer * NE * 2048; E.act = p.act();
  gemm8_phase(lds, (const char*)p.H(), DM, S, E);
}
__device__ __forceinline__ void phase_moe_dn(const Params& p, int layer, int bid, int nb, char* lds) {
  int* scnt = (int*)(lds + 131072);
  if (ltid() < NE) scnt[ltid()] = p.cnt()[layer * NE + ltid()];
  __syncthreads();
  G8Moe S; S.cnt = scnt; S.ntn = 4; S.K = DFF; S.G = nb; S.c = bid; S.Bt = (const char*)(p.bt_dn() + (size_t)layer * NE * DM * DFF); S.bstride = (size_t)DM * DFF * 2; S.rtok = nullptr;
  EpiDn E; E.bdl = p.moe_b_down + (size_t)layer * NE * DM; E.rw = p.rw(); E.yd = p.yd();
  gemm8_phase(lds, (const char*)p.act(), DFF, S, E);
}

__device__ __forceinline__ void phase_final(const Params& p, int bid, int nb, char* lds) {
  int* pre = (int*)lds;
  expert_prefix(p.cnt() + NE, pre); __syncthreads();
  const int wid = ltid() >> 6, lane = ltid() & 63;
  for (int tok = bid * 8 + wid; tok < TL; tok += nb * 8) {
    float v[16];
    load_row_comb(p, 1, 1, tok, lane, pre, v);
    float ss = 0;
#pragma unroll
    for (int i = 0; i < 16; ++i) ss += v[i] * v[i];
    ss = wave_sum(ss);
    const float rs = rsqrtf(ss * (1.f / DM) + EPS);
    float* o = p.out + (size_t)tok * DM;
#pragma unroll
    for (int i = 0; i < 4; ++i) {
      const int c = lane * 4 + i * 256;
      const float4 g = *(const float4*)(p.final_g + c);
      *(float4*)(o + c) = make_float4(v[4 * i] * rs * g.x, v[4 * i + 1] * rs * g.y, v[4 * i + 2] * rs * g.z, v[4 * i + 3] * rs * g.w);
    }
  }
}

#define XB_TMO      128
#define XB_XCNT(j)  (256  + 64 * (j))
#define XB_XSUB(j)  (1280 + 64 * (j))
#define XB_XGEN(j)  (2304 + 64 * (j))
#define XB_TOP      3328
#define XB_TOPGEN   3392
#define XCD_BAR_WORDS 3456
#define XB_SPIN_CAP (1u << 18)
#define LAS __attribute__((address_space(3)))

__device__ __forceinline__ unsigned xb_ld(unsigned* p)              { return __hip_atomic_load(p, __ATOMIC_RELAXED, __HIP_MEMORY_SCOPE_AGENT); }
__device__ __forceinline__ unsigned xb_add(unsigned* p, unsigned v) { return __hip_atomic_fetch_add(p, v, __ATOMIC_RELAXED, __HIP_MEMORY_SCOPE_AGENT); }
__device__ __forceinline__ unsigned xb_xcc_id() { return (unsigned)__builtin_amdgcn_s_getreg((3 << 11) | 20) & 0xFu; }
#define XB_SPIN(cond, bar) do { unsigned _sp = 0; while (cond) { __builtin_amdgcn_s_sleep(1); \
    if ((++_sp & 255u) == 0u) { if (xb_ld(&(bar)[XB_TMO])) break; if (_sp > XB_SPIN_CAP) { atomicAdd(&(bar)[XB_TMO], 1u); break; } } } } while (0)

struct XcdBarrier {
    unsigned* bar; unsigned x;
    volatile LAS unsigned* st;
};

__device__ __forceinline__ XcdBarrier xcd_barrier_post(unsigned* bar, volatile LAS unsigned* st) {
    XcdBarrier b; b.bar = bar; b.x = xb_xcc_id(); b.st = st;
    if (threadIdx.x == 0) (void)xb_add(&bar[XB_XCNT(b.x)], 1u);
    return b;
}
__device__ __forceinline__ void xcd_barrier_complete(unsigned* bar, unsigned x, unsigned& nloc, unsigned& nx) {
    const unsigned G = gridDim.x * gridDim.y * gridDim.z;
    unsigned sum, cnt, mine, sp = 0u;
    for (;;) {
        sum = 0u; cnt = 0u; mine = 0u;
#pragma unroll
        for (unsigned j = 0; j < 16; ++j) { const unsigned c = xb_ld(&bar[XB_XCNT(j)]); sum += c; cnt += (c > 0u) ? 1u : 0u; mine = (j == x) ? c : mine; }
        if (sum == G) break;
        __builtin_amdgcn_s_sleep(1);
        if ((++sp & 255u) == 0u) { if (xb_ld(&bar[XB_TMO])) break; if (sp > XB_SPIN_CAP) { atomicAdd(&bar[XB_TMO], 1u); break; } }
    }
    nloc = mine > 0u ? mine : 1u; nx = cnt > 0u ? cnt : 1u;
}

__device__ __forceinline__ void xcd_barrier(const XcdBarrier& b) {
    asm volatile("s_waitcnt vmcnt(0)" ::: "memory");
    __syncthreads();
    if (threadIdx.x == 0) {
        unsigned* bar = b.bar;
        __builtin_amdgcn_s_waitcnt(0);
        unsigned nloc = b.st[0], nx = b.st[1];
        if (nloc == 0u) { xcd_barrier_complete(bar, b.x, nloc, nx); b.st[0] = nloc; b.st[1] = nx; }
        const unsigned old = xb_add(&bar[XB_XSUB(b.x)], 1u);
        const unsigned gen = old / nloc;
        if (old + 1u == (gen + 1u) * nloc) {
            __builtin_amdgcn_fence(__ATOMIC_RELEASE, "agent");
            asm volatile("s_waitcnt vmcnt(0)" ::: "memory");
            const unsigned og = xb_add(&bar[XB_TOP], 1u);
            const unsigned tg = og / nx;
            if (og + 1u == (tg + 1u) * nx) xb_add(&bar[XB_TOPGEN], 1u);
            else XB_SPIN(xb_ld(&bar[XB_TOPGEN]) == tg, bar);
            __builtin_amdgcn_fence(__ATOMIC_ACQUIRE, "agent");
            xb_add(&bar[XB_XGEN(b.x)], 1u);
            asm volatile("s_waitcnt vmcnt(0)" ::: "memory");
        } else {
            XB_SPIN(xb_ld(&bar[XB_XGEN(b.x)]) == gen, bar);
            __builtin_amdgcn_fence(__ATOMIC_ACQUIRE, "agent");
            asm volatile("s_waitcnt vmcnt(0)" ::: "memory");
        }
    }
    __syncthreads();
}

constexpr int LDS_MAIN = 147456;
constexpr int LDS_BYTES = LDS_MAIN + 1024;
enum { PH_TABLES = 0, PH_MOD, PH_FOLD, PH_CONVERT, PH_HYMLP, PH_HYFILT, PH_NORM1, PH_GEMM_IN, PH_QKV, PH_ATTN, PH_FFTMIX,
       PH_GLA_A, PH_GLA_B, PH_GLA_C, PH_MIX, PH_GEMM_OUT, PH_NORM2, PH_MOE_GU, PH_MOE_DN, PH_FINAL };

template <int PH>
__global__ void __launch_bounds__(NTHR, 2) k_phase(Params p, int layer) {
  extern __shared__ __attribute__((aligned(1024))) char lds[];
  const int bid = blockIdx.x, nb = gridDim.x;
  if constexpr (PH == PH_TABLES) phase_tables(p, bid, nb);
  else if constexpr (PH == PH_MOD) phase_mod(p, bid, nb, lds);
  else if constexpr (PH == PH_FOLD) phase_fold(p, bid, nb, lds);
  else if constexpr (PH == PH_CONVERT) phase_convert(p, bid, nb, lds);
  else if constexpr (PH == PH_HYMLP) {
    if (layer < 2) phase_hy_mlp(p, layer, SEQ, p.hfb() + (size_t)layer * 2 * 256 * SEQ, p.hssq() + layer * 256, bid, nb, lds);
    else phase_hy_mlp(p, 0, LC, p.hfc(), p.hssq() + 512, bid, nb, lds);
  }
  else if constexpr (PH == PH_HYFILT) phase_hy_filtfft(p, bid, nb, lds);
  else if constexpr (PH == PH_NORM1) phase_norm1(p, layer, bid, nb, lds);
  else if constexpr (PH == PH_GEMM_IN) phase_gemm_in(p, layer, bid, nb, lds);
  else if constexpr (PH == PH_QKV) phase_qkv(p, layer, bid, nb, lds);
  else if constexpr (PH == PH_ATTN) phase_attn(p, layer, bid, nb, lds);
  else if constexpr (PH == PH_FFTMIX) phase_fftmix(p, layer, bid, nb, lds);
  else if constexpr (PH == PH_GLA_A) phase_gla_a(p, layer, bid, nb, lds);
  else if constexpr (PH == PH_GLA_C) phase_gla_c(p, layer, bid, nb, lds);
  else if constexpr (PH == PH_MIX) phase_mix(p, layer, bid, nb, lds);
  else if constexpr (PH == PH_GEMM_OUT) phase_gemm_out(p, layer, bid, nb, lds);
  else if constexpr (PH == PH_NORM2) phase_norm2_router(p, layer, bid, nb, lds);
  else if constexpr (PH == PH_MOE_GU) phase_moe_gu(p, layer, bid, nb, lds);
  else if constexpr (PH == PH_MOE_DN) phase_moe_dn(p, layer, bid, nb, lds);
  else if constexpr (PH == PH_FINAL) phase_final(p, bid, nb, lds);
}


#ifndef MK_LAUNCHES
#define MK_LAUNCHES 1
#endif
__global__ void __launch_bounds__(NTHR, 2) k_mega(Params p) {
  extern __shared__ __attribute__((aligned(1024))) char lds[];
  const int bid = blockIdx.x, nb = gridDim.x;
  if (threadIdx.x == 0) *(uint4*)(lds + LDS_MAIN) = make_uint4(0u, 0u, 0u, 0u);
  __syncthreads();
  XcdBarrier bar = xcd_barrier_post(p.bar(), (volatile LAS unsigned*)(lds + LDS_MAIN));
#ifndef DBLMASK
#define DBLMASK 0u
#endif
#define RUNPH(bit, call) do { call; if (DBLMASK & (1u << (bit))) { __syncthreads(); call; } } while (0)
  RUNPH(13, phase_tables(p, bid, nb); phase_mod(p, bid, nb, lds); phase_fold(p, bid, nb, lds));
  RUNPH(0, phase_convert(p, bid, nb, lds));
  phase_hy_mlp(p, 0, SEQ, p.hfb(), p.hssq(), bid, nb, lds);
  phase_hy_mlp(p, 1, SEQ, p.hfb() + (size_t)2 * 256 * SEQ, p.hssq() + 256, bid, nb, lds);
  phase_hy_mlp(p, 0, LC, p.hfc(), p.hssq() + 512, bid, nb, lds);
  xcd_barrier(bar);
  RUNPH(2, phase_hy_filtfft(p, bid, nb, lds));
#define MK_LAYER(l) do { \
  phase_norm1(p, l, bid, nb, lds); \
  xcd_barrier(bar); \
  RUNPH(3, phase_gemm_in(p, l, bid, nb, lds)); \
  xcd_barrier(bar); \
  RUNPH(4, phase_qkv(p, l, bid, nb, lds)); \
  RUNPH(5, phase_gla_a(p, l, bid, nb, lds)); \
  xcd_barrier(bar); \
  RUNPH(6, phase_attn(p, l, bid, nb, lds)); \
  RUNPH(7, phase_fftmix(p, l, bid, nb, lds)); \
  RUNPH(9, phase_gla_c(p, l, bid, nb, lds)); \
  xcd_barrier(bar); \
  RUNPH(10, phase_mix(p, l, bid, nb, lds)); \
  xcd_barrier(bar); \
  phase_gemm_out(p, l, bid, nb, lds); \
  xcd_barrier(bar); \
  phase_norm2_router(p, l, bid, nb, lds); \
  xcd_barrier(bar); \
  RUNPH(11, phase_moe_gu(p, l, bid, nb, lds)); \
  xcd_barrier(bar); \
  RUNPH(12, phase_moe_dn(p, l, bid, nb, lds)); \
  xcd_barrier(bar); \
  } while (0)
  MK_LAYER(0);
  MK_LAYER(1);
#undef MK_LAYER
  phase_final(p, bid, nb, lds);
}
static size_t carve(char*& cur, size_t bytes) { char* r = cur; cur += (bytes + 1023) & ~(size_t)1023; return (size_t)(uintptr_t)r; }
#define CARVE(T, field, n) p.field = (T*)carve(cur, (size_t)(n) * sizeof(T))

template <int PH> static void launch_phase(const Params& p, int layer, hipStream_t stream) {
  static bool attr = false;
  if (!attr) { hipFuncSetAttribute((const void*)k_phase<PH>, hipFuncAttributeMaxDynamicSharedMemorySize, LDS_BYTES); attr = true; }
  hipLaunchKernelGGL(k_phase<PH>, dim3(256), dim3(NTHR), LDS_BYTES, stream, p, layer);
}

extern "C" void kernel_launch(void* const* d_in, const int* in_sizes, int n_in, void* d_out, int out_size, void* d_ws, size_t ws_size, hipStream_t stream) {
  Params p; memset(&p, 0, sizeof(p));
  const float** ins = (const float**)&p;
  for (int i = 0; i < 34; ++i) ins[i] = (const float*)d_in[i];
  p.out = (float*)d_out;
  p.ws = (char*)d_ws;
  if (WS_TOTAL > ws_size) { fprintf(stderr, "workspace too small: need %zu have %zu\n", (size_t)WS_TOTAL, ws_size); return; }
  hipMemsetAsync(p.bar(), 0, OFF_mod - OFF_bar, stream);
  static int grid = 0;
  if (!grid) {
    int dev = 0, cus = 0, per_cu = 0;
    hipGetDevice(&dev);
    hipDeviceGetAttribute(&cus, hipDeviceAttributeMultiprocessorCount, dev);
    hipFuncSetAttribute((const void*)k_mega, hipFuncAttributeMaxDynamicSharedMemorySize, LDS_BYTES);
    hipOccupancyMaxActiveBlocksPerMultiprocessor(&per_cu, (const void*)k_mega, NTHR, LDS_BYTES);
    grid = cus * (per_cu < 1 ? per_cu : 1);
    if (grid != 256) fprintf(stderr, "unexpected grid %d (cus %d per_cu %d)\n", grid, cus, per_cu);
  }
  hipLaunchKernelGGL(k_mega, dim3(grid), dim3(NTHR), LDS_BYTES, stream, p);
}
```

```cpp
#include <hip/hip_runtime.h>
#include <hip/hip_bf16.h>
#include <cstdio>
#include <cstdint>
#include <cstring>

typedef unsigned short u16;
using bf16x8 = __attribute__((ext_vector_type(8))) short;
using s16x4  = __attribute__((ext_vector_type(4))) short;
using f32x4  = __attribute__((ext_vector_type(4))) float;
using f32x16 = __attribute__((ext_vector_type(16))) float;
using u32x4  = __attribute__((ext_vector_type(4))) unsigned;
using u32x2  = __attribute__((ext_vector_type(2))) unsigned;

constexpr int DM = 1024, NB = 2, SEQ = 16384, LC = 256;
constexpr int TL = NB * SEQ;
constexpr int TC = NB * LC;
constexpr int TT = TL + TC;
constexpr int NIN = 2816;
constexpr int DIN0 = 2240;
constexpr int NE = 32, TOPK = 4, DFF = 1024;
constexpr int SKV = SEQ + LC;
constexpr int NTHR = 512;
constexpr float EPS = 1e-6f;
constexpr int ZG_W = 1152, ZG_GQ = 0, ZG_GK = 128, ZG_KR = 256, ZG_GV = 384, ZG_GP = 640, ZG_OG = 896;
constexpr int ZT_HY = 0, ZT_FR = 768, ZT_FI = 1024, ZT_R = 1280;
constexpr int NCH = 260;
constexpr int FM = 16384;
constexpr int HSP = FM / 2 + 1;

constexpr size_t ws_al(size_t b) { return (b + 1023) & ~(size_t)1023; }
constexpr size_t OFF_bar = 0;
constexpr size_t OFF_cnt = OFF_bar + ws_al((size_t)(4096) * sizeof(unsigned));
constexpr size_t OFF_hssq = OFF_cnt + ws_al((size_t)(64) * sizeof(int));
constexpr size_t OFF_mod = OFF_hssq + ws_al((size_t)(768) * sizeof(float));
constexpr size_t OFF_ropec = OFF_mod + ws_al((size_t)(2 * 3 * 6144) * sizeof(float));
constexpr size_t OFF_ropes = OFF_ropec + ws_al((size_t)(SEQ * 16) * sizeof(float));
constexpr size_t OFF_tw = OFF_ropes + ws_al((size_t)(SEQ * 16) * sizeof(float));
constexpr size_t OFF_bt_in = OFF_tw + ws_al((size_t)(FM) * sizeof(float2));
constexpr size_t OFF_bt_qkv = OFF_bt_in + ws_al((size_t)((size_t)2 * NIN * DM) * sizeof(u16));
constexpr size_t OFF_bt_out = OFF_bt_qkv + ws_al((size_t)(2 * 1024 * 384) * sizeof(u16));
constexpr size_t OFF_bt_gu = OFF_bt_out + ws_al((size_t)((size_t)2 * DM * DM) * sizeof(u16));
constexpr size_t OFF_bt_dn = OFF_bt_gu + ws_al((size_t)((size_t)2 * NE * 2048 * DM) * sizeof(u16));
constexpr size_t OFF_hfb = OFF_bt_dn + ws_al((size_t)((size_t)2 * NE * DM * DFF) * sizeof(u16));
constexpr size_t OFF_hfc = OFF_hfb + ws_al((size_t)((size_t)2 * 2 * 256 * SEQ) * sizeof(float));
constexpr size_t OFF_hspec = OFF_hfc + ws_al((size_t)(2 * 256 * LC) * sizeof(float));
constexpr size_t OFF_H = OFF_hspec + ws_al((size_t)((size_t)2 * 256 * HSP) * sizeof(float4));
constexpr size_t OFF_zqkv = OFF_H + ws_al((size_t)((size_t)TT * DM) * sizeof(u16));
constexpr size_t OFF_zg = OFF_zqkv + ws_al((size_t)((size_t)TT * 384) * sizeof(u16));
constexpr size_t OFF_zt = OFF_zg + ws_al((size_t)((size_t)TT * ZG_W) * sizeof(float));
constexpr size_t OFF_Q = OFF_zt + ws_al((size_t)((size_t)ZT_R * TT) * sizeof(float));
constexpr size_t OFF_KV = OFF_Q + ws_al((size_t)((size_t)2 * 4 * SKV * 96) * sizeof(u16));
constexpr size_t OFF_ymix = OFF_KV + ws_al((size_t)((size_t)2 * 4 * SKV * 160) * sizeof(u16));
constexpr size_t OFF_hyo = OFF_ymix + ws_al((size_t)((size_t)TT * DM) * sizeof(u16));
constexpr size_t OFF_fno = OFF_hyo + ws_al((size_t)((size_t)256 * TT) * sizeof(float));
constexpr size_t OFF_glao = OFF_fno + ws_al((size_t)((size_t)256 * TT) * sizeof(float));
constexpr size_t OFF_gds = OFF_glao + ws_al((size_t)((size_t)TT * 256) * sizeof(float));
constexpr size_t OFF_gdv = OFF_gds + ws_al((size_t)((size_t)16 * NCH * 2048) * sizeof(float));
constexpr size_t OFF_gst = OFF_gdv + ws_al((size_t)((size_t)16 * NCH * 32) * sizeof(float));
constexpr size_t OFF_X = OFF_gst + ws_al((size_t)((size_t)16 * NCH * 2048) * sizeof(float));
constexpr size_t OFF_rtok = OFF_X + ws_al((size_t)((size_t)TT * DM) * sizeof(float));
constexpr size_t OFF_rw = OFF_rtok + ws_al((size_t)((size_t)NE * TT) * sizeof(int));
constexpr size_t OFF_tslot = OFF_rw + ws_al((size_t)((size_t)NE * TT) * sizeof(float));
constexpr size_t OFF_act = OFF_tslot + ws_al((size_t)((size_t)TT * 4) * sizeof(int));
constexpr size_t OFF_yd = OFF_act + ws_al((size_t)((size_t)TT * 4 * DFF) * sizeof(u16));
constexpr size_t WS_TOTAL = OFF_yd + ws_al((size_t)((size_t)TT * 4 * DM) * sizeof(u16));
struct Params {
  const float *x, *c, *ctx, *c_ctx, *ada_w, *ada_b, *norm1_g, *norm2_g, *w_in, *mla_q_g, *mla_w_uq, *mla_kv_g, *mla_w_ukv,
      *hy_conv_w, *hy_conv_b, *hy_w1, *hy_b1, *hy_w2, *hy_b2, *hy_w3, *hy_freq, *hy_bias, *gla_gk_w, *gla_gk_b,
      *fnet_w, *mix_g, *w_out, *router_w, *router_b, *moe_w_gu, *moe_b_gu, *moe_w_down, *moe_b_down, *final_g;
  float* out;
  char* ws;
  __device__ __host__ __forceinline__ unsigned* bar() const { return (unsigned*)(ws + OFF_bar); }
  __device__ __host__ __forceinline__ int* cnt() const { return (int*)(ws + OFF_cnt); }
  __device__ __host__ __forceinline__ float* hssq() const { return (float*)(ws + OFF_hssq); }
  __device__ __host__ __forceinline__ float* mod() const { return (float*)(ws + OFF_mod); }
  __device__ __host__ __forceinline__ float* ropec() const { return (float*)(ws + OFF_ropec); }
  __device__ __host__ __forceinline__ float* ropes() const { return (float*)(ws + OFF_ropes); }
  __device__ __host__ __forceinline__ float2* tw() const { return (float2*)(ws + OFF_tw); }
  __device__ __host__ __forceinline__ u16* bt_in() const { return (u16*)(ws + OFF_bt_in); }
  __device__ __host__ __forceinline__ u16* bt_qkv() const { return (u16*)(ws + OFF_bt_qkv); }
  __device__ __host__ __forceinline__ u16* bt_out() const { return (u16*)(ws + OFF_bt_out); }
  __device__ __host__ __forceinline__ u16* bt_gu() const { return (u16*)(ws + OFF_bt_gu); }
  __device__ __host__ __forceinline__ u16* bt_dn() const { return (u16*)(ws + OFF_bt_dn); }
  __device__ __host__ __forceinline__ float* hfb() const { return (float*)(ws + OFF_hfb); }
  __device__ __host__ __forceinline__ float* hfc() const { return (float*)(ws + OFF_hfc); }
  __device__ __host__ __forceinline__ float4* hspec() const { return (float4*)(ws + OFF_hspec); }
  __device__ __host__ __forceinline__ u16* H() const { return (u16*)(ws + OFF_H); }
  __device__ __host__ __forceinline__ u16* zqkv() const { return (u16*)(ws + OFF_zqkv); }
  __device__ __host__ __forceinline__ float* zg() const { return (float*)(ws + OFF_zg); }
  __device__ __host__ __forceinline__ float* zt() const { return (float*)(ws + OFF_zt); }
  __device__ __host__ __forceinline__ u16* Q() const { return (u16*)(ws + OFF_Q); }
  __device__ __host__ __forceinline__ u16* KV() const { return (u16*)(ws + OFF_KV); }
  __device__ __host__ __forceinline__ u16* ymix() const { return (u16*)(ws + OFF_ymix); }
  __device__ __host__ __forceinline__ float* hyo() const { return (float*)(ws + OFF_hyo); }
  __device__ __host__ __forceinline__ float* fno() const { return (float*)(ws + OFF_fno); }
  __device__ __host__ __forceinline__ float* glao() const { return (float*)(ws + OFF_glao); }
  __device__ __host__ __forceinline__ float* gds() const { return (float*)(ws + OFF_gds); }
  __device__ __host__ __forceinline__ float* gdv() const { return (float*)(ws + OFF_gdv); }
  __device__ __host__ __forceinline__ float* gst() const { return (float*)(ws + OFF_gst); }
  __device__ __host__ __forceinline__ float* X() const { return (float*)(ws + OFF_X); }
  __device__ __host__ __forceinline__ int* rtok() const { return (int*)(ws + OFF_rtok); }
  __device__ __host__ __forceinline__ float* rw() const { return (float*)(ws + OFF_rw); }
  __device__ __host__ __forceinline__ int* tslot() const { return (int*)(ws + OFF_tslot); }
  __device__ __host__ __forceinline__ u16* act() const { return (u16*)(ws + OFF_act); }
  __device__ __host__ __forceinline__ u16* yd() const { return (u16*)(ws + OFF_yd); }
};


__device__ __forceinline__ u16 f2bf(float f) {
  unsigned u = __float_as_uint(f); u += 0x7FFFu + ((u >> 16) & 1u); return (u16)(u >> 16);
}
__device__ __forceinline__ float bf2f(u16 h) { return __uint_as_float(((unsigned)h) << 16); }
__device__ __forceinline__ unsigned cvtpk(float lo, float hi) {
  unsigned r; asm volatile("v_cvt_pk_bf16_f32 %0, %1, %2" : "=v"(r) : "v"(lo), "v"(hi)); return r;
}
__device__ __forceinline__ float wave_sum(float v) {
#pragma unroll
  for (int o = 32; o > 0; o >>= 1) v += __shfl_xor(v, o, 64);
  return v;
}
__device__ __forceinline__ int ltid() { int t = threadIdx.x; asm volatile("" : "+v"(t)); return t; }
__device__ __forceinline__ float silu_f(float x) { return x / (1.f + __expf(-x)); }
__device__ __forceinline__ float2 cmul(float2 a, float2 b) { return make_float2(a.x * b.x - a.y * b.y, a.x * b.y + a.y * b.x); }
__device__ __forceinline__ float2 cmulc(float2 a, float2 b) { return make_float2(a.x * b.x + a.y * b.y, a.y * b.x - a.x * b.y); }
__device__ __forceinline__ int modv(int tok) { return tok < TL ? (tok >> 14) : 2; }
__device__ __forceinline__ void phase_tables(const Params& p, int bid, int nb) {
  const int gt = bid * NTHR + ltid(), gs = nb * NTHR;
  for (int i = gt; i < SEQ * 16; i += gs) {
    const int t = i >> 4, f = i & 15;
    const float pos = (f < 8) ? (float)(t >> 6) : (float)(t & 63);
    const float inv = powf(10000.f, -(float)(f & 7) / 8.f);
    float s, c; sincosf(pos * inv, &s, &c);
    p.ropec()[i] = c; p.ropes()[i] = s;
  }
  for (int i = gt; i < FM; i += gs) {
    float s, c; sincospif((float)i / 8192.f, &s, &c);
    p.tw()[i] = make_float2(c, -s);
  }
}

__device__ __forceinline__ void phase_mod(const Params& p, int bid, int nb, char* lds) {
  float* red = (float*)lds;
  const int tid = ltid(), part = tid >> 6, cl = tid & 63;
  for (int it = bid; it < 2 * 96; it += nb) {
    const int l = it / 96, n = (it % 96) * 64 + cl;
    const float* W = p.ada_w + (size_t)l * DM * 6144;
    float a0 = 0, a1 = 0, a2 = 0;
    for (int k = part * 128; k < part * 128 + 128; ++k) {
      const float w = W[(size_t)k * 6144 + n];
      a0 += silu_f(p.c[k]) * w; a1 += silu_f(p.c[DM + k]) * w; a2 += silu_f(p.c_ctx[k]) * w;
    }
    red[(part * 3 + 0) * 64 + cl] = a0; red[(part * 3 + 1) * 64 + cl] = a1; red[(part * 3 + 2) * 64 + cl] = a2;
    __syncthreads();
    if (tid < 192) {
      const int v = tid >> 6; float s = 0;
      for (int q = 0; q < 8; ++q) s += red[(q * 3 + v) * 64 + cl];
      p.mod()[((size_t)l * 3 + v) * 6144 + n] = s + p.ada_b[(size_t)l * 6144 + n];
    }
    __syncthreads();
  }
}

__device__ __forceinline__ void phase_fold(const Params& p, int bid, int nb, char* lds) {
  float* wrow = (float*)lds;
  float* dre = wrow + 256;
  float* dim_ = dre + 256;
  float* glr = dim_ + 256;
  float* cst = glr + 32;
  float* snt = cst + 256;
  const int tid = ltid();
  if (tid < 256) { float s, c; sincospif((float)tid / 128.f, &s, &c); cst[tid] = c; snt[tid] = s; }
  __syncthreads();
  for (int it = bid; it < 2 * DM; it += nb) {
    const int l = it >> 10, k = it & 1023;
    const float* wr = p.w_in + ((size_t)l * DM + k) * DIN0;
    if (tid < 256) wrow[tid] = wr[1984 + tid];
    if (tid >= 256 && tid < 288) glr[tid - 256] = wr[1696 + tid - 256];
    __syncthreads();
    {
      const int kp = tid & 255; const bool im = tid >= 256;
      float s = 0;
      for (int c = 0; c < 256; ++c) { const int m = (c * kp) & 255; s += wrow[c] * (im ? -snt[m] : cst[m]); }
      if (im) dim_[kp] = s; else dre[kp] = s;
    }
    __syncthreads();
    {
      const int j = tid & 255; const bool im = tid >= 256;
      const float* Wf = p.fnet_w + (size_t)l * 65536;
      const float* d = im ? dim_ : dre;
      float s = 0;
      for (int kp = 0; kp < 256; ++kp) s += d[kp] * Wf[kp * 256 + j];
      p.bt_in()[((size_t)l * NIN + (im ? 2560 : 2304) + j) * DM + k] = f2bf(s * 0.0625f);
    }
    if (tid < 256) {
      const int dir = tid >> 7, kk = tid & 127;
      const float* gw = p.gla_gk_w + ((size_t)l * 2 + dir) * 16 * 128;
      float s = 0;
      for (int r = 0; r < 16; ++r) s += glr[dir * 16 + r] * gw[r * 128 + kk];
      p.bt_in()[((size_t)l * NIN + 1024 + tid) * DM + k] = f2bf(s);
    }
    __syncthreads();
  }
}

enum { MAP_ID = 0, MAP_IN = 1, MAP_UQ = 2, MAP_UKV = 3, MAP_GU = 4 };
__device__ __forceinline__ int colmap(int mt, int n) {
  switch (mt) {
    case MAP_ID: return n;
    case MAP_IN:
      if (n < 256) return n;
      if (n < 384) return 256 + (n - 256);
      if (n < 512) return 1184 + (n - 384);
      if (n < 640) return 1312 + (n - 512);
      if (n < 672) return 384 + (n - 640);
      if (n < 768) return -1;
      if (n < 1024) return 1440 + (n - 768);
      if (n < 1280) return -2;
      if (n < 1536) return 1728 + (n - 1280);
      if (n < 2304) return 416 + (n - 1536);
      return -2;
    case MAP_UQ:
      if (n < 256) return (n >> 6) * 96 + (n & 63);
      if (n < 384) return ((n - 256) >> 5) * 96 + 64 + ((n - 256) & 31);
      return -1;
    case MAP_UKV:
      if (n < 256) return (n >> 6) * 128 + (n & 63);
      return ((n - 256) >> 6) * 128 + 64 + ((n - 256) & 63);
    default: {
      const int pn = n >> 8, w = n & 255;
      return w < 128 ? 2 * (pn * 128 + w) : 2 * (pn * 128 + w - 128) + 1;
    }
  }
}
__device__ __forceinline__ int invmap(int mt, int sc) {
  if (mt == MAP_ID) return sc;
  if (mt == MAP_GU) { const int j = sc >> 1, t = sc & 1; return (j >> 7) * 256 + t * 128 + (j & 127); }
  if (sc < 384) return sc;
  if (sc < 416) return 640 + (sc - 384);
  if (sc < 1184) return 1536 + (sc - 416);
  if (sc < 1312) return 384 + (sc - 1184);
  if (sc < 1440) return 512 + (sc - 1312);
  if (sc < 1696) return 768 + (sc - 1440);
  if (sc < 1728) return -1;
  if (sc < 1984) return 1280 + (sc - 1728);
  return -1;
}
__device__ __forceinline__ void conv_tile(const float* __restrict__ src, int ld, int K, u16* __restrict__ dst, int mt, const float* __restrict__ scale,
                                          int k0, int s0, float* tile  , int tid) {
  {
    const int kk = tid >> 5, s4 = (tid & 31) * 4;
    float4 v[4];
#pragma unroll
    for (int i = 0; i < 4; ++i) {
      v[i] = make_float4(0.f, 0.f, 0.f, 0.f);
      if (s0 + s4 < ld) v[i] = *(const float4*)(src + (size_t)(k0 + kk + 16 * i) * ld + s0 + s4);
    }
#pragma unroll
    for (int i = 0; i < 4; ++i) {
      const float sc = scale ? scale[k0 + kk + 16 * i] : 1.f;
      float* t = tile + (kk + 16 * i) * 129 + s4;
      t[0] = v[i].x * sc; t[1] = v[i].y * sc; t[2] = v[i].z * sc; t[3] = v[i].w * sc;
    }
  }
  __syncthreads();
#pragma unroll
  for (int h = 0; h < 2; ++h) {
    const int sl = (tid >> 3) + 64 * h, ks = (tid & 7) * 8, sc = s0 + sl;
    const int row = sc < ld ? invmap(mt, sc) : -1;
    if (row >= 0) {
      const float* t = tile + ks * 129 + sl;
      u32x4 w;
      w[0] = cvtpk(t[0], t[129]); w[1] = cvtpk(t[2 * 129], t[3 * 129]); w[2] = cvtpk(t[4 * 129], t[5 * 129]); w[3] = cvtpk(t[6 * 129], t[7 * 129]);
      *(u32x4*)(dst + (size_t)row * K + k0 + ks) = w;
    }
  }
  __syncthreads();
}
__device__ __forceinline__ void phase_convert(const Params& p, int bid, int nb, char* lds) {
  float* tile = (float*)lds;
  const int tid = ltid();
  constexpr int T_IN = 16 * 18, T_OUT = 16 * 8, T_GU = NE * 256, T_DN = NE * 128, T_L = T_IN + T_OUT + T_GU + T_DN;
  for (int t = bid; t < 2 * T_L; t += nb) {
    const int l = t / T_L; int r = t % T_L;
    if (r < T_IN) { conv_tile(p.w_in + (size_t)l * DM * DIN0, DIN0, DM, p.bt_in() + (size_t)l * NIN * DM, MAP_IN, nullptr, (r / 18) * 64, (r % 18) * 128, tile, tid); continue; }
    r -= T_IN;
    if (r < T_OUT) { conv_tile(p.w_out + (size_t)l * DM * DM, DM, DM, p.bt_out() + (size_t)l * DM * DM, MAP_ID, p.mix_g + l * DM, (r / 8) * 64, (r % 8) * 128, tile, tid); continue; }
    r -= T_OUT;
    if (r < T_GU) { const int e = r >> 8, q = r & 255;
      conv_tile(p.moe_w_gu + ((size_t)l * NE + e) * DM * 2048, 2048, DM, p.bt_gu() + ((size_t)l * NE + e) * 2048 * DM, MAP_GU, nullptr, (q >> 4) * 64, (q & 15) * 128, tile, tid); continue; }
    r -= T_GU;
    { const int e = r >> 7, q = r & 127;
      conv_tile(p.moe_w_down + ((size_t)l * NE + e) * DFF * DM, DM, DFF, p.bt_dn() + ((size_t)l * NE + e) * DM * DFF, MAP_ID, nullptr, (q >> 3) * 64, (q & 7) * 128, tile, tid); }
  }
  for (int l = 0; l < 2; ++l) {
    for (int i = bid * NTHR + tid; i < 96 * DM / 8; i += nb * NTHR) *(u32x4*)(p.bt_in() + ((size_t)l * NIN + 672) * DM + (size_t)i * 8) = u32x4{0u, 0u, 0u, 0u};
    {
      const float* wq = p.mla_w_uq + (size_t)l * 256 * 384; const float* wkv = p.mla_w_ukv + (size_t)l * 128 * 512;
      const float* gq = p.mla_q_g + l * 256; const float* gkv = p.mla_kv_g + l * 128;
      u16* dst = p.bt_qkv() + (size_t)l * 1024 * 384;
      for (int i = bid * NTHR + ltid(); i < 1024 * 384; i += nb * NTHR) {
        const int n = i / 384, k = i % 384; float v = 0.f;
        if (n < 512) { const int sc = colmap(MAP_UQ, n); if (k < 256 && sc >= 0) v = gq[k] * wq[k * 384 + sc]; }
        else { if (k >= 256) v = gkv[k - 256] * wkv[(k - 256) * 512 + colmap(MAP_UKV, n - 512)]; }
        dst[i] = f2bf(v);
      }
    }
  }
}

__device__ __forceinline__ void phase_hy_mlp(const Params& p, int l, int Lf, float* __restrict__ hout  , float* __restrict__ ssq  ,
                             int bid, int nb, char* lds) {
  float* zf = (float*)lds;
  float* h1 = zf + 64 * 33;
  float* h2 = h1 + 64 * 64;
  const int tid = ltid();
  const float* w1 = p.hy_w1 + (size_t)l * 33 * 64; const float* b1 = p.hy_b1 + l * 64;
  const float* w2 = p.hy_w2 + (size_t)l * 64 * 64; const float* b2 = p.hy_b2 + l * 64;
  const float* w3 = p.hy_w3 + (size_t)l * 64 * 512; const float* fr = p.hy_freq + l * 64;
  float w3c[64];
#pragma unroll
  for (int k = 0; k < 64; ++k) w3c[k] = w3[k * 512 + tid];
  const int dir = tid >> 8, ch = tid & 255;
  const float maxd = logf(1e-2f) / 0.3f, mind = logf(1e-2f) / 1.5f;
  const float delta = fabsf(mind + (maxd - mind) * (float)ch / 255.f);
  float ssq_acc = 0.f;
  for (int it = bid; it < Lf / 64; it += nb) {
    const int t0 = it * 64;
    for (int i = tid; i < 64 * 33; i += NTHR) {
      const int tt = i / 33, f = i % 33, t = t0 + tt;
      float v;
      if (f == 0) v = (float)t / (float)(Lf - 1);
      else {
        const int j = (f - 1) & 15;
        const float fj = 1e-4f + (float)j * ((15.f - 1e-4f) / 15.f);
        const float w = 6.283185307179586f * (float)t / (float)Lf;
        v = (f <= 16) ? cosf(fj * w) : -sinf(fj * w);
      }
      zf[i] = v;
    }
    __syncthreads();
    for (int i = tid; i < 64 * 64; i += NTHR) {
      const int tt = i >> 6, o = i & 63; float s = b1[o];
      for (int f = 0; f < 33; ++f) s += zf[tt * 33 + f] * w1[f * 64 + o];
      h1[i] = sinf(fr[o] * s);
    }
    __syncthreads();
    for (int i = tid; i < 64 * 64; i += NTHR) {
      const int tt = i >> 6, o = i & 63; float s = b2[o];
      for (int f = 0; f < 64; ++f) s += h1[tt * 64 + f] * w2[f * 64 + o];
      h2[i] = sinf(fr[o] * s);
    }
    __syncthreads();
    float* orow = hout + ((size_t)dir * 256 + ch) * Lf + t0;
    for (int tt = 0; tt < 64; ++tt) {
      float s = 0;
#pragma unroll
      for (int k = 0; k < 64; ++k) s += h2[tt * 64 + k] * w3c[k];
      const int t = t0 + tt;
      s *= __expf(-((float)t / (float)(Lf - 1)) * delta);
      orow[tt] = s;
      if (dir == 0 || t > 0) ssq_acc += s * s;
    }
    __syncthreads();
  }
  atomicAdd(&ssq[ch], ssq_acc);
}

__device__ __forceinline__ int rev7(int k) {
  unsigned r = __brev((unsigned)k) >> 18;
  return (int)(((r & 0x2AAAu) >> 1) | ((r & 0x1555u) << 1));
}
template <int ST, bool INV>
__device__ __forceinline__ void fft_stage(float2* s, const float2* __restrict__ tw, const int tid) {
  constexpr int sh = 12 - 2 * ST, q = 1 << sh, ND = q >= 512 ? q / 512 : 1;
  float2 w1[ND], w2[ND], w3[ND];
  if constexpr (ST < 6) {
#pragma unroll
    for (int d = 0; d < ND; ++d) {
      const int j = q >= 512 ? tid + 512 * d : (tid & (q - 1)), ti = j << (2 * ST);
      w1[d] = tw[ti]; w2[d] = tw[2 * ti]; w3[d] = tw[3 * ti];
    }
  }
#pragma unroll
  for (int m = 0; m < 8; ++m) {
    const int u = tid + 512 * m, g = u >> sh, j = u & (q - 1), base = (g << (sh + 2)) + j;
    constexpr int dummy = 0; (void)dummy;
    const int d = q >= 512 ? (m % ND) : 0;
    if constexpr (!INV) {
      const float2 a0 = s[base], a1 = s[base + q], a2 = s[base + 2 * q], a3 = s[base + 3 * q];
      const float2 b0 = make_float2(a0.x + a2.x, a0.y + a2.y), b1 = make_float2(a0.x - a2.x, a0.y - a2.y);
      const float2 b2 = make_float2(a1.x + a3.x, a1.y + a3.y), b3 = make_float2(a1.x - a3.x, a1.y - a3.y);
      const float2 y1 = make_float2(b1.x + b3.y, b1.y - b3.x), y2 = make_float2(b0.x - b2.x, b0.y - b2.y), y3 = make_float2(b1.x - b3.y, b1.y + b3.x);
      s[base] = make_float2(b0.x + b2.x, b0.y + b2.y);
      if constexpr (ST < 6) { s[base + q] = cmul(y1, w1[d]); s[base + 2 * q] = cmul(y2, w2[d]); s[base + 3 * q] = cmul(y3, w3[d]); }
      else { s[base + q] = y1; s[base + 2 * q] = y2; s[base + 3 * q] = y3; }
    } else {
      float2 t0 = s[base], t1 = s[base + q], t2 = s[base + 2 * q], t3 = s[base + 3 * q];
      if constexpr (ST < 6) { t1 = cmulc(t1, w1[d]); t2 = cmulc(t2, w2[d]); t3 = cmulc(t3, w3[d]); }
      const float2 b0 = make_float2(t0.x + t2.x, t0.y + t2.y), b1 = make_float2(t0.x - t2.x, t0.y - t2.y);
      const float2 b2 = make_float2(t1.x + t3.x, t1.y + t3.y), b3 = make_float2(t1.x - t3.x, t1.y - t3.y);
      s[base] = make_float2(b0.x + b2.x, b0.y + b2.y);
      s[base + q] = make_float2(b1.x - b3.y, b1.y + b3.x);
      s[base + 2 * q] = make_float2(b0.x - b2.x, b0.y - b2.y);
      s[base + 3 * q] = make_float2(b1.x + b3.y, b1.y - b3.x);
    }
  }
  __syncthreads();
}
__device__ __forceinline__ void fft_fwd(float2* s, const float2* __restrict__ tw) {
  const int tid = ltid();
  fft_stage<0, false>(s, tw, tid); fft_stage<1, false>(s, tw, tid); fft_stage<2, false>(s, tw, tid); fft_stage<3, false>(s, tw, tid);
  fft_stage<4, false>(s, tw, tid); fft_stage<5, false>(s, tw, tid); fft_stage<6, false>(s, tw, tid);
}
__device__ __forceinline__ void fft_inv(float2* s, const float2* __restrict__ tw) {
  const int tid = ltid();
  fft_stage<6, true>(s, tw, tid); fft_stage<5, true>(s, tw, tid); fft_stage<4, true>(s, tw, tid); fft_stage<3, true>(s, tw, tid);
  fft_stage<2, true>(s, tw, tid); fft_stage<1, true>(s, tw, tid); fft_stage<0, true>(s, tw, tid);
}

__device__ __forceinline__ void phase_hy_filtfft(const Params& p, int bid, int nb, char* lds) {
  float2* s = (float2*)lds;
  const int tid = ltid();
  for (int it = bid; it < 512; it += nb) {
    const int l = it >> 8, ch = it & 255;
    const float* hf = p.hfb() + (((size_t)l * 2 + 0) * 256 + ch) * SEQ;
    const float* hb = p.hfb() + (((size_t)l * 2 + 1) * 256 + ch) * SEQ;
    for (int m = tid; m < FM; m += NTHR) {
      const int n0 = 2 * m, n1 = 2 * m + 1;
      const float a = (n0 < SEQ) ? hf[n0] : (n0 == SEQ ? 0.f : hb[2 * SEQ - n0]);
      const float b = (n1 < SEQ) ? hf[n1] : hb[2 * SEQ - n1];
      s[m] = make_float2(a, b);
    }
    __syncthreads();
    fft_fwd(s, p.tw());
    const float sc = rsqrtf(p.hssq()[l * 256 + ch]) * (1.f / 16384.f);
    float4* out = p.hspec() + ((size_t)l * 256 + ch) * HSP;
    for (int k = tid; k <= FM / 2; k += NTHR) {
      const float2 zk = s[rev7(k)], zm = s[rev7((FM - k) & (FM - 1))];
      const float er = 0.5f * (zk.x + zm.x), ei = 0.5f * (zk.y - zm.y);
      const float dr = 0.5f * (zk.x - zm.x), di = 0.5f * (zk.y + zm.y);
      out[k] = make_float4(er * sc, ei * sc, di * sc, -dr * sc);
    }
    __syncthreads();
  }
}
constexpr int G_TILE_B = 256 * 64 * 2;
constexpr int G_STAGE_B = 2 * G_TILE_B;
constexpr int GEMM_LDS = 2 * G_STAGE_B;

__device__ __forceinline__ int lds_byte2(int r, int c) {
  const int st = (r >> 4) * 2 + (c >> 5), ob = (r & 15) * 64 + (c & 31) * 2;
  return st * 1024 + (ob ^ (((ob >> 9) & 1) << 5));
}
__device__ __forceinline__ void stage_rc2(int b, int& R, int& C) {
  const int st = b >> 10, sb = b & 1023, swz = sb ^ (((sb >> 9) & 1) << 5);
  R = (st >> 1) * 16 + (swz >> 6);
  C = (st & 1) * 32 + ((swz & 63) >> 1);
}
__device__ __forceinline__ void gemm_stage_coords(int (&sR)[4], int (&sC)[4]) {
  const int wid = ltid() >> 6, lane = ltid() & 63;
#pragma unroll
  for (int i = 0; i < 4; ++i) stage_rc2(wid * 1024 + i * 8192 + lane * 16, sR[i], sC[i]);
}

#define WAIT_V0() asm volatile("s_waitcnt vmcnt(0)" ::: "memory")

__device__ __forceinline__ void gemm256_core(const u16* const (&ap)[4], const u16* const (&bp)[4], int nt, char* shm, f32x4 (&acc)[8][4]) {
  const int tid = ltid(), wid = tid >> 6, lane = tid & 63, wr = wid >> 2, wc = wid & 3, fr = lane & 15, fq = lane >> 4;
#pragma unroll
  for (int m = 0; m < 8; ++m)
#pragma unroll
    for (int n = 0; n < 4; ++n) acc[m][n] = f32x4{0.f, 0.f, 0.f, 0.f};
#define G_SA(b) (shm + (b) * G_STAGE_B)
#define G_SB(b) (shm + (b) * G_STAGE_B + G_TILE_B)
#define G_STAGE(buf, kt) do { _Pragma("unroll") for (int i = 0; i < 4; ++i) {                                                   \
    __builtin_amdgcn_global_load_lds((const unsigned*)(ap[i] + (kt) * 64), (unsigned*)(G_SA(buf) + wid * 1024 + i * 8192), 16, 0, 0); \
    __builtin_amdgcn_global_load_lds((const unsigned*)(bp[i] + (kt) * 64), (unsigned*)(G_SB(buf) + wid * 1024 + i * 8192), 16, 0, 0); } } while (0)
  G_STAGE(0, 0); WAIT_V0(); __syncthreads();
#pragma unroll 1
  for (int t = 0; t < nt; ++t) {
    const int cur = t & 1;
    if (t + 1 < nt) G_STAGE(cur ^ 1, t + 1);
#pragma unroll
    for (int ks = 0; ks < 2; ++ks) {
      bf16x8 At[8], Bf[4];
#pragma unroll
      for (int m = 0; m < 8; ++m) At[m] = *(const bf16x8*)(G_SA(cur) + lds_byte2(wr * 128 + m * 16 + fr, ks * 32 + fq * 8));
#pragma unroll
      for (int n = 0; n < 4; ++n) Bf[n] = *(const bf16x8*)(G_SB(cur) + lds_byte2(wc * 64 + n * 16 + fr, ks * 32 + fq * 8));
#pragma unroll
      for (int m = 0; m < 8; ++m)
#pragma unroll
        for (int n = 0; n < 4; ++n) acc[m][n] = __builtin_amdgcn_mfma_f32_16x16x32_bf16(At[m], Bf[n], acc[m][n], 0, 0, 0);
      __builtin_amdgcn_sched_barrier(0);
    }
    WAIT_V0(); __syncthreads();
  }
#undef G_STAGE
}

#define LAS3 __attribute__((address_space(3)))
constexpr int G8_HTB = 128 * 64 * 2;
__device__ __forceinline__ int g8_perm32(int rho) { const int n = rho >> 4, i = rho & 15; return 8 * (i >> 2) + 4 * n + (i & 3); }
__device__ __forceinline__ int g8_lds_byte(int r, int c) { const int st = (r >> 4) * 2 + (c >> 5), rr = r & 15, cc = c & 31, ob = rr * 64 + cc * 2; return st * 1024 + (ob ^ (((ob >> 9) & 1) << 5)); }
__device__ __forceinline__ void g8_stage_rc(int b, int& R, int& C) { const int st = b / 1024, sb = b % 1024, swz = sb ^ (((sb >> 9) & 1) << 5); R = (st >> 1) * 16 + swz / 64; C = (st & 1) * 32 + (swz % 64) / 2; }
struct G8Unit { int pm, pn, e, ce, pre; };

template <class Sched, class Epi>
__device__ __forceinline__ void gemm8_phase(char* lds_g, const char* Abase, const int K, const Sched& S, const Epi& E) {
    LAS3 unsigned char* lds = (LAS3 unsigned char*)lds_g;
    const int tid = ltid(), wid = __builtin_amdgcn_readfirstlane(tid >> 6), lane = tid & 63, wr = wid >> 2, wc = wid & 3, fr = lane & 15, fq = lane >> 4;
    const int nt = K / 64;
    int sRr[2], sCc[2]; unsigned voffB[2];
#pragma unroll
    for (int i = 0; i < 2; ++i) { g8_stage_rc(tid * 16 + i * 8192, sRr[i], sCc[i]); const int Rb = (sRr[i] & ~31) + g8_perm32(sRr[i] & 31); voffB[i] = (unsigned)(Rb * K + sCc[i]) * 2u; }
    const size_t kstep = 128;
    const size_t hstepB = (size_t)128 * K * 2;
    const unsigned ldsw = (unsigned)wid * 1024u;
    const int aoff = g8_lds_byte(wr * 64 + fr, fq * 8), boff = g8_lds_byte(wc * 32 + fr, fq * 8);
#define G8_SA(b, h) (((b) * 2 + (h)) * G8_HTB)
#define G8_SB(b, h) ((4 + (b) * 2 + (h)) * G8_HTB)
#define G8_STAGE_B(bufoff, gbase) do { _Pragma("unroll") for (int _i = 0; _i < 2; ++_i) \
        __builtin_amdgcn_global_load_lds((const unsigned*)((const char*)(gbase) + voffB[_i]), (LAS3 unsigned*)(lds + (bufoff) + ldsw + _i * 8192), 16, 0, 0); } while (0)
#define G8_STAGE_A(bufoff, o0, o1) do { \
        __builtin_amdgcn_global_load_lds((const unsigned*)(Abase + (o0)), (LAS3 unsigned*)(lds + (bufoff) + ldsw), 16, 0, 0); \
        __builtin_amdgcn_global_load_lds((const unsigned*)(Abase + (o1)), (LAS3 unsigned*)(lds + (bufoff) + ldsw + 8192), 16, 0, 0); } while (0)
#define G8_LDA(dst, b, h) do { _Pragma("unroll") for (int m = 0; m < 4; ++m) _Pragma("unroll") for (int k = 0; k < 2; ++k) dst[m][k] = *(const LAS3 bf16x8*)(lds + G8_SA(b, h) + aoff + m * 2048 + k * 1024); } while (0)
#define G8_LDB(dst, b, h) do { _Pragma("unroll") for (int n = 0; n < 2; ++n) _Pragma("unroll") for (int k = 0; k < 2; ++k) dst[n][k] = *(const LAS3 bf16x8*)(lds + G8_SB(b, h) + boff + n * 2048 + k * 1024); } while (0)
#define G8_MMA(ai, bj, At, Bt) do { __builtin_amdgcn_s_setprio(1); _Pragma("unroll") for (int m = 0; m < 4; ++m) _Pragma("unroll") for (int n = 0; n < 2; ++n) _Pragma("unroll") for (int k = 0; k < 2; ++k) \
        acc[ai][bj][m][n] = __builtin_amdgcn_mfma_f32_16x16x32_bf16(Bt[n][k], At[m][k], acc[ai][bj][m][n], 0, 0, 0); __builtin_amdgcn_s_setprio(0); } while (0)
#define G8_WAIT_V(n) asm volatile("s_waitcnt vmcnt(" #n ")" ::: "memory")
#define G8_WAIT_L(n) asm volatile("s_waitcnt lgkmcnt(" #n ")" ::: "memory")
#define G8_BAR __builtin_amdgcn_s_barrier()
#define G8_SCHED __builtin_amdgcn_sched_barrier(0)
    G8Unit cur, nxt; int ui = 0;
    if (!S.next(0, cur)) return;
    f32x4 acc[2][2][4][2];
#pragma unroll
    for (int a = 0; a < 2; ++a)
#pragma unroll
        for (int b = 0; b < 2; ++b)
#pragma unroll
            for (int m = 0; m < 4; ++m)
#pragma unroll
                for (int n = 0; n < 2; ++n) acc[a][b][m][n] = (f32x4){0.f, 0.f, 0.f, 0.f};
    bf16x8 At[4][2], B0[2][2], B1[2][2];
    unsigned va[2][2], vn[2][2];
#pragma unroll
    for (int h = 0; h < 2; ++h)
#pragma unroll
        for (int i = 0; i < 2; ++i) va[h][i] = S.a_off(cur, h * 128 + sRr[i]) + (unsigned)sCc[i] * 2u;
    const char* cB = S.b_ptr(cur);
    G8_STAGE_B(G8_SB(0, 0), cB); G8_STAGE_A(G8_SA(0, 0), va[0][0], va[0][1]); G8_STAGE_B(G8_SB(0, 1), cB + hstepB); G8_STAGE_A(G8_SA(0, 1), va[1][0], va[1][1]);
    if (wr == 1) G8_BAR;
    G8_WAIT_V(4); G8_BAR;
    G8_STAGE_B(G8_SB(1, 0), cB + kstep); G8_STAGE_A(G8_SA(1, 0), va[0][0] + kstep, va[0][1] + kstep); G8_STAGE_B(G8_SB(1, 1), cB + hstepB + kstep);
    G8_WAIT_V(6); G8_BAR;
    for (;;) {
        const bool has_next = S.next(ui + 1, nxt);
        const char* nB = cB;
#pragma unroll
        for (int h = 0; h < 2; ++h)
#pragma unroll
            for (int i = 0; i < 2; ++i) vn[h][i] = va[h][i];
        if (has_next) {
            nB = S.b_ptr(nxt);
#pragma unroll
            for (int h = 0; h < 2; ++h)
#pragma unroll
                for (int i = 0; i < 2; ++i) vn[h][i] = S.a_off(nxt, h * 128 + sRr[i]) + (unsigned)sCc[i] * 2u;
        }
#pragma unroll 1
        for (int t = 0; t < nt; t += 2) {
            const bool last = (t == nt - 2);
            const unsigned k1 = (unsigned)(t + 1) * 128u;
            const unsigned k2 = last ? 0u : (unsigned)(t + 2) * 128u;
            const unsigned a2_00 = (last ? vn[0][0] : va[0][0]) + k2, a2_01 = (last ? vn[0][1] : va[0][1]) + k2;
            const unsigned a2_10 = (last ? vn[1][0] : va[1][0]) + k2, a2_11 = (last ? vn[1][1] : va[1][1]) + k2;
            const char* b2 = (last ? nB : cB) + k2; const char* b3 = b2 + kstep;
            G8_LDB(B0, 0, 0); G8_SCHED; G8_LDA(At, 0, 0); G8_STAGE_A(G8_SA(1, 1), va[1][0] + k1, va[1][1] + k1);
            G8_WAIT_L(8); G8_BAR; G8_WAIT_L(0); G8_MMA(0, 0, At, B0); G8_BAR; G8_SCHED;
            G8_LDB(B1, 0, 1); G8_STAGE_B(G8_SB(0, 0), b2);
            G8_BAR; G8_WAIT_L(0); G8_MMA(0, 1, At, B1); G8_BAR;
            G8_LDA(At, 0, 1); G8_STAGE_A(G8_SA(0, 0), a2_00, a2_01);
            G8_BAR; G8_WAIT_L(0); G8_MMA(1, 0, At, B0); G8_BAR; G8_SCHED;
            G8_STAGE_B(G8_SB(0, 1), b2 + hstepB);
            G8_WAIT_V(6); G8_BAR; G8_MMA(1, 1, At, B1); G8_BAR;
            G8_LDB(B0, 1, 0); G8_SCHED; G8_LDA(At, 1, 0); G8_STAGE_A(G8_SA(0, 1), a2_10, a2_11);
            G8_WAIT_L(8); G8_BAR; G8_WAIT_L(0); G8_MMA(0, 0, At, B0); G8_BAR; G8_SCHED;
            G8_LDB(B1, 1, 1); G8_STAGE_B(G8_SB(1, 0), b3);
            G8_BAR; G8_WAIT_L(0); G8_MMA(0, 1, At, B1); G8_BAR;
            G8_LDA(At, 1, 1); G8_STAGE_A(G8_SA(1, 0), a2_00 + 128u, a2_01 + 128u);
            G8_BAR; G8_WAIT_L(0); G8_MMA(1, 0, At, B0); G8_BAR; G8_SCHED;
            G8_STAGE_B(G8_SB(1, 1), b3 + hstepB);
            G8_WAIT_V(6); G8_BAR; G8_MMA(1, 1, At, B1); G8_BAR;
        }
        E(acc, cur, wr, wc, fr, fq);
        if (!has_next) break;
#pragma unroll
        for (int a = 0; a < 2; ++a)
#pragma unroll
            for (int b = 0; b < 2; ++b)
#pragma unroll
                for (int m = 0; m < 4; ++m)
#pragma unroll
                    for (int n = 0; n < 2; ++n) acc[a][b][m][n] = (f32x4){0.f, 0.f, 0.f, 0.f};
        cur = nxt; cB = nB; ++ui;
#pragma unroll
        for (int h = 0; h < 2; ++h)
#pragma unroll
            for (int i = 0; i < 2; ++i) va[h][i] = vn[h][i];
    }
    G8_WAIT_V(0);
    if (wr == 0) G8_BAR;
    G8_BAR;
#undef G8_SA
#undef G8_SB
#undef G8_STAGE_A
#undef G8_STAGE_B
#undef G8_LDA
#undef G8_LDB
#undef G8_MMA
#undef G8_WAIT_V
#undef G8_WAIT_L
#undef G8_BAR
#undef G8_SCHED
}
struct G8Plain {
    int nM, nN, K, G, c; const char* Bt;
    __device__ __forceinline__ bool next(int i, G8Unit& u) const {
        const int L = (i * 8 + (c & 7)) * (G >> 3) + (c >> 3); if (L >= nM * nN) return false;
        const int nig = 8 * nN, gid = L / nig, fm = gid * 8, gsz = (nM - fm) < 8 ? (nM - fm) : 8;
        u.pm = fm + ((L % nig) % gsz); u.pn = (L % nig) / gsz; u.e = 0; u.ce = 256; u.pre = 0; return true;
    }
    __device__ __forceinline__ unsigned a_off(const G8Unit& u, int row) const { return (unsigned)((u.pm * 256 + row) * K) * 2u; }
    __device__ __forceinline__ const char* b_ptr(const G8Unit& u) const { return Bt + (size_t)u.pn * 256 * K * 2; }
};

__device__ __forceinline__ const float* resid_row(const Params& p, int layer_src, int tok) {
  if (layer_src == 0) return tok < TL ? p.x + (size_t)tok * DM : p.ctx + (size_t)(tok - TL) * DM;
  return p.X() + (size_t)tok * DM;
}
__device__ __forceinline__ void load_row_comb(const Params& p, int src_layer, int lc, int tok, int lane, const int* pre  , float (&v)[16]) {
  const float* r = resid_row(p, src_layer, tok);
#pragma unroll
  for (int i = 0; i < 4; ++i) { const float4 a = *(const float4*)(r + lane * 4 + i * 256); v[4 * i] = a.x; v[4 * i + 1] = a.y; v[4 * i + 2] = a.z; v[4 * i + 3] = a.w; }
  if (lc >= 0) {
    const float* g2 = p.mod() + ((size_t)lc * 3 + modv(tok)) * 6144 + 5 * DM;
    float s[16];
#pragma unroll
    for (int i = 0; i < 16; ++i) s[i] = 0.f;
#pragma unroll
    for (int k = 0; k < TOPK; ++k) {
      const int sl = p.tslot()[tok * 4 + k];
      const size_t arow = (size_t)(pre[sl >> 20] + (sl & 0xFFFFF));
      const u16* y = p.yd() + arow * DM;
#pragma unroll
      for (int i = 0; i < 4; ++i) {
        const u32x2 w = *(const u32x2*)(y + lane * 4 + i * 256);
        s[4 * i] += __uint_as_float(w[0] << 16); s[4 * i + 1] += __uint_as_float(w[0] & 0xFFFF0000u);
        s[4 * i + 2] += __uint_as_float(w[1] << 16); s[4 * i + 3] += __uint_as_float(w[1] & 0xFFFF0000u);
      }
    }
#pragma unroll
    for (int i = 0; i < 4; ++i) {
      const float4 g = *(const float4*)(g2 + lane * 4 + i * 256);
      v[4 * i] += g.x * s[4 * i]; v[4 * i + 1] += g.y * s[4 * i + 1]; v[4 * i + 2] += g.z * s[4 * i + 2]; v[4 * i + 3] += g.w * s[4 * i + 3];
    }
  }
}
__device__ __forceinline__ void expert_prefix(const int* cnt, int* pre) {
  if (ltid() == 0) { int s = 0; for (int e = 0; e < NE; ++e) { pre[e] = s; s += cnt[e]; } pre[NE] = s; }
}

__device__ __forceinline__ void phase_norm1(const Params& p, int layer, int bid, int nb, char* lds) {
  int* pre = (int*)lds;
  const int lc = layer - 1;
  if (lc >= 0) { expert_prefix(p.cnt() + lc * NE, pre); __syncthreads(); }
  const int wid = ltid() >> 6, lane = ltid() & 63;
  const float* gn = p.norm1_g + layer * DM;
  const int ntok = TT;
  for (int tok = bid * 8 + wid; tok < ntok; tok += nb * 8) {
    float v[16];
    load_row_comb(p, layer == 0 ? 0 : 1, lc, tok, lane, pre, v);
    if (lc >= 0) {
      float* xr = p.X() + (size_t)tok * DM;
#pragma unroll
      for (int i = 0; i < 4; ++i) *(float4*)(xr + lane * 4 + i * 256) = make_float4(v[4 * i], v[4 * i + 1], v[4 * i + 2], v[4 * i + 3]);
    }
    float ss = 0;
#pragma unroll
    for (int i = 0; i < 16; ++i) ss += v[i] * v[i];
    ss = wave_sum(ss);
    const float rs = rsqrtf(ss * (1.f / DM) + EPS);
    const float* md = p.mod() + ((size_t)layer * 3 + modv(tok)) * 6144;
    u16* h = p.H() + (size_t)tok * DM;
#pragma unroll
    for (int i = 0; i < 4; ++i) {
      const int c = lane * 4 + i * 256;
      const float4 g = *(const float4*)(gn + c), sh = *(const float4*)(md + c), sc = *(const float4*)(md + DM + c);
      const float y0 = v[4 * i] * rs * g.x * (1.f + sc.x) + sh.x, y1 = v[4 * i + 1] * rs * g.y * (1.f + sc.y) + sh.y;
      const float y2 = v[4 * i + 2] * rs * g.z * (1.f + sc.z) + sh.z, y3 = v[4 * i + 3] * rs * g.w * (1.f + sc.w) + sh.w;
      u32x2 w; w[0] = cvtpk(y0, y1); w[1] = cvtpk(y2, y3);
      *(u32x2*)(h + c) = w;
    }
  }
}

struct EpiIn {
  u16* zqkv; float* zg; float* zt;
  __device__ __forceinline__ void operator()(const f32x4 (&acc)[2][2][4][2], const G8Unit& u, int wr, int wc, int fr, int fq) const {
#pragma unroll
    for (int bj = 0; bj < 2; ++bj) {
      const int c32 = u.pn * 256 + bj * 128 + wc * 32, c0 = c32 + 8 * fq;
      if (c32 < 384) {
#pragma unroll
        for (int ai = 0; ai < 2; ++ai)
#pragma unroll
          for (int m = 0; m < 4; ++m) {
            const int row = u.pm * 256 + ai * 128 + wr * 64 + m * 16 + fr;
            const f32x4 a = acc[ai][bj][m][0], b = acc[ai][bj][m][1];
            *(u32x4*)(zqkv + (size_t)row * 384 + c0) = u32x4{cvtpk(a[0], a[1]), cvtpk(a[2], a[3]), cvtpk(b[0], b[1]), cvtpk(b[2], b[3])};
          }
      } else if (c32 < 1536) {
#pragma unroll
        for (int ai = 0; ai < 2; ++ai)
#pragma unroll
          for (int m = 0; m < 4; ++m) {
            const int row = u.pm * 256 + ai * 128 + wr * 64 + m * 16 + fr;
            float* d = zg + (size_t)row * ZG_W + (c0 - 384);
            *(f32x4*)d = acc[ai][bj][m][0]; *(f32x4*)(d + 4) = acc[ai][bj][m][1];
          }
      } else {
#pragma unroll
        for (int ai = 0; ai < 2; ++ai)
#pragma unroll
          for (int m = 0; m < 4; ++m) {
            const int row = u.pm * 256 + ai * 128 + wr * 64 + m * 16 + fr;
#pragma unroll
            for (int n = 0; n < 2; ++n)
#pragma unroll
              for (int j = 0; j < 4; ++j) zt[(size_t)(c0 - 1536 + 4 * n + j) * TT + row] = acc[ai][bj][m][n][j];
          }
      }
    }
  }
};
__device__ __forceinline__ void phase_gemm_in(const Params& p, int layer, int bid, int nb, char* lds) {
  G8Plain S; S.nM = TT / 256; S.nN = NIN / 256; S.K = DM; S.G = nb; S.c = bid; S.Bt = (const char*)(p.bt_in() + (size_t)layer * NIN * DM);
  EpiIn E; E.zqkv = p.zqkv(); E.zg = p.zg(); E.zt = p.zt();
  gemm8_phase(lds, (const char*)p.H(), DM, S, E);
}

__device__ __forceinline__ size_t qkv_row(int tok, int h) {
  const int b = tok < TL ? (tok >> 14) : ((tok - TL) >> 8);
  const int s = tok < TL ? (tok & (SEQ - 1)) : SEQ + ((tok - TL) & (LC - 1));
  return ((size_t)(b * 4 + h)) * SKV + s;
}
struct EpiQkv {
  const u16* zqkv; u16* Q; u16* KV; const float* ropec; const float* ropes; float* rsl;
  __device__ __forceinline__ void operator()(const f32x4 (&acc)[2][2][4][2], const G8Unit& u, int wr, int wc, int fr, int fq) const {
    const int tid = ltid();
    {
      const int r = tid >> 1, half = tid & 1;
      const u16* row = zqkv + (size_t)(u.pm * 256 + r) * 384;
      float sq = 0, sk = 0;
#pragma unroll
      for (int i = 0; i < 16; ++i) {
        const u32x4 w = *(const u32x4*)(row + half * 128 + i * 8);
#pragma unroll
        for (int q = 0; q < 4; ++q) { const float a = __uint_as_float(w[q] << 16), b = __uint_as_float(w[q] & 0xFFFF0000u); sq += a * a + b * b; }
      }
#pragma unroll
      for (int i = 0; i < 8; ++i) {
        const u32x4 w = *(const u32x4*)(row + 256 + half * 64 + i * 8);
#pragma unroll
        for (int q = 0; q < 4; ++q) { const float a = __uint_as_float(w[q] << 16), b = __uint_as_float(w[q] & 0xFFFF0000u); sk += a * a + b * b; }
      }
      sq += __shfl_xor(sq, 1, 64); sk += __shfl_xor(sk, 1, 64);
      if (half == 0) { rsl[r] = rsqrtf(sq * (1.f / 256.f) + EPS); rsl[256 + r] = rsqrtf(sk * (1.f / 128.f) + EPS); }
    }
    asm volatile("s_waitcnt lgkmcnt(0)" ::: "memory"); __builtin_amdgcn_s_barrier(); __builtin_amdgcn_s_barrier(); asm volatile("" ::: "memory");
    const float* rsp = rsl + (u.pn >= 2 ? 256 : 0);
#pragma unroll
    for (int ai = 0; ai < 2; ++ai)
#pragma unroll
      for (int m = 0; m < 4; ++m) {
        const int rl = ai * 128 + wr * 64 + m * 16 + fr, tok = u.pm * 256 + rl;
        const float rs = rsp[rl];
        if (u.pn == 1) {
          f32x4 a = acc[ai][0][m][0] * rs, b = acc[ai][0][m][1] * rs;
          f32x4 pa, pb;
#pragma unroll
          for (int j = 0; j < 4; ++j) { pa[j] = __shfl_xor(a[j], 32, 64); pb[j] = __shfl_xor(b[j], 32, 64); }
          f32x4 ca = {1.f, 1.f, 1.f, 1.f}, cb = ca, sa = {0.f, 0.f, 0.f, 0.f}, sb = sa;
          if (tok < TL) {
            const float* cp = ropec + (size_t)(tok & (SEQ - 1)) * 16 + 8 * (fq & 1); const float* sp = ropes + (size_t)(tok & (SEQ - 1)) * 16 + 8 * (fq & 1);
            ca = *(const f32x4*)cp; cb = *(const f32x4*)(cp + 4); sa = *(const f32x4*)sp; sb = *(const f32x4*)(sp + 4);
          }
          const float sg = fq < 2 ? -1.f : 1.f;
          a = a * ca + pa * sa * sg; b = b * cb + pb * sb * sg;
          *(u32x4*)(Q + qkv_row(tok, wc) * 96 + 64 + 8 * fq) = u32x4{cvtpk(a[0], a[1]), cvtpk(a[2], a[3]), cvtpk(b[0], b[1]), cvtpk(b[2], b[3])};
        } else {
#pragma unroll
          for (int bj = 0; bj < 2; ++bj) {
            const int c = bj * 128 + wc * 32 + 8 * fq, h = c >> 6, d = c & 63;
            const f32x4 a = acc[ai][bj][m][0] * rs, b = acc[ai][bj][m][1] * rs;
            u16* dst = u.pn == 0 ? Q + qkv_row(tok, h) * 96 + d : KV + qkv_row(tok, h) * 160 + (u.pn == 2 ? 0 : 96) + d;
            *(u32x4*)dst = u32x4{cvtpk(a[0], a[1]), cvtpk(a[2], a[3]), cvtpk(b[0], b[1]), cvtpk(b[2], b[3])};
          }
        }
      }
  }
};
__device__ __forceinline__ void phase_qkv(const Params& p, int layer, int bid, int nb, char* lds) {
  const int tid = ltid();
  {
    G8Plain S; S.nM = TT / 256; S.nN = 4; S.K = 384; S.G = nb; S.c = bid; S.Bt = (const char*)(p.bt_qkv() + (size_t)layer * 1024 * 384);
    EpiQkv E; E.zqkv = p.zqkv(); E.Q = p.Q(); E.KV = p.KV(); E.ropec = p.ropec(); E.ropes = p.ropes(); E.rsl = (float*)(lds + 131072);
    gemm8_phase(lds, (const char*)p.zqkv(), 384, S, E);
  }
  for (int i = bid * NTHR + tid; i < TT * 16; i += nb * NTHR) {
    const int tok = i >> 4, f = i & 15;
    const float x1 = p.zg()[(size_t)tok * ZG_W + ZG_KR + f], x2 = p.zg()[(size_t)tok * ZG_W + ZG_KR + 16 + f];
    float cs = 1.f, sn = 0.f;
    if (tok < TL) { const int tpos = tok & (SEQ - 1); cs = p.ropec()[tpos * 16 + f]; sn = p.ropes()[tpos * 16 + f]; }
    const u16 o1 = f2bf(x1 * cs - x2 * sn), o2 = f2bf(x2 * cs + x1 * sn);
#pragma unroll
    for (int h = 0; h < 4; ++h) { u16* kv = p.KV() + qkv_row(tok, h) * 160 + 64; kv[f] = o1; kv[16 + f] = o2; }
  }
}
constexpr int A_KROW = 208;
constexpr int A_SHM_K = 64 * A_KROW;
constexpr int A_SHM_V = 64 * 64 * 2;
constexpr int A_OFF_K = 2 * A_SHM_V;
constexpr int A_OFF_W = A_OFF_K + 2 * A_SHM_K;
constexpr int ATTN_LDS = A_OFF_W + 8 * 64 * 4;
constexpr float A_SCALE = 0.10206207261596575f;
constexpr float A_THR = 8.f;
#define SBAR() __builtin_amdgcn_sched_barrier(0)
__device__ __forceinline__ int crow(int r, int hi) { return (r & 3) + 8 * (r >> 2) + 4 * hi; }

__device__ __forceinline__ void a_partialSM(f32x16& p0, f32x16& p1, float& m_reg, float& mn, float& alpha) {
  constexpr float C = A_SCALE * 1.4426950408889634f;
  float pmax = p0[0];
#pragma unroll
  for (int r = 1; r < 16; ++r) pmax = fmaxf(pmax, p0[r]);
#pragma unroll
  for (int r = 0; r < 16; ++r) pmax = fmaxf(pmax, p1[r]);
  { auto rr = __builtin_amdgcn_permlane32_swap(__float_as_uint(pmax), __float_as_uint(pmax), false, false);
    pmax = fmaxf(__uint_as_float(rr[0]), __uint_as_float(rr[1])); }
  if (__builtin_expect(__all(pmax - m_reg <= A_THR / A_SCALE), 1)) { mn = m_reg; alpha = 1.f; }
  else { mn = fmaxf(m_reg, pmax); alpha = __builtin_amdgcn_exp2f((m_reg - mn) * C); m_reg = mn; }
  const float mnC = -mn * C;
#pragma unroll
  for (int r = 0; r < 16; ++r) p0[r] = fmaf(p0[r], C, mnC);
#pragma unroll
  for (int r = 0; r < 16; ++r) p1[r] = fmaf(p1[r], C, mnC);
#pragma unroll
  for (int r = 0; r < 16; ++r) p0[r] = __builtin_amdgcn_exp2f(p0[r]);
}
__device__ __forceinline__ void a_finishSM(f32x16& p0, f32x16& p1, float alpha, float& l_reg, bf16x8& pa0, bf16x8& pa1, bf16x8& pa2, bf16x8& pa3) {
#pragma unroll
  for (int r = 0; r < 16; ++r) p1[r] = __builtin_amdgcn_exp2f(p1[r]);
  float ps = 0;
#pragma unroll
  for (int r = 0; r < 16; ++r) ps += p0[r];
#pragma unroll
  for (int r = 0; r < 16; ++r) ps += p1[r];
  { auto rr = __builtin_amdgcn_permlane32_swap(__float_as_uint(ps), __float_as_uint(ps), false, false);
    ps = __uint_as_float(rr[0]) + __uint_as_float(rr[1]); }
  l_reg = l_reg * alpha + ps;
#define PK4(P, BASE, OUT) do { unsigned a0 = cvtpk(P[BASE + 0], P[BASE + 1]), a1 = cvtpk(P[BASE + 2], P[BASE + 3]);   \
    unsigned b0 = cvtpk(P[BASE + 4], P[BASE + 5]), b1 = cvtpk(P[BASE + 6], P[BASE + 7]);                              \
    auto r0 = __builtin_amdgcn_permlane32_swap(a0, b0, false, false); auto r1 = __builtin_amdgcn_permlane32_swap(a1, b1, false, false); \
    u32x4 w = {r0[0], r1[0], r0[1], r1[1]}; OUT = *reinterpret_cast<bf16x8*>(&w); } while (0)
  PK4(p0, 0, pa0); PK4(p0, 8, pa1); PK4(p1, 0, pa2); PK4(p1, 8, pa3);
#undef PK4
}
__device__ __forceinline__ void a_qkt(f32x16& p0, f32x16& p1, const char* Ks, const bf16x8* qr, int r32, int hi) {
  p0 = f32x16{}; p1 = f32x16{};
#pragma unroll
  for (int d0 = 0; d0 < 6; ++d0) {
    const int cb = (d0 * 16 + hi * 8) * 2;
    const bf16x8 b0 = *reinterpret_cast<const bf16x8*>(Ks + r32 * A_KROW + cb);
    const bf16x8 b1 = *reinterpret_cast<const bf16x8*>(Ks + (32 + r32) * A_KROW + cb);
    p0 = __builtin_amdgcn_mfma_f32_32x32x16_bf16(b0, qr[d0], p0, 0, 0, 0);
    p1 = __builtin_amdgcn_mfma_f32_32x32x16_bf16(b1, qr[d0], p1, 0, 0, 0);
  }
}
__device__ __forceinline__ int a_v_st(int k, int c) { const int kk = (k & ~0xC) | ((k & 4) << 1) | ((k & 8) >> 1); return ((kk >> 3) * 2 + (c >> 5)) * 512 + ((kk & 7) * 32 + (c & 31)) * 2; }
__device__ __forceinline__ int a_v_rd_base(int lane) { return ((lane & 3) << 3) | (((lane >> 2) & 3) << 6) | (((lane >> 4) & 1) << 5) | (((lane >> 5) & 1) << 8); }
constexpr int a_v_rd_off(int d0, int ks, int half) { return d0 * 512 + ks * 2048 + half * 1024; }
template <int OFF> __device__ __forceinline__ s16x4 a_tr_read(int vb) {
  s16x4 r; asm volatile("ds_read_b64_tr_b16 %0, %1 offset:%2" : "=&v"(r) : "v"(vb), "i"(OFF) : "memory"); return r;
}
template <int D0> __device__ __forceinline__ void a_pv_one(f32x16& od, int vb, bf16x8 pa0, bf16x8 pa1, bf16x8 pa2, bf16x8 pa3) {
  const s16x4 l0 = a_tr_read<a_v_rd_off(D0, 0, 0)>(vb), h0 = a_tr_read<a_v_rd_off(D0, 0, 1)>(vb), l1 = a_tr_read<a_v_rd_off(D0, 1, 0)>(vb), h1 = a_tr_read<a_v_rd_off(D0, 1, 1)>(vb);
  const s16x4 l2 = a_tr_read<a_v_rd_off(D0, 2, 0)>(vb), h2 = a_tr_read<a_v_rd_off(D0, 2, 1)>(vb), l3 = a_tr_read<a_v_rd_off(D0, 3, 0)>(vb), h3 = a_tr_read<a_v_rd_off(D0, 3, 1)>(vb);
  asm volatile("s_waitcnt lgkmcnt(0)" ::: "memory"); SBAR();
#define PK(L, H) (bf16x8){L[0], L[1], L[2], L[3], H[0], H[1], H[2], H[3]}
  od = __builtin_amdgcn_mfma_f32_32x32x16_bf16(pa0, PK(l0, h0), od, 0, 0, 0);
  od = __builtin_amdgcn_mfma_f32_32x32x16_bf16(pa1, PK(l1, h1), od, 0, 0, 0);
  od = __builtin_amdgcn_mfma_f32_32x32x16_bf16(pa2, PK(l2, h2), od, 0, 0, 0);
  od = __builtin_amdgcn_mfma_f32_32x32x16_bf16(pa3, PK(l3, h3), od, 0, 0, 0);
#undef PK
}
__device__ __forceinline__ void a_pv(f32x16* o, int vb, bf16x8 pa0, bf16x8 pa1, bf16x8 pa2, bf16x8 pa3) {
  a_pv_one<0>(o[0], vb, pa0, pa1, pa2, pa3); a_pv_one<1>(o[1], vb, pa0, pa1, pa2, pa3);
}

__device__ __forceinline__ void attn_item(const u16* __restrict__ Qb, const u16* __restrict__ KVh, int seq, u16* __restrict__ yout  , char* lds) {
  const int tid = ltid(), wid = tid >> 6, lane = tid & 63, r32 = lane & 31, hi = lane >> 5;
  char* V_lds = lds; char* K_lds = lds + A_OFF_K;
  float* ws = (float*)(lds + A_OFF_W) + wid * 64; float* li_l = ws; float* al_l = ws + 32;
  float m_reg = -1e30f, l_reg = 0; f32x16 o[2] = {}; bf16x8 qr[6];
  const u16* Qw = Qb + (size_t)(wid * 32 + r32) * 96 + hi * 8;
#pragma unroll
  for (int d0 = 0; d0 < 6; ++d0) qr[d0] = *reinterpret_cast<const bf16x8*>(Qw + d0 * 16);
  int lw[3], lsz[3];
#pragma unroll
  for (int i = 0; i < 3; ++i) {
    const int g = tid + i * 512, key = g / 20, cc = g % 20;
    lw[i] = cc < 12 ? (A_OFF_K + key * A_KROW + cc * 16) : a_v_st(key, (cc - 12) * 8);
    lsz[i] = cc < 12 ? A_SHM_K : A_SHM_V;
  }
  const bool third = wid < 4;
  const int vb0 = (int)(uintptr_t)V_lds + a_v_rd_base(lane);
  struct { bf16x8 g0, g1, g2; } sr_[2];
  const char* gsrc = (const char*)KVh + tid * 16;
#define SLOAD(i, k0) do { const char* s_ = gsrc + (size_t)(k0) * 320; sr_[i].g0 = *(const bf16x8*)(s_); sr_[i].g1 = *(const bf16x8*)(s_ + 8192); \
    if (third) sr_[i].g2 = *(const bf16x8*)(s_ + 16384); } while (0)
#define SWRITE(b, i) do { *(bf16x8*)(lds + lw[0] + (b) * lsz[0]) = sr_[i].g0; *(bf16x8*)(lds + lw[1] + (b) * lsz[1]) = sr_[i].g1; \
    if (third) *(bf16x8*)(lds + lw[2] + (b) * lsz[2]) = sr_[i].g2; } while (0)
#define SWAIT() do { if (third) asm volatile("s_waitcnt vmcnt(3)" ::: "memory"); else asm volatile("s_waitcnt vmcnt(2)" ::: "memory"); } while (0)
#define RESC(a) do { if (__any((a) < 1.f)) { if (hi == 0) al_l[r32] = (a); asm volatile("s_waitcnt lgkmcnt(0)" ::: "memory"); \
    _Pragma("unroll") for (int d = 0; d < 2; ++d) _Pragma("unroll") for (int r = 0; r < 16; ++r) o[d][r] *= al_l[crow(r, hi)]; } } while (0)
  f32x16 pA0, pA1, pB0, pB1; float mnA, mnB, alA, alB; bf16x8 pa0, pa1, pa2, pa3; const int NT = seq / 64;
  constexpr int SE = 0, SO = 1;
  SLOAD(SE, 0); asm volatile("s_waitcnt vmcnt(0)" ::: "memory"); SWRITE(0, SE); __syncthreads();
  a_qkt(pA0, pA1, K_lds, qr, r32, hi); a_partialSM(pA0, pA1, m_reg, mnA, alA);
  SLOAD(SO, 64); if (2 < NT) SLOAD(SE, 128);
  SWAIT(); SWRITE(1, SO); __syncthreads();
  for (int j = 1; j + 1 < NT; j += 2) {
    SBAR(); a_qkt(pB0, pB1, K_lds + A_SHM_K, qr, r32, hi);
    a_finishSM(pA0, pA1, alA, l_reg, pa0, pa1, pa2, pa3); SBAR();
    SLOAD(SO, (j + 2) * 64); SBAR();
    a_pv(o, vb0, pa0, pa1, pa2, pa3); a_partialSM(pB0, pB1, m_reg, mnB, alB);
    __syncthreads(); SWAIT(); SWRITE(0, SE);
    RESC(alB); __syncthreads();
    SBAR(); a_qkt(pA0, pA1, K_lds, qr, r32, hi);
    a_finishSM(pB0, pB1, alB, l_reg, pa0, pa1, pa2, pa3); SBAR();
    if (j + 3 < NT) SLOAD(SE, (j + 3) * 64); SBAR();
    a_pv(o, vb0 + A_SHM_V, pa0, pa1, pa2, pa3); a_partialSM(pA0, pA1, m_reg, mnA, alA);
    __syncthreads(); SWAIT(); SWRITE(1, SO);
    RESC(alA); __syncthreads();
  }
  SBAR(); a_qkt(pB0, pB1, K_lds + A_SHM_K, qr, r32, hi);
  a_finishSM(pA0, pA1, alA, l_reg, pa0, pa1, pa2, pa3); SBAR();
  a_pv(o, vb0, pa0, pa1, pa2, pa3); a_partialSM(pB0, pB1, m_reg, mnB, alB);
  __syncthreads(); RESC(alB);
  a_finishSM(pB0, pB1, alB, l_reg, pa0, pa1, pa2, pa3); SBAR();
  a_pv(o, vb0 + A_SHM_V, pa0, pa1, pa2, pa3);
  if (hi == 0) li_l[r32] = l_reg; asm volatile("s_waitcnt lgkmcnt(0)" ::: "memory");
#pragma unroll
  for (int r = 0; r < 16; ++r) {
    const int orow = crow(r, hi);
    const float rl = __builtin_amdgcn_rcpf(li_l[orow]);
    const float v0 = o[0][r] * rl, v1 = o[1][r] * rl;
    float ss = v0 * v0 + v1 * v1;
#pragma unroll
    for (int off = 16; off > 0; off >>= 1) ss += __shfl_xor(ss, off, 64);
    const float rs = rsqrtf(ss * (1.f / 64.f) + EPS);
    u16* dst = yout + (size_t)(wid * 32 + orow) * DM;
    dst[r32] = f2bf(v0 * rs); dst[32 + r32] = f2bf(v1 * rs);
  }
  __syncthreads();
#undef SLOAD
#undef SWRITE
#undef SWAIT
#undef RESC
}

__device__ __forceinline__ void phase_attn(const Params& p, int layer, int bid, int nb, char* lds) {
  const int nitems = 512 + (layer == 0 ? 8 : 0);
  for (int it = bid; it < nitems; it += nb) {
    int b, h, q0, k0, seq, tok0;
    if (it < 512) { const int qb = it & 63; h = (it >> 6) & 3; b = it >> 8; q0 = qb * 256; k0 = 0; seq = SKV; tok0 = b * SEQ + qb * 256; }
    else { const int i2 = it - 512; h = i2 & 3; b = i2 >> 2; q0 = SEQ; k0 = SEQ; seq = LC; tok0 = TL + b * LC; }
    const size_t base = (size_t)(b * 4 + h) * SKV;
    attn_item(p.Q() + (base + q0) * 96, p.KV() + (base + k0) * 160, seq, p.ymix() + (size_t)tok0 * DM + h * 64, lds);
  }
}
__device__ __forceinline__ float hy_sconv(const float* __restrict__ row, int t, int Ls, float w0, float w1, float w2, float bb) {
  const float zm = t > 0 ? row[t - 1] : 0.f, z0 = row[t], zp = t + 1 < Ls ? row[t + 1] : 0.f;
  return w0 * zm + w1 * z0 + w2 * zp + bb;
}
__device__ __forceinline__ void hyena_item(const Params& p, int layer, int b, int ch, char* lds) {
  float2* s = (float2*)lds;
  const int tid = ltid();
  const float* cw = p.hy_conv_w + (size_t)layer * 3 * 768; const float* cb = p.hy_conv_b + (size_t)layer * 768;
  const float* r0 = p.zt() + (size_t)(ZT_HY + ch) * TT + (size_t)b * SEQ;
  const float* r1 = p.zt() + (size_t)(ZT_HY + 256 + ch) * TT + (size_t)b * SEQ;
  const float* r2 = p.zt() + (size_t)(ZT_HY + 512 + ch) * TT + (size_t)b * SEQ;
  const float a0 = cw[ch], a1 = cw[768 + ch], a2 = cw[1536 + ch], ab = cb[ch];
  const float b0 = cw[256 + ch], b1 = cw[768 + 256 + ch], b2 = cw[1536 + 256 + ch], bb = cb[256 + ch];
  const float c0 = cw[512 + ch], c1 = cw[768 + 512 + ch], c2 = cw[1536 + 512 + ch], cbb = cb[512 + ch];
  for (int m = tid; m < FM; m += NTHR) {
    float2 z = make_float2(0.f, 0.f);
    if (m < SEQ / 2) {
      const int t = 2 * m;
      z.x = hy_sconv(r2, t, SEQ, c0, c1, c2, cbb) * hy_sconv(r1, t, SEQ, b0, b1, b2, bb);
      z.y = hy_sconv(r2, t + 1, SEQ, c0, c1, c2, cbb) * hy_sconv(r1, t + 1, SEQ, b0, b1, b2, bb);
    }
    s[m] = z;
  }
  __syncthreads();
  fft_fwd(s, p.tw());
  const float4* hs = p.hspec() + ((size_t)layer * 256 + ch) * HSP;
  for (int k = tid; k <= FM / 2; k += NTHR) {
    const int pk = rev7(k), pm = rev7((FM - k) & (FM - 1));
    const float2 zk = s[pk], zm = s[pm];
    const float4 h = hs[k];
    const float2 He = make_float2(h.x, h.y), Ho = make_float2(h.z, h.w);
    const float2 Xe = make_float2(0.5f * (zk.x + zm.x), 0.5f * (zk.y - zm.y));
    const float2 Xo = make_float2(0.5f * (zk.y + zm.y), -0.5f * (zk.x - zm.x));
    const float2 t1 = cmul(p.tw()[k], cmul(Xo, Ho));
    const float2 e1 = cmul(Xe, He);
    const float2 Ye = make_float2(e1.x + t1.x, e1.y + t1.y);
    const float2 o1 = cmul(Xe, Ho), o2 = cmul(Xo, He);
    const float2 Yo = make_float2(o1.x + o2.x, o1.y + o2.y);
    s[pk] = make_float2(Ye.x - Yo.y, Ye.y + Yo.x);
    if (pm != pk) s[pm] = make_float2(Ye.x + Yo.y, -Ye.y + Yo.x);
  }
  __syncthreads();
  fft_inv(s, p.tw());
  const float hb = p.hy_bias[layer * 256 + ch];
  float* orow = p.hyo() + (size_t)ch * TT + (size_t)b * SEQ;
  for (int m = tid; m < SEQ / 2; m += NTHR) {
    const int t = 2 * m;
    const float2 y = s[m];
    const float vg0 = hy_sconv(r2, t, SEQ, c0, c1, c2, cbb) * hy_sconv(r1, t, SEQ, b0, b1, b2, bb);
    const float vg1 = hy_sconv(r2, t + 1, SEQ, c0, c1, c2, cbb) * hy_sconv(r1, t + 1, SEQ, b0, b1, b2, bb);
    const float x00 = hy_sconv(r0, t, SEQ, a0, a1, a2, ab), x01 = hy_sconv(r0, t + 1, SEQ, a0, a1, a2, ab);
    *(float2*)(orow + t) = make_float2((y.x + vg0 * hb) * x00, (y.y + vg1 * hb) * x01);
  }
  __syncthreads();
}
__device__ __forceinline__ void fnet_item(const Params& p, int b, int j, char* lds) {
  float2* s = (float2*)lds;
  const int tid = ltid();
  const float* rr = p.zt() + (size_t)(ZT_FR + j) * TT + (size_t)b * SEQ;
  const float* ri = p.zt() + (size_t)(ZT_FI + j) * TT + (size_t)b * SEQ;
  for (int m = tid; m < FM; m += NTHR) s[m] = make_float2(rr[m], ri[m]);
  __syncthreads();
  fft_fwd(s, p.tw());
  float* orow = p.fno() + (size_t)j * TT + (size_t)b * SEQ;
  for (int k = tid; k < FM; k += NTHR) orow[k] = s[rev7(k)].x * (1.f / 128.f);
  __syncthreads();
}
__device__ __forceinline__ void hyena_ctx_item(const Params& p, int b, int ch, char* lds) {
  float* vg = (float*)lds;
  float* x0 = vg + 256;
  float* hf = x0 + 256;
  float* hbk = hf + 256;
  const int tid = ltid();
  const float* cw = p.hy_conv_w; const float* cb = p.hy_conv_b;
  const size_t off = (size_t)TL + (size_t)b * LC;
  const float* r0 = p.zt() + (size_t)(ZT_HY + ch) * TT + off;
  const float* r1 = p.zt() + (size_t)(ZT_HY + 256 + ch) * TT + off;
  const float* r2 = p.zt() + (size_t)(ZT_HY + 512 + ch) * TT + off;
  if (tid < 256) {
    const int t = tid;
    vg[t] = hy_sconv(r2, t, LC, cw[512 + ch], cw[768 + 512 + ch], cw[1536 + 512 + ch], cb[512 + ch]) *
            hy_sconv(r1, t, LC, cw[256 + ch], cw[768 + 256 + ch], cw[1536 + 256 + ch], cb[256 + ch]);
    x0[t] = hy_sconv(r0, t, LC, cw[ch], cw[768 + ch], cw[1536 + ch], cb[ch]);
    hf[t] = p.hfc()[(size_t)ch * LC + t]; hbk[t] = p.hfc()[(size_t)(256 + ch) * LC + t];
  }
  __syncthreads();
  if (tid < 256) {
    const int t = tid; float y = 0;
    for (int q = 0; q <= t; ++q) y += hf[t - q] * vg[q];
    for (int q = t + 1; q < LC; ++q) y += hbk[q - t] * vg[q];
    y *= rsqrtf(p.hssq()[512 + ch]);
    p.hyo()[(size_t)ch * TT + off + t] = (y + vg[t] * p.hy_bias[ch]) * x0[t];
  }
  __syncthreads();
}
__device__ __forceinline__ void fnet_ctx_item(const Params& p, int b, int j, char* lds) {
  float* ur = (float*)lds; float* ui = ur + 256; float* cst = ui + 256; float* snt = cst + 256;
  const int tid = ltid();
  const size_t off = (size_t)TL + (size_t)b * LC;
  if (tid < 256) {
    ur[tid] = p.zt()[(size_t)(ZT_FR + j) * TT + off + tid]; ui[tid] = p.zt()[(size_t)(ZT_FI + j) * TT + off + tid];
    float sn, cs; sincospif((float)tid / 128.f, &sn, &cs); cst[tid] = cs; snt[tid] = sn;
  }
  __syncthreads();
  if (tid < 256) {
    const int k = tid; float y = 0;
    for (int l = 0; l < 256; ++l) { const int m = (l * k) & 255; y += cst[m] * ur[l] + snt[m] * ui[l]; }
    p.fno()[(size_t)j * TT + off + k] = y * 0.0625f;
  }
  __syncthreads();
}
__device__ __forceinline__ void phase_fftmix(const Params& p, int layer, int bid, int nb, char* lds) {
  const int nitems = layer == 0 ? 2048 : 1024;
  for (int it = bid; it < nitems; it += nb) {
    const int k = it & 511, b = k >> 8, c = k & 255;
    if (it < 512) hyena_item(p, layer, b, c, lds);
    else if (it < 1024) fnet_item(p, b, c, lds);
    else if (it < 1536) hyena_ctx_item(p, b, c, lds);
    else fnet_ctx_item(p, b, c, lds);
  }
}
constexpr int GLG = 17, NGRP = 16;
__device__ __forceinline__ int gla_chain_tok(int dir, int b, int n, int i) {
  const int base = n < 4 ? TL + b * LC : b * SEQ, len = n < 4 ? LC : SEQ, m = n < 4 ? n : n - 4;
  return dir == 0 ? base + 64 * m + i : base + (len - 1) - (64 * m + i);
}
__device__ __forceinline__ float logsig16(float x) { return (fminf(x, 0.f) - log1pf(__expf(-fabsf(x)))) * (1.f / 16.f); }
__device__ __forceinline__ float wave_scan_incl(float v, int lane) {
#pragma unroll
  for (int o = 1; o < 64; o <<= 1) { const float t = __shfl_up(v, o, 64); if (lane >= o) v += t; }
  return v;
}
__device__ __forceinline__ void phase_gla_a(const Params& p, int layer, int bid, int nb, char* lds) {
  float* kl = (float*)lds;
  float* gl = kl + 64 * 33;
  float* vl = gl + 64 * 33;
  const int tid = ltid(), wid = tid >> 6, lane = tid & 63;
  const float* gb = p.gla_gk_b + (size_t)layer * 256;
  for (int it = bid; it < 16 * NGRP; it += nb) {
    const int chain = it >> 4, g = it & 15, dir = chain >> 3, b = (chain >> 2) & 1, h = chain & 3;
    const int n0 = g * GLG, n1 = min(n0 + GLG, NCH);
    const int kk = tid >> 4, v0 = (tid & 15) * 4;
    float st[4] = {0.f, 0.f, 0.f, 0.f}; float dcum = 1.f;
    for (int n = n0; n < n1; ++n) {
      {
        const int i = tid >> 3, c4 = (tid & 7) * 4;
        const float* zr = p.zg() + (size_t)gla_chain_tok(dir, b, n, i) * ZG_W;
        const float4 k4 = *(const float4*)(zr + ZG_GK + h * 32 + c4);
        const float4 g4 = *(const float4*)(zr + ZG_GP + dir * 128 + h * 32 + c4);
        const float4 bb = *(const float4*)(gb + dir * 128 + h * 32 + c4);
        const float4 va = *(const float4*)(zr + ZG_GV + h * 64 + c4 * 2), vb = *(const float4*)(zr + ZG_GV + h * 64 + c4 * 2 + 4);
        kl[i * 33 + c4] = k4.x; kl[i * 33 + c4 + 1] = k4.y; kl[i * 33 + c4 + 2] = k4.z; kl[i * 33 + c4 + 3] = k4.w;
        gl[i * 33 + c4] = logsig16(g4.x + bb.x); gl[i * 33 + c4 + 1] = logsig16(g4.y + bb.y); gl[i * 33 + c4 + 2] = logsig16(g4.z + bb.z); gl[i * 33 + c4 + 3] = logsig16(g4.w + bb.w);
        *(float4*)(vl + i * 68 + c4 * 2) = va; *(float4*)(vl + i * 68 + c4 * 2 + 4) = vb;
      }
      __syncthreads();
#pragma unroll
      for (int q = 0; q < 4; ++q) { const int c = wid * 4 + q; gl[lane * 33 + c] = wave_scan_incl(gl[lane * 33 + c], lane); }
      __syncthreads();
      {
        float* lp = p.gds() + ((size_t)chain * NCH + n) * 2048 + kk * 64 + v0;
        *(float4*)lp = make_float4(st[0], st[1], st[2], st[3]);
        if ((tid & 15) == 0) p.gdv()[((size_t)chain * NCH + n) * 32 + kk] = dcum;
        const float bl = gl[63 * 33 + kk];
        float acc[4] = {0.f, 0.f, 0.f, 0.f};
#pragma unroll 8
        for (int i = 0; i < 64; ++i) {
          const float w = kl[i * 33 + kk] * __expf(bl - gl[i * 33 + kk]);
          const float4 vv = *(const float4*)(vl + i * 68 + v0);
          acc[0] += w * vv.x; acc[1] += w * vv.y; acc[2] += w * vv.z; acc[3] += w * vv.w;
        }
        const float d = __expf(bl);
#pragma unroll
        for (int j = 0; j < 4; ++j) st[j] = st[j] * d + acc[j];
        dcum *= d;
      }
      __syncthreads();
    }
    float* at = p.gst() + ((size_t)chain * NGRP + g) * 2048 + kk * 64 + v0;
    *(float4*)at = make_float4(st[0], st[1], st[2], st[3]);
    if ((tid & 15) == 0) p.gst()[(size_t)16 * NGRP * 2048 + ((size_t)chain * NGRP + g) * 32 + kk] = dcum;
  }
}

constexpr int GC_QP = 33792, GC_KP = GC_QP + 10240, GC_VT = GC_KP + 10240, GC_ST = GC_VT + 18432, GC_AX = GC_ST + 10240;
__device__ __forceinline__ void phase_gla_c(const Params& p, int layer, int bid, int nb, char* lds) {
  float* gl = (float*)lds;
  float* qraw = gl + 2 * 64 * 33;
  float* kraw = qraw + 64 * 33;
  float* Of = (float*)lds;
  char* Qp = lds + GC_QP;
  char* Kp = lds + GC_KP;
  char* VT = lds + GC_VT;
  char* ST = lds + GC_ST;
  const int tid = ltid(), wid = tid >> 6, lane = tid & 63, r32 = lane & 31, hi = lane >> 5;
  char* Ax = lds + GC_AX + wid * 4608;
  const float* gb = p.gla_gk_b + (size_t)layer * 256;
  const int pc_lo = layer == 0 ? 0 : 4, npc = NCH - pc_lo, nitem = 8 * npc;
  const int per = (nitem + nb - 1) / nb, q_beg = bid * per, q_end = min(nitem, q_beg + per);
  const int sdir = tid >> 8, sk = (tid >> 3) & 31, sv0 = (tid & 7) * 8;
  float G[8]; int g_cached = -1, bh_cached = -1;
  for (int qi = q_beg; qi < q_end; ++qi) {
    const int bh = qi / npc, pc = pc_lo + qi % npc, b = bh >> 2, h = bh & 3;
    const int tok0 = pc < 4 ? TL + b * LC + pc * 64 : b * SEQ + (pc - 4) * 64;
    {
      const int pos = tid >> 3, c4 = (tid & 7) * 4;
      const float* zr = p.zg() + (size_t)(tok0 + pos) * ZG_W;
      const float4 q4 = *(const float4*)(zr + ZG_GQ + h * 32 + c4), k4 = *(const float4*)(zr + ZG_GK + h * 32 + c4);
      const float sc = 0.17677669529663687f;
      qraw[pos * 33 + c4] = q4.x * sc; qraw[pos * 33 + c4 + 1] = q4.y * sc; qraw[pos * 33 + c4 + 2] = q4.z * sc; qraw[pos * 33 + c4 + 3] = q4.w * sc;
      kraw[pos * 33 + c4] = k4.x; kraw[pos * 33 + c4 + 1] = k4.y; kraw[pos * 33 + c4 + 2] = k4.z; kraw[pos * 33 + c4 + 3] = k4.w;
#pragma unroll
      for (int d = 0; d < 2; ++d) {
        const float4 g4 = *(const float4*)(zr + ZG_GP + d * 128 + h * 32 + c4), bb = *(const float4*)(gb + d * 128 + h * 32 + c4);
        const int i = d ? 63 - pos : pos;
        float* gd = gl + (d * 64 + i) * 33 + c4;
        gd[0] = logsig16(g4.x + bb.x); gd[1] = logsig16(g4.y + bb.y); gd[2] = logsig16(g4.z + bb.z); gd[3] = logsig16(g4.w + bb.w);
      }
      const float4 va = *(const float4*)(zr + ZG_GV + h * 64 + c4 * 2), vb = *(const float4*)(zr + ZG_GV + h * 64 + c4 * 2 + 4);
      const float vv[8] = {va.x, va.y, va.z, va.w, vb.x, vb.y, vb.z, vb.w};
#pragma unroll
      for (int j = 0; j < 8; ++j) {
        const u16 hv = f2bf(vv[j]); const int v = c4 * 2 + j;
        *(u16*)(VT + (0 * 64 + v) * 144 + pos * 2) = hv; *(u16*)(VT + (1 * 64 + v) * 144 + (63 - pos) * 2) = hv;
      }
    }
    __syncthreads();
#pragma unroll
    for (int q = 0; q < 8; ++q) { const int col = wid * 8 + q, d = col >> 5, c = col & 31; float* gp = gl + (d * 64 + lane) * 33 + c; *gp = wave_scan_incl(*gp, lane); }
    __syncthreads();
    {
#pragma unroll
      for (int e = 0; e < 2; ++e) {
        const int idx = tid + e * 512, d = idx >> 9, i = (idx >> 3) & 63, c4 = (idx & 7) * 4, pos = d ? 63 - i : i;
        float qo[4], ko[4];
#pragma unroll
        for (int j = 0; j < 4; ++j) {
          const float bi = gl[(d * 64 + i) * 33 + c4 + j], bm = gl[(d * 64 + 31) * 33 + c4 + j];
          qo[j] = qraw[pos * 33 + c4 + j] * __expf(bi - bm); ko[j] = kraw[pos * 33 + c4 + j] * __expf(bm - bi);
        }
        *(u32x2*)(Qp + (d * 64 + i) * 80 + c4 * 2) = u32x2{cvtpk(qo[0], qo[1]), cvtpk(qo[2], qo[3])};
        *(u32x2*)(Kp + (d * 64 + i) * 80 + c4 * 2) = u32x2{cvtpk(ko[0], ko[1]), cvtpk(ko[2], ko[3])};
      }
      const int chain = sdir * 8 + b * 4 + h;
      const int n = sdir == 0 ? pc : (pc < 4 ? 3 - pc : 4 + 255 - (pc - 4)), g = n / GLG;
      if (g != g_cached || bh != bh_cached) {
#pragma unroll
        for (int j = 0; j < 8; ++j) G[j] = 0.f;
        const float* at = p.gst() + (size_t)chain * NGRP * 2048 + sk * 64 + sv0;
        const float* dt = p.gst() + (size_t)16 * NGRP * 2048 + (size_t)chain * NGRP * 32 + sk;
        for (int gg = 0; gg < g; ++gg) {
          const float4 a0 = *(const float4*)(at + (size_t)gg * 2048), a1 = *(const float4*)(at + (size_t)gg * 2048 + 4); const float dd = dt[gg * 32];
          G[0] = G[0] * dd + a0.x; G[1] = G[1] * dd + a0.y; G[2] = G[2] * dd + a0.z; G[3] = G[3] * dd + a0.w;
          G[4] = G[4] * dd + a1.x; G[5] = G[5] * dd + a1.y; G[6] = G[6] * dd + a1.z; G[7] = G[7] * dd + a1.w;
        }
        g_cached = g; bh_cached = bh;
      }
      const float* lp = p.gds() + ((size_t)chain * NCH + n) * 2048 + sk * 64 + sv0;
      const float4 l0 = *(const float4*)lp, l1 = *(const float4*)(lp + 4);
      const float dp = p.gdv()[((size_t)chain * NCH + n) * 32 + sk];
      const float em = __expf(gl[(sdir * 64 + 31) * 33 + sk]);
      const float sv[8] = {l0.x + dp * G[0], l0.y + dp * G[1], l0.z + dp * G[2], l0.w + dp * G[3], l1.x + dp * G[4], l1.y + dp * G[5], l1.z + dp * G[6], l1.w + dp * G[7]};
#pragma unroll
      for (int j = 0; j < 8; ++j) *(u16*)(ST + (sdir * 64 + sv0 + j) * 80 + sk * 2) = f2bf(sv[j] * em);
    }
    __syncthreads();
    {
      const int d = wid >> 2, ib = (wid >> 1) & 1, vb = wid & 1;
      const char* Qd = Qp + d * 64 * 80; const char* Kd = Kp + d * 64 * 80; const char* Vd = VT + d * 64 * 144; const char* Sd = ST + d * 64 * 80;
      bf16x8 qf[2];
#pragma unroll
      for (int s2 = 0; s2 < 2; ++s2) qf[s2] = *(const bf16x8*)(Qd + (ib * 32 + r32) * 80 + (16 * s2 + 8 * hi) * 2);
#pragma unroll
      for (int jb = 0; jb < 2; ++jb) {
        if (jb <= ib) {
          f32x16 x = {};
#pragma unroll
          for (int s2 = 0; s2 < 2; ++s2) {
            const bf16x8 kf = *(const bf16x8*)(Kd + (jb * 32 + r32) * 80 + (16 * s2 + 8 * hi) * 2);
            x = __builtin_amdgcn_mfma_f32_32x32x16_bf16(qf[s2], kf, x, 0, 0, 0);
          }
#pragma unroll
          for (int r = 0; r < 16; ++r) {
            const int il = crow(r, hi), i = ib * 32 + il, j = jb * 32 + r32;
            *(u16*)(Ax + il * 144 + j * 2) = f2bf(j <= i ? x[r] : 0.f);
          }
        }
      }
      asm volatile("s_waitcnt lgkmcnt(0)" ::: "memory");
      f32x16 o = {};
#pragma unroll
      for (int s4 = 0; s4 < 4; ++s4) {
        if (s4 < 2 * (ib + 1)) {
          const bf16x8 af = *(const bf16x8*)(Ax + r32 * 144 + (16 * s4 + 8 * hi) * 2);
          const bf16x8 vf = *(const bf16x8*)(Vd + (vb * 32 + r32) * 144 + (16 * s4 + 8 * hi) * 2);
          o = __builtin_amdgcn_mfma_f32_32x32x16_bf16(af, vf, o, 0, 0, 0);
        }
      }
#pragma unroll
      for (int s2 = 0; s2 < 2; ++s2) {
        const bf16x8 sf = *(const bf16x8*)(Sd + (vb * 32 + r32) * 80 + (16 * s2 + 8 * hi) * 2);
        o = __builtin_amdgcn_mfma_f32_32x32x16_bf16(qf[s2], sf, o, 0, 0, 0);
      }
#pragma unroll
      for (int r = 0; r < 16; ++r) {
        const int i = ib * 32 + crow(r, hi), pos = d ? 63 - i : i;
        Of[(d * 64 + pos) * 65 + vb * 32 + r32] = o[r];
      }
    }
    __syncthreads();
    {
      const int pos = tid >> 3, v0 = (tid & 7) * 8;
      float* op = p.glao() + (size_t)(tok0 + pos) * 256 + h * 64 + v0;
      float r8[8];
#pragma unroll
      for (int j = 0; j < 8; ++j) r8[j] = Of[pos * 65 + v0 + j] + Of[(64 + pos) * 65 + v0 + j];
      *(float4*)op = make_float4(r8[0], r8[1], r8[2], r8[3]); *(float4*)(op + 4) = make_float4(r8[4], r8[5], r8[6], r8[7]);
    }
    __syncthreads();
  }
}

__device__ __forceinline__ void phase_mix(const Params& p, int layer, int bid, int nb, char* lds) {
  float* part = (float*)lds;
  u16* tile = (u16*)(lds + 4096);
  const int tid = ltid(), wid = tid >> 6, lane = tid & 63;
  const int ntok = layer == 0 ? TT : TL;
  for (int it = bid; it < ntok / 64; it += nb) {
    const int tok0 = it * 64;
    float vh[32], vf[32]; float sh = 0, sf = 0;
#pragma unroll
    for (int c = 0; c < 32; ++c) {
      vh[c] = p.hyo()[(size_t)(wid * 32 + c) * TT + tok0 + lane]; vf[c] = p.fno()[(size_t)(wid * 32 + c) * TT + tok0 + lane];
      sh += vh[c] * vh[c]; sf += vf[c] * vf[c];
    }
    part[(0 * 8 + wid) * 64 + lane] = sh; part[(1 * 8 + wid) * 64 + lane] = sf;
    __syncthreads();
    float th = 0, tf = 0;
#pragma unroll
    for (int q = 0; q < 8; ++q) { th += part[(0 * 8 + q) * 64 + lane]; tf += part[(1 * 8 + q) * 64 + lane]; }
    const float rh = rsqrtf(th * (1.f / 256.f) + EPS), rf = rsqrtf(tf * (1.f / 256.f) + EPS);
#pragma unroll
    for (int c = 0; c < 32; ++c) { tile[lane * 520 + wid * 32 + c] = f2bf(vh[c] * rh); tile[lane * 520 + 256 + wid * 32 + c] = f2bf(vf[c] * rf); }
    __syncthreads();
    for (int g = tid; g < 64 * 64; g += NTHR) {
      const int tl = g >> 6, cg = g & 63;
      const u32x4 w = *(const u32x4*)(tile + tl * 520 + cg * 8);
      *(u32x4*)(p.ymix() + (size_t)(tok0 + tl) * DM + (cg < 32 ? 256 + cg * 8 : 768 + (cg - 32) * 8)) = w;
    }
    for (int tl = wid * 8; tl < wid * 8 + 8; ++tl) {
      const int tok = tok0 + tl;
      const float4 o = *(const float4*)(p.glao() + (size_t)tok * 256 + lane * 4);
      float ss = o.x * o.x + o.y * o.y + o.z * o.z + o.w * o.w;
#pragma unroll
      for (int off = 8; off > 0; off >>= 1) ss += __shfl_xor(ss, off, 64);
      const float rs = rsqrtf(ss * (1.f / 64.f) + EPS);
      const float4 g = *(const float4*)(p.zg() + (size_t)tok * ZG_W + ZG_OG + lane * 4);
      u32x2 w; w[0] = cvtpk(o.x * rs * silu_f(g.x), o.y * rs * silu_f(g.y)); w[1] = cvtpk(o.z * rs * silu_f(g.z), o.w * rs * silu_f(g.w));
      *(u32x2*)(p.ymix() + (size_t)tok * DM + 512 + lane * 4) = w;
    }
    __syncthreads();
  }
}

struct EpiOut {
  const Params* pp; int layer;
  __device__ __forceinline__ void operator()(const f32x4 (&acc)[2][2][4][2], const G8Unit& u, int wr, int wc, int fr, int fq) const {
    const Params& p = *pp;
    const float* g1 = p.mod() + ((size_t)layer * 3 + modv(u.pm * 256)) * 6144 + 2 * DM;
#pragma unroll
    for (int bj = 0; bj < 2; ++bj) {
      const int c0 = u.pn * 256 + bj * 128 + wc * 32 + 8 * fq;
      const f32x4 ga = *(const f32x4*)(g1 + c0), gb = *(const f32x4*)(g1 + c0 + 4);
#pragma unroll
      for (int ai = 0; ai < 2; ++ai)
#pragma unroll
        for (int m = 0; m < 4; ++m) {
          const int tok = u.pm * 256 + ai * 128 + wr * 64 + m * 16 + fr;
          const float* xr = resid_row(p, layer == 0 ? 0 : 1, tok) + c0;
          float* xo = p.X() + (size_t)tok * DM + c0;
          const f32x4 xa = *(const f32x4*)xr, xb = *(const f32x4*)(xr + 4);
          *(f32x4*)xo = xa + ga * acc[ai][bj][m][0]; *(f32x4*)(xo + 4) = xb + gb * acc[ai][bj][m][1];
        }
    }
  }
};
__device__ __forceinline__ void phase_gemm_out(const Params& p, int layer, int bid, int nb, char* lds) {
  G8Plain S; S.nM = (layer == 0 ? TT : TL) / 256; S.nN = DM / 256; S.K = DM; S.G = nb; S.c = bid; S.Bt = (const char*)(p.bt_out() + (size_t)layer * DM * DM);
  EpiOut E; E.pp = &p; E.layer = layer;
  gemm8_phase(lds, (const char*)p.ymix(), DM, S, E);
}

__device__ __forceinline__ void phase_norm2_router(const Params& p, int layer, int bid, int nb, char* lds) {
  float* rwl = (float*)lds;
  int* lcnt = (int*)(lds + 131072);
  int* lbase = lcnt + 32;
  int* ent = lbase + 32;
  float* entw = (float*)(ent + 2 * 1024);
  const int tid = ltid(), wid = tid >> 6, lane = tid & 63;
  const int ntok = layer == 0 ? TT : TL;
  const float* rw = p.router_w + (size_t)layer * DM * NE;
  for (int i = tid; i < DM * NE / 4; i += NTHR) {
    const int k = i >> 3, q4 = i & 7;
    ((float4*)rwl)[q4 * 1024 + ((k & 3) * 256 + (k >> 2))] = ((const float4*)rw)[i];
  }
  if (tid < 32) lcnt[tid] = 0;
  __syncthreads();
  const float* gn = p.norm2_g + layer * DM; const float* rb = p.router_b + layer * NE;
  const int per = (ntok + nb - 1) / nb, t_beg = bid * per, t_end = min(ntok, t_beg + per);
  for (int tok = t_beg + wid; tok < t_end; tok += 8) {
    const float* xr = p.X() + (size_t)tok * DM;
    float v[16];
#pragma unroll
    for (int i = 0; i < 4; ++i) { const float4 a = *(const float4*)(xr + lane * 4 + i * 256); v[4 * i] = a.x; v[4 * i + 1] = a.y; v[4 * i + 2] = a.z; v[4 * i + 3] = a.w; }
    float ss = 0;
#pragma unroll
    for (int i = 0; i < 16; ++i) ss += v[i] * v[i];
    ss = wave_sum(ss);
    const float rs = rsqrtf(ss * (1.f / DM) + EPS);
    const float* md = p.mod() + ((size_t)layer * 3 + modv(tok)) * 6144 + 3 * DM;
    u16* h = p.H() + (size_t)tok * DM;
#pragma unroll
    for (int i = 0; i < 4; ++i) {
      const int c = lane * 4 + i * 256;
      const float4 g = *(const float4*)(gn + c), sh = *(const float4*)(md + c), sc = *(const float4*)(md + DM + c);
      v[4 * i] = v[4 * i] * rs * g.x * (1.f + sc.x) + sh.x; v[4 * i + 1] = v[4 * i + 1] * rs * g.y * (1.f + sc.y) + sh.y;
      v[4 * i + 2] = v[4 * i + 2] * rs * g.z * (1.f + sc.z) + sh.z; v[4 * i + 3] = v[4 * i + 3] * rs * g.w * (1.f + sc.w) + sh.w;
      u32x2 w; w[0] = cvtpk(v[4 * i], v[4 * i + 1]); w[1] = cvtpk(v[4 * i + 2], v[4 * i + 3]);
      *(u32x2*)(h + c) = w;
    }
    float lg[32];
#pragma unroll
    for (int e = 0; e < 32; ++e) lg[e] = 0.f;
#pragma unroll
    for (int i = 0; i < 16; ++i) {
      const float4* wr4 = (const float4*)rwl + ((i & 3) * 256 + (i >> 2) * 64 + lane);
#pragma unroll
      for (int q = 0; q < 8; ++q) { const float4 w = wr4[q * 1024]; lg[4 * q] += v[i] * w.x; lg[4 * q + 1] += v[i] * w.y; lg[4 * q + 2] += v[i] * w.z; lg[4 * q + 3] += v[i] * w.w; }
    }
    float r16[16], r8[8], r4[4], r2[2], lv;
    { const bool up = lane & 32;
#pragma unroll
      for (int e = 0; e < 16; ++e) { const float keep = up ? lg[16 + e] : lg[e], send = up ? lg[e] : lg[16 + e]; r16[e] = keep + __shfl_xor(send, 32, 64); } }
    { const bool up = lane & 16;
#pragma unroll
      for (int e = 0; e < 8; ++e) { const float keep = up ? r16[8 + e] : r16[e], send = up ? r16[e] : r16[8 + e]; r8[e] = keep + __shfl_xor(send, 16, 64); } }
    { const bool up = lane & 8;
#pragma unroll
      for (int e = 0; e < 4; ++e) { const float keep = up ? r8[4 + e] : r8[e], send = up ? r8[e] : r8[4 + e]; r4[e] = keep + __shfl_xor(send, 8, 64); } }
    { const bool up = lane & 4;
#pragma unroll
      for (int e = 0; e < 2; ++e) { const float keep = up ? r4[2 + e] : r4[e], send = up ? r4[e] : r4[2 + e]; r2[e] = keep + __shfl_xor(send, 4, 64); } }
    { const bool up = lane & 2; const float keep = up ? r2[1] : r2[0], send = up ? r2[0] : r2[1]; lv = keep + __shfl_xor(send, 2, 64); }
    lv += __shfl_xor(lv, 1, 64);
    lv += rb[lane >> 1];
    int ids[4]; float vals[4];
#pragma unroll
    for (int k = 0; k < 4; ++k) {
      float mx = lv;
#pragma unroll
      for (int o = 32; o > 0; o >>= 1) mx = fmaxf(mx, __shfl_xor(mx, o, 64));
      const unsigned long long bal = __ballot(lv == mx);
      const int win = __ffsll((long long)bal) - 1;
      ids[k] = win >> 1; vals[k] = mx;
      if ((lane >> 1) == ids[k]) lv = -3.4e38f;
    }
    if (lane == 0) {
      const float mx = vals[0];
      float ex[4], sum = 0;
#pragma unroll
      for (int k = 0; k < 4; ++k) { ex[k] = __expf(vals[k] - mx); sum += ex[k]; }
      const float inv = 1.f / sum;
#pragma unroll
      for (int k = 0; k < 4; ++k) {
        const int lp = atomicAdd(&lcnt[ids[k]], 1);
        const int slot = (tok - t_beg) * 4 + k;
        ent[2 * slot] = tok * 4 + k; ent[2 * slot + 1] = (ids[k] << 20) | lp; entw[slot] = ex[k] * inv;
      }
    }
  }
  __syncthreads();
  if (tid < 32) lbase[tid] = atomicAdd(&p.cnt()[layer * NE + tid], lcnt[tid]);
  __syncthreads();
  const int nas = (t_end > t_beg ? (t_end - t_beg) : 0) * 4;
  for (int s = tid; s < nas; s += NTHR) {
    const int tk = ent[2 * s], el = ent[2 * s + 1], e = el >> 20, pos = lbase[e] + (el & 0xFFFFF);
    p.rtok()[(size_t)e * TT + pos] = tk >> 2; p.rw()[(size_t)e * TT + pos] = entw[s];
    p.tslot()[tk] = (e << 20) | pos;
  }
}

struct G8Moe {
  const int* cnt;
  int ntn, K, G, c; const char* Bt; size_t bstride;
  const int* rtok;
  __device__ __forceinline__ bool next(int i, G8Unit& u) const {
    const int w = (i * 8 + (c & 7)) * (G >> 3) + (c >> 3); int acc = 0, rows = 0;
    for (int ee = 0; ee < NE; ++ee) {
      const int cc = cnt[ee], tiles = ((cc + 255) >> 8) * ntn;
      if (w < acc + tiles) { const int r = w - acc; u.e = ee; u.pm = r / ntn; u.pn = r % ntn; u.ce = cc; u.pre = rows; return true; }
      acc += tiles; rows += cc;
    }
    return false;
  }
  __device__ __forceinline__ unsigned a_off(const G8Unit& u, int row) const {
    const int r = min(u.pm * 256 + row, u.ce - 1);
    const int arow = rtok ? rtok[(size_t)u.e * TT + r] : u.pre + r;
    return (unsigned)arow * (unsigned)(K * 2);
  }
  __device__ __forceinline__ const char* b_ptr(const G8Unit& u) const { return Bt + (size_t)u.e * bstride + (size_t)u.pn * 256 * K * 2; }
};
struct EpiGu {
  const float* bgl; u16* act;
  __device__ __forceinline__ void operator()(const f32x4 (&acc)[2][2][4][2], const G8Unit& u, int wr, int wc, int fr, int fq) const {
    const int j0 = u.pn * 128 + wc * 32 + 8 * fq;
    const float* bg = bgl + (size_t)u.e * 2048 + 2 * j0;
    float bgt[8], bup[8];
#pragma unroll
    for (int q = 0; q < 4; ++q) { const f32x4 t = *(const f32x4*)(bg + 4 * q); bgt[2 * q] = t[0]; bup[2 * q] = t[1]; bgt[2 * q + 1] = t[2]; bup[2 * q + 1] = t[3]; }
#pragma unroll
    for (int ai = 0; ai < 2; ++ai)
#pragma unroll
      for (int m = 0; m < 4; ++m) {
        const int r = u.pm * 256 + ai * 128 + wr * 64 + m * 16 + fr;
        if (r < u.ce) {
          float o[8];
#pragma unroll
          for (int n = 0; n < 2; ++n)
#pragma unroll
            for (int j = 0; j < 4; ++j) {
              const float gate = fminf(acc[ai][0][m][n][j] + bgt[4 * n + j], 7.f);
              const float up = fminf(fmaxf(acc[ai][1][m][n][j] + bup[4 * n + j], -7.f), 7.f);
              o[4 * n + j] = (up + 1.f) * gate * __builtin_amdgcn_rcpf(1.f + __expf(-1.702f * gate));
            }
          *(u32x4*)(act + (size_t)(u.pre + r) * DFF + j0) = u32x4{cvtpk(o[0], o[1]), cvtpk(o[2], o[3]), cvtpk(o[4], o[5]), cvtpk(o[6], o[7])};
        }
      }
  }
};
struct EpiDn {
  const float* bdl; const float* rw; u16* yd;
  __device__ __forceinline__ void operator()(const f32x4 (&acc)[2][2][4][2], const G8Unit& u, int wr, int wc, int fr, int fq) const {
#pragma unroll
    for (int bj = 0; bj < 2; ++bj) {
      const int c0 = u.pn * 256 + bj * 128 + wc * 32 + 8 * fq;
      const f32x4 ba = *(const f32x4*)(bdl + (size_t)u.e * DM + c0), bb = *(const f32x4*)(bdl + (size_t)u.e * DM + c0 + 4);
#pragma unroll
      for (int ai = 0; ai < 2; ++ai)
#pragma unroll
        for (int m = 0; m < 4; ++m) {
          const int r = u.pm * 256 + ai * 128 + wr * 64 + m * 16 + fr;
          if (r < u.ce) {
            const float wgt = rw[(size_t)u.e * TT + r];
            const f32x4 a = (acc[ai][bj][m][0] + ba) * wgt, b = (acc[ai][bj][m][1] + bb) * wgt;
            *(u32x4*)(yd + (size_t)(u.pre + r) * DM + c0) = u32x4{cvtpk(a[0], a[1]), cvtpk(a[2], a[3]), cvtpk(b[0], b[1]), cvtpk(b[2], b[3])};
          }
        }
    }
  }
};
__device__ __forceinline__ void phase_moe_gu(const Params& p, int layer, int bid, int nb, char* lds) {
  int* scnt = (int*)(lds + 131072);
  if (ltid() < NE) scnt[ltid()] = p.cnt()[layer * NE + ltid()];
  __syncthreads();
  G8Moe S; S.cnt = scnt; S.ntn = 8; S.K = DM; S.G = nb; S.c = bid; S.Bt = (const char*)(p.bt_gu() + (size_t)layer * NE * 2048 * DM); S.bstride = (size_t)2048 * DM * 2; S.rtok = p.rtok();
  EpiGu E; E.bgl = p.moe_b_gu + (size_t)layer * NE * 2048; E.act = p.act();
  gemm8_phase(lds, (const char*)p.H(), DM, S, E);
}
__device__ __forceinline__ void phase_moe_dn(const Params& p, int layer, int bid, int nb, char* lds) {
  int* scnt = (int*)(lds + 131072);
  if (ltid() < NE) scnt[ltid()] = p.cnt()[layer * NE + ltid()];
  __syncthreads();
  G8Moe S; S.cnt = scnt; S.ntn = 4; S.K = DFF; S.G = nb; S.c = bid; S.Bt = (const char*)(p.bt_dn() + (size_t)layer * NE * DM * DFF); S.bstride = (size_t)DM * DFF * 2; S.rtok = nullptr;
  EpiDn E; E.bdl = p.moe_b_down + (size_t)layer * NE * DM; E.rw = p.rw(); E.yd = p.yd();
  gemm8_phase(lds, (const char*)p.act(), DFF, S, E);
}

__device__ __forceinline__ void phase_final(const Params& p, int bid, int nb, char* lds) {
  int* pre = (int*)lds;
  expert_prefix(p.cnt() + NE, pre); __syncthreads();
  const int wid = ltid() >> 6, lane = ltid() & 63;
  for (int tok = bid * 8 + wid; tok < TL; tok += nb * 8) {
    float v[16];
    load_row_comb(p, 1, 1, tok, lane, pre, v);
    float ss = 0;
#pragma unroll
    for (int i = 0; i < 16; ++i) ss += v[i] * v[i];
    ss = wave_sum(ss);
    const float rs = rsqrtf(ss * (1.f / DM) + EPS);
    float* o = p.out + (size_t)tok * DM;
#pragma unroll
    for (int i = 0; i < 4; ++i) {
      const int c = lane * 4 + i * 256;
      const float4 g = *(const float4*)(p.final_g + c);
      *(float4*)(o + c) = make_float4(v[4 * i] * rs * g.x, v[4 * i + 1] * rs * g.y, v[4 * i + 2] * rs * g.z, v[4 * i + 3] * rs * g.w);
    }
  }
}

#define XB_TMO      128
#define XB_XCNT(j)  (256  + 64 * (j))
#define XB_XSUB(j)  (1280 + 64 * (j))
#define XB_XGEN(j)  (2304 + 64 * (j))
#define XB_TOP      3328
#define XB_TOPGEN   3392
#define XCD_BAR_WORDS 3456
#define XB_SPIN_CAP (1u << 18)
#define LAS __attribute__((address_space(3)))

__device__ __forceinline__ unsigned xb_ld(unsigned* p)              { return __hip_atomic_load(p, __ATOMIC_RELAXED, __HIP_MEMORY_SCOPE_AGENT); }
__device__ __forceinline__ unsigned xb_add(unsigned* p, unsigned v) { return __hip_atomic_fetch_add(p, v, __ATOMIC_RELAXED, __HIP_MEMORY_SCOPE_AGENT); }
__device__ __forceinline__ unsigned xb_xcc_id() { return (unsigned)__builtin_amdgcn_s_getreg((3 << 11) | 20) & 0xFu; }
#define XB_SPIN(cond, bar) do { unsigned _sp = 0; while (cond) { __builtin_amdgcn_s_sleep(1); \
    if ((++_sp & 255u) == 0u) { if (xb_ld(&(bar)[XB_TMO])) break; if (_sp > XB_SPIN_CAP) { atomicAdd(&(bar)[XB_TMO], 1u); break; } } } } while (0)

struct XcdBarrier {
    unsigned* bar; unsigned x;
    volatile LAS unsigned* st;
};

__device__ __forceinline__ XcdBarrier xcd_barrier_post(unsigned* bar, volatile LAS unsigned* st) {
    XcdBarrier b; b.bar = bar; b.x = xb_xcc_id(); b.st = st;
    if (threadIdx.x == 0) (void)xb_add(&bar[XB_XCNT(b.x)], 1u);
    return b;
}
__device__ __forceinline__ void xcd_barrier_complete(unsigned* bar, unsigned x, unsigned& nloc, unsigned& nx) {
    const unsigned G = gridDim.x * gridDim.y * gridDim.z;
    unsigned sum, cnt, mine, sp = 0u;
    for (;;) {
        sum = 0u; cnt = 0u; mine = 0u;
#pragma unroll
        for (unsigned j = 0; j < 16; ++j) { const unsigned c = xb_ld(&bar[XB_XCNT(j)]); sum += c; cnt += (c > 0u) ? 1u : 0u; mine = (j == x) ? c : mine; }
        if (sum == G) break;
        __builtin_amdgcn_s_sleep(1);
        if ((++sp & 255u) == 0u) { if (xb_ld(&bar[XB_TMO])) break; if (sp > XB_SPIN_CAP) { atomicAdd(&bar[XB_TMO], 1u); break; } }
    }
    nloc = mine > 0u ? mine : 1u; nx = cnt > 0u ? cnt : 1u;
}

__device__ __forceinline__ void xcd_barrier(const XcdBarrier& b) {
    asm volatile("s_waitcnt vmcnt(0)" ::: "memory");
    __syncthreads();
    if (threadIdx.x == 0) {
        unsigned* bar = b.bar;
        __builtin_amdgcn_s_waitcnt(0);
        unsigned nloc = b.st[0], nx = b.st[1];
        if (nloc == 0u) { xcd_barrier_complete(bar, b.x, nloc, nx); b.st[0] = nloc; b.st[1] = nx; }
        const unsigned old = xb_add(&bar[XB_XSUB(b.x)], 1u);
        const unsigned gen = old / nloc;
        if (old + 1u == (gen + 1u) * nloc) {
            __builtin_amdgcn_fence(__ATOMIC_RELEASE, "agent");
            asm volatile("s_waitcnt vmcnt(0)" ::: "memory");
            const unsigned og = xb_add(&bar[XB_TOP], 1u);
            const unsigned tg = og / nx;
            if (og + 1u == (tg + 1u) * nx) xb_add(&bar[XB_TOPGEN], 1u);
            else XB_SPIN(xb_ld(&bar[XB_TOPGEN]) == tg, bar);
            __builtin_amdgcn_fence(__ATOMIC_ACQUIRE, "agent");
            xb_add(&bar[XB_XGEN(b.x)], 1u);
            asm volatile("s_waitcnt vmcnt(0)" ::: "memory");
        } else {
            XB_SPIN(xb_ld(&bar[XB_XGEN(b.x)]) == gen, bar);
            __builtin_amdgcn_fence(__ATOMIC_ACQUIRE, "agent");
            asm volatile("s_waitcnt vmcnt(0)" ::: "memory");
        }
    }
    __syncthreads();
}

constexpr int LDS_MAIN = 147456;
constexpr int LDS_BYTES = LDS_MAIN + 1024;
enum { PH_TABLES = 0, PH_MOD, PH_FOLD, PH_CONVERT, PH_HYMLP, PH_HYFILT, PH_NORM1, PH_GEMM_IN, PH_QKV, PH_ATTN, PH_FFTMIX,
       PH_GLA_A, PH_GLA_B, PH_GLA_C, PH_MIX, PH_GEMM_OUT, PH_NORM2, PH_MOE_GU, PH_MOE_DN, PH_FINAL };

template <int PH>
__global__ void __launch_bounds__(NTHR, 2) k_phase(Params p, int layer) {
  extern __shared__ __attribute__((aligned(1024))) char lds[];
  const int bid = blockIdx.x, nb = gridDim.x;
  if constexpr (PH == PH_TABLES) phase_tables(p, bid, nb);
  else if constexpr (PH == PH_MOD) phase_mod(p, bid, nb, lds);
  else if constexpr (PH == PH_FOLD) phase_fold(p, bid, nb, lds);
  else if constexpr (PH == PH_CONVERT) phase_convert(p, bid, nb, lds);
  else if constexpr (PH == PH_HYMLP) {
    if (layer < 2) phase_hy_mlp(p, layer, SEQ, p.hfb() + (size_t)layer * 2 * 256 * SEQ, p.hssq() + layer * 256, bid, nb, lds);
    else phase_hy_mlp(p, 0, LC, p.hfc(), p.hssq() + 512, bid, nb, lds);
  }
  else if constexpr (PH == PH_HYFILT) phase_hy_filtfft(p, bid, nb, lds);
  else if constexpr (PH == PH_NORM1) phase_norm1(p, layer, bid, nb, lds);
  else if constexpr (PH == PH_GEMM_IN) phase_gemm_in(p, layer, bid, nb, lds);
  else if constexpr (PH == PH_QKV) phase_qkv(p, layer, bid, nb, lds);
  else if constexpr (PH == PH_ATTN) phase_attn(p, layer, bid, nb, lds);
  else if constexpr (PH == PH_FFTMIX) phase_fftmix(p, layer, bid, nb, lds);
  else if constexpr (PH == PH_GLA_A) phase_gla_a(p, layer, bid, nb, lds);
  else if constexpr (PH == PH_GLA_C) phase_gla_c(p, layer, bid, nb, lds);
  else if constexpr (PH == PH_MIX) phase_mix(p, layer, bid, nb, lds);
  else if constexpr (PH == PH_GEMM_OUT) phase_gemm_out(p, layer, bid, nb, lds);
  else if constexpr (PH == PH_NORM2) phase_norm2_router(p, layer, bid, nb, lds);
  else if constexpr (PH == PH_MOE_GU) phase_moe_gu(p, layer, bid, nb, lds);
  else if constexpr (PH == PH_MOE_DN) phase_moe_dn(p, layer, bid, nb, lds);
  else if constexpr (PH == PH_FINAL) phase_final(p, bid, nb, lds);
}


#ifndef MK_LAUNCHES
#define MK_LAUNCHES 1
#endif
__global__ void __launch_bounds__(NTHR, 2) k_mega(Params p) {
  extern __shared__ __attribute__((aligned(1024))) char lds[];
  const int bid = blockIdx.x, nb = gridDim.x;
  if (threadIdx.x == 0) *(uint4*)(lds + LDS_MAIN) = make_uint4(0u, 0u, 0u, 0u);
  __syncthreads();
  XcdBarrier bar = xcd_barrier_post(p.bar(), (volatile LAS unsigned*)(lds + LDS_MAIN));
#ifndef DBLMASK
#define DBLMASK 0u
#endif
#define RUNPH(bit, call) do { call; if (DBLMASK & (1u << (bit))) { __syncthreads(); call; } } while (0)
  RUNPH(13, phase_tables(p, bid, nb); phase_mod(p, bid, nb, lds); phase_fold(p, bid, nb, lds));
  RUNPH(0, phase_convert(p, bid, nb, lds));
  phase_hy_mlp(p, 0, SEQ, p.hfb(), p.hssq(), bid, nb, lds);
  phase_hy_mlp(p, 1, SEQ, p.hfb() + (size_t)2 * 256 * SEQ, p.hssq() + 256, bid, nb, lds);
  phase_hy_mlp(p, 0, LC, p.hfc(), p.hssq() + 512, bid, nb, lds);
  xcd_barrier(bar);
  RUNPH(2, phase_hy_filtfft(p, bid, nb, lds));
#define MK_LAYER(l) do { \
  phase_norm1(p, l, bid, nb, lds); \
  xcd_barrier(bar); \
  RUNPH(3, phase_gemm_in(p, l, bid, nb, lds)); \
  xcd_barrier(bar); \
  RUNPH(4, phase_qkv(p, l, bid, nb, lds)); \
  RUNPH(5, phase_gla_a(p, l, bid, nb, lds)); \
  xcd_barrier(bar); \
  RUNPH(6, phase_attn(p, l, bid, nb, lds)); \
  RUNPH(7, phase_fftmix(p, l, bid, nb, lds)); \
  RUNPH(9, phase_gla_c(p, l, bid, nb, lds)); \
  xcd_barrier(bar); \
  RUNPH(10, phase_mix(p, l, bid, nb, lds)); \
  xcd_barrier(bar); \
  phase_gemm_out(p, l, bid, nb, lds); \
  xcd_barrier(bar); \
  phase_norm2_router(p, l, bid, nb, lds); \
  xcd_barrier(bar); \
  RUNPH(11, phase_moe_gu(p, l, bid, nb, lds)); \
  xcd_barrier(bar); \
  RUNPH(12, phase_moe_dn(p, l, bid, nb, lds)); \
  xcd_barrier(bar); \
  } while (0)
  MK_LAYER(0);
  MK_LAYER(1);
#undef MK_LAYER
  phase_final(p, bid, nb, lds);
}
static size_t carve(char*& cur, size_t bytes) { char* r = cur; cur += (bytes + 1023) & ~(size_t)1023; return (size_t)(uintptr_t)r; }
#define CARVE(T, field, n) p.field = (T*)carve(cur, (size_t)(n) * sizeof(T))

template <int PH> static void launch_phase(const Params& p, int layer, hipStream_t stream) {
  static bool attr = false;
  if (!attr) { hipFuncSetAttribute((const void*)k_phase<PH>, hipFuncAttributeMaxDynamicSharedMemorySize, LDS_BYTES); attr = true; }
  hipLaunchKernelGGL(k_phase<PH>, dim3(256), dim3(NTHR), LDS_BYTES, stream, p, layer);
}

extern "C" void kernel_launch(void* const* d_in, const int* in_sizes, int n_in, void* d_out, int out_size, void* d_ws, size_t ws_size, hipStream_t stream) {
  Params p; memset(&p, 0, sizeof(p));
  const float** ins = (const float**)&p;
  for (int i = 0; i < 34; ++i) ins[i] = (const float*)d_in[i];
  p.out = (float*)d_out;
  p.ws = (char*)d_ws;
  if (WS_TOTAL > ws_size) { fprintf(stderr, "workspace too small: need %zu have %zu\n", (size_t)WS_TOTAL, ws_size); return; }
  hipMemsetAsync(p.bar(), 0, OFF_mod - OFF_bar, stream);
  static int grid = 0;
  if (!grid) {
    int dev = 0, cus = 0, per_cu = 0;
    hipGetDevice(&dev);
    hipDeviceGetAttribute(&cus, hipDeviceAttributeMultiprocessorCount, dev);
    hipFuncSetAttribute((const void*)k_mega, hipFuncAttributeMaxDynamicSharedMemorySize, LDS_BYTES);
    hipOccupancyMaxActiveBlocksPerMultiprocessor(&per_cu, (const void*)k_mega, NTHR, LDS_BYTES);
    grid = cus * (per_cu < 1 ? per_cu : 1);
    if (grid != 256) fprintf(stderr, "unexpected grid %d (cus %d per_cu %d)\n", grid, cus, per_cu);
  }
  hipLaunchKernelGGL(k_mega, dim3(grid), dim3(NTHR), LDS_BYTES, stream, p);
}
```

```cpp
#include <hip/hip_runtime.h>
#include <hip/hip_bf16.h>
#include <cstdio>
#include <cstdint>
#include <cstring>
#include <cstddef>
#include <type_traits>

typedef unsigned short u16;
using bf16x8 = __attribute__((ext_vector_type(8))) short;
using s16x4  = __attribute__((ext_vector_type(4))) short;
using f32x4  = __attribute__((ext_vector_type(4))) float;
using f32x16 = __attribute__((ext_vector_type(16))) float;
using u32x4  = __attribute__((ext_vector_type(4))) unsigned;
using u32x2  = __attribute__((ext_vector_type(2))) unsigned;

constexpr int DM = 1024, NB = 2, SEQ = 16384, LC = 256;
constexpr int TL = NB * SEQ;
constexpr int TC = NB * LC;
constexpr int TT = TL + TC;
constexpr int NIN = 2816;
constexpr int DIN0 = 2240;
constexpr int NE = 32, TOPK = 4, DFF = 1024;
constexpr int SKV = SEQ + LC;
constexpr int NTHR = 512;
constexpr float EPS = 1e-6f;
constexpr float A_SCALE = 0.10206207261596575f;
constexpr float A_QSCALE = A_SCALE * 1.4426950408889634f;
constexpr int ZG_W = 1152, ZG_GQ = 0, ZG_GK = 128, ZG_KR = 256, ZG_GV = 384, ZG_GP = 640, ZG_OG = 896;
constexpr int ZT_HY = 0, ZT_FR = 768, ZT_FI = 1024, ZT_R = 1280;
constexpr int NCH = 260;
constexpr int FM = 16384;
constexpr int HSP = FM / 2 + 1;

constexpr size_t ws_al(size_t b) { return (b + 1023) & ~(size_t)1023; }
constexpr size_t OFF_bar = 0;
constexpr size_t OFF_cnt = OFF_bar + ws_al((size_t)(4096) * sizeof(unsigned));
constexpr size_t OFF_hssq = OFF_cnt + ws_al((size_t)(64) * sizeof(int));
constexpr size_t OFF_kmx = OFF_hssq + ws_al((size_t)(768) * sizeof(float));
constexpr size_t OFF_mod = OFF_kmx + ws_al((size_t)(128) * sizeof(unsigned));
constexpr size_t OFF_ropec = OFF_mod + ws_al((size_t)(2 * 3 * 6144) * sizeof(float));
constexpr size_t OFF_ropes = OFF_ropec + ws_al((size_t)(SEQ * 16) * sizeof(float));
constexpr size_t OFF_tw = OFF_ropes + ws_al((size_t)(SEQ * 16) * sizeof(float));
constexpr size_t OFF_bt_in = OFF_tw + ws_al((size_t)(FM) * sizeof(float2));
constexpr size_t OFF_bt_qkv = OFF_bt_in + ws_al((size_t)((size_t)2 * NIN * DM) * sizeof(u16));
constexpr size_t OFF_bt_out = OFF_bt_qkv + ws_al((size_t)(2 * 1024 * 384) * sizeof(u16));
constexpr size_t OFF_bt_gu = OFF_bt_out + ws_al((size_t)((size_t)2 * DM * DM) * sizeof(u16));
constexpr size_t OFF_bt_dn = OFF_bt_gu + ws_al((size_t)((size_t)2 * NE * 2048 * DM) * sizeof(u16));
constexpr size_t OFF_hfb = OFF_bt_dn + ws_al((size_t)((size_t)2 * NE * DM * DFF) * sizeof(u16));
constexpr size_t OFF_hfc = OFF_hfb + ws_al((size_t)((size_t)2 * 2 * 256 * SEQ) * sizeof(float));
constexpr size_t OFF_hspec = OFF_hfc + ws_al((size_t)(2 * 256 * LC) * sizeof(float));
constexpr size_t OFF_H = OFF_hspec + ws_al((size_t)((size_t)2 * 256 * HSP) * sizeof(float4));
constexpr size_t OFF_zqkv = OFF_H + ws_al((size_t)((size_t)TT * DM) * sizeof(u16));
constexpr size_t OFF_zg = OFF_zqkv + ws_al((size_t)((size_t)TT * 384) * sizeof(u16));
constexpr size_t OFF_zt = OFF_zg + ws_al((size_t)((size_t)TT * ZG_W) * sizeof(float));
constexpr size_t OFF_Q = OFF_zt + ws_al((size_t)((size_t)ZT_R * TT) * sizeof(float));
constexpr size_t OFF_KV = OFF_Q + ws_al((size_t)((size_t)2 * 4 * SKV * 96) * sizeof(u16));
constexpr size_t OFF_ymix = OFF_KV + ws_al((size_t)((size_t)2 * 4 * SKV * 160) * sizeof(u16));
constexpr size_t OFF_hyo = OFF_ymix + ws_al((size_t)((size_t)TT * DM) * sizeof(u16));
constexpr size_t OFF_fno = OFF_hyo + ws_al((size_t)((size_t)256 * TT) * sizeof(float));
constexpr size_t OFF_glao = OFF_fno + ws_al((size_t)((size_t)256 * TT) * sizeof(float));
constexpr size_t OFF_gds = OFF_glao + ws_al((size_t)((size_t)TT * 256) * sizeof(float));
constexpr size_t OFF_gdv = OFF_gds + ws_al((size_t)((size_t)16 * NCH * 2048) * sizeof(float));
constexpr size_t OFF_gst = OFF_gdv + ws_al((size_t)((size_t)16 * NCH * 32) * sizeof(float));
constexpr size_t OFF_X = OFF_gst + ws_al((size_t)((size_t)16 * NCH * 2048) * sizeof(float));
constexpr size_t OFF_rtok = OFF_X + ws_al((size_t)((size_t)TT * DM) * sizeof(float));
constexpr size_t OFF_rw = OFF_rtok + ws_al((size_t)((size_t)NE * TT) * sizeof(int));
constexpr size_t OFF_tslot = OFF_rw + ws_al((size_t)((size_t)NE * TT) * sizeof(float));
constexpr size_t OFF_act = OFF_tslot + ws_al((size_t)((size_t)TT * 4) * sizeof(int));
constexpr size_t OFF_yd = OFF_act + ws_al((size_t)((size_t)TT * 4 * DFF) * sizeof(u16));
constexpr size_t OFF_swin = OFF_yd + ws_al((size_t)((size_t)TT * 4 * DM) * sizeof(u16));
constexpr size_t OFF_swgu = OFF_swin + ws_al((size_t)(2 * NIN) * sizeof(float));
constexpr size_t OFF_hs = OFF_swgu + ws_al((size_t)(2 * NE * 2048) * sizeof(float));
constexpr size_t WS_TOTAL = OFF_hs + ws_al((size_t)(TT) * sizeof(float));
struct ParamsData {
  const float *x_, *c_, *ctx_, *c_ctx_, *ada_w_, *ada_b_, *norm1_g_, *norm2_g_, *w_in_, *mla_q_g_, *mla_w_uq_, *mla_kv_g_, *mla_w_ukv_, *hy_conv_w_, *hy_conv_b_, *hy_w1_, *hy_b1_, *hy_w2_, *hy_b2_, *hy_w3_, *hy_freq_, *hy_bias_, *gla_gk_w_, *gla_gk_b_, *fnet_w_, *mix_g_, *w_out_, *router_w_, *router_b_, *moe_w_gu_, *moe_b_gu_, *moe_w_down_, *moe_b_down_, *final_g_;
  float* out_;
  char* ws_;
};
struct Params {
  const __attribute__((address_space(4))) char* kb;
  template <class T> __device__ __forceinline__ T karg(size_t off) const { return *(const __attribute__((address_space(4))) T*)(kb + off); }
  __device__ __forceinline__ const float* x() const { return karg<const float*>(offsetof(ParamsData, x_)); }
  __device__ __forceinline__ const float* c() const { return karg<const float*>(offsetof(ParamsData, c_)); }
  __device__ __forceinline__ const float* ctx() const { return karg<const float*>(offsetof(ParamsData, ctx_)); }
  __device__ __forceinline__ const float* c_ctx() const { return karg<const float*>(offsetof(ParamsData, c_ctx_)); }
  __device__ __forceinline__ const float* ada_w() const { return karg<const float*>(offsetof(ParamsData, ada_w_)); }
  __device__ __forceinline__ const float* ada_b() const { return karg<const float*>(offsetof(ParamsData, ada_b_)); }
  __device__ __forceinline__ const float* norm1_g() const { return karg<const float*>(offsetof(ParamsData, norm1_g_)); }
  __device__ __forceinline__ const float* norm2_g() const { return karg<const float*>(offsetof(ParamsData, norm2_g_)); }
  __device__ __forceinline__ const float* w_in() const { return karg<const float*>(offsetof(ParamsData, w_in_)); }
  __device__ __forceinline__ const float* mla_q_g() const { return karg<const float*>(offsetof(ParamsData, mla_q_g_)); }
  __device__ __forceinline__ const float* mla_w_uq() const { return karg<const float*>(offsetof(ParamsData, mla_w_uq_)); }
  __device__ __forceinline__ const float* mla_kv_g() const { return karg<const float*>(offsetof(ParamsData, mla_kv_g_)); }
  __device__ __forceinline__ const float* mla_w_ukv() const { return karg<const float*>(offsetof(ParamsData, mla_w_ukv_)); }
  __device__ __forceinline__ const float* hy_conv_w() const { return karg<const float*>(offsetof(ParamsData, hy_conv_w_)); }
  __device__ __forceinline__ const float* hy_conv_b() const { return karg<const float*>(offsetof(ParamsData, hy_conv_b_)); }
  __device__ __forceinline__ const float* hy_w1() const { return karg<const float*>(offsetof(ParamsData, hy_w1_)); }
  __device__ __forceinline__ const float* hy_b1() const { return karg<const float*>(offsetof(ParamsData, hy_b1_)); }
  __device__ __forceinline__ const float* hy_w2() const { return karg<const float*>(offsetof(ParamsData, hy_w2_)); }
  __device__ __forceinline__ const float* hy_b2() const { return karg<const float*>(offsetof(ParamsData, hy_b2_)); }
  __device__ __forceinline__ const float* hy_w3() const { return karg<const float*>(offsetof(ParamsData, hy_w3_)); }
  __device__ __forceinline__ const float* hy_freq() const { return karg<const float*>(offsetof(ParamsData, hy_freq_)); }
  __device__ __forceinline__ const float* hy_bias() const { return karg<const float*>(offsetof(ParamsData, hy_bias_)); }
  __device__ __forceinline__ const float* gla_gk_w() const { return karg<const float*>(offsetof(ParamsData, gla_gk_w_)); }
  __device__ __forceinline__ const float* gla_gk_b() const { return karg<const float*>(offsetof(ParamsData, gla_gk_b_)); }
  __device__ __forceinline__ const float* fnet_w() const { return karg<const float*>(offsetof(ParamsData, fnet_w_)); }
  __device__ __forceinline__ const float* mix_g() const { return karg<const float*>(offsetof(ParamsData, mix_g_)); }
  __device__ __forceinline__ const float* w_out() const { return karg<const float*>(offsetof(ParamsData, w_out_)); }
  __device__ __forceinline__ const float* router_w() const { return karg<const float*>(offsetof(ParamsData, router_w_)); }
  __device__ __forceinline__ const float* router_b() const { return karg<const float*>(offsetof(ParamsData, router_b_)); }
  __device__ __forceinline__ const float* moe_w_gu() const { return karg<const float*>(offsetof(ParamsData, moe_w_gu_)); }
  __device__ __forceinline__ const float* moe_b_gu() const { return karg<const float*>(offsetof(ParamsData, moe_b_gu_)); }
  __device__ __forceinline__ const float* moe_w_down() const { return karg<const float*>(offsetof(ParamsData, moe_w_down_)); }
  __device__ __forceinline__ const float* moe_b_down() const { return karg<const float*>(offsetof(ParamsData, moe_b_down_)); }
  __device__ __forceinline__ const float* final_g() const { return karg<const float*>(offsetof(ParamsData, final_g_)); }
  __device__ __forceinline__ float* out() const { return karg<float*>(offsetof(ParamsData, out_)); }
  __device__ __forceinline__ char* ws() const { return karg<char*>(offsetof(ParamsData, ws_)); }
  __device__ __forceinline__ unsigned* bar() const { return (unsigned*)(ws() + OFF_bar); }
  __device__ __forceinline__ int* cnt() const { return (int*)(ws() + OFF_cnt); }
  __device__ __forceinline__ float* hssq() const { return (float*)(ws() + OFF_hssq); }
  __device__ __forceinline__ unsigned* kmx() const { return (unsigned*)(ws() + OFF_kmx); }
  __device__ __forceinline__ float* mod() const { return (float*)(ws() + OFF_mod); }
  __device__ __forceinline__ float* ropec() const { return (float*)(ws() + OFF_ropec); }
  __device__ __forceinline__ float* ropes() const { return (float*)(ws() + OFF_ropes); }
  __device__ __forceinline__ float2* tw() const { return (float2*)(ws() + OFF_tw); }
  __device__ __forceinline__ signed char* bt_in() const { return (signed char*)(ws() + OFF_bt_in); }
  __device__ __forceinline__ u16* bt_qkv() const { return (u16*)(ws() + OFF_bt_qkv); }
  __device__ __forceinline__ u16* bt_out() const { return (u16*)(ws() + OFF_bt_out); }
  __device__ __forceinline__ signed char* bt_gu() const { return (signed char*)(ws() + OFF_bt_gu); }
  __device__ __forceinline__ u16* bt_dn() const { return (u16*)(ws() + OFF_bt_dn); }
  __device__ __forceinline__ float* hfb() const { return (float*)(ws() + OFF_hfb); }
  __device__ __forceinline__ float* hfc() const { return (float*)(ws() + OFF_hfc); }
  __device__ __forceinline__ float4* hspec() const { return (float4*)(ws() + OFF_hspec); }
  __device__ __forceinline__ signed char* H() const { return (signed char*)(ws() + OFF_H); }
  __device__ __forceinline__ float* hs() const { return (float*)(ws() + OFF_hs); }
  __device__ __forceinline__ float* swin() const { return (float*)(ws() + OFF_swin); }
  __device__ __forceinline__ float* swgu() const { return (float*)(ws() + OFF_swgu); }
  __device__ __forceinline__ float* btf() const { return (float*)(ws() + OFF_act); }
  __device__ __forceinline__ u16* zqkv() const { return (u16*)(ws() + OFF_zqkv); }
  __device__ __forceinline__ float* zg() const { return (float*)(ws() + OFF_zg); }
  __device__ __forceinline__ float* zt() const { return (float*)(ws() + OFF_zt); }
  __device__ __forceinline__ u16* Q() const { return (u16*)(ws() + OFF_Q); }
  __device__ __forceinline__ u16* KV() const { return (u16*)(ws() + OFF_KV); }
  __device__ __forceinline__ u16* ymix() const { return (u16*)(ws() + OFF_ymix); }
  __device__ __forceinline__ float* hyo() const { return (float*)(ws() + OFF_hyo); }
  __device__ __forceinline__ float* fno() const { return (float*)(ws() + OFF_fno); }
  __device__ __forceinline__ float* glao() const { return (float*)(ws() + OFF_glao); }
  __device__ __forceinline__ float* gds() const { return (float*)(ws() + OFF_gds); }
  __device__ __forceinline__ float* gdv() const { return (float*)(ws() + OFF_gdv); }
  __device__ __forceinline__ float* gst() const { return (float*)(ws() + OFF_gst); }
  __device__ __forceinline__ float* X() const { return (float*)(ws() + OFF_X); }
  __device__ __forceinline__ int* rtok() const { return (int*)(ws() + OFF_rtok); }
  __device__ __forceinline__ float* rw() const { return (float*)(ws() + OFF_rw); }
  __device__ __forceinline__ int* tslot() const { return (int*)(ws() + OFF_tslot); }
  __device__ __forceinline__ u16* act() const { return (u16*)(ws() + OFF_act); }
  __device__ __forceinline__ u16* yd() const { return (u16*)(ws() + OFF_yd); }
};


__device__ __forceinline__ u16 f2bf(float f) {
  unsigned u = __float_as_uint(f); u += 0x7FFFu + ((u >> 16) & 1u); return (u16)(u >> 16);
}
__device__ __forceinline__ float bf2f(u16 h) { return __uint_as_float(((unsigned)h) << 16); }
__device__ __forceinline__ unsigned cvtpk(float lo, float hi) {
  unsigned r; asm volatile("v_cvt_pk_bf16_f32 %0, %1, %2" : "=v"(r) : "v"(lo), "v"(hi)); return r;
}
__device__ __forceinline__ float wave_sum(float v) {
#pragma unroll
  for (int o = 32; o > 0; o >>= 1) v += __shfl_xor(v, o, 64);
  return v;
}
__device__ __forceinline__ int ltid() { int t = threadIdx.x; asm volatile("" : "+v"(t)); return t; }
__device__ __forceinline__ float silu_f(float x) { return x / (1.f + __expf(-x)); }
__device__ __forceinline__ float2 cmul(float2 a, float2 b) { return make_float2(a.x * b.x - a.y * b.y, a.x * b.y + a.y * b.x); }
__device__ __forceinline__ float2 cmulc(float2 a, float2 b) { return make_float2(a.x * b.x + a.y * b.y, a.y * b.x - a.x * b.y); }
__device__ __forceinline__ int modv(int tok) { return tok < TL ? (tok >> 14) : 2; }
__device__ __forceinline__ void phase_tables(const Params& p, int bid, int nb) {
  const int gt = bid * NTHR + ltid(), gs = nb * NTHR;
  for (int i = gt; i < SEQ * 16; i += gs) {
    const int t = i >> 4, f = i & 15;
    const float pos = (f < 8) ? (float)(t >> 6) : (float)(t & 63);
    const float inv = powf(10000.f, -(float)(f & 7) / 8.f);
    float s, c; sincosf(pos * inv, &s, &c);
    p.ropec()[i] = c; p.ropes()[i] = s;
  }
  for (int i = gt; i < FM; i += gs) {
    float s, c; sincospif((float)i / 8192.f, &s, &c);
    p.tw()[i] = make_float2(c, -s);
  }
}

__device__ __forceinline__ void phase_mod(const Params& p, int bid, int nb, char* lds) {
  float* red = (float*)lds;
  const int tid = ltid(), part = tid >> 6, cl = tid & 63;
  for (int it = bid; it < 2 * 96; it += nb) {
    const int l = it / 96, n = (it % 96) * 64 + cl;
    const float* W = p.ada_w() + (size_t)l * DM * 6144;
    float a0 = 0, a1 = 0, a2 = 0;
    for (int k = part * 128; k < part * 128 + 128; ++k) {
      const float w = W[(size_t)k * 6144 + n];
      a0 += silu_f(p.c()[k]) * w; a1 += silu_f(p.c()[DM + k]) * w; a2 += silu_f(p.c_ctx()[k]) * w;
    }
    red[(part * 3 + 0) * 64 + cl] = a0; red[(part * 3 + 1) * 64 + cl] = a1; red[(part * 3 + 2) * 64 + cl] = a2;
    __syncthreads();
    if (tid < 192) {
      const int v = tid >> 6; float s = 0;
      for (int q = 0; q < 8; ++q) s += red[(q * 3 + v) * 64 + cl];
      p.mod()[((size_t)l * 3 + v) * 6144 + n] = s + p.ada_b()[(size_t)l * 6144 + n];
    }
    __syncthreads();
  }
}

__device__ __forceinline__ void phase_fold(const Params& p, int bid, int nb, char* lds) {
  float* wrow = (float*)lds;
  float* dre = wrow + 256;
  float* dim_ = dre + 256;
  float* glr = dim_ + 256;
  float* cst = glr + 32;
  float* snt = cst + 256;
  const int tid = ltid();
  if (tid < 256) { float s, c; sincospif((float)tid / 128.f, &s, &c); cst[tid] = c; snt[tid] = s; }
  __syncthreads();
  for (int it = bid; it < 2 * DM; it += nb) {
    const int l = it >> 10, k = it & 1023;
    const float* wr = p.w_in() + ((size_t)l * DM + k) * DIN0;
    if (tid < 256) wrow[tid] = wr[1984 + tid];
    if (tid >= 256 && tid < 288) glr[tid - 256] = wr[1696 + tid - 256];
    __syncthreads();
    {
      const int kp = tid & 255; const bool im = tid >= 256;
      float s = 0;
      for (int c = 0; c < 256; ++c) { const int m = (c * kp) & 255; s += wrow[c] * (im ? -snt[m] : cst[m]); }
      if (im) dim_[kp] = s; else dre[kp] = s;
    }
    __syncthreads();
    {
      const int j = tid & 255; const bool im = tid >= 256;
      const float* Wf = p.fnet_w() + (size_t)l * 65536;
      const float* d = im ? dim_ : dre;
      float s = 0;
      for (int kp = 0; kp < 256; ++kp) s += d[kp] * Wf[kp * 256 + j];
      p.btf()[((size_t)l * NIN + (im ? 2560 : 2304) + j) * DM + k] = s * 0.0625f;
    }
    if (tid < 256) {
      const int dir = tid >> 7, kk = tid & 127;
      const float* gw = p.gla_gk_w() + ((size_t)l * 2 + dir) * 16 * 128;
      float s = 0;
      for (int r = 0; r < 16; ++r) s += glr[dir * 16 + r] * gw[r * 128 + kk];
      p.btf()[((size_t)l * NIN + 1024 + tid) * DM + k] = s;
    }
    __syncthreads();
  }
}

enum { MAP_ID = 0, MAP_IN = 1, MAP_UQ = 2, MAP_UKV = 3, MAP_GU = 4 };
__device__ __forceinline__ int colmap(int mt, int n) {
  switch (mt) {
    case MAP_ID: return n;
    case MAP_IN:
      if (n < 256) return n;
      if (n < 384) return 256 + (n - 256);
      if (n < 512) return 1184 + (n - 384);
      if (n < 640) return 1312 + (n - 512);
      if (n < 672) return 384 + (n - 640);
      if (n < 768) return -1;
      if (n < 1024) return 1440 + (n - 768);
      if (n < 1280) return -2;
      if (n < 1536) return 1728 + (n - 1280);
      if (n < 2304) return 416 + (n - 1536);
      return -2;
    case MAP_UQ:
      if (n < 256) return (n >> 6) * 96 + (n & 63);
      if (n < 384) return ((n - 256) >> 5) * 96 + 64 + ((n - 256) & 31);
      return -1;
    case MAP_UKV:
      if (n < 256) return (n >> 6) * 128 + (n & 63);
      return ((n - 256) >> 6) * 128 + 64 + ((n - 256) & 63);
    default: {
      const int pn = n >> 8, w = n & 255;
      return w < 128 ? 2 * (pn * 128 + w) : 2 * (pn * 128 + w - 128) + 1;
    }
  }
}
__device__ __forceinline__ int invmap(int mt, int sc) {
  if (mt == MAP_ID) return sc;
  if (mt == MAP_GU) { const int j = sc >> 1, t = sc & 1; return (j >> 7) * 256 + t * 128 + (j & 127); }
  if (sc < 384) return sc;
  if (sc < 416) return 640 + (sc - 384);
  if (sc < 1184) return 1536 + (sc - 416);
  if (sc < 1312) return 384 + (sc - 1184);
  if (sc < 1440) return 512 + (sc - 1312);
  if (sc < 1696) return 768 + (sc - 1440);
  if (sc < 1728) return -1;
  if (sc < 1984) return 1280 + (sc - 1728);
  return -1;
}
template <bool F32OUT>
__device__ __forceinline__ void conv_tile(const float* __restrict__ src, int ld, int K, void* __restrict__ dstv, int mt, const float* __restrict__ scale,
                                          int k0, int s0, float* tile  , int tid) {
  {
    const int kk = tid >> 5, s4 = (tid & 31) * 4;
    float4 v[4];
#pragma unroll
    for (int i = 0; i < 4; ++i) {
      v[i] = make_float4(0.f, 0.f, 0.f, 0.f);
      if (s0 + s4 < ld) v[i] = *(const float4*)(src + (size_t)(k0 + kk + 16 * i) * ld + s0 + s4);
    }
#pragma unroll
    for (int i = 0; i < 4; ++i) {
      const float sc = scale ? scale[k0 + kk + 16 * i] : 1.f;
      float* t = tile + (kk + 16 * i) * 129 + s4;
      t[0] = v[i].x * sc; t[1] = v[i].y * sc; t[2] = v[i].z * sc; t[3] = v[i].w * sc;
    }
  }
  __syncthreads();
#pragma unroll
  for (int h = 0; h < 2; ++h) {
    const int sl = (tid >> 3) + 64 * h, ks = (tid & 7) * 8, sc = s0 + sl;
    const int row = sc < ld ? invmap(mt, sc) : -1;
    if (row >= 0) {
      const float* t = tile + ks * 129 + sl;
      if constexpr (F32OUT) {
        float* dst = (float*)dstv + (size_t)row * K + k0 + ks;
        *(float4*)dst = make_float4(t[0], t[129], t[2 * 129], t[3 * 129]); *(float4*)(dst + 4) = make_float4(t[4 * 129], t[5 * 129], t[6 * 129], t[7 * 129]);
      } else {
        u32x4 w;
        w[0] = cvtpk(t[0], t[129]); w[1] = cvtpk(t[2 * 129], t[3 * 129]); w[2] = cvtpk(t[4 * 129], t[5 * 129]); w[3] = cvtpk(t[6 * 129], t[7 * 129]);
        *(u32x4*)((u16*)dstv + (size_t)row * K + k0 + ks) = w;
      }
    }
  }
  __syncthreads();
}
__device__ __forceinline__ void conv_gu8(const float* __restrict__ src  , signed char* __restrict__ dst  , float* __restrict__ sw  ,
                                         int s0, float* tile  , int tid) {
  float* cmax = tile + 1024 * 33;
  {
    const int c4 = (tid & 7) * 4, r0 = tid >> 3;
#pragma unroll 4
    for (int pss = 0; pss < 16; ++pss) {
      const int k = r0 + 64 * pss;
      const float4 v = *(const float4*)(src + (size_t)k * 2048 + s0 + c4);
      float* t = tile + k * 33 + c4; t[0] = v.x; t[1] = v.y; t[2] = v.z; t[3] = v.w;
    }
  }
  __syncthreads();
  {
    const int col = tid & 31, part = tid >> 5; float m = 0.f;
    for (int k = part * 64; k < part * 64 + 64; ++k) m = fmaxf(m, fabsf(tile[k * 33 + col]));
    cmax[part * 32 + col] = m;
  }
  __syncthreads();
  if (tid < 32) {
    float m = 0.f;
#pragma unroll
    for (int q = 0; q < 16; ++q) m = fmaxf(m, cmax[q * 32 + tid]);
    const float sc = fmaxf(m, 1e-20f) * (1.f / 127.f);
    cmax[512 + tid] = sc;
    sw[invmap(MAP_GU, s0 + tid)] = sc;
  }
  __syncthreads();
#pragma unroll
  for (int h = 0; h < 4; ++h) {
    const int g = tid + 512 * h, col = g & 31, k0 = (g >> 5) * 16;
    const float inv = 1.f / cmax[512 + col];
    unsigned w[4];
#pragma unroll
    for (int q = 0; q < 4; ++q) {
      const float* t = tile + (k0 + 4 * q) * 33 + col;
      const int q0 = (int)rintf(t[0] * inv), q1 = (int)rintf(t[33] * inv), q2 = (int)rintf(t[66] * inv), q3 = (int)rintf(t[99] * inv);
      w[q] = (unsigned)(q0 & 255) | ((unsigned)(q1 & 255) << 8) | ((unsigned)(q2 & 255) << 16) | ((unsigned)(q3 & 255) << 24);
    }
    *(u32x4*)(dst + (size_t)invmap(MAP_GU, s0 + col) * DM + k0) = u32x4{w[0], w[1], w[2], w[3]};
  }
  __syncthreads();
}
__device__ __forceinline__ void phase_convert(const Params& p, int bid, int nb, char* lds) {
  float* tile = (float*)lds;
  const int tid = ltid();
  constexpr int T_IN = 16 * 18, T_OUT = 16 * 8, T_GU = NE * 64, T_DN = NE * 128, T_L = T_IN + T_OUT + T_GU + T_DN;
  for (int t = bid; t < 2 * T_L; t += nb) {
    const int l = t / T_L; int r = t % T_L;
    if (r < T_IN) { conv_tile<true>(p.w_in() + (size_t)l * DM * DIN0, DIN0, DM, p.btf() + (size_t)l * NIN * DM, MAP_IN, nullptr, (r / 18) * 64, (r % 18) * 128, tile, tid); continue; }
    r -= T_IN;
    if (r < T_OUT) { conv_tile<false>(p.w_out() + (size_t)l * DM * DM, DM, DM, p.bt_out() + (size_t)l * DM * DM, MAP_ID, p.mix_g() + l * DM, (r / 8) * 64, (r % 8) * 128, tile, tid); continue; }
    r -= T_OUT;
    if (r < T_GU) { conv_gu8(p.moe_w_gu() + ((size_t)l * NE + (r >> 6)) * DM * 2048, p.bt_gu() + ((size_t)l * NE + (r >> 6)) * 2048 * DM, p.swgu() + ((size_t)l * NE + (r >> 6)) * 2048, (r & 63) * 32, tile, tid); continue; }
    r -= T_GU;
    { const int e = r >> 7, q = r & 127;
      conv_tile<false>(p.moe_w_down() + ((size_t)l * NE + e) * DFF * DM, DM, DFF, p.bt_dn() + ((size_t)l * NE + e) * DM * DFF, MAP_ID, nullptr, (q >> 3) * 64, (q & 7) * 128, tile, tid); }
  }
  for (int l = 0; l < 2; ++l) {
    for (int i = bid * NTHR + tid; i < 96 * DM / 4; i += nb * NTHR) *(float4*)(p.btf() + ((size_t)l * NIN + 672) * DM + (size_t)i * 4) = make_float4(0.f, 0.f, 0.f, 0.f);
    {
      const float* wq = p.mla_w_uq() + (size_t)l * 256 * 384; const float* wkv = p.mla_w_ukv() + (size_t)l * 128 * 512;
      const float* gq = p.mla_q_g() + l * 256; const float* gkv = p.mla_kv_g() + l * 128;
      u16* dst = p.bt_qkv() + (size_t)l * 1024 * 384;
      for (int i = bid * NTHR + ltid(); i < 1024 * 384; i += nb * NTHR) {
        const int n = i / 384, k = i % 384; float v = 0.f;
        if (n < 512) { const int sc = colmap(MAP_UQ, n); if (k < 256 && sc >= 0) v = gq[k] * wq[k * 384 + sc]; }
        else { if (k >= 256) v = gkv[k - 256] * wkv[(k - 256) * 512 + colmap(MAP_UKV, n - 512)]; }
        dst[i] = f2bf(v);
      }
    }
  }
}

__device__ __forceinline__ void phase_hy_mlp(const Params& p, int l, int Lf, float* __restrict__ hout  , float* __restrict__ ssq  ,
                             int bid, int nb, char* lds) {
  float* zf = (float*)lds;
  float* h1 = zf + 64 * 33;
  float* h2 = h1 + 64 * 64;
  const int tid = ltid();
  const float* w1 = p.hy_w1() + (size_t)l * 33 * 64; const float* b1 = p.hy_b1() + l * 64;
  const float* w2 = p.hy_w2() + (size_t)l * 64 * 64; const float* b2 = p.hy_b2() + l * 64;
  const float* w3 = p.hy_w3() + (size_t)l * 64 * 512; const float* fr = p.hy_freq() + l * 64;
  float w3c[64];
#pragma unroll
  for (int k = 0; k < 64; ++k) w3c[k] = w3[k * 512 + tid];
  const int dir = tid >> 8, ch = tid & 255;
  const float maxd = logf(1e-2f) / 0.3f, mind = logf(1e-2f) / 1.5f;
  const float delta = fabsf(mind + (maxd - mind) * (float)ch / 255.f);
  float ssq_acc = 0.f;
  for (int it = bid; it < Lf / 64; it += nb) {
    const int t0 = it * 64;
    for (int i = tid; i < 64 * 33; i += NTHR) {
      const int tt = i / 33, f = i % 33, t = t0 + tt;
      float v;
      if (f == 0) v = (float)t / (float)(Lf - 1);
      else {
        const int j = (f - 1) & 15;
        const float fj = 1e-4f + (float)j * ((15.f - 1e-4f) / 15.f);
        const float w = 6.283185307179586f * (float)t / (float)Lf;
        v = (f <= 16) ? cosf(fj * w) : -sinf(fj * w);
      }
      zf[i] = v;
    }
    __syncthreads();
    for (int i = tid; i < 64 * 64; i += NTHR) {
      const int tt = i >> 6, o = i & 63; float s = b1[o];
      for (int f = 0; f < 33; ++f) s += zf[tt * 33 + f] * w1[f * 64 + o];
      h1[i] = sinf(fr[o] * s);
    }
    __syncthreads();
    for (int i = tid; i < 64 * 64; i += NTHR) {
      const int tt = i >> 6, o = i & 63; float s = b2[o];
      for (int f = 0; f < 64; ++f) s += h1[tt * 64 + f] * w2[f * 64 + o];
      h2[i] = sinf(fr[o] * s);
    }
    __syncthreads();
    float* orow = hout + ((size_t)dir * 256 + ch) * Lf + t0;
    for (int tt = 0; tt < 64; ++tt) {
      float s = 0;
#pragma unroll
      for (int k = 0; k < 64; ++k) s += h2[tt * 64 + k] * w3c[k];
      const int t = t0 + tt;
      s *= __expf(-((float)t / (float)(Lf - 1)) * delta);
      orow[tt] = s;
      if (dir == 0 || t > 0) ssq_acc += s * s;
    }
    __syncthreads();
  }
  atomicAdd(&ssq[ch], ssq_acc);
}

__device__ __forceinline__ int rev7(int k) {
  unsigned r = __brev((unsigned)k) >> 18;
  return (int)(((r & 0x2AAAu) >> 1) | ((r & 0x1555u) << 1));
}
template <int ST, bool INV>
__device__ __forceinline__ void fft_stage(float2* s, const float2* __restrict__ tw, const int tid) {
  constexpr int sh = 12 - 2 * ST, q = 1 << sh, ND = q >= 512 ? q / 512 : 1;
  float2 w1[ND], w2[ND], w3[ND];
  if constexpr (ST < 6) {
#pragma unroll
    for (int d = 0; d < ND; ++d) {
      const int j = q >= 512 ? tid + 512 * d : (tid & (q - 1)), ti = j << (2 * ST);
      w1[d] = tw[ti]; w2[d] = tw[2 * ti]; w3[d] = tw[3 * ti];
    }
  }
#pragma unroll
  for (int m = 0; m < 8; ++m) {
    const int u = tid + 512 * m, g = u >> sh, j = u & (q - 1), base = (g << (sh + 2)) + j;
    constexpr int dummy = 0; (void)dummy;
    const int d = q >= 512 ? (m % ND) : 0;
    if constexpr (!INV) {
      const float2 a0 = s[base], a1 = s[base + q], a2 = s[base + 2 * q], a3 = s[base + 3 * q];
      const float2 b0 = make_float2(a0.x + a2.x, a0.y + a2.y), b1 = make_float2(a0.x - a2.x, a0.y - a2.y);
      const float2 b2 = make_float2(a1.x + a3.x, a1.y + a3.y), b3 = make_float2(a1.x - a3.x, a1.y - a3.y);
      const float2 y1 = make_float2(b1.x + b3.y, b1.y - b3.x), y2 = make_float2(b0.x - b2.x, b0.y - b2.y), y3 = make_float2(b1.x - b3.y, b1.y + b3.x);
      s[base] = make_float2(b0.x + b2.x, b0.y + b2.y);
      if constexpr (ST < 6) { s[base + q] = cmul(y1, w1[d]); s[base + 2 * q] = cmul(y2, w2[d]); s[base + 3 * q] = cmul(y3, w3[d]); }
      else { s[base + q] = y1; s[base + 2 * q] = y2; s[base + 3 * q] = y3; }
    } else {
      float2 t0 = s[base], t1 = s[base + q], t2 = s[base + 2 * q], t3 = s[base + 3 * q];
      if constexpr (ST < 6) { t1 = cmulc(t1, w1[d]); t2 = cmulc(t2, w2[d]); t3 = cmulc(t3, w3[d]); }
      const float2 b0 = make_float2(t0.x + t2.x, t0.y + t2.y), b1 = make_float2(t0.x - t2.x, t0.y - t2.y);
      const float2 b2 = make_float2(t1.x + t3.x, t1.y + t3.y), b3 = make_float2(t1.x - t3.x, t1.y - t3.y);
      s[base] = make_float2(b0.x + b2.x, b0.y + b2.y);
      s[base + q] = make_float2(b1.x - b3.y, b1.y + b3.x);
      s[base + 2 * q] = make_float2(b0.x - b2.x, b0.y - b2.y);
      s[base + 3 * q] = make_float2(b1.x + b3.y, b1.y - b3.x);
    }
  }
  __syncthreads();
}
__device__ __forceinline__ void fft_fwd(float2* s, const float2* __restrict__ tw) {
  const int tid = ltid();
  fft_stage<0, false>(s, tw, tid); fft_stage<1, false>(s, tw, tid); fft_stage<2, false>(s, tw, tid); fft_stage<3, false>(s, tw, tid);
  fft_stage<4, false>(s, tw, tid); fft_stage<5, false>(s, tw, tid); fft_stage<6, false>(s, tw, tid);
}
__device__ __forceinline__ void fft_inv(float2* s, const float2* __restrict__ tw) {
  const int tid = ltid();
  fft_stage<6, true>(s, tw, tid); fft_stage<5, true>(s, tw, tid); fft_stage<4, true>(s, tw, tid); fft_stage<3, true>(s, tw, tid);
  fft_stage<2, true>(s, tw, tid); fft_stage<1, true>(s, tw, tid); fft_stage<0, true>(s, tw, tid);
}

__device__ __forceinline__ void phase_hy_filtfft(const Params& p, int bid, int nb, char* lds) {
  float2* s = (float2*)lds;
  const int tid = ltid();
  for (int it = bid; it < 512; it += nb) {
    const int l = it >> 8, ch = it & 255;
    const float* hf = p.hfb() + (((size_t)l * 2 + 0) * 256 + ch) * SEQ;
    const float* hb = p.hfb() + (((size_t)l * 2 + 1) * 256 + ch) * SEQ;
    for (int m = tid; m < FM; m += NTHR) {
      const int n0 = 2 * m, n1 = 2 * m + 1;
      const float a = (n0 < SEQ) ? hf[n0] : (n0 == SEQ ? 0.f : hb[2 * SEQ - n0]);
      const float b = (n1 < SEQ) ? hf[n1] : hb[2 * SEQ - n1];
      s[m] = make_float2(a, b);
    }
    __syncthreads();
    fft_fwd(s, p.tw());
    const float sc = rsqrtf(p.hssq()[l * 256 + ch]) * (1.f / 16384.f);
    float4* out = p.hspec() + ((size_t)l * 256 + ch) * HSP;
    for (int k = tid; k <= FM / 2; k += NTHR) {
      const float2 zk = s[rev7(k)], zm = s[rev7((FM - k) & (FM - 1))];
      const float er = 0.5f * (zk.x + zm.x), ei = 0.5f * (zk.y - zm.y);
      const float dr = 0.5f * (zk.x - zm.x), di = 0.5f * (zk.y + zm.y);
      out[k] = make_float4(er * sc, ei * sc, di * sc, -dr * sc);
    }
    __syncthreads();
  }
}
constexpr int G_TILE_B = 256 * 64 * 2;
constexpr int G_STAGE_B = 2 * G_TILE_B;
constexpr int GEMM_LDS = 2 * G_STAGE_B;

__device__ __forceinline__ int lds_byte2(int r, int c) {
  const int st = (r >> 4) * 2 + (c >> 5), ob = (r & 15) * 64 + (c & 31) * 2;
  return st * 1024 + (ob ^ (((ob >> 9) & 1) << 5));
}
__device__ __forceinline__ void stage_rc2(int b, int& R, int& C) {
  const int st = b >> 10, sb = b & 1023, swz = sb ^ (((sb >> 9) & 1) << 5);
  R = (st >> 1) * 16 + (swz >> 6);
  C = (st & 1) * 32 + ((swz & 63) >> 1);
}
__device__ __forceinline__ void gemm_stage_coords(int (&sR)[4], int (&sC)[4]) {
  const int wid = ltid() >> 6, lane = ltid() & 63;
#pragma unroll
  for (int i = 0; i < 4; ++i) stage_rc2(wid * 1024 + i * 8192 + lane * 16, sR[i], sC[i]);
}

#define WAIT_V0() asm volatile("s_waitcnt vmcnt(0)" ::: "memory")

__device__ __forceinline__ void gemm256_core(const u16* const (&ap)[4], const u16* const (&bp)[4], int nt, char* shm, f32x4 (&acc)[8][4]) {
  const int tid = ltid(), wid = tid >> 6, lane = tid & 63, wr = wid >> 2, wc = wid & 3, fr = lane & 15, fq = lane >> 4;
#pragma unroll
  for (int m = 0; m < 8; ++m)
#pragma unroll
    for (int n = 0; n < 4; ++n) acc[m][n] = f32x4{0.f, 0.f, 0.f, 0.f};
#define G_SA(b) (shm + (b) * G_STAGE_B)
#define G_SB(b) (shm + (b) * G_STAGE_B + G_TILE_B)
#define G_STAGE(buf, kt) do { _Pragma("unroll") for (int i = 0; i < 4; ++i) {                                                   \
    __builtin_amdgcn_global_load_lds((const unsigned*)(ap[i] + (kt) * 64), (unsigned*)(G_SA(buf) + wid * 1024 + i * 8192), 16, 0, 0); \
    __builtin_amdgcn_global_load_lds((const unsigned*)(bp[i] + (kt) * 64), (unsigned*)(G_SB(buf) + wid * 1024 + i * 8192), 16, 0, 0); } } while (0)
  G_STAGE(0, 0); WAIT_V0(); __syncthreads();
#pragma unroll 1
  for (int t = 0; t < nt; ++t) {
    const int cur = t & 1;
    if (t + 1 < nt) G_STAGE(cur ^ 1, t + 1);
#pragma unroll
    for (int ks = 0; ks < 2; ++ks) {
      bf16x8 At[8], Bf[4];
#pragma unroll
      for (int m = 0; m < 8; ++m) At[m] = *(const bf16x8*)(G_SA(cur) + lds_byte2(wr * 128 + m * 16 + fr, ks * 32 + fq * 8));
#pragma unroll
      for (int n = 0; n < 4; ++n) Bf[n] = *(const bf16x8*)(G_SB(cur) + lds_byte2(wc * 64 + n * 16 + fr, ks * 32 + fq * 8));
#pragma unroll
      for (int m = 0; m < 8; ++m)
#pragma unroll
        for (int n = 0; n < 4; ++n) acc[m][n] = __builtin_amdgcn_mfma_f32_16x16x32_bf16(At[m], Bf[n], acc[m][n], 0, 0, 0);
      __builtin_amdgcn_sched_barrier(0);
    }
    WAIT_V0(); __syncthreads();
  }
#undef G_STAGE
}

#define LAS3 __attribute__((address_space(3)))
constexpr int G8_HTB = 128 * 64 * 2;
__device__ __forceinline__ int g8_perm32(int rho) { const int n = rho >> 4, i = rho & 15; return 8 * (i >> 2) + 4 * n + (i & 3); }
__device__ __forceinline__ int g8_lds_byte(int r, int c) { const int st = (r >> 4) * 2 + (c >> 5), rr = r & 15, cc = c & 31, ob = rr * 64 + cc * 2; return st * 1024 + (ob ^ (((ob >> 9) & 1) << 5)); }
__device__ __forceinline__ void g8_stage_rc(int b, int& R, int& C) { const int st = b / 1024, sb = b % 1024, swz = sb ^ (((sb >> 9) & 1) << 5); R = (st >> 1) * 16 + swz / 64; C = (st & 1) * 32 + (swz % 64) / 2; }
struct G8Unit { int pm, pn, e, ce, pre; };

template <bool I8> __device__ __forceinline__ typename std::conditional<I8, int __attribute__((ext_vector_type(4))), f32x4>::type
g8_mma(bf16x8 x, bf16x8 y, typename std::conditional<I8, int __attribute__((ext_vector_type(4))), f32x4>::type c) {
  if constexpr (I8) { typedef int v4i __attribute__((ext_vector_type(4))); return __builtin_amdgcn_mfma_i32_16x16x64_i8(*(v4i*)&x, *(v4i*)&y, c, 0, 0, 0); }
  else return __builtin_amdgcn_mfma_f32_16x16x32_bf16(x, y, c, 0, 0, 0);
}
typedef int i32x4 __attribute__((ext_vector_type(4)));
template <bool I8> struct G8Acc { typedef f32x4 T; };
template <> struct G8Acc<true> { typedef i32x4 T; };
template <bool I8, class Sched, class Epi>
__device__ __forceinline__ void gemm8_phase(char* lds_g, const char* Abase, const int Kb, const Sched& S, const Epi& E) {
    typedef typename G8Acc<I8>::T ACC;
    LAS3 unsigned char* lds = (LAS3 unsigned char*)lds_g;
    const int tid = ltid(), wid = __builtin_amdgcn_readfirstlane(tid >> 6), lane = tid & 63, wr = wid >> 2, wc = wid & 3, fr = lane & 15, fq = lane >> 4;
    const int nt = Kb / 128;
    int sRr[2], sCc[2]; unsigned voffB[2];
#pragma unroll
    for (int i = 0; i < 2; ++i) { g8_stage_rc(tid * 16 + i * 8192, sRr[i], sCc[i]); const int Rb = (sRr[i] & ~31) + g8_perm32(sRr[i] & 31); voffB[i] = (unsigned)(Rb * Kb) + (unsigned)sCc[i] * 2u; }
    const size_t kstep = 128;
    const size_t hstepB = (size_t)128 * Kb;
    const unsigned ldsw = (unsigned)wid * 1024u;
    const int aoff = g8_lds_byte(wr * 64 + fr, fq * 8), boff = g8_lds_byte(wc * 32 + fr, fq * 8);
#define G8_SA(b, h) (((b) * 2 + (h)) * G8_HTB)
#define G8_SB(b, h) ((4 + (b) * 2 + (h)) * G8_HTB)
#define G8_STAGE_B(bufoff, gbase) do { _Pragma("unroll") for (int _i = 0; _i < 2; ++_i) \
        __builtin_amdgcn_global_load_lds((const unsigned*)((const char*)(gbase) + voffB[_i]), (LAS3 unsigned*)(lds + (bufoff) + ldsw + _i * 8192), 16, 0, 0); } while (0)
#define G8_STAGE_A(bufoff, o0, o1) do { \
        __builtin_amdgcn_global_load_lds((const unsigned*)(Abase + (o0)), (LAS3 unsigned*)(lds + (bufoff) + ldsw), 16, 0, 0); \
        __builtin_amdgcn_global_load_lds((const unsigned*)(Abase + (o1)), (LAS3 unsigned*)(lds + (bufoff) + ldsw + 8192), 16, 0, 0); } while (0)
#define G8_LDA(dst, b, h) do { _Pragma("unroll") for (int m = 0; m < 4; ++m) _Pragma("unroll") for (int k = 0; k < 2; ++k) dst[m][k] = *(const LAS3 bf16x8*)(lds + G8_SA(b, h) + aoff + m * 2048 + k * 1024); } while (0)
#define G8_LDB(dst, b, h) do { _Pragma("unroll") for (int n = 0; n < 2; ++n) _Pragma("unroll") for (int k = 0; k < 2; ++k) dst[n][k] = *(const LAS3 bf16x8*)(lds + G8_SB(b, h) + boff + n * 2048 + k * 1024); } while (0)
#define G8_MMA(ai, bj, At, Bt) do { __builtin_amdgcn_s_setprio(1); _Pragma("unroll") for (int m = 0; m < 4; ++m) _Pragma("unroll") for (int n = 0; n < 2; ++n) _Pragma("unroll") for (int k = 0; k < 2; ++k) \
        acc[ai][bj][m][n] = g8_mma<I8>(Bt[n][k], At[m][k], acc[ai][bj][m][n]); __builtin_amdgcn_s_setprio(0); } while (0)
#define G8_WAIT_V(n) asm volatile("s_waitcnt vmcnt(" #n ")" ::: "memory")
#define G8_WAIT_L(n) asm volatile("s_waitcnt lgkmcnt(" #n ")" ::: "memory")
#define G8_BAR __builtin_amdgcn_s_barrier()
#define G8_SCHED __builtin_amdgcn_sched_barrier(0)
    G8Unit cur, nxt; int ui = 0;
    if (!S.next(0, cur)) return;
    ACC acc[2][2][4][2];
#pragma unroll
    for (int a = 0; a < 2; ++a)
#pragma unroll
        for (int b = 0; b < 2; ++b)
#pragma unroll
            for (int m = 0; m < 4; ++m)
#pragma unroll
                for (int n = 0; n < 2; ++n) acc[a][b][m][n] = ACC{};
    bf16x8 At[4][2], B0[2][2], B1[2][2];
    unsigned va[2][2], vn[2][2];
#pragma unroll
    for (int h = 0; h < 2; ++h)
#pragma unroll
        for (int i = 0; i < 2; ++i) va[h][i] = S.a_off(cur, h * 128 + sRr[i]) + (unsigned)sCc[i] * 2u;
    const char* cB = S.b_ptr(cur);
    G8_STAGE_B(G8_SB(0, 0), cB); G8_STAGE_A(G8_SA(0, 0), va[0][0], va[0][1]); G8_STAGE_B(G8_SB(0, 1), cB + hstepB); G8_STAGE_A(G8_SA(0, 1), va[1][0], va[1][1]);
    if (wr == 1) G8_BAR;
    G8_WAIT_V(4); G8_BAR;
    G8_STAGE_B(G8_SB(1, 0), cB + kstep); G8_STAGE_A(G8_SA(1, 0), va[0][0] + kstep, va[0][1] + kstep); G8_STAGE_B(G8_SB(1, 1), cB + hstepB + kstep);
    G8_WAIT_V(6); G8_BAR;
    for (;;) {
        const bool has_next = S.next(ui + 1, nxt);
        const char* nB = cB;
#pragma unroll
        for (int h = 0; h < 2; ++h)
#pragma unroll
            for (int i = 0; i < 2; ++i) vn[h][i] = va[h][i];
        if (has_next) {
            nB = S.b_ptr(nxt);
#pragma unroll
            for (int h = 0; h < 2; ++h)
#pragma unroll
                for (int i = 0; i < 2; ++i) vn[h][i] = S.a_off(nxt, h * 128 + sRr[i]) + (unsigned)sCc[i] * 2u;
        }
#pragma unroll 1
        for (int t = 0; t < nt; t += 2) {
            const bool last = (t == nt - 2);
            const unsigned k1 = (unsigned)(t + 1) * 128u;
            const unsigned k2 = last ? 0u : (unsigned)(t + 2) * 128u;
            const unsigned a2_00 = (last ? vn[0][0] : va[0][0]) + k2, a2_01 = (last ? vn[0][1] : va[0][1]) + k2;
            const unsigned a2_10 = (last ? vn[1][0] : va[1][0]) + k2, a2_11 = (last ? vn[1][1] : va[1][1]) + k2;
            const char* b2 = (last ? nB : cB) + k2; const char* b3 = b2 + kstep;
            G8_LDB(B0, 0, 0); G8_SCHED; G8_LDA(At, 0, 0); G8_STAGE_A(G8_SA(1, 1), va[1][0] + k1, va[1][1] + k1);
            G8_WAIT_L(8); G8_BAR; G8_WAIT_L(0); G8_MMA(0, 0, At, B0); G8_BAR; G8_SCHED;
            G8_LDB(B1, 0, 1); G8_STAGE_B(G8_SB(0, 0), b2);
            G8_BAR; G8_WAIT_L(0); G8_MMA(0, 1, At, B1); G8_BAR;
            G8_LDA(At, 0, 1); G8_STAGE_A(G8_SA(0, 0), a2_00, a2_01);
            G8_BAR; G8_WAIT_L(0); G8_MMA(1, 0, At, B0); G8_BAR; G8_SCHED;
            G8_STAGE_B(G8_SB(0, 1), b2 + hstepB);
            G8_WAIT_V(6); G8_BAR; G8_MMA(1, 1, At, B1); G8_BAR;
            G8_LDB(B0, 1, 0); G8_SCHED; G8_LDA(At, 1, 0); G8_STAGE_A(G8_SA(0, 1), a2_10, a2_11);
            G8_WAIT_L(8); G8_BAR; G8_WAIT_L(0); G8_MMA(0, 0, At, B0); G8_BAR; G8_SCHED;
            G8_LDB(B1, 1, 1); G8_STAGE_B(G8_SB(1, 0), b3);
            G8_BAR; G8_WAIT_L(0); G8_MMA(0, 1, At, B1); G8_BAR;
            G8_LDA(At, 1, 1); G8_STAGE_A(G8_SA(1, 0), a2_00 + 128u, a2_01 + 128u);
            G8_BAR; G8_WAIT_L(0); G8_MMA(1, 0, At, B0); G8_BAR; G8_SCHED;
            G8_STAGE_B(G8_SB(1, 1), b3 + hstepB);
            G8_WAIT_V(6); G8_BAR; G8_MMA(1, 1, At, B1); G8_BAR;
        }
        E(acc, cur, wr, wc, fr, fq);
        if (!has_next) break;
#pragma unroll
        for (int a = 0; a < 2; ++a)
#pragma unroll
            for (int b = 0; b < 2; ++b)
#pragma unroll
                for (int m = 0; m < 4; ++m)
#pragma unroll
                    for (int n = 0; n < 2; ++n) acc[a][b][m][n] = ACC{};
        cur = nxt; cB = nB; ++ui;
#pragma unroll
        for (int h = 0; h < 2; ++h)
#pragma unroll
            for (int i = 0; i < 2; ++i) va[h][i] = vn[h][i];
    }
    G8_WAIT_V(0);
    if (wr == 0) G8_BAR;
    G8_BAR;
#undef G8_SA
#undef G8_SB
#undef G8_STAGE_A
#undef G8_STAGE_B
#undef G8_LDA
#undef G8_LDB
#undef G8_MMA
#undef G8_WAIT_V
#undef G8_WAIT_L
#undef G8_BAR
#undef G8_SCHED
}
struct G8Plain {
    int nM, nN, Kb, G, c; const char* Bt;
    __device__ __forceinline__ bool next(int i, G8Unit& u) const {
        const int L = (i * 8 + (c & 7)) * (G >> 3) + (c >> 3); if (L >= nM * nN) return false;
        const int nig = 8 * nN, gid = L / nig, fm = gid * 8, gsz = (nM - fm) < 8 ? (nM - fm) : 8;
        u.pm = fm + ((L % nig) % gsz); u.pn = (L % nig) / gsz; u.e = 0; u.ce = 256; u.pre = 0; return true;
    }
    __device__ __forceinline__ unsigned a_off(const G8Unit& u, int row) const { return (unsigned)(u.pm * 256 + row) * (unsigned)Kb; }
    __device__ __forceinline__ const char* b_ptr(const G8Unit& u) const { return Bt + (size_t)u.pn * 256 * Kb; }
};

__device__ __forceinline__ const float* resid_row(const Params& p, int layer_src, int tok) {
  if (layer_src == 0) return tok < TL ? p.x() + (size_t)tok * DM : p.ctx() + (size_t)(tok - TL) * DM;
  return p.X() + (size_t)tok * DM;
}
__device__ __forceinline__ void load_row_comb(const Params& p, int src_layer, int lc, int tok, int lane, const int* pre  , float (&v)[16]) {
  const float* r = resid_row(p, src_layer, tok);
#pragma unroll
  for (int i = 0; i < 4; ++i) { const float4 a = *(const float4*)(r + lane * 4 + i * 256); v[4 * i] = a.x; v[4 * i + 1] = a.y; v[4 * i + 2] = a.z; v[4 * i + 3] = a.w; }
  if (lc >= 0) {
    const float* g2 = p.mod() + ((size_t)lc * 3 + modv(tok)) * 6144 + 5 * DM;
    float s[16];
#pragma unroll
    for (int i = 0; i < 16; ++i) s[i] = 0.f;
#pragma unroll
    for (int k = 0; k < TOPK; ++k) {
      const int sl = p.tslot()[tok * 4 + k];
      const size_t arow = (size_t)(pre[sl >> 20] + (sl & 0xFFFFF));
      const u16* y = p.yd() + arow * DM;
#pragma unroll
      for (int i = 0; i < 4; ++i) {
        const u32x2 w = *(const u32x2*)(y + lane * 4 + i * 256);
        s[4 * i] += __uint_as_float(w[0] << 16); s[4 * i + 1] += __uint_as_float(w[0] & 0xFFFF0000u);
        s[4 * i + 2] += __uint_as_float(w[1] << 16); s[4 * i + 3] += __uint_as_float(w[1] & 0xFFFF0000u);
      }
    }
#pragma unroll
    for (int i = 0; i < 4; ++i) {
      const float4 g = *(const float4*)(g2 + lane * 4 + i * 256);
      v[4 * i] += g.x * s[4 * i]; v[4 * i + 1] += g.y * s[4 * i + 1]; v[4 * i + 2] += g.z * s[4 * i + 2]; v[4 * i + 3] += g.w * s[4 * i + 3];
    }
  }
}
__device__ __forceinline__ void expert_prefix(const int* cnt, int* pre) {
  if (ltid() == 0) { int s = 0; for (int e = 0; e < NE; ++e) { pre[e] = s; s += cnt[e]; } pre[NE] = s; }
}

__device__ __forceinline__ void store_row_i8(const float (&y)[16], signed char* __restrict__ h, float* __restrict__ hs_row, int lane) {
  float am = 0.f;
#pragma unroll
  for (int i = 0; i < 16; ++i) am = fmaxf(am, fabsf(y[i]));
#pragma unroll
  for (int o = 32; o > 0; o >>= 1) am = fmaxf(am, __shfl_xor(am, o, 64));
  const float s = fmaxf(am, 1e-20f) * (1.f / 127.f), inv = 1.f / s;
#pragma unroll
  for (int i = 0; i < 4; ++i) {
    const int q0 = (int)rintf(y[4 * i] * inv), q1 = (int)rintf(y[4 * i + 1] * inv), q2 = (int)rintf(y[4 * i + 2] * inv), q3 = (int)rintf(y[4 * i + 3] * inv);
    *(unsigned*)(h + lane * 4 + i * 256) = (unsigned)(q0 & 255) | ((unsigned)(q1 & 255) << 8) | ((unsigned)(q2 & 255) << 16) | ((unsigned)(q3 & 255) << 24);
  }
  if (lane == 0) *hs_row = s;
}
__device__ __forceinline__ void phase_quant_in(const Params& p, int bid, int nb) {
  const int wid = ltid() >> 6, lane = ltid() & 63;
  for (int r = bid * 8 + wid; r < 2 * NIN; r += nb * 8) {
    const float* src = p.btf() + (size_t)r * DM;
    float y[16];
#pragma unroll
    for (int i = 0; i < 4; ++i) { const float4 a = *(const float4*)(src + lane * 4 + i * 256); y[4 * i] = a.x; y[4 * i + 1] = a.y; y[4 * i + 2] = a.z; y[4 * i + 3] = a.w; }
    store_row_i8(y, p.bt_in() + (size_t)r * DM, p.swin() + r, lane);
  }
}
__device__ __forceinline__ void phase_norm1(const Params& p, int layer, int bid, int nb, char* lds) {
  int* pre = (int*)lds;
  const int lc = layer - 1;
  if (lc >= 0) { expert_prefix(p.cnt() + lc * NE, pre); __syncthreads(); }
  const int wid = ltid() >> 6, lane = ltid() & 63;
  const float* gn = p.norm1_g() + layer * DM;
  const int ntok = TT;
  for (int tok = bid * 8 + wid; tok < ntok; tok += nb * 8) {
    float v[16];
    load_row_comb(p, layer == 0 ? 0 : 1, lc, tok, lane, pre, v);
    if (lc >= 0) {
      float* xr = p.X() + (size_t)tok * DM;
#pragma unroll
      for (int i = 0; i < 4; ++i) *(float4*)(xr + lane * 4 + i * 256) = make_float4(v[4 * i], v[4 * i + 1], v[4 * i + 2], v[4 * i + 3]);
    }
    float ss = 0;
#pragma unroll
    for (int i = 0; i < 16; ++i) ss += v[i] * v[i];
    ss = wave_sum(ss);
    const float rs = rsqrtf(ss * (1.f / DM) + EPS);
    const float* md = p.mod() + ((size_t)layer * 3 + modv(tok)) * 6144;
#pragma unroll
    for (int i = 0; i < 4; ++i) {
      const int c = lane * 4 + i * 256;
      const float4 g = *(const float4*)(gn + c), sh = *(const float4*)(md + c), sc = *(const float4*)(md + DM + c);
      v[4 * i] = v[4 * i] * rs * g.x * (1.f + sc.x) + sh.x; v[4 * i + 1] = v[4 * i + 1] * rs * g.y * (1.f + sc.y) + sh.y;
      v[4 * i + 2] = v[4 * i + 2] * rs * g.z * (1.f + sc.z) + sh.z; v[4 * i + 3] = v[4 * i + 3] * rs * g.w * (1.f + sc.w) + sh.w;
    }
    store_row_i8(v, p.H() + (size_t)tok * DM, p.hs() + tok, lane);
  }
}

struct EpiIn {
  u16* zqkv; float* zg; float* zt; const float* hs; const float* sw;
  __device__ __forceinline__ void operator()(const i32x4 (&acc)[2][2][4][2], const G8Unit& u, int wr, int wc, int fr, int fq) const {
    float sa[2][4];
#pragma unroll
    for (int ai = 0; ai < 2; ++ai)
#pragma unroll
      for (int m = 0; m < 4; ++m) sa[ai][m] = hs[u.pm * 256 + ai * 128 + wr * 64 + m * 16 + fr];
#pragma unroll
    for (int bj = 0; bj < 2; ++bj) {
      const int c32 = u.pn * 256 + bj * 128 + wc * 32, c0 = c32 + 8 * fq;
      const f32x4 w0 = *(const f32x4*)(sw + c0), w1 = *(const f32x4*)(sw + c0 + 4);
#pragma unroll
      for (int ai = 0; ai < 2; ++ai)
#pragma unroll
        for (int m = 0; m < 4; ++m) {
          const int row = u.pm * 256 + ai * 128 + wr * 64 + m * 16 + fr;
          f32x4 a, b;
#pragma unroll
          for (int j = 0; j < 4; ++j) { a[j] = (float)acc[ai][bj][m][0][j] * sa[ai][m] * w0[j]; b[j] = (float)acc[ai][bj][m][1][j] * sa[ai][m] * w1[j]; }
          if (c32 < 384) {
            *(u32x4*)(zqkv + (size_t)row * 384 + c0) = u32x4{cvtpk(a[0], a[1]), cvtpk(a[2], a[3]), cvtpk(b[0], b[1]), cvtpk(b[2], b[3])};
          } else if (c32 < 1536) {
            float* d = zg + (size_t)row * ZG_W + (c0 - 384);
            *(f32x4*)d = a; *(f32x4*)(d + 4) = b;
          } else {
#pragma unroll
            for (int j = 0; j < 4; ++j) { zt[(size_t)(c0 - 1536 + j) * TT + row] = a[j]; zt[(size_t)(c0 - 1536 + 4 + j) * TT + row] = b[j]; }
          }
        }
    }
  }
};
__device__ __forceinline__ void phase_gemm_in(const Params& p, int layer, int bid, int nb, char* lds) {
  G8Plain S; S.nM = TT / 256; S.nN = NIN / 256; S.Kb = DM; S.G = nb; S.c = bid; S.Bt = (const char*)(p.bt_in() + (size_t)layer * NIN * DM);
  EpiIn E; E.zqkv = p.zqkv(); E.zg = p.zg(); E.zt = p.zt(); E.hs = p.hs(); E.sw = p.swin() + layer * NIN;
  gemm8_phase<true>(lds, (const char*)p.H(), DM, S, E);
}

__device__ __forceinline__ size_t qkv_row(int tok, int h) {
  const int b = tok < TL ? (tok >> 14) : ((tok - TL) >> 8);
  const int s = tok < TL ? (tok & (SEQ - 1)) : SEQ + ((tok - TL) & (LC - 1));
  return ((size_t)(b * 4 + h)) * SKV + s;
}
struct EpiQkv {
  const u16* zqkv; u16* Q; u16* KV; const float* ropec; const float* ropes; float* rsl;
  unsigned* kmx;
  __device__ __forceinline__ void operator()(const f32x4 (&acc)[2][2][4][2], const G8Unit& u, int wr, int wc, int fr, int fq) const {
    const int tid = ltid();
    {
      const int r = tid >> 1, half = tid & 1;
      const u16* row = zqkv + (size_t)(u.pm * 256 + r) * 384;
      float sq = 0, sk = 0;
#pragma unroll
      for (int i = 0; i < 16; ++i) {
        const u32x4 w = *(const u32x4*)(row + half * 128 + i * 8);
#pragma unroll
        for (int q = 0; q < 4; ++q) { const float a = __uint_as_float(w[q] << 16), b = __uint_as_float(w[q] & 0xFFFF0000u); sq += a * a + b * b; }
      }
#pragma unroll
      for (int i = 0; i < 8; ++i) {
        const u32x4 w = *(const u32x4*)(row + 256 + half * 64 + i * 8);
#pragma unroll
        for (int q = 0; q < 4; ++q) { const float a = __uint_as_float(w[q] << 16), b = __uint_as_float(w[q] & 0xFFFF0000u); sk += a * a + b * b; }
      }
      sq += __shfl_xor(sq, 1, 64); sk += __shfl_xor(sk, 1, 64);
      if (half == 0) { rsl[r] = rsqrtf(sq * (1.f / 256.f) + EPS); rsl[256 + r] = rsqrtf(sk * (1.f / 128.f) + EPS); }
    }
    asm volatile("s_waitcnt lgkmcnt(0)" ::: "memory"); __builtin_amdgcn_s_barrier(); __builtin_amdgcn_s_barrier(); asm volatile("" ::: "memory");
    const float* rsp = rsl + (u.pn >= 2 ? 256 : 0);
#pragma unroll
    for (int ai = 0; ai < 2; ++ai)
#pragma unroll
      for (int m = 0; m < 4; ++m) {
        const int rl = ai * 128 + wr * 64 + m * 16 + fr, tok = u.pm * 256 + rl;
        const float rs = rsp[rl] * (u.pn < 2 ? A_QSCALE : 1.f);
        if (u.pn == 1) {
          f32x4 a = acc[ai][0][m][0] * rs, b = acc[ai][0][m][1] * rs;
          f32x4 pa, pb;
#pragma unroll
          for (int j = 0; j < 4; ++j) { pa[j] = __shfl_xor(a[j], 32, 64); pb[j] = __shfl_xor(b[j], 32, 64); }
          f32x4 ca = {1.f, 1.f, 1.f, 1.f}, cb = ca, sa = {0.f, 0.f, 0.f, 0.f}, sb = sa;
          if (tok < TL) {
            const float* cp = ropec + (size_t)(tok & (SEQ - 1)) * 16 + 8 * (fq & 1); const float* sp = ropes + (size_t)(tok & (SEQ - 1)) * 16 + 8 * (fq & 1);
            ca = *(const f32x4*)cp; cb = *(const f32x4*)(cp + 4); sa = *(const f32x4*)sp; sb = *(const f32x4*)(sp + 4);
          }
          const float sg = fq < 2 ? -1.f : 1.f;
          a = a * ca + pa * sa * sg; b = b * cb + pb * sb * sg;
          *(u32x4*)(Q + qkv_row(tok, wc) * 96 + 64 + 8 * fq) = u32x4{cvtpk(a[0], a[1]), cvtpk(a[2], a[3]), cvtpk(b[0], b[1]), cvtpk(b[2], b[3])};
        } else {
#pragma unroll
          for (int bj = 0; bj < 2; ++bj) {
            const int c = bj * 128 + wc * 32 + 8 * fq, h = c >> 6, d = c & 63;
            const f32x4 a = acc[ai][bj][m][0] * rs, b = acc[ai][bj][m][1] * rs;
            u16* dst = u.pn == 0 ? Q + qkv_row(tok, h) * 96 + d : KV + qkv_row(tok, h) * 160 + (u.pn == 2 ? 0 : 96) + d;
            *(u32x4*)dst = u32x4{cvtpk(a[0], a[1]), cvtpk(a[2], a[3]), cvtpk(b[0], b[1]), cvtpk(b[2], b[3])};
          }
        }
      }
    if (u.pn == 2) {
      const int b = u.pm * 256 < TL ? (u.pm * 256) >> 14 : (u.pm * 256 - TL) >> 8;
#pragma unroll
      for (int bj = 0; bj < 2; ++bj) {
        float mx = 0.f;
#pragma unroll
        for (int ai = 0; ai < 2; ++ai)
#pragma unroll
          for (int m = 0; m < 4; ++m) {
            const float rs = rsp[ai * 128 + wr * 64 + m * 16 + fr];
            const f32x4 a = acc[ai][bj][m][0] * rs, b4 = acc[ai][bj][m][1] * rs;
            float ss = a[0] * a[0] + a[1] * a[1] + a[2] * a[2] + a[3] * a[3] + b4[0] * b4[0] + b4[1] * b4[1] + b4[2] * b4[2] + b4[3] * b4[3];
            ss += __shfl_xor(ss, 16, 64); ss += __shfl_xor(ss, 32, 64);
            mx = fmaxf(mx, ss);
          }
#pragma unroll
        for (int o = 8; o > 0; o >>= 1) mx = fmaxf(mx, __shfl_xor(mx, o, 64));
        if ((ltid() & 63) == 0) atomicMax(kmx + (b * 4 + bj * 2 + (wc >> 1)) * 4 + (wc & 1), __float_as_uint(mx));
      }
    }
  }
};
__device__ __forceinline__ void phase_qkv(const Params& p, int layer, int bid, int nb, char* lds) {
  const int tid = ltid();
  {
    G8Plain S; S.nM = TT / 256; S.nN = 4; S.Kb = 768; S.G = nb; S.c = bid; S.Bt = (const char*)(p.bt_qkv() + (size_t)layer * 1024 * 384);
    EpiQkv E; E.zqkv = p.zqkv(); E.Q = p.Q(); E.KV = p.KV(); E.ropec = p.ropec(); E.ropes = p.ropes(); E.rsl = (float*)(lds + 131072); E.kmx = p.kmx() + layer * 32;
    gemm8_phase<false>(lds, (const char*)p.zqkv(), 768, S, E);
  }
  float krm0 = 0.f, krm1 = 0.f;
  for (int i = bid * NTHR + tid; i < TT * 16; i += nb * NTHR) {
    const int tok = i >> 4, f = i & 15;
    const float x1 = p.zg()[(size_t)tok * ZG_W + ZG_KR + f], x2 = p.zg()[(size_t)tok * ZG_W + ZG_KR + 16 + f];
    float cs = 1.f, sn = 0.f;
    if (tok < TL) { const int tpos = tok & (SEQ - 1); cs = p.ropec()[tpos * 16 + f]; sn = p.ropes()[tpos * 16 + f]; }
    const float y1 = x1 * cs - x2 * sn, y2 = x2 * cs + x1 * sn;
    const u16 o1 = f2bf(y1), o2 = f2bf(y2);
#pragma unroll
    for (int h = 0; h < 4; ++h) { u16* kv = p.KV() + qkv_row(tok, h) * 160 + 64; kv[f] = o1; kv[16 + f] = o2; }
    float ss = y1 * y1 + y2 * y2;
#pragma unroll
    for (int o = 8; o > 0; o >>= 1) ss += __shfl_xor(ss, o, 64);
    const int b = tok < TL ? (tok >> 14) : ((tok - TL) >> 8);
    if (b == 0) krm0 = fmaxf(krm0, ss); else krm1 = fmaxf(krm1, ss);
  }
#pragma unroll
  for (int o = 32; o > 0; o >>= 1) { krm0 = fmaxf(krm0, __shfl_xor(krm0, o, 64)); krm1 = fmaxf(krm1, __shfl_xor(krm1, o, 64)); }
  if ((tid & 63) == 0) { atomicMax(p.kmx() + layer * 32 + 0 * 16 + 2, __float_as_uint(krm0)); atomicMax(p.kmx() + layer * 32 + 1 * 16 + 2, __float_as_uint(krm1)); }
}

constexpr int A_KROW = 208;
constexpr int A_TV = 128 * 64 * 2;
constexpr int A_TK = 128 * A_KROW;
constexpr int A_BUF = A_TV + A_TK;
constexpr int A_OFF_W = 3 * A_BUF;
constexpr int ATTN_LDS = A_OFF_W + 8 * 64 * 4;
#define SBAR() __builtin_amdgcn_sched_barrier(0)
__device__ __forceinline__ int crow(int r, int hi) { return (r & 3) + 8 * (r >> 2) + 4 * hi; }

__device__ __forceinline__ void a_partialSM(f32x16& p0) {
#pragma unroll
  for (int r = 0; r < 16; ++r) p0[r] = __builtin_amdgcn_exp2f(p0[r]);
}
__device__ __forceinline__ void a_finishSM(f32x16& p0, f32x16& p1, float& l_reg, bf16x8& pa0, bf16x8& pa1, bf16x8& pa2, bf16x8& pa3) {
#pragma unroll
  for (int r = 0; r < 16; ++r) p1[r] = __builtin_amdgcn_exp2f(p1[r]);
  float ps = 0;
#pragma unroll
  for (int r = 0; r < 16; ++r) ps += p0[r];
#pragma unroll
  for (int r = 0; r < 16; ++r) ps += p1[r];
  { auto rr = __builtin_amdgcn_permlane32_swap(__float_as_uint(ps), __float_as_uint(ps), false, false);
    ps = __uint_as_float(rr[0]) + __uint_as_float(rr[1]); }
  l_reg += ps;
#define PK4(P, BASE, OUT) do { unsigned a0 = cvtpk(P[BASE + 0], P[BASE + 1]), a1 = cvtpk(P[BASE + 2], P[BASE + 3]);   \
    unsigned b0 = cvtpk(P[BASE + 4], P[BASE + 5]), b1 = cvtpk(P[BASE + 6], P[BASE + 7]);                              \
    auto r0 = __builtin_amdgcn_permlane32_swap(a0, b0, false, false); auto r1 = __builtin_amdgcn_permlane32_swap(a1, b1, false, false); \
    u32x4 w = {r0[0], r1[0], r0[1], r1[1]}; OUT = *reinterpret_cast<bf16x8*>(&w); } while (0)
  PK4(p0, 0, pa0); PK4(p0, 8, pa1); PK4(p1, 0, pa2); PK4(p1, 8, pa3);
#undef PK4
}
__device__ __forceinline__ void a_qkt(f32x16& p0, f32x16& p1, const char* Ks, const bf16x8* qr, const float mneg, int r32, int hi) {
#pragma unroll
  for (int r = 0; r < 16; ++r) { p0[r] = mneg; p1[r] = mneg; }
#pragma unroll
  for (int d0 = 0; d0 < 6; ++d0) {
    const int cb = (d0 * 16 + hi * 8) * 2;
    const bf16x8 b0 = *reinterpret_cast<const bf16x8*>(Ks + r32 * A_KROW + cb);
    const bf16x8 b1 = *reinterpret_cast<const bf16x8*>(Ks + (32 + r32) * A_KROW + cb);
    p0 = __builtin_amdgcn_mfma_f32_32x32x16_bf16(b0, qr[d0], p0, 0, 0, 0); p1 = __builtin_amdgcn_mfma_f32_32x32x16_bf16(b1, qr[d0], p1, 0, 0, 0);
  }
}
__device__ __forceinline__ int a_v_st(int k, int c) { const int kk = (k & ~0xC) | ((k & 4) << 1) | ((k & 8) >> 1); return ((kk >> 3) * 2 + (c >> 5)) * 512 + ((kk & 7) * 32 + (c & 31)) * 2; }
__device__ __forceinline__ int a_v_rd_base(int lane) { return ((lane & 3) << 3) | (((lane >> 2) & 3) << 6) | (((lane >> 4) & 1) << 5) | (((lane >> 5) & 1) << 8); }
constexpr int a_v_rd_off(int d0, int ks, int half) { return d0 * 512 + ks * 2048 + half * 1024; }
template <int OFF> __device__ __forceinline__ s16x4 a_tr_read(int vb) {
  s16x4 r; asm volatile("ds_read_b64_tr_b16 %0, %1 offset:%2" : "=&v"(r) : "v"(vb), "i"(OFF) : "memory"); return r;
}
template <int D0> __device__ __forceinline__ void a_pv_one(f32x16& od, int vb, bf16x8 pa0, bf16x8 pa1, bf16x8 pa2, bf16x8 pa3) {
  const s16x4 l0 = a_tr_read<a_v_rd_off(D0, 0, 0)>(vb), h0 = a_tr_read<a_v_rd_off(D0, 0, 1)>(vb), l1 = a_tr_read<a_v_rd_off(D0, 1, 0)>(vb), h1 = a_tr_read<a_v_rd_off(D0, 1, 1)>(vb);
  const s16x4 l2 = a_tr_read<a_v_rd_off(D0, 2, 0)>(vb), h2 = a_tr_read<a_v_rd_off(D0, 2, 1)>(vb), l3 = a_tr_read<a_v_rd_off(D0, 3, 0)>(vb), h3 = a_tr_read<a_v_rd_off(D0, 3, 1)>(vb);
  asm volatile("s_waitcnt lgkmcnt(0)" ::: "memory"); SBAR();
#define PK(L, H) (bf16x8){L[0], L[1], L[2], L[3], H[0], H[1], H[2], H[3]}
  od = __builtin_amdgcn_mfma_f32_32x32x16_bf16(pa0, PK(l0, h0), od, 0, 0, 0);
  od = __builtin_amdgcn_mfma_f32_32x32x16_bf16(pa1, PK(l1, h1), od, 0, 0, 0);
  od = __builtin_amdgcn_mfma_f32_32x32x16_bf16(pa2, PK(l2, h2), od, 0, 0, 0);
  od = __builtin_amdgcn_mfma_f32_32x32x16_bf16(pa3, PK(l3, h3), od, 0, 0, 0);
#undef PK
}
__device__ __forceinline__ void a_pv(f32x16* o, int vb, bf16x8 pa0, bf16x8 pa1, bf16x8 pa2, bf16x8 pa3) {
  a_pv_one<0>(o[0], vb, pa0, pa1, pa2, pa3); a_pv_one<1>(o[1], vb, pa0, pa1, pa2, pa3);
}

__device__ __forceinline__ void attn_item(const u16* __restrict__ Qb, const u16* __restrict__ KVh, int seq, float kmax, u16* __restrict__ yout  , char* lds) {
  const int tid = ltid(), wid = tid >> 6, lane = tid & 63, r32 = lane & 31, hi = lane >> 5;
  float* ws = (float*)(lds + A_OFF_W) + wid * 64; float* li_l = ws;
  float l_reg = 0; f32x16 o[2] = {}; bf16x8 qr[6];
  const u16* Qw = Qb + (size_t)(wid * 32 + r32) * 96 + hi * 8;
#pragma unroll
  for (int d0 = 0; d0 < 6; ++d0) qr[d0] = *reinterpret_cast<const bf16x8*>(Qw + d0 * 16);
  float mneg;
  {
    float ss = 0.f;
#pragma unroll
    for (int d0 = 0; d0 < 6; ++d0)
#pragma unroll
      for (int j = 0; j < 8; ++j) { const float v = bf2f((u16)qr[d0][j]); ss += v * v; }
    ss += __shfl_xor(ss, 32, 64);
    mneg = -sqrtf(ss) * kmax;
  }
  int lw[5];
#pragma unroll
  for (int i = 0; i < 5; ++i) {
    const int g = tid + i * 512, key = g / 20, cc = g % 20;
    lw[i] = cc < 12 ? (A_TV + key * A_KROW + cc * 16) : ((key >> 6) * 8192 + a_v_st(key & 63, (cc - 12) * 8));
  }
  const int vrb = (int)(uintptr_t)lds + a_v_rd_base(lane);
  bf16x8 sg[5];
  const char* gsrc = (const char*)KVh + tid * 16;
#define SLOAD(t) do { const char* s_ = gsrc + (size_t)(t) * 40960; _Pragma("unroll") for (int i = 0; i < 5; ++i) sg[i] = *(const bf16x8*)(s_ + i * 8192); } while (0)
#define SWRITE(bo_) do { _Pragma("unroll") for (int i = 0; i < 5; ++i) *(bf16x8*)(lds + (bo_) + lw[i]) = sg[i]; } while (0)
  f32x16 pA0, pA1, pB0, pB1; bf16x8 pa0, pa1, pa2, pa3; const int NT = seq / 128;
  SLOAD(0); SWRITE(0); if (1 < NT) SLOAD(1);
  __syncthreads();
  int bo = 0;
  {
    if (1 < NT) { SWRITE(A_BUF); if (2 < NT) SLOAD(2); }
    SBAR(); a_qkt(pA0, pA1, lds + bo + A_TV, qr, mneg, r32, hi); a_partialSM(pA0);
    SBAR(); a_qkt(pB0, pB1, lds + bo + A_TV + 64 * A_KROW, qr, mneg, r32, hi);
    a_finishSM(pA0, pA1, l_reg, pa0, pa1, pa2, pa3); SBAR();
    a_pv(o, vrb + bo, pa0, pa1, pa2, pa3); a_partialSM(pB0);
    __syncthreads();
  }
  for (int t = 1; t < NT; ++t) {
    const int bp = bo;
    bo = bo + A_BUF; if (bo == 3 * A_BUF) bo = 0;
    int bn = bo + A_BUF; if (bn == 3 * A_BUF) bn = 0;
    if (t + 1 < NT) { SWRITE(bn); if (t + 2 < NT) SLOAD(t + 2); }
    SBAR(); a_qkt(pA0, pA1, lds + bo + A_TV, qr, mneg, r32, hi);
    a_finishSM(pB0, pB1, l_reg, pa0, pa1, pa2, pa3); SBAR();
    a_pv(o, vrb + bp + 8192, pa0, pa1, pa2, pa3); a_partialSM(pA0);
    SBAR(); a_qkt(pB0, pB1, lds + bo + A_TV + 64 * A_KROW, qr, mneg, r32, hi);
    a_finishSM(pA0, pA1, l_reg, pa0, pa1, pa2, pa3); SBAR();
    a_pv(o, vrb + bo, pa0, pa1, pa2, pa3); a_partialSM(pB0);
    __syncthreads();
  }
  a_finishSM(pB0, pB1, l_reg, pa0, pa1, pa2, pa3); SBAR();
  a_pv(o, vrb + bo + 8192, pa0, pa1, pa2, pa3);
  if (hi == 0) li_l[r32] = l_reg; asm volatile("s_waitcnt lgkmcnt(0)" ::: "memory");
#pragma unroll
  for (int r = 0; r < 16; ++r) {
    const int orow = crow(r, hi);
    const float rl = __builtin_amdgcn_rcpf(li_l[orow]);
    const float v0 = o[0][r] * rl, v1 = o[1][r] * rl;
    float ss = v0 * v0 + v1 * v1;
#pragma unroll
    for (int off = 16; off > 0; off >>= 1) ss += __shfl_xor(ss, off, 64);
    const float rs = rsqrtf(ss * (1.f / 64.f) + EPS);
    u16* dst = yout + (size_t)(wid * 32 + orow) * DM;
    dst[r32] = f2bf(v0 * rs); dst[32 + r32] = f2bf(v1 * rs);
  }
  __syncthreads();
#undef SLOAD
#undef SWRITE
}

__device__ __forceinline__ void phase_attn(const Params& p, int layer, int bid, int nb, char* lds) {
  const int nitems = 512 + (layer == 0 ? 8 : 0);
  const unsigned* kmx = p.kmx() + layer * 32;
  for (int it = bid; it < nitems; it += nb) {
    int b, h, q0, k0, seq, tok0;
    if (it < 512) { const int pair = it & 7, qb = (it >> 3); h = pair & 3; b = pair >> 2; q0 = qb * 256; k0 = 0; seq = SKV; tok0 = b * SEQ + qb * 256; }
    else { const int i2 = it - 512; h = i2 & 3; b = i2 >> 2; q0 = SEQ; k0 = SEQ; seq = LC; tok0 = TL + b * LC; }
    const size_t base = (size_t)(b * 4 + h) * SKV;
    const float k2 = __uint_as_float(kmx[(b * 4 + h) * 4 + 0]) + __uint_as_float(kmx[(b * 4 + h) * 4 + 1]) + __uint_as_float(kmx[b * 16 + 2]);
    attn_item(p.Q() + (base + q0) * 96, p.KV() + (base + k0) * 160, seq, sqrtf(k2) * 1.02f, p.ymix() + (size_t)tok0 * DM + h * 64, lds);
  }
}

__device__ __forceinline__ float hy_sconv(const float* __restrict__ row, int t, int Ls, float w0, float w1, float w2, float bb) {
  const float zm = t > 0 ? row[t - 1] : 0.f, z0 = row[t], zp = t + 1 < Ls ? row[t + 1] : 0.f;
  return w0 * zm + w1 * z0 + w2 * zp + bb;
}
__device__ __forceinline__ void hyena_item(const Params& p, int layer, int b, int ch, char* lds) {
  float2* s = (float2*)lds;
  const int tid = ltid();
  const float* cw = p.hy_conv_w() + (size_t)layer * 3 * 768; const float* cb = p.hy_conv_b() + (size_t)layer * 768;
  const float* r0 = p.zt() + (size_t)(ZT_HY + ch) * TT + (size_t)b * SEQ;
  const float* r1 = p.zt() + (size_t)(ZT_HY + 256 + ch) * TT + (size_t)b * SEQ;
  const float* r2 = p.zt() + (size_t)(ZT_HY + 512 + ch) * TT + (size_t)b * SEQ;
  const float a0 = cw[ch], a1 = cw[768 + ch], a2 = cw[1536 + ch], ab = cb[ch];
  const float b0 = cw[256 + ch], b1 = cw[768 + 256 + ch], b2 = cw[1536 + 256 + ch], bb = cb[256 + ch];
  const float c0 = cw[512 + ch], c1 = cw[768 + 512 + ch], c2 = cw[1536 + 512 + ch], cbb = cb[512 + ch];
  for (int m = tid; m < FM; m += NTHR) {
    float2 z = make_float2(0.f, 0.f);
    if (m < SEQ / 2) {
      const int t = 2 * m;
      z.x = hy_sconv(r2, t, SEQ, c0, c1, c2, cbb) * hy_sconv(r1, t, SEQ, b0, b1, b2, bb);
      z.y = hy_sconv(r2, t + 1, SEQ, c0, c1, c2, cbb) * hy_sconv(r1, t + 1, SEQ, b0, b1, b2, bb);
    }
    s[m] = z;
  }
  __syncthreads();
  fft_fwd(s, p.tw());
  const float4* hs = p.hspec() + ((size_t)layer * 256 + ch) * HSP;
  for (int k = tid; k <= FM / 2; k += NTHR) {
    const int pk = rev7(k), pm = rev7((FM - k) & (FM - 1));
    const float2 zk = s[pk], zm = s[pm];
    const float4 h = hs[k];
    const float2 He = make_float2(h.x, h.y), Ho = make_float2(h.z, h.w);
    const float2 Xe = make_float2(0.5f * (zk.x + zm.x), 0.5f * (zk.y - zm.y));
    const float2 Xo = make_float2(0.5f * (zk.y + zm.y), -0.5f * (zk.x - zm.x));
    const float2 t1 = cmul(p.tw()[k], cmul(Xo, Ho));
    const float2 e1 = cmul(Xe, He);
    const float2 Ye = make_float2(e1.x + t1.x, e1.y + t1.y);
    const float2 o1 = cmul(Xe, Ho), o2 = cmul(Xo, He);
    const float2 Yo = make_float2(o1.x + o2.x, o1.y + o2.y);
    s[pk] = make_float2(Ye.x - Yo.y, Ye.y + Yo.x);
    if (pm != pk) s[pm] = make_float2(Ye.x + Yo.y, -Ye.y + Yo.x);
  }
  __syncthreads();
  fft_inv(s, p.tw());
  const float hb = p.hy_bias()[layer * 256 + ch];
  float* orow = p.hyo() + (size_t)ch * TT + (size_t)b * SEQ;
  for (int m = tid; m < SEQ / 2; m += NTHR) {
    const int t = 2 * m;
    const float2 y = s[m];
    const float vg0 = hy_sconv(r2, t, SEQ, c0, c1, c2, cbb) * hy_sconv(r1, t, SEQ, b0, b1, b2, bb);
    const float vg1 = hy_sconv(r2, t + 1, SEQ, c0, c1, c2, cbb) * hy_sconv(r1, t + 1, SEQ, b0, b1, b2, bb);
    const float x00 = hy_sconv(r0, t, SEQ, a0, a1, a2, ab), x01 = hy_sconv(r0, t + 1, SEQ, a0, a1, a2, ab);
    *(float2*)(orow + t) = make_float2((y.x + vg0 * hb) * x00, (y.y + vg1 * hb) * x01);
  }
  __syncthreads();
}
__device__ __forceinline__ void fnet_item(const Params& p, int b, int j, char* lds) {
  float2* s = (float2*)lds;
  const int tid = ltid();
  const float* rr = p.zt() + (size_t)(ZT_FR + j) * TT + (size_t)b * SEQ;
  const float* ri = p.zt() + (size_t)(ZT_FI + j) * TT + (size_t)b * SEQ;
  for (int m = tid; m < FM; m += NTHR) s[m] = make_float2(rr[m], ri[m]);
  __syncthreads();
  fft_fwd(s, p.tw());
  float* orow = p.fno() + (size_t)j * TT + (size_t)b * SEQ;
  for (int k = tid; k < FM; k += NTHR) orow[k] = s[rev7(k)].x * (1.f / 128.f);
  __syncthreads();
}
__device__ __forceinline__ void hyena_ctx_item(const Params& p, int b, int ch, char* lds) {
  float* vg = (float*)lds;
  float* x0 = vg + 256;
  float* hf = x0 + 256;
  float* hbk = hf + 256;
  const int tid = ltid();
  const float* cw = p.hy_conv_w(); const float* cb = p.hy_conv_b();
  const size_t off = (size_t)TL + (size_t)b * LC;
  const float* r0 = p.zt() + (size_t)(ZT_HY + ch) * TT + off;
  const float* r1 = p.zt() + (size_t)(ZT_HY + 256 + ch) * TT + off;
  const float* r2 = p.zt() + (size_t)(ZT_HY + 512 + ch) * TT + off;
  if (tid < 256) {
    const int t = tid;
    vg[t] = hy_sconv(r2, t, LC, cw[512 + ch], cw[768 + 512 + ch], cw[1536 + 512 + ch], cb[512 + ch]) *
            hy_sconv(r1, t, LC, cw[256 + ch], cw[768 + 256 + ch], cw[1536 + 256 + ch], cb[256 + ch]);
    x0[t] = hy_sconv(r0, t, LC, cw[ch], cw[768 + ch], cw[1536 + ch], cb[ch]);
    hf[t] = p.hfc()[(size_t)ch * LC + t]; hbk[t] = p.hfc()[(size_t)(256 + ch) * LC + t];
  }
  __syncthreads();
  if (tid < 256) {
    const int t = tid; float y = 0;
    for (int q = 0; q <= t; ++q) y += hf[t - q] * vg[q];
    for (int q = t + 1; q < LC; ++q) y += hbk[q - t] * vg[q];
    y *= rsqrtf(p.hssq()[512 + ch]);
    p.hyo()[(size_t)ch * TT + off + t] = (y + vg[t] * p.hy_bias()[ch]) * x0[t];
  }
  __syncthreads();
}
__device__ __forceinline__ void fnet_ctx_item(const Params& p, int b, int j, char* lds) {
  float* ur = (float*)lds; float* ui = ur + 256; float* cst = ui + 256; float* snt = cst + 256;
  const int tid = ltid();
  const size_t off = (size_t)TL + (size_t)b * LC;
  if (tid < 256) {
    ur[tid] = p.zt()[(size_t)(ZT_FR + j) * TT + off + tid]; ui[tid] = p.zt()[(size_t)(ZT_FI + j) * TT + off + tid];
    float sn, cs; sincospif((float)tid / 128.f, &sn, &cs); cst[tid] = cs; snt[tid] = sn;
  }
  __syncthreads();
  if (tid < 256) {
    const int k = tid; float y = 0;
    for (int l = 0; l < 256; ++l) { const int m = (l * k) & 255; y += cst[m] * ur[l] + snt[m] * ui[l]; }
    p.fno()[(size_t)j * TT + off + k] = y * 0.0625f;
  }
  __syncthreads();
}
__device__ __forceinline__ void phase_fftmix(const Params& p, int layer, int bid, int nb, char* lds) {
  const int nitems = layer == 0 ? 2048 : 1024;
  for (int it = bid; it < nitems; it += nb) {
    const int k = it & 511, b = k >> 8, c = k & 255;
    if (it < 512) hyena_item(p, layer, b, c, lds);
    else if (it < 1024) fnet_item(p, b, c, lds);
    else if (it < 1536) hyena_ctx_item(p, b, c, lds);
    else fnet_ctx_item(p, b, c, lds);
  }
}
constexpr int GLG = 17, NGRP = 16;
__device__ __forceinline__ int gla_chain_tok(int dir, int b, int n, int i) {
  const int base = n < 4 ? TL + b * LC : b * SEQ, len = n < 4 ? LC : SEQ, m = n < 4 ? n : n - 4;
  return dir == 0 ? base + 64 * m + i : base + (len - 1) - (64 * m + i);
}
__device__ __forceinline__ float logsig16(float x) { return (fminf(x, 0.f) - log1pf(__expf(-fabsf(x)))) * (1.f / 16.f); }
__device__ __forceinline__ float wave_scan_incl(float v, int lane) {
#pragma unroll
  for (int o = 1; o < 64; o <<= 1) { const float t = __shfl_up(v, o, 64); if (lane >= o) v += t; }
  return v;
}
__device__ __forceinline__ void phase_gla_a(const Params& p, int layer, int bid, int nb, char* lds) {
  float* kl = (float*)lds;
  float* gl = kl + 64 * 33;
  float* vl = gl + 64 * 33;
  const int tid = ltid(), wid = tid >> 6, lane = tid & 63;
  const float* gb = p.gla_gk_b() + (size_t)layer * 256;
  for (int it = bid; it < 16 * NGRP; it += nb) {
    const int chain = it >> 4, g = it & 15, dir = chain >> 3, b = (chain >> 2) & 1, h = chain & 3;
    const int n0 = g * GLG, n1 = min(n0 + GLG, NCH);
    const int kk = tid >> 4, v0 = (tid & 15) * 4;
    float st[4] = {0.f, 0.f, 0.f, 0.f}; float dcum = 1.f;
    for (int n = n0; n < n1; ++n) {
      {
        const int i = tid >> 3, c4 = (tid & 7) * 4;
        const float* zr = p.zg() + (size_t)gla_chain_tok(dir, b, n, i) * ZG_W;
        const float4 k4 = *(const float4*)(zr + ZG_GK + h * 32 + c4);
        const float4 g4 = *(const float4*)(zr + ZG_GP + dir * 128 + h * 32 + c4);
        const float4 bb = *(const float4*)(gb + dir * 128 + h * 32 + c4);
        const float4 va = *(const float4*)(zr + ZG_GV + h * 64 + c4 * 2), vb = *(const float4*)(zr + ZG_GV + h * 64 + c4 * 2 + 4);
        kl[i * 33 + c4] = k4.x; kl[i * 33 + c4 + 1] = k4.y; kl[i * 33 + c4 + 2] = k4.z; kl[i * 33 + c4 + 3] = k4.w;
        gl[i * 33 + c4] = logsig16(g4.x + bb.x); gl[i * 33 + c4 + 1] = logsig16(g4.y + bb.y); gl[i * 33 + c4 + 2] = logsig16(g4.z + bb.z); gl[i * 33 + c4 + 3] = logsig16(g4.w + bb.w);
        *(float4*)(vl + i * 68 + c4 * 2) = va; *(float4*)(vl + i * 68 + c4 * 2 + 4) = vb;
      }
      __syncthreads();
#pragma unroll
      for (int q = 0; q < 4; ++q) { const int c = wid * 4 + q; gl[lane * 33 + c] = wave_scan_incl(gl[lane * 33 + c], lane); }
      __syncthreads();
      {
        float* lp = p.gds() + ((size_t)chain * NCH + n) * 2048 + kk * 64 + v0;
        *(float4*)lp = make_float4(st[0], st[1], st[2], st[3]);
        if ((tid & 15) == 0) p.gdv()[((size_t)chain * NCH + n) * 32 + kk] = dcum;
        const float bl = gl[63 * 33 + kk];
        float acc[4] = {0.f, 0.f, 0.f, 0.f};
#pragma unroll 8
        for (int i = 0; i < 64; ++i) {
          const float w = kl[i * 33 + kk] * __expf(bl - gl[i * 33 + kk]);
          const float4 vv = *(const float4*)(vl + i * 68 + v0);
          acc[0] += w * vv.x; acc[1] += w * vv.y; acc[2] += w * vv.z; acc[3] += w * vv.w;
        }
        const float d = __expf(bl);
#pragma unroll
        for (int j = 0; j < 4; ++j) st[j] = st[j] * d + acc[j];
        dcum *= d;
      }
      __syncthreads();
    }
    float* at = p.gst() + ((size_t)chain * NGRP + g) * 2048 + kk * 64 + v0;
    *(float4*)at = make_float4(st[0], st[1], st[2], st[3]);
    if ((tid & 15) == 0) p.gst()[(size_t)16 * NGRP * 2048 + ((size_t)chain * NGRP + g) * 32 + kk] = dcum;
  }
}

constexpr int GC_QP = 33792, GC_KP = GC_QP + 10240, GC_VT = GC_KP + 10240, GC_ST = GC_VT + 18432, GC_AX = GC_ST + 10240;
__device__ __forceinline__ void phase_gla_c(const Params& p, int layer, int bid, int nb, char* lds) {
  float* gl = (float*)lds;
  float* qraw = gl + 2 * 64 * 33;
  float* kraw = qraw + 64 * 33;
  float* Of = (float*)lds;
  char* Qp = lds + GC_QP;
  char* Kp = lds + GC_KP;
  char* VT = lds + GC_VT;
  char* ST = lds + GC_ST;
  const int tid = ltid(), wid = tid >> 6, lane = tid & 63, r32 = lane & 31, hi = lane >> 5;
  char* Ax = lds + GC_AX + wid * 4608;
  const float* gb = p.gla_gk_b() + (size_t)layer * 256;
  const int pc_lo = layer == 0 ? 0 : 4, npc = NCH - pc_lo, nitem = 8 * npc;
  const int per = (nitem + nb - 1) / nb, q_beg = bid * per, q_end = min(nitem, q_beg + per);
  const int sdir = tid >> 8, sk = (tid >> 3) & 31, sv0 = (tid & 7) * 8;
  float G[8]; int g_cached = -1, bh_cached = -1;
  for (int qi = q_beg; qi < q_end; ++qi) {
    const int bh = qi / npc, pc = pc_lo + qi % npc, b = bh >> 2, h = bh & 3;
    const int tok0 = pc < 4 ? TL + b * LC + pc * 64 : b * SEQ + (pc - 4) * 64;
    {
      const int pos = tid >> 3, c4 = (tid & 7) * 4;
      const float* zr = p.zg() + (size_t)(tok0 + pos) * ZG_W;
      const float4 q4 = *(const float4*)(zr + ZG_GQ + h * 32 + c4), k4 = *(const float4*)(zr + ZG_GK + h * 32 + c4);
      const float sc = 0.17677669529663687f;
      qraw[pos * 33 + c4] = q4.x * sc; qraw[pos * 33 + c4 + 1] = q4.y * sc; qraw[pos * 33 + c4 + 2] = q4.z * sc; qraw[pos * 33 + c4 + 3] = q4.w * sc;
      kraw[pos * 33 + c4] = k4.x; kraw[pos * 33 + c4 + 1] = k4.y; kraw[pos * 33 + c4 + 2] = k4.z; kraw[pos * 33 + c4 + 3] = k4.w;
#pragma unroll
      for (int d = 0; d < 2; ++d) {
        const float4 g4 = *(const float4*)(zr + ZG_GP + d * 128 + h * 32 + c4), bb = *(const float4*)(gb + d * 128 + h * 32 + c4);
        const int i = d ? 63 - pos : pos;
        float* gd = gl + (d * 64 + i) * 33 + c4;
        gd[0] = logsig16(g4.x + bb.x); gd[1] = logsig16(g4.y + bb.y); gd[2] = logsig16(g4.z + bb.z); gd[3] = logsig16(g4.w + bb.w);
      }
      const float4 va = *(const float4*)(zr + ZG_GV + h * 64 + c4 * 2), vb = *(const float4*)(zr + ZG_GV + h * 64 + c4 * 2 + 4);
      const float vv[8] = {va.x, va.y, va.z, va.w, vb.x, vb.y, vb.z, vb.w};
#pragma unroll
      for (int j = 0; j < 8; ++j) {
        const u16 hv = f2bf(vv[j]); const int v = c4 * 2 + j;
        *(u16*)(VT + (0 * 64 + v) * 144 + pos * 2) = hv; *(u16*)(VT + (1 * 64 + v) * 144 + (63 - pos) * 2) = hv;
      }
    }
    __syncthreads();
#pragma unroll
    for (int q = 0; q < 8; ++q) { const int col = wid * 8 + q, d = col >> 5, c = col & 31; float* gp = gl + (d * 64 + lane) * 33 + c; *gp = wave_scan_incl(*gp, lane); }
    __syncthreads();
    {
#pragma unroll
      for (int e = 0; e < 2; ++e) {
        const int idx = tid + e * 512, d = idx >> 9, i = (idx >> 3) & 63, c4 = (idx & 7) * 4, pos = d ? 63 - i : i;
        float qo[4], ko[4];
#pragma unroll
        for (int j = 0; j < 4; ++j) {
          const float bi = gl[(d * 64 + i) * 33 + c4 + j], bm = gl[(d * 64 + 31) * 33 + c4 + j];
          qo[j] = qraw[pos * 33 + c4 + j] * __expf(bi - bm); ko[j] = kraw[pos * 33 + c4 + j] * __expf(bm - bi);
        }
        *(u32x2*)(Qp + (d * 64 + i) * 80 + c4 * 2) = u32x2{cvtpk(qo[0], qo[1]), cvtpk(qo[2], qo[3])};
        *(u32x2*)(Kp + (d * 64 + i) * 80 + c4 * 2) = u32x2{cvtpk(ko[0], ko[1]), cvtpk(ko[2], ko[3])};
      }
      const int chain = sdir * 8 + b * 4 + h;
      const int n = sdir == 0 ? pc : (pc < 4 ? 3 - pc : 4 + 255 - (pc - 4)), g = n / GLG;
      if (g != g_cached || bh != bh_cached) {
#pragma unroll
        for (int j = 0; j < 8; ++j) G[j] = 0.f;
        const float* at = p.gst() + (size_t)chain * NGRP * 2048 + sk * 64 + sv0;
        const float* dt = p.gst() + (size_t)16 * NGRP * 2048 + (size_t)chain * NGRP * 32 + sk;
        for (int gg = 0; gg < g; ++gg) {
          const float4 a0 = *(const float4*)(at + (size_t)gg * 2048), a1 = *(const float4*)(at + (size_t)gg * 2048 + 4); const float dd = dt[gg * 32];
          G[0] = G[0] * dd + a0.x; G[1] = G[1] * dd + a0.y; G[2] = G[2] * dd + a0.z; G[3] = G[3] * dd + a0.w;
          G[4] = G[4] * dd + a1.x; G[5] = G[5] * dd + a1.y; G[6] = G[6] * dd + a1.z; G[7] = G[7] * dd + a1.w;
        }
        g_cached = g; bh_cached = bh;
      }
      const float* lp = p.gds() + ((size_t)chain * NCH + n) * 2048 + sk * 64 + sv0;
      const float4 l0 = *(const float4*)lp, l1 = *(const float4*)(lp + 4);
      const float dp = p.gdv()[((size_t)chain * NCH + n) * 32 + sk];
      const float em = __expf(gl[(sdir * 64 + 31) * 33 + sk]);
      const float sv[8] = {l0.x + dp * G[0], l0.y + dp * G[1], l0.z + dp * G[2], l0.w + dp * G[3], l1.x + dp * G[4], l1.y + dp * G[5], l1.z + dp * G[6], l1.w + dp * G[7]};
#pragma unroll
      for (int j = 0; j < 8; ++j) *(u16*)(ST + (sdir * 64 + sv0 + j) * 80 + sk * 2) = f2bf(sv[j] * em);
    }
    __syncthreads();
    {
      const int d = wid >> 2, ib = (wid >> 1) & 1, vb = wid & 1;
      const char* Qd = Qp + d * 64 * 80; const char* Kd = Kp + d * 64 * 80; const char* Vd = VT + d * 64 * 144; const char* Sd = ST + d * 64 * 80;
      bf16x8 qf[2];
#pragma unroll
      for (int s2 = 0; s2 < 2; ++s2) qf[s2] = *(const bf16x8*)(Qd + (ib * 32 + r32) * 80 + (16 * s2 + 8 * hi) * 2);
#pragma unroll
      for (int jb = 0; jb < 2; ++jb) {
        if (jb <= ib) {
          f32x16 x = {};
#pragma unroll
          for (int s2 = 0; s2 < 2; ++s2) {
            const bf16x8 kf = *(const bf16x8*)(Kd + (jb * 32 + r32) * 80 + (16 * s2 + 8 * hi) * 2);
            x = __builtin_amdgcn_mfma_f32_32x32x16_bf16(qf[s2], kf, x, 0, 0, 0);
          }
#pragma unroll
          for (int r = 0; r < 16; ++r) {
            const int il = crow(r, hi), i = ib * 32 + il, j = jb * 32 + r32;
            *(u16*)(Ax + il * 144 + j * 2) = f2bf(j <= i ? x[r] : 0.f);
          }
        }
      }
      asm volatile("s_waitcnt lgkmcnt(0)" ::: "memory");
      f32x16 o = {};
#pragma unroll
      for (int s4 = 0; s4 < 4; ++s4) {
        if (s4 < 2 * (ib + 1)) {
          const bf16x8 af = *(const bf16x8*)(Ax + r32 * 144 + (16 * s4 + 8 * hi) * 2);
          const bf16x8 vf = *(const bf16x8*)(Vd + (vb * 32 + r32) * 144 + (16 * s4 + 8 * hi) * 2);
          o = __builtin_amdgcn_mfma_f32_32x32x16_bf16(af, vf, o, 0, 0, 0);
        }
      }
#pragma unroll
      for (int s2 = 0; s2 < 2; ++s2) {
        const bf16x8 sf = *(const bf16x8*)(Sd + (vb * 32 + r32) * 80 + (16 * s2 + 8 * hi) * 2);
        o = __builtin_amdgcn_mfma_f32_32x32x16_bf16(qf[s2], sf, o, 0, 0, 0);
      }
#pragma unroll
      for (int r = 0; r < 16; ++r) {
        const int i = ib * 32 + crow(r, hi), pos = d ? 63 - i : i;
        Of[(d * 64 + pos) * 65 + vb * 32 + r32] = o[r];
      }
    }
    __syncthreads();
    {
      const int pos = tid >> 3, v0 = (tid & 7) * 8;
      float* op = p.glao() + (size_t)(tok0 + pos) * 256 + h * 64 + v0;
      float r8[8];
#pragma unroll
      for (int j = 0; j < 8; ++j) r8[j] = Of[pos * 65 + v0 + j] + Of[(64 + pos) * 65 + v0 + j];
      *(float4*)op = make_float4(r8[0], r8[1], r8[2], r8[3]); *(float4*)(op + 4) = make_float4(r8[4], r8[5], r8[6], r8[7]);
    }
    __syncthreads();
  }
}

__device__ __forceinline__ void phase_mix(const Params& p, int layer, int bid, int nb, char* lds) {
  float* part = (float*)lds;
  u16* tile = (u16*)(lds + 4096);
  const int tid = ltid(), wid = tid >> 6, lane = tid & 63;
  const int ntok = layer == 0 ? TT : TL;
  for (int it = bid; it < ntok / 64; it += nb) {
    const int tok0 = it * 64;
    float vh[32], vf[32]; float sh = 0, sf = 0;
#pragma unroll
    for (int c = 0; c < 32; ++c) {
      vh[c] = p.hyo()[(size_t)(wid * 32 + c) * TT + tok0 + lane]; vf[c] = p.fno()[(size_t)(wid * 32 + c) * TT + tok0 + lane];
      sh += vh[c] * vh[c]; sf += vf[c] * vf[c];
    }
    part[(0 * 8 + wid) * 64 + lane] = sh; part[(1 * 8 + wid) * 64 + lane] = sf;
    __syncthreads();
    float th = 0, tf = 0;
#pragma unroll
    for (int q = 0; q < 8; ++q) { th += part[(0 * 8 + q) * 64 + lane]; tf += part[(1 * 8 + q) * 64 + lane]; }
    const float rh = rsqrtf(th * (1.f / 256.f) + EPS), rf = rsqrtf(tf * (1.f / 256.f) + EPS);
#pragma unroll
    for (int c = 0; c < 32; ++c) { tile[lane * 520 + wid * 32 + c] = f2bf(vh[c] * rh); tile[lane * 520 + 256 + wid * 32 + c] = f2bf(vf[c] * rf); }
    __syncthreads();
    for (int g = tid; g < 64 * 64; g += NTHR) {
      const int tl = g >> 6, cg = g & 63;
      const u32x4 w = *(const u32x4*)(tile + tl * 520 + cg * 8);
      *(u32x4*)(p.ymix() + (size_t)(tok0 + tl) * DM + (cg < 32 ? 256 + cg * 8 : 768 + (cg - 32) * 8)) = w;
    }
    for (int tl = wid * 8; tl < wid * 8 + 8; ++tl) {
      const int tok = tok0 + tl;
      const float4 o = *(const float4*)(p.glao() + (size_t)tok * 256 + lane * 4);
      float ss = o.x * o.x + o.y * o.y + o.z * o.z + o.w * o.w;
#pragma unroll
      for (int off = 8; off > 0; off >>= 1) ss += __shfl_xor(ss, off, 64);
      const float rs = rsqrtf(ss * (1.f / 64.f) + EPS);
      const float4 g = *(const float4*)(p.zg() + (size_t)tok * ZG_W + ZG_OG + lane * 4);
      u32x2 w; w[0] = cvtpk(o.x * rs * silu_f(g.x), o.y * rs * silu_f(g.y)); w[1] = cvtpk(o.z * rs * silu_f(g.z), o.w * rs * silu_f(g.w));
      *(u32x2*)(p.ymix() + (size_t)tok * DM + 512 + lane * 4) = w;
    }
    __syncthreads();
  }
}

struct EpiOut {
  const Params* pp; int layer;
  __device__ __forceinline__ void operator()(const f32x4 (&acc)[2][2][4][2], const G8Unit& u, int wr, int wc, int fr, int fq) const {
    const Params& p = *pp;
    const float* g1 = p.mod() + ((size_t)layer * 3 + modv(u.pm * 256)) * 6144 + 2 * DM;
#pragma unroll
    for (int bj = 0; bj < 2; ++bj) {
      const int c0 = u.pn * 256 + bj * 128 + wc * 32 + 8 * fq;
      const f32x4 ga = *(const f32x4*)(g1 + c0), gb = *(const f32x4*)(g1 + c0 + 4);
#pragma unroll
      for (int ai = 0; ai < 2; ++ai)
#pragma unroll
        for (int m = 0; m < 4; ++m) {
          const int tok = u.pm * 256 + ai * 128 + wr * 64 + m * 16 + fr;
          const float* xr = resid_row(p, layer == 0 ? 0 : 1, tok) + c0;
          float* xo = p.X() + (size_t)tok * DM + c0;
          const f32x4 xa = *(const f32x4*)xr, xb = *(const f32x4*)(xr + 4);
          *(f32x4*)xo = xa + ga * acc[ai][bj][m][0]; *(f32x4*)(xo + 4) = xb + gb * acc[ai][bj][m][1];
        }
    }
  }
};
__device__ __forceinline__ void phase_gemm_out(const Params& p, int layer, int bid, int nb, char* lds) {
  G8Plain S; S.nM = (layer == 0 ? TT : TL) / 256; S.nN = DM / 256; S.Kb = 2 * DM; S.G = nb; S.c = bid; S.Bt = (const char*)(p.bt_out() + (size_t)layer * DM * DM);
  EpiOut E; E.pp = &p; E.layer = layer;
  gemm8_phase<false>(lds, (const char*)p.ymix(), 2 * DM, S, E);
}

__device__ __forceinline__ void phase_norm2_router(const Params& p, int layer, int bid, int nb, char* lds) {
  float* rwl = (float*)lds;
  int* lcnt = (int*)(lds + 131072);
  int* lbase = lcnt + 32;
  int* ent = lbase + 32;
  float* entw = (float*)(ent + 2 * 1024);
  const int tid = ltid(), wid = tid >> 6, lane = tid & 63;
  const int ntok = layer == 0 ? TT : TL;
  const float* rw = p.router_w() + (size_t)layer * DM * NE;
  for (int i = tid; i < DM * NE / 4; i += NTHR) {
    const int k = i >> 3, q4 = i & 7;
    ((float4*)rwl)[q4 * 1024 + ((k & 3) * 256 + (k >> 2))] = ((const float4*)rw)[i];
  }
  if (tid < 32) lcnt[tid] = 0;
  __syncthreads();
  const float* gn = p.norm2_g() + layer * DM; const float* rb = p.router_b() + layer * NE;
  const int per = (ntok + nb - 1) / nb, t_beg = bid * per, t_end = min(ntok, t_beg + per);
  for (int tok = t_beg + wid; tok < t_end; tok += 8) {
    const float* xr = p.X() + (size_t)tok * DM;
    float v[16];
#pragma unroll
    for (int i = 0; i < 4; ++i) { const float4 a = *(const float4*)(xr + lane * 4 + i * 256); v[4 * i] = a.x; v[4 * i + 1] = a.y; v[4 * i + 2] = a.z; v[4 * i + 3] = a.w; }
    float ss = 0;
#pragma unroll
    for (int i = 0; i < 16; ++i) ss += v[i] * v[i];
    ss = wave_sum(ss);
    const float rs = rsqrtf(ss * (1.f / DM) + EPS);
    const float* md = p.mod() + ((size_t)layer * 3 + modv(tok)) * 6144 + 3 * DM;
#pragma unroll
    for (int i = 0; i < 4; ++i) {
      const int c = lane * 4 + i * 256;
      const float4 g = *(const float4*)(gn + c), sh = *(const float4*)(md + c), sc = *(const float4*)(md + DM + c);
      v[4 * i] = v[4 * i] * rs * g.x * (1.f + sc.x) + sh.x; v[4 * i + 1] = v[4 * i + 1] * rs * g.y * (1.f + sc.y) + sh.y;
      v[4 * i + 2] = v[4 * i + 2] * rs * g.z * (1.f + sc.z) + sh.z; v[4 * i + 3] = v[4 * i + 3] * rs * g.w * (1.f + sc.w) + sh.w;
    }
    store_row_i8(v, p.H() + (size_t)tok * DM, p.hs() + tok, lane);
    float lg[32];
#pragma unroll
    for (int e = 0; e < 32; ++e) lg[e] = 0.f;
#pragma unroll
    for (int i = 0; i < 16; ++i) {
      const float4* wr4 = (const float4*)rwl + ((i & 3) * 256 + (i >> 2) * 64 + lane);
#pragma unroll
      for (int q = 0; q < 8; ++q) { const float4 w = wr4[q * 1024]; lg[4 * q] += v[i] * w.x; lg[4 * q + 1] += v[i] * w.y; lg[4 * q + 2] += v[i] * w.z; lg[4 * q + 3] += v[i] * w.w; }
    }
    float r16[16], r8[8], r4[4], r2[2], lv;
    { const bool up = lane & 32;
#pragma unroll
      for (int e = 0; e < 16; ++e) { const float keep = up ? lg[16 + e] : lg[e], send = up ? lg[e] : lg[16 + e]; r16[e] = keep + __shfl_xor(send, 32, 64); } }
    { const bool up = lane & 16;
#pragma unroll
      for (int e = 0; e < 8; ++e) { const float keep = up ? r16[8 + e] : r16[e], send = up ? r16[e] : r16[8 + e]; r8[e] = keep + __shfl_xor(send, 16, 64); } }
    { const bool up = lane & 8;
#pragma unroll
      for (int e = 0; e < 4; ++e) { const float keep = up ? r8[4 + e] : r8[e], send = up ? r8[e] : r8[4 + e]; r4[e] = keep + __shfl_xor(send, 8, 64); } }
    { const bool up = lane & 4;
#pragma unroll
      for (int e = 0; e < 2; ++e) { const float keep = up ? r4[2 + e] : r4[e], send = up ? r4[e] : r4[2 + e]; r2[e] = keep + __shfl_xor(send, 4, 64); } }
    { const bool up = lane & 2; const float keep = up ? r2[1] : r2[0], send = up ? r2[0] : r2[1]; lv = keep + __shfl_xor(send, 2, 64); }
    lv += __shfl_xor(lv, 1, 64);
    lv += rb[lane >> 1];
    int ids[4]; float vals[4];
#pragma unroll
    for (int k = 0; k < 4; ++k) {
      float mx = lv;
#pragma unroll
      for (int o = 32; o > 0; o >>= 1) mx = fmaxf(mx, __shfl_xor(mx, o, 64));
      const unsigned long long bal = __ballot(lv == mx);
      const int win = __ffsll((long long)bal) - 1;
      ids[k] = win >> 1; vals[k] = mx;
      if ((lane >> 1) == ids[k]) lv = -3.4e38f;
    }
    if (lane == 0) {
      const float mx = vals[0];
      float ex[4], sum = 0;
#pragma unroll
      for (int k = 0; k < 4; ++k) { ex[k] = __expf(vals[k] - mx); sum += ex[k]; }
      const float inv = 1.f / sum;
#pragma unroll
      for (int k = 0; k < 4; ++k) {
        const int lp = atomicAdd(&lcnt[ids[k]], 1);
        const int slot = (tok - t_beg) * 4 + k;
        ent[2 * slot] = tok * 4 + k; ent[2 * slot + 1] = (ids[k] << 20) | lp; entw[slot] = ex[k] * inv;
      }
    }
  }
  __syncthreads();
  if (tid < 32) lbase[tid] = atomicAdd(&p.cnt()[layer * NE + tid], lcnt[tid]);
  __syncthreads();
  const int nas = (t_end > t_beg ? (t_end - t_beg) : 0) * 4;
  for (int s = tid; s < nas; s += NTHR) {
    const int tk = ent[2 * s], el = ent[2 * s + 1], e = el >> 20, pos = lbase[e] + (el & 0xFFFFF);
    p.rtok()[(size_t)e * TT + pos] = tk >> 2; p.rw()[(size_t)e * TT + pos] = entw[s];
    p.tslot()[tk] = (e << 20) | pos;
  }
}

struct G8Moe {
  const int* cnt;
  int ntn, Kb, G, c; const char* Bt; size_t bstride;
  const int* rtok;
  __device__ __forceinline__ bool next(int i, G8Unit& u) const {
    const int w = (i * 8 + (c & 7)) * (G >> 3) + (c >> 3); int acc = 0, rows = 0;
    for (int ee = 0; ee < NE; ++ee) {
      const int cc = cnt[ee], tiles = ((cc + 255) >> 8) * ntn;
      if (w < acc + tiles) { const int r = w - acc; u.e = ee; u.pm = r / ntn; u.pn = r % ntn; u.ce = cc; u.pre = rows; return true; }
      acc += tiles; rows += cc;
    }
    return false;
  }
  __device__ __forceinline__ unsigned a_off(const G8Unit& u, int row) const {
    const int r = min(u.pm * 256 + row, u.ce - 1);
    const int arow = rtok ? rtok[(size_t)u.e * TT + r] : u.pre + r;
    return (unsigned)arow * (unsigned)Kb;
  }
  __device__ __forceinline__ const char* b_ptr(const G8Unit& u) const { return Bt + (size_t)u.e * bstride + (size_t)u.pn * 256 * Kb; }
};
struct EpiGu {
  const float* bgl; u16* act; const float* hs; const float* swl; const int* rtok;
  __device__ __forceinline__ void operator()(const i32x4 (&acc)[2][2][4][2], const G8Unit& u, int wr, int wc, int fr, int fq) const {
    const int j0 = u.pn * 128 + wc * 32 + 8 * fq;
    const float* bg = bgl + (size_t)u.e * 2048 + 2 * j0;
    float bgt[8], bup[8], sg[8], su[8];
#pragma unroll
    for (int q = 0; q < 4; ++q) { const f32x4 t = *(const f32x4*)(bg + 4 * q); bgt[2 * q] = t[0]; bup[2 * q] = t[1]; bgt[2 * q + 1] = t[2]; bup[2 * q + 1] = t[3]; }
    {
      const float* sp = swl + (size_t)u.e * 2048 + u.pn * 256 + wc * 32 + 8 * fq;
      const f32x4 g0 = *(const f32x4*)sp, g1 = *(const f32x4*)(sp + 4), u0 = *(const f32x4*)(sp + 128), u1 = *(const f32x4*)(sp + 132);
#pragma unroll
      for (int j = 0; j < 4; ++j) { sg[j] = g0[j]; sg[4 + j] = g1[j]; su[j] = u0[j]; su[4 + j] = u1[j]; }
    }
#pragma unroll
    for (int ai = 0; ai < 2; ++ai)
#pragma unroll
      for (int m = 0; m < 4; ++m) {
        const int r = u.pm * 256 + ai * 128 + wr * 64 + m * 16 + fr;
        if (r < u.ce) {
          const float sa = hs[rtok[(size_t)u.e * TT + r]];
          float o[8];
#pragma unroll
          for (int n = 0; n < 2; ++n)
#pragma unroll
            for (int j = 0; j < 4; ++j) {
              const float gate = fminf((float)acc[ai][0][m][n][j] * sa * sg[4 * n + j] + bgt[4 * n + j], 7.f);
              const float up = fminf(fmaxf((float)acc[ai][1][m][n][j] * sa * su[4 * n + j] + bup[4 * n + j], -7.f), 7.f);
              o[4 * n + j] = (up + 1.f) * gate * __builtin_amdgcn_rcpf(1.f + __expf(-1.702f * gate));
            }
          *(u32x4*)(act + (size_t)(u.pre + r) * DFF + j0) = u32x4{cvtpk(o[0], o[1]), cvtpk(o[2], o[3]), cvtpk(o[4], o[5]), cvtpk(o[6], o[7])};
        }
      }
  }
};
struct EpiDn {
  const float* bdl; const float* rw; u16* yd;
  __device__ __forceinline__ void operator()(const f32x4 (&acc)[2][2][4][2], const G8Unit& u, int wr, int wc, int fr, int fq) const {
#pragma unroll
    for (int bj = 0; bj < 2; ++bj) {
      const int c0 = u.pn * 256 + bj * 128 + wc * 32 + 8 * fq;
      const f32x4 ba = *(const f32x4*)(bdl + (size_t)u.e * DM + c0), bb = *(const f32x4*)(bdl + (size_t)u.e * DM + c0 + 4);
#pragma unroll
      for (int ai = 0; ai < 2; ++ai)
#pragma unroll
        for (int m = 0; m < 4; ++m) {
          const int r = u.pm * 256 + ai * 128 + wr * 64 + m * 16 + fr;
          if (r < u.ce) {
            const float wgt = rw[(size_t)u.e * TT + r];
            const f32x4 a = (acc[ai][bj][m][0] + ba) * wgt, b = (acc[ai][bj][m][1] + bb) * wgt;
            *(u32x4*)(yd + (size_t)(u.pre + r) * DM + c0) = u32x4{cvtpk(a[0], a[1]), cvtpk(a[2], a[3]), cvtpk(b[0], b[1]), cvtpk(b[2], b[3])};
          }
        }
    }
  }
};
__device__ __forceinline__ void phase_moe_gu(const Params& p, int layer, int bid, int nb, char* lds) {
  int* scnt = (int*)(lds + 131072);
  if (ltid() < NE) scnt[ltid()] = p.cnt()[layer * NE + ltid()];
  __syncthreads();
  G8Moe S; S.cnt = scnt; S.ntn = 8; S.Kb = DM; S.G = nb; S.c = bid; S.Bt = (const char*)(p.bt_gu() + (size_t)layer * NE * 2048 * DM); S.bstride = (size_t)2048 * DM; S.rtok = p.rtok();
  EpiGu E; E.bgl = p.moe_b_gu() + (size_t)layer * NE * 2048; E.act = p.act(); E.hs = p.hs(); E.swl = p.swgu() + (size_t)layer * NE * 2048; E.rtok = p.rtok();
  gemm8_phase<true>(lds, (const char*)p.H(), DM, S, E);
}
__device__ __forceinline__ void phase_moe_dn(const Params& p, int layer, int bid, int nb, char* lds) {
  int* scnt = (int*)(lds + 131072);
  if (ltid() < NE) scnt[ltid()] = p.cnt()[layer * NE + ltid()];
  __syncthreads();
  G8Moe S; S.cnt = scnt; S.ntn = 4; S.Kb = 2 * DFF; S.G = nb; S.c = bid; S.Bt = (const char*)(p.bt_dn() + (size_t)layer * NE * DM * DFF); S.bstride = (size_t)DM * DFF * 2; S.rtok = nullptr;
  EpiDn E; E.bdl = p.moe_b_down() + (size_t)layer * NE * DM; E.rw = p.rw(); E.yd = p.yd();
  gemm8_phase<false>(lds, (const char*)p.act(), 2 * DFF, S, E);
}

__device__ __forceinline__ void phase_final(const Params& p, int bid, int nb, char* lds) {
  int* pre = (int*)lds;
  expert_prefix(p.cnt() + NE, pre); __syncthreads();
  const int wid = ltid() >> 6, lane = ltid() & 63;
  for (int tok = bid * 8 + wid; tok < TL; tok += nb * 8) {
    float v[16];
    load_row_comb(p, 1, 1, tok, lane, pre, v);
    float ss = 0;
#pragma unroll
    for (int i = 0; i < 16; ++i) ss += v[i] * v[i];
    ss = wave_sum(ss);
    const float rs = rsqrtf(ss * (1.f / DM) + EPS);
    float* o = p.out() + (size_t)tok * DM;
#pragma unroll
    for (int i = 0; i < 4; ++i) {
      const int c = lane * 4 + i * 256;
      const float4 g = *(const float4*)(p.final_g() + c);
      *(float4*)(o + c) = make_float4(v[4 * i] * rs * g.x, v[4 * i + 1] * rs * g.y, v[4 * i + 2] * rs * g.z, v[4 * i + 3] * rs * g.w);
    }
  }
}

#define XB_TMO      128
#define XB_XCNT(j)  (256  + 64 * (j))
#define XB_XSUB(j)  (1280 + 64 * (j))
#define XB_XGEN(j)  (2304 + 64 * (j))
#define XB_TOP      3328
#define XB_TOPGEN   3392
#define XCD_BAR_WORDS 3456
#define XB_SPIN_CAP (1u << 18)
#define LAS __attribute__((address_space(3)))

__device__ __forceinline__ unsigned xb_ld(unsigned* p)              { return __hip_atomic_load(p, __ATOMIC_RELAXED, __HIP_MEMORY_SCOPE_AGENT); }
__device__ __forceinline__ unsigned xb_add(unsigned* p, unsigned v) { return __hip_atomic_fetch_add(p, v, __ATOMIC_RELAXED, __HIP_MEMORY_SCOPE_AGENT); }
__device__ __forceinline__ unsigned xb_xcc_id() { return (unsigned)__builtin_amdgcn_s_getreg((3 << 11) | 20) & 0xFu; }
#define XB_SPIN(cond, bar) do { unsigned _sp = 0; while (cond) { __builtin_amdgcn_s_sleep(1); \
    if ((++_sp & 255u) == 0u) { if (xb_ld(&(bar)[XB_TMO])) break; if (_sp > XB_SPIN_CAP) { atomicAdd(&(bar)[XB_TMO], 1u); break; } } } } while (0)

struct XcdBarrier {
    unsigned* bar; unsigned x;
    volatile LAS unsigned* st;
};

__device__ __forceinline__ XcdBarrier xcd_barrier_post(unsigned* bar, volatile LAS unsigned* st) {
    XcdBarrier b; b.bar = bar; b.x = xb_xcc_id(); b.st = st;
    if (threadIdx.x == 0) (void)xb_add(&bar[XB_XCNT(b.x)], 1u);
    return b;
}
__device__ __forceinline__ void xcd_barrier_complete(unsigned* bar, unsigned x, unsigned& nloc, unsigned& nx) {
    const unsigned G = gridDim.x * gridDim.y * gridDim.z;
    unsigned sum, cnt, mine, sp = 0u;
    for (;;) {
        sum = 0u; cnt = 0u; mine = 0u;
#pragma unroll
        for (unsigned j = 0; j < 16; ++j) { const unsigned c = xb_ld(&bar[XB_XCNT(j)]); sum += c; cnt += (c > 0u) ? 1u : 0u; mine = (j == x) ? c : mine; }
        if (sum == G) break;
        __builtin_amdgcn_s_sleep(1);
        if ((++sp & 255u) == 0u) { if (xb_ld(&bar[XB_TMO])) break; if (sp > XB_SPIN_CAP) { atomicAdd(&bar[XB_TMO], 1u); break; } }
    }
    nloc = mine > 0u ? mine : 1u; nx = cnt > 0u ? cnt : 1u;
}

__device__ __forceinline__ void xcd_barrier(const XcdBarrier& b) {
    asm volatile("s_waitcnt vmcnt(0)" ::: "memory");
    __syncthreads();
    if (threadIdx.x == 0) {
        unsigned* bar = b.bar;
        __builtin_amdgcn_s_waitcnt(0);
        unsigned nloc = b.st[0], nx = b.st[1];
        if (nloc == 0u) { xcd_barrier_complete(bar, b.x, nloc, nx); b.st[0] = nloc; b.st[1] = nx; }
        const unsigned old = xb_add(&bar[XB_XSUB(b.x)], 1u);
        const unsigned gen = old / nloc;
        if (old + 1u == (gen + 1u) * nloc) {
            __builtin_amdgcn_fence(__ATOMIC_RELEASE, "agent");
            asm volatile("s_waitcnt vmcnt(0)" ::: "memory");
            const unsigned og = xb_add(&bar[XB_TOP], 1u);
            const unsigned tg = og / nx;
            if (og + 1u == (tg + 1u) * nx) xb_add(&bar[XB_TOPGEN], 1u);
            else XB_SPIN(xb_ld(&bar[XB_TOPGEN]) == tg, bar);
            __builtin_amdgcn_fence(__ATOMIC_ACQUIRE, "agent");
            xb_add(&bar[XB_XGEN(b.x)], 1u);
            asm volatile("s_waitcnt vmcnt(0)" ::: "memory");
        } else {
            XB_SPIN(xb_ld(&bar[XB_XGEN(b.x)]) == gen, bar);
            __builtin_amdgcn_fence(__ATOMIC_ACQUIRE, "agent");
            asm volatile("s_waitcnt vmcnt(0)" ::: "memory");
        }
    }
    __syncthreads();
}

constexpr int LDS_MAIN = 147456;
constexpr int LDS_BYTES = LDS_MAIN + 1024;
enum { PH_TABLES = 0, PH_MOD, PH_FOLD, PH_CONVERT, PH_HYMLP, PH_HYFILT, PH_NORM1, PH_GEMM_IN, PH_QKV, PH_ATTN, PH_FFTMIX,
       PH_GLA_A, PH_GLA_B, PH_GLA_C, PH_MIX, PH_GEMM_OUT, PH_NORM2, PH_MOE_GU, PH_MOE_DN, PH_FINAL };

__device__ __forceinline__ Params make_params() {
  const __attribute__((address_space(4))) char* kb = (const __attribute__((address_space(4))) char*)__builtin_amdgcn_kernarg_segment_ptr();
  asm volatile("" : "+s"(kb));
  Params p; p.kb = kb; return p;
}
#ifndef MK_LAUNCHES
#define MK_LAUNCHES 1
#endif
__global__ void __launch_bounds__(NTHR, 2) k_mega(ParamsData pd) {
  extern __shared__ __attribute__((aligned(1024))) char lds[];
  const int bid = blockIdx.x, nb = gridDim.x;
  if (threadIdx.x == 0) *(uint4*)(lds + LDS_MAIN) = make_uint4(0u, 0u, 0u, 0u);
  __syncthreads();
  XcdBarrier bar = xcd_barrier_post(make_params().bar(), (volatile LAS unsigned*)(lds + LDS_MAIN));
#ifndef DBLMASK
#define DBLMASK 0u
#endif
#define RUNPH(bit, call) do { call; if (DBLMASK & (1u << (bit))) { __syncthreads(); call; } } while (0)
  RUNPH(13, phase_tables(make_params(), bid, nb); phase_mod(make_params(), bid, nb, lds); phase_fold(make_params(), bid, nb, lds));
  RUNPH(0, phase_convert(make_params(), bid, nb, lds));
  phase_hy_mlp(make_params(), 0, SEQ, make_params().hfb(), make_params().hssq(), bid, nb, lds);
  phase_hy_mlp(make_params(), 1, SEQ, make_params().hfb() + (size_t)2 * 256 * SEQ, make_params().hssq() + 256, bid, nb, lds);
  phase_hy_mlp(make_params(), 0, LC, make_params().hfc(), make_params().hssq() + 512, bid, nb, lds);
  xcd_barrier(bar);
  RUNPH(2, phase_hy_filtfft(make_params(), bid, nb, lds));
  phase_quant_in(make_params(), bid, nb);
#define MK_LAYER(l) do { \
  phase_norm1(make_params(), l, bid, nb, lds); if ((DBLMASK & (1u << 14)) && l == 0) { __syncthreads(); phase_norm1(make_params(), l, bid, nb, lds); } \
  xcd_barrier(bar); \
  RUNPH(3, phase_gemm_in(make_params(), l, bid, nb, lds)); \
  xcd_barrier(bar); \
  RUNPH(4, phase_qkv(make_params(), l, bid, nb, lds)); \
  RUNPH(5, phase_gla_a(make_params(), l, bid, nb, lds)); \
  xcd_barrier(bar); \
  RUNPH(6, phase_attn(make_params(), l, bid, nb, lds)); \
  RUNPH(7, phase_fftmix(make_params(), l, bid, nb, lds)); \
  RUNPH(9, phase_gla_c(make_params(), l, bid, nb, lds)); \
  xcd_barrier(bar); \
  RUNPH(10, phase_mix(make_params(), l, bid, nb, lds)); \
  xcd_barrier(bar); \
  phase_gemm_out(make_params(), l, bid, nb, lds); if ((DBLMASK & (1u << 16)) && l == 0) { __syncthreads(); phase_gemm_out(make_params(), l, bid, nb, lds); } \
  xcd_barrier(bar); \
  phase_norm2_router(make_params(), l, bid, nb, lds); \
  xcd_barrier(bar); \
  RUNPH(11, phase_moe_gu(make_params(), l, bid, nb, lds)); \
  xcd_barrier(bar); \
  RUNPH(12, phase_moe_dn(make_params(), l, bid, nb, lds)); \
  xcd_barrier(bar); \
  } while (0)
  MK_LAYER(0);
  MK_LAYER(1);
#undef MK_LAYER
  RUNPH(15, phase_final(make_params(), bid, nb, lds));
}
static size_t carve(char*& cur, size_t bytes) { char* r = cur; cur += (bytes + 1023) & ~(size_t)1023; return (size_t)(uintptr_t)r; }
#define CARVE(T, field, n) p.field = (T*)carve(cur, (size_t)(n) * sizeof(T))

extern "C" void kernel_launch(void* const* d_in, const int* in_sizes, int n_in, void* d_out, int out_size, void* d_ws, size_t ws_size, hipStream_t stream) {
  ParamsData p; memset(&p, 0, sizeof(p));
  const float** ins = (const float**)&p;
  for (int i = 0; i < 34; ++i) ins[i] = (const float*)d_in[i];
  p.out_ = (float*)d_out;
  p.ws_ = (char*)d_ws;
  if (WS_TOTAL > ws_size) { fprintf(stderr, "workspace too small: need %zu have %zu\n", (size_t)WS_TOTAL, ws_size); return; }
  hipMemsetAsync((char*)d_ws + OFF_bar, 0, OFF_mod - OFF_bar, stream);
  static int grid = 0;
  if (!grid) {
    int dev = 0, cus = 0, per_cu = 0;
    hipGetDevice(&dev);
    hipDeviceGetAttribute(&cus, hipDeviceAttributeMultiprocessorCount, dev);
    hipFuncSetAttribute((const void*)k_mega, hipFuncAttributeMaxDynamicSharedMemorySize, LDS_BYTES);
    hipOccupancyMaxActiveBlocksPerMultiprocessor(&per_cu, (const void*)k_mega, NTHR, LDS_BYTES);
    grid = cus * (per_cu < 1 ? per_cu : 1);
    if (grid != 256) fprintf(stderr, "unexpected grid %d (cus %d per_cu %d)\n", grid, cus, per_cu);
  }
  hipLaunchKernelGGL(k_mega, dim3(grid), dim3(NTHR), LDS_BYTES, stream, p);
}
```

```cpp
#include <hip/hip_runtime.h>
#include <hip/hip_bf16.h>
#include <cstdio>
#include <cstdint>
#include <cstring>
#include <cstddef>
#include <type_traits>

typedef unsigned short u16;
using bf16x8 = __attribute__((ext_vector_type(8))) short;
using s16x4  = __attribute__((ext_vector_type(4))) short;
using f32x4  = __attribute__((ext_vector_type(4))) float;
using f32x16 = __attribute__((ext_vector_type(16))) float;
using u32x4  = __attribute__((ext_vector_type(4))) unsigned;
using u32x2  = __attribute__((ext_vector_type(2))) unsigned;

constexpr int DM = 1024, NB = 2, SEQ = 16384, LC = 256;
constexpr int TL = NB * SEQ;
constexpr int TC = NB * LC;
constexpr int TT = TL + TC;
constexpr int NIN = 2816;
constexpr int DIN0 = 2240;
constexpr int NE = 32, TOPK = 4, DFF = 1024;
constexpr int SKV = SEQ + LC;
constexpr int NTHR = 512;
constexpr float EPS = 1e-6f;
constexpr float A_SCALE = 0.10206207261596575f;
constexpr float A_QSCALE = A_SCALE * 1.4426950408889634f;
constexpr int ZG_W = 1152, ZG_GQ = 0, ZG_GK = 128, ZG_KR = 256, ZG_GV = 384, ZG_GP = 640, ZG_OG = 896;
constexpr int ZT_HY = 0, ZT_FR = 768, ZT_FI = 1024, ZT_R = 1280;
constexpr int NCH = 260;
constexpr int FM = 16384;
constexpr int HSP = FM / 2 + 1;

constexpr size_t ws_al(size_t b) { return (b + 1023) & ~(size_t)1023; }
constexpr size_t OFF_bar = 0;
constexpr size_t OFF_cnt = OFF_bar + ws_al((size_t)(4096) * sizeof(unsigned));
constexpr size_t OFF_hssq = OFF_cnt + ws_al((size_t)(64) * sizeof(int));
constexpr size_t OFF_kmx = OFF_hssq + ws_al((size_t)(768) * sizeof(float));
constexpr size_t OFF_mod = OFF_kmx + ws_al((size_t)(128) * sizeof(unsigned));
constexpr size_t OFF_ropec = OFF_mod + ws_al((size_t)(2 * 3 * 6144) * sizeof(float));
constexpr size_t OFF_ropes = OFF_ropec + ws_al((size_t)(SEQ * 16) * sizeof(float));
constexpr size_t OFF_tw = OFF_ropes + ws_al((size_t)(SEQ * 16) * sizeof(float));
constexpr size_t OFF_bt_in = OFF_tw + ws_al((size_t)(FM) * sizeof(float2));
constexpr size_t OFF_bt_qkv = OFF_bt_in + ws_al((size_t)((size_t)2 * NIN * DM) * sizeof(u16));
constexpr size_t OFF_bt_out = OFF_bt_qkv + ws_al((size_t)(2 * 1024 * 384) * sizeof(u16));
constexpr size_t OFF_bt_gu = OFF_bt_out + ws_al((size_t)((size_t)2 * DM * DM) * sizeof(u16));
constexpr size_t OFF_bt_dn = OFF_bt_gu + ws_al((size_t)((size_t)2 * NE * 2048 * DM) * sizeof(u16));
constexpr size_t OFF_hfb = OFF_bt_dn + ws_al((size_t)((size_t)2 * NE * DM * DFF) * sizeof(u16));
constexpr size_t OFF_hfc = OFF_hfb + ws_al((size_t)((size_t)2 * 2 * 256 * SEQ) * sizeof(float));
constexpr size_t OFF_hspec = OFF_hfc + ws_al((size_t)(2 * 256 * LC) * sizeof(float));
constexpr size_t OFF_H = OFF_hspec + ws_al((size_t)((size_t)2 * 256 * HSP) * sizeof(float4));
constexpr size_t OFF_zqkv = OFF_H + ws_al((size_t)((size_t)TT * DM) * sizeof(u16));
constexpr size_t OFF_zg = OFF_zqkv + ws_al((size_t)((size_t)TT * 384) * sizeof(u16));
constexpr size_t OFF_zt = OFF_zg + ws_al((size_t)((size_t)TT * ZG_W) * sizeof(float));
constexpr size_t OFF_Q = OFF_zt + ws_al((size_t)((size_t)ZT_R * TT) * sizeof(float));
constexpr size_t OFF_KV = OFF_Q + ws_al((size_t)((size_t)2 * 4 * SKV * 96) * sizeof(u16));
constexpr size_t OFF_ymix = OFF_KV + ws_al((size_t)((size_t)2 * 4 * SKV * 160) * sizeof(u16));
constexpr size_t OFF_hyo = OFF_ymix + ws_al((size_t)((size_t)TT * DM) * sizeof(u16));
constexpr size_t OFF_fno = OFF_hyo + ws_al((size_t)((size_t)256 * TT) * sizeof(float));
constexpr size_t OFF_glao = OFF_fno + ws_al((size_t)((size_t)256 * TT) * sizeof(float));
constexpr size_t OFF_gds = OFF_glao + ws_al((size_t)((size_t)TT * 256) * sizeof(float));
constexpr size_t OFF_gdv = OFF_gds + ws_al((size_t)((size_t)16 * NCH * 2048) * sizeof(float));
constexpr size_t OFF_gst = OFF_gdv + ws_al((size_t)((size_t)16 * NCH * 32) * sizeof(float));
constexpr size_t OFF_X = OFF_gst + ws_al((size_t)((size_t)16 * NCH * 2048) * sizeof(float));
constexpr size_t OFF_rtok = OFF_X + ws_al((size_t)((size_t)TT * DM) * sizeof(float));
constexpr size_t OFF_rw = OFF_rtok + ws_al((size_t)((size_t)NE * TT) * sizeof(int));
constexpr size_t OFF_tslot = OFF_rw + ws_al((size_t)((size_t)NE * TT) * sizeof(float));
constexpr size_t OFF_act = OFF_tslot + ws_al((size_t)((size_t)TT * 4) * sizeof(int));
constexpr size_t OFF_yd = OFF_act + ws_al((size_t)((size_t)TT * 4 * DFF) * sizeof(u16));
constexpr size_t OFF_swin = OFF_yd + ws_al((size_t)((size_t)TT * 4 * DM) * sizeof(u16));
constexpr size_t OFF_swgu = OFF_swin + ws_al((size_t)(2 * NIN) * sizeof(float));
constexpr size_t OFF_hs = OFF_swgu + ws_al((size_t)(2 * NE * 2048) * sizeof(float));
constexpr size_t OFF_hpart = OFF_hs + ws_al((size_t)(TT) * sizeof(float));
constexpr size_t WS_TOTAL = OFF_hpart + ws_al((size_t)(3 * 256 * 512) * sizeof(float));
struct ParamsData {
  const float *x_, *c_, *ctx_, *c_ctx_, *ada_w_, *ada_b_, *norm1_g_, *norm2_g_, *w_in_, *mla_q_g_, *mla_w_uq_, *mla_kv_g_, *mla_w_ukv_, *hy_conv_w_, *hy_conv_b_, *hy_w1_, *hy_b1_, *hy_w2_, *hy_b2_, *hy_w3_, *hy_freq_, *hy_bias_, *gla_gk_w_, *gla_gk_b_, *fnet_w_, *mix_g_, *w_out_, *router_w_, *router_b_, *moe_w_gu_, *moe_b_gu_, *moe_w_down_, *moe_b_down_, *final_g_;
  float* out_;
  char* ws_;
};
struct Params {
  const __attribute__((address_space(4))) char* kb;
  template <class T> __device__ __forceinline__ T karg(size_t off) const { return *(const __attribute__((address_space(4))) T*)(kb + off); }
  __device__ __forceinline__ const float* x() const { return karg<const float*>(offsetof(ParamsData, x_)); }
  __device__ __forceinline__ const float* c() const { return karg<const float*>(offsetof(ParamsData, c_)); }
  __device__ __forceinline__ const float* ctx() const { return karg<const float*>(offsetof(ParamsData, ctx_)); }
  __device__ __forceinline__ const float* c_ctx() const { return karg<const float*>(offsetof(ParamsData, c_ctx_)); }
  __device__ __forceinline__ const float* ada_w() const { return karg<const float*>(offsetof(ParamsData, ada_w_)); }
  __device__ __forceinline__ const float* ada_b() const { return karg<const float*>(offsetof(ParamsData, ada_b_)); }
  __device__ __forceinline__ const float* norm1_g() const { return karg<const float*>(offsetof(ParamsData, norm1_g_)); }
  __device__ __forceinline__ const float* norm2_g() const { return karg<const float*>(offsetof(ParamsData, norm2_g_)); }
  __device__ __forceinline__ const float* w_in() const { return karg<const float*>(offsetof(ParamsData, w_in_)); }
  __device__ __forceinline__ const float* mla_q_g() const { return karg<const float*>(offsetof(ParamsData, mla_q_g_)); }
  __device__ __forceinline__ const float* mla_w_uq() const { return karg<const float*>(offsetof(ParamsData, mla_w_uq_)); }
  __device__ __forceinline__ const float* mla_kv_g() const { return karg<const float*>(offsetof(ParamsData, mla_kv_g_)); }
  __device__ __forceinline__ const float* mla_w_ukv() const { return karg<const float*>(offsetof(ParamsData, mla_w_ukv_)); }
  __device__ __forceinline__ const float* hy_conv_w() const { return karg<const float*>(offsetof(ParamsData, hy_conv_w_)); }
  __device__ __forceinline__ const float* hy_conv_b() const { return karg<const float*>(offsetof(ParamsData, hy_conv_b_)); }
  __device__ __forceinline__ const float* hy_w1() const { return karg<const float*>(offsetof(ParamsData, hy_w1_)); }
  __device__ __forceinline__ const float* hy_b1() const { return karg<const float*>(offsetof(ParamsData, hy_b1_)); }
  __device__ __forceinline__ const float* hy_w2() const { return karg<const float*>(offsetof(ParamsData, hy_w2_)); }
  __device__ __forceinline__ const float* hy_b2() const { return karg<const float*>(offsetof(ParamsData, hy_b2_)); }
  __device__ __forceinline__ const float* hy_w3() const { return karg<const float*>(offsetof(ParamsData, hy_w3_)); }
  __device__ __forceinline__ const float* hy_freq() const { return karg<const float*>(offsetof(ParamsData, hy_freq_)); }
  __device__ __forceinline__ const float* hy_bias() const { return karg<const float*>(offsetof(ParamsData, hy_bias_)); }
  __device__ __forceinline__ const float* gla_gk_w() const { return karg<const float*>(offsetof(ParamsData, gla_gk_w_)); }
  __device__ __forceinline__ const float* gla_gk_b() const { return karg<const float*>(offsetof(ParamsData, gla_gk_b_)); }
  __device__ __forceinline__ const float* fnet_w() const { return karg<const float*>(offsetof(ParamsData, fnet_w_)); }
  __device__ __forceinline__ const float* mix_g() const { return karg<const float*>(offsetof(ParamsData, mix_g_)); }
  __device__ __forceinline__ const float* w_out() const { return karg<const float*>(offsetof(ParamsData, w_out_)); }
  __device__ __forceinline__ const float* router_w() const { return karg<const float*>(offsetof(ParamsData, router_w_)); }
  __device__ __forceinline__ const float* router_b() const { return karg<const float*>(offsetof(ParamsData, router_b_)); }
  __device__ __forceinline__ const float* moe_w_gu() const { return karg<const float*>(offsetof(ParamsData, moe_w_gu_)); }
  __device__ __forceinline__ const float* moe_b_gu() const { return karg<const float*>(offsetof(ParamsData, moe_b_gu_)); }
  __device__ __forceinline__ const float* moe_w_down() const { return karg<const float*>(offsetof(ParamsData, moe_w_down_)); }
  __device__ __forceinline__ const float* moe_b_down() const { return karg<const float*>(offsetof(ParamsData, moe_b_down_)); }
  __device__ __forceinline__ const float* final_g() const { return karg<const float*>(offsetof(ParamsData, final_g_)); }
  __device__ __forceinline__ float* out() const { return karg<float*>(offsetof(ParamsData, out_)); }
  __device__ __forceinline__ char* ws() const { return karg<char*>(offsetof(ParamsData, ws_)); }
  __device__ __forceinline__ unsigned* bar() const { return (unsigned*)(ws() + OFF_bar); }
  __device__ __forceinline__ int* cnt() const { return (int*)(ws() + OFF_cnt); }
  __device__ __forceinline__ float* hssq() const { return (float*)(ws() + OFF_hssq); }
  __device__ __forceinline__ unsigned* kmx() const { return (unsigned*)(ws() + OFF_kmx); }
  __device__ __forceinline__ float* mod() const { return (float*)(ws() + OFF_mod); }
  __device__ __forceinline__ float* ropec() const { return (float*)(ws() + OFF_ropec); }
  __device__ __forceinline__ float* ropes() const { return (float*)(ws() + OFF_ropes); }
  __device__ __forceinline__ float2* tw() const { return (float2*)(ws() + OFF_tw); }
  __device__ __forceinline__ signed char* bt_in() const { return (signed char*)(ws() + OFF_bt_in); }
  __device__ __forceinline__ u16* bt_qkv() const { return (u16*)(ws() + OFF_bt_qkv); }
  __device__ __forceinline__ u16* bt_out() const { return (u16*)(ws() + OFF_bt_out); }
  __device__ __forceinline__ signed char* bt_gu() const { return (signed char*)(ws() + OFF_bt_gu); }
  __device__ __forceinline__ u16* bt_dn() const { return (u16*)(ws() + OFF_bt_dn); }
  __device__ __forceinline__ float* hfb() const { return (float*)(ws() + OFF_hfb); }
  __device__ __forceinline__ float* hfc() const { return (float*)(ws() + OFF_hfc); }
  __device__ __forceinline__ float4* hspec() const { return (float4*)(ws() + OFF_hspec); }
  __device__ __forceinline__ signed char* H() const { return (signed char*)(ws() + OFF_H); }
  __device__ __forceinline__ float* hs() const { return (float*)(ws() + OFF_hs); }
  __device__ __forceinline__ float* hpart() const { return (float*)(ws() + OFF_hpart); }
  __device__ __forceinline__ float* swin() const { return (float*)(ws() + OFF_swin); }
  __device__ __forceinline__ float* swgu() const { return (float*)(ws() + OFF_swgu); }
  __device__ __forceinline__ float* btf() const { return (float*)(ws() + OFF_act); }
  __device__ __forceinline__ u16* zqkv() const { return (u16*)(ws() + OFF_zqkv); }
  __device__ __forceinline__ u16* zg() const { return (u16*)(ws() + OFF_zg); }
  __device__ __forceinline__ u16* zt() const { return (u16*)(ws() + OFF_zt); }
  __device__ __forceinline__ u16* Q() const { return (u16*)(ws() + OFF_Q); }
  __device__ __forceinline__ u16* KV() const { return (u16*)(ws() + OFF_KV); }
  __device__ __forceinline__ u16* ymix() const { return (u16*)(ws() + OFF_ymix); }
  __device__ __forceinline__ u16* hyo() const { return (u16*)(ws() + OFF_hyo); }
  __device__ __forceinline__ u16* fno() const { return (u16*)(ws() + OFF_fno); }
  __device__ __forceinline__ u16* glao() const { return (u16*)(ws() + OFF_glao); }
  __device__ __forceinline__ float* gds() const { return (float*)(ws() + OFF_gds); }
  __device__ __forceinline__ float* gdv() const { return (float*)(ws() + OFF_gdv); }
  __device__ __forceinline__ float* gst() const { return (float*)(ws() + OFF_gst); }
  __device__ __forceinline__ float* X() const { return (float*)(ws() + OFF_X); }
  __device__ __forceinline__ int* rtok() const { return (int*)(ws() + OFF_rtok); }
  __device__ __forceinline__ float* rw() const { return (float*)(ws() + OFF_rw); }
  __device__ __forceinline__ int* tslot() const { return (int*)(ws() + OFF_tslot); }
  __device__ __forceinline__ u16* act() const { return (u16*)(ws() + OFF_act); }
  __device__ __forceinline__ u16* yd() const { return (u16*)(ws() + OFF_yd); }
};


__device__ __forceinline__ u16 f2bf(float f) {
  unsigned u = __float_as_uint(f); u += 0x7FFFu + ((u >> 16) & 1u); return (u16)(u >> 16);
}
__device__ __forceinline__ float bf2f(u16 h) { return __uint_as_float(((unsigned)h) << 16); }
__device__ __forceinline__ unsigned cvtpk(float lo, float hi) {
  unsigned r; asm volatile("v_cvt_pk_bf16_f32 %0, %1, %2" : "=v"(r) : "v"(lo), "v"(hi)); return r;
}
__device__ __forceinline__ float4 ld4bf(const u16* p) { const u32x2 w = *(const u32x2*)p; return make_float4(__uint_as_float(w[0] << 16), __uint_as_float(w[0] & 0xFFFF0000u), __uint_as_float(w[1] << 16), __uint_as_float(w[1] & 0xFFFF0000u)); }
__device__ __forceinline__ float wave_sum(float v) {
#pragma unroll
  for (int o = 32; o > 0; o >>= 1) v += __shfl_xor(v, o, 64);
  return v;
}
__device__ __forceinline__ int ltid() { int t = threadIdx.x; asm volatile("" : "+v"(t)); return t; }
__device__ __forceinline__ float silu_f(float x) { return x / (1.f + __expf(-x)); }
__device__ __forceinline__ float2 cmul(float2 a, float2 b) { return make_float2(a.x * b.x - a.y * b.y, a.x * b.y + a.y * b.x); }
__device__ __forceinline__ float2 cmulc(float2 a, float2 b) { return make_float2(a.x * b.x + a.y * b.y, a.y * b.x - a.x * b.y); }
__device__ __forceinline__ int modv(int tok) { return tok < TL ? (tok >> 14) : 2; }
__device__ __forceinline__ void phase_tables(const Params& p, int bid, int nb) {
  const int gt = bid * NTHR + ltid(), gs = nb * NTHR;
  for (int i = gt; i < SEQ * 16; i += gs) {
    const int t = i >> 4, f = i & 15;
    const float pos = (f < 8) ? (float)(t >> 6) : (float)(t & 63);
    const float inv = powf(10000.f, -(float)(f & 7) / 8.f);
    float s, c; sincosf(pos * inv, &s, &c);
    p.ropec()[i] = c; p.ropes()[i] = s;
  }
  for (int i = gt; i < FM; i += gs) {
    float s, c; sincospif((float)i / 8192.f, &s, &c);
    p.tw()[i] = make_float2(c, -s);
  }
}

__device__ __forceinline__ void phase_mod(const Params& p, int bid, int nb, char* lds) {
  float* red = (float*)lds;
  const int tid = ltid(), part = tid >> 6, cl = tid & 63;
  for (int it = bid; it < 2 * 96; it += nb) {
    const int l = it / 96, n = (it % 96) * 64 + cl;
    const float* W = p.ada_w() + (size_t)l * DM * 6144;
    float a0 = 0, a1 = 0, a2 = 0;
    for (int k = part * 128; k < part * 128 + 128; ++k) {
      const float w = W[(size_t)k * 6144 + n];
      a0 += silu_f(p.c()[k]) * w; a1 += silu_f(p.c()[DM + k]) * w; a2 += silu_f(p.c_ctx()[k]) * w;
    }
    red[(part * 3 + 0) * 64 + cl] = a0; red[(part * 3 + 1) * 64 + cl] = a1; red[(part * 3 + 2) * 64 + cl] = a2;
    __syncthreads();
    if (tid < 192) {
      const int v = tid >> 6; float s = 0;
      for (int q = 0; q < 8; ++q) s += red[(q * 3 + v) * 64 + cl];
      p.mod()[((size_t)l * 3 + v) * 6144 + n] = s + p.ada_b()[(size_t)l * 6144 + n];
    }
    __syncthreads();
  }
}

__device__ __forceinline__ void phase_fold(const Params& p, int bid, int nb, char* lds) {
  float* wrow = (float*)lds;
  float* dre = wrow + 256;
  float* dim_ = dre + 256;
  float* glr = dim_ + 256;
  float* cst = glr + 32;
  float* snt = cst + 256;
  const int tid = ltid();
  if (tid < 256) { float s, c; sincospif((float)tid / 128.f, &s, &c); cst[tid] = c; snt[tid] = s; }
  __syncthreads();
  for (int it = bid; it < 2 * DM; it += nb) {
    const int l = it >> 10, k = it & 1023;
    const float* wr = p.w_in() + ((size_t)l * DM + k) * DIN0;
    if (tid < 256) wrow[tid] = wr[1984 + tid];
    if (tid >= 256 && tid < 288) glr[tid - 256] = wr[1696 + tid - 256];
    __syncthreads();
    {
      const int kp = tid & 255; const bool im = tid >= 256;
      float s = 0;
      for (int c = 0; c < 256; ++c) { const int m = (c * kp) & 255; s += wrow[c] * (im ? -snt[m] : cst[m]); }
      if (im) dim_[kp] = s; else dre[kp] = s;
    }
    __syncthreads();
    {
      const int j = tid & 255; const bool im = tid >= 256;
      const float* Wf = p.fnet_w() + (size_t)l * 65536;
      const float* d = im ? dim_ : dre;
      float s = 0;
      for (int kp = 0; kp < 256; ++kp) s += d[kp] * Wf[kp * 256 + j];
      p.btf()[((size_t)l * NIN + (im ? 2560 : 2304) + j) * DM + k] = s * 0.0625f;
    }
    if (tid < 256) {
      const int dir = tid >> 7, kk = tid & 127;
      const float* gw = p.gla_gk_w() + ((size_t)l * 2 + dir) * 16 * 128;
      float s = 0;
      for (int r = 0; r < 16; ++r) s += glr[dir * 16 + r] * gw[r * 128 + kk];
      p.btf()[((size_t)l * NIN + 1024 + tid) * DM + k] = s;
    }
    __syncthreads();
  }
}

enum { MAP_ID = 0, MAP_IN = 1, MAP_UQ = 2, MAP_UKV = 3, MAP_GU = 4 };
__device__ __forceinline__ int colmap(int mt, int n) {
  switch (mt) {
    case MAP_ID: return n;
    case MAP_IN:
      if (n < 256) return n;
      if (n < 384) return 256 + (n - 256);
      if (n < 512) return 1184 + (n - 384);
      if (n < 640) return 1312 + (n - 512);
      if (n < 672) return 384 + (n - 640);
      if (n < 768) return -1;
      if (n < 1024) return 1440 + (n - 768);
      if (n < 1280) return -2;
      if (n < 1536) return 1728 + (n - 1280);
      if (n < 2304) return 416 + (n - 1536);
      return -2;
    case MAP_UQ:
      if (n < 256) return (n >> 6) * 96 + (n & 63);
      if (n < 384) return ((n - 256) >> 5) * 96 + 64 + ((n - 256) & 31);
      return -1;
    case MAP_UKV:
      if (n < 256) return (n >> 6) * 128 + (n & 63);
      return ((n - 256) >> 6) * 128 + 64 + ((n - 256) & 63);
    default: {
      const int pn = n >> 8, w = n & 255;
      return w < 128 ? 2 * (pn * 128 + w) : 2 * (pn * 128 + w - 128) + 1;
    }
  }
}
__device__ __forceinline__ int invmap(int mt, int sc) {
  if (mt == MAP_ID) return sc;
  if (mt == MAP_GU) { const int j = sc >> 1, t = sc & 1; return (j >> 7) * 256 + t * 128 + (j & 127); }
  if (sc < 384) return sc;
  if (sc < 416) return 640 + (sc - 384);
  if (sc < 1184) return 1536 + (sc - 416);
  if (sc < 1312) return 384 + (sc - 1184);
  if (sc < 1440) return 512 + (sc - 1312);
  if (sc < 1696) return 768 + (sc - 1440);
  if (sc < 1728) return -1;
  if (sc < 1984) return 1280 + (sc - 1728);
  return -1;
}
template <bool F32OUT>
__device__ __forceinline__ void conv_tile(const float* __restrict__ src, int ld, int K, void* __restrict__ dstv, int mt, const float* __restrict__ scale,
                                          int k0, int s0, float* tile  , int tid) {
  {
    const int kk = tid >> 5, s4 = (tid & 31) * 4;
    float4 v[4];
#pragma unroll
    for (int i = 0; i < 4; ++i) {
      v[i] = make_float4(0.f, 0.f, 0.f, 0.f);
      if (s0 + s4 < ld) v[i] = *(const float4*)(src + (size_t)(k0 + kk + 16 * i) * ld + s0 + s4);
    }
#pragma unroll
    for (int i = 0; i < 4; ++i) {
      const float sc = scale ? scale[k0 + kk + 16 * i] : 1.f;
      float* t = tile + (kk + 16 * i) * 129 + s4;
      t[0] = v[i].x * sc; t[1] = v[i].y * sc; t[2] = v[i].z * sc; t[3] = v[i].w * sc;
    }
  }
  __syncthreads();
#pragma unroll
  for (int h = 0; h < 2; ++h) {
    const int sl = (tid >> 3) + 64 * h, ks = (tid & 7) * 8, sc = s0 + sl;
    const int row = sc < ld ? invmap(mt, sc) : -1;
    if (row >= 0) {
      const float* t = tile + ks * 129 + sl;
      if constexpr (F32OUT) {
        float* dst = (float*)dstv + (size_t)row * K + k0 + ks;
        *(float4*)dst = make_float4(t[0], t[129], t[2 * 129], t[3 * 129]); *(float4*)(dst + 4) = make_float4(t[4 * 129], t[5 * 129], t[6 * 129], t[7 * 129]);
      } else {
        u32x4 w;
        w[0] = cvtpk(t[0], t[129]); w[1] = cvtpk(t[2 * 129], t[3 * 129]); w[2] = cvtpk(t[4 * 129], t[5 * 129]); w[3] = cvtpk(t[6 * 129], t[7 * 129]);
        *(u32x4*)((u16*)dstv + (size_t)row * K + k0 + ks) = w;
      }
    }
  }
  __syncthreads();
}
__device__ __forceinline__ void conv_gu8(const float* __restrict__ src  , signed char* __restrict__ dst  , float* __restrict__ sw  ,
                                         int s0, float* tile  , int tid) {
  float* cmax = tile + 1024 * 33;
  {
    const int c4 = (tid & 7) * 4, r0 = tid >> 3;
#pragma unroll 4
    for (int pss = 0; pss < 16; ++pss) {
      const int k = r0 + 64 * pss;
      const float4 v = *(const float4*)(src + (size_t)k * 2048 + s0 + c4);
      float* t = tile + k * 33 + c4; t[0] = v.x; t[1] = v.y; t[2] = v.z; t[3] = v.w;
    }
  }
  __syncthreads();
  {
    const int col = tid & 31, part = tid >> 5; float m = 0.f;
    for (int k = part * 64; k < part * 64 + 64; ++k) m = fmaxf(m, fabsf(tile[k * 33 + col]));
    cmax[part * 32 + col] = m;
  }
  __syncthreads();
  if (tid < 32) {
    float m = 0.f;
#pragma unroll
    for (int q = 0; q < 16; ++q) m = fmaxf(m, cmax[q * 32 + tid]);
    const float sc = fmaxf(m, 1e-20f) * (1.f / 127.f);
    cmax[512 + tid] = sc;
    sw[invmap(MAP_GU, s0 + tid)] = sc;
  }
  __syncthreads();
#pragma unroll
  for (int h = 0; h < 4; ++h) {
    const int g = tid + 512 * h, col = g & 31, k0 = (g >> 5) * 16;
    const float inv = 1.f / cmax[512 + col];
    unsigned w[4];
#pragma unroll
    for (int q = 0; q < 4; ++q) {
      const float* t = tile + (k0 + 4 * q) * 33 + col;
      const int q0 = (int)rintf(t[0] * inv), q1 = (int)rintf(t[33] * inv), q2 = (int)rintf(t[66] * inv), q3 = (int)rintf(t[99] * inv);
      w[q] = (unsigned)(q0 & 255) | ((unsigned)(q1 & 255) << 8) | ((unsigned)(q2 & 255) << 16) | ((unsigned)(q3 & 255) << 24);
    }
    *(u32x4*)(dst + (size_t)invmap(MAP_GU, s0 + col) * DM + k0) = u32x4{w[0], w[1], w[2], w[3]};
  }
  __syncthreads();
}
__device__ __forceinline__ void phase_convert(const Params& p, int bid, int nb, char* lds) {
  float* tile = (float*)lds;
  const int tid = ltid();
  constexpr int T_IN = 16 * 18, T_OUT = 16 * 8, T_GU = NE * 64, T_DN = NE * 128, T_L = T_IN + T_OUT + T_GU + T_DN;
  for (int t = bid; t < 2 * T_L; t += nb) {
    const int l = t / T_L; int r = t % T_L;
    if (r < T_IN) { conv_tile<true>(p.w_in() + (size_t)l * DM * DIN0, DIN0, DM, p.btf() + (size_t)l * NIN * DM, MAP_IN, nullptr, (r / 18) * 64, (r % 18) * 128, tile, tid); continue; }
    r -= T_IN;
    if (r < T_OUT) { conv_tile<false>(p.w_out() + (size_t)l * DM * DM, DM, DM, p.bt_out() + (size_t)l * DM * DM, MAP_ID, p.mix_g() + l * DM, (r / 8) * 64, (r % 8) * 128, tile, tid); continue; }
    r -= T_OUT;
    if (r < T_GU) { conv_gu8(p.moe_w_gu() + ((size_t)l * NE + (r >> 6)) * DM * 2048, p.bt_gu() + ((size_t)l * NE + (r >> 6)) * 2048 * DM, p.swgu() + ((size_t)l * NE + (r >> 6)) * 2048, (r & 63) * 32, tile, tid); continue; }
    r -= T_GU;
    { const int e = r >> 7, q = r & 127;
      conv_tile<false>(p.moe_w_down() + ((size_t)l * NE + e) * DFF * DM, DM, DFF, p.bt_dn() + ((size_t)l * NE + e) * DM * DFF, MAP_ID, nullptr, (q >> 3) * 64, (q & 7) * 128, tile, tid); }
  }
  for (int l = 0; l < 2; ++l) {
    for (int i = bid * NTHR + tid; i < 96 * DM / 4; i += nb * NTHR) *(float4*)(p.btf() + ((size_t)l * NIN + 672) * DM + (size_t)i * 4) = make_float4(0.f, 0.f, 0.f, 0.f);
    {
      const float* wq = p.mla_w_uq() + (size_t)l * 256 * 384; const float* wkv = p.mla_w_ukv() + (size_t)l * 128 * 512;
      const float* gq = p.mla_q_g() + l * 256; const float* gkv = p.mla_kv_g() + l * 128;
      u16* dst = p.bt_qkv() + (size_t)l * 1024 * 384;
      for (int i = bid * NTHR + ltid(); i < 1024 * 384; i += nb * NTHR) {
        const int n = i / 384, k = i % 384; float v = 0.f;
        if (n < 512) { const int sc = colmap(MAP_UQ, n); if (k < 256 && sc >= 0) v = gq[k] * wq[k * 384 + sc]; }
        else { if (k >= 256) v = gkv[k - 256] * wkv[(k - 256) * 512 + colmap(MAP_UKV, n - 512)]; }
        dst[i] = f2bf(v);
      }
    }
  }
}

__device__ __forceinline__ void phase_hy_mlp(const Params& p, int l, int Lf, float* __restrict__ hout  , float* __restrict__ ssq  ,
                             int bid, int nb, char* lds) {
  float* zf = (float*)lds;
  float* h1 = zf + 64 * 33;
  float* h2 = h1 + 64 * 64;
  const int tid = ltid();
  const float* w1 = p.hy_w1() + (size_t)l * 33 * 64; const float* b1 = p.hy_b1() + l * 64;
  const float* w2 = p.hy_w2() + (size_t)l * 64 * 64; const float* b2 = p.hy_b2() + l * 64;
  const float* w3 = p.hy_w3() + (size_t)l * 64 * 512; const float* fr = p.hy_freq() + l * 64;
  float w3c[64];
#pragma unroll
  for (int k = 0; k < 64; ++k) w3c[k] = w3[k * 512 + tid];
  const int dir = tid >> 8, ch = tid & 255;
  const float maxd = logf(1e-2f) / 0.3f, mind = logf(1e-2f) / 1.5f;
  const float delta = fabsf(mind + (maxd - mind) * (float)ch / 255.f);
  float ssq_acc = 0.f;
  for (int it = bid; it < Lf / 64; it += nb) {
    const int t0 = it * 64;
    for (int i = tid; i < 64 * 33; i += NTHR) {
      const int tt = i / 33, f = i % 33, t = t0 + tt;
      float v;
      if (f == 0) v = (float)t / (float)(Lf - 1);
      else {
        const int j = (f - 1) & 15;
        const float fj = 1e-4f + (float)j * ((15.f - 1e-4f) / 15.f);
        const float w = 6.283185307179586f * (float)t / (float)Lf;
        v = (f <= 16) ? cosf(fj * w) : -sinf(fj * w);
      }
      zf[i] = v;
    }
    __syncthreads();
    for (int i = tid; i < 64 * 64; i += NTHR) {
      const int tt = i >> 6, o = i & 63; float s = b1[o];
      for (int f = 0; f < 33; ++f) s += zf[tt * 33 + f] * w1[f * 64 + o];
      h1[i] = sinf(fr[o] * s);
    }
    __syncthreads();
    for (int i = tid; i < 64 * 64; i += NTHR) {
      const int tt = i >> 6, o = i & 63; float s = b2[o];
      for (int f = 0; f < 64; ++f) s += h1[tt * 64 + f] * w2[f * 64 + o];
      h2[i] = sinf(fr[o] * s);
    }
    __syncthreads();
    float* orow = hout + ((size_t)dir * 256 + ch) * Lf + t0;
    for (int tt = 0; tt < 64; ++tt) {
      float s = 0;
#pragma unroll
      for (int k = 0; k < 64; ++k) s += h2[tt * 64 + k] * w3c[k];
      const int t = t0 + tt;
      s *= __expf(-((float)t / (float)(Lf - 1)) * delta);
      orow[tt] = s;
      if (dir == 0 || t > 0) ssq_acc += s * s;
    }
    __syncthreads();
  }
  ssq[(size_t)bid * 512 + tid] = ssq_acc;
}

__host__ __device__ constexpr int fx(int p) {
  return ((p >> 12) & 3) ^ (((p >> 10) & 3) << 2) ^ ((p >> 4) & 16) ^ (((p >> 5) & 1) * 5) ^ (((p >> 6) & 1) * 26);
}
__device__ __forceinline__ int swz(int p) { return p ^ fx(p); }
__device__ __forceinline__ int rev7(int k) {
  unsigned r = __brev((unsigned)k) >> 18;
  return (int)(((r & 0x2AAAu) >> 1) | ((r & 0x1555u) << 1));
}
template <int ST, bool INV>
__device__ __forceinline__ void fft_stage(float2* s, const float2* __restrict__ tw, const int tid) {
  constexpr int sh = 12 - 2 * ST, q = 1 << sh, ND = q >= 512 ? q / 512 : 1;
  float2 w1[ND], w2[ND], w3[ND];
  if constexpr (ST < 6) {
#pragma unroll
    for (int d = 0; d < ND; ++d) {
      const int j = q >= 512 ? tid + 512 * d : (tid & (q - 1)), ti = j << (2 * ST);
      w1[d] = tw[ti]; w2[d] = tw[2 * ti]; w3[d] = tw[3 * ti];
    }
  }
  float2 x[8][4];
#pragma unroll
  for (int m = 0; m < 8; ++m) {
    const int u = tid + 512 * m, g = u >> sh, j = u & (q - 1), base = (g << (sh + 2)) + j, xb = fx(base);
    x[m][0] = s[base ^ xb]; x[m][1] = s[(base + q) ^ xb ^ fx(q)]; x[m][2] = s[(base + 2 * q) ^ xb ^ fx(2 * q)]; x[m][3] = s[(base + 3 * q) ^ xb ^ fx(3 * q)];
  }
#pragma unroll
  for (int m = 0; m < 8; ++m) {
    const int u = tid + 512 * m, g = u >> sh, j = u & (q - 1), base = (g << (sh + 2)) + j, xb = fx(base);
    const int i0 = base ^ xb, i1 = (base + q) ^ xb ^ fx(q), i2 = (base + 2 * q) ^ xb ^ fx(2 * q), i3 = (base + 3 * q) ^ xb ^ fx(3 * q);
    const int d = q >= 512 ? (m % ND) : 0;
    if constexpr (!INV) {
      const float2 a0 = x[m][0], a1 = x[m][1], a2 = x[m][2], a3 = x[m][3];
      const float2 b0 = make_float2(a0.x + a2.x, a0.y + a2.y), b1 = make_float2(a0.x - a2.x, a0.y - a2.y);
      const float2 b2 = make_float2(a1.x + a3.x, a1.y + a3.y), b3 = make_float2(a1.x - a3.x, a1.y - a3.y);
      const float2 y1 = make_float2(b1.x + b3.y, b1.y - b3.x), y2 = make_float2(b0.x - b2.x, b0.y - b2.y), y3 = make_float2(b1.x - b3.y, b1.y + b3.x);
      s[i0] = make_float2(b0.x + b2.x, b0.y + b2.y);
      if constexpr (ST < 6) { s[i1] = cmul(y1, w1[d]); s[i2] = cmul(y2, w2[d]); s[i3] = cmul(y3, w3[d]); }
      else { s[i1] = y1; s[i2] = y2; s[i3] = y3; }
    } else {
      float2 t0 = x[m][0], t1 = x[m][1], t2 = x[m][2], t3 = x[m][3];
      if constexpr (ST < 6) { t1 = cmulc(t1, w1[d]); t2 = cmulc(t2, w2[d]); t3 = cmulc(t3, w3[d]); }
      const float2 b0 = make_float2(t0.x + t2.x, t0.y + t2.y), b1 = make_float2(t0.x - t2.x, t0.y - t2.y);
      const float2 b2 = make_float2(t1.x + t3.x, t1.y + t3.y), b3 = make_float2(t1.x - t3.x, t1.y - t3.y);
      s[i0] = make_float2(b0.x + b2.x, b0.y + b2.y);
      s[i1] = make_float2(b1.x - b3.y, b1.y + b3.x);
      s[i2] = make_float2(b0.x - b2.x, b0.y - b2.y);
      s[i3] = make_float2(b1.x + b3.y, b1.y - b3.x);
    }
  }
  __syncthreads();
}
__device__ __forceinline__ void fft_fwd(float2* s, const float2* __restrict__ tw) {
  const int tid = ltid();
  fft_stage<0, false>(s, tw, tid); fft_stage<1, false>(s, tw, tid); fft_stage<2, false>(s, tw, tid); fft_stage<3, false>(s, tw, tid);
  fft_stage<4, false>(s, tw, tid); fft_stage<5, false>(s, tw, tid); fft_stage<6, false>(s, tw, tid);
}
__device__ __forceinline__ void fft_inv(float2* s, const float2* __restrict__ tw) {
  const int tid = ltid();
  fft_stage<6, true>(s, tw, tid); fft_stage<5, true>(s, tw, tid); fft_stage<4, true>(s, tw, tid); fft_stage<3, true>(s, tw, tid);
  fft_stage<2, true>(s, tw, tid); fft_stage<1, true>(s, tw, tid); fft_stage<0, true>(s, tw, tid);
}

__device__ __forceinline__ float filt_ssq(const float* __restrict__ part  , int ch, float* red  ) {
  const int tid = ltid();
  float v = part[(size_t)(tid >> 1) * 512 + (tid & 1) * 256 + ch];
  v = wave_sum(v);
  __syncthreads();
  if ((tid & 63) == 0) red[tid >> 6] = v;
  __syncthreads();
  return ((red[0] + red[1]) + (red[2] + red[3])) + ((red[4] + red[5]) + (red[6] + red[7]));
}
__device__ __forceinline__ void phase_hy_filtfft(const Params& p, int bid, int nb, char* lds) {
  float2* s = (float2*)lds;
  const int tid = ltid();
  for (int it = bid; it < 512; it += nb) {
    const int l = it >> 8, ch = it & 255;
    const float* hf = p.hfb() + (((size_t)l * 2 + 0) * 256 + ch) * SEQ;
    const float* hb = p.hfb() + (((size_t)l * 2 + 1) * 256 + ch) * SEQ;
#pragma unroll 8
    for (int m = tid; m < FM; m += NTHR) {
      const int n0 = 2 * m, n1 = 2 * m + 1;
      const float a = (n0 < SEQ) ? hf[n0] : (n0 == SEQ ? 0.f : hb[2 * SEQ - n0]);
      const float b = (n1 < SEQ) ? hf[n1] : hb[2 * SEQ - n1];
      s[swz(m)] = make_float2(a, b);
    }
    __syncthreads();
    fft_fwd(s, p.tw());
    const float sc = rsqrtf(filt_ssq(p.hpart() + (size_t)l * 256 * 512, ch, (float*)(lds + 139264))) * (1.f / 16384.f);
    float4* out = p.hspec() + ((size_t)l * 256 + ch) * HSP;
#pragma unroll 4
    for (int k = tid; k <= FM / 2; k += NTHR) {
      const float2 zk = s[swz(rev7(k))], zm = s[swz(rev7((FM - k) & (FM - 1)))];
      const float er = 0.5f * (zk.x + zm.x), ei = 0.5f * (zk.y - zm.y);
      const float dr = 0.5f * (zk.x - zm.x), di = 0.5f * (zk.y + zm.y);
      out[k] = make_float4(er * sc, ei * sc, di * sc, -dr * sc);
    }
    __syncthreads();
  }
}
constexpr int G_TILE_B = 256 * 64 * 2;
constexpr int G_STAGE_B = 2 * G_TILE_B;
constexpr int GEMM_LDS = 2 * G_STAGE_B;

__device__ __forceinline__ int lds_byte2(int r, int c) {
  const int st = (r >> 4) * 2 + (c >> 5), ob = (r & 15) * 64 + (c & 31) * 2;
  return st * 1024 + (ob ^ (((ob >> 9) & 1) << 5));
}
__device__ __forceinline__ void stage_rc2(int b, int& R, int& C) {
  const int st = b >> 10, sb = b & 1023, swz = sb ^ (((sb >> 9) & 1) << 5);
  R = (st >> 1) * 16 + (swz >> 6);
  C = (st & 1) * 32 + ((swz & 63) >> 1);
}
__device__ __forceinline__ void gemm_stage_coords(int (&sR)[4], int (&sC)[4]) {
  const int wid = ltid() >> 6, lane = ltid() & 63;
#pragma unroll
  for (int i = 0; i < 4; ++i) stage_rc2(wid * 1024 + i * 8192 + lane * 16, sR[i], sC[i]);
}

#define WAIT_V0() asm volatile("s_waitcnt vmcnt(0)" ::: "memory")

__device__ __forceinline__ void gemm256_core(const u16* const (&ap)[4], const u16* const (&bp)[4], int nt, char* shm, f32x4 (&acc)[8][4]) {
  const int tid = ltid(), wid = tid >> 6, lane = tid & 63, wr = wid >> 2, wc = wid & 3, fr = lane & 15, fq = lane >> 4;
#pragma unroll
  for (int m = 0; m < 8; ++m)
#pragma unroll
    for (int n = 0; n < 4; ++n) acc[m][n] = f32x4{0.f, 0.f, 0.f, 0.f};
#define G_SA(b) (shm + (b) * G_STAGE_B)
#define G_SB(b) (shm + (b) * G_STAGE_B + G_TILE_B)
#define G_STAGE(buf, kt) do { _Pragma("unroll") for (int i = 0; i < 4; ++i) {                                                   \
    __builtin_amdgcn_global_load_lds((const unsigned*)(ap[i] + (kt) * 64), (unsigned*)(G_SA(buf) + wid * 1024 + i * 8192), 16, 0, 0); \
    __builtin_amdgcn_global_load_lds((const unsigned*)(bp[i] + (kt) * 64), (unsigned*)(G_SB(buf) + wid * 1024 + i * 8192), 16, 0, 0); } } while (0)
  G_STAGE(0, 0); WAIT_V0(); __syncthreads();
#pragma unroll 1
  for (int t = 0; t < nt; ++t) {
    const int cur = t & 1;
    if (t + 1 < nt) G_STAGE(cur ^ 1, t + 1);
#pragma unroll
    for (int ks = 0; ks < 2; ++ks) {
      bf16x8 At[8], Bf[4];
#pragma unroll
      for (int m = 0; m < 8; ++m) At[m] = *(const bf16x8*)(G_SA(cur) + lds_byte2(wr * 128 + m * 16 + fr, ks * 32 + fq * 8));
#pragma unroll
      for (int n = 0; n < 4; ++n) Bf[n] = *(const bf16x8*)(G_SB(cur) + lds_byte2(wc * 64 + n * 16 + fr, ks * 32 + fq * 8));
#pragma unroll
      for (int m = 0; m < 8; ++m)
#pragma unroll
        for (int n = 0; n < 4; ++n) acc[m][n] = __builtin_amdgcn_mfma_f32_16x16x32_bf16(At[m], Bf[n], acc[m][n], 0, 0, 0);
      __builtin_amdgcn_sched_barrier(0);
    }
    WAIT_V0(); __syncthreads();
  }
#undef G_STAGE
}

#define LAS3 __attribute__((address_space(3)))
constexpr int G8_HTB = 128 * 64 * 2;
__device__ __forceinline__ int g8_perm32(int rho) { const int n = rho >> 4, i = rho & 15; return 8 * (i >> 2) + 4 * n + (i & 3); }
__device__ __forceinline__ int g8_lds_byte(int r, int c) { const int st = (r >> 4) * 2 + (c >> 5), rr = r & 15, cc = c & 31, ob = rr * 64 + cc * 2; return st * 1024 + (ob ^ (((ob >> 9) & 1) << 5)); }
__device__ __forceinline__ void g8_stage_rc(int b, int& R, int& C) { const int st = b / 1024, sb = b % 1024, swz = sb ^ (((sb >> 9) & 1) << 5); R = (st >> 1) * 16 + swz / 64; C = (st & 1) * 32 + (swz % 64) / 2; }
struct G8Unit { int pm, pn, e, ce, pre; };

template <bool I8> __device__ __forceinline__ typename std::conditional<I8, int __attribute__((ext_vector_type(4))), f32x4>::type
g8_mma(bf16x8 x, bf16x8 y, typename std::conditional<I8, int __attribute__((ext_vector_type(4))), f32x4>::type c) {
  if constexpr (I8) { typedef int v4i __attribute__((ext_vector_type(4))); return __builtin_amdgcn_mfma_i32_16x16x64_i8(*(v4i*)&x, *(v4i*)&y, c, 0, 0, 0); }
  else return __builtin_amdgcn_mfma_f32_16x16x32_bf16(x, y, c, 0, 0, 0);
}
typedef int i32x4 __attribute__((ext_vector_type(4)));
template <bool I8> struct G8Acc { typedef f32x4 T; };
template <> struct G8Acc<true> { typedef i32x4 T; };
template <bool I8, class Sched, class Epi>
__device__ __forceinline__ void gemm8_phase(char* lds_g, const char* Abase, const int Kb, const Sched& S, const Epi& E) {
    typedef typename G8Acc<I8>::T ACC;
    LAS3 unsigned char* lds = (LAS3 unsigned char*)lds_g;
    const int tid = ltid(), wid = __builtin_amdgcn_readfirstlane(tid >> 6), lane = tid & 63, wr = wid >> 2, wc = wid & 3, fr = lane & 15, fq = lane >> 4;
    const int nt = Kb / 128;
    int sRr[2], sCc[2]; unsigned voffB[2];
#pragma unroll
    for (int i = 0; i < 2; ++i) { g8_stage_rc(tid * 16 + i * 8192, sRr[i], sCc[i]); const int Rb = (sRr[i] & ~31) + g8_perm32(sRr[i] & 31); voffB[i] = (unsigned)(Rb * Kb) + (unsigned)sCc[i] * 2u; }
    const size_t kstep = 128;
    const size_t hstepB = (size_t)128 * Kb;
    const unsigned ldsw = (unsigned)wid * 1024u;
    const int aoff = g8_lds_byte(wr * 64 + fr, fq * 8), boff = g8_lds_byte(wc * 32 + fr, fq * 8);
#define G8_SA(b, h) (((b) * 2 + (h)) * G8_HTB)
#define G8_SB(b, h) ((4 + (b) * 2 + (h)) * G8_HTB)
#define G8_STAGE_B(bufoff, gbase) do { _Pragma("unroll") for (int _i = 0; _i < 2; ++_i) \
        __builtin_amdgcn_global_load_lds((const unsigned*)((const char*)(gbase) + voffB[_i]), (LAS3 unsigned*)(lds + (bufoff) + ldsw + _i * 8192), 16, 0, 0); } while (0)
#define G8_STAGE_A(bufoff, o0, o1) do { \
        __builtin_amdgcn_global_load_lds((const unsigned*)(Abase + (o0)), (LAS3 unsigned*)(lds + (bufoff) + ldsw), 16, 0, 0); \
        __builtin_amdgcn_global_load_lds((const unsigned*)(Abase + (o1)), (LAS3 unsigned*)(lds + (bufoff) + ldsw + 8192), 16, 0, 0); } while (0)
#define G8_LDA(dst, b, h) do { _Pragma("unroll") for (int m = 0; m < 4; ++m) _Pragma("unroll") for (int k = 0; k < 2; ++k) dst[m][k] = *(const LAS3 bf16x8*)(lds + G8_SA(b, h) + aoff + m * 2048 + k * 1024); } while (0)
#define G8_LDB(dst, b, h) do { _Pragma("unroll") for (int n = 0; n < 2; ++n) _Pragma("unroll") for (int k = 0; k < 2; ++k) dst[n][k] = *(const LAS3 bf16x8*)(lds + G8_SB(b, h) + boff + n * 2048 + k * 1024); } while (0)
#define G8_MMA(ai, bj, At, Bt) do { __builtin_amdgcn_s_setprio(1); _Pragma("unroll") for (int m = 0; m < 4; ++m) _Pragma("unroll") for (int n = 0; n < 2; ++n) _Pragma("unroll") for (int k = 0; k < 2; ++k) \
        acc[ai][bj][m][n] = g8_mma<I8>(Bt[n][k], At[m][k], acc[ai][bj][m][n]); __builtin_amdgcn_s_setprio(0); } while (0)
#define G8_WAIT_V(n) asm volatile("s_waitcnt vmcnt(" #n ")" ::: "memory")
#define G8_WAIT_L(n) asm volatile("s_waitcnt lgkmcnt(" #n ")" ::: "memory")
#define G8_BAR __builtin_amdgcn_s_barrier()
#define G8_SCHED __builtin_amdgcn_sched_barrier(0)
    G8Unit cur, nxt; int ui = 0;
    if (!S.next(0, cur)) return;
    ACC acc[2][2][4][2];
#pragma unroll
    for (int a = 0; a < 2; ++a)
#pragma unroll
        for (int b = 0; b < 2; ++b)
#pragma unroll
            for (int m = 0; m < 4; ++m)
#pragma unroll
                for (int n = 0; n < 2; ++n) acc[a][b][m][n] = ACC{};
    bf16x8 At[4][2], B0[2][2], B1[2][2];
    unsigned va[2][2], vn[2][2];
#pragma unroll
    for (int h = 0; h < 2; ++h)
#pragma unroll
        for (int i = 0; i < 2; ++i) va[h][i] = S.a_off(cur, h * 128 + sRr[i]) + (unsigned)sCc[i] * 2u;
    const char* cB = S.b_ptr(cur);
    G8_STAGE_B(G8_SB(0, 0), cB); G8_STAGE_A(G8_SA(0, 0), va[0][0], va[0][1]); G8_STAGE_B(G8_SB(0, 1), cB + hstepB); G8_STAGE_A(G8_SA(0, 1), va[1][0], va[1][1]);
    if (wr == 1) G8_BAR;
    G8_WAIT_V(4); G8_BAR;
    G8_STAGE_B(G8_SB(1, 0), cB + kstep); G8_STAGE_A(G8_SA(1, 0), va[0][0] + kstep, va[0][1] + kstep); G8_STAGE_B(G8_SB(1, 1), cB + hstepB + kstep);
    G8_WAIT_V(6); G8_BAR;
    for (;;) {
        const bool has_next = S.next(ui + 1, nxt);
        const char* nB = cB;
#pragma unroll
        for (int h = 0; h < 2; ++h)
#pragma unroll
            for (int i = 0; i < 2; ++i) vn[h][i] = va[h][i];
        if (has_next) {
            nB = S.b_ptr(nxt);
#pragma unroll
            for (int h = 0; h < 2; ++h)
#pragma unroll
                for (int i = 0; i < 2; ++i) vn[h][i] = S.a_off(nxt, h * 128 + sRr[i]) + (unsigned)sCc[i] * 2u;
        }
#pragma unroll 1
        for (int t = 0; t < nt; t += 2) {
            const bool last = (t == nt - 2);
            const unsigned k1 = (unsigned)(t + 1) * 128u;
            const unsigned k2 = last ? 0u : (unsigned)(t + 2) * 128u;
            const unsigned a2_00 = (last ? vn[0][0] : va[0][0]) + k2, a2_01 = (last ? vn[0][1] : va[0][1]) + k2;
            const unsigned a2_10 = (last ? vn[1][0] : va[1][0]) + k2, a2_11 = (last ? vn[1][1] : va[1][1]) + k2;
            const char* b2 = (last ? nB : cB) + k2; const char* b3 = b2 + kstep;
            G8_LDB(B0, 0, 0); G8_SCHED; G8_LDA(At, 0, 0); G8_STAGE_A(G8_SA(1, 1), va[1][0] + k1, va[1][1] + k1);
            G8_WAIT_L(8); G8_BAR; G8_WAIT_L(0); G8_MMA(0, 0, At, B0); G8_BAR; G8_SCHED;
            G8_LDB(B1, 0, 1); G8_STAGE_B(G8_SB(0, 0), b2);
            G8_BAR; G8_WAIT_L(0); G8_MMA(0, 1, At, B1); G8_BAR;
            G8_LDA(At, 0, 1); G8_STAGE_A(G8_SA(0, 0), a2_00, a2_01);
            G8_BAR; G8_WAIT_L(0); G8_MMA(1, 0, At, B0); G8_BAR; G8_SCHED;
            G8_STAGE_B(G8_SB(0, 1), b2 + hstepB);
            G8_WAIT_V(6); G8_BAR; G8_MMA(1, 1, At, B1); G8_BAR;
            G8_LDB(B0, 1, 0); G8_SCHED; G8_LDA(At, 1, 0); G8_STAGE_A(G8_SA(0, 1), a2_10, a2_11);
            G8_WAIT_L(8); G8_BAR; G8_WAIT_L(0); G8_MMA(0, 0, At, B0); G8_BAR; G8_SCHED;
            G8_LDB(B1, 1, 1); G8_STAGE_B(G8_SB(1, 0), b3);
            G8_BAR; G8_WAIT_L(0); G8_MMA(0, 1, At, B1); G8_BAR;
            G8_LDA(At, 1, 1); G8_STAGE_A(G8_SA(1, 0), a2_00 + 128u, a2_01 + 128u);
            G8_BAR; G8_WAIT_L(0); G8_MMA(1, 0, At, B0); G8_BAR; G8_SCHED;
            G8_STAGE_B(G8_SB(1, 1), b3 + hstepB);
            G8_WAIT_V(6); G8_BAR; G8_MMA(1, 1, At, B1); G8_BAR;
        }
        E(acc, cur, wr, wc, fr, fq);
        if (!has_next) break;
#pragma unroll
        for (int a = 0; a < 2; ++a)
#pragma unroll
            for (int b = 0; b < 2; ++b)
#pragma unroll
                for (int m = 0; m < 4; ++m)
#pragma unroll
                    for (int n = 0; n < 2; ++n) acc[a][b][m][n] = ACC{};
        cur = nxt; cB = nB; ++ui;
#pragma unroll
        for (int h = 0; h < 2; ++h)
#pragma unroll
            for (int i = 0; i < 2; ++i) va[h][i] = vn[h][i];
    }
    G8_WAIT_V(0);
    if (wr == 0) G8_BAR;
    G8_BAR;
#undef G8_SA
#undef G8_SB
#undef G8_STAGE_A
#undef G8_STAGE_B
#undef G8_LDA
#undef G8_LDB
#undef G8_MMA
#undef G8_WAIT_V
#undef G8_WAIT_L
#undef G8_BAR
#undef G8_SCHED
}
struct G8Plain {
    int nM, nN, Kb, G, c; const char* Bt;
    __device__ __forceinline__ bool next(int i, G8Unit& u) const {
        const int L = (i * 8 + (c & 7)) * (G >> 3) + (c >> 3); if (L >= nM * nN) return false;
        const int nig = 8 * nN, gid = L / nig, fm = gid * 8, gsz = (nM - fm) < 8 ? (nM - fm) : 8;
        u.pm = fm + ((L % nig) % gsz); u.pn = (L % nig) / gsz; u.e = 0; u.ce = 256; u.pre = 0; return true;
    }
    __device__ __forceinline__ unsigned a_off(const G8Unit& u, int row) const { return (unsigned)(u.pm * 256 + row) * (unsigned)Kb; }
    __device__ __forceinline__ const char* b_ptr(const G8Unit& u) const { return Bt + (size_t)u.pn * 256 * Kb; }
};

__device__ __forceinline__ const float* resid_row(const Params& p, int layer_src, int tok) {
  if (layer_src == 0) return tok < TL ? p.x() + (size_t)tok * DM : p.ctx() + (size_t)(tok - TL) * DM;
  return p.X() + (size_t)tok * DM;
}
__device__ __forceinline__ void load_row_comb(const Params& p, int src_layer, int lc, int tok, int lane, const int* pre  , float (&v)[16]) {
  const float* r = resid_row(p, src_layer, tok);
#pragma unroll
  for (int i = 0; i < 4; ++i) { const float4 a = *(const float4*)(r + lane * 4 + i * 256); v[4 * i] = a.x; v[4 * i + 1] = a.y; v[4 * i + 2] = a.z; v[4 * i + 3] = a.w; }
  if (lc >= 0) {
    const float* g2 = p.mod() + ((size_t)lc * 3 + modv(tok)) * 6144 + 5 * DM;
    float s[16];
#pragma unroll
    for (int i = 0; i < 16; ++i) s[i] = 0.f;
#pragma unroll
    for (int k = 0; k < TOPK; ++k) {
      const int sl = p.tslot()[tok * 4 + k];
      const size_t arow = (size_t)(pre[sl >> 20] + (sl & 0xFFFFF));
      const u16* y = p.yd() + arow * DM;
#pragma unroll
      for (int i = 0; i < 4; ++i) {
        const u32x2 w = *(const u32x2*)(y + lane * 4 + i * 256);
        s[4 * i] += __uint_as_float(w[0] << 16); s[4 * i + 1] += __uint_as_float(w[0] & 0xFFFF0000u);
        s[4 * i + 2] += __uint_as_float(w[1] << 16); s[4 * i + 3] += __uint_as_float(w[1] & 0xFFFF0000u);
      }
    }
#pragma unroll
    for (int i = 0; i < 4; ++i) {
      const float4 g = *(const float4*)(g2 + lane * 4 + i * 256);
      v[4 * i] += g.x * s[4 * i]; v[4 * i + 1] += g.y * s[4 * i + 1]; v[4 * i + 2] += g.z * s[4 * i + 2]; v[4 * i + 3] += g.w * s[4 * i + 3];
    }
  }
}
__device__ __forceinline__ void expert_prefix(const int* cnt, int* pre) {
  if (ltid() == 0) { int s = 0; for (int e = 0; e < NE; ++e) { pre[e] = s; s += cnt[e]; } pre[NE] = s; }
}

__device__ __forceinline__ void store_row_i8(const float (&y)[16], signed char* __restrict__ h, float* __restrict__ hs_row, int lane) {
  float am = 0.f;
#pragma unroll
  for (int i = 0; i < 16; ++i) am = fmaxf(am, fabsf(y[i]));
#pragma unroll
  for (int o = 32; o > 0; o >>= 1) am = fmaxf(am, __shfl_xor(am, o, 64));
  const float s = fmaxf(am, 1e-20f) * (1.f / 127.f), inv = 1.f / s;
#pragma unroll
  for (int i = 0; i < 4; ++i) {
    const int q0 = (int)rintf(y[4 * i] * inv), q1 = (int)rintf(y[4 * i + 1] * inv), q2 = (int)rintf(y[4 * i + 2] * inv), q3 = (int)rintf(y[4 * i + 3] * inv);
    *(unsigned*)(h + lane * 4 + i * 256) = (unsigned)(q0 & 255) | ((unsigned)(q1 & 255) << 8) | ((unsigned)(q2 & 255) << 16) | ((unsigned)(q3 & 255) << 24);
  }
  if (lane == 0) *hs_row = s;
}
__device__ __forceinline__ void phase_quant_in(const Params& p, int bid, int nb) {
  const int wid = ltid() >> 6, lane = ltid() & 63;
  for (int r = bid * 8 + wid; r < 2 * NIN; r += nb * 8) {
    const float* src = p.btf() + (size_t)r * DM;
    float y[16];
#pragma unroll
    for (int i = 0; i < 4; ++i) { const float4 a = *(const float4*)(src + lane * 4 + i * 256); y[4 * i] = a.x; y[4 * i + 1] = a.y; y[4 * i + 2] = a.z; y[4 * i + 3] = a.w; }
    store_row_i8(y, p.bt_in() + (size_t)r * DM, p.swin() + r, lane);
  }
}
__device__ __forceinline__ void phase_norm1(const Params& p, int layer, int bid, int nb, char* lds) {
  int* pre = (int*)lds;
  const int lc = layer - 1;
  if (lc >= 0) { expert_prefix(p.cnt() + lc * NE, pre); __syncthreads(); }
  const int wid = ltid() >> 6, lane = ltid() & 63;
  const float* gn = p.norm1_g() + layer * DM;
  const int ntok = TT;
  for (int tok = bid * 8 + wid; tok < ntok; tok += nb * 8) {
    float v[16];
    load_row_comb(p, layer == 0 ? 0 : 1, lc, tok, lane, pre, v);
    if (lc >= 0) {
      float* xr = p.X() + (size_t)tok * DM;
#pragma unroll
      for (int i = 0; i < 4; ++i) *(float4*)(xr + lane * 4 + i * 256) = make_float4(v[4 * i], v[4 * i + 1], v[4 * i + 2], v[4 * i + 3]);
    }
    float ss = 0;
#pragma unroll
    for (int i = 0; i < 16; ++i) ss += v[i] * v[i];
    ss = wave_sum(ss);
    const float rs = rsqrtf(ss * (1.f / DM) + EPS);
    const float* md = p.mod() + ((size_t)layer * 3 + modv(tok)) * 6144;
#pragma unroll
    for (int i = 0; i < 4; ++i) {
      const int c = lane * 4 + i * 256;
      const float4 g = *(const float4*)(gn + c), sh = *(const float4*)(md + c), sc = *(const float4*)(md + DM + c);
      v[4 * i] = v[4 * i] * rs * g.x * (1.f + sc.x) + sh.x; v[4 * i + 1] = v[4 * i + 1] * rs * g.y * (1.f + sc.y) + sh.y;
      v[4 * i + 2] = v[4 * i + 2] * rs * g.z * (1.f + sc.z) + sh.z; v[4 * i + 3] = v[4 * i + 3] * rs * g.w * (1.f + sc.w) + sh.w;
    }
    store_row_i8(v, p.H() + (size_t)tok * DM, p.hs() + tok, lane);
  }
}

struct EpiIn {
  u16* zqkv; u16* zg; u16* zt; const float* hs; const float* sw;
  __device__ __forceinline__ void operator()(const i32x4 (&acc)[2][2][4][2], const G8Unit& u, int wr, int wc, int fr, int fq) const {
    float sa[2][4];
#pragma unroll
    for (int ai = 0; ai < 2; ++ai)
#pragma unroll
      for (int m = 0; m < 4; ++m) sa[ai][m] = hs[u.pm * 256 + ai * 128 + wr * 64 + m * 16 + fr];
#pragma unroll
    for (int bj = 0; bj < 2; ++bj) {
      const int c32 = u.pn * 256 + bj * 128 + wc * 32, c0 = c32 + 8 * fq;
      const f32x4 w0 = *(const f32x4*)(sw + c0), w1 = *(const f32x4*)(sw + c0 + 4);
#pragma unroll
      for (int ai = 0; ai < 2; ++ai)
#pragma unroll
        for (int m = 0; m < 4; ++m) {
          const int row = u.pm * 256 + ai * 128 + wr * 64 + m * 16 + fr;
          f32x4 a, b;
#pragma unroll
          for (int j = 0; j < 4; ++j) { a[j] = (float)acc[ai][bj][m][0][j] * sa[ai][m] * w0[j]; b[j] = (float)acc[ai][bj][m][1][j] * sa[ai][m] * w1[j]; }
          if (c32 < 384) {
            *(u32x4*)(zqkv + (size_t)row * 384 + c0) = u32x4{cvtpk(a[0], a[1]), cvtpk(a[2], a[3]), cvtpk(b[0], b[1]), cvtpk(b[2], b[3])};
          } else if (c32 < 1536) {
            *(u32x4*)(zg + (size_t)row * ZG_W + (c0 - 384)) = u32x4{cvtpk(a[0], a[1]), cvtpk(a[2], a[3]), cvtpk(b[0], b[1]), cvtpk(b[2], b[3])};
          } else {
#pragma unroll
            for (int j = 0; j < 4; ++j) { zt[(size_t)(c0 - 1536 + j) * TT + row] = f2bf(a[j]); zt[(size_t)(c0 - 1536 + 4 + j) * TT + row] = f2bf(b[j]); }
          }
        }
    }
  }
};
__device__ __forceinline__ void phase_gemm_in(const Params& p, int layer, int bid, int nb, char* lds) {
  G8Plain S; S.nM = TT / 256; S.nN = NIN / 256; S.Kb = DM; S.G = nb; S.c = bid; S.Bt = (const char*)(p.bt_in() + (size_t)layer * NIN * DM);
  EpiIn E; E.zqkv = p.zqkv(); E.zg = p.zg(); E.zt = p.zt(); E.hs = p.hs(); E.sw = p.swin() + layer * NIN;
  gemm8_phase<true>(lds, (const char*)p.H(), DM, S, E);
}

__device__ __forceinline__ size_t qkv_row(int tok, int h) {
  const int b = tok < TL ? (tok >> 14) : ((tok - TL) >> 8);
  const int s = tok < TL ? (tok & (SEQ - 1)) : SEQ + ((tok - TL) & (LC - 1));
  return ((size_t)(b * 4 + h)) * SKV + s;
}
struct EpiQkv {
  const u16* zqkv; u16* Q; u16* KV; const float* ropec; const float* ropes; float* rsl;
  unsigned* kmx;
  __device__ __forceinline__ void operator()(const f32x4 (&acc)[2][2][4][2], const G8Unit& u, int wr, int wc, int fr, int fq) const {
    const int tid = ltid();
    {
      const int r = tid >> 1, half = tid & 1;
      const u16* row = zqkv + (size_t)(u.pm * 256 + r) * 384;
      float sq = 0, sk = 0;
#pragma unroll
      for (int i = 0; i < 16; ++i) {
        const u32x4 w = *(const u32x4*)(row + half * 128 + i * 8);
#pragma unroll
        for (int q = 0; q < 4; ++q) { const float a = __uint_as_float(w[q] << 16), b = __uint_as_float(w[q] & 0xFFFF0000u); sq += a * a + b * b; }
      }
#pragma unroll
      for (int i = 0; i < 8; ++i) {
        const u32x4 w = *(const u32x4*)(row + 256 + half * 64 + i * 8);
#pragma unroll
        for (int q = 0; q < 4; ++q) { const float a = __uint_as_float(w[q] << 16), b = __uint_as_float(w[q] & 0xFFFF0000u); sk += a * a + b * b; }
      }
      sq += __shfl_xor(sq, 1, 64); sk += __shfl_xor(sk, 1, 64);
      if (half == 0) { rsl[r] = rsqrtf(sq * (1.f / 256.f) + EPS); rsl[256 + r] = rsqrtf(sk * (1.f / 128.f) + EPS); }
    }
    asm volatile("s_waitcnt lgkmcnt(0)" ::: "memory"); __builtin_amdgcn_s_barrier(); __builtin_amdgcn_s_barrier(); asm volatile("" ::: "memory");
    const float* rsp = rsl + (u.pn >= 2 ? 256 : 0);
#pragma unroll
    for (int ai = 0; ai < 2; ++ai)
#pragma unroll
      for (int m = 0; m < 4; ++m) {
        const int rl = ai * 128 + wr * 64 + m * 16 + fr, tok = u.pm * 256 + rl;
        const float rs = rsp[rl] * (u.pn < 2 ? A_QSCALE : 1.f);
        if (u.pn == 1) {
          f32x4 a = acc[ai][0][m][0] * rs, b = acc[ai][0][m][1] * rs;
          f32x4 pa, pb;
#pragma unroll
          for (int j = 0; j < 4; ++j) { pa[j] = __shfl_xor(a[j], 32, 64); pb[j] = __shfl_xor(b[j], 32, 64); }
          f32x4 ca = {1.f, 1.f, 1.f, 1.f}, cb = ca, sa = {0.f, 0.f, 0.f, 0.f}, sb = sa;
          if (tok < TL) {
            const float* cp = ropec + (size_t)(tok & (SEQ - 1)) * 16 + 8 * (fq & 1); const float* sp = ropes + (size_t)(tok & (SEQ - 1)) * 16 + 8 * (fq & 1);
            ca = *(const f32x4*)cp; cb = *(const f32x4*)(cp + 4); sa = *(const f32x4*)sp; sb = *(const f32x4*)(sp + 4);
          }
          const float sg = fq < 2 ? -1.f : 1.f;
          a = a * ca + pa * sa * sg; b = b * cb + pb * sb * sg;
          *(u32x4*)(Q + qkv_row(tok, wc) * 96 + 64 + 8 * fq) = u32x4{cvtpk(a[0], a[1]), cvtpk(a[2], a[3]), cvtpk(b[0], b[1]), cvtpk(b[2], b[3])};
        } else {
#pragma unroll
          for (int bj = 0; bj < 2; ++bj) {
            const int c = bj * 128 + wc * 32 + 8 * fq, h = c >> 6, d = c & 63;
            const f32x4 a = acc[ai][bj][m][0] * rs, b = acc[ai][bj][m][1] * rs;
            u16* dst = u.pn == 0 ? Q + qkv_row(tok, h) * 96 + d : KV + qkv_row(tok, h) * 160 + (u.pn == 2 ? 0 : 96) + d;
            *(u32x4*)dst = u32x4{cvtpk(a[0], a[1]), cvtpk(a[2], a[3]), cvtpk(b[0], b[1]), cvtpk(b[2], b[3])};
          }
        }
      }
    if (u.pn == 2) {
      const int b = u.pm * 256 < TL ? (u.pm * 256) >> 14 : (u.pm * 256 - TL) >> 8;
#pragma unroll
      for (int bj = 0; bj < 2; ++bj) {
        float mx = 0.f;
#pragma unroll
        for (int ai = 0; ai < 2; ++ai)
#pragma unroll
          for (int m = 0; m < 4; ++m) {
            const float rs = rsp[ai * 128 + wr * 64 + m * 16 + fr];
            const f32x4 a = acc[ai][bj][m][0] * rs, b4 = acc[ai][bj][m][1] * rs;
            float ss = a[0] * a[0] + a[1] * a[1] + a[2] * a[2] + a[3] * a[3] + b4[0] * b4[0] + b4[1] * b4[1] + b4[2] * b4[2] + b4[3] * b4[3];
            ss += __shfl_xor(ss, 16, 64); ss += __shfl_xor(ss, 32, 64);
            mx = fmaxf(mx, ss);
          }
#pragma unroll
        for (int o = 8; o > 0; o >>= 1) mx = fmaxf(mx, __shfl_xor(mx, o, 64));
        if ((ltid() & 63) == 0) atomicMax(kmx + (b * 4 + bj * 2 + (wc >> 1)) * 4 + (wc & 1), __float_as_uint(mx));
      }
    }
  }
};
__device__ __forceinline__ void phase_qkv(const Params& p, int layer, int bid, int nb, char* lds) {
  const int tid = ltid();
  {
    G8Plain S; S.nM = TT / 256; S.nN = 4; S.Kb = 768; S.G = nb; S.c = bid; S.Bt = (const char*)(p.bt_qkv() + (size_t)layer * 1024 * 384);
    EpiQkv E; E.zqkv = p.zqkv(); E.Q = p.Q(); E.KV = p.KV(); E.ropec = p.ropec(); E.ropes = p.ropes(); E.rsl = (float*)(lds + 131072); E.kmx = p.kmx() + layer * 32;
    gemm8_phase<false>(lds, (const char*)p.zqkv(), 768, S, E);
  }
  float krm0 = 0.f, krm1 = 0.f;
  for (int i = bid * NTHR + tid; i < TT * 16; i += nb * NTHR) {
    const int tok = i >> 4, f = i & 15;
    const float x1 = bf2f(p.zg()[(size_t)tok * ZG_W + ZG_KR + f]), x2 = bf2f(p.zg()[(size_t)tok * ZG_W + ZG_KR + 16 + f]);
    float cs = 1.f, sn = 0.f;
    if (tok < TL) { const int tpos = tok & (SEQ - 1); cs = p.ropec()[tpos * 16 + f]; sn = p.ropes()[tpos * 16 + f]; }
    const float y1 = x1 * cs - x2 * sn, y2 = x2 * cs + x1 * sn;
    const u16 o1 = f2bf(y1), o2 = f2bf(y2);
#pragma unroll
    for (int h = 0; h < 4; ++h) { u16* kv = p.KV() + qkv_row(tok, h) * 160 + 64; kv[f] = o1; kv[16 + f] = o2; }
    float ss = y1 * y1 + y2 * y2;
#pragma unroll
    for (int o = 8; o > 0; o >>= 1) ss += __shfl_xor(ss, o, 64);
    const int b = tok < TL ? (tok >> 14) : ((tok - TL) >> 8);
    if (b == 0) krm0 = fmaxf(krm0, ss); else krm1 = fmaxf(krm1, ss);
  }
#pragma unroll
  for (int o = 32; o > 0; o >>= 1) { krm0 = fmaxf(krm0, __shfl_xor(krm0, o, 64)); krm1 = fmaxf(krm1, __shfl_xor(krm1, o, 64)); }
  if ((tid & 63) == 0) { atomicMax(p.kmx() + layer * 32 + 0 * 16 + 2, __float_as_uint(krm0)); atomicMax(p.kmx() + layer * 32 + 1 * 16 + 2, __float_as_uint(krm1)); }
}

constexpr int A_KROW = 208;
constexpr int A_TV = 128 * 64 * 2;
constexpr int A_TK = 128 * A_KROW;
constexpr int A_BUF = A_TV + A_TK;
constexpr int A_OFF_W = 3 * A_BUF;
constexpr int ATTN_LDS = A_OFF_W + 8 * 64 * 4;
#define SBAR() __builtin_amdgcn_sched_barrier(0)
__device__ __forceinline__ int crow(int r, int hi) { return (r & 3) + 8 * (r >> 2) + 4 * hi; }

__device__ __forceinline__ void a_partialSM(f32x16& p0) {
#pragma unroll
  for (int r = 0; r < 16; ++r) p0[r] = __builtin_amdgcn_exp2f(p0[r]);
}
__device__ __forceinline__ void a_finishSM(f32x16& p0, f32x16& p1, float& l_reg, bf16x8& pa0, bf16x8& pa1, bf16x8& pa2, bf16x8& pa3) {
#pragma unroll
  for (int r = 0; r < 16; ++r) p1[r] = __builtin_amdgcn_exp2f(p1[r]);
  float ps = 0;
#pragma unroll
  for (int r = 0; r < 16; ++r) ps += p0[r];
#pragma unroll
  for (int r = 0; r < 16; ++r) ps += p1[r];
  { auto rr = __builtin_amdgcn_permlane32_swap(__float_as_uint(ps), __float_as_uint(ps), false, false);
    ps = __uint_as_float(rr[0]) + __uint_as_float(rr[1]); }
  l_reg += ps;
#define PK4(P, BASE, OUT) do { unsigned a0 = cvtpk(P[BASE + 0], P[BASE + 1]), a1 = cvtpk(P[BASE + 2], P[BASE + 3]);   \
    unsigned b0 = cvtpk(P[BASE + 4], P[BASE + 5]), b1 = cvtpk(P[BASE + 6], P[BASE + 7]);                              \
    auto r0 = __builtin_amdgcn_permlane32_swap(a0, b0, false, false); auto r1 = __builtin_amdgcn_permlane32_swap(a1, b1, false, false); \
    u32x4 w = {r0[0], r1[0], r0[1], r1[1]}; OUT = *reinterpret_cast<bf16x8*>(&w); } while (0)
  PK4(p0, 0, pa0); PK4(p0, 8, pa1); PK4(p1, 0, pa2); PK4(p1, 8, pa3);
#undef PK4
}
__device__ __forceinline__ void a_qkt(f32x16& p0, f32x16& p1, const char* Ks, const bf16x8* qr, const float mneg, int r32, int hi) {
#pragma unroll
  for (int r = 0; r < 16; ++r) { p0[r] = mneg; p1[r] = mneg; }
#pragma unroll
  for (int d0 = 0; d0 < 6; ++d0) {
    const int cb = (d0 * 16 + hi * 8) * 2;
    const bf16x8 b0 = *reinterpret_cast<const bf16x8*>(Ks + r32 * A_KROW + cb);
    const bf16x8 b1 = *reinterpret_cast<const bf16x8*>(Ks + (32 + r32) * A_KROW + cb);
    p0 = __builtin_amdgcn_mfma_f32_32x32x16_bf16(b0, qr[d0], p0, 0, 0, 0); p1 = __builtin_amdgcn_mfma_f32_32x32x16_bf16(b1, qr[d0], p1, 0, 0, 0);
  }
}
__device__ __forceinline__ int a_v_st(int k, int c) { const int kk = (k & ~0xC) | ((k & 4) << 1) | ((k & 8) >> 1); return ((kk >> 3) * 2 + (c >> 5)) * 512 + ((kk & 7) * 32 + (c & 31)) * 2; }
__device__ __forceinline__ int a_v_rd_base(int lane) { return ((lane & 3) << 3) | (((lane >> 2) & 3) << 6) | (((lane >> 4) & 1) << 5) | (((lane >> 5) & 1) << 8); }
constexpr int a_v_rd_off(int d0, int ks, int half) { return d0 * 512 + ks * 2048 + half * 1024; }
template <int OFF> __device__ __forceinline__ s16x4 a_tr_read(int vb) {
  s16x4 r; asm volatile("ds_read_b64_tr_b16 %0, %1 offset:%2" : "=&v"(r) : "v"(vb), "i"(OFF) : "memory"); return r;
}
template <int D0> __device__ __forceinline__ void a_pv_one(f32x16& od, int vb, bf16x8 pa0, bf16x8 pa1, bf16x8 pa2, bf16x8 pa3) {
  const s16x4 l0 = a_tr_read<a_v_rd_off(D0, 0, 0)>(vb), h0 = a_tr_read<a_v_rd_off(D0, 0, 1)>(vb), l1 = a_tr_read<a_v_rd_off(D0, 1, 0)>(vb), h1 = a_tr_read<a_v_rd_off(D0, 1, 1)>(vb);
  const s16x4 l2 = a_tr_read<a_v_rd_off(D0, 2, 0)>(vb), h2 = a_tr_read<a_v_rd_off(D0, 2, 1)>(vb), l3 = a_tr_read<a_v_rd_off(D0, 3, 0)>(vb), h3 = a_tr_read<a_v_rd_off(D0, 3, 1)>(vb);
  asm volatile("s_waitcnt lgkmcnt(0)" ::: "memory"); SBAR();
#define PK(L, H) (bf16x8){L[0], L[1], L[2], L[3], H[0], H[1], H[2], H[3]}
  od = __builtin_amdgcn_mfma_f32_32x32x16_bf16(pa0, PK(l0, h0), od, 0, 0, 0);
  od = __builtin_amdgcn_mfma_f32_32x32x16_bf16(pa1, PK(l1, h1), od, 0, 0, 0);
  od = __builtin_amdgcn_mfma_f32_32x32x16_bf16(pa2, PK(l2, h2), od, 0, 0, 0);
  od = __builtin_amdgcn_mfma_f32_32x32x16_bf16(pa3, PK(l3, h3), od, 0, 0, 0);
#undef PK
}
__device__ __forceinline__ void a_pv(f32x16* o, int vb, bf16x8 pa0, bf16x8 pa1, bf16x8 pa2, bf16x8 pa3) {
  a_pv_one<0>(o[0], vb, pa0, pa1, pa2, pa3); a_pv_one<1>(o[1], vb, pa0, pa1, pa2, pa3);
}

__device__ __forceinline__ void attn_item(const u16* __restrict__ Qb, const u16* __restrict__ KVh, int seq, float kmax, u16* __restrict__ yout  , char* lds) {
  const int tid = ltid(), wid = tid >> 6, lane = tid & 63, r32 = lane & 31, hi = lane >> 5;
  float* ws = (float*)(lds + A_OFF_W) + wid * 64; float* li_l = ws;
  float l_reg = 0; f32x16 o[2] = {}; bf16x8 qr[6];
  const u16* Qw = Qb + (size_t)(wid * 32 + r32) * 96 + hi * 8;
#pragma unroll
  for (int d0 = 0; d0 < 6; ++d0) qr[d0] = *reinterpret_cast<const bf16x8*>(Qw + d0 * 16);
  float mneg;
  {
    float ss = 0.f;
#pragma unroll
    for (int d0 = 0; d0 < 6; ++d0)
#pragma unroll
      for (int j = 0; j < 8; ++j) { const float v = bf2f((u16)qr[d0][j]); ss += v * v; }
    ss += __shfl_xor(ss, 32, 64);
    mneg = -sqrtf(ss) * kmax;
  }
  int lw[5];
#pragma unroll
  for (int i = 0; i < 5; ++i) {
    const int g = tid + i * 512, key = g / 20, cc = g % 20;
    lw[i] = cc < 12 ? (A_TV + key * A_KROW + cc * 16) : ((key >> 6) * 8192 + a_v_st(key & 63, (cc - 12) * 8));
  }
  const int vrb = (int)(uintptr_t)lds + a_v_rd_base(lane);
  bf16x8 sg[5];
  const char* gsrc = (const char*)KVh + tid * 16;
#define SLOAD(t) do { const char* s_ = gsrc + (size_t)(t) * 40960; _Pragma("unroll") for (int i = 0; i < 5; ++i) sg[i] = *(const bf16x8*)(s_ + i * 8192); } while (0)
#define SWRITE(bo_) do { _Pragma("unroll") for (int i = 0; i < 5; ++i) *(bf16x8*)(lds + (bo_) + lw[i]) = sg[i]; } while (0)
  f32x16 pA0, pA1, pB0, pB1; bf16x8 pa0, pa1, pa2, pa3; const int NT = seq / 128;
  SLOAD(0); SWRITE(0); if (1 < NT) SLOAD(1);
  __syncthreads();
  int bo = 0;
  {
    if (1 < NT) { SWRITE(A_BUF); if (2 < NT) SLOAD(2); }
    SBAR(); a_qkt(pA0, pA1, lds + bo + A_TV, qr, mneg, r32, hi); a_partialSM(pA0);
    SBAR(); a_qkt(pB0, pB1, lds + bo + A_TV + 64 * A_KROW, qr, mneg, r32, hi);
    a_finishSM(pA0, pA1, l_reg, pa0, pa1, pa2, pa3); SBAR();
    a_pv(o, vrb + bo, pa0, pa1, pa2, pa3); a_partialSM(pB0);
    __syncthreads();
  }
  for (int t = 1; t < NT; ++t) {
    const int bp = bo;
    bo = bo + A_BUF; if (bo == 3 * A_BUF) bo = 0;
    int bn = bo + A_BUF; if (bn == 3 * A_BUF) bn = 0;
    if (t + 1 < NT) { SWRITE(bn); if (t + 2 < NT) SLOAD(t + 2); }
    SBAR(); a_qkt(pA0, pA1, lds + bo + A_TV, qr, mneg, r32, hi);
    a_finishSM(pB0, pB1, l_reg, pa0, pa1, pa2, pa3); SBAR();
    a_pv(o, vrb + bp + 8192, pa0, pa1, pa2, pa3); a_partialSM(pA0);
    SBAR(); a_qkt(pB0, pB1, lds + bo + A_TV + 64 * A_KROW, qr, mneg, r32, hi);
    a_finishSM(pA0, pA1, l_reg, pa0, pa1, pa2, pa3); SBAR();
    a_pv(o, vrb + bo, pa0, pa1, pa2, pa3); a_partialSM(pB0);
    __syncthreads();
  }
  a_finishSM(pB0, pB1, l_reg, pa0, pa1, pa2, pa3); SBAR();
  a_pv(o, vrb + bo + 8192, pa0, pa1, pa2, pa3);
  if (hi == 0) li_l[r32] = l_reg; asm volatile("s_waitcnt lgkmcnt(0)" ::: "memory");
#pragma unroll
  for (int r = 0; r < 16; ++r) {
    const int orow = crow(r, hi);
    const float rl = __builtin_amdgcn_rcpf(li_l[orow]);
    const float v0 = o[0][r] * rl, v1 = o[1][r] * rl;
    float ss = v0 * v0 + v1 * v1;
#pragma unroll
    for (int off = 16; off > 0; off >>= 1) ss += __shfl_xor(ss, off, 64);
    const float rs = rsqrtf(ss * (1.f / 64.f) + EPS);
    u16* dst = yout + (size_t)(wid * 32 + orow) * DM;
    dst[r32] = f2bf(v0 * rs); dst[32 + r32] = f2bf(v1 * rs);
  }
  __syncthreads();
#undef SLOAD
#undef SWRITE
}

__device__ __forceinline__ void phase_attn(const Params& p, int layer, int bid, int nb, char* lds) {
  const int nitems = 512 + (layer == 0 ? 8 : 0);
  const unsigned* kmx = p.kmx() + layer * 32;
  for (int it = bid; it < nitems; it += nb) {
    int b, h, q0, k0, seq, tok0;
    if (it < 512) { const int pair = it & 7, qb = (it >> 3); h = pair & 3; b = pair >> 2; q0 = qb * 256; k0 = 0; seq = SKV; tok0 = b * SEQ + qb * 256; }
    else { const int i2 = it - 512; h = i2 & 3; b = i2 >> 2; q0 = SEQ; k0 = SEQ; seq = LC; tok0 = TL + b * LC; }
    const size_t base = (size_t)(b * 4 + h) * SKV;
    const float k2 = __uint_as_float(kmx[(b * 4 + h) * 4 + 0]) + __uint_as_float(kmx[(b * 4 + h) * 4 + 1]) + __uint_as_float(kmx[b * 16 + 2]);
    attn_item(p.Q() + (base + q0) * 96, p.KV() + (base + k0) * 160, seq, sqrtf(k2) * 1.02f, p.ymix() + (size_t)tok0 * DM + h * 64, lds);
  }
}

__device__ __forceinline__ float hy_sconv(const u16* __restrict__ row, int t, int Ls, float w0, float w1, float w2, float bb) {
  const float zm = t > 0 ? bf2f(row[t - 1]) : 0.f, z0 = bf2f(row[t]), zp = t + 1 < Ls ? bf2f(row[t + 1]) : 0.f;
  return w0 * zm + w1 * z0 + w2 * zp + bb;
}
__device__ __forceinline__ float2 hy_sconv2(unsigned prv, unsigned cur, unsigned nxt, float w0, float w1, float w2, float bb) {
  const float zm = __uint_as_float(prv & 0xFFFF0000u), z0 = __uint_as_float(cur << 16), z1 = __uint_as_float(cur & 0xFFFF0000u), z2 = __uint_as_float(nxt << 16);
  return make_float2(w0 * zm + w1 * z0 + w2 * z1 + bb, w0 * z0 + w1 * z1 + w2 * z2 + bb);
}
__device__ __forceinline__ void hyena_item(const Params& p, int layer, int b, int ch, char* lds) {
  float2* s = (float2*)lds;
  const int tid = ltid();
  const float* cw = p.hy_conv_w() + (size_t)layer * 3 * 768; const float* cb = p.hy_conv_b() + (size_t)layer * 768;
  const unsigned* r0 = (const unsigned*)(p.zt() + (size_t)(ZT_HY + ch) * TT + (size_t)b * SEQ);
  const unsigned* r1 = (const unsigned*)(p.zt() + (size_t)(ZT_HY + 256 + ch) * TT + (size_t)b * SEQ);
  const unsigned* r2 = (const unsigned*)(p.zt() + (size_t)(ZT_HY + 512 + ch) * TT + (size_t)b * SEQ);
  const float a0 = cw[ch], a1 = cw[768 + ch], a2 = cw[1536 + ch], ab = cb[ch];
  const float b0 = cw[256 + ch], b1 = cw[768 + 256 + ch], b2 = cw[1536 + 256 + ch], bb = cb[256 + ch];
  const float c0 = cw[512 + ch], c1 = cw[768 + 512 + ch], c2 = cw[1536 + 512 + ch], cbb = cb[512 + ch];
  unsigned vgr[16], x0r[16];
#pragma unroll
  for (int hb2 = 0; hb2 < 2; ++hb2) {
    unsigned ld[8][9];
#pragma unroll
    for (int ii = 0; ii < 8; ++ii) {
      const int m = tid + 512 * (hb2 * 8 + ii);
      const int mp = m > 0 ? m - 1 : 0, mn = m + 1 < SEQ / 2 ? m + 1 : m;
      ld[ii][0] = r0[mp]; ld[ii][1] = r0[m]; ld[ii][2] = r0[mn];
      ld[ii][3] = r1[mp]; ld[ii][4] = r1[m]; ld[ii][5] = r1[mn];
      ld[ii][6] = r2[mp]; ld[ii][7] = r2[m]; ld[ii][8] = r2[mn];
    }
#pragma unroll
    for (int ii = 0; ii < 8; ++ii) {
      const int i = hb2 * 8 + ii, m = tid + 512 * i;
      const unsigned mkp = m > 0 ? 0xFFFFFFFFu : 0u, mkn = m + 1 < SEQ / 2 ? 0xFFFFFFFFu : 0u;
      const float2 ux = hy_sconv2(ld[ii][0] & mkp, ld[ii][1], ld[ii][2] & mkn, a0, a1, a2, ab);
      x0r[i] = cvtpk(ux.x, ux.y);
      const float2 u1 = hy_sconv2(ld[ii][3] & mkp, ld[ii][4], ld[ii][5] & mkn, b0, b1, b2, bb);
      const float2 uv = hy_sconv2(ld[ii][6] & mkp, ld[ii][7], ld[ii][8] & mkn, c0, c1, c2, cbb);
      const float2 vgf = make_float2(uv.x * u1.x, uv.y * u1.y);
      vgr[i] = cvtpk(vgf.x, vgf.y);
      s[swz(m)] = vgf;
      s[swz(m + SEQ / 2)] = make_float2(0.f, 0.f);
    }
  }
  __syncthreads();
  fft_fwd(s, p.tw());
  {
    const float4* hs = p.hspec() + ((size_t)layer * 256 + ch) * HSP;
    float4 hv[17];
#pragma unroll
    for (int i = 0; i < 17; ++i) { const int k = tid + 512 * i; hv[i] = hs[k <= FM / 2 ? k : 0]; }
    const float2 twl = p.tw()[tid];
#pragma unroll
    for (int i = 0; i < 17; ++i) {
      const int k = tid + 512 * i;
      if (k <= FM / 2) {
        const int pk = swz(rev7(k)), pm = swz(rev7((FM - k) & (FM - 1)));
        const float2 zk = s[pk], zm = s[pm];
        const float4 h = hv[i];
        const float2 He = make_float2(h.x, h.y), Ho = make_float2(h.z, h.w);
        const float2 Xe = make_float2(0.5f * (zk.x + zm.x), 0.5f * (zk.y - zm.y));
        const float2 Xo = make_float2(0.5f * (zk.y + zm.y), -0.5f * (zk.x - zm.x));
        const float2 twk = cmul(twl, p.tw()[512 * i]);
        const float2 t1 = cmul(twk, cmul(Xo, Ho));
        const float2 e1 = cmul(Xe, He);
        const float2 Ye = make_float2(e1.x + t1.x, e1.y + t1.y);
        const float2 o1 = cmul(Xe, Ho), o2 = cmul(Xo, He);
        const float2 Yo = make_float2(o1.x + o2.x, o1.y + o2.y);
        s[pk] = make_float2(Ye.x - Yo.y, Ye.y + Yo.x);
        if (pm != pk) s[pm] = make_float2(Ye.x + Yo.y, -Ye.y + Yo.x);
      }
    }
  }
  __syncthreads();
  fft_inv(s, p.tw());
  const float hb = p.hy_bias()[layer * 256 + ch];
  unsigned* orow = (unsigned*)(p.hyo() + (size_t)ch * TT + (size_t)b * SEQ);
#pragma unroll
  for (int i = 0; i < 16; ++i) {
    const int m = tid + 512 * i;
    const float2 y = s[swz(m)];
    orow[m] = cvtpk((y.x + __uint_as_float(vgr[i] << 16) * hb) * __uint_as_float(x0r[i] << 16), (y.y + __uint_as_float(vgr[i] & 0xFFFF0000u) * hb) * __uint_as_float(x0r[i] & 0xFFFF0000u));
  }
  __syncthreads();
}
__device__ __forceinline__ void fnet_item(const Params& p, int b, int j, char* lds) {
  float2* s = (float2*)lds;
  const int tid = ltid();
  const u16* rr = p.zt() + (size_t)(ZT_FR + j) * TT + (size_t)b * SEQ;
  const u16* ri = p.zt() + (size_t)(ZT_FI + j) * TT + (size_t)b * SEQ;
  {
    u32x4 vr[4], vi[4];
#pragma unroll
    for (int i = 0; i < 4; ++i) { const int m0 = (tid + 512 * i) * 8; vr[i] = *(const u32x4*)(rr + m0); vi[i] = *(const u32x4*)(ri + m0); }
#pragma unroll
    for (int i = 0; i < 4; ++i) {
      const int m0 = (tid + 512 * i) * 8;
#pragma unroll
      for (int q = 0; q < 4; ++q) {
        s[swz(m0 + 2 * q)] = make_float2(__uint_as_float(vr[i][q] << 16), __uint_as_float(vi[i][q] << 16));
        s[swz(m0 + 2 * q + 1)] = make_float2(__uint_as_float(vr[i][q] & 0xFFFF0000u), __uint_as_float(vi[i][q] & 0xFFFF0000u));
      }
    }
  }
  __syncthreads();
  fft_fwd(s, p.tw());
#ifdef PROBE_FFT
  fft_inv(s, p.tw());
  for (int m = tid; m < FM; m += NTHR) { float2 v = s[m]; v.x *= (1.f / 16384.f); v.y *= (1.f / 16384.f); s[m] = v; }
  __syncthreads();
  fft_fwd(s, p.tw());
#endif
  u16* orow = p.fno() + (size_t)j * TT + (size_t)b * SEQ;
#pragma unroll 8
  for (int k = tid; k < FM; k += NTHR) orow[k] = f2bf(s[swz(rev7(k))].x * (1.f / 128.f));
  __syncthreads();
}
__device__ __forceinline__ void hyena_ctx_item(const Params& p, int b, int ch, char* lds) {
  float* vg = (float*)lds;
  float* x0 = vg + 256;
  float* hf = x0 + 256;
  float* hbk = hf + 256;
  const int tid = ltid();
  const float* cw = p.hy_conv_w(); const float* cb = p.hy_conv_b();
  const size_t off = (size_t)TL + (size_t)b * LC;
  const u16* r0 = p.zt() + (size_t)(ZT_HY + ch) * TT + off;
  const u16* r1 = p.zt() + (size_t)(ZT_HY + 256 + ch) * TT + off;
  const u16* r2 = p.zt() + (size_t)(ZT_HY + 512 + ch) * TT + off;
  if (tid < 256) {
    const int t = tid;
    vg[t] = hy_sconv(r2, t, LC, cw[512 + ch], cw[768 + 512 + ch], cw[1536 + 512 + ch], cb[512 + ch]) *
            hy_sconv(r1, t, LC, cw[256 + ch], cw[768 + 256 + ch], cw[1536 + 256 + ch], cb[256 + ch]);
    x0[t] = hy_sconv(r0, t, LC, cw[ch], cw[768 + ch], cw[1536 + ch], cb[ch]);
    hf[t] = p.hfc()[(size_t)ch * LC + t]; hbk[t] = p.hfc()[(size_t)(256 + ch) * LC + t];
  }
  const float ssq_c = filt_ssq(p.hpart() + (size_t)2 * 256 * 512, ch, (float*)(lds + 8192));
  if (tid < 256) {
    const int t = tid; float y = 0;
    for (int q = 0; q <= t; ++q) y += hf[t - q] * vg[q];
    for (int q = t + 1; q < LC; ++q) y += hbk[q - t] * vg[q];
    y *= rsqrtf(ssq_c);
    p.hyo()[(size_t)ch * TT + off + t] = f2bf((y + vg[t] * p.hy_bias()[ch]) * x0[t]);
  }
  __syncthreads();
}
__device__ __forceinline__ void fnet_ctx_item(const Params& p, int b, int j, char* lds) {
  float* ur = (float*)lds; float* ui = ur + 256; float* cst = ui + 256; float* snt = cst + 256;
  const int tid = ltid();
  const size_t off = (size_t)TL + (size_t)b * LC;
  if (tid < 256) {
    ur[tid] = bf2f(p.zt()[(size_t)(ZT_FR + j) * TT + off + tid]); ui[tid] = bf2f(p.zt()[(size_t)(ZT_FI + j) * TT + off + tid]);
    float sn, cs; sincospif((float)tid / 128.f, &sn, &cs); cst[tid] = cs; snt[tid] = sn;
  }
  __syncthreads();
  if (tid < 256) {
    const int k = tid; float y = 0;
    for (int l = 0; l < 256; ++l) { const int m = (l * k) & 255; y += cst[m] * ur[l] + snt[m] * ui[l]; }
    p.fno()[(size_t)j * TT + off + k] = f2bf(y * 0.0625f);
  }
  __syncthreads();
}
__device__ __forceinline__ void phase_fftmix(const Params& p, int layer, int bid, int nb, char* lds) {
  const int nitems = layer == 0 ? 2048 : 1024;
  for (int it = bid; it < nitems; it += nb) {
    const int k = it & 511, b = k >> 8, c = k & 255;
    if (it < 512) hyena_item(p, layer, b, c, lds);
    else if (it < 1024) fnet_item(p, b, c, lds);
    else if (it < 1536) hyena_ctx_item(p, b, c, lds);
    else fnet_ctx_item(p, b, c, lds);
  }
}
constexpr int GLG = 17, NGRP = 16;
__device__ __forceinline__ int gla_chain_tok(int dir, int b, int n, int i) {
  const int base = n < 4 ? TL + b * LC : b * SEQ, len = n < 4 ? LC : SEQ, m = n < 4 ? n : n - 4;
  return dir == 0 ? base + 64 * m + i : base + (len - 1) - (64 * m + i);
}
__device__ __forceinline__ float logsig16(float x) { return (fminf(x, 0.f) - log1pf(__expf(-fabsf(x)))) * (1.f / 16.f); }
__device__ __forceinline__ float wave_scan_incl(float v, int lane) {
#pragma unroll
  for (int o = 1; o < 64; o <<= 1) { const float t = __shfl_up(v, o, 64); if (lane >= o) v += t; }
  return v;
}
__device__ __forceinline__ void phase_gla_a(const Params& p, int layer, int bid, int nb, char* lds) {
  float* kl = (float*)lds;
  float* gl = kl + 64 * 33;
  float* vl = gl + 64 * 33;
  const int tid = ltid(), wid = tid >> 6, lane = tid & 63;
  const float* gb = p.gla_gk_b() + (size_t)layer * 256;
  for (int it = bid; it < 16 * NGRP; it += nb) {
    const int chain = it >> 4, g = it & 15, dir = chain >> 3, b = (chain >> 2) & 1, h = chain & 3;
    const int n0 = g * GLG, n1 = min(n0 + GLG, NCH);
    const int kk = tid >> 4, v0 = (tid & 15) * 4;
    float st[4] = {0.f, 0.f, 0.f, 0.f}; float dcum = 1.f;
    for (int n = n0; n < n1; ++n) {
      {
        const int i = tid >> 3, c4 = (tid & 7) * 4;
        const u16* zr = p.zg() + (size_t)gla_chain_tok(dir, b, n, i) * ZG_W;
        const float4 k4 = ld4bf(zr + ZG_GK + h * 32 + c4);
        const float4 g4 = ld4bf(zr + ZG_GP + dir * 128 + h * 32 + c4);
        const float4 bb = *(const float4*)(gb + dir * 128 + h * 32 + c4);
        const float4 va = ld4bf(zr + ZG_GV + h * 64 + c4 * 2), vb = ld4bf(zr + ZG_GV + h * 64 + c4 * 2 + 4);
        kl[i * 33 + c4] = k4.x; kl[i * 33 + c4 + 1] = k4.y; kl[i * 33 + c4 + 2] = k4.z; kl[i * 33 + c4 + 3] = k4.w;
        gl[i * 33 + c4] = logsig16(g4.x + bb.x); gl[i * 33 + c4 + 1] = logsig16(g4.y + bb.y); gl[i * 33 + c4 + 2] = logsig16(g4.z + bb.z); gl[i * 33 + c4 + 3] = logsig16(g4.w + bb.w);
        *(float4*)(vl + i * 68 + c4 * 2) = va; *(float4*)(vl + i * 68 + c4 * 2 + 4) = vb;
      }
      __syncthreads();
#pragma unroll
      for (int q = 0; q < 4; ++q) { const int c = wid * 4 + q; gl[lane * 33 + c] = wave_scan_incl(gl[lane * 33 + c], lane); }
      __syncthreads();
      {
        float* lp = p.gds() + ((size_t)chain * NCH + n) * 2048 + kk * 64 + v0;
        *(float4*)lp = make_float4(st[0], st[1], st[2], st[3]);
        if ((tid & 15) == 0) p.gdv()[((size_t)chain * NCH + n) * 32 + kk] = dcum;
        const float bl = gl[63 * 33 + kk];
        float acc[4] = {0.f, 0.f, 0.f, 0.f};
#pragma unroll 8
        for (int i = 0; i < 64; ++i) {
          const float w = kl[i * 33 + kk] * __expf(bl - gl[i * 33 + kk]);
          const float4 vv = *(const float4*)(vl + i * 68 + v0);
          acc[0] += w * vv.x; acc[1] += w * vv.y; acc[2] += w * vv.z; acc[3] += w * vv.w;
        }
        const float d = __expf(bl);
#pragma unroll
        for (int j = 0; j < 4; ++j) st[j] = st[j] * d + acc[j];
        dcum *= d;
      }
      __syncthreads();
    }
    float* at = p.gst() + ((size_t)chain * NGRP + g) * 2048 + kk * 64 + v0;
    *(float4*)at = make_float4(st[0], st[1], st[2], st[3]);
    if ((tid & 15) == 0) p.gst()[(size_t)16 * NGRP * 2048 + ((size_t)chain * NGRP + g) * 32 + kk] = dcum;
  }
}

constexpr int GC_QP = 33792, GC_KP = GC_QP + 10240, GC_VT = GC_KP + 10240, GC_ST = GC_VT + 18432, GC_AX = GC_ST + 10240;
__device__ __forceinline__ void phase_gla_c(const Params& p, int layer, int bid, int nb, char* lds) {
  float* gl = (float*)lds;
  float* qraw = gl + 2 * 64 * 33;
  float* kraw = qraw + 64 * 33;
  float* Of = (float*)lds;
  char* Qp = lds + GC_QP;
  char* Kp = lds + GC_KP;
  char* VT = lds + GC_VT;
  char* ST = lds + GC_ST;
  const int tid = ltid(), wid = tid >> 6, lane = tid & 63, r32 = lane & 31, hi = lane >> 5;
  char* Ax = lds + GC_AX + wid * 4608;
  const float* gb = p.gla_gk_b() + (size_t)layer * 256;
  const int pc_lo = layer == 0 ? 0 : 4, npc = NCH - pc_lo, nitem = 8 * npc;
  const int per = (nitem + nb - 1) / nb, q_beg = bid * per, q_end = min(nitem, q_beg + per);
  const int sdir = tid >> 8, sk = (tid >> 3) & 31, sv0 = (tid & 7) * 8;
  float G[8]; int g_cached = -1, bh_cached = -1;
  for (int qi = q_beg; qi < q_end; ++qi) {
    const int bh = qi / npc, pc = pc_lo + qi % npc, b = bh >> 2, h = bh & 3;
    const int tok0 = pc < 4 ? TL + b * LC + pc * 64 : b * SEQ + (pc - 4) * 64;
    {
      const int pos = tid >> 3, c4 = (tid & 7) * 4;
      const u16* zr = p.zg() + (size_t)(tok0 + pos) * ZG_W;
      const float4 q4 = ld4bf(zr + ZG_GQ + h * 32 + c4), k4 = ld4bf(zr + ZG_GK + h * 32 + c4);
      const float sc = 0.17677669529663687f;
      qraw[pos * 33 + c4] = q4.x * sc; qraw[pos * 33 + c4 + 1] = q4.y * sc; qraw[pos * 33 + c4 + 2] = q4.z * sc; qraw[pos * 33 + c4 + 3] = q4.w * sc;
      kraw[pos * 33 + c4] = k4.x; kraw[pos * 33 + c4 + 1] = k4.y; kraw[pos * 33 + c4 + 2] = k4.z; kraw[pos * 33 + c4 + 3] = k4.w;
#pragma unroll
      for (int d = 0; d < 2; ++d) {
        const float4 g4 = ld4bf(zr + ZG_GP + d * 128 + h * 32 + c4), bb = *(const float4*)(gb + d * 128 + h * 32 + c4);
        const int i = d ? 63 - pos : pos;
        float* gd = gl + (d * 64 + i) * 33 + c4;
        gd[0] = logsig16(g4.x + bb.x); gd[1] = logsig16(g4.y + bb.y); gd[2] = logsig16(g4.z + bb.z); gd[3] = logsig16(g4.w + bb.w);
      }
      const float4 va = ld4bf(zr + ZG_GV + h * 64 + c4 * 2), vb = ld4bf(zr + ZG_GV + h * 64 + c4 * 2 + 4);
      const float vv[8] = {va.x, va.y, va.z, va.w, vb.x, vb.y, vb.z, vb.w};
#pragma unroll
      for (int j = 0; j < 8; ++j) {
        const u16 hv = f2bf(vv[j]); const int v = c4 * 2 + j;
        *(u16*)(VT + (0 * 64 + v) * 144 + pos * 2) = hv; *(u16*)(VT + (1 * 64 + v) * 144 + (63 - pos) * 2) = hv;
      }
    }
    __syncthreads();
#pragma unroll
    for (int q = 0; q < 8; ++q) { const int col = wid * 8 + q, d = col >> 5, c = col & 31; float* gp = gl + (d * 64 + lane) * 33 + c; *gp = wave_scan_incl(*gp, lane); }
    __syncthreads();
    {
#pragma unroll
      for (int e = 0; e < 2; ++e) {
        const int idx = tid + e * 512, d = idx >> 9, i = (idx >> 3) & 63, c4 = (idx & 7) * 4, pos = d ? 63 - i : i;
        float qo[4], ko[4];
#pragma unroll
        for (int j = 0; j < 4; ++j) {
          const float bi = gl[(d * 64 + i) * 33 + c4 + j], bm = gl[(d * 64 + 31) * 33 + c4 + j];
          qo[j] = qraw[pos * 33 + c4 + j] * __expf(bi - bm); ko[j] = kraw[pos * 33 + c4 + j] * __expf(bm - bi);
        }
        *(u32x2*)(Qp + (d * 64 + i) * 80 + c4 * 2) = u32x2{cvtpk(qo[0], qo[1]), cvtpk(qo[2], qo[3])};
        *(u32x2*)(Kp + (d * 64 + i) * 80 + c4 * 2) = u32x2{cvtpk(ko[0], ko[1]), cvtpk(ko[2], ko[3])};
      }
      const int chain = sdir * 8 + b * 4 + h;
      const int n = sdir == 0 ? pc : (pc < 4 ? 3 - pc : 4 + 255 - (pc - 4)), g = n / GLG;
      if (g != g_cached || bh != bh_cached) {
#pragma unroll
        for (int j = 0; j < 8; ++j) G[j] = 0.f;
        const float* at = p.gst() + (size_t)chain * NGRP * 2048 + sk * 64 + sv0;
        const float* dt = p.gst() + (size_t)16 * NGRP * 2048 + (size_t)chain * NGRP * 32 + sk;
        for (int gg = 0; gg < g; ++gg) {
          const float4 a0 = *(const float4*)(at + (size_t)gg * 2048), a1 = *(const float4*)(at + (size_t)gg * 2048 + 4); const float dd = dt[gg * 32];
          G[0] = G[0] * dd + a0.x; G[1] = G[1] * dd + a0.y; G[2] = G[2] * dd + a0.z; G[3] = G[3] * dd + a0.w;
          G[4] = G[4] * dd + a1.x; G[5] = G[5] * dd + a1.y; G[6] = G[6] * dd + a1.z; G[7] = G[7] * dd + a1.w;
        }
        g_cached = g; bh_cached = bh;
      }
      const float* lp = p.gds() + ((size_t)chain * NCH + n) * 2048 + sk * 64 + sv0;
      const float4 l0 = *(const float4*)lp, l1 = *(const float4*)(lp + 4);
      const float dp = p.gdv()[((size_t)chain * NCH + n) * 32 + sk];
      const float em = __expf(gl[(sdir * 64 + 31) * 33 + sk]);
      const float sv[8] = {l0.x + dp * G[0], l0.y + dp * G[1], l0.z + dp * G[2], l0.w + dp * G[3], l1.x + dp * G[4], l1.y + dp * G[5], l1.z + dp * G[6], l1.w + dp * G[7]};
#pragma unroll
      for (int j = 0; j < 8; ++j) *(u16*)(ST + (sdir * 64 + sv0 + j) * 80 + sk * 2) = f2bf(sv[j] * em);
    }
    __syncthreads();
    {
      const int d = wid >> 2, ib = (wid >> 1) & 1, vb = wid & 1;
      const char* Qd = Qp + d * 64 * 80; const char* Kd = Kp + d * 64 * 80; const char* Vd = VT + d * 64 * 144; const char* Sd = ST + d * 64 * 80;
      bf16x8 qf[2];
#pragma unroll
      for (int s2 = 0; s2 < 2; ++s2) qf[s2] = *(const bf16x8*)(Qd + (ib * 32 + r32) * 80 + (16 * s2 + 8 * hi) * 2);
#pragma unroll
      for (int jb = 0; jb < 2; ++jb) {
        if (jb <= ib) {
          f32x16 x = {};
#pragma unroll
          for (int s2 = 0; s2 < 2; ++s2) {
            const bf16x8 kf = *(const bf16x8*)(Kd + (jb * 32 + r32) * 80 + (16 * s2 + 8 * hi) * 2);
            x = __builtin_amdgcn_mfma_f32_32x32x16_bf16(qf[s2], kf, x, 0, 0, 0);
          }
#pragma unroll
          for (int r = 0; r < 16; ++r) {
            const int il = crow(r, hi), i = ib * 32 + il, j = jb * 32 + r32;
            *(u16*)(Ax + il * 144 + j * 2) = f2bf(j <= i ? x[r] : 0.f);
          }
        }
      }
      asm volatile("s_waitcnt lgkmcnt(0)" ::: "memory");
      f32x16 o = {};
#pragma unroll
      for (int s4 = 0; s4 < 4; ++s4) {
        if (s4 < 2 * (ib + 1)) {
          const bf16x8 af = *(const bf16x8*)(Ax + r32 * 144 + (16 * s4 + 8 * hi) * 2);
          const bf16x8 vf = *(const bf16x8*)(Vd + (vb * 32 + r32) * 144 + (16 * s4 + 8 * hi) * 2);
          o = __builtin_amdgcn_mfma_f32_32x32x16_bf16(af, vf, o, 0, 0, 0);
        }
      }
#pragma unroll
      for (int s2 = 0; s2 < 2; ++s2) {
        const bf16x8 sf = *(const bf16x8*)(Sd + (vb * 32 + r32) * 80 + (16 * s2 + 8 * hi) * 2);
        o = __builtin_amdgcn_mfma_f32_32x32x16_bf16(qf[s2], sf, o, 0, 0, 0);
      }
#pragma unroll
      for (int r = 0; r < 16; ++r) {
        const int i = ib * 32 + crow(r, hi), pos = d ? 63 - i : i;
        Of[(d * 64 + pos) * 65 + vb * 32 + r32] = o[r];
      }
    }
    __syncthreads();
    {
      const int pos = tid >> 3, v0 = (tid & 7) * 8;
      u16* op = p.glao() + (size_t)(tok0 + pos) * 256 + h * 64 + v0;
      float r8[8];
#pragma unroll
      for (int j = 0; j < 8; ++j) r8[j] = Of[pos * 65 + v0 + j] + Of[(64 + pos) * 65 + v0 + j];
      *(u32x4*)op = u32x4{cvtpk(r8[0], r8[1]), cvtpk(r8[2], r8[3]), cvtpk(r8[4], r8[5]), cvtpk(r8[6], r8[7])};
    }
    __syncthreads();
  }
}

__device__ __forceinline__ void phase_mix(const Params& p, int layer, int bid, int nb, char* lds) {
  float* part = (float*)lds;
  u16* tile = (u16*)(lds + 4096);
  const int tid = ltid(), wid = tid >> 6, lane = tid & 63;
  const int ntok = layer == 0 ? TT : TL;
  for (int it = bid; it < ntok / 64; it += nb) {
    const int tok0 = it * 64;
    float vh[32], vf[32]; float sh = 0, sf = 0;
#pragma unroll
    for (int c = 0; c < 32; ++c) {
      vh[c] = bf2f(p.hyo()[(size_t)(wid * 32 + c) * TT + tok0 + lane]); vf[c] = bf2f(p.fno()[(size_t)(wid * 32 + c) * TT + tok0 + lane]);
      sh += vh[c] * vh[c]; sf += vf[c] * vf[c];
    }
    part[(0 * 8 + wid) * 64 + lane] = sh; part[(1 * 8 + wid) * 64 + lane] = sf;
    __syncthreads();
    float th = 0, tf = 0;
#pragma unroll
    for (int q = 0; q < 8; ++q) { th += part[(0 * 8 + q) * 64 + lane]; tf += part[(1 * 8 + q) * 64 + lane]; }
    const float rh = rsqrtf(th * (1.f / 256.f) + EPS), rf = rsqrtf(tf * (1.f / 256.f) + EPS);
#pragma unroll
    for (int c = 0; c < 32; ++c) { tile[lane * 520 + wid * 32 + c] = f2bf(vh[c] * rh); tile[lane * 520 + 256 + wid * 32 + c] = f2bf(vf[c] * rf); }
    __syncthreads();
    for (int g = tid; g < 64 * 64; g += NTHR) {
      const int tl = g >> 6, cg = g & 63;
      const u32x4 w = *(const u32x4*)(tile + tl * 520 + cg * 8);
      *(u32x4*)(p.ymix() + (size_t)(tok0 + tl) * DM + (cg < 32 ? 256 + cg * 8 : 768 + (cg - 32) * 8)) = w;
    }
    for (int tl = wid * 8; tl < wid * 8 + 8; ++tl) {
      const int tok = tok0 + tl;
      const float4 o = ld4bf(p.glao() + (size_t)tok * 256 + lane * 4);
      float ss = o.x * o.x + o.y * o.y + o.z * o.z + o.w * o.w;
#pragma unroll
      for (int off = 8; off > 0; off >>= 1) ss += __shfl_xor(ss, off, 64);
      const float rs = rsqrtf(ss * (1.f / 64.f) + EPS);
      const float4 g = ld4bf(p.zg() + (size_t)tok * ZG_W + ZG_OG + lane * 4);
      u32x2 w; w[0] = cvtpk(o.x * rs * silu_f(g.x), o.y * rs * silu_f(g.y)); w[1] = cvtpk(o.z * rs * silu_f(g.z), o.w * rs * silu_f(g.w));
      *(u32x2*)(p.ymix() + (size_t)tok * DM + 512 + lane * 4) = w;
    }
    __syncthreads();
  }
}

struct EpiOut {
  const Params* pp; int layer;
  __device__ __forceinline__ void operator()(const f32x4 (&acc)[2][2][4][2], const G8Unit& u, int wr, int wc, int fr, int fq) const {
    const Params& p = *pp;
    const float* g1 = p.mod() + ((size_t)layer * 3 + modv(u.pm * 256)) * 6144 + 2 * DM;
#pragma unroll
    for (int bj = 0; bj < 2; ++bj) {
      const int c0 = u.pn * 256 + bj * 128 + wc * 32 + 8 * fq;
      const f32x4 ga = *(const f32x4*)(g1 + c0), gb = *(const f32x4*)(g1 + c0 + 4);
#pragma unroll
      for (int ai = 0; ai < 2; ++ai)
#pragma unroll
        for (int m = 0; m < 4; ++m) {
          const int tok = u.pm * 256 + ai * 128 + wr * 64 + m * 16 + fr;
          const float* xr = resid_row(p, layer == 0 ? 0 : 1, tok) + c0;
          float* xo = p.X() + (size_t)tok * DM + c0;
          const f32x4 xa = *(const f32x4*)xr, xb = *(const f32x4*)(xr + 4);
          *(f32x4*)xo = xa + ga * acc[ai][bj][m][0]; *(f32x4*)(xo + 4) = xb + gb * acc[ai][bj][m][1];
        }
    }
  }
};
__device__ __forceinline__ void phase_gemm_out(const Params& p, int layer, int bid, int nb, char* lds) {
  G8Plain S; S.nM = (layer == 0 ? TT : TL) / 256; S.nN = DM / 256; S.Kb = 2 * DM; S.G = nb; S.c = bid; S.Bt = (const char*)(p.bt_out() + (size_t)layer * DM * DM);
  EpiOut E; E.pp = &p; E.layer = layer;
  gemm8_phase<false>(lds, (const char*)p.ymix(), 2 * DM, S, E);
}

__device__ __forceinline__ void phase_norm2_router(const Params& p, int layer, int bid, int nb, char* lds) {
  float* rwl = (float*)lds;
  int* lcnt = (int*)(lds + 131072);
  int* lbase = lcnt + 32;
  int* ent = lbase + 32;
  float* entw = (float*)(ent + 2 * 1024);
  const int tid = ltid(), wid = tid >> 6, lane = tid & 63;
  const int ntok = layer == 0 ? TT : TL;
  const float* rw = p.router_w() + (size_t)layer * DM * NE;
  for (int i = tid; i < DM * NE / 4; i += NTHR) {
    const int k = i >> 3, q4 = i & 7;
    ((float4*)rwl)[q4 * 1024 + ((k & 3) * 256 + (k >> 2))] = ((const float4*)rw)[i];
  }
  if (tid < 32) lcnt[tid] = 0;
  __syncthreads();
  const float* gn = p.norm2_g() + layer * DM; const float* rb = p.router_b() + layer * NE;
  const int per = (ntok + nb - 1) / nb, t_beg = bid * per, t_end = min(ntok, t_beg + per);
  for (int tok = t_beg + wid; tok < t_end; tok += 8) {
    const float* xr = p.X() + (size_t)tok * DM;
    float v[16];
#pragma unroll
    for (int i = 0; i < 4; ++i) { const float4 a = *(const float4*)(xr + lane * 4 + i * 256); v[4 * i] = a.x; v[4 * i + 1] = a.y; v[4 * i + 2] = a.z; v[4 * i + 3] = a.w; }
    float ss = 0;
#pragma unroll
    for (int i = 0; i < 16; ++i) ss += v[i] * v[i];
    ss = wave_sum(ss);
    const float rs = rsqrtf(ss * (1.f / DM) + EPS);
    const float* md = p.mod() + ((size_t)layer * 3 + modv(tok)) * 6144 + 3 * DM;
#pragma unroll
    for (int i = 0; i < 4; ++i) {
      const int c = lane * 4 + i * 256;
      const float4 g = *(const float4*)(gn + c), sh = *(const float4*)(md + c), sc = *(const float4*)(md + DM + c);
      v[4 * i] = v[4 * i] * rs * g.x * (1.f + sc.x) + sh.x; v[4 * i + 1] = v[4 * i + 1] * rs * g.y * (1.f + sc.y) + sh.y;
      v[4 * i + 2] = v[4 * i + 2] * rs * g.z * (1.f + sc.z) + sh.z; v[4 * i + 3] = v[4 * i + 3] * rs * g.w * (1.f + sc.w) + sh.w;
    }
    store_row_i8(v, p.H() + (size_t)tok * DM, p.hs() + tok, lane);
    float lg[32];
#pragma unroll
    for (int e = 0; e < 32; ++e) lg[e] = 0.f;
#pragma unroll
    for (int i = 0; i < 16; ++i) {
      const float4* wr4 = (const float4*)rwl + ((i & 3) * 256 + (i >> 2) * 64 + lane);
#pragma unroll
      for (int q = 0; q < 8; ++q) { const float4 w = wr4[q * 1024]; lg[4 * q] += v[i] * w.x; lg[4 * q + 1] += v[i] * w.y; lg[4 * q + 2] += v[i] * w.z; lg[4 * q + 3] += v[i] * w.w; }
    }
    float r16[16], r8[8], r4[4], r2[2], lv;
    { const bool up = lane & 32;
#pragma unroll
      for (int e = 0; e < 16; ++e) { const float keep = up ? lg[16 + e] : lg[e], send = up ? lg[e] : lg[16 + e]; r16[e] = keep + __shfl_xor(send, 32, 64); } }
    { const bool up = lane & 16;
#pragma unroll
      for (int e = 0; e < 8; ++e) { const float keep = up ? r16[8 + e] : r16[e], send = up ? r16[e] : r16[8 + e]; r8[e] = keep + __shfl_xor(send, 16, 64); } }
    { const bool up = lane & 8;
#pragma unroll
      for (int e = 0; e < 4; ++e) { const float keep = up ? r8[4 + e] : r8[e], send = up ? r8[e] : r8[4 + e]; r4[e] = keep + __shfl_xor(send, 8, 64); } }
    { const bool up = lane & 4;
#pragma unroll
      for (int e = 0; e < 2; ++e) { const float keep = up ? r4[2 + e] : r4[e], send = up ? r4[e] : r4[2 + e]; r2[e] = keep + __shfl_xor(send, 4, 64); } }
    { const bool up = lane & 2; const float keep = up ? r2[1] : r2[0], send = up ? r2[0] : r2[1]; lv = keep + __shfl_xor(send, 2, 64); }
    lv += __shfl_xor(lv, 1, 64);
    lv += rb[lane >> 1];
    int ids[4]; float vals[4];
#pragma unroll
    for (int k = 0; k < 4; ++k) {
      float mx = lv;
#pragma unroll
      for (int o = 32; o > 0; o >>= 1) mx = fmaxf(mx, __shfl_xor(mx, o, 64));
      const unsigned long long bal = __ballot(lv == mx);
      const int win = __ffsll((long long)bal) - 1;
      ids[k] = win >> 1; vals[k] = mx;
      if ((lane >> 1) == ids[k]) lv = -3.4e38f;
    }
    if (lane == 0) {
      const float mx = vals[0];
      float ex[4], sum = 0;
#pragma unroll
      for (int k = 0; k < 4; ++k) { ex[k] = __expf(vals[k] - mx); sum += ex[k]; }
      const float inv = 1.f / sum;
#pragma unroll
      for (int k = 0; k < 4; ++k) {
        const int lp = atomicAdd(&lcnt[ids[k]], 1);
        const int slot = (tok - t_beg) * 4 + k;
        ent[2 * slot] = tok * 4 + k; ent[2 * slot + 1] = (ids[k] << 20) | lp; entw[slot] = ex[k] * inv;
      }
    }
  }
  __syncthreads();
  if (tid < 32) lbase[tid] = atomicAdd(&p.cnt()[layer * NE + tid], lcnt[tid]);
  __syncthreads();
  const int nas = (t_end > t_beg ? (t_end - t_beg) : 0) * 4;
  for (int s = tid; s < nas; s += NTHR) {
    const int tk = ent[2 * s], el = ent[2 * s + 1], e = el >> 20, pos = lbase[e] + (el & 0xFFFFF);
    p.rtok()[(size_t)e * TT + pos] = tk >> 2; p.rw()[(size_t)e * TT + pos] = entw[s];
    p.tslot()[tk] = (e << 20) | pos;
  }
}

struct G8Moe {
  const int* cnt;
  int ntn, Kb, G, c; const char* Bt; size_t bstride;
  const int* rtok;
  __device__ __forceinline__ bool next(int i, G8Unit& u) const {
    const int w = (i * 8 + (c & 7)) * (G >> 3) + (c >> 3); int acc = 0, rows = 0;
    for (int ee = 0; ee < NE; ++ee) {
      const int cc = cnt[ee], tiles = ((cc + 255) >> 8) * ntn;
      if (w < acc + tiles) { const int r = w - acc; u.e = ee; u.pm = r / ntn; u.pn = r % ntn; u.ce = cc; u.pre = rows; return true; }
      acc += tiles; rows += cc;
    }
    return false;
  }
  __device__ __forceinline__ unsigned a_off(const G8Unit& u, int row) const {
    const int r = min(u.pm * 256 + row, u.ce - 1);
    const int arow = rtok ? rtok[(size_t)u.e * TT + r] : u.pre + r;
    return (unsigned)arow * (unsigned)Kb;
  }
  __device__ __forceinline__ const char* b_ptr(const G8Unit& u) const { return Bt + (size_t)u.e * bstride + (size_t)u.pn * 256 * Kb; }
};
struct EpiGu {
  const float* bgl; u16* act; const float* hs; const float* swl; const int* rtok;
  __device__ __forceinline__ void operator()(const i32x4 (&acc)[2][2][4][2], const G8Unit& u, int wr, int wc, int fr, int fq) const {
    const int j0 = u.pn * 128 + wc * 32 + 8 * fq;
    const float* bg = bgl + (size_t)u.e * 2048 + 2 * j0;
    float bgt[8], bup[8], sg[8], su[8];
#pragma unroll
    for (int q = 0; q < 4; ++q) { const f32x4 t = *(const f32x4*)(bg + 4 * q); bgt[2 * q] = t[0]; bup[2 * q] = t[1]; bgt[2 * q + 1] = t[2]; bup[2 * q + 1] = t[3]; }
    {
      const float* sp = swl + (size_t)u.e * 2048 + u.pn * 256 + wc * 32 + 8 * fq;
      const f32x4 g0 = *(const f32x4*)sp, g1 = *(const f32x4*)(sp + 4), u0 = *(const f32x4*)(sp + 128), u1 = *(const f32x4*)(sp + 132);
#pragma unroll
      for (int j = 0; j < 4; ++j) { sg[j] = g0[j]; sg[4 + j] = g1[j]; su[j] = u0[j]; su[4 + j] = u1[j]; }
    }
#pragma unroll
    for (int ai = 0; ai < 2; ++ai)
#pragma unroll
      for (int m = 0; m < 4; ++m) {
        const int r = u.pm * 256 + ai * 128 + wr * 64 + m * 16 + fr;
        if (r < u.ce) {
          const float sa = hs[rtok[(size_t)u.e * TT + r]];
          float o[8];
#pragma unroll
          for (int n = 0; n < 2; ++n)
#pragma unroll
            for (int j = 0; j < 4; ++j) {
              const float gate = fminf((float)acc[ai][0][m][n][j] * sa * sg[4 * n + j] + bgt[4 * n + j], 7.f);
              const float up = fminf(fmaxf((float)acc[ai][1][m][n][j] * sa * su[4 * n + j] + bup[4 * n + j], -7.f), 7.f);
              o[4 * n + j] = (up + 1.f) * gate * __builtin_amdgcn_rcpf(1.f + __expf(-1.702f * gate));
            }
          *(u32x4*)(act + (size_t)(u.pre + r) * DFF + j0) = u32x4{cvtpk(o[0], o[1]), cvtpk(o[2], o[3]), cvtpk(o[4], o[5]), cvtpk(o[6], o[7])};
        }
      }
  }
};
struct EpiDn {
  const float* bdl; const float* rw; u16* yd;
  __device__ __forceinline__ void operator()(const f32x4 (&acc)[2][2][4][2], const G8Unit& u, int wr, int wc, int fr, int fq) const {
#pragma unroll
    for (int bj = 0; bj < 2; ++bj) {
      const int c0 = u.pn * 256 + bj * 128 + wc * 32 + 8 * fq;
      const f32x4 ba = *(const f32x4*)(bdl + (size_t)u.e * DM + c0), bb = *(const f32x4*)(bdl + (size_t)u.e * DM + c0 + 4);
#pragma unroll
      for (int ai = 0; ai < 2; ++ai)
#pragma unroll
        for (int m = 0; m < 4; ++m) {
          const int r = u.pm * 256 + ai * 128 + wr * 64 + m * 16 + fr;
          if (r < u.ce) {
            const float wgt = rw[(size_t)u.e * TT + r];
            const f32x4 a = (acc[ai][bj][m][0] + ba) * wgt, b = (acc[ai][bj][m][1] + bb) * wgt;
            *(u32x4*)(yd + (size_t)(u.pre + r) * DM + c0) = u32x4{cvtpk(a[0], a[1]), cvtpk(a[2], a[3]), cvtpk(b[0], b[1]), cvtpk(b[2], b[3])};
          }
        }
    }
  }
};
__device__ __forceinline__ void phase_moe_gu(const Params& p, int layer, int bid, int nb, char* lds) {
  int* scnt = (int*)(lds + 131072);
  if (ltid() < NE) scnt[ltid()] = p.cnt()[layer * NE + ltid()];
  __syncthreads();
  G8Moe S; S.cnt = scnt; S.ntn = 8; S.Kb = DM; S.G = nb; S.c = bid; S.Bt = (const char*)(p.bt_gu() + (size_t)layer * NE * 2048 * DM); S.bstride = (size_t)2048 * DM; S.rtok = p.rtok();
  EpiGu E; E.bgl = p.moe_b_gu() + (size_t)layer * NE * 2048; E.act = p.act(); E.hs = p.hs(); E.swl = p.swgu() + (size_t)layer * NE * 2048; E.rtok = p.rtok();
  gemm8_phase<true>(lds, (const char*)p.H(), DM, S, E);
}
__device__ __forceinline__ void phase_moe_dn(const Params& p, int layer, int bid, int nb, char* lds) {
  int* scnt = (int*)(lds + 131072);
  if (ltid() < NE) scnt[ltid()] = p.cnt()[layer * NE + ltid()];
  __syncthreads();
  G8Moe S; S.cnt = scnt; S.ntn = 4; S.Kb = 2 * DFF; S.G = nb; S.c = bid; S.Bt = (const char*)(p.bt_dn() + (size_t)layer * NE * DM * DFF); S.bstride = (size_t)DM * DFF * 2; S.rtok = nullptr;
  EpiDn E; E.bdl = p.moe_b_down() + (size_t)layer * NE * DM; E.rw = p.rw(); E.yd = p.yd();
  gemm8_phase<false>(lds, (const char*)p.act(), 2 * DFF, S, E);
}

__device__ __forceinline__ void phase_final(const Params& p, int bid, int nb, char* lds) {
  int* pre = (int*)lds;
  expert_prefix(p.cnt() + NE, pre); __syncthreads();
  const int wid = ltid() >> 6, lane = ltid() & 63;
  for (int tok = bid * 8 + wid; tok < TL; tok += nb * 8) {
    float v[16];
    load_row_comb(p, 1, 1, tok, lane, pre, v);
    float ss = 0;
#pragma unroll
    for (int i = 0; i < 16; ++i) ss += v[i] * v[i];
    ss = wave_sum(ss);
    const float rs = rsqrtf(ss * (1.f / DM) + EPS);
    float* o = p.out() + (size_t)tok * DM;
#pragma unroll
    for (int i = 0; i < 4; ++i) {
      const int c = lane * 4 + i * 256;
      const float4 g = *(const float4*)(p.final_g() + c);
      *(float4*)(o + c) = make_float4(v[4 * i] * rs * g.x, v[4 * i + 1] * rs * g.y, v[4 * i + 2] * rs * g.z, v[4 * i + 3] * rs * g.w);
    }
  }
}

#define XB_TMO      128
#define XB_XCNT(j)  (256  + 64 * (j))
#define XB_XSUB(j)  (1280 + 64 * (j))
#define XB_XGEN(j)  (2304 + 64 * (j))
#define XB_TOP      3328
#define XB_TOPGEN   3392
#define XCD_BAR_WORDS 3456
#define XB_SPIN_CAP (1u << 18)
#define LAS __attribute__((address_space(3)))

__device__ __forceinline__ unsigned xb_ld(unsigned* p)              { return __hip_atomic_load(p, __ATOMIC_RELAXED, __HIP_MEMORY_SCOPE_AGENT); }
__device__ __forceinline__ unsigned xb_add(unsigned* p, unsigned v) { return __hip_atomic_fetch_add(p, v, __ATOMIC_RELAXED, __HIP_MEMORY_SCOPE_AGENT); }
__device__ __forceinline__ unsigned xb_xcc_id() { return (unsigned)__builtin_amdgcn_s_getreg((3 << 11) | 20) & 0xFu; }
#define XB_SPIN(cond, bar) do { unsigned _sp = 0; while (cond) { __builtin_amdgcn_s_sleep(1); \
    if ((++_sp & 255u) == 0u) { if (xb_ld(&(bar)[XB_TMO])) break; if (_sp > XB_SPIN_CAP) { atomicAdd(&(bar)[XB_TMO], 1u); break; } } } } while (0)

struct XcdBarrier {
    unsigned* bar; unsigned x;
    volatile LAS unsigned* st;
};

__device__ __forceinline__ XcdBarrier xcd_barrier_post(unsigned* bar, volatile LAS unsigned* st) {
    XcdBarrier b; b.bar = bar; b.x = xb_xcc_id(); b.st = st;
    if (threadIdx.x == 0) (void)xb_add(&bar[XB_XCNT(b.x)], 1u);
    return b;
}
__device__ __forceinline__ void xcd_barrier_complete(unsigned* bar, unsigned x, unsigned& nloc, unsigned& nx) {
    const unsigned G = gridDim.x * gridDim.y * gridDim.z;
    unsigned sum, cnt, mine, sp = 0u;
    for (;;) {
        sum = 0u; cnt = 0u; mine = 0u;
#pragma unroll
        for (unsigned j = 0; j < 16; ++j) { const unsigned c = xb_ld(&bar[XB_XCNT(j)]); sum += c; cnt += (c > 0u) ? 1u : 0u; mine = (j == x) ? c : mine; }
        if (sum == G) break;
        __builtin_amdgcn_s_sleep(1);
        if ((++sp & 255u) == 0u) { if (xb_ld(&bar[XB_TMO])) break; if (sp > XB_SPIN_CAP) { atomicAdd(&bar[XB_TMO], 1u); break; } }
    }
    nloc = mine > 0u ? mine : 1u; nx = cnt > 0u ? cnt : 1u;
}

__device__ __forceinline__ void xcd_barrier(const XcdBarrier& b) {
    asm volatile("s_waitcnt vmcnt(0)" ::: "memory");
    __syncthreads();
    if (threadIdx.x == 0) {
        unsigned* bar = b.bar;
        __builtin_amdgcn_s_waitcnt(0);
        unsigned nloc = b.st[0], nx = b.st[1];
        if (nloc == 0u) { xcd_barrier_complete(bar, b.x, nloc, nx); b.st[0] = nloc; b.st[1] = nx; }
        const unsigned old = xb_add(&bar[XB_XSUB(b.x)], 1u);
        const unsigned gen = old / nloc;
        if (old + 1u == (gen + 1u) * nloc) {
            __builtin_amdgcn_fence(__ATOMIC_RELEASE, "agent");
            asm volatile("s_waitcnt vmcnt(0)" ::: "memory");
            const unsigned og = xb_add(&bar[XB_TOP], 1u);
            const unsigned tg = og / nx;
            if (og + 1u == (tg + 1u) * nx) xb_add(&bar[XB_TOPGEN], 1u);
            else XB_SPIN(xb_ld(&bar[XB_TOPGEN]) == tg, bar);
            __builtin_amdgcn_fence(__ATOMIC_ACQUIRE, "agent");
            xb_add(&bar[XB_XGEN(b.x)], 1u);
            asm volatile("s_waitcnt vmcnt(0)" ::: "memory");
        } else {
            XB_SPIN(xb_ld(&bar[XB_XGEN(b.x)]) == gen, bar);
            __builtin_amdgcn_fence(__ATOMIC_ACQUIRE, "agent");
            asm volatile("s_waitcnt vmcnt(0)" ::: "memory");
        }
    }
    __syncthreads();
}

constexpr int LDS_MAIN = 147456;
constexpr int LDS_BYTES = LDS_MAIN + 1024;
enum { PH_TABLES = 0, PH_MOD, PH_FOLD, PH_CONVERT, PH_HYMLP, PH_HYFILT, PH_NORM1, PH_GEMM_IN, PH_QKV, PH_ATTN, PH_FFTMIX,
       PH_GLA_A, PH_GLA_B, PH_GLA_C, PH_MIX, PH_GEMM_OUT, PH_NORM2, PH_MOE_GU, PH_MOE_DN, PH_FINAL };

__device__ __forceinline__ Params make_params() {
  const __attribute__((address_space(4))) char* kb = (const __attribute__((address_space(4))) char*)__builtin_amdgcn_kernarg_segment_ptr();
  asm volatile("" : "+s"(kb));
  Params p; p.kb = kb; return p;
}
#ifndef MK_LAUNCHES
#define MK_LAUNCHES 1
#endif
__global__ void __launch_bounds__(NTHR, 2) k_mega(ParamsData pd) {
  extern __shared__ __attribute__((aligned(1024))) char lds[];
  const int bid = blockIdx.x, nb = gridDim.x;
  if (threadIdx.x == 0) *(uint4*)(lds + LDS_MAIN) = make_uint4(0u, 0u, 0u, 0u);
  __syncthreads();
  XcdBarrier bar = xcd_barrier_post(make_params().bar(), (volatile LAS unsigned*)(lds + LDS_MAIN));
#ifndef DBLMASK
#define DBLMASK 0u
#endif
#define RUNPH(bit, call) do { call; if (DBLMASK & (1u << (bit))) { __syncthreads(); call; } } while (0)
  RUNPH(13, phase_tables(make_params(), bid, nb); phase_mod(make_params(), bid, nb, lds); phase_fold(make_params(), bid, nb, lds));
  RUNPH(0, phase_convert(make_params(), bid, nb, lds));
  phase_hy_mlp(make_params(), 0, SEQ, make_params().hfb(), make_params().hpart(), bid, nb, lds);
  phase_hy_mlp(make_params(), 1, SEQ, make_params().hfb() + (size_t)2 * 256 * SEQ, make_params().hpart() + 256 * 512, bid, nb, lds);
  phase_hy_mlp(make_params(), 0, LC, make_params().hfc(), make_params().hpart() + 2 * 256 * 512, bid, nb, lds);
  xcd_barrier(bar);
  RUNPH(2, phase_hy_filtfft(make_params(), bid, nb, lds));
  phase_quant_in(make_params(), bid, nb);
#define MK_LAYER(l) do { \
  phase_norm1(make_params(), l, bid, nb, lds); if ((DBLMASK & (1u << 14)) && l == 0) { __syncthreads(); phase_norm1(make_params(), l, bid, nb, lds); } \
  xcd_barrier(bar); \
  RUNPH(3, phase_gemm_in(make_params(), l, bid, nb, lds)); \
  xcd_barrier(bar); \
  RUNPH(4, phase_qkv(make_params(), l, bid, nb, lds)); \
  RUNPH(5, phase_gla_a(make_params(), l, bid, nb, lds)); \
  xcd_barrier(bar); \
  RUNPH(6, phase_attn(make_params(), l, bid, nb, lds)); \
  RUNPH(7, phase_fftmix(make_params(), l, bid, nb, lds)); \
  RUNPH(9, phase_gla_c(make_params(), l, bid, nb, lds)); \
  xcd_barrier(bar); \
  RUNPH(10, phase_mix(make_params(), l, bid, nb, lds)); \
  xcd_barrier(bar); \
  phase_gemm_out(make_params(), l, bid, nb, lds); if ((DBLMASK & (1u << 16)) && l == 0) { __syncthreads(); phase_gemm_out(make_params(), l, bid, nb, lds); } \
  xcd_barrier(bar); \
  phase_norm2_router(make_params(), l, bid, nb, lds); \
  xcd_barrier(bar); \
  RUNPH(11, phase_moe_gu(make_params(), l, bid, nb, lds)); \
  xcd_barrier(bar); \
  RUNPH(12, phase_moe_dn(make_params(), l, bid, nb, lds)); \
  xcd_barrier(bar); \
  } while (0)
  MK_LAYER(0);
  MK_LAYER(1);
#undef MK_LAYER
  RUNPH(15, phase_final(make_params(), bid, nb, lds));
}
static size_t carve(char*& cur, size_t bytes) { char* r = cur; cur += (bytes + 1023) & ~(size_t)1023; return (size_t)(uintptr_t)r; }
#define CARVE(T, field, n) p.field = (T*)carve(cur, (size_t)(n) * sizeof(T))

extern "C" void kernel_launch(void* const* d_in, const int* in_sizes, int n_in, void* d_out, int out_size, void* d_ws, size_t ws_size, hipStream_t stream) {
  ParamsData p; memset(&p, 0, sizeof(p));
  const float** ins = (const float**)&p;
  for (int i = 0; i < 34; ++i) ins[i] = (const float*)d_in[i];
  p.out_ = (float*)d_out;
  p.ws_ = (char*)d_ws;
  if (WS_TOTAL > ws_size) { fprintf(stderr, "workspace too small: need %zu have %zu\n", (size_t)WS_TOTAL, ws_size); return; }
  hipMemsetAsync((char*)d_ws + OFF_bar, 0, OFF_mod - OFF_bar, stream);
  static int grid = 0;
  if (!grid) {
    int dev = 0, cus = 0, per_cu = 0;
    hipGetDevice(&dev);
    hipDeviceGetAttribute(&cus, hipDeviceAttributeMultiprocessorCount, dev);
    hipFuncSetAttribute((const void*)k_mega, hipFuncAttributeMaxDynamicSharedMemorySize, LDS_BYTES);
    hipOccupancyMaxActiveBlocksPerMultiprocessor(&per_cu, (const void*)k_mega, NTHR, LDS_BYTES);
    grid = cus * (per_cu < 1 ? per_cu : 1);
    if (grid != 256) fprintf(stderr, "unexpected grid %d (cus %d per_cu %d)\n", grid, cus, per_cu);
  }
  hipLaunchKernelGGL(k_mega, dim3(grid), dim3(NTHR), LDS_BYTES, stream, p);
}
```

```cpp
#include <hip/hip_runtime.h>
#include <hip/hip_bf16.h>
#include <cstdio>
#include <cstdint>
#include <cstring>
#include <cstddef>
#include <type_traits>

typedef unsigned short u16;
using bf16x8 = __attribute__((ext_vector_type(8))) short;
using s16x4  = __attribute__((ext_vector_type(4))) short;
using f32x4  = __attribute__((ext_vector_type(4))) float;
using f32x16 = __attribute__((ext_vector_type(16))) float;
using u32x4  = __attribute__((ext_vector_type(4))) unsigned;
using u32x2  = __attribute__((ext_vector_type(2))) unsigned;

constexpr int DM = 1024, NB = 2, SEQ = 16384, LC = 256;
constexpr int TL = NB * SEQ;
constexpr int TC = NB * LC;
constexpr int TT = TL + TC;
constexpr int NIN = 2816;
constexpr int DIN0 = 2240;
constexpr int NE = 32, TOPK = 4, DFF = 1024;
constexpr int SKV = SEQ + LC;
constexpr int NTHR = 512;
constexpr float EPS = 1e-6f;
constexpr float A_SCALE = 0.10206207261596575f;
constexpr float A_QSCALE = A_SCALE * 1.4426950408889634f;
constexpr int ZG_W = 1152, ZG_GQ = 0, ZG_GK = 128, ZG_KR = 256, ZG_GV = 384, ZG_GP = 640, ZG_OG = 896;
constexpr int ZT_HY = 0, ZT_FR = 768, ZT_FI = 1024, ZT_R = 1280;
constexpr int NCH = 260;
constexpr int FM = 16384;
constexpr int HSP = FM / 2 + 1;

constexpr size_t ws_al(size_t b) { return (b + 1023) & ~(size_t)1023; }
constexpr size_t OFF_bar = 0;
constexpr size_t OFF_cnt = OFF_bar + ws_al((size_t)(4096) * sizeof(unsigned));
constexpr size_t OFF_hssq = OFF_cnt + ws_al((size_t)(64) * sizeof(int));
constexpr size_t OFF_kmx = OFF_hssq + ws_al((size_t)(768) * sizeof(float));
constexpr size_t OFF_mod = OFF_kmx + ws_al((size_t)(128) * sizeof(unsigned));
constexpr size_t OFF_ropec = OFF_mod + ws_al((size_t)(2 * 3 * 6144) * sizeof(float));
constexpr size_t OFF_ropes = OFF_ropec + ws_al((size_t)(SEQ * 16) * sizeof(float));
constexpr size_t OFF_tw = OFF_ropes + ws_al((size_t)(SEQ * 16) * sizeof(float));
constexpr size_t OFF_bt_in = OFF_tw + ws_al((size_t)(FM) * sizeof(float2));
constexpr size_t OFF_bt_qkv = OFF_bt_in + ws_al((size_t)((size_t)2 * NIN * DM) * sizeof(u16));
constexpr size_t OFF_bt_out = OFF_bt_qkv + ws_al((size_t)(2 * 1024 * 384) * sizeof(u16));
constexpr size_t OFF_bt_gu = OFF_bt_out + ws_al((size_t)((size_t)2 * DM * DM) * sizeof(u16));
constexpr size_t OFF_bt_dn = OFF_bt_gu + ws_al((size_t)((size_t)2 * NE * 2048 * DM) * sizeof(u16));
constexpr size_t OFF_hfb = OFF_bt_dn + ws_al((size_t)((size_t)2 * NE * DM * DFF) * sizeof(u16));
constexpr size_t OFF_hfc = OFF_hfb + ws_al((size_t)((size_t)2 * 2 * 256 * SEQ) * sizeof(float));
constexpr size_t OFF_hspec = OFF_hfc + ws_al((size_t)(2 * 256 * LC) * sizeof(float));
constexpr size_t OFF_H = OFF_hspec + ws_al((size_t)((size_t)2 * 256 * HSP) * sizeof(float4));
constexpr size_t OFF_zqkv = OFF_H + ws_al((size_t)((size_t)TT * DM) * sizeof(u16));
constexpr size_t OFF_zg = OFF_zqkv + ws_al((size_t)((size_t)TT * 384) * sizeof(u16));
constexpr size_t OFF_zt = OFF_zg + ws_al((size_t)((size_t)TT * ZG_W) * sizeof(float));
constexpr size_t OFF_Q = OFF_zt + ws_al((size_t)((size_t)ZT_R * TT) * sizeof(float));
constexpr size_t OFF_KV = OFF_Q + ws_al((size_t)((size_t)2 * 4 * SKV * 96) * sizeof(u16));
constexpr size_t OFF_ymix = OFF_KV + ws_al((size_t)((size_t)2 * 4 * SKV * 160) * sizeof(u16));
constexpr size_t OFF_hyo = OFF_ymix + ws_al((size_t)((size_t)TT * DM) * sizeof(u16));
constexpr size_t OFF_fno = OFF_hyo + ws_al((size_t)((size_t)256 * TT) * sizeof(float));
constexpr size_t OFF_glao = OFF_fno + ws_al((size_t)((size_t)256 * TT) * sizeof(float));
constexpr size_t OFF_gds = OFF_glao + ws_al((size_t)((size_t)TT * 256) * sizeof(float));
constexpr size_t OFF_gdv = OFF_gds + ws_al((size_t)((size_t)16 * NCH * 2048) * sizeof(float));
constexpr size_t OFF_gst = OFF_gdv + ws_al((size_t)((size_t)16 * NCH * 32) * sizeof(float));
constexpr size_t OFF_X = OFF_gst + ws_al((size_t)((size_t)16 * NCH * 2048) * sizeof(float));
constexpr size_t OFF_rtok = OFF_X + ws_al((size_t)((size_t)TT * DM) * sizeof(float));
constexpr size_t OFF_rw = OFF_rtok + ws_al((size_t)((size_t)NE * TT) * sizeof(int));
constexpr size_t OFF_tslot = OFF_rw + ws_al((size_t)((size_t)NE * TT) * sizeof(float));
constexpr size_t OFF_act = OFF_tslot + ws_al((size_t)((size_t)TT * 4) * sizeof(int));
constexpr size_t OFF_yd = OFF_act + ws_al((size_t)((size_t)TT * 4 * DFF) * sizeof(u16));
constexpr size_t OFF_swin = OFF_yd + ws_al((size_t)((size_t)TT * 4 * DM) * sizeof(u16));
constexpr size_t OFF_swgu = OFF_swin + ws_al((size_t)(2 * NIN) * sizeof(float));
constexpr size_t OFF_hs = OFF_swgu + ws_al((size_t)(2 * NE * 2048) * sizeof(float));
constexpr size_t OFF_hpart = OFF_hs + ws_al((size_t)(TT) * sizeof(float));
constexpr size_t OFF_rsc = OFF_hpart + ws_al((size_t)(3 * 256 * 512) * sizeof(float));
constexpr size_t WS_TOTAL = OFF_rsc + ws_al((size_t)((size_t)NE * TT) * sizeof(float));
struct ParamsData {
  const float *x_, *c_, *ctx_, *c_ctx_, *ada_w_, *ada_b_, *norm1_g_, *norm2_g_, *w_in_, *mla_q_g_, *mla_w_uq_, *mla_kv_g_, *mla_w_ukv_, *hy_conv_w_, *hy_conv_b_, *hy_w1_, *hy_b1_, *hy_w2_, *hy_b2_, *hy_w3_, *hy_freq_, *hy_bias_, *gla_gk_w_, *gla_gk_b_, *fnet_w_, *mix_g_, *w_out_, *router_w_, *router_b_, *moe_w_gu_, *moe_b_gu_, *moe_w_down_, *moe_b_down_, *final_g_;
  float* out_;
  char* ws_;
};
struct Params {
  const __attribute__((address_space(4))) char* kb;
  template <class T> __device__ __forceinline__ T karg(size_t off) const { return *(const __attribute__((address_space(4))) T*)(kb + off); }
  __device__ __forceinline__ const float* x() const { return karg<const float*>(offsetof(ParamsData, x_)); }
  __device__ __forceinline__ const float* c() const { return karg<const float*>(offsetof(ParamsData, c_)); }
  __device__ __forceinline__ const float* ctx() const { return karg<const float*>(offsetof(ParamsData, ctx_)); }
  __device__ __forceinline__ const float* c_ctx() const { return karg<const float*>(offsetof(ParamsData, c_ctx_)); }
  __device__ __forceinline__ const float* ada_w() const { return karg<const float*>(offsetof(ParamsData, ada_w_)); }
  __device__ __forceinline__ const float* ada_b() const { return karg<const float*>(offsetof(ParamsData, ada_b_)); }
  __device__ __forceinline__ const float* norm1_g() const { return karg<const float*>(offsetof(ParamsData, norm1_g_)); }
  __device__ __forceinline__ const float* norm2_g() const { return karg<const float*>(offsetof(ParamsData, norm2_g_)); }
  __device__ __forceinline__ const float* w_in() const { return karg<const float*>(offsetof(ParamsData, w_in_)); }
  __device__ __forceinline__ const float* mla_q_g() const { return karg<const float*>(offsetof(ParamsData, mla_q_g_)); }
  __device__ __forceinline__ const float* mla_w_uq() const { return karg<const float*>(offsetof(ParamsData, mla_w_uq_)); }
  __device__ __forceinline__ const float* mla_kv_g() const { return karg<const float*>(offsetof(ParamsData, mla_kv_g_)); }
  __device__ __forceinline__ const float* mla_w_ukv() const { return karg<const float*>(offsetof(ParamsData, mla_w_ukv_)); }
  __device__ __forceinline__ const float* hy_conv_w() const { return karg<const float*>(offsetof(ParamsData, hy_conv_w_)); }
  __device__ __forceinline__ const float* hy_conv_b() const { return karg<const float*>(offsetof(ParamsData, hy_conv_b_)); }
  __device__ __forceinline__ const float* hy_w1() const { return karg<const float*>(offsetof(ParamsData, hy_w1_)); }
  __device__ __forceinline__ const float* hy_b1() const { return karg<const float*>(offsetof(ParamsData, hy_b1_)); }
  __device__ __forceinline__ const float* hy_w2() const { return karg<const float*>(offsetof(ParamsData, hy_w2_)); }
  __device__ __forceinline__ const float* hy_b2() const { return karg<const float*>(offsetof(ParamsData, hy_b2_)); }
  __device__ __forceinline__ const float* hy_w3() const { return karg<const float*>(offsetof(ParamsData, hy_w3_)); }
  __device__ __forceinline__ const float* hy_freq() const { return karg<const float*>(offsetof(ParamsData, hy_freq_)); }
  __device__ __forceinline__ const float* hy_bias() const { return karg<const float*>(offsetof(ParamsData, hy_bias_)); }
  __device__ __forceinline__ const float* gla_gk_w() const { return karg<const float*>(offsetof(ParamsData, gla_gk_w_)); }
  __device__ __forceinline__ const float* gla_gk_b() const { return karg<const float*>(offsetof(ParamsData, gla_gk_b_)); }
  __device__ __forceinline__ const float* fnet_w() const { return karg<const float*>(offsetof(ParamsData, fnet_w_)); }
  __device__ __forceinline__ const float* mix_g() const { return karg<const float*>(offsetof(ParamsData, mix_g_)); }
  __device__ __forceinline__ const float* w_out() const { return karg<const float*>(offsetof(ParamsData, w_out_)); }
  __device__ __forceinline__ const float* router_w() const { return karg<const float*>(offsetof(ParamsData, router_w_)); }
  __device__ __forceinline__ const float* router_b() const { return karg<const float*>(offsetof(ParamsData, router_b_)); }
  __device__ __forceinline__ const float* moe_w_gu() const { return karg<const float*>(offsetof(ParamsData, moe_w_gu_)); }
  __device__ __forceinline__ const float* moe_b_gu() const { return karg<const float*>(offsetof(ParamsData, moe_b_gu_)); }
  __device__ __forceinline__ const float* moe_w_down() const { return karg<const float*>(offsetof(ParamsData, moe_w_down_)); }
  __device__ __forceinline__ const float* moe_b_down() const { return karg<const float*>(offsetof(ParamsData, moe_b_down_)); }
  __device__ __forceinline__ const float* final_g() const { return karg<const float*>(offsetof(ParamsData, final_g_)); }
  __device__ __forceinline__ float* out() const { return karg<float*>(offsetof(ParamsData, out_)); }
  __device__ __forceinline__ char* ws() const { return karg<char*>(offsetof(ParamsData, ws_)); }
  __device__ __forceinline__ unsigned* bar() const { return (unsigned*)(ws() + OFF_bar); }
  __device__ __forceinline__ int* cnt() const { return (int*)(ws() + OFF_cnt); }
  __device__ __forceinline__ float* hssq() const { return (float*)(ws() + OFF_hssq); }
  __device__ __forceinline__ unsigned* kmx() const { return (unsigned*)(ws() + OFF_kmx); }
  __device__ __forceinline__ float* mod() const { return (float*)(ws() + OFF_mod); }
  __device__ __forceinline__ float* ropec() const { return (float*)(ws() + OFF_ropec); }
  __device__ __forceinline__ float* ropes() const { return (float*)(ws() + OFF_ropes); }
  __device__ __forceinline__ float2* tw() const { return (float2*)(ws() + OFF_tw); }
  __device__ __forceinline__ signed char* bt_in() const { return (signed char*)(ws() + OFF_bt_in); }
  __device__ __forceinline__ u16* bt_qkv() const { return (u16*)(ws() + OFF_bt_qkv); }
  __device__ __forceinline__ u16* bt_out() const { return (u16*)(ws() + OFF_bt_out); }
  __device__ __forceinline__ signed char* bt_gu() const { return (signed char*)(ws() + OFF_bt_gu); }
  __device__ __forceinline__ u16* bt_dn() const { return (u16*)(ws() + OFF_bt_dn); }
  __device__ __forceinline__ float* hfb() const { return (float*)(ws() + OFF_hfb); }
  __device__ __forceinline__ float* hfc() const { return (float*)(ws() + OFF_hfc); }
  __device__ __forceinline__ float4* hspec() const { return (float4*)(ws() + OFF_hspec); }
  __device__ __forceinline__ signed char* H() const { return (signed char*)(ws() + OFF_H); }
  __device__ __forceinline__ float* hs() const { return (float*)(ws() + OFF_hs); }
  __device__ __forceinline__ float* rsc() const { return (float*)(ws() + OFF_rsc); }
  __device__ __forceinline__ float* hpart() const { return (float*)(ws() + OFF_hpart); }
  __device__ __forceinline__ float* swin() const { return (float*)(ws() + OFF_swin); }
  __device__ __forceinline__ float* swgu() const { return (float*)(ws() + OFF_swgu); }
  __device__ __forceinline__ float* btf() const { return (float*)(ws() + OFF_act); }
  __device__ __forceinline__ u16* zqkv() const { return (u16*)(ws() + OFF_zqkv); }
  __device__ __forceinline__ u16* zg() const { return (u16*)(ws() + OFF_zg); }
  __device__ __forceinline__ u16* zt() const { return (u16*)(ws() + OFF_zt); }
  __device__ __forceinline__ u16* Q() const { return (u16*)(ws() + OFF_Q); }
  __device__ __forceinline__ u16* KV() const { return (u16*)(ws() + OFF_KV); }
  __device__ __forceinline__ u16* ymix() const { return (u16*)(ws() + OFF_ymix); }
  __device__ __forceinline__ u16* hyo() const { return (u16*)(ws() + OFF_hyo); }
  __device__ __forceinline__ u16* fno() const { return (u16*)(ws() + OFF_fno); }
  __device__ __forceinline__ u16* glao() const { return (u16*)(ws() + OFF_glao); }
  __device__ __forceinline__ float* gds() const { return (float*)(ws() + OFF_gds); }
  __device__ __forceinline__ float* gdv() const { return (float*)(ws() + OFF_gdv); }
  __device__ __forceinline__ float* gst() const { return (float*)(ws() + OFF_gst); }
  __device__ __forceinline__ u16* X() const { return (u16*)(ws() + OFF_X); }
  __device__ __forceinline__ int* rtok() const { return (int*)(ws() + OFF_rtok); }
  __device__ __forceinline__ float* rw() const { return (float*)(ws() + OFF_rw); }
  __device__ __forceinline__ int* tslot() const { return (int*)(ws() + OFF_tslot); }
  __device__ __forceinline__ u16* act() const { return (u16*)(ws() + OFF_act); }
  __device__ __forceinline__ u16* yd() const { return (u16*)(ws() + OFF_yd); }
};


__device__ __forceinline__ u16 f2bf(float f) {
  unsigned u = __float_as_uint(f); u += 0x7FFFu + ((u >> 16) & 1u); return (u16)(u >> 16);
}
__device__ __forceinline__ float bf2f(u16 h) { return __uint_as_float(((unsigned)h) << 16); }
__device__ __forceinline__ unsigned cvtpk(float lo, float hi) {
  unsigned r; asm volatile("v_cvt_pk_bf16_f32 %0, %1, %2" : "=v"(r) : "v"(lo), "v"(hi)); return r;
}
__device__ __forceinline__ float4 ld4bf(const u16* p) { const u32x2 w = *(const u32x2*)p; return make_float4(__uint_as_float(w[0] << 16), __uint_as_float(w[0] & 0xFFFF0000u), __uint_as_float(w[1] << 16), __uint_as_float(w[1] & 0xFFFF0000u)); }
__device__ __forceinline__ float wave_sum(float v) {
#pragma unroll
  for (int o = 32; o > 0; o >>= 1) v += __shfl_xor(v, o, 64);
  return v;
}
__device__ __forceinline__ int ltid() { int t = threadIdx.x; asm volatile("" : "+v"(t)); return t; }
__device__ __forceinline__ float silu_f(float x) { return x / (1.f + __expf(-x)); }
__device__ __forceinline__ float2 cmul(float2 a, float2 b) { return make_float2(a.x * b.x - a.y * b.y, a.x * b.y + a.y * b.x); }
__device__ __forceinline__ float2 cmulc(float2 a, float2 b) { return make_float2(a.x * b.x + a.y * b.y, a.y * b.x - a.x * b.y); }
__device__ __forceinline__ int modv(int tok) { return tok < TL ? (tok >> 14) : 2; }
__device__ __forceinline__ void phase_tables(const Params& p, int bid, int nb) {
  const int gt = bid * NTHR + ltid(), gs = nb * NTHR;
  for (int i = gt; i < SEQ * 16; i += gs) {
    const int t = i >> 4, f = i & 15;
    const float pos = (f < 8) ? (float)(t >> 6) : (float)(t & 63);
    const float inv = powf(10000.f, -(float)(f & 7) / 8.f);
    float s, c; sincosf(pos * inv, &s, &c);
    p.ropec()[i] = c; p.ropes()[i] = s;
  }
  for (int i = gt; i < FM; i += gs) {
    float s, c; sincospif((float)i / 8192.f, &s, &c);
    p.tw()[i] = make_float2(c, -s);
  }
}

__device__ __forceinline__ void phase_mod(const Params& p, int bid, int nb, char* lds) {
  float* red = (float*)lds;
  const int tid = ltid(), part = tid >> 6, cl = tid & 63;
  for (int it = bid; it < 2 * 96; it += nb) {
    const int l = it / 96, n = (it % 96) * 64 + cl;
    const float* W = p.ada_w() + (size_t)l * DM * 6144;
    float a0 = 0, a1 = 0, a2 = 0;
    for (int k = part * 128; k < part * 128 + 128; ++k) {
      const float w = W[(size_t)k * 6144 + n];
      a0 += silu_f(p.c()[k]) * w; a1 += silu_f(p.c()[DM + k]) * w; a2 += silu_f(p.c_ctx()[k]) * w;
    }
    red[(part * 3 + 0) * 64 + cl] = a0; red[(part * 3 + 1) * 64 + cl] = a1; red[(part * 3 + 2) * 64 + cl] = a2;
    __syncthreads();
    if (tid < 192) {
      const int v = tid >> 6; float s = 0;
      for (int q = 0; q < 8; ++q) s += red[(q * 3 + v) * 64 + cl];
      p.mod()[((size_t)l * 3 + v) * 6144 + n] = s + p.ada_b()[(size_t)l * 6144 + n];
    }
    __syncthreads();
  }
}

__device__ __forceinline__ void phase_fold(const Params& p, int bid, int nb, char* lds) {
  float* wrow = (float*)lds;
  float* dre = wrow + 256;
  float* dim_ = dre + 256;
  float* glr = dim_ + 256;
  float* cst = glr + 32;
  float* snt = cst + 256;
  const int tid = ltid();
  if (tid < 256) { float s, c; sincospif((float)tid / 128.f, &s, &c); cst[tid] = c; snt[tid] = s; }
  __syncthreads();
  for (int it = bid; it < 2 * DM; it += nb) {
    const int l = it >> 10, k = it & 1023;
    const float* wr = p.w_in() + ((size_t)l * DM + k) * DIN0;
    if (tid < 256) wrow[tid] = wr[1984 + tid];
    if (tid >= 256 && tid < 288) glr[tid - 256] = wr[1696 + tid - 256];
    __syncthreads();
    {
      const int kp = tid & 255; const bool im = tid >= 256;
      float s = 0;
      for (int c = 0; c < 256; ++c) { const int m = (c * kp) & 255; s += wrow[c] * (im ? -snt[m] : cst[m]); }
      if (im) dim_[kp] = s; else dre[kp] = s;
    }
    __syncthreads();
    {
      const int j = tid & 255; const bool im = tid >= 256;
      const float* Wf = p.fnet_w() + (size_t)l * 65536;
      const float* d = im ? dim_ : dre;
      float s = 0;
      for (int kp = 0; kp < 256; ++kp) s += d[kp] * Wf[kp * 256 + j];
      p.btf()[((size_t)l * NIN + (im ? 2560 : 2304) + j) * DM + k] = s * 0.0625f;
    }
    if (tid < 256) {
      const int dir = tid >> 7, kk = tid & 127;
      const float* gw = p.gla_gk_w() + ((size_t)l * 2 + dir) * 16 * 128;
      float s = 0;
      for (int r = 0; r < 16; ++r) s += glr[dir * 16 + r] * gw[r * 128 + kk];
      p.btf()[((size_t)l * NIN + 1024 + tid) * DM + k] = s;
    }
    __syncthreads();
  }
}

enum { MAP_ID = 0, MAP_IN = 1, MAP_UQ = 2, MAP_UKV = 3, MAP_GU = 4 };
__device__ __forceinline__ int colmap(int mt, int n) {
  switch (mt) {
    case MAP_ID: return n;
    case MAP_IN:
      if (n < 256) return n;
      if (n < 384) return 256 + (n - 256);
      if (n < 512) return 1184 + (n - 384);
      if (n < 640) return 1312 + (n - 512);
      if (n < 672) return 384 + (n - 640);
      if (n < 768) return -1;
      if (n < 1024) return 1440 + (n - 768);
      if (n < 1280) return -2;
      if (n < 1536) return 1728 + (n - 1280);
      if (n < 2304) return 416 + (n - 1536);
      return -2;
    case MAP_UQ:
      if (n < 256) return (n >> 6) * 96 + (n & 63);
      if (n < 384) return ((n - 256) >> 5) * 96 + 64 + ((n - 256) & 31);
      return -1;
    case MAP_UKV:
      if (n < 256) return (n >> 6) * 128 + (n & 63);
      return ((n - 256) >> 6) * 128 + 64 + ((n - 256) & 63);
    default: {
      const int pn = n >> 8, w = n & 255;
      return w < 128 ? 2 * (pn * 128 + w) : 2 * (pn * 128 + w - 128) + 1;
    }
  }
}
__device__ __forceinline__ int invmap(int mt, int sc) {
  if (mt == MAP_ID) return sc;
  if (mt == MAP_GU) { const int j = sc >> 1, t = sc & 1; return (j >> 7) * 256 + t * 128 + (j & 127); }
  if (sc < 384) return sc;
  if (sc < 416) return 640 + (sc - 384);
  if (sc < 1184) return 1536 + (sc - 416);
  if (sc < 1312) return 384 + (sc - 1184);
  if (sc < 1440) return 512 + (sc - 1312);
  if (sc < 1696) return 768 + (sc - 1440);
  if (sc < 1728) return -1;
  if (sc < 1984) return 1280 + (sc - 1728);
  return -1;
}
template <bool F32OUT>
__device__ __forceinline__ void conv_tile(const float* __restrict__ src, int ld, int K, void* __restrict__ dstv, int mt, const float* __restrict__ scale,
                                          int k0, int s0, float* tile  , int tid) {
  {
    const int kk = tid >> 5, s4 = (tid & 31) * 4;
    float4 v[4];
#pragma unroll
    for (int i = 0; i < 4; ++i) {
      v[i] = make_float4(0.f, 0.f, 0.f, 0.f);
      if (s0 + s4 < ld) v[i] = *(const float4*)(src + (size_t)(k0 + kk + 16 * i) * ld + s0 + s4);
    }
#pragma unroll
    for (int i = 0; i < 4; ++i) {
      const float sc = scale ? scale[k0 + kk + 16 * i] : 1.f;
      float* t = tile + (kk + 16 * i) * 129 + s4;
      t[0] = v[i].x * sc; t[1] = v[i].y * sc; t[2] = v[i].z * sc; t[3] = v[i].w * sc;
    }
  }
  __syncthreads();
#pragma unroll
  for (int h = 0; h < 2; ++h) {
    const int sl = (tid >> 3) + 64 * h, ks = (tid & 7) * 8, sc = s0 + sl;
    const int row = sc < ld ? invmap(mt, sc) : -1;
    if (row >= 0) {
      const float* t = tile + ks * 129 + sl;
      if constexpr (F32OUT) {
        float* dst = (float*)dstv + (size_t)row * K + k0 + ks;
        *(float4*)dst = make_float4(t[0], t[129], t[2 * 129], t[3 * 129]); *(float4*)(dst + 4) = make_float4(t[4 * 129], t[5 * 129], t[6 * 129], t[7 * 129]);
      } else {
        u32x4 w;
        w[0] = cvtpk(t[0], t[129]); w[1] = cvtpk(t[2 * 129], t[3 * 129]); w[2] = cvtpk(t[4 * 129], t[5 * 129]); w[3] = cvtpk(t[6 * 129], t[7 * 129]);
        *(u32x4*)((u16*)dstv + (size_t)row * K + k0 + ks) = w;
      }
    }
  }
  __syncthreads();
}
__device__ __forceinline__ void conv_gu8(const float* __restrict__ src  , signed char* __restrict__ dst  , float* __restrict__ sw  ,
                                         int s0, float* tile  , int tid) {
  float* cmax = tile + 1024 * 33;
  {
    const int c4 = (tid & 7) * 4, r0 = tid >> 3;
#pragma unroll 4
    for (int pss = 0; pss < 16; ++pss) {
      const int k = r0 + 64 * pss;
      const float4 v = *(const float4*)(src + (size_t)k * 2048 + s0 + c4);
      float* t = tile + k * 33 + c4; t[0] = v.x; t[1] = v.y; t[2] = v.z; t[3] = v.w;
    }
  }
  __syncthreads();
  {
    const int col = tid & 31, part = tid >> 5; float m = 0.f;
    for (int k = part * 64; k < part * 64 + 64; ++k) m = fmaxf(m, fabsf(tile[k * 33 + col]));
    cmax[part * 32 + col] = m;
  }
  __syncthreads();
  if (tid < 32) {
    float m = 0.f;
#pragma unroll
    for (int q = 0; q < 16; ++q) m = fmaxf(m, cmax[q * 32 + tid]);
    const float sc = fmaxf(m, 1e-20f) * (1.f / 127.f);
    cmax[512 + tid] = sc;
    sw[invmap(MAP_GU, s0 + tid)] = sc;
  }
  __syncthreads();
#pragma unroll
  for (int h = 0; h < 4; ++h) {
    const int g = tid + 512 * h, col = g & 31, k0 = (g >> 5) * 16;
    const float inv = 1.f / cmax[512 + col];
    unsigned w[4];
#pragma unroll
    for (int q = 0; q < 4; ++q) {
      const float* t = tile + (k0 + 4 * q) * 33 + col;
      const int q0 = (int)rintf(t[0] * inv), q1 = (int)rintf(t[33] * inv), q2 = (int)rintf(t[66] * inv), q3 = (int)rintf(t[99] * inv);
      w[q] = (unsigned)(q0 & 255) | ((unsigned)(q1 & 255) << 8) | ((unsigned)(q2 & 255) << 16) | ((unsigned)(q3 & 255) << 24);
    }
    *(u32x4*)(dst + (size_t)invmap(MAP_GU, s0 + col) * DM + k0) = u32x4{w[0], w[1], w[2], w[3]};
  }
  __syncthreads();
}
__device__ __forceinline__ void phase_convert(const Params& p, int bid, int nb, char* lds) {
  float* tile = (float*)lds;
  const int tid = ltid();
  constexpr int T_IN = 16 * 18, T_OUT = 16 * 8, T_GU = NE * 64, T_DN = NE * 128, T_L = T_IN + T_OUT + T_GU + T_DN;
  for (int t = bid; t < 2 * T_L; t += nb) {
    const int l = t / T_L; int r = t % T_L;
    if (r < T_IN) { conv_tile<true>(p.w_in() + (size_t)l * DM * DIN0, DIN0, DM, p.btf() + (size_t)l * NIN * DM, MAP_IN, nullptr, (r / 18) * 64, (r % 18) * 128, tile, tid); continue; }
    r -= T_IN;
    if (r < T_OUT) { conv_tile<false>(p.w_out() + (size_t)l * DM * DM, DM, DM, p.bt_out() + (size_t)l * DM * DM, MAP_ID, p.mix_g() + l * DM, (r / 8) * 64, (r % 8) * 128, tile, tid); continue; }
    r -= T_OUT;
    if (r < T_GU) { conv_gu8(p.moe_w_gu() + ((size_t)l * NE + (r >> 6)) * DM * 2048, p.bt_gu() + ((size_t)l * NE + (r >> 6)) * 2048 * DM, p.swgu() + ((size_t)l * NE + (r >> 6)) * 2048, (r & 63) * 32, tile, tid); continue; }
    r -= T_GU;
    { const int e = r >> 7, q = r & 127;
      conv_tile<false>(p.moe_w_down() + ((size_t)l * NE + e) * DFF * DM, DM, DFF, p.bt_dn() + ((size_t)l * NE + e) * DM * DFF, MAP_ID, nullptr, (q >> 3) * 64, (q & 7) * 128, tile, tid); }
  }
  for (int l = 0; l < 2; ++l) {
    for (int i = bid * NTHR + tid; i < 96 * DM / 4; i += nb * NTHR) *(float4*)(p.btf() + ((size_t)l * NIN + 672) * DM + (size_t)i * 4) = make_float4(0.f, 0.f, 0.f, 0.f);
    {
      const float* wq = p.mla_w_uq() + (size_t)l * 256 * 384; const float* wkv = p.mla_w_ukv() + (size_t)l * 128 * 512;
      const float* gq = p.mla_q_g() + l * 256; const float* gkv = p.mla_kv_g() + l * 128;
      u16* dst = p.bt_qkv() + (size_t)l * 1024 * 384;
      for (int i = bid * NTHR + ltid(); i < 1024 * 384; i += nb * NTHR) {
        const int n = i / 384, k = i % 384; float v = 0.f;
        if (n < 512) { const int sc = colmap(MAP_UQ, n); if (k < 256 && sc >= 0) v = gq[k] * wq[k * 384 + sc]; }
        else { if (k >= 256) v = gkv[k - 256] * wkv[(k - 256) * 512 + colmap(MAP_UKV, n - 512)]; }
        dst[i] = f2bf(v);
      }
    }
  }
}

__device__ __forceinline__ void phase_hy_mlp(const Params& p, int l, int Lf, float* __restrict__ hout  , float* __restrict__ ssq  ,
                             int bid, int nb, char* lds) {
  float* zf = (float*)lds;
  float* h1 = zf + 64 * 33;
  float* h2 = h1 + 64 * 64;
  const int tid = ltid();
  const float* w1 = p.hy_w1() + (size_t)l * 33 * 64; const float* b1 = p.hy_b1() + l * 64;
  const float* w2 = p.hy_w2() + (size_t)l * 64 * 64; const float* b2 = p.hy_b2() + l * 64;
  const float* w3 = p.hy_w3() + (size_t)l * 64 * 512; const float* fr = p.hy_freq() + l * 64;
  float w3c[64];
#pragma unroll
  for (int k = 0; k < 64; ++k) w3c[k] = w3[k * 512 + tid];
  const int dir = tid >> 8, ch = tid & 255;
  const float maxd = logf(1e-2f) / 0.3f, mind = logf(1e-2f) / 1.5f;
  const float delta = fabsf(mind + (maxd - mind) * (float)ch / 255.f);
  float ssq_acc = 0.f;
  for (int it = bid; it < Lf / 64; it += nb) {
    const int t0 = it * 64;
    for (int i = tid; i < 64 * 33; i += NTHR) {
      const int tt = i / 33, f = i % 33, t = t0 + tt;
      float v;
      if (f == 0) v = (float)t / (float)(Lf - 1);
      else {
        const int j = (f - 1) & 15;
        const float fj = 1e-4f + (float)j * ((15.f - 1e-4f) / 15.f);
        const float w = 6.283185307179586f * (float)t / (float)Lf;
        v = (f <= 16) ? cosf(fj * w) : -sinf(fj * w);
      }
      zf[i] = v;
    }
    __syncthreads();
    for (int i = tid; i < 64 * 64; i += NTHR) {
      const int tt = i >> 6, o = i & 63; float s = b1[o];
      for (int f = 0; f < 33; ++f) s += zf[tt * 33 + f] * w1[f * 64 + o];
      h1[i] = sinf(fr[o] * s);
    }
    __syncthreads();
    for (int i = tid; i < 64 * 64; i += NTHR) {
      const int tt = i >> 6, o = i & 63; float s = b2[o];
      for (int f = 0; f < 64; ++f) s += h1[tt * 64 + f] * w2[f * 64 + o];
      h2[i] = sinf(fr[o] * s);
    }
    __syncthreads();
    float* orow = hout + ((size_t)dir * 256 + ch) * Lf + t0;
    for (int tt = 0; tt < 64; ++tt) {
      float s = 0;
#pragma unroll
      for (int k = 0; k < 64; ++k) s += h2[tt * 64 + k] * w3c[k];
      const int t = t0 + tt;
      s *= __expf(-((float)t / (float)(Lf - 1)) * delta);
      orow[tt] = s;
      if (dir == 0 || t > 0) ssq_acc += s * s;
    }
    __syncthreads();
  }
  ssq[(size_t)bid * 512 + tid] = ssq_acc;
}

__host__ __device__ constexpr int fx(int p) {
  return ((p >> 12) & 3) ^ (((p >> 10) & 3) << 2) ^ ((p >> 4) & 16) ^ (((p >> 5) & 1) * 5) ^ (((p >> 6) & 1) * 26);
}
__device__ __forceinline__ int swz(int p) { return p ^ fx(p); }
__device__ __forceinline__ int rev7(int k) {
  unsigned r = __brev((unsigned)k) >> 18;
  return (int)(((r & 0x2AAAu) >> 1) | ((r & 0x1555u) << 1));
}
template <int ST, bool INV>
__device__ __forceinline__ void fft_stage(float2* s, const float2* __restrict__ tw, const int tid) {
  constexpr int sh = 12 - 2 * ST, q = 1 << sh, ND = q >= 512 ? q / 512 : 1;
  float2 w1[ND], w2[ND], w3[ND];
  if constexpr (ST < 6) {
#pragma unroll
    for (int d = 0; d < ND; ++d) {
      const int j = q >= 512 ? tid + 512 * d : (tid & (q - 1)), ti = j << (2 * ST);
      w1[d] = tw[ti]; w2[d] = tw[2 * ti]; w3[d] = tw[3 * ti];
    }
  }
  float2 x[8][4];
#pragma unroll
  for (int m = 0; m < 8; ++m) {
    const int u = tid + 512 * m, g = u >> sh, j = u & (q - 1), base = (g << (sh + 2)) + j, xb = fx(base);
    x[m][0] = s[base ^ xb]; x[m][1] = s[(base + q) ^ xb ^ fx(q)]; x[m][2] = s[(base + 2 * q) ^ xb ^ fx(2 * q)]; x[m][3] = s[(base + 3 * q) ^ xb ^ fx(3 * q)];
  }
#pragma unroll
  for (int m = 0; m < 8; ++m) {
    const int u = tid + 512 * m, g = u >> sh, j = u & (q - 1), base = (g << (sh + 2)) + j, xb = fx(base);
    const int i0 = base ^ xb, i1 = (base + q) ^ xb ^ fx(q), i2 = (base + 2 * q) ^ xb ^ fx(2 * q), i3 = (base + 3 * q) ^ xb ^ fx(3 * q);
    const int d = q >= 512 ? (m % ND) : 0;
    if constexpr (!INV) {
      const float2 a0 = x[m][0], a1 = x[m][1], a2 = x[m][2], a3 = x[m][3];
      const float2 b0 = make_float2(a0.x + a2.x, a0.y + a2.y), b1 = make_float2(a0.x - a2.x, a0.y - a2.y);
      const float2 b2 = make_float2(a1.x + a3.x, a1.y + a3.y), b3 = make_float2(a1.x - a3.x, a1.y - a3.y);
      const float2 y1 = make_float2(b1.x + b3.y, b1.y - b3.x), y2 = make_float2(b0.x - b2.x, b0.y - b2.y), y3 = make_float2(b1.x - b3.y, b1.y + b3.x);
      s[i0] = make_float2(b0.x + b2.x, b0.y + b2.y);
      if constexpr (ST < 6) { s[i1] = cmul(y1, w1[d]); s[i2] = cmul(y2, w2[d]); s[i3] = cmul(y3, w3[d]); }
      else { s[i1] = y1; s[i2] = y2; s[i3] = y3; }
    } else {
      float2 t0 = x[m][0], t1 = x[m][1], t2 = x[m][2], t3 = x[m][3];
      if constexpr (ST < 6) { t1 = cmulc(t1, w1[d]); t2 = cmulc(t2, w2[d]); t3 = cmulc(t3, w3[d]); }
      const float2 b0 = make_float2(t0.x + t2.x, t0.y + t2.y), b1 = make_float2(t0.x - t2.x, t0.y - t2.y);
      const float2 b2 = make_float2(t1.x + t3.x, t1.y + t3.y), b3 = make_float2(t1.x - t3.x, t1.y - t3.y);
      s[i0] = make_float2(b0.x + b2.x, b0.y + b2.y);
      s[i1] = make_float2(b1.x - b3.y, b1.y + b3.x);
      s[i2] = make_float2(b0.x - b2.x, b0.y - b2.y);
      s[i3] = make_float2(b1.x + b3.y, b1.y - b3.x);
    }
  }
  __syncthreads();
}
__device__ __forceinline__ void fft_fwd(float2* s, const float2* __restrict__ tw) {
  const int tid = ltid();
  fft_stage<0, false>(s, tw, tid); fft_stage<1, false>(s, tw, tid); fft_stage<2, false>(s, tw, tid); fft_stage<3, false>(s, tw, tid);
  fft_stage<4, false>(s, tw, tid); fft_stage<5, false>(s, tw, tid); fft_stage<6, false>(s, tw, tid);
}
__device__ __forceinline__ void fft_inv(float2* s, const float2* __restrict__ tw) {
  const int tid = ltid();
  fft_stage<6, true>(s, tw, tid); fft_stage<5, true>(s, tw, tid); fft_stage<4, true>(s, tw, tid); fft_stage<3, true>(s, tw, tid);
  fft_stage<2, true>(s, tw, tid); fft_stage<1, true>(s, tw, tid); fft_stage<0, true>(s, tw, tid);
}

__device__ __forceinline__ float filt_ssq(const float* __restrict__ part  , int ch, float* red  ) {
  const int tid = ltid();
  float v = part[(size_t)(tid >> 1) * 512 + (tid & 1) * 256 + ch];
  v = wave_sum(v);
  __syncthreads();
  if ((tid & 63) == 0) red[tid >> 6] = v;
  __syncthreads();
  return ((red[0] + red[1]) + (red[2] + red[3])) + ((red[4] + red[5]) + (red[6] + red[7]));
}
__device__ __forceinline__ void phase_hy_filtfft(const Params& p, int bid, int nb, char* lds) {
  float2* s = (float2*)lds;
  const int tid = ltid();
  for (int it = bid; it < 512; it += nb) {
    const int l = it >> 8, ch = it & 255;
    const float* hf = p.hfb() + (((size_t)l * 2 + 0) * 256 + ch) * SEQ;
    const float* hb = p.hfb() + (((size_t)l * 2 + 1) * 256 + ch) * SEQ;
#pragma unroll 8
    for (int m = tid; m < FM; m += NTHR) {
      const int n0 = 2 * m, n1 = 2 * m + 1;
      const float a = (n0 < SEQ) ? hf[n0] : (n0 == SEQ ? 0.f : hb[2 * SEQ - n0]);
      const float b = (n1 < SEQ) ? hf[n1] : hb[2 * SEQ - n1];
      s[swz(m)] = make_float2(a, b);
    }
    __syncthreads();
    fft_fwd(s, p.tw());
    const float sc = rsqrtf(filt_ssq(p.hpart() + (size_t)l * 256 * 512, ch, (float*)(lds + 139264))) * (1.f / 16384.f);
    float4* out = p.hspec() + ((size_t)l * 256 + ch) * HSP;
#pragma unroll 4
    for (int k = tid; k <= FM / 2; k += NTHR) {
      const float2 zk = s[swz(rev7(k))], zm = s[swz(rev7((FM - k) & (FM - 1)))];
      const float er = 0.5f * (zk.x + zm.x), ei = 0.5f * (zk.y - zm.y);
      const float dr = 0.5f * (zk.x - zm.x), di = 0.5f * (zk.y + zm.y);
      out[k] = make_float4(er * sc, ei * sc, di * sc, -dr * sc);
    }
    __syncthreads();
  }
}
constexpr int G_TILE_B = 256 * 64 * 2;
constexpr int G_STAGE_B = 2 * G_TILE_B;
constexpr int GEMM_LDS = 2 * G_STAGE_B;

__device__ __forceinline__ int lds_byte2(int r, int c) {
  const int st = (r >> 4) * 2 + (c >> 5), ob = (r & 15) * 64 + (c & 31) * 2;
  return st * 1024 + (ob ^ (((ob >> 9) & 1) << 5));
}
__device__ __forceinline__ void stage_rc2(int b, int& R, int& C) {
  const int st = b >> 10, sb = b & 1023, swz = sb ^ (((sb >> 9) & 1) << 5);
  R = (st >> 1) * 16 + (swz >> 6);
  C = (st & 1) * 32 + ((swz & 63) >> 1);
}
__device__ __forceinline__ void gemm_stage_coords(int (&sR)[4], int (&sC)[4]) {
  const int wid = ltid() >> 6, lane = ltid() & 63;
#pragma unroll
  for (int i = 0; i < 4; ++i) stage_rc2(wid * 1024 + i * 8192 + lane * 16, sR[i], sC[i]);
}

#define WAIT_V0() asm volatile("s_waitcnt vmcnt(0)" ::: "memory")

__device__ __forceinline__ void gemm256_core(const u16* const (&ap)[4], const u16* const (&bp)[4], int nt, char* shm, f32x4 (&acc)[8][4]) {
  const int tid = ltid(), wid = tid >> 6, lane = tid & 63, wr = wid >> 2, wc = wid & 3, fr = lane & 15, fq = lane >> 4;
#pragma unroll
  for (int m = 0; m < 8; ++m)
#pragma unroll
    for (int n = 0; n < 4; ++n) acc[m][n] = f32x4{0.f, 0.f, 0.f, 0.f};
#define G_SA(b) (shm + (b) * G_STAGE_B)
#define G_SB(b) (shm + (b) * G_STAGE_B + G_TILE_B)
#define G_STAGE(buf, kt) do { _Pragma("unroll") for (int i = 0; i < 4; ++i) {                                                   \
    __builtin_amdgcn_global_load_lds((const unsigned*)(ap[i] + (kt) * 64), (unsigned*)(G_SA(buf) + wid * 1024 + i * 8192), 16, 0, 0); \
    __builtin_amdgcn_global_load_lds((const unsigned*)(bp[i] + (kt) * 64), (unsigned*)(G_SB(buf) + wid * 1024 + i * 8192), 16, 0, 0); } } while (0)
  G_STAGE(0, 0); WAIT_V0(); __syncthreads();
#pragma unroll 1
  for (int t = 0; t < nt; ++t) {
    const int cur = t & 1;
    if (t + 1 < nt) G_STAGE(cur ^ 1, t + 1);
#pragma unroll
    for (int ks = 0; ks < 2; ++ks) {
      bf16x8 At[8], Bf[4];
#pragma unroll
      for (int m = 0; m < 8; ++m) At[m] = *(const bf16x8*)(G_SA(cur) + lds_byte2(wr * 128 + m * 16 + fr, ks * 32 + fq * 8));
#pragma unroll
      for (int n = 0; n < 4; ++n) Bf[n] = *(const bf16x8*)(G_SB(cur) + lds_byte2(wc * 64 + n * 16 + fr, ks * 32 + fq * 8));
#pragma unroll
      for (int m = 0; m < 8; ++m)
#pragma unroll
        for (int n = 0; n < 4; ++n) acc[m][n] = __builtin_amdgcn_mfma_f32_16x16x32_bf16(At[m], Bf[n], acc[m][n], 0, 0, 0);
      __builtin_amdgcn_sched_barrier(0);
    }
    WAIT_V0(); __syncthreads();
  }
#undef G_STAGE
}

#define LAS3 __attribute__((address_space(3)))
constexpr int G8_HTB = 128 * 64 * 2;
__device__ __forceinline__ int g8_perm32(int rho) { const int n = rho >> 4, i = rho & 15; return 8 * (i >> 2) + 4 * n + (i & 3); }
__device__ __forceinline__ int g8_lds_byte(int r, int c) { const int st = (r >> 4) * 2 + (c >> 5), rr = r & 15, cc = c & 31, ob = rr * 64 + cc * 2; return st * 1024 + (ob ^ (((ob >> 9) & 1) << 5)); }
__device__ __forceinline__ void g8_stage_rc(int b, int& R, int& C) { const int st = b / 1024, sb = b % 1024, swz = sb ^ (((sb >> 9) & 1) << 5); R = (st >> 1) * 16 + swz / 64; C = (st & 1) * 32 + (swz % 64) / 2; }
struct G8Unit { int pm, pn, e, ce, pre; };
__device__ __forceinline__ void g8_cload(const float* __restrict__ src, float* dst) {
  __builtin_amdgcn_global_load_lds((const unsigned*)(src + (ltid() & 63) * 4), (LAS3 unsigned*)dst, 16, 0, 0);
}


template <bool I8> __device__ __forceinline__ typename std::conditional<I8, int __attribute__((ext_vector_type(4))), f32x4>::type
g8_mma(bf16x8 x, bf16x8 y, typename std::conditional<I8, int __attribute__((ext_vector_type(4))), f32x4>::type c) {
  if constexpr (I8) { typedef int v4i __attribute__((ext_vector_type(4))); return __builtin_amdgcn_mfma_i32_16x16x64_i8(*(v4i*)&x, *(v4i*)&y, c, 0, 0, 0); }
  else return __builtin_amdgcn_mfma_f32_16x16x32_bf16(x, y, c, 0, 0, 0);
}
typedef int i32x4 __attribute__((ext_vector_type(4)));
template <bool I8> struct G8Acc { typedef f32x4 T; };
template <> struct G8Acc<true> { typedef i32x4 T; };
template <bool I8, class Sched, class Epi>
__device__ __forceinline__ void gemm8_phase(char* lds_g, const char* Abase, const int Kb, const Sched& S, const Epi& E) {
    typedef typename G8Acc<I8>::T ACC;
    LAS3 unsigned char* lds = (LAS3 unsigned char*)lds_g;
    const int tid = ltid(), wid = __builtin_amdgcn_readfirstlane(tid >> 6), lane = tid & 63, wr = wid >> 2, wc = wid & 3, fr = lane & 15, fq = lane >> 4;
    const int nt = Kb / 128;
    int sRr[2], sCc[2]; unsigned voffB[2];
#pragma unroll
    for (int i = 0; i < 2; ++i) { g8_stage_rc(tid * 16 + i * 8192, sRr[i], sCc[i]); const int Rb = (sRr[i] & ~31) + g8_perm32(sRr[i] & 31); voffB[i] = (unsigned)(Rb * Kb) + (unsigned)sCc[i] * 2u; }
    const size_t kstep = 128;
    const size_t hstepB = (size_t)128 * Kb;
    const unsigned ldsw = (unsigned)wid * 1024u;
    const int aoff = g8_lds_byte(wr * 64 + fr, fq * 8), boff = g8_lds_byte(wc * 32 + fr, fq * 8);
#define G8_SA(b, h) (((b) * 2 + (h)) * G8_HTB)
#define G8_SB(b, h) ((4 + (b) * 2 + (h)) * G8_HTB)
#define G8_STAGE_B(bufoff, gbase) do { _Pragma("unroll") for (int _i = 0; _i < 2; ++_i) \
        __builtin_amdgcn_global_load_lds((const unsigned*)((const char*)(gbase) + voffB[_i]), (LAS3 unsigned*)(lds + (bufoff) + ldsw + _i * 8192), 16, 0, 0); } while (0)
#define G8_STAGE_A(bufoff, o0, o1) do { \
        __builtin_amdgcn_global_load_lds((const unsigned*)(Abase + (o0)), (LAS3 unsigned*)(lds + (bufoff) + ldsw), 16, 0, 0); \
        __builtin_amdgcn_global_load_lds((const unsigned*)(Abase + (o1)), (LAS3 unsigned*)(lds + (bufoff) + ldsw + 8192), 16, 0, 0); } while (0)
#define G8_LDA(dst, b, h) do { _Pragma("unroll") for (int m = 0; m < 4; ++m) _Pragma("unroll") for (int k = 0; k < 2; ++k) dst[m][k] = *(const LAS3 bf16x8*)(lds + G8_SA(b, h) + aoff + m * 2048 + k * 1024); } while (0)
#define G8_LDB(dst, b, h) do { _Pragma("unroll") for (int n = 0; n < 2; ++n) _Pragma("unroll") for (int k = 0; k < 2; ++k) dst[n][k] = *(const LAS3 bf16x8*)(lds + G8_SB(b, h) + boff + n * 2048 + k * 1024); } while (0)
#define G8_MMA(ai, bj, At, Bt) do { __builtin_amdgcn_s_setprio(1); _Pragma("unroll") for (int m = 0; m < 4; ++m) _Pragma("unroll") for (int n = 0; n < 2; ++n) _Pragma("unroll") for (int k = 0; k < 2; ++k) \
        acc[ai][bj][m][n] = g8_mma<I8>(Bt[n][k], At[m][k], acc[ai][bj][m][n]); __builtin_amdgcn_s_setprio(0); } while (0)
#define G8_WAIT_V(n) asm volatile("s_waitcnt vmcnt(" #n ")" ::: "memory")
#define G8_WAIT_L(n) asm volatile("s_waitcnt lgkmcnt(" #n ")" ::: "memory")
#define G8_BAR __builtin_amdgcn_s_barrier()
#define G8_SCHED __builtin_amdgcn_sched_barrier(0)
    G8Unit cur, nxt; int ui = 0;
    if (!S.next(0, cur)) return;
    ACC acc[2][2][4][2];
#pragma unroll
    for (int a = 0; a < 2; ++a)
#pragma unroll
        for (int b = 0; b < 2; ++b)
#pragma unroll
            for (int m = 0; m < 4; ++m)
#pragma unroll
                for (int n = 0; n < 2; ++n) acc[a][b][m][n] = ACC{};
    bf16x8 At[4][2], B0[2][2], B1[2][2];
    float ep[8];
    unsigned va[2][2], vn[2][2];
#pragma unroll
    for (int h = 0; h < 2; ++h)
#pragma unroll
        for (int i = 0; i < 2; ++i) va[h][i] = S.a_off(cur, h * 128 + sRr[i]) + (unsigned)sCc[i] * 2u;
    const char* cB = S.b_ptr(cur);
    G8_STAGE_B(G8_SB(0, 0), cB); G8_STAGE_A(G8_SA(0, 0), va[0][0], va[0][1]); G8_STAGE_B(G8_SB(0, 1), cB + hstepB); G8_STAGE_A(G8_SA(0, 1), va[1][0], va[1][1]);
    if (wr == 1) G8_BAR;
    G8_WAIT_V(4); G8_BAR;
    G8_STAGE_B(G8_SB(1, 0), cB + kstep); G8_STAGE_A(G8_SA(1, 0), va[0][0] + kstep, va[0][1] + kstep); G8_STAGE_B(G8_SB(1, 1), cB + hstepB + kstep);
    G8_WAIT_V(6); G8_BAR;
    for (;;) {
        float* cb = (float*)(lds_g + 136192 + (ui & 1) * 2048);
        E.pre(cur, wr, fr, ep, cb);
        const bool has_next = S.next(ui + 1, nxt);
        const char* nB = cB;
#pragma unroll
        for (int h = 0; h < 2; ++h)
#pragma unroll
            for (int i = 0; i < 2; ++i) vn[h][i] = va[h][i];
        if (has_next) {
            nB = S.b_ptr(nxt);
#pragma unroll
            for (int h = 0; h < 2; ++h)
#pragma unroll
                for (int i = 0; i < 2; ++i) vn[h][i] = S.a_off(nxt, h * 128 + sRr[i]) + (unsigned)sCc[i] * 2u;
        }
#pragma unroll 1
        for (int t = 0; t < nt; t += 2) {
            const bool last = (t == nt - 2);
            const unsigned k1 = (unsigned)(t + 1) * 128u;
            const unsigned k2 = last ? 0u : (unsigned)(t + 2) * 128u;
            const unsigned a2_00 = (last ? vn[0][0] : va[0][0]) + k2, a2_01 = (last ? vn[0][1] : va[0][1]) + k2;
            const unsigned a2_10 = (last ? vn[1][0] : va[1][0]) + k2, a2_11 = (last ? vn[1][1] : va[1][1]) + k2;
            const char* b2 = (last ? nB : cB) + k2; const char* b3 = b2 + kstep;
            G8_LDB(B0, 0, 0); G8_SCHED; G8_LDA(At, 0, 0); G8_STAGE_A(G8_SA(1, 1), va[1][0] + k1, va[1][1] + k1);
            G8_WAIT_L(8); G8_BAR; G8_WAIT_L(0); G8_MMA(0, 0, At, B0); G8_BAR; G8_SCHED;
            G8_LDB(B1, 0, 1); G8_STAGE_B(G8_SB(0, 0), b2);
            G8_BAR; G8_WAIT_L(0); G8_MMA(0, 1, At, B1); G8_BAR;
            G8_LDA(At, 0, 1); G8_STAGE_A(G8_SA(0, 0), a2_00, a2_01);
            G8_BAR; G8_WAIT_L(0); G8_MMA(1, 0, At, B0); G8_BAR; G8_SCHED;
            G8_STAGE_B(G8_SB(0, 1), b2 + hstepB);
            G8_WAIT_V(6); G8_BAR; G8_MMA(1, 1, At, B1); G8_BAR;
            G8_LDB(B0, 1, 0); G8_SCHED; G8_LDA(At, 1, 0); G8_STAGE_A(G8_SA(0, 1), a2_10, a2_11);
            G8_WAIT_L(8); G8_BAR; G8_WAIT_L(0); G8_MMA(0, 0, At, B0); G8_BAR; G8_SCHED;
            G8_LDB(B1, 1, 1); G8_STAGE_B(G8_SB(1, 0), b3);
            G8_BAR; G8_WAIT_L(0); G8_MMA(0, 1, At, B1); G8_BAR;
            G8_LDA(At, 1, 1); G8_STAGE_A(G8_SA(1, 0), a2_00 + 128u, a2_01 + 128u);
            G8_BAR; G8_WAIT_L(0); G8_MMA(1, 0, At, B0); G8_BAR; G8_SCHED;
            G8_STAGE_B(G8_SB(1, 1), b3 + hstepB);
            G8_WAIT_V(6); G8_BAR; G8_MMA(1, 1, At, B1); G8_BAR;
        }
        E(acc, cur, wr, wc, fr, fq, ep, cb);
        if (!has_next) break;
#pragma unroll
        for (int a = 0; a < 2; ++a)
#pragma unroll
            for (int b = 0; b < 2; ++b)
#pragma unroll
                for (int m = 0; m < 4; ++m)
#pragma unroll
                    for (int n = 0; n < 2; ++n) acc[a][b][m][n] = ACC{};
        cur = nxt; cB = nB; ++ui;
#pragma unroll
        for (int h = 0; h < 2; ++h)
#pragma unroll
            for (int i = 0; i < 2; ++i) va[h][i] = vn[h][i];
    }
    G8_WAIT_V(0);
    if (wr == 0) G8_BAR;
    G8_BAR;
#undef G8_SA
#undef G8_SB
#undef G8_STAGE_A
#undef G8_STAGE_B
#undef G8_LDA
#undef G8_LDB
#undef G8_MMA
#undef G8_WAIT_V
#undef G8_WAIT_L
#undef G8_BAR
#undef G8_SCHED
}
struct G8Plain {
    int nM, nN, Kb, G, c; const char* Bt;
    __device__ __forceinline__ bool next(int i, G8Unit& u) const {
        const int L = (i * 8 + (c & 7)) * (G >> 3) + (c >> 3); if (L >= nM * nN) return false;
        const int nig = 8 * nN, gid = L / nig, fm = gid * 8, gsz = (nM - fm) < 8 ? (nM - fm) : 8;
        u.pm = fm + ((L % nig) % gsz); u.pn = (L % nig) / gsz; u.e = 0; u.ce = 256; u.pre = 0; return true;
    }
    __device__ __forceinline__ unsigned a_off(const G8Unit& u, int row) const { return (unsigned)(u.pm * 256 + row) * (unsigned)Kb; }
    __device__ __forceinline__ const char* b_ptr(const G8Unit& u) const { return Bt + (size_t)u.pn * 256 * Kb; }
};

__device__ __forceinline__ const float* resid_row_in(const Params& p, int tok) {
  return tok < TL ? p.x() + (size_t)tok * DM : p.ctx() + (size_t)(tok - TL) * DM;
}
__device__ __forceinline__ void load_row_comb(const Params& p, int src_layer, int lc, int tok, int lane, const int* pre  , float (&v)[16]) {
  if (src_layer == 0) {
    const float* r = resid_row_in(p, tok);
#pragma unroll
    for (int i = 0; i < 4; ++i) { const float4 a = *(const float4*)(r + lane * 4 + i * 256); v[4 * i] = a.x; v[4 * i + 1] = a.y; v[4 * i + 2] = a.z; v[4 * i + 3] = a.w; }
  } else {
    const u16* r = p.X() + (size_t)tok * DM;
#pragma unroll
    for (int i = 0; i < 4; ++i) { const float4 a = ld4bf(r + lane * 4 + i * 256); v[4 * i] = a.x; v[4 * i + 1] = a.y; v[4 * i + 2] = a.z; v[4 * i + 3] = a.w; }
  }
  if (lc >= 0) {
    const float* g2 = p.mod() + ((size_t)lc * 3 + modv(tok)) * 6144 + 5 * DM;
    float s[16];
#pragma unroll
    for (int i = 0; i < 16; ++i) s[i] = 0.f;
#pragma unroll
    for (int k = 0; k < TOPK; ++k) {
      const int sl = p.tslot()[tok * 4 + k];
      const size_t arow = (size_t)(pre[sl >> 20] + (sl & 0xFFFFF));
      const u16* y = p.yd() + arow * DM;
#pragma unroll
      for (int i = 0; i < 4; ++i) {
        const u32x2 w = *(const u32x2*)(y + lane * 4 + i * 256);
        s[4 * i] += __uint_as_float(w[0] << 16); s[4 * i + 1] += __uint_as_float(w[0] & 0xFFFF0000u);
        s[4 * i + 2] += __uint_as_float(w[1] << 16); s[4 * i + 3] += __uint_as_float(w[1] & 0xFFFF0000u);
      }
    }
#pragma unroll
    for (int i = 0; i < 4; ++i) {
      const float4 g = *(const float4*)(g2 + lane * 4 + i * 256);
      v[4 * i] += g.x * s[4 * i]; v[4 * i + 1] += g.y * s[4 * i + 1]; v[4 * i + 2] += g.z * s[4 * i + 2]; v[4 * i + 3] += g.w * s[4 * i + 3];
    }
  }
}
__device__ __forceinline__ void expert_prefix(const int* cnt, int* pre) {
  if (ltid() == 0) { int s = 0; for (int e = 0; e < NE; ++e) { pre[e] = s; s += cnt[e]; } pre[NE] = s; }
}

__device__ __forceinline__ float store_row_i8(const float (&y)[16], signed char* __restrict__ h, float* __restrict__ hs_row, int lane) {
  float am = 0.f;
#pragma unroll
  for (int i = 0; i < 16; ++i) am = fmaxf(am, fabsf(y[i]));
#pragma unroll
  for (int o = 32; o > 0; o >>= 1) am = fmaxf(am, __shfl_xor(am, o, 64));
  const float s = fmaxf(am, 1e-20f) * (1.f / 127.f), inv = 1.f / s;
#pragma unroll
  for (int i = 0; i < 4; ++i) {
    const int q0 = (int)rintf(y[4 * i] * inv), q1 = (int)rintf(y[4 * i + 1] * inv), q2 = (int)rintf(y[4 * i + 2] * inv), q3 = (int)rintf(y[4 * i + 3] * inv);
    *(unsigned*)(h + lane * 4 + i * 256) = (unsigned)(q0 & 255) | ((unsigned)(q1 & 255) << 8) | ((unsigned)(q2 & 255) << 16) | ((unsigned)(q3 & 255) << 24);
  }
  if (lane == 0) *hs_row = s;
  return s;
}
__device__ __forceinline__ void phase_quant_in(const Params& p, int bid, int nb) {
  const int wid = ltid() >> 6, lane = ltid() & 63;
  for (int r = bid * 8 + wid; r < 2 * NIN; r += nb * 8) {
    const float* src = p.btf() + (size_t)r * DM;
    float y[16];
#pragma unroll
    for (int i = 0; i < 4; ++i) { const float4 a = *(const float4*)(src + lane * 4 + i * 256); y[4 * i] = a.x; y[4 * i + 1] = a.y; y[4 * i + 2] = a.z; y[4 * i + 3] = a.w; }
    store_row_i8(y, p.bt_in() + (size_t)r * DM, p.swin() + r, lane);
  }
}
__device__ __forceinline__ void phase_norm1(const Params& p, int layer, int bid, int nb, char* lds) {
  int* pre = (int*)lds;
  const int lc = layer - 1;
  if (lc >= 0) { expert_prefix(p.cnt() + lc * NE, pre); __syncthreads(); }
  const int wid = ltid() >> 6, lane = ltid() & 63;
  const float* gn = p.norm1_g() + layer * DM;
  const int ntok = TT;
  for (int tok = bid * 8 + wid; tok < ntok; tok += nb * 8) {
    float v[16];
    load_row_comb(p, layer == 0 ? 0 : 1, lc, tok, lane, pre, v);
    if (lc >= 0) {
      u16* xr = p.X() + (size_t)tok * DM;
#pragma unroll
      for (int i = 0; i < 4; ++i) *(u32x2*)(xr + lane * 4 + i * 256) = u32x2{cvtpk(v[4 * i], v[4 * i + 1]), cvtpk(v[4 * i + 2], v[4 * i + 3])};
    }
    float ss = 0;
#pragma unroll
    for (int i = 0; i < 16; ++i) ss += v[i] * v[i];
    ss = wave_sum(ss);
    const float rs = rsqrtf(ss * (1.f / DM) + EPS);
    const float* md = p.mod() + ((size_t)layer * 3 + modv(tok)) * 6144;
#pragma unroll
    for (int i = 0; i < 4; ++i) {
      const int c = lane * 4 + i * 256;
      const float4 g = *(const float4*)(gn + c), sh = *(const float4*)(md + c), sc = *(const float4*)(md + DM + c);
      v[4 * i] = v[4 * i] * rs * g.x * (1.f + sc.x) + sh.x; v[4 * i + 1] = v[4 * i + 1] * rs * g.y * (1.f + sc.y) + sh.y;
      v[4 * i + 2] = v[4 * i + 2] * rs * g.z * (1.f + sc.z) + sh.z; v[4 * i + 3] = v[4 * i + 3] * rs * g.w * (1.f + sc.w) + sh.w;
    }
    store_row_i8(v, p.H() + (size_t)tok * DM, p.hs() + tok, lane);
  }
}

struct EpiIn {
  u16* zqkv; u16* zg; u16* zt; const float* hs; const float* sw;
  __device__ __forceinline__ void pre(const G8Unit& u, int wr, int fr, float (&ep)[8], float* cb) const {
    if ((ltid() >> 6) == 0) g8_cload(sw + u.pn * 256, cb);
#pragma unroll
    for (int ai = 0; ai < 2; ++ai)
#pragma unroll
      for (int m = 0; m < 4; ++m) ep[ai * 4 + m] = hs[u.pm * 256 + ai * 128 + wr * 64 + m * 16 + fr];
  }
  __device__ __forceinline__ void operator()(const i32x4 (&acc)[2][2][4][2], const G8Unit& u, int wr, int wc, int fr, int fq, const float (&ep)[8], const float* cb) const {
#pragma unroll
    for (int bj = 0; bj < 2; ++bj) {
      const int c32 = u.pn * 256 + bj * 128 + wc * 32, c0 = c32 + 8 * fq;
      const f32x4 w0 = *(const f32x4*)(cb + bj * 128 + wc * 32 + 8 * fq), w1 = *(const f32x4*)(cb + bj * 128 + wc * 32 + 8 * fq + 4);
#pragma unroll
      for (int ai = 0; ai < 2; ++ai)
#pragma unroll
        for (int m = 0; m < 4; ++m) {
          const int row = u.pm * 256 + ai * 128 + wr * 64 + m * 16 + fr;
          f32x4 a, b;
#pragma unroll
          for (int j = 0; j < 4; ++j) { a[j] = (float)acc[ai][bj][m][0][j] * ep[ai * 4 + m] * w0[j]; b[j] = (float)acc[ai][bj][m][1][j] * ep[ai * 4 + m] * w1[j]; }
          if (c32 < 384) {
            *(u32x4*)(zqkv + (size_t)row * 384 + c0) = u32x4{cvtpk(a[0], a[1]), cvtpk(a[2], a[3]), cvtpk(b[0], b[1]), cvtpk(b[2], b[3])};
          } else if (c32 < 1536) {
            *(u32x4*)(zg + (size_t)row * ZG_W + (c0 - 384)) = u32x4{cvtpk(a[0], a[1]), cvtpk(a[2], a[3]), cvtpk(b[0], b[1]), cvtpk(b[2], b[3])};
          } else {
#pragma unroll
            for (int j = 0; j < 4; ++j) { zt[(size_t)(c0 - 1536 + j) * TT + row] = f2bf(a[j]); zt[(size_t)(c0 - 1536 + 4 + j) * TT + row] = f2bf(b[j]); }
          }
        }
    }
  }
};
__device__ __forceinline__ void phase_gemm_in(const Params& p, int layer, int bid, int nb, char* lds) {
  G8Plain S; S.nM = TT / 256; S.nN = NIN / 256; S.Kb = DM; S.G = nb; S.c = bid; S.Bt = (const char*)(p.bt_in() + (size_t)layer * NIN * DM);
  EpiIn E; E.zqkv = p.zqkv(); E.zg = p.zg(); E.zt = p.zt(); E.hs = p.hs(); E.sw = p.swin() + layer * NIN;
  gemm8_phase<true>(lds, (const char*)p.H(), DM, S, E);
}

__device__ __forceinline__ size_t qkv_row(int tok, int h) {
  const int b = tok < TL ? (tok >> 14) : ((tok - TL) >> 8);
  const int s = tok < TL ? (tok & (SEQ - 1)) : SEQ + ((tok - TL) & (LC - 1));
  return ((size_t)(b * 4 + h)) * SKV + s;
}
struct EpiQkv {
  const u16* zqkv; u16* Q; u16* KV; const float* ropec; const float* ropes; float* rsl;
  unsigned* kmx;
  __device__ __forceinline__ void pre(const G8Unit&, int, int, float (&)[8], float*) const {}
  __device__ __forceinline__ void operator()(const f32x4 (&acc)[2][2][4][2], const G8Unit& u, int wr, int wc, int fr, int fq, const float (&)[8], const float*) const {
    const int tid = ltid();
    {
      const int r = tid >> 1, half = tid & 1;
      const u16* row = zqkv + (size_t)(u.pm * 256 + r) * 384;
      float sq = 0, sk = 0;
#pragma unroll
      for (int i = 0; i < 16; ++i) {
        const u32x4 w = *(const u32x4*)(row + half * 128 + i * 8);
#pragma unroll
        for (int q = 0; q < 4; ++q) { const float a = __uint_as_float(w[q] << 16), b = __uint_as_float(w[q] & 0xFFFF0000u); sq += a * a + b * b; }
      }
#pragma unroll
      for (int i = 0; i < 8; ++i) {
        const u32x4 w = *(const u32x4*)(row + 256 + half * 64 + i * 8);
#pragma unroll
        for (int q = 0; q < 4; ++q) { const float a = __uint_as_float(w[q] << 16), b = __uint_as_float(w[q] & 0xFFFF0000u); sk += a * a + b * b; }
      }
      sq += __shfl_xor(sq, 1, 64); sk += __shfl_xor(sk, 1, 64);
      if (half == 0) { rsl[r] = rsqrtf(sq * (1.f / 256.f) + EPS); rsl[256 + r] = rsqrtf(sk * (1.f / 128.f) + EPS); }
    }
    asm volatile("s_waitcnt lgkmcnt(0)" ::: "memory"); __builtin_amdgcn_s_barrier(); __builtin_amdgcn_s_barrier(); asm volatile("" ::: "memory");
    const float* rsp = rsl + (u.pn >= 2 ? 256 : 0);
#pragma unroll
    for (int ai = 0; ai < 2; ++ai)
#pragma unroll
      for (int m = 0; m < 4; ++m) {
        const int rl = ai * 128 + wr * 64 + m * 16 + fr, tok = u.pm * 256 + rl;
        const float rs = rsp[rl] * (u.pn < 2 ? A_QSCALE : 1.f);
        if (u.pn == 1) {
          f32x4 a = acc[ai][0][m][0] * rs, b = acc[ai][0][m][1] * rs;
          f32x4 pa, pb;
#pragma unroll
          for (int j = 0; j < 4; ++j) { pa[j] = __shfl_xor(a[j], 32, 64); pb[j] = __shfl_xor(b[j], 32, 64); }
          f32x4 ca = {1.f, 1.f, 1.f, 1.f}, cb = ca, sa = {0.f, 0.f, 0.f, 0.f}, sb = sa;
          if (tok < TL) {
            const float* cp = ropec + (size_t)(tok & (SEQ - 1)) * 16 + 8 * (fq & 1); const float* sp = ropes + (size_t)(tok & (SEQ - 1)) * 16 + 8 * (fq & 1);
            ca = *(const f32x4*)cp; cb = *(const f32x4*)(cp + 4); sa = *(const f32x4*)sp; sb = *(const f32x4*)(sp + 4);
          }
          const float sg = fq < 2 ? -1.f : 1.f;
          a = a * ca + pa * sa * sg; b = b * cb + pb * sb * sg;
          *(u32x4*)(Q + qkv_row(tok, wc) * 96 + 64 + 8 * fq) = u32x4{cvtpk(a[0], a[1]), cvtpk(a[2], a[3]), cvtpk(b[0], b[1]), cvtpk(b[2], b[3])};
        } else {
#pragma unroll
          for (int bj = 0; bj < 2; ++bj) {
            const int c = bj * 128 + wc * 32 + 8 * fq, h = c >> 6, d = c & 63;
            const f32x4 a = acc[ai][bj][m][0] * rs, b = acc[ai][bj][m][1] * rs;
            u16* dst = u.pn == 0 ? Q + qkv_row(tok, h) * 96 + d : KV + qkv_row(tok, h) * 160 + (u.pn == 2 ? 0 : 96) + d;
            *(u32x4*)dst = u32x4{cvtpk(a[0], a[1]), cvtpk(a[2], a[3]), cvtpk(b[0], b[1]), cvtpk(b[2], b[3])};
          }
        }
      }
    if (u.pn == 2) {
      const int b = u.pm * 256 < TL ? (u.pm * 256) >> 14 : (u.pm * 256 - TL) >> 8;
#pragma unroll
      for (int bj = 0; bj < 2; ++bj) {
        float mx = 0.f;
#pragma unroll
        for (int ai = 0; ai < 2; ++ai)
#pragma unroll
          for (int m = 0; m < 4; ++m) {
            const float rs = rsp[ai * 128 + wr * 64 + m * 16 + fr];
            const f32x4 a = acc[ai][bj][m][0] * rs, b4 = acc[ai][bj][m][1] * rs;
            float ss = a[0] * a[0] + a[1] * a[1] + a[2] * a[2] + a[3] * a[3] + b4[0] * b4[0] + b4[1] * b4[1] + b4[2] * b4[2] + b4[3] * b4[3];
            ss += __shfl_xor(ss, 16, 64); ss += __shfl_xor(ss, 32, 64);
            mx = fmaxf(mx, ss);
          }
#pragma unroll
        for (int o = 8; o > 0; o >>= 1) mx = fmaxf(mx, __shfl_xor(mx, o, 64));
        if ((ltid() & 63) == 0) atomicMax(kmx + (b * 4 + bj * 2 + (wc >> 1)) * 4 + (wc & 1), __float_as_uint(mx));
      }
    }
  }
};
__device__ __forceinline__ void phase_qkv(const Params& p, int layer, int bid, int nb, char* lds) {
  const int tid = ltid();
  {
    G8Plain S; S.nM = TT / 256; S.nN = 4; S.Kb = 768; S.G = nb; S.c = bid; S.Bt = (const char*)(p.bt_qkv() + (size_t)layer * 1024 * 384);
    EpiQkv E; E.zqkv = p.zqkv(); E.Q = p.Q(); E.KV = p.KV(); E.ropec = p.ropec(); E.ropes = p.ropes(); E.rsl = (float*)(lds + 131072); E.kmx = p.kmx() + layer * 32;
    gemm8_phase<false>(lds, (const char*)p.zqkv(), 768, S, E);
  }
  float krm0 = 0.f, krm1 = 0.f;
  for (int i = bid * NTHR + tid; i < TT * 16; i += nb * NTHR) {
    const int tok = i >> 4, f = i & 15;
    const float x1 = bf2f(p.zg()[(size_t)tok * ZG_W + ZG_KR + f]), x2 = bf2f(p.zg()[(size_t)tok * ZG_W + ZG_KR + 16 + f]);
    float cs = 1.f, sn = 0.f;
    if (tok < TL) { const int tpos = tok & (SEQ - 1); cs = p.ropec()[tpos * 16 + f]; sn = p.ropes()[tpos * 16 + f]; }
    const float y1 = x1 * cs - x2 * sn, y2 = x2 * cs + x1 * sn;
    const u16 o1 = f2bf(y1), o2 = f2bf(y2);
#pragma unroll
    for (int h = 0; h < 4; ++h) { u16* kv = p.KV() + qkv_row(tok, h) * 160 + 64; kv[f] = o1; kv[16 + f] = o2; }
    float ss = y1 * y1 + y2 * y2;
#pragma unroll
    for (int o = 8; o > 0; o >>= 1) ss += __shfl_xor(ss, o, 64);
    const int b = tok < TL ? (tok >> 14) : ((tok - TL) >> 8);
    if (b == 0) krm0 = fmaxf(krm0, ss); else krm1 = fmaxf(krm1, ss);
  }
#pragma unroll
  for (int o = 32; o > 0; o >>= 1) { krm0 = fmaxf(krm0, __shfl_xor(krm0, o, 64)); krm1 = fmaxf(krm1, __shfl_xor(krm1, o, 64)); }
  if ((tid & 63) == 0) { atomicMax(p.kmx() + layer * 32 + 0 * 16 + 2, __float_as_uint(krm0)); atomicMax(p.kmx() + layer * 32 + 1 * 16 + 2, __float_as_uint(krm1)); }
}

constexpr int A_KROW = 208;
constexpr int A_TV = 128 * 64 * 2;
constexpr int A_TK = 128 * A_KROW;
constexpr int A_BUF = A_TV + A_TK;
constexpr int A_OFF_W = 3 * A_BUF;
constexpr int ATTN_LDS = A_OFF_W + 8 * 64 * 4;
#define SBAR() __builtin_amdgcn_sched_barrier(0)
__device__ __forceinline__ int crow(int r, int hi) { return (r & 3) + 8 * (r >> 2) + 4 * hi; }

__device__ __forceinline__ void a_partialSM(f32x16& p0) {
#pragma unroll
  for (int r = 0; r < 16; ++r) p0[r] = __builtin_amdgcn_exp2f(p0[r]);
}
__device__ __forceinline__ void a_finishSM(f32x16& p0, f32x16& p1, float& l_reg, bf16x8& pa0, bf16x8& pa1, bf16x8& pa2, bf16x8& pa3) {
#pragma unroll
  for (int r = 0; r < 16; ++r) p1[r] = __builtin_amdgcn_exp2f(p1[r]);
  float ps = 0;
#pragma unroll
  for (int r = 0; r < 16; ++r) ps += p0[r];
#pragma unroll
  for (int r = 0; r < 16; ++r) ps += p1[r];
  { auto rr = __builtin_amdgcn_permlane32_swap(__float_as_uint(ps), __float_as_uint(ps), false, false);
    ps = __uint_as_float(rr[0]) + __uint_as_float(rr[1]); }
  l_reg += ps;
#define PK4(P, BASE, OUT) do { unsigned a0 = cvtpk(P[BASE + 0], P[BASE + 1]), a1 = cvtpk(P[BASE + 2], P[BASE + 3]);   \
    unsigned b0 = cvtpk(P[BASE + 4], P[BASE + 5]), b1 = cvtpk(P[BASE + 6], P[BASE + 7]);                              \
    auto r0 = __builtin_amdgcn_permlane32_swap(a0, b0, false, false); auto r1 = __builtin_amdgcn_permlane32_swap(a1, b1, false, false); \
    u32x4 w = {r0[0], r1[0], r0[1], r1[1]}; OUT = *reinterpret_cast<bf16x8*>(&w); } while (0)
  PK4(p0, 0, pa0); PK4(p0, 8, pa1); PK4(p1, 0, pa2); PK4(p1, 8, pa3);
#undef PK4
}
__device__ __forceinline__ void a_qkt(f32x16& p0, f32x16& p1, const char* Ks, const bf16x8* qr, const float mneg, int r32, int hi) {
#pragma unroll
  for (int r = 0; r < 16; ++r) { p0[r] = mneg; p1[r] = mneg; }
#pragma unroll
  for (int d0 = 0; d0 < 6; ++d0) {
    const int cb = (d0 * 16 + hi * 8) * 2;
    const bf16x8 b0 = *reinterpret_cast<const bf16x8*>(Ks + r32 * A_KROW + cb);
    const bf16x8 b1 = *reinterpret_cast<const bf16x8*>(Ks + (32 + r32) * A_KROW + cb);
    p0 = __builtin_amdgcn_mfma_f32_32x32x16_bf16(b0, qr[d0], p0, 0, 0, 0); p1 = __builtin_amdgcn_mfma_f32_32x32x16_bf16(b1, qr[d0], p1, 0, 0, 0);
  }
}
__device__ __forceinline__ int a_v_st(int k, int c) { const int kk = (k & ~0xC) | ((k & 4) << 1) | ((k & 8) >> 1); return ((kk >> 3) * 2 + (c >> 5)) * 512 + ((kk & 7) * 32 + (c & 31)) * 2; }
__device__ __forceinline__ int a_v_rd_base(int lane) { return ((lane & 3) << 3) | (((lane >> 2) & 3) << 6) | (((lane >> 4) & 1) << 5) | (((lane >> 5) & 1) << 8); }
constexpr int a_v_rd_off(int d0, int ks, int half) { return d0 * 512 + ks * 2048 + half * 1024; }
template <int OFF> __device__ __forceinline__ s16x4 a_tr_read(int vb) {
  s16x4 r; asm volatile("ds_read_b64_tr_b16 %0, %1 offset:%2" : "=&v"(r) : "v"(vb), "i"(OFF) : "memory"); return r;
}
template <int D0> __device__ __forceinline__ void a_pv_one(f32x16& od, int vb, bf16x8 pa0, bf16x8 pa1, bf16x8 pa2, bf16x8 pa3) {
  const s16x4 l0 = a_tr_read<a_v_rd_off(D0, 0, 0)>(vb), h0 = a_tr_read<a_v_rd_off(D0, 0, 1)>(vb), l1 = a_tr_read<a_v_rd_off(D0, 1, 0)>(vb), h1 = a_tr_read<a_v_rd_off(D0, 1, 1)>(vb);
  const s16x4 l2 = a_tr_read<a_v_rd_off(D0, 2, 0)>(vb), h2 = a_tr_read<a_v_rd_off(D0, 2, 1)>(vb), l3 = a_tr_read<a_v_rd_off(D0, 3, 0)>(vb), h3 = a_tr_read<a_v_rd_off(D0, 3, 1)>(vb);
  asm volatile("s_waitcnt lgkmcnt(0)" ::: "memory"); SBAR();
#define PK(L, H) (bf16x8){L[0], L[1], L[2], L[3], H[0], H[1], H[2], H[3]}
  od = __builtin_amdgcn_mfma_f32_32x32x16_bf16(pa0, PK(l0, h0), od, 0, 0, 0);
  od = __builtin_amdgcn_mfma_f32_32x32x16_bf16(pa1, PK(l1, h1), od, 0, 0, 0);
  od = __builtin_amdgcn_mfma_f32_32x32x16_bf16(pa2, PK(l2, h2), od, 0, 0, 0);
  od = __builtin_amdgcn_mfma_f32_32x32x16_bf16(pa3, PK(l3, h3), od, 0, 0, 0);
#undef PK
}
__device__ __forceinline__ void a_pv(f32x16* o, int vb, bf16x8 pa0, bf16x8 pa1, bf16x8 pa2, bf16x8 pa3) {
  a_pv_one<0>(o[0], vb, pa0, pa1, pa2, pa3); a_pv_one<1>(o[1], vb, pa0, pa1, pa2, pa3);
}

__device__ __forceinline__ void attn_item(const u16* __restrict__ Qb, const u16* __restrict__ KVh, int seq, float kmax, u16* __restrict__ yout  , char* lds) {
  const int tid = ltid(), wid = tid >> 6, lane = tid & 63, r32 = lane & 31, hi = lane >> 5;
  float* ws = (float*)(lds + A_OFF_W) + wid * 64; float* li_l = ws;
  float l_reg = 0; f32x16 o[2] = {}; bf16x8 qr[6];
  const u16* Qw = Qb + (size_t)(wid * 32 + r32) * 96 + hi * 8;
#pragma unroll
  for (int d0 = 0; d0 < 6; ++d0) qr[d0] = *reinterpret_cast<const bf16x8*>(Qw + d0 * 16);
  float mneg;
  {
    float ss = 0.f;
#pragma unroll
    for (int d0 = 0; d0 < 6; ++d0)
#pragma unroll
      for (int j = 0; j < 8; ++j) { const float v = bf2f((u16)qr[d0][j]); ss += v * v; }
    ss += __shfl_xor(ss, 32, 64);
    mneg = -sqrtf(ss) * kmax;
  }
  int lw[5];
#pragma unroll
  for (int i = 0; i < 5; ++i) {
    const int g = tid + i * 512, key = g / 20, cc = g % 20;
    lw[i] = cc < 12 ? (A_TV + key * A_KROW + cc * 16) : ((key >> 6) * 8192 + a_v_st(key & 63, (cc - 12) * 8));
  }
  const int vrb = (int)(uintptr_t)lds + a_v_rd_base(lane);
  bf16x8 sg[5];
  const char* gsrc = (const char*)KVh + tid * 16;
#define SLOAD(t) do { const char* s_ = gsrc + (size_t)(t) * 40960; _Pragma("unroll") for (int i = 0; i < 5; ++i) sg[i] = *(const bf16x8*)(s_ + i * 8192); } while (0)
#define SWRITE(bo_) do { _Pragma("unroll") for (int i = 0; i < 5; ++i) *(bf16x8*)(lds + (bo_) + lw[i]) = sg[i]; } while (0)
  f32x16 pA0, pA1, pB0, pB1; bf16x8 pa0, pa1, pa2, pa3; const int NT = seq / 128;
  SLOAD(0); SWRITE(0); if (1 < NT) SLOAD(1);
  __syncthreads();
  int bo = 0;
  {
    if (1 < NT) { SWRITE(A_BUF); if (2 < NT) SLOAD(2); }
    SBAR(); a_qkt(pA0, pA1, lds + bo + A_TV, qr, mneg, r32, hi); a_partialSM(pA0);
    SBAR(); a_qkt(pB0, pB1, lds + bo + A_TV + 64 * A_KROW, qr, mneg, r32, hi);
    a_finishSM(pA0, pA1, l_reg, pa0, pa1, pa2, pa3); SBAR();
    a_pv(o, vrb + bo, pa0, pa1, pa2, pa3); a_partialSM(pB0);
    __syncthreads();
  }
  for (int t = 1; t < NT; ++t) {
    const int bp = bo;
    bo = bo + A_BUF; if (bo == 3 * A_BUF) bo = 0;
    int bn = bo + A_BUF; if (bn == 3 * A_BUF) bn = 0;
    if (t + 1 < NT) { SWRITE(bn); if (t + 2 < NT) SLOAD(t + 2); }
    SBAR(); a_qkt(pA0, pA1, lds + bo + A_TV, qr, mneg, r32, hi);
    a_finishSM(pB0, pB1, l_reg, pa0, pa1, pa2, pa3); SBAR();
    a_pv(o, vrb + bp + 8192, pa0, pa1, pa2, pa3); a_partialSM(pA0);
    SBAR(); a_qkt(pB0, pB1, lds + bo + A_TV + 64 * A_KROW, qr, mneg, r32, hi);
    a_finishSM(pA0, pA1, l_reg, pa0, pa1, pa2, pa3); SBAR();
    a_pv(o, vrb + bo, pa0, pa1, pa2, pa3); a_partialSM(pB0);
    __syncthreads();
  }
  a_finishSM(pB0, pB1, l_reg, pa0, pa1, pa2, pa3); SBAR();
  a_pv(o, vrb + bo + 8192, pa0, pa1, pa2, pa3);
  if (hi == 0) li_l[r32] = l_reg; asm volatile("s_waitcnt lgkmcnt(0)" ::: "memory");
#pragma unroll
  for (int r = 0; r < 16; ++r) {
    const int orow = crow(r, hi);
    const float rl = __builtin_amdgcn_rcpf(li_l[orow]);
    const float v0 = o[0][r] * rl, v1 = o[1][r] * rl;
    float ss = v0 * v0 + v1 * v1;
#pragma unroll
    for (int off = 16; off > 0; off >>= 1) ss += __shfl_xor(ss, off, 64);
    const float rs = rsqrtf(ss * (1.f / 64.f) + EPS);
    u16* dst = yout + (size_t)(wid * 32 + orow) * DM;
    dst[r32] = f2bf(v0 * rs); dst[32 + r32] = f2bf(v1 * rs);
  }
  __syncthreads();
#undef SLOAD
#undef SWRITE
}

__device__ __forceinline__ void phase_attn(const Params& p, int layer, int bid, int nb, char* lds) {
  const int nitems = 512 + (layer == 0 ? 8 : 0);
  const unsigned* kmx = p.kmx() + layer * 32;
  for (int it = bid; it < nitems; it += nb) {
    int b, h, q0, k0, seq, tok0;
    if (it < 512) { const int pair = it & 7, qb = (it >> 3); h = pair & 3; b = pair >> 2; q0 = qb * 256; k0 = 0; seq = SKV; tok0 = b * SEQ + qb * 256; }
    else { const int i2 = it - 512; h = i2 & 3; b = i2 >> 2; q0 = SEQ; k0 = SEQ; seq = LC; tok0 = TL + b * LC; }
    const size_t base = (size_t)(b * 4 + h) * SKV;
    const float k2 = __uint_as_float(kmx[(b * 4 + h) * 4 + 0]) + __uint_as_float(kmx[(b * 4 + h) * 4 + 1]) + __uint_as_float(kmx[b * 16 + 2]);
    attn_item(p.Q() + (base + q0) * 96, p.KV() + (base + k0) * 160, seq, sqrtf(k2) * 1.02f, p.ymix() + (size_t)tok0 * DM + h * 64, lds);
  }
}

__device__ __forceinline__ float hy_sconv(const u16* __restrict__ row, int t, int Ls, float w0, float w1, float w2, float bb) {
  const float zm = t > 0 ? bf2f(row[t - 1]) : 0.f, z0 = bf2f(row[t]), zp = t + 1 < Ls ? bf2f(row[t + 1]) : 0.f;
  return w0 * zm + w1 * z0 + w2 * zp + bb;
}
__device__ __forceinline__ float2 hy_sconv2(unsigned prv, unsigned cur, unsigned nxt, float w0, float w1, float w2, float bb) {
  const float zm = __uint_as_float(prv & 0xFFFF0000u), z0 = __uint_as_float(cur << 16), z1 = __uint_as_float(cur & 0xFFFF0000u), z2 = __uint_as_float(nxt << 16);
  return make_float2(w0 * zm + w1 * z0 + w2 * z1 + bb, w0 * z0 + w1 * z1 + w2 * z2 + bb);
}
__device__ __forceinline__ void hyena_item(const Params& p, int layer, int b, int ch, char* lds) {
  float2* s = (float2*)lds;
  const int tid = ltid();
  const float* cw = p.hy_conv_w() + (size_t)layer * 3 * 768; const float* cb = p.hy_conv_b() + (size_t)layer * 768;
  const unsigned* r0 = (const unsigned*)(p.zt() + (size_t)(ZT_HY + ch) * TT + (size_t)b * SEQ);
  const unsigned* r1 = (const unsigned*)(p.zt() + (size_t)(ZT_HY + 256 + ch) * TT + (size_t)b * SEQ);
  const unsigned* r2 = (const unsigned*)(p.zt() + (size_t)(ZT_HY + 512 + ch) * TT + (size_t)b * SEQ);
  const float a0 = cw[ch], a1 = cw[768 + ch], a2 = cw[1536 + ch], ab = cb[ch];
  const float b0 = cw[256 + ch], b1 = cw[768 + 256 + ch], b2 = cw[1536 + 256 + ch], bb = cb[256 + ch];
  const float c0 = cw[512 + ch], c1 = cw[768 + 512 + ch], c2 = cw[1536 + 512 + ch], cbb = cb[512 + ch];
  unsigned vgr[16], x0r[16];
#pragma unroll
  for (int hb2 = 0; hb2 < 2; ++hb2) {
    unsigned ld[8][9];
#pragma unroll
    for (int ii = 0; ii < 8; ++ii) {
      const int m = tid + 512 * (hb2 * 8 + ii);
      const int mp = m > 0 ? m - 1 : 0, mn = m + 1 < SEQ / 2 ? m + 1 : m;
      ld[ii][0] = r0[mp]; ld[ii][1] = r0[m]; ld[ii][2] = r0[mn];
      ld[ii][3] = r1[mp]; ld[ii][4] = r1[m]; ld[ii][5] = r1[mn];
      ld[ii][6] = r2[mp]; ld[ii][7] = r2[m]; ld[ii][8] = r2[mn];
    }
#pragma unroll
    for (int ii = 0; ii < 8; ++ii) {
      const int i = hb2 * 8 + ii, m = tid + 512 * i;
      const unsigned mkp = m > 0 ? 0xFFFFFFFFu : 0u, mkn = m + 1 < SEQ / 2 ? 0xFFFFFFFFu : 0u;
      const float2 ux = hy_sconv2(ld[ii][0] & mkp, ld[ii][1], ld[ii][2] & mkn, a0, a1, a2, ab);
      x0r[i] = cvtpk(ux.x, ux.y);
      const float2 u1 = hy_sconv2(ld[ii][3] & mkp, ld[ii][4], ld[ii][5] & mkn, b0, b1, b2, bb);
      const float2 uv = hy_sconv2(ld[ii][6] & mkp, ld[ii][7], ld[ii][8] & mkn, c0, c1, c2, cbb);
      const float2 vgf = make_float2(uv.x * u1.x, uv.y * u1.y);
      vgr[i] = cvtpk(vgf.x, vgf.y);
      s[swz(m)] = vgf;
      s[swz(m + SEQ / 2)] = make_float2(0.f, 0.f);
    }
  }
  __syncthreads();
  fft_fwd(s, p.tw());
  {
    const float4* hs = p.hspec() + ((size_t)layer * 256 + ch) * HSP;
    float4 hv[17];
#pragma unroll
    for (int i = 0; i < 17; ++i) { const int k = tid + 512 * i; hv[i] = hs[k <= FM / 2 ? k : 0]; }
    const float2 twl = p.tw()[tid];
#pragma unroll
    for (int i = 0; i < 17; ++i) {
      const int k = tid + 512 * i;
      if (k <= FM / 2) {
        const int pk = swz(rev7(k)), pm = swz(rev7((FM - k) & (FM - 1)));
        const float2 zk = s[pk], zm = s[pm];
        const float4 h = hv[i];
        const float2 He = make_float2(h.x, h.y), Ho = make_float2(h.z, h.w);
        const float2 Xe = make_float2(0.5f * (zk.x + zm.x), 0.5f * (zk.y - zm.y));
        const float2 Xo = make_float2(0.5f * (zk.y + zm.y), -0.5f * (zk.x - zm.x));
        const float2 twk = cmul(twl, p.tw()[512 * i]);
        const float2 t1 = cmul(twk, cmul(Xo, Ho));
        const float2 e1 = cmul(Xe, He);
        const float2 Ye = make_float2(e1.x + t1.x, e1.y + t1.y);
        const float2 o1 = cmul(Xe, Ho), o2 = cmul(Xo, He);
        const float2 Yo = make_float2(o1.x + o2.x, o1.y + o2.y);
        s[pk] = make_float2(Ye.x - Yo.y, Ye.y + Yo.x);
        if (pm != pk) s[pm] = make_float2(Ye.x + Yo.y, -Ye.y + Yo.x);
      }
    }
  }
  __syncthreads();
  fft_inv(s, p.tw());
  const float hb = p.hy_bias()[layer * 256 + ch];
  unsigned* orow = (unsigned*)(p.hyo() + (size_t)ch * TT + (size_t)b * SEQ);
#pragma unroll
  for (int i = 0; i < 16; ++i) {
    const int m = tid + 512 * i;
    const float2 y = s[swz(m)];
    orow[m] = cvtpk((y.x + __uint_as_float(vgr[i] << 16) * hb) * __uint_as_float(x0r[i] << 16), (y.y + __uint_as_float(vgr[i] & 0xFFFF0000u) * hb) * __uint_as_float(x0r[i] & 0xFFFF0000u));
  }
  __syncthreads();
}
__device__ __forceinline__ void fnet_item(const Params& p, int b, int j, char* lds) {
  float2* s = (float2*)lds;
  const int tid = ltid();
  const u16* rr = p.zt() + (size_t)(ZT_FR + j) * TT + (size_t)b * SEQ;
  const u16* ri = p.zt() + (size_t)(ZT_FI + j) * TT + (size_t)b * SEQ;
  {
    u32x4 vr[4], vi[4];
#pragma unroll
    for (int i = 0; i < 4; ++i) { const int m0 = (tid + 512 * i) * 8; vr[i] = *(const u32x4*)(rr + m0); vi[i] = *(const u32x4*)(ri + m0); }
#pragma unroll
    for (int i = 0; i < 4; ++i) {
      const int m0 = (tid + 512 * i) * 8;
#pragma unroll
      for (int q = 0; q < 4; ++q) {
        s[swz(m0 + 2 * q)] = make_float2(__uint_as_float(vr[i][q] << 16), __uint_as_float(vi[i][q] << 16));
        s[swz(m0 + 2 * q + 1)] = make_float2(__uint_as_float(vr[i][q] & 0xFFFF0000u), __uint_as_float(vi[i][q] & 0xFFFF0000u));
      }
    }
  }
  __syncthreads();
  fft_fwd(s, p.tw());
#ifdef PROBE_FFT
  fft_inv(s, p.tw());
  for (int m = tid; m < FM; m += NTHR) { float2 v = s[m]; v.x *= (1.f / 16384.f); v.y *= (1.f / 16384.f); s[m] = v; }
  __syncthreads();
  fft_fwd(s, p.tw());
#endif
  u16* orow = p.fno() + (size_t)j * TT + (size_t)b * SEQ;
#pragma unroll 8
  for (int k = tid; k < FM; k += NTHR) orow[k] = f2bf(s[swz(rev7(k))].x * (1.f / 128.f));
  __syncthreads();
}
__device__ __forceinline__ void hyena_ctx_item(const Params& p, int b, int ch, char* lds) {
  float* vg = (float*)lds;
  float* x0 = vg + 256;
  float* hf = x0 + 256;
  float* hbk = hf + 256;
  const int tid = ltid();
  const float* cw = p.hy_conv_w(); const float* cb = p.hy_conv_b();
  const size_t off = (size_t)TL + (size_t)b * LC;
  const u16* r0 = p.zt() + (size_t)(ZT_HY + ch) * TT + off;
  const u16* r1 = p.zt() + (size_t)(ZT_HY + 256 + ch) * TT + off;
  const u16* r2 = p.zt() + (size_t)(ZT_HY + 512 + ch) * TT + off;
  if (tid < 256) {
    const int t = tid;
    vg[t] = hy_sconv(r2, t, LC, cw[512 + ch], cw[768 + 512 + ch], cw[1536 + 512 + ch], cb[512 + ch]) *
            hy_sconv(r1, t, LC, cw[256 + ch], cw[768 + 256 + ch], cw[1536 + 256 + ch], cb[256 + ch]);
    x0[t] = hy_sconv(r0, t, LC, cw[ch], cw[768 + ch], cw[1536 + ch], cb[ch]);
    hf[t] = p.hfc()[(size_t)ch * LC + t]; hbk[t] = p.hfc()[(size_t)(256 + ch) * LC + t];
  }
  const float ssq_c = filt_ssq(p.hpart() + (size_t)2 * 256 * 512, ch, (float*)(lds + 8192));
  if (tid < 256) {
    const int t = tid; float y = 0;
    for (int q = 0; q <= t; ++q) y += hf[t - q] * vg[q];
    for (int q = t + 1; q < LC; ++q) y += hbk[q - t] * vg[q];
    y *= rsqrtf(ssq_c);
    p.hyo()[(size_t)ch * TT + off + t] = f2bf((y + vg[t] * p.hy_bias()[ch]) * x0[t]);
  }
  __syncthreads();
}
__device__ __forceinline__ void fnet_ctx_item(const Params& p, int b, int j, char* lds) {
  float* ur = (float*)lds; float* ui = ur + 256; float* cst = ui + 256; float* snt = cst + 256;
  const int tid = ltid();
  const size_t off = (size_t)TL + (size_t)b * LC;
  if (tid < 256) {
    ur[tid] = bf2f(p.zt()[(size_t)(ZT_FR + j) * TT + off + tid]); ui[tid] = bf2f(p.zt()[(size_t)(ZT_FI + j) * TT + off + tid]);
    float sn, cs; sincospif((float)tid / 128.f, &sn, &cs); cst[tid] = cs; snt[tid] = sn;
  }
  __syncthreads();
  if (tid < 256) {
    const int k = tid; float y = 0;
    for (int l = 0; l < 256; ++l) { const int m = (l * k) & 255; y += cst[m] * ur[l] + snt[m] * ui[l]; }
    p.fno()[(size_t)j * TT + off + k] = f2bf(y * 0.0625f);
  }
  __syncthreads();
}
__device__ __forceinline__ void phase_fftmix(const Params& p, int layer, int bid, int nb, char* lds) {
  const int nitems = layer == 0 ? 2048 : 1024;
  for (int it = bid; it < nitems; it += nb) {
    const int k = it & 511, b = k >> 8, c = k & 255;
    if (it < 512) hyena_item(p, layer, b, c, lds);
    else if (it < 1024) fnet_item(p, b, c, lds);
    else if (it < 1536) hyena_ctx_item(p, b, c, lds);
    else fnet_ctx_item(p, b, c, lds);
  }
}
constexpr int GLG = 17, NGRP = 16;
__device__ __forceinline__ int gla_chain_tok(int dir, int b, int n, int i) {
  const int base = n < 4 ? TL + b * LC : b * SEQ, len = n < 4 ? LC : SEQ, m = n < 4 ? n : n - 4;
  return dir == 0 ? base + 64 * m + i : base + (len - 1) - (64 * m + i);
}
__device__ __forceinline__ float logsig16(float x) { return (fminf(x, 0.f) - log1pf(__expf(-fabsf(x)))) * (1.f / 16.f); }
__device__ __forceinline__ float wave_scan_incl(float v, int lane) {
#pragma unroll
  for (int o = 1; o < 64; o <<= 1) { const float t = __shfl_up(v, o, 64); if (lane >= o) v += t; }
  return v;
}
__device__ __forceinline__ void phase_gla_a(const Params& p, int layer, int bid, int nb, char* lds) {
  float* kl = (float*)lds;
  float* gl = kl + 64 * 33;
  float* vl = gl + 64 * 33;
  const int tid = ltid(), wid = tid >> 6, lane = tid & 63;
  const float* gb = p.gla_gk_b() + (size_t)layer * 256;
  for (int it = bid; it < 16 * NGRP; it += nb) {
    const int chain = it >> 4, g = it & 15, dir = chain >> 3, b = (chain >> 2) & 1, h = chain & 3;
    const int n0 = g * GLG, n1 = min(n0 + GLG, NCH);
    const int kk = tid >> 4, v0 = (tid & 15) * 4;
    float st[4] = {0.f, 0.f, 0.f, 0.f}; float dcum = 1.f;
    for (int n = n0; n < n1; ++n) {
      {
        const int i = tid >> 3, c4 = (tid & 7) * 4;
        const u16* zr = p.zg() + (size_t)gla_chain_tok(dir, b, n, i) * ZG_W;
        const float4 k4 = ld4bf(zr + ZG_GK + h * 32 + c4);
        const float4 g4 = ld4bf(zr + ZG_GP + dir * 128 + h * 32 + c4);
        const float4 bb = *(const float4*)(gb + dir * 128 + h * 32 + c4);
        const float4 va = ld4bf(zr + ZG_GV + h * 64 + c4 * 2), vb = ld4bf(zr + ZG_GV + h * 64 + c4 * 2 + 4);
        kl[i * 33 + c4] = k4.x; kl[i * 33 + c4 + 1] = k4.y; kl[i * 33 + c4 + 2] = k4.z; kl[i * 33 + c4 + 3] = k4.w;
        gl[i * 33 + c4] = logsig16(g4.x + bb.x); gl[i * 33 + c4 + 1] = logsig16(g4.y + bb.y); gl[i * 33 + c4 + 2] = logsig16(g4.z + bb.z); gl[i * 33 + c4 + 3] = logsig16(g4.w + bb.w);
        *(float4*)(vl + i * 68 + c4 * 2) = va; *(float4*)(vl + i * 68 + c4 * 2 + 4) = vb;
      }
      __syncthreads();
#pragma unroll
      for (int q = 0; q < 4; ++q) { const int c = wid * 4 + q; gl[lane * 33 + c] = wave_scan_incl(gl[lane * 33 + c], lane); }
      __syncthreads();
      {
        float* lp = p.gds() + ((size_t)chain * NCH + n) * 2048 + kk * 64 + v0;
        *(float4*)lp = make_float4(st[0], st[1], st[2], st[3]);
        if ((tid & 15) == 0) p.gdv()[((size_t)chain * NCH + n) * 32 + kk] = dcum;
        const float bl = gl[63 * 33 + kk];
        float acc[4] = {0.f, 0.f, 0.f, 0.f};
#pragma unroll 8
        for (int i = 0; i < 64; ++i) {
          const float w = kl[i * 33 + kk] * __expf(bl - gl[i * 33 + kk]);
          const float4 vv = *(const float4*)(vl + i * 68 + v0);
          acc[0] += w * vv.x; acc[1] += w * vv.y; acc[2] += w * vv.z; acc[3] += w * vv.w;
        }
        const float d = __expf(bl);
#pragma unroll
        for (int j = 0; j < 4; ++j) st[j] = st[j] * d + acc[j];
        dcum *= d;
      }
      __syncthreads();
    }
    float* at = p.gst() + ((size_t)chain * NGRP + g) * 2048 + kk * 64 + v0;
    *(float4*)at = make_float4(st[0], st[1], st[2], st[3]);
    if ((tid & 15) == 0) p.gst()[(size_t)16 * NGRP * 2048 + ((size_t)chain * NGRP + g) * 32 + kk] = dcum;
  }
}

constexpr int GC_QP = 33792, GC_KP = GC_QP + 10240, GC_VT = GC_KP + 10240, GC_ST = GC_VT + 18432, GC_AX = GC_ST + 10240;
__device__ __forceinline__ void phase_gla_c(const Params& p, int layer, int bid, int nb, char* lds) {
  float* gl = (float*)lds;
  float* qraw = gl + 2 * 64 * 33;
  float* kraw = qraw + 64 * 33;
  float* Of = (float*)lds;
  char* Qp = lds + GC_QP;
  char* Kp = lds + GC_KP;
  char* VT = lds + GC_VT;
  char* ST = lds + GC_ST;
  const int tid = ltid(), wid = tid >> 6, lane = tid & 63, r32 = lane & 31, hi = lane >> 5;
  char* Ax = lds + GC_AX + wid * 4608;
  const float* gb = p.gla_gk_b() + (size_t)layer * 256;
  const int pc_lo = layer == 0 ? 0 : 4, npc = NCH - pc_lo, nitem = 8 * npc;
  const int per = (nitem + nb - 1) / nb, q_beg = bid * per, q_end = min(nitem, q_beg + per);
  const int sdir = tid >> 8, sk = (tid >> 3) & 31, sv0 = (tid & 7) * 8;
  float G[8]; int g_cached = -1, bh_cached = -1;
  for (int qi = q_beg; qi < q_end; ++qi) {
    const int bh = qi / npc, pc = pc_lo + qi % npc, b = bh >> 2, h = bh & 3;
    const int tok0 = pc < 4 ? TL + b * LC + pc * 64 : b * SEQ + (pc - 4) * 64;
    {
      const int pos = tid >> 3, c4 = (tid & 7) * 4;
      const u16* zr = p.zg() + (size_t)(tok0 + pos) * ZG_W;
      const float4 q4 = ld4bf(zr + ZG_GQ + h * 32 + c4), k4 = ld4bf(zr + ZG_GK + h * 32 + c4);
      const float sc = 0.17677669529663687f;
      qraw[pos * 33 + c4] = q4.x * sc; qraw[pos * 33 + c4 + 1] = q4.y * sc; qraw[pos * 33 + c4 + 2] = q4.z * sc; qraw[pos * 33 + c4 + 3] = q4.w * sc;
      kraw[pos * 33 + c4] = k4.x; kraw[pos * 33 + c4 + 1] = k4.y; kraw[pos * 33 + c4 + 2] = k4.z; kraw[pos * 33 + c4 + 3] = k4.w;
#pragma unroll
      for (int d = 0; d < 2; ++d) {
        const float4 g4 = ld4bf(zr + ZG_GP + d * 128 + h * 32 + c4), bb = *(const float4*)(gb + d * 128 + h * 32 + c4);
        const int i = d ? 63 - pos : pos;
        float* gd = gl + (d * 64 + i) * 33 + c4;
        gd[0] = logsig16(g4.x + bb.x); gd[1] = logsig16(g4.y + bb.y); gd[2] = logsig16(g4.z + bb.z); gd[3] = logsig16(g4.w + bb.w);
      }
      const float4 va = ld4bf(zr + ZG_GV + h * 64 + c4 * 2), vb = ld4bf(zr + ZG_GV + h * 64 + c4 * 2 + 4);
      const float vv[8] = {va.x, va.y, va.z, va.w, vb.x, vb.y, vb.z, vb.w};
#pragma unroll
      for (int j = 0; j < 8; ++j) {
        const u16 hv = f2bf(vv[j]); const int v = c4 * 2 + j;
        *(u16*)(VT + (0 * 64 + v) * 144 + pos * 2) = hv; *(u16*)(VT + (1 * 64 + v) * 144 + (63 - pos) * 2) = hv;
      }
    }
    __syncthreads();
#pragma unroll
    for (int q = 0; q < 8; ++q) { const int col = wid * 8 + q, d = col >> 5, c = col & 31; float* gp = gl + (d * 64 + lane) * 33 + c; *gp = wave_scan_incl(*gp, lane); }
    __syncthreads();
    {
#pragma unroll
      for (int e = 0; e < 2; ++e) {
        const int idx = tid + e * 512, d = idx >> 9, i = (idx >> 3) & 63, c4 = (idx & 7) * 4, pos = d ? 63 - i : i;
        float qo[4], ko[4];
#pragma unroll
        for (int j = 0; j < 4; ++j) {
          const float bi = gl[(d * 64 + i) * 33 + c4 + j], bm = gl[(d * 64 + 31) * 33 + c4 + j];
          qo[j] = qraw[pos * 33 + c4 + j] * __expf(bi - bm); ko[j] = kraw[pos * 33 + c4 + j] * __expf(bm - bi);
        }
        *(u32x2*)(Qp + (d * 64 + i) * 80 + c4 * 2) = u32x2{cvtpk(qo[0], qo[1]), cvtpk(qo[2], qo[3])};
        *(u32x2*)(Kp + (d * 64 + i) * 80 + c4 * 2) = u32x2{cvtpk(ko[0], ko[1]), cvtpk(ko[2], ko[3])};
      }
      const int chain = sdir * 8 + b * 4 + h;
      const int n = sdir == 0 ? pc : (pc < 4 ? 3 - pc : 4 + 255 - (pc - 4)), g = n / GLG;
      if (g != g_cached || bh != bh_cached) {
#pragma unroll
        for (int j = 0; j < 8; ++j) G[j] = 0.f;
        const float* at = p.gst() + (size_t)chain * NGRP * 2048 + sk * 64 + sv0;
        const float* dt = p.gst() + (size_t)16 * NGRP * 2048 + (size_t)chain * NGRP * 32 + sk;
        for (int gg = 0; gg < g; ++gg) {
          const float4 a0 = *(const float4*)(at + (size_t)gg * 2048), a1 = *(const float4*)(at + (size_t)gg * 2048 + 4); const float dd = dt[gg * 32];
          G[0] = G[0] * dd + a0.x; G[1] = G[1] * dd + a0.y; G[2] = G[2] * dd + a0.z; G[3] = G[3] * dd + a0.w;
          G[4] = G[4] * dd + a1.x; G[5] = G[5] * dd + a1.y; G[6] = G[6] * dd + a1.z; G[7] = G[7] * dd + a1.w;
        }
        g_cached = g; bh_cached = bh;
      }
      const float* lp = p.gds() + ((size_t)chain * NCH + n) * 2048 + sk * 64 + sv0;
      const float4 l0 = *(const float4*)lp, l1 = *(const float4*)(lp + 4);
      const float dp = p.gdv()[((size_t)chain * NCH + n) * 32 + sk];
      const float em = __expf(gl[(sdir * 64 + 31) * 33 + sk]);
      const float sv[8] = {l0.x + dp * G[0], l0.y + dp * G[1], l0.z + dp * G[2], l0.w + dp * G[3], l1.x + dp * G[4], l1.y + dp * G[5], l1.z + dp * G[6], l1.w + dp * G[7]};
#pragma unroll
      for (int j = 0; j < 8; ++j) *(u16*)(ST + (sdir * 64 + sv0 + j) * 80 + sk * 2) = f2bf(sv[j] * em);
    }
    __syncthreads();
    {
      const int d = wid >> 2, ib = (wid >> 1) & 1, vb = wid & 1;
      const char* Qd = Qp + d * 64 * 80; const char* Kd = Kp + d * 64 * 80; const char* Vd = VT + d * 64 * 144; const char* Sd = ST + d * 64 * 80;
      bf16x8 qf[2];
#pragma unroll
      for (int s2 = 0; s2 < 2; ++s2) qf[s2] = *(const bf16x8*)(Qd + (ib * 32 + r32) * 80 + (16 * s2 + 8 * hi) * 2);
#pragma unroll
      for (int jb = 0; jb < 2; ++jb) {
        if (jb <= ib) {
          f32x16 x = {};
#pragma unroll
          for (int s2 = 0; s2 < 2; ++s2) {
            const bf16x8 kf = *(const bf16x8*)(Kd + (jb * 32 + r32) * 80 + (16 * s2 + 8 * hi) * 2);
            x = __builtin_amdgcn_mfma_f32_32x32x16_bf16(qf[s2], kf, x, 0, 0, 0);
          }
#pragma unroll
          for (int r = 0; r < 16; ++r) {
            const int il = crow(r, hi), i = ib * 32 + il, j = jb * 32 + r32;
            *(u16*)(Ax + il * 144 + j * 2) = f2bf(j <= i ? x[r] : 0.f);
          }
        }
      }
      asm volatile("s_waitcnt lgkmcnt(0)" ::: "memory");
      f32x16 o = {};
#pragma unroll
      for (int s4 = 0; s4 < 4; ++s4) {
        if (s4 < 2 * (ib + 1)) {
          const bf16x8 af = *(const bf16x8*)(Ax + r32 * 144 + (16 * s4 + 8 * hi) * 2);
          const bf16x8 vf = *(const bf16x8*)(Vd + (vb * 32 + r32) * 144 + (16 * s4 + 8 * hi) * 2);
          o = __builtin_amdgcn_mfma_f32_32x32x16_bf16(af, vf, o, 0, 0, 0);
        }
      }
#pragma unroll
      for (int s2 = 0; s2 < 2; ++s2) {
        const bf16x8 sf = *(const bf16x8*)(Sd + (vb * 32 + r32) * 80 + (16 * s2 + 8 * hi) * 2);
        o = __builtin_amdgcn_mfma_f32_32x32x16_bf16(qf[s2], sf, o, 0, 0, 0);
      }
#pragma unroll
      for (int r = 0; r < 16; ++r) {
        const int i = ib * 32 + crow(r, hi), pos = d ? 63 - i : i;
        Of[(d * 64 + pos) * 65 + vb * 32 + r32] = o[r];
      }
    }
    __syncthreads();
    {
      const int pos = tid >> 3, v0 = (tid & 7) * 8;
      u16* op = p.glao() + (size_t)(tok0 + pos) * 256 + h * 64 + v0;
      float r8[8];
#pragma unroll
      for (int j = 0; j < 8; ++j) r8[j] = Of[pos * 65 + v0 + j] + Of[(64 + pos) * 65 + v0 + j];
      *(u32x4*)op = u32x4{cvtpk(r8[0], r8[1]), cvtpk(r8[2], r8[3]), cvtpk(r8[4], r8[5]), cvtpk(r8[6], r8[7])};
    }
    __syncthreads();
  }
}

__device__ __forceinline__ void phase_mix(const Params& p, int layer, int bid, int nb, char* lds) {
  float* part = (float*)lds;
  u16* tile = (u16*)(lds + 4096);
  const int tid = ltid(), wid = tid >> 6, lane = tid & 63;
  const int ntok = layer == 0 ? TT : TL;
  for (int it = bid; it < ntok / 64; it += nb) {
    const int tok0 = it * 64;
    float vh[32], vf[32]; float sh = 0, sf = 0;
#pragma unroll
    for (int c = 0; c < 32; ++c) {
      vh[c] = bf2f(p.hyo()[(size_t)(wid * 32 + c) * TT + tok0 + lane]); vf[c] = bf2f(p.fno()[(size_t)(wid * 32 + c) * TT + tok0 + lane]);
      sh += vh[c] * vh[c]; sf += vf[c] * vf[c];
    }
    part[(0 * 8 + wid) * 64 + lane] = sh; part[(1 * 8 + wid) * 64 + lane] = sf;
    __syncthreads();
    float th = 0, tf = 0;
#pragma unroll
    for (int q = 0; q < 8; ++q) { th += part[(0 * 8 + q) * 64 + lane]; tf += part[(1 * 8 + q) * 64 + lane]; }
    const float rh = rsqrtf(th * (1.f / 256.f) + EPS), rf = rsqrtf(tf * (1.f / 256.f) + EPS);
#pragma unroll
    for (int c = 0; c < 32; ++c) { tile[lane * 520 + wid * 32 + c] = f2bf(vh[c] * rh); tile[lane * 520 + 256 + wid * 32 + c] = f2bf(vf[c] * rf); }
    __syncthreads();
    for (int g = tid; g < 64 * 64; g += NTHR) {
      const int tl = g >> 6, cg = g & 63;
      const u32x4 w = *(const u32x4*)(tile + tl * 520 + cg * 8);
      *(u32x4*)(p.ymix() + (size_t)(tok0 + tl) * DM + (cg < 32 ? 256 + cg * 8 : 768 + (cg - 32) * 8)) = w;
    }
    for (int tl = wid * 8; tl < wid * 8 + 8; ++tl) {
      const int tok = tok0 + tl;
      const float4 o = ld4bf(p.glao() + (size_t)tok * 256 + lane * 4);
      float ss = o.x * o.x + o.y * o.y + o.z * o.z + o.w * o.w;
#pragma unroll
      for (int off = 8; off > 0; off >>= 1) ss += __shfl_xor(ss, off, 64);
      const float rs = rsqrtf(ss * (1.f / 64.f) + EPS);
      const float4 g = ld4bf(p.zg() + (size_t)tok * ZG_W + ZG_OG + lane * 4);
      u32x2 w; w[0] = cvtpk(o.x * rs * silu_f(g.x), o.y * rs * silu_f(g.y)); w[1] = cvtpk(o.z * rs * silu_f(g.z), o.w * rs * silu_f(g.w));
      *(u32x2*)(p.ymix() + (size_t)tok * DM + 512 + lane * 4) = w;
    }
    __syncthreads();
  }
}

struct EpiOut {
  const Params* pp; int layer;
  __device__ __forceinline__ void pre(const G8Unit& u, int, int, float (&)[8], float* cb) const {
    if ((ltid() >> 6) == 0) g8_cload(pp->mod() + ((size_t)layer * 3 + modv(u.pm * 256)) * 6144 + 2 * DM + u.pn * 256, cb);
  }
  __device__ __forceinline__ void operator()(const f32x4 (&acc)[2][2][4][2], const G8Unit& u, int wr, int wc, int fr, int fq, const float (&)[8], const float* cb) const {
    const Params& p = *pp;
#pragma unroll
    for (int bj = 0; bj < 2; ++bj) {
      const int c0 = u.pn * 256 + bj * 128 + wc * 32 + 8 * fq;
      const f32x4 ga = *(const f32x4*)(cb + bj * 128 + wc * 32 + 8 * fq), gb = *(const f32x4*)(cb + bj * 128 + wc * 32 + 8 * fq + 4);
#pragma unroll
      for (int ai = 0; ai < 2; ++ai)
#pragma unroll
        for (int m = 0; m < 4; ++m) {
          const int tok = u.pm * 256 + ai * 128 + wr * 64 + m * 16 + fr;
          u16* xo = p.X() + (size_t)tok * DM + c0;
          f32x4 xa, xb;
          if (layer == 0) { const float* xr = resid_row_in(p, tok) + c0; xa = *(const f32x4*)xr; xb = *(const f32x4*)(xr + 4); }
          else { const u32x4 w = *(const u32x4*)xo;
            xa = f32x4{__uint_as_float(w[0] << 16), __uint_as_float(w[0] & 0xFFFF0000u), __uint_as_float(w[1] << 16), __uint_as_float(w[1] & 0xFFFF0000u)};
            xb = f32x4{__uint_as_float(w[2] << 16), __uint_as_float(w[2] & 0xFFFF0000u), __uint_as_float(w[3] << 16), __uint_as_float(w[3] & 0xFFFF0000u)}; }
          xa = xa + ga * acc[ai][bj][m][0]; xb = xb + gb * acc[ai][bj][m][1];
          *(u32x4*)xo = u32x4{cvtpk(xa[0], xa[1]), cvtpk(xa[2], xa[3]), cvtpk(xb[0], xb[1]), cvtpk(xb[2], xb[3])};
        }
    }
  }
};
__device__ __forceinline__ void phase_gemm_out(const Params& p, int layer, int bid, int nb, char* lds) {
  G8Plain S; S.nM = (layer == 0 ? TT : TL) / 256; S.nN = DM / 256; S.Kb = 2 * DM; S.G = nb; S.c = bid; S.Bt = (const char*)(p.bt_out() + (size_t)layer * DM * DM);
  EpiOut E; E.pp = &p; E.layer = layer;
  gemm8_phase<false>(lds, (const char*)p.ymix(), 2 * DM, S, E);
}

__device__ __forceinline__ void phase_norm2_router(const Params& p, int layer, int bid, int nb, char* lds) {
  float* rwl = (float*)lds;
  int* lcnt = (int*)(lds + 131072);
  int* lbase = lcnt + 32;
  int* ent = lbase + 32;
  float* entw = (float*)(ent + 2 * 640);
  float* ents = entw + 640;
  const int tid = ltid(), wid = tid >> 6, lane = tid & 63;
  const int ntok = layer == 0 ? TT : TL;
  const float* rw = p.router_w() + (size_t)layer * DM * NE;
  for (int i = tid; i < DM * NE / 4; i += NTHR) {
    const int k = i >> 3, q4 = i & 7;
    ((float4*)rwl)[q4 * 1024 + ((k & 3) * 256 + (k >> 2))] = ((const float4*)rw)[i];
  }
  if (tid < 32) lcnt[tid] = 0;
  __syncthreads();
  const float* gn = p.norm2_g() + layer * DM; const float* rb = p.router_b() + layer * NE;
  const int per = (ntok + nb - 1) / nb, t_beg = bid * per, t_end = min(ntok, t_beg + per);
  for (int tok = t_beg + wid; tok < t_end; tok += 8) {
    const u16* xr = p.X() + (size_t)tok * DM;
    float v[16];
#pragma unroll
    for (int i = 0; i < 4; ++i) { const float4 a = ld4bf(xr + lane * 4 + i * 256); v[4 * i] = a.x; v[4 * i + 1] = a.y; v[4 * i + 2] = a.z; v[4 * i + 3] = a.w; }
    float ss = 0;
#pragma unroll
    for (int i = 0; i < 16; ++i) ss += v[i] * v[i];
    ss = wave_sum(ss);
    const float rs = rsqrtf(ss * (1.f / DM) + EPS);
    const float* md = p.mod() + ((size_t)layer * 3 + modv(tok)) * 6144 + 3 * DM;
#pragma unroll
    for (int i = 0; i < 4; ++i) {
      const int c = lane * 4 + i * 256;
      const float4 g = *(const float4*)(gn + c), sh = *(const float4*)(md + c), sc = *(const float4*)(md + DM + c);
      v[4 * i] = v[4 * i] * rs * g.x * (1.f + sc.x) + sh.x; v[4 * i + 1] = v[4 * i + 1] * rs * g.y * (1.f + sc.y) + sh.y;
      v[4 * i + 2] = v[4 * i + 2] * rs * g.z * (1.f + sc.z) + sh.z; v[4 * i + 3] = v[4 * i + 3] * rs * g.w * (1.f + sc.w) + sh.w;
    }
    const float rowsc = store_row_i8(v, p.H() + (size_t)tok * DM, p.hs() + tok, lane);
    float lg[32];
#pragma unroll
    for (int e = 0; e < 32; ++e) lg[e] = 0.f;
#pragma unroll
    for (int i = 0; i < 16; ++i) {
      const float4* wr4 = (const float4*)rwl + ((i & 3) * 256 + (i >> 2) * 64 + lane);
#pragma unroll
      for (int q = 0; q < 8; ++q) { const float4 w = wr4[q * 1024]; lg[4 * q] += v[i] * w.x; lg[4 * q + 1] += v[i] * w.y; lg[4 * q + 2] += v[i] * w.z; lg[4 * q + 3] += v[i] * w.w; }
    }
    float r16[16], r8[8], r4[4], r2[2], lv;
    { const bool up = lane & 32;
#pragma unroll
      for (int e = 0; e < 16; ++e) { const float keep = up ? lg[16 + e] : lg[e], send = up ? lg[e] : lg[16 + e]; r16[e] = keep + __shfl_xor(send, 32, 64); } }
    { const bool up = lane & 16;
#pragma unroll
      for (int e = 0; e < 8; ++e) { const float keep = up ? r16[8 + e] : r16[e], send = up ? r16[e] : r16[8 + e]; r8[e] = keep + __shfl_xor(send, 16, 64); } }
    { const bool up = lane & 8;
#pragma unroll
      for (int e = 0; e < 4; ++e) { const float keep = up ? r8[4 + e] : r8[e], send = up ? r8[e] : r8[4 + e]; r4[e] = keep + __shfl_xor(send, 8, 64); } }
    { const bool up = lane & 4;
#pragma unroll
      for (int e = 0; e < 2; ++e) { const float keep = up ? r4[2 + e] : r4[e], send = up ? r4[e] : r4[2 + e]; r2[e] = keep + __shfl_xor(send, 4, 64); } }
    { const bool up = lane & 2; const float keep = up ? r2[1] : r2[0], send = up ? r2[0] : r2[1]; lv = keep + __shfl_xor(send, 2, 64); }
    lv += __shfl_xor(lv, 1, 64);
    lv += rb[lane >> 1];
    int ids[4]; float vals[4];
#pragma unroll
    for (int k = 0; k < 4; ++k) {
      float mx = lv;
#pragma unroll
      for (int o = 32; o > 0; o >>= 1) mx = fmaxf(mx, __shfl_xor(mx, o, 64));
      const unsigned long long bal = __ballot(lv == mx);
      const int win = __ffsll((long long)bal) - 1;
      ids[k] = win >> 1; vals[k] = mx;
      if ((lane >> 1) == ids[k]) lv = -3.4e38f;
    }
    if (lane == 0) {
      const float mx = vals[0];
      float ex[4], sum = 0;
#pragma unroll
      for (int k = 0; k < 4; ++k) { ex[k] = __expf(vals[k] - mx); sum += ex[k]; }
      const float inv = 1.f / sum;
#pragma unroll
      for (int k = 0; k < 4; ++k) {
        const int lp = atomicAdd(&lcnt[ids[k]], 1);
        const int slot = (tok - t_beg) * 4 + k;
        ent[2 * slot] = tok * 4 + k; ent[2 * slot + 1] = (ids[k] << 20) | lp; entw[slot] = ex[k] * inv; ents[slot] = rowsc;
      }
    }
  }
  __syncthreads();
  if (tid < 32) lbase[tid] = atomicAdd(&p.cnt()[layer * NE + tid], lcnt[tid]);
  __syncthreads();
  const int nas = (t_end > t_beg ? (t_end - t_beg) : 0) * 4;
  for (int s = tid; s < nas; s += NTHR) {
    const int tk = ent[2 * s], el = ent[2 * s + 1], e = el >> 20, pos = lbase[e] + (el & 0xFFFFF);
    p.rtok()[(size_t)e * TT + pos] = tk >> 2; p.rw()[(size_t)e * TT + pos] = entw[s]; p.rsc()[(size_t)e * TT + pos] = ents[s];
    p.tslot()[tk] = (e << 20) | pos;
  }
}

struct G8Moe {
  const int* cnt;
  int ntn, Kb, G, c; const char* Bt; size_t bstride;
  const int* rtok;
  __device__ __forceinline__ bool next(int i, G8Unit& u) const {
    const int w = (i * 8 + (c & 7)) * (G >> 3) + (c >> 3); int acc = 0, rows = 0;
    for (int ee = 0; ee < NE; ++ee) {
      const int cc = cnt[ee], tiles = ((cc + 255) >> 8) * ntn;
      if (w < acc + tiles) { const int r = w - acc; u.e = ee; u.pm = r / ntn; u.pn = r % ntn; u.ce = cc; u.pre = rows; return true; }
      acc += tiles; rows += cc;
    }
    return false;
  }
  __device__ __forceinline__ unsigned a_off(const G8Unit& u, int row) const {
    const int r = min(u.pm * 256 + row, u.ce - 1);
    const int arow = rtok ? rtok[(size_t)u.e * TT + r] : u.pre + r;
    return (unsigned)arow * (unsigned)Kb;
  }
  __device__ __forceinline__ const char* b_ptr(const G8Unit& u) const { return Bt + (size_t)u.e * bstride + (size_t)u.pn * 256 * Kb; }
};
struct EpiGu {
  const float* bgl; u16* act; const float* rsc; const float* swl;
  __device__ __forceinline__ void pre(const G8Unit& u, int wr, int fr, float (&ep)[8], float* cb) const {
    if ((ltid() >> 6) == 0) g8_cload(bgl + (size_t)u.e * 2048 + u.pn * 256, cb);
    if ((ltid() >> 6) == 1) g8_cload(swl + (size_t)u.e * 2048 + u.pn * 256, cb + 256);
#pragma unroll
    for (int ai = 0; ai < 2; ++ai)
#pragma unroll
      for (int m = 0; m < 4; ++m) ep[ai * 4 + m] = rsc[(size_t)u.e * TT + min(u.pm * 256 + ai * 128 + wr * 64 + m * 16 + fr, u.ce - 1)];
  }
  __device__ __forceinline__ void operator()(const i32x4 (&acc)[2][2][4][2], const G8Unit& u, int wr, int wc, int fr, int fq, const float (&ep)[8], const float* cb) const {
    const int j0 = u.pn * 128 + wc * 32 + 8 * fq;
    const float* bg = cb + 2 * (wc * 32 + 8 * fq);
    float bgt[8], bup[8], sg[8], su[8];
#pragma unroll
    for (int q = 0; q < 4; ++q) { const f32x4 t = *(const f32x4*)(bg + 4 * q); bgt[2 * q] = t[0]; bup[2 * q] = t[1]; bgt[2 * q + 1] = t[2]; bup[2 * q + 1] = t[3]; }
    {
      const float* sp = cb + 256 + wc * 32 + 8 * fq;
      const f32x4 g0 = *(const f32x4*)sp, g1 = *(const f32x4*)(sp + 4), u0 = *(const f32x4*)(sp + 128), u1 = *(const f32x4*)(sp + 132);
#pragma unroll
      for (int j = 0; j < 4; ++j) { sg[j] = g0[j]; sg[4 + j] = g1[j]; su[j] = u0[j]; su[4 + j] = u1[j]; }
    }
#pragma unroll
    for (int ai = 0; ai < 2; ++ai)
#pragma unroll
      for (int m = 0; m < 4; ++m) {
        const int r = u.pm * 256 + ai * 128 + wr * 64 + m * 16 + fr;
        if (r < u.ce) {
          const float sa = ep[ai * 4 + m];
          float o[8];
#pragma unroll
          for (int n = 0; n < 2; ++n)
#pragma unroll
            for (int j = 0; j < 4; ++j) {
              const float gate = fminf((float)acc[ai][0][m][n][j] * sa * sg[4 * n + j] + bgt[4 * n + j], 7.f);
              const float up = fminf(fmaxf((float)acc[ai][1][m][n][j] * sa * su[4 * n + j] + bup[4 * n + j], -7.f), 7.f);
              o[4 * n + j] = (up + 1.f) * gate * __builtin_amdgcn_rcpf(1.f + __expf(-1.702f * gate));
            }
          *(u32x4*)(act + (size_t)(u.pre + r) * DFF + j0) = u32x4{cvtpk(o[0], o[1]), cvtpk(o[2], o[3]), cvtpk(o[4], o[5]), cvtpk(o[6], o[7])};
        }
      }
  }
};
struct EpiDn {
  const float* bdl; const float* rw; u16* yd;
  __device__ __forceinline__ void pre(const G8Unit& u, int wr, int fr, float (&ep)[8], float* cb) const {
    if ((ltid() >> 6) == 0) g8_cload(bdl + (size_t)u.e * DM + u.pn * 256, cb);
#pragma unroll
    for (int ai = 0; ai < 2; ++ai)
#pragma unroll
      for (int m = 0; m < 4; ++m) ep[ai * 4 + m] = rw[(size_t)u.e * TT + min(u.pm * 256 + ai * 128 + wr * 64 + m * 16 + fr, u.ce - 1)];
  }
  __device__ __forceinline__ void operator()(const f32x4 (&acc)[2][2][4][2], const G8Unit& u, int wr, int wc, int fr, int fq, const float (&ep)[8], const float* cb) const {
#pragma unroll
    for (int bj = 0; bj < 2; ++bj) {
      const int c0 = u.pn * 256 + bj * 128 + wc * 32 + 8 * fq;
      const f32x4 ba = *(const f32x4*)(cb + bj * 128 + wc * 32 + 8 * fq), bb = *(const f32x4*)(cb + bj * 128 + wc * 32 + 8 * fq + 4);
#pragma unroll
      for (int ai = 0; ai < 2; ++ai)
#pragma unroll
        for (int m = 0; m < 4; ++m) {
          const int r = u.pm * 256 + ai * 128 + wr * 64 + m * 16 + fr;
          if (r < u.ce) {
            const float wgt = ep[ai * 4 + m];
            const f32x4 a = (acc[ai][bj][m][0] + ba) * wgt, b = (acc[ai][bj][m][1] + bb) * wgt;
            *(u32x4*)(yd + (size_t)(u.pre + r) * DM + c0) = u32x4{cvtpk(a[0], a[1]), cvtpk(a[2], a[3]), cvtpk(b[0], b[1]), cvtpk(b[2], b[3])};
          }
        }
    }
  }
};
__device__ __forceinline__ void phase_moe_gu(const Params& p, int layer, int bid, int nb, char* lds) {
  int* scnt = (int*)(lds + 131072);
  if (ltid() < NE) scnt[ltid()] = p.cnt()[layer * NE + ltid()];
  __syncthreads();
  G8Moe S; S.cnt = scnt; S.ntn = 8; S.Kb = DM; S.G = nb; S.c = bid; S.Bt = (const char*)(p.bt_gu() + (size_t)layer * NE * 2048 * DM); S.bstride = (size_t)2048 * DM; S.rtok = p.rtok();
  EpiGu E; E.bgl = p.moe_b_gu() + (size_t)layer * NE * 2048; E.act = p.act(); E.rsc = p.rsc(); E.swl = p.swgu() + (size_t)layer * NE * 2048;
  gemm8_phase<true>(lds, (const char*)p.H(), DM, S, E);
}
__device__ __forceinline__ void phase_moe_dn(const Params& p, int layer, int bid, int nb, char* lds) {
  int* scnt = (int*)(lds + 131072);
  if (ltid() < NE) scnt[ltid()] = p.cnt()[layer * NE + ltid()];
  __syncthreads();
  G8Moe S; S.cnt = scnt; S.ntn = 4; S.Kb = 2 * DFF; S.G = nb; S.c = bid; S.Bt = (const char*)(p.bt_dn() + (size_t)layer * NE * DM * DFF); S.bstride = (size_t)DM * DFF * 2; S.rtok = nullptr;
  EpiDn E; E.bdl = p.moe_b_down() + (size_t)layer * NE * DM; E.rw = p.rw(); E.yd = p.yd();
  gemm8_phase<false>(lds, (const char*)p.act(), 2 * DFF, S, E);
}

__device__ __forceinline__ void phase_final(const Params& p, int bid, int nb, char* lds) {
  int* pre = (int*)lds;
  expert_prefix(p.cnt() + NE, pre); __syncthreads();
  const int wid = ltid() >> 6, lane = ltid() & 63;
  for (int tok = bid * 8 + wid; tok < TL; tok += nb * 8) {
    float v[16];
    load_row_comb(p, 1, 1, tok, lane, pre, v);
    float ss = 0;
#pragma unroll
    for (int i = 0; i < 16; ++i) ss += v[i] * v[i];
    ss = wave_sum(ss);
    const float rs = rsqrtf(ss * (1.f / DM) + EPS);
    float* o = p.out() + (size_t)tok * DM;
#pragma unroll
    for (int i = 0; i < 4; ++i) {
      const int c = lane * 4 + i * 256;
      const float4 g = *(const float4*)(p.final_g() + c);
      *(float4*)(o + c) = make_float4(v[4 * i] * rs * g.x, v[4 * i + 1] * rs * g.y, v[4 * i + 2] * rs * g.z, v[4 * i + 3] * rs * g.w);
    }
  }
}

#define XB_TMO      128
#define XB_XCNT(j)  (256  + 64 * (j))
#define XB_XSUB(j)  (1280 + 64 * (j))
#define XB_XGEN(j)  (2304 + 64 * (j))
#define XB_TOP      3328
#define XB_TOPGEN   3392
#define XCD_BAR_WORDS 3456
#define XB_SPIN_CAP (1u << 18)
#define LAS __attribute__((address_space(3)))

__device__ __forceinline__ unsigned xb_ld(unsigned* p)              { return __hip_atomic_load(p, __ATOMIC_RELAXED, __HIP_MEMORY_SCOPE_AGENT); }
__device__ __forceinline__ unsigned xb_add(unsigned* p, unsigned v) { return __hip_atomic_fetch_add(p, v, __ATOMIC_RELAXED, __HIP_MEMORY_SCOPE_AGENT); }
__device__ __forceinline__ unsigned xb_xcc_id() { return (unsigned)__builtin_amdgcn_s_getreg((3 << 11) | 20) & 0xFu; }
#define XB_SPIN(cond, bar) do { unsigned _sp = 0; while (cond) { __builtin_amdgcn_s_sleep(1); \
    if ((++_sp & 255u) == 0u) { if (xb_ld(&(bar)[XB_TMO])) break; if (_sp > XB_SPIN_CAP) { atomicAdd(&(bar)[XB_TMO], 1u); break; } } } } while (0)

struct XcdBarrier {
    unsigned* bar; unsigned x;
    volatile LAS unsigned* st;
};

__device__ __forceinline__ XcdBarrier xcd_barrier_post(unsigned* bar, volatile LAS unsigned* st) {
    XcdBarrier b; b.bar = bar; b.x = xb_xcc_id(); b.st = st;
    if (threadIdx.x == 0) (void)xb_add(&bar[XB_XCNT(b.x)], 1u);
    return b;
}
__device__ __forceinline__ void xcd_barrier_complete(unsigned* bar, unsigned x, unsigned& nloc, unsigned& nx) {
    const unsigned G = gridDim.x * gridDim.y * gridDim.z;
    unsigned sum, cnt, mine, sp = 0u;
    for (;;) {
        sum = 0u; cnt = 0u; mine = 0u;
#pragma unroll
        for (unsigned j = 0; j < 16; ++j) { const unsigned c = xb_ld(&bar[XB_XCNT(j)]); sum += c; cnt += (c > 0u) ? 1u : 0u; mine = (j == x) ? c : mine; }
        if (sum == G) break;
        __builtin_amdgcn_s_sleep(1);
        if ((++sp & 255u) == 0u) { if (xb_ld(&bar[XB_TMO])) break; if (sp > XB_SPIN_CAP) { atomicAdd(&bar[XB_TMO], 1u); break; } }
    }
    nloc = mine > 0u ? mine : 1u; nx = cnt > 0u ? cnt : 1u;
}

__device__ __forceinline__ void xcd_barrier(const XcdBarrier& b) {
    asm volatile("s_waitcnt vmcnt(0)" ::: "memory");
    __syncthreads();
    if (threadIdx.x == 0) {
        unsigned* bar = b.bar;
        __builtin_amdgcn_s_waitcnt(0);
        unsigned nloc = b.st[0], nx = b.st[1];
        if (nloc == 0u) { xcd_barrier_complete(bar, b.x, nloc, nx); b.st[0] = nloc; b.st[1] = nx; }
        const unsigned old = xb_add(&bar[XB_XSUB(b.x)], 1u);
        const unsigned gen = old / nloc;
        if (old + 1u == (gen + 1u) * nloc) {
            __builtin_amdgcn_fence(__ATOMIC_RELEASE, "agent");
            asm volatile("s_waitcnt vmcnt(0)" ::: "memory");
            const unsigned og = xb_add(&bar[XB_TOP], 1u);
            const unsigned tg = og / nx;
            if (og + 1u == (tg + 1u) * nx) xb_add(&bar[XB_TOPGEN], 1u);
            else XB_SPIN(xb_ld(&bar[XB_TOPGEN]) == tg, bar);
            __builtin_amdgcn_fence(__ATOMIC_ACQUIRE, "agent");
            xb_add(&bar[XB_XGEN(b.x)], 1u);
            asm volatile("s_waitcnt vmcnt(0)" ::: "memory");
        } else {
            XB_SPIN(xb_ld(&bar[XB_XGEN(b.x)]) == gen, bar);
            __builtin_amdgcn_fence(__ATOMIC_ACQUIRE, "agent");
            asm volatile("s_waitcnt vmcnt(0)" ::: "memory");
        }
    }
    __syncthreads();
}

constexpr int LDS_MAIN = 147456;
constexpr int LDS_BYTES = LDS_MAIN + 1024;
enum { PH_TABLES = 0, PH_MOD, PH_FOLD, PH_CONVERT, PH_HYMLP, PH_HYFILT, PH_NORM1, PH_GEMM_IN, PH_QKV, PH_ATTN, PH_FFTMIX,
       PH_GLA_A, PH_GLA_B, PH_GLA_C, PH_MIX, PH_GEMM_OUT, PH_NORM2, PH_MOE_GU, PH_MOE_DN, PH_FINAL };

__device__ __forceinline__ Params make_params() {
  const __attribute__((address_space(4))) char* kb = (const __attribute__((address_space(4))) char*)__builtin_amdgcn_kernarg_segment_ptr();
  asm volatile("" : "+s"(kb));
  Params p; p.kb = kb; return p;
}
#ifndef MK_LAUNCHES
#define MK_LAUNCHES 1
#endif
__global__ void __launch_bounds__(NTHR, 2) k_mega(ParamsData pd) {
  extern __shared__ __attribute__((aligned(1024))) char lds[];
  const int bid = blockIdx.x, nb = gridDim.x;
  if (threadIdx.x == 0) *(uint4*)(lds + LDS_MAIN) = make_uint4(0u, 0u, 0u, 0u);
  __syncthreads();
  XcdBarrier bar = xcd_barrier_post(make_params().bar(), (volatile LAS unsigned*)(lds + LDS_MAIN));
#ifndef DBLMASK
#define DBLMASK 0u
#endif
#define RUNPH(bit, call) do { call; if (DBLMASK & (1u << (bit))) { __syncthreads(); call; } } while (0)
  RUNPH(13, phase_tables(make_params(), bid, nb); phase_mod(make_params(), bid, nb, lds); phase_fold(make_params(), bid, nb, lds));
  RUNPH(0, phase_convert(make_params(), bid, nb, lds));
  phase_hy_mlp(make_params(), 0, SEQ, make_params().hfb(), make_params().hpart(), bid, nb, lds);
  phase_hy_mlp(make_params(), 1, SEQ, make_params().hfb() + (size_t)2 * 256 * SEQ, make_params().hpart() + 256 * 512, bid, nb, lds);
  phase_hy_mlp(make_params(), 0, LC, make_params().hfc(), make_params().hpart() + 2 * 256 * 512, bid, nb, lds);
  xcd_barrier(bar);
  RUNPH(2, phase_hy_filtfft(make_params(), bid, nb, lds));
  phase_quant_in(make_params(), bid, nb);
#define MK_LAYER(l) do { \
  phase_norm1(make_params(), l, bid, nb, lds); if ((DBLMASK & (1u << 14)) && l == 0) { __syncthreads(); phase_norm1(make_params(), l, bid, nb, lds); } \
  xcd_barrier(bar); \
  RUNPH(3, phase_gemm_in(make_params(), l, bid, nb, lds)); \
  xcd_barrier(bar); \
  RUNPH(4, phase_qkv(make_params(), l, bid, nb, lds)); \
  RUNPH(5, phase_gla_a(make_params(), l, bid, nb, lds)); \
  xcd_barrier(bar); \
  RUNPH(6, phase_attn(make_params(), l, bid, nb, lds)); \
  RUNPH(7, phase_fftmix(make_params(), l, bid, nb, lds)); \
  RUNPH(9, phase_gla_c(make_params(), l, bid, nb, lds)); \
  xcd_barrier(bar); \
  RUNPH(10, phase_mix(make_params(), l, bid, nb, lds)); \
  xcd_barrier(bar); \
  phase_gemm_out(make_params(), l, bid, nb, lds); if ((DBLMASK & (1u << 16)) && l == 0) { __syncthreads(); phase_gemm_out(make_params(), l, bid, nb, lds); } \
  xcd_barrier(bar); \
  phase_norm2_router(make_params(), l, bid, nb, lds); \
  xcd_barrier(bar); \
  RUNPH(11, phase_moe_gu(make_params(), l, bid, nb, lds)); \
  xcd_barrier(bar); \
  RUNPH(12, phase_moe_dn(make_params(), l, bid, nb, lds)); \
  xcd_barrier(bar); \
  } while (0)
  MK_LAYER(0);
  MK_LAYER(1);
#undef MK_LAYER
  RUNPH(15, phase_final(make_params(), bid, nb, lds));
}
static size_t carve(char*& cur, size_t bytes) { char* r = cur; cur += (bytes + 1023) & ~(size_t)1023; return (size_t)(uintptr_t)r; }
#define CARVE(T, field, n) p.field = (T*)carve(cur, (size_t)(n) * sizeof(T))

extern "C" void kernel_launch(void* const* d_in, const int* in_sizes, int n_in, void* d_out, int out_size, void* d_ws, size_t ws_size, hipStream_t stream) {
  ParamsData p; memset(&p, 0, sizeof(p));
  const float** ins = (const float**)&p;
  for (int i = 0; i < 34; ++i) ins[i] = (const float*)d_in[i];
  p.out_ = (float*)d_out;
  p.ws_ = (char*)d_ws;
  if (WS_TOTAL > ws_size) { fprintf(stderr, "workspace too small: need %zu have %zu\n", (size_t)WS_TOTAL, ws_size); return; }
  hipMemsetAsync((char*)d_ws + OFF_bar, 0, OFF_mod - OFF_bar, stream);
  static int grid = 0;
  if (!grid) {
    int dev = 0, cus = 0, per_cu = 0;
    hipGetDevice(&dev);
    hipDeviceGetAttribute(&cus, hipDeviceAttributeMultiprocessorCount, dev);
    hipFuncSetAttribute((const void*)k_mega, hipFuncAttributeMaxDynamicSharedMemorySize, LDS_BYTES);
    hipOccupancyMaxActiveBlocksPerMultiprocessor(&per_cu, (const void*)k_mega, NTHR, LDS_BYTES);
    grid = cus * (per_cu < 1 ? per_cu : 1);
    if (grid != 256) fprintf(stderr, "unexpected grid %d (cus %d per_cu %d)\n", grid, cus, per_cu);
  }
  hipLaunchKernelGGL(k_mega, dim3(grid), dim3(NTHR), LDS_BYTES, stream, p);
}
```

```cpp
#include <hip/hip_runtime.h>
#include <hip/hip_bf16.h>
#include <cstdio>
#include <cstdint>
#include <cstring>
#include <cstddef>
#include <type_traits>

typedef unsigned short u16;
using bf16x8 = __attribute__((ext_vector_type(8))) short;
using s16x4  = __attribute__((ext_vector_type(4))) short;
using f32x4  = __attribute__((ext_vector_type(4))) float;
using f32x16 = __attribute__((ext_vector_type(16))) float;
using u32x4  = __attribute__((ext_vector_type(4))) unsigned;
using u32x2  = __attribute__((ext_vector_type(2))) unsigned;

constexpr int DM = 1024, NB = 2, SEQ = 16384, LC = 256;
constexpr int TL = NB * SEQ;
constexpr int TC = NB * LC;
constexpr int TT = TL + TC;
constexpr int NIN = 2816;
constexpr int DIN0 = 2240;
constexpr int NE = 32, TOPK = 4, DFF = 1024;
constexpr int SKV = SEQ + LC;
constexpr int NTHR = 512;
constexpr float EPS = 1e-6f;
constexpr float A_SCALE = 0.10206207261596575f;
constexpr float A_QSCALE = A_SCALE * 1.4426950408889634f;
constexpr int ZG_W = 1152, ZG_GQ = 0, ZG_GK = 128, ZG_KR = 256, ZG_GV = 384, ZG_GP = 640, ZG_OG = 896;
constexpr int ZT_HY = 0, ZT_FR = 768, ZT_FI = 1024, ZT_R = 1280;
constexpr int NCH = 260;
constexpr int FM = 16384;
constexpr int HSP = FM / 2 + 1;

constexpr size_t ws_al(size_t b) { return (b + 1023) & ~(size_t)1023; }
constexpr size_t OFF_bar = 0;
constexpr size_t OFF_cnt = OFF_bar + ws_al((size_t)(4096) * sizeof(unsigned));
constexpr size_t OFF_hssq = OFF_cnt + ws_al((size_t)(64) * sizeof(int));
constexpr size_t OFF_kmx = OFF_hssq + ws_al((size_t)(768) * sizeof(float));
constexpr size_t OFF_mod = OFF_kmx + ws_al((size_t)(128) * sizeof(unsigned));
constexpr size_t OFF_ropec = OFF_mod + ws_al((size_t)(2 * 3 * 6144) * sizeof(float));
constexpr size_t OFF_ropes = OFF_ropec + ws_al((size_t)(SEQ * 16) * sizeof(float));
constexpr size_t OFF_tw = OFF_ropes + ws_al((size_t)(SEQ * 16) * sizeof(float));
constexpr size_t OFF_bt_in = OFF_tw + ws_al((size_t)(FM) * sizeof(float2));
constexpr size_t OFF_bt_qkv = OFF_bt_in + ws_al((size_t)((size_t)2 * NIN * DM) * sizeof(u16));
constexpr size_t OFF_bt_out = OFF_bt_qkv + ws_al((size_t)(2 * 1024 * 384) * sizeof(u16));
constexpr size_t OFF_bt_gu = OFF_bt_out + ws_al((size_t)((size_t)2 * DM * DM) * sizeof(u16));
constexpr size_t OFF_bt_dn = OFF_bt_gu + ws_al((size_t)((size_t)2 * NE * 2048 * DM) * sizeof(u16));
constexpr size_t OFF_hfb = OFF_bt_dn + ws_al((size_t)((size_t)2 * NE * DM * DFF) * sizeof(u16));
constexpr size_t OFF_hfc = OFF_hfb + ws_al((size_t)((size_t)2 * 2 * 256 * SEQ) * sizeof(float));
constexpr size_t OFF_hspec = OFF_hfc + ws_al((size_t)(2 * 256 * LC) * sizeof(float));
constexpr size_t OFF_H = OFF_hspec + ws_al((size_t)((size_t)2 * 256 * HSP) * sizeof(float4));
constexpr size_t OFF_zqkv = OFF_H + ws_al((size_t)((size_t)TT * DM) * sizeof(u16));
constexpr size_t OFF_zg = OFF_zqkv + ws_al((size_t)((size_t)TT * 384) * sizeof(u16));
constexpr size_t OFF_zt = OFF_zg + ws_al((size_t)((size_t)TT * ZG_W) * sizeof(float));
constexpr size_t OFF_Q = OFF_zt + ws_al((size_t)((size_t)ZT_R * TT) * sizeof(float));
constexpr size_t OFF_KV = OFF_Q + ws_al((size_t)((size_t)2 * 4 * SKV * 96) * sizeof(u16));
constexpr size_t OFF_ymix = OFF_KV + ws_al((size_t)((size_t)2 * 4 * SKV * 160) * sizeof(u16));
constexpr size_t OFF_hyo = OFF_ymix + ws_al((size_t)((size_t)TT * DM) * sizeof(u16));
constexpr size_t OFF_fno = OFF_hyo + ws_al((size_t)((size_t)256 * TT) * sizeof(float));
constexpr size_t OFF_glao = OFF_fno + ws_al((size_t)((size_t)256 * TT) * sizeof(float));
constexpr size_t OFF_gds = OFF_glao + ws_al((size_t)((size_t)TT * 256) * sizeof(float));
constexpr size_t OFF_gdv = OFF_gds + ws_al((size_t)((size_t)16 * NCH * 2048) * sizeof(float));
constexpr size_t OFF_gst = OFF_gdv + ws_al((size_t)((size_t)16 * NCH * 32) * sizeof(float));
constexpr size_t OFF_X = OFF_gst + ws_al((size_t)((size_t)16 * NCH * 2048) * sizeof(float));
constexpr size_t OFF_rtok = OFF_X + ws_al((size_t)((size_t)TT * DM) * sizeof(float));
constexpr size_t OFF_rw = OFF_rtok + ws_al((size_t)((size_t)NE * TT) * sizeof(int));
constexpr size_t OFF_tslot = OFF_rw + ws_al((size_t)((size_t)NE * TT) * sizeof(float));
constexpr size_t OFF_act = OFF_tslot + ws_al((size_t)((size_t)TT * 4) * sizeof(int));
constexpr size_t OFF_yd = OFF_act + ws_al((size_t)((size_t)TT * 4 * DFF) * sizeof(u16));
constexpr size_t OFF_swin = OFF_yd + ws_al((size_t)((size_t)TT * 4 * DM) * sizeof(u16));
constexpr size_t OFF_swgu = OFF_swin + ws_al((size_t)(2 * NIN) * sizeof(float));
constexpr size_t OFF_hs = OFF_swgu + ws_al((size_t)(2 * NE * 2048) * sizeof(float));
constexpr size_t OFF_hpart = OFF_hs + ws_al((size_t)(TT) * sizeof(float));
constexpr size_t OFF_rsc = OFF_hpart + ws_al((size_t)(3 * 256 * 512) * sizeof(float));
constexpr size_t WS_TOTAL = OFF_rsc + ws_al((size_t)((size_t)NE * TT) * sizeof(float));
struct ParamsData {
  const float *x_, *c_, *ctx_, *c_ctx_, *ada_w_, *ada_b_, *norm1_g_, *norm2_g_, *w_in_, *mla_q_g_, *mla_w_uq_, *mla_kv_g_, *mla_w_ukv_, *hy_conv_w_, *hy_conv_b_, *hy_w1_, *hy_b1_, *hy_w2_, *hy_b2_, *hy_w3_, *hy_freq_, *hy_bias_, *gla_gk_w_, *gla_gk_b_, *fnet_w_, *mix_g_, *w_out_, *router_w_, *router_b_, *moe_w_gu_, *moe_b_gu_, *moe_w_down_, *moe_b_down_, *final_g_;
  float* out_;
  char* ws_;
};
struct Params {
  const __attribute__((address_space(4))) char* kb;
  template <class T> __device__ __forceinline__ T karg(size_t off) const { return *(const __attribute__((address_space(4))) T*)(kb + off); }
  __device__ __forceinline__ const float* x() const { return karg<const float*>(offsetof(ParamsData, x_)); }
  __device__ __forceinline__ const float* c() const { return karg<const float*>(offsetof(ParamsData, c_)); }
  __device__ __forceinline__ const float* ctx() const { return karg<const float*>(offsetof(ParamsData, ctx_)); }
  __device__ __forceinline__ const float* c_ctx() const { return karg<const float*>(offsetof(ParamsData, c_ctx_)); }
  __device__ __forceinline__ const float* ada_w() const { return karg<const float*>(offsetof(ParamsData, ada_w_)); }
  __device__ __forceinline__ const float* ada_b() const { return karg<const float*>(offsetof(ParamsData, ada_b_)); }
  __device__ __forceinline__ const float* norm1_g() const { return karg<const float*>(offsetof(ParamsData, norm1_g_)); }
  __device__ __forceinline__ const float* norm2_g() const { return karg<const float*>(offsetof(ParamsData, norm2_g_)); }
  __device__ __forceinline__ const float* w_in() const { return karg<const float*>(offsetof(ParamsData, w_in_)); }
  __device__ __forceinline__ const float* mla_q_g() const { return karg<const float*>(offsetof(ParamsData, mla_q_g_)); }
  __device__ __forceinline__ const float* mla_w_uq() const { return karg<const float*>(offsetof(ParamsData, mla_w_uq_)); }
  __device__ __forceinline__ const float* mla_kv_g() const { return karg<const float*>(offsetof(ParamsData, mla_kv_g_)); }
  __device__ __forceinline__ const float* mla_w_ukv() const { return karg<const float*>(offsetof(ParamsData, mla_w_ukv_)); }
  __device__ __forceinline__ const float* hy_conv_w() const { return karg<const float*>(offsetof(ParamsData, hy_conv_w_)); }
  __device__ __forceinline__ const float* hy_conv_b() const { return karg<const float*>(offsetof(ParamsData, hy_conv_b_)); }
  __device__ __forceinline__ const float* hy_w1() const { return karg<const float*>(offsetof(ParamsData, hy_w1_)); }
  __device__ __forceinline__ const float* hy_b1() const { return karg<const float*>(offsetof(ParamsData, hy_b1_)); }
  __device__ __forceinline__ const float* hy_w2() const { return karg<const float*>(offsetof(ParamsData, hy_w2_)); }
  __device__ __forceinline__ const float* hy_b2() const { return karg<const float*>(offsetof(ParamsData, hy_b2_)); }
  __device__ __forceinline__ const float* hy_w3() const { return karg<const float*>(offsetof(ParamsData, hy_w3_)); }
  __device__ __forceinline__ const float* hy_freq() const { return karg<const float*>(offsetof(ParamsData, hy_freq_)); }
  __device__ __forceinline__ const float* hy_bias() const { return karg<const float*>(offsetof(ParamsData, hy_bias_)); }
  __device__ __forceinline__ const float* gla_gk_w() const { return karg<const float*>(offsetof(ParamsData, gla_gk_w_)); }
  __device__ __forceinline__ const float* gla_gk_b() const { return karg<const float*>(offsetof(ParamsData, gla_gk_b_)); }
  __device__ __forceinline__ const float* fnet_w() const { return karg<const float*>(offsetof(ParamsData, fnet_w_)); }
  __device__ __forceinline__ const float* mix_g() const { return karg<const float*>(offsetof(ParamsData, mix_g_)); }
  __device__ __forceinline__ const float* w_out() const { return karg<const float*>(offsetof(ParamsData, w_out_)); }
  __device__ __forceinline__ const float* router_w() const { return karg<const float*>(offsetof(ParamsData, router_w_)); }
  __device__ __forceinline__ const float* router_b() const { return karg<const float*>(offsetof(ParamsData, router_b_)); }
  __device__ __forceinline__ const float* moe_w_gu() const { return karg<const float*>(offsetof(ParamsData, moe_w_gu_)); }
  __device__ __forceinline__ const float* moe_b_gu() const { return karg<const float*>(offsetof(ParamsData, moe_b_gu_)); }
  __device__ __forceinline__ const float* moe_w_down() const { return karg<const float*>(offsetof(ParamsData, moe_w_down_)); }
  __device__ __forceinline__ const float* moe_b_down() const { return karg<const float*>(offsetof(ParamsData, moe_b_down_)); }
  __device__ __forceinline__ const float* final_g() const { return karg<const float*>(offsetof(ParamsData, final_g_)); }
  __device__ __forceinline__ float* out() const { return karg<float*>(offsetof(ParamsData, out_)); }
  __device__ __forceinline__ char* ws() const { return karg<char*>(offsetof(ParamsData, ws_)); }
  __device__ __forceinline__ unsigned* bar() const { return (unsigned*)(ws() + OFF_bar); }
  __device__ __forceinline__ int* cnt() const { return (int*)(ws() + OFF_cnt); }
  __device__ __forceinline__ float* hssq() const { return (float*)(ws() + OFF_hssq); }
  __device__ __forceinline__ unsigned* kmx() const { return (unsigned*)(ws() + OFF_kmx); }
  __device__ __forceinline__ float* mod() const { return (float*)(ws() + OFF_mod); }
  __device__ __forceinline__ float* ropec() const { return (float*)(ws() + OFF_ropec); }
  __device__ __forceinline__ float* ropes() const { return (float*)(ws() + OFF_ropes); }
  __device__ __forceinline__ float2* tw() const { return (float2*)(ws() + OFF_tw); }
  __device__ __forceinline__ signed char* bt_in() const { return (signed char*)(ws() + OFF_bt_in); }
  __device__ __forceinline__ u16* bt_qkv() const { return (u16*)(ws() + OFF_bt_qkv); }
  __device__ __forceinline__ u16* bt_out() const { return (u16*)(ws() + OFF_bt_out); }
  __device__ __forceinline__ signed char* bt_gu() const { return (signed char*)(ws() + OFF_bt_gu); }
  __device__ __forceinline__ u16* bt_dn() const { return (u16*)(ws() + OFF_bt_dn); }
  __device__ __forceinline__ float* hfb() const { return (float*)(ws() + OFF_hfb); }
  __device__ __forceinline__ float* hfc() const { return (float*)(ws() + OFF_hfc); }
  __device__ __forceinline__ float4* hspec() const { return (float4*)(ws() + OFF_hspec); }
  __device__ __forceinline__ signed char* H() const { return (signed char*)(ws() + OFF_H); }
  __device__ __forceinline__ float* hs() const { return (float*)(ws() + OFF_hs); }
  __device__ __forceinline__ float* rsc() const { return (float*)(ws() + OFF_rsc); }
  __device__ __forceinline__ float* hpart() const { return (float*)(ws() + OFF_hpart); }
  __device__ __forceinline__ float* swin() const { return (float*)(ws() + OFF_swin); }
  __device__ __forceinline__ float* swgu() const { return (float*)(ws() + OFF_swgu); }
  __device__ __forceinline__ float* btf() const { return (float*)(ws() + OFF_act); }
  __device__ __forceinline__ u16* zqkv() const { return (u16*)(ws() + OFF_zqkv); }
  __device__ __forceinline__ u16* zg() const { return (u16*)(ws() + OFF_zg); }
  __device__ __forceinline__ u16* zt() const { return (u16*)(ws() + OFF_zt); }
  __device__ __forceinline__ u16* Q() const { return (u16*)(ws() + OFF_Q); }
  __device__ __forceinline__ u16* KV() const { return (u16*)(ws() + OFF_KV); }
  __device__ __forceinline__ u16* ymix() const { return (u16*)(ws() + OFF_ymix); }
  __device__ __forceinline__ u16* hyo() const { return (u16*)(ws() + OFF_hyo); }
  __device__ __forceinline__ u16* fno() const { return (u16*)(ws() + OFF_fno); }
  __device__ __forceinline__ u16* glao() const { return (u16*)(ws() + OFF_glao); }
  __device__ __forceinline__ float* gds() const { return (float*)(ws() + OFF_gds); }
  __device__ __forceinline__ float* gdv() const { return (float*)(ws() + OFF_gdv); }
  __device__ __forceinline__ float* gst() const { return (float*)(ws() + OFF_gst); }
  __device__ __forceinline__ u16* X() const { return (u16*)(ws() + OFF_X); }
  __device__ __forceinline__ int* rtok() const { return (int*)(ws() + OFF_rtok); }
  __device__ __forceinline__ float* rw() const { return (float*)(ws() + OFF_rw); }
  __device__ __forceinline__ int* tslot() const { return (int*)(ws() + OFF_tslot); }
  __device__ __forceinline__ u16* act() const { return (u16*)(ws() + OFF_act); }
  __device__ __forceinline__ u16* yd() const { return (u16*)(ws() + OFF_yd); }
};


__device__ __forceinline__ u16 f2bf(float f) {
  unsigned u = __float_as_uint(f); u += 0x7FFFu + ((u >> 16) & 1u); return (u16)(u >> 16);
}
__device__ __forceinline__ float bf2f(u16 h) { return __uint_as_float(((unsigned)h) << 16); }
__device__ __forceinline__ unsigned cvtpk(float lo, float hi) {
  unsigned r; asm volatile("v_cvt_pk_bf16_f32 %0, %1, %2" : "=v"(r) : "v"(lo), "v"(hi)); return r;
}
__device__ __forceinline__ float4 ld4bf(const u16* p) { const u32x2 w = *(const u32x2*)p; return make_float4(__uint_as_float(w[0] << 16), __uint_as_float(w[0] & 0xFFFF0000u), __uint_as_float(w[1] << 16), __uint_as_float(w[1] & 0xFFFF0000u)); }
__device__ __forceinline__ float wave_sum(float v) {
#pragma unroll
  for (int o = 32; o > 0; o >>= 1) v += __shfl_xor(v, o, 64);
  return v;
}
__device__ __forceinline__ int ltid() { int t = threadIdx.x; asm volatile("" : "+v"(t)); return t; }
__device__ __forceinline__ float silu_f(float x) { return x / (1.f + __expf(-x)); }
__device__ __forceinline__ float2 cmul(float2 a, float2 b) { return make_float2(a.x * b.x - a.y * b.y, a.x * b.y + a.y * b.x); }
__device__ __forceinline__ float2 cmulc(float2 a, float2 b) { return make_float2(a.x * b.x + a.y * b.y, a.y * b.x - a.x * b.y); }
__device__ __forceinline__ int modv(int tok) { return tok < TL ? (tok >> 14) : 2; }
__device__ __forceinline__ void phase_tables(const Params& p, int bid, int nb) {
  const int gt = bid * NTHR + ltid(), gs = nb * NTHR;
  for (int i = gt; i < SEQ * 16; i += gs) {
    const int t = i >> 4, f = i & 15;
    const float pos = (f < 8) ? (float)(t >> 6) : (float)(t & 63);
    const float inv = powf(10000.f, -(float)(f & 7) / 8.f);
    float s, c; sincosf(pos * inv, &s, &c);
    p.ropec()[i] = c; p.ropes()[i] = s;
  }
  for (int i = gt; i < FM; i += gs) {
    float s, c; sincospif((float)i / 8192.f, &s, &c);
    p.tw()[i] = make_float2(c, -s);
  }
}

__device__ __forceinline__ void phase_mod(const Params& p, int bid, int nb, char* lds) {
  float* red = (float*)lds;
  const int tid = ltid(), part = tid >> 6, cl = tid & 63;
  for (int it = bid; it < 2 * 96; it += nb) {
    const int l = it / 96, n = (it % 96) * 64 + cl;
    const float* W = p.ada_w() + (size_t)l * DM * 6144;
    float a0 = 0, a1 = 0, a2 = 0;
    for (int k = part * 128; k < part * 128 + 128; ++k) {
      const float w = W[(size_t)k * 6144 + n];
      a0 += silu_f(p.c()[k]) * w; a1 += silu_f(p.c()[DM + k]) * w; a2 += silu_f(p.c_ctx()[k]) * w;
    }
    red[(part * 3 + 0) * 64 + cl] = a0; red[(part * 3 + 1) * 64 + cl] = a1; red[(part * 3 + 2) * 64 + cl] = a2;
    __syncthreads();
    if (tid < 192) {
      const int v = tid >> 6; float s = 0;
      for (int q = 0; q < 8; ++q) s += red[(q * 3 + v) * 64 + cl];
      p.mod()[((size_t)l * 3 + v) * 6144 + n] = s + p.ada_b()[(size_t)l * 6144 + n];
    }
    __syncthreads();
  }
}

__device__ __forceinline__ void phase_fold(const Params& p, int bid, int nb, char* lds) {
  float* wrow = (float*)lds;
  float* dre = wrow + 2048;
  float* dim_ = dre + 2048;
  float* glr = dim_ + 2048;
  float* cst = glr + 256;
  float* snt = cst + 256;
  const int tid = ltid();
  if (tid < 256) { float sn, cs; sincospif((float)tid / 128.f, &sn, &cs); cst[tid] = cs; snt[tid] = sn; }
  __syncthreads();
  for (int it = bid; it < 2 * DM / 8; it += nb) {
    const int l = it >> 7, k0 = (it & 127) * 8;
    for (int i = tid; i < 8 * 256; i += NTHR) { const int r = i >> 8, c = i & 255; wrow[c * 8 + r] = p.w_in()[((size_t)l * DM + k0 + r) * DIN0 + 1984 + c]; }
    if (tid < 256) { const int r = tid >> 5, c = tid & 31; glr[c * 8 + r] = p.w_in()[((size_t)l * DM + k0 + r) * DIN0 + 1696 + c]; }
    __syncthreads();
    {
      const int kp = tid & 255; const bool im = tid >= 256;
      float acc[8] = {0.f, 0.f, 0.f, 0.f, 0.f, 0.f, 0.f, 0.f};
#pragma unroll 4
      for (int c = 0; c < 256; ++c) {
        const int m = (c * kp) & 255; const float t = im ? -snt[m] : cst[m];
        const float4 w0 = *(const float4*)(wrow + c * 8), w1 = *(const float4*)(wrow + c * 8 + 4);
        acc[0] += w0.x * t; acc[1] += w0.y * t; acc[2] += w0.z * t; acc[3] += w0.w * t; acc[4] += w1.x * t; acc[5] += w1.y * t; acc[6] += w1.z * t; acc[7] += w1.w * t;
      }
      float* d = (im ? dim_ : dre) + kp * 8;
      *(float4*)d = make_float4(acc[0], acc[1], acc[2], acc[3]); *(float4*)(d + 4) = make_float4(acc[4], acc[5], acc[6], acc[7]);
    }
    __syncthreads();
    {
      const int j = tid & 255; const bool im = tid >= 256;
      const float* Wf = p.fnet_w() + (size_t)l * 65536 + j;
      const float* d = im ? dim_ : dre;
      float acc[8] = {0.f, 0.f, 0.f, 0.f, 0.f, 0.f, 0.f, 0.f};
#pragma unroll 8
      for (int kp = 0; kp < 256; ++kp) {
        const float w = Wf[kp * 256];
        const float4 d0 = *(const float4*)(d + kp * 8), d1 = *(const float4*)(d + kp * 8 + 4);
        acc[0] += d0.x * w; acc[1] += d0.y * w; acc[2] += d0.z * w; acc[3] += d0.w * w; acc[4] += d1.x * w; acc[5] += d1.y * w; acc[6] += d1.z * w; acc[7] += d1.w * w;
      }
      float* o = p.btf() + ((size_t)l * NIN + (im ? 2560 : 2304) + j) * DM + k0;
      *(float4*)o = make_float4(acc[0] * 0.0625f, acc[1] * 0.0625f, acc[2] * 0.0625f, acc[3] * 0.0625f);
      *(float4*)(o + 4) = make_float4(acc[4] * 0.0625f, acc[5] * 0.0625f, acc[6] * 0.0625f, acc[7] * 0.0625f);
    }
    if (tid < 256) {
      const int dir = tid >> 7, kk = tid & 127;
      const float* gw = p.gla_gk_w() + ((size_t)l * 2 + dir) * 16 * 128 + kk;
      float acc[8] = {0.f, 0.f, 0.f, 0.f, 0.f, 0.f, 0.f, 0.f};
#pragma unroll
      for (int r16 = 0; r16 < 16; ++r16) {
        const float w = gw[r16 * 128];
        const float4 g0 = *(const float4*)(glr + (dir * 16 + r16) * 8), g1 = *(const float4*)(glr + (dir * 16 + r16) * 8 + 4);
        acc[0] += g0.x * w; acc[1] += g0.y * w; acc[2] += g0.z * w; acc[3] += g0.w * w; acc[4] += g1.x * w; acc[5] += g1.y * w; acc[6] += g1.z * w; acc[7] += g1.w * w;
      }
      float* o = p.btf() + ((size_t)l * NIN + 1024 + tid) * DM + k0;
      *(float4*)o = make_float4(acc[0], acc[1], acc[2], acc[3]); *(float4*)(o + 4) = make_float4(acc[4], acc[5], acc[6], acc[7]);
    }
    __syncthreads();
  }
}

enum { MAP_ID = 0, MAP_IN = 1, MAP_UQ = 2, MAP_UKV = 3, MAP_GU = 4 };
__device__ __forceinline__ int colmap(int mt, int n) {
  switch (mt) {
    case MAP_ID: return n;
    case MAP_IN:
      if (n < 256) return n;
      if (n < 384) return 256 + (n - 256);
      if (n < 512) return 1184 + (n - 384);
      if (n < 640) return 1312 + (n - 512);
      if (n < 672) return 384 + (n - 640);
      if (n < 768) return -1;
      if (n < 1024) return 1440 + (n - 768);
      if (n < 1280) return -2;
      if (n < 1536) return 1728 + (n - 1280);
      if (n < 2304) return 416 + (n - 1536);
      return -2;
    case MAP_UQ:
      if (n < 256) return (n >> 6) * 96 + (n & 63);
      if (n < 384) return ((n - 256) >> 5) * 96 + 64 + ((n - 256) & 31);
      return -1;
    case MAP_UKV:
      if (n < 256) return (n >> 6) * 128 + (n & 63);
      return ((n - 256) >> 6) * 128 + 64 + ((n - 256) & 63);
    default: {
      const int pn = n >> 8, w = n & 255;
      return w < 128 ? 2 * (pn * 128 + w) : 2 * (pn * 128 + w - 128) + 1;
    }
  }
}
__device__ __forceinline__ int invmap(int mt, int sc) {
  if (mt == MAP_ID) return sc;
  if (mt == MAP_GU) { const int j = sc >> 1, t = sc & 1; return (j >> 7) * 256 + t * 128 + (j & 127); }
  if (sc < 384) return sc;
  if (sc < 416) return 640 + (sc - 384);
  if (sc < 1184) return 1536 + (sc - 416);
  if (sc < 1312) return 384 + (sc - 1184);
  if (sc < 1440) return 512 + (sc - 1312);
  if (sc < 1696) return 768 + (sc - 1440);
  if (sc < 1728) return -1;
  if (sc < 1984) return 1280 + (sc - 1728);
  return -1;
}
struct ConvJob { const float* src; void* dst; const float* scale; int ld, K, mt, k0, s0, f32; };
__device__ __forceinline__ void conv_tile_load(const ConvJob& J, int tid, float4 (&v)[4]) {
  const int kk = tid >> 5, s4 = (tid & 31) * 4;
#pragma unroll
  for (int i = 0; i < 4; ++i) {
    v[i] = make_float4(0.f, 0.f, 0.f, 0.f);
    if (J.s0 + s4 < J.ld) v[i] = *(const float4*)(J.src + (size_t)(J.k0 + kk + 16 * i) * J.ld + J.s0 + s4);
  }
}
__device__ __forceinline__ void conv_tile_proc(const ConvJob& J, int tid, const float4 (&v)[4], float* tile  ) {
  {
    const int kk = tid >> 5, s4 = (tid & 31) * 4;
#pragma unroll
    for (int i = 0; i < 4; ++i) {
      const float sc = J.scale ? J.scale[J.k0 + kk + 16 * i] : 1.f;
      float* t = tile + (kk + 16 * i) * 129 + s4;
      t[0] = v[i].x * sc; t[1] = v[i].y * sc; t[2] = v[i].z * sc; t[3] = v[i].w * sc;
    }
  }
  __syncthreads();
#pragma unroll
  for (int h = 0; h < 2; ++h) {
    const int sl = (tid >> 3) + 64 * h, ks = (tid & 7) * 8, sc = J.s0 + sl;
    const int row = sc < J.ld ? invmap(J.mt, sc) : -1;
    if (row >= 0) {
      const float* t = tile + ks * 129 + sl;
      if (J.f32) {
        float* dst = (float*)J.dst + (size_t)row * J.K + J.k0 + ks;
        *(float4*)dst = make_float4(t[0], t[129], t[2 * 129], t[3 * 129]); *(float4*)(dst + 4) = make_float4(t[4 * 129], t[5 * 129], t[6 * 129], t[7 * 129]);
      } else {
        u32x4 w;
        w[0] = cvtpk(t[0], t[129]); w[1] = cvtpk(t[2 * 129], t[3 * 129]); w[2] = cvtpk(t[4 * 129], t[5 * 129]); w[3] = cvtpk(t[6 * 129], t[7 * 129]);
        *(u32x4*)((u16*)J.dst + (size_t)row * J.K + J.k0 + ks) = w;
      }
    }
  }
  __syncthreads();
}
constexpr int CT_IN = 16 * 18, CT_OUT = 16 * 8, CT_DN = NE * 128, CT_L = CT_IN + CT_OUT + CT_DN;
__device__ __forceinline__ void conv_decode(const Params& p, int t, ConvJob& J) {
  const int l = t / CT_L; int r = t % CT_L;
  if (r < CT_IN) { J.src = p.w_in() + (size_t)l * DM * DIN0; J.ld = DIN0; J.K = DM; J.dst = p.btf() + (size_t)l * NIN * DM; J.mt = MAP_IN; J.scale = nullptr; J.k0 = (r / 18) * 64; J.s0 = (r % 18) * 128; J.f32 = 1; return; }
  r -= CT_IN;
  if (r < CT_OUT) { J.src = p.w_out() + (size_t)l * DM * DM; J.ld = DM; J.K = DM; J.dst = p.bt_out() + (size_t)l * DM * DM; J.mt = MAP_ID; J.scale = p.mix_g() + l * DM; J.k0 = (r / 8) * 64; J.s0 = (r % 8) * 128; J.f32 = 0; return; }
  r -= CT_OUT;
  const int e = r >> 7, q = r & 127;
  J.src = p.moe_w_down() + ((size_t)l * NE + e) * DFF * DM; J.ld = DM; J.K = DFF; J.dst = p.bt_dn() + ((size_t)l * NE + e) * DM * DFF; J.mt = MAP_ID; J.scale = nullptr; J.k0 = (q >> 3) * 64; J.s0 = (q & 7) * 128; J.f32 = 0;
}
__device__ __forceinline__ void conv_gu8_load(const float* __restrict__ src  , int s0, int tid, float4 (&v)[16]) {
  const int c4 = (tid & 7) * 4, r0 = tid >> 3;
#pragma unroll
  for (int pss = 0; pss < 16; ++pss) v[pss] = *(const float4*)(src + (size_t)(r0 + 64 * pss) * 2048 + s0 + c4);
}
__device__ __forceinline__ void conv_gu8_proc(const float4 (&v)[16], signed char* __restrict__ dst  , float* __restrict__ sw  ,
                                              int s0, float* tile  , int tid) {
  float* cmax = tile + 1024 * 33;
  {
    const int c4 = (tid & 7) * 4, r0 = tid >> 3;
#pragma unroll
    for (int pss = 0; pss < 16; ++pss) { float* t = tile + (r0 + 64 * pss) * 33 + c4; t[0] = v[pss].x; t[1] = v[pss].y; t[2] = v[pss].z; t[3] = v[pss].w; }
  }
  __syncthreads();
  {
    const int col = tid & 31, part = tid >> 5; float m = 0.f;
#pragma unroll 8
    for (int k = part * 64; k < part * 64 + 64; ++k) m = fmaxf(m, fabsf(tile[k * 33 + col]));
    cmax[part * 32 + col] = m;
  }
  __syncthreads();
  if (tid < 32) {
    float m = 0.f;
#pragma unroll
    for (int q = 0; q < 16; ++q) m = fmaxf(m, cmax[q * 32 + tid]);
    const float sc = fmaxf(m, 1e-20f) * (1.f / 127.f);
    cmax[512 + tid] = sc;
    sw[invmap(MAP_GU, s0 + tid)] = sc;
  }
  __syncthreads();
#pragma unroll
  for (int h = 0; h < 4; ++h) {
    const int g = tid + 512 * h, col = g & 31, k0 = (g >> 5) * 16;
    const float inv = 1.f / cmax[512 + col];
    unsigned w[4];
#pragma unroll
    for (int q = 0; q < 4; ++q) {
      const float* t = tile + (k0 + 4 * q) * 33 + col;
      const int q0 = (int)rintf(t[0] * inv), q1 = (int)rintf(t[33] * inv), q2 = (int)rintf(t[66] * inv), q3 = (int)rintf(t[99] * inv);
      w[q] = (unsigned)(q0 & 255) | ((unsigned)(q1 & 255) << 8) | ((unsigned)(q2 & 255) << 16) | ((unsigned)(q3 & 255) << 24);
    }
    *(u32x4*)(dst + (size_t)invmap(MAP_GU, s0 + col) * DM + k0) = u32x4{w[0], w[1], w[2], w[3]};
  }
  __syncthreads();
}
__device__ __forceinline__ void phase_convert(const Params& p, int bid, int nb, char* lds) {
  float* tile = (float*)lds;
  const int tid = ltid();
  {
    ConvJob J, Jn; float4 v[4], vn[4];
    int t = bid;
    if (t < 2 * CT_L) { conv_decode(p, t, J); conv_tile_load(J, tid, v); }
    for (; t < 2 * CT_L; t += nb) {
      const bool more = t + nb < 2 * CT_L;
      if (more) { conv_decode(p, t + nb, Jn); conv_tile_load(Jn, tid, vn); }
      conv_tile_proc(J, tid, v, tile);
      if (more) { J = Jn;
#pragma unroll
        for (int i = 0; i < 4; ++i) v[i] = vn[i]; }
    }
  }
  {
    float4 v[16], vn[16];
    int t = bid;
    if (t < 2 * NE * 64) conv_gu8_load(p.moe_w_gu() + (size_t)(t >> 6) * DM * 2048, (t & 63) * 32, tid, v);
    for (; t < 2 * NE * 64; t += nb) {
      const bool more = t + nb < 2 * NE * 64; const int tn = t + nb;
      if (more) conv_gu8_load(p.moe_w_gu() + (size_t)(tn >> 6) * DM * 2048, (tn & 63) * 32, tid, vn);
      conv_gu8_proc(v, p.bt_gu() + (size_t)(t >> 6) * 2048 * DM, p.swgu() + (size_t)(t >> 6) * 2048, (t & 63) * 32, tile, tid);
      if (more) {
#pragma unroll
        for (int i = 0; i < 16; ++i) v[i] = vn[i]; }
    }
  }
  for (int l = 0; l < 2; ++l) {
    for (int i = bid * NTHR + tid; i < 96 * DM / 4; i += nb * NTHR) *(float4*)(p.btf() + ((size_t)l * NIN + 672) * DM + (size_t)i * 4) = make_float4(0.f, 0.f, 0.f, 0.f);
    {
      const float* wq = p.mla_w_uq() + (size_t)l * 256 * 384; const float* wkv = p.mla_w_ukv() + (size_t)l * 128 * 512;
      const float* gq = p.mla_q_g() + l * 256; const float* gkv = p.mla_kv_g() + l * 128;
      u16* dst = p.bt_qkv() + (size_t)l * 1024 * 384;
      for (int i = bid * NTHR + ltid(); i < 1024 * 384; i += nb * NTHR) {
        const int n = i / 384, k = i % 384; float v = 0.f;
        if (n < 512) { const int sc = colmap(MAP_UQ, n); if (k < 256 && sc >= 0) v = gq[k] * wq[k * 384 + sc]; }
        else { if (k >= 256) v = gkv[k - 256] * wkv[(k - 256) * 512 + colmap(MAP_UKV, n - 512)]; }
        dst[i] = f2bf(v);
      }
    }
  }
}

__device__ __forceinline__ void phase_hy_mlp(const Params& p, int l, int Lf, float* __restrict__ hout  , float* __restrict__ ssq  ,
                             int bid, int nb, char* lds) {
  float* zf = (float*)lds;
  float* h1 = zf + 64 * 33;
  float* h2 = h1 + 64 * 64;
  const int tid = ltid();
  const float* w1 = p.hy_w1() + (size_t)l * 33 * 64; const float* b1 = p.hy_b1() + l * 64;
  const float* w2 = p.hy_w2() + (size_t)l * 64 * 64; const float* b2 = p.hy_b2() + l * 64;
  const float* w3 = p.hy_w3() + (size_t)l * 64 * 512; const float* fr = p.hy_freq() + l * 64;
  float w3c[64];
#pragma unroll
  for (int k = 0; k < 64; ++k) w3c[k] = w3[k * 512 + tid];
  const int dir = tid >> 8, ch = tid & 255;
  const float maxd = logf(1e-2f) / 0.3f, mind = logf(1e-2f) / 1.5f;
  const float delta = fabsf(mind + (maxd - mind) * (float)ch / 255.f);
  float ssq_acc = 0.f;
  for (int it = bid; it < Lf / 64; it += nb) {
    const int t0 = it * 64;
    for (int i = tid; i < 64 * 33; i += NTHR) {
      const int tt = i / 33, f = i % 33, t = t0 + tt;
      float v;
      if (f == 0) v = (float)t / (float)(Lf - 1);
      else {
        const int j = (f - 1) & 15;
        const float fj = 1e-4f + (float)j * ((15.f - 1e-4f) / 15.f);
        const float w = 6.283185307179586f * (float)t / (float)Lf;
        v = (f <= 16) ? cosf(fj * w) : -sinf(fj * w);
      }
      zf[i] = v;
    }
    __syncthreads();
    {
      const int o = tid & 63, tb = tid >> 6;
      float acc[8];
#pragma unroll
      for (int j = 0; j < 8; ++j) acc[j] = b1[o];
#pragma unroll 3
      for (int f = 0; f < 33; ++f) {
        const float w = w1[f * 64 + o];
#pragma unroll
        for (int j = 0; j < 8; ++j) acc[j] += zf[(tb + 8 * j) * 33 + f] * w;
      }
      const float fo = fr[o];
#pragma unroll
      for (int j = 0; j < 8; ++j) h1[(tb + 8 * j) * 64 + o] = sinf(fo * acc[j]);
    }
    __syncthreads();
    {
      const int o = tid & 63, tb = tid >> 6;
      float acc[8];
#pragma unroll
      for (int j = 0; j < 8; ++j) acc[j] = b2[o];
#pragma unroll 4
      for (int f = 0; f < 64; f += 4) {
        const float wa = w2[f * 64 + o], wb = w2[(f + 1) * 64 + o], wc2 = w2[(f + 2) * 64 + o], wd = w2[(f + 3) * 64 + o];
#pragma unroll
        for (int j = 0; j < 8; ++j) { const float4 hv = *(const float4*)(h1 + (tb + 8 * j) * 64 + f); acc[j] += hv.x * wa + hv.y * wb + hv.z * wc2 + hv.w * wd; }
      }
      const float fo = fr[o];
#pragma unroll
      for (int j = 0; j < 8; ++j) h2[(tb + 8 * j) * 64 + o] = sinf(fo * acc[j]);
    }
    __syncthreads();
    float* orow = hout + ((size_t)dir * 256 + ch) * Lf + t0;
    for (int tq = 0; tq < 16; ++tq) {
      float sv[4];
#pragma unroll
      for (int u = 0; u < 4; ++u) {
        const int tt = tq * 4 + u;
        float s = 0;
#pragma unroll
        for (int k = 0; k < 64; k += 4) { const float4 hv = *(const float4*)(h2 + tt * 64 + k); s += hv.x * w3c[k] + hv.y * w3c[k + 1] + hv.z * w3c[k + 2] + hv.w * w3c[k + 3]; }
        const int t = t0 + tt;
        s *= __expf(-((float)t / (float)(Lf - 1)) * delta);
        if (dir == 0 || t > 0) ssq_acc += s * s;
        sv[u] = s;
      }
      *(float4*)(orow + tq * 4) = make_float4(sv[0], sv[1], sv[2], sv[3]);
    }
    __syncthreads();
  }
  ssq[(size_t)bid * 512 + tid] = ssq_acc;
}

__host__ __device__ constexpr int fx(int p) {
  return ((p >> 12) & 3) ^ (((p >> 10) & 3) << 2) ^ ((p >> 4) & 16) ^ (((p >> 5) & 1) * 5) ^ (((p >> 6) & 1) * 26);
}
__device__ __forceinline__ int swz(int p) { return p ^ fx(p); }
__device__ __forceinline__ int rev7(int k) {
  unsigned r = __brev((unsigned)k) >> 18;
  return (int)(((r & 0x2AAAu) >> 1) | ((r & 0x1555u) << 1));
}
template <int ST, bool INV>
__device__ __forceinline__ void fft_stage(float2* s, const float2* __restrict__ tw, const int tid) {
  constexpr int sh = 12 - 2 * ST, q = 1 << sh, ND = q >= 512 ? q / 512 : 1;
  float2 w1[ND], w2[ND], w3[ND];
  if constexpr (ST < 6) {
#pragma unroll
    for (int d = 0; d < ND; ++d) {
      const int j = q >= 512 ? tid + 512 * d : (tid & (q - 1)), ti = j << (2 * ST);
      w1[d] = tw[ti]; w2[d] = tw[2 * ti]; w3[d] = tw[3 * ti];
    }
  }
  float2 x[8][4];
#pragma unroll
  for (int m = 0; m < 8; ++m) {
    const int u = tid + 512 * m, g = u >> sh, j = u & (q - 1), base = (g << (sh + 2)) + j, xb = fx(base);
    x[m][0] = s[base ^ xb]; x[m][1] = s[(base + q) ^ xb ^ fx(q)]; x[m][2] = s[(base + 2 * q) ^ xb ^ fx(2 * q)]; x[m][3] = s[(base + 3 * q) ^ xb ^ fx(3 * q)];
  }
#pragma unroll
  for (int m = 0; m < 8; ++m) {
    const int u = tid + 512 * m, g = u >> sh, j = u & (q - 1), base = (g << (sh + 2)) + j, xb = fx(base);
    const int i0 = base ^ xb, i1 = (base + q) ^ xb ^ fx(q), i2 = (base + 2 * q) ^ xb ^ fx(2 * q), i3 = (base + 3 * q) ^ xb ^ fx(3 * q);
    const int d = q >= 512 ? (m % ND) : 0;
    if constexpr (!INV) {
      const float2 a0 = x[m][0], a1 = x[m][1], a2 = x[m][2], a3 = x[m][3];
      const float2 b0 = make_float2(a0.x + a2.x, a0.y + a2.y), b1 = make_float2(a0.x - a2.x, a0.y - a2.y);
      const float2 b2 = make_float2(a1.x + a3.x, a1.y + a3.y), b3 = make_float2(a1.x - a3.x, a1.y - a3.y);
      const float2 y1 = make_float2(b1.x + b3.y, b1.y - b3.x), y2 = make_float2(b0.x - b2.x, b0.y - b2.y), y3 = make_float2(b1.x - b3.y, b1.y + b3.x);
      s[i0] = make_float2(b0.x + b2.x, b0.y + b2.y);
      if constexpr (ST < 6) { s[i1] = cmul(y1, w1[d]); s[i2] = cmul(y2, w2[d]); s[i3] = cmul(y3, w3[d]); }
      else { s[i1] = y1; s[i2] = y2; s[i3] = y3; }
    } else {
      float2 t0 = x[m][0], t1 = x[m][1], t2 = x[m][2], t3 = x[m][3];
      if constexpr (ST < 6) { t1 = cmulc(t1, w1[d]); t2 = cmulc(t2, w2[d]); t3 = cmulc(t3, w3[d]); }
      const float2 b0 = make_float2(t0.x + t2.x, t0.y + t2.y), b1 = make_float2(t0.x - t2.x, t0.y - t2.y);
      const float2 b2 = make_float2(t1.x + t3.x, t1.y + t3.y), b3 = make_float2(t1.x - t3.x, t1.y - t3.y);
      s[i0] = make_float2(b0.x + b2.x, b0.y + b2.y);
      s[i1] = make_float2(b1.x - b3.y, b1.y + b3.x);
      s[i2] = make_float2(b0.x - b2.x, b0.y - b2.y);
      s[i3] = make_float2(b1.x + b3.y, b1.y - b3.x);
    }
  }
  __syncthreads();
}
__device__ __forceinline__ void fft_fwd(float2* s, const float2* __restrict__ tw) {
  const int tid = ltid();
  fft_stage<0, false>(s, tw, tid); fft_stage<1, false>(s, tw, tid); fft_stage<2, false>(s, tw, tid); fft_stage<3, false>(s, tw, tid);
  fft_stage<4, false>(s, tw, tid); fft_stage<5, false>(s, tw, tid); fft_stage<6, false>(s, tw, tid);
}
__device__ __forceinline__ void fft_inv(float2* s, const float2* __restrict__ tw) {
  const int tid = ltid();
  fft_stage<6, true>(s, tw, tid); fft_stage<5, true>(s, tw, tid); fft_stage<4, true>(s, tw, tid); fft_stage<3, true>(s, tw, tid);
  fft_stage<2, true>(s, tw, tid); fft_stage<1, true>(s, tw, tid); fft_stage<0, true>(s, tw, tid);
}

__device__ __forceinline__ float filt_ssq(const float* __restrict__ part  , int ch, float* red  ) {
  const int tid = ltid();
  float v = part[(size_t)(tid >> 1) * 512 + (tid & 1) * 256 + ch];
  v = wave_sum(v);
  __syncthreads();
  if ((tid & 63) == 0) red[tid >> 6] = v;
  __syncthreads();
  return ((red[0] + red[1]) + (red[2] + red[3])) + ((red[4] + red[5]) + (red[6] + red[7]));
}
__device__ __forceinline__ void phase_hy_filtfft(const Params& p, int bid, int nb, char* lds) {
  float2* s = (float2*)lds;
  const int tid = ltid();
  for (int it = bid; it < 512; it += nb) {
    const int l = it >> 8, ch = it & 255;
    const float* hf = p.hfb() + (((size_t)l * 2 + 0) * 256 + ch) * SEQ;
    const float* hb = p.hfb() + (((size_t)l * 2 + 1) * 256 + ch) * SEQ;
#pragma unroll 8
    for (int m = tid; m < FM; m += NTHR) {
      const int n0 = 2 * m, n1 = 2 * m + 1;
      const float a = (n0 < SEQ) ? hf[n0] : (n0 == SEQ ? 0.f : hb[2 * SEQ - n0]);
      const float b = (n1 < SEQ) ? hf[n1] : hb[2 * SEQ - n1];
      s[swz(m)] = make_float2(a, b);
    }
    __syncthreads();
    fft_fwd(s, p.tw());
    const float sc = rsqrtf(filt_ssq(p.hpart() + (size_t)l * 256 * 512, ch, (float*)(lds + 139264))) * (1.f / 16384.f);
    float4* out = p.hspec() + ((size_t)l * 256 + ch) * HSP;
#pragma unroll 4
    for (int k = tid; k <= FM / 2; k += NTHR) {
      const float2 zk = s[swz(rev7(k))], zm = s[swz(rev7((FM - k) & (FM - 1)))];
      const float er = 0.5f * (zk.x + zm.x), ei = 0.5f * (zk.y - zm.y);
      const float dr = 0.5f * (zk.x - zm.x), di = 0.5f * (zk.y + zm.y);
      out[k] = make_float4(er * sc, ei * sc, di * sc, -dr * sc);
    }
    __syncthreads();
  }
}
constexpr int G_TILE_B = 256 * 64 * 2;
constexpr int G_STAGE_B = 2 * G_TILE_B;
constexpr int GEMM_LDS = 2 * G_STAGE_B;

__device__ __forceinline__ int lds_byte2(int r, int c) {
  const int st = (r >> 4) * 2 + (c >> 5), ob = (r & 15) * 64 + (c & 31) * 2;
  return st * 1024 + (ob ^ (((ob >> 9) & 1) << 5));
}
__device__ __forceinline__ void stage_rc2(int b, int& R, int& C) {
  const int st = b >> 10, sb = b & 1023, swz = sb ^ (((sb >> 9) & 1) << 5);
  R = (st >> 1) * 16 + (swz >> 6);
  C = (st & 1) * 32 + ((swz & 63) >> 1);
}
__device__ __forceinline__ void gemm_stage_coords(int (&sR)[4], int (&sC)[4]) {
  const int wid = ltid() >> 6, lane = ltid() & 63;
#pragma unroll
  for (int i = 0; i < 4; ++i) stage_rc2(wid * 1024 + i * 8192 + lane * 16, sR[i], sC[i]);
}

#define WAIT_V0() asm volatile("s_waitcnt vmcnt(0)" ::: "memory")

__device__ __forceinline__ void gemm256_core(const u16* const (&ap)[4], const u16* const (&bp)[4], int nt, char* shm, f32x4 (&acc)[8][4]) {
  const int tid = ltid(), wid = tid >> 6, lane = tid & 63, wr = wid >> 2, wc = wid & 3, fr = lane & 15, fq = lane >> 4;
#pragma unroll
  for (int m = 0; m < 8; ++m)
#pragma unroll
    for (int n = 0; n < 4; ++n) acc[m][n] = f32x4{0.f, 0.f, 0.f, 0.f};
#define G_SA(b) (shm + (b) * G_STAGE_B)
#define G_SB(b) (shm + (b) * G_STAGE_B + G_TILE_B)
#define G_STAGE(buf, kt) do { _Pragma("unroll") for (int i = 0; i < 4; ++i) {                                                   \
    __builtin_amdgcn_global_load_lds((const unsigned*)(ap[i] + (kt) * 64), (unsigned*)(G_SA(buf) + wid * 1024 + i * 8192), 16, 0, 0); \
    __builtin_amdgcn_global_load_lds((const unsigned*)(bp[i] + (kt) * 64), (unsigned*)(G_SB(buf) + wid * 1024 + i * 8192), 16, 0, 0); } } while (0)
  G_STAGE(0, 0); WAIT_V0(); __syncthreads();
#pragma unroll 1
  for (int t = 0; t < nt; ++t) {
    const int cur = t & 1;
    if (t + 1 < nt) G_STAGE(cur ^ 1, t + 1);
#pragma unroll
    for (int ks = 0; ks < 2; ++ks) {
      bf16x8 At[8], Bf[4];
#pragma unroll
      for (int m = 0; m < 8; ++m) At[m] = *(const bf16x8*)(G_SA(cur) + lds_byte2(wr * 128 + m * 16 + fr, ks * 32 + fq * 8));
#pragma unroll
      for (int n = 0; n < 4; ++n) Bf[n] = *(const bf16x8*)(G_SB(cur) + lds_byte2(wc * 64 + n * 16 + fr, ks * 32 + fq * 8));
#pragma unroll
      for (int m = 0; m < 8; ++m)
#pragma unroll
        for (int n = 0; n < 4; ++n) acc[m][n] = __builtin_amdgcn_mfma_f32_16x16x32_bf16(At[m], Bf[n], acc[m][n], 0, 0, 0);
      __builtin_amdgcn_sched_barrier(0);
    }
    WAIT_V0(); __syncthreads();
  }
#undef G_STAGE
}

#define LAS3 __attribute__((address_space(3)))
constexpr int G8_HTB = 128 * 64 * 2;
__device__ __forceinline__ int g8_perm32(int rho) { const int n = rho >> 4, i = rho & 15; return 8 * (i >> 2) + 4 * n + (i & 3); }
__device__ __forceinline__ int g8_lds_byte(int r, int c) { const int st = (r >> 4) * 2 + (c >> 5), rr = r & 15, cc = c & 31, ob = rr * 64 + cc * 2; return st * 1024 + (ob ^ (((ob >> 9) & 1) << 5)); }
__device__ __forceinline__ void g8_stage_rc(int b, int& R, int& C) { const int st = b / 1024, sb = b % 1024, swz = sb ^ (((sb >> 9) & 1) << 5); R = (st >> 1) * 16 + swz / 64; C = (st & 1) * 32 + (swz % 64) / 2; }
struct G8Unit { int pm, pn, e, ce, pre; };
__device__ __forceinline__ void g8_cload(const float* __restrict__ src, float* dst) {
  __builtin_amdgcn_global_load_lds((const unsigned*)(src + (ltid() & 63) * 4), (LAS3 unsigned*)dst, 16, 0, 0);
}


template <bool I8> __device__ __forceinline__ typename std::conditional<I8, int __attribute__((ext_vector_type(4))), f32x4>::type
g8_mma(bf16x8 x, bf16x8 y, typename std::conditional<I8, int __attribute__((ext_vector_type(4))), f32x4>::type c) {
  if constexpr (I8) { typedef int v4i __attribute__((ext_vector_type(4))); return __builtin_amdgcn_mfma_i32_16x16x64_i8(*(v4i*)&x, *(v4i*)&y, c, 0, 0, 0); }
  else return __builtin_amdgcn_mfma_f32_16x16x32_bf16(x, y, c, 0, 0, 0);
}
typedef int i32x4 __attribute__((ext_vector_type(4)));
template <bool I8> struct G8Acc { typedef f32x4 T; };
template <> struct G8Acc<true> { typedef i32x4 T; };
template <bool I8, class Sched, class Epi>
__device__ __forceinline__ void gemm8_phase(char* lds_g, const char* Abase, const int Kb, const Sched& S, const Epi& E) {
    typedef typename G8Acc<I8>::T ACC;
    LAS3 unsigned char* lds = (LAS3 unsigned char*)lds_g;
    const int tid = ltid(), wid = __builtin_amdgcn_readfirstlane(tid >> 6), lane = tid & 63, wr = wid >> 2, wc = wid & 3, fr = lane & 15, fq = lane >> 4;
    const int nt = Kb / 128;
    int sRr[2], sCc[2]; unsigned voffB[2];
#pragma unroll
    for (int i = 0; i < 2; ++i) { g8_stage_rc(tid * 16 + i * 8192, sRr[i], sCc[i]); const int Rb = (sRr[i] & ~31) + g8_perm32(sRr[i] & 31); voffB[i] = (unsigned)(Rb * Kb) + (unsigned)sCc[i] * 2u; }
    const size_t kstep = 128;
    const size_t hstepB = (size_t)128 * Kb;
    const unsigned ldsw = (unsigned)wid * 1024u;
    const int aoff = g8_lds_byte(wr * 64 + fr, fq * 8), boff = g8_lds_byte(wc * 32 + fr, fq * 8);
#define G8_SA(b, h) (((b) * 2 + (h)) * G8_HTB)
#define G8_SB(b, h) ((4 + (b) * 2 + (h)) * G8_HTB)
#define G8_STAGE_B(bufoff, gbase) do { _Pragma("unroll") for (int _i = 0; _i < 2; ++_i) \
        __builtin_amdgcn_global_load_lds((const unsigned*)((const char*)(gbase) + voffB[_i]), (LAS3 unsigned*)(lds + (bufoff) + ldsw + _i * 8192), 16, 0, 0); } while (0)
#define G8_STAGE_A(bufoff, o0, o1) do { \
        __builtin_amdgcn_global_load_lds((const unsigned*)(Abase + (o0)), (LAS3 unsigned*)(lds + (bufoff) + ldsw), 16, 0, 0); \
        __builtin_amdgcn_global_load_lds((const unsigned*)(Abase + (o1)), (LAS3 unsigned*)(lds + (bufoff) + ldsw + 8192), 16, 0, 0); } while (0)
#define G8_LDA(dst, b, h) do { _Pragma("unroll") for (int m = 0; m < 4; ++m) _Pragma("unroll") for (int k = 0; k < 2; ++k) dst[m][k] = *(const LAS3 bf16x8*)(lds + G8_SA(b, h) + aoff + m * 2048 + k * 1024); } while (0)
#define G8_LDB(dst, b, h) do { _Pragma("unroll") for (int n = 0; n < 2; ++n) _Pragma("unroll") for (int k = 0; k < 2; ++k) dst[n][k] = *(const LAS3 bf16x8*)(lds + G8_SB(b, h) + boff + n * 2048 + k * 1024); } while (0)
#define G8_MMA(ai, bj, At, Bt) do { __builtin_amdgcn_s_setprio(1); _Pragma("unroll") for (int m = 0; m < 4; ++m) _Pragma("unroll") for (int n = 0; n < 2; ++n) _Pragma("unroll") for (int k = 0; k < 2; ++k) \
        acc[ai][bj][m][n] = g8_mma<I8>(Bt[n][k], At[m][k], acc[ai][bj][m][n]); __builtin_amdgcn_s_setprio(0); } while (0)
#define G8_WAIT_V(n) asm volatile("s_waitcnt vmcnt(" #n ")" ::: "memory")
#define G8_WAIT_L(n) asm volatile("s_waitcnt lgkmcnt(" #n ")" ::: "memory")
#define G8_BAR __builtin_amdgcn_s_barrier()
#define G8_SCHED __builtin_amdgcn_sched_barrier(0)
    G8Unit cur, nxt; int ui = 0;
    if (!S.next(0, cur)) return;
    ACC acc[2][2][4][2];
#pragma unroll
    for (int a = 0; a < 2; ++a)
#pragma unroll
        for (int b = 0; b < 2; ++b)
#pragma unroll
            for (int m = 0; m < 4; ++m)
#pragma unroll
                for (int n = 0; n < 2; ++n) acc[a][b][m][n] = ACC{};
    bf16x8 At[4][2], B0[2][2], B1[2][2];
    float ep[8];
    unsigned va[2][2], vn[2][2];
#pragma unroll
    for (int h = 0; h < 2; ++h)
#pragma unroll
        for (int i = 0; i < 2; ++i) va[h][i] = S.a_off(cur, h * 128 + sRr[i]) + (unsigned)sCc[i] * 2u;
    const char* cB = S.b_ptr(cur);
    G8_STAGE_B(G8_SB(0, 0), cB); G8_STAGE_A(G8_SA(0, 0), va[0][0], va[0][1]); G8_STAGE_B(G8_SB(0, 1), cB + hstepB); G8_STAGE_A(G8_SA(0, 1), va[1][0], va[1][1]);
    if (wr == 1) G8_BAR;
    G8_WAIT_V(4); G8_BAR;
    G8_STAGE_B(G8_SB(1, 0), cB + kstep); G8_STAGE_A(G8_SA(1, 0), va[0][0] + kstep, va[0][1] + kstep); G8_STAGE_B(G8_SB(1, 1), cB + hstepB + kstep);
    G8_WAIT_V(6); G8_BAR;
    for (;;) {
        float* cb = (float*)(lds_g + 136192 + (ui & 1) * 2048);
        E.pre(cur, wr, fr, ep, cb);
        const bool has_next = S.next(ui + 1, nxt);
        const char* nB = cB;
#pragma unroll
        for (int h = 0; h < 2; ++h)
#pragma unroll
            for (int i = 0; i < 2; ++i) vn[h][i] = va[h][i];
        if (has_next) {
            nB = S.b_ptr(nxt);
#pragma unroll
            for (int h = 0; h < 2; ++h)
#pragma unroll
                for (int i = 0; i < 2; ++i) vn[h][i] = S.a_off(nxt, h * 128 + sRr[i]) + (unsigned)sCc[i] * 2u;
        }
#pragma unroll 1
        for (int t = 0; t < nt; t += 2) {
            const bool last = (t == nt - 2);
            const unsigned k1 = (unsigned)(t + 1) * 128u;
            const unsigned k2 = last ? 0u : (unsigned)(t + 2) * 128u;
            const unsigned a2_00 = (last ? vn[0][0] : va[0][0]) + k2, a2_01 = (last ? vn[0][1] : va[0][1]) + k2;
            const unsigned a2_10 = (last ? vn[1][0] : va[1][0]) + k2, a2_11 = (last ? vn[1][1] : va[1][1]) + k2;
            const char* b2 = (last ? nB : cB) + k2; const char* b3 = b2 + kstep;
            G8_LDB(B0, 0, 0); G8_SCHED; G8_LDA(At, 0, 0); G8_STAGE_A(G8_SA(1, 1), va[1][0] + k1, va[1][1] + k1);
            G8_WAIT_L(8); G8_BAR; G8_WAIT_L(0); G8_MMA(0, 0, At, B0); G8_BAR; G8_SCHED;
            G8_LDB(B1, 0, 1); G8_STAGE_B(G8_SB(0, 0), b2);
            G8_BAR; G8_WAIT_L(0); G8_MMA(0, 1, At, B1); G8_BAR;
            G8_LDA(At, 0, 1); G8_STAGE_A(G8_SA(0, 0), a2_00, a2_01);
            G8_BAR; G8_WAIT_L(0); G8_MMA(1, 0, At, B0); G8_BAR; G8_SCHED;
            G8_STAGE_B(G8_SB(0, 1), b2 + hstepB);
            G8_WAIT_V(6); G8_BAR; G8_MMA(1, 1, At, B1); G8_BAR;
            G8_LDB(B0, 1, 0); G8_SCHED; G8_LDA(At, 1, 0); G8_STAGE_A(G8_SA(0, 1), a2_10, a2_11);
            G8_WAIT_L(8); G8_BAR; G8_WAIT_L(0); G8_MMA(0, 0, At, B0); G8_BAR; G8_SCHED;
            G8_LDB(B1, 1, 1); G8_STAGE_B(G8_SB(1, 0), b3);
            G8_BAR; G8_WAIT_L(0); G8_MMA(0, 1, At, B1); G8_BAR;
            G8_LDA(At, 1, 1); G8_STAGE_A(G8_SA(1, 0), a2_00 + 128u, a2_01 + 128u);
            G8_BAR; G8_WAIT_L(0); G8_MMA(1, 0, At, B0); G8_BAR; G8_SCHED;
            G8_STAGE_B(G8_SB(1, 1), b3 + hstepB);
            G8_WAIT_V(6); G8_BAR; G8_MMA(1, 1, At, B1); G8_BAR;
        }
        E(acc, cur, wr, wc, fr, fq, ep, cb);
        if (!has_next) break;
#pragma unroll
        for (int a = 0; a < 2; ++a)
#pragma unroll
            for (int b = 0; b < 2; ++b)
#pragma unroll
                for (int m = 0; m < 4; ++m)
#pragma unroll
                    for (int n = 0; n < 2; ++n) acc[a][b][m][n] = ACC{};
        cur = nxt; cB = nB; ++ui;
#pragma unroll
        for (int h = 0; h < 2; ++h)
#pragma unroll
            for (int i = 0; i < 2; ++i) va[h][i] = vn[h][i];
    }
    G8_WAIT_V(0);
    if (wr == 0) G8_BAR;
    G8_BAR;
#undef G8_SA
#undef G8_SB
#undef G8_STAGE_A
#undef G8_STAGE_B
#undef G8_LDA
#undef G8_LDB
#undef G8_MMA
#undef G8_WAIT_V
#undef G8_WAIT_L
#undef G8_BAR
#undef G8_SCHED
}
struct G8Plain {
    int nM, nN, Kb, G, c; const char* Bt;
    __device__ __forceinline__ bool next(int i, G8Unit& u) const {
        const int L = (i * 8 + (c & 7)) * (G >> 3) + (c >> 3); if (L >= nM * nN) return false;
        const int nig = 8 * nN, gid = L / nig, fm = gid * 8, gsz = (nM - fm) < 8 ? (nM - fm) : 8;
        u.pm = fm + ((L % nig) % gsz); u.pn = (L % nig) / gsz; u.e = 0; u.ce = 256; u.pre = 0; return true;
    }
    __device__ __forceinline__ unsigned a_off(const G8Unit& u, int row) const { return (unsigned)(u.pm * 256 + row) * (unsigned)Kb; }
    __device__ __forceinline__ const char* b_ptr(const G8Unit& u) const { return Bt + (size_t)u.pn * 256 * Kb; }
};

__device__ __forceinline__ const float* resid_row_in(const Params& p, int tok) {
  return tok < TL ? p.x() + (size_t)tok * DM : p.ctx() + (size_t)(tok - TL) * DM;
}
__device__ __forceinline__ void load_row_comb(const Params& p, int src_layer, int lc, int tok, int lane, const int* pre  , float (&v)[16]) {
  if (src_layer == 0) {
    const float* r = resid_row_in(p, tok);
#pragma unroll
    for (int i = 0; i < 4; ++i) { const float4 a = *(const float4*)(r + lane * 4 + i * 256); v[4 * i] = a.x; v[4 * i + 1] = a.y; v[4 * i + 2] = a.z; v[4 * i + 3] = a.w; }
  } else {
    const u16* r = p.X() + (size_t)tok * DM;
#pragma unroll
    for (int i = 0; i < 4; ++i) { const float4 a = ld4bf(r + lane * 4 + i * 256); v[4 * i] = a.x; v[4 * i + 1] = a.y; v[4 * i + 2] = a.z; v[4 * i + 3] = a.w; }
  }
  if (lc >= 0) {
    const float* g2 = p.mod() + ((size_t)lc * 3 + modv(tok)) * 6144 + 5 * DM;
    float s[16];
#pragma unroll
    for (int i = 0; i < 16; ++i) s[i] = 0.f;
#pragma unroll
    for (int k = 0; k < TOPK; ++k) {
      const int sl = p.tslot()[tok * 4 + k];
      const size_t arow = (size_t)(pre[sl >> 20] + (sl & 0xFFFFF));
      const u16* y = p.yd() + arow * DM;
#pragma unroll
      for (int i = 0; i < 4; ++i) {
        const u32x2 w = *(const u32x2*)(y + lane * 4 + i * 256);
        s[4 * i] += __uint_as_float(w[0] << 16); s[4 * i + 1] += __uint_as_float(w[0] & 0xFFFF0000u);
        s[4 * i + 2] += __uint_as_float(w[1] << 16); s[4 * i + 3] += __uint_as_float(w[1] & 0xFFFF0000u);
      }
    }
#pragma unroll
    for (int i = 0; i < 4; ++i) {
      const float4 g = *(const float4*)(g2 + lane * 4 + i * 256);
      v[4 * i] += g.x * s[4 * i]; v[4 * i + 1] += g.y * s[4 * i + 1]; v[4 * i + 2] += g.z * s[4 * i + 2]; v[4 * i + 3] += g.w * s[4 * i + 3];
    }
  }
}
__device__ __forceinline__ void expert_prefix(const int* cnt, int* pre) {
  if (ltid() == 0) { int s = 0; for (int e = 0; e < NE; ++e) { pre[e] = s; s += cnt[e]; } pre[NE] = s; }
}

__device__ __forceinline__ float store_row_i8(const float (&y)[16], signed char* __restrict__ h, float* __restrict__ hs_row, int lane) {
  float am = 0.f;
#pragma unroll
  for (int i = 0; i < 16; ++i) am = fmaxf(am, fabsf(y[i]));
#pragma unroll
  for (int o = 32; o > 0; o >>= 1) am = fmaxf(am, __shfl_xor(am, o, 64));
  const float s = fmaxf(am, 1e-20f) * (1.f / 127.f), inv = 1.f / s;
#pragma unroll
  for (int i = 0; i < 4; ++i) {
    const int q0 = (int)rintf(y[4 * i] * inv), q1 = (int)rintf(y[4 * i + 1] * inv), q2 = (int)rintf(y[4 * i + 2] * inv), q3 = (int)rintf(y[4 * i + 3] * inv);
    *(unsigned*)(h + lane * 4 + i * 256) = (unsigned)(q0 & 255) | ((unsigned)(q1 & 255) << 8) | ((unsigned)(q2 & 255) << 16) | ((unsigned)(q3 & 255) << 24);
  }
  if (lane == 0) *hs_row = s;
  return s;
}
__device__ __forceinline__ void phase_quant_in(const Params& p, int bid, int nb) {
  const int wid = ltid() >> 6, lane = ltid() & 63;
  for (int r = bid * 8 + wid; r < 2 * NIN; r += nb * 8) {
    const float* src = p.btf() + (size_t)r * DM;
    float y[16];
#pragma unroll
    for (int i = 0; i < 4; ++i) { const float4 a = *(const float4*)(src + lane * 4 + i * 256); y[4 * i] = a.x; y[4 * i + 1] = a.y; y[4 * i + 2] = a.z; y[4 * i + 3] = a.w; }
    store_row_i8(y, p.bt_in() + (size_t)r * DM, p.swin() + r, lane);
  }
}
__device__ __forceinline__ void phase_norm1(const Params& p, int layer, int bid, int nb, char* lds) {
  int* pre = (int*)lds;
  const int lc = layer - 1;
  if (lc >= 0) { expert_prefix(p.cnt() + lc * NE, pre); __syncthreads(); }
  const int wid = ltid() >> 6, lane = ltid() & 63;
  const float* gn = p.norm1_g() + layer * DM;
  const int ntok = TT;
  for (int tok = bid * 8 + wid; tok < ntok; tok += nb * 8) {
    float v[16];
    load_row_comb(p, layer == 0 ? 0 : 1, lc, tok, lane, pre, v);
    if (lc >= 0) {
      u16* xr = p.X() + (size_t)tok * DM;
#pragma unroll
      for (int i = 0; i < 4; ++i) *(u32x2*)(xr + lane * 4 + i * 256) = u32x2{cvtpk(v[4 * i], v[4 * i + 1]), cvtpk(v[4 * i + 2], v[4 * i + 3])};
    }
    float ss = 0;
#pragma unroll
    for (int i = 0; i < 16; ++i) ss += v[i] * v[i];
    ss = wave_sum(ss);
    const float rs = rsqrtf(ss * (1.f / DM) + EPS);
    const float* md = p.mod() + ((size_t)layer * 3 + modv(tok)) * 6144;
#pragma unroll
    for (int i = 0; i < 4; ++i) {
      const int c = lane * 4 + i * 256;
      const float4 g = *(const float4*)(gn + c), sh = *(const float4*)(md + c), sc = *(const float4*)(md + DM + c);
      v[4 * i] = v[4 * i] * rs * g.x * (1.f + sc.x) + sh.x; v[4 * i + 1] = v[4 * i + 1] * rs * g.y * (1.f + sc.y) + sh.y;
      v[4 * i + 2] = v[4 * i + 2] * rs * g.z * (1.f + sc.z) + sh.z; v[4 * i + 3] = v[4 * i + 3] * rs * g.w * (1.f + sc.w) + sh.w;
    }
    store_row_i8(v, p.H() + (size_t)tok * DM, p.hs() + tok, lane);
  }
}

struct EpiIn {
  u16* zqkv; u16* zg; u16* zt; const float* hs; const float* sw;
  __device__ __forceinline__ void pre(const G8Unit& u, int wr, int fr, float (&ep)[8], float* cb) const {
    if ((ltid() >> 6) == 0) g8_cload(sw + u.pn * 256, cb);
#pragma unroll
    for (int ai = 0; ai < 2; ++ai)
#pragma unroll
      for (int m = 0; m < 4; ++m) ep[ai * 4 + m] = hs[u.pm * 256 + ai * 128 + wr * 64 + m * 16 + fr];
  }
  __device__ __forceinline__ void operator()(const i32x4 (&acc)[2][2][4][2], const G8Unit& u, int wr, int wc, int fr, int fq, const float (&ep)[8], const float* cb) const {
#pragma unroll
    for (int bj = 0; bj < 2; ++bj) {
      const int c32 = u.pn * 256 + bj * 128 + wc * 32, c0 = c32 + 8 * fq;
      const f32x4 w0 = *(const f32x4*)(cb + bj * 128 + wc * 32 + 8 * fq), w1 = *(const f32x4*)(cb + bj * 128 + wc * 32 + 8 * fq + 4);
#pragma unroll
      for (int ai = 0; ai < 2; ++ai)
#pragma unroll
        for (int m = 0; m < 4; ++m) {
          const int row = u.pm * 256 + ai * 128 + wr * 64 + m * 16 + fr;
          f32x4 a, b;
#pragma unroll
          for (int j = 0; j < 4; ++j) { a[j] = (float)acc[ai][bj][m][0][j] * ep[ai * 4 + m] * w0[j]; b[j] = (float)acc[ai][bj][m][1][j] * ep[ai * 4 + m] * w1[j]; }
          if (c32 < 384) {
            *(u32x4*)(zqkv + (size_t)row * 384 + c0) = u32x4{cvtpk(a[0], a[1]), cvtpk(a[2], a[3]), cvtpk(b[0], b[1]), cvtpk(b[2], b[3])};
          } else if (c32 < 1536) {
            *(u32x4*)(zg + (size_t)row * ZG_W + (c0 - 384)) = u32x4{cvtpk(a[0], a[1]), cvtpk(a[2], a[3]), cvtpk(b[0], b[1]), cvtpk(b[2], b[3])};
          } else {
#pragma unroll
            for (int j = 0; j < 4; ++j) { zt[(size_t)(c0 - 1536 + j) * TT + row] = f2bf(a[j]); zt[(size_t)(c0 - 1536 + 4 + j) * TT + row] = f2bf(b[j]); }
          }
        }
    }
  }
};
__device__ __forceinline__ void phase_gemm_in(const Params& p, int layer, int bid, int nb, char* lds) {
  G8Plain S; S.nM = TT / 256; S.nN = NIN / 256; S.Kb = DM; S.G = nb; S.c = bid; S.Bt = (const char*)(p.bt_in() + (size_t)layer * NIN * DM);
  EpiIn E; E.zqkv = p.zqkv(); E.zg = p.zg(); E.zt = p.zt(); E.hs = p.hs(); E.sw = p.swin() + layer * NIN;
  gemm8_phase<true>(lds, (const char*)p.H(), DM, S, E);
}

__device__ __forceinline__ size_t qkv_row(int tok, int h) {
  const int b = tok < TL ? (tok >> 14) : ((tok - TL) >> 8);
  const int s = tok < TL ? (tok & (SEQ - 1)) : SEQ + ((tok - TL) & (LC - 1));
  return ((size_t)(b * 4 + h)) * SKV + s;
}
struct EpiQkv {
  const u16* zqkv; u16* Q; u16* KV; const float* ropec; const float* ropes; float* rsl;
  unsigned* kmx;
  __device__ __forceinline__ void pre(const G8Unit&, int, int, float (&)[8], float*) const {}
  __device__ __forceinline__ void operator()(const f32x4 (&acc)[2][2][4][2], const G8Unit& u, int wr, int wc, int fr, int fq, const float (&)[8], const float*) const {
    const int tid = ltid();
    {
      const int r = tid >> 1, half = tid & 1;
      const u16* row = zqkv + (size_t)(u.pm * 256 + r) * 384;
      float sq = 0, sk = 0;
#pragma unroll
      for (int i = 0; i < 16; ++i) {
        const u32x4 w = *(const u32x4*)(row + half * 128 + i * 8);
#pragma unroll
        for (int q = 0; q < 4; ++q) { const float a = __uint_as_float(w[q] << 16), b = __uint_as_float(w[q] & 0xFFFF0000u); sq += a * a + b * b; }
      }
#pragma unroll
      for (int i = 0; i < 8; ++i) {
        const u32x4 w = *(const u32x4*)(row + 256 + half * 64 + i * 8);
#pragma unroll
        for (int q = 0; q < 4; ++q) { const float a = __uint_as_float(w[q] << 16), b = __uint_as_float(w[q] & 0xFFFF0000u); sk += a * a + b * b; }
      }
      sq += __shfl_xor(sq, 1, 64); sk += __shfl_xor(sk, 1, 64);
      if (half == 0) { rsl[r] = rsqrtf(sq * (1.f / 256.f) + EPS); rsl[256 + r] = rsqrtf(sk * (1.f / 128.f) + EPS); }
    }
    asm volatile("s_waitcnt lgkmcnt(0)" ::: "memory"); __builtin_amdgcn_s_barrier(); __builtin_amdgcn_s_barrier(); asm volatile("" ::: "memory");
    const float* rsp = rsl + (u.pn >= 2 ? 256 : 0);
#pragma unroll
    for (int ai = 0; ai < 2; ++ai)
#pragma unroll
      for (int m = 0; m < 4; ++m) {
        const int rl = ai * 128 + wr * 64 + m * 16 + fr, tok = u.pm * 256 + rl;
        const float rs = rsp[rl] * (u.pn < 2 ? A_QSCALE : 1.f);
        if (u.pn == 1) {
          f32x4 a = acc[ai][0][m][0] * rs, b = acc[ai][0][m][1] * rs;
          f32x4 pa, pb;
#pragma unroll
          for (int j = 0; j < 4; ++j) { pa[j] = __shfl_xor(a[j], 32, 64); pb[j] = __shfl_xor(b[j], 32, 64); }
          f32x4 ca = {1.f, 1.f, 1.f, 1.f}, cb = ca, sa = {0.f, 0.f, 0.f, 0.f}, sb = sa;
          if (tok < TL) {
            const float* cp = ropec + (size_t)(tok & (SEQ - 1)) * 16 + 8 * (fq & 1); const float* sp = ropes + (size_t)(tok & (SEQ - 1)) * 16 + 8 * (fq & 1);
            ca = *(const f32x4*)cp; cb = *(const f32x4*)(cp + 4); sa = *(const f32x4*)sp; sb = *(const f32x4*)(sp + 4);
          }
          const float sg = fq < 2 ? -1.f : 1.f;
          a = a * ca + pa * sa * sg; b = b * cb + pb * sb * sg;
          *(u32x4*)(Q + qkv_row(tok, wc) * 96 + 64 + 8 * fq) = u32x4{cvtpk(a[0], a[1]), cvtpk(a[2], a[3]), cvtpk(b[0], b[1]), cvtpk(b[2], b[3])};
        } else {
#pragma unroll
          for (int bj = 0; bj < 2; ++bj) {
            const int c = bj * 128 + wc * 32 + 8 * fq, h = c >> 6, d = c & 63;
            const f32x4 a = acc[ai][bj][m][0] * rs, b = acc[ai][bj][m][1] * rs;
            u16* dst = u.pn == 0 ? Q + qkv_row(tok, h) * 96 + d : KV + qkv_row(tok, h) * 160 + (u.pn == 2 ? 0 : 96) + d;
            *(u32x4*)dst = u32x4{cvtpk(a[0], a[1]), cvtpk(a[2], a[3]), cvtpk(b[0], b[1]), cvtpk(b[2], b[3])};
          }
        }
      }
    if (u.pn == 2) {
      const int b = u.pm * 256 < TL ? (u.pm * 256) >> 14 : (u.pm * 256 - TL) >> 8;
#pragma unroll
      for (int bj = 0; bj < 2; ++bj) {
        float mx = 0.f;
#pragma unroll
        for (int ai = 0; ai < 2; ++ai)
#pragma unroll
          for (int m = 0; m < 4; ++m) {
            const float rs = rsp[ai * 128 + wr * 64 + m * 16 + fr];
            const f32x4 a = acc[ai][bj][m][0] * rs, b4 = acc[ai][bj][m][1] * rs;
            float ss = a[0] * a[0] + a[1] * a[1] + a[2] * a[2] + a[3] * a[3] + b4[0] * b4[0] + b4[1] * b4[1] + b4[2] * b4[2] + b4[3] * b4[3];
            ss += __shfl_xor(ss, 16, 64); ss += __shfl_xor(ss, 32, 64);
            mx = fmaxf(mx, ss);
          }
#pragma unroll
        for (int o = 8; o > 0; o >>= 1) mx = fmaxf(mx, __shfl_xor(mx, o, 64));
        if ((ltid() & 63) == 0) atomicMax(kmx + (b * 4 + bj * 2 + (wc >> 1)) * 4 + (wc & 1), __float_as_uint(mx));
      }
    }
  }
};
__device__ __forceinline__ void phase_qkv(const Params& p, int layer, int bid, int nb, char* lds) {
  const int tid = ltid();
  {
    G8Plain S; S.nM = TT / 256; S.nN = 4; S.Kb = 768; S.G = nb; S.c = bid; S.Bt = (const char*)(p.bt_qkv() + (size_t)layer * 1024 * 384);
    EpiQkv E; E.zqkv = p.zqkv(); E.Q = p.Q(); E.KV = p.KV(); E.ropec = p.ropec(); E.ropes = p.ropes(); E.rsl = (float*)(lds + 131072); E.kmx = p.kmx() + layer * 32;
    gemm8_phase<false>(lds, (const char*)p.zqkv(), 768, S, E);
  }
  float krm0 = 0.f, krm1 = 0.f;
  for (int i = bid * NTHR + tid; i < TT * 16; i += nb * NTHR) {
    const int tok = i >> 4, f = i & 15;
    const float x1 = bf2f(p.zg()[(size_t)tok * ZG_W + ZG_KR + f]), x2 = bf2f(p.zg()[(size_t)tok * ZG_W + ZG_KR + 16 + f]);
    float cs = 1.f, sn = 0.f;
    if (tok < TL) { const int tpos = tok & (SEQ - 1); cs = p.ropec()[tpos * 16 + f]; sn = p.ropes()[tpos * 16 + f]; }
    const float y1 = x1 * cs - x2 * sn, y2 = x2 * cs + x1 * sn;
    const u16 o1 = f2bf(y1), o2 = f2bf(y2);
#pragma unroll
    for (int h = 0; h < 4; ++h) { u16* kv = p.KV() + qkv_row(tok, h) * 160 + 64; kv[f] = o1; kv[16 + f] = o2; }
    float ss = y1 * y1 + y2 * y2;
#pragma unroll
    for (int o = 8; o > 0; o >>= 1) ss += __shfl_xor(ss, o, 64);
    const int b = tok < TL ? (tok >> 14) : ((tok - TL) >> 8);
    if (b == 0) krm0 = fmaxf(krm0, ss); else krm1 = fmaxf(krm1, ss);
  }
#pragma unroll
  for (int o = 32; o > 0; o >>= 1) { krm0 = fmaxf(krm0, __shfl_xor(krm0, o, 64)); krm1 = fmaxf(krm1, __shfl_xor(krm1, o, 64)); }
  if ((tid & 63) == 0) { atomicMax(p.kmx() + layer * 32 + 0 * 16 + 2, __float_as_uint(krm0)); atomicMax(p.kmx() + layer * 32 + 1 * 16 + 2, __float_as_uint(krm1)); }
}

constexpr int A_KROW = 208;
constexpr int A_TV = 128 * 64 * 2;
constexpr int A_TK = 128 * A_KROW;
constexpr int A_BUF = A_TV + A_TK;
constexpr int A_OFF_W = 3 * A_BUF;
constexpr int ATTN_LDS = A_OFF_W + 8 * 64 * 4;
#define SBAR() __builtin_amdgcn_sched_barrier(0)
__device__ __forceinline__ int crow(int r, int hi) { return (r & 3) + 8 * (r >> 2) + 4 * hi; }

__device__ __forceinline__ void a_partialSM(f32x16& p0) {
#pragma unroll
  for (int r = 0; r < 16; ++r) p0[r] = __builtin_amdgcn_exp2f(p0[r]);
}
__device__ __forceinline__ void a_finishSM(f32x16& p0, f32x16& p1, bf16x8& pa0, bf16x8& pa1, bf16x8& pa2, bf16x8& pa3) {
#pragma unroll
  for (int r = 0; r < 16; ++r) p1[r] = __builtin_amdgcn_exp2f(p1[r]);
#define PK4(P, BASE, OUT) do { unsigned a0 = cvtpk(P[BASE + 0], P[BASE + 1]), a1 = cvtpk(P[BASE + 2], P[BASE + 3]);   \
    unsigned b0 = cvtpk(P[BASE + 4], P[BASE + 5]), b1 = cvtpk(P[BASE + 6], P[BASE + 7]);                              \
    auto r0 = __builtin_amdgcn_permlane32_swap(a0, b0, false, false); auto r1 = __builtin_amdgcn_permlane32_swap(a1, b1, false, false); \
    u32x4 w = {r0[0], r1[0], r0[1], r1[1]}; OUT = *reinterpret_cast<bf16x8*>(&w); } while (0)
  PK4(p0, 0, pa0); PK4(p0, 8, pa1); PK4(p1, 0, pa2); PK4(p1, 8, pa3);
#undef PK4
}
__device__ __forceinline__ void a_qkt(f32x16& p0, f32x16& p1, const char* Ks, const bf16x8* qr, const float mneg, int r32, int hi) {
#pragma unroll
  for (int r = 0; r < 16; ++r) { p0[r] = mneg; p1[r] = mneg; }
#pragma unroll
  for (int d0 = 0; d0 < 6; ++d0) {
    const int cb = (d0 * 16 + hi * 8) * 2;
    const bf16x8 b0 = *reinterpret_cast<const bf16x8*>(Ks + r32 * A_KROW + cb);
    const bf16x8 b1 = *reinterpret_cast<const bf16x8*>(Ks + (32 + r32) * A_KROW + cb);
    p0 = __builtin_amdgcn_mfma_f32_32x32x16_bf16(b0, qr[d0], p0, 0, 0, 0); p1 = __builtin_amdgcn_mfma_f32_32x32x16_bf16(b1, qr[d0], p1, 0, 0, 0);
  }
}
__device__ __forceinline__ int a_v_st(int k, int c) { const int kk = (k & ~0xC) | ((k & 4) << 1) | ((k & 8) >> 1); return ((kk >> 3) * 2 + (c >> 5)) * 512 + ((kk & 7) * 32 + (c & 31)) * 2; }
__device__ __forceinline__ int a_v_rd_base(int lane) { return ((lane & 3) << 3) | (((lane >> 2) & 3) << 6) | (((lane >> 4) & 1) << 5) | (((lane >> 5) & 1) << 8); }
constexpr int a_v_rd_off(int d0, int ks, int half) { return d0 * 512 + ks * 2048 + half * 1024; }
template <int OFF> __device__ __forceinline__ s16x4 a_tr_read(int vb) {
  s16x4 r; asm volatile("ds_read_b64_tr_b16 %0, %1 offset:%2" : "=&v"(r) : "v"(vb), "i"(OFF) : "memory"); return r;
}
template <int D0> __device__ __forceinline__ void a_pv_one(f32x16& od, int vb, bf16x8 pa0, bf16x8 pa1, bf16x8 pa2, bf16x8 pa3) {
  const s16x4 l0 = a_tr_read<a_v_rd_off(D0, 0, 0)>(vb), h0 = a_tr_read<a_v_rd_off(D0, 0, 1)>(vb), l1 = a_tr_read<a_v_rd_off(D0, 1, 0)>(vb), h1 = a_tr_read<a_v_rd_off(D0, 1, 1)>(vb);
  const s16x4 l2 = a_tr_read<a_v_rd_off(D0, 2, 0)>(vb), h2 = a_tr_read<a_v_rd_off(D0, 2, 1)>(vb), l3 = a_tr_read<a_v_rd_off(D0, 3, 0)>(vb), h3 = a_tr_read<a_v_rd_off(D0, 3, 1)>(vb);
  asm volatile("s_waitcnt lgkmcnt(0)" ::: "memory"); SBAR();
#define PK(L, H) (bf16x8){L[0], L[1], L[2], L[3], H[0], H[1], H[2], H[3]}
  od = __builtin_amdgcn_mfma_f32_32x32x16_bf16(pa0, PK(l0, h0), od, 0, 0, 0);
  od = __builtin_amdgcn_mfma_f32_32x32x16_bf16(pa1, PK(l1, h1), od, 0, 0, 0);
  od = __builtin_amdgcn_mfma_f32_32x32x16_bf16(pa2, PK(l2, h2), od, 0, 0, 0);
  od = __builtin_amdgcn_mfma_f32_32x32x16_bf16(pa3, PK(l3, h3), od, 0, 0, 0);
#undef PK
}
__device__ __forceinline__ void a_pv(f32x16* o, int vb, bf16x8 pa0, bf16x8 pa1, bf16x8 pa2, bf16x8 pa3) {
  a_pv_one<0>(o[0], vb, pa0, pa1, pa2, pa3);
  { const bf16x8 ones = {0x3F80, 0x3F80, 0x3F80, 0x3F80, 0x3F80, 0x3F80, 0x3F80, 0x3F80};
    o[2] = __builtin_amdgcn_mfma_f32_32x32x16_bf16(pa0, ones, o[2], 0, 0, 0); o[2] = __builtin_amdgcn_mfma_f32_32x32x16_bf16(pa1, ones, o[2], 0, 0, 0);
    o[2] = __builtin_amdgcn_mfma_f32_32x32x16_bf16(pa2, ones, o[2], 0, 0, 0); o[2] = __builtin_amdgcn_mfma_f32_32x32x16_bf16(pa3, ones, o[2], 0, 0, 0); }
  a_pv_one<1>(o[1], vb, pa0, pa1, pa2, pa3);
}

__device__ __forceinline__ void attn_item(const u16* __restrict__ Qb, const u16* __restrict__ KVh, int seq, float kmax, u16* __restrict__ yout  , char* lds) {
  const int tid = ltid(), wid = tid >> 6, lane = tid & 63, r32 = lane & 31, hi = lane >> 5;
  f32x16 o[3] = {}; bf16x8 qr[6];
  const u16* Qw = Qb + (size_t)(wid * 32 + r32) * 96 + hi * 8;
#pragma unroll
  for (int d0 = 0; d0 < 6; ++d0) qr[d0] = *reinterpret_cast<const bf16x8*>(Qw + d0 * 16);
  float mneg;
  {
    float ss = 0.f;
#pragma unroll
    for (int d0 = 0; d0 < 6; ++d0)
#pragma unroll
      for (int j = 0; j < 8; ++j) { const float v = bf2f((u16)qr[d0][j]); ss += v * v; }
    ss += __shfl_xor(ss, 32, 64);
    mneg = -sqrtf(ss) * kmax;
  }
  int lw[5];
#pragma unroll
  for (int i = 0; i < 5; ++i) {
    const int g = tid + i * 512, key = g / 20, cc = g % 20;
    lw[i] = cc < 12 ? (A_TV + key * A_KROW + cc * 16) : ((key >> 6) * 8192 + a_v_st(key & 63, (cc - 12) * 8));
  }
  const int vrb = (int)(uintptr_t)lds + a_v_rd_base(lane);
  bf16x8 sg[5];
  const char* gsrc = (const char*)KVh + tid * 16;
#define SLOAD(t) do { const char* s_ = gsrc + (size_t)(t) * 40960; _Pragma("unroll") for (int i = 0; i < 5; ++i) sg[i] = *(const bf16x8*)(s_ + i * 8192); } while (0)
#define SWRITE(bo_) do { _Pragma("unroll") for (int i = 0; i < 5; ++i) *(bf16x8*)(lds + (bo_) + lw[i]) = sg[i]; } while (0)
  f32x16 pA0, pA1, pB0, pB1; bf16x8 pa0, pa1, pa2, pa3; const int NT = seq / 128;
  SLOAD(0); SWRITE(0); if (1 < NT) SLOAD(1);
  __syncthreads();
  int bo = 0;
  {
    if (1 < NT) { SWRITE(A_BUF); if (2 < NT) SLOAD(2); }
    SBAR(); a_qkt(pA0, pA1, lds + bo + A_TV, qr, mneg, r32, hi); a_partialSM(pA0);
    SBAR(); a_qkt(pB0, pB1, lds + bo + A_TV + 64 * A_KROW, qr, mneg, r32, hi);
    a_finishSM(pA0, pA1, pa0, pa1, pa2, pa3); SBAR();
    a_pv(o, vrb + bo, pa0, pa1, pa2, pa3); a_partialSM(pB0);
    __syncthreads();
  }
  for (int t = 1; t < NT; ++t) {
    const int bp = bo;
    bo = bo + A_BUF; if (bo == 3 * A_BUF) bo = 0;
    int bn = bo + A_BUF; if (bn == 3 * A_BUF) bn = 0;
    if (t + 1 < NT) { SWRITE(bn); if (t + 2 < NT) SLOAD(t + 2); }
    SBAR(); a_qkt(pA0, pA1, lds + bo + A_TV, qr, mneg, r32, hi);
    a_finishSM(pB0, pB1, pa0, pa1, pa2, pa3); SBAR();
    a_pv(o, vrb + bp + 8192, pa0, pa1, pa2, pa3); a_partialSM(pA0);
    SBAR(); a_qkt(pB0, pB1, lds + bo + A_TV + 64 * A_KROW, qr, mneg, r32, hi);
    a_finishSM(pA0, pA1, pa0, pa1, pa2, pa3); SBAR();
    a_pv(o, vrb + bo, pa0, pa1, pa2, pa3); a_partialSM(pB0);
    __syncthreads();
  }
  a_finishSM(pB0, pB1, pa0, pa1, pa2, pa3); SBAR();
  a_pv(o, vrb + bo + 8192, pa0, pa1, pa2, pa3);
#pragma unroll
  for (int r = 0; r < 16; ++r) {
    const int orow = crow(r, hi);
    const float rl = __builtin_amdgcn_rcpf(o[2][r]);
    const float v0 = o[0][r] * rl, v1 = o[1][r] * rl;
    float ss = v0 * v0 + v1 * v1;
#pragma unroll
    for (int off = 16; off > 0; off >>= 1) ss += __shfl_xor(ss, off, 64);
    const float rs = rsqrtf(ss * (1.f / 64.f) + EPS);
    u16* dst = yout + (size_t)(wid * 32 + orow) * DM;
    dst[r32] = f2bf(v0 * rs); dst[32 + r32] = f2bf(v1 * rs);
  }
  __syncthreads();
#undef SLOAD
#undef SWRITE
}

__device__ __forceinline__ void phase_attn(const Params& p, int layer, int bid, int nb, char* lds) {
  const int nitems = 512 + (layer == 0 ? 8 : 0);
  const unsigned* kmx = p.kmx() + layer * 32;
  for (int it = bid; it < nitems; it += nb) {
    int b, h, q0, k0, seq, tok0;
    if (it < 512) { const int pair = it & 7, qb = (it >> 3); h = pair & 3; b = pair >> 2; q0 = qb * 256; k0 = 0; seq = SKV; tok0 = b * SEQ + qb * 256; }
    else { const int i2 = it - 512; h = i2 & 3; b = i2 >> 2; q0 = SEQ; k0 = SEQ; seq = LC; tok0 = TL + b * LC; }
    const size_t base = (size_t)(b * 4 + h) * SKV;
    const float k2 = __uint_as_float(kmx[(b * 4 + h) * 4 + 0]) + __uint_as_float(kmx[(b * 4 + h) * 4 + 1]) + __uint_as_float(kmx[b * 16 + 2]);
    attn_item(p.Q() + (base + q0) * 96, p.KV() + (base + k0) * 160, seq, sqrtf(k2) * 1.02f, p.ymix() + (size_t)tok0 * DM + h * 64, lds);
  }
}

__device__ __forceinline__ float hy_sconv(const u16* __restrict__ row, int t, int Ls, float w0, float w1, float w2, float bb) {
  const float zm = t > 0 ? bf2f(row[t - 1]) : 0.f, z0 = bf2f(row[t]), zp = t + 1 < Ls ? bf2f(row[t + 1]) : 0.f;
  return w0 * zm + w1 * z0 + w2 * zp + bb;
}
__device__ __forceinline__ float2 hy_sconv2(unsigned prv, unsigned cur, unsigned nxt, float w0, float w1, float w2, float bb) {
  const float zm = __uint_as_float(prv & 0xFFFF0000u), z0 = __uint_as_float(cur << 16), z1 = __uint_as_float(cur & 0xFFFF0000u), z2 = __uint_as_float(nxt << 16);
  return make_float2(w0 * zm + w1 * z0 + w2 * z1 + bb, w0 * z0 + w1 * z1 + w2 * z2 + bb);
}
__device__ __forceinline__ void hyena_item(const Params& p, int layer, int b, int ch, char* lds) {
  float2* s = (float2*)lds;
  const int tid = ltid();
  const float* cw = p.hy_conv_w() + (size_t)layer * 3 * 768; const float* cb = p.hy_conv_b() + (size_t)layer * 768;
  const unsigned* r0 = (const unsigned*)(p.zt() + (size_t)(ZT_HY + ch) * TT + (size_t)b * SEQ);
  const unsigned* r1 = (const unsigned*)(p.zt() + (size_t)(ZT_HY + 256 + ch) * TT + (size_t)b * SEQ);
  const unsigned* r2 = (const unsigned*)(p.zt() + (size_t)(ZT_HY + 512 + ch) * TT + (size_t)b * SEQ);
  const float a0 = cw[ch], a1 = cw[768 + ch], a2 = cw[1536 + ch], ab = cb[ch];
  const float b0 = cw[256 + ch], b1 = cw[768 + 256 + ch], b2 = cw[1536 + 256 + ch], bb = cb[256 + ch];
  const float c0 = cw[512 + ch], c1 = cw[768 + 512 + ch], c2 = cw[1536 + 512 + ch], cbb = cb[512 + ch];
  unsigned vgr[16], x0r[16];
#pragma unroll
  for (int hb2 = 0; hb2 < 2; ++hb2) {
    unsigned ld[8][9];
#pragma unroll
    for (int ii = 0; ii < 8; ++ii) {
      const int m = tid + 512 * (hb2 * 8 + ii);
      const int mp = m > 0 ? m - 1 : 0, mn = m + 1 < SEQ / 2 ? m + 1 : m;
      ld[ii][0] = r0[mp]; ld[ii][1] = r0[m]; ld[ii][2] = r0[mn];
      ld[ii][3] = r1[mp]; ld[ii][4] = r1[m]; ld[ii][5] = r1[mn];
      ld[ii][6] = r2[mp]; ld[ii][7] = r2[m]; ld[ii][8] = r2[mn];
    }
#pragma unroll
    for (int ii = 0; ii < 8; ++ii) {
      const int i = hb2 * 8 + ii, m = tid + 512 * i;
      const unsigned mkp = m > 0 ? 0xFFFFFFFFu : 0u, mkn = m + 1 < SEQ / 2 ? 0xFFFFFFFFu : 0u;
      const float2 ux = hy_sconv2(ld[ii][0] & mkp, ld[ii][1], ld[ii][2] & mkn, a0, a1, a2, ab);
      x0r[i] = cvtpk(ux.x, ux.y);
      const float2 u1 = hy_sconv2(ld[ii][3] & mkp, ld[ii][4], ld[ii][5] & mkn, b0, b1, b2, bb);
      const float2 uv = hy_sconv2(ld[ii][6] & mkp, ld[ii][7], ld[ii][8] & mkn, c0, c1, c2, cbb);
      const float2 vgf = make_float2(uv.x * u1.x, uv.y * u1.y);
      vgr[i] = cvtpk(vgf.x, vgf.y);
      s[swz(m)] = vgf;
      s[swz(m + SEQ / 2)] = make_float2(0.f, 0.f);
    }
  }
  __syncthreads();
  fft_fwd(s, p.tw());
  {
    const float4* hs = p.hspec() + ((size_t)layer * 256 + ch) * HSP;
    float4 hv[17];
#pragma unroll
    for (int i = 0; i < 17; ++i) { const int k = tid + 512 * i; hv[i] = hs[k <= FM / 2 ? k : 0]; }
    const float2 twl = p.tw()[tid];
#pragma unroll
    for (int i = 0; i < 17; ++i) {
      const int k = tid + 512 * i;
      if (k <= FM / 2) {
        const int pk = swz(rev7(k)), pm = swz(rev7((FM - k) & (FM - 1)));
        const float2 zk = s[pk], zm = s[pm];
        const float4 h = hv[i];
        const float2 He = make_float2(h.x, h.y), Ho = make_float2(h.z, h.w);
        const float2 Xe = make_float2(0.5f * (zk.x + zm.x), 0.5f * (zk.y - zm.y));
        const float2 Xo = make_float2(0.5f * (zk.y + zm.y), -0.5f * (zk.x - zm.x));
        const float2 twk = cmul(twl, p.tw()[512 * i]);
        const float2 t1 = cmul(twk, cmul(Xo, Ho));
        const float2 e1 = cmul(Xe, He);
        const float2 Ye = make_float2(e1.x + t1.x, e1.y + t1.y);
        const float2 o1 = cmul(Xe, Ho), o2 = cmul(Xo, He);
        const float2 Yo = make_float2(o1.x + o2.x, o1.y + o2.y);
        s[pk] = make_float2(Ye.x - Yo.y, Ye.y + Yo.x);
        if (pm != pk) s[pm] = make_float2(Ye.x + Yo.y, -Ye.y + Yo.x);
      }
    }
  }
  __syncthreads();
  fft_inv(s, p.tw());
  const float hb = p.hy_bias()[layer * 256 + ch];
  unsigned* orow = (unsigned*)(p.hyo() + (size_t)ch * TT + (size_t)b * SEQ);
#pragma unroll
  for (int i = 0; i < 16; ++i) {
    const int m = tid + 512 * i;
    const float2 y = s[swz(m)];
    orow[m] = cvtpk((y.x + __uint_as_float(vgr[i] << 16) * hb) * __uint_as_float(x0r[i] << 16), (y.y + __uint_as_float(vgr[i] & 0xFFFF0000u) * hb) * __uint_as_float(x0r[i] & 0xFFFF0000u));
  }
  __syncthreads();
}
__device__ __forceinline__ void fnet_item(const Params& p, int b, int j, char* lds) {
  float2* s = (float2*)lds;
  const int tid = ltid();
  const u16* rr = p.zt() + (size_t)(ZT_FR + j) * TT + (size_t)b * SEQ;
  const u16* ri = p.zt() + (size_t)(ZT_FI + j) * TT + (size_t)b * SEQ;
  {
    u32x4 vr[4], vi[4];
#pragma unroll
    for (int i = 0; i < 4; ++i) { const int m0 = (tid + 512 * i) * 8; vr[i] = *(const u32x4*)(rr + m0); vi[i] = *(const u32x4*)(ri + m0); }
#pragma unroll
    for (int i = 0; i < 4; ++i) {
      const int m0 = (tid + 512 * i) * 8;
#pragma unroll
      for (int q = 0; q < 4; ++q) {
        s[swz(m0 + 2 * q)] = make_float2(__uint_as_float(vr[i][q] << 16), __uint_as_float(vi[i][q] << 16));
        s[swz(m0 + 2 * q + 1)] = make_float2(__uint_as_float(vr[i][q] & 0xFFFF0000u), __uint_as_float(vi[i][q] & 0xFFFF0000u));
      }
    }
  }
  __syncthreads();
  fft_fwd(s, p.tw());
#ifdef PROBE_FFT
  fft_inv(s, p.tw());
  for (int m = tid; m < FM; m += NTHR) { float2 v = s[m]; v.x *= (1.f / 16384.f); v.y *= (1.f / 16384.f); s[m] = v; }
  __syncthreads();
  fft_fwd(s, p.tw());
#endif
  u16* orow = p.fno() + (size_t)j * TT + (size_t)b * SEQ;
#pragma unroll 8
  for (int k = tid; k < FM; k += NTHR) orow[k] = f2bf(s[swz(rev7(k))].x * (1.f / 128.f));
  __syncthreads();
}
__device__ __forceinline__ void hyena_ctx_item(const Params& p, int b, int ch, char* lds) {
  float* vg = (float*)lds;
  float* x0 = vg + 256;
  float* hf = x0 + 256;
  float* hbk = hf + 256;
  const int tid = ltid();
  const float* cw = p.hy_conv_w(); const float* cb = p.hy_conv_b();
  const size_t off = (size_t)TL + (size_t)b * LC;
  const u16* r0 = p.zt() + (size_t)(ZT_HY + ch) * TT + off;
  const u16* r1 = p.zt() + (size_t)(ZT_HY + 256 + ch) * TT + off;
  const u16* r2 = p.zt() + (size_t)(ZT_HY + 512 + ch) * TT + off;
  if (tid < 256) {
    const int t = tid;
    vg[t] = hy_sconv(r2, t, LC, cw[512 + ch], cw[768 + 512 + ch], cw[1536 + 512 + ch], cb[512 + ch]) *
            hy_sconv(r1, t, LC, cw[256 + ch], cw[768 + 256 + ch], cw[1536 + 256 + ch], cb[256 + ch]);
    x0[t] = hy_sconv(r0, t, LC, cw[ch], cw[768 + ch], cw[1536 + ch], cb[ch]);
    hf[t] = p.hfc()[(size_t)ch * LC + t]; hbk[t] = p.hfc()[(size_t)(256 + ch) * LC + t];
  }
  const float ssq_c = filt_ssq(p.hpart() + (size_t)2 * 256 * 512, ch, (float*)(lds + 8192));
  if (tid < 256) {
    const int t = tid; float y = 0;
    for (int q = 0; q <= t; ++q) y += hf[t - q] * vg[q];
    for (int q = t + 1; q < LC; ++q) y += hbk[q - t] * vg[q];
    y *= rsqrtf(ssq_c);
    p.hyo()[(size_t)ch * TT + off + t] = f2bf((y + vg[t] * p.hy_bias()[ch]) * x0[t]);
  }
  __syncthreads();
}
__device__ __forceinline__ void fnet_ctx_item(const Params& p, int b, int j, char* lds) {
  float* ur = (float*)lds; float* ui = ur + 256; float* cst = ui + 256; float* snt = cst + 256;
  const int tid = ltid();
  const size_t off = (size_t)TL + (size_t)b * LC;
  if (tid < 256) {
    ur[tid] = bf2f(p.zt()[(size_t)(ZT_FR + j) * TT + off + tid]); ui[tid] = bf2f(p.zt()[(size_t)(ZT_FI + j) * TT + off + tid]);
    float sn, cs; sincospif((float)tid / 128.f, &sn, &cs); cst[tid] = cs; snt[tid] = sn;
  }
  __syncthreads();
  if (tid < 256) {
    const int k = tid; float y = 0;
    for (int l = 0; l < 256; ++l) { const int m = (l * k) & 255; y += cst[m] * ur[l] + snt[m] * ui[l]; }
    p.fno()[(size_t)j * TT + off + k] = f2bf(y * 0.0625f);
  }
  __syncthreads();
}
__device__ __forceinline__ void phase_fftmix(const Params& p, int layer, int bid, int nb, char* lds) {
  const int nitems = layer == 0 ? 2048 : 1024;
  for (int it = bid; it < nitems; it += nb) {
    const int k = it & 511, b = k >> 8, c = k & 255;
    if (it < 512) hyena_item(p, layer, b, c, lds);
    else if (it < 1024) fnet_item(p, b, c, lds);
    else if (it < 1536) hyena_ctx_item(p, b, c, lds);
    else fnet_ctx_item(p, b, c, lds);
  }
}
constexpr int GLG = 17, NGRP = 16;
__device__ __forceinline__ int gla_chain_tok(int dir, int b, int n, int i) {
  const int base = n < 4 ? TL + b * LC : b * SEQ, len = n < 4 ? LC : SEQ, m = n < 4 ? n : n - 4;
  return dir == 0 ? base + 64 * m + i : base + (len - 1) - (64 * m + i);
}
__device__ __forceinline__ float logsig16(float x) { return (fminf(x, 0.f) - log1pf(__expf(-fabsf(x)))) * (1.f / 16.f); }
__device__ __forceinline__ float wave_scan_incl(float v, int lane) {
#pragma unroll
  for (int o = 1; o < 64; o <<= 1) { const float t = __shfl_up(v, o, 64); if (lane >= o) v += t; }
  return v;
}
__device__ __forceinline__ void phase_gla_a(const Params& p, int layer, int bid, int nb, char* lds) {
  float* kl = (float*)lds;
  float* gl = kl + 64 * 33;
  float* vl = gl + 64 * 33;
  const int tid = ltid(), wid = tid >> 6, lane = tid & 63;
  const float* gb = p.gla_gk_b() + (size_t)layer * 256;
  for (int it = bid; it < 16 * NGRP; it += nb) {
    const int chain = it >> 4, g = it & 15, dir = chain >> 3, b = (chain >> 2) & 1, h = chain & 3;
    const int n0 = g * GLG, n1 = min(n0 + GLG, NCH);
    const int kk = tid >> 4, v0 = (tid & 15) * 4;
    float st[4] = {0.f, 0.f, 0.f, 0.f}; float dcum = 1.f;
    const int li = tid >> 3, c4 = (tid & 7) * 4;
    const float4 bb = *(const float4*)(gb + dir * 128 + h * 32 + c4);
    u32x2 rk, rg, rva, rvb;
#define GLA_LOAD(n_) do { const u16* zr = p.zg() + (size_t)gla_chain_tok(dir, b, (n_), li) * ZG_W; \
      rk = *(const u32x2*)(zr + ZG_GK + h * 32 + c4); rg = *(const u32x2*)(zr + ZG_GP + dir * 128 + h * 32 + c4); \
      rva = *(const u32x2*)(zr + ZG_GV + h * 64 + c4 * 2); rvb = *(const u32x2*)(zr + ZG_GV + h * 64 + c4 * 2 + 4); } while (0)
#define BF_LO(w) __uint_as_float((w) << 16)
#define BF_HI(w) __uint_as_float((w) & 0xFFFF0000u)
    GLA_LOAD(n0);
    for (int n = n0; n < n1; ++n) {
      {
        kl[li * 33 + c4] = BF_LO(rk[0]); kl[li * 33 + c4 + 1] = BF_HI(rk[0]); kl[li * 33 + c4 + 2] = BF_LO(rk[1]); kl[li * 33 + c4 + 3] = BF_HI(rk[1]);
        gl[li * 33 + c4] = logsig16(BF_LO(rg[0]) + bb.x); gl[li * 33 + c4 + 1] = logsig16(BF_HI(rg[0]) + bb.y);
        gl[li * 33 + c4 + 2] = logsig16(BF_LO(rg[1]) + bb.z); gl[li * 33 + c4 + 3] = logsig16(BF_HI(rg[1]) + bb.w);
        *(float4*)(vl + li * 68 + c4 * 2) = make_float4(BF_LO(rva[0]), BF_HI(rva[0]), BF_LO(rva[1]), BF_HI(rva[1]));
        *(float4*)(vl + li * 68 + c4 * 2 + 4) = make_float4(BF_LO(rvb[0]), BF_HI(rvb[0]), BF_LO(rvb[1]), BF_HI(rvb[1]));
      }
      if (n + 1 < n1) GLA_LOAD(n + 1);
      __syncthreads();
#pragma unroll
      for (int q = 0; q < 4; ++q) { const int c = wid * 4 + q; gl[lane * 33 + c] = wave_scan_incl(gl[lane * 33 + c], lane); }
      __syncthreads();
#pragma unroll
      for (int j = 0; j < 4; ++j) kl[li * 33 + c4 + j] *= __expf(gl[63 * 33 + c4 + j] - gl[li * 33 + c4 + j]);
      __syncthreads();
      {
        float* lp = p.gds() + ((size_t)chain * NCH + n) * 2048 + kk * 64 + v0;
        *(float4*)lp = make_float4(st[0], st[1], st[2], st[3]);
        if ((tid & 15) == 0) p.gdv()[((size_t)chain * NCH + n) * 32 + kk] = dcum;
        float acc[4] = {0.f, 0.f, 0.f, 0.f};
#pragma unroll 16
        for (int i = 0; i < 64; ++i) {
          const float w = kl[i * 33 + kk];
          const float4 vv = *(const float4*)(vl + i * 68 + v0);
          acc[0] += w * vv.x; acc[1] += w * vv.y; acc[2] += w * vv.z; acc[3] += w * vv.w;
        }
        const float d = __expf(gl[63 * 33 + kk]);
#pragma unroll
        for (int j = 0; j < 4; ++j) st[j] = st[j] * d + acc[j];
        dcum *= d;
      }
      __syncthreads();
    }
#undef GLA_LOAD
    float* at = p.gst() + ((size_t)chain * NGRP + g) * 2048 + kk * 64 + v0;
    *(float4*)at = make_float4(st[0], st[1], st[2], st[3]);
    if ((tid & 15) == 0) p.gst()[(size_t)16 * NGRP * 2048 + ((size_t)chain * NGRP + g) * 32 + kk] = dcum;
  }
}

constexpr int GC_QP = 33792, GC_KP = GC_QP + 10240, GC_VT = GC_KP + 10240, GC_ST = GC_VT + 18432, GC_AX = GC_ST + 10240;
__device__ __forceinline__ void phase_gla_c(const Params& p, int layer, int bid, int nb, char* lds) {
  float* gl = (float*)lds;
  float* qraw = gl + 2 * 64 * 33;
  float* kraw = qraw + 64 * 33;
  float* Of = (float*)lds;
  char* Qp = lds + GC_QP;
  char* Kp = lds + GC_KP;
  char* VT = lds + GC_VT;
  char* ST = lds + GC_ST;
  const int tid = ltid(), wid = tid >> 6, lane = tid & 63, r32 = lane & 31, hi = lane >> 5;
  char* Ax = lds + GC_AX + wid * 4608;
  const float* gb = p.gla_gk_b() + (size_t)layer * 256;
  const int pc_lo = layer == 0 ? 0 : 4, npc = NCH - pc_lo, nitem = 8 * npc;
  const int per = (nitem + nb - 1) / nb, q_beg = bid * per, q_end = min(nitem, q_beg + per);
  const int sdir = tid >> 8, sk = (tid >> 3) & 31, sv0 = (tid & 7) * 8;
  float G[8]; int g_cached = -1, bh_cached = -1;
  for (int qi = q_beg; qi < q_end; ++qi) {
    const int bh = qi / npc, pc = pc_lo + qi % npc, b = bh >> 2, h = bh & 3;
    const int tok0 = pc < 4 ? TL + b * LC + pc * 64 : b * SEQ + (pc - 4) * 64;
    {
      const int pos = tid >> 3, c4 = (tid & 7) * 4;
      const u16* zr = p.zg() + (size_t)(tok0 + pos) * ZG_W;
      const float4 q4 = ld4bf(zr + ZG_GQ + h * 32 + c4), k4 = ld4bf(zr + ZG_GK + h * 32 + c4);
      const float sc = 0.17677669529663687f;
      qraw[pos * 33 + c4] = q4.x * sc; qraw[pos * 33 + c4 + 1] = q4.y * sc; qraw[pos * 33 + c4 + 2] = q4.z * sc; qraw[pos * 33 + c4 + 3] = q4.w * sc;
      kraw[pos * 33 + c4] = k4.x; kraw[pos * 33 + c4 + 1] = k4.y; kraw[pos * 33 + c4 + 2] = k4.z; kraw[pos * 33 + c4 + 3] = k4.w;
#pragma unroll
      for (int d = 0; d < 2; ++d) {
        const float4 g4 = ld4bf(zr + ZG_GP + d * 128 + h * 32 + c4), bb = *(const float4*)(gb + d * 128 + h * 32 + c4);
        const int i = d ? 63 - pos : pos;
        float* gd = gl + (d * 64 + i) * 33 + c4;
        gd[0] = logsig16(g4.x + bb.x); gd[1] = logsig16(g4.y + bb.y); gd[2] = logsig16(g4.z + bb.z); gd[3] = logsig16(g4.w + bb.w);
      }
      const float4 va = ld4bf(zr + ZG_GV + h * 64 + c4 * 2), vb = ld4bf(zr + ZG_GV + h * 64 + c4 * 2 + 4);
      const float vv[8] = {va.x, va.y, va.z, va.w, vb.x, vb.y, vb.z, vb.w};
#pragma unroll
      for (int j = 0; j < 8; ++j) {
        const u16 hv = f2bf(vv[j]); const int v = c4 * 2 + j;
        *(u16*)(VT + (0 * 64 + v) * 144 + pos * 2) = hv; *(u16*)(VT + (1 * 64 + v) * 144 + (63 - pos) * 2) = hv;
      }
    }
    __syncthreads();
#pragma unroll
    for (int q = 0; q < 8; ++q) { const int col = wid * 8 + q, d = col >> 5, c = col & 31; float* gp = gl + (d * 64 + lane) * 33 + c; *gp = wave_scan_incl(*gp, lane); }
    __syncthreads();
    {
#pragma unroll
      for (int e = 0; e < 2; ++e) {
        const int idx = tid + e * 512, d = idx >> 9, i = (idx >> 3) & 63, c4 = (idx & 7) * 4, pos = d ? 63 - i : i;
        float qo[4], ko[4];
#pragma unroll
        for (int j = 0; j < 4; ++j) {
          const float bi = gl[(d * 64 + i) * 33 + c4 + j], bm = gl[(d * 64 + 31) * 33 + c4 + j];
          qo[j] = qraw[pos * 33 + c4 + j] * __expf(bi - bm); ko[j] = kraw[pos * 33 + c4 + j] * __expf(bm - bi);
        }
        *(u32x2*)(Qp + (d * 64 + i) * 80 + c4 * 2) = u32x2{cvtpk(qo[0], qo[1]), cvtpk(qo[2], qo[3])};
        *(u32x2*)(Kp + (d * 64 + i) * 80 + c4 * 2) = u32x2{cvtpk(ko[0], ko[1]), cvtpk(ko[2], ko[3])};
      }
      const int chain = sdir * 8 + b * 4 + h;
      const int n = sdir == 0 ? pc : (pc < 4 ? 3 - pc : 4 + 255 - (pc - 4)), g = n / GLG;
      if (g != g_cached || bh != bh_cached) {
#pragma unroll
        for (int j = 0; j < 8; ++j) G[j] = 0.f;
        const float* at = p.gst() + (size_t)chain * NGRP * 2048 + sk * 64 + sv0;
        const float* dt = p.gst() + (size_t)16 * NGRP * 2048 + (size_t)chain * NGRP * 32 + sk;
        for (int gg = 0; gg < g; ++gg) {
          const float4 a0 = *(const float4*)(at + (size_t)gg * 2048), a1 = *(const float4*)(at + (size_t)gg * 2048 + 4); const float dd = dt[gg * 32];
          G[0] = G[0] * dd + a0.x; G[1] = G[1] * dd + a0.y; G[2] = G[2] * dd + a0.z; G[3] = G[3] * dd + a0.w;
          G[4] = G[4] * dd + a1.x; G[5] = G[5] * dd + a1.y; G[6] = G[6] * dd + a1.z; G[7] = G[7] * dd + a1.w;
        }
        g_cached = g; bh_cached = bh;
      }
      const float* lp = p.gds() + ((size_t)chain * NCH + n) * 2048 + sk * 64 + sv0;
      const float4 l0 = *(const float4*)lp, l1 = *(const float4*)(lp + 4);
      const float dp = p.gdv()[((size_t)chain * NCH + n) * 32 + sk];
      const float em = __expf(gl[(sdir * 64 + 31) * 33 + sk]);
      const float sv[8] = {l0.x + dp * G[0], l0.y + dp * G[1], l0.z + dp * G[2], l0.w + dp * G[3], l1.x + dp * G[4], l1.y + dp * G[5], l1.z + dp * G[6], l1.w + dp * G[7]};
#pragma unroll
      for (int j = 0; j < 8; ++j) *(u16*)(ST + (sdir * 64 + sv0 + j) * 80 + sk * 2) = f2bf(sv[j] * em);
    }
    __syncthreads();
    {
      const int d = wid >> 2, ib = (wid >> 1) & 1, vb = wid & 1;
      const char* Qd = Qp + d * 64 * 80; const char* Kd = Kp + d * 64 * 80; const char* Vd = VT + d * 64 * 144; const char* Sd = ST + d * 64 * 80;
      bf16x8 qf[2];
#pragma unroll
      for (int s2 = 0; s2 < 2; ++s2) qf[s2] = *(const bf16x8*)(Qd + (ib * 32 + r32) * 80 + (16 * s2 + 8 * hi) * 2);
#pragma unroll
      for (int jb = 0; jb < 2; ++jb) {
        if (jb <= ib) {
          f32x16 x = {};
#pragma unroll
          for (int s2 = 0; s2 < 2; ++s2) {
            const bf16x8 kf = *(const bf16x8*)(Kd + (jb * 32 + r32) * 80 + (16 * s2 + 8 * hi) * 2);
            x = __builtin_amdgcn_mfma_f32_32x32x16_bf16(qf[s2], kf, x, 0, 0, 0);
          }
#pragma unroll
          for (int r = 0; r < 16; ++r) {
            const int il = crow(r, hi), i = ib * 32 + il, j = jb * 32 + r32;
            *(u16*)(Ax + il * 144 + j * 2) = f2bf(j <= i ? x[r] : 0.f);
          }
        }
      }
      asm volatile("s_waitcnt lgkmcnt(0)" ::: "memory");
      f32x16 o = {};
#pragma unroll
      for (int s4 = 0; s4 < 4; ++s4) {
        if (s4 < 2 * (ib + 1)) {
          const bf16x8 af = *(const bf16x8*)(Ax + r32 * 144 + (16 * s4 + 8 * hi) * 2);
          const bf16x8 vf = *(const bf16x8*)(Vd + (vb * 32 + r32) * 144 + (16 * s4 + 8 * hi) * 2);
          o = __builtin_amdgcn_mfma_f32_32x32x16_bf16(af, vf, o, 0, 0, 0);
        }
      }
#pragma unroll
      for (int s2 = 0; s2 < 2; ++s2) {
        const bf16x8 sf = *(const bf16x8*)(Sd + (vb * 32 + r32) * 80 + (16 * s2 + 8 * hi) * 2);
        o = __builtin_amdgcn_mfma_f32_32x32x16_bf16(qf[s2], sf, o, 0, 0, 0);
      }
#pragma unroll
      for (int r = 0; r < 16; ++r) {
        const int i = ib * 32 + crow(r, hi), pos = d ? 63 - i : i;
        Of[(d * 64 + pos) * 65 + vb * 32 + r32] = o[r];
      }
    }
    __syncthreads();
    {
      const int pos = tid >> 3, v0 = (tid & 7) * 8;
      u16* op = p.glao() + (size_t)(tok0 + pos) * 256 + h * 64 + v0;
      float r8[8];
#pragma unroll
      for (int j = 0; j < 8; ++j) r8[j] = Of[pos * 65 + v0 + j] + Of[(64 + pos) * 65 + v0 + j];
      *(u32x4*)op = u32x4{cvtpk(r8[0], r8[1]), cvtpk(r8[2], r8[3]), cvtpk(r8[4], r8[5]), cvtpk(r8[6], r8[7])};
    }
    __syncthreads();
  }
}

__device__ __forceinline__ void phase_mix(const Params& p, int layer, int bid, int nb, char* lds) {
  float* part = (float*)lds;
  u16* tile = (u16*)(lds + 4096);
  const int tid = ltid(), wid = tid >> 6, lane = tid & 63;
  const int ntok = layer == 0 ? TT : TL;
  for (int it = bid; it < ntok / 64; it += nb) {
    const int tok0 = it * 64;
    float vh[32], vf[32]; float sh = 0, sf = 0;
#pragma unroll
    for (int c = 0; c < 32; ++c) {
      vh[c] = bf2f(p.hyo()[(size_t)(wid * 32 + c) * TT + tok0 + lane]); vf[c] = bf2f(p.fno()[(size_t)(wid * 32 + c) * TT + tok0 + lane]);
      sh += vh[c] * vh[c]; sf += vf[c] * vf[c];
    }
    part[(0 * 8 + wid) * 64 + lane] = sh; part[(1 * 8 + wid) * 64 + lane] = sf;
    __syncthreads();
    float th = 0, tf = 0;
#pragma unroll
    for (int q = 0; q < 8; ++q) { th += part[(0 * 8 + q) * 64 + lane]; tf += part[(1 * 8 + q) * 64 + lane]; }
    const float rh = rsqrtf(th * (1.f / 256.f) + EPS), rf = rsqrtf(tf * (1.f / 256.f) + EPS);
#pragma unroll
    for (int c = 0; c < 32; ++c) { tile[lane * 520 + wid * 32 + c] = f2bf(vh[c] * rh); tile[lane * 520 + 256 + wid * 32 + c] = f2bf(vf[c] * rf); }
    __syncthreads();
    for (int g = tid; g < 64 * 64; g += NTHR) {
      const int tl = g >> 6, cg = g & 63;
      const u32x4 w = *(const u32x4*)(tile + tl * 520 + cg * 8);
      *(u32x4*)(p.ymix() + (size_t)(tok0 + tl) * DM + (cg < 32 ? 256 + cg * 8 : 768 + (cg - 32) * 8)) = w;
    }
    for (int tl = wid * 8; tl < wid * 8 + 8; ++tl) {
      const int tok = tok0 + tl;
      const float4 o = ld4bf(p.glao() + (size_t)tok * 256 + lane * 4);
      float ss = o.x * o.x + o.y * o.y + o.z * o.z + o.w * o.w;
#pragma unroll
      for (int off = 8; off > 0; off >>= 1) ss += __shfl_xor(ss, off, 64);
      const float rs = rsqrtf(ss * (1.f / 64.f) + EPS);
      const float4 g = ld4bf(p.zg() + (size_t)tok * ZG_W + ZG_OG + lane * 4);
      u32x2 w; w[0] = cvtpk(o.x * rs * silu_f(g.x), o.y * rs * silu_f(g.y)); w[1] = cvtpk(o.z * rs * silu_f(g.z), o.w * rs * silu_f(g.w));
      *(u32x2*)(p.ymix() + (size_t)tok * DM + 512 + lane * 4) = w;
    }
    __syncthreads();
  }
}

struct EpiOut {
  const Params* pp; int layer;
  __device__ __forceinline__ void pre(const G8Unit& u, int, int, float (&)[8], float* cb) const {
    if ((ltid() >> 6) == 0) g8_cload(pp->mod() + ((size_t)layer * 3 + modv(u.pm * 256)) * 6144 + 2 * DM + u.pn * 256, cb);
  }
  __device__ __forceinline__ void operator()(const f32x4 (&acc)[2][2][4][2], const G8Unit& u, int wr, int wc, int fr, int fq, const float (&)[8], const float* cb) const {
    const Params& p = *pp;
#pragma unroll
    for (int bj = 0; bj < 2; ++bj) {
      const int c0 = u.pn * 256 + bj * 128 + wc * 32 + 8 * fq;
      const f32x4 ga = *(const f32x4*)(cb + bj * 128 + wc * 32 + 8 * fq), gb = *(const f32x4*)(cb + bj * 128 + wc * 32 + 8 * fq + 4);
#pragma unroll
      for (int ai = 0; ai < 2; ++ai)
#pragma unroll
        for (int m = 0; m < 4; ++m) {
          const int tok = u.pm * 256 + ai * 128 + wr * 64 + m * 16 + fr;
          u16* xo = p.X() + (size_t)tok * DM + c0;
          f32x4 xa, xb;
          if (layer == 0) { const float* xr = resid_row_in(p, tok) + c0; xa = *(const f32x4*)xr; xb = *(const f32x4*)(xr + 4); }
          else { const u32x4 w = *(const u32x4*)xo;
            xa = f32x4{__uint_as_float(w[0] << 16), __uint_as_float(w[0] & 0xFFFF0000u), __uint_as_float(w[1] << 16), __uint_as_float(w[1] & 0xFFFF0000u)};
            xb = f32x4{__uint_as_float(w[2] << 16), __uint_as_float(w[2] & 0xFFFF0000u), __uint_as_float(w[3] << 16), __uint_as_float(w[3] & 0xFFFF0000u)}; }
          xa = xa + ga * acc[ai][bj][m][0]; xb = xb + gb * acc[ai][bj][m][1];
          *(u32x4*)xo = u32x4{cvtpk(xa[0], xa[1]), cvtpk(xa[2], xa[3]), cvtpk(xb[0], xb[1]), cvtpk(xb[2], xb[3])};
        }
    }
  }
};
__device__ __forceinline__ void phase_gemm_out(const Params& p, int layer, int bid, int nb, char* lds) {
  G8Plain S; S.nM = (layer == 0 ? TT : TL) / 256; S.nN = DM / 256; S.Kb = 2 * DM; S.G = nb; S.c = bid; S.Bt = (const char*)(p.bt_out() + (size_t)layer * DM * DM);
  EpiOut E; E.pp = &p; E.layer = layer;
  gemm8_phase<false>(lds, (const char*)p.ymix(), 2 * DM, S, E);
}

__device__ __forceinline__ void phase_norm2_router(const Params& p, int layer, int bid, int nb, char* lds) {
  float* rwl = (float*)lds;
  int* lcnt = (int*)(lds + 131072);
  int* lbase = lcnt + 32;
  int* ent = lbase + 32;
  float* entw = (float*)(ent + 2 * 640);
  float* ents = entw + 640;
  const int tid = ltid(), wid = tid >> 6, lane = tid & 63;
  const int ntok = layer == 0 ? TT : TL;
  const float* rw = p.router_w() + (size_t)layer * DM * NE;
  for (int i = tid; i < DM * NE / 4; i += NTHR) {
    const int k = i >> 3, q4 = i & 7;
    ((float4*)rwl)[q4 * 1024 + ((k & 3) * 256 + (k >> 2))] = ((const float4*)rw)[i];
  }
  if (tid < 32) lcnt[tid] = 0;
  __syncthreads();
  const float* gn = p.norm2_g() + layer * DM; const float* rb = p.router_b() + layer * NE;
  const int per = (ntok + nb - 1) / nb, t_beg = bid * per, t_end = min(ntok, t_beg + per);
  for (int tok = t_beg + wid; tok < t_end; tok += 8) {
    const u16* xr = p.X() + (size_t)tok * DM;
    float v[16];
#pragma unroll
    for (int i = 0; i < 4; ++i) { const float4 a = ld4bf(xr + lane * 4 + i * 256); v[4 * i] = a.x; v[4 * i + 1] = a.y; v[4 * i + 2] = a.z; v[4 * i + 3] = a.w; }
    float ss = 0;
#pragma unroll
    for (int i = 0; i < 16; ++i) ss += v[i] * v[i];
    ss = wave_sum(ss);
    const float rs = rsqrtf(ss * (1.f / DM) + EPS);
    const float* md = p.mod() + ((size_t)layer * 3 + modv(tok)) * 6144 + 3 * DM;
#pragma unroll
    for (int i = 0; i < 4; ++i) {
      const int c = lane * 4 + i * 256;
      const float4 g = *(const float4*)(gn + c), sh = *(const float4*)(md + c), sc = *(const float4*)(md + DM + c);
      v[4 * i] = v[4 * i] * rs * g.x * (1.f + sc.x) + sh.x; v[4 * i + 1] = v[4 * i + 1] * rs * g.y * (1.f + sc.y) + sh.y;
      v[4 * i + 2] = v[4 * i + 2] * rs * g.z * (1.f + sc.z) + sh.z; v[4 * i + 3] = v[4 * i + 3] * rs * g.w * (1.f + sc.w) + sh.w;
    }
    const float rowsc = store_row_i8(v, p.H() + (size_t)tok * DM, p.hs() + tok, lane);
    float lg[32];
#pragma unroll
    for (int e = 0; e < 32; ++e) lg[e] = 0.f;
#pragma unroll
    for (int i = 0; i < 16; ++i) {
      const float4* wr4 = (const float4*)rwl + ((i & 3) * 256 + (i >> 2) * 64 + lane);
#pragma unroll
      for (int q = 0; q < 8; ++q) { const float4 w = wr4[q * 1024]; lg[4 * q] += v[i] * w.x; lg[4 * q + 1] += v[i] * w.y; lg[4 * q + 2] += v[i] * w.z; lg[4 * q + 3] += v[i] * w.w; }
    }
    float r16[16], r8[8], r4[4], r2[2], lv;
    { const bool up = lane & 32;
#pragma unroll
      for (int e = 0; e < 16; ++e) { const float keep = up ? lg[16 + e] : lg[e], send = up ? lg[e] : lg[16 + e]; r16[e] = keep + __shfl_xor(send, 32, 64); } }
    { const bool up = lane & 16;
#pragma unroll
      for (int e = 0; e < 8; ++e) { const float keep = up ? r16[8 + e] : r16[e], send = up ? r16[e] : r16[8 + e]; r8[e] = keep + __shfl_xor(send, 16, 64); } }
    { const bool up = lane & 8;
#pragma unroll
      for (int e = 0; e < 4; ++e) { const float keep = up ? r8[4 + e] : r8[e], send = up ? r8[e] : r8[4 + e]; r4[e] = keep + __shfl_xor(send, 8, 64); } }
    { const bool up = lane & 4;
#pragma unroll
      for (int e = 0; e < 2; ++e) { const float keep = up ? r4[2 + e] : r4[e], send = up ? r4[e] : r4[2 + e]; r2[e] = keep + __shfl_xor(send, 4, 64); } }
    { const bool up = lane & 2; const float keep = up ? r2[1] : r2[0], send = up ? r2[0] : r2[1]; lv = keep + __shfl_xor(send, 2, 64); }
    lv += __shfl_xor(lv, 1, 64);
    lv += rb[lane >> 1];
    int ids[4]; float vals[4];
#pragma unroll
    for (int k = 0; k < 4; ++k) {
      float mx = lv;
#pragma unroll
      for (int o = 32; o > 0; o >>= 1) mx = fmaxf(mx, __shfl_xor(mx, o, 64));
      const unsigned long long bal = __ballot(lv == mx);
      const int win = __ffsll((long long)bal) - 1;
      ids[k] = win >> 1; vals[k] = mx;
      if ((lane >> 1) == ids[k]) lv = -3.4e38f;
    }
    if (lane == 0) {
      const float mx = vals[0];
      float ex[4], sum = 0;
#pragma unroll
      for (int k = 0; k < 4; ++k) { ex[k] = __expf(vals[k] - mx); sum += ex[k]; }
      const float inv = 1.f / sum;
#pragma unroll
      for (int k = 0; k < 4; ++k) {
        const int lp = atomicAdd(&lcnt[ids[k]], 1);
        const int slot = (tok - t_beg) * 4 + k;
        ent[2 * slot] = tok * 4 + k; ent[2 * slot + 1] = (ids[k] << 20) | lp; entw[slot] = ex[k] * inv; ents[slot] = rowsc;
      }
    }
  }
  __syncthreads();
  if (tid < 32) lbase[tid] = atomicAdd(&p.cnt()[layer * NE + tid], lcnt[tid]);
  __syncthreads();
  const int nas = (t_end > t_beg ? (t_end - t_beg) : 0) * 4;
  for (int s = tid; s < nas; s += NTHR) {
    const int tk = ent[2 * s], el = ent[2 * s + 1], e = el >> 20, pos = lbase[e] + (el & 0xFFFFF);
    p.rtok()[(size_t)e * TT + pos] = tk >> 2; p.rw()[(size_t)e * TT + pos] = entw[s]; p.rsc()[(size_t)e * TT + pos] = ents[s];
    p.tslot()[tk] = (e << 20) | pos;
  }
}

struct G8Moe {
  const int* cnt;
  int ntn, Kb, G, c; const char* Bt; size_t bstride;
  const int* rtok;
  __device__ __forceinline__ bool next(int i, G8Unit& u) const {
    const int w = (i * 8 + (c & 7)) * (G >> 3) + (c >> 3); int acc = 0, rows = 0;
    for (int ee = 0; ee < NE; ++ee) {
      const int cc = cnt[ee], tiles = ((cc + 255) >> 8) * ntn;
      if (w < acc + tiles) { const int r = w - acc; u.e = ee; u.pm = r / ntn; u.pn = r % ntn; u.ce = cc; u.pre = rows; return true; }
      acc += tiles; rows += cc;
    }
    return false;
  }
  __device__ __forceinline__ unsigned a_off(const G8Unit& u, int row) const {
    const int r = min(u.pm * 256 + row, u.ce - 1);
    const int arow = rtok ? rtok[(size_t)u.e * TT + r] : u.pre + r;
    return (unsigned)arow * (unsigned)Kb;
  }
  __device__ __forceinline__ const char* b_ptr(const G8Unit& u) const { return Bt + (size_t)u.e * bstride + (size_t)u.pn * 256 * Kb; }
};
struct EpiGu {
  const float* bgl; u16* act; const float* rsc; const float* swl;
  __device__ __forceinline__ void pre(const G8Unit& u, int wr, int fr, float (&ep)[8], float* cb) const {
    if ((ltid() >> 6) == 0) g8_cload(bgl + (size_t)u.e * 2048 + u.pn * 256, cb);
    if ((ltid() >> 6) == 1) g8_cload(swl + (size_t)u.e * 2048 + u.pn * 256, cb + 256);
#pragma unroll
    for (int ai = 0; ai < 2; ++ai)
#pragma unroll
      for (int m = 0; m < 4; ++m) ep[ai * 4 + m] = rsc[(size_t)u.e * TT + min(u.pm * 256 + ai * 128 + wr * 64 + m * 16 + fr, u.ce - 1)];
  }
  __device__ __forceinline__ void operator()(const i32x4 (&acc)[2][2][4][2], const G8Unit& u, int wr, int wc, int fr, int fq, const float (&ep)[8], const float* cb) const {
    const int j0 = u.pn * 128 + wc * 32 + 8 * fq;
    const float* bg = cb + 2 * (wc * 32 + 8 * fq);
    float bgt[8], bup[8], sg[8], su[8];
#pragma unroll
    for (int q = 0; q < 4; ++q) { const f32x4 t = *(const f32x4*)(bg + 4 * q); bgt[2 * q] = t[0]; bup[2 * q] = t[1]; bgt[2 * q + 1] = t[2]; bup[2 * q + 1] = t[3]; }
    {
      const float* sp = cb + 256 + wc * 32 + 8 * fq;
      const f32x4 g0 = *(const f32x4*)sp, g1 = *(const f32x4*)(sp + 4), u0 = *(const f32x4*)(sp + 128), u1 = *(const f32x4*)(sp + 132);
#pragma unroll
      for (int j = 0; j < 4; ++j) { sg[j] = g0[j]; sg[4 + j] = g1[j]; su[j] = u0[j]; su[4 + j] = u1[j]; }
    }
#pragma unroll
    for (int ai = 0; ai < 2; ++ai)
#pragma unroll
      for (int m = 0; m < 4; ++m) {
        const int r = u.pm * 256 + ai * 128 + wr * 64 + m * 16 + fr;
        if (r < u.ce) {
          const float sa = ep[ai * 4 + m];
          float o[8];
#pragma unroll
          for (int n = 0; n < 2; ++n)
#pragma unroll
            for (int j = 0; j < 4; ++j) {
              const float gate = fminf((float)acc[ai][0][m][n][j] * sa * sg[4 * n + j] + bgt[4 * n + j], 7.f);
              const float up = fminf(fmaxf((float)acc[ai][1][m][n][j] * sa * su[4 * n + j] + bup[4 * n + j], -7.f), 7.f);
              o[4 * n + j] = (up + 1.f) * gate * __builtin_amdgcn_rcpf(1.f + __expf(-1.702f * gate));
            }
          *(u32x4*)(act + (size_t)(u.pre + r) * DFF + j0) = u32x4{cvtpk(o[0], o[1]), cvtpk(o[2], o[3]), cvtpk(o[4], o[5]), cvtpk(o[6], o[7])};
        }
      }
  }
};
struct EpiDn {
  const float* bdl; const float* rw; u16* yd;
  __device__ __forceinline__ void pre(const G8Unit& u, int wr, int fr, float (&ep)[8], float* cb) const {
    if ((ltid() >> 6) == 0) g8_cload(bdl + (size_t)u.e * DM + u.pn * 256, cb);
#pragma unroll
    for (int ai = 0; ai < 2; ++ai)
#pragma unroll
      for (int m = 0; m < 4; ++m) ep[ai * 4 + m] = rw[(size_t)u.e * TT + min(u.pm * 256 + ai * 128 + wr * 64 + m * 16 + fr, u.ce - 1)];
  }
  __device__ __forceinline__ void operator()(const f32x4 (&acc)[2][2][4][2], const G8Unit& u, int wr, int wc, int fr, int fq, const float (&ep)[8], const float* cb) const {
#pragma unroll
    for (int bj = 0; bj < 2; ++bj) {
      const int c0 = u.pn * 256 + bj * 128 + wc * 32 + 8 * fq;
      const f32x4 ba = *(const f32x4*)(cb + bj * 128 + wc * 32 + 8 * fq), bb = *(const f32x4*)(cb + bj * 128 + wc * 32 + 8 * fq + 4);
#pragma unroll
      for (int ai = 0; ai < 2; ++ai)
#pragma unroll
        for (int m = 0; m < 4; ++m) {
          const int r = u.pm * 256 + ai * 128 + wr * 64 + m * 16 + fr;
          if (r < u.ce) {
            const float wgt = ep[ai * 4 + m];
            const f32x4 a = (acc[ai][bj][m][0] + ba) * wgt, b = (acc[ai][bj][m][1] + bb) * wgt;
            *(u32x4*)(yd + (size_t)(u.pre + r) * DM + c0) = u32x4{cvtpk(a[0], a[1]), cvtpk(a[2], a[3]), cvtpk(b[0], b[1]), cvtpk(b[2], b[3])};
          }
        }
    }
  }
};
__device__ __forceinline__ void phase_moe_gu(const Params& p, int layer, int bid, int nb, char* lds) {
  int* scnt = (int*)(lds + 131072);
  if (ltid() < NE) scnt[ltid()] = p.cnt()[layer * NE + ltid()];
  __syncthreads();
  G8Moe S; S.cnt = scnt; S.ntn = 8; S.Kb = DM; S.G = nb; S.c = bid; S.Bt = (const char*)(p.bt_gu() + (size_t)layer * NE * 2048 * DM); S.bstride = (size_t)2048 * DM; S.rtok = p.rtok();
  EpiGu E; E.bgl = p.moe_b_gu() + (size_t)layer * NE * 2048; E.act = p.act(); E.rsc = p.rsc(); E.swl = p.swgu() + (size_t)layer * NE * 2048;
  gemm8_phase<true>(lds, (const char*)p.H(), DM, S, E);
}
__device__ __forceinline__ void phase_moe_dn(const Params& p, int layer, int bid, int nb, char* lds) {
  int* scnt = (int*)(lds + 131072);
  if (ltid() < NE) scnt[ltid()] = p.cnt()[layer * NE + ltid()];
  __syncthreads();
  G8Moe S; S.cnt = scnt; S.ntn = 4; S.Kb = 2 * DFF; S.G = nb; S.c = bid; S.Bt = (const char*)(p.bt_dn() + (size_t)layer * NE * DM * DFF); S.bstride = (size_t)DM * DFF * 2; S.rtok = nullptr;
  EpiDn E; E.bdl = p.moe_b_down() + (size_t)layer * NE * DM; E.rw = p.rw(); E.yd = p.yd();
  gemm8_phase<false>(lds, (const char*)p.act(), 2 * DFF, S, E);
}

__device__ __forceinline__ void phase_final(const Params& p, int bid, int nb, char* lds) {
  int* pre = (int*)lds;
  expert_prefix(p.cnt() + NE, pre); __syncthreads();
  const int wid = ltid() >> 6, lane = ltid() & 63;
  for (int tok = bid * 8 + wid; tok < TL; tok += nb * 8) {
    float v[16];
    load_row_comb(p, 1, 1, tok, lane, pre, v);
    float ss = 0;
#pragma unroll
    for (int i = 0; i < 16; ++i) ss += v[i] * v[i];
    ss = wave_sum(ss);
    const float rs = rsqrtf(ss * (1.f / DM) + EPS);
    float* o = p.out() + (size_t)tok * DM;
#pragma unroll
    for (int i = 0; i < 4; ++i) {
      const int c = lane * 4 + i * 256;
      const float4 g = *(const float4*)(p.final_g() + c);
      *(float4*)(o + c) = make_float4(v[4 * i] * rs * g.x, v[4 * i + 1] * rs * g.y, v[4 * i + 2] * rs * g.z, v[4 * i + 3] * rs * g.w);
    }
  }
}

#define XB_TMO      128
#define XB_XCNT(j)  (256  + 64 * (j))
#define XB_XSUB(j)  (1280 + 64 * (j))
#define XB_XGEN(j)  (2304 + 64 * (j))
#define XB_TOP      3328
#define XB_TOPGEN   3392
#define XCD_BAR_WORDS 3456
#define XB_SPIN_CAP (1u << 18)
#define LAS __attribute__((address_space(3)))

__device__ __forceinline__ unsigned xb_ld(unsigned* p)              { return __hip_atomic_load(p, __ATOMIC_RELAXED, __HIP_MEMORY_SCOPE_AGENT); }
__device__ __forceinline__ unsigned xb_add(unsigned* p, unsigned v) { return __hip_atomic_fetch_add(p, v, __ATOMIC_RELAXED, __HIP_MEMORY_SCOPE_AGENT); }
__device__ __forceinline__ unsigned xb_xcc_id() { return (unsigned)__builtin_amdgcn_s_getreg((3 << 11) | 20) & 0xFu; }
#define XB_SPIN(cond, bar) do { unsigned _sp = 0; while (cond) { __builtin_amdgcn_s_sleep(1); \
    if ((++_sp & 255u) == 0u) { if (xb_ld(&(bar)[XB_TMO])) break; if (_sp > XB_SPIN_CAP) { atomicAdd(&(bar)[XB_TMO], 1u); break; } } } } while (0)

struct XcdBarrier {
    unsigned* bar; unsigned x;
    volatile LAS unsigned* st;
};

__device__ __forceinline__ XcdBarrier xcd_barrier_post(unsigned* bar, volatile LAS unsigned* st) {
    XcdBarrier b; b.bar = bar; b.x = xb_xcc_id(); b.st = st;
    if (threadIdx.x == 0) (void)xb_add(&bar[XB_XCNT(b.x)], 1u);
    return b;
}
__device__ __forceinline__ void xcd_barrier_complete(unsigned* bar, unsigned x, unsigned& nloc, unsigned& nx) {
    const unsigned G = gridDim.x * gridDim.y * gridDim.z;
    unsigned sum, cnt, mine, sp = 0u;
    for (;;) {
        sum = 0u; cnt = 0u; mine = 0u;
#pragma unroll
        for (unsigned j = 0; j < 16; ++j) { const unsigned c = xb_ld(&bar[XB_XCNT(j)]); sum += c; cnt += (c > 0u) ? 1u : 0u; mine = (j == x) ? c : mine; }
        if (sum == G) break;
        __builtin_amdgcn_s_sleep(1);
        if ((++sp & 255u) == 0u) { if (xb_ld(&bar[XB_TMO])) break; if (sp > XB_SPIN_CAP) { atomicAdd(&bar[XB_TMO], 1u); break; } }
    }
    nloc = mine > 0u ? mine : 1u; nx = cnt > 0u ? cnt : 1u;
}

__device__ __forceinline__ void xcd_barrier(const XcdBarrier& b) {
    asm volatile("s_waitcnt vmcnt(0)" ::: "memory");
    __syncthreads();
    if (threadIdx.x == 0) {
        unsigned* bar = b.bar;
        __builtin_amdgcn_s_waitcnt(0);
        unsigned nloc = b.st[0], nx = b.st[1];
        if (nloc == 0u) { xcd_barrier_complete(bar, b.x, nloc, nx); b.st[0] = nloc; b.st[1] = nx; }
        const unsigned old = xb_add(&bar[XB_XSUB(b.x)], 1u);
        const unsigned gen = old / nloc;
        if (old + 1u == (gen + 1u) * nloc) {
            __builtin_amdgcn_fence(__ATOMIC_RELEASE, "agent");
            asm volatile("s_waitcnt vmcnt(0)" ::: "memory");
            const unsigned og = xb_add(&bar[XB_TOP], 1u);
            const unsigned tg = og / nx;
            if (og + 1u == (tg + 1u) * nx) xb_add(&bar[XB_TOPGEN], 1u);
            else XB_SPIN(xb_ld(&bar[XB_TOPGEN]) == tg, bar);
            __builtin_amdgcn_fence(__ATOMIC_ACQUIRE, "agent");
            xb_add(&bar[XB_XGEN(b.x)], 1u);
            asm volatile("s_waitcnt vmcnt(0)" ::: "memory");
        } else {
            XB_SPIN(xb_ld(&bar[XB_XGEN(b.x)]) == gen, bar);
            __builtin_amdgcn_fence(__ATOMIC_ACQUIRE, "agent");
            asm volatile("s_waitcnt vmcnt(0)" ::: "memory");
        }
    }
    __syncthreads();
}

constexpr int LDS_MAIN = 147456;
constexpr int LDS_BYTES = LDS_MAIN + 1024;
enum { PH_TABLES = 0, PH_MOD, PH_FOLD, PH_CONVERT, PH_HYMLP, PH_HYFILT, PH_NORM1, PH_GEMM_IN, PH_QKV, PH_ATTN, PH_FFTMIX,
       PH_GLA_A, PH_GLA_B, PH_GLA_C, PH_MIX, PH_GEMM_OUT, PH_NORM2, PH_MOE_GU, PH_MOE_DN, PH_FINAL };

__device__ __forceinline__ Params make_params() {
  const __attribute__((address_space(4))) char* kb = (const __attribute__((address_space(4))) char*)__builtin_amdgcn_kernarg_segment_ptr();
  asm volatile("" : "+s"(kb));
  Params p; p.kb = kb; return p;
}
#ifndef MK_LAUNCHES
#define MK_LAUNCHES 1
#endif
__global__ void __launch_bounds__(NTHR, 2) k_mega(ParamsData pd) {
  extern __shared__ __attribute__((aligned(1024))) char lds[];
  const int bid = blockIdx.x, nb = gridDim.x;
  if (threadIdx.x == 0) *(uint4*)(lds + LDS_MAIN) = make_uint4(0u, 0u, 0u, 0u);
  __syncthreads();
  XcdBarrier bar = xcd_barrier_post(make_params().bar(), (volatile LAS unsigned*)(lds + LDS_MAIN));
#ifndef DBLMASK
#define DBLMASK 0u
#endif
#define RUNPH(bit, call) do { call; if (DBLMASK & (1u << (bit))) { __syncthreads(); call; } } while (0)
  RUNPH(13, phase_tables(make_params(), bid, nb); phase_mod(make_params(), bid, nb, lds); phase_fold(make_params(), bid, nb, lds));
  RUNPH(0, phase_convert(make_params(), bid, nb, lds));
  phase_hy_mlp(make_params(), 0, SEQ, make_params().hfb(), make_params().hpart(), bid, nb, lds);
  phase_hy_mlp(make_params(), 1, SEQ, make_params().hfb() + (size_t)2 * 256 * SEQ, make_params().hpart() + 256 * 512, bid, nb, lds);
  phase_hy_mlp(make_params(), 0, LC, make_params().hfc(), make_params().hpart() + 2 * 256 * 512, bid, nb, lds);
  xcd_barrier(bar);
  RUNPH(2, phase_hy_filtfft(make_params(), bid, nb, lds));
  phase_quant_in(make_params(), bid, nb);
#define MK_LAYER(l) do { \
  phase_norm1(make_params(), l, bid, nb, lds); if ((DBLMASK & (1u << 14)) && l == 0) { __syncthreads(); phase_norm1(make_params(), l, bid, nb, lds); } \
  xcd_barrier(bar); \
  RUNPH(3, phase_gemm_in(make_params(), l, bid, nb, lds)); \
  xcd_barrier(bar); \
  RUNPH(4, phase_qkv(make_params(), l, bid, nb, lds)); \
  RUNPH(5, phase_gla_a(make_params(), l, bid, nb, lds)); \
  xcd_barrier(bar); \
  RUNPH(6, phase_attn(make_params(), l, bid, nb, lds)); \
  RUNPH(7, phase_fftmix(make_params(), l, bid, nb, lds)); \
  RUNPH(9, phase_gla_c(make_params(), l, bid, nb, lds)); \
  xcd_barrier(bar); \
  RUNPH(10, phase_mix(make_params(), l, bid, nb, lds)); \
  xcd_barrier(bar); \
  phase_gemm_out(make_params(), l, bid, nb, lds); if ((DBLMASK & (1u << 16)) && l == 0) { __syncthreads(); phase_gemm_out(make_params(), l, bid, nb, lds); } \
  xcd_barrier(bar); \
  phase_norm2_router(make_params(), l, bid, nb, lds); \
  xcd_barrier(bar); \
  RUNPH(11, phase_moe_gu(make_params(), l, bid, nb, lds)); \
  xcd_barrier(bar); \
  RUNPH(12, phase_moe_dn(make_params(), l, bid, nb, lds)); \
  xcd_barrier(bar); \
  } while (0)
  MK_LAYER(0);
  MK_LAYER(1);
#undef MK_LAYER
  RUNPH(15, phase_final(make_params(), bid, nb, lds));
}
static size_t carve(char*& cur, size_t bytes) { char* r = cur; cur += (bytes + 1023) & ~(size_t)1023; return (size_t)(uintptr_t)r; }
#define CARVE(T, field, n) p.field = (T*)carve(cur, (size_t)(n) * sizeof(T))

extern "C" void kernel_launch(void* const* d_in, const int* in_sizes, int n_in, void* d_out, int out_size, void* d_ws, size_t ws_size, hipStream_t stream) {
  ParamsData p; memset(&p, 0, sizeof(p));
  const float** ins = (const float**)&p;
  for (int i = 0; i < 34; ++i) ins[i] = (const float*)d_in[i];
  p.out_ = (float*)d_out;
  p.ws_ = (char*)d_ws;
  if (WS_TOTAL > ws_size) { fprintf(stderr, "workspace too small: need %zu have %zu\n", (size_t)WS_TOTAL, ws_size); return; }
  hipMemsetAsync((char*)d_ws + OFF_bar, 0, OFF_mod - OFF_bar, stream);
  static int grid = 0;
  if (!grid) {
    int dev = 0, cus = 0, per_cu = 0;
    hipGetDevice(&dev);
    hipDeviceGetAttribute(&cus, hipDeviceAttributeMultiprocessorCount, dev);
    hipFuncSetAttribute((const void*)k_mega, hipFuncAttributeMaxDynamicSharedMemorySize, LDS_BYTES);
    hipOccupancyMaxActiveBlocksPerMultiprocessor(&per_cu, (const void*)k_mega, NTHR, LDS_BYTES);
    grid = cus * (per_cu < 1 ? per_cu : 1);
    if (grid != 256) fprintf(stderr, "unexpected grid %d (cus %d per_cu %d)\n", grid, cus, per_cu);
  }
  hipLaunchKernelGGL(k_mega, dim3(grid), dim3(NTHR), LDS_BYTES, stream, p);
}
```

```cpp
#include <hip/hip_runtime.h>
#include <hip/hip_bf16.h>
#include <cstdio>
#include <cstdint>
#include <cstring>
#include <cstddef>
#include <type_traits>

typedef unsigned short u16;
using bf16x8 = __attribute__((ext_vector_type(8))) short;
using s16x4  = __attribute__((ext_vector_type(4))) short;
using f32x4  = __attribute__((ext_vector_type(4))) float;
using f32x16 = __attribute__((ext_vector_type(16))) float;
using u32x4  = __attribute__((ext_vector_type(4))) unsigned;
using u32x2  = __attribute__((ext_vector_type(2))) unsigned;

constexpr int DM = 1024, NB = 2, SEQ = 16384, LC = 256;
constexpr int TL = NB * SEQ;
constexpr int TC = NB * LC;
constexpr int TT = TL + TC;
constexpr int NIN = 2816;
constexpr int DIN0 = 2240;
constexpr int NE = 32, TOPK = 4, DFF = 1024;
constexpr int SKV = SEQ + LC;
constexpr int NTHR = 512;
constexpr float EPS = 1e-6f;
constexpr float A_SCALE = 0.10206207261596575f;
constexpr float A_QSCALE = A_SCALE * 1.4426950408889634f;
constexpr int ZG_W = 1152, ZG_GQ = 0, ZG_GK = 128, ZG_KR = 256, ZG_GV = 384, ZG_GP = 640, ZG_OG = 896;
constexpr int ZT_HY = 0, ZT_FR = 768, ZT_FI = 1024, ZT_R = 1280;
constexpr int NCH = 260;
constexpr int FM = 16384;
constexpr int HSP = FM / 2 + 1;

constexpr size_t ws_al(size_t b) { return (b + 1023) & ~(size_t)1023; }
constexpr size_t OFF_bar = 0;
constexpr size_t OFF_cnt = OFF_bar + ws_al((size_t)(4096) * sizeof(unsigned));
constexpr size_t OFF_hssq = OFF_cnt + ws_al((size_t)(64) * sizeof(int));
constexpr size_t OFF_kmx = OFF_hssq + ws_al((size_t)(768) * sizeof(float));
constexpr size_t OFF_mod = OFF_kmx + ws_al((size_t)(128) * sizeof(unsigned));
constexpr size_t OFF_ropec = OFF_mod + ws_al((size_t)(2 * 3 * 6144) * sizeof(float));
constexpr size_t OFF_ropes = OFF_ropec + ws_al((size_t)(SEQ * 16) * sizeof(float));
constexpr size_t OFF_tw = OFF_ropes + ws_al((size_t)(SEQ * 16) * sizeof(float));
constexpr size_t OFF_bt_in = OFF_tw + ws_al((size_t)(FM) * sizeof(float2));
constexpr size_t OFF_bt_qkv = OFF_bt_in + ws_al((size_t)((size_t)2 * NIN * DM) * sizeof(u16));
constexpr size_t OFF_bt_out = OFF_bt_qkv + ws_al((size_t)(2 * 1024 * 384) * sizeof(u16));
constexpr size_t OFF_bt_gu = OFF_bt_out + ws_al((size_t)((size_t)2 * DM * DM) * sizeof(u16));
constexpr size_t OFF_bt_dn = OFF_bt_gu + ws_al((size_t)((size_t)2 * NE * 2048 * DM) * sizeof(u16));
constexpr size_t OFF_hfb = OFF_bt_dn + ws_al((size_t)((size_t)2 * NE * DM * DFF) * sizeof(u16));
constexpr size_t OFF_hfc = OFF_hfb + ws_al((size_t)((size_t)2 * 2 * 256 * SEQ) * sizeof(float));
constexpr size_t OFF_hspec = OFF_hfc + ws_al((size_t)(2 * 256 * LC) * sizeof(float));
constexpr size_t OFF_H = OFF_hspec + ws_al((size_t)((size_t)2 * 256 * HSP) * sizeof(float4));
constexpr size_t OFF_zqkv = OFF_H + ws_al((size_t)((size_t)TT * DM) * sizeof(u16));
constexpr size_t OFF_zg = OFF_zqkv + ws_al((size_t)((size_t)TT * 384) * sizeof(u16));
constexpr size_t OFF_zt = OFF_zg + ws_al((size_t)((size_t)TT * ZG_W) * sizeof(float));
constexpr size_t OFF_Q = OFF_zt + ws_al((size_t)((size_t)ZT_R * TT) * sizeof(float));
constexpr size_t OFF_KV = OFF_Q + ws_al((size_t)((size_t)2 * 4 * SKV * 96) * sizeof(u16));
constexpr size_t OFF_ymix = OFF_KV + ws_al((size_t)((size_t)2 * 4 * SKV * 160) * sizeof(u16));
constexpr size_t OFF_hyo = OFF_ymix + ws_al((size_t)((size_t)TT * DM) * sizeof(u16));
constexpr size_t OFF_fno = OFF_hyo + ws_al((size_t)((size_t)256 * TT) * sizeof(float));
constexpr size_t OFF_glao = OFF_fno + ws_al((size_t)((size_t)256 * TT) * sizeof(float));
constexpr size_t OFF_gds = OFF_glao + ws_al((size_t)((size_t)TT * 256) * sizeof(float));
constexpr size_t OFF_gdv = OFF_gds + ws_al((size_t)((size_t)16 * NCH * 2048) * sizeof(float));
constexpr size_t OFF_gst = OFF_gdv + ws_al((size_t)((size_t)16 * NCH * 32) * sizeof(float));
constexpr size_t OFF_X = OFF_gst + ws_al((size_t)((size_t)16 * NCH * 2048) * sizeof(float));
constexpr size_t OFF_rtok = OFF_X + ws_al((size_t)((size_t)TT * DM) * sizeof(float));
constexpr size_t OFF_rw = OFF_rtok + ws_al((size_t)((size_t)NE * TT) * sizeof(int));
constexpr size_t OFF_tslot = OFF_rw + ws_al((size_t)((size_t)NE * TT) * sizeof(float));
constexpr size_t OFF_act = OFF_tslot + ws_al((size_t)((size_t)TT * 4) * sizeof(int));
constexpr size_t OFF_yd = OFF_act + ws_al((size_t)((size_t)TT * 4 * DFF) * sizeof(u16));
constexpr size_t OFF_swin = OFF_yd + ws_al((size_t)((size_t)TT * 4 * DM) * sizeof(u16));
constexpr size_t OFF_swgu = OFF_swin + ws_al((size_t)(2 * NIN) * sizeof(float));
constexpr size_t OFF_hs = OFF_swgu + ws_al((size_t)(2 * NE * 2048) * sizeof(float));
constexpr size_t OFF_hpart = OFF_hs + ws_al((size_t)(TT) * sizeof(float));
constexpr size_t OFF_rsc = OFF_hpart + ws_al((size_t)(3 * 256 * 512) * sizeof(float));
constexpr size_t WS_TOTAL = OFF_rsc + ws_al((size_t)((size_t)NE * TT) * sizeof(float));
struct ParamsData {
  const float *x_, *c_, *ctx_, *c_ctx_, *ada_w_, *ada_b_, *norm1_g_, *norm2_g_, *w_in_, *mla_q_g_, *mla_w_uq_, *mla_kv_g_, *mla_w_ukv_, *hy_conv_w_, *hy_conv_b_, *hy_w1_, *hy_b1_, *hy_w2_, *hy_b2_, *hy_w3_, *hy_freq_, *hy_bias_, *gla_gk_w_, *gla_gk_b_, *fnet_w_, *mix_g_, *w_out_, *router_w_, *router_b_, *moe_w_gu_, *moe_b_gu_, *moe_w_down_, *moe_b_down_, *final_g_;
  float* out_;
  char* ws_;
};
struct Params {
  const __attribute__((address_space(4))) char* kb;
  template <class T> __device__ __forceinline__ T karg(size_t off) const { return *(const __attribute__((address_space(4))) T*)(kb + off); }
  __device__ __forceinline__ const float* x() const { return karg<const float*>(offsetof(ParamsData, x_)); }
  __device__ __forceinline__ const float* c() const { return karg<const float*>(offsetof(ParamsData, c_)); }
  __device__ __forceinline__ const float* ctx() const { return karg<const float*>(offsetof(ParamsData, ctx_)); }
  __device__ __forceinline__ const float* c_ctx() const { return karg<const float*>(offsetof(ParamsData, c_ctx_)); }
  __device__ __forceinline__ const float* ada_w() const { return karg<const float*>(offsetof(ParamsData, ada_w_)); }
  __device__ __forceinline__ const float* ada_b() const { return karg<const float*>(offsetof(ParamsData, ada_b_)); }
  __device__ __forceinline__ const float* norm1_g() const { return karg<const float*>(offsetof(ParamsData, norm1_g_)); }
  __device__ __forceinline__ const float* norm2_g() const { return karg<const float*>(offsetof(ParamsData, norm2_g_)); }
  __device__ __forceinline__ const float* w_in() const { return karg<const float*>(offsetof(ParamsData, w_in_)); }
  __device__ __forceinline__ const float* mla_q_g() const { return karg<const float*>(offsetof(ParamsData, mla_q_g_)); }
  __device__ __forceinline__ const float* mla_w_uq() const { return karg<const float*>(offsetof(ParamsData, mla_w_uq_)); }
  __device__ __forceinline__ const float* mla_kv_g() const { return karg<const float*>(offsetof(ParamsData, mla_kv_g_)); }
  __device__ __forceinline__ const float* mla_w_ukv() const { return karg<const float*>(offsetof(ParamsData, mla_w_ukv_)); }
  __device__ __forceinline__ const float* hy_conv_w() const { return karg<const float*>(offsetof(ParamsData, hy_conv_w_)); }
  __device__ __forceinline__ const float* hy_conv_b() const { return karg<const float*>(offsetof(ParamsData, hy_conv_b_)); }
  __device__ __forceinline__ const float* hy_w1() const { return karg<const float*>(offsetof(ParamsData, hy_w1_)); }
  __device__ __forceinline__ const float* hy_b1() const { return karg<const float*>(offsetof(ParamsData, hy_b1_)); }
  __device__ __forceinline__ const float* hy_w2() const { return karg<const float*>(offsetof(ParamsData, hy_w2_)); }
  __device__ __forceinline__ const float* hy_b2() const { return karg<const float*>(offsetof(ParamsData, hy_b2_)); }
  __device__ __forceinline__ const float* hy_w3() const { return karg<const float*>(offsetof(ParamsData, hy_w3_)); }
  __device__ __forceinline__ const float* hy_freq() const { return karg<const float*>(offsetof(ParamsData, hy_freq_)); }
  __device__ __forceinline__ const float* hy_bias() const { return karg<const float*>(offsetof(ParamsData, hy_bias_)); }
  __device__ __forceinline__ const float* gla_gk_w() const { return karg<const float*>(offsetof(ParamsData, gla_gk_w_)); }
  __device__ __forceinline__ const float* gla_gk_b() const { return karg<const float*>(offsetof(ParamsData, gla_gk_b_)); }
  __device__ __forceinline__ const float* fnet_w() const { return karg<const float*>(offsetof(ParamsData, fnet_w_)); }
  __device__ __forceinline__ const float* mix_g() const { return karg<const float*>(offsetof(ParamsData, mix_g_)); }
  __device__ __forceinline__ const float* w_out() const { return karg<const float*>(offsetof(ParamsData, w_out_)); }
  __device__ __forceinline__ const float* router_w() const { return karg<const float*>(offsetof(ParamsData, router_w_)); }
  __device__ __forceinline__ const float* router_b() const { return karg<const float*>(offsetof(ParamsData, router_b_)); }
  __device__ __forceinline__ const float* moe_w_gu() const { return karg<const float*>(offsetof(ParamsData, moe_w_gu_)); }
  __device__ __forceinline__ const float* moe_b_gu() const { return karg<const float*>(offsetof(ParamsData, moe_b_gu_)); }
  __device__ __forceinline__ const float* moe_w_down() const { return karg<const float*>(offsetof(ParamsData, moe_w_down_)); }
  __device__ __forceinline__ const float* moe_b_down() const { return karg<const float*>(offsetof(ParamsData, moe_b_down_)); }
  __device__ __forceinline__ const float* final_g() const { return karg<const float*>(offsetof(ParamsData, final_g_)); }
  __device__ __forceinline__ float* out() const { return karg<float*>(offsetof(ParamsData, out_)); }
  __device__ __forceinline__ char* ws() const { return karg<char*>(offsetof(ParamsData, ws_)); }
  __device__ __forceinline__ unsigned* bar() const { return (unsigned*)(ws() + OFF_bar); }
  __device__ __forceinline__ int* cnt() const { return (int*)(ws() + OFF_cnt); }
  __device__ __forceinline__ float* hssq() const { return (float*)(ws() + OFF_hssq); }
  __device__ __forceinline__ unsigned* kmx() const { return (unsigned*)(ws() + OFF_kmx); }
  __device__ __forceinline__ float* mod() const { return (float*)(ws() + OFF_mod); }
  __device__ __forceinline__ float* ropec() const { return (float*)(ws() + OFF_ropec); }
  __device__ __forceinline__ float* ropes() const { return (float*)(ws() + OFF_ropes); }
  __device__ __forceinline__ float2* tw() const { return (float2*)(ws() + OFF_tw); }
  __device__ __forceinline__ signed char* bt_in() const { return (signed char*)(ws() + OFF_bt_in); }
  __device__ __forceinline__ u16* bt_qkv() const { return (u16*)(ws() + OFF_bt_qkv); }
  __device__ __forceinline__ u16* bt_out() const { return (u16*)(ws() + OFF_bt_out); }
  __device__ __forceinline__ signed char* bt_gu() const { return (signed char*)(ws() + OFF_bt_gu); }
  __device__ __forceinline__ u16* bt_dn() const { return (u16*)(ws() + OFF_bt_dn); }
  __device__ __forceinline__ float* hfb() const { return (float*)(ws() + OFF_hfb); }
  __device__ __forceinline__ float* hfc() const { return (float*)(ws() + OFF_hfc); }
  __device__ __forceinline__ float4* hspec() const { return (float4*)(ws() + OFF_hspec); }
  __device__ __forceinline__ signed char* H() const { return (signed char*)(ws() + OFF_H); }
  __device__ __forceinline__ float* hs() const { return (float*)(ws() + OFF_hs); }
  __device__ __forceinline__ float* rsc() const { return (float*)(ws() + OFF_rsc); }
  __device__ __forceinline__ float* hpart() const { return (float*)(ws() + OFF_hpart); }
  __device__ __forceinline__ float* swin() const { return (float*)(ws() + OFF_swin); }
  __device__ __forceinline__ float* swgu() const { return (float*)(ws() + OFF_swgu); }
  __device__ __forceinline__ float* btf() const { return (float*)(ws() + OFF_act); }
  __device__ __forceinline__ u16* zqkv() const { return (u16*)(ws() + OFF_zqkv); }
  __device__ __forceinline__ u16* zg() const { return (u16*)(ws() + OFF_zg); }
  __device__ __forceinline__ u16* zt() const { return (u16*)(ws() + OFF_zt); }
  __device__ __forceinline__ u16* Q() const { return (u16*)(ws() + OFF_Q); }
  __device__ __forceinline__ u16* KV() const { return (u16*)(ws() + OFF_KV); }
  __device__ __forceinline__ u16* ymix() const { return (u16*)(ws() + OFF_ymix); }
  __device__ __forceinline__ u16* hyo() const { return (u16*)(ws() + OFF_hyo); }
  __device__ __forceinline__ u16* fno() const { return (u16*)(ws() + OFF_fno); }
  __device__ __forceinline__ u16* glao() const { return (u16*)(ws() + OFF_glao); }
  __device__ __forceinline__ float* gds() const { return (float*)(ws() + OFF_gds); }
  __device__ __forceinline__ float* gdv() const { return (float*)(ws() + OFF_gdv); }
  __device__ __forceinline__ float* gst() const { return (float*)(ws() + OFF_gst); }
  __device__ __forceinline__ u16* X() const { return (u16*)(ws() + OFF_X); }
  __device__ __forceinline__ int* rtok() const { return (int*)(ws() + OFF_rtok); }
  __device__ __forceinline__ float* rw() const { return (float*)(ws() + OFF_rw); }
  __device__ __forceinline__ int* tslot() const { return (int*)(ws() + OFF_tslot); }
  __device__ __forceinline__ u16* act() const { return (u16*)(ws() + OFF_act); }
  __device__ __forceinline__ u16* yd() const { return (u16*)(ws() + OFF_yd); }
};


__device__ __forceinline__ u16 f2bf(float f) {
  unsigned u = __float_as_uint(f); u += 0x7FFFu + ((u >> 16) & 1u); return (u16)(u >> 16);
}
__device__ __forceinline__ float bf2f(u16 h) { return __uint_as_float(((unsigned)h) << 16); }
__device__ __forceinline__ unsigned cvtpk(float lo, float hi) {
  unsigned r; asm volatile("v_cvt_pk_bf16_f32 %0, %1, %2" : "=v"(r) : "v"(lo), "v"(hi)); return r;
}
__device__ __forceinline__ float4 ld4bf(const u16* p) { const u32x2 w = *(const u32x2*)p; return make_float4(__uint_as_float(w[0] << 16), __uint_as_float(w[0] & 0xFFFF0000u), __uint_as_float(w[1] << 16), __uint_as_float(w[1] & 0xFFFF0000u)); }
template <int CTRL> __device__ __forceinline__ float dppf(float v) { return __builtin_bit_cast(float, __builtin_amdgcn_update_dpp(0, __builtin_bit_cast(int, v), CTRL, 0xF, 0xF, true)); }
template <int M> __device__ __forceinline__ float shx(float v) {
  if constexpr (M == 1) return dppf<0xB1>(v);
  else if constexpr (M == 2) return dppf<0x4E>(v);
  else if constexpr (M == 4) return dppf<0x1B>(dppf<0x141>(v));
  else if constexpr (M == 8) return dppf<0x141>(dppf<0x140>(v));
  else if constexpr (M == 16) { auto r = __builtin_amdgcn_permlane16_swap(__float_as_uint(v), __float_as_uint(v), false, false);
    return __uint_as_float((__lane_id() & 16) ? r[0] : r[1]); }
  else { auto r = __builtin_amdgcn_permlane32_swap(__float_as_uint(v), __float_as_uint(v), false, false);
    return __uint_as_float((__lane_id() & 32) ? r[0] : r[1]); }
}
__device__ __forceinline__ float wave_sum(float v) {
  v += dppf<0xB1>(v); v += dppf<0x4E>(v); v += dppf<0x141>(v); v += dppf<0x140>(v);
  { auto r = __builtin_amdgcn_permlane16_swap(__float_as_uint(v), __float_as_uint(v), false, false); v = __uint_as_float(r[0]) + __uint_as_float(r[1]); }
  { auto r = __builtin_amdgcn_permlane32_swap(__float_as_uint(v), __float_as_uint(v), false, false); v = __uint_as_float(r[0]) + __uint_as_float(r[1]); }
  return v;
}
__device__ __forceinline__ float wave_max(float v) {
  v = fmaxf(v, dppf<0xB1>(v)); v = fmaxf(v, dppf<0x4E>(v)); v = fmaxf(v, dppf<0x141>(v)); v = fmaxf(v, dppf<0x140>(v));
  { auto r = __builtin_amdgcn_permlane16_swap(__float_as_uint(v), __float_as_uint(v), false, false); v = fmaxf(__uint_as_float(r[0]), __uint_as_float(r[1])); }
  { auto r = __builtin_amdgcn_permlane32_swap(__float_as_uint(v), __float_as_uint(v), false, false); v = fmaxf(__uint_as_float(r[0]), __uint_as_float(r[1])); }
  return v;
}
__device__ __forceinline__ int ltid() { int t = threadIdx.x; asm volatile("" : "+v"(t)); return t; }
__device__ __forceinline__ float silu_f(float x) { return x / (1.f + __expf(-x)); }
__device__ __forceinline__ float2 cmul(float2 a, float2 b) { return make_float2(a.x * b.x - a.y * b.y, a.x * b.y + a.y * b.x); }
__device__ __forceinline__ float2 cmulc(float2 a, float2 b) { return make_float2(a.x * b.x + a.y * b.y, a.y * b.x - a.x * b.y); }
__device__ __forceinline__ int modv(int tok) { return tok < TL ? (tok >> 14) : 2; }
__device__ __forceinline__ void phase_tables(const Params& p, int bid, int nb) {
  const int gt = bid * NTHR + ltid(), gs = nb * NTHR;
  for (int i = gt; i < SEQ * 16; i += gs) {
    const int t = i >> 4, f = i & 15;
    const float pos = (f < 8) ? (float)(t >> 6) : (float)(t & 63);
    const float inv = powf(10000.f, -(float)(f & 7) / 8.f);
    float s, c; sincosf(pos * inv, &s, &c);
    p.ropec()[i] = c; p.ropes()[i] = s;
  }
  for (int i = gt; i < FM; i += gs) {
    float s, c; sincospif((float)i / 8192.f, &s, &c);
    p.tw()[i] = make_float2(c, -s);
  }
}

__device__ __forceinline__ void phase_mod(const Params& p, int bid, int nb, char* lds) {
  float* red = (float*)lds;
  const int tid = ltid(), part = tid >> 6, cl = tid & 63;
  for (int it = bid; it < 2 * 96; it += nb) {
    const int l = it / 96, n = (it % 96) * 64 + cl;
    const float* W = p.ada_w() + (size_t)l * DM * 6144;
    float a0 = 0, a1 = 0, a2 = 0;
    for (int k = part * 128; k < part * 128 + 128; ++k) {
      const float w = W[(size_t)k * 6144 + n];
      a0 += silu_f(p.c()[k]) * w; a1 += silu_f(p.c()[DM + k]) * w; a2 += silu_f(p.c_ctx()[k]) * w;
    }
    red[(part * 3 + 0) * 64 + cl] = a0; red[(part * 3 + 1) * 64 + cl] = a1; red[(part * 3 + 2) * 64 + cl] = a2;
    __syncthreads();
    if (tid < 192) {
      const int v = tid >> 6; float s = 0;
      for (int q = 0; q < 8; ++q) s += red[(q * 3 + v) * 64 + cl];
      p.mod()[((size_t)l * 3 + v) * 6144 + n] = s + p.ada_b()[(size_t)l * 6144 + n];
    }
    __syncthreads();
  }
}

__device__ __forceinline__ void phase_fold(const Params& p, int bid, int nb, char* lds) {
  float* wrow = (float*)lds;
  float* dre = wrow + 2048;
  float* dim_ = dre + 2048;
  float* glr = dim_ + 2048;
  float* cst = glr + 256;
  float* snt = cst + 256;
  const int tid = ltid();
  if (tid < 256) { float sn, cs; sincospif((float)tid / 128.f, &sn, &cs); cst[tid] = cs; snt[tid] = sn; }
  __syncthreads();
  for (int it = bid; it < 2 * DM / 8; it += nb) {
    const int l = it >> 7, k0 = (it & 127) * 8;
    for (int i = tid; i < 8 * 256; i += NTHR) { const int r = i >> 8, c = i & 255; wrow[c * 8 + r] = p.w_in()[((size_t)l * DM + k0 + r) * DIN0 + 1984 + c]; }
    if (tid < 256) { const int r = tid >> 5, c = tid & 31; glr[c * 8 + r] = p.w_in()[((size_t)l * DM + k0 + r) * DIN0 + 1696 + c]; }
    __syncthreads();
    {
      const int kp = tid & 255; const bool im = tid >= 256;
      float acc[8] = {0.f, 0.f, 0.f, 0.f, 0.f, 0.f, 0.f, 0.f};
#pragma unroll 4
      for (int c = 0; c < 256; ++c) {
        const int m = (c * kp) & 255; const float t = im ? -snt[m] : cst[m];
        const float4 w0 = *(const float4*)(wrow + c * 8), w1 = *(const float4*)(wrow + c * 8 + 4);
        acc[0] += w0.x * t; acc[1] += w0.y * t; acc[2] += w0.z * t; acc[3] += w0.w * t; acc[4] += w1.x * t; acc[5] += w1.y * t; acc[6] += w1.z * t; acc[7] += w1.w * t;
      }
      float* d = (im ? dim_ : dre) + kp * 8;
      *(float4*)d = make_float4(acc[0], acc[1], acc[2], acc[3]); *(float4*)(d + 4) = make_float4(acc[4], acc[5], acc[6], acc[7]);
    }
    __syncthreads();
    {
      const int j = tid & 255; const bool im = tid >= 256;
      const float* Wf = p.fnet_w() + (size_t)l * 65536 + j;
      const float* d = im ? dim_ : dre;
      float acc[8] = {0.f, 0.f, 0.f, 0.f, 0.f, 0.f, 0.f, 0.f};
#pragma unroll 8
      for (int kp = 0; kp < 256; ++kp) {
        const float w = Wf[kp * 256];
        const float4 d0 = *(const float4*)(d + kp * 8), d1 = *(const float4*)(d + kp * 8 + 4);
        acc[0] += d0.x * w; acc[1] += d0.y * w; acc[2] += d0.z * w; acc[3] += d0.w * w; acc[4] += d1.x * w; acc[5] += d1.y * w; acc[6] += d1.z * w; acc[7] += d1.w * w;
      }
      float* o = p.btf() + ((size_t)l * NIN + (im ? 2560 : 2304) + j) * DM + k0;
      *(float4*)o = make_float4(acc[0] * 0.0625f, acc[1] * 0.0625f, acc[2] * 0.0625f, acc[3] * 0.0625f);
      *(float4*)(o + 4) = make_float4(acc[4] * 0.0625f, acc[5] * 0.0625f, acc[6] * 0.0625f, acc[7] * 0.0625f);
    }
    if (tid < 256) {
      const int dir = tid >> 7, kk = tid & 127;
      const float* gw = p.gla_gk_w() + ((size_t)l * 2 + dir) * 16 * 128 + kk;
      float acc[8] = {0.f, 0.f, 0.f, 0.f, 0.f, 0.f, 0.f, 0.f};
#pragma unroll
      for (int r16 = 0; r16 < 16; ++r16) {
        const float w = gw[r16 * 128];
        const float4 g0 = *(const float4*)(glr + (dir * 16 + r16) * 8), g1 = *(const float4*)(glr + (dir * 16 + r16) * 8 + 4);
        acc[0] += g0.x * w; acc[1] += g0.y * w; acc[2] += g0.z * w; acc[3] += g0.w * w; acc[4] += g1.x * w; acc[5] += g1.y * w; acc[6] += g1.z * w; acc[7] += g1.w * w;
      }
      float* o = p.btf() + ((size_t)l * NIN + 1024 + tid) * DM + k0;
      *(float4*)o = make_float4(acc[0], acc[1], acc[2], acc[3]); *(float4*)(o + 4) = make_float4(acc[4], acc[5], acc[6], acc[7]);
    }
    __syncthreads();
  }
}

enum { MAP_ID = 0, MAP_IN = 1, MAP_UQ = 2, MAP_UKV = 3, MAP_GU = 4 };
__device__ __forceinline__ int colmap(int mt, int n) {
  switch (mt) {
    case MAP_ID: return n;
    case MAP_IN:
      if (n < 256) return n;
      if (n < 384) return 256 + (n - 256);
      if (n < 512) return 1184 + (n - 384);
      if (n < 640) return 1312 + (n - 512);
      if (n < 672) return 384 + (n - 640);
      if (n < 768) return -1;
      if (n < 1024) return 1440 + (n - 768);
      if (n < 1280) return -2;
      if (n < 1536) return 1728 + (n - 1280);
      if (n < 2304) return 416 + (n - 1536);
      return -2;
    case MAP_UQ:
      if (n < 256) return (n >> 6) * 96 + (n & 63);
      if (n < 384) return ((n - 256) >> 5) * 96 + 64 + ((n - 256) & 31);
      return -1;
    case MAP_UKV:
      if (n < 256) return (n >> 6) * 128 + (n & 63);
      return ((n - 256) >> 6) * 128 + 64 + ((n - 256) & 63);
    default: {
      const int pn = n >> 8, w = n & 255;
      return w < 128 ? 2 * (pn * 128 + w) : 2 * (pn * 128 + w - 128) + 1;
    }
  }
}
__device__ __forceinline__ int invmap(int mt, int sc) {
  if (mt == MAP_ID) return sc;
  if (mt == MAP_GU) { const int j = sc >> 1, t = sc & 1; return (j >> 7) * 256 + t * 128 + (j & 127); }
  if (sc < 384) return sc;
  if (sc < 416) return 640 + (sc - 384);
  if (sc < 1184) return 1536 + (sc - 416);
  if (sc < 1312) return 384 + (sc - 1184);
  if (sc < 1440) return 512 + (sc - 1312);
  if (sc < 1696) return 768 + (sc - 1440);
  if (sc < 1728) return -1;
  if (sc < 1984) return 1280 + (sc - 1728);
  return -1;
}
struct ConvJob { const float* src; void* dst; const float* scale; int ld, K, mt, k0, s0, f32; };
__device__ __forceinline__ void conv_tile_load(const ConvJob& J, int tid, float4 (&v)[4]) {
  const int kk = tid >> 5, s4 = (tid & 31) * 4;
#pragma unroll
  for (int i = 0; i < 4; ++i) {
    v[i] = make_float4(0.f, 0.f, 0.f, 0.f);
    if (J.s0 + s4 < J.ld) v[i] = *(const float4*)(J.src + (size_t)(J.k0 + kk + 16 * i) * J.ld + J.s0 + s4);
  }
}
__device__ __forceinline__ void conv_tile_proc(const ConvJob& J, int tid, const float4 (&v)[4], float* tile  ) {
  {
    const int kk = tid >> 5, s4 = (tid & 31) * 4;
#pragma unroll
    for (int i = 0; i < 4; ++i) {
      const float sc = J.scale ? J.scale[J.k0 + kk + 16 * i] : 1.f;
      float* t = tile + (kk + 16 * i) * 129 + s4;
      t[0] = v[i].x * sc; t[1] = v[i].y * sc; t[2] = v[i].z * sc; t[3] = v[i].w * sc;
    }
  }
  __syncthreads();
#pragma unroll
  for (int h = 0; h < 2; ++h) {
    const int sl = (tid >> 3) + 64 * h, ks = (tid & 7) * 8, sc = J.s0 + sl;
    const int row = sc < J.ld ? invmap(J.mt, sc) : -1;
    if (row >= 0) {
      const float* t = tile + ks * 129 + sl;
      if (J.f32) {
        float* dst = (float*)J.dst + (size_t)row * J.K + J.k0 + ks;
        *(float4*)dst = make_float4(t[0], t[129], t[2 * 129], t[3 * 129]); *(float4*)(dst + 4) = make_float4(t[4 * 129], t[5 * 129], t[6 * 129], t[7 * 129]);
      } else {
        u32x4 w;
        w[0] = cvtpk(t[0], t[129]); w[1] = cvtpk(t[2 * 129], t[3 * 129]); w[2] = cvtpk(t[4 * 129], t[5 * 129]); w[3] = cvtpk(t[6 * 129], t[7 * 129]);
        *(u32x4*)((u16*)J.dst + (size_t)row * J.K + J.k0 + ks) = w;
      }
    }
  }
  __syncthreads();
}
constexpr int CT_IN = 16 * 18, CT_OUT = 16 * 8, CT_DN = NE * 128, CT_L = CT_IN + CT_OUT + CT_DN;
__device__ __forceinline__ void conv_decode(const Params& p, int t, ConvJob& J) {
  const int l = t / CT_L; int r = t % CT_L;
  if (r < CT_IN) { J.src = p.w_in() + (size_t)l * DM * DIN0; J.ld = DIN0; J.K = DM; J.dst = p.btf() + (size_t)l * NIN * DM; J.mt = MAP_IN; J.scale = nullptr; J.k0 = (r / 18) * 64; J.s0 = (r % 18) * 128; J.f32 = 1; return; }
  r -= CT_IN;
  if (r < CT_OUT) { J.src = p.w_out() + (size_t)l * DM * DM; J.ld = DM; J.K = DM; J.dst = p.bt_out() + (size_t)l * DM * DM; J.mt = MAP_ID; J.scale = p.mix_g() + l * DM; J.k0 = (r / 8) * 64; J.s0 = (r % 8) * 128; J.f32 = 0; return; }
  r -= CT_OUT;
  const int e = r >> 7, q = r & 127;
  J.src = p.moe_w_down() + ((size_t)l * NE + e) * DFF * DM; J.ld = DM; J.K = DFF; J.dst = p.bt_dn() + ((size_t)l * NE + e) * DM * DFF; J.mt = MAP_ID; J.scale = nullptr; J.k0 = (q >> 3) * 64; J.s0 = (q & 7) * 128; J.f32 = 0;
}
__device__ __forceinline__ void conv_gu8_load(const float* __restrict__ src  , int s0, int tid, float4 (&v)[16]) {
  const int c4 = (tid & 7) * 4, r0 = tid >> 3;
#pragma unroll
  for (int pss = 0; pss < 16; ++pss) v[pss] = *(const float4*)(src + (size_t)(r0 + 64 * pss) * 2048 + s0 + c4);
}
__device__ __forceinline__ void conv_gu8_proc(const float4 (&v)[16], signed char* __restrict__ dst  , float* __restrict__ sw  ,
                                              int s0, float* tile  , int tid) {
  float* cmax = tile + 1024 * 33;
  {
    const int c4 = (tid & 7) * 4, r0 = tid >> 3;
#pragma unroll
    for (int pss = 0; pss < 16; ++pss) { float* t = tile + (r0 + 64 * pss) * 33 + c4; t[0] = v[pss].x; t[1] = v[pss].y; t[2] = v[pss].z; t[3] = v[pss].w; }
  }
  __syncthreads();
  {
    const int col = tid & 31, part = tid >> 5; float m = 0.f;
#pragma unroll 8
    for (int k = part * 64; k < part * 64 + 64; ++k) m = fmaxf(m, fabsf(tile[k * 33 + col]));
    cmax[part * 32 + col] = m;
  }
  __syncthreads();
  if (tid < 32) {
    float m = 0.f;
#pragma unroll
    for (int q = 0; q < 16; ++q) m = fmaxf(m, cmax[q * 32 + tid]);
    const float sc = fmaxf(m, 1e-20f) * (1.f / 127.f);
    cmax[512 + tid] = sc;
    sw[invmap(MAP_GU, s0 + tid)] = sc;
  }
  __syncthreads();
#pragma unroll
  for (int h = 0; h < 4; ++h) {
    const int g = tid + 512 * h, col = g & 31, k0 = (g >> 5) * 16;
    const float inv = 1.f / cmax[512 + col];
    unsigned w[4];
#pragma unroll
    for (int q = 0; q < 4; ++q) {
      const float* t = tile + (k0 + 4 * q) * 33 + col;
      const int q0 = (int)rintf(t[0] * inv), q1 = (int)rintf(t[33] * inv), q2 = (int)rintf(t[66] * inv), q3 = (int)rintf(t[99] * inv);
      w[q] = (unsigned)(q0 & 255) | ((unsigned)(q1 & 255) << 8) | ((unsigned)(q2 & 255) << 16) | ((unsigned)(q3 & 255) << 24);
    }
    *(u32x4*)(dst + (size_t)invmap(MAP_GU, s0 + col) * DM + k0) = u32x4{w[0], w[1], w[2], w[3]};
  }
  __syncthreads();
}
__device__ __forceinline__ void phase_convert(const Params& p, int bid, int nb, char* lds) {
  float* tile = (float*)lds;
  const int tid = ltid();
  {
    ConvJob J, Jn; float4 v[4], vn[4];
    int t = bid;
    if (t < 2 * CT_L) { conv_decode(p, t, J); conv_tile_load(J, tid, v); }
    for (; t < 2 * CT_L; t += nb) {
      const bool more = t + nb < 2 * CT_L;
      if (more) { conv_decode(p, t + nb, Jn); conv_tile_load(Jn, tid, vn); }
      conv_tile_proc(J, tid, v, tile);
      if (more) { J = Jn;
#pragma unroll
        for (int i = 0; i < 4; ++i) v[i] = vn[i]; }
    }
  }
  {
    float4 v[16], vn[16];
    int t = bid;
    if (t < 2 * NE * 64) conv_gu8_load(p.moe_w_gu() + (size_t)(t >> 6) * DM * 2048, (t & 63) * 32, tid, v);
    for (; t < 2 * NE * 64; t += nb) {
      const bool more = t + nb < 2 * NE * 64; const int tn = t + nb;
      if (more) conv_gu8_load(p.moe_w_gu() + (size_t)(tn >> 6) * DM * 2048, (tn & 63) * 32, tid, vn);
      conv_gu8_proc(v, p.bt_gu() + (size_t)(t >> 6) * 2048 * DM, p.swgu() + (size_t)(t >> 6) * 2048, (t & 63) * 32, tile, tid);
      if (more) {
#pragma unroll
        for (int i = 0; i < 16; ++i) v[i] = vn[i]; }
    }
  }
  for (int l = 0; l < 2; ++l) {
    for (int i = bid * NTHR + tid; i < 96 * DM / 4; i += nb * NTHR) *(float4*)(p.btf() + ((size_t)l * NIN + 672) * DM + (size_t)i * 4) = make_float4(0.f, 0.f, 0.f, 0.f);
    {
      const float* wq = p.mla_w_uq() + (size_t)l * 256 * 384; const float* wkv = p.mla_w_ukv() + (size_t)l * 128 * 512;
      const float* gq = p.mla_q_g() + l * 256; const float* gkv = p.mla_kv_g() + l * 128;
      u16* dst = p.bt_qkv() + (size_t)l * 1024 * 384;
      for (int i = bid * NTHR + ltid(); i < 1024 * 384; i += nb * NTHR) {
        const int n = i / 384, k = i % 384; float v = 0.f;
        if (n < 512) { const int sc = colmap(MAP_UQ, n); if (k < 256 && sc >= 0) v = gq[k] * wq[k * 384 + sc]; }
        else { if (k >= 256) v = gkv[k - 256] * wkv[(k - 256) * 512 + colmap(MAP_UKV, n - 512)]; }
        dst[i] = f2bf(v);
      }
    }
  }
}

__device__ __forceinline__ void phase_hy_mlp(const Params& p, int l, int Lf, float* __restrict__ hout  , float* __restrict__ ssq  ,
                             int bid, int nb, char* lds) {
  float* zf = (float*)lds;
  float* h1 = zf + 64 * 33;
  float* h2 = h1 + 64 * 64;
  const int tid = ltid();
  const float* w1 = p.hy_w1() + (size_t)l * 33 * 64; const float* b1 = p.hy_b1() + l * 64;
  const float* w2 = p.hy_w2() + (size_t)l * 64 * 64; const float* b2 = p.hy_b2() + l * 64;
  const float* w3 = p.hy_w3() + (size_t)l * 64 * 512; const float* fr = p.hy_freq() + l * 64;
  float w3c[64];
#pragma unroll
  for (int k = 0; k < 64; ++k) w3c[k] = w3[k * 512 + tid];
  const int dir = tid >> 8, ch = tid & 255;
  const float maxd = logf(1e-2f) / 0.3f, mind = logf(1e-2f) / 1.5f;
  const float delta = fabsf(mind + (maxd - mind) * (float)ch / 255.f);
  float ssq_acc = 0.f;
  for (int it = bid; it < Lf / 64; it += nb) {
    const int t0 = it * 64;
    for (int i = tid; i < 64 * 33; i += NTHR) {
      const int tt = i / 33, f = i % 33, t = t0 + tt;
      float v;
      if (f == 0) v = (float)t / (float)(Lf - 1);
      else {
        const int j = (f - 1) & 15;
        const float fj = 1e-4f + (float)j * ((15.f - 1e-4f) / 15.f);
        const float w = 6.283185307179586f * (float)t / (float)Lf;
        v = (f <= 16) ? cosf(fj * w) : -sinf(fj * w);
      }
      zf[i] = v;
    }
    __syncthreads();
    {
      const int o = tid & 63, tb = tid >> 6;
      float acc[8];
#pragma unroll
      for (int j = 0; j < 8; ++j) acc[j] = b1[o];
#pragma unroll 3
      for (int f = 0; f < 33; ++f) {
        const float w = w1[f * 64 + o];
#pragma unroll
        for (int j = 0; j < 8; ++j) acc[j] += zf[(tb + 8 * j) * 33 + f] * w;
      }
      const float fo = fr[o];
#pragma unroll
      for (int j = 0; j < 8; ++j) h1[(tb + 8 * j) * 64 + o] = sinf(fo * acc[j]);
    }
    __syncthreads();
    {
      const int o = tid & 63, tb = tid >> 6;
      float acc[8];
#pragma unroll
      for (int j = 0; j < 8; ++j) acc[j] = b2[o];
#pragma unroll 4
      for (int f = 0; f < 64; f += 4) {
        const float wa = w2[f * 64 + o], wb = w2[(f + 1) * 64 + o], wc2 = w2[(f + 2) * 64 + o], wd = w2[(f + 3) * 64 + o];
#pragma unroll
        for (int j = 0; j < 8; ++j) { const float4 hv = *(const float4*)(h1 + (tb + 8 * j) * 64 + f); acc[j] += hv.x * wa + hv.y * wb + hv.z * wc2 + hv.w * wd; }
      }
      const float fo = fr[o];
#pragma unroll
      for (int j = 0; j < 8; ++j) h2[(tb + 8 * j) * 64 + o] = sinf(fo * acc[j]);
    }
    __syncthreads();
    float* orow = hout + ((size_t)dir * 256 + ch) * Lf + t0;
    for (int tq = 0; tq < 16; ++tq) {
      float sv[4];
#pragma unroll
      for (int u = 0; u < 4; ++u) {
        const int tt = tq * 4 + u;
        float s = 0;
#pragma unroll
        for (int k = 0; k < 64; k += 4) { const float4 hv = *(const float4*)(h2 + tt * 64 + k); s += hv.x * w3c[k] + hv.y * w3c[k + 1] + hv.z * w3c[k + 2] + hv.w * w3c[k + 3]; }
        const int t = t0 + tt;
        s *= __expf(-((float)t / (float)(Lf - 1)) * delta);
        if (dir == 0 || t > 0) ssq_acc += s * s;
        sv[u] = s;
      }
      *(float4*)(orow + tq * 4) = make_float4(sv[0], sv[1], sv[2], sv[3]);
    }
    __syncthreads();
  }
  ssq[(size_t)bid * 512 + tid] = ssq_acc;
}

__host__ __device__ constexpr int fx(int p) {
  return ((p >> 12) & 3) ^ (((p >> 10) & 3) << 2) ^ ((p >> 4) & 16) ^ (((p >> 5) & 1) * 5) ^ (((p >> 6) & 1) * 26);
}
__device__ __forceinline__ int swz(int p) { return p ^ fx(p); }
__device__ __forceinline__ int rev7(int k) {
  unsigned r = __brev((unsigned)k) >> 18;
  return (int)(((r & 0x2AAAu) >> 1) | ((r & 0x1555u) << 1));
}
template <int ST, bool INV>
__device__ __forceinline__ void fft_stage(float2* s, const float2* __restrict__ tw, const int tid) {
  constexpr int sh = 12 - 2 * ST, q = 1 << sh, ND = q >= 512 ? q / 512 : 1;
  float2 w1[ND], w2[ND], w3[ND];
  if constexpr (ST < 6) {
#pragma unroll
    for (int d = 0; d < ND; ++d) {
      const int j = q >= 512 ? tid + 512 * d : (tid & (q - 1)), ti = j << (2 * ST);
      w1[d] = tw[ti]; w2[d] = tw[2 * ti]; w3[d] = tw[3 * ti];
    }
  }
  float2 x[8][4];
#pragma unroll
  for (int m = 0; m < 8; ++m) {
    const int u = tid + 512 * m, g = u >> sh, j = u & (q - 1), base = (g << (sh + 2)) + j, xb = fx(base);
    x[m][0] = s[base ^ xb]; x[m][1] = s[(base + q) ^ xb ^ fx(q)]; x[m][2] = s[(base + 2 * q) ^ xb ^ fx(2 * q)]; x[m][3] = s[(base + 3 * q) ^ xb ^ fx(3 * q)];
  }
#pragma unroll
  for (int m = 0; m < 8; ++m) {
    const int u = tid + 512 * m, g = u >> sh, j = u & (q - 1), base = (g << (sh + 2)) + j, xb = fx(base);
    const int i0 = base ^ xb, i1 = (base + q) ^ xb ^ fx(q), i2 = (base + 2 * q) ^ xb ^ fx(2 * q), i3 = (base + 3 * q) ^ xb ^ fx(3 * q);
    const int d = q >= 512 ? (m % ND) : 0;
    if constexpr (!INV) {
      const float2 a0 = x[m][0], a1 = x[m][1], a2 = x[m][2], a3 = x[m][3];
      const float2 b0 = make_float2(a0.x + a2.x, a0.y + a2.y), b1 = make_float2(a0.x - a2.x, a0.y - a2.y);
      const float2 b2 = make_float2(a1.x + a3.x, a1.y + a3.y), b3 = make_float2(a1.x - a3.x, a1.y - a3.y);
      const float2 y1 = make_float2(b1.x + b3.y, b1.y - b3.x), y2 = make_float2(b0.x - b2.x, b0.y - b2.y), y3 = make_float2(b1.x - b3.y, b1.y + b3.x);
      s[i0] = make_float2(b0.x + b2.x, b0.y + b2.y);
      if constexpr (ST < 6) { s[i1] = cmul(y1, w1[d]); s[i2] = cmul(y2, w2[d]); s[i3] = cmul(y3, w3[d]); }
      else { s[i1] = y1; s[i2] = y2; s[i3] = y3; }
    } else {
      float2 t0 = x[m][0], t1 = x[m][1], t2 = x[m][2], t3 = x[m][3];
      if constexpr (ST < 6) { t1 = cmulc(t1, w1[d]); t2 = cmulc(t2, w2[d]); t3 = cmulc(t3, w3[d]); }
      const float2 b0 = make_float2(t0.x + t2.x, t0.y + t2.y), b1 = make_float2(t0.x - t2.x, t0.y - t2.y);
      const float2 b2 = make_float2(t1.x + t3.x, t1.y + t3.y), b3 = make_float2(t1.x - t3.x, t1.y - t3.y);
      s[i0] = make_float2(b0.x + b2.x, b0.y + b2.y);
      s[i1] = make_float2(b1.x - b3.y, b1.y + b3.x);
      s[i2] = make_float2(b0.x - b2.x, b0.y - b2.y);
      s[i3] = make_float2(b1.x + b3.y, b1.y - b3.x);
    }
  }
  __syncthreads();
}
__device__ __forceinline__ void fft_fwd(float2* s, const float2* __restrict__ tw) {
  const int tid = ltid();
  fft_stage<0, false>(s, tw, tid); fft_stage<1, false>(s, tw, tid); fft_stage<2, false>(s, tw, tid); fft_stage<3, false>(s, tw, tid);
  fft_stage<4, false>(s, tw, tid); fft_stage<5, false>(s, tw, tid); fft_stage<6, false>(s, tw, tid);
}
__device__ __forceinline__ void fft_inv(float2* s, const float2* __restrict__ tw) {
  const int tid = ltid();
  fft_stage<6, true>(s, tw, tid); fft_stage<5, true>(s, tw, tid); fft_stage<4, true>(s, tw, tid); fft_stage<3, true>(s, tw, tid);
  fft_stage<2, true>(s, tw, tid); fft_stage<1, true>(s, tw, tid); fft_stage<0, true>(s, tw, tid);
}

__device__ __forceinline__ float filt_ssq(const float* __restrict__ part  , int ch, float* red  ) {
  const int tid = ltid();
  float v = part[(size_t)(tid >> 1) * 512 + (tid & 1) * 256 + ch];
  v = wave_sum(v);
  __syncthreads();
  if ((tid & 63) == 0) red[tid >> 6] = v;
  __syncthreads();
  return ((red[0] + red[1]) + (red[2] + red[3])) + ((red[4] + red[5]) + (red[6] + red[7]));
}
__device__ __forceinline__ void phase_hy_filtfft(const Params& p, int bid, int nb, char* lds) {
  float2* s = (float2*)lds;
  const int tid = ltid();
  for (int it = bid; it < 512; it += nb) {
    const int l = it >> 8, ch = it & 255;
    const float* hf = p.hfb() + (((size_t)l * 2 + 0) * 256 + ch) * SEQ;
    const float* hb = p.hfb() + (((size_t)l * 2 + 1) * 256 + ch) * SEQ;
#pragma unroll 8
    for (int m = tid; m < FM; m += NTHR) {
      const int n0 = 2 * m, n1 = 2 * m + 1;
      const float a = (n0 < SEQ) ? hf[n0] : (n0 == SEQ ? 0.f : hb[2 * SEQ - n0]);
      const float b = (n1 < SEQ) ? hf[n1] : hb[2 * SEQ - n1];
      s[swz(m)] = make_float2(a, b);
    }
    __syncthreads();
    fft_fwd(s, p.tw());
    const float sc = rsqrtf(filt_ssq(p.hpart() + (size_t)l * 256 * 512, ch, (float*)(lds + 139264))) * (1.f / 16384.f);
    float4* out = p.hspec() + ((size_t)l * 256 + ch) * HSP;
#pragma unroll 4
    for (int k = tid; k <= FM / 2; k += NTHR) {
      const float2 zk = s[swz(rev7(k))], zm = s[swz(rev7((FM - k) & (FM - 1)))];
      const float er = 0.5f * (zk.x + zm.x), ei = 0.5f * (zk.y - zm.y);
      const float dr = 0.5f * (zk.x - zm.x), di = 0.5f * (zk.y + zm.y);
      out[k] = make_float4(er * sc, ei * sc, di * sc, -dr * sc);
    }
    __syncthreads();
  }
}
constexpr int G_TILE_B = 256 * 64 * 2;
constexpr int G_STAGE_B = 2 * G_TILE_B;
constexpr int GEMM_LDS = 2 * G_STAGE_B;

__device__ __forceinline__ int lds_byte2(int r, int c) {
  const int st = (r >> 4) * 2 + (c >> 5), ob = (r & 15) * 64 + (c & 31) * 2;
  return st * 1024 + (ob ^ (((ob >> 9) & 1) << 5));
}
__device__ __forceinline__ void stage_rc2(int b, int& R, int& C) {
  const int st = b >> 10, sb = b & 1023, swz = sb ^ (((sb >> 9) & 1) << 5);
  R = (st >> 1) * 16 + (swz >> 6);
  C = (st & 1) * 32 + ((swz & 63) >> 1);
}
__device__ __forceinline__ void gemm_stage_coords(int (&sR)[4], int (&sC)[4]) {
  const int wid = ltid() >> 6, lane = ltid() & 63;
#pragma unroll
  for (int i = 0; i < 4; ++i) stage_rc2(wid * 1024 + i * 8192 + lane * 16, sR[i], sC[i]);
}

#define WAIT_V0() asm volatile("s_waitcnt vmcnt(0)" ::: "memory")

__device__ __forceinline__ void gemm256_core(const u16* const (&ap)[4], const u16* const (&bp)[4], int nt, char* shm, f32x4 (&acc)[8][4]) {
  const int tid = ltid(), wid = tid >> 6, lane = tid & 63, wr = wid >> 2, wc = wid & 3, fr = lane & 15, fq = lane >> 4;
#pragma unroll
  for (int m = 0; m < 8; ++m)
#pragma unroll
    for (int n = 0; n < 4; ++n) acc[m][n] = f32x4{0.f, 0.f, 0.f, 0.f};
#define G_SA(b) (shm + (b) * G_STAGE_B)
#define G_SB(b) (shm + (b) * G_STAGE_B + G_TILE_B)
#define G_STAGE(buf, kt) do { _Pragma("unroll") for (int i = 0; i < 4; ++i) {                                                   \
    __builtin_amdgcn_global_load_lds((const unsigned*)(ap[i] + (kt) * 64), (unsigned*)(G_SA(buf) + wid * 1024 + i * 8192), 16, 0, 0); \
    __builtin_amdgcn_global_load_lds((const unsigned*)(bp[i] + (kt) * 64), (unsigned*)(G_SB(buf) + wid * 1024 + i * 8192), 16, 0, 0); } } while (0)
  G_STAGE(0, 0); WAIT_V0(); __syncthreads();
#pragma unroll 1
  for (int t = 0; t < nt; ++t) {
    const int cur = t & 1;
    if (t + 1 < nt) G_STAGE(cur ^ 1, t + 1);
#pragma unroll
    for (int ks = 0; ks < 2; ++ks) {
      bf16x8 At[8], Bf[4];
#pragma unroll
      for (int m = 0; m < 8; ++m) At[m] = *(const bf16x8*)(G_SA(cur) + lds_byte2(wr * 128 + m * 16 + fr, ks * 32 + fq * 8));
#pragma unroll
      for (int n = 0; n < 4; ++n) Bf[n] = *(const bf16x8*)(G_SB(cur) + lds_byte2(wc * 64 + n * 16 + fr, ks * 32 + fq * 8));
#pragma unroll
      for (int m = 0; m < 8; ++m)
#pragma unroll
        for (int n = 0; n < 4; ++n) acc[m][n] = __builtin_amdgcn_mfma_f32_16x16x32_bf16(At[m], Bf[n], acc[m][n], 0, 0, 0);
      __builtin_amdgcn_sched_barrier(0);
    }
    WAIT_V0(); __syncthreads();
  }
#undef G_STAGE
}

#define LAS3 __attribute__((address_space(3)))
constexpr int G8_HTB = 128 * 64 * 2;
__device__ __forceinline__ int g8_perm32(int rho) { const int n = rho >> 4, i = rho & 15; return 8 * (i >> 2) + 4 * n + (i & 3); }
__device__ __forceinline__ int g8_lds_byte(int r, int c) { const int st = (r >> 4) * 2 + (c >> 5), rr = r & 15, cc = c & 31, ob = rr * 64 + cc * 2; return st * 1024 + (ob ^ (((ob >> 9) & 1) << 5)); }
__device__ __forceinline__ void g8_stage_rc(int b, int& R, int& C) { const int st = b / 1024, sb = b % 1024, swz = sb ^ (((sb >> 9) & 1) << 5); R = (st >> 1) * 16 + swz / 64; C = (st & 1) * 32 + (swz % 64) / 2; }
struct G8Unit { int pm, pn, e, ce, pre; };
__device__ __forceinline__ void g8_cload(const float* __restrict__ src, float* dst) {
  __builtin_amdgcn_global_load_lds((const unsigned*)(src + (ltid() & 63) * 4), (LAS3 unsigned*)dst, 16, 0, 0);
}


template <bool I8> __device__ __forceinline__ typename std::conditional<I8, int __attribute__((ext_vector_type(4))), f32x4>::type
g8_mma(bf16x8 x, bf16x8 y, typename std::conditional<I8, int __attribute__((ext_vector_type(4))), f32x4>::type c) {
  if constexpr (I8) { typedef int v4i __attribute__((ext_vector_type(4))); return __builtin_amdgcn_mfma_i32_16x16x64_i8(*(v4i*)&x, *(v4i*)&y, c, 0, 0, 0); }
  else return __builtin_amdgcn_mfma_f32_16x16x32_bf16(x, y, c, 0, 0, 0);
}
typedef int i32x4 __attribute__((ext_vector_type(4)));
template <bool I8> struct G8Acc { typedef f32x4 T; };
template <> struct G8Acc<true> { typedef i32x4 T; };
template <bool I8, class Sched, class Epi>
__device__ __forceinline__ void gemm8_phase(char* lds_g, const char* Abase, const int Kb, const Sched& S, const Epi& E) {
    typedef typename G8Acc<I8>::T ACC;
    LAS3 unsigned char* lds = (LAS3 unsigned char*)lds_g;
    const int tid = ltid(), wid = __builtin_amdgcn_readfirstlane(tid >> 6), lane = tid & 63, wr = wid >> 2, wc = wid & 3, fr = lane & 15, fq = lane >> 4;
    const int nt = Kb / 128;
    int sRr[2], sCc[2]; unsigned voffB[2];
#pragma unroll
    for (int i = 0; i < 2; ++i) { g8_stage_rc(tid * 16 + i * 8192, sRr[i], sCc[i]); const int Rb = (sRr[i] & ~31) + g8_perm32(sRr[i] & 31); voffB[i] = (unsigned)(Rb * Kb) + (unsigned)sCc[i] * 2u; }
    const size_t kstep = 128;
    const size_t hstepB = (size_t)128 * Kb;
    const unsigned ldsw = (unsigned)wid * 1024u;
    const int aoff = g8_lds_byte(wr * 64 + fr, fq * 8), boff = g8_lds_byte(wc * 32 + fr, fq * 8);
#define G8_SA(b, h) (((b) * 2 + (h)) * G8_HTB)
#define G8_SB(b, h) ((4 + (b) * 2 + (h)) * G8_HTB)
#define G8_STAGE_B(bufoff, gbase) do { _Pragma("unroll") for (int _i = 0; _i < 2; ++_i) \
        __builtin_amdgcn_global_load_lds((const unsigned*)((const char*)(gbase) + voffB[_i]), (LAS3 unsigned*)(lds + (bufoff) + ldsw + _i * 8192), 16, 0, 0); } while (0)
#define G8_STAGE_A(bufoff, o0, o1) do { \
        __builtin_amdgcn_global_load_lds((const unsigned*)(Abase + (o0)), (LAS3 unsigned*)(lds + (bufoff) + ldsw), 16, 0, 0); \
        __builtin_amdgcn_global_load_lds((const unsigned*)(Abase + (o1)), (LAS3 unsigned*)(lds + (bufoff) + ldsw + 8192), 16, 0, 0); } while (0)
#define G8_LDA(dst, b, h) do { _Pragma("unroll") for (int m = 0; m < 4; ++m) _Pragma("unroll") for (int k = 0; k < 2; ++k) dst[m][k] = *(const LAS3 bf16x8*)(lds + G8_SA(b, h) + aoff + m * 2048 + k * 1024); } while (0)
#define G8_LDB(dst, b, h) do { _Pragma("unroll") for (int n = 0; n < 2; ++n) _Pragma("unroll") for (int k = 0; k < 2; ++k) dst[n][k] = *(const LAS3 bf16x8*)(lds + G8_SB(b, h) + boff + n * 2048 + k * 1024); } while (0)
#define G8_MMA(ai, bj, At, Bt) do { __builtin_amdgcn_s_setprio(1); _Pragma("unroll") for (int m = 0; m < 4; ++m) _Pragma("unroll") for (int n = 0; n < 2; ++n) _Pragma("unroll") for (int k = 0; k < 2; ++k) \
        acc[ai][bj][m][n] = g8_mma<I8>(Bt[n][k], At[m][k], acc[ai][bj][m][n]); __builtin_amdgcn_s_setprio(0); } while (0)
#define G8_WAIT_V(n) asm volatile("s_waitcnt vmcnt(" #n ")" ::: "memory")
#define G8_WAIT_L(n) asm volatile("s_waitcnt lgkmcnt(" #n ")" ::: "memory")
#define G8_BAR __builtin_amdgcn_s_barrier()
#define G8_SCHED __builtin_amdgcn_sched_barrier(0)
    G8Unit cur, nxt; int ui = 0;
    if (!S.next(0, cur)) return;
    ACC acc[2][2][4][2];
#pragma unroll
    for (int a = 0; a < 2; ++a)
#pragma unroll
        for (int b = 0; b < 2; ++b)
#pragma unroll
            for (int m = 0; m < 4; ++m)
#pragma unroll
                for (int n = 0; n < 2; ++n) acc[a][b][m][n] = ACC{};
    bf16x8 At[4][2], B0[2][2], B1[2][2];
    float ep[8];
    unsigned va[2][2], vn[2][2];
#pragma unroll
    for (int h = 0; h < 2; ++h)
#pragma unroll
        for (int i = 0; i < 2; ++i) va[h][i] = S.a_off(cur, h * 128 + sRr[i]) + (unsigned)sCc[i] * 2u;
    const char* cB = S.b_ptr(cur);
    G8_STAGE_B(G8_SB(0, 0), cB); G8_STAGE_A(G8_SA(0, 0), va[0][0], va[0][1]); G8_STAGE_B(G8_SB(0, 1), cB + hstepB); G8_STAGE_A(G8_SA(0, 1), va[1][0], va[1][1]);
    if (wr == 1) G8_BAR;
    G8_WAIT_V(4); G8_BAR;
    G8_STAGE_B(G8_SB(1, 0), cB + kstep); G8_STAGE_A(G8_SA(1, 0), va[0][0] + kstep, va[0][1] + kstep); G8_STAGE_B(G8_SB(1, 1), cB + hstepB + kstep);
    G8_WAIT_V(6); G8_BAR;
    for (;;) {
        float* cb = (float*)(lds_g + 136192 + (ui & 1) * 2048);
        E.pre(cur, wr, fr, ep, cb);
        const bool has_next = S.next(ui + 1, nxt);
        const char* nB = cB;
#pragma unroll
        for (int h = 0; h < 2; ++h)
#pragma unroll
            for (int i = 0; i < 2; ++i) vn[h][i] = va[h][i];
        if (has_next) {
            nB = S.b_ptr(nxt);
#pragma unroll
            for (int h = 0; h < 2; ++h)
#pragma unroll
                for (int i = 0; i < 2; ++i) vn[h][i] = S.a_off(nxt, h * 128 + sRr[i]) + (unsigned)sCc[i] * 2u;
        }
#pragma unroll 1
        for (int t = 0; t < nt; t += 2) {
            const bool last = (t == nt - 2);
            const unsigned k1 = (unsigned)(t + 1) * 128u;
            const unsigned k2 = last ? 0u : (unsigned)(t + 2) * 128u;
            const unsigned a2_00 = (last ? vn[0][0] : va[0][0]) + k2, a2_01 = (last ? vn[0][1] : va[0][1]) + k2;
            const unsigned a2_10 = (last ? vn[1][0] : va[1][0]) + k2, a2_11 = (last ? vn[1][1] : va[1][1]) + k2;
            const char* b2 = (last ? nB : cB) + k2; const char* b3 = b2 + kstep;
            G8_LDB(B0, 0, 0); G8_SCHED; G8_LDA(At, 0, 0); G8_STAGE_A(G8_SA(1, 1), va[1][0] + k1, va[1][1] + k1);
            G8_WAIT_L(8); G8_BAR; G8_WAIT_L(0); G8_MMA(0, 0, At, B0); G8_BAR; G8_SCHED;
            G8_LDB(B1, 0, 1); G8_STAGE_B(G8_SB(0, 0), b2);
            G8_BAR; G8_WAIT_L(0); G8_MMA(0, 1, At, B1); G8_BAR;
            G8_LDA(At, 0, 1); G8_STAGE_A(G8_SA(0, 0), a2_00, a2_01);
            G8_BAR; G8_WAIT_L(0); G8_MMA(1, 0, At, B0); G8_BAR; G8_SCHED;
            G8_STAGE_B(G8_SB(0, 1), b2 + hstepB);
            G8_WAIT_V(6); G8_BAR; G8_MMA(1, 1, At, B1); G8_BAR;
            G8_LDB(B0, 1, 0); G8_SCHED; G8_LDA(At, 1, 0); G8_STAGE_A(G8_SA(0, 1), a2_10, a2_11);
            G8_WAIT_L(8); G8_BAR; G8_WAIT_L(0); G8_MMA(0, 0, At, B0); G8_BAR; G8_SCHED;
            G8_LDB(B1, 1, 1); G8_STAGE_B(G8_SB(1, 0), b3);
            G8_BAR; G8_WAIT_L(0); G8_MMA(0, 1, At, B1); G8_BAR;
            G8_LDA(At, 1, 1); G8_STAGE_A(G8_SA(1, 0), a2_00 + 128u, a2_01 + 128u);
            G8_BAR; G8_WAIT_L(0); G8_MMA(1, 0, At, B0); G8_BAR; G8_SCHED;
            G8_STAGE_B(G8_SB(1, 1), b3 + hstepB);
            G8_WAIT_V(6); G8_BAR; G8_MMA(1, 1, At, B1); G8_BAR;
        }
        E(acc, cur, wr, wc, fr, fq, ep, cb);
        if (!has_next) break;
#pragma unroll
        for (int a = 0; a < 2; ++a)
#pragma unroll
            for (int b = 0; b < 2; ++b)
#pragma unroll
                for (int m = 0; m < 4; ++m)
#pragma unroll
                    for (int n = 0; n < 2; ++n) acc[a][b][m][n] = ACC{};
        cur = nxt; cB = nB; ++ui;
#pragma unroll
        for (int h = 0; h < 2; ++h)
#pragma unroll
            for (int i = 0; i < 2; ++i) va[h][i] = vn[h][i];
    }
    G8_WAIT_V(0);
    if (wr == 0) G8_BAR;
    G8_BAR;
#undef G8_SA
#undef G8_SB
#undef G8_STAGE_A
#undef G8_STAGE_B
#undef G8_LDA
#undef G8_LDB
#undef G8_MMA
#undef G8_WAIT_V
#undef G8_WAIT_L
#undef G8_BAR
#undef G8_SCHED
}
struct G8Plain {
    int nM, nN, Kb, G, c; const char* Bt;
    __device__ __forceinline__ bool next(int i, G8Unit& u) const {
        const int L = (i * 8 + (c & 7)) * (G >> 3) + (c >> 3); if (L >= nM * nN) return false;
        const int nig = 8 * nN, gid = L / nig, fm = gid * 8, gsz = (nM - fm) < 8 ? (nM - fm) : 8;
        u.pm = fm + ((L % nig) % gsz); u.pn = (L % nig) / gsz; u.e = 0; u.ce = 256; u.pre = 0; return true;
    }
    __device__ __forceinline__ unsigned a_off(const G8Unit& u, int row) const { return (unsigned)(u.pm * 256 + row) * (unsigned)Kb; }
    __device__ __forceinline__ const char* b_ptr(const G8Unit& u) const { return Bt + (size_t)u.pn * 256 * Kb; }
};

__device__ __forceinline__ const float* resid_row_in(const Params& p, int tok) {
  return tok < TL ? p.x() + (size_t)tok * DM : p.ctx() + (size_t)(tok - TL) * DM;
}
__device__ __forceinline__ void load_row_comb(const Params& p, int src_layer, int lc, int tok, int lane, const int* pre  , float (&v)[16]) {
  if (src_layer == 0) {
    const float* r = resid_row_in(p, tok);
#pragma unroll
    for (int i = 0; i < 4; ++i) { const float4 a = *(const float4*)(r + lane * 4 + i * 256); v[4 * i] = a.x; v[4 * i + 1] = a.y; v[4 * i + 2] = a.z; v[4 * i + 3] = a.w; }
  } else {
    const u16* r = p.X() + (size_t)tok * DM;
#pragma unroll
    for (int i = 0; i < 4; ++i) { const float4 a = ld4bf(r + lane * 4 + i * 256); v[4 * i] = a.x; v[4 * i + 1] = a.y; v[4 * i + 2] = a.z; v[4 * i + 3] = a.w; }
  }
  if (lc >= 0) {
    const float* g2 = p.mod() + ((size_t)lc * 3 + modv(tok)) * 6144 + 5 * DM;
    float s[16];
#pragma unroll
    for (int i = 0; i < 16; ++i) s[i] = 0.f;
#pragma unroll
    for (int k = 0; k < TOPK; ++k) {
      const int sl = p.tslot()[tok * 4 + k];
      const size_t arow = (size_t)(pre[sl >> 20] + (sl & 0xFFFFF));
      const u16* y = p.yd() + arow * DM;
#pragma unroll
      for (int i = 0; i < 4; ++i) {
        const u32x2 w = *(const u32x2*)(y + lane * 4 + i * 256);
        s[4 * i] += __uint_as_float(w[0] << 16); s[4 * i + 1] += __uint_as_float(w[0] & 0xFFFF0000u);
        s[4 * i + 2] += __uint_as_float(w[1] << 16); s[4 * i + 3] += __uint_as_float(w[1] & 0xFFFF0000u);
      }
    }
#pragma unroll
    for (int i = 0; i < 4; ++i) {
      const float4 g = *(const float4*)(g2 + lane * 4 + i * 256);
      v[4 * i] += g.x * s[4 * i]; v[4 * i + 1] += g.y * s[4 * i + 1]; v[4 * i + 2] += g.z * s[4 * i + 2]; v[4 * i + 3] += g.w * s[4 * i + 3];
    }
  }
}
__device__ __forceinline__ void expert_prefix(const int* cnt, int* pre) {
  if (ltid() == 0) { int s = 0; for (int e = 0; e < NE; ++e) { pre[e] = s; s += cnt[e]; } pre[NE] = s; }
}

__device__ __forceinline__ float store_row_i8(const float (&y)[16], signed char* __restrict__ h, float* __restrict__ hs_row, int lane) {
  float am = 0.f;
#pragma unroll
  for (int i = 0; i < 16; ++i) am = fmaxf(am, fabsf(y[i]));
  am = wave_max(am);
  const float s = fmaxf(am, 1e-20f) * (1.f / 127.f), inv = 1.f / s;
#pragma unroll
  for (int i = 0; i < 4; ++i) {
    const int q0 = (int)rintf(y[4 * i] * inv), q1 = (int)rintf(y[4 * i + 1] * inv), q2 = (int)rintf(y[4 * i + 2] * inv), q3 = (int)rintf(y[4 * i + 3] * inv);
    *(unsigned*)(h + lane * 4 + i * 256) = (unsigned)(q0 & 255) | ((unsigned)(q1 & 255) << 8) | ((unsigned)(q2 & 255) << 16) | ((unsigned)(q3 & 255) << 24);
  }
  if (lane == 0) *hs_row = s;
  return s;
}
__device__ __forceinline__ void phase_quant_in(const Params& p, int bid, int nb) {
  const int wid = ltid() >> 6, lane = ltid() & 63;
  for (int r = bid * 8 + wid; r < 2 * NIN; r += nb * 8) {
    const float* src = p.btf() + (size_t)r * DM;
    float y[16];
#pragma unroll
    for (int i = 0; i < 4; ++i) { const float4 a = *(const float4*)(src + lane * 4 + i * 256); y[4 * i] = a.x; y[4 * i + 1] = a.y; y[4 * i + 2] = a.z; y[4 * i + 3] = a.w; }
    store_row_i8(y, p.bt_in() + (size_t)r * DM, p.swin() + r, lane);
  }
}
__device__ __forceinline__ void phase_norm1(const Params& p, int layer, int bid, int nb, char* lds) {
  int* pre = (int*)lds;
  const int lc = layer - 1;
  if (lc >= 0) { expert_prefix(p.cnt() + lc * NE, pre); __syncthreads(); }
  const int wid = ltid() >> 6, lane = ltid() & 63;
  const float* gn = p.norm1_g() + layer * DM;
  const int ntok = TT;
  for (int tok = bid * 8 + wid; tok < ntok; tok += nb * 8) {
    float v[16];
    load_row_comb(p, layer == 0 ? 0 : 1, lc, tok, lane, pre, v);
    if (lc >= 0) {
      u16* xr = p.X() + (size_t)tok * DM;
#pragma unroll
      for (int i = 0; i < 4; ++i) *(u32x2*)(xr + lane * 4 + i * 256) = u32x2{cvtpk(v[4 * i], v[4 * i + 1]), cvtpk(v[4 * i + 2], v[4 * i + 3])};
    }
    float ss = 0;
#pragma unroll
    for (int i = 0; i < 16; ++i) ss += v[i] * v[i];
    ss = wave_sum(ss);
    const float rs = rsqrtf(ss * (1.f / DM) + EPS);
    const float* md = p.mod() + ((size_t)layer * 3 + modv(tok)) * 6144;
#pragma unroll
    for (int i = 0; i < 4; ++i) {
      const int c = lane * 4 + i * 256;
      const float4 g = *(const float4*)(gn + c), sh = *(const float4*)(md + c), sc = *(const float4*)(md + DM + c);
      v[4 * i] = v[4 * i] * rs * g.x * (1.f + sc.x) + sh.x; v[4 * i + 1] = v[4 * i + 1] * rs * g.y * (1.f + sc.y) + sh.y;
      v[4 * i + 2] = v[4 * i + 2] * rs * g.z * (1.f + sc.z) + sh.z; v[4 * i + 3] = v[4 * i + 3] * rs * g.w * (1.f + sc.w) + sh.w;
    }
    store_row_i8(v, p.H() + (size_t)tok * DM, p.hs() + tok, lane);
  }
}

struct EpiIn {
  u16* zqkv; u16* zg; u16* zt; const float* hs; const float* sw;
  __device__ __forceinline__ void pre(const G8Unit& u, int wr, int fr, float (&ep)[8], float* cb) const {
    if ((ltid() >> 6) == 0) g8_cload(sw + u.pn * 256, cb);
#pragma unroll
    for (int ai = 0; ai < 2; ++ai)
#pragma unroll
      for (int m = 0; m < 4; ++m) ep[ai * 4 + m] = hs[u.pm * 256 + ai * 128 + wr * 64 + m * 16 + fr];
  }
  __device__ __forceinline__ void operator()(const i32x4 (&acc)[2][2][4][2], const G8Unit& u, int wr, int wc, int fr, int fq, const float (&ep)[8], const float* cb) const {
#pragma unroll
    for (int bj = 0; bj < 2; ++bj) {
      const int c32 = u.pn * 256 + bj * 128 + wc * 32, c0 = c32 + 8 * fq;
      const f32x4 w0 = *(const f32x4*)(cb + bj * 128 + wc * 32 + 8 * fq), w1 = *(const f32x4*)(cb + bj * 128 + wc * 32 + 8 * fq + 4);
#pragma unroll
      for (int ai = 0; ai < 2; ++ai)
#pragma unroll
        for (int m = 0; m < 4; ++m) {
          const int row = u.pm * 256 + ai * 128 + wr * 64 + m * 16 + fr;
          f32x4 a, b;
#pragma unroll
          for (int j = 0; j < 4; ++j) { a[j] = (float)acc[ai][bj][m][0][j] * ep[ai * 4 + m] * w0[j]; b[j] = (float)acc[ai][bj][m][1][j] * ep[ai * 4 + m] * w1[j]; }
          if (c32 < 384) {
            *(u32x4*)(zqkv + (size_t)row * 384 + c0) = u32x4{cvtpk(a[0], a[1]), cvtpk(a[2], a[3]), cvtpk(b[0], b[1]), cvtpk(b[2], b[3])};
          } else if (c32 < 1536) {
            *(u32x4*)(zg + (size_t)row * ZG_W + (c0 - 384)) = u32x4{cvtpk(a[0], a[1]), cvtpk(a[2], a[3]), cvtpk(b[0], b[1]), cvtpk(b[2], b[3])};
          } else {
#pragma unroll
            for (int j = 0; j < 4; ++j) { zt[(size_t)(c0 - 1536 + j) * TT + row] = f2bf(a[j]); zt[(size_t)(c0 - 1536 + 4 + j) * TT + row] = f2bf(b[j]); }
          }
        }
    }
  }
};
__device__ __forceinline__ void phase_gemm_in(const Params& p, int layer, int bid, int nb, char* lds) {
  G8Plain S; S.nM = TT / 256; S.nN = NIN / 256; S.Kb = DM; S.G = nb; S.c = bid; S.Bt = (const char*)(p.bt_in() + (size_t)layer * NIN * DM);
  EpiIn E; E.zqkv = p.zqkv(); E.zg = p.zg(); E.zt = p.zt(); E.hs = p.hs(); E.sw = p.swin() + layer * NIN;
  gemm8_phase<true>(lds, (const char*)p.H(), DM, S, E);
}

__device__ __forceinline__ size_t qkv_row(int tok, int h) {
  const int b = tok < TL ? (tok >> 14) : ((tok - TL) >> 8);
  const int s = tok < TL ? (tok & (SEQ - 1)) : SEQ + ((tok - TL) & (LC - 1));
  return ((size_t)(b * 4 + h)) * SKV + s;
}
struct EpiQkv {
  const u16* zqkv; u16* Q; u16* KV; const float* ropec; const float* ropes; float* rsl;
  unsigned* kmx;
  __device__ __forceinline__ void pre(const G8Unit&, int, int, float (&)[8], float*) const {}
  __device__ __forceinline__ void operator()(const f32x4 (&acc)[2][2][4][2], const G8Unit& u, int wr, int wc, int fr, int fq, const float (&)[8], const float*) const {
    const int tid = ltid();
    {
      const int r = tid >> 1, half = tid & 1;
      const u16* row = zqkv + (size_t)(u.pm * 256 + r) * 384;
      float sq = 0, sk = 0;
#pragma unroll
      for (int i = 0; i < 16; ++i) {
        const u32x4 w = *(const u32x4*)(row + half * 128 + i * 8);
#pragma unroll
        for (int q = 0; q < 4; ++q) { const float a = __uint_as_float(w[q] << 16), b = __uint_as_float(w[q] & 0xFFFF0000u); sq += a * a + b * b; }
      }
#pragma unroll
      for (int i = 0; i < 8; ++i) {
        const u32x4 w = *(const u32x4*)(row + 256 + half * 64 + i * 8);
#pragma unroll
        for (int q = 0; q < 4; ++q) { const float a = __uint_as_float(w[q] << 16), b = __uint_as_float(w[q] & 0xFFFF0000u); sk += a * a + b * b; }
      }
      sq += __shfl_xor(sq, 1, 64); sk += __shfl_xor(sk, 1, 64);
      if (half == 0) { rsl[r] = rsqrtf(sq * (1.f / 256.f) + EPS); rsl[256 + r] = rsqrtf(sk * (1.f / 128.f) + EPS); }
    }
    asm volatile("s_waitcnt lgkmcnt(0)" ::: "memory"); __builtin_amdgcn_s_barrier(); __builtin_amdgcn_s_barrier(); asm volatile("" ::: "memory");
    const float* rsp = rsl + (u.pn >= 2 ? 256 : 0);
#pragma unroll
    for (int ai = 0; ai < 2; ++ai)
#pragma unroll
      for (int m = 0; m < 4; ++m) {
        const int rl = ai * 128 + wr * 64 + m * 16 + fr, tok = u.pm * 256 + rl;
        const float rs = rsp[rl] * (u.pn < 2 ? A_QSCALE : 1.f);
        if (u.pn == 1) {
          f32x4 a = acc[ai][0][m][0] * rs, b = acc[ai][0][m][1] * rs;
          f32x4 pa, pb;
#pragma unroll
          for (int j = 0; j < 4; ++j) { pa[j] = __shfl_xor(a[j], 32, 64); pb[j] = __shfl_xor(b[j], 32, 64); }
          f32x4 ca = {1.f, 1.f, 1.f, 1.f}, cb = ca, sa = {0.f, 0.f, 0.f, 0.f}, sb = sa;
          if (tok < TL) {
            const float* cp = ropec + (size_t)(tok & (SEQ - 1)) * 16 + 8 * (fq & 1); const float* sp = ropes + (size_t)(tok & (SEQ - 1)) * 16 + 8 * (fq & 1);
            ca = *(const f32x4*)cp; cb = *(const f32x4*)(cp + 4); sa = *(const f32x4*)sp; sb = *(const f32x4*)(sp + 4);
          }
          const float sg = fq < 2 ? -1.f : 1.f;
          a = a * ca + pa * sa * sg; b = b * cb + pb * sb * sg;
          *(u32x4*)(Q + qkv_row(tok, wc) * 96 + 64 + 8 * fq) = u32x4{cvtpk(a[0], a[1]), cvtpk(a[2], a[3]), cvtpk(b[0], b[1]), cvtpk(b[2], b[3])};
        } else {
#pragma unroll
          for (int bj = 0; bj < 2; ++bj) {
            const int c = bj * 128 + wc * 32 + 8 * fq, h = c >> 6, d = c & 63;
            const f32x4 a = acc[ai][bj][m][0] * rs, b = acc[ai][bj][m][1] * rs;
            u16* dst = u.pn == 0 ? Q + qkv_row(tok, h) * 96 + d : KV + qkv_row(tok, h) * 160 + (u.pn == 2 ? 0 : 96) + d;
            *(u32x4*)dst = u32x4{cvtpk(a[0], a[1]), cvtpk(a[2], a[3]), cvtpk(b[0], b[1]), cvtpk(b[2], b[3])};
          }
        }
      }
    if (u.pn == 2) {
      const int b = u.pm * 256 < TL ? (u.pm * 256) >> 14 : (u.pm * 256 - TL) >> 8;
#pragma unroll
      for (int bj = 0; bj < 2; ++bj) {
        float mx = 0.f;
#pragma unroll
        for (int ai = 0; ai < 2; ++ai)
#pragma unroll
          for (int m = 0; m < 4; ++m) {
            const float rs = rsp[ai * 128 + wr * 64 + m * 16 + fr];
            const f32x4 a = acc[ai][bj][m][0] * rs, b4 = acc[ai][bj][m][1] * rs;
            float ss = a[0] * a[0] + a[1] * a[1] + a[2] * a[2] + a[3] * a[3] + b4[0] * b4[0] + b4[1] * b4[1] + b4[2] * b4[2] + b4[3] * b4[3];
            ss += __shfl_xor(ss, 16, 64); ss += __shfl_xor(ss, 32, 64);
            mx = fmaxf(mx, ss);
          }
#pragma unroll
        for (int o = 8; o > 0; o >>= 1) mx = fmaxf(mx, __shfl_xor(mx, o, 64));
        if ((ltid() & 63) == 0) atomicMax(kmx + (b * 4 + bj * 2 + (wc >> 1)) * 4 + (wc & 1), __float_as_uint(mx));
      }
    }
  }
};
__device__ __forceinline__ void phase_qkv(const Params& p, int layer, int bid, int nb, char* lds) {
  const int tid = ltid();
  {
    G8Plain S; S.nM = TT / 256; S.nN = 4; S.Kb = 768; S.G = nb; S.c = bid; S.Bt = (const char*)(p.bt_qkv() + (size_t)layer * 1024 * 384);
    EpiQkv E; E.zqkv = p.zqkv(); E.Q = p.Q(); E.KV = p.KV(); E.ropec = p.ropec(); E.ropes = p.ropes(); E.rsl = (float*)(lds + 131072); E.kmx = p.kmx() + layer * 32;
    gemm8_phase<false>(lds, (const char*)p.zqkv(), 768, S, E);
  }
  float krm0 = 0.f, krm1 = 0.f;
  for (int i = bid * NTHR + tid; i < TT * 16; i += nb * NTHR) {
    const int tok = i >> 4, f = i & 15;
    const float x1 = bf2f(p.zg()[(size_t)tok * ZG_W + ZG_KR + f]), x2 = bf2f(p.zg()[(size_t)tok * ZG_W + ZG_KR + 16 + f]);
    float cs = 1.f, sn = 0.f;
    if (tok < TL) { const int tpos = tok & (SEQ - 1); cs = p.ropec()[tpos * 16 + f]; sn = p.ropes()[tpos * 16 + f]; }
    const float y1 = x1 * cs - x2 * sn, y2 = x2 * cs + x1 * sn;
    const u16 o1 = f2bf(y1), o2 = f2bf(y2);
#pragma unroll
    for (int h = 0; h < 4; ++h) { u16* kv = p.KV() + qkv_row(tok, h) * 160 + 64; kv[f] = o1; kv[16 + f] = o2; }
    float ss = y1 * y1 + y2 * y2;
#pragma unroll
    for (int o = 8; o > 0; o >>= 1) ss += __shfl_xor(ss, o, 64);
    const int b = tok < TL ? (tok >> 14) : ((tok - TL) >> 8);
    if (b == 0) krm0 = fmaxf(krm0, ss); else krm1 = fmaxf(krm1, ss);
  }
#pragma unroll
  for (int o = 32; o > 0; o >>= 1) { krm0 = fmaxf(krm0, __shfl_xor(krm0, o, 64)); krm1 = fmaxf(krm1, __shfl_xor(krm1, o, 64)); }
  if ((tid & 63) == 0) { atomicMax(p.kmx() + layer * 32 + 0 * 16 + 2, __float_as_uint(krm0)); atomicMax(p.kmx() + layer * 32 + 1 * 16 + 2, __float_as_uint(krm1)); }
}

constexpr int A_KROW = 208;
constexpr int A_TV = 128 * 64 * 2;
constexpr int A_TK = 128 * A_KROW;
constexpr int A_BUF = A_TV + A_TK;
constexpr int A_OFF_W = 3 * A_BUF;
constexpr int ATTN_LDS = A_OFF_W + 8 * 64 * 4;
#define SBAR() __builtin_amdgcn_sched_barrier(0)
__device__ __forceinline__ int crow(int r, int hi) { return (r & 3) + 8 * (r >> 2) + 4 * hi; }

__device__ __forceinline__ void a_partialSM(f32x16& p0) {
#pragma unroll
  for (int r = 0; r < 16; ++r) p0[r] = __builtin_amdgcn_exp2f(p0[r]);
}
__device__ __forceinline__ void a_finishSM(f32x16& p0, f32x16& p1, bf16x8& pa0, bf16x8& pa1, bf16x8& pa2, bf16x8& pa3) {
#pragma unroll
  for (int r = 0; r < 16; ++r) p1[r] = __builtin_amdgcn_exp2f(p1[r]);
#define PK4(P, BASE, OUT) do { unsigned a0 = cvtpk(P[BASE + 0], P[BASE + 1]), a1 = cvtpk(P[BASE + 2], P[BASE + 3]);   \
    unsigned b0 = cvtpk(P[BASE + 4], P[BASE + 5]), b1 = cvtpk(P[BASE + 6], P[BASE + 7]);                              \
    auto r0 = __builtin_amdgcn_permlane32_swap(a0, b0, false, false); auto r1 = __builtin_amdgcn_permlane32_swap(a1, b1, false, false); \
    u32x4 w = {r0[0], r1[0], r0[1], r1[1]}; OUT = *reinterpret_cast<bf16x8*>(&w); } while (0)
  PK4(p0, 0, pa0); PK4(p0, 8, pa1); PK4(p1, 0, pa2); PK4(p1, 8, pa3);
#undef PK4
}
__device__ __forceinline__ void a_qkt(f32x16& p0, f32x16& p1, const char* Ks, const bf16x8* qr, const float mneg, int r32, int hi) {
#pragma unroll
  for (int r = 0; r < 16; ++r) { p0[r] = mneg; p1[r] = mneg; }
#pragma unroll
  for (int d0 = 0; d0 < 6; ++d0) {
    const int cb = (d0 * 16 + hi * 8) * 2;
    const bf16x8 b0 = *reinterpret_cast<const bf16x8*>(Ks + r32 * A_KROW + cb);
    const bf16x8 b1 = *reinterpret_cast<const bf16x8*>(Ks + (32 + r32) * A_KROW + cb);
    p0 = __builtin_amdgcn_mfma_f32_32x32x16_bf16(b0, qr[d0], p0, 0, 0, 0); p1 = __builtin_amdgcn_mfma_f32_32x32x16_bf16(b1, qr[d0], p1, 0, 0, 0);
  }
}
__device__ __forceinline__ int a_v_st(int k, int c) { const int kk = (k & ~0xC) | ((k & 4) << 1) | ((k & 8) >> 1); return ((kk >> 3) * 2 + (c >> 5)) * 512 + ((kk & 7) * 32 + (c & 31)) * 2; }
__device__ __forceinline__ int a_v_rd_base(int lane) { return ((lane & 3) << 3) | (((lane >> 2) & 3) << 6) | (((lane >> 4) & 1) << 5) | (((lane >> 5) & 1) << 8); }
constexpr int a_v_rd_off(int d0, int ks, int half) { return d0 * 512 + ks * 2048 + half * 1024; }
template <int OFF> __device__ __forceinline__ s16x4 a_tr_read(int vb) {
  s16x4 r; asm volatile("ds_read_b64_tr_b16 %0, %1 offset:%2" : "=&v"(r) : "v"(vb), "i"(OFF) : "memory"); return r;
}
template <int D0> __device__ __forceinline__ void a_pv_one(f32x16& od, int vb, bf16x8 pa0, bf16x8 pa1, bf16x8 pa2, bf16x8 pa3) {
  const s16x4 l0 = a_tr_read<a_v_rd_off(D0, 0, 0)>(vb), h0 = a_tr_read<a_v_rd_off(D0, 0, 1)>(vb), l1 = a_tr_read<a_v_rd_off(D0, 1, 0)>(vb), h1 = a_tr_read<a_v_rd_off(D0, 1, 1)>(vb);
  const s16x4 l2 = a_tr_read<a_v_rd_off(D0, 2, 0)>(vb), h2 = a_tr_read<a_v_rd_off(D0, 2, 1)>(vb), l3 = a_tr_read<a_v_rd_off(D0, 3, 0)>(vb), h3 = a_tr_read<a_v_rd_off(D0, 3, 1)>(vb);
  asm volatile("s_waitcnt lgkmcnt(0)" ::: "memory"); SBAR();
#define PK(L, H) (bf16x8){L[0], L[1], L[2], L[3], H[0], H[1], H[2], H[3]}
  od = __builtin_amdgcn_mfma_f32_32x32x16_bf16(pa0, PK(l0, h0), od, 0, 0, 0);
  od = __builtin_amdgcn_mfma_f32_32x32x16_bf16(pa1, PK(l1, h1), od, 0, 0, 0);
  od = __builtin_amdgcn_mfma_f32_32x32x16_bf16(pa2, PK(l2, h2), od, 0, 0, 0);
  od = __builtin_amdgcn_mfma_f32_32x32x16_bf16(pa3, PK(l3, h3), od, 0, 0, 0);
#undef PK
}
__device__ __forceinline__ void a_pv(f32x16* o, int vb, bf16x8 pa0, bf16x8 pa1, bf16x8 pa2, bf16x8 pa3) {
  a_pv_one<0>(o[0], vb, pa0, pa1, pa2, pa3);
  { const bf16x8 ones = {0x3F80, 0x3F80, 0x3F80, 0x3F80, 0x3F80, 0x3F80, 0x3F80, 0x3F80};
    o[2] = __builtin_amdgcn_mfma_f32_32x32x16_bf16(pa0, ones, o[2], 0, 0, 0); o[2] = __builtin_amdgcn_mfma_f32_32x32x16_bf16(pa1, ones, o[2], 0, 0, 0);
    o[2] = __builtin_amdgcn_mfma_f32_32x32x16_bf16(pa2, ones, o[2], 0, 0, 0); o[2] = __builtin_amdgcn_mfma_f32_32x32x16_bf16(pa3, ones, o[2], 0, 0, 0); }
  a_pv_one<1>(o[1], vb, pa0, pa1, pa2, pa3);
}

__device__ __forceinline__ void attn_item(const u16* __restrict__ Qb, const u16* __restrict__ KVh, int seq, float kmax, u16* __restrict__ yout  , char* lds) {
  const int tid = ltid(), wid = tid >> 6, lane = tid & 63, r32 = lane & 31, hi = lane >> 5;
  f32x16 o[3] = {}; bf16x8 qr[6];
  const u16* Qw = Qb + (size_t)(wid * 32 + r32) * 96 + hi * 8;
#pragma unroll
  for (int d0 = 0; d0 < 6; ++d0) qr[d0] = *reinterpret_cast<const bf16x8*>(Qw + d0 * 16);
  float mneg;
  {
    float ss = 0.f;
#pragma unroll
    for (int d0 = 0; d0 < 6; ++d0)
#pragma unroll
      for (int j = 0; j < 8; ++j) { const float v = bf2f((u16)qr[d0][j]); ss += v * v; }
    ss += __shfl_xor(ss, 32, 64);
    mneg = -sqrtf(ss) * kmax;
  }
  int lw[5];
#pragma unroll
  for (int i = 0; i < 5; ++i) {
    const int g = tid + i * 512, key = g / 20, cc = g % 20;
    lw[i] = cc < 12 ? (A_TV + key * A_KROW + cc * 16) : ((key >> 6) * 8192 + a_v_st(key & 63, (cc - 12) * 8));
  }
  const int vrb = (int)(uintptr_t)lds + a_v_rd_base(lane);
  bf16x8 sg[5];
  const char* gsrc = (const char*)KVh + tid * 16;
#define SLOAD(t) do { const char* s_ = gsrc + (size_t)(t) * 40960; _Pragma("unroll") for (int i = 0; i < 5; ++i) sg[i] = *(const bf16x8*)(s_ + i * 8192); } while (0)
#define SWRITE(bo_) do { _Pragma("unroll") for (int i = 0; i < 5; ++i) *(bf16x8*)(lds + (bo_) + lw[i]) = sg[i]; } while (0)
  f32x16 pA0, pA1, pB0, pB1; bf16x8 pa0, pa1, pa2, pa3; const int NT = seq / 128;
  SLOAD(0); SWRITE(0); if (1 < NT) SLOAD(1);
  __syncthreads();
  int bo = 0;
  {
    if (1 < NT) { SWRITE(A_BUF); if (2 < NT) SLOAD(2); }
    SBAR(); a_qkt(pA0, pA1, lds + bo + A_TV, qr, mneg, r32, hi); a_partialSM(pA0);
    SBAR(); a_qkt(pB0, pB1, lds + bo + A_TV + 64 * A_KROW, qr, mneg, r32, hi);
    a_finishSM(pA0, pA1, pa0, pa1, pa2, pa3); SBAR();
    a_pv(o, vrb + bo, pa0, pa1, pa2, pa3); a_partialSM(pB0);
    __syncthreads();
  }
  for (int t = 1; t < NT; ++t) {
    const int bp = bo;
    bo = bo + A_BUF; if (bo == 3 * A_BUF) bo = 0;
    int bn = bo + A_BUF; if (bn == 3 * A_BUF) bn = 0;
    if (t + 1 < NT) { SWRITE(bn); if (t + 2 < NT) SLOAD(t + 2); }
    SBAR(); a_qkt(pA0, pA1, lds + bo + A_TV, qr, mneg, r32, hi);
    a_finishSM(pB0, pB1, pa0, pa1, pa2, pa3); SBAR();
    a_pv(o, vrb + bp + 8192, pa0, pa1, pa2, pa3); a_partialSM(pA0);
    SBAR(); a_qkt(pB0, pB1, lds + bo + A_TV + 64 * A_KROW, qr, mneg, r32, hi);
    a_finishSM(pA0, pA1, pa0, pa1, pa2, pa3); SBAR();
    a_pv(o, vrb + bo, pa0, pa1, pa2, pa3); a_partialSM(pB0);
    __syncthreads();
  }
  a_finishSM(pB0, pB1, pa0, pa1, pa2, pa3); SBAR();
  a_pv(o, vrb + bo + 8192, pa0, pa1, pa2, pa3);
#pragma unroll
  for (int r = 0; r < 16; ++r) {
    const int orow = crow(r, hi);
    const float rl = __builtin_amdgcn_rcpf(o[2][r]);
    const float v0 = o[0][r] * rl, v1 = o[1][r] * rl;
    float ss = v0 * v0 + v1 * v1;
#pragma unroll
    for (int off = 16; off > 0; off >>= 1) ss += __shfl_xor(ss, off, 64);
    const float rs = rsqrtf(ss * (1.f / 64.f) + EPS);
    u16* dst = yout + (size_t)(wid * 32 + orow) * DM;
    dst[r32] = f2bf(v0 * rs); dst[32 + r32] = f2bf(v1 * rs);
  }
  __syncthreads();
#undef SLOAD
#undef SWRITE
}

__device__ __forceinline__ void phase_attn(const Params& p, int layer, int bid, int nb, char* lds) {
  const int nitems = 512 + (layer == 0 ? 8 : 0);
  const unsigned* kmx = p.kmx() + layer * 32;
  for (int it = bid; it < nitems; it += nb) {
    int b, h, q0, k0, seq, tok0;
    if (it < 512) { const int pair = it & 7, qb = (it >> 3); h = pair & 3; b = pair >> 2; q0 = qb * 256; k0 = 0; seq = SKV; tok0 = b * SEQ + qb * 256; }
    else { const int i2 = it - 512; h = i2 & 3; b = i2 >> 2; q0 = SEQ; k0 = SEQ; seq = LC; tok0 = TL + b * LC; }
    const size_t base = (size_t)(b * 4 + h) * SKV;
    const float k2 = __uint_as_float(kmx[(b * 4 + h) * 4 + 0]) + __uint_as_float(kmx[(b * 4 + h) * 4 + 1]) + __uint_as_float(kmx[b * 16 + 2]);
    attn_item(p.Q() + (base + q0) * 96, p.KV() + (base + k0) * 160, seq, sqrtf(k2) * 1.02f, p.ymix() + (size_t)tok0 * DM + h * 64, lds);
  }
}

__device__ __forceinline__ float hy_sconv(const u16* __restrict__ row, int t, int Ls, float w0, float w1, float w2, float bb) {
  const float zm = t > 0 ? bf2f(row[t - 1]) : 0.f, z0 = bf2f(row[t]), zp = t + 1 < Ls ? bf2f(row[t + 1]) : 0.f;
  return w0 * zm + w1 * z0 + w2 * zp + bb;
}
__device__ __forceinline__ float2 hy_sconv2(unsigned prv, unsigned cur, unsigned nxt, float w0, float w1, float w2, float bb) {
  const float zm = __uint_as_float(prv & 0xFFFF0000u), z0 = __uint_as_float(cur << 16), z1 = __uint_as_float(cur & 0xFFFF0000u), z2 = __uint_as_float(nxt << 16);
  return make_float2(w0 * zm + w1 * z0 + w2 * z1 + bb, w0 * z0 + w1 * z1 + w2 * z2 + bb);
}
__device__ __forceinline__ void hyena_item(const Params& p, int layer, int b, int ch, char* lds) {
  float2* s = (float2*)lds;
  const int tid = ltid();
  const float* cw = p.hy_conv_w() + (size_t)layer * 3 * 768; const float* cb = p.hy_conv_b() + (size_t)layer * 768;
  const unsigned* r0 = (const unsigned*)(p.zt() + (size_t)(ZT_HY + ch) * TT + (size_t)b * SEQ);
  const unsigned* r1 = (const unsigned*)(p.zt() + (size_t)(ZT_HY + 256 + ch) * TT + (size_t)b * SEQ);
  const unsigned* r2 = (const unsigned*)(p.zt() + (size_t)(ZT_HY + 512 + ch) * TT + (size_t)b * SEQ);
  const float a0 = cw[ch], a1 = cw[768 + ch], a2 = cw[1536 + ch], ab = cb[ch];
  const float b0 = cw[256 + ch], b1 = cw[768 + 256 + ch], b2 = cw[1536 + 256 + ch], bb = cb[256 + ch];
  const float c0 = cw[512 + ch], c1 = cw[768 + 512 + ch], c2 = cw[1536 + 512 + ch], cbb = cb[512 + ch];
  unsigned vgr[16], x0r[16];
#pragma unroll
  for (int hb2 = 0; hb2 < 2; ++hb2) {
    unsigned ld[8][9];
#pragma unroll
    for (int ii = 0; ii < 8; ++ii) {
      const int m = tid + 512 * (hb2 * 8 + ii);
      const int mp = m > 0 ? m - 1 : 0, mn = m + 1 < SEQ / 2 ? m + 1 : m;
      ld[ii][0] = r0[mp]; ld[ii][1] = r0[m]; ld[ii][2] = r0[mn];
      ld[ii][3] = r1[mp]; ld[ii][4] = r1[m]; ld[ii][5] = r1[mn];
      ld[ii][6] = r2[mp]; ld[ii][7] = r2[m]; ld[ii][8] = r2[mn];
    }
#pragma unroll
    for (int ii = 0; ii < 8; ++ii) {
      const int i = hb2 * 8 + ii, m = tid + 512 * i;
      const unsigned mkp = m > 0 ? 0xFFFFFFFFu : 0u, mkn = m + 1 < SEQ / 2 ? 0xFFFFFFFFu : 0u;
      const float2 ux = hy_sconv2(ld[ii][0] & mkp, ld[ii][1], ld[ii][2] & mkn, a0, a1, a2, ab);
      x0r[i] = cvtpk(ux.x, ux.y);
      const float2 u1 = hy_sconv2(ld[ii][3] & mkp, ld[ii][4], ld[ii][5] & mkn, b0, b1, b2, bb);
      const float2 uv = hy_sconv2(ld[ii][6] & mkp, ld[ii][7], ld[ii][8] & mkn, c0, c1, c2, cbb);
      const float2 vgf = make_float2(uv.x * u1.x, uv.y * u1.y);
      vgr[i] = cvtpk(vgf.x, vgf.y);
      s[swz(m)] = vgf;
      s[swz(m + SEQ / 2)] = make_float2(0.f, 0.f);
    }
  }
  __syncthreads();
  fft_fwd(s, p.tw());
  {
    const float4* hs = p.hspec() + ((size_t)layer * 256 + ch) * HSP;
    float4 hv[17];
#pragma unroll
    for (int i = 0; i < 17; ++i) { const int k = tid + 512 * i; hv[i] = hs[k <= FM / 2 ? k : 0]; }
    const float2 twl = p.tw()[tid];
#pragma unroll
    for (int i = 0; i < 17; ++i) {
      const int k = tid + 512 * i;
      if (k <= FM / 2) {
        const int pk = swz(rev7(k)), pm = swz(rev7((FM - k) & (FM - 1)));
        const float2 zk = s[pk], zm = s[pm];
        const float4 h = hv[i];
        const float2 He = make_float2(h.x, h.y), Ho = make_float2(h.z, h.w);
        const float2 Xe = make_float2(0.5f * (zk.x + zm.x), 0.5f * (zk.y - zm.y));
        const float2 Xo = make_float2(0.5f * (zk.y + zm.y), -0.5f * (zk.x - zm.x));
        const float2 twk = cmul(twl, p.tw()[512 * i]);
        const float2 t1 = cmul(twk, cmul(Xo, Ho));
        const float2 e1 = cmul(Xe, He);
        const float2 Ye = make_float2(e1.x + t1.x, e1.y + t1.y);
        const float2 o1 = cmul(Xe, Ho), o2 = cmul(Xo, He);
        const float2 Yo = make_float2(o1.x + o2.x, o1.y + o2.y);
        s[pk] = make_float2(Ye.x - Yo.y, Ye.y + Yo.x);
        if (pm != pk) s[pm] = make_float2(Ye.x + Yo.y, -Ye.y + Yo.x);
      }
    }
  }
  __syncthreads();
  fft_inv(s, p.tw());
  const float hb = p.hy_bias()[layer * 256 + ch];
  unsigned* orow = (unsigned*)(p.hyo() + (size_t)ch * TT + (size_t)b * SEQ);
#pragma unroll
  for (int i = 0; i < 16; ++i) {
    const int m = tid + 512 * i;
    const float2 y = s[swz(m)];
    orow[m] = cvtpk((y.x + __uint_as_float(vgr[i] << 16) * hb) * __uint_as_float(x0r[i] << 16), (y.y + __uint_as_float(vgr[i] & 0xFFFF0000u) * hb) * __uint_as_float(x0r[i] & 0xFFFF0000u));
  }
  __syncthreads();
}
__device__ __forceinline__ void fnet_item(const Params& p, int b, int j, char* lds) {
  float2* s = (float2*)lds;
  const int tid = ltid();
  const u16* rr = p.zt() + (size_t)(ZT_FR + j) * TT + (size_t)b * SEQ;
  const u16* ri = p.zt() + (size_t)(ZT_FI + j) * TT + (size_t)b * SEQ;
  {
    u32x4 vr[4], vi[4];
#pragma unroll
    for (int i = 0; i < 4; ++i) { const int m0 = (tid + 512 * i) * 8; vr[i] = *(const u32x4*)(rr + m0); vi[i] = *(const u32x4*)(ri + m0); }
#pragma unroll
    for (int i = 0; i < 4; ++i) {
      const int m0 = (tid + 512 * i) * 8;
#pragma unroll
      for (int q = 0; q < 4; ++q) {
        s[swz(m0 + 2 * q)] = make_float2(__uint_as_float(vr[i][q] << 16), __uint_as_float(vi[i][q] << 16));
        s[swz(m0 + 2 * q + 1)] = make_float2(__uint_as_float(vr[i][q] & 0xFFFF0000u), __uint_as_float(vi[i][q] & 0xFFFF0000u));
      }
    }
  }
  __syncthreads();
  fft_fwd(s, p.tw());
#ifdef PROBE_FFT
  fft_inv(s, p.tw());
  for (int m = tid; m < FM; m += NTHR) { float2 v = s[m]; v.x *= (1.f / 16384.f); v.y *= (1.f / 16384.f); s[m] = v; }
  __syncthreads();
  fft_fwd(s, p.tw());
#endif
  u16* orow = p.fno() + (size_t)j * TT + (size_t)b * SEQ;
#pragma unroll 8
  for (int k = tid; k < FM; k += NTHR) orow[k] = f2bf(s[swz(rev7(k))].x * (1.f / 128.f));
  __syncthreads();
}
__device__ __forceinline__ void hyena_ctx_item(const Params& p, int b, int ch, char* lds) {
  float* vg = (float*)lds;
  float* x0 = vg + 256;
  float* hf = x0 + 256;
  float* hbk = hf + 256;
  const int tid = ltid();
  const float* cw = p.hy_conv_w(); const float* cb = p.hy_conv_b();
  const size_t off = (size_t)TL + (size_t)b * LC;
  const u16* r0 = p.zt() + (size_t)(ZT_HY + ch) * TT + off;
  const u16* r1 = p.zt() + (size_t)(ZT_HY + 256 + ch) * TT + off;
  const u16* r2 = p.zt() + (size_t)(ZT_HY + 512 + ch) * TT + off;
  if (tid < 256) {
    const int t = tid;
    vg[t] = hy_sconv(r2, t, LC, cw[512 + ch], cw[768 + 512 + ch], cw[1536 + 512 + ch], cb[512 + ch]) *
            hy_sconv(r1, t, LC, cw[256 + ch], cw[768 + 256 + ch], cw[1536 + 256 + ch], cb[256 + ch]);
    x0[t] = hy_sconv(r0, t, LC, cw[ch], cw[768 + ch], cw[1536 + ch], cb[ch]);
    hf[t] = p.hfc()[(size_t)ch * LC + t]; hbk[t] = p.hfc()[(size_t)(256 + ch) * LC + t];
  }
  const float ssq_c = filt_ssq(p.hpart() + (size_t)2 * 256 * 512, ch, (float*)(lds + 8192));
  if (tid < 256) {
    const int t = tid; float y = 0;
    for (int q = 0; q <= t; ++q) y += hf[t - q] * vg[q];
    for (int q = t + 1; q < LC; ++q) y += hbk[q - t] * vg[q];
    y *= rsqrtf(ssq_c);
    p.hyo()[(size_t)ch * TT + off + t] = f2bf((y + vg[t] * p.hy_bias()[ch]) * x0[t]);
  }
  __syncthreads();
}
__device__ __forceinline__ void fnet_ctx_item(const Params& p, int b, int j, char* lds) {
  float* ur = (float*)lds; float* ui = ur + 256; float* cst = ui + 256; float* snt = cst + 256;
  const int tid = ltid();
  const size_t off = (size_t)TL + (size_t)b * LC;
  if (tid < 256) {
    ur[tid] = bf2f(p.zt()[(size_t)(ZT_FR + j) * TT + off + tid]); ui[tid] = bf2f(p.zt()[(size_t)(ZT_FI + j) * TT + off + tid]);
    float sn, cs; sincospif((float)tid / 128.f, &sn, &cs); cst[tid] = cs; snt[tid] = sn;
  }
  __syncthreads();
  if (tid < 256) {
    const int k = tid; float y = 0;
    for (int l = 0; l < 256; ++l) { const int m = (l * k) & 255; y += cst[m] * ur[l] + snt[m] * ui[l]; }
    p.fno()[(size_t)j * TT + off + k] = f2bf(y * 0.0625f);
  }
  __syncthreads();
}
__device__ __forceinline__ void phase_fftmix(const Params& p, int layer, int bid, int nb, char* lds) {
  const int nitems = layer == 0 ? 2048 : 1024;
  for (int it = bid; it < nitems; it += nb) {
    const int k = it & 511, b = k >> 8, c = k & 255;
    if (it < 512) hyena_item(p, layer, b, c, lds);
    else if (it < 1024) fnet_item(p, b, c, lds);
    else if (it < 1536) hyena_ctx_item(p, b, c, lds);
    else fnet_ctx_item(p, b, c, lds);
  }
}
constexpr int GLG = 17, NGRP = 16;
__device__ __forceinline__ int gla_chain_tok(int dir, int b, int n, int i) {
  const int base = n < 4 ? TL + b * LC : b * SEQ, len = n < 4 ? LC : SEQ, m = n < 4 ? n : n - 4;
  return dir == 0 ? base + 64 * m + i : base + (len - 1) - (64 * m + i);
}
__device__ __forceinline__ float logsig16(float x) { return (fminf(x, 0.f) - __logf(1.f + __expf(-fabsf(x)))) * (1.f / 16.f); }
__device__ __forceinline__ float wave_scan_incl(float v, int lane) {
#pragma unroll
  for (int o = 1; o < 64; o <<= 1) { const float t = __shfl_up(v, o, 64); if (lane >= o) v += t; }
  return v;
}
__device__ __forceinline__ void phase_gla_a(const Params& p, int layer, int bid, int nb, char* lds) {
  const int tid = ltid(), wid = tid >> 6, lane = tid & 63, r32 = lane & 31, hi = lane >> 5;
  const float* gb = p.gla_gk_b() + (size_t)layer * 256;
  char* wimg = lds + wid * 12288;
  for (int it = bid; it < 16 * NGRP; it += nb) {
    const int chain = it >> 4, g = it & 15, dir = chain >> 3, b = (chain >> 2) & 1, h = chain & 3;
    const int n0 = g * GLG, n1 = min(n0 + GLG, NCH), nch = n1 - n0;
    char* WT = lds + wid * 13824; char* VT = WT + 4608;
    float* dvl = (float*)(lds + 8 * 13824);
#pragma unroll
    for (int c = 0; c < 3; ++c) {
      const int cl = wid + 8 * c;
      if (cl < nch) {
        const int n = n0 + cl;
        {
          const u16* vbase = p.zg() + ZG_GV + h * 64 + lane;
          u16 vv[64];
#pragma unroll
          for (int i = 0; i < 64; ++i) vv[i] = vbase[(size_t)gla_chain_tok(dir, b, n, i) * ZG_W];
#pragma unroll
          for (int q = 0; q < 8; ++q)
            *(u32x4*)(VT + lane * 144 + q * 16) = u32x4{(unsigned)vv[8 * q] | ((unsigned)vv[8 * q + 1] << 16), (unsigned)vv[8 * q + 2] | ((unsigned)vv[8 * q + 3] << 16),
                                                       (unsigned)vv[8 * q + 4] | ((unsigned)vv[8 * q + 5] << 16), (unsigned)vv[8 * q + 6] | ((unsigned)vv[8 * q + 7] << 16)};
        }
        {
          const int kk = lane & 31, hs = lane >> 5;
          const u16* kb = p.zg() + ZG_GK + h * 32 + kk; const u16* gbp = p.zg() + ZG_GP + dir * 128 + h * 32 + kk;
          const float bias = gb[dir * 128 + h * 32 + kk];
          float bc[32], kf[32];
#pragma unroll
          for (int i = 0; i < 32; ++i) {
            const size_t ro = (size_t)gla_chain_tok(dir, b, n, hs * 32 + i) * ZG_W;
            kf[i] = bf2f(kb[ro]); bc[i] = bf2f(gbp[ro]);
          }
          float run = 0.f;
#pragma unroll
          for (int i = 0; i < 32; ++i) { const float x = bc[i] + bias; run += (fminf(x, 0.f) - __logf(1.f + __expf(-fabsf(x)))) * (1.f / 16.f); bc[i] = run; }
          const float lowtot = __shfl(run, kk, 64);
          const float uptot = __shfl(run, 32 + kk, 64);
          const float bl = lowtot + uptot, off = hs ? lowtot : 0.f;
          unsigned wp[16];
#pragma unroll
          for (int i = 0; i < 16; ++i) wp[i] = cvtpk(kf[2 * i] * __expf(bl - (bc[2 * i] + off)), kf[2 * i + 1] * __expf(bl - (bc[2 * i + 1] + off)));
#pragma unroll
          for (int q = 0; q < 4; ++q) *(u32x4*)(WT + kk * 144 + hs * 64 + q * 16) = u32x4{wp[4 * q], wp[4 * q + 1], wp[4 * q + 2], wp[4 * q + 3]};
          if (hs == 0) dvl[cl * 32 + kk] = __expf(bl);
        }
        asm volatile("s_waitcnt lgkmcnt(0)" ::: "memory");
        f32x16 d0 = {}, d1 = {};
#pragma unroll
        for (int s4 = 0; s4 < 4; ++s4) {
          const bf16x8 af = *(const bf16x8*)(WT + r32 * 144 + (16 * s4 + 8 * hi) * 2);
          const bf16x8 v0 = *(const bf16x8*)(VT + r32 * 144 + (16 * s4 + 8 * hi) * 2);
          const bf16x8 v1 = *(const bf16x8*)(VT + (32 + r32) * 144 + (16 * s4 + 8 * hi) * 2);
          d0 = __builtin_amdgcn_mfma_f32_32x32x16_bf16(af, v0, d0, 0, 0, 0);
          d1 = __builtin_amdgcn_mfma_f32_32x32x16_bf16(af, v1, d1, 0, 0, 0);
        }
        asm volatile("s_waitcnt lgkmcnt(0)" ::: "memory");
        {
          float* dg = p.gds() + ((size_t)chain * NCH + n) * 2048;
#pragma unroll
          for (int r = 0; r < 16; ++r) { dg[crow(r, hi) * 64 + r32] = d0[r]; dg[crow(r, hi) * 64 + 32 + r32] = d1[r]; }
        }
      }
      __builtin_amdgcn_sched_barrier(0);
    }
    __syncthreads();
    {
      const int kk = tid >> 4, v0 = (tid & 15) * 4;
      float st[4] = {0.f, 0.f, 0.f, 0.f}; float dcum = 1.f;
      float* gp0 = p.gds() + ((size_t)chain * NCH + n0) * 2048 + kk * 64 + v0;
      float4 av[GLG];
#pragma unroll
      for (int cl = 0; cl < GLG; ++cl) av[cl] = *(const float4*)(gp0 + (size_t)(cl < nch ? cl : 0) * 2048);
#pragma unroll
      for (int cl = 0; cl < GLG; ++cl) {
        if (cl < nch) {
          const float d = dvl[cl * 32 + kk];
          *(float4*)(gp0 + (size_t)cl * 2048) = make_float4(st[0], st[1], st[2], st[3]);
          if ((tid & 15) == 0) p.gdv()[((size_t)chain * NCH + n0 + cl) * 32 + kk] = dcum;
          st[0] = st[0] * d + av[cl].x; st[1] = st[1] * d + av[cl].y; st[2] = st[2] * d + av[cl].z; st[3] = st[3] * d + av[cl].w;
          dcum *= d;
        }
      }
      float* at = p.gst() + ((size_t)chain * NGRP + g) * 2048 + kk * 64 + v0;
      *(float4*)at = make_float4(st[0], st[1], st[2], st[3]);
      if ((tid & 15) == 0) p.gst()[(size_t)16 * NGRP * 2048 + ((size_t)chain * NGRP + g) * 32 + kk] = dcum;
    }
    __syncthreads();
  }
}

constexpr int GC_QP = 33792, GC_KP = GC_QP + 10240, GC_VT = GC_KP + 10240, GC_ST = GC_VT + 18432, GC_AX = GC_ST + 10240;
__device__ __forceinline__ void phase_gla_c(const Params& p, int layer, int bid, int nb, char* lds) {
  float* gl = (float*)lds;
  float* qraw = gl + 2 * 64 * 33;
  float* kraw = qraw + 64 * 33;
  float* Of = (float*)lds;
  char* Qp = lds + GC_QP;
  char* Kp = lds + GC_KP;
  char* VT = lds + GC_VT;
  char* ST = lds + GC_ST;
  const int tid = ltid(), wid = tid >> 6, lane = tid & 63, r32 = lane & 31, hi = lane >> 5;
  char* Ax = lds + GC_AX + wid * 4608;
  const float* gb = p.gla_gk_b() + (size_t)layer * 256;
  const int pc_lo = layer == 0 ? 0 : 4, npc = NCH - pc_lo, nitem = 8 * npc;
  const int per = (nitem + nb - 1) / nb, q_beg = bid * per, q_end = min(nitem, q_beg + per);
  const int sdir = tid >> 8, sk = (tid >> 3) & 31, sv0 = (tid & 7) * 8;
  float G[8]; int g_cached = -1, bh_cached = -1;
  for (int qi = q_beg; qi < q_end; ++qi) {
    const int bh = qi / npc, pc = pc_lo + qi % npc, b = bh >> 2, h = bh & 3;
    const int tok0 = pc < 4 ? TL + b * LC + pc * 64 : b * SEQ + (pc - 4) * 64;
    {
      const int pos = tid >> 3, c4 = (tid & 7) * 4;
      const u16* zr = p.zg() + (size_t)(tok0 + pos) * ZG_W;
      const float4 q4 = ld4bf(zr + ZG_GQ + h * 32 + c4), k4 = ld4bf(zr + ZG_GK + h * 32 + c4);
      const float sc = 0.17677669529663687f;
      qraw[pos * 33 + c4] = q4.x * sc; qraw[pos * 33 + c4 + 1] = q4.y * sc; qraw[pos * 33 + c4 + 2] = q4.z * sc; qraw[pos * 33 + c4 + 3] = q4.w * sc;
      kraw[pos * 33 + c4] = k4.x; kraw[pos * 33 + c4 + 1] = k4.y; kraw[pos * 33 + c4 + 2] = k4.z; kraw[pos * 33 + c4 + 3] = k4.w;
#pragma unroll
      for (int d = 0; d < 2; ++d) {
        const float4 g4 = ld4bf(zr + ZG_GP + d * 128 + h * 32 + c4), bb = *(const float4*)(gb + d * 128 + h * 32 + c4);
        const int i = d ? 63 - pos : pos;
        float* gd = gl + (d * 64 + i) * 33 + c4;
        gd[0] = logsig16(g4.x + bb.x); gd[1] = logsig16(g4.y + bb.y); gd[2] = logsig16(g4.z + bb.z); gd[3] = logsig16(g4.w + bb.w);
      }
      const float4 va = ld4bf(zr + ZG_GV + h * 64 + c4 * 2), vb = ld4bf(zr + ZG_GV + h * 64 + c4 * 2 + 4);
      const float vv[8] = {va.x, va.y, va.z, va.w, vb.x, vb.y, vb.z, vb.w};
#pragma unroll
      for (int j = 0; j < 8; ++j) {
        const u16 hv = f2bf(vv[j]); const int v = c4 * 2 + j;
        *(u16*)(VT + (0 * 64 + v) * 144 + pos * 2) = hv; *(u16*)(VT + (1 * 64 + v) * 144 + (63 - pos) * 2) = hv;
      }
    }
    __syncthreads();
    {
      const int col = tid & 63, d = col >> 5, c = col & 31, part = tid >> 6;
      float* ptot = (float*)(lds + GC_AX);
      float bv[8]; float run = 0.f;
#pragma unroll
      for (int j = 0; j < 8; ++j) { run += gl[(d * 64 + part * 8 + j) * 33 + c]; bv[j] = run; }
      ptot[part * 64 + col] = run;
      __syncthreads();
      float off = 0.f;
#pragma unroll
      for (int q = 0; q < 7; ++q) off += (q < part) ? ptot[q * 64 + col] : 0.f;
#pragma unroll
      for (int j = 0; j < 8; ++j) gl[(d * 64 + part * 8 + j) * 33 + c] = bv[j] + off;
    }
    __syncthreads();
    {
#pragma unroll
      for (int e = 0; e < 2; ++e) {
        const int idx = tid + e * 512, d = idx >> 9, i = (idx >> 3) & 63, c4 = (idx & 7) * 4, pos = d ? 63 - i : i;
        float qo[4], ko[4];
#pragma unroll
        for (int j = 0; j < 4; ++j) {
          const float bi = gl[(d * 64 + i) * 33 + c4 + j], bm = gl[(d * 64 + 31) * 33 + c4 + j];
          qo[j] = qraw[pos * 33 + c4 + j] * __expf(bi - bm); ko[j] = kraw[pos * 33 + c4 + j] * __expf(bm - bi);
        }
        *(u32x2*)(Qp + (d * 64 + i) * 80 + c4 * 2) = u32x2{cvtpk(qo[0], qo[1]), cvtpk(qo[2], qo[3])};
        *(u32x2*)(Kp + (d * 64 + i) * 80 + c4 * 2) = u32x2{cvtpk(ko[0], ko[1]), cvtpk(ko[2], ko[3])};
      }
      const int chain = sdir * 8 + b * 4 + h;
      const int n = sdir == 0 ? pc : (pc < 4 ? 3 - pc : 4 + 255 - (pc - 4)), g = n / GLG;
      if (g != g_cached || bh != bh_cached) {
#pragma unroll
        for (int j = 0; j < 8; ++j) G[j] = 0.f;
        const float* at = p.gst() + (size_t)chain * NGRP * 2048 + sk * 64 + sv0;
        const float* dt = p.gst() + (size_t)16 * NGRP * 2048 + (size_t)chain * NGRP * 32 + sk;
        for (int gg = 0; gg < g; ++gg) {
          const float4 a0 = *(const float4*)(at + (size_t)gg * 2048), a1 = *(const float4*)(at + (size_t)gg * 2048 + 4); const float dd = dt[gg * 32];
          G[0] = G[0] * dd + a0.x; G[1] = G[1] * dd + a0.y; G[2] = G[2] * dd + a0.z; G[3] = G[3] * dd + a0.w;
          G[4] = G[4] * dd + a1.x; G[5] = G[5] * dd + a1.y; G[6] = G[6] * dd + a1.z; G[7] = G[7] * dd + a1.w;
        }
        g_cached = g; bh_cached = bh;
      }
      const float* lp = p.gds() + ((size_t)chain * NCH + n) * 2048 + sk * 64 + sv0;
      const float4 l0 = *(const float4*)lp, l1 = *(const float4*)(lp + 4);
      const float dp = p.gdv()[((size_t)chain * NCH + n) * 32 + sk];
      const float em = __expf(gl[(sdir * 64 + 31) * 33 + sk]);
      const float sv[8] = {l0.x + dp * G[0], l0.y + dp * G[1], l0.z + dp * G[2], l0.w + dp * G[3], l1.x + dp * G[4], l1.y + dp * G[5], l1.z + dp * G[6], l1.w + dp * G[7]};
#pragma unroll
      for (int j = 0; j < 8; ++j) *(u16*)(ST + (sdir * 64 + sv0 + j) * 80 + sk * 2) = f2bf(sv[j] * em);
    }
    __syncthreads();
    {
      const int d = wid >> 2, ib = (wid >> 1) & 1, vb = wid & 1;
      const char* Qd = Qp + d * 64 * 80; const char* Kd = Kp + d * 64 * 80; const char* Vd = VT + d * 64 * 144; const char* Sd = ST + d * 64 * 80;
      bf16x8 qf[2];
#pragma unroll
      for (int s2 = 0; s2 < 2; ++s2) qf[s2] = *(const bf16x8*)(Qd + (ib * 32 + r32) * 80 + (16 * s2 + 8 * hi) * 2);
#pragma unroll
      for (int jb = 0; jb < 2; ++jb) {
        if (jb <= ib) {
          f32x16 x = {};
#pragma unroll
          for (int s2 = 0; s2 < 2; ++s2) {
            const bf16x8 kf = *(const bf16x8*)(Kd + (jb * 32 + r32) * 80 + (16 * s2 + 8 * hi) * 2);
            x = __builtin_amdgcn_mfma_f32_32x32x16_bf16(qf[s2], kf, x, 0, 0, 0);
          }
#pragma unroll
          for (int r = 0; r < 16; ++r) {
            const int il = crow(r, hi), i = ib * 32 + il, j = jb * 32 + r32;
            *(u16*)(Ax + il * 144 + j * 2) = f2bf(j <= i ? x[r] : 0.f);
          }
        }
      }
      asm volatile("s_waitcnt lgkmcnt(0)" ::: "memory");
      f32x16 o = {};
#pragma unroll
      for (int s4 = 0; s4 < 4; ++s4) {
        if (s4 < 2 * (ib + 1)) {
          const bf16x8 af = *(const bf16x8*)(Ax + r32 * 144 + (16 * s4 + 8 * hi) * 2);
          const bf16x8 vf = *(const bf16x8*)(Vd + (vb * 32 + r32) * 144 + (16 * s4 + 8 * hi) * 2);
          o = __builtin_amdgcn_mfma_f32_32x32x16_bf16(af, vf, o, 0, 0, 0);
        }
      }
#pragma unroll
      for (int s2 = 0; s2 < 2; ++s2) {
        const bf16x8 sf = *(const bf16x8*)(Sd + (vb * 32 + r32) * 80 + (16 * s2 + 8 * hi) * 2);
        o = __builtin_amdgcn_mfma_f32_32x32x16_bf16(qf[s2], sf, o, 0, 0, 0);
      }
#pragma unroll
      for (int r = 0; r < 16; ++r) {
        const int i = ib * 32 + crow(r, hi), pos = d ? 63 - i : i;
        Of[(d * 64 + pos) * 65 + vb * 32 + r32] = o[r];
      }
    }
    __syncthreads();
    {
      const int pos = tid >> 3, v0 = (tid & 7) * 8;
      u16* op = p.glao() + (size_t)(tok0 + pos) * 256 + h * 64 + v0;
      float r8[8];
#pragma unroll
      for (int j = 0; j < 8; ++j) r8[j] = Of[pos * 65 + v0 + j] + Of[(64 + pos) * 65 + v0 + j];
      *(u32x4*)op = u32x4{cvtpk(r8[0], r8[1]), cvtpk(r8[2], r8[3]), cvtpk(r8[4], r8[5]), cvtpk(r8[6], r8[7])};
    }
    __syncthreads();
  }
}

__device__ __forceinline__ void phase_mix(const Params& p, int layer, int bid, int nb, char* lds) {
  float* part = (float*)lds;
  u16* tile = (u16*)(lds + 4096);
  const int tid = ltid(), wid = tid >> 6, lane = tid & 63;
  const int ntok = layer == 0 ? TT : TL;
  for (int it = bid; it < ntok / 64; it += nb) {
    const int tok0 = it * 64;
    float vh[32], vf[32]; float sh = 0, sf = 0;
#pragma unroll
    for (int c = 0; c < 32; ++c) {
      vh[c] = bf2f(p.hyo()[(size_t)(wid * 32 + c) * TT + tok0 + lane]); vf[c] = bf2f(p.fno()[(size_t)(wid * 32 + c) * TT + tok0 + lane]);
      sh += vh[c] * vh[c]; sf += vf[c] * vf[c];
    }
    part[(0 * 8 + wid) * 64 + lane] = sh; part[(1 * 8 + wid) * 64 + lane] = sf;
    __syncthreads();
    float th = 0, tf = 0;
#pragma unroll
    for (int q = 0; q < 8; ++q) { th += part[(0 * 8 + q) * 64 + lane]; tf += part[(1 * 8 + q) * 64 + lane]; }
    const float rh = rsqrtf(th * (1.f / 256.f) + EPS), rf = rsqrtf(tf * (1.f / 256.f) + EPS);
#pragma unroll
    for (int c = 0; c < 32; ++c) { tile[lane * 520 + wid * 32 + c] = f2bf(vh[c] * rh); tile[lane * 520 + 256 + wid * 32 + c] = f2bf(vf[c] * rf); }
    __syncthreads();
    for (int g = tid; g < 64 * 64; g += NTHR) {
      const int tl = g >> 6, cg = g & 63;
      const u32x4 w = *(const u32x4*)(tile + tl * 520 + cg * 8);
      *(u32x4*)(p.ymix() + (size_t)(tok0 + tl) * DM + (cg < 32 ? 256 + cg * 8 : 768 + (cg - 32) * 8)) = w;
    }
    for (int tl = wid * 8; tl < wid * 8 + 8; ++tl) {
      const int tok = tok0 + tl;
      const float4 o = ld4bf(p.glao() + (size_t)tok * 256 + lane * 4);
      float ss = o.x * o.x + o.y * o.y + o.z * o.z + o.w * o.w;
#pragma unroll
      for (int off = 8; off > 0; off >>= 1) ss += __shfl_xor(ss, off, 64);
      const float rs = rsqrtf(ss * (1.f / 64.f) + EPS);
      const float4 g = ld4bf(p.zg() + (size_t)tok * ZG_W + ZG_OG + lane * 4);
      u32x2 w; w[0] = cvtpk(o.x * rs * silu_f(g.x), o.y * rs * silu_f(g.y)); w[1] = cvtpk(o.z * rs * silu_f(g.z), o.w * rs * silu_f(g.w));
      *(u32x2*)(p.ymix() + (size_t)tok * DM + 512 + lane * 4) = w;
    }
    __syncthreads();
  }
}

struct EpiOut {
  const Params* pp; int layer;
  __device__ __forceinline__ void pre(const G8Unit& u, int, int, float (&)[8], float* cb) const {
    if ((ltid() >> 6) == 0) g8_cload(pp->mod() + ((size_t)layer * 3 + modv(u.pm * 256)) * 6144 + 2 * DM + u.pn * 256, cb);
  }
  __device__ __forceinline__ void operator()(const f32x4 (&acc)[2][2][4][2], const G8Unit& u, int wr, int wc, int fr, int fq, const float (&)[8], const float* cb) const {
    const Params& p = *pp;
#pragma unroll
    for (int bj = 0; bj < 2; ++bj) {
      const int c0 = u.pn * 256 + bj * 128 + wc * 32 + 8 * fq;
      const f32x4 ga = *(const f32x4*)(cb + bj * 128 + wc * 32 + 8 * fq), gb = *(const f32x4*)(cb + bj * 128 + wc * 32 + 8 * fq + 4);
#pragma unroll
      for (int ai = 0; ai < 2; ++ai)
#pragma unroll
        for (int m = 0; m < 4; ++m) {
          const int tok = u.pm * 256 + ai * 128 + wr * 64 + m * 16 + fr;
          u16* xo = p.X() + (size_t)tok * DM + c0;
          f32x4 xa, xb;
          if (layer == 0) { const float* xr = resid_row_in(p, tok) + c0; xa = *(const f32x4*)xr; xb = *(const f32x4*)(xr + 4); }
          else { const u32x4 w = *(const u32x4*)xo;
            xa = f32x4{__uint_as_float(w[0] << 16), __uint_as_float(w[0] & 0xFFFF0000u), __uint_as_float(w[1] << 16), __uint_as_float(w[1] & 0xFFFF0000u)};
            xb = f32x4{__uint_as_float(w[2] << 16), __uint_as_float(w[2] & 0xFFFF0000u), __uint_as_float(w[3] << 16), __uint_as_float(w[3] & 0xFFFF0000u)}; }
          xa = xa + ga * acc[ai][bj][m][0]; xb = xb + gb * acc[ai][bj][m][1];
          *(u32x4*)xo = u32x4{cvtpk(xa[0], xa[1]), cvtpk(xa[2], xa[3]), cvtpk(xb[0], xb[1]), cvtpk(xb[2], xb[3])};
        }
    }
  }
};
__device__ __forceinline__ void phase_gemm_out(const Params& p, int layer, int bid, int nb, char* lds) {
  G8Plain S; S.nM = (layer == 0 ? TT : TL) / 256; S.nN = DM / 256; S.Kb = 2 * DM; S.G = nb; S.c = bid; S.Bt = (const char*)(p.bt_out() + (size_t)layer * DM * DM);
  EpiOut E; E.pp = &p; E.layer = layer;
  gemm8_phase<false>(lds, (const char*)p.ymix(), 2 * DM, S, E);
}

__device__ __forceinline__ void phase_norm2_router(const Params& p, int layer, int bid, int nb, char* lds) {
  float* rwl = (float*)lds;
  int* lcnt = (int*)(lds + 131072);
  int* lbase = lcnt + 32;
  int* ent = lbase + 32;
  float* entw = (float*)(ent + 2 * 640);
  float* ents = entw + 640;
  const int tid = ltid(), wid = tid >> 6, lane = tid & 63;
  const int ntok = layer == 0 ? TT : TL;
  const float* rw = p.router_w() + (size_t)layer * DM * NE;
  for (int i = tid; i < DM * NE / 4; i += NTHR) {
    const int k = i >> 3, q4 = i & 7;
    ((float4*)rwl)[q4 * 1024 + ((k & 3) * 256 + (k >> 2))] = ((const float4*)rw)[i];
  }
  if (tid < 32) lcnt[tid] = 0;
  __syncthreads();
  const float* gn = p.norm2_g() + layer * DM; const float* rb = p.router_b() + layer * NE;
  const int per = (ntok + nb - 1) / nb, t_beg = bid * per, t_end = min(ntok, t_beg + per);
  for (int tok = t_beg + wid; tok < t_end; tok += 8) {
    const u16* xr = p.X() + (size_t)tok * DM;
    float v[16];
#pragma unroll
    for (int i = 0; i < 4; ++i) { const float4 a = ld4bf(xr + lane * 4 + i * 256); v[4 * i] = a.x; v[4 * i + 1] = a.y; v[4 * i + 2] = a.z; v[4 * i + 3] = a.w; }
    float ss = 0;
#pragma unroll
    for (int i = 0; i < 16; ++i) ss += v[i] * v[i];
    ss = wave_sum(ss);
    const float rs = rsqrtf(ss * (1.f / DM) + EPS);
    const float* md = p.mod() + ((size_t)layer * 3 + modv(tok)) * 6144 + 3 * DM;
#pragma unroll
    for (int i = 0; i < 4; ++i) {
      const int c = lane * 4 + i * 256;
      const float4 g = *(const float4*)(gn + c), sh = *(const float4*)(md + c), sc = *(const float4*)(md + DM + c);
      v[4 * i] = v[4 * i] * rs * g.x * (1.f + sc.x) + sh.x; v[4 * i + 1] = v[4 * i + 1] * rs * g.y * (1.f + sc.y) + sh.y;
      v[4 * i + 2] = v[4 * i + 2] * rs * g.z * (1.f + sc.z) + sh.z; v[4 * i + 3] = v[4 * i + 3] * rs * g.w * (1.f + sc.w) + sh.w;
    }
    const float rowsc = store_row_i8(v, p.H() + (size_t)tok * DM, p.hs() + tok, lane);
    float lg[32];
#pragma unroll
    for (int e = 0; e < 32; ++e) lg[e] = 0.f;
#pragma unroll
    for (int i = 0; i < 16; ++i) {
      const float4* wr4 = (const float4*)rwl + ((i & 3) * 256 + (i >> 2) * 64 + lane);
#pragma unroll
      for (int q = 0; q < 8; ++q) { const float4 w = wr4[q * 1024]; lg[4 * q] += v[i] * w.x; lg[4 * q + 1] += v[i] * w.y; lg[4 * q + 2] += v[i] * w.z; lg[4 * q + 3] += v[i] * w.w; }
    }
    float r16[16], r8[8], r4[4], r2[2], lv;
    { const bool up = lane & 32;
#pragma unroll
      for (int e = 0; e < 16; ++e) { const float keep = up ? lg[16 + e] : lg[e], send = up ? lg[e] : lg[16 + e]; r16[e] = keep + shx<32>(send); } }
    { const bool up = lane & 16;
#pragma unroll
      for (int e = 0; e < 8; ++e) { const float keep = up ? r16[8 + e] : r16[e], send = up ? r16[e] : r16[8 + e]; r8[e] = keep + shx<16>(send); } }
    { const bool up = lane & 8;
#pragma unroll
      for (int e = 0; e < 4; ++e) { const float keep = up ? r8[4 + e] : r8[e], send = up ? r8[e] : r8[4 + e]; r4[e] = keep + shx<8>(send); } }
    { const bool up = lane & 4;
#pragma unroll
      for (int e = 0; e < 2; ++e) { const float keep = up ? r4[2 + e] : r4[e], send = up ? r4[e] : r4[2 + e]; r2[e] = keep + shx<4>(send); } }
    { const bool up = lane & 2; const float keep = up ? r2[1] : r2[0], send = up ? r2[0] : r2[1]; lv = keep + shx<2>(send); }
    lv += shx<1>(lv);
    lv += rb[lane >> 1];
    int ids[4]; float vals[4];
#pragma unroll
    for (int k = 0; k < 4; ++k) {
      const float mx = wave_max(lv);
      const unsigned long long bal = __ballot(lv == mx);
      const int win = __ffsll((long long)bal) - 1;
      ids[k] = win >> 1; vals[k] = mx;
      if ((lane >> 1) == ids[k]) lv = -3.4e38f;
    }
    if (lane == 0) {
      const float mx = vals[0];
      float ex[4], sum = 0;
#pragma unroll
      for (int k = 0; k < 4; ++k) { ex[k] = __expf(vals[k] - mx); sum += ex[k]; }
      const float inv = 1.f / sum;
#pragma unroll
      for (int k = 0; k < 4; ++k) {
        const int lp = atomicAdd(&lcnt[ids[k]], 1);
        const int slot = (tok - t_beg) * 4 + k;
        ent[2 * slot] = tok * 4 + k; ent[2 * slot + 1] = (ids[k] << 20) | lp; entw[slot] = ex[k] * inv; ents[slot] = rowsc;
      }
    }
  }
  __syncthreads();
  if (tid < 32) lbase[tid] = atomicAdd(&p.cnt()[layer * NE + tid], lcnt[tid]);
  __syncthreads();
  const int nas = (t_end > t_beg ? (t_end - t_beg) : 0) * 4;
  for (int s = tid; s < nas; s += NTHR) {
    const int tk = ent[2 * s], el = ent[2 * s + 1], e = el >> 20, pos = lbase[e] + (el & 0xFFFFF);
    p.rtok()[(size_t)e * TT + pos] = tk >> 2; p.rw()[(size_t)e * TT + pos] = entw[s]; p.rsc()[(size_t)e * TT + pos] = ents[s];
    p.tslot()[tk] = (e << 20) | pos;
  }
}

struct G8Moe {
  const int* cnt;
  int ntn, Kb, G, c; const char* Bt; size_t bstride;
  const int* rtok;
  __device__ __forceinline__ bool next(int i, G8Unit& u) const {
    const int w = (i * 8 + (c & 7)) * (G >> 3) + (c >> 3); int acc = 0, rows = 0;
    for (int ee = 0; ee < NE; ++ee) {
      const int cc = cnt[ee], tiles = ((cc + 255) >> 8) * ntn;
      if (w < acc + tiles) { const int r = w - acc; u.e = ee; u.pm = r / ntn; u.pn = r % ntn; u.ce = cc; u.pre = rows; return true; }
      acc += tiles; rows += cc;
    }
    return false;
  }
  __device__ __forceinline__ unsigned a_off(const G8Unit& u, int row) const {
    const int r = min(u.pm * 256 + row, u.ce - 1);
    const int arow = rtok ? rtok[(size_t)u.e * TT + r] : u.pre + r;
    return (unsigned)arow * (unsigned)Kb;
  }
  __device__ __forceinline__ const char* b_ptr(const G8Unit& u) const { return Bt + (size_t)u.e * bstride + (size_t)u.pn * 256 * Kb; }
};
struct EpiGu {
  const float* bgl; u16* act; const float* rsc; const float* swl;
  __device__ __forceinline__ void pre(const G8Unit& u, int wr, int fr, float (&ep)[8], float* cb) const {
    if ((ltid() >> 6) == 0) g8_cload(bgl + (size_t)u.e * 2048 + u.pn * 256, cb);
    if ((ltid() >> 6) == 1) g8_cload(swl + (size_t)u.e * 2048 + u.pn * 256, cb + 256);
#pragma unroll
    for (int ai = 0; ai < 2; ++ai)
#pragma unroll
      for (int m = 0; m < 4; ++m) ep[ai * 4 + m] = rsc[(size_t)u.e * TT + min(u.pm * 256 + ai * 128 + wr * 64 + m * 16 + fr, u.ce - 1)];
  }
  __device__ __forceinline__ void operator()(const i32x4 (&acc)[2][2][4][2], const G8Unit& u, int wr, int wc, int fr, int fq, const float (&ep)[8], const float* cb) const {
    const int j0 = u.pn * 128 + wc * 32 + 8 * fq;
    const float* bg = cb + 2 * (wc * 32 + 8 * fq);
    float bgt[8], bup[8], sg[8], su[8];
#pragma unroll
    for (int q = 0; q < 4; ++q) { const f32x4 t = *(const f32x4*)(bg + 4 * q); bgt[2 * q] = t[0]; bup[2 * q] = t[1]; bgt[2 * q + 1] = t[2]; bup[2 * q + 1] = t[3]; }
    {
      const float* sp = cb + 256 + wc * 32 + 8 * fq;
      const f32x4 g0 = *(const f32x4*)sp, g1 = *(const f32x4*)(sp + 4), u0 = *(const f32x4*)(sp + 128), u1 = *(const f32x4*)(sp + 132);
#pragma unroll
      for (int j = 0; j < 4; ++j) { sg[j] = g0[j]; sg[4 + j] = g1[j]; su[j] = u0[j]; su[4 + j] = u1[j]; }
    }
#pragma unroll
    for (int ai = 0; ai < 2; ++ai)
#pragma unroll
      for (int m = 0; m < 4; ++m) {
        const int r = u.pm * 256 + ai * 128 + wr * 64 + m * 16 + fr;
        if (r < u.ce) {
          const float sa = ep[ai * 4 + m];
          float o[8];
#pragma unroll
          for (int n = 0; n < 2; ++n)
#pragma unroll
            for (int j = 0; j < 4; ++j) {
              const float gate = fminf((float)acc[ai][0][m][n][j] * sa * sg[4 * n + j] + bgt[4 * n + j], 7.f);
              const float up = fminf(fmaxf((float)acc[ai][1][m][n][j] * sa * su[4 * n + j] + bup[4 * n + j], -7.f), 7.f);
              o[4 * n + j] = (up + 1.f) * gate * __builtin_amdgcn_rcpf(1.f + __expf(-1.702f * gate));
            }
          *(u32x4*)(act + (size_t)(u.pre + r) * DFF + j0) = u32x4{cvtpk(o[0], o[1]), cvtpk(o[2], o[3]), cvtpk(o[4], o[5]), cvtpk(o[6], o[7])};
        }
      }
  }
};
struct EpiDn {
  const float* bdl; const float* rw; u16* yd;
  __device__ __forceinline__ void pre(const G8Unit& u, int wr, int fr, float (&ep)[8], float* cb) const {
    if ((ltid() >> 6) == 0) g8_cload(bdl + (size_t)u.e * DM + u.pn * 256, cb);
#pragma unroll
    for (int ai = 0; ai < 2; ++ai)
#pragma unroll
      for (int m = 0; m < 4; ++m) ep[ai * 4 + m] = rw[(size_t)u.e * TT + min(u.pm * 256 + ai * 128 + wr * 64 + m * 16 + fr, u.ce - 1)];
  }
  __device__ __forceinline__ void operator()(const f32x4 (&acc)[2][2][4][2], const G8Unit& u, int wr, int wc, int fr, int fq, const float (&ep)[8], const float* cb) const {
#pragma unroll
    for (int bj = 0; bj < 2; ++bj) {
      const int c0 = u.pn * 256 + bj * 128 + wc * 32 + 8 * fq;
      const f32x4 ba = *(const f32x4*)(cb + bj * 128 + wc * 32 + 8 * fq), bb = *(const f32x4*)(cb + bj * 128 + wc * 32 + 8 * fq + 4);
#pragma unroll
      for (int ai = 0; ai < 2; ++ai)
#pragma unroll
        for (int m = 0; m < 4; ++m) {
          const int r = u.pm * 256 + ai * 128 + wr * 64 + m * 16 + fr;
          if (r < u.ce) {
            const float wgt = ep[ai * 4 + m];
            const f32x4 a = (acc[ai][bj][m][0] + ba) * wgt, b = (acc[ai][bj][m][1] + bb) * wgt;
            *(u32x4*)(yd + (size_t)(u.pre + r) * DM + c0) = u32x4{cvtpk(a[0], a[1]), cvtpk(a[2], a[3]), cvtpk(b[0], b[1]), cvtpk(b[2], b[3])};
          }
        }
    }
  }
};
__device__ __forceinline__ void phase_moe_gu(const Params& p, int layer, int bid, int nb, char* lds) {
  int* scnt = (int*)(lds + 131072);
  if (ltid() < NE) scnt[ltid()] = p.cnt()[layer * NE + ltid()];
  __syncthreads();
  G8Moe S; S.cnt = scnt; S.ntn = 8; S.Kb = DM; S.G = nb; S.c = bid; S.Bt = (const char*)(p.bt_gu() + (size_t)layer * NE * 2048 * DM); S.bstride = (size_t)2048 * DM; S.rtok = p.rtok();
  EpiGu E; E.bgl = p.moe_b_gu() + (size_t)layer * NE * 2048; E.act = p.act(); E.rsc = p.rsc(); E.swl = p.swgu() + (size_t)layer * NE * 2048;
  gemm8_phase<true>(lds, (const char*)p.H(), DM, S, E);
}
__device__ __forceinline__ void phase_moe_dn(const Params& p, int layer, int bid, int nb, char* lds) {
  int* scnt = (int*)(lds + 131072);
  if (ltid() < NE) scnt[ltid()] = p.cnt()[layer * NE + ltid()];
  __syncthreads();
  G8Moe S; S.cnt = scnt; S.ntn = 4; S.Kb = 2 * DFF; S.G = nb; S.c = bid; S.Bt = (const char*)(p.bt_dn() + (size_t)layer * NE * DM * DFF); S.bstride = (size_t)DM * DFF * 2; S.rtok = nullptr;
  EpiDn E; E.bdl = p.moe_b_down() + (size_t)layer * NE * DM; E.rw = p.rw(); E.yd = p.yd();
  gemm8_phase<false>(lds, (const char*)p.act(), 2 * DFF, S, E);
}

__device__ __forceinline__ void phase_final(const Params& p, int bid, int nb, char* lds) {
  int* pre = (int*)lds;
  expert_prefix(p.cnt() + NE, pre); __syncthreads();
  const int wid = ltid() >> 6, lane = ltid() & 63;
  for (int tok = bid * 8 + wid; tok < TL; tok += nb * 8) {
    float v[16];
    load_row_comb(p, 1, 1, tok, lane, pre, v);
    float ss = 0;
#pragma unroll
    for (int i = 0; i < 16; ++i) ss += v[i] * v[i];
    ss = wave_sum(ss);
    const float rs = rsqrtf(ss * (1.f / DM) + EPS);
    float* o = p.out() + (size_t)tok * DM;
#pragma unroll
    for (int i = 0; i < 4; ++i) {
      const int c = lane * 4 + i * 256;
      const float4 g = *(const float4*)(p.final_g() + c);
      *(float4*)(o + c) = make_float4(v[4 * i] * rs * g.x, v[4 * i + 1] * rs * g.y, v[4 * i + 2] * rs * g.z, v[4 * i + 3] * rs * g.w);
    }
  }
}

#define XB_TMO      128
#define XB_XCNT(j)  (256  + 64 * (j))
#define XB_XSUB(j)  (1280 + 64 * (j))
#define XB_XGEN(j)  (2304 + 64 * (j))
#define XB_TOP      3328
#define XB_TOPGEN   3392
#define XCD_BAR_WORDS 3456
#define XB_SPIN_CAP (1u << 18)
#define LAS __attribute__((address_space(3)))

__device__ __forceinline__ unsigned xb_ld(unsigned* p)              { return __hip_atomic_load(p, __ATOMIC_RELAXED, __HIP_MEMORY_SCOPE_AGENT); }
__device__ __forceinline__ unsigned xb_add(unsigned* p, unsigned v) { return __hip_atomic_fetch_add(p, v, __ATOMIC_RELAXED, __HIP_MEMORY_SCOPE_AGENT); }
__device__ __forceinline__ unsigned xb_xcc_id() { return (unsigned)__builtin_amdgcn_s_getreg((3 << 11) | 20) & 0xFu; }
#define XB_SPIN(cond, bar) do { unsigned _sp = 0; while (cond) { __builtin_amdgcn_s_sleep(1); \
    if ((++_sp & 255u) == 0u) { if (xb_ld(&(bar)[XB_TMO])) break; if (_sp > XB_SPIN_CAP) { atomicAdd(&(bar)[XB_TMO], 1u); break; } } } } while (0)

struct XcdBarrier {
    unsigned* bar; unsigned x;
    volatile LAS unsigned* st;
};

__device__ __forceinline__ XcdBarrier xcd_barrier_post(unsigned* bar, volatile LAS unsigned* st) {
    XcdBarrier b; b.bar = bar; b.x = xb_xcc_id(); b.st = st;
    if (threadIdx.x == 0) (void)xb_add(&bar[XB_XCNT(b.x)], 1u);
    return b;
}
__device__ __forceinline__ void xcd_barrier_complete(unsigned* bar, unsigned x, unsigned& nloc, unsigned& nx) {
    const unsigned G = gridDim.x * gridDim.y * gridDim.z;
    unsigned sum, cnt, mine, sp = 0u;
    for (;;) {
        sum = 0u; cnt = 0u; mine = 0u;
#pragma unroll
        for (unsigned j = 0; j < 16; ++j) { const unsigned c = xb_ld(&bar[XB_XCNT(j)]); sum += c; cnt += (c > 0u) ? 1u : 0u; mine = (j == x) ? c : mine; }
        if (sum == G) break;
        __builtin_amdgcn_s_sleep(1);
        if ((++sp & 255u) == 0u) { if (xb_ld(&bar[XB_TMO])) break; if (sp > XB_SPIN_CAP) { atomicAdd(&bar[XB_TMO], 1u); break; } }
    }
    nloc = mine > 0u ? mine : 1u; nx = cnt > 0u ? cnt : 1u;
}

__device__ __forceinline__ void xcd_barrier(const XcdBarrier& b) {
    asm volatile("s_waitcnt vmcnt(0)" ::: "memory");
    __syncthreads();
    if (threadIdx.x == 0) {
        unsigned* bar = b.bar;
        __builtin_amdgcn_s_waitcnt(0);
        unsigned nloc = b.st[0], nx = b.st[1];
        if (nloc == 0u) { xcd_barrier_complete(bar, b.x, nloc, nx); b.st[0] = nloc; b.st[1] = nx; }
        const unsigned old = xb_add(&bar[XB_XSUB(b.x)], 1u);
        const unsigned gen = old / nloc;
        if (old + 1u == (gen + 1u) * nloc) {
            __builtin_amdgcn_fence(__ATOMIC_RELEASE, "agent");
            asm volatile("s_waitcnt vmcnt(0)" ::: "memory");
            const unsigned og = xb_add(&bar[XB_TOP], 1u);
            const unsigned tg = og / nx;
            if (og + 1u == (tg + 1u) * nx) xb_add(&bar[XB_TOPGEN], 1u);
            else XB_SPIN(xb_ld(&bar[XB_TOPGEN]) == tg, bar);
            __builtin_amdgcn_fence(__ATOMIC_ACQUIRE, "agent");
            xb_add(&bar[XB_XGEN(b.x)], 1u);
            asm volatile("s_waitcnt vmcnt(0)" ::: "memory");
        } else {
            XB_SPIN(xb_ld(&bar[XB_XGEN(b.x)]) == gen, bar);
            __builtin_amdgcn_fence(__ATOMIC_ACQUIRE, "agent");
            asm volatile("s_waitcnt vmcnt(0)" ::: "memory");
        }
    }
    __syncthreads();
}

constexpr int LDS_MAIN = 147456;
constexpr int LDS_BYTES = LDS_MAIN + 1024;
enum { PH_TABLES = 0, PH_MOD, PH_FOLD, PH_CONVERT, PH_HYMLP, PH_HYFILT, PH_NORM1, PH_GEMM_IN, PH_QKV, PH_ATTN, PH_FFTMIX,
       PH_GLA_A, PH_GLA_B, PH_GLA_C, PH_MIX, PH_GEMM_OUT, PH_NORM2, PH_MOE_GU, PH_MOE_DN, PH_FINAL };

__device__ __forceinline__ Params make_params() {
  const __attribute__((address_space(4))) char* kb = (const __attribute__((address_space(4))) char*)__builtin_amdgcn_kernarg_segment_ptr();
  asm volatile("" : "+s"(kb));
  Params p; p.kb = kb; return p;
}
#ifndef MK_LAUNCHES
#define MK_LAUNCHES 1
#endif
__global__ void __launch_bounds__(NTHR, 2) k_mega(ParamsData pd) {
  extern __shared__ __attribute__((aligned(1024))) char lds[];
  const int bid = blockIdx.x, nb = gridDim.x;
  if (threadIdx.x == 0) *(uint4*)(lds + LDS_MAIN) = make_uint4(0u, 0u, 0u, 0u);
  __syncthreads();
  XcdBarrier bar = xcd_barrier_post(make_params().bar(), (volatile LAS unsigned*)(lds + LDS_MAIN));
#ifndef DBLMASK
#define DBLMASK 0u
#endif
#define RUNPH(bit, call) do { call; if (DBLMASK & (1u << (bit))) { __syncthreads(); call; } } while (0)
  RUNPH(13, phase_tables(make_params(), bid, nb); phase_mod(make_params(), bid, nb, lds); phase_fold(make_params(), bid, nb, lds));
  RUNPH(0, phase_convert(make_params(), bid, nb, lds));
  phase_hy_mlp(make_params(), 0, SEQ, make_params().hfb(), make_params().hpart(), bid, nb, lds);
  phase_hy_mlp(make_params(), 1, SEQ, make_params().hfb() + (size_t)2 * 256 * SEQ, make_params().hpart() + 256 * 512, bid, nb, lds);
  phase_hy_mlp(make_params(), 0, LC, make_params().hfc(), make_params().hpart() + 2 * 256 * 512, bid, nb, lds);
  xcd_barrier(bar);
  RUNPH(2, phase_hy_filtfft(make_params(), bid, nb, lds));
  phase_quant_in(make_params(), bid, nb);
#define MK_LAYER(l) do { \
  phase_norm1(make_params(), l, bid, nb, lds); if ((DBLMASK & (1u << 14)) && l == 0) { __syncthreads(); phase_norm1(make_params(), l, bid, nb, lds); } \
  xcd_barrier(bar); \
  RUNPH(3, phase_gemm_in(make_params(), l, bid, nb, lds)); \
  xcd_barrier(bar); \
  RUNPH(4, phase_qkv(make_params(), l, bid, nb, lds)); \
  RUNPH(5, phase_gla_a(make_params(), l, bid, nb, lds)); \
  xcd_barrier(bar); \
  RUNPH(6, phase_attn(make_params(), l, bid, nb, lds)); \
  RUNPH(7, phase_fftmix(make_params(), l, bid, nb, lds)); \
  RUNPH(9, phase_gla_c(make_params(), l, bid, nb, lds)); \
  xcd_barrier(bar); \
  RUNPH(10, phase_mix(make_params(), l, bid, nb, lds)); \
  xcd_barrier(bar); \
  phase_gemm_out(make_params(), l, bid, nb, lds); if ((DBLMASK & (1u << 16)) && l == 0) { __syncthreads(); phase_gemm_out(make_params(), l, bid, nb, lds); } \
  xcd_barrier(bar); \
  phase_norm2_router(make_params(), l, bid, nb, lds); \
  xcd_barrier(bar); \
  RUNPH(11, phase_moe_gu(make_params(), l, bid, nb, lds)); \
  xcd_barrier(bar); \
  RUNPH(12, phase_moe_dn(make_params(), l, bid, nb, lds)); \
  xcd_barrier(bar); \
  } while (0)
  MK_LAYER(0);
  MK_LAYER(1);
#undef MK_LAYER
  RUNPH(15, phase_final(make_params(), bid, nb, lds));
}
static size_t carve(char*& cur, size_t bytes) { char* r = cur; cur += (bytes + 1023) & ~(size_t)1023; return (size_t)(uintptr_t)r; }
#define CARVE(T, field, n) p.field = (T*)carve(cur, (size_t)(n) * sizeof(T))

extern "C" void kernel_launch(void* const* d_in, const int* in_sizes, int n_in, void* d_out, int out_size, void* d_ws, size_t ws_size, hipStream_t stream) {
  ParamsData p; memset(&p, 0, sizeof(p));
  const float** ins = (const float**)&p;
  for (int i = 0; i < 34; ++i) ins[i] = (const float*)d_in[i];
  p.out_ = (float*)d_out;
  p.ws_ = (char*)d_ws;
  if (WS_TOTAL > ws_size) { fprintf(stderr, "workspace too small: need %zu have %zu\n", (size_t)WS_TOTAL, ws_size); return; }
  hipMemsetAsync((char*)d_ws + OFF_bar, 0, OFF_mod - OFF_bar, stream);
  static int grid = 0;
  if (!grid) {
    int dev = 0, cus = 0, per_cu = 0;
    hipGetDevice(&dev);
    hipDeviceGetAttribute(&cus, hipDeviceAttributeMultiprocessorCount, dev);
    hipFuncSetAttribute((const void*)k_mega, hipFuncAttributeMaxDynamicSharedMemorySize, LDS_BYTES);
    hipOccupancyMaxActiveBlocksPerMultiprocessor(&per_cu, (const void*)k_mega, NTHR, LDS_BYTES);
    grid = cus * (per_cu < 1 ? per_cu : 1);
    if (grid != 256) fprintf(stderr, "unexpected grid %d (cus %d per_cu %d)\n", grid, cus, per_cu);
  }
  hipLaunchKernelGGL(k_mega, dim3(grid), dim3(NTHR), LDS_BYTES, stream, p);
}
```

```cpp
#define PROBE_BAR 1
#include <hip/hip_runtime.h>
#include <hip/hip_bf16.h>
#include <cstdio>
#include <cstdint>
#include <cstring>
#include <cstddef>
#include <type_traits>

typedef unsigned short u16;
using bf16x8 = __attribute__((ext_vector_type(8))) short;
using s16x4  = __attribute__((ext_vector_type(4))) short;
using f32x4  = __attribute__((ext_vector_type(4))) float;
using f32x16 = __attribute__((ext_vector_type(16))) float;
using u32x4  = __attribute__((ext_vector_type(4))) unsigned;
using u32x2  = __attribute__((ext_vector_type(2))) unsigned;

constexpr int DM = 1024, NB = 2, SEQ = 16384, LC = 256;
constexpr int TL = NB * SEQ;
constexpr int TC = NB * LC;
constexpr int TT = TL + TC;
constexpr int NIN = 2816;
constexpr int DIN0 = 2240;
constexpr int NE = 32, TOPK = 4, DFF = 1024;
constexpr int SKV = SEQ + LC;
constexpr int NTHR = 512;
constexpr float EPS = 1e-6f;
constexpr float A_SCALE = 0.10206207261596575f;
constexpr float A_QSCALE = A_SCALE * 1.4426950408889634f;
constexpr int ZG_W = 1152, ZG_GQ = 0, ZG_GK = 128, ZG_KR = 256, ZG_GV = 384, ZG_GP = 640, ZG_OG = 896;
constexpr int ZT_HY = 0, ZT_FR = 768, ZT_FI = 1024, ZT_R = 1280;
constexpr int NCH = 260;
constexpr int FM = 16384;
constexpr int HSP = FM / 2 + 1;

constexpr size_t ws_al(size_t b) { return (b + 1023) & ~(size_t)1023; }
constexpr size_t OFF_bar = 0;
constexpr size_t OFF_cnt = OFF_bar + ws_al((size_t)(4096) * sizeof(unsigned));
constexpr size_t OFF_hssq = OFF_cnt + ws_al((size_t)(64) * sizeof(int));
constexpr size_t OFF_kmx = OFF_hssq + ws_al((size_t)(768) * sizeof(float));
constexpr size_t OFF_mod = OFF_kmx + ws_al((size_t)(128) * sizeof(unsigned));
constexpr size_t OFF_ropec = OFF_mod + ws_al((size_t)(2 * 3 * 6144) * sizeof(float));
constexpr size_t OFF_ropes = OFF_ropec + ws_al((size_t)(SEQ * 16) * sizeof(float));
constexpr size_t OFF_tw = OFF_ropes + ws_al((size_t)(SEQ * 16) * sizeof(float));
constexpr size_t OFF_bt_in = OFF_tw + ws_al((size_t)(FM) * sizeof(float2));
constexpr size_t OFF_bt_qkv = OFF_bt_in + ws_al((size_t)((size_t)2 * NIN * DM) * sizeof(u16));
constexpr size_t OFF_bt_out = OFF_bt_qkv + ws_al((size_t)(2 * 1024 * 384) * sizeof(u16));
constexpr size_t OFF_bt_gu = OFF_bt_out + ws_al((size_t)((size_t)2 * DM * DM) * sizeof(u16));
constexpr size_t OFF_bt_dn = OFF_bt_gu + ws_al((size_t)((size_t)2 * NE * 2048 * DM) * sizeof(u16));
constexpr size_t OFF_hfb = OFF_bt_dn + ws_al((size_t)((size_t)2 * NE * DM * DFF) * sizeof(u16));
constexpr size_t OFF_hfc = OFF_hfb + ws_al((size_t)((size_t)2 * 2 * 256 * SEQ) * sizeof(float));
constexpr size_t OFF_hspec = OFF_hfc + ws_al((size_t)(2 * 256 * LC) * sizeof(float));
constexpr size_t OFF_H = OFF_hspec + ws_al((size_t)((size_t)2 * 256 * HSP) * sizeof(float4));
constexpr size_t OFF_zqkv = OFF_H + ws_al((size_t)((size_t)TT * DM) * sizeof(u16));
constexpr size_t OFF_zg = OFF_zqkv + ws_al((size_t)((size_t)TT * 384) * sizeof(u16));
constexpr size_t OFF_zt = OFF_zg + ws_al((size_t)((size_t)TT * ZG_W) * sizeof(float));
constexpr size_t OFF_Q = OFF_zt + ws_al((size_t)((size_t)ZT_R * TT) * sizeof(float));
constexpr size_t OFF_KV = OFF_Q + ws_al((size_t)((size_t)2 * 4 * SKV * 96) * sizeof(u16));
constexpr size_t OFF_ymix = OFF_KV + ws_al((size_t)((size_t)2 * 4 * SKV * 160) * sizeof(u16));
constexpr size_t OFF_hyo = OFF_ymix + ws_al((size_t)((size_t)TT * DM) * sizeof(u16));
constexpr size_t OFF_fno = OFF_hyo + ws_al((size_t)((size_t)256 * TT) * sizeof(float));
constexpr size_t OFF_glao = OFF_fno + ws_al((size_t)((size_t)256 * TT) * sizeof(float));
constexpr size_t OFF_gds = OFF_glao + ws_al((size_t)((size_t)TT * 256) * sizeof(float));
constexpr size_t OFF_gdv = OFF_gds + ws_al((size_t)((size_t)16 * NCH * 2048) * sizeof(float));
constexpr size_t OFF_gst = OFF_gdv + ws_al((size_t)((size_t)16 * NCH * 32) * sizeof(float));
constexpr size_t OFF_X = OFF_gst + ws_al((size_t)((size_t)16 * NCH * 2048) * sizeof(float));
constexpr size_t OFF_rtok = OFF_X + ws_al((size_t)((size_t)TT * DM) * sizeof(float));
constexpr size_t OFF_rw = OFF_rtok + ws_al((size_t)((size_t)NE * TT) * sizeof(int));
constexpr size_t OFF_tslot = OFF_rw + ws_al((size_t)((size_t)NE * TT) * sizeof(float));
constexpr size_t OFF_act = OFF_tslot + ws_al((size_t)((size_t)TT * 4) * sizeof(int));
constexpr size_t OFF_yd = OFF_act + ws_al((size_t)((size_t)TT * 4 * DFF) * sizeof(u16));
constexpr size_t OFF_swin = OFF_yd + ws_al((size_t)((size_t)TT * 4 * DM) * sizeof(u16));
constexpr size_t OFF_swgu = OFF_swin + ws_al((size_t)(2 * NIN) * sizeof(float));
constexpr size_t OFF_hs = OFF_swgu + ws_al((size_t)(2 * NE * 2048) * sizeof(float));
constexpr size_t OFF_hpart = OFF_hs + ws_al((size_t)(TT) * sizeof(float));
constexpr size_t OFF_rsc = OFF_hpart + ws_al((size_t)(3 * 256 * 512) * sizeof(float));
constexpr size_t WS_TOTAL = OFF_rsc + ws_al((size_t)((size_t)NE * TT) * sizeof(float));
struct ParamsData {
  const float *x_, *c_, *ctx_, *c_ctx_, *ada_w_, *ada_b_, *norm1_g_, *norm2_g_, *w_in_, *mla_q_g_, *mla_w_uq_, *mla_kv_g_, *mla_w_ukv_, *hy_conv_w_, *hy_conv_b_, *hy_w1_, *hy_b1_, *hy_w2_, *hy_b2_, *hy_w3_, *hy_freq_, *hy_bias_, *gla_gk_w_, *gla_gk_b_, *fnet_w_, *mix_g_, *w_out_, *router_w_, *router_b_, *moe_w_gu_, *moe_b_gu_, *moe_w_down_, *moe_b_down_, *final_g_;
  float* out_;
  char* ws_;
};
struct Params {
  const __attribute__((address_space(4))) char* kb;
  template <class T> __device__ __forceinline__ T karg(size_t off) const { return *(const __attribute__((address_space(4))) T*)(kb + off); }
  __device__ __forceinline__ const float* x() const { return karg<const float*>(offsetof(ParamsData, x_)); }
  __device__ __forceinline__ const float* c() const { return karg<const float*>(offsetof(ParamsData, c_)); }
  __device__ __forceinline__ const float* ctx() const { return karg<const float*>(offsetof(ParamsData, ctx_)); }
  __device__ __forceinline__ const float* c_ctx() const { return karg<const float*>(offsetof(ParamsData, c_ctx_)); }
  __device__ __forceinline__ const float* ada_w() const { return karg<const float*>(offsetof(ParamsData, ada_w_)); }
  __device__ __forceinline__ const float* ada_b() const { return karg<const float*>(offsetof(ParamsData, ada_b_)); }
  __device__ __forceinline__ const float* norm1_g() const { return karg<const float*>(offsetof(ParamsData, norm1_g_)); }
  __device__ __forceinline__ const float* norm2_g() const { return karg<const float*>(offsetof(ParamsData, norm2_g_)); }
  __device__ __forceinline__ const float* w_in() const { return karg<const float*>(offsetof(ParamsData, w_in_)); }
  __device__ __forceinline__ const float* mla_q_g() const { return karg<const float*>(offsetof(ParamsData, mla_q_g_)); }
  __device__ __forceinline__ const float* mla_w_uq() const { return karg<const float*>(offsetof(ParamsData, mla_w_uq_)); }
  __device__ __forceinline__ const float* mla_kv_g() const { return karg<const float*>(offsetof(ParamsData, mla_kv_g_)); }
  __device__ __forceinline__ const float* mla_w_ukv() const { return karg<const float*>(offsetof(ParamsData, mla_w_ukv_)); }
  __device__ __forceinline__ const float* hy_conv_w() const { return karg<const float*>(offsetof(ParamsData, hy_conv_w_)); }
  __device__ __forceinline__ const float* hy_conv_b() const { return karg<const float*>(offsetof(ParamsData, hy_conv_b_)); }
  __device__ __forceinline__ const float* hy_w1() const { return karg<const float*>(offsetof(ParamsData, hy_w1_)); }
  __device__ __forceinline__ const float* hy_b1() const { return karg<const float*>(offsetof(ParamsData, hy_b1_)); }
  __device__ __forceinline__ const float* hy_w2() const { return karg<const float*>(offsetof(ParamsData, hy_w2_)); }
  __device__ __forceinline__ const float* hy_b2() const { return karg<const float*>(offsetof(ParamsData, hy_b2_)); }
  __device__ __forceinline__ const float* hy_w3() const { return karg<const float*>(offsetof(ParamsData, hy_w3_)); }
  __device__ __forceinline__ const float* hy_freq() const { return karg<const float*>(offsetof(ParamsData, hy_freq_)); }
  __device__ __forceinline__ const float* hy_bias() const { return karg<const float*>(offsetof(ParamsData, hy_bias_)); }
  __device__ __forceinline__ const float* gla_gk_w() const { return karg<const float*>(offsetof(ParamsData, gla_gk_w_)); }
  __device__ __forceinline__ const float* gla_gk_b() const { return karg<const float*>(offsetof(ParamsData, gla_gk_b_)); }
  __device__ __forceinline__ const float* fnet_w() const { return karg<const float*>(offsetof(ParamsData, fnet_w_)); }
  __device__ __forceinline__ const float* mix_g() const { return karg<const float*>(offsetof(ParamsData, mix_g_)); }
  __device__ __forceinline__ const float* w_out() const { return karg<const float*>(offsetof(ParamsData, w_out_)); }
  __device__ __forceinline__ const float* router_w() const { return karg<const float*>(offsetof(ParamsData, router_w_)); }
  __device__ __forceinline__ const float* router_b() const { return karg<const float*>(offsetof(ParamsData, router_b_)); }
  __device__ __forceinline__ const float* moe_w_gu() const { return karg<const float*>(offsetof(ParamsData, moe_w_gu_)); }
  __device__ __forceinline__ const float* moe_b_gu() const { return karg<const float*>(offsetof(ParamsData, moe_b_gu_)); }
  __device__ __forceinline__ const float* moe_w_down() const { return karg<const float*>(offsetof(ParamsData, moe_w_down_)); }
  __device__ __forceinline__ const float* moe_b_down() const { return karg<const float*>(offsetof(ParamsData, moe_b_down_)); }
  __device__ __forceinline__ const float* final_g() const { return karg<const float*>(offsetof(ParamsData, final_g_)); }
  __device__ __forceinline__ float* out() const { return karg<float*>(offsetof(ParamsData, out_)); }
  __device__ __forceinline__ char* ws() const { return karg<char*>(offsetof(ParamsData, ws_)); }
  __device__ __forceinline__ unsigned* bar() const { return (unsigned*)(ws() + OFF_bar); }
  __device__ __forceinline__ int* cnt() const { return (int*)(ws() + OFF_cnt); }
  __device__ __forceinline__ float* hssq() const { return (float*)(ws() + OFF_hssq); }
  __device__ __forceinline__ unsigned* kmx() const { return (unsigned*)(ws() + OFF_kmx); }
  __device__ __forceinline__ float* mod() const { return (float*)(ws() + OFF_mod); }
  __device__ __forceinline__ float* ropec() const { return (float*)(ws() + OFF_ropec); }
  __device__ __forceinline__ float* ropes() const { return (float*)(ws() + OFF_ropes); }
  __device__ __forceinline__ float2* tw() const { return (float2*)(ws() + OFF_tw); }
  __device__ __forceinline__ signed char* bt_in() const { return (signed char*)(ws() + OFF_bt_in); }
  __device__ __forceinline__ u16* bt_qkv() const { return (u16*)(ws() + OFF_bt_qkv); }
  __device__ __forceinline__ u16* bt_out() const { return (u16*)(ws() + OFF_bt_out); }
  __device__ __forceinline__ signed char* bt_gu() const { return (signed char*)(ws() + OFF_bt_gu); }
  __device__ __forceinline__ u16* bt_dn() const { return (u16*)(ws() + OFF_bt_dn); }
  __device__ __forceinline__ float* hfb() const { return (float*)(ws() + OFF_hfb); }
  __device__ __forceinline__ float* hfc() const { return (float*)(ws() + OFF_hfc); }
  __device__ __forceinline__ float4* hspec() const { return (float4*)(ws() + OFF_hspec); }
  __device__ __forceinline__ signed char* H() const { return (signed char*)(ws() + OFF_H); }
  __device__ __forceinline__ float* hs() const { return (float*)(ws() + OFF_hs); }
  __device__ __forceinline__ float* rsc() const { return (float*)(ws() + OFF_rsc); }
  __device__ __forceinline__ float* hpart() const { return (float*)(ws() + OFF_hpart); }
  __device__ __forceinline__ float* swin() const { return (float*)(ws() + OFF_swin); }
  __device__ __forceinline__ float* swgu() const { return (float*)(ws() + OFF_swgu); }
  __device__ __forceinline__ float* btf() const { return (float*)(ws() + OFF_act); }
  __device__ __forceinline__ u16* zqkv() const { return (u16*)(ws() + OFF_zqkv); }
  __device__ __forceinline__ u16* zg() const { return (u16*)(ws() + OFF_zg); }
  __device__ __forceinline__ u16* zt() const { return (u16*)(ws() + OFF_zt); }
  __device__ __forceinline__ u16* Q() const { return (u16*)(ws() + OFF_Q); }
  __device__ __forceinline__ u16* KV() const { return (u16*)(ws() + OFF_KV); }
  __device__ __forceinline__ u16* ymix() const { return (u16*)(ws() + OFF_ymix); }
  __device__ __forceinline__ u16* hyo() const { return (u16*)(ws() + OFF_hyo); }
  __device__ __forceinline__ u16* fno() const { return (u16*)(ws() + OFF_fno); }
  __device__ __forceinline__ u16* glao() const { return (u16*)(ws() + OFF_glao); }
  __device__ __forceinline__ float* gds() const { return (float*)(ws() + OFF_gds); }
  __device__ __forceinline__ float* gdv() const { return (float*)(ws() + OFF_gdv); }
  __device__ __forceinline__ float* gst() const { return (float*)(ws() + OFF_gst); }
  __device__ __forceinline__ u16* X() const { return (u16*)(ws() + OFF_X); }
  __device__ __forceinline__ int* rtok() const { return (int*)(ws() + OFF_rtok); }
  __device__ __forceinline__ float* rw() const { return (float*)(ws() + OFF_rw); }
  __device__ __forceinline__ int* tslot() const { return (int*)(ws() + OFF_tslot); }
  __device__ __forceinline__ u16* act() const { return (u16*)(ws() + OFF_act); }
  __device__ __forceinline__ unsigned char* yd() const { return (unsigned char*)(ws() + OFF_yd); }
};


__device__ __forceinline__ u16 f2bf(float f) {
  unsigned u = __float_as_uint(f); u += 0x7FFFu + ((u >> 16) & 1u); return (u16)(u >> 16);
}
__device__ __forceinline__ float bf2f(u16 h) { return __uint_as_float(((unsigned)h) << 16); }
__device__ __forceinline__ unsigned cvtpk(float lo, float hi) {
  unsigned r; asm volatile("v_cvt_pk_bf16_f32 %0, %1, %2" : "=v"(r) : "v"(lo), "v"(hi)); return r;
}
#define BF_LO(w) __uint_as_float((w) << 16)
#define BF_HI(w) __uint_as_float((w) & 0xFFFF0000u)
__device__ __forceinline__ float4 ld4bf(const u16* p) { const u32x2 w = *(const u32x2*)p; return make_float4(__uint_as_float(w[0] << 16), __uint_as_float(w[0] & 0xFFFF0000u), __uint_as_float(w[1] << 16), __uint_as_float(w[1] & 0xFFFF0000u)); }
template <int CTRL> __device__ __forceinline__ float dppf(float v) { return __builtin_bit_cast(float, __builtin_amdgcn_update_dpp(0, __builtin_bit_cast(int, v), CTRL, 0xF, 0xF, true)); }
template <int M> __device__ __forceinline__ float shx(float v) {
  if constexpr (M == 1) return dppf<0xB1>(v);
  else if constexpr (M == 2) return dppf<0x4E>(v);
  else if constexpr (M == 4) return dppf<0x1B>(dppf<0x141>(v));
  else if constexpr (M == 8) return dppf<0x141>(dppf<0x140>(v));
  else if constexpr (M == 16) { auto r = __builtin_amdgcn_permlane16_swap(__float_as_uint(v), __float_as_uint(v), false, false);
    return __uint_as_float((__lane_id() & 16) ? r[0] : r[1]); }
  else { auto r = __builtin_amdgcn_permlane32_swap(__float_as_uint(v), __float_as_uint(v), false, false);
    return __uint_as_float((__lane_id() & 32) ? r[0] : r[1]); }
}
__device__ __forceinline__ float wave_sum(float v) {
  v += dppf<0xB1>(v); v += dppf<0x4E>(v); v += dppf<0x141>(v); v += dppf<0x140>(v);
  { auto r = __builtin_amdgcn_permlane16_swap(__float_as_uint(v), __float_as_uint(v), false, false); v = __uint_as_float(r[0]) + __uint_as_float(r[1]); }
  { auto r = __builtin_amdgcn_permlane32_swap(__float_as_uint(v), __float_as_uint(v), false, false); v = __uint_as_float(r[0]) + __uint_as_float(r[1]); }
  return v;
}
__device__ __forceinline__ float wave_max(float v) {
  v = fmaxf(v, dppf<0xB1>(v)); v = fmaxf(v, dppf<0x4E>(v)); v = fmaxf(v, dppf<0x141>(v)); v = fmaxf(v, dppf<0x140>(v));
  { auto r = __builtin_amdgcn_permlane16_swap(__float_as_uint(v), __float_as_uint(v), false, false); v = fmaxf(__uint_as_float(r[0]), __uint_as_float(r[1])); }
  { auto r = __builtin_amdgcn_permlane32_swap(__float_as_uint(v), __float_as_uint(v), false, false); v = fmaxf(__uint_as_float(r[0]), __uint_as_float(r[1])); }
  return v;
}
__device__ __forceinline__ int ltid() { int t = threadIdx.x; asm volatile("" : "+v"(t)); return t; }
__device__ __forceinline__ float silu_f(float x) { return x / (1.f + __expf(-x)); }
__device__ __forceinline__ float2 cmul(float2 a, float2 b) { return make_float2(a.x * b.x - a.y * b.y, a.x * b.y + a.y * b.x); }
__device__ __forceinline__ float2 cmulc(float2 a, float2 b) { return make_float2(a.x * b.x + a.y * b.y, a.y * b.x - a.x * b.y); }
__device__ __forceinline__ int modv(int tok) { return tok < TL ? (tok >> 14) : 2; }
__device__ __forceinline__ void phase_tables(const Params& p, int bid, int nb) {
  const int gt = bid * NTHR + ltid(), gs = nb * NTHR;
  for (int i = gt; i < SEQ * 16; i += gs) {
    const int t = i >> 4, f = i & 15;
    const float pos = (f < 8) ? (float)(t >> 6) : (float)(t & 63);
    const float inv = powf(10000.f, -(float)(f & 7) / 8.f);
    float s, c; sincosf(pos * inv, &s, &c);
    p.ropec()[i] = c; p.ropes()[i] = s;
  }
  for (int i = gt; i < FM; i += gs) {
    float s, c; sincospif((float)i / 8192.f, &s, &c);
    p.tw()[i] = make_float2(c, -s);
  }
}

__device__ __forceinline__ void phase_mod(const Params& p, int bid, int nb, char* lds) {
  float* red = (float*)lds;
  const int tid = ltid(), part = tid >> 6, cl = tid & 63;
  for (int it = bid; it < 2 * 96; it += nb) {
    const int l = it / 96, n = (it % 96) * 64 + cl;
    const float* W = p.ada_w() + (size_t)l * DM * 6144;
    float a0 = 0, a1 = 0, a2 = 0;
    for (int k = part * 128; k < part * 128 + 128; ++k) {
      const float w = W[(size_t)k * 6144 + n];
      a0 += silu_f(p.c()[k]) * w; a1 += silu_f(p.c()[DM + k]) * w; a2 += silu_f(p.c_ctx()[k]) * w;
    }
    red[(part * 3 + 0) * 64 + cl] = a0; red[(part * 3 + 1) * 64 + cl] = a1; red[(part * 3 + 2) * 64 + cl] = a2;
    __syncthreads();
    if (tid < 192) {
      const int v = tid >> 6; float s = 0;
      for (int q = 0; q < 8; ++q) s += red[(q * 3 + v) * 64 + cl];
      p.mod()[((size_t)l * 3 + v) * 6144 + n] = s + p.ada_b()[(size_t)l * 6144 + n];
    }
    __syncthreads();
  }
}

__device__ __forceinline__ void phase_fold(const Params& p, int bid, int nb, char* lds) {
  float* wrow = (float*)lds;
  float* dre = wrow + 2048;
  float* dim_ = dre + 2048;
  float* glr = dim_ + 2048;
  float* cst = glr + 256;
  float* snt = cst + 256;
  const int tid = ltid();
  if (tid < 256) { float sn, cs; sincospif((float)tid / 128.f, &sn, &cs); cst[tid] = cs; snt[tid] = sn; }
  __syncthreads();
  for (int it = bid; it < 2 * DM / 8; it += nb) {
    const int l = it >> 7, k0 = (it & 127) * 8;
    for (int i = tid; i < 8 * 256; i += NTHR) { const int r = i >> 8, c = i & 255; wrow[c * 8 + r] = p.w_in()[((size_t)l * DM + k0 + r) * DIN0 + 1984 + c]; }
    if (tid < 256) { const int r = tid >> 5, c = tid & 31; glr[c * 8 + r] = p.w_in()[((size_t)l * DM + k0 + r) * DIN0 + 1696 + c]; }
    __syncthreads();
    {
      const int kp = tid & 255; const bool im = tid >= 256;
      float acc[8] = {0.f, 0.f, 0.f, 0.f, 0.f, 0.f, 0.f, 0.f};
#pragma unroll 4
      for (int c = 0; c < 256; ++c) {
        const int m = (c * kp) & 255; const float t = im ? -snt[m] : cst[m];
        const float4 w0 = *(const float4*)(wrow + c * 8), w1 = *(const float4*)(wrow + c * 8 + 4);
        acc[0] += w0.x * t; acc[1] += w0.y * t; acc[2] += w0.z * t; acc[3] += w0.w * t; acc[4] += w1.x * t; acc[5] += w1.y * t; acc[6] += w1.z * t; acc[7] += w1.w * t;
      }
      float* d = (im ? dim_ : dre) + kp * 8;
      *(float4*)d = make_float4(acc[0], acc[1], acc[2], acc[3]); *(float4*)(d + 4) = make_float4(acc[4], acc[5], acc[6], acc[7]);
    }
    __syncthreads();
    {
      const int j = tid & 255; const bool im = tid >= 256;
      const float* Wf = p.fnet_w() + (size_t)l * 65536 + j;
      const float* d = im ? dim_ : dre;
      float acc[8] = {0.f, 0.f, 0.f, 0.f, 0.f, 0.f, 0.f, 0.f};
#pragma unroll 8
      for (int kp = 0; kp < 256; ++kp) {
        const float w = Wf[kp * 256];
        const float4 d0 = *(const float4*)(d + kp * 8), d1 = *(const float4*)(d + kp * 8 + 4);
        acc[0] += d0.x * w; acc[1] += d0.y * w; acc[2] += d0.z * w; acc[3] += d0.w * w; acc[4] += d1.x * w; acc[5] += d1.y * w; acc[6] += d1.z * w; acc[7] += d1.w * w;
      }
      float* o = p.btf() + ((size_t)l * NIN + (im ? 2560 : 2304) + j) * DM + k0;
      *(float4*)o = make_float4(acc[0] * 0.0625f, acc[1] * 0.0625f, acc[2] * 0.0625f, acc[3] * 0.0625f);
      *(float4*)(o + 4) = make_float4(acc[4] * 0.0625f, acc[5] * 0.0625f, acc[6] * 0.0625f, acc[7] * 0.0625f);
    }
    if (tid < 256) {
      const int dir = tid >> 7, kk = tid & 127;
      const float* gw = p.gla_gk_w() + ((size_t)l * 2 + dir) * 16 * 128 + kk;
      float acc[8] = {0.f, 0.f, 0.f, 0.f, 0.f, 0.f, 0.f, 0.f};
#pragma unroll
      for (int r16 = 0; r16 < 16; ++r16) {
        const float w = gw[r16 * 128];
        const float4 g0 = *(const float4*)(glr + (dir * 16 + r16) * 8), g1 = *(const float4*)(glr + (dir * 16 + r16) * 8 + 4);
        acc[0] += g0.x * w; acc[1] += g0.y * w; acc[2] += g0.z * w; acc[3] += g0.w * w; acc[4] += g1.x * w; acc[5] += g1.y * w; acc[6] += g1.z * w; acc[7] += g1.w * w;
      }
      float* o = p.btf() + ((size_t)l * NIN + 1024 + tid) * DM + k0;
      *(float4*)o = make_float4(acc[0], acc[1], acc[2], acc[3]); *(float4*)(o + 4) = make_float4(acc[4], acc[5], acc[6], acc[7]);
    }
    __syncthreads();
  }
}

enum { MAP_ID = 0, MAP_IN = 1, MAP_UQ = 2, MAP_UKV = 3, MAP_GU = 4 };
__device__ __forceinline__ int colmap(int mt, int n) {
  switch (mt) {
    case MAP_ID: return n;
    case MAP_IN:
      if (n < 256) return n;
      if (n < 384) return 256 + (n - 256);
      if (n < 512) return 1184 + (n - 384);
      if (n < 640) return 1312 + (n - 512);
      if (n < 672) return 384 + (n - 640);
      if (n < 768) return -1;
      if (n < 1024) return 1440 + (n - 768);
      if (n < 1280) return -2;
      if (n < 1536) return 1728 + (n - 1280);
      if (n < 2304) return 416 + (n - 1536);
      return -2;
    case MAP_UQ:
      if (n < 256) return (n >> 6) * 96 + (n & 63);
      if (n < 384) return ((n - 256) >> 5) * 96 + 64 + ((n - 256) & 31);
      return -1;
    case MAP_UKV:
      if (n < 256) return (n >> 6) * 128 + (n & 63);
      return ((n - 256) >> 6) * 128 + 64 + ((n - 256) & 63);
    default: {
      const int pn = n >> 8, w = n & 255;
      return w < 128 ? 2 * (pn * 128 + w) : 2 * (pn * 128 + w - 128) + 1;
    }
  }
}
__device__ __forceinline__ int invmap(int mt, int sc) {
  if (mt == MAP_ID) return sc;
  if (mt == MAP_GU) { const int j = sc >> 1, t = sc & 1; return (j >> 7) * 256 + t * 128 + (j & 127); }
  if (sc < 384) return sc;
  if (sc < 416) return 640 + (sc - 384);
  if (sc < 1184) return 1536 + (sc - 416);
  if (sc < 1312) return 384 + (sc - 1184);
  if (sc < 1440) return 512 + (sc - 1312);
  if (sc < 1696) return 768 + (sc - 1440);
  if (sc < 1728) return -1;
  if (sc < 1984) return 1280 + (sc - 1728);
  return -1;
}
struct ConvJob { const float* src; void* dst; const float* scale; int ld, K, mt, k0, s0, f32; };
__device__ __forceinline__ void conv_tile_load(const ConvJob& J, int tid, float4 (&v)[4]) {
  const int kk = tid >> 5, s4 = (tid & 31) * 4;
#pragma unroll
  for (int i = 0; i < 4; ++i) {
    v[i] = make_float4(0.f, 0.f, 0.f, 0.f);
    if (J.s0 + s4 < J.ld) v[i] = *(const float4*)(J.src + (size_t)(J.k0 + kk + 16 * i) * J.ld + J.s0 + s4);
  }
}
__device__ __forceinline__ void conv_tile_proc(const ConvJob& J, int tid, const float4 (&v)[4], float* tile  ) {
  {
    const int kk = tid >> 5, s4 = (tid & 31) * 4;
#pragma unroll
    for (int i = 0; i < 4; ++i) {
      const float sc = J.scale ? J.scale[J.k0 + kk + 16 * i] : 1.f;
      float* t = tile + (kk + 16 * i) * 129 + s4;
      t[0] = v[i].x * sc; t[1] = v[i].y * sc; t[2] = v[i].z * sc; t[3] = v[i].w * sc;
    }
  }
  __syncthreads();
#pragma unroll
  for (int h = 0; h < 2; ++h) {
    const int sl = (tid >> 3) + 64 * h, ks = (tid & 7) * 8, sc = J.s0 + sl;
    const int row = sc < J.ld ? invmap(J.mt, sc) : -1;
    if (row >= 0) {
      const float* t = tile + ks * 129 + sl;
      if (J.f32) {
        float* dst = (float*)J.dst + (size_t)row * J.K + J.k0 + ks;
        *(float4*)dst = make_float4(t[0], t[129], t[2 * 129], t[3 * 129]); *(float4*)(dst + 4) = make_float4(t[4 * 129], t[5 * 129], t[6 * 129], t[7 * 129]);
      } else {
        u32x4 w;
        w[0] = cvtpk(t[0], t[129]); w[1] = cvtpk(t[2 * 129], t[3 * 129]); w[2] = cvtpk(t[4 * 129], t[5 * 129]); w[3] = cvtpk(t[6 * 129], t[7 * 129]);
        *(u32x4*)((u16*)J.dst + (size_t)row * J.K + J.k0 + ks) = w;
      }
    }
  }
  __syncthreads();
}
constexpr int CT_IN = 16 * 18, CT_OUT = 16 * 8, CT_DN = NE * 128, CT_L = CT_IN + CT_OUT + CT_DN;
__device__ __forceinline__ void conv_decode(const Params& p, int t, ConvJob& J) {
  const int l = t / CT_L; int r = t % CT_L;
  if (r < CT_IN) { J.src = p.w_in() + (size_t)l * DM * DIN0; J.ld = DIN0; J.K = DM; J.dst = p.btf() + (size_t)l * NIN * DM; J.mt = MAP_IN; J.scale = nullptr; J.k0 = (r / 18) * 64; J.s0 = (r % 18) * 128; J.f32 = 1; return; }
  r -= CT_IN;
  if (r < CT_OUT) { J.src = p.w_out() + (size_t)l * DM * DM; J.ld = DM; J.K = DM; J.dst = p.bt_out() + (size_t)l * DM * DM; J.mt = MAP_ID; J.scale = p.mix_g() + l * DM; J.k0 = (r / 8) * 64; J.s0 = (r % 8) * 128; J.f32 = 0; return; }
  r -= CT_OUT;
  const int e = r >> 7, q = r & 127;
  J.src = p.moe_w_down() + ((size_t)l * NE + e) * DFF * DM; J.ld = DM; J.K = DFF; J.dst = p.bt_dn() + ((size_t)l * NE + e) * DM * DFF; J.mt = MAP_ID; J.scale = nullptr; J.k0 = (q >> 3) * 64; J.s0 = (q & 7) * 128; J.f32 = 0;
}
__device__ __forceinline__ void conv_gu8_load(const float* __restrict__ src  , int s0, int tid, float4 (&v)[16]) {
  const int c4 = (tid & 7) * 4, r0 = tid >> 3;
#pragma unroll
  for (int pss = 0; pss < 16; ++pss) v[pss] = *(const float4*)(src + (size_t)(r0 + 64 * pss) * 2048 + s0 + c4);
}
__device__ __forceinline__ void conv_gu8_proc(const float4 (&v)[16], signed char* __restrict__ dst  , float* __restrict__ sw  ,
                                              int s0, float* tile  , int tid) {
  float* cmax = tile + 1024 * 33;
  {
    const int c4 = (tid & 7) * 4, r0 = tid >> 3;
#pragma unroll
    for (int pss = 0; pss < 16; ++pss) { float* t = tile + (r0 + 64 * pss) * 33 + c4; t[0] = v[pss].x; t[1] = v[pss].y; t[2] = v[pss].z; t[3] = v[pss].w; }
  }
  __syncthreads();
  {
    const int col = tid & 31, part = tid >> 5; float m = 0.f;
#pragma unroll 8
    for (int k = part * 64; k < part * 64 + 64; ++k) m = fmaxf(m, fabsf(tile[k * 33 + col]));
    cmax[part * 32 + col] = m;
  }
  __syncthreads();
  if (tid < 32) {
    float m = 0.f;
#pragma unroll
    for (int q = 0; q < 16; ++q) m = fmaxf(m, cmax[q * 32 + tid]);
    const float sc = fmaxf(m, 1e-20f) * (1.f / 127.f);
    cmax[512 + tid] = sc;
    sw[invmap(MAP_GU, s0 + tid)] = sc;
  }
  __syncthreads();
#pragma unroll
  for (int h = 0; h < 4; ++h) {
    const int g = tid + 512 * h, col = g & 31, k0 = (g >> 5) * 16;
    const float inv = 1.f / cmax[512 + col];
    unsigned w[4];
#pragma unroll
    for (int q = 0; q < 4; ++q) {
      const float* t = tile + (k0 + 4 * q) * 33 + col;
      const int q0 = (int)rintf(t[0] * inv), q1 = (int)rintf(t[33] * inv), q2 = (int)rintf(t[66] * inv), q3 = (int)rintf(t[99] * inv);
      w[q] = (unsigned)(q0 & 255) | ((unsigned)(q1 & 255) << 8) | ((unsigned)(q2 & 255) << 16) | ((unsigned)(q3 & 255) << 24);
    }
    *(u32x4*)(dst + (size_t)invmap(MAP_GU, s0 + col) * DM + k0) = u32x4{w[0], w[1], w[2], w[3]};
  }
  __syncthreads();
}
__device__ __forceinline__ void phase_convert(const Params& p, int bid, int nb, char* lds) {
  float* tile = (float*)lds;
  const int tid = ltid();
  {
    ConvJob J, Jn; float4 v[4], vn[4];
    int t = bid;
    if (t < 2 * CT_L) { conv_decode(p, t, J); conv_tile_load(J, tid, v); }
    for (; t < 2 * CT_L; t += nb) {
      const bool more = t + nb < 2 * CT_L;
      if (more) { conv_decode(p, t + nb, Jn); conv_tile_load(Jn, tid, vn); }
      conv_tile_proc(J, tid, v, tile);
      if (more) { J = Jn;
#pragma unroll
        for (int i = 0; i < 4; ++i) v[i] = vn[i]; }
    }
  }
  {
    float4 v[16], vn[16];
    int t = bid;
    if (t < 2 * NE * 64) conv_gu8_load(p.moe_w_gu() + (size_t)(t >> 6) * DM * 2048, (t & 63) * 32, tid, v);
    for (; t < 2 * NE * 64; t += nb) {
      const bool more = t + nb < 2 * NE * 64; const int tn = t + nb;
      if (more) conv_gu8_load(p.moe_w_gu() + (size_t)(tn >> 6) * DM * 2048, (tn & 63) * 32, tid, vn);
      conv_gu8_proc(v, p.bt_gu() + (size_t)(t >> 6) * 2048 * DM, p.swgu() + (size_t)(t >> 6) * 2048, (t & 63) * 32, tile, tid);
      if (more) {
#pragma unroll
        for (int i = 0; i < 16; ++i) v[i] = vn[i]; }
    }
  }
  for (int l = 0; l < 2; ++l) {
    for (int i = bid * NTHR + tid; i < 96 * DM / 4; i += nb * NTHR) *(float4*)(p.btf() + ((size_t)l * NIN + 672) * DM + (size_t)i * 4) = make_float4(0.f, 0.f, 0.f, 0.f);
    {
      const float* wq = p.mla_w_uq() + (size_t)l * 256 * 384; const float* wkv = p.mla_w_ukv() + (size_t)l * 128 * 512;
      const float* gq = p.mla_q_g() + l * 256; const float* gkv = p.mla_kv_g() + l * 128;
      u16* dst = p.bt_qkv() + (size_t)l * 1024 * 384;
      for (int i = bid * NTHR + ltid(); i < 1024 * 384; i += nb * NTHR) {
        const int n = i / 384, k = i % 384; float v = 0.f;
        if (n < 512) { const int sc = colmap(MAP_UQ, n); if (k < 256 && sc >= 0) v = gq[k] * wq[k * 384 + sc]; }
        else { if (k >= 256) v = gkv[k - 256] * wkv[(k - 256) * 512 + colmap(MAP_UKV, n - 512)]; }
        dst[i] = f2bf(v);
      }
    }
  }
}

__device__ __forceinline__ void phase_hy_mlp(const Params& p, int l, int Lf, float* __restrict__ hout  , float* __restrict__ ssq  ,
                             int bid, int nb, char* lds) {
  float* zf = (float*)lds;
  float* h1 = zf + 64 * 33;
  float* h2 = h1 + 64 * 64;
  const int tid = ltid();
  const float* w1 = p.hy_w1() + (size_t)l * 33 * 64; const float* b1 = p.hy_b1() + l * 64;
  const float* w2 = p.hy_w2() + (size_t)l * 64 * 64; const float* b2 = p.hy_b2() + l * 64;
  const float* w3 = p.hy_w3() + (size_t)l * 64 * 512; const float* fr = p.hy_freq() + l * 64;
  float w3c[64];
#pragma unroll
  for (int k = 0; k < 64; ++k) w3c[k] = w3[k * 512 + tid];
  const int dir = tid >> 8, ch = tid & 255;
  const float maxd = logf(1e-2f) / 0.3f, mind = logf(1e-2f) / 1.5f;
  const float delta = fabsf(mind + (maxd - mind) * (float)ch / 255.f);
  float ssq_acc = 0.f;
  for (int it = bid; it < Lf / 64; it += nb) {
    const int t0 = it * 64;
    for (int i = tid; i < 64 * 33; i += NTHR) {
      const int tt = i / 33, f = i % 33, t = t0 + tt;
      float v;
      if (f == 0) v = (float)t / (float)(Lf - 1);
      else {
        const int j = (f - 1) & 15;
        const float fj = 1e-4f + (float)j * ((15.f - 1e-4f) / 15.f);
        const float w = 6.283185307179586f * (float)t / (float)Lf;
        v = (f <= 16) ? cosf(fj * w) : -sinf(fj * w);
      }
      zf[i] = v;
    }
    __syncthreads();
    {
      const int o = tid & 63, tb = tid >> 6;
      float acc[8];
#pragma unroll
      for (int j = 0; j < 8; ++j) acc[j] = b1[o];
#pragma unroll 3
      for (int f = 0; f < 33; ++f) {
        const float w = w1[f * 64 + o];
#pragma unroll
        for (int j = 0; j < 8; ++j) acc[j] += zf[(tb + 8 * j) * 33 + f] * w;
      }
      const float fo = fr[o];
#pragma unroll
      for (int j = 0; j < 8; ++j) h1[(tb + 8 * j) * 64 + o] = sinf(fo * acc[j]);
    }
    __syncthreads();
    {
      const int o = tid & 63, tb = tid >> 6;
      float acc[8];
#pragma unroll
      for (int j = 0; j < 8; ++j) acc[j] = b2[o];
#pragma unroll 4
      for (int f = 0; f < 64; f += 4) {
        const float wa = w2[f * 64 + o], wb = w2[(f + 1) * 64 + o], wc2 = w2[(f + 2) * 64 + o], wd = w2[(f + 3) * 64 + o];
#pragma unroll
        for (int j = 0; j < 8; ++j) { const float4 hv = *(const float4*)(h1 + (tb + 8 * j) * 64 + f); acc[j] += hv.x * wa + hv.y * wb + hv.z * wc2 + hv.w * wd; }
      }
      const float fo = fr[o];
#pragma unroll
      for (int j = 0; j < 8; ++j) h2[(tb + 8 * j) * 64 + o] = sinf(fo * acc[j]);
    }
    __syncthreads();
    float* orow = hout + ((size_t)dir * 256 + ch) * Lf + t0;
    for (int tq = 0; tq < 16; ++tq) {
      float sv[4];
#pragma unroll
      for (int u = 0; u < 4; ++u) {
        const int tt = tq * 4 + u;
        float s = 0;
#pragma unroll
        for (int k = 0; k < 64; k += 4) { const float4 hv = *(const float4*)(h2 + tt * 64 + k); s += hv.x * w3c[k] + hv.y * w3c[k + 1] + hv.z * w3c[k + 2] + hv.w * w3c[k + 3]; }
        const int t = t0 + tt;
        s *= __expf(-((float)t / (float)(Lf - 1)) * delta);
        if (dir == 0 || t > 0) ssq_acc += s * s;
        sv[u] = s;
      }
      *(float4*)(orow + tq * 4) = make_float4(sv[0], sv[1], sv[2], sv[3]);
    }
    __syncthreads();
  }
  ssq[(size_t)bid * 512 + tid] = ssq_acc;
}

__host__ __device__ constexpr int fx(int p) {
  return ((p >> 12) & 3) ^ (((p >> 10) & 3) << 2) ^ ((p >> 4) & 16) ^ (((p >> 5) & 1) * 5) ^ (((p >> 6) & 1) * 26);
}
__device__ __forceinline__ int swz(int p) { return p ^ fx(p); }
__device__ __forceinline__ int rev7(int k) {
  unsigned r = __brev((unsigned)k) >> 18;
  return (int)(((r & 0x2AAAu) >> 1) | ((r & 0x1555u) << 1));
}
template <int ST, bool INV>
__device__ __forceinline__ void fft_stage(float2* s, const float2* __restrict__ tw, const int tid) {
  constexpr int sh = 12 - 2 * ST, q = 1 << sh, ND = q >= 512 ? q / 512 : 1;
  float2 w1[ND], w2[ND], w3[ND];
  if constexpr (ST < 6) {
#pragma unroll
    for (int d = 0; d < ND; ++d) {
      const int j = q >= 512 ? tid + 512 * d : (tid & (q - 1)), ti = j << (2 * ST);
      w1[d] = tw[ti]; w2[d] = tw[2 * ti]; w3[d] = tw[3 * ti];
    }
  }
  float2 x[8][4];
#pragma unroll
  for (int m = 0; m < 8; ++m) {
    const int u = tid + 512 * m, g = u >> sh, j = u & (q - 1), base = (g << (sh + 2)) + j, xb = fx(base);
    x[m][0] = s[base ^ xb]; x[m][1] = s[(base + q) ^ xb ^ fx(q)]; x[m][2] = s[(base + 2 * q) ^ xb ^ fx(2 * q)]; x[m][3] = s[(base + 3 * q) ^ xb ^ fx(3 * q)];
  }
#pragma unroll
  for (int m = 0; m < 8; ++m) {
    const int u = tid + 512 * m, g = u >> sh, j = u & (q - 1), base = (g << (sh + 2)) + j, xb = fx(base);
    const int i0 = base ^ xb, i1 = (base + q) ^ xb ^ fx(q), i2 = (base + 2 * q) ^ xb ^ fx(2 * q), i3 = (base + 3 * q) ^ xb ^ fx(3 * q);
    const int d = q >= 512 ? (m % ND) : 0;
    if constexpr (!INV) {
      const float2 a0 = x[m][0], a1 = x[m][1], a2 = x[m][2], a3 = x[m][3];
      const float2 b0 = make_float2(a0.x + a2.x, a0.y + a2.y), b1 = make_float2(a0.x - a2.x, a0.y - a2.y);
      const float2 b2 = make_float2(a1.x + a3.x, a1.y + a3.y), b3 = make_float2(a1.x - a3.x, a1.y - a3.y);
      const float2 y1 = make_float2(b1.x + b3.y, b1.y - b3.x), y2 = make_float2(b0.x - b2.x, b0.y - b2.y), y3 = make_float2(b1.x - b3.y, b1.y + b3.x);
      s[i0] = make_float2(b0.x + b2.x, b0.y + b2.y);
      if constexpr (ST < 6) { s[i1] = cmul(y1, w1[d]); s[i2] = cmul(y2, w2[d]); s[i3] = cmul(y3, w3[d]); }
      else { s[i1] = y1; s[i2] = y2; s[i3] = y3; }
    } else {
      float2 t0 = x[m][0], t1 = x[m][1], t2 = x[m][2], t3 = x[m][3];
      if constexpr (ST < 6) { t1 = cmulc(t1, w1[d]); t2 = cmulc(t2, w2[d]); t3 = cmulc(t3, w3[d]); }
      const float2 b0 = make_float2(t0.x + t2.x, t0.y + t2.y), b1 = make_float2(t0.x - t2.x, t0.y - t2.y);
      const float2 b2 = make_float2(t1.x + t3.x, t1.y + t3.y), b3 = make_float2(t1.x - t3.x, t1.y - t3.y);
      s[i0] = make_float2(b0.x + b2.x, b0.y + b2.y);
      s[i1] = make_float2(b1.x - b3.y, b1.y + b3.x);
      s[i2] = make_float2(b0.x - b2.x, b0.y - b2.y);
      s[i3] = make_float2(b1.x + b3.y, b1.y - b3.x);
    }
  }
  __syncthreads();
}
__device__ __forceinline__ void fft_fwd(float2* s, const float2* __restrict__ tw) {
  const int tid = ltid();
  fft_stage<0, false>(s, tw, tid); fft_stage<1, false>(s, tw, tid); fft_stage<2, false>(s, tw, tid); fft_stage<3, false>(s, tw, tid);
  fft_stage<4, false>(s, tw, tid); fft_stage<5, false>(s, tw, tid); fft_stage<6, false>(s, tw, tid);
}
__device__ __forceinline__ void fft_inv(float2* s, const float2* __restrict__ tw) {
  const int tid = ltid();
  fft_stage<6, true>(s, tw, tid); fft_stage<5, true>(s, tw, tid); fft_stage<4, true>(s, tw, tid); fft_stage<3, true>(s, tw, tid);
  fft_stage<2, true>(s, tw, tid); fft_stage<1, true>(s, tw, tid); fft_stage<0, true>(s, tw, tid);
}

__device__ __forceinline__ float filt_ssq(const float* __restrict__ part  , int ch, float* red  ) {
  const int tid = ltid();
  float v = part[(size_t)(tid >> 1) * 512 + (tid & 1) * 256 + ch];
  v = wave_sum(v);
  __syncthreads();
  if ((tid & 63) == 0) red[tid >> 6] = v;
  __syncthreads();
  return ((red[0] + red[1]) + (red[2] + red[3])) + ((red[4] + red[5]) + (red[6] + red[7]));
}
__device__ __forceinline__ void phase_hy_filtfft(const Params& p, int bid, int nb, char* lds) {
  float2* s = (float2*)lds;
  const int tid = ltid();
  for (int it = bid; it < 512; it += nb) {
    const int l = it >> 8, ch = it & 255;
    const float* hf = p.hfb() + (((size_t)l * 2 + 0) * 256 + ch) * SEQ;
    const float* hb = p.hfb() + (((size_t)l * 2 + 1) * 256 + ch) * SEQ;
#pragma unroll 8
    for (int m = tid; m < FM; m += NTHR) {
      const int n0 = 2 * m, n1 = 2 * m + 1;
      const float a = (n0 < SEQ) ? hf[n0] : (n0 == SEQ ? 0.f : hb[2 * SEQ - n0]);
      const float b = (n1 < SEQ) ? hf[n1] : hb[2 * SEQ - n1];
      s[swz(m)] = make_float2(a, b);
    }
    __syncthreads();
    fft_fwd(s, p.tw());
    const float sc = rsqrtf(filt_ssq(p.hpart() + (size_t)l * 256 * 512, ch, (float*)(lds + 139264))) * (1.f / 16384.f);
    float4* out = p.hspec() + ((size_t)l * 256 + ch) * HSP;
#pragma unroll 4
    for (int k = tid; k <= FM / 2; k += NTHR) {
      const float2 zk = s[swz(rev7(k))], zm = s[swz(rev7((FM - k) & (FM - 1)))];
      const float er = 0.5f * (zk.x + zm.x), ei = 0.5f * (zk.y - zm.y);
      const float dr = 0.5f * (zk.x - zm.x), di = 0.5f * (zk.y + zm.y);
      out[k] = make_float4(er * sc, ei * sc, di * sc, -dr * sc);
    }
    __syncthreads();
  }
}
constexpr int G_TILE_B = 256 * 64 * 2;
constexpr int G_STAGE_B = 2 * G_TILE_B;
constexpr int GEMM_LDS = 2 * G_STAGE_B;

__device__ __forceinline__ int lds_byte2(int r, int c) {
  const int st = (r >> 4) * 2 + (c >> 5), ob = (r & 15) * 64 + (c & 31) * 2;
  return st * 1024 + (ob ^ (((ob >> 9) & 1) << 5));
}
__device__ __forceinline__ void stage_rc2(int b, int& R, int& C) {
  const int st = b >> 10, sb = b & 1023, swz = sb ^ (((sb >> 9) & 1) << 5);
  R = (st >> 1) * 16 + (swz >> 6);
  C = (st & 1) * 32 + ((swz & 63) >> 1);
}
__device__ __forceinline__ void gemm_stage_coords(int (&sR)[4], int (&sC)[4]) {
  const int wid = ltid() >> 6, lane = ltid() & 63;
#pragma unroll
  for (int i = 0; i < 4; ++i) stage_rc2(wid * 1024 + i * 8192 + lane * 16, sR[i], sC[i]);
}

#define WAIT_V0() asm volatile("s_waitcnt vmcnt(0)" ::: "memory")

__device__ __forceinline__ void gemm256_core(const u16* const (&ap)[4], const u16* const (&bp)[4], int nt, char* shm, f32x4 (&acc)[8][4]) {
  const int tid = ltid(), wid = tid >> 6, lane = tid & 63, wr = wid >> 2, wc = wid & 3, fr = lane & 15, fq = lane >> 4;
#pragma unroll
  for (int m = 0; m < 8; ++m)
#pragma unroll
    for (int n = 0; n < 4; ++n) acc[m][n] = f32x4{0.f, 0.f, 0.f, 0.f};
#define G_SA(b) (shm + (b) * G_STAGE_B)
#define G_SB(b) (shm + (b) * G_STAGE_B + G_TILE_B)
#define G_STAGE(buf, kt) do { _Pragma("unroll") for (int i = 0; i < 4; ++i) {                                                   \
    __builtin_amdgcn_global_load_lds((const unsigned*)(ap[i] + (kt) * 64), (unsigned*)(G_SA(buf) + wid * 1024 + i * 8192), 16, 0, 0); \
    __builtin_amdgcn_global_load_lds((const unsigned*)(bp[i] + (kt) * 64), (unsigned*)(G_SB(buf) + wid * 1024 + i * 8192), 16, 0, 0); } } while (0)
  G_STAGE(0, 0); WAIT_V0(); __syncthreads();
#pragma unroll 1
  for (int t = 0; t < nt; ++t) {
    const int cur = t & 1;
    if (t + 1 < nt) G_STAGE(cur ^ 1, t + 1);
#pragma unroll
    for (int ks = 0; ks < 2; ++ks) {
      bf16x8 At[8], Bf[4];
#pragma unroll
      for (int m = 0; m < 8; ++m) At[m] = *(const bf16x8*)(G_SA(cur) + lds_byte2(wr * 128 + m * 16 + fr, ks * 32 + fq * 8));
#pragma unroll
      for (int n = 0; n < 4; ++n) Bf[n] = *(const bf16x8*)(G_SB(cur) + lds_byte2(wc * 64 + n * 16 + fr, ks * 32 + fq * 8));
#pragma unroll
      for (int m = 0; m < 8; ++m)
#pragma unroll
        for (int n = 0; n < 4; ++n) acc[m][n] = __builtin_amdgcn_mfma_f32_16x16x32_bf16(At[m], Bf[n], acc[m][n], 0, 0, 0);
      __builtin_amdgcn_sched_barrier(0);
    }
    WAIT_V0(); __syncthreads();
  }
#undef G_STAGE
}

#define LAS3 __attribute__((address_space(3)))
constexpr int G8_HTB = 128 * 64 * 2;
__device__ __forceinline__ int g8_perm32(int rho) { const int n = rho >> 4, i = rho & 15; return 8 * (i >> 2) + 4 * n + (i & 3); }
__device__ __forceinline__ int g8_lds_byte(int r, int c) { const int st = (r >> 4) * 2 + (c >> 5), rr = r & 15, cc = c & 31, ob = rr * 64 + cc * 2; return st * 1024 + (ob ^ (((ob >> 9) & 1) << 5)); }
__device__ __forceinline__ void g8_stage_rc(int b, int& R, int& C) { const int st = b / 1024, sb = b % 1024, swz = sb ^ (((sb >> 9) & 1) << 5); R = (st >> 1) * 16 + swz / 64; C = (st & 1) * 32 + (swz % 64) / 2; }
struct G8Unit { int pm, pn, e, ce, pre; };
__device__ __forceinline__ void g8_cload(const float* __restrict__ src, float* dst) {
  __builtin_amdgcn_global_load_lds((const unsigned*)(src + (ltid() & 63) * 4), (LAS3 unsigned*)dst, 16, 0, 0);
}


template <bool I8> __device__ __forceinline__ typename std::conditional<I8, int __attribute__((ext_vector_type(4))), f32x4>::type
g8_mma(bf16x8 x, bf16x8 y, typename std::conditional<I8, int __attribute__((ext_vector_type(4))), f32x4>::type c) {
  if constexpr (I8) { typedef int v4i __attribute__((ext_vector_type(4))); return __builtin_amdgcn_mfma_i32_16x16x64_i8(*(v4i*)&x, *(v4i*)&y, c, 0, 0, 0); }
  else return __builtin_amdgcn_mfma_f32_16x16x32_bf16(x, y, c, 0, 0, 0);
}
typedef int i32x4 __attribute__((ext_vector_type(4)));
template <bool I8> struct G8Acc { typedef f32x4 T; };
template <> struct G8Acc<true> { typedef i32x4 T; };
template <bool I8, class Sched, class Epi>
__device__ __forceinline__ void gemm8_phase(char* lds_g, const char* Abase, const int Kb, const Sched& S, const Epi& E) {
    typedef typename G8Acc<I8>::T ACC;
    LAS3 unsigned char* lds = (LAS3 unsigned char*)lds_g;
    const int tid = ltid(), wid = __builtin_amdgcn_readfirstlane(tid >> 6), lane = tid & 63, wr = wid >> 2, wc = wid & 3, fr = lane & 15, fq = lane >> 4;
    const int nt = Kb / 128;
    int sRr[2], sCc[2]; unsigned voffB[2];
#pragma unroll
    for (int i = 0; i < 2; ++i) { g8_stage_rc(tid * 16 + i * 8192, sRr[i], sCc[i]); const int Rb = (sRr[i] & ~31) + g8_perm32(sRr[i] & 31); voffB[i] = (unsigned)(Rb * Kb) + (unsigned)sCc[i] * 2u; }
    const size_t kstep = 128;
    const size_t hstepB = (size_t)128 * Kb;
    const unsigned ldsw = (unsigned)wid * 1024u;
    const int aoff = g8_lds_byte(wr * 64 + fr, fq * 8), boff = g8_lds_byte(wc * 32 + fr, fq * 8);
#define G8_SA(b, h) (((b) * 2 + (h)) * G8_HTB)
#define G8_SB(b, h) ((4 + (b) * 2 + (h)) * G8_HTB)
#define G8_STAGE_B(bufoff, gbase) do { _Pragma("unroll") for (int _i = 0; _i < 2; ++_i) \
        __builtin_amdgcn_global_load_lds((const unsigned*)((const char*)(gbase) + voffB[_i]), (LAS3 unsigned*)(lds + (bufoff) + ldsw + _i * 8192), 16, 0, 0); } while (0)
#define G8_STAGE_A(bufoff, o0, o1) do { \
        __builtin_amdgcn_global_load_lds((const unsigned*)(Abase + (o0)), (LAS3 unsigned*)(lds + (bufoff) + ldsw), 16, 0, 0); \
        __builtin_amdgcn_global_load_lds((const unsigned*)(Abase + (o1)), (LAS3 unsigned*)(lds + (bufoff) + ldsw + 8192), 16, 0, 0); } while (0)
#define G8_LDA(dst, b, h) do { _Pragma("unroll") for (int m = 0; m < 4; ++m) _Pragma("unroll") for (int k = 0; k < 2; ++k) dst[m][k] = *(const LAS3 bf16x8*)(lds + G8_SA(b, h) + aoff + m * 2048 + k * 1024); } while (0)
#define G8_LDB(dst, b, h) do { _Pragma("unroll") for (int n = 0; n < 2; ++n) _Pragma("unroll") for (int k = 0; k < 2; ++k) dst[n][k] = *(const LAS3 bf16x8*)(lds + G8_SB(b, h) + boff + n * 2048 + k * 1024); } while (0)
#define G8_MMA(ai, bj, At, Bt) do { __builtin_amdgcn_s_setprio(1); _Pragma("unroll") for (int m = 0; m < 4; ++m) _Pragma("unroll") for (int n = 0; n < 2; ++n) _Pragma("unroll") for (int k = 0; k < 2; ++k) \
        acc[ai][bj][m][n] = g8_mma<I8>(Bt[n][k], At[m][k], acc[ai][bj][m][n]); __builtin_amdgcn_s_setprio(0); } while (0)
#define G8_WAIT_V(n) asm volatile("s_waitcnt vmcnt(" #n ")" ::: "memory")
#define G8_WAIT_L(n) asm volatile("s_waitcnt lgkmcnt(" #n ")" ::: "memory")
#define G8_BAR __builtin_amdgcn_s_barrier()
#define G8_SCHED __builtin_amdgcn_sched_barrier(0)
    G8Unit cur, nxt; int ui = 0;
    if (!S.next(0, cur)) return;
    ACC acc[2][2][4][2];
#pragma unroll
    for (int a = 0; a < 2; ++a)
#pragma unroll
        for (int b = 0; b < 2; ++b)
#pragma unroll
            for (int m = 0; m < 4; ++m)
#pragma unroll
                for (int n = 0; n < 2; ++n) acc[a][b][m][n] = ACC{};
    bf16x8 At[4][2], B0[2][2], B1[2][2];
    float ep[8];
    unsigned va[2][2], vn[2][2];
#pragma unroll
    for (int h = 0; h < 2; ++h)
#pragma unroll
        for (int i = 0; i < 2; ++i) va[h][i] = S.a_off(cur, h * 128 + sRr[i]) + (unsigned)sCc[i] * 2u;
    const char* cB = S.b_ptr(cur);
    G8_STAGE_B(G8_SB(0, 0), cB); G8_STAGE_A(G8_SA(0, 0), va[0][0], va[0][1]); G8_STAGE_B(G8_SB(0, 1), cB + hstepB); G8_STAGE_A(G8_SA(0, 1), va[1][0], va[1][1]);
    if (wr == 1) G8_BAR;
    G8_WAIT_V(4); G8_BAR;
    G8_STAGE_B(G8_SB(1, 0), cB + kstep); G8_STAGE_A(G8_SA(1, 0), va[0][0] + kstep, va[0][1] + kstep); G8_STAGE_B(G8_SB(1, 1), cB + hstepB + kstep);
    G8_WAIT_V(6); G8_BAR;
    for (;;) {
        float* cb = (float*)(lds_g + 136192 + (ui & 1) * 2048);
        E.pre(cur, wr, fr, ep, cb);
        const bool has_next = S.next(ui + 1, nxt);
        const char* nB = cB;
#pragma unroll
        for (int h = 0; h < 2; ++h)
#pragma unroll
            for (int i = 0; i < 2; ++i) vn[h][i] = va[h][i];
        if (has_next) {
            nB = S.b_ptr(nxt);
#pragma unroll
            for (int h = 0; h < 2; ++h)
#pragma unroll
                for (int i = 0; i < 2; ++i) vn[h][i] = S.a_off(nxt, h * 128 + sRr[i]) + (unsigned)sCc[i] * 2u;
        }
#pragma unroll 1
        for (int t = 0; t < nt; t += 2) {
            const bool last = (t == nt - 2);
            const unsigned k1 = (unsigned)(t + 1) * 128u;
            const unsigned k2 = last ? 0u : (unsigned)(t + 2) * 128u;
            const unsigned a2_00 = (last ? vn[0][0] : va[0][0]) + k2, a2_01 = (last ? vn[0][1] : va[0][1]) + k2;
            const unsigned a2_10 = (last ? vn[1][0] : va[1][0]) + k2, a2_11 = (last ? vn[1][1] : va[1][1]) + k2;
            const char* b2 = (last ? nB : cB) + k2; const char* b3 = b2 + kstep;
            G8_LDB(B0, 0, 0); G8_SCHED; G8_LDA(At, 0, 0); G8_STAGE_A(G8_SA(1, 1), va[1][0] + k1, va[1][1] + k1);
            G8_WAIT_L(8); G8_BAR; G8_WAIT_L(0); G8_MMA(0, 0, At, B0); G8_BAR; G8_SCHED;
            G8_LDB(B1, 0, 1); G8_STAGE_B(G8_SB(0, 0), b2);
            G8_BAR; G8_WAIT_L(0); G8_MMA(0, 1, At, B1); G8_BAR;
            G8_LDA(At, 0, 1); G8_STAGE_A(G8_SA(0, 0), a2_00, a2_01);
            G8_BAR; G8_WAIT_L(0); G8_MMA(1, 0, At, B0); G8_BAR; G8_SCHED;
            G8_STAGE_B(G8_SB(0, 1), b2 + hstepB);
            G8_WAIT_V(6); G8_BAR; G8_MMA(1, 1, At, B1); G8_BAR;
            G8_LDB(B0, 1, 0); G8_SCHED; G8_LDA(At, 1, 0); G8_STAGE_A(G8_SA(0, 1), a2_10, a2_11);
            G8_WAIT_L(8); G8_BAR; G8_WAIT_L(0); G8_MMA(0, 0, At, B0); G8_BAR; G8_SCHED;
            G8_LDB(B1, 1, 1); G8_STAGE_B(G8_SB(1, 0), b3);
            G8_BAR; G8_WAIT_L(0); G8_MMA(0, 1, At, B1); G8_BAR;
            G8_LDA(At, 1, 1); G8_STAGE_A(G8_SA(1, 0), a2_00 + 128u, a2_01 + 128u);
            G8_BAR; G8_WAIT_L(0); G8_MMA(1, 0, At, B0); G8_BAR; G8_SCHED;
            G8_STAGE_B(G8_SB(1, 1), b3 + hstepB);
            G8_WAIT_V(6); G8_BAR; G8_MMA(1, 1, At, B1); G8_BAR;
        }
        E(acc, cur, wr, wc, fr, fq, ep, cb);
        if (!has_next) break;
#pragma unroll
        for (int a = 0; a < 2; ++a)
#pragma unroll
            for (int b = 0; b < 2; ++b)
#pragma unroll
                for (int m = 0; m < 4; ++m)
#pragma unroll
                    for (int n = 0; n < 2; ++n) acc[a][b][m][n] = ACC{};
        cur = nxt; cB = nB; ++ui;
#pragma unroll
        for (int h = 0; h < 2; ++h)
#pragma unroll
            for (int i = 0; i < 2; ++i) va[h][i] = vn[h][i];
    }
    G8_WAIT_V(0);
    if (wr == 0) G8_BAR;
    G8_BAR;
#undef G8_SA
#undef G8_SB
#undef G8_STAGE_A
#undef G8_STAGE_B
#undef G8_LDA
#undef G8_LDB
#undef G8_MMA
#undef G8_WAIT_V
#undef G8_WAIT_L
#undef G8_BAR
#undef G8_SCHED
}
struct G8Plain {
    int nM, nN, Kb, G, c; const char* Bt;
    __device__ __forceinline__ bool next(int i, G8Unit& u) const {
        const int L = (i * 8 + (c & 7)) * (G >> 3) + (c >> 3); if (L >= nM * nN) return false;
        const int nig = 8 * nN, gid = L / nig, fm = gid * 8, gsz = (nM - fm) < 8 ? (nM - fm) : 8;
        u.pm = fm + ((L % nig) % gsz); u.pn = (L % nig) / gsz; u.e = 0; u.ce = 256; u.pre = 0; return true;
    }
    __device__ __forceinline__ unsigned a_off(const G8Unit& u, int row) const { return (unsigned)(u.pm * 256 + row) * (unsigned)Kb; }
    __device__ __forceinline__ const char* b_ptr(const G8Unit& u) const { return Bt + (size_t)u.pn * 256 * Kb; }
};

__device__ __forceinline__ const float* resid_row_in(const Params& p, int tok) {
  return tok < TL ? p.x() + (size_t)tok * DM : p.ctx() + (size_t)(tok - TL) * DM;
}
__device__ __forceinline__ void load_row_comb(const Params& p, int src_layer, int lc, int tok, int lane, const int* pre  , float (&v)[16]) {
  if (src_layer == 0) {
    const float* r = resid_row_in(p, tok);
#pragma unroll
    for (int i = 0; i < 4; ++i) { const float4 a = *(const float4*)(r + lane * 4 + i * 256); v[4 * i] = a.x; v[4 * i + 1] = a.y; v[4 * i + 2] = a.z; v[4 * i + 3] = a.w; }
  } else {
    const u16* r = p.X() + (size_t)tok * DM;
#pragma unroll
    for (int i = 0; i < 4; ++i) { const float4 a = ld4bf(r + lane * 4 + i * 256); v[4 * i] = a.x; v[4 * i + 1] = a.y; v[4 * i + 2] = a.z; v[4 * i + 3] = a.w; }
  }
  if (lc >= 0) {
    const float* g2 = p.mod() + ((size_t)lc * 3 + modv(tok)) * 6144 + 5 * DM;
    float s[16];
#pragma unroll
    for (int i = 0; i < 16; ++i) s[i] = 0.f;
#pragma unroll
    for (int k = 0; k < TOPK; ++k) {
      const int sl = p.tslot()[tok * 4 + k];
      const size_t arow = (size_t)(pre[sl >> 20] + (sl & 0xFFFFF));
      const unsigned char* y = p.yd() + arow * DM;
#pragma unroll
      for (int i = 0; i < 4; ++i) {
        const int w = *(const int*)(y + lane * 4 + i * 256);
        const auto lo = __builtin_amdgcn_cvt_pk_f32_fp8(w, false), hi2 = __builtin_amdgcn_cvt_pk_f32_fp8(w, true);
        s[4 * i] += lo[0]; s[4 * i + 1] += lo[1]; s[4 * i + 2] += hi2[0]; s[4 * i + 3] += hi2[1];
      }
    }
#pragma unroll
    for (int i = 0; i < 4; ++i) {
      const float4 g = *(const float4*)(g2 + lane * 4 + i * 256);
      v[4 * i] += g.x * 0.125f * s[4 * i]; v[4 * i + 1] += g.y * 0.125f * s[4 * i + 1]; v[4 * i + 2] += g.z * 0.125f * s[4 * i + 2]; v[4 * i + 3] += g.w * 0.125f * s[4 * i + 3];
    }
  }
}
__device__ __forceinline__ void expert_prefix(const int* cnt, int* pre) {
  if (ltid() == 0) { int s = 0; for (int e = 0; e < NE; ++e) { pre[e] = s; s += cnt[e]; } pre[NE] = s; }
}

__device__ __forceinline__ float store_row_i8(const float (&y)[16], signed char* __restrict__ h, float* __restrict__ hs_row, int lane) {
  float am = 0.f;
#pragma unroll
  for (int i = 0; i < 16; ++i) am = fmaxf(am, fabsf(y[i]));
  am = wave_max(am);
  const float s = fmaxf(am, 1e-20f) * (1.f / 127.f), inv = 1.f / s;
#pragma unroll
  for (int i = 0; i < 4; ++i) {
    const int q0 = (int)rintf(y[4 * i] * inv), q1 = (int)rintf(y[4 * i + 1] * inv), q2 = (int)rintf(y[4 * i + 2] * inv), q3 = (int)rintf(y[4 * i + 3] * inv);
    *(unsigned*)(h + lane * 4 + i * 256) = (unsigned)(q0 & 255) | ((unsigned)(q1 & 255) << 8) | ((unsigned)(q2 & 255) << 16) | ((unsigned)(q3 & 255) << 24);
  }
  if (lane == 0) *hs_row = s;
  return s;
}
__device__ __forceinline__ void phase_quant_in(const Params& p, int bid, int nb) {
  const int wid = ltid() >> 6, lane = ltid() & 63;
  for (int r = bid * 8 + wid; r < 2 * NIN; r += nb * 8) {
    const float* src = p.btf() + (size_t)r * DM;
    float y[16];
#pragma unroll
    for (int i = 0; i < 4; ++i) { const float4 a = *(const float4*)(src + lane * 4 + i * 256); y[4 * i] = a.x; y[4 * i + 1] = a.y; y[4 * i + 2] = a.z; y[4 * i + 3] = a.w; }
    store_row_i8(y, p.bt_in() + (size_t)r * DM, p.swin() + r, lane);
  }
}
__device__ __forceinline__ void phase_norm1(const Params& p, int layer, int bid, int nb, char* lds) {
  int* pre = (int*)lds;
  const int lc = layer - 1;
  if (lc >= 0) { expert_prefix(p.cnt() + lc * NE, pre); __syncthreads(); }
  const int wid = ltid() >> 6, lane = ltid() & 63;
  const float* gn = p.norm1_g() + layer * DM;
  const int ntok = TT;
  for (int tok = bid * 8 + wid; tok < ntok; tok += nb * 8) {
    float v[16];
    load_row_comb(p, layer == 0 ? 0 : 1, lc, tok, lane, pre, v);
    if (lc >= 0) {
      u16* xr = p.X() + (size_t)tok * DM;
#pragma unroll
      for (int i = 0; i < 4; ++i) *(u32x2*)(xr + lane * 4 + i * 256) = u32x2{cvtpk(v[4 * i], v[4 * i + 1]), cvtpk(v[4 * i + 2], v[4 * i + 3])};
    }
    float ss = 0;
#pragma unroll
    for (int i = 0; i < 16; ++i) ss += v[i] * v[i];
    ss = wave_sum(ss);
    const float rs = rsqrtf(ss * (1.f / DM) + EPS);
    const float* md = p.mod() + ((size_t)layer * 3 + modv(tok)) * 6144;
#pragma unroll
    for (int i = 0; i < 4; ++i) {
      const int c = lane * 4 + i * 256;
      const float4 g = *(const float4*)(gn + c), sh = *(const float4*)(md + c), sc = *(const float4*)(md + DM + c);
      v[4 * i] = v[4 * i] * rs * g.x * (1.f + sc.x) + sh.x; v[4 * i + 1] = v[4 * i + 1] * rs * g.y * (1.f + sc.y) + sh.y;
      v[4 * i + 2] = v[4 * i + 2] * rs * g.z * (1.f + sc.z) + sh.z; v[4 * i + 3] = v[4 * i + 3] * rs * g.w * (1.f + sc.w) + sh.w;
    }
    store_row_i8(v, p.H() + (size_t)tok * DM, p.hs() + tok, lane);
  }
}

struct EpiIn {
  u16* zqkv; u16* zg; u16* zt; const float* hs; const float* sw;
  __device__ __forceinline__ void pre(const G8Unit& u, int wr, int fr, float (&ep)[8], float* cb) const {
    if ((ltid() >> 6) == 0) g8_cload(sw + u.pn * 256, cb);
#pragma unroll
    for (int ai = 0; ai < 2; ++ai)
#pragma unroll
      for (int m = 0; m < 4; ++m) ep[ai * 4 + m] = hs[u.pm * 256 + ai * 128 + wr * 64 + m * 16 + fr];
  }
  __device__ __forceinline__ void operator()(const i32x4 (&acc)[2][2][4][2], const G8Unit& u, int wr, int wc, int fr, int fq, const float (&ep)[8], const float* cb) const {
#pragma unroll
    for (int bj = 0; bj < 2; ++bj) {
      const int c32 = u.pn * 256 + bj * 128 + wc * 32, c0 = c32 + 8 * fq;
      const f32x4 w0 = *(const f32x4*)(cb + bj * 128 + wc * 32 + 8 * fq), w1 = *(const f32x4*)(cb + bj * 128 + wc * 32 + 8 * fq + 4);
#pragma unroll
      for (int ai = 0; ai < 2; ++ai)
#pragma unroll
        for (int m = 0; m < 4; ++m) {
          const int row = u.pm * 256 + ai * 128 + wr * 64 + m * 16 + fr;
          f32x4 a, b;
#pragma unroll
          for (int j = 0; j < 4; ++j) { a[j] = (float)acc[ai][bj][m][0][j] * ep[ai * 4 + m] * w0[j]; b[j] = (float)acc[ai][bj][m][1][j] * ep[ai * 4 + m] * w1[j]; }
          if (c32 < 384) {
            *(u32x4*)(zqkv + (size_t)row * 384 + c0) = u32x4{cvtpk(a[0], a[1]), cvtpk(a[2], a[3]), cvtpk(b[0], b[1]), cvtpk(b[2], b[3])};
          } else if (c32 < 1536) {
            *(u32x4*)(zg + (size_t)row * ZG_W + (c0 - 384)) = u32x4{cvtpk(a[0], a[1]), cvtpk(a[2], a[3]), cvtpk(b[0], b[1]), cvtpk(b[2], b[3])};
          } else {
#pragma unroll
            for (int j = 0; j < 4; ++j) { zt[(size_t)(c0 - 1536 + j) * TT + row] = f2bf(a[j]); zt[(size_t)(c0 - 1536 + 4 + j) * TT + row] = f2bf(b[j]); }
          }
        }
    }
  }
};
__device__ __forceinline__ void phase_gemm_in(const Params& p, int layer, int bid, int nb, char* lds) {
  G8Plain S; S.nM = TT / 256; S.nN = NIN / 256; S.Kb = DM; S.G = nb; S.c = bid; S.Bt = (const char*)(p.bt_in() + (size_t)layer * NIN * DM);
  EpiIn E; E.zqkv = p.zqkv(); E.zg = p.zg(); E.zt = p.zt(); E.hs = p.hs(); E.sw = p.swin() + layer * NIN;
  gemm8_phase<true>(lds, (const char*)p.H(), DM, S, E);
}

__device__ __forceinline__ size_t qkv_row(int tok, int h) {
  const int b = tok < TL ? (tok >> 14) : ((tok - TL) >> 8);
  const int s = tok < TL ? (tok & (SEQ - 1)) : SEQ + ((tok - TL) & (LC - 1));
  return ((size_t)(b * 4 + h)) * SKV + s;
}
struct EpiQkv {
  const u16* zqkv; u16* Q; u16* KV; const float* ropec; const float* ropes; float* rsl;
  unsigned* kmx;
  __device__ __forceinline__ void pre(const G8Unit&, int, int, float (&)[8], float*) const {}
  __device__ __forceinline__ void operator()(const f32x4 (&acc)[2][2][4][2], const G8Unit& u, int wr, int wc, int fr, int fq, const float (&)[8], const float*) const {
    const int tid = ltid();
    {
      const int r = tid >> 1, half = tid & 1;
      const u16* row = zqkv + (size_t)(u.pm * 256 + r) * 384;
      float sq = 0, sk = 0;
#pragma unroll
      for (int i = 0; i < 16; ++i) {
        const u32x4 w = *(const u32x4*)(row + half * 128 + i * 8);
#pragma unroll
        for (int q = 0; q < 4; ++q) { const float a = __uint_as_float(w[q] << 16), b = __uint_as_float(w[q] & 0xFFFF0000u); sq += a * a + b * b; }
      }
#pragma unroll
      for (int i = 0; i < 8; ++i) {
        const u32x4 w = *(const u32x4*)(row + 256 + half * 64 + i * 8);
#pragma unroll
        for (int q = 0; q < 4; ++q) { const float a = __uint_as_float(w[q] << 16), b = __uint_as_float(w[q] & 0xFFFF0000u); sk += a * a + b * b; }
      }
      sq += shx<1>(sq); sk += shx<1>(sk);
      if (half == 0) { rsl[r] = rsqrtf(sq * (1.f / 256.f) + EPS); rsl[256 + r] = rsqrtf(sk * (1.f / 128.f) + EPS); }
    }
    asm volatile("s_waitcnt lgkmcnt(0)" ::: "memory"); __builtin_amdgcn_s_barrier(); __builtin_amdgcn_s_barrier(); asm volatile("" ::: "memory");
    const float* rsp = rsl + (u.pn >= 2 ? 256 : 0);
#pragma unroll
    for (int ai = 0; ai < 2; ++ai)
#pragma unroll
      for (int m = 0; m < 4; ++m) {
        const int rl = ai * 128 + wr * 64 + m * 16 + fr, tok = u.pm * 256 + rl;
        const float rs = rsp[rl] * (u.pn < 2 ? A_QSCALE : 1.f);
        if (u.pn == 1) {
          f32x4 a = acc[ai][0][m][0] * rs, b = acc[ai][0][m][1] * rs;
          f32x4 pa, pb;
#pragma unroll
          for (int j = 0; j < 4; ++j) { pa[j] = shx<32>(a[j]); pb[j] = shx<32>(b[j]); }
          f32x4 ca = {1.f, 1.f, 1.f, 1.f}, cb = ca, sa = {0.f, 0.f, 0.f, 0.f}, sb = sa;
          if (tok < TL) {
            const float* cp = ropec + (size_t)(tok & (SEQ - 1)) * 16 + 8 * (fq & 1); const float* sp = ropes + (size_t)(tok & (SEQ - 1)) * 16 + 8 * (fq & 1);
            ca = *(const f32x4*)cp; cb = *(const f32x4*)(cp + 4); sa = *(const f32x4*)sp; sb = *(const f32x4*)(sp + 4);
          }
          const float sg = fq < 2 ? -1.f : 1.f;
          a = a * ca + pa * sa * sg; b = b * cb + pb * sb * sg;
          *(u32x4*)(Q + qkv_row(tok, wc) * 96 + 64 + 8 * fq) = u32x4{cvtpk(a[0], a[1]), cvtpk(a[2], a[3]), cvtpk(b[0], b[1]), cvtpk(b[2], b[3])};
        } else {
#pragma unroll
          for (int bj = 0; bj < 2; ++bj) {
            const int c = bj * 128 + wc * 32 + 8 * fq, h = c >> 6, d = c & 63;
            const f32x4 a = acc[ai][bj][m][0] * rs, b = acc[ai][bj][m][1] * rs;
            u16* dst = u.pn == 0 ? Q + qkv_row(tok, h) * 96 + d : KV + qkv_row(tok, h) * 160 + (u.pn == 2 ? 0 : 96) + d;
            *(u32x4*)dst = u32x4{cvtpk(a[0], a[1]), cvtpk(a[2], a[3]), cvtpk(b[0], b[1]), cvtpk(b[2], b[3])};
          }
        }
      }
    if (u.pn == 2) {
      const int b = u.pm * 256 < TL ? (u.pm * 256) >> 14 : (u.pm * 256 - TL) >> 8;
#pragma unroll
      for (int bj = 0; bj < 2; ++bj) {
        float mx = 0.f;
#pragma unroll
        for (int ai = 0; ai < 2; ++ai)
#pragma unroll
          for (int m = 0; m < 4; ++m) {
            const float rs = rsp[ai * 128 + wr * 64 + m * 16 + fr];
            const f32x4 a = acc[ai][bj][m][0] * rs, b4 = acc[ai][bj][m][1] * rs;
            float ss = a[0] * a[0] + a[1] * a[1] + a[2] * a[2] + a[3] * a[3] + b4[0] * b4[0] + b4[1] * b4[1] + b4[2] * b4[2] + b4[3] * b4[3];
            ss += shx<16>(ss); ss += shx<32>(ss);
            mx = fmaxf(mx, ss);
          }
        mx = fmaxf(mx, shx<8>(mx)); mx = fmaxf(mx, shx<4>(mx)); mx = fmaxf(mx, shx<2>(mx)); mx = fmaxf(mx, shx<1>(mx));
        if ((ltid() & 63) == 0) atomicMax(kmx + (b * 4 + bj * 2 + (wc >> 1)) * 4 + (wc & 1), __float_as_uint(mx));
      }
    }
  }
};
__device__ __forceinline__ void phase_qkv(const Params& p, int layer, int bid, int nb, char* lds) {
  const int tid = ltid();
  {
    G8Plain S; S.nM = TT / 256; S.nN = 4; S.Kb = 768; S.G = nb; S.c = bid; S.Bt = (const char*)(p.bt_qkv() + (size_t)layer * 1024 * 384);
    EpiQkv E; E.zqkv = p.zqkv(); E.Q = p.Q(); E.KV = p.KV(); E.ropec = p.ropec(); E.ropes = p.ropes(); E.rsl = (float*)(lds + 131072); E.kmx = p.kmx() + layer * 32;
    gemm8_phase<false>(lds, (const char*)p.zqkv(), 768, S, E);
  }
  float krm0 = 0.f, krm1 = 0.f;
  for (int i = bid * NTHR + tid; i < TT * 16; i += nb * NTHR) {
    const int tok = i >> 4, f = i & 15;
    const float x1 = bf2f(p.zg()[(size_t)tok * ZG_W + ZG_KR + f]), x2 = bf2f(p.zg()[(size_t)tok * ZG_W + ZG_KR + 16 + f]);
    float cs = 1.f, sn = 0.f;
    if (tok < TL) { const int tpos = tok & (SEQ - 1); cs = p.ropec()[tpos * 16 + f]; sn = p.ropes()[tpos * 16 + f]; }
    const float y1 = x1 * cs - x2 * sn, y2 = x2 * cs + x1 * sn;
    const u16 o1 = f2bf(y1), o2 = f2bf(y2);
#pragma unroll
    for (int h = 0; h < 4; ++h) { u16* kv = p.KV() + qkv_row(tok, h) * 160 + 64; kv[f] = o1; kv[16 + f] = o2; }
    float ss = y1 * y1 + y2 * y2;
    ss += shx<8>(ss); ss += shx<4>(ss); ss += shx<2>(ss); ss += shx<1>(ss);
    const int b = tok < TL ? (tok >> 14) : ((tok - TL) >> 8);
    if (b == 0) krm0 = fmaxf(krm0, ss); else krm1 = fmaxf(krm1, ss);
  }
  krm0 = wave_max(krm0); krm1 = wave_max(krm1);
  if ((tid & 63) == 0) { atomicMax(p.kmx() + layer * 32 + 0 * 16 + 2, __float_as_uint(krm0)); atomicMax(p.kmx() + layer * 32 + 1 * 16 + 2, __float_as_uint(krm1)); }
}

constexpr int A_KROW = 208;
constexpr int A_TV = 128 * 64 * 2;
constexpr int A_TK = 128 * A_KROW;
constexpr int A_BUF = A_TV + A_TK;
constexpr int A_OFF_W = 3 * A_BUF;
constexpr int ATTN_LDS = A_OFF_W + 8 * 64 * 4;
#define SBAR() __builtin_amdgcn_sched_barrier(0)
__device__ __forceinline__ int crow(int r, int hi) { return (r & 3) + 8 * (r >> 2) + 4 * hi; }

__device__ __forceinline__ void a_partialSM(f32x16& p0) {
#pragma unroll
  for (int r = 0; r < 16; ++r) p0[r] = __builtin_amdgcn_exp2f(p0[r]);
}
__device__ __forceinline__ void a_finishSM(f32x16& p0, f32x16& p1, bf16x8& pa0, bf16x8& pa1, bf16x8& pa2, bf16x8& pa3) {
#pragma unroll
  for (int r = 0; r < 16; ++r) p1[r] = __builtin_amdgcn_exp2f(p1[r]);
#define PK4(P, BASE, OUT) do { unsigned a0 = cvtpk(P[BASE + 0], P[BASE + 1]), a1 = cvtpk(P[BASE + 2], P[BASE + 3]);   \
    unsigned b0 = cvtpk(P[BASE + 4], P[BASE + 5]), b1 = cvtpk(P[BASE + 6], P[BASE + 7]);                              \
    auto r0 = __builtin_amdgcn_permlane32_swap(a0, b0, false, false); auto r1 = __builtin_amdgcn_permlane32_swap(a1, b1, false, false); \
    u32x4 w = {r0[0], r1[0], r0[1], r1[1]}; OUT = *reinterpret_cast<bf16x8*>(&w); } while (0)
  PK4(p0, 0, pa0); PK4(p0, 8, pa1); PK4(p1, 0, pa2); PK4(p1, 8, pa3);
#undef PK4
}
__device__ __forceinline__ void a_qkt(f32x16& p0, f32x16& p1, const char* Ks, const bf16x8* qr, const float mneg, int r32, int hi) {
#pragma unroll
  for (int r = 0; r < 16; ++r) { p0[r] = mneg; p1[r] = mneg; }
#pragma unroll
  for (int d0 = 0; d0 < 6; ++d0) {
    const int cb = (d0 * 16 + hi * 8) * 2;
    const bf16x8 b0 = *reinterpret_cast<const bf16x8*>(Ks + r32 * A_KROW + cb);
    const bf16x8 b1 = *reinterpret_cast<const bf16x8*>(Ks + (32 + r32) * A_KROW + cb);
    p0 = __builtin_amdgcn_mfma_f32_32x32x16_bf16(b0, qr[d0], p0, 0, 0, 0); p1 = __builtin_amdgcn_mfma_f32_32x32x16_bf16(b1, qr[d0], p1, 0, 0, 0);
  }
}
__device__ __forceinline__ int a_v_st(int k, int c) { const int kk = (k & ~0xC) | ((k & 4) << 1) | ((k & 8) >> 1); return ((kk >> 3) * 2 + (c >> 5)) * 512 + ((kk & 7) * 32 + (c & 31)) * 2; }
__device__ __forceinline__ int a_v_rd_base(int lane) { return ((lane & 3) << 3) | (((lane >> 2) & 3) << 6) | (((lane >> 4) & 1) << 5) | (((lane >> 5) & 1) << 8); }
constexpr int a_v_rd_off(int d0, int ks, int half) { return d0 * 512 + ks * 2048 + half * 1024; }
template <int OFF> __device__ __forceinline__ s16x4 a_tr_read(int vb) {
  s16x4 r; asm volatile("ds_read_b64_tr_b16 %0, %1 offset:%2" : "=&v"(r) : "v"(vb), "i"(OFF) : "memory"); return r;
}
template <int D0> __device__ __forceinline__ void a_pv_one(f32x16& od, int vb, bf16x8 pa0, bf16x8 pa1, bf16x8 pa2, bf16x8 pa3) {
  const s16x4 l0 = a_tr_read<a_v_rd_off(D0, 0, 0)>(vb), h0 = a_tr_read<a_v_rd_off(D0, 0, 1)>(vb), l1 = a_tr_read<a_v_rd_off(D0, 1, 0)>(vb), h1 = a_tr_read<a_v_rd_off(D0, 1, 1)>(vb);
  const s16x4 l2 = a_tr_read<a_v_rd_off(D0, 2, 0)>(vb), h2 = a_tr_read<a_v_rd_off(D0, 2, 1)>(vb), l3 = a_tr_read<a_v_rd_off(D0, 3, 0)>(vb), h3 = a_tr_read<a_v_rd_off(D0, 3, 1)>(vb);
  asm volatile("s_waitcnt lgkmcnt(0)" ::: "memory"); SBAR();
#define PK(L, H) (bf16x8){L[0], L[1], L[2], L[3], H[0], H[1], H[2], H[3]}
  od = __builtin_amdgcn_mfma_f32_32x32x16_bf16(pa0, PK(l0, h0), od, 0, 0, 0);
  od = __builtin_amdgcn_mfma_f32_32x32x16_bf16(pa1, PK(l1, h1), od, 0, 0, 0);
  od = __builtin_amdgcn_mfma_f32_32x32x16_bf16(pa2, PK(l2, h2), od, 0, 0, 0);
  od = __builtin_amdgcn_mfma_f32_32x32x16_bf16(pa3, PK(l3, h3), od, 0, 0, 0);
#undef PK
}
__device__ __forceinline__ void a_pv(f32x16* o, int vb, bf16x8 pa0, bf16x8 pa1, bf16x8 pa2, bf16x8 pa3) {
  a_pv_one<0>(o[0], vb, pa0, pa1, pa2, pa3);
  { const bf16x8 ones = {0x3F80, 0x3F80, 0x3F80, 0x3F80, 0x3F80, 0x3F80, 0x3F80, 0x3F80};
    o[2] = __builtin_amdgcn_mfma_f32_32x32x16_bf16(pa0, ones, o[2], 0, 0, 0); o[2] = __builtin_amdgcn_mfma_f32_32x32x16_bf16(pa1, ones, o[2], 0, 0, 0);
    o[2] = __builtin_amdgcn_mfma_f32_32x32x16_bf16(pa2, ones, o[2], 0, 0, 0); o[2] = __builtin_amdgcn_mfma_f32_32x32x16_bf16(pa3, ones, o[2], 0, 0, 0); }
  a_pv_one<1>(o[1], vb, pa0, pa1, pa2, pa3);
}

__device__ __forceinline__ void attn_item(const u16* __restrict__ Qb, const u16* __restrict__ KVh, int seq, float kmax, u16* __restrict__ yout  , char* lds) {
  const int tid = ltid(), wid = tid >> 6, lane = tid & 63, r32 = lane & 31, hi = lane >> 5;
  f32x16 o[3] = {}; bf16x8 qr[6];
  const u16* Qw = Qb + (size_t)(wid * 32 + r32) * 96 + hi * 8;
#pragma unroll
  for (int d0 = 0; d0 < 6; ++d0) qr[d0] = *reinterpret_cast<const bf16x8*>(Qw + d0 * 16);
  float mneg;
  {
    float ss = 0.f;
#pragma unroll
    for (int d0 = 0; d0 < 6; ++d0)
#pragma unroll
      for (int j = 0; j < 8; ++j) { const float v = bf2f((u16)qr[d0][j]); ss += v * v; }
    ss += shx<32>(ss);
    mneg = -sqrtf(ss) * kmax;
  }
  int lw[5];
#pragma unroll
  for (int i = 0; i < 5; ++i) {
    const int g = tid + i * 512, key = g / 20, cc = g % 20;
    lw[i] = cc < 12 ? (A_TV + key * A_KROW + cc * 16) : ((key >> 6) * 8192 + a_v_st(key & 63, (cc - 12) * 8));
  }
  const int vrb = (int)(uintptr_t)lds + a_v_rd_base(lane);
  bf16x8 sg[5];
  const char* gsrc = (const char*)KVh + tid * 16;
#define SLOAD(t) do { const char* s_ = gsrc + (size_t)(t) * 40960; _Pragma("unroll") for (int i = 0; i < 5; ++i) sg[i] = *(const bf16x8*)(s_ + i * 8192); } while (0)
#define SWRITE(bo_) do { _Pragma("unroll") for (int i = 0; i < 5; ++i) *(bf16x8*)(lds + (bo_) + lw[i]) = sg[i]; } while (0)
  f32x16 pA0, pA1, pB0, pB1; bf16x8 pa0, pa1, pa2, pa3; const int NT = seq / 128;
  SLOAD(0); SWRITE(0); if (1 < NT) SLOAD(1);
  __syncthreads();
  int bo = 0;
  {
    if (1 < NT) { SWRITE(A_BUF); if (2 < NT) SLOAD(2); }
    SBAR(); a_qkt(pA0, pA1, lds + bo + A_TV, qr, mneg, r32, hi); a_partialSM(pA0);
    SBAR(); a_qkt(pB0, pB1, lds + bo + A_TV + 64 * A_KROW, qr, mneg, r32, hi);
    a_finishSM(pA0, pA1, pa0, pa1, pa2, pa3); SBAR();
    a_pv(o, vrb + bo, pa0, pa1, pa2, pa3); a_partialSM(pB0);
    __syncthreads();
  }
  for (int t = 1; t < NT; ++t) {
    const int bp = bo;
    bo = bo + A_BUF; if (bo == 3 * A_BUF) bo = 0;
    int bn = bo + A_BUF; if (bn == 3 * A_BUF) bn = 0;
    if (t + 1 < NT) { SWRITE(bn); if (t + 2 < NT) SLOAD(t + 2); }
    SBAR(); a_qkt(pA0, pA1, lds + bo + A_TV, qr, mneg, r32, hi);
    a_finishSM(pB0, pB1, pa0, pa1, pa2, pa3); SBAR();
    a_pv(o, vrb + bp + 8192, pa0, pa1, pa2, pa3); a_partialSM(pA0);
    SBAR(); a_qkt(pB0, pB1, lds + bo + A_TV + 64 * A_KROW, qr, mneg, r32, hi);
    a_finishSM(pA0, pA1, pa0, pa1, pa2, pa3); SBAR();
    a_pv(o, vrb + bo, pa0, pa1, pa2, pa3); a_partialSM(pB0);
    __syncthreads();
  }
  a_finishSM(pB0, pB1, pa0, pa1, pa2, pa3); SBAR();
  a_pv(o, vrb + bo + 8192, pa0, pa1, pa2, pa3);
#pragma unroll
  for (int r = 0; r < 16; ++r) {
    const int orow = crow(r, hi);
    const float rl = __builtin_amdgcn_rcpf(o[2][r]);
    const float v0 = o[0][r] * rl, v1 = o[1][r] * rl;
    float ss = v0 * v0 + v1 * v1;
    ss += shx<16>(ss); ss += shx<8>(ss); ss += shx<4>(ss); ss += shx<2>(ss); ss += shx<1>(ss);
    const float rs = rsqrtf(ss * (1.f / 64.f) + EPS);
    u16* dst = yout + (size_t)(wid * 32 + orow) * DM;
    dst[r32] = f2bf(v0 * rs); dst[32 + r32] = f2bf(v1 * rs);
  }
  __syncthreads();
#undef SLOAD
#undef SWRITE
}

__device__ __forceinline__ void phase_attn(const Params& p, int layer, int bid, int nb, char* lds) {
  const int nitems = 512 + (layer == 0 ? 8 : 0);
  const unsigned* kmx = p.kmx() + layer * 32;
  for (int it = bid; it < nitems; it += nb) {
    int b, h, q0, k0, seq, tok0;
    if (it < 512) { const int pair = it & 7, qb = (it >> 3); h = pair & 3; b = pair >> 2; q0 = qb * 256; k0 = 0; seq = SKV; tok0 = b * SEQ + qb * 256; }
    else { const int i2 = it - 512; h = i2 & 3; b = i2 >> 2; q0 = SEQ; k0 = SEQ; seq = LC; tok0 = TL + b * LC; }
    const size_t base = (size_t)(b * 4 + h) * SKV;
    const float k2 = __uint_as_float(kmx[(b * 4 + h) * 4 + 0]) + __uint_as_float(kmx[(b * 4 + h) * 4 + 1]) + __uint_as_float(kmx[b * 16 + 2]);
    attn_item(p.Q() + (base + q0) * 96, p.KV() + (base + k0) * 160, seq, sqrtf(k2) * 1.02f, p.ymix() + (size_t)tok0 * DM + h * 64, lds);
  }
}

__device__ __forceinline__ float hy_sconv(const u16* __restrict__ row, int t, int Ls, float w0, float w1, float w2, float bb) {
  const float zm = t > 0 ? bf2f(row[t - 1]) : 0.f, z0 = bf2f(row[t]), zp = t + 1 < Ls ? bf2f(row[t + 1]) : 0.f;
  return w0 * zm + w1 * z0 + w2 * zp + bb;
}
__device__ __forceinline__ float2 hy_sconv2(unsigned prv, unsigned cur, unsigned nxt, float w0, float w1, float w2, float bb) {
  const float zm = __uint_as_float(prv & 0xFFFF0000u), z0 = __uint_as_float(cur << 16), z1 = __uint_as_float(cur & 0xFFFF0000u), z2 = __uint_as_float(nxt << 16);
  return make_float2(w0 * zm + w1 * z0 + w2 * z1 + bb, w0 * z0 + w1 * z1 + w2 * z2 + bb);
}
__device__ __forceinline__ void hyena_item(const Params& p, int layer, int b, int ch, char* lds) {
  float2* s = (float2*)lds;
  const int tid = ltid();
  const float* cw = p.hy_conv_w() + (size_t)layer * 3 * 768; const float* cb = p.hy_conv_b() + (size_t)layer * 768;
  const unsigned* r0 = (const unsigned*)(p.zt() + (size_t)(ZT_HY + ch) * TT + (size_t)b * SEQ);
  const unsigned* r1 = (const unsigned*)(p.zt() + (size_t)(ZT_HY + 256 + ch) * TT + (size_t)b * SEQ);
  const unsigned* r2 = (const unsigned*)(p.zt() + (size_t)(ZT_HY + 512 + ch) * TT + (size_t)b * SEQ);
  const float a0 = cw[ch], a1 = cw[768 + ch], a2 = cw[1536 + ch], ab = cb[ch];
  const float b0 = cw[256 + ch], b1 = cw[768 + 256 + ch], b2 = cw[1536 + 256 + ch], bb = cb[256 + ch];
  const float c0 = cw[512 + ch], c1 = cw[768 + 512 + ch], c2 = cw[1536 + 512 + ch], cbb = cb[512 + ch];
  unsigned vgr[16], x0r[16];
#pragma unroll
  for (int hb2 = 0; hb2 < 2; ++hb2) {
    unsigned ld[8][9];
#pragma unroll
    for (int ii = 0; ii < 8; ++ii) {
      const int m = tid + 512 * (hb2 * 8 + ii);
      const int mp = m > 0 ? m - 1 : 0, mn = m + 1 < SEQ / 2 ? m + 1 : m;
      ld[ii][0] = r0[mp]; ld[ii][1] = r0[m]; ld[ii][2] = r0[mn];
      ld[ii][3] = r1[mp]; ld[ii][4] = r1[m]; ld[ii][5] = r1[mn];
      ld[ii][6] = r2[mp]; ld[ii][7] = r2[m]; ld[ii][8] = r2[mn];
    }
#pragma unroll
    for (int ii = 0; ii < 8; ++ii) {
      const int i = hb2 * 8 + ii, m = tid + 512 * i;
      const unsigned mkp = m > 0 ? 0xFFFFFFFFu : 0u, mkn = m + 1 < SEQ / 2 ? 0xFFFFFFFFu : 0u;
      const float2 ux = hy_sconv2(ld[ii][0] & mkp, ld[ii][1], ld[ii][2] & mkn, a0, a1, a2, ab);
      x0r[i] = cvtpk(ux.x, ux.y);
      const float2 u1 = hy_sconv2(ld[ii][3] & mkp, ld[ii][4], ld[ii][5] & mkn, b0, b1, b2, bb);
      const float2 uv = hy_sconv2(ld[ii][6] & mkp, ld[ii][7], ld[ii][8] & mkn, c0, c1, c2, cbb);
      const float2 vgf = make_float2(uv.x * u1.x, uv.y * u1.y);
      vgr[i] = cvtpk(vgf.x, vgf.y);
      s[swz(m)] = vgf;
      s[swz(m + SEQ / 2)] = make_float2(0.f, 0.f);
    }
  }
  __syncthreads();
  fft_fwd(s, p.tw());
  {
    const float4* hs = p.hspec() + ((size_t)layer * 256 + ch) * HSP;
    float4 hv[17];
#pragma unroll
    for (int i = 0; i < 17; ++i) { const int k = tid + 512 * i; hv[i] = hs[k <= FM / 2 ? k : 0]; }
    const float2 twl = p.tw()[tid];
#pragma unroll
    for (int i = 0; i < 17; ++i) {
      const int k = tid + 512 * i;
      if (k <= FM / 2) {
        const int pk = swz(rev7(k)), pm = swz(rev7((FM - k) & (FM - 1)));
        const float2 zk = s[pk], zm = s[pm];
        const float4 h = hv[i];
        const float2 He = make_float2(h.x, h.y), Ho = make_float2(h.z, h.w);
        const float2 Xe = make_float2(0.5f * (zk.x + zm.x), 0.5f * (zk.y - zm.y));
        const float2 Xo = make_float2(0.5f * (zk.y + zm.y), -0.5f * (zk.x - zm.x));
        const float2 twk = cmul(twl, p.tw()[512 * i]);
        const float2 t1 = cmul(twk, cmul(Xo, Ho));
        const float2 e1 = cmul(Xe, He);
        const float2 Ye = make_float2(e1.x + t1.x, e1.y + t1.y);
        const float2 o1 = cmul(Xe, Ho), o2 = cmul(Xo, He);
        const float2 Yo = make_float2(o1.x + o2.x, o1.y + o2.y);
        s[pk] = make_float2(Ye.x - Yo.y, Ye.y + Yo.x);
        if (pm != pk) s[pm] = make_float2(Ye.x + Yo.y, -Ye.y + Yo.x);
      }
    }
  }
  __syncthreads();
  fft_inv(s, p.tw());
  const float hb = p.hy_bias()[layer * 256 + ch];
  unsigned* orow = (unsigned*)(p.hyo() + (size_t)ch * TT + (size_t)b * SEQ);
#pragma unroll
  for (int i = 0; i < 16; ++i) {
    const int m = tid + 512 * i;
    const float2 y = s[swz(m)];
    orow[m] = cvtpk((y.x + __uint_as_float(vgr[i] << 16) * hb) * __uint_as_float(x0r[i] << 16), (y.y + __uint_as_float(vgr[i] & 0xFFFF0000u) * hb) * __uint_as_float(x0r[i] & 0xFFFF0000u));
  }
  __syncthreads();
}
__device__ __forceinline__ void fnet_item(const Params& p, int b, int j, char* lds) {
  float2* s = (float2*)lds;
  const int tid = ltid();
  const u16* rr = p.zt() + (size_t)(ZT_FR + j) * TT + (size_t)b * SEQ;
  const u16* ri = p.zt() + (size_t)(ZT_FI + j) * TT + (size_t)b * SEQ;
  {
    u32x4 vr[4], vi[4];
#pragma unroll
    for (int i = 0; i < 4; ++i) { const int m0 = (tid + 512 * i) * 8; vr[i] = *(const u32x4*)(rr + m0); vi[i] = *(const u32x4*)(ri + m0); }
#pragma unroll
    for (int i = 0; i < 4; ++i) {
      const int m0 = (tid + 512 * i) * 8;
#pragma unroll
      for (int q = 0; q < 4; ++q) {
        s[swz(m0 + 2 * q)] = make_float2(__uint_as_float(vr[i][q] << 16), __uint_as_float(vi[i][q] << 16));
        s[swz(m0 + 2 * q + 1)] = make_float2(__uint_as_float(vr[i][q] & 0xFFFF0000u), __uint_as_float(vi[i][q] & 0xFFFF0000u));
      }
    }
  }
  __syncthreads();
  fft_fwd(s, p.tw());
#ifdef PROBE_FFT
  fft_inv(s, p.tw());
  for (int m = tid; m < FM; m += NTHR) { float2 v = s[m]; v.x *= (1.f / 16384.f); v.y *= (1.f / 16384.f); s[m] = v; }
  __syncthreads();
  fft_fwd(s, p.tw());
#endif
  u16* orow = p.fno() + (size_t)j * TT + (size_t)b * SEQ;
#pragma unroll 8
  for (int k = tid; k < FM; k += NTHR) orow[k] = f2bf(s[swz(rev7(k))].x * (1.f / 128.f));
  __syncthreads();
}
__device__ __forceinline__ void hyena_ctx_item(const Params& p, int b, int ch, char* lds) {
  float* vg = (float*)lds;
  float* x0 = vg + 256;
  float* hf = x0 + 256;
  float* hbk = hf + 256;
  const int tid = ltid();
  const float* cw = p.hy_conv_w(); const float* cb = p.hy_conv_b();
  const size_t off = (size_t)TL + (size_t)b * LC;
  const u16* r0 = p.zt() + (size_t)(ZT_HY + ch) * TT + off;
  const u16* r1 = p.zt() + (size_t)(ZT_HY + 256 + ch) * TT + off;
  const u16* r2 = p.zt() + (size_t)(ZT_HY + 512 + ch) * TT + off;
  if (tid < 256) {
    const int t = tid;
    vg[t] = hy_sconv(r2, t, LC, cw[512 + ch], cw[768 + 512 + ch], cw[1536 + 512 + ch], cb[512 + ch]) *
            hy_sconv(r1, t, LC, cw[256 + ch], cw[768 + 256 + ch], cw[1536 + 256 + ch], cb[256 + ch]);
    x0[t] = hy_sconv(r0, t, LC, cw[ch], cw[768 + ch], cw[1536 + ch], cb[ch]);
    hf[t] = p.hfc()[(size_t)ch * LC + t]; hbk[t] = p.hfc()[(size_t)(256 + ch) * LC + t];
  }
  const float ssq_c = filt_ssq(p.hpart() + (size_t)2 * 256 * 512, ch, (float*)(lds + 8192));
  if (tid < 256) {
    const int t = tid; float y = 0;
    for (int q = 0; q <= t; ++q) y += hf[t - q] * vg[q];
    for (int q = t + 1; q < LC; ++q) y += hbk[q - t] * vg[q];
    y *= rsqrtf(ssq_c);
    p.hyo()[(size_t)ch * TT + off + t] = f2bf((y + vg[t] * p.hy_bias()[ch]) * x0[t]);
  }
  __syncthreads();
}
__device__ __forceinline__ void fnet_ctx_item(const Params& p, int b, int j, char* lds) {
  float* ur = (float*)lds; float* ui = ur + 256; float* cst = ui + 256; float* snt = cst + 256;
  const int tid = ltid();
  const size_t off = (size_t)TL + (size_t)b * LC;
  if (tid < 256) {
    ur[tid] = bf2f(p.zt()[(size_t)(ZT_FR + j) * TT + off + tid]); ui[tid] = bf2f(p.zt()[(size_t)(ZT_FI + j) * TT + off + tid]);
    float sn, cs; sincospif((float)tid / 128.f, &sn, &cs); cst[tid] = cs; snt[tid] = sn;
  }
  __syncthreads();
  if (tid < 256) {
    const int k = tid; float y = 0;
    for (int l = 0; l < 256; ++l) { const int m = (l * k) & 255; y += cst[m] * ur[l] + snt[m] * ui[l]; }
    p.fno()[(size_t)j * TT + off + k] = f2bf(y * 0.0625f);
  }
  __syncthreads();
}
__device__ __forceinline__ void phase_fftmix(const Params& p, int layer, int bid, int nb, char* lds) {
  const int nitems = layer == 0 ? 2048 : 1024;
  for (int it = bid; it < nitems; it += nb) {
    const int k = it & 511, b = k >> 8, c = k & 255;
    if (it < 512) hyena_item(p, layer, b, c, lds);
    else if (it < 1024) fnet_item(p, b, c, lds);
    else if (it < 1536) hyena_ctx_item(p, b, c, lds);
    else fnet_ctx_item(p, b, c, lds);
  }
}
constexpr int GLG = 17, NGRP = 16;
__device__ __forceinline__ int gla_chain_tok(int dir, int b, int n, int i) {
  const int base = n < 4 ? TL + b * LC : b * SEQ, len = n < 4 ? LC : SEQ, m = n < 4 ? n : n - 4;
  return dir == 0 ? base + 64 * m + i : base + (len - 1) - (64 * m + i);
}
__device__ __forceinline__ float logsig16(float x) { return (fminf(x, 0.f) - __logf(1.f + __expf(-fabsf(x)))) * (1.f / 16.f); }
__device__ __forceinline__ float wave_scan_incl(float v, int lane) {
#pragma unroll
  for (int o = 1; o < 64; o <<= 1) { const float t = __shfl_up(v, o, 64); if (lane >= o) v += t; }
  return v;
}
__device__ __forceinline__ void phase_gla_a(const Params& p, int layer, int bid, int nb, char* lds) {
  const int tid = ltid(), wid = tid >> 6, lane = tid & 63, r32 = lane & 31, hi = lane >> 5;
  const float* gb = p.gla_gk_b() + (size_t)layer * 256;
  char* wimg = lds + wid * 12288;
  for (int it = bid; it < 16 * NGRP; it += nb) {
    const int chain = it >> 4, g = it & 15, dir = chain >> 3, b = (chain >> 2) & 1, h = chain & 3;
    const int n0 = g * GLG, n1 = min(n0 + GLG, NCH), nch = n1 - n0;
    char* WT = lds + wid * 13824; char* VT = WT + 4608;
    float* dvl = (float*)(lds + 8 * 13824);
#pragma unroll
    for (int c = 0; c < 3; ++c) {
      const int cl = wid + 8 * c;
      if (cl < nch) {
        const int n = n0 + cl;
        {
          const u16* vbase = p.zg() + ZG_GV + h * 64 + lane;
          u16 vv[64];
#pragma unroll
          for (int i = 0; i < 64; ++i) vv[i] = vbase[(size_t)gla_chain_tok(dir, b, n, i) * ZG_W];
#pragma unroll
          for (int q = 0; q < 8; ++q)
            *(u32x4*)(VT + lane * 144 + q * 16) = u32x4{(unsigned)vv[8 * q] | ((unsigned)vv[8 * q + 1] << 16), (unsigned)vv[8 * q + 2] | ((unsigned)vv[8 * q + 3] << 16),
                                                       (unsigned)vv[8 * q + 4] | ((unsigned)vv[8 * q + 5] << 16), (unsigned)vv[8 * q + 6] | ((unsigned)vv[8 * q + 7] << 16)};
        }
        {
          const int kk = lane & 31, hs = lane >> 5;
          const u16* kb = p.zg() + ZG_GK + h * 32 + kk; const u16* gbp = p.zg() + ZG_GP + dir * 128 + h * 32 + kk;
          const float bias = gb[dir * 128 + h * 32 + kk];
          float bc[32], kf[32];
#pragma unroll
          for (int i = 0; i < 32; ++i) {
            const size_t ro = (size_t)gla_chain_tok(dir, b, n, hs * 32 + i) * ZG_W;
            kf[i] = bf2f(kb[ro]); bc[i] = bf2f(gbp[ro]);
          }
          float run = 0.f;
#pragma unroll
          for (int i = 0; i < 32; ++i) { const float x = bc[i] + bias; run += (fminf(x, 0.f) - __logf(1.f + __expf(-fabsf(x)))) * (1.f / 16.f); bc[i] = run; }
          const float lowtot = __shfl(run, kk, 64);
          const float uptot = __shfl(run, 32 + kk, 64);
          const float bl = lowtot + uptot, off = hs ? lowtot : 0.f;
          unsigned wp[16];
#pragma unroll
          for (int i = 0; i < 16; ++i) wp[i] = cvtpk(kf[2 * i] * __expf(bl - (bc[2 * i] + off)), kf[2 * i + 1] * __expf(bl - (bc[2 * i + 1] + off)));
#pragma unroll
          for (int q = 0; q < 4; ++q) *(u32x4*)(WT + kk * 144 + hs * 64 + q * 16) = u32x4{wp[4 * q], wp[4 * q + 1], wp[4 * q + 2], wp[4 * q + 3]};
          if (hs == 0) dvl[cl * 32 + kk] = __expf(bl);
        }
        asm volatile("s_waitcnt lgkmcnt(0)" ::: "memory");
        f32x16 d0 = {}, d1 = {};
#pragma unroll
        for (int s4 = 0; s4 < 4; ++s4) {
          const bf16x8 af = *(const bf16x8*)(WT + r32 * 144 + (16 * s4 + 8 * hi) * 2);
          const bf16x8 v0 = *(const bf16x8*)(VT + r32 * 144 + (16 * s4 + 8 * hi) * 2);
          const bf16x8 v1 = *(const bf16x8*)(VT + (32 + r32) * 144 + (16 * s4 + 8 * hi) * 2);
          d0 = __builtin_amdgcn_mfma_f32_32x32x16_bf16(af, v0, d0, 0, 0, 0);
          d1 = __builtin_amdgcn_mfma_f32_32x32x16_bf16(af, v1, d1, 0, 0, 0);
        }
        asm volatile("s_waitcnt lgkmcnt(0)" ::: "memory");
        {
          float* dg = p.gds() + ((size_t)chain * NCH + n) * 2048;
#pragma unroll
          for (int r = 0; r < 16; ++r) { dg[crow(r, hi) * 64 + r32] = d0[r]; dg[crow(r, hi) * 64 + 32 + r32] = d1[r]; }
        }
      }
      __builtin_amdgcn_sched_barrier(0);
    }
    __syncthreads();
    {
      const int kk = tid >> 4, v0 = (tid & 15) * 4;
      float st[4] = {0.f, 0.f, 0.f, 0.f}; float dcum = 1.f;
      float* gp0 = p.gds() + ((size_t)chain * NCH + n0) * 2048 + kk * 64 + v0;
      float4 av[GLG];
#pragma unroll
      for (int cl = 0; cl < GLG; ++cl) av[cl] = *(const float4*)(gp0 + (size_t)(cl < nch ? cl : 0) * 2048);
#pragma unroll
      for (int cl = 0; cl < GLG; ++cl) {
        if (cl < nch) {
          const float d = dvl[cl * 32 + kk];
          *(float4*)(gp0 + (size_t)cl * 2048) = make_float4(st[0], st[1], st[2], st[3]);
          if ((tid & 15) == 0) p.gdv()[((size_t)chain * NCH + n0 + cl) * 32 + kk] = dcum;
          st[0] = st[0] * d + av[cl].x; st[1] = st[1] * d + av[cl].y; st[2] = st[2] * d + av[cl].z; st[3] = st[3] * d + av[cl].w;
          dcum *= d;
        }
      }
      float* at = p.gst() + ((size_t)chain * NGRP + g) * 2048 + kk * 64 + v0;
      *(float4*)at = make_float4(st[0], st[1], st[2], st[3]);
      if ((tid & 15) == 0) p.gst()[(size_t)16 * NGRP * 2048 + ((size_t)chain * NGRP + g) * 32 + kk] = dcum;
    }
    __syncthreads();
  }
}

constexpr int GC_QP = 33792, GC_KP = GC_QP + 10240, GC_VT = GC_KP + 10240, GC_ST = GC_VT + 18432, GC_AX = GC_ST + 10240;
__device__ __forceinline__ void phase_gla_c(const Params& p, int layer, int bid, int nb, char* lds) {
  float* gl = (float*)lds;
  float* qraw = gl + 2 * 64 * 33;
  float* kraw = qraw + 64 * 33;
  float* Of = (float*)lds;
  char* Qp = lds + GC_QP;
  char* Kp = lds + GC_KP;
  char* VT = lds + GC_VT;
  char* ST = lds + GC_ST;
  const int tid = ltid(), wid = tid >> 6, lane = tid & 63, r32 = lane & 31, hi = lane >> 5;
  char* Ax = lds + GC_AX + wid * 4608;
  const float* gb = p.gla_gk_b() + (size_t)layer * 256;
  const int pc_lo = layer == 0 ? 0 : 4, npc = NCH - pc_lo, nitem = 8 * npc;
  const int per = (nitem + nb - 1) / nb, q_beg = bid * per, q_end = min(nitem, q_beg + per);
  const int sdir = tid >> 8, sk = (tid >> 3) & 31, sv0 = (tid & 7) * 8;
  float G[8]; int g_cached = -1, bh_cached = -1;
  const int lpos = tid >> 3, lc4 = (tid & 7) * 4;
  u32x2 rq, rk, rg0, rg1, rva, rvb; float4 pl0, pl1; float pdp;
#define GC_ITEM(q_, bh_, pc_, b_, h_, tok0_) const int bh_ = (q_) / npc, pc_ = pc_lo + (q_) % npc, b_ = bh_ >> 2, h_ = bh_ & 3; \
    const int tok0_ = pc_ < 4 ? TL + b_ * LC + pc_ * 64 : b_ * SEQ + (pc_ - 4) * 64
#define GC_LOADRAW(tok0_, h_) do { const u16* zr = p.zg() + (size_t)((tok0_) + lpos) * ZG_W; \
    rq = *(const u32x2*)(zr + ZG_GQ + (h_) * 32 + lc4); rk = *(const u32x2*)(zr + ZG_GK + (h_) * 32 + lc4); \
    rg0 = *(const u32x2*)(zr + ZG_GP + (h_) * 32 + lc4); rg1 = *(const u32x2*)(zr + ZG_GP + 128 + (h_) * 32 + lc4); \
    rva = *(const u32x2*)(zr + ZG_GV + (h_) * 64 + lc4 * 2); rvb = *(const u32x2*)(zr + ZG_GV + (h_) * 64 + lc4 * 2 + 4); } while (0)
#define GC_LOADST(pc_, b_, h_) do { const int chain_ = sdir * 8 + (b_) * 4 + (h_); \
    const int n_ = sdir == 0 ? (pc_) : ((pc_) < 4 ? 3 - (pc_) : 4 + 255 - ((pc_) - 4)); \
    const float* lp_ = p.gds() + ((size_t)chain_ * NCH + n_) * 2048 + sk * 64 + sv0; \
    pl0 = *(const float4*)lp_; pl1 = *(const float4*)(lp_ + 4); pdp = p.gdv()[((size_t)chain_ * NCH + n_) * 32 + sk]; } while (0)
  if (q_beg < q_end) { GC_ITEM(q_beg, bh0, pc0, b0, h0, t00); GC_LOADRAW(t00, h0); GC_LOADST(pc0, b0, h0); }
  for (int qi = q_beg; qi < q_end; ++qi) {
    GC_ITEM(qi, bh, pc, b, h, tok0);
    {
      const int pos = lpos, c4 = lc4;
      const float sc = 0.17677669529663687f;
      qraw[pos * 33 + c4] = BF_LO(rq[0]) * sc; qraw[pos * 33 + c4 + 1] = BF_HI(rq[0]) * sc; qraw[pos * 33 + c4 + 2] = BF_LO(rq[1]) * sc; qraw[pos * 33 + c4 + 3] = BF_HI(rq[1]) * sc;
      kraw[pos * 33 + c4] = BF_LO(rk[0]); kraw[pos * 33 + c4 + 1] = BF_HI(rk[0]); kraw[pos * 33 + c4 + 2] = BF_LO(rk[1]); kraw[pos * 33 + c4 + 3] = BF_HI(rk[1]);
#pragma unroll
      for (int d = 0; d < 2; ++d) {
        const u32x2 rg = d ? rg1 : rg0; const float4 bb = *(const float4*)(gb + d * 128 + h * 32 + c4);
        const int i = d ? 63 - pos : pos;
        float* gd = gl + (d * 64 + i) * 33 + c4;
        gd[0] = logsig16(BF_LO(rg[0]) + bb.x); gd[1] = logsig16(BF_HI(rg[0]) + bb.y); gd[2] = logsig16(BF_LO(rg[1]) + bb.z); gd[3] = logsig16(BF_HI(rg[1]) + bb.w);
      }
#pragma unroll
      for (int j = 0; j < 4; ++j) {
        const unsigned w = j < 2 ? rva[j] : rvb[j - 2]; const int v = c4 * 2 + 2 * j;
        *(u16*)(VT + (0 * 64 + v) * 144 + pos * 2) = (u16)(w & 0xFFFFu); *(u16*)(VT + (1 * 64 + v) * 144 + (63 - pos) * 2) = (u16)(w & 0xFFFFu);
        *(u16*)(VT + (0 * 64 + v + 1) * 144 + pos * 2) = (u16)(w >> 16); *(u16*)(VT + (1 * 64 + v + 1) * 144 + (63 - pos) * 2) = (u16)(w >> 16);
      }
    }
    if (qi + 1 < q_end) { GC_ITEM(qi + 1, bhn, pcn, bn, hn, t0n); GC_LOADRAW(t0n, hn); }
    __syncthreads();
    {
      const int col = tid & 63, d = col >> 5, c = col & 31, part = tid >> 6;
      float* ptot = (float*)(lds + GC_AX);
      float bv[8]; float run = 0.f;
#pragma unroll
      for (int j = 0; j < 8; ++j) { run += gl[(d * 64 + part * 8 + j) * 33 + c]; bv[j] = run; }
      ptot[part * 64 + col] = run;
      __syncthreads();
      float off = 0.f;
#pragma unroll
      for (int q = 0; q < 7; ++q) off += (q < part) ? ptot[q * 64 + col] : 0.f;
#pragma unroll
      for (int j = 0; j < 8; ++j) gl[(d * 64 + part * 8 + j) * 33 + c] = bv[j] + off;
    }
    __syncthreads();
    {
#pragma unroll
      for (int e = 0; e < 2; ++e) {
        const int idx = tid + e * 512, d = idx >> 9, i = (idx >> 3) & 63, c4 = (idx & 7) * 4, pos = d ? 63 - i : i;
        float qo[4], ko[4];
#pragma unroll
        for (int j = 0; j < 4; ++j) {
          const float bi = gl[(d * 64 + i) * 33 + c4 + j], bm = gl[(d * 64 + 31) * 33 + c4 + j];
          qo[j] = qraw[pos * 33 + c4 + j] * __expf(bi - bm); ko[j] = kraw[pos * 33 + c4 + j] * __expf(bm - bi);
        }
        *(u32x2*)(Qp + (d * 64 + i) * 80 + c4 * 2) = u32x2{cvtpk(qo[0], qo[1]), cvtpk(qo[2], qo[3])};
        *(u32x2*)(Kp + (d * 64 + i) * 80 + c4 * 2) = u32x2{cvtpk(ko[0], ko[1]), cvtpk(ko[2], ko[3])};
      }
      const int chain = sdir * 8 + b * 4 + h;
      const int n = sdir == 0 ? pc : (pc < 4 ? 3 - pc : 4 + 255 - (pc - 4)), g = n / GLG;
      if (g != g_cached || bh != bh_cached) {
#pragma unroll
        for (int j = 0; j < 8; ++j) G[j] = 0.f;
        const float* at = p.gst() + (size_t)chain * NGRP * 2048 + sk * 64 + sv0;
        const float* dt = p.gst() + (size_t)16 * NGRP * 2048 + (size_t)chain * NGRP * 32 + sk;
        for (int gg = 0; gg < g; ++gg) {
          const float4 a0 = *(const float4*)(at + (size_t)gg * 2048), a1 = *(const float4*)(at + (size_t)gg * 2048 + 4); const float dd = dt[gg * 32];
          G[0] = G[0] * dd + a0.x; G[1] = G[1] * dd + a0.y; G[2] = G[2] * dd + a0.z; G[3] = G[3] * dd + a0.w;
          G[4] = G[4] * dd + a1.x; G[5] = G[5] * dd + a1.y; G[6] = G[6] * dd + a1.z; G[7] = G[7] * dd + a1.w;
        }
        g_cached = g; bh_cached = bh;
      }
      const float4 l0 = pl0, l1 = pl1; const float dp = pdp;
      const float em = __expf(gl[(sdir * 64 + 31) * 33 + sk]);
      const float sv[8] = {l0.x + dp * G[0], l0.y + dp * G[1], l0.z + dp * G[2], l0.w + dp * G[3], l1.x + dp * G[4], l1.y + dp * G[5], l1.z + dp * G[6], l1.w + dp * G[7]};
      if (qi + 1 < q_end) { GC_ITEM(qi + 1, bhn, pcn, bn, hn, t0n); (void)bhn; (void)t0n; GC_LOADST(pcn, bn, hn); }
#pragma unroll
      for (int j = 0; j < 8; ++j) *(u16*)(ST + (sdir * 64 + sv0 + j) * 80 + sk * 2) = f2bf(sv[j] * em);
    }
    __syncthreads();
    {
      const int d = wid >> 2, ib = (wid >> 1) & 1, vb = wid & 1;
      const char* Qd = Qp + d * 64 * 80; const char* Kd = Kp + d * 64 * 80; const char* Vd = VT + d * 64 * 144; const char* Sd = ST + d * 64 * 80;
      bf16x8 qf[2];
#pragma unroll
      for (int s2 = 0; s2 < 2; ++s2) qf[s2] = *(const bf16x8*)(Qd + (ib * 32 + r32) * 80 + (16 * s2 + 8 * hi) * 2);
#pragma unroll
      for (int jb = 0; jb < 2; ++jb) {
        if (jb <= ib) {
          f32x16 x = {};
#pragma unroll
          for (int s2 = 0; s2 < 2; ++s2) {
            const bf16x8 kf = *(const bf16x8*)(Kd + (jb * 32 + r32) * 80 + (16 * s2 + 8 * hi) * 2);
            x = __builtin_amdgcn_mfma_f32_32x32x16_bf16(qf[s2], kf, x, 0, 0, 0);
          }
#pragma unroll
          for (int r = 0; r < 16; ++r) {
            const int il = crow(r, hi), i = ib * 32 + il, j = jb * 32 + r32;
            *(u16*)(Ax + il * 144 + j * 2) = f2bf(j <= i ? x[r] : 0.f);
          }
        }
      }
      asm volatile("s_waitcnt lgkmcnt(0)" ::: "memory");
      f32x16 o = {};
#pragma unroll
      for (int s4 = 0; s4 < 4; ++s4) {
        if (s4 < 2 * (ib + 1)) {
          const bf16x8 af = *(const bf16x8*)(Ax + r32 * 144 + (16 * s4 + 8 * hi) * 2);
          const bf16x8 vf = *(const bf16x8*)(Vd + (vb * 32 + r32) * 144 + (16 * s4 + 8 * hi) * 2);
          o = __builtin_amdgcn_mfma_f32_32x32x16_bf16(af, vf, o, 0, 0, 0);
        }
      }
#pragma unroll
      for (int s2 = 0; s2 < 2; ++s2) {
        const bf16x8 sf = *(const bf16x8*)(Sd + (vb * 32 + r32) * 80 + (16 * s2 + 8 * hi) * 2);
        o = __builtin_amdgcn_mfma_f32_32x32x16_bf16(qf[s2], sf, o, 0, 0, 0);
      }
#pragma unroll
      for (int r = 0; r < 16; ++r) {
        const int i = ib * 32 + crow(r, hi), pos = d ? 63 - i : i;
        Of[(d * 64 + pos) * 65 + vb * 32 + r32] = o[r];
      }
    }
    __syncthreads();
    {
      const int pos = tid >> 3, v0 = (tid & 7) * 8;
      float r8[8]; float ss = 0.f;
#pragma unroll
      for (int j = 0; j < 8; ++j) { r8[j] = Of[pos * 65 + v0 + j] + Of[(64 + pos) * 65 + v0 + j]; ss += r8[j] * r8[j]; }
      ss += shx<4>(ss); ss += shx<2>(ss); ss += shx<1>(ss);
      const float rs = rsqrtf(ss * (1.f / 64.f) + EPS);
      const u16* og = p.zg() + (size_t)(tok0 + pos) * ZG_W + ZG_OG + h * 64 + v0;
      const float4 g0 = ld4bf(og), g1 = ld4bf(og + 4);
      *(u32x4*)(p.ymix() + (size_t)(tok0 + pos) * DM + 512 + h * 64 + v0) =
          u32x4{cvtpk(r8[0] * rs * silu_f(g0.x), r8[1] * rs * silu_f(g0.y)), cvtpk(r8[2] * rs * silu_f(g0.z), r8[3] * rs * silu_f(g0.w)),
                cvtpk(r8[4] * rs * silu_f(g1.x), r8[5] * rs * silu_f(g1.y)), cvtpk(r8[6] * rs * silu_f(g1.z), r8[7] * rs * silu_f(g1.w))};
    }
    __syncthreads();
  }
}

__device__ __forceinline__ void phase_mix(const Params& p, int layer, int bid, int nb, char* lds) {
  float* part = (float*)lds;
  u16* tile = (u16*)(lds + 4096);
  const int tid = ltid(), wid = tid >> 6, lane = tid & 63;
  const int ntok = layer == 0 ? TT : TL;
  for (int it = bid; it < ntok / 64; it += nb) {
    const int tok0 = it * 64;
    float vh[32], vf[32]; float sh = 0, sf = 0;
#pragma unroll
    for (int c = 0; c < 32; ++c) {
      vh[c] = bf2f(p.hyo()[(size_t)(wid * 32 + c) * TT + tok0 + lane]); vf[c] = bf2f(p.fno()[(size_t)(wid * 32 + c) * TT + tok0 + lane]);
      sh += vh[c] * vh[c]; sf += vf[c] * vf[c];
    }
    part[(0 * 8 + wid) * 64 + lane] = sh; part[(1 * 8 + wid) * 64 + lane] = sf;
    __syncthreads();
    float th = 0, tf = 0;
#pragma unroll
    for (int q = 0; q < 8; ++q) { th += part[(0 * 8 + q) * 64 + lane]; tf += part[(1 * 8 + q) * 64 + lane]; }
    const float rh = rsqrtf(th * (1.f / 256.f) + EPS), rf = rsqrtf(tf * (1.f / 256.f) + EPS);
#pragma unroll
    for (int c = 0; c < 32; ++c) { tile[lane * 520 + wid * 32 + c] = f2bf(vh[c] * rh); tile[lane * 520 + 256 + wid * 32 + c] = f2bf(vf[c] * rf); }
    __syncthreads();
    for (int g = tid; g < 64 * 64; g += NTHR) {
      const int tl = g >> 6, cg = g & 63;
      const u32x4 w = *(const u32x4*)(tile + tl * 520 + cg * 8);
      *(u32x4*)(p.ymix() + (size_t)(tok0 + tl) * DM + (cg < 32 ? 256 + cg * 8 : 768 + (cg - 32) * 8)) = w;
    }
    __syncthreads();
  }
}

struct EpiOut {
  const Params* pp; int layer;
  __device__ __forceinline__ void pre(const G8Unit& u, int, int, float (&)[8], float* cb) const {
    if ((ltid() >> 6) == 0) g8_cload(pp->mod() + ((size_t)layer * 3 + modv(u.pm * 256)) * 6144 + 2 * DM + u.pn * 256, cb);
  }
  __device__ __forceinline__ void operator()(const f32x4 (&acc)[2][2][4][2], const G8Unit& u, int wr, int wc, int fr, int fq, const float (&)[8], const float* cb) const {
    const Params& p = *pp;
#pragma unroll
    for (int bj = 0; bj < 2; ++bj) {
      const int c0 = u.pn * 256 + bj * 128 + wc * 32 + 8 * fq;
      const f32x4 ga = *(const f32x4*)(cb + bj * 128 + wc * 32 + 8 * fq), gb = *(const f32x4*)(cb + bj * 128 + wc * 32 + 8 * fq + 4);
#pragma unroll
      for (int ai = 0; ai < 2; ++ai)
#pragma unroll
        for (int m = 0; m < 4; ++m) {
          const int tok = u.pm * 256 + ai * 128 + wr * 64 + m * 16 + fr;
          u16* xo = p.X() + (size_t)tok * DM + c0;
          f32x4 xa, xb;
          if (layer == 0) { const float* xr = resid_row_in(p, tok) + c0; xa = *(const f32x4*)xr; xb = *(const f32x4*)(xr + 4); }
          else { const u32x4 w = *(const u32x4*)xo;
            xa = f32x4{__uint_as_float(w[0] << 16), __uint_as_float(w[0] & 0xFFFF0000u), __uint_as_float(w[1] << 16), __uint_as_float(w[1] & 0xFFFF0000u)};
            xb = f32x4{__uint_as_float(w[2] << 16), __uint_as_float(w[2] & 0xFFFF0000u), __uint_as_float(w[3] << 16), __uint_as_float(w[3] & 0xFFFF0000u)}; }
          xa = xa + ga * acc[ai][bj][m][0]; xb = xb + gb * acc[ai][bj][m][1];
          *(u32x4*)xo = u32x4{cvtpk(xa[0], xa[1]), cvtpk(xa[2], xa[3]), cvtpk(xb[0], xb[1]), cvtpk(xb[2], xb[3])};
        }
    }
  }
};
__device__ __forceinline__ void phase_gemm_out(const Params& p, int layer, int bid, int nb, char* lds) {
  G8Plain S; S.nM = (layer == 0 ? TT : TL) / 256; S.nN = DM / 256; S.Kb = 2 * DM; S.G = nb; S.c = bid; S.Bt = (const char*)(p.bt_out() + (size_t)layer * DM * DM);
  EpiOut E; E.pp = &p; E.layer = layer;
  gemm8_phase<false>(lds, (const char*)p.ymix(), 2 * DM, S, E);
}

__device__ __forceinline__ void phase_norm2_router(const Params& p, int layer, int bid, int nb, char* lds) {
  float* rwl = (float*)lds;
  int* lcnt = (int*)(lds + 131072);
  int* lbase = lcnt + 32;
  int* ent = lbase + 32;
  float* entw = (float*)(ent + 2 * 640);
  float* ents = entw + 640;
  const int tid = ltid(), wid = tid >> 6, lane = tid & 63;
  const int ntok = layer == 0 ? TT : TL;
  const float* rw = p.router_w() + (size_t)layer * DM * NE;
  for (int i = tid; i < DM * NE / 4; i += NTHR) {
    const int k = i >> 3, q4 = i & 7;
    ((float4*)rwl)[q4 * 1024 + ((k & 3) * 256 + (k >> 2))] = ((const float4*)rw)[i];
  }
  if (tid < 32) lcnt[tid] = 0;
  __syncthreads();
  const float* gn = p.norm2_g() + layer * DM; const float* rb = p.router_b() + layer * NE;
  const int per = (ntok + nb - 1) / nb, t_beg = bid * per, t_end = min(ntok, t_beg + per);
  for (int tok = t_beg + wid; tok < t_end; tok += 8) {
    const u16* xr = p.X() + (size_t)tok * DM;
    float v[16];
#pragma unroll
    for (int i = 0; i < 4; ++i) { const float4 a = ld4bf(xr + lane * 4 + i * 256); v[4 * i] = a.x; v[4 * i + 1] = a.y; v[4 * i + 2] = a.z; v[4 * i + 3] = a.w; }
    float ss = 0;
#pragma unroll
    for (int i = 0; i < 16; ++i) ss += v[i] * v[i];
    ss = wave_sum(ss);
    const float rs = rsqrtf(ss * (1.f / DM) + EPS);
    const float* md = p.mod() + ((size_t)layer * 3 + modv(tok)) * 6144 + 3 * DM;
#pragma unroll
    for (int i = 0; i < 4; ++i) {
      const int c = lane * 4 + i * 256;
      const float4 g = *(const float4*)(gn + c), sh = *(const float4*)(md + c), sc = *(const float4*)(md + DM + c);
      v[4 * i] = v[4 * i] * rs * g.x * (1.f + sc.x) + sh.x; v[4 * i + 1] = v[4 * i + 1] * rs * g.y * (1.f + sc.y) + sh.y;
      v[4 * i + 2] = v[4 * i + 2] * rs * g.z * (1.f + sc.z) + sh.z; v[4 * i + 3] = v[4 * i + 3] * rs * g.w * (1.f + sc.w) + sh.w;
    }
    const float rowsc = store_row_i8(v, p.H() + (size_t)tok * DM, p.hs() + tok, lane);
    float lg[32];
#pragma unroll
    for (int e = 0; e < 32; ++e) lg[e] = 0.f;
#pragma unroll
    for (int i = 0; i < 16; ++i) {
      const float4* wr4 = (const float4*)rwl + ((i & 3) * 256 + (i >> 2) * 64 + lane);
#pragma unroll
      for (int q = 0; q < 8; ++q) { const float4 w = wr4[q * 1024]; lg[4 * q] += v[i] * w.x; lg[4 * q + 1] += v[i] * w.y; lg[4 * q + 2] += v[i] * w.z; lg[4 * q + 3] += v[i] * w.w; }
    }
    float r16[16], r8[8], r4[4], r2[2], lv;
    { const bool up = lane & 32;
#pragma unroll
      for (int e = 0; e < 16; ++e) { const float keep = up ? lg[16 + e] : lg[e], send = up ? lg[e] : lg[16 + e]; r16[e] = keep + shx<32>(send); } }
    { const bool up = lane & 16;
#pragma unroll
      for (int e = 0; e < 8; ++e) { const float keep = up ? r16[8 + e] : r16[e], send = up ? r16[e] : r16[8 + e]; r8[e] = keep + shx<16>(send); } }
    { const bool up = lane & 8;
#pragma unroll
      for (int e = 0; e < 4; ++e) { const float keep = up ? r8[4 + e] : r8[e], send = up ? r8[e] : r8[4 + e]; r4[e] = keep + shx<8>(send); } }
    { const bool up = lane & 4;
#pragma unroll
      for (int e = 0; e < 2; ++e) { const float keep = up ? r4[2 + e] : r4[e], send = up ? r4[e] : r4[2 + e]; r2[e] = keep + shx<4>(send); } }
    { const bool up = lane & 2; const float keep = up ? r2[1] : r2[0], send = up ? r2[0] : r2[1]; lv = keep + shx<2>(send); }
    lv += shx<1>(lv);
    lv += rb[lane >> 1];
    int ids[4]; float vals[4];
#pragma unroll
    for (int k = 0; k < 4; ++k) {
      const float mx = wave_max(lv);
      const unsigned long long bal = __ballot(lv == mx);
      const int win = __ffsll((long long)bal) - 1;
      ids[k] = win >> 1; vals[k] = mx;
      if ((lane >> 1) == ids[k]) lv = -3.4e38f;
    }
    if (lane == 0) {
      const float mx = vals[0];
      float ex[4], sum = 0;
#pragma unroll
      for (int k = 0; k < 4; ++k) { ex[k] = __expf(vals[k] - mx); sum += ex[k]; }
      const float inv = 1.f / sum;
#pragma unroll
      for (int k = 0; k < 4; ++k) {
        const int lp = atomicAdd(&lcnt[ids[k]], 1);
        const int slot = (tok - t_beg) * 4 + k;
        ent[2 * slot] = tok * 4 + k; ent[2 * slot + 1] = (ids[k] << 20) | lp; entw[slot] = ex[k] * inv; ents[slot] = rowsc;
      }
    }
  }
  __syncthreads();
  if (tid < 32) lbase[tid] = atomicAdd(&p.cnt()[layer * NE + tid], lcnt[tid]);
  __syncthreads();
  const int nas = (t_end > t_beg ? (t_end - t_beg) : 0) * 4;
  for (int s = tid; s < nas; s += NTHR) {
    const int tk = ent[2 * s], el = ent[2 * s + 1], e = el >> 20, pos = lbase[e] + (el & 0xFFFFF);
    p.rtok()[(size_t)e * TT + pos] = tk >> 2; p.rw()[(size_t)e * TT + pos] = entw[s]; p.rsc()[(size_t)e * TT + pos] = ents[s];
    p.tslot()[tk] = (e << 20) | pos;
  }
}

struct G8Moe {
  const int* cnt;
  int ntn, Kb, G, c; const char* Bt; size_t bstride;
  const int* rtok;
  __device__ __forceinline__ bool next(int i, G8Unit& u) const {
    const int w = (i * 8 + (c & 7)) * (G >> 3) + (c >> 3); int acc = 0, rows = 0;
    for (int ee = 0; ee < NE; ++ee) {
      const int cc = cnt[ee], tiles = ((cc + 255) >> 8) * ntn;
      if (w < acc + tiles) { const int r = w - acc; u.e = ee; u.pm = r / ntn; u.pn = r % ntn; u.ce = cc; u.pre = rows; return true; }
      acc += tiles; rows += cc;
    }
    return false;
  }
  __device__ __forceinline__ unsigned a_off(const G8Unit& u, int row) const {
    const int r = min(u.pm * 256 + row, u.ce - 1);
    const int arow = rtok ? rtok[(size_t)u.e * TT + r] : u.pre + r;
    return (unsigned)arow * (unsigned)Kb;
  }
  __device__ __forceinline__ const char* b_ptr(const G8Unit& u) const { return Bt + (size_t)u.e * bstride + (size_t)u.pn * 256 * Kb; }
};
struct EpiGu {
  const float* bgl; u16* act; const float* rsc; const float* swl;
  __device__ __forceinline__ void pre(const G8Unit& u, int wr, int fr, float (&ep)[8], float* cb) const {
    if ((ltid() >> 6) == 0) g8_cload(bgl + (size_t)u.e * 2048 + u.pn * 256, cb);
    if ((ltid() >> 6) == 1) g8_cload(swl + (size_t)u.e * 2048 + u.pn * 256, cb + 256);
#pragma unroll
    for (int ai = 0; ai < 2; ++ai)
#pragma unroll
      for (int m = 0; m < 4; ++m) ep[ai * 4 + m] = rsc[(size_t)u.e * TT + min(u.pm * 256 + ai * 128 + wr * 64 + m * 16 + fr, u.ce - 1)];
  }
  __device__ __forceinline__ void operator()(const i32x4 (&acc)[2][2][4][2], const G8Unit& u, int wr, int wc, int fr, int fq, const float (&ep)[8], const float* cb) const {
    const int j0 = u.pn * 128 + wc * 32 + 8 * fq;
    const float* bg = cb + 2 * (wc * 32 + 8 * fq);
    float bgt[8], bup[8], sg[8], su[8];
#pragma unroll
    for (int q = 0; q < 4; ++q) { const f32x4 t = *(const f32x4*)(bg + 4 * q); bgt[2 * q] = t[0]; bup[2 * q] = t[1]; bgt[2 * q + 1] = t[2]; bup[2 * q + 1] = t[3]; }
    {
      const float* sp = cb + 256 + wc * 32 + 8 * fq;
      const f32x4 g0 = *(const f32x4*)sp, g1 = *(const f32x4*)(sp + 4), u0 = *(const f32x4*)(sp + 128), u1 = *(const f32x4*)(sp + 132);
#pragma unroll
      for (int j = 0; j < 4; ++j) { sg[j] = g0[j]; sg[4 + j] = g1[j]; su[j] = u0[j]; su[4 + j] = u1[j]; }
    }
#pragma unroll
    for (int ai = 0; ai < 2; ++ai)
#pragma unroll
      for (int m = 0; m < 4; ++m) {
        const int r = u.pm * 256 + ai * 128 + wr * 64 + m * 16 + fr;
        if (r < u.ce) {
          const float sa = ep[ai * 4 + m];
          float o[8];
#pragma unroll
          for (int n = 0; n < 2; ++n)
#pragma unroll
            for (int j = 0; j < 4; ++j) {
              const float gate = fminf((float)acc[ai][0][m][n][j] * sa * sg[4 * n + j] + bgt[4 * n + j], 7.f);
              const float up = fminf(fmaxf((float)acc[ai][1][m][n][j] * sa * su[4 * n + j] + bup[4 * n + j], -7.f), 7.f);
              o[4 * n + j] = (up + 1.f) * gate * __builtin_amdgcn_rcpf(1.f + __expf(-1.702f * gate));
            }
          *(u32x4*)(act + (size_t)(u.pre + r) * DFF + j0) = u32x4{cvtpk(o[0], o[1]), cvtpk(o[2], o[3]), cvtpk(o[4], o[5]), cvtpk(o[6], o[7])};
        }
      }
  }
};
struct EpiDn {
  const float* bdl; const float* rw; unsigned char* yd;
  __device__ __forceinline__ void pre(const G8Unit& u, int wr, int fr, float (&ep)[8], float* cb) const {
    if ((ltid() >> 6) == 0) g8_cload(bdl + (size_t)u.e * DM + u.pn * 256, cb);
#pragma unroll
    for (int ai = 0; ai < 2; ++ai)
#pragma unroll
      for (int m = 0; m < 4; ++m) ep[ai * 4 + m] = rw[(size_t)u.e * TT + min(u.pm * 256 + ai * 128 + wr * 64 + m * 16 + fr, u.ce - 1)];
  }
  __device__ __forceinline__ void operator()(const f32x4 (&acc)[2][2][4][2], const G8Unit& u, int wr, int wc, int fr, int fq, const float (&ep)[8], const float* cb) const {
#pragma unroll
    for (int bj = 0; bj < 2; ++bj) {
      const int c0 = u.pn * 256 + bj * 128 + wc * 32 + 8 * fq;
      const f32x4 ba = *(const f32x4*)(cb + bj * 128 + wc * 32 + 8 * fq), bb = *(const f32x4*)(cb + bj * 128 + wc * 32 + 8 * fq + 4);
#pragma unroll
      for (int ai = 0; ai < 2; ++ai)
#pragma unroll
        for (int m = 0; m < 4; ++m) {
          const int r = u.pm * 256 + ai * 128 + wr * 64 + m * 16 + fr;
          if (r < u.ce) {
            const float wgt = ep[ai * 4 + m];
            const float w8 = wgt * 8.f;
            f32x4 a = (acc[ai][bj][m][0] + ba) * w8, b = (acc[ai][bj][m][1] + bb) * w8;
#pragma unroll
            for (int j = 0; j < 4; ++j) { a[j] = fminf(fmaxf(a[j], -440.f), 440.f); b[j] = fminf(fmaxf(b[j], -440.f), 440.f); }
            int w0 = 0, w1 = 0;
            w0 = __builtin_amdgcn_cvt_pk_fp8_f32(a[0], a[1], w0, false); w0 = __builtin_amdgcn_cvt_pk_fp8_f32(a[2], a[3], w0, true);
            w1 = __builtin_amdgcn_cvt_pk_fp8_f32(b[0], b[1], w1, false); w1 = __builtin_amdgcn_cvt_pk_fp8_f32(b[2], b[3], w1, true);
            *(u32x2*)(yd + (size_t)(u.pre + r) * DM + c0) = u32x2{(unsigned)w0, (unsigned)w1};
          }
        }
    }
  }
};
__device__ __forceinline__ void phase_moe_gu(const Params& p, int layer, int bid, int nb, char* lds) {
  int* scnt = (int*)(lds + 131072);
  if (ltid() < NE) scnt[ltid()] = p.cnt()[layer * NE + ltid()];
  __syncthreads();
  G8Moe S; S.cnt = scnt; S.ntn = 8; S.Kb = DM; S.G = nb; S.c = bid; S.Bt = (const char*)(p.bt_gu() + (size_t)layer * NE * 2048 * DM); S.bstride = (size_t)2048 * DM; S.rtok = p.rtok();
  EpiGu E; E.bgl = p.moe_b_gu() + (size_t)layer * NE * 2048; E.act = p.act(); E.rsc = p.rsc(); E.swl = p.swgu() + (size_t)layer * NE * 2048;
  gemm8_phase<true>(lds, (const char*)p.H(), DM, S, E);
}
__device__ __forceinline__ void phase_moe_dn(const Params& p, int layer, int bid, int nb, char* lds) {
  int* scnt = (int*)(lds + 131072);
  if (ltid() < NE) scnt[ltid()] = p.cnt()[layer * NE + ltid()];
  __syncthreads();
  G8Moe S; S.cnt = scnt; S.ntn = 4; S.Kb = 2 * DFF; S.G = nb; S.c = bid; S.Bt = (const char*)(p.bt_dn() + (size_t)layer * NE * DM * DFF); S.bstride = (size_t)DM * DFF * 2; S.rtok = nullptr;
  EpiDn E; E.bdl = p.moe_b_down() + (size_t)layer * NE * DM; E.rw = p.rw(); E.yd = p.yd();
  gemm8_phase<false>(lds, (const char*)p.act(), 2 * DFF, S, E);
}

__device__ __forceinline__ void phase_final(const Params& p, int bid, int nb, char* lds) {
  int* pre = (int*)lds;
  expert_prefix(p.cnt() + NE, pre); __syncthreads();
  const int wid = ltid() >> 6, lane = ltid() & 63;
  for (int tok = bid * 8 + wid; tok < TL; tok += nb * 8) {
    float v[16];
    load_row_comb(p, 1, 1, tok, lane, pre, v);
    float ss = 0;
#pragma unroll
    for (int i = 0; i < 16; ++i) ss += v[i] * v[i];
    ss = wave_sum(ss);
    const float rs = rsqrtf(ss * (1.f / DM) + EPS);
    float* o = p.out() + (size_t)tok * DM;
#pragma unroll
    for (int i = 0; i < 4; ++i) {
      const int c = lane * 4 + i * 256;
      const float4 g = *(const float4*)(p.final_g() + c);
      *(float4*)(o + c) = make_float4(v[4 * i] * rs * g.x, v[4 * i + 1] * rs * g.y, v[4 * i + 2] * rs * g.z, v[4 * i + 3] * rs * g.w);
    }
  }
}

#define XB_TMO      128
#define XB_XCNT(j)  (256  + 64 * (j))
#define XB_XSUB(j)  (1280 + 64 * (j))
#define XB_XGEN(j)  (2304 + 64 * (j))
#define XB_TOP      3328
#define XB_TOPGEN   3392
#define XCD_BAR_WORDS 3456
#define XB_SPIN_CAP (1u << 18)
#define LAS __attribute__((address_space(3)))

__device__ __forceinline__ unsigned xb_ld(unsigned* p)              { return __hip_atomic_load(p, __ATOMIC_RELAXED, __HIP_MEMORY_SCOPE_AGENT); }
__device__ __forceinline__ unsigned xb_add(unsigned* p, unsigned v) { return __hip_atomic_fetch_add(p, v, __ATOMIC_RELAXED, __HIP_MEMORY_SCOPE_AGENT); }
__device__ __forceinline__ unsigned xb_xcc_id() { return (unsigned)__builtin_amdgcn_s_getreg((3 << 11) | 20) & 0xFu; }
#define XB_SPIN(cond, bar) do { unsigned _sp = 0; while (cond) { __builtin_amdgcn_s_sleep(1); \
    if ((++_sp & 255u) == 0u) { if (xb_ld(&(bar)[XB_TMO])) break; if (_sp > XB_SPIN_CAP) { atomicAdd(&(bar)[XB_TMO], 1u); break; } } } } while (0)

struct XcdBarrier {
    unsigned* bar; unsigned x;
    volatile LAS unsigned* st;
};

__device__ __forceinline__ XcdBarrier xcd_barrier_post(unsigned* bar, volatile LAS unsigned* st) {
    XcdBarrier b; b.bar = bar; b.x = xb_xcc_id(); b.st = st;
    if (threadIdx.x == 0) (void)xb_add(&bar[XB_XCNT(b.x)], 1u);
    return b;
}
__device__ __forceinline__ void xcd_barrier_complete(unsigned* bar, unsigned x, unsigned& nloc, unsigned& nx) {
    const unsigned G = gridDim.x * gridDim.y * gridDim.z;
    unsigned sum, cnt, mine, sp = 0u;
    for (;;) {
        sum = 0u; cnt = 0u; mine = 0u;
#pragma unroll
        for (unsigned j = 0; j < 16; ++j) { const unsigned c = xb_ld(&bar[XB_XCNT(j)]); sum += c; cnt += (c > 0u) ? 1u : 0u; mine = (j == x) ? c : mine; }
        if (sum == G) break;
        __builtin_amdgcn_s_sleep(1);
        if ((++sp & 255u) == 0u) { if (xb_ld(&bar[XB_TMO])) break; if (sp > XB_SPIN_CAP) { atomicAdd(&bar[XB_TMO], 1u); break; } }
    }
    nloc = mine > 0u ? mine : 1u; nx = cnt > 0u ? cnt : 1u;
}

__device__ __forceinline__ void xcd_barrier(const XcdBarrier& b) {
    asm volatile("s_waitcnt vmcnt(0)" ::: "memory");
    __syncthreads();
    if (threadIdx.x == 0) {
        unsigned* bar = b.bar;
        __builtin_amdgcn_s_waitcnt(0);
        unsigned nloc = b.st[0], nx = b.st[1];
        if (nloc == 0u) { xcd_barrier_complete(bar, b.x, nloc, nx); b.st[0] = nloc; b.st[1] = nx; }
        const unsigned old = xb_add(&bar[XB_XSUB(b.x)], 1u);
        const unsigned gen = old / nloc;
        if (old + 1u == (gen + 1u) * nloc) {
            __builtin_amdgcn_fence(__ATOMIC_RELEASE, "agent");
            asm volatile("s_waitcnt vmcnt(0)" ::: "memory");
            const unsigned og = xb_add(&bar[XB_TOP], 1u);
            const unsigned tg = og / nx;
            if (og + 1u == (tg + 1u) * nx) xb_add(&bar[XB_TOPGEN], 1u);
            else XB_SPIN(xb_ld(&bar[XB_TOPGEN]) == tg, bar);
            __builtin_amdgcn_fence(__ATOMIC_ACQUIRE, "agent");
            xb_add(&bar[XB_XGEN(b.x)], 1u);
            asm volatile("s_waitcnt vmcnt(0)" ::: "memory");
        } else {
            XB_SPIN(xb_ld(&bar[XB_XGEN(b.x)]) == gen, bar);
            __builtin_amdgcn_fence(__ATOMIC_ACQUIRE, "agent");
            asm volatile("s_waitcnt vmcnt(0)" ::: "memory");
        }
    }
    __syncthreads();
}


#ifdef PROBE_BAR
__device__ __forceinline__ void flat_barrier_probe(unsigned* bar, unsigned& epoch) {
  asm volatile("s_waitcnt vmcnt(0)" ::: "memory");
  __syncthreads();
  if (threadIdx.x == 0) {
    epoch += gridDim.x;
    xb_add(&bar[3400], 1u);
    unsigned sp = 0;
    while (xb_ld(&bar[3400]) < epoch) { __builtin_amdgcn_s_sleep(1); if (++sp > (1u << 20)) break; }
  }
  __syncthreads();
}
#endif
constexpr int LDS_MAIN = 147456;
constexpr int LDS_BYTES = LDS_MAIN + 1024;
enum { PH_TABLES = 0, PH_MOD, PH_FOLD, PH_CONVERT, PH_HYMLP, PH_HYFILT, PH_NORM1, PH_GEMM_IN, PH_QKV, PH_ATTN, PH_FFTMIX,
       PH_GLA_A, PH_GLA_B, PH_GLA_C, PH_MIX, PH_GEMM_OUT, PH_NORM2, PH_MOE_GU, PH_MOE_DN, PH_FINAL };

__device__ __forceinline__ Params make_params() {
  const __attribute__((address_space(4))) char* kb = (const __attribute__((address_space(4))) char*)__builtin_amdgcn_kernarg_segment_ptr();
  asm volatile("" : "+s"(kb));
  Params p; p.kb = kb; return p;
}
#ifndef MK_LAUNCHES
#define MK_LAUNCHES 1
#endif
__global__ void __launch_bounds__(NTHR, 2) k_mega(ParamsData pd) {
  extern __shared__ __attribute__((aligned(1024))) char lds[];
  const int bid = blockIdx.x, nb = gridDim.x;
  if (threadIdx.x == 0) *(uint4*)(lds + LDS_MAIN) = make_uint4(0u, 0u, 0u, 0u);
  __syncthreads();
  XcdBarrier bar = xcd_barrier_post(make_params().bar(), (volatile LAS unsigned*)(lds + LDS_MAIN));
#ifndef DBLMASK
#define DBLMASK 0u
#endif
#define RUNPH(bit, call) do { call; if (DBLMASK & (1u << (bit))) { __syncthreads(); call; } } while (0)
  RUNPH(13, phase_tables(make_params(), bid, nb); phase_mod(make_params(), bid, nb, lds); phase_fold(make_params(), bid, nb, lds));
  RUNPH(0, phase_convert(make_params(), bid, nb, lds));
  phase_hy_mlp(make_params(), 0, SEQ, make_params().hfb(), make_params().hpart(), bid, nb, lds);
  phase_hy_mlp(make_params(), 1, SEQ, make_params().hfb() + (size_t)2 * 256 * SEQ, make_params().hpart() + 256 * 512, bid, nb, lds);
  phase_hy_mlp(make_params(), 0, LC, make_params().hfc(), make_params().hpart() + 2 * 256 * 512, bid, nb, lds);
  xcd_barrier(bar);
  RUNPH(2, phase_hy_filtfft(make_params(), bid, nb, lds));
#ifdef PROBE_BAR
  { unsigned ep_ = 0; for (int i_ = 0; i_ < 20; ++i_) flat_barrier_probe(make_params().bar(), ep_); }
#endif
  phase_quant_in(make_params(), bid, nb);
#define MK_LAYER(l) do { \
  phase_norm1(make_params(), l, bid, nb, lds); if ((DBLMASK & (1u << 14)) && l == 0) { __syncthreads(); phase_norm1(make_params(), l, bid, nb, lds); } \
  xcd_barrier(bar); \
  RUNPH(3, phase_gemm_in(make_params(), l, bid, nb, lds)); \
  xcd_barrier(bar); \
  RUNPH(4, phase_qkv(make_params(), l, bid, nb, lds)); \
  RUNPH(5, phase_gla_a(make_params(), l, bid, nb, lds)); \
  RUNPH(7, phase_fftmix(make_params(), l, bid, nb, lds)); \
  xcd_barrier(bar); \
  RUNPH(6, phase_attn(make_params(), l, bid, nb, lds)); \
  RUNPH(9, phase_gla_c(make_params(), l, bid, nb, lds)); \
  RUNPH(10, phase_mix(make_params(), l, bid, nb, lds)); \
  xcd_barrier(bar); \
  phase_gemm_out(make_params(), l, bid, nb, lds); if ((DBLMASK & (1u << 16)) && l == 0) { __syncthreads(); phase_gemm_out(make_params(), l, bid, nb, lds); } \
  xcd_barrier(bar); \
  phase_norm2_router(make_params(), l, bid, nb, lds); \
  xcd_barrier(bar); \
  RUNPH(11, phase_moe_gu(make_params(), l, bid, nb, lds)); \
  xcd_barrier(bar); \
  RUNPH(12, phase_moe_dn(make_params(), l, bid, nb, lds)); \
  xcd_barrier(bar); \
  } while (0)
  MK_LAYER(0);
  MK_LAYER(1);
#undef MK_LAYER
  RUNPH(15, phase_final(make_params(), bid, nb, lds));
}
static size_t carve(char*& cur, size_t bytes) { char* r = cur; cur += (bytes + 1023) & ~(size_t)1023; return (size_t)(uintptr_t)r; }
#define CARVE(T, field, n) p.field = (T*)carve(cur, (size_t)(n) * sizeof(T))

extern "C" void kernel_launch(void* const* d_in, const int* in_sizes, int n_in, void* d_out, int out_size, void* d_ws, size_t ws_size, hipStream_t stream) {
  ParamsData p; memset(&p, 0, sizeof(p));
  const float** ins = (const float**)&p;
  for (int i = 0; i < 34; ++i) ins[i] = (const float*)d_in[i];
  p.out_ = (float*)d_out;
  p.ws_ = (char*)d_ws;
  if (WS_TOTAL > ws_size) { fprintf(stderr, "workspace too small: need %zu have %zu\n", (size_t)WS_TOTAL, ws_size); return; }
  hipMemsetAsync((char*)d_ws + OFF_bar, 0, OFF_mod - OFF_bar, stream);
  static int grid = 0;
  if (!grid) {
    int dev = 0, cus = 0, per_cu = 0;
    hipGetDevice(&dev);
    hipDeviceGetAttribute(&cus, hipDeviceAttributeMultiprocessorCount, dev);
    hipFuncSetAttribute((const void*)k_mega, hipFuncAttributeMaxDynamicSharedMemorySize, LDS_BYTES);
    hipOccupancyMaxActiveBlocksPerMultiprocessor(&per_cu, (const void*)k_mega, NTHR, LDS_BYTES);
    grid = cus * (per_cu < 1 ? per_cu : 1);
    if (grid != 256) fprintf(stderr, "unexpected grid %d (cus %d per_cu %d)\n", grid, cus, per_cu);
  }
  hipLaunchKernelGGL(k_mega, dim3(grid), dim3(NTHR), LDS_BYTES, stream, p);
}
```

```cpp
#include <hip/hip_runtime.h>
#include <hip/hip_bf16.h>
#include <cstdio>
#include <cstdint>
#include <cstring>
#include <cstddef>
#include <type_traits>

typedef unsigned short u16;
using bf16x8 = __attribute__((ext_vector_type(8))) short;
using s16x4  = __attribute__((ext_vector_type(4))) short;
using f32x4  = __attribute__((ext_vector_type(4))) float;
using f32x16 = __attribute__((ext_vector_type(16))) float;
using u32x4  = __attribute__((ext_vector_type(4))) unsigned;
using u32x2  = __attribute__((ext_vector_type(2))) unsigned;

constexpr int DM = 1024, NB = 2, SEQ = 16384, LC = 256;
constexpr int TL = NB * SEQ;
constexpr int TC = NB * LC;
constexpr int TT = TL + TC;
constexpr int NIN = 2816;
constexpr int DIN0 = 2240;
constexpr int NE = 32, TOPK = 4, DFF = 1024;
constexpr int SKV = SEQ + LC;
constexpr int NTHR = 512;
constexpr float EPS = 1e-6f;
constexpr float A_SCALE = 0.10206207261596575f;
constexpr float A_QSCALE = A_SCALE * 1.4426950408889634f;
constexpr int ZG_W = 1152, ZG_GQ = 0, ZG_GK = 128, ZG_KR = 256, ZG_GV = 384, ZG_GP = 640, ZG_OG = 896;
constexpr int ZT_HY = 0, ZT_FR = 768, ZT_FI = 1024, ZT_R = 1280;
constexpr int NCH = 260;
constexpr int FM = 16384;
constexpr int HSP = FM / 2 + 1;

constexpr size_t ws_al(size_t b) { return (b + 1023) & ~(size_t)1023; }
constexpr size_t OFF_bar = 0;
constexpr size_t OFF_cnt = OFF_bar + ws_al((size_t)(4096) * sizeof(unsigned));
constexpr size_t OFF_hssq = OFF_cnt + ws_al((size_t)(64) * sizeof(int));
constexpr size_t OFF_kmx = OFF_hssq + ws_al((size_t)(768) * sizeof(float));
constexpr size_t OFF_mod = OFF_kmx + ws_al((size_t)(128) * sizeof(unsigned));
constexpr size_t OFF_ropec = OFF_mod + ws_al((size_t)(2 * 3 * 6144) * sizeof(float));
constexpr size_t OFF_ropes = OFF_ropec + ws_al((size_t)(SEQ * 16) * sizeof(float));
constexpr size_t OFF_tw = OFF_ropes + ws_al((size_t)(SEQ * 16) * sizeof(float));
constexpr size_t OFF_bt_in = OFF_tw + ws_al((size_t)(FM) * sizeof(float2));
constexpr size_t OFF_bt_qkv = OFF_bt_in + ws_al((size_t)((size_t)2 * NIN * DM) * sizeof(u16));
constexpr size_t OFF_bt_out = OFF_bt_qkv + ws_al((size_t)(2 * 1024 * 384) * sizeof(u16));
constexpr size_t OFF_bt_gu = OFF_bt_out + ws_al((size_t)((size_t)2 * DM * DM) * sizeof(u16));
constexpr size_t OFF_bt_dn = OFF_bt_gu + ws_al((size_t)((size_t)2 * NE * 2048 * DM) * sizeof(u16));
constexpr size_t OFF_hfb = OFF_bt_dn + ws_al((size_t)((size_t)2 * NE * DM * DFF) * sizeof(u16));
constexpr size_t OFF_hfc = OFF_hfb + ws_al((size_t)((size_t)2 * 2 * 256 * SEQ) * sizeof(float));
constexpr size_t OFF_hspec = OFF_hfc + ws_al((size_t)(2 * 256 * LC) * sizeof(float));
constexpr size_t OFF_H = OFF_hspec + ws_al((size_t)((size_t)2 * 256 * HSP) * sizeof(float4));
constexpr size_t OFF_zqkv = OFF_H + ws_al((size_t)((size_t)TT * DM) * sizeof(u16));
constexpr size_t OFF_zg = OFF_zqkv + ws_al((size_t)((size_t)TT * 384) * sizeof(u16));
constexpr size_t OFF_zt = OFF_zg + ws_al((size_t)((size_t)TT * ZG_W) * sizeof(float));
constexpr size_t OFF_Q = OFF_zt + ws_al((size_t)((size_t)ZT_R * TT) * sizeof(float));
constexpr size_t OFF_KV = OFF_Q + ws_al((size_t)((size_t)2 * 4 * SKV * 96) * sizeof(u16));
constexpr size_t OFF_ymix = OFF_KV + ws_al((size_t)((size_t)2 * 4 * SKV * 160) * sizeof(u16));
constexpr size_t OFF_hyo = OFF_ymix + ws_al((size_t)((size_t)TT * DM) * sizeof(u16));
constexpr size_t OFF_fno = OFF_hyo + ws_al((size_t)((size_t)256 * TT) * sizeof(float));
constexpr size_t OFF_glao = OFF_fno + ws_al((size_t)((size_t)256 * TT) * sizeof(float));
constexpr size_t OFF_gds = OFF_glao + ws_al((size_t)((size_t)TT * 256) * sizeof(float));
constexpr size_t OFF_gdv = OFF_gds + ws_al((size_t)((size_t)16 * NCH * 2048) * sizeof(float));
constexpr size_t OFF_gst = OFF_gdv + ws_al((size_t)((size_t)16 * NCH * 32) * sizeof(float));
constexpr size_t OFF_X = OFF_gst + ws_al((size_t)((size_t)16 * NCH * 2048) * sizeof(float));
constexpr size_t OFF_rtok = OFF_X + ws_al((size_t)((size_t)TT * DM) * sizeof(float));
constexpr size_t OFF_rw = OFF_rtok + ws_al((size_t)((size_t)NE * TT) * sizeof(int));
constexpr size_t OFF_tslot = OFF_rw + ws_al((size_t)((size_t)NE * TT) * sizeof(float));
constexpr size_t OFF_act = OFF_tslot + ws_al((size_t)((size_t)TT * 4) * sizeof(int));
constexpr size_t OFF_yd = OFF_act + ws_al((size_t)((size_t)TT * 4 * DFF) * sizeof(u16));
constexpr size_t OFF_swin = OFF_yd + ws_al((size_t)((size_t)TT * 4 * DM) * sizeof(u16));
constexpr size_t OFF_swgu = OFF_swin + ws_al((size_t)(2 * NIN) * sizeof(float));
constexpr size_t OFF_hs = OFF_swgu + ws_al((size_t)(2 * NE * 2048) * sizeof(float));
constexpr size_t OFF_hpart = OFF_hs + ws_al((size_t)(TT) * sizeof(float));
constexpr size_t OFF_rsc = OFF_hpart + ws_al((size_t)(3 * 256 * 512) * sizeof(float));
constexpr size_t WS_TOTAL = OFF_rsc + ws_al((size_t)((size_t)NE * TT) * sizeof(float));
struct ParamsData {
  const float *x_, *c_, *ctx_, *c_ctx_, *ada_w_, *ada_b_, *norm1_g_, *norm2_g_, *w_in_, *mla_q_g_, *mla_w_uq_, *mla_kv_g_, *mla_w_ukv_, *hy_conv_w_, *hy_conv_b_, *hy_w1_, *hy_b1_, *hy_w2_, *hy_b2_, *hy_w3_, *hy_freq_, *hy_bias_, *gla_gk_w_, *gla_gk_b_, *fnet_w_, *mix_g_, *w_out_, *router_w_, *router_b_, *moe_w_gu_, *moe_b_gu_, *moe_w_down_, *moe_b_down_, *final_g_;
  float* out_;
  char* ws_;
};
struct Params {
  const __attribute__((address_space(4))) char* kb;
  template <class T> __device__ __forceinline__ T karg(size_t off) const { return *(const __attribute__((address_space(4))) T*)(kb + off); }
  __device__ __forceinline__ const float* x() const { return karg<const float*>(offsetof(ParamsData, x_)); }
  __device__ __forceinline__ const float* c() const { return karg<const float*>(offsetof(ParamsData, c_)); }
  __device__ __forceinline__ const float* ctx() const { return karg<const float*>(offsetof(ParamsData, ctx_)); }
  __device__ __forceinline__ const float* c_ctx() const { return karg<const float*>(offsetof(ParamsData, c_ctx_)); }
  __device__ __forceinline__ const float* ada_w() const { return karg<const float*>(offsetof(ParamsData, ada_w_)); }
  __device__ __forceinline__ const float* ada_b() const { return karg<const float*>(offsetof(ParamsData, ada_b_)); }
  __device__ __forceinline__ const float* norm1_g() const { return karg<const float*>(offsetof(ParamsData, norm1_g_)); }
  __device__ __forceinline__ const float* norm2_g() const { return karg<const float*>(offsetof(ParamsData, norm2_g_)); }
  __device__ __forceinline__ const float* w_in() const { return karg<const float*>(offsetof(ParamsData, w_in_)); }
  __device__ __forceinline__ const float* mla_q_g() const { return karg<const float*>(offsetof(ParamsData, mla_q_g_)); }
  __device__ __forceinline__ const float* mla_w_uq() const { return karg<const float*>(offsetof(ParamsData, mla_w_uq_)); }
  __device__ __forceinline__ const float* mla_kv_g() const { return karg<const float*>(offsetof(ParamsData, mla_kv_g_)); }
  __device__ __forceinline__ const float* mla_w_ukv() const { return karg<const float*>(offsetof(ParamsData, mla_w_ukv_)); }
  __device__ __forceinline__ const float* hy_conv_w() const { return karg<const float*>(offsetof(ParamsData, hy_conv_w_)); }
  __device__ __forceinline__ const float* hy_conv_b() const { return karg<const float*>(offsetof(ParamsData, hy_conv_b_)); }
  __device__ __forceinline__ const float* hy_w1() const { return karg<const float*>(offsetof(ParamsData, hy_w1_)); }
  __device__ __forceinline__ const float* hy_b1() const { return karg<const float*>(offsetof(ParamsData, hy_b1_)); }
  __device__ __forceinline__ const float* hy_w2() const { return karg<const float*>(offsetof(ParamsData, hy_w2_)); }
  __device__ __forceinline__ const float* hy_b2() const { return karg<const float*>(offsetof(ParamsData, hy_b2_)); }
  __device__ __forceinline__ const float* hy_w3() const { return karg<const float*>(offsetof(ParamsData, hy_w3_)); }
  __device__ __forceinline__ const float* hy_freq() const { return karg<const float*>(offsetof(ParamsData, hy_freq_)); }
  __device__ __forceinline__ const float* hy_bias() const { return karg<const float*>(offsetof(ParamsData, hy_bias_)); }
  __device__ __forceinline__ const float* gla_gk_w() const { return karg<const float*>(offsetof(ParamsData, gla_gk_w_)); }
  __device__ __forceinline__ const float* gla_gk_b() const { return karg<const float*>(offsetof(ParamsData, gla_gk_b_)); }
  __device__ __forceinline__ const float* fnet_w() const { return karg<const float*>(offsetof(ParamsData, fnet_w_)); }
  __device__ __forceinline__ const float* mix_g() const { return karg<const float*>(offsetof(ParamsData, mix_g_)); }
  __device__ __forceinline__ const float* w_out() const { return karg<const float*>(offsetof(ParamsData, w_out_)); }
  __device__ __forceinline__ const float* router_w() const { return karg<const float*>(offsetof(ParamsData, router_w_)); }
  __device__ __forceinline__ const float* router_b() const { return karg<const float*>(offsetof(ParamsData, router_b_)); }
  __device__ __forceinline__ const float* moe_w_gu() const { return karg<const float*>(offsetof(ParamsData, moe_w_gu_)); }
  __device__ __forceinline__ const float* moe_b_gu() const { return karg<const float*>(offsetof(ParamsData, moe_b_gu_)); }
  __device__ __forceinline__ const float* moe_w_down() const { return karg<const float*>(offsetof(ParamsData, moe_w_down_)); }
  __device__ __forceinline__ const float* moe_b_down() const { return karg<const float*>(offsetof(ParamsData, moe_b_down_)); }
  __device__ __forceinline__ const float* final_g() const { return karg<const float*>(offsetof(ParamsData, final_g_)); }
  __device__ __forceinline__ float* out() const { return karg<float*>(offsetof(ParamsData, out_)); }
  __device__ __forceinline__ char* ws() const { return karg<char*>(offsetof(ParamsData, ws_)); }
  __device__ __forceinline__ unsigned* bar() const { return (unsigned*)(ws() + OFF_bar); }
  __device__ __forceinline__ int* cnt() const { return (int*)(ws() + OFF_cnt); }
  __device__ __forceinline__ float* hssq() const { return (float*)(ws() + OFF_hssq); }
  __device__ __forceinline__ unsigned* kmx() const { return (unsigned*)(ws() + OFF_kmx); }
  __device__ __forceinline__ float* mod() const { return (float*)(ws() + OFF_mod); }
  __device__ __forceinline__ float* ropec() const { return (float*)(ws() + OFF_ropec); }
  __device__ __forceinline__ float* ropes() const { return (float*)(ws() + OFF_ropes); }
  __device__ __forceinline__ float2* tw() const { return (float2*)(ws() + OFF_tw); }
  __device__ __forceinline__ signed char* bt_in() const { return (signed char*)(ws() + OFF_bt_in); }
  __device__ __forceinline__ u16* bt_qkv() const { return (u16*)(ws() + OFF_bt_qkv); }
  __device__ __forceinline__ u16* bt_out() const { return (u16*)(ws() + OFF_bt_out); }
  __device__ __forceinline__ signed char* bt_gu() const { return (signed char*)(ws() + OFF_bt_gu); }
  __device__ __forceinline__ u16* bt_dn() const { return (u16*)(ws() + OFF_bt_dn); }
  __device__ __forceinline__ float* hfb() const { return (float*)(ws() + OFF_hfb); }
  __device__ __forceinline__ float* hfc() const { return (float*)(ws() + OFF_hfc); }
  __device__ __forceinline__ float4* hspec() const { return (float4*)(ws() + OFF_hspec); }
  __device__ __forceinline__ signed char* H() const { return (signed char*)(ws() + OFF_H); }
  __device__ __forceinline__ float* hs() const { return (float*)(ws() + OFF_hs); }
  __device__ __forceinline__ float* rsc() const { return (float*)(ws() + OFF_rsc); }
  __device__ __forceinline__ float* hpart() const { return (float*)(ws() + OFF_hpart); }
  __device__ __forceinline__ float* swin() const { return (float*)(ws() + OFF_swin); }
  __device__ __forceinline__ float* swgu() const { return (float*)(ws() + OFF_swgu); }
  __device__ __forceinline__ float* btf() const { return (float*)(ws() + OFF_act); }
  __device__ __forceinline__ u16* zqkv() const { return (u16*)(ws() + OFF_zqkv); }
  __device__ __forceinline__ u16* zg() const { return (u16*)(ws() + OFF_zg); }
  __device__ __forceinline__ u16* zt() const { return (u16*)(ws() + OFF_zt); }
  __device__ __forceinline__ u16* Q() const { return (u16*)(ws() + OFF_Q); }
  __device__ __forceinline__ u16* KV() const { return (u16*)(ws() + OFF_KV); }
  __device__ __forceinline__ u16* ymix() const { return (u16*)(ws() + OFF_ymix); }
  __device__ __forceinline__ u16* hyo() const { return (u16*)(ws() + OFF_hyo); }
  __device__ __forceinline__ u16* fno() const { return (u16*)(ws() + OFF_fno); }
  __device__ __forceinline__ u16* glao() const { return (u16*)(ws() + OFF_glao); }
  __device__ __forceinline__ float* gds() const { return (float*)(ws() + OFF_gds); }
  __device__ __forceinline__ float* gdv() const { return (float*)(ws() + OFF_gdv); }
  __device__ __forceinline__ float* gst() const { return (float*)(ws() + OFF_gst); }
  __device__ __forceinline__ u16* X() const { return (u16*)(ws() + OFF_X); }
  __device__ __forceinline__ int* rtok() const { return (int*)(ws() + OFF_rtok); }
  __device__ __forceinline__ float* rw() const { return (float*)(ws() + OFF_rw); }
  __device__ __forceinline__ int* tslot() const { return (int*)(ws() + OFF_tslot); }
  __device__ __forceinline__ u16* act() const { return (u16*)(ws() + OFF_act); }
  __device__ __forceinline__ unsigned char* yd() const { return (unsigned char*)(ws() + OFF_yd); }
};


__device__ __forceinline__ u16 f2bf(float f) {
  unsigned u = __float_as_uint(f); u += 0x7FFFu + ((u >> 16) & 1u); return (u16)(u >> 16);
}
__device__ __forceinline__ float bf2f(u16 h) { return __uint_as_float(((unsigned)h) << 16); }
__device__ __forceinline__ unsigned cvtpk(float lo, float hi) {
  unsigned r; asm volatile("v_cvt_pk_bf16_f32 %0, %1, %2" : "=v"(r) : "v"(lo), "v"(hi)); return r;
}
#define BF_LO(w) __uint_as_float((w) << 16)
#define BF_HI(w) __uint_as_float((w) & 0xFFFF0000u)
__device__ __forceinline__ float4 ld4bf(const u16* p) { const u32x2 w = *(const u32x2*)p; return make_float4(__uint_as_float(w[0] << 16), __uint_as_float(w[0] & 0xFFFF0000u), __uint_as_float(w[1] << 16), __uint_as_float(w[1] & 0xFFFF0000u)); }
template <int CTRL> __device__ __forceinline__ float dppf(float v) { return __builtin_bit_cast(float, __builtin_amdgcn_update_dpp(0, __builtin_bit_cast(int, v), CTRL, 0xF, 0xF, true)); }
template <int M> __device__ __forceinline__ float shx(float v) {
  if constexpr (M == 1) return dppf<0xB1>(v);
  else if constexpr (M == 2) return dppf<0x4E>(v);
  else if constexpr (M == 4) return dppf<0x1B>(dppf<0x141>(v));
  else if constexpr (M == 8) return dppf<0x141>(dppf<0x140>(v));
  else if constexpr (M == 16) { auto r = __builtin_amdgcn_permlane16_swap(__float_as_uint(v), __float_as_uint(v), false, false);
    return __uint_as_float((__lane_id() & 16) ? r[0] : r[1]); }
  else { auto r = __builtin_amdgcn_permlane32_swap(__float_as_uint(v), __float_as_uint(v), false, false);
    return __uint_as_float((__lane_id() & 32) ? r[0] : r[1]); }
}
__device__ __forceinline__ float wave_sum(float v) {
  v += dppf<0xB1>(v); v += dppf<0x4E>(v); v += dppf<0x141>(v); v += dppf<0x140>(v);
  { auto r = __builtin_amdgcn_permlane16_swap(__float_as_uint(v), __float_as_uint(v), false, false); v = __uint_as_float(r[0]) + __uint_as_float(r[1]); }
  { auto r = __builtin_amdgcn_permlane32_swap(__float_as_uint(v), __float_as_uint(v), false, false); v = __uint_as_float(r[0]) + __uint_as_float(r[1]); }
  return v;
}
__device__ __forceinline__ float wave_max(float v) {
  v = fmaxf(v, dppf<0xB1>(v)); v = fmaxf(v, dppf<0x4E>(v)); v = fmaxf(v, dppf<0x141>(v)); v = fmaxf(v, dppf<0x140>(v));
  { auto r = __builtin_amdgcn_permlane16_swap(__float_as_uint(v), __float_as_uint(v), false, false); v = fmaxf(__uint_as_float(r[0]), __uint_as_float(r[1])); }
  { auto r = __builtin_amdgcn_permlane32_swap(__float_as_uint(v), __float_as_uint(v), false, false); v = fmaxf(__uint_as_float(r[0]), __uint_as_float(r[1])); }
  return v;
}
__device__ __forceinline__ int ltid() { int t = threadIdx.x; asm volatile("" : "+v"(t)); return t; }
__device__ __forceinline__ float silu_f(float x) { return x / (1.f + __expf(-x)); }
__device__ __forceinline__ float2 cmul(float2 a, float2 b) { return make_float2(a.x * b.x - a.y * b.y, a.x * b.y + a.y * b.x); }
__device__ __forceinline__ float2 cmulc(float2 a, float2 b) { return make_float2(a.x * b.x + a.y * b.y, a.y * b.x - a.x * b.y); }
__device__ __forceinline__ int modv(int tok) { return tok < TL ? (tok >> 14) : 2; }
__device__ __forceinline__ void phase_tables(const Params& p, int bid, int nb) {
  const int gt = bid * NTHR + ltid(), gs = nb * NTHR;
  for (int i = gt; i < SEQ * 16; i += gs) {
    const int t = i >> 4, f = i & 15;
    const float pos = (f < 8) ? (float)(t >> 6) : (float)(t & 63);
    const float inv = powf(10000.f, -(float)(f & 7) / 8.f);
    float s, c; sincosf(pos * inv, &s, &c);
    p.ropec()[i] = c; p.ropes()[i] = s;
  }
  for (int i = gt; i < FM; i += gs) {
    float s, c; sincospif((float)i / 8192.f, &s, &c);
    p.tw()[i] = make_float2(c, -s);
  }
}

__device__ __forceinline__ void phase_mod(const Params& p, int bid, int nb, char* lds) {
  float* red = (float*)lds;
  const int tid = ltid(), part = tid >> 6, cl = tid & 63;
  for (int it = bid; it < 2 * 96; it += nb) {
    const int l = it / 96, n = (it % 96) * 64 + cl;
    const float* W = p.ada_w() + (size_t)l * DM * 6144;
    float a0 = 0, a1 = 0, a2 = 0;
    for (int k = part * 128; k < part * 128 + 128; ++k) {
      const float w = W[(size_t)k * 6144 + n];
      a0 += silu_f(p.c()[k]) * w; a1 += silu_f(p.c()[DM + k]) * w; a2 += silu_f(p.c_ctx()[k]) * w;
    }
    red[(part * 3 + 0) * 64 + cl] = a0; red[(part * 3 + 1) * 64 + cl] = a1; red[(part * 3 + 2) * 64 + cl] = a2;
    __syncthreads();
    if (tid < 192) {
      const int v = tid >> 6; float s = 0;
      for (int q = 0; q < 8; ++q) s += red[(q * 3 + v) * 64 + cl];
      p.mod()[((size_t)l * 3 + v) * 6144 + n] = s + p.ada_b()[(size_t)l * 6144 + n];
    }
    __syncthreads();
  }
}

__device__ __forceinline__ void phase_fold(const Params& p, int bid, int nb, char* lds) {
  float* wrow = (float*)lds;
  float* dre = wrow + 2048;
  float* dim_ = dre + 2048;
  float* glr = dim_ + 2048;
  float* cst = glr + 256;
  float* snt = cst + 256;
  const int tid = ltid();
  if (tid < 256) { float sn, cs; sincospif((float)tid / 128.f, &sn, &cs); cst[tid] = cs; snt[tid] = sn; }
  __syncthreads();
  for (int it = bid; it < 2 * DM / 8; it += nb) {
    const int l = it >> 7, k0 = (it & 127) * 8;
    for (int i = tid; i < 8 * 256; i += NTHR) { const int r = i >> 8, c = i & 255; wrow[c * 8 + r] = p.w_in()[((size_t)l * DM + k0 + r) * DIN0 + 1984 + c]; }
    if (tid < 256) { const int r = tid >> 5, c = tid & 31; glr[c * 8 + r] = p.w_in()[((size_t)l * DM + k0 + r) * DIN0 + 1696 + c]; }
    __syncthreads();
    {
      const int kp = tid & 255; const bool im = tid >= 256;
      float acc[8] = {0.f, 0.f, 0.f, 0.f, 0.f, 0.f, 0.f, 0.f};
#pragma unroll 4
      for (int c = 0; c < 256; ++c) {
        const int m = (c * kp) & 255; const float t = im ? -snt[m] : cst[m];
        const float4 w0 = *(const float4*)(wrow + c * 8), w1 = *(const float4*)(wrow + c * 8 + 4);
        acc[0] += w0.x * t; acc[1] += w0.y * t; acc[2] += w0.z * t; acc[3] += w0.w * t; acc[4] += w1.x * t; acc[5] += w1.y * t; acc[6] += w1.z * t; acc[7] += w1.w * t;
      }
      float* d = (im ? dim_ : dre) + kp * 8;
      *(float4*)d = make_float4(acc[0], acc[1], acc[2], acc[3]); *(float4*)(d + 4) = make_float4(acc[4], acc[5], acc[6], acc[7]);
    }
    __syncthreads();
    {
      const int j = tid & 255; const bool im = tid >= 256;
      const float* Wf = p.fnet_w() + (size_t)l * 65536 + j;
      const float* d = im ? dim_ : dre;
      float acc[8] = {0.f, 0.f, 0.f, 0.f, 0.f, 0.f, 0.f, 0.f};
#pragma unroll 8
      for (int kp = 0; kp < 256; ++kp) {
        const float w = Wf[kp * 256];
        const float4 d0 = *(const float4*)(d + kp * 8), d1 = *(const float4*)(d + kp * 8 + 4);
        acc[0] += d0.x * w; acc[1] += d0.y * w; acc[2] += d0.z * w; acc[3] += d0.w * w; acc[4] += d1.x * w; acc[5] += d1.y * w; acc[6] += d1.z * w; acc[7] += d1.w * w;
      }
      float* o = p.btf() + ((size_t)l * NIN + (im ? 2560 : 2304) + j) * DM + k0;
      *(float4*)o = make_float4(acc[0] * 0.0625f, acc[1] * 0.0625f, acc[2] * 0.0625f, acc[3] * 0.0625f);
      *(float4*)(o + 4) = make_float4(acc[4] * 0.0625f, acc[5] * 0.0625f, acc[6] * 0.0625f, acc[7] * 0.0625f);
    }
    if (tid < 256) {
      const int dir = tid >> 7, kk = tid & 127;
      const float* gw = p.gla_gk_w() + ((size_t)l * 2 + dir) * 16 * 128 + kk;
      float acc[8] = {0.f, 0.f, 0.f, 0.f, 0.f, 0.f, 0.f, 0.f};
#pragma unroll
      for (int r16 = 0; r16 < 16; ++r16) {
        const float w = gw[r16 * 128];
        const float4 g0 = *(const float4*)(glr + (dir * 16 + r16) * 8), g1 = *(const float4*)(glr + (dir * 16 + r16) * 8 + 4);
        acc[0] += g0.x * w; acc[1] += g0.y * w; acc[2] += g0.z * w; acc[3] += g0.w * w; acc[4] += g1.x * w; acc[5] += g1.y * w; acc[6] += g1.z * w; acc[7] += g1.w * w;
      }
      float* o = p.btf() + ((size_t)l * NIN + 1024 + tid) * DM + k0;
      *(float4*)o = make_float4(acc[0], acc[1], acc[2], acc[3]); *(float4*)(o + 4) = make_float4(acc[4], acc[5], acc[6], acc[7]);
    }
    __syncthreads();
  }
}

enum { MAP_ID = 0, MAP_IN = 1, MAP_UQ = 2, MAP_UKV = 3, MAP_GU = 4 };
__device__ __forceinline__ int colmap(int mt, int n) {
  switch (mt) {
    case MAP_ID: return n;
    case MAP_IN:
      if (n < 256) return n;
      if (n < 384) return 256 + (n - 256);
      if (n < 512) return 1184 + (n - 384);
      if (n < 640) return 1312 + (n - 512);
      if (n < 672) return 384 + (n - 640);
      if (n < 768) return -1;
      if (n < 1024) return 1440 + (n - 768);
      if (n < 1280) return -2;
      if (n < 1536) return 1728 + (n - 1280);
      if (n < 2304) return 416 + (n - 1536);
      return -2;
    case MAP_UQ:
      if (n < 256) return (n >> 6) * 96 + (n & 63);
      if (n < 384) return ((n - 256) >> 5) * 96 + 64 + ((n - 256) & 31);
      return -1;
    case MAP_UKV:
      if (n < 256) return (n >> 6) * 128 + (n & 63);
      return ((n - 256) >> 6) * 128 + 64 + ((n - 256) & 63);
    default: {
      const int pn = n >> 8, w = n & 255;
      return w < 128 ? 2 * (pn * 128 + w) : 2 * (pn * 128 + w - 128) + 1;
    }
  }
}
__device__ __forceinline__ int invmap(int mt, int sc) {
  if (mt == MAP_ID) return sc;
  if (mt == MAP_GU) { const int j = sc >> 1, t = sc & 1; return (j >> 7) * 256 + t * 128 + (j & 127); }
  if (sc < 384) return sc;
  if (sc < 416) return 640 + (sc - 384);
  if (sc < 1184) return 1536 + (sc - 416);
  if (sc < 1312) return 384 + (sc - 1184);
  if (sc < 1440) return 512 + (sc - 1312);
  if (sc < 1696) return 768 + (sc - 1440);
  if (sc < 1728) return -1;
  if (sc < 1984) return 1280 + (sc - 1728);
  return -1;
}
struct ConvJob { const float* src; void* dst; const float* scale; int ld, K, mt, k0, s0, f32; };
__device__ __forceinline__ void conv_tile_load(const ConvJob& J, int tid, float4 (&v)[4]) {
  const int kk = tid >> 5, s4 = (tid & 31) * 4;
#pragma unroll
  for (int i = 0; i < 4; ++i) {
    v[i] = make_float4(0.f, 0.f, 0.f, 0.f);
    if (J.s0 + s4 < J.ld) v[i] = *(const float4*)(J.src + (size_t)(J.k0 + kk + 16 * i) * J.ld + J.s0 + s4);
  }
}
__device__ __forceinline__ void conv_tile_proc(const ConvJob& J, int tid, const float4 (&v)[4], float* tile  ) {
  {
    const int kk = tid >> 5, s4 = (tid & 31) * 4;
#pragma unroll
    for (int i = 0; i < 4; ++i) {
      const float sc = J.scale ? J.scale[J.k0 + kk + 16 * i] : 1.f;
      float* t = tile + (kk + 16 * i) * 129 + s4;
      t[0] = v[i].x * sc; t[1] = v[i].y * sc; t[2] = v[i].z * sc; t[3] = v[i].w * sc;
    }
  }
  __syncthreads();
#pragma unroll
  for (int h = 0; h < 2; ++h) {
    const int sl = (tid >> 3) + 64 * h, ks = (tid & 7) * 8, sc = J.s0 + sl;
    const int row = sc < J.ld ? invmap(J.mt, sc) : -1;
    if (row >= 0) {
      const float* t = tile + ks * 129 + sl;
      if (J.f32) {
        float* dst = (float*)J.dst + (size_t)row * J.K + J.k0 + ks;
        *(float4*)dst = make_float4(t[0], t[129], t[2 * 129], t[3 * 129]); *(float4*)(dst + 4) = make_float4(t[4 * 129], t[5 * 129], t[6 * 129], t[7 * 129]);
      } else {
        u32x4 w;
        w[0] = cvtpk(t[0], t[129]); w[1] = cvtpk(t[2 * 129], t[3 * 129]); w[2] = cvtpk(t[4 * 129], t[5 * 129]); w[3] = cvtpk(t[6 * 129], t[7 * 129]);
        *(u32x4*)((u16*)J.dst + (size_t)row * J.K + J.k0 + ks) = w;
      }
    }
  }
  __syncthreads();
}
constexpr int CT_IN = 16 * 18, CT_OUT = 16 * 8, CT_DN = NE * 128, CT_L = CT_IN + CT_OUT + CT_DN;
__device__ __forceinline__ void conv_decode(const Params& p, int t, ConvJob& J) {
  const int l = t / CT_L; int r = t % CT_L;
  if (r < CT_IN) { J.src = p.w_in() + (size_t)l * DM * DIN0; J.ld = DIN0; J.K = DM; J.dst = p.btf() + (size_t)l * NIN * DM; J.mt = MAP_IN; J.scale = nullptr; J.k0 = (r / 18) * 64; J.s0 = (r % 18) * 128; J.f32 = 1; return; }
  r -= CT_IN;
  if (r < CT_OUT) { J.src = p.w_out() + (size_t)l * DM * DM; J.ld = DM; J.K = DM; J.dst = p.bt_out() + (size_t)l * DM * DM; J.mt = MAP_ID; J.scale = p.mix_g() + l * DM; J.k0 = (r / 8) * 64; J.s0 = (r % 8) * 128; J.f32 = 0; return; }
  r -= CT_OUT;
  const int e = r >> 7, q = r & 127;
  J.src = p.moe_w_down() + ((size_t)l * NE + e) * DFF * DM; J.ld = DM; J.K = DFF; J.dst = p.bt_dn() + ((size_t)l * NE + e) * DM * DFF; J.mt = MAP_ID; J.scale = nullptr; J.k0 = (q >> 3) * 64; J.s0 = (q & 7) * 128; J.f32 = 0;
}
__device__ __forceinline__ void conv_gu8_load(const float* __restrict__ src  , int s0, int tid, float4 (&v)[16]) {
  const int c4 = (tid & 7) * 4, r0 = tid >> 3;
#pragma unroll
  for (int pss = 0; pss < 16; ++pss) v[pss] = *(const float4*)(src + (size_t)(r0 + 64 * pss) * 2048 + s0 + c4);
}
__device__ __forceinline__ void conv_gu8_proc(const float4 (&v)[16], signed char* __restrict__ dst  , float* __restrict__ sw  ,
                                              int s0, float* tile  , int tid) {
  float* cmax = tile + 1024 * 33;
  {
    const int c4 = (tid & 7) * 4, r0 = tid >> 3;
#pragma unroll
    for (int pss = 0; pss < 16; ++pss) { float* t = tile + (r0 + 64 * pss) * 33 + c4; t[0] = v[pss].x; t[1] = v[pss].y; t[2] = v[pss].z; t[3] = v[pss].w; }
  }
  __syncthreads();
  {
    const int col = tid & 31, part = tid >> 5; float m = 0.f;
#pragma unroll 8
    for (int k = part * 64; k < part * 64 + 64; ++k) m = fmaxf(m, fabsf(tile[k * 33 + col]));
    cmax[part * 32 + col] = m;
  }
  __syncthreads();
  if (tid < 32) {
    float m = 0.f;
#pragma unroll
    for (int q = 0; q < 16; ++q) m = fmaxf(m, cmax[q * 32 + tid]);
    const float sc = fmaxf(m, 1e-20f) * (1.f / 127.f);
    cmax[512 + tid] = sc;
    sw[invmap(MAP_GU, s0 + tid)] = sc;
  }
  __syncthreads();
#pragma unroll
  for (int h = 0; h < 4; ++h) {
    const int g = tid + 512 * h, col = g & 31, k0 = (g >> 5) * 16;
    const float inv = 1.f / cmax[512 + col];
    unsigned w[4];
#pragma unroll
    for (int q = 0; q < 4; ++q) {
      const float* t = tile + (k0 + 4 * q) * 33 + col;
      const int q0 = (int)rintf(t[0] * inv), q1 = (int)rintf(t[33] * inv), q2 = (int)rintf(t[66] * inv), q3 = (int)rintf(t[99] * inv);
      w[q] = (unsigned)(q0 & 255) | ((unsigned)(q1 & 255) << 8) | ((unsigned)(q2 & 255) << 16) | ((unsigned)(q3 & 255) << 24);
    }
    *(u32x4*)(dst + (size_t)invmap(MAP_GU, s0 + col) * DM + k0) = u32x4{w[0], w[1], w[2], w[3]};
  }
  __syncthreads();
}
__device__ __forceinline__ void phase_convert(const Params& p, int bid, int nb, char* lds) {
  float* tile = (float*)lds;
  const int tid = ltid();
  {
    ConvJob J, Jn; float4 v[4], vn[4];
    int t = bid;
    if (t < 2 * CT_L) { conv_decode(p, t, J); conv_tile_load(J, tid, v); }
    for (; t < 2 * CT_L; t += nb) {
      const bool more = t + nb < 2 * CT_L;
      if (more) { conv_decode(p, t + nb, Jn); conv_tile_load(Jn, tid, vn); }
      conv_tile_proc(J, tid, v, tile);
      if (more) { J = Jn;
#pragma unroll
        for (int i = 0; i < 4; ++i) v[i] = vn[i]; }
    }
  }
  {
    float4 v[16], vn[16];
    int t = bid;
    if (t < 2 * NE * 64) conv_gu8_load(p.moe_w_gu() + (size_t)(t >> 6) * DM * 2048, (t & 63) * 32, tid, v);
    for (; t < 2 * NE * 64; t += nb) {
      const bool more = t + nb < 2 * NE * 64; const int tn = t + nb;
      if (more) conv_gu8_load(p.moe_w_gu() + (size_t)(tn >> 6) * DM * 2048, (tn & 63) * 32, tid, vn);
      conv_gu8_proc(v, p.bt_gu() + (size_t)(t >> 6) * 2048 * DM, p.swgu() + (size_t)(t >> 6) * 2048, (t & 63) * 32, tile, tid);
      if (more) {
#pragma unroll
        for (int i = 0; i < 16; ++i) v[i] = vn[i]; }
    }
  }
  for (int l = 0; l < 2; ++l) {
    for (int i = bid * NTHR + tid; i < 96 * DM / 4; i += nb * NTHR) *(float4*)(p.btf() + ((size_t)l * NIN + 672) * DM + (size_t)i * 4) = make_float4(0.f, 0.f, 0.f, 0.f);
    {
      const float* wq = p.mla_w_uq() + (size_t)l * 256 * 384; const float* wkv = p.mla_w_ukv() + (size_t)l * 128 * 512;
      const float* gq = p.mla_q_g() + l * 256; const float* gkv = p.mla_kv_g() + l * 128;
      u16* dst = p.bt_qkv() + (size_t)l * 1024 * 384;
      for (int i = bid * NTHR + ltid(); i < 1024 * 384; i += nb * NTHR) {
        const int n = i / 384, k = i % 384; float v = 0.f;
        if (n < 512) { const int sc = colmap(MAP_UQ, n); if (k < 256 && sc >= 0) v = gq[k] * wq[k * 384 + sc]; }
        else { if (k >= 256) v = gkv[k - 256] * wkv[(k - 256) * 512 + colmap(MAP_UKV, n - 512)]; }
        dst[i] = f2bf(v);
      }
    }
  }
}

__device__ __forceinline__ void phase_hy_mlp(const Params& p, int l, int Lf, float* __restrict__ hout  , float* __restrict__ ssq  ,
                             int bid, int nb, char* lds) {
  float* zf = (float*)lds;
  float* h1 = zf + 64 * 33;
  float* h2 = h1 + 64 * 64;
  const int tid = ltid();
  const float* w1 = p.hy_w1() + (size_t)l * 33 * 64; const float* b1 = p.hy_b1() + l * 64;
  const float* w2 = p.hy_w2() + (size_t)l * 64 * 64; const float* b2 = p.hy_b2() + l * 64;
  const float* w3 = p.hy_w3() + (size_t)l * 64 * 512; const float* fr = p.hy_freq() + l * 64;
  float w3c[64];
#pragma unroll
  for (int k = 0; k < 64; ++k) w3c[k] = w3[k * 512 + tid];
  const int dir = tid >> 8, ch = tid & 255;
  const float maxd = logf(1e-2f) / 0.3f, mind = logf(1e-2f) / 1.5f;
  const float delta = fabsf(mind + (maxd - mind) * (float)ch / 255.f);
  float ssq_acc = 0.f;
  for (int it = bid; it < Lf / 64; it += nb) {
    const int t0 = it * 64;
    for (int i = tid; i < 64 * 33; i += NTHR) {
      const int tt = i / 33, f = i % 33, t = t0 + tt;
      float v;
      if (f == 0) v = (float)t / (float)(Lf - 1);
      else {
        const int j = (f - 1) & 15;
        const float fj = 1e-4f + (float)j * ((15.f - 1e-4f) / 15.f);
        const float w = 6.283185307179586f * (float)t / (float)Lf;
        v = (f <= 16) ? cosf(fj * w) : -sinf(fj * w);
      }
      zf[i] = v;
    }
    __syncthreads();
    {
      const int o = tid & 63, tb = tid >> 6;
      float acc[8];
#pragma unroll
      for (int j = 0; j < 8; ++j) acc[j] = b1[o];
#pragma unroll 3
      for (int f = 0; f < 33; ++f) {
        const float w = w1[f * 64 + o];
#pragma unroll
        for (int j = 0; j < 8; ++j) acc[j] += zf[(tb + 8 * j) * 33 + f] * w;
      }
      const float fo = fr[o];
#pragma unroll
      for (int j = 0; j < 8; ++j) h1[(tb + 8 * j) * 64 + o] = sinf(fo * acc[j]);
    }
    __syncthreads();
    {
      const int o = tid & 63, tb = tid >> 6;
      float acc[8];
#pragma unroll
      for (int j = 0; j < 8; ++j) acc[j] = b2[o];
#pragma unroll 4
      for (int f = 0; f < 64; f += 4) {
        const float wa = w2[f * 64 + o], wb = w2[(f + 1) * 64 + o], wc2 = w2[(f + 2) * 64 + o], wd = w2[(f + 3) * 64 + o];
#pragma unroll
        for (int j = 0; j < 8; ++j) { const float4 hv = *(const float4*)(h1 + (tb + 8 * j) * 64 + f); acc[j] += hv.x * wa + hv.y * wb + hv.z * wc2 + hv.w * wd; }
      }
      const float fo = fr[o];
#pragma unroll
      for (int j = 0; j < 8; ++j) h2[(tb + 8 * j) * 64 + o] = sinf(fo * acc[j]);
    }
    __syncthreads();
    float* orow = hout + ((size_t)dir * 256 + ch) * Lf + t0;
    for (int tq = 0; tq < 16; ++tq) {
      float sv[4];
#pragma unroll
      for (int u = 0; u < 4; ++u) {
        const int tt = tq * 4 + u;
        float s = 0;
#pragma unroll
        for (int k = 0; k < 64; k += 4) { const float4 hv = *(const float4*)(h2 + tt * 64 + k); s += hv.x * w3c[k] + hv.y * w3c[k + 1] + hv.z * w3c[k + 2] + hv.w * w3c[k + 3]; }
        const int t = t0 + tt;
        s *= __expf(-((float)t / (float)(Lf - 1)) * delta);
        if (dir == 0 || t > 0) ssq_acc += s * s;
        sv[u] = s;
      }
      *(float4*)(orow + tq * 4) = make_float4(sv[0], sv[1], sv[2], sv[3]);
    }
    __syncthreads();
  }
  ssq[(size_t)bid * 512 + tid] = ssq_acc;
}

__host__ __device__ constexpr int fx(int p) {
  return ((p >> 12) & 3) ^ (((p >> 10) & 3) << 2) ^ ((p >> 4) & 16) ^ (((p >> 5) & 1) * 5) ^ (((p >> 6) & 1) * 26);
}
__device__ __forceinline__ int swz(int p) { return p ^ fx(p); }
__device__ __forceinline__ int rev7(int k) {
  unsigned r = __brev((unsigned)k) >> 18;
  return (int)(((r & 0x2AAAu) >> 1) | ((r & 0x1555u) << 1));
}
template <int ST, bool INV>
__device__ __forceinline__ void fft_stage(float2* s, const float2* __restrict__ tw, const int tid) {
  constexpr int sh = 12 - 2 * ST, q = 1 << sh, ND = q >= 512 ? q / 512 : 1;
  float2 w1[ND], w2[ND], w3[ND];
  if constexpr (ST < 6) {
#pragma unroll
    for (int d = 0; d < ND; ++d) {
      const int j = q >= 512 ? tid + 512 * d : (tid & (q - 1)), ti = j << (2 * ST);
      w1[d] = tw[ti]; w2[d] = tw[2 * ti]; w3[d] = tw[3 * ti];
    }
  }
  float2 x[8][4];
#pragma unroll
  for (int m = 0; m < 8; ++m) {
    const int u = tid + 512 * m, g = u >> sh, j = u & (q - 1), base = (g << (sh + 2)) + j, xb = fx(base);
    x[m][0] = s[base ^ xb]; x[m][1] = s[(base + q) ^ xb ^ fx(q)]; x[m][2] = s[(base + 2 * q) ^ xb ^ fx(2 * q)]; x[m][3] = s[(base + 3 * q) ^ xb ^ fx(3 * q)];
  }
#pragma unroll
  for (int m = 0; m < 8; ++m) {
    const int u = tid + 512 * m, g = u >> sh, j = u & (q - 1), base = (g << (sh + 2)) + j, xb = fx(base);
    const int i0 = base ^ xb, i1 = (base + q) ^ xb ^ fx(q), i2 = (base + 2 * q) ^ xb ^ fx(2 * q), i3 = (base + 3 * q) ^ xb ^ fx(3 * q);
    const int d = q >= 512 ? (m % ND) : 0;
    if constexpr (!INV) {
      const float2 a0 = x[m][0], a1 = x[m][1], a2 = x[m][2], a3 = x[m][3];
      const float2 b0 = make_float2(a0.x + a2.x, a0.y + a2.y), b1 = make_float2(a0.x - a2.x, a0.y - a2.y);
      const float2 b2 = make_float2(a1.x + a3.x, a1.y + a3.y), b3 = make_float2(a1.x - a3.x, a1.y - a3.y);
      const float2 y1 = make_float2(b1.x + b3.y, b1.y - b3.x), y2 = make_float2(b0.x - b2.x, b0.y - b2.y), y3 = make_float2(b1.x - b3.y, b1.y + b3.x);
      s[i0] = make_float2(b0.x + b2.x, b0.y + b2.y);
      if constexpr (ST < 6) { s[i1] = cmul(y1, w1[d]); s[i2] = cmul(y2, w2[d]); s[i3] = cmul(y3, w3[d]); }
      else { s[i1] = y1; s[i2] = y2; s[i3] = y3; }
    } else {
      float2 t0 = x[m][0], t1 = x[m][1], t2 = x[m][2], t3 = x[m][3];
      if constexpr (ST < 6) { t1 = cmulc(t1, w1[d]); t2 = cmulc(t2, w2[d]); t3 = cmulc(t3, w3[d]); }
      const float2 b0 = make_float2(t0.x + t2.x, t0.y + t2.y), b1 = make_float2(t0.x - t2.x, t0.y - t2.y);
      const float2 b2 = make_float2(t1.x + t3.x, t1.y + t3.y), b3 = make_float2(t1.x - t3.x, t1.y - t3.y);
      s[i0] = make_float2(b0.x + b2.x, b0.y + b2.y);
      s[i1] = make_float2(b1.x - b3.y, b1.y + b3.x);
      s[i2] = make_float2(b0.x - b2.x, b0.y - b2.y);
      s[i3] = make_float2(b1.x + b3.y, b1.y - b3.x);
    }
  }
  __syncthreads();
}
__device__ __forceinline__ void fft_fwd(float2* s, const float2* __restrict__ tw) {
  const int tid = ltid();
  fft_stage<0, false>(s, tw, tid); fft_stage<1, false>(s, tw, tid); fft_stage<2, false>(s, tw, tid); fft_stage<3, false>(s, tw, tid);
  fft_stage<4, false>(s, tw, tid); fft_stage<5, false>(s, tw, tid); fft_stage<6, false>(s, tw, tid);
}
__device__ __forceinline__ void fft_inv(float2* s, const float2* __restrict__ tw) {
  const int tid = ltid();
  fft_stage<6, true>(s, tw, tid); fft_stage<5, true>(s, tw, tid); fft_stage<4, true>(s, tw, tid); fft_stage<3, true>(s, tw, tid);
  fft_stage<2, true>(s, tw, tid); fft_stage<1, true>(s, tw, tid); fft_stage<0, true>(s, tw, tid);
}

__device__ __forceinline__ float filt_ssq(const float* __restrict__ part  , int ch, float* red  ) {
  const int tid = ltid();
  float v = part[(size_t)(tid >> 1) * 512 + (tid & 1) * 256 + ch];
  v = wave_sum(v);
  __syncthreads();
  if ((tid & 63) == 0) red[tid >> 6] = v;
  __syncthreads();
  return ((red[0] + red[1]) + (red[2] + red[3])) + ((red[4] + red[5]) + (red[6] + red[7]));
}
__device__ __forceinline__ void phase_hy_filtfft(const Params& p, int bid, int nb, char* lds) {
  float2* s = (float2*)lds;
  const int tid = ltid();
  for (int it = bid; it < 512; it += nb) {
    const int l = it >> 8, ch = it & 255;
    const float* hf = p.hfb() + (((size_t)l * 2 + 0) * 256 + ch) * SEQ;
    const float* hb = p.hfb() + (((size_t)l * 2 + 1) * 256 + ch) * SEQ;
#pragma unroll 8
    for (int m = tid; m < FM; m += NTHR) {
      const int n0 = 2 * m, n1 = 2 * m + 1;
      const float a = (n0 < SEQ) ? hf[n0] : (n0 == SEQ ? 0.f : hb[2 * SEQ - n0]);
      const float b = (n1 < SEQ) ? hf[n1] : hb[2 * SEQ - n1];
      s[swz(m)] = make_float2(a, b);
    }
    __syncthreads();
    fft_fwd(s, p.tw());
    const float sc = rsqrtf(filt_ssq(p.hpart() + (size_t)l * 256 * 512, ch, (float*)(lds + 139264))) * (1.f / 16384.f);
    float4* out = p.hspec() + ((size_t)l * 256 + ch) * HSP;
#pragma unroll 4
    for (int k = tid; k <= FM / 2; k += NTHR) {
      const float2 zk = s[swz(rev7(k))], zm = s[swz(rev7((FM - k) & (FM - 1)))];
      const float er = 0.5f * (zk.x + zm.x), ei = 0.5f * (zk.y - zm.y);
      const float dr = 0.5f * (zk.x - zm.x), di = 0.5f * (zk.y + zm.y);
      out[k] = make_float4(er * sc, ei * sc, di * sc, -dr * sc);
    }
    __syncthreads();
  }
}
constexpr int G_TILE_B = 256 * 64 * 2;
constexpr int G_STAGE_B = 2 * G_TILE_B;
constexpr int GEMM_LDS = 2 * G_STAGE_B;

__device__ __forceinline__ int lds_byte2(int r, int c) {
  const int st = (r >> 4) * 2 + (c >> 5), ob = (r & 15) * 64 + (c & 31) * 2;
  return st * 1024 + (ob ^ (((ob >> 9) & 1) << 5));
}
__device__ __forceinline__ void stage_rc2(int b, int& R, int& C) {
  const int st = b >> 10, sb = b & 1023, swz = sb ^ (((sb >> 9) & 1) << 5);
  R = (st >> 1) * 16 + (swz >> 6);
  C = (st & 1) * 32 + ((swz & 63) >> 1);
}
__device__ __forceinline__ void gemm_stage_coords(int (&sR)[4], int (&sC)[4]) {
  const int wid = ltid() >> 6, lane = ltid() & 63;
#pragma unroll
  for (int i = 0; i < 4; ++i) stage_rc2(wid * 1024 + i * 8192 + lane * 16, sR[i], sC[i]);
}

#define WAIT_V0() asm volatile("s_waitcnt vmcnt(0)" ::: "memory")

__device__ __forceinline__ void gemm256_core(const u16* const (&ap)[4], const u16* const (&bp)[4], int nt, char* shm, f32x4 (&acc)[8][4]) {
  const int tid = ltid(), wid = tid >> 6, lane = tid & 63, wr = wid >> 2, wc = wid & 3, fr = lane & 15, fq = lane >> 4;
#pragma unroll
  for (int m = 0; m < 8; ++m)
#pragma unroll
    for (int n = 0; n < 4; ++n) acc[m][n] = f32x4{0.f, 0.f, 0.f, 0.f};
#define G_SA(b) (shm + (b) * G_STAGE_B)
#define G_SB(b) (shm + (b) * G_STAGE_B + G_TILE_B)
#define G_STAGE(buf, kt) do { _Pragma("unroll") for (int i = 0; i < 4; ++i) {                                                   \
    __builtin_amdgcn_global_load_lds((const unsigned*)(ap[i] + (kt) * 64), (unsigned*)(G_SA(buf) + wid * 1024 + i * 8192), 16, 0, 0); \
    __builtin_amdgcn_global_load_lds((const unsigned*)(bp[i] + (kt) * 64), (unsigned*)(G_SB(buf) + wid * 1024 + i * 8192), 16, 0, 0); } } while (0)
  G_STAGE(0, 0); WAIT_V0(); __syncthreads();
#pragma unroll 1
  for (int t = 0; t < nt; ++t) {
    const int cur = t & 1;
    if (t + 1 < nt) G_STAGE(cur ^ 1, t + 1);
#pragma unroll
    for (int ks = 0; ks < 2; ++ks) {
      bf16x8 At[8], Bf[4];
#pragma unroll
      for (int m = 0; m < 8; ++m) At[m] = *(const bf16x8*)(G_SA(cur) + lds_byte2(wr * 128 + m * 16 + fr, ks * 32 + fq * 8));
#pragma unroll
      for (int n = 0; n < 4; ++n) Bf[n] = *(const bf16x8*)(G_SB(cur) + lds_byte2(wc * 64 + n * 16 + fr, ks * 32 + fq * 8));
#pragma unroll
      for (int m = 0; m < 8; ++m)
#pragma unroll
        for (int n = 0; n < 4; ++n) acc[m][n] = __builtin_amdgcn_mfma_f32_16x16x32_bf16(At[m], Bf[n], acc[m][n], 0, 0, 0);
      __builtin_amdgcn_sched_barrier(0);
    }
    WAIT_V0(); __syncthreads();
  }
#undef G_STAGE
}

#define LAS3 __attribute__((address_space(3)))
constexpr int G8_HTB = 128 * 64 * 2;
__device__ __forceinline__ int g8_perm32(int rho) { const int n = rho >> 4, i = rho & 15; return 8 * (i >> 2) + 4 * n + (i & 3); }
__device__ __forceinline__ int g8_lds_byte(int r, int c) { const int st = (r >> 4) * 2 + (c >> 5), rr = r & 15, cc = c & 31, ob = rr * 64 + cc * 2; return st * 1024 + (ob ^ (((ob >> 9) & 1) << 5)); }
__device__ __forceinline__ void g8_stage_rc(int b, int& R, int& C) { const int st = b / 1024, sb = b % 1024, swz = sb ^ (((sb >> 9) & 1) << 5); R = (st >> 1) * 16 + swz / 64; C = (st & 1) * 32 + (swz % 64) / 2; }
struct G8Unit { int pm, pn, e, ce, pre; };
__device__ __forceinline__ void g8_cload(const float* __restrict__ src, float* dst) {
  __builtin_amdgcn_global_load_lds((const unsigned*)(src + (ltid() & 63) * 4), (LAS3 unsigned*)dst, 16, 0, 0);
}


template <bool I8> __device__ __forceinline__ typename std::conditional<I8, int __attribute__((ext_vector_type(4))), f32x4>::type
g8_mma(bf16x8 x, bf16x8 y, typename std::conditional<I8, int __attribute__((ext_vector_type(4))), f32x4>::type c) {
  if constexpr (I8) { typedef int v4i __attribute__((ext_vector_type(4))); return __builtin_amdgcn_mfma_i32_16x16x64_i8(*(v4i*)&x, *(v4i*)&y, c, 0, 0, 0); }
  else return __builtin_amdgcn_mfma_f32_16x16x32_bf16(x, y, c, 0, 0, 0);
}
typedef int i32x4 __attribute__((ext_vector_type(4)));
template <bool I8> struct G8Acc { typedef f32x4 T; };
template <> struct G8Acc<true> { typedef i32x4 T; };
template <bool I8, class Sched, class Epi>
__device__ __forceinline__ void gemm8_phase(char* lds_g, const char* Abase, const int Kb, const Sched& S, const Epi& E) {
    typedef typename G8Acc<I8>::T ACC;
    LAS3 unsigned char* lds = (LAS3 unsigned char*)lds_g;
    const int tid = ltid(), wid = __builtin_amdgcn_readfirstlane(tid >> 6), lane = tid & 63, wr = wid >> 2, wc = wid & 3, fr = lane & 15, fq = lane >> 4;
    const int nt = Kb / 128;
    int sRr[2], sCc[2]; unsigned voffB[2];
#pragma unroll
    for (int i = 0; i < 2; ++i) { g8_stage_rc(tid * 16 + i * 8192, sRr[i], sCc[i]); const int Rb = (sRr[i] & ~31) + g8_perm32(sRr[i] & 31); voffB[i] = (unsigned)(Rb * Kb) + (unsigned)sCc[i] * 2u; }
    const size_t kstep = 128;
    const size_t hstepB = (size_t)128 * Kb;
    const unsigned ldsw = (unsigned)wid * 1024u;
    const int aoff = g8_lds_byte(wr * 64 + fr, fq * 8), boff = g8_lds_byte(wc * 32 + fr, fq * 8);
#define G8_SA(b, h) (((b) * 2 + (h)) * G8_HTB)
#define G8_SB(b, h) ((4 + (b) * 2 + (h)) * G8_HTB)
#define G8_STAGE_B(bufoff, gbase) do { _Pragma("unroll") for (int _i = 0; _i < 2; ++_i) \
        __builtin_amdgcn_global_load_lds((const unsigned*)((const char*)(gbase) + voffB[_i]), (LAS3 unsigned*)(lds + (bufoff) + ldsw + _i * 8192), 16, 0, 0); } while (0)
#define G8_STAGE_A(bufoff, o0, o1) do { \
        __builtin_amdgcn_global_load_lds((const unsigned*)(Abase + (o0)), (LAS3 unsigned*)(lds + (bufoff) + ldsw), 16, 0, 0); \
        __builtin_amdgcn_global_load_lds((const unsigned*)(Abase + (o1)), (LAS3 unsigned*)(lds + (bufoff) + ldsw + 8192), 16, 0, 0); } while (0)
#define G8_LDA(dst, b, h) do { _Pragma("unroll") for (int m = 0; m < 4; ++m) _Pragma("unroll") for (int k = 0; k < 2; ++k) dst[m][k] = *(const LAS3 bf16x8*)(lds + G8_SA(b, h) + aoff + m * 2048 + k * 1024); } while (0)
#define G8_LDB(dst, b, h) do { _Pragma("unroll") for (int n = 0; n < 2; ++n) _Pragma("unroll") for (int k = 0; k < 2; ++k) dst[n][k] = *(const LAS3 bf16x8*)(lds + G8_SB(b, h) + boff + n * 2048 + k * 1024); } while (0)
#define G8_MMA(ai, bj, At, Bt) do { __builtin_amdgcn_s_setprio(1); _Pragma("unroll") for (int m = 0; m < 4; ++m) _Pragma("unroll") for (int n = 0; n < 2; ++n) _Pragma("unroll") for (int k = 0; k < 2; ++k) \
        acc[ai][bj][m][n] = g8_mma<I8>(Bt[n][k], At[m][k], acc[ai][bj][m][n]); __builtin_amdgcn_s_setprio(0); } while (0)
#define G8_WAIT_V(n) asm volatile("s_waitcnt vmcnt(" #n ")" ::: "memory")
#define G8_WAIT_L(n) asm volatile("s_waitcnt lgkmcnt(" #n ")" ::: "memory")
#define G8_BAR __builtin_amdgcn_s_barrier()
#define G8_SCHED __builtin_amdgcn_sched_barrier(0)
    G8Unit cur, nxt; int ui = 0;
    if (!S.next(0, cur)) return;
    ACC acc[2][2][4][2];
#pragma unroll
    for (int a = 0; a < 2; ++a)
#pragma unroll
        for (int b = 0; b < 2; ++b)
#pragma unroll
            for (int m = 0; m < 4; ++m)
#pragma unroll
                for (int n = 0; n < 2; ++n) acc[a][b][m][n] = ACC{};
    bf16x8 At[4][2], B0[2][2], B1[2][2];
    float ep[8];
    unsigned va[2][2], vn[2][2];
#pragma unroll
    for (int h = 0; h < 2; ++h)
#pragma unroll
        for (int i = 0; i < 2; ++i) va[h][i] = S.a_off(cur, h * 128 + sRr[i]) + (unsigned)sCc[i] * 2u;
    const char* cB = S.b_ptr(cur);
    G8_STAGE_B(G8_SB(0, 0), cB); G8_STAGE_A(G8_SA(0, 0), va[0][0], va[0][1]); G8_STAGE_B(G8_SB(0, 1), cB + hstepB); G8_STAGE_A(G8_SA(0, 1), va[1][0], va[1][1]);
    if (wr == 1) G8_BAR;
    G8_WAIT_V(4); G8_BAR;
    G8_STAGE_B(G8_SB(1, 0), cB + kstep); G8_STAGE_A(G8_SA(1, 0), va[0][0] + kstep, va[0][1] + kstep); G8_STAGE_B(G8_SB(1, 1), cB + hstepB + kstep);
    G8_WAIT_V(6); G8_BAR;
    for (;;) {
        float* cb = (float*)(lds_g + 136192 + (ui & 1) * 2048);
        E.pre(cur, wr, fr, ep, cb);
        const bool has_next = S.next(ui + 1, nxt);
        const char* nB = cB;
#pragma unroll
        for (int h = 0; h < 2; ++h)
#pragma unroll
            for (int i = 0; i < 2; ++i) vn[h][i] = va[h][i];
        if (has_next) {
            nB = S.b_ptr(nxt);
#pragma unroll
            for (int h = 0; h < 2; ++h)
#pragma unroll
                for (int i = 0; i < 2; ++i) vn[h][i] = S.a_off(nxt, h * 128 + sRr[i]) + (unsigned)sCc[i] * 2u;
        }
#pragma unroll 1
        for (int t = 0; t < nt; t += 2) {
            const bool last = (t == nt - 2);
            const unsigned k1 = (unsigned)(t + 1) * 128u;
            const unsigned k2 = last ? 0u : (unsigned)(t + 2) * 128u;
            const unsigned a2_00 = (last ? vn[0][0] : va[0][0]) + k2, a2_01 = (last ? vn[0][1] : va[0][1]) + k2;
            const unsigned a2_10 = (last ? vn[1][0] : va[1][0]) + k2, a2_11 = (last ? vn[1][1] : va[1][1]) + k2;
            const char* b2 = (last ? nB : cB) + k2; const char* b3 = b2 + kstep;
            G8_LDB(B0, 0, 0); G8_SCHED; G8_LDA(At, 0, 0); G8_STAGE_A(G8_SA(1, 1), va[1][0] + k1, va[1][1] + k1);
            G8_WAIT_L(8); G8_BAR; G8_WAIT_L(0); G8_MMA(0, 0, At, B0); G8_BAR; G8_SCHED;
            G8_LDB(B1, 0, 1); G8_STAGE_B(G8_SB(0, 0), b2);
            G8_BAR; G8_WAIT_L(0); G8_MMA(0, 1, At, B1); G8_BAR;
            G8_LDA(At, 0, 1); G8_STAGE_A(G8_SA(0, 0), a2_00, a2_01);
            G8_BAR; G8_WAIT_L(0); G8_MMA(1, 0, At, B0); G8_BAR; G8_SCHED;
            G8_STAGE_B(G8_SB(0, 1), b2 + hstepB);
            G8_WAIT_V(6); G8_BAR; G8_MMA(1, 1, At, B1); G8_BAR;
            G8_LDB(B0, 1, 0); G8_SCHED; G8_LDA(At, 1, 0); G8_STAGE_A(G8_SA(0, 1), a2_10, a2_11);
            G8_WAIT_L(8); G8_BAR; G8_WAIT_L(0); G8_MMA(0, 0, At, B0); G8_BAR; G8_SCHED;
            G8_LDB(B1, 1, 1); G8_STAGE_B(G8_SB(1, 0), b3);
            G8_BAR; G8_WAIT_L(0); G8_MMA(0, 1, At, B1); G8_BAR;
            G8_LDA(At, 1, 1); G8_STAGE_A(G8_SA(1, 0), a2_00 + 128u, a2_01 + 128u);
            G8_BAR; G8_WAIT_L(0); G8_MMA(1, 0, At, B0); G8_BAR; G8_SCHED;
            G8_STAGE_B(G8_SB(1, 1), b3 + hstepB);
            G8_WAIT_V(6); G8_BAR; G8_MMA(1, 1, At, B1); G8_BAR;
        }
        E(acc, cur, wr, wc, fr, fq, ep, cb);
        if (!has_next) break;
#pragma unroll
        for (int a = 0; a < 2; ++a)
#pragma unroll
            for (int b = 0; b < 2; ++b)
#pragma unroll
                for (int m = 0; m < 4; ++m)
#pragma unroll
                    for (int n = 0; n < 2; ++n) acc[a][b][m][n] = ACC{};
        cur = nxt; cB = nB; ++ui;
#pragma unroll
        for (int h = 0; h < 2; ++h)
#pragma unroll
            for (int i = 0; i < 2; ++i) va[h][i] = vn[h][i];
    }
    G8_WAIT_V(0);
    if (wr == 0) G8_BAR;
    G8_BAR;
#undef G8_SA
#undef G8_SB
#undef G8_STAGE_A
#undef G8_STAGE_B
#undef G8_LDA
#undef G8_LDB
#undef G8_MMA
#undef G8_WAIT_V
#undef G8_WAIT_L
#undef G8_BAR
#undef G8_SCHED
}
struct G8Plain {
    int nM, nN, Kb, G, c; const char* Bt;
    __device__ __forceinline__ bool next(int i, G8Unit& u) const {
        const int L = (i * 8 + (c & 7)) * (G >> 3) + (c >> 3); if (L >= nM * nN) return false;
        const int nig = 8 * nN, gid = L / nig, fm = gid * 8, gsz = (nM - fm) < 8 ? (nM - fm) : 8;
        u.pm = fm + ((L % nig) % gsz); u.pn = (L % nig) / gsz; u.e = 0; u.ce = 256; u.pre = 0; return true;
    }
    __device__ __forceinline__ unsigned a_off(const G8Unit& u, int row) const { return (unsigned)(u.pm * 256 + row) * (unsigned)Kb; }
    __device__ __forceinline__ const char* b_ptr(const G8Unit& u) const { return Bt + (size_t)u.pn * 256 * Kb; }
};

__device__ __forceinline__ const float* resid_row_in(const Params& p, int tok) {
  return tok < TL ? p.x() + (size_t)tok * DM : p.ctx() + (size_t)(tok - TL) * DM;
}
__device__ __forceinline__ void load_row_comb(const Params& p, int src_layer, int lc, int tok, int lane, const int* pre  , float (&v)[16]) {
  if (src_layer == 0) {
    const float* r = resid_row_in(p, tok);
#pragma unroll
    for (int i = 0; i < 4; ++i) { const float4 a = *(const float4*)(r + lane * 4 + i * 256); v[4 * i] = a.x; v[4 * i + 1] = a.y; v[4 * i + 2] = a.z; v[4 * i + 3] = a.w; }
  } else {
    const u16* r = p.X() + (size_t)tok * DM;
#pragma unroll
    for (int i = 0; i < 4; ++i) { const float4 a = ld4bf(r + lane * 4 + i * 256); v[4 * i] = a.x; v[4 * i + 1] = a.y; v[4 * i + 2] = a.z; v[4 * i + 3] = a.w; }
  }
  if (lc >= 0) {
    const float* g2 = p.mod() + ((size_t)lc * 3 + modv(tok)) * 6144 + 5 * DM;
    float s[16];
#pragma unroll
    for (int i = 0; i < 16; ++i) s[i] = 0.f;
#pragma unroll
    for (int k = 0; k < TOPK; ++k) {
      const int sl = p.tslot()[tok * 4 + k];
      const size_t arow = (size_t)(pre[sl >> 20] + (sl & 0xFFFFF));
      const unsigned char* y = p.yd() + arow * DM;
#pragma unroll
      for (int i = 0; i < 4; ++i) {
        const int w = *(const int*)(y + lane * 4 + i * 256);
        const auto lo = __builtin_amdgcn_cvt_pk_f32_fp8(w, false), hi2 = __builtin_amdgcn_cvt_pk_f32_fp8(w, true);
        s[4 * i] += lo[0]; s[4 * i + 1] += lo[1]; s[4 * i + 2] += hi2[0]; s[4 * i + 3] += hi2[1];
      }
    }
#pragma unroll
    for (int i = 0; i < 4; ++i) {
      const float4 g = *(const float4*)(g2 + lane * 4 + i * 256);
      v[4 * i] += g.x * 0.125f * s[4 * i]; v[4 * i + 1] += g.y * 0.125f * s[4 * i + 1]; v[4 * i + 2] += g.z * 0.125f * s[4 * i + 2]; v[4 * i + 3] += g.w * 0.125f * s[4 * i + 3];
    }
  }
}
__device__ __forceinline__ void expert_prefix(const int* cnt, int* pre) {
  if (ltid() == 0) { int s = 0; for (int e = 0; e < NE; ++e) { pre[e] = s; s += cnt[e]; } pre[NE] = s; }
}

__device__ __forceinline__ float store_row_i8(const float (&y)[16], signed char* __restrict__ h, float* __restrict__ hs_row, int lane) {
  float am = 0.f;
#pragma unroll
  for (int i = 0; i < 16; ++i) am = fmaxf(am, fabsf(y[i]));
  am = wave_max(am);
  const float s = fmaxf(am, 1e-20f) * (1.f / 127.f), inv = 1.f / s;
#pragma unroll
  for (int i = 0; i < 4; ++i) {
    const int q0 = (int)rintf(y[4 * i] * inv), q1 = (int)rintf(y[4 * i + 1] * inv), q2 = (int)rintf(y[4 * i + 2] * inv), q3 = (int)rintf(y[4 * i + 3] * inv);
    *(unsigned*)(h + lane * 4 + i * 256) = (unsigned)(q0 & 255) | ((unsigned)(q1 & 255) << 8) | ((unsigned)(q2 & 255) << 16) | ((unsigned)(q3 & 255) << 24);
  }
  if (lane == 0) *hs_row = s;
  return s;
}
__device__ __forceinline__ void phase_quant_in(const Params& p, int bid, int nb) {
  const int wid = ltid() >> 6, lane = ltid() & 63;
  for (int r = bid * 8 + wid; r < 2 * NIN; r += nb * 8) {
    const float* src = p.btf() + (size_t)r * DM;
    float y[16];
#pragma unroll
    for (int i = 0; i < 4; ++i) { const float4 a = *(const float4*)(src + lane * 4 + i * 256); y[4 * i] = a.x; y[4 * i + 1] = a.y; y[4 * i + 2] = a.z; y[4 * i + 3] = a.w; }
    store_row_i8(y, p.bt_in() + (size_t)r * DM, p.swin() + r, lane);
  }
}
__device__ __forceinline__ void phase_norm1(const Params& p, int layer, int bid, int nb, char* lds) {
  int* pre = (int*)lds;
  const int lc = layer - 1;
  if (lc >= 0) { expert_prefix(p.cnt() + lc * NE, pre); __syncthreads(); }
  const int wid = ltid() >> 6, lane = ltid() & 63;
  const float* gn = p.norm1_g() + layer * DM;
  const int ntok = TT;
  for (int tok = bid * 8 + wid; tok < ntok; tok += nb * 8) {
    float v[16];
    load_row_comb(p, layer == 0 ? 0 : 1, lc, tok, lane, pre, v);
    if (lc >= 0) {
      u16* xr = p.X() + (size_t)tok * DM;
#pragma unroll
      for (int i = 0; i < 4; ++i) *(u32x2*)(xr + lane * 4 + i * 256) = u32x2{cvtpk(v[4 * i], v[4 * i + 1]), cvtpk(v[4 * i + 2], v[4 * i + 3])};
    }
    float ss = 0;
#pragma unroll
    for (int i = 0; i < 16; ++i) ss += v[i] * v[i];
    ss = wave_sum(ss);
    const float rs = rsqrtf(ss * (1.f / DM) + EPS);
    const float* md = p.mod() + ((size_t)layer * 3 + modv(tok)) * 6144;
#pragma unroll
    for (int i = 0; i < 4; ++i) {
      const int c = lane * 4 + i * 256;
      const float4 g = *(const float4*)(gn + c), sh = *(const float4*)(md + c), sc = *(const float4*)(md + DM + c);
      v[4 * i] = v[4 * i] * rs * g.x * (1.f + sc.x) + sh.x; v[4 * i + 1] = v[4 * i + 1] * rs * g.y * (1.f + sc.y) + sh.y;
      v[4 * i + 2] = v[4 * i + 2] * rs * g.z * (1.f + sc.z) + sh.z; v[4 * i + 3] = v[4 * i + 3] * rs * g.w * (1.f + sc.w) + sh.w;
    }
    store_row_i8(v, p.H() + (size_t)tok * DM, p.hs() + tok, lane);
  }
}

struct EpiIn {
  u16* zqkv; u16* zg; u16* zt; const float* hs; const float* sw;
  __device__ __forceinline__ void pre(const G8Unit& u, int wr, int fr, float (&ep)[8], float* cb) const {
    if ((ltid() >> 6) == 0) g8_cload(sw + u.pn * 256, cb);
#pragma unroll
    for (int ai = 0; ai < 2; ++ai)
#pragma unroll
      for (int m = 0; m < 4; ++m) ep[ai * 4 + m] = hs[u.pm * 256 + ai * 128 + wr * 64 + m * 16 + fr];
  }
  __device__ __forceinline__ void operator()(const i32x4 (&acc)[2][2][4][2], const G8Unit& u, int wr, int wc, int fr, int fq, const float (&ep)[8], const float* cb) const {
#pragma unroll
    for (int bj = 0; bj < 2; ++bj) {
      const int c32 = u.pn * 256 + bj * 128 + wc * 32, c0 = c32 + 8 * fq;
      const f32x4 w0 = *(const f32x4*)(cb + bj * 128 + wc * 32 + 8 * fq), w1 = *(const f32x4*)(cb + bj * 128 + wc * 32 + 8 * fq + 4);
#pragma unroll
      for (int ai = 0; ai < 2; ++ai)
#pragma unroll
        for (int m = 0; m < 4; ++m) {
          const int row = u.pm * 256 + ai * 128 + wr * 64 + m * 16 + fr;
          f32x4 a, b;
#pragma unroll
          for (int j = 0; j < 4; ++j) { a[j] = (float)acc[ai][bj][m][0][j] * ep[ai * 4 + m] * w0[j]; b[j] = (float)acc[ai][bj][m][1][j] * ep[ai * 4 + m] * w1[j]; }
          if (c32 < 384) {
            *(u32x4*)(zqkv + (size_t)row * 384 + c0) = u32x4{cvtpk(a[0], a[1]), cvtpk(a[2], a[3]), cvtpk(b[0], b[1]), cvtpk(b[2], b[3])};
          } else if (c32 < 1536) {
            *(u32x4*)(zg + (size_t)row * ZG_W + (c0 - 384)) = u32x4{cvtpk(a[0], a[1]), cvtpk(a[2], a[3]), cvtpk(b[0], b[1]), cvtpk(b[2], b[3])};
          } else {
#pragma unroll
            for (int j = 0; j < 4; ++j) { zt[(size_t)(c0 - 1536 + j) * TT + row] = f2bf(a[j]); zt[(size_t)(c0 - 1536 + 4 + j) * TT + row] = f2bf(b[j]); }
          }
        }
    }
  }
};
__device__ __forceinline__ void phase_gemm_in(const Params& p, int layer, int bid, int nb, char* lds) {
  G8Plain S; S.nM = TT / 256; S.nN = NIN / 256; S.Kb = DM; S.G = nb; S.c = bid; S.Bt = (const char*)(p.bt_in() + (size_t)layer * NIN * DM);
  EpiIn E; E.zqkv = p.zqkv(); E.zg = p.zg(); E.zt = p.zt(); E.hs = p.hs(); E.sw = p.swin() + layer * NIN;
  gemm8_phase<true>(lds, (const char*)p.H(), DM, S, E);
}

__device__ __forceinline__ size_t qkv_row(int tok, int h) {
  const int b = tok < TL ? (tok >> 14) : ((tok - TL) >> 8);
  const int s = tok < TL ? (tok & (SEQ - 1)) : SEQ + ((tok - TL) & (LC - 1));
  return ((size_t)(b * 4 + h)) * SKV + s;
}
struct EpiQkv {
  const u16* zqkv; u16* Q; u16* KV; const float* ropec; const float* ropes; float* rsl;
  unsigned* kmx;
  __device__ __forceinline__ void pre(const G8Unit&, int, int, float (&)[8], float*) const {}
  __device__ __forceinline__ void operator()(const f32x4 (&acc)[2][2][4][2], const G8Unit& u, int wr, int wc, int fr, int fq, const float (&)[8], const float*) const {
    const int tid = ltid();
    {
      const int r = tid >> 1, half = tid & 1;
      const u16* row = zqkv + (size_t)(u.pm * 256 + r) * 384;
      float sq = 0, sk = 0;
#pragma unroll
      for (int i = 0; i < 16; ++i) {
        const u32x4 w = *(const u32x4*)(row + half * 128 + i * 8);
#pragma unroll
        for (int q = 0; q < 4; ++q) { const float a = __uint_as_float(w[q] << 16), b = __uint_as_float(w[q] & 0xFFFF0000u); sq += a * a + b * b; }
      }
#pragma unroll
      for (int i = 0; i < 8; ++i) {
        const u32x4 w = *(const u32x4*)(row + 256 + half * 64 + i * 8);
#pragma unroll
        for (int q = 0; q < 4; ++q) { const float a = __uint_as_float(w[q] << 16), b = __uint_as_float(w[q] & 0xFFFF0000u); sk += a * a + b * b; }
      }
      sq += shx<1>(sq); sk += shx<1>(sk);
      if (half == 0) { rsl[r] = rsqrtf(sq * (1.f / 256.f) + EPS); rsl[256 + r] = rsqrtf(sk * (1.f / 128.f) + EPS); }
    }
    asm volatile("s_waitcnt lgkmcnt(0)" ::: "memory"); __builtin_amdgcn_s_barrier(); __builtin_amdgcn_s_barrier(); asm volatile("" ::: "memory");
    const float* rsp = rsl + (u.pn >= 2 ? 256 : 0);
#pragma unroll
    for (int ai = 0; ai < 2; ++ai)
#pragma unroll
      for (int m = 0; m < 4; ++m) {
        const int rl = ai * 128 + wr * 64 + m * 16 + fr, tok = u.pm * 256 + rl;
        const float rs = rsp[rl] * (u.pn < 2 ? A_QSCALE : 1.f);
        if (u.pn == 1) {
          f32x4 a = acc[ai][0][m][0] * rs, b = acc[ai][0][m][1] * rs;
          f32x4 pa, pb;
#pragma unroll
          for (int j = 0; j < 4; ++j) { pa[j] = shx<32>(a[j]); pb[j] = shx<32>(b[j]); }
          f32x4 ca = {1.f, 1.f, 1.f, 1.f}, cb = ca, sa = {0.f, 0.f, 0.f, 0.f}, sb = sa;
          if (tok < TL) {
            const float* cp = ropec + (size_t)(tok & (SEQ - 1)) * 16 + 8 * (fq & 1); const float* sp = ropes + (size_t)(tok & (SEQ - 1)) * 16 + 8 * (fq & 1);
            ca = *(const f32x4*)cp; cb = *(const f32x4*)(cp + 4); sa = *(const f32x4*)sp; sb = *(const f32x4*)(sp + 4);
          }
          const float sg = fq < 2 ? -1.f : 1.f;
          a = a * ca + pa * sa * sg; b = b * cb + pb * sb * sg;
          *(u32x4*)(Q + qkv_row(tok, wc) * 96 + 64 + 8 * fq) = u32x4{cvtpk(a[0], a[1]), cvtpk(a[2], a[3]), cvtpk(b[0], b[1]), cvtpk(b[2], b[3])};
        } else {
#pragma unroll
          for (int bj = 0; bj < 2; ++bj) {
            const int c = bj * 128 + wc * 32 + 8 * fq, h = c >> 6, d = c & 63;
            const f32x4 a = acc[ai][bj][m][0] * rs, b = acc[ai][bj][m][1] * rs;
            u16* dst = u.pn == 0 ? Q + qkv_row(tok, h) * 96 + d : KV + qkv_row(tok, h) * 160 + (u.pn == 2 ? 0 : 96) + d;
            *(u32x4*)dst = u32x4{cvtpk(a[0], a[1]), cvtpk(a[2], a[3]), cvtpk(b[0], b[1]), cvtpk(b[2], b[3])};
          }
        }
      }
    if (u.pn == 2) {
      const int b = u.pm * 256 < TL ? (u.pm * 256) >> 14 : (u.pm * 256 - TL) >> 8;
#pragma unroll
      for (int bj = 0; bj < 2; ++bj) {
        float mx = 0.f;
#pragma unroll
        for (int ai = 0; ai < 2; ++ai)
#pragma unroll
          for (int m = 0; m < 4; ++m) {
            const float rs = rsp[ai * 128 + wr * 64 + m * 16 + fr];
            const f32x4 a = acc[ai][bj][m][0] * rs, b4 = acc[ai][bj][m][1] * rs;
            float ss = a[0] * a[0] + a[1] * a[1] + a[2] * a[2] + a[3] * a[3] + b4[0] * b4[0] + b4[1] * b4[1] + b4[2] * b4[2] + b4[3] * b4[3];
            ss += shx<16>(ss); ss += shx<32>(ss);
            mx = fmaxf(mx, ss);
          }
        mx = fmaxf(mx, shx<8>(mx)); mx = fmaxf(mx, shx<4>(mx)); mx = fmaxf(mx, shx<2>(mx)); mx = fmaxf(mx, shx<1>(mx));
        if ((ltid() & 63) == 0) atomicMax(kmx + (b * 4 + bj * 2 + (wc >> 1)) * 4 + (wc & 1), __float_as_uint(mx));
      }
    }
  }
};
__device__ __forceinline__ void phase_qkv(const Params& p, int layer, int bid, int nb, char* lds) {
  const int tid = ltid();
  {
    G8Plain S; S.nM = TT / 256; S.nN = 4; S.Kb = 768; S.G = nb; S.c = bid; S.Bt = (const char*)(p.bt_qkv() + (size_t)layer * 1024 * 384);
    EpiQkv E; E.zqkv = p.zqkv(); E.Q = p.Q(); E.KV = p.KV(); E.ropec = p.ropec(); E.ropes = p.ropes(); E.rsl = (float*)(lds + 131072); E.kmx = p.kmx() + layer * 32;
    gemm8_phase<false>(lds, (const char*)p.zqkv(), 768, S, E);
  }
  float krm0 = 0.f, krm1 = 0.f;
  for (int i = bid * NTHR + tid; i < TT * 16; i += nb * NTHR) {
    const int tok = i >> 4, f = i & 15;
    const float x1 = bf2f(p.zg()[(size_t)tok * ZG_W + ZG_KR + f]), x2 = bf2f(p.zg()[(size_t)tok * ZG_W + ZG_KR + 16 + f]);
    float cs = 1.f, sn = 0.f;
    if (tok < TL) { const int tpos = tok & (SEQ - 1); cs = p.ropec()[tpos * 16 + f]; sn = p.ropes()[tpos * 16 + f]; }
    const float y1 = x1 * cs - x2 * sn, y2 = x2 * cs + x1 * sn;
    const u16 o1 = f2bf(y1), o2 = f2bf(y2);
#pragma unroll
    for (int h = 0; h < 4; ++h) { u16* kv = p.KV() + qkv_row(tok, h) * 160 + 64; kv[f] = o1; kv[16 + f] = o2; }
    float ss = y1 * y1 + y2 * y2;
    ss += shx<8>(ss); ss += shx<4>(ss); ss += shx<2>(ss); ss += shx<1>(ss);
    const int b = tok < TL ? (tok >> 14) : ((tok - TL) >> 8);
    if (b == 0) krm0 = fmaxf(krm0, ss); else krm1 = fmaxf(krm1, ss);
  }
  krm0 = wave_max(krm0); krm1 = wave_max(krm1);
  if ((tid & 63) == 0) { atomicMax(p.kmx() + layer * 32 + 0 * 16 + 2, __float_as_uint(krm0)); atomicMax(p.kmx() + layer * 32 + 1 * 16 + 2, __float_as_uint(krm1)); }
}

constexpr int A_KROW = 208;
constexpr int A_TV = 128 * 64 * 2;
constexpr int A_TK = 128 * A_KROW;
constexpr int A_BUF = A_TV + A_TK;
constexpr int A_OFF_W = 3 * A_BUF;
constexpr int ATTN_LDS = A_OFF_W + 8 * 64 * 4;
#define SBAR() __builtin_amdgcn_sched_barrier(0)
__device__ __forceinline__ int crow(int r, int hi) { return (r & 3) + 8 * (r >> 2) + 4 * hi; }

__device__ __forceinline__ void a_partialSM(f32x16& p0) {
#pragma unroll
  for (int r = 0; r < 16; ++r) p0[r] = __builtin_amdgcn_exp2f(p0[r]);
}
__device__ __forceinline__ void a_finishSM(f32x16& p0, f32x16& p1, bf16x8& pa0, bf16x8& pa1, bf16x8& pa2, bf16x8& pa3) {
#pragma unroll
  for (int r = 0; r < 16; ++r) p1[r] = __builtin_amdgcn_exp2f(p1[r]);
#define PK4(P, BASE, OUT) do { unsigned a0 = cvtpk(P[BASE + 0], P[BASE + 1]), a1 = cvtpk(P[BASE + 2], P[BASE + 3]);   \
    unsigned b0 = cvtpk(P[BASE + 4], P[BASE + 5]), b1 = cvtpk(P[BASE + 6], P[BASE + 7]);                              \
    auto r0 = __builtin_amdgcn_permlane32_swap(a0, b0, false, false); auto r1 = __builtin_amdgcn_permlane32_swap(a1, b1, false, false); \
    u32x4 w = {r0[0], r1[0], r0[1], r1[1]}; OUT = *reinterpret_cast<bf16x8*>(&w); } while (0)
  PK4(p0, 0, pa0); PK4(p0, 8, pa1); PK4(p1, 0, pa2); PK4(p1, 8, pa3);
#undef PK4
}
__device__ __forceinline__ void a_qkt(f32x16& p0, f32x16& p1, const char* Ks, const bf16x8* qr, const float mneg, int r32, int hi) {
#pragma unroll
  for (int r = 0; r < 16; ++r) { p0[r] = mneg; p1[r] = mneg; }
#pragma unroll
  for (int d0 = 0; d0 < 6; ++d0) {
    const int cb = (d0 * 16 + hi * 8) * 2;
    const bf16x8 b0 = *reinterpret_cast<const bf16x8*>(Ks + r32 * A_KROW + cb);
    const bf16x8 b1 = *reinterpret_cast<const bf16x8*>(Ks + (32 + r32) * A_KROW + cb);
    p0 = __builtin_amdgcn_mfma_f32_32x32x16_bf16(b0, qr[d0], p0, 0, 0, 0); p1 = __builtin_amdgcn_mfma_f32_32x32x16_bf16(b1, qr[d0], p1, 0, 0, 0);
  }
}
__device__ __forceinline__ int a_v_st(int k, int c) { const int kk = (k & ~0xC) | ((k & 4) << 1) | ((k & 8) >> 1); return ((kk >> 3) * 2 + (c >> 5)) * 512 + ((kk & 7) * 32 + (c & 31)) * 2; }
__device__ __forceinline__ int a_v_rd_base(int lane) { return ((lane & 3) << 3) | (((lane >> 2) & 3) << 6) | (((lane >> 4) & 1) << 5) | (((lane >> 5) & 1) << 8); }
constexpr int a_v_rd_off(int d0, int ks, int half) { return d0 * 512 + ks * 2048 + half * 1024; }
template <int OFF> __device__ __forceinline__ s16x4 a_tr_read(int vb) {
  s16x4 r; asm volatile("ds_read_b64_tr_b16 %0, %1 offset:%2" : "=&v"(r) : "v"(vb), "i"(OFF) : "memory"); return r;
}
template <int D0> __device__ __forceinline__ void a_pv_one(f32x16& od, int vb, bf16x8 pa0, bf16x8 pa1, bf16x8 pa2, bf16x8 pa3) {
  const s16x4 l0 = a_tr_read<a_v_rd_off(D0, 0, 0)>(vb), h0 = a_tr_read<a_v_rd_off(D0, 0, 1)>(vb), l1 = a_tr_read<a_v_rd_off(D0, 1, 0)>(vb), h1 = a_tr_read<a_v_rd_off(D0, 1, 1)>(vb);
  const s16x4 l2 = a_tr_read<a_v_rd_off(D0, 2, 0)>(vb), h2 = a_tr_read<a_v_rd_off(D0, 2, 1)>(vb), l3 = a_tr_read<a_v_rd_off(D0, 3, 0)>(vb), h3 = a_tr_read<a_v_rd_off(D0, 3, 1)>(vb);
  asm volatile("s_waitcnt lgkmcnt(0)" ::: "memory"); SBAR();
#define PK(L, H) (bf16x8){L[0], L[1], L[2], L[3], H[0], H[1], H[2], H[3]}
  od = __builtin_amdgcn_mfma_f32_32x32x16_bf16(pa0, PK(l0, h0), od, 0, 0, 0);
  od = __builtin_amdgcn_mfma_f32_32x32x16_bf16(pa1, PK(l1, h1), od, 0, 0, 0);
  od = __builtin_amdgcn_mfma_f32_32x32x16_bf16(pa2, PK(l2, h2), od, 0, 0, 0);
  od = __builtin_amdgcn_mfma_f32_32x32x16_bf16(pa3, PK(l3, h3), od, 0, 0, 0);
#undef PK
}
__device__ __forceinline__ void a_pv(f32x16* o, int vb, bf16x8 pa0, bf16x8 pa1, bf16x8 pa2, bf16x8 pa3) {
  a_pv_one<0>(o[0], vb, pa0, pa1, pa2, pa3);
  { const bf16x8 ones = {0x3F80, 0x3F80, 0x3F80, 0x3F80, 0x3F80, 0x3F80, 0x3F80, 0x3F80};
    o[2] = __builtin_amdgcn_mfma_f32_32x32x16_bf16(pa0, ones, o[2], 0, 0, 0); o[2] = __builtin_amdgcn_mfma_f32_32x32x16_bf16(pa1, ones, o[2], 0, 0, 0);
    o[2] = __builtin_amdgcn_mfma_f32_32x32x16_bf16(pa2, ones, o[2], 0, 0, 0); o[2] = __builtin_amdgcn_mfma_f32_32x32x16_bf16(pa3, ones, o[2], 0, 0, 0); }
  a_pv_one<1>(o[1], vb, pa0, pa1, pa2, pa3);
}

__device__ __forceinline__ void attn_item(const u16* __restrict__ Qb, const u16* __restrict__ KVh, int seq, float kmax, u16* __restrict__ yout  , char* lds) {
  const int tid = ltid(), wid = tid >> 6, lane = tid & 63, r32 = lane & 31, hi = lane >> 5;
  f32x16 o[3] = {}; bf16x8 qr[6];
  const u16* Qw = Qb + (size_t)(wid * 32 + r32) * 96 + hi * 8;
#pragma unroll
  for (int d0 = 0; d0 < 6; ++d0) qr[d0] = *reinterpret_cast<const bf16x8*>(Qw + d0 * 16);
  float mneg;
  {
    float ss = 0.f;
#pragma unroll
    for (int d0 = 0; d0 < 6; ++d0)
#pragma unroll
      for (int j = 0; j < 8; ++j) { const float v = bf2f((u16)qr[d0][j]); ss += v * v; }
    ss += shx<32>(ss);
    mneg = -sqrtf(ss) * kmax;
  }
  int lw[5];
#pragma unroll
  for (int i = 0; i < 5; ++i) {
    const int g = tid + i * 512, key = g / 20, cc = g % 20;
    lw[i] = cc < 12 ? (A_TV + key * A_KROW + cc * 16) : ((key >> 6) * 8192 + a_v_st(key & 63, (cc - 12) * 8));
  }
  const int vrb = (int)(uintptr_t)lds + a_v_rd_base(lane);
  bf16x8 sg[5];
  const char* gsrc = (const char*)KVh + tid * 16;
#define SLOAD(t) do { const char* s_ = gsrc + (size_t)(t) * 40960; _Pragma("unroll") for (int i = 0; i < 5; ++i) sg[i] = *(const bf16x8*)(s_ + i * 8192); } while (0)
#define SWRITE(bo_) do { _Pragma("unroll") for (int i = 0; i < 5; ++i) *(bf16x8*)(lds + (bo_) + lw[i]) = sg[i]; } while (0)
  f32x16 pA0, pA1, pB0, pB1; bf16x8 pa0, pa1, pa2, pa3; const int NT = seq / 128;
  SLOAD(0); SWRITE(0); if (1 < NT) SLOAD(1);
  __syncthreads();
  int bo = 0;
  {
    if (1 < NT) { SWRITE(A_BUF); if (2 < NT) SLOAD(2); }
    SBAR(); a_qkt(pA0, pA1, lds + bo + A_TV, qr, mneg, r32, hi); a_partialSM(pA0);
    SBAR(); a_qkt(pB0, pB1, lds + bo + A_TV + 64 * A_KROW, qr, mneg, r32, hi);
    a_finishSM(pA0, pA1, pa0, pa1, pa2, pa3); SBAR();
    a_pv(o, vrb + bo, pa0, pa1, pa2, pa3); a_partialSM(pB0);
    __syncthreads();
  }
  for (int t = 1; t < NT; ++t) {
    const int bp = bo;
    bo = bo + A_BUF; if (bo == 3 * A_BUF) bo = 0;
    int bn = bo + A_BUF; if (bn == 3 * A_BUF) bn = 0;
    if (t + 1 < NT) { SWRITE(bn); if (t + 2 < NT) SLOAD(t + 2); }
    SBAR(); a_qkt(pA0, pA1, lds + bo + A_TV, qr, mneg, r32, hi);
    a_finishSM(pB0, pB1, pa0, pa1, pa2, pa3); SBAR();
    a_pv(o, vrb + bp + 8192, pa0, pa1, pa2, pa3); a_partialSM(pA0);
    SBAR(); a_qkt(pB0, pB1, lds + bo + A_TV + 64 * A_KROW, qr, mneg, r32, hi);
    a_finishSM(pA0, pA1, pa0, pa1, pa2, pa3); SBAR();
    a_pv(o, vrb + bo, pa0, pa1, pa2, pa3); a_partialSM(pB0);
    __syncthreads();
  }
  a_finishSM(pB0, pB1, pa0, pa1, pa2, pa3); SBAR();
  a_pv(o, vrb + bo + 8192, pa0, pa1, pa2, pa3);
#pragma unroll
  for (int r = 0; r < 16; ++r) {
    const int orow = crow(r, hi);
    const float rl = __builtin_amdgcn_rcpf(o[2][r]);
    const float v0 = o[0][r] * rl, v1 = o[1][r] * rl;
    float ss = v0 * v0 + v1 * v1;
    ss += shx<16>(ss); ss += shx<8>(ss); ss += shx<4>(ss); ss += shx<2>(ss); ss += shx<1>(ss);
    const float rs = rsqrtf(ss * (1.f / 64.f) + EPS);
    u16* dst = yout + (size_t)(wid * 32 + orow) * DM;
    dst[r32] = f2bf(v0 * rs); dst[32 + r32] = f2bf(v1 * rs);
  }
  __syncthreads();
#undef SLOAD
#undef SWRITE
}

__device__ __forceinline__ void phase_attn(const Params& p, int layer, int bid, int nb, char* lds) {
  const int nitems = 512 + (layer == 0 ? 8 : 0);
  const unsigned* kmx = p.kmx() + layer * 32;
  for (int it = bid; it < nitems; it += nb) {
    int b, h, q0, k0, seq, tok0;
    if (it < 512) { const int pair = it & 7, qb = (it >> 3); h = pair & 3; b = pair >> 2; q0 = qb * 256; k0 = 0; seq = SKV; tok0 = b * SEQ + qb * 256; }
    else { const int i2 = it - 512; h = i2 & 3; b = i2 >> 2; q0 = SEQ; k0 = SEQ; seq = LC; tok0 = TL + b * LC; }
    const size_t base = (size_t)(b * 4 + h) * SKV;
    const float k2 = __uint_as_float(kmx[(b * 4 + h) * 4 + 0]) + __uint_as_float(kmx[(b * 4 + h) * 4 + 1]) + __uint_as_float(kmx[b * 16 + 2]);
    attn_item(p.Q() + (base + q0) * 96, p.KV() + (base + k0) * 160, seq, sqrtf(k2) * 1.02f, p.ymix() + (size_t)tok0 * DM + h * 64, lds);
  }
}

__device__ __forceinline__ float hy_sconv(const u16* __restrict__ row, int t, int Ls, float w0, float w1, float w2, float bb) {
  const float zm = t > 0 ? bf2f(row[t - 1]) : 0.f, z0 = bf2f(row[t]), zp = t + 1 < Ls ? bf2f(row[t + 1]) : 0.f;
  return w0 * zm + w1 * z0 + w2 * zp + bb;
}
__device__ __forceinline__ float2 hy_sconv2(unsigned prv, unsigned cur, unsigned nxt, float w0, float w1, float w2, float bb) {
  const float zm = __uint_as_float(prv & 0xFFFF0000u), z0 = __uint_as_float(cur << 16), z1 = __uint_as_float(cur & 0xFFFF0000u), z2 = __uint_as_float(nxt << 16);
  return make_float2(w0 * zm + w1 * z0 + w2 * z1 + bb, w0 * z0 + w1 * z1 + w2 * z2 + bb);
}
__device__ __forceinline__ void hyena_item(const Params& p, int layer, int b, int ch, char* lds) {
  float2* s = (float2*)lds;
  const int tid = ltid();
  const float* cw = p.hy_conv_w() + (size_t)layer * 3 * 768; const float* cb = p.hy_conv_b() + (size_t)layer * 768;
  const unsigned* r0 = (const unsigned*)(p.zt() + (size_t)(ZT_HY + ch) * TT + (size_t)b * SEQ);
  const unsigned* r1 = (const unsigned*)(p.zt() + (size_t)(ZT_HY + 256 + ch) * TT + (size_t)b * SEQ);
  const unsigned* r2 = (const unsigned*)(p.zt() + (size_t)(ZT_HY + 512 + ch) * TT + (size_t)b * SEQ);
  const float a0 = cw[ch], a1 = cw[768 + ch], a2 = cw[1536 + ch], ab = cb[ch];
  const float b0 = cw[256 + ch], b1 = cw[768 + 256 + ch], b2 = cw[1536 + 256 + ch], bb = cb[256 + ch];
  const float c0 = cw[512 + ch], c1 = cw[768 + 512 + ch], c2 = cw[1536 + 512 + ch], cbb = cb[512 + ch];
  unsigned vgr[16], x0r[16];
#pragma unroll
  for (int hb2 = 0; hb2 < 2; ++hb2) {
    unsigned ld[8][9];
#pragma unroll
    for (int ii = 0; ii < 8; ++ii) {
      const int m = tid + 512 * (hb2 * 8 + ii);
      const int mp = m > 0 ? m - 1 : 0, mn = m + 1 < SEQ / 2 ? m + 1 : m;
      ld[ii][0] = r0[mp]; ld[ii][1] = r0[m]; ld[ii][2] = r0[mn];
      ld[ii][3] = r1[mp]; ld[ii][4] = r1[m]; ld[ii][5] = r1[mn];
      ld[ii][6] = r2[mp]; ld[ii][7] = r2[m]; ld[ii][8] = r2[mn];
    }
#pragma unroll
    for (int ii = 0; ii < 8; ++ii) {
      const int i = hb2 * 8 + ii, m = tid + 512 * i;
      const unsigned mkp = m > 0 ? 0xFFFFFFFFu : 0u, mkn = m + 1 < SEQ / 2 ? 0xFFFFFFFFu : 0u;
      const float2 ux = hy_sconv2(ld[ii][0] & mkp, ld[ii][1], ld[ii][2] & mkn, a0, a1, a2, ab);
      x0r[i] = cvtpk(ux.x, ux.y);
      const float2 u1 = hy_sconv2(ld[ii][3] & mkp, ld[ii][4], ld[ii][5] & mkn, b0, b1, b2, bb);
      const float2 uv = hy_sconv2(ld[ii][6] & mkp, ld[ii][7], ld[ii][8] & mkn, c0, c1, c2, cbb);
      const float2 vgf = make_float2(uv.x * u1.x, uv.y * u1.y);
      vgr[i] = cvtpk(vgf.x, vgf.y);
      s[swz(m)] = vgf;
      s[swz(m + SEQ / 2)] = make_float2(0.f, 0.f);
    }
  }
  __syncthreads();
  fft_fwd(s, p.tw());
  {
    const float4* hs = p.hspec() + ((size_t)layer * 256 + ch) * HSP;
    float4 hv[17];
#pragma unroll
    for (int i = 0; i < 17; ++i) { const int k = tid + 512 * i; hv[i] = hs[k <= FM / 2 ? k : 0]; }
    const float2 twl = p.tw()[tid];
#pragma unroll
    for (int i = 0; i < 17; ++i) {
      const int k = tid + 512 * i;
      if (k <= FM / 2) {
        const int pk = swz(rev7(k)), pm = swz(rev7((FM - k) & (FM - 1)));
        const float2 zk = s[pk], zm = s[pm];
        const float4 h = hv[i];
        const float2 He = make_float2(h.x, h.y), Ho = make_float2(h.z, h.w);
        const float2 Xe = make_float2(0.5f * (zk.x + zm.x), 0.5f * (zk.y - zm.y));
        const float2 Xo = make_float2(0.5f * (zk.y + zm.y), -0.5f * (zk.x - zm.x));
        const float2 twk = cmul(twl, p.tw()[512 * i]);
        const float2 t1 = cmul(twk, cmul(Xo, Ho));
        const float2 e1 = cmul(Xe, He);
        const float2 Ye = make_float2(e1.x + t1.x, e1.y + t1.y);
        const float2 o1 = cmul(Xe, Ho), o2 = cmul(Xo, He);
        const float2 Yo = make_float2(o1.x + o2.x, o1.y + o2.y);
        s[pk] = make_float2(Ye.x - Yo.y, Ye.y + Yo.x);
        if (pm != pk) s[pm] = make_float2(Ye.x + Yo.y, -Ye.y + Yo.x);
      }
    }
  }
  __syncthreads();
  fft_inv(s, p.tw());
  const float hb = p.hy_bias()[layer * 256 + ch];
  unsigned* orow = (unsigned*)(p.hyo() + (size_t)ch * TT + (size_t)b * SEQ);
#pragma unroll
  for (int i = 0; i < 16; ++i) {
    const int m = tid + 512 * i;
    const float2 y = s[swz(m)];
    orow[m] = cvtpk((y.x + __uint_as_float(vgr[i] << 16) * hb) * __uint_as_float(x0r[i] << 16), (y.y + __uint_as_float(vgr[i] & 0xFFFF0000u) * hb) * __uint_as_float(x0r[i] & 0xFFFF0000u));
  }
  __syncthreads();
}
__device__ __forceinline__ void fnet_item(const Params& p, int b, int j, char* lds) {
  float2* s = (float2*)lds;
  const int tid = ltid();
  const u16* rr = p.zt() + (size_t)(ZT_FR + j) * TT + (size_t)b * SEQ;
  const u16* ri = p.zt() + (size_t)(ZT_FI + j) * TT + (size_t)b * SEQ;
  {
    u32x4 vr[4], vi[4];
#pragma unroll
    for (int i = 0; i < 4; ++i) { const int m0 = (tid + 512 * i) * 8; vr[i] = *(const u32x4*)(rr + m0); vi[i] = *(const u32x4*)(ri + m0); }
#pragma unroll
    for (int i = 0; i < 4; ++i) {
      const int m0 = (tid + 512 * i) * 8;
#pragma unroll
      for (int q = 0; q < 4; ++q) {
        s[swz(m0 + 2 * q)] = make_float2(__uint_as_float(vr[i][q] << 16), __uint_as_float(vi[i][q] << 16));
        s[swz(m0 + 2 * q + 1)] = make_float2(__uint_as_float(vr[i][q] & 0xFFFF0000u), __uint_as_float(vi[i][q] & 0xFFFF0000u));
      }
    }
  }
  __syncthreads();
  fft_fwd(s, p.tw());
#ifdef PROBE_FFT
  fft_inv(s, p.tw());
  for (int m = tid; m < FM; m += NTHR) { float2 v = s[m]; v.x *= (1.f / 16384.f); v.y *= (1.f / 16384.f); s[m] = v; }
  __syncthreads();
  fft_fwd(s, p.tw());
#endif
  u16* orow = p.fno() + (size_t)j * TT + (size_t)b * SEQ;
#pragma unroll 8
  for (int k = tid; k < FM; k += NTHR) orow[k] = f2bf(s[swz(rev7(k))].x * (1.f / 128.f));
  __syncthreads();
}
__device__ __forceinline__ void hyena_ctx_item(const Params& p, int b, int ch, char* lds) {
  float* vg = (float*)lds;
  float* x0 = vg + 256;
  float* hf = x0 + 256;
  float* hbk = hf + 256;
  const int tid = ltid();
  const float* cw = p.hy_conv_w(); const float* cb = p.hy_conv_b();
  const size_t off = (size_t)TL + (size_t)b * LC;
  const u16* r0 = p.zt() + (size_t)(ZT_HY + ch) * TT + off;
  const u16* r1 = p.zt() + (size_t)(ZT_HY + 256 + ch) * TT + off;
  const u16* r2 = p.zt() + (size_t)(ZT_HY + 512 + ch) * TT + off;
  if (tid < 256) {
    const int t = tid;
    vg[t] = hy_sconv(r2, t, LC, cw[512 + ch], cw[768 + 512 + ch], cw[1536 + 512 + ch], cb[512 + ch]) *
            hy_sconv(r1, t, LC, cw[256 + ch], cw[768 + 256 + ch], cw[1536 + 256 + ch], cb[256 + ch]);
    x0[t] = hy_sconv(r0, t, LC, cw[ch], cw[768 + ch], cw[1536 + ch], cb[ch]);
    hf[t] = p.hfc()[(size_t)ch * LC + t]; hbk[t] = p.hfc()[(size_t)(256 + ch) * LC + t];
  }
  const float ssq_c = filt_ssq(p.hpart() + (size_t)2 * 256 * 512, ch, (float*)(lds + 8192));
  if (tid < 256) {
    const int t = tid; float y = 0;
    for (int q = 0; q <= t; ++q) y += hf[t - q] * vg[q];
    for (int q = t + 1; q < LC; ++q) y += hbk[q - t] * vg[q];
    y *= rsqrtf(ssq_c);
    p.hyo()[(size_t)ch * TT + off + t] = f2bf((y + vg[t] * p.hy_bias()[ch]) * x0[t]);
  }
  __syncthreads();
}
__device__ __forceinline__ void fnet_ctx_item(const Params& p, int b, int j, char* lds) {
  float* ur = (float*)lds; float* ui = ur + 256; float* cst = ui + 256; float* snt = cst + 256;
  const int tid = ltid();
  const size_t off = (size_t)TL + (size_t)b * LC;
  if (tid < 256) {
    ur[tid] = bf2f(p.zt()[(size_t)(ZT_FR + j) * TT + off + tid]); ui[tid] = bf2f(p.zt()[(size_t)(ZT_FI + j) * TT + off + tid]);
    float sn, cs; sincospif((float)tid / 128.f, &sn, &cs); cst[tid] = cs; snt[tid] = sn;
  }
  __syncthreads();
  if (tid < 256) {
    const int k = tid; float y = 0;
    for (int l = 0; l < 256; ++l) { const int m = (l * k) & 255; y += cst[m] * ur[l] + snt[m] * ui[l]; }
    p.fno()[(size_t)j * TT + off + k] = f2bf(y * 0.0625f);
  }
  __syncthreads();
}
__device__ __forceinline__ void phase_fftmix(const Params& p, int layer, int bid, int nb, char* lds) {
  const int nitems = layer == 0 ? 2048 : 1024;
  for (int it = bid; it < nitems; it += nb) {
    const int k = it & 511, b = k >> 8, c = k & 255;
    if (it < 512) hyena_item(p, layer, b, c, lds);
    else if (it < 1024) fnet_item(p, b, c, lds);
    else if (it < 1536) hyena_ctx_item(p, b, c, lds);
    else fnet_ctx_item(p, b, c, lds);
  }
}
constexpr int GLG = 17, NGRP = 16;
__device__ __forceinline__ int gla_chain_tok(int dir, int b, int n, int i) {
  const int base = n < 4 ? TL + b * LC : b * SEQ, len = n < 4 ? LC : SEQ, m = n < 4 ? n : n - 4;
  return dir == 0 ? base + 64 * m + i : base + (len - 1) - (64 * m + i);
}
__device__ __forceinline__ float logsig16(float x) { return (fminf(x, 0.f) - __logf(1.f + __expf(-fabsf(x)))) * (1.f / 16.f); }
__device__ __forceinline__ float wave_scan_incl(float v, int lane) {
#pragma unroll
  for (int o = 1; o < 64; o <<= 1) { const float t = __shfl_up(v, o, 64); if (lane >= o) v += t; }
  return v;
}
__device__ __forceinline__ void phase_gla_a(const Params& p, int layer, int bid, int nb, char* lds) {
  const int tid = ltid(), wid = tid >> 6, lane = tid & 63, r32 = lane & 31, hi = lane >> 5;
  const float* gb = p.gla_gk_b() + (size_t)layer * 256;
  char* wimg = lds + wid * 12288;
  for (int it = bid; it < 16 * NGRP; it += nb) {
    const int chain = it >> 4, g = it & 15, dir = chain >> 3, b = (chain >> 2) & 1, h = chain & 3;
    const int n0 = g * GLG, n1 = min(n0 + GLG, NCH), nch = n1 - n0;
    char* WT = lds + wid * 13824; char* VT = WT + 4608;
    float* dvl = (float*)(lds + 8 * 13824);
#pragma unroll
    for (int c = 0; c < 3; ++c) {
      const int cl = wid + 8 * c;
      if (cl < nch) {
        const int n = n0 + cl;
        {
          const u16* vbase = p.zg() + ZG_GV + h * 64 + lane;
          u16 vv[64];
#pragma unroll
          for (int i = 0; i < 64; ++i) vv[i] = vbase[(size_t)gla_chain_tok(dir, b, n, i) * ZG_W];
#pragma unroll
          for (int q = 0; q < 8; ++q)
            *(u32x4*)(VT + lane * 144 + q * 16) = u32x4{(unsigned)vv[8 * q] | ((unsigned)vv[8 * q + 1] << 16), (unsigned)vv[8 * q + 2] | ((unsigned)vv[8 * q + 3] << 16),
                                                       (unsigned)vv[8 * q + 4] | ((unsigned)vv[8 * q + 5] << 16), (unsigned)vv[8 * q + 6] | ((unsigned)vv[8 * q + 7] << 16)};
        }
        {
          const int kk = lane & 31, hs = lane >> 5;
          const u16* kb = p.zg() + ZG_GK + h * 32 + kk; const u16* gbp = p.zg() + ZG_GP + dir * 128 + h * 32 + kk;
          const float bias = gb[dir * 128 + h * 32 + kk];
          float bc[32], kf[32];
#pragma unroll
          for (int i = 0; i < 32; ++i) {
            const size_t ro = (size_t)gla_chain_tok(dir, b, n, hs * 32 + i) * ZG_W;
            kf[i] = bf2f(kb[ro]); bc[i] = bf2f(gbp[ro]);
          }
          float run = 0.f;
#pragma unroll
          for (int i = 0; i < 32; ++i) { const float x = bc[i] + bias; run += (fminf(x, 0.f) - __logf(1.f + __expf(-fabsf(x)))) * (1.f / 16.f); bc[i] = run; }
          const float lowtot = __shfl(run, kk, 64);
          const float uptot = __shfl(run, 32 + kk, 64);
          const float bl = lowtot + uptot, off = hs ? lowtot : 0.f;
          unsigned wp[16];
#pragma unroll
          for (int i = 0; i < 16; ++i) wp[i] = cvtpk(kf[2 * i] * __expf(bl - (bc[2 * i] + off)), kf[2 * i + 1] * __expf(bl - (bc[2 * i + 1] + off)));
#pragma unroll
          for (int q = 0; q < 4; ++q) *(u32x4*)(WT + kk * 144 + hs * 64 + q * 16) = u32x4{wp[4 * q], wp[4 * q + 1], wp[4 * q + 2], wp[4 * q + 3]};
          if (hs == 0) dvl[cl * 32 + kk] = __expf(bl);
        }
        asm volatile("s_waitcnt lgkmcnt(0)" ::: "memory");
        f32x16 d0 = {}, d1 = {};
#pragma unroll
        for (int s4 = 0; s4 < 4; ++s4) {
          const bf16x8 af = *(const bf16x8*)(WT + r32 * 144 + (16 * s4 + 8 * hi) * 2);
          const bf16x8 v0 = *(const bf16x8*)(VT + r32 * 144 + (16 * s4 + 8 * hi) * 2);
          const bf16x8 v1 = *(const bf16x8*)(VT + (32 + r32) * 144 + (16 * s4 + 8 * hi) * 2);
          d0 = __builtin_amdgcn_mfma_f32_32x32x16_bf16(af, v0, d0, 0, 0, 0);
          d1 = __builtin_amdgcn_mfma_f32_32x32x16_bf16(af, v1, d1, 0, 0, 0);
        }
        asm volatile("s_waitcnt lgkmcnt(0)" ::: "memory");
        {
          float* dg = p.gds() + ((size_t)chain * NCH + n) * 2048;
#pragma unroll
          for (int r = 0; r < 16; ++r) { dg[crow(r, hi) * 64 + r32] = d0[r]; dg[crow(r, hi) * 64 + 32 + r32] = d1[r]; }
        }
      }
      __builtin_amdgcn_sched_barrier(0);
    }
    __syncthreads();
    {
      const int kk = tid >> 4, v0 = (tid & 15) * 4;
      float st[4] = {0.f, 0.f, 0.f, 0.f}; float dcum = 1.f;
      float* gp0 = p.gds() + ((size_t)chain * NCH + n0) * 2048 + kk * 64 + v0;
      float4 av[GLG];
#pragma unroll
      for (int cl = 0; cl < GLG; ++cl) av[cl] = *(const float4*)(gp0 + (size_t)(cl < nch ? cl : 0) * 2048);
#pragma unroll
      for (int cl = 0; cl < GLG; ++cl) {
        if (cl < nch) {
          const float d = dvl[cl * 32 + kk];
          *(float4*)(gp0 + (size_t)cl * 2048) = make_float4(st[0], st[1], st[2], st[3]);
          if ((tid & 15) == 0) p.gdv()[((size_t)chain * NCH + n0 + cl) * 32 + kk] = dcum;
          st[0] = st[0] * d + av[cl].x; st[1] = st[1] * d + av[cl].y; st[2] = st[2] * d + av[cl].z; st[3] = st[3] * d + av[cl].w;
          dcum *= d;
        }
      }
      float* at = p.gst() + ((size_t)chain * NGRP + g) * 2048 + kk * 64 + v0;
      *(float4*)at = make_float4(st[0], st[1], st[2], st[3]);
      if ((tid & 15) == 0) p.gst()[(size_t)16 * NGRP * 2048 + ((size_t)chain * NGRP + g) * 32 + kk] = dcum;
    }
    __syncthreads();
  }
}

constexpr int GC_QP = 33792, GC_KP = GC_QP + 10240, GC_VT = GC_KP + 10240, GC_ST = GC_VT + 18432, GC_AX = GC_ST + 10240;
__device__ __forceinline__ void phase_gla_c(const Params& p, int layer, int bid, int nb, char* lds) {
  float* gl = (float*)lds;
  float* qraw = gl + 2 * 64 * 33;
  float* kraw = qraw + 64 * 33;
  float* Of = (float*)lds;
  char* Qp = lds + GC_QP;
  char* Kp = lds + GC_KP;
  char* VT = lds + GC_VT;
  char* ST = lds + GC_ST;
  const int tid = ltid(), wid = tid >> 6, lane = tid & 63, r32 = lane & 31, hi = lane >> 5;
  char* Ax = lds + GC_AX + wid * 4608;
  const float* gb = p.gla_gk_b() + (size_t)layer * 256;
  const int pc_lo = layer == 0 ? 0 : 4, npc = NCH - pc_lo, nitem = 8 * npc;
  const int per = (nitem + nb - 1) / nb, q_beg = bid * per, q_end = min(nitem, q_beg + per);
  const int sdir = tid >> 8, sk = (tid >> 3) & 31, sv0 = (tid & 7) * 8;
  float G[8]; int g_cached = -1, bh_cached = -1;
  const int lpos = tid >> 3, lc4 = (tid & 7) * 4;
  u32x2 rq, rk, rg0, rg1, rva, rvb; float4 pl0, pl1; float pdp;
#define GC_ITEM(q_, bh_, pc_, b_, h_, tok0_) const int bh_ = (q_) / npc, pc_ = pc_lo + (q_) % npc, b_ = bh_ >> 2, h_ = bh_ & 3; \
    const int tok0_ = pc_ < 4 ? TL + b_ * LC + pc_ * 64 : b_ * SEQ + (pc_ - 4) * 64
#define GC_LOADRAW(tok0_, h_) do { const u16* zr = p.zg() + (size_t)((tok0_) + lpos) * ZG_W; \
    rq = *(const u32x2*)(zr + ZG_GQ + (h_) * 32 + lc4); rk = *(const u32x2*)(zr + ZG_GK + (h_) * 32 + lc4); \
    rg0 = *(const u32x2*)(zr + ZG_GP + (h_) * 32 + lc4); rg1 = *(const u32x2*)(zr + ZG_GP + 128 + (h_) * 32 + lc4); \
    rva = *(const u32x2*)(zr + ZG_GV + (h_) * 64 + lc4 * 2); rvb = *(const u32x2*)(zr + ZG_GV + (h_) * 64 + lc4 * 2 + 4); } while (0)
#define GC_LOADST(pc_, b_, h_) do { const int chain_ = sdir * 8 + (b_) * 4 + (h_); \
    const int n_ = sdir == 0 ? (pc_) : ((pc_) < 4 ? 3 - (pc_) : 4 + 255 - ((pc_) - 4)); \
    const float* lp_ = p.gds() + ((size_t)chain_ * NCH + n_) * 2048 + sk * 64 + sv0; \
    pl0 = *(const float4*)lp_; pl1 = *(const float4*)(lp_ + 4); pdp = p.gdv()[((size_t)chain_ * NCH + n_) * 32 + sk]; } while (0)
  if (q_beg < q_end) { GC_ITEM(q_beg, bh0, pc0, b0, h0, t00); GC_LOADRAW(t00, h0); GC_LOADST(pc0, b0, h0); }
  for (int qi = q_beg; qi < q_end; ++qi) {
    GC_ITEM(qi, bh, pc, b, h, tok0);
    {
      const int pos = lpos, c4 = lc4;
      const float sc = 0.17677669529663687f;
      qraw[pos * 33 + c4] = BF_LO(rq[0]) * sc; qraw[pos * 33 + c4 + 1] = BF_HI(rq[0]) * sc; qraw[pos * 33 + c4 + 2] = BF_LO(rq[1]) * sc; qraw[pos * 33 + c4 + 3] = BF_HI(rq[1]) * sc;
      kraw[pos * 33 + c4] = BF_LO(rk[0]); kraw[pos * 33 + c4 + 1] = BF_HI(rk[0]); kraw[pos * 33 + c4 + 2] = BF_LO(rk[1]); kraw[pos * 33 + c4 + 3] = BF_HI(rk[1]);
#pragma unroll
      for (int d = 0; d < 2; ++d) {
        const u32x2 rg = d ? rg1 : rg0; const float4 bb = *(const float4*)(gb + d * 128 + h * 32 + c4);
        const int i = d ? 63 - pos : pos;
        float* gd = gl + (d * 64 + i) * 33 + c4;
        gd[0] = logsig16(BF_LO(rg[0]) + bb.x); gd[1] = logsig16(BF_HI(rg[0]) + bb.y); gd[2] = logsig16(BF_LO(rg[1]) + bb.z); gd[3] = logsig16(BF_HI(rg[1]) + bb.w);
      }
#pragma unroll
      for (int j = 0; j < 4; ++j) {
        const unsigned w = j < 2 ? rva[j] : rvb[j - 2]; const int v = c4 * 2 + 2 * j;
        *(u16*)(VT + (0 * 64 + v) * 144 + pos * 2) = (u16)(w & 0xFFFFu); *(u16*)(VT + (1 * 64 + v) * 144 + (63 - pos) * 2) = (u16)(w & 0xFFFFu);
        *(u16*)(VT + (0 * 64 + v + 1) * 144 + pos * 2) = (u16)(w >> 16); *(u16*)(VT + (1 * 64 + v + 1) * 144 + (63 - pos) * 2) = (u16)(w >> 16);
      }
    }
    if (qi + 1 < q_end) { GC_ITEM(qi + 1, bhn, pcn, bn, hn, t0n); GC_LOADRAW(t0n, hn); }
    __syncthreads();
    {
      const int col = tid & 63, d = col >> 5, c = col & 31, part = tid >> 6;
      float* ptot = (float*)(lds + GC_AX);
      float bv[8]; float run = 0.f;
#pragma unroll
      for (int j = 0; j < 8; ++j) { run += gl[(d * 64 + part * 8 + j) * 33 + c]; bv[j] = run; }
      ptot[part * 64 + col] = run;
      __syncthreads();
      float off = 0.f;
#pragma unroll
      for (int q = 0; q < 7; ++q) off += (q < part) ? ptot[q * 64 + col] : 0.f;
#pragma unroll
      for (int j = 0; j < 8; ++j) gl[(d * 64 + part * 8 + j) * 33 + c] = bv[j] + off;
    }
    __syncthreads();
    {
#pragma unroll
      for (int e = 0; e < 2; ++e) {
        const int idx = tid + e * 512, d = idx >> 9, i = (idx >> 3) & 63, c4 = (idx & 7) * 4, pos = d ? 63 - i : i;
        float qo[4], ko[4];
#pragma unroll
        for (int j = 0; j < 4; ++j) {
          const float bi = gl[(d * 64 + i) * 33 + c4 + j], bm = gl[(d * 64 + 31) * 33 + c4 + j];
          qo[j] = qraw[pos * 33 + c4 + j] * __expf(bi - bm); ko[j] = kraw[pos * 33 + c4 + j] * __expf(bm - bi);
        }
        *(u32x2*)(Qp + (d * 64 + i) * 80 + c4 * 2) = u32x2{cvtpk(qo[0], qo[1]), cvtpk(qo[2], qo[3])};
        *(u32x2*)(Kp + (d * 64 + i) * 80 + c4 * 2) = u32x2{cvtpk(ko[0], ko[1]), cvtpk(ko[2], ko[3])};
      }
      const int chain = sdir * 8 + b * 4 + h;
      const int n = sdir == 0 ? pc : (pc < 4 ? 3 - pc : 4 + 255 - (pc - 4)), g = n / GLG;
      if (g != g_cached || bh != bh_cached) {
#pragma unroll
        for (int j = 0; j < 8; ++j) G[j] = 0.f;
        const float* at = p.gst() + (size_t)chain * NGRP * 2048 + sk * 64 + sv0;
        const float* dt = p.gst() + (size_t)16 * NGRP * 2048 + (size_t)chain * NGRP * 32 + sk;
        for (int gg = 0; gg < g; ++gg) {
          const float4 a0 = *(const float4*)(at + (size_t)gg * 2048), a1 = *(const float4*)(at + (size_t)gg * 2048 + 4); const float dd = dt[gg * 32];
          G[0] = G[0] * dd + a0.x; G[1] = G[1] * dd + a0.y; G[2] = G[2] * dd + a0.z; G[3] = G[3] * dd + a0.w;
          G[4] = G[4] * dd + a1.x; G[5] = G[5] * dd + a1.y; G[6] = G[6] * dd + a1.z; G[7] = G[7] * dd + a1.w;
        }
        g_cached = g; bh_cached = bh;
      }
      const float4 l0 = pl0, l1 = pl1; const float dp = pdp;
      const float em = __expf(gl[(sdir * 64 + 31) * 33 + sk]);
      const float sv[8] = {l0.x + dp * G[0], l0.y + dp * G[1], l0.z + dp * G[2], l0.w + dp * G[3], l1.x + dp * G[4], l1.y + dp * G[5], l1.z + dp * G[6], l1.w + dp * G[7]};
      if (qi + 1 < q_end) { GC_ITEM(qi + 1, bhn, pcn, bn, hn, t0n); (void)bhn; (void)t0n; GC_LOADST(pcn, bn, hn); }
#pragma unroll
      for (int j = 0; j < 8; ++j) *(u16*)(ST + (sdir * 64 + sv0 + j) * 80 + sk * 2) = f2bf(sv[j] * em);
    }
    __syncthreads();
    {
      const int d = wid >> 2, ib = (wid >> 1) & 1, vb = wid & 1;
      const char* Qd = Qp + d * 64 * 80; const char* Kd = Kp + d * 64 * 80; const char* Vd = VT + d * 64 * 144; const char* Sd = ST + d * 64 * 80;
      bf16x8 qf[2];
#pragma unroll
      for (int s2 = 0; s2 < 2; ++s2) qf[s2] = *(const bf16x8*)(Qd + (ib * 32 + r32) * 80 + (16 * s2 + 8 * hi) * 2);
#pragma unroll
      for (int jb = 0; jb < 2; ++jb) {
        if (jb <= ib) {
          f32x16 x = {};
#pragma unroll
          for (int s2 = 0; s2 < 2; ++s2) {
            const bf16x8 kf = *(const bf16x8*)(Kd + (jb * 32 + r32) * 80 + (16 * s2 + 8 * hi) * 2);
            x = __builtin_amdgcn_mfma_f32_32x32x16_bf16(qf[s2], kf, x, 0, 0, 0);
          }
#pragma unroll
          for (int r = 0; r < 16; ++r) {
            const int il = crow(r, hi), i = ib * 32 + il, j = jb * 32 + r32;
            *(u16*)(Ax + il * 144 + j * 2) = f2bf(j <= i ? x[r] : 0.f);
          }
        }
      }
      asm volatile("s_waitcnt lgkmcnt(0)" ::: "memory");
      f32x16 o = {};
#pragma unroll
      for (int s4 = 0; s4 < 4; ++s4) {
        if (s4 < 2 * (ib + 1)) {
          const bf16x8 af = *(const bf16x8*)(Ax + r32 * 144 + (16 * s4 + 8 * hi) * 2);
          const bf16x8 vf = *(const bf16x8*)(Vd + (vb * 32 + r32) * 144 + (16 * s4 + 8 * hi) * 2);
          o = __builtin_amdgcn_mfma_f32_32x32x16_bf16(af, vf, o, 0, 0, 0);
        }
      }
#pragma unroll
      for (int s2 = 0; s2 < 2; ++s2) {
        const bf16x8 sf = *(const bf16x8*)(Sd + (vb * 32 + r32) * 80 + (16 * s2 + 8 * hi) * 2);
        o = __builtin_amdgcn_mfma_f32_32x32x16_bf16(qf[s2], sf, o, 0, 0, 0);
      }
#pragma unroll
      for (int r = 0; r < 16; ++r) {
        const int i = ib * 32 + crow(r, hi), pos = d ? 63 - i : i;
        Of[(d * 64 + pos) * 65 + vb * 32 + r32] = o[r];
      }
    }
    __syncthreads();
    {
      const int pos = tid >> 3, v0 = (tid & 7) * 8;
      float r8[8]; float ss = 0.f;
#pragma unroll
      for (int j = 0; j < 8; ++j) { r8[j] = Of[pos * 65 + v0 + j] + Of[(64 + pos) * 65 + v0 + j]; ss += r8[j] * r8[j]; }
      ss += shx<4>(ss); ss += shx<2>(ss); ss += shx<1>(ss);
      const float rs = rsqrtf(ss * (1.f / 64.f) + EPS);
      const u16* og = p.zg() + (size_t)(tok0 + pos) * ZG_W + ZG_OG + h * 64 + v0;
      const float4 g0 = ld4bf(og), g1 = ld4bf(og + 4);
      *(u32x4*)(p.ymix() + (size_t)(tok0 + pos) * DM + 512 + h * 64 + v0) =
          u32x4{cvtpk(r8[0] * rs * silu_f(g0.x), r8[1] * rs * silu_f(g0.y)), cvtpk(r8[2] * rs * silu_f(g0.z), r8[3] * rs * silu_f(g0.w)),
                cvtpk(r8[4] * rs * silu_f(g1.x), r8[5] * rs * silu_f(g1.y)), cvtpk(r8[6] * rs * silu_f(g1.z), r8[7] * rs * silu_f(g1.w))};
    }
    __syncthreads();
  }
}

__device__ __forceinline__ void phase_mix(const Params& p, int layer, int bid, int nb, char* lds) {
  float* part = (float*)lds;
  u16* tile = (u16*)(lds + 4096);
  const int tid = ltid(), wid = tid >> 6, lane = tid & 63;
  const int ntok = layer == 0 ? TT : TL;
  for (int it = bid; it < ntok / 64; it += nb) {
    const int tok0 = it * 64;
    float vh[32], vf[32]; float sh = 0, sf = 0;
#pragma unroll
    for (int c = 0; c < 32; ++c) {
      vh[c] = bf2f(p.hyo()[(size_t)(wid * 32 + c) * TT + tok0 + lane]); vf[c] = bf2f(p.fno()[(size_t)(wid * 32 + c) * TT + tok0 + lane]);
      sh += vh[c] * vh[c]; sf += vf[c] * vf[c];
    }
    part[(0 * 8 + wid) * 64 + lane] = sh; part[(1 * 8 + wid) * 64 + lane] = sf;
    __syncthreads();
    float th = 0, tf = 0;
#pragma unroll
    for (int q = 0; q < 8; ++q) { th += part[(0 * 8 + q) * 64 + lane]; tf += part[(1 * 8 + q) * 64 + lane]; }
    const float rh = rsqrtf(th * (1.f / 256.f) + EPS), rf = rsqrtf(tf * (1.f / 256.f) + EPS);
#pragma unroll
    for (int c = 0; c < 32; ++c) { tile[lane * 520 + wid * 32 + c] = f2bf(vh[c] * rh); tile[lane * 520 + 256 + wid * 32 + c] = f2bf(vf[c] * rf); }
    __syncthreads();
    for (int g = tid; g < 64 * 64; g += NTHR) {
      const int tl = g >> 6, cg = g & 63;
      const u32x4 w = *(const u32x4*)(tile + tl * 520 + cg * 8);
      *(u32x4*)(p.ymix() + (size_t)(tok0 + tl) * DM + (cg < 32 ? 256 + cg * 8 : 768 + (cg - 32) * 8)) = w;
    }
    __syncthreads();
  }
}

struct EpiOut {
  const Params* pp; int layer;
  __device__ __forceinline__ void pre(const G8Unit& u, int, int, float (&)[8], float* cb) const {
    if ((ltid() >> 6) == 0) g8_cload(pp->mod() + ((size_t)layer * 3 + modv(u.pm * 256)) * 6144 + 2 * DM + u.pn * 256, cb);
  }
  __device__ __forceinline__ void operator()(const f32x4 (&acc)[2][2][4][2], const G8Unit& u, int wr, int wc, int fr, int fq, const float (&)[8], const float* cb) const {
    const Params& p = *pp;
#pragma unroll
    for (int bj = 0; bj < 2; ++bj) {
      const int c0 = u.pn * 256 + bj * 128 + wc * 32 + 8 * fq;
      const f32x4 ga = *(const f32x4*)(cb + bj * 128 + wc * 32 + 8 * fq), gb = *(const f32x4*)(cb + bj * 128 + wc * 32 + 8 * fq + 4);
#pragma unroll
      for (int ai = 0; ai < 2; ++ai)
#pragma unroll
        for (int m = 0; m < 4; ++m) {
          const int tok = u.pm * 256 + ai * 128 + wr * 64 + m * 16 + fr;
          u16* xo = p.X() + (size_t)tok * DM + c0;
          f32x4 xa, xb;
          if (layer == 0) { const float* xr = resid_row_in(p, tok) + c0; xa = *(const f32x4*)xr; xb = *(const f32x4*)(xr + 4); }
          else { const u32x4 w = *(const u32x4*)xo;
            xa = f32x4{__uint_as_float(w[0] << 16), __uint_as_float(w[0] & 0xFFFF0000u), __uint_as_float(w[1] << 16), __uint_as_float(w[1] & 0xFFFF0000u)};
            xb = f32x4{__uint_as_float(w[2] << 16), __uint_as_float(w[2] & 0xFFFF0000u), __uint_as_float(w[3] << 16), __uint_as_float(w[3] & 0xFFFF0000u)}; }
          xa = xa + ga * acc[ai][bj][m][0]; xb = xb + gb * acc[ai][bj][m][1];
          *(u32x4*)xo = u32x4{cvtpk(xa[0], xa[1]), cvtpk(xa[2], xa[3]), cvtpk(xb[0], xb[1]), cvtpk(xb[2], xb[3])};
        }
    }
  }
};
__device__ __forceinline__ void phase_gemm_out(const Params& p, int layer, int bid, int nb, char* lds) {
  G8Plain S; S.nM = (layer == 0 ? TT : TL) / 256; S.nN = DM / 256; S.Kb = 2 * DM; S.G = nb; S.c = bid; S.Bt = (const char*)(p.bt_out() + (size_t)layer * DM * DM);
  EpiOut E; E.pp = &p; E.layer = layer;
  gemm8_phase<false>(lds, (const char*)p.ymix(), 2 * DM, S, E);
}

__device__ __forceinline__ void phase_norm2_router(const Params& p, int layer, int bid, int nb, char* lds) {
  float* rwl = (float*)lds;
  int* lcnt = (int*)(lds + 131072);
  int* lbase = lcnt + 32;
  int* ent = lbase + 32;
  float* entw = (float*)(ent + 2 * 640);
  float* ents = entw + 640;
  const int tid = ltid(), wid = tid >> 6, lane = tid & 63;
  const int ntok = layer == 0 ? TT : TL;
  const float* rw = p.router_w() + (size_t)layer * DM * NE;
  for (int i = tid; i < DM * NE / 4; i += NTHR) {
    const int k = i >> 3, q4 = i & 7;
    ((float4*)rwl)[q4 * 1024 + ((k & 3) * 256 + (k >> 2))] = ((const float4*)rw)[i];
  }
  if (tid < 32) lcnt[tid] = 0;
  __syncthreads();
  const float* gn = p.norm2_g() + layer * DM; const float* rb = p.router_b() + layer * NE;
  const int per = (ntok + nb - 1) / nb, t_beg = bid * per, t_end = min(ntok, t_beg + per);
  for (int tok = t_beg + wid; tok < t_end; tok += 8) {
    const u16* xr = p.X() + (size_t)tok * DM;
    float v[16];
#pragma unroll
    for (int i = 0; i < 4; ++i) { const float4 a = ld4bf(xr + lane * 4 + i * 256); v[4 * i] = a.x; v[4 * i + 1] = a.y; v[4 * i + 2] = a.z; v[4 * i + 3] = a.w; }
    float ss = 0;
#pragma unroll
    for (int i = 0; i < 16; ++i) ss += v[i] * v[i];
    ss = wave_sum(ss);
    const float rs = rsqrtf(ss * (1.f / DM) + EPS);
    const float* md = p.mod() + ((size_t)layer * 3 + modv(tok)) * 6144 + 3 * DM;
#pragma unroll
    for (int i = 0; i < 4; ++i) {
      const int c = lane * 4 + i * 256;
      const float4 g = *(const float4*)(gn + c), sh = *(const float4*)(md + c), sc = *(const float4*)(md + DM + c);
      v[4 * i] = v[4 * i] * rs * g.x * (1.f + sc.x) + sh.x; v[4 * i + 1] = v[4 * i + 1] * rs * g.y * (1.f + sc.y) + sh.y;
      v[4 * i + 2] = v[4 * i + 2] * rs * g.z * (1.f + sc.z) + sh.z; v[4 * i + 3] = v[4 * i + 3] * rs * g.w * (1.f + sc.w) + sh.w;
    }
    const float rowsc = store_row_i8(v, p.H() + (size_t)tok * DM, p.hs() + tok, lane);
    float lg[32];
#pragma unroll
    for (int e = 0; e < 32; ++e) lg[e] = 0.f;
#pragma unroll
    for (int i = 0; i < 16; ++i) {
      const float4* wr4 = (const float4*)rwl + ((i & 3) * 256 + (i >> 2) * 64 + lane);
#pragma unroll
      for (int q = 0; q < 8; ++q) { const float4 w = wr4[q * 1024]; lg[4 * q] += v[i] * w.x; lg[4 * q + 1] += v[i] * w.y; lg[4 * q + 2] += v[i] * w.z; lg[4 * q + 3] += v[i] * w.w; }
    }
    float r16[16], r8[8], r4[4], r2[2], lv;
    { const bool up = lane & 32;
#pragma unroll
      for (int e = 0; e < 16; ++e) { const float keep = up ? lg[16 + e] : lg[e], send = up ? lg[e] : lg[16 + e]; r16[e] = keep + shx<32>(send); } }
    { const bool up = lane & 16;
#pragma unroll
      for (int e = 0; e < 8; ++e) { const float keep = up ? r16[8 + e] : r16[e], send = up ? r16[e] : r16[8 + e]; r8[e] = keep + shx<16>(send); } }
    { const bool up = lane & 8;
#pragma unroll
      for (int e = 0; e < 4; ++e) { const float keep = up ? r8[4 + e] : r8[e], send = up ? r8[e] : r8[4 + e]; r4[e] = keep + shx<8>(send); } }
    { const bool up = lane & 4;
#pragma unroll
      for (int e = 0; e < 2; ++e) { const float keep = up ? r4[2 + e] : r4[e], send = up ? r4[e] : r4[2 + e]; r2[e] = keep + shx<4>(send); } }
    { const bool up = lane & 2; const float keep = up ? r2[1] : r2[0], send = up ? r2[0] : r2[1]; lv = keep + shx<2>(send); }
    lv += shx<1>(lv);
    lv += rb[lane >> 1];
    int ids[4]; float vals[4];
#pragma unroll
    for (int k = 0; k < 4; ++k) {
      const float mx = wave_max(lv);
      const unsigned long long bal = __ballot(lv == mx);
      const int win = __ffsll((long long)bal) - 1;
      ids[k] = win >> 1; vals[k] = mx;
      if ((lane >> 1) == ids[k]) lv = -3.4e38f;
    }
    if (lane == 0) {
      const float mx = vals[0];
      float ex[4], sum = 0;
#pragma unroll
      for (int k = 0; k < 4; ++k) { ex[k] = __expf(vals[k] - mx); sum += ex[k]; }
      const float inv = 1.f / sum;
#pragma unroll
      for (int k = 0; k < 4; ++k) {
        const int lp = atomicAdd(&lcnt[ids[k]], 1);
        const int slot = (tok - t_beg) * 4 + k;
        ent[2 * slot] = tok * 4 + k; ent[2 * slot + 1] = (ids[k] << 20) | lp; entw[slot] = ex[k] * inv; ents[slot] = rowsc;
      }
    }
  }
  __syncthreads();
  if (tid < 32) lbase[tid] = atomicAdd(&p.cnt()[layer * NE + tid], lcnt[tid]);
  __syncthreads();
  const int nas = (t_end > t_beg ? (t_end - t_beg) : 0) * 4;
  for (int s = tid; s < nas; s += NTHR) {
    const int tk = ent[2 * s], el = ent[2 * s + 1], e = el >> 20, pos = lbase[e] + (el & 0xFFFFF);
    p.rtok()[(size_t)e * TT + pos] = tk >> 2; p.rw()[(size_t)e * TT + pos] = entw[s]; p.rsc()[(size_t)e * TT + pos] = ents[s];
    p.tslot()[tk] = (e << 20) | pos;
  }
}

struct G8Moe {
  const int* cnt;
  int ntn, Kb, G, c; const char* Bt; size_t bstride;
  const int* rtok;
  __device__ __forceinline__ bool next(int i, G8Unit& u) const {
    const int w = (i * 8 + (c & 7)) * (G >> 3) + (c >> 3); int acc = 0, rows = 0;
    for (int ee = 0; ee < NE; ++ee) {
      const int cc = cnt[ee], tiles = ((cc + 255) >> 8) * ntn;
      if (w < acc + tiles) { const int r = w - acc; u.e = ee; u.pm = r / ntn; u.pn = r % ntn; u.ce = cc; u.pre = rows; return true; }
      acc += tiles; rows += cc;
    }
    return false;
  }
  __device__ __forceinline__ unsigned a_off(const G8Unit& u, int row) const {
    const int r = min(u.pm * 256 + row, u.ce - 1);
    const int arow = rtok ? rtok[(size_t)u.e * TT + r] : u.pre + r;
    return (unsigned)arow * (unsigned)Kb;
  }
  __device__ __forceinline__ const char* b_ptr(const G8Unit& u) const { return Bt + (size_t)u.e * bstride + (size_t)u.pn * 256 * Kb; }
};
struct EpiGu {
  const float* bgl; u16* act; const float* rsc; const float* swl;
  __device__ __forceinline__ void pre(const G8Unit& u, int wr, int fr, float (&ep)[8], float* cb) const {
    if ((ltid() >> 6) == 0) g8_cload(bgl + (size_t)u.e * 2048 + u.pn * 256, cb);
    if ((ltid() >> 6) == 1) g8_cload(swl + (size_t)u.e * 2048 + u.pn * 256, cb + 256);
#pragma unroll
    for (int ai = 0; ai < 2; ++ai)
#pragma unroll
      for (int m = 0; m < 4; ++m) ep[ai * 4 + m] = rsc[(size_t)u.e * TT + min(u.pm * 256 + ai * 128 + wr * 64 + m * 16 + fr, u.ce - 1)];
  }
  __device__ __forceinline__ void operator()(const i32x4 (&acc)[2][2][4][2], const G8Unit& u, int wr, int wc, int fr, int fq, const float (&ep)[8], const float* cb) const {
    const int j0 = u.pn * 128 + wc * 32 + 8 * fq;
    const float* bg = cb + 2 * (wc * 32 + 8 * fq);
    float bgt[8], bup[8], sg[8], su[8];
#pragma unroll
    for (int q = 0; q < 4; ++q) { const f32x4 t = *(const f32x4*)(bg + 4 * q); bgt[2 * q] = t[0]; bup[2 * q] = t[1]; bgt[2 * q + 1] = t[2]; bup[2 * q + 1] = t[3]; }
    {
      const float* sp = cb + 256 + wc * 32 + 8 * fq;
      const f32x4 g0 = *(const f32x4*)sp, g1 = *(const f32x4*)(sp + 4), u0 = *(const f32x4*)(sp + 128), u1 = *(const f32x4*)(sp + 132);
#pragma unroll
      for (int j = 0; j < 4; ++j) { sg[j] = g0[j]; sg[4 + j] = g1[j]; su[j] = u0[j]; su[4 + j] = u1[j]; }
    }
#pragma unroll
    for (int ai = 0; ai < 2; ++ai)
#pragma unroll
      for (int m = 0; m < 4; ++m) {
        const int r = u.pm * 256 + ai * 128 + wr * 64 + m * 16 + fr;
        if (r < u.ce) {
          const float sa = ep[ai * 4 + m];
          float o[8];
#pragma unroll
          for (int n = 0; n < 2; ++n)
#pragma unroll
            for (int j = 0; j < 4; ++j) {
              const float gate = fminf((float)acc[ai][0][m][n][j] * sa * sg[4 * n + j] + bgt[4 * n + j], 7.f);
              const float up = fminf(fmaxf((float)acc[ai][1][m][n][j] * sa * su[4 * n + j] + bup[4 * n + j], -7.f), 7.f);
              o[4 * n + j] = (up + 1.f) * gate * __builtin_amdgcn_rcpf(1.f + __expf(-1.702f * gate));
            }
          *(u32x4*)(act + (size_t)(u.pre + r) * DFF + j0) = u32x4{cvtpk(o[0], o[1]), cvtpk(o[2], o[3]), cvtpk(o[4], o[5]), cvtpk(o[6], o[7])};
        }
      }
  }
};
struct EpiDn {
  const float* bdl; const float* rw; unsigned char* yd;
  __device__ __forceinline__ void pre(const G8Unit& u, int wr, int fr, float (&ep)[8], float* cb) const {
    if ((ltid() >> 6) == 0) g8_cload(bdl + (size_t)u.e * DM + u.pn * 256, cb);
#pragma unroll
    for (int ai = 0; ai < 2; ++ai)
#pragma unroll
      for (int m = 0; m < 4; ++m) ep[ai * 4 + m] = rw[(size_t)u.e * TT + min(u.pm * 256 + ai * 128 + wr * 64 + m * 16 + fr, u.ce - 1)];
  }
  __device__ __forceinline__ void operator()(const f32x4 (&acc)[2][2][4][2], const G8Unit& u, int wr, int wc, int fr, int fq, const float (&ep)[8], const float* cb) const {
#pragma unroll
    for (int bj = 0; bj < 2; ++bj) {
      const int c0 = u.pn * 256 + bj * 128 + wc * 32 + 8 * fq;
      const f32x4 ba = *(const f32x4*)(cb + bj * 128 + wc * 32 + 8 * fq), bb = *(const f32x4*)(cb + bj * 128 + wc * 32 + 8 * fq + 4);
#pragma unroll
      for (int ai = 0; ai < 2; ++ai)
#pragma unroll
        for (int m = 0; m < 4; ++m) {
          const int r = u.pm * 256 + ai * 128 + wr * 64 + m * 16 + fr;
          if (r < u.ce) {
            const float wgt = ep[ai * 4 + m];
            const float w8 = wgt * 8.f;
            f32x4 a = (acc[ai][bj][m][0] + ba) * w8, b = (acc[ai][bj][m][1] + bb) * w8;
#pragma unroll
            for (int j = 0; j < 4; ++j) { a[j] = fminf(fmaxf(a[j], -440.f), 440.f); b[j] = fminf(fmaxf(b[j], -440.f), 440.f); }
            int w0 = 0, w1 = 0;
            w0 = __builtin_amdgcn_cvt_pk_fp8_f32(a[0], a[1], w0, false); w0 = __builtin_amdgcn_cvt_pk_fp8_f32(a[2], a[3], w0, true);
            w1 = __builtin_amdgcn_cvt_pk_fp8_f32(b[0], b[1], w1, false); w1 = __builtin_amdgcn_cvt_pk_fp8_f32(b[2], b[3], w1, true);
            *(u32x2*)(yd + (size_t)(u.pre + r) * DM + c0) = u32x2{(unsigned)w0, (unsigned)w1};
          }
        }
    }
  }
};
__device__ __forceinline__ void phase_moe_gu(const Params& p, int layer, int bid, int nb, char* lds) {
  int* scnt = (int*)(lds + 131072);
  if (ltid() < NE) scnt[ltid()] = p.cnt()[layer * NE + ltid()];
  __syncthreads();
  G8Moe S; S.cnt = scnt; S.ntn = 8; S.Kb = DM; S.G = nb; S.c = bid; S.Bt = (const char*)(p.bt_gu() + (size_t)layer * NE * 2048 * DM); S.bstride = (size_t)2048 * DM; S.rtok = p.rtok();
  EpiGu E; E.bgl = p.moe_b_gu() + (size_t)layer * NE * 2048; E.act = p.act(); E.rsc = p.rsc(); E.swl = p.swgu() + (size_t)layer * NE * 2048;
  gemm8_phase<true>(lds, (const char*)p.H(), DM, S, E);
}
__device__ __forceinline__ void phase_moe_dn(const Params& p, int layer, int bid, int nb, char* lds) {
  int* scnt = (int*)(lds + 131072);
  if (ltid() < NE) scnt[ltid()] = p.cnt()[layer * NE + ltid()];
  __syncthreads();
  G8Moe S; S.cnt = scnt; S.ntn = 4; S.Kb = 2 * DFF; S.G = nb; S.c = bid; S.Bt = (const char*)(p.bt_dn() + (size_t)layer * NE * DM * DFF); S.bstride = (size_t)DM * DFF * 2; S.rtok = nullptr;
  EpiDn E; E.bdl = p.moe_b_down() + (size_t)layer * NE * DM; E.rw = p.rw(); E.yd = p.yd();
  gemm8_phase<false>(lds, (const char*)p.act(), 2 * DFF, S, E);
}

__device__ __forceinline__ void phase_final(const Params& p, int bid, int nb, char* lds) {
  int* pre = (int*)lds;
  expert_prefix(p.cnt() + NE, pre); __syncthreads();
  const int wid = ltid() >> 6, lane = ltid() & 63;
  for (int tok = bid * 8 + wid; tok < TL; tok += nb * 8) {
    float v[16];
    load_row_comb(p, 1, 1, tok, lane, pre, v);
    float ss = 0;
#pragma unroll
    for (int i = 0; i < 16; ++i) ss += v[i] * v[i];
    ss = wave_sum(ss);
    const float rs = rsqrtf(ss * (1.f / DM) + EPS);
    float* o = p.out() + (size_t)tok * DM;
#pragma unroll
    for (int i = 0; i < 4; ++i) {
      const int c = lane * 4 + i * 256;
      const float4 g = *(const float4*)(p.final_g() + c);
      *(float4*)(o + c) = make_float4(v[4 * i] * rs * g.x, v[4 * i + 1] * rs * g.y, v[4 * i + 2] * rs * g.z, v[4 * i + 3] * rs * g.w);
    }
  }
}

#define XB_TMO      128
#define XB_XCNT(j)  (256  + 64 * (j))
#define XB_XSUB(j)  (1280 + 64 * (j))
#define XB_XGEN(j)  (2304 + 64 * (j))
#define XB_TOP      3328
#define XB_TOPGEN   3392
#define XCD_BAR_WORDS 3456
#define XB_SPIN_CAP (1u << 18)
#define LAS __attribute__((address_space(3)))

__device__ __forceinline__ unsigned xb_ld(unsigned* p)              { return __hip_atomic_load(p, __ATOMIC_RELAXED, __HIP_MEMORY_SCOPE_AGENT); }
__device__ __forceinline__ unsigned xb_add(unsigned* p, unsigned v) { return __hip_atomic_fetch_add(p, v, __ATOMIC_RELAXED, __HIP_MEMORY_SCOPE_AGENT); }
__device__ __forceinline__ unsigned xb_xcc_id() { return (unsigned)__builtin_amdgcn_s_getreg((3 << 11) | 20) & 0xFu; }
#define XB_SPIN(cond, bar) do { unsigned _sp = 0; while (cond) { __builtin_amdgcn_s_sleep(1); \
    if ((++_sp & 255u) == 0u) { if (xb_ld(&(bar)[XB_TMO])) break; if (_sp > XB_SPIN_CAP) { atomicAdd(&(bar)[XB_TMO], 1u); break; } } } } while (0)

struct XcdBarrier {
    unsigned* bar; unsigned x;
    volatile LAS unsigned* st;
};

__device__ __forceinline__ XcdBarrier xcd_barrier_post(unsigned* bar, volatile LAS unsigned* st) {
    XcdBarrier b; b.bar = bar; b.x = xb_xcc_id(); b.st = st;
    if (threadIdx.x == 0) (void)xb_add(&bar[XB_XCNT(b.x)], 1u);
    return b;
}
__device__ __forceinline__ void xcd_barrier_complete(unsigned* bar, unsigned x, unsigned& nloc, unsigned& nx) {
    const unsigned G = gridDim.x * gridDim.y * gridDim.z;
    unsigned sum, cnt, mine, sp = 0u;
    for (;;) {
        sum = 0u; cnt = 0u; mine = 0u;
#pragma unroll
        for (unsigned j = 0; j < 16; ++j) { const unsigned c = xb_ld(&bar[XB_XCNT(j)]); sum += c; cnt += (c > 0u) ? 1u : 0u; mine = (j == x) ? c : mine; }
        if (sum == G) break;
        __builtin_amdgcn_s_sleep(1);
        if ((++sp & 255u) == 0u) { if (xb_ld(&bar[XB_TMO])) break; if (sp > XB_SPIN_CAP) { atomicAdd(&bar[XB_TMO], 1u); break; } }
    }
    nloc = mine > 0u ? mine : 1u; nx = cnt > 0u ? cnt : 1u;
}

__device__ __forceinline__ void xcd_barrier(const XcdBarrier& b) {
    asm volatile("s_waitcnt vmcnt(0)" ::: "memory");
    __syncthreads();
    if (threadIdx.x == 0) {
        unsigned* bar = b.bar;
        __builtin_amdgcn_s_waitcnt(0);
        unsigned nloc = b.st[0], nx = b.st[1];
        if (nloc == 0u) { xcd_barrier_complete(bar, b.x, nloc, nx); b.st[0] = nloc; b.st[1] = nx; }
        const unsigned old = xb_add(&bar[XB_XSUB(b.x)], 1u);
        const unsigned gen = old / nloc;
        if (old + 1u == (gen + 1u) * nloc) {
            __builtin_amdgcn_fence(__ATOMIC_RELEASE, "agent");
            asm volatile("s_waitcnt vmcnt(0)" ::: "memory");
            const unsigned og = xb_add(&bar[XB_TOP], 1u);
            const unsigned tg = og / nx;
            if (og + 1u == (tg + 1u) * nx) xb_add(&bar[XB_TOPGEN], 1u);
            else XB_SPIN(xb_ld(&bar[XB_TOPGEN]) == tg, bar);
            __builtin_amdgcn_fence(__ATOMIC_ACQUIRE, "agent");
            xb_add(&bar[XB_XGEN(b.x)], 1u);
            asm volatile("s_waitcnt vmcnt(0)" ::: "memory");
        } else {
            XB_SPIN(xb_ld(&bar[XB_XGEN(b.x)]) == gen, bar);
            __builtin_amdgcn_fence(__ATOMIC_ACQUIRE, "agent");
            asm volatile("s_waitcnt vmcnt(0)" ::: "memory");
        }
    }
    __syncthreads();
}


constexpr int LDS_MAIN = 147456;
constexpr int LDS_BYTES = LDS_MAIN + 1024;
enum { PH_TABLES = 0, PH_MOD, PH_FOLD, PH_CONVERT, PH_HYMLP, PH_HYFILT, PH_NORM1, PH_GEMM_IN, PH_QKV, PH_ATTN, PH_FFTMIX,
       PH_GLA_A, PH_GLA_B, PH_GLA_C, PH_MIX, PH_GEMM_OUT, PH_NORM2, PH_MOE_GU, PH_MOE_DN, PH_FINAL };

__device__ __forceinline__ Params make_params() {
  const __attribute__((address_space(4))) char* kb = (const __attribute__((address_space(4))) char*)__builtin_amdgcn_kernarg_segment_ptr();
  asm volatile("" : "+s"(kb));
  Params p; p.kb = kb; return p;
}
#ifndef MK_LAUNCHES
#define MK_LAUNCHES 1
#endif
__global__ void __launch_bounds__(NTHR, 2) k_mega(ParamsData pd) {
  extern __shared__ __attribute__((aligned(1024))) char lds[];
  const int bid = blockIdx.x, nb = gridDim.x;
  if (threadIdx.x == 0) *(uint4*)(lds + LDS_MAIN) = make_uint4(0u, 0u, 0u, 0u);
  __syncthreads();
  XcdBarrier bar = xcd_barrier_post(make_params().bar(), (volatile LAS unsigned*)(lds + LDS_MAIN));
#ifndef DBLMASK
#define DBLMASK 0u
#endif
#define RUNPH(bit, call) do { call; if (DBLMASK & (1u << (bit))) { __syncthreads(); call; } } while (0)
  RUNPH(13, phase_tables(make_params(), bid, nb); phase_mod(make_params(), bid, nb, lds); phase_fold(make_params(), bid, nb, lds));
  RUNPH(0, phase_convert(make_params(), bid, nb, lds));
  phase_hy_mlp(make_params(), 0, SEQ, make_params().hfb(), make_params().hpart(), bid, nb, lds);
  phase_hy_mlp(make_params(), 1, SEQ, make_params().hfb() + (size_t)2 * 256 * SEQ, make_params().hpart() + 256 * 512, bid, nb, lds);
  phase_hy_mlp(make_params(), 0, LC, make_params().hfc(), make_params().hpart() + 2 * 256 * 512, bid, nb, lds);
  xcd_barrier(bar);
  RUNPH(2, phase_hy_filtfft(make_params(), bid, nb, lds));
  phase_quant_in(make_params(), bid, nb);
#define MK_LAYER(l) do { \
  phase_norm1(make_params(), l, bid, nb, lds); if ((DBLMASK & (1u << 14)) && l == 0) { __syncthreads(); phase_norm1(make_params(), l, bid, nb, lds); } \
  xcd_barrier(bar); \
  RUNPH(3, phase_gemm_in(make_params(), l, bid, nb, lds)); \
  xcd_barrier(bar); \
  RUNPH(4, phase_qkv(make_params(), l, bid, nb, lds)); \
  RUNPH(5, phase_gla_a(make_params(), l, bid, nb, lds)); \
  RUNPH(7, phase_fftmix(make_params(), l, bid, nb, lds)); \
  xcd_barrier(bar); \
  RUNPH(6, phase_attn(make_params(), l, bid, nb, lds)); \
  RUNPH(9, phase_gla_c(make_params(), l, bid, nb, lds)); \
  RUNPH(10, phase_mix(make_params(), l, bid, nb, lds)); \
  xcd_barrier(bar); \
  phase_gemm_out(make_params(), l, bid, nb, lds); if ((DBLMASK & (1u << 16)) && l == 0) { __syncthreads(); phase_gemm_out(make_params(), l, bid, nb, lds); } \
  xcd_barrier(bar); \
  phase_norm2_router(make_params(), l, bid, nb, lds); \
  xcd_barrier(bar); \
  RUNPH(11, phase_moe_gu(make_params(), l, bid, nb, lds)); \
  xcd_barrier(bar); \
  RUNPH(12, phase_moe_dn(make_params(), l, bid, nb, lds)); \
  xcd_barrier(bar); \
  } while (0)
  MK_LAYER(0);
  MK_LAYER(1);
#undef MK_LAYER
  RUNPH(15, phase_final(make_params(), bid, nb, lds));
}
static size_t carve(char*& cur, size_t bytes) { char* r = cur; cur += (bytes + 1023) & ~(size_t)1023; return (size_t)(uintptr_t)r; }
#define CARVE(T, field, n) p.field = (T*)carve(cur, (size_t)(n) * sizeof(T))

extern "C" void kernel_launch(void* const* d_in, const int* in_sizes, int n_in, void* d_out, int out_size, void* d_ws, size_t ws_size, hipStream_t stream) {
  ParamsData p; memset(&p, 0, sizeof(p));
  const float** ins = (const float**)&p;
  for (int i = 0; i < 34; ++i) ins[i] = (const float*)d_in[i];
  p.out_ = (float*)d_out;
  p.ws_ = (char*)d_ws;
  if (WS_TOTAL > ws_size) { fprintf(stderr, "workspace too small: need %zu have %zu\n", (size_t)WS_TOTAL, ws_size); return; }
  hipMemsetAsync((char*)d_ws + OFF_bar, 0, OFF_mod - OFF_bar, stream);
  static int grid = 0;
  if (!grid) {
    int dev = 0, cus = 0, per_cu = 0;
    hipGetDevice(&dev);
    hipDeviceGetAttribute(&cus, hipDeviceAttributeMultiprocessorCount, dev);
    hipFuncSetAttribute((const void*)k_mega, hipFuncAttributeMaxDynamicSharedMemorySize, LDS_BYTES);
    hipOccupancyMaxActiveBlocksPerMultiprocessor(&per_cu, (const void*)k_mega, NTHR, LDS_BYTES);
    grid = cus * (per_cu < 1 ? per_cu : 1);
    if (grid != 256) fprintf(stderr, "unexpected grid %d (cus %d per_cu %d)\n", grid, cus, per_cu);
  }
  hipLaunchKernelGGL(k_mega, dim3(grid), dim3(NTHR), LDS_BYTES, stream, p);
}
```

```cpp
#include <hip/hip_runtime.h>
#include <hip/hip_bf16.h>
#include <cstdio>
#include <cstdint>
#include <cstring>
#include <cstddef>
#include <type_traits>

typedef unsigned short u16;
using bf16x8 = __attribute__((ext_vector_type(8))) short;
using s16x4  = __attribute__((ext_vector_type(4))) short;
using f32x4  = __attribute__((ext_vector_type(4))) float;
using f32x16 = __attribute__((ext_vector_type(16))) float;
using u32x4  = __attribute__((ext_vector_type(4))) unsigned;
using u32x2  = __attribute__((ext_vector_type(2))) unsigned;

constexpr int DM = 1024, NB = 2, SEQ = 16384, LC = 256;
constexpr int TL = NB * SEQ;
constexpr int TC = NB * LC;
constexpr int TT = TL + TC;
constexpr int NIN = 2816;
constexpr int DIN0 = 2240;
constexpr int NE = 32, TOPK = 4, DFF = 1024;
constexpr int SKV = SEQ + LC;
constexpr int NTHR = 512;
constexpr float EPS = 1e-6f;
constexpr float A_SCALE = 0.10206207261596575f;
constexpr float A_QSCALE = A_SCALE * 1.4426950408889634f;
constexpr int ZG_W = 1152, ZG_GQ = 0, ZG_GK = 128, ZG_KR = 256, ZG_GV = 384, ZG_GP = 640, ZG_OG = 896;
constexpr int ZT_HY = 0, ZT_FR = 768, ZT_FI = 1024, ZT_R = 1280;
constexpr int NCH = 260;
constexpr int FM = 16384;
constexpr int HSP = FM / 2 + 1;

constexpr size_t ws_al(size_t b) { return (b + 1023) & ~(size_t)1023; }
constexpr size_t OFF_bar = 0;
constexpr size_t OFF_cnt = OFF_bar + ws_al((size_t)(4096) * sizeof(unsigned));
constexpr size_t OFF_hssq = OFF_cnt + ws_al((size_t)(64) * sizeof(int));
constexpr size_t OFF_kmx = OFF_hssq + ws_al((size_t)(768) * sizeof(float));
constexpr size_t OFF_mod = OFF_kmx + ws_al((size_t)(128) * sizeof(unsigned));
constexpr size_t OFF_ropec = OFF_mod + ws_al((size_t)(2 * 3 * 6144) * sizeof(float));
constexpr size_t OFF_ropes = OFF_ropec + ws_al((size_t)(SEQ * 16) * sizeof(float));
constexpr size_t OFF_tw = OFF_ropes + ws_al((size_t)(SEQ * 16) * sizeof(float));
constexpr size_t OFF_bt_in = OFF_tw + ws_al((size_t)(FM) * sizeof(float2));
constexpr size_t OFF_bt_qkv = OFF_bt_in + ws_al((size_t)((size_t)2 * NIN * DM) * sizeof(u16));
constexpr size_t OFF_bt_out = OFF_bt_qkv + ws_al((size_t)(2 * 1024 * 384) * sizeof(u16));
constexpr size_t OFF_bt_gu = OFF_bt_out + ws_al((size_t)((size_t)2 * DM * DM) * sizeof(u16));
constexpr size_t OFF_bt_dn = OFF_bt_gu + ws_al((size_t)((size_t)2 * NE * 2048 * DM) * sizeof(u16));
constexpr size_t OFF_hfb = OFF_bt_dn + ws_al((size_t)((size_t)2 * NE * DM * DFF) * sizeof(u16));
constexpr size_t OFF_hfc = OFF_hfb + ws_al((size_t)((size_t)2 * 2 * 256 * SEQ) * sizeof(float));
constexpr size_t OFF_hspec = OFF_hfc + ws_al((size_t)(2 * 256 * LC) * sizeof(float));
constexpr size_t OFF_H = OFF_hspec + ws_al((size_t)((size_t)2 * 256 * HSP) * sizeof(float4));
constexpr size_t OFF_zqkv = OFF_H + ws_al((size_t)((size_t)TT * DM) * sizeof(u16));
constexpr size_t OFF_zg = OFF_zqkv + ws_al((size_t)((size_t)TT * 384) * sizeof(u16));
constexpr size_t OFF_zt = OFF_zg + ws_al((size_t)((size_t)TT * ZG_W) * sizeof(float));
constexpr size_t OFF_Q = OFF_zt + ws_al((size_t)((size_t)ZT_R * TT) * sizeof(float));
constexpr size_t OFF_KV = OFF_Q + ws_al((size_t)((size_t)2 * 4 * SKV * 96) * sizeof(u16));
constexpr size_t OFF_ymix = OFF_KV + ws_al((size_t)((size_t)2 * 4 * SKV * 160) * sizeof(u16));
constexpr size_t OFF_hyo = OFF_ymix + ws_al((size_t)((size_t)TT * DM) * sizeof(u16));
constexpr size_t OFF_fno = OFF_hyo + ws_al((size_t)((size_t)256 * TT) * sizeof(float));
constexpr size_t OFF_glao = OFF_fno + ws_al((size_t)((size_t)256 * TT) * sizeof(float));
constexpr size_t OFF_gds = OFF_glao + ws_al((size_t)((size_t)TT * 256) * sizeof(float));
constexpr size_t OFF_gdv = OFF_gds + ws_al((size_t)((size_t)16 * NCH * 2048) * sizeof(float));
constexpr size_t OFF_gst = OFF_gdv + ws_al((size_t)((size_t)16 * NCH * 32) * sizeof(float));
constexpr size_t OFF_X = OFF_gst + ws_al((size_t)((size_t)16 * NCH * 2048) * sizeof(float));
constexpr size_t OFF_rtok = OFF_X + ws_al((size_t)((size_t)TT * DM) * sizeof(float));
constexpr size_t OFF_rw = OFF_rtok + ws_al((size_t)((size_t)NE * TT) * sizeof(int));
constexpr size_t OFF_tslot = OFF_rw + ws_al((size_t)((size_t)NE * TT) * sizeof(float));
constexpr size_t OFF_act = OFF_tslot + ws_al((size_t)((size_t)TT * 4) * sizeof(int));
constexpr size_t OFF_yd = OFF_act + ws_al((size_t)((size_t)TT * 4 * DFF) * sizeof(u16));
constexpr size_t OFF_swin = OFF_yd + ws_al((size_t)((size_t)TT * 4 * DM) * sizeof(u16));
constexpr size_t OFF_swgu = OFF_swin + ws_al((size_t)(2 * NIN) * sizeof(float));
constexpr size_t OFF_hs = OFF_swgu + ws_al((size_t)(2 * NE * 2048) * sizeof(float));
constexpr size_t OFF_hpart = OFF_hs + ws_al((size_t)(TT) * sizeof(float));
constexpr size_t OFF_rsc = OFF_hpart + ws_al((size_t)(3 * 256 * 512) * sizeof(float));
constexpr size_t WS_TOTAL = OFF_rsc + ws_al((size_t)((size_t)NE * TT) * sizeof(float));
struct ParamsData {
  const float *x_, *c_, *ctx_, *c_ctx_, *ada_w_, *ada_b_, *norm1_g_, *norm2_g_, *w_in_, *mla_q_g_, *mla_w_uq_, *mla_kv_g_, *mla_w_ukv_, *hy_conv_w_, *hy_conv_b_, *hy_w1_, *hy_b1_, *hy_w2_, *hy_b2_, *hy_w3_, *hy_freq_, *hy_bias_, *gla_gk_w_, *gla_gk_b_, *fnet_w_, *mix_g_, *w_out_, *router_w_, *router_b_, *moe_w_gu_, *moe_b_gu_, *moe_w_down_, *moe_b_down_, *final_g_;
  float* out_;
  char* ws_;
};
struct Params {
  const __attribute__((address_space(4))) char* kb;
  template <class T> __device__ __forceinline__ T karg(size_t off) const { return *(const __attribute__((address_space(4))) T*)(kb + off); }
  __device__ __forceinline__ const float* x() const { return karg<const float*>(offsetof(ParamsData, x_)); }
  __device__ __forceinline__ const float* c() const { return karg<const float*>(offsetof(ParamsData, c_)); }
  __device__ __forceinline__ const float* ctx() const { return karg<const float*>(offsetof(ParamsData, ctx_)); }
  __device__ __forceinline__ const float* c_ctx() const { return karg<const float*>(offsetof(ParamsData, c_ctx_)); }
  __device__ __forceinline__ const float* ada_w() const { return karg<const float*>(offsetof(ParamsData, ada_w_)); }
  __device__ __forceinline__ const float* ada_b() const { return karg<const float*>(offsetof(ParamsData, ada_b_)); }
  __device__ __forceinline__ const float* norm1_g() const { return karg<const float*>(offsetof(ParamsData, norm1_g_)); }
  __device__ __forceinline__ const float* norm2_g() const { return karg<const float*>(offsetof(ParamsData, norm2_g_)); }
  __device__ __forceinline__ const float* w_in() const { return karg<const float*>(offsetof(ParamsData, w_in_)); }
  __device__ __forceinline__ const float* mla_q_g() const { return karg<const float*>(offsetof(ParamsData, mla_q_g_)); }
  __device__ __forceinline__ const float* mla_w_uq() const { return karg<const float*>(offsetof(ParamsData, mla_w_uq_)); }
  __device__ __forceinline__ const float* mla_kv_g() const { return karg<const float*>(offsetof(ParamsData, mla_kv_g_)); }
  __device__ __forceinline__ const float* mla_w_ukv() const { return karg<const float*>(offsetof(ParamsData, mla_w_ukv_)); }
  __device__ __forceinline__ const float* hy_conv_w() const { return karg<const float*>(offsetof(ParamsData, hy_conv_w_)); }
  __device__ __forceinline__ const float* hy_conv_b() const { return karg<const float*>(offsetof(ParamsData, hy_conv_b_)); }
  __device__ __forceinline__ const float* hy_w1() const { return karg<const float*>(offsetof(ParamsData, hy_w1_)); }
  __device__ __forceinline__ const float* hy_b1() const { return karg<const float*>(offsetof(ParamsData, hy_b1_)); }
  __device__ __forceinline__ const float* hy_w2() const { return karg<const float*>(offsetof(ParamsData, hy_w2_)); }
  __device__ __forceinline__ const float* hy_b2() const { return karg<const float*>(offsetof(ParamsData, hy_b2_)); }
  __device__ __forceinline__ const float* hy_w3() const { return karg<const float*>(offsetof(ParamsData, hy_w3_)); }
  __device__ __forceinline__ const float* hy_freq() const { return karg<const float*>(offsetof(ParamsData, hy_freq_)); }
  __device__ __forceinline__ const float* hy_bias() const { return karg<const float*>(offsetof(ParamsData, hy_bias_)); }
  __device__ __forceinline__ const float* gla_gk_w() const { return karg<const float*>(offsetof(ParamsData, gla_gk_w_)); }
  __device__ __forceinline__ const float* gla_gk_b() const { return karg<const float*>(offsetof(ParamsData, gla_gk_b_)); }
  __device__ __forceinline__ const float* fnet_w() const { return karg<const float*>(offsetof(ParamsData, fnet_w_)); }
  __device__ __forceinline__ const float* mix_g() const { return karg<const float*>(offsetof(ParamsData, mix_g_)); }
  __device__ __forceinline__ const float* w_out() const { return karg<const float*>(offsetof(ParamsData, w_out_)); }
  __device__ __forceinline__ const float* router_w() const { return karg<const float*>(offsetof(ParamsData, router_w_)); }
  __device__ __forceinline__ const float* router_b() const { return karg<const float*>(offsetof(ParamsData, router_b_)); }
  __device__ __forceinline__ const float* moe_w_gu() const { return karg<const float*>(offsetof(ParamsData, moe_w_gu_)); }
  __device__ __forceinline__ const float* moe_b_gu() const { return karg<const float*>(offsetof(ParamsData, moe_b_gu_)); }
  __device__ __forceinline__ const float* moe_w_down() const { return karg<const float*>(offsetof(ParamsData, moe_w_down_)); }
  __device__ __forceinline__ const float* moe_b_down() const { return karg<const float*>(offsetof(ParamsData, moe_b_down_)); }
  __device__ __forceinline__ const float* final_g() const { return karg<const float*>(offsetof(ParamsData, final_g_)); }
  __device__ __forceinline__ float* out() const { return karg<float*>(offsetof(ParamsData, out_)); }
  __device__ __forceinline__ char* ws() const { return karg<char*>(offsetof(ParamsData, ws_)); }
  __device__ __forceinline__ unsigned* bar() const { return (unsigned*)(ws() + OFF_bar); }
  __device__ __forceinline__ int* cnt() const { return (int*)(ws() + OFF_cnt); }
  __device__ __forceinline__ float* hssq() const { return (float*)(ws() + OFF_hssq); }
  __device__ __forceinline__ unsigned* kmx() const { return (unsigned*)(ws() + OFF_kmx); }
  __device__ __forceinline__ float* mod() const { return (float*)(ws() + OFF_mod); }
  __device__ __forceinline__ float* ropec() const { return (float*)(ws() + OFF_ropec); }
  __device__ __forceinline__ float* ropes() const { return (float*)(ws() + OFF_ropes); }
  __device__ __forceinline__ float2* tw() const { return (float2*)(ws() + OFF_tw); }
  __device__ __forceinline__ signed char* bt_in() const { return (signed char*)(ws() + OFF_bt_in); }
  __device__ __forceinline__ u16* bt_qkv() const { return (u16*)(ws() + OFF_bt_qkv); }
  __device__ __forceinline__ u16* bt_out() const { return (u16*)(ws() + OFF_bt_out); }
  __device__ __forceinline__ signed char* bt_gu() const { return (signed char*)(ws() + OFF_bt_gu); }
  __device__ __forceinline__ u16* bt_dn() const { return (u16*)(ws() + OFF_bt_dn); }
  __device__ __forceinline__ float* hfb() const { return (float*)(ws() + OFF_hfb); }
  __device__ __forceinline__ float* hfc() const { return (float*)(ws() + OFF_hfc); }
  __device__ __forceinline__ float4* hspec() const { return (float4*)(ws() + OFF_hspec); }
  __device__ __forceinline__ signed char* H() const { return (signed char*)(ws() + OFF_H); }
  __device__ __forceinline__ float* hs() const { return (float*)(ws() + OFF_hs); }
  __device__ __forceinline__ float* rsc() const { return (float*)(ws() + OFF_rsc); }
  __device__ __forceinline__ float* hpart() const { return (float*)(ws() + OFF_hpart); }
  __device__ __forceinline__ float* swin() const { return (float*)(ws() + OFF_swin); }
  __device__ __forceinline__ float* swgu() const { return (float*)(ws() + OFF_swgu); }
  __device__ __forceinline__ float* btf() const { return (float*)(ws() + OFF_act); }
  __device__ __forceinline__ u16* zqkv() const { return (u16*)(ws() + OFF_zqkv); }
  __device__ __forceinline__ u16* zg() const { return (u16*)(ws() + OFF_zg); }
  __device__ __forceinline__ u16* zt() const { return (u16*)(ws() + OFF_zt); }
  __device__ __forceinline__ u16* Q() const { return (u16*)(ws() + OFF_Q); }
  __device__ __forceinline__ u16* KV() const { return (u16*)(ws() + OFF_KV); }
  __device__ __forceinline__ u16* ymix() const { return (u16*)(ws() + OFF_ymix); }
  __device__ __forceinline__ u16* hyo() const { return (u16*)(ws() + OFF_hyo); }
  __device__ __forceinline__ u16* fno() const { return (u16*)(ws() + OFF_fno); }
  __device__ __forceinline__ u16* glao() const { return (u16*)(ws() + OFF_glao); }
  __device__ __forceinline__ float* gds() const { return (float*)(ws() + OFF_gds); }
  __device__ __forceinline__ float* gdv() const { return (float*)(ws() + OFF_gdv); }
  __device__ __forceinline__ float* gst() const { return (float*)(ws() + OFF_gst); }
  __device__ __forceinline__ u16* X() const { return (u16*)(ws() + OFF_X); }
  __device__ __forceinline__ int* rtok() const { return (int*)(ws() + OFF_rtok); }
  __device__ __forceinline__ float* rw() const { return (float*)(ws() + OFF_rw); }
  __device__ __forceinline__ int* tslot() const { return (int*)(ws() + OFF_tslot); }
  __device__ __forceinline__ u16* act() const { return (u16*)(ws() + OFF_act); }
  __device__ __forceinline__ unsigned char* yd() const { return (unsigned char*)(ws() + OFF_yd); }
};


__device__ __forceinline__ u16 f2bf(float f) {
  unsigned u = __float_as_uint(f); u += 0x7FFFu + ((u >> 16) & 1u); return (u16)(u >> 16);
}
__device__ __forceinline__ float bf2f(u16 h) { return __uint_as_float(((unsigned)h) << 16); }
__device__ __forceinline__ unsigned cvtpk(float lo, float hi) {
  unsigned r; asm volatile("v_cvt_pk_bf16_f32 %0, %1, %2" : "=v"(r) : "v"(lo), "v"(hi)); return r;
}
#define BF_LO(w) __uint_as_float((w) << 16)
#define BF_HI(w) __uint_as_float((w) & 0xFFFF0000u)
__device__ __forceinline__ float4 ld4bf(const u16* p) { const u32x2 w = *(const u32x2*)p; return make_float4(__uint_as_float(w[0] << 16), __uint_as_float(w[0] & 0xFFFF0000u), __uint_as_float(w[1] << 16), __uint_as_float(w[1] & 0xFFFF0000u)); }
template <int CTRL> __device__ __forceinline__ float dppf(float v) { return __builtin_bit_cast(float, __builtin_amdgcn_update_dpp(0, __builtin_bit_cast(int, v), CTRL, 0xF, 0xF, true)); }
template <int M> __device__ __forceinline__ float shx(float v) {
  if constexpr (M == 1) return dppf<0xB1>(v);
  else if constexpr (M == 2) return dppf<0x4E>(v);
  else if constexpr (M == 4) return dppf<0x1B>(dppf<0x141>(v));
  else if constexpr (M == 8) return dppf<0x141>(dppf<0x140>(v));
  else if constexpr (M == 16) { auto r = __builtin_amdgcn_permlane16_swap(__float_as_uint(v), __float_as_uint(v), false, false);
    return __uint_as_float((__lane_id() & 16) ? r[0] : r[1]); }
  else { auto r = __builtin_amdgcn_permlane32_swap(__float_as_uint(v), __float_as_uint(v), false, false);
    return __uint_as_float((__lane_id() & 32) ? r[0] : r[1]); }
}
__device__ __forceinline__ float wave_sum(float v) {
  v += dppf<0xB1>(v); v += dppf<0x4E>(v); v += dppf<0x141>(v); v += dppf<0x140>(v);
  { auto r = __builtin_amdgcn_permlane16_swap(__float_as_uint(v), __float_as_uint(v), false, false); v = __uint_as_float(r[0]) + __uint_as_float(r[1]); }
  { auto r = __builtin_amdgcn_permlane32_swap(__float_as_uint(v), __float_as_uint(v), false, false); v = __uint_as_float(r[0]) + __uint_as_float(r[1]); }
  return v;
}
__device__ __forceinline__ float wave_max(float v) {
  v = fmaxf(v, dppf<0xB1>(v)); v = fmaxf(v, dppf<0x4E>(v)); v = fmaxf(v, dppf<0x141>(v)); v = fmaxf(v, dppf<0x140>(v));
  { auto r = __builtin_amdgcn_permlane16_swap(__float_as_uint(v), __float_as_uint(v), false, false); v = fmaxf(__uint_as_float(r[0]), __uint_as_float(r[1])); }
  { auto r = __builtin_amdgcn_permlane32_swap(__float_as_uint(v), __float_as_uint(v), false, false); v = fmaxf(__uint_as_float(r[0]), __uint_as_float(r[1])); }
  return v;
}
__device__ __forceinline__ int ltid() { int t = threadIdx.x; asm volatile("" : "+v"(t)); return t; }
__device__ __forceinline__ float silu_f(float x) { return x / (1.f + __expf(-x)); }
__device__ __forceinline__ float2 cmul(float2 a, float2 b) { return make_float2(a.x * b.x - a.y * b.y, a.x * b.y + a.y * b.x); }
__device__ __forceinline__ float2 cmulc(float2 a, float2 b) { return make_float2(a.x * b.x + a.y * b.y, a.y * b.x - a.x * b.y); }
__device__ __forceinline__ int modv(int tok) { return tok < TL ? (tok >> 14) : 2; }
__device__ __forceinline__ void phase_tables(const Params& p, int bid, int nb) {
  const int gt = bid * NTHR + ltid(), gs = nb * NTHR;
  for (int i = gt; i < SEQ * 16; i += gs) {
    const int t = i >> 4, f = i & 15;
    const float pos = (f < 8) ? (float)(t >> 6) : (float)(t & 63);
    const float inv = powf(10000.f, -(float)(f & 7) / 8.f);
    float s, c; sincosf(pos * inv, &s, &c);
    p.ropec()[i] = c; p.ropes()[i] = s;
  }
  for (int i = gt; i < FM; i += gs) {
    float s, c; sincospif((float)i / 8192.f, &s, &c);
    p.tw()[i] = make_float2(c, -s);
  }
}

__device__ __forceinline__ void phase_mod(const Params& p, int bid, int nb, char* lds) {
  float* red = (float*)lds;
  const int tid = ltid(), part = tid >> 6, cl = tid & 63;
  for (int it = bid; it < 2 * 96; it += nb) {
    const int l = it / 96, n = (it % 96) * 64 + cl;
    const float* W = p.ada_w() + (size_t)l * DM * 6144;
    float a0 = 0, a1 = 0, a2 = 0;
    for (int k = part * 128; k < part * 128 + 128; ++k) {
      const float w = W[(size_t)k * 6144 + n];
      a0 += silu_f(p.c()[k]) * w; a1 += silu_f(p.c()[DM + k]) * w; a2 += silu_f(p.c_ctx()[k]) * w;
    }
    red[(part * 3 + 0) * 64 + cl] = a0; red[(part * 3 + 1) * 64 + cl] = a1; red[(part * 3 + 2) * 64 + cl] = a2;
    __syncthreads();
    if (tid < 192) {
      const int v = tid >> 6; float s = 0;
      for (int q = 0; q < 8; ++q) s += red[(q * 3 + v) * 64 + cl];
      p.mod()[((size_t)l * 3 + v) * 6144 + n] = s + p.ada_b()[(size_t)l * 6144 + n];
    }
    __syncthreads();
  }
}

__device__ __forceinline__ void phase_fold(const Params& p, int bid, int nb, char* lds) {
  float* wrow = (float*)lds;
  float* dre = wrow + 2048;
  float* dim_ = dre + 2048;
  float* glr = dim_ + 2048;
  float* cst = glr + 256;
  float* snt = cst + 256;
  const int tid = ltid();
  if (tid < 256) { float sn, cs; sincospif((float)tid / 128.f, &sn, &cs); cst[tid] = cs; snt[tid] = sn; }
  __syncthreads();
  for (int it = bid; it < 2 * DM / 8; it += nb) {
    const int l = it >> 7, k0 = (it & 127) * 8;
    for (int i = tid; i < 8 * 256; i += NTHR) { const int r = i >> 8, c = i & 255; wrow[c * 8 + r] = p.w_in()[((size_t)l * DM + k0 + r) * DIN0 + 1984 + c]; }
    if (tid < 256) { const int r = tid >> 5, c = tid & 31; glr[c * 8 + r] = p.w_in()[((size_t)l * DM + k0 + r) * DIN0 + 1696 + c]; }
    __syncthreads();
    {
      const int kp = tid & 255; const bool im = tid >= 256;
      float acc[8] = {0.f, 0.f, 0.f, 0.f, 0.f, 0.f, 0.f, 0.f};
#pragma unroll 4
      for (int c = 0; c < 256; ++c) {
        const int m = (c * kp) & 255; const float t = im ? -snt[m] : cst[m];
        const float4 w0 = *(const float4*)(wrow + c * 8), w1 = *(const float4*)(wrow + c * 8 + 4);
        acc[0] += w0.x * t; acc[1] += w0.y * t; acc[2] += w0.z * t; acc[3] += w0.w * t; acc[4] += w1.x * t; acc[5] += w1.y * t; acc[6] += w1.z * t; acc[7] += w1.w * t;
      }
      float* d = (im ? dim_ : dre) + kp * 8;
      *(float4*)d = make_float4(acc[0], acc[1], acc[2], acc[3]); *(float4*)(d + 4) = make_float4(acc[4], acc[5], acc[6], acc[7]);
    }
    __syncthreads();
    {
      const int j = tid & 255; const bool im = tid >= 256;
      const float* Wf = p.fnet_w() + (size_t)l * 65536 + j;
      const float* d = im ? dim_ : dre;
      float acc[8] = {0.f, 0.f, 0.f, 0.f, 0.f, 0.f, 0.f, 0.f};
#pragma unroll 8
      for (int kp = 0; kp < 256; ++kp) {
        const float w = Wf[kp * 256];
        const float4 d0 = *(const float4*)(d + kp * 8), d1 = *(const float4*)(d + kp * 8 + 4);
        acc[0] += d0.x * w; acc[1] += d0.y * w; acc[2] += d0.z * w; acc[3] += d0.w * w; acc[4] += d1.x * w; acc[5] += d1.y * w; acc[6] += d1.z * w; acc[7] += d1.w * w;
      }
      float* o = p.btf() + ((size_t)l * NIN + (im ? 2560 : 2304) + j) * DM + k0;
      *(float4*)o = make_float4(acc[0] * 0.0625f, acc[1] * 0.0625f, acc[2] * 0.0625f, acc[3] * 0.0625f);
      *(float4*)(o + 4) = make_float4(acc[4] * 0.0625f, acc[5] * 0.0625f, acc[6] * 0.0625f, acc[7] * 0.0625f);
    }
    if (tid < 256) {
      const int dir = tid >> 7, kk = tid & 127;
      const float* gw = p.gla_gk_w() + ((size_t)l * 2 + dir) * 16 * 128 + kk;
      float acc[8] = {0.f, 0.f, 0.f, 0.f, 0.f, 0.f, 0.f, 0.f};
#pragma unroll
      for (int r16 = 0; r16 < 16; ++r16) {
        const float w = gw[r16 * 128];
        const float4 g0 = *(const float4*)(glr + (dir * 16 + r16) * 8), g1 = *(const float4*)(glr + (dir * 16 + r16) * 8 + 4);
        acc[0] += g0.x * w; acc[1] += g0.y * w; acc[2] += g0.z * w; acc[3] += g0.w * w; acc[4] += g1.x * w; acc[5] += g1.y * w; acc[6] += g1.z * w; acc[7] += g1.w * w;
      }
      float* o = p.btf() + ((size_t)l * NIN + 1024 + tid) * DM + k0;
      *(float4*)o = make_float4(acc[0], acc[1], acc[2], acc[3]); *(float4*)(o + 4) = make_float4(acc[4], acc[5], acc[6], acc[7]);
    }
    __syncthreads();
  }
}

enum { MAP_ID = 0, MAP_IN = 1, MAP_UQ = 2, MAP_UKV = 3, MAP_GU = 4 };
__device__ __forceinline__ int colmap(int mt, int n) {
  switch (mt) {
    case MAP_ID: return n;
    case MAP_IN:
      if (n < 256) return n;
      if (n < 384) return 256 + (n - 256);
      if (n < 512) return 1184 + (n - 384);
      if (n < 640) return 1312 + (n - 512);
      if (n < 672) return 384 + (n - 640);
      if (n < 768) return -1;
      if (n < 1024) return 1440 + (n - 768);
      if (n < 1280) return -2;
      if (n < 1536) return 1728 + (n - 1280);
      if (n < 2304) return 416 + (n - 1536);
      return -2;
    case MAP_UQ:
      if (n < 256) return (n >> 6) * 96 + (n & 63);
      if (n < 384) return ((n - 256) >> 5) * 96 + 64 + ((n - 256) & 31);
      return -1;
    case MAP_UKV:
      if (n < 256) return (n >> 6) * 128 + (n & 63);
      return ((n - 256) >> 6) * 128 + 64 + ((n - 256) & 63);
    default: {
      const int pn = n >> 8, w = n & 255;
      return w < 128 ? 2 * (pn * 128 + w) : 2 * (pn * 128 + w - 128) + 1;
    }
  }
}
__device__ __forceinline__ int invmap(int mt, int sc) {
  if (mt == MAP_ID) return sc;
  if (mt == MAP_GU) { const int j = sc >> 1, t = sc & 1; return (j >> 7) * 256 + t * 128 + (j & 127); }
  if (sc < 384) return sc;
  if (sc < 416) return 640 + (sc - 384);
  if (sc < 1184) return 1536 + (sc - 416);
  if (sc < 1312) return 384 + (sc - 1184);
  if (sc < 1440) return 512 + (sc - 1312);
  if (sc < 1696) return 768 + (sc - 1440);
  if (sc < 1728) return -1;
  if (sc < 1984) return 1280 + (sc - 1728);
  return -1;
}
struct ConvJob { const float* src; void* dst; const float* scale; int ld, K, mt, k0, s0, f32; };
__device__ __forceinline__ void conv_tile_load(const ConvJob& J, int tid, float4 (&v)[4]) {
  const int kk = tid >> 5, s4 = (tid & 31) * 4;
#pragma unroll
  for (int i = 0; i < 4; ++i) {
    v[i] = make_float4(0.f, 0.f, 0.f, 0.f);
    if (J.s0 + s4 < J.ld) v[i] = *(const float4*)(J.src + (size_t)(J.k0 + kk + 16 * i) * J.ld + J.s0 + s4);
  }
}
__device__ __forceinline__ void conv_tile_proc(const ConvJob& J, int tid, const float4 (&v)[4], float* tile  ) {
  {
    const int kk = tid >> 5, s4 = (tid & 31) * 4;
#pragma unroll
    for (int i = 0; i < 4; ++i) {
      const float sc = J.scale ? J.scale[J.k0 + kk + 16 * i] : 1.f;
      float* t = tile + (kk + 16 * i) * 129 + s4;
      t[0] = v[i].x * sc; t[1] = v[i].y * sc; t[2] = v[i].z * sc; t[3] = v[i].w * sc;
    }
  }
  __syncthreads();
#pragma unroll
  for (int h = 0; h < 2; ++h) {
    const int sl = (tid >> 3) + 64 * h, ks = (tid & 7) * 8, sc = J.s0 + sl;
    const int row = sc < J.ld ? invmap(J.mt, sc) : -1;
    if (row >= 0) {
      const float* t = tile + ks * 129 + sl;
      if (J.f32) {
        float* dst = (float*)J.dst + (size_t)row * J.K + J.k0 + ks;
        *(float4*)dst = make_float4(t[0], t[129], t[2 * 129], t[3 * 129]); *(float4*)(dst + 4) = make_float4(t[4 * 129], t[5 * 129], t[6 * 129], t[7 * 129]);
      } else {
        u32x4 w;
        w[0] = cvtpk(t[0], t[129]); w[1] = cvtpk(t[2 * 129], t[3 * 129]); w[2] = cvtpk(t[4 * 129], t[5 * 129]); w[3] = cvtpk(t[6 * 129], t[7 * 129]);
        *(u32x4*)((u16*)J.dst + (size_t)row * J.K + J.k0 + ks) = w;
      }
    }
  }
  __syncthreads();
}
constexpr int CT_IN = 16 * 18, CT_OUT = 16 * 8, CT_DN = NE * 128, CT_L = CT_IN + CT_OUT + CT_DN;
__device__ __forceinline__ void conv_decode(const Params& p, int t, ConvJob& J) {
  const int l = t / CT_L; int r = t % CT_L;
  if (r < CT_IN) { J.src = p.w_in() + (size_t)l * DM * DIN0; J.ld = DIN0; J.K = DM; J.dst = p.btf() + (size_t)l * NIN * DM; J.mt = MAP_IN; J.scale = nullptr; J.k0 = (r / 18) * 64; J.s0 = (r % 18) * 128; J.f32 = 1; return; }
  r -= CT_IN;
  if (r < CT_OUT) { J.src = p.w_out() + (size_t)l * DM * DM; J.ld = DM; J.K = DM; J.dst = p.bt_out() + (size_t)l * DM * DM; J.mt = MAP_ID; J.scale = p.mix_g() + l * DM; J.k0 = (r / 8) * 64; J.s0 = (r % 8) * 128; J.f32 = 0; return; }
  r -= CT_OUT;
  const int e = r >> 7, q = r & 127;
  J.src = p.moe_w_down() + ((size_t)l * NE + e) * DFF * DM; J.ld = DM; J.K = DFF; J.dst = p.bt_dn() + ((size_t)l * NE + e) * DM * DFF; J.mt = MAP_ID; J.scale = nullptr; J.k0 = (q >> 3) * 64; J.s0 = (q & 7) * 128; J.f32 = 0;
}
__device__ __forceinline__ void conv_gu8_load(const float* __restrict__ src  , int s0, int tid, float4 (&v)[16]) {
  const int c4 = (tid & 7) * 4, r0 = tid >> 3;
#pragma unroll
  for (int pss = 0; pss < 16; ++pss) v[pss] = *(const float4*)(src + (size_t)(r0 + 64 * pss) * 2048 + s0 + c4);
}
__device__ __forceinline__ void conv_gu8_proc(const float4 (&v)[16], signed char* __restrict__ dst  , float* __restrict__ sw  ,
                                              int s0, float* tile  , int tid) {
  float* cmax = tile + 1024 * 33;
  {
    const int c4 = (tid & 7) * 4, r0 = tid >> 3;
#pragma unroll
    for (int pss = 0; pss < 16; ++pss) { float* t = tile + (r0 + 64 * pss) * 33 + c4; t[0] = v[pss].x; t[1] = v[pss].y; t[2] = v[pss].z; t[3] = v[pss].w; }
  }
  __syncthreads();
  {
    const int col = tid & 31, part = tid >> 5; float m = 0.f;
#pragma unroll 8
    for (int k = part * 64; k < part * 64 + 64; ++k) m = fmaxf(m, fabsf(tile[k * 33 + col]));
    cmax[part * 32 + col] = m;
  }
  __syncthreads();
  if (tid < 32) {
    float m = 0.f;
#pragma unroll
    for (int q = 0; q < 16; ++q) m = fmaxf(m, cmax[q * 32 + tid]);
    const float sc = fmaxf(m, 1e-20f) * (1.f / 127.f);
    cmax[512 + tid] = sc;
    sw[invmap(MAP_GU, s0 + tid)] = sc;
  }
  __syncthreads();
#pragma unroll
  for (int h = 0; h < 4; ++h) {
    const int g = tid + 512 * h, col = g & 31, k0 = (g >> 5) * 16;
    const float inv = 1.f / cmax[512 + col];
    unsigned w[4];
#pragma unroll
    for (int q = 0; q < 4; ++q) {
      const float* t = tile + (k0 + 4 * q) * 33 + col;
      const int q0 = (int)rintf(t[0] * inv), q1 = (int)rintf(t[33] * inv), q2 = (int)rintf(t[66] * inv), q3 = (int)rintf(t[99] * inv);
      w[q] = (unsigned)(q0 & 255) | ((unsigned)(q1 & 255) << 8) | ((unsigned)(q2 & 255) << 16) | ((unsigned)(q3 & 255) << 24);
    }
    *(u32x4*)(dst + (size_t)invmap(MAP_GU, s0 + col) * DM + k0) = u32x4{w[0], w[1], w[2], w[3]};
  }
  __syncthreads();
}
__device__ __forceinline__ void phase_convert(const Params& p, int bid, int nb, char* lds) {
  float* tile = (float*)lds;
  const int tid = ltid();
  {
    ConvJob J, Jn; float4 v[4], vn[4];
    int t = bid;
    if (t < 2 * CT_L) { conv_decode(p, t, J); conv_tile_load(J, tid, v); }
    for (; t < 2 * CT_L; t += nb) {
      const bool more = t + nb < 2 * CT_L;
      if (more) { conv_decode(p, t + nb, Jn); conv_tile_load(Jn, tid, vn); }
      conv_tile_proc(J, tid, v, tile);
      if (more) { J = Jn;
#pragma unroll
        for (int i = 0; i < 4; ++i) v[i] = vn[i]; }
    }
  }
  {
    float4 v[16], vn[16];
    int t = bid;
    if (t < 2 * NE * 64) conv_gu8_load(p.moe_w_gu() + (size_t)(t >> 6) * DM * 2048, (t & 63) * 32, tid, v);
    for (; t < 2 * NE * 64; t += nb) {
      const bool more = t + nb < 2 * NE * 64; const int tn = t + nb;
      if (more) conv_gu8_load(p.moe_w_gu() + (size_t)(tn >> 6) * DM * 2048, (tn & 63) * 32, tid, vn);
      conv_gu8_proc(v, p.bt_gu() + (size_t)(t >> 6) * 2048 * DM, p.swgu() + (size_t)(t >> 6) * 2048, (t & 63) * 32, tile, tid);
      if (more) {
#pragma unroll
        for (int i = 0; i < 16; ++i) v[i] = vn[i]; }
    }
  }
  for (int l = 0; l < 2; ++l) {
    for (int i = bid * NTHR + tid; i < 96 * DM / 4; i += nb * NTHR) *(float4*)(p.btf() + ((size_t)l * NIN + 672) * DM + (size_t)i * 4) = make_float4(0.f, 0.f, 0.f, 0.f);
    {
      const float* wq = p.mla_w_uq() + (size_t)l * 256 * 384; const float* wkv = p.mla_w_ukv() + (size_t)l * 128 * 512;
      const float* gq = p.mla_q_g() + l * 256; const float* gkv = p.mla_kv_g() + l * 128;
      u16* dst = p.bt_qkv() + (size_t)l * 1024 * 384;
      for (int i = bid * NTHR + ltid(); i < 1024 * 384; i += nb * NTHR) {
        const int n = i / 384, k = i % 384; float v = 0.f;
        if (n < 512) { const int sc = colmap(MAP_UQ, n); if (k < 256 && sc >= 0) v = gq[k] * wq[k * 384 + sc]; }
        else { if (k >= 256) v = gkv[k - 256] * wkv[(k - 256) * 512 + colmap(MAP_UKV, n - 512)]; }
        dst[i] = f2bf(v);
      }
    }
  }
}

__device__ __forceinline__ void phase_hy_mlp(const Params& p, int l, int Lf, float* __restrict__ hout  , float* __restrict__ ssq  ,
                             int bid, int nb, char* lds) {
  float* zf = (float*)lds;
  float* h1 = zf + 64 * 33;
  float* h2 = h1 + 64 * 64;
  const int tid = ltid();
  const float* w1 = p.hy_w1() + (size_t)l * 33 * 64; const float* b1 = p.hy_b1() + l * 64;
  const float* w2 = p.hy_w2() + (size_t)l * 64 * 64; const float* b2 = p.hy_b2() + l * 64;
  const float* w3 = p.hy_w3() + (size_t)l * 64 * 512; const float* fr = p.hy_freq() + l * 64;
  float w3c[64];
#pragma unroll
  for (int k = 0; k < 64; ++k) w3c[k] = w3[k * 512 + tid];
  const int dir = tid >> 8, ch = tid & 255;
  const float maxd = logf(1e-2f) / 0.3f, mind = logf(1e-2f) / 1.5f;
  const float delta = fabsf(mind + (maxd - mind) * (float)ch / 255.f);
  float ssq_acc = 0.f;
  for (int it = bid; it < Lf / 64; it += nb) {
    const int t0 = it * 64;
    for (int i = tid; i < 64 * 33; i += NTHR) {
      const int tt = i / 33, f = i % 33, t = t0 + tt;
      float v;
      if (f == 0) v = (float)t / (float)(Lf - 1);
      else {
        const int j = (f - 1) & 15;
        const float fj = 1e-4f + (float)j * ((15.f - 1e-4f) / 15.f);
        const float w = 6.283185307179586f * (float)t / (float)Lf;
        v = (f <= 16) ? cosf(fj * w) : -sinf(fj * w);
      }
      zf[i] = v;
    }
    __syncthreads();
    {
      const int o = tid & 63, tb = tid >> 6;
      float acc[8];
#pragma unroll
      for (int j = 0; j < 8; ++j) acc[j] = b1[o];
#pragma unroll 3
      for (int f = 0; f < 33; ++f) {
        const float w = w1[f * 64 + o];
#pragma unroll
        for (int j = 0; j < 8; ++j) acc[j] += zf[(tb + 8 * j) * 33 + f] * w;
      }
      const float fo = fr[o];
#pragma unroll
      for (int j = 0; j < 8; ++j) h1[(tb + 8 * j) * 64 + o] = sinf(fo * acc[j]);
    }
    __syncthreads();
    {
      const int o = tid & 63, tb = tid >> 6;
      float acc[8];
#pragma unroll
      for (int j = 0; j < 8; ++j) acc[j] = b2[o];
#pragma unroll 4
      for (int f = 0; f < 64; f += 4) {
        const float wa = w2[f * 64 + o], wb = w2[(f + 1) * 64 + o], wc2 = w2[(f + 2) * 64 + o], wd = w2[(f + 3) * 64 + o];
#pragma unroll
        for (int j = 0; j < 8; ++j) { const float4 hv = *(const float4*)(h1 + (tb + 8 * j) * 64 + f); acc[j] += hv.x * wa + hv.y * wb + hv.z * wc2 + hv.w * wd; }
      }
      const float fo = fr[o];
#pragma unroll
      for (int j = 0; j < 8; ++j) h2[(tb + 8 * j) * 64 + o] = sinf(fo * acc[j]);
    }
    __syncthreads();
    float* orow = hout + ((size_t)dir * 256 + ch) * Lf + t0;
    for (int tq = 0; tq < 16; ++tq) {
      float sv[4];
#pragma unroll
      for (int u = 0; u < 4; ++u) {
        const int tt = tq * 4 + u;
        float s = 0;
#pragma unroll
        for (int k = 0; k < 64; k += 4) { const float4 hv = *(const float4*)(h2 + tt * 64 + k); s += hv.x * w3c[k] + hv.y * w3c[k + 1] + hv.z * w3c[k + 2] + hv.w * w3c[k + 3]; }
        const int t = t0 + tt;
        s *= __expf(-((float)t / (float)(Lf - 1)) * delta);
        if (dir == 0 || t > 0) ssq_acc += s * s;
        sv[u] = s;
      }
      *(float4*)(orow + tq * 4) = make_float4(sv[0], sv[1], sv[2], sv[3]);
    }
    __syncthreads();
  }
  ssq[(size_t)bid * 512 + tid] = ssq_acc;
}

__host__ __device__ constexpr int fx(int p) {
  return ((p >> 12) & 3) ^ (((p >> 10) & 3) << 2) ^ ((p >> 4) & 16) ^ (((p >> 5) & 1) * 5) ^ (((p >> 6) & 1) * 26);
}
__device__ __forceinline__ int swz(int p) { return p ^ fx(p); }
__device__ __forceinline__ int rev7(int k) {
  unsigned r = __brev((unsigned)k) >> 18;
  return (int)(((r & 0x2AAAu) >> 1) | ((r & 0x1555u) << 1));
}
template <int ST, bool INV>
__device__ __forceinline__ void fft_stage(float2* s, const float2* __restrict__ tw, const int tid) {
  constexpr int sh = 12 - 2 * ST, q = 1 << sh, ND = q >= 512 ? q / 512 : 1;
  float2 w1[ND], w2[ND], w3[ND];
  if constexpr (ST < 6) {
#pragma unroll
    for (int d = 0; d < ND; ++d) {
      const int j = q >= 512 ? tid + 512 * d : (tid & (q - 1)), ti = j << (2 * ST);
      w1[d] = tw[ti]; w2[d] = tw[2 * ti]; w3[d] = tw[3 * ti];
    }
  }
  float2 x[8][4];
#pragma unroll
  for (int m = 0; m < 8; ++m) {
    const int u = tid + 512 * m, g = u >> sh, j = u & (q - 1), base = (g << (sh + 2)) + j, xb = fx(base);
    x[m][0] = s[base ^ xb]; x[m][1] = s[(base + q) ^ xb ^ fx(q)]; x[m][2] = s[(base + 2 * q) ^ xb ^ fx(2 * q)]; x[m][3] = s[(base + 3 * q) ^ xb ^ fx(3 * q)];
  }
#pragma unroll
  for (int m = 0; m < 8; ++m) {
    const int u = tid + 512 * m, g = u >> sh, j = u & (q - 1), base = (g << (sh + 2)) + j, xb = fx(base);
    const int i0 = base ^ xb, i1 = (base + q) ^ xb ^ fx(q), i2 = (base + 2 * q) ^ xb ^ fx(2 * q), i3 = (base + 3 * q) ^ xb ^ fx(3 * q);
    const int d = q >= 512 ? (m % ND) : 0;
    if constexpr (!INV) {
      const float2 a0 = x[m][0], a1 = x[m][1], a2 = x[m][2], a3 = x[m][3];
      const float2 b0 = make_float2(a0.x + a2.x, a0.y + a2.y), b1 = make_float2(a0.x - a2.x, a0.y - a2.y);
      const float2 b2 = make_float2(a1.x + a3.x, a1.y + a3.y), b3 = make_float2(a1.x - a3.x, a1.y - a3.y);
      const float2 y1 = make_float2(b1.x + b3.y, b1.y - b3.x), y2 = make_float2(b0.x - b2.x, b0.y - b2.y), y3 = make_float2(b1.x - b3.y, b1.y + b3.x);
      s[i0] = make_float2(b0.x + b2.x, b0.y + b2.y);
      if constexpr (ST < 6) { s[i1] = cmul(y1, w1[d]); s[i2] = cmul(y2, w2[d]); s[i3] = cmul(y3, w3[d]); }
      else { s[i1] = y1; s[i2] = y2; s[i3] = y3; }
    } else {
      float2 t0 = x[m][0], t1 = x[m][1], t2 = x[m][2], t3 = x[m][3];
      if constexpr (ST < 6) { t1 = cmulc(t1, w1[d]); t2 = cmulc(t2, w2[d]); t3 = cmulc(t3, w3[d]); }
      const float2 b0 = make_float2(t0.x + t2.x, t0.y + t2.y), b1 = make_float2(t0.x - t2.x, t0.y - t2.y);
      const float2 b2 = make_float2(t1.x + t3.x, t1.y + t3.y), b3 = make_float2(t1.x - t3.x, t1.y - t3.y);
      s[i0] = make_float2(b0.x + b2.x, b0.y + b2.y);
      s[i1] = make_float2(b1.x - b3.y, b1.y + b3.x);
      s[i2] = make_float2(b0.x - b2.x, b0.y - b2.y);
      s[i3] = make_float2(b1.x + b3.y, b1.y - b3.x);
    }
  }
  __syncthreads();
}
__device__ __forceinline__ void fft_fwd(float2* s, const float2* __restrict__ tw) {
  const int tid = ltid();
  fft_stage<0, false>(s, tw, tid); fft_stage<1, false>(s, tw, tid); fft_stage<2, false>(s, tw, tid); fft_stage<3, false>(s, tw, tid);
  fft_stage<4, false>(s, tw, tid); fft_stage<5, false>(s, tw, tid); fft_stage<6, false>(s, tw, tid);
}
__device__ __forceinline__ void fft_inv(float2* s, const float2* __restrict__ tw) {
  const int tid = ltid();
  fft_stage<6, true>(s, tw, tid); fft_stage<5, true>(s, tw, tid); fft_stage<4, true>(s, tw, tid); fft_stage<3, true>(s, tw, tid);
  fft_stage<2, true>(s, tw, tid); fft_stage<1, true>(s, tw, tid); fft_stage<0, true>(s, tw, tid);
}

__device__ __forceinline__ float filt_ssq(const float* __restrict__ part  , int ch, float* red  ) {
  const int tid = ltid();
  float v = part[(size_t)(tid >> 1) * 512 + (tid & 1) * 256 + ch];
  v = wave_sum(v);
  __syncthreads();
  if ((tid & 63) == 0) red[tid >> 6] = v;
  __syncthreads();
  return ((red[0] + red[1]) + (red[2] + red[3])) + ((red[4] + red[5]) + (red[6] + red[7]));
}
__device__ __forceinline__ void phase_hy_filtfft(const Params& p, int bid, int nb, char* lds) {
  float2* s = (float2*)lds;
  const int tid = ltid();
  for (int it = bid; it < 512; it += nb) {
    const int l = it >> 8, ch = it & 255;
    const float* hf = p.hfb() + (((size_t)l * 2 + 0) * 256 + ch) * SEQ;
    const float* hb = p.hfb() + (((size_t)l * 2 + 1) * 256 + ch) * SEQ;
#pragma unroll 8
    for (int m = tid; m < FM; m += NTHR) {
      const int n0 = 2 * m, n1 = 2 * m + 1;
      const float a = (n0 < SEQ) ? hf[n0] : (n0 == SEQ ? 0.f : hb[2 * SEQ - n0]);
      const float b = (n1 < SEQ) ? hf[n1] : hb[2 * SEQ - n1];
      s[swz(m)] = make_float2(a, b);
    }
    __syncthreads();
    fft_fwd(s, p.tw());
    const float sc = rsqrtf(filt_ssq(p.hpart() + (size_t)l * 256 * 512, ch, (float*)(lds + 139264))) * (1.f / 16384.f);
    float4* out = p.hspec() + ((size_t)l * 256 + ch) * HSP;
#pragma unroll 4
    for (int k = tid; k <= FM / 2; k += NTHR) {
      const float2 zk = s[swz(rev7(k))], zm = s[swz(rev7((FM - k) & (FM - 1)))];
      const float er = 0.5f * (zk.x + zm.x), ei = 0.5f * (zk.y - zm.y);
      const float dr = 0.5f * (zk.x - zm.x), di = 0.5f * (zk.y + zm.y);
      out[k] = make_float4(er * sc, ei * sc, di * sc, -dr * sc);
    }
    __syncthreads();
  }
}
constexpr int G_TILE_B = 256 * 64 * 2;
constexpr int G_STAGE_B = 2 * G_TILE_B;
constexpr int GEMM_LDS = 2 * G_STAGE_B;

__device__ __forceinline__ int lds_byte2(int r, int c) {
  const int st = (r >> 4) * 2 + (c >> 5), ob = (r & 15) * 64 + (c & 31) * 2;
  return st * 1024 + (ob ^ (((ob >> 9) & 1) << 5));
}
__device__ __forceinline__ void stage_rc2(int b, int& R, int& C) {
  const int st = b >> 10, sb = b & 1023, swz = sb ^ (((sb >> 9) & 1) << 5);
  R = (st >> 1) * 16 + (swz >> 6);
  C = (st & 1) * 32 + ((swz & 63) >> 1);
}
__device__ __forceinline__ void gemm_stage_coords(int (&sR)[4], int (&sC)[4]) {
  const int wid = ltid() >> 6, lane = ltid() & 63;
#pragma unroll
  for (int i = 0; i < 4; ++i) stage_rc2(wid * 1024 + i * 8192 + lane * 16, sR[i], sC[i]);
}

#define WAIT_V0() asm volatile("s_waitcnt vmcnt(0)" ::: "memory")

__device__ __forceinline__ void gemm256_core(const u16* const (&ap)[4], const u16* const (&bp)[4], int nt, char* shm, f32x4 (&acc)[8][4]) {
  const int tid = ltid(), wid = tid >> 6, lane = tid & 63, wr = wid >> 2, wc = wid & 3, fr = lane & 15, fq = lane >> 4;
#pragma unroll
  for (int m = 0; m < 8; ++m)
#pragma unroll
    for (int n = 0; n < 4; ++n) acc[m][n] = f32x4{0.f, 0.f, 0.f, 0.f};
#define G_SA(b) (shm + (b) * G_STAGE_B)
#define G_SB(b) (shm + (b) * G_STAGE_B + G_TILE_B)
#define G_STAGE(buf, kt) do { _Pragma("unroll") for (int i = 0; i < 4; ++i) {                                                   \
    __builtin_amdgcn_global_load_lds((const unsigned*)(ap[i] + (kt) * 64), (unsigned*)(G_SA(buf) + wid * 1024 + i * 8192), 16, 0, 0); \
    __builtin_amdgcn_global_load_lds((const unsigned*)(bp[i] + (kt) * 64), (unsigned*)(G_SB(buf) + wid * 1024 + i * 8192), 16, 0, 0); } } while (0)
  G_STAGE(0, 0); WAIT_V0(); __syncthreads();
#pragma unroll 1
  for (int t = 0; t < nt; ++t) {
    const int cur = t & 1;
    if (t + 1 < nt) G_STAGE(cur ^ 1, t + 1);
#pragma unroll
    for (int ks = 0; ks < 2; ++ks) {
      bf16x8 At[8], Bf[4];
#pragma unroll
      for (int m = 0; m < 8; ++m) At[m] = *(const bf16x8*)(G_SA(cur) + lds_byte2(wr * 128 + m * 16 + fr, ks * 32 + fq * 8));
#pragma unroll
      for (int n = 0; n < 4; ++n) Bf[n] = *(const bf16x8*)(G_SB(cur) + lds_byte2(wc * 64 + n * 16 + fr, ks * 32 + fq * 8));
#pragma unroll
      for (int m = 0; m < 8; ++m)
#pragma unroll
        for (int n = 0; n < 4; ++n) acc[m][n] = __builtin_amdgcn_mfma_f32_16x16x32_bf16(At[m], Bf[n], acc[m][n], 0, 0, 0);
      __builtin_amdgcn_sched_barrier(0);
    }
    WAIT_V0(); __syncthreads();
  }
#undef G_STAGE
}

#define LAS3 __attribute__((address_space(3)))
constexpr int G8_HTB = 128 * 64 * 2;
__device__ __forceinline__ int g8_perm32(int rho) { const int n = rho >> 4, i = rho & 15; return 8 * (i >> 2) + 4 * n + (i & 3); }
__device__ __forceinline__ int g8_lds_byte(int r, int c) { const int st = (r >> 4) * 2 + (c >> 5), rr = r & 15, cc = c & 31, ob = rr * 64 + cc * 2; return st * 1024 + (ob ^ (((ob >> 9) & 1) << 5)); }
__device__ __forceinline__ void g8_stage_rc(int b, int& R, int& C) { const int st = b / 1024, sb = b % 1024, swz = sb ^ (((sb >> 9) & 1) << 5); R = (st >> 1) * 16 + swz / 64; C = (st & 1) * 32 + (swz % 64) / 2; }
struct G8Unit { int pm, pn, e, ce, pre; };
__device__ __forceinline__ void g8_cload(const float* __restrict__ src, float* dst) {
  __builtin_amdgcn_global_load_lds((const unsigned*)(src + (ltid() & 63) * 4), (LAS3 unsigned*)dst, 16, 0, 0);
}


template <bool I8> __device__ __forceinline__ typename std::conditional<I8, int __attribute__((ext_vector_type(4))), f32x4>::type
g8_mma(bf16x8 x, bf16x8 y, typename std::conditional<I8, int __attribute__((ext_vector_type(4))), f32x4>::type c) {
  if constexpr (I8) { typedef int v4i __attribute__((ext_vector_type(4))); return __builtin_amdgcn_mfma_i32_16x16x64_i8(*(v4i*)&x, *(v4i*)&y, c, 0, 0, 0); }
  else return __builtin_amdgcn_mfma_f32_16x16x32_bf16(x, y, c, 0, 0, 0);
}
typedef int i32x4 __attribute__((ext_vector_type(4)));
template <bool I8> struct G8Acc { typedef f32x4 T; };
template <> struct G8Acc<true> { typedef i32x4 T; };
template <bool I8, class Sched, class Epi>
__device__ __forceinline__ void gemm8_phase(char* lds_g, const char* Abase, const int Kb, const Sched& S, const Epi& E) {
    typedef typename G8Acc<I8>::T ACC;
    LAS3 unsigned char* lds = (LAS3 unsigned char*)lds_g;
    const int tid = ltid(), wid = __builtin_amdgcn_readfirstlane(tid >> 6), lane = tid & 63, wr = wid >> 2, wc = wid & 3, fr = lane & 15, fq = lane >> 4;
    const int nt = Kb / 128;
    int sRr[2], sCc[2]; unsigned voffB[2];
#pragma unroll
    for (int i = 0; i < 2; ++i) { g8_stage_rc(tid * 16 + i * 8192, sRr[i], sCc[i]); const int Rb = (sRr[i] & ~31) + g8_perm32(sRr[i] & 31); voffB[i] = (unsigned)(Rb * Kb) + (unsigned)sCc[i] * 2u; }
    const size_t kstep = 128;
    const size_t hstepB = (size_t)128 * Kb;
    const unsigned ldsw = (unsigned)wid * 1024u;
    const int aoff = g8_lds_byte(wr * 64 + fr, fq * 8), boff = g8_lds_byte(wc * 32 + fr, fq * 8);
#define G8_SA(b, h) (((b) * 2 + (h)) * G8_HTB)
#define G8_SB(b, h) ((4 + (b) * 2 + (h)) * G8_HTB)
#define G8_STAGE_B(bufoff, gbase) do { _Pragma("unroll") for (int _i = 0; _i < 2; ++_i) \
        __builtin_amdgcn_global_load_lds((const unsigned*)((const char*)(gbase) + voffB[_i]), (LAS3 unsigned*)(lds + (bufoff) + ldsw + _i * 8192), 16, 0, 0); } while (0)
#define G8_STAGE_A(bufoff, o0, o1) do { \
        __builtin_amdgcn_global_load_lds((const unsigned*)(Abase + (o0)), (LAS3 unsigned*)(lds + (bufoff) + ldsw), 16, 0, 0); \
        __builtin_amdgcn_global_load_lds((const unsigned*)(Abase + (o1)), (LAS3 unsigned*)(lds + (bufoff) + ldsw + 8192), 16, 0, 0); } while (0)
#define G8_LDA(dst, b, h) do { _Pragma("unroll") for (int m = 0; m < 4; ++m) _Pragma("unroll") for (int k = 0; k < 2; ++k) dst[m][k] = *(const LAS3 bf16x8*)(lds + G8_SA(b, h) + aoff + m * 2048 + k * 1024); } while (0)
#define G8_LDB(dst, b, h) do { _Pragma("unroll") for (int n = 0; n < 2; ++n) _Pragma("unroll") for (int k = 0; k < 2; ++k) dst[n][k] = *(const LAS3 bf16x8*)(lds + G8_SB(b, h) + boff + n * 2048 + k * 1024); } while (0)
#define G8_MMA(ai, bj, At, Bt) do { __builtin_amdgcn_s_setprio(1); _Pragma("unroll") for (int m = 0; m < 4; ++m) _Pragma("unroll") for (int n = 0; n < 2; ++n) _Pragma("unroll") for (int k = 0; k < 2; ++k) \
        acc[ai][bj][m][n] = g8_mma<I8>(Bt[n][k], At[m][k], acc[ai][bj][m][n]); __builtin_amdgcn_s_setprio(0); } while (0)
#define G8_WAIT_V(n) asm volatile("s_waitcnt vmcnt(" #n ")" ::: "memory")
#define G8_WAIT_L(n) asm volatile("s_waitcnt lgkmcnt(" #n ")" ::: "memory")
#define G8_BAR __builtin_amdgcn_s_barrier()
#define G8_SCHED __builtin_amdgcn_sched_barrier(0)
    G8Unit cur, nxt; int ui = 0;
    if (!S.next(0, cur)) return;
    ACC acc[2][2][4][2];
#pragma unroll
    for (int a = 0; a < 2; ++a)
#pragma unroll
        for (int b = 0; b < 2; ++b)
#pragma unroll
            for (int m = 0; m < 4; ++m)
#pragma unroll
                for (int n = 0; n < 2; ++n) acc[a][b][m][n] = ACC{};
    bf16x8 At[4][2], B0[2][2], B1[2][2];
    float ep[8];
    unsigned va[2][2], vn[2][2];
#pragma unroll
    for (int h = 0; h < 2; ++h)
#pragma unroll
        for (int i = 0; i < 2; ++i) va[h][i] = S.a_off(cur, h * 128 + sRr[i]) + (unsigned)sCc[i] * 2u;
    const char* cB = S.b_ptr(cur);
    G8_STAGE_B(G8_SB(0, 0), cB); G8_STAGE_A(G8_SA(0, 0), va[0][0], va[0][1]); G8_STAGE_B(G8_SB(0, 1), cB + hstepB); G8_STAGE_A(G8_SA(0, 1), va[1][0], va[1][1]);
    if (wr == 1) G8_BAR;
    G8_WAIT_V(4); G8_BAR;
    G8_STAGE_B(G8_SB(1, 0), cB + kstep); G8_STAGE_A(G8_SA(1, 0), va[0][0] + kstep, va[0][1] + kstep); G8_STAGE_B(G8_SB(1, 1), cB + hstepB + kstep);
    G8_WAIT_V(6); G8_BAR;
    for (;;) {
        float* cb = (float*)(lds_g + 136192 + (ui & 1) * 2048);
        E.pre(cur, wr, fr, ep, cb);
        const bool has_next = S.next(ui + 1, nxt);
        const char* nB = cB;
#pragma unroll
        for (int h = 0; h < 2; ++h)
#pragma unroll
            for (int i = 0; i < 2; ++i) vn[h][i] = va[h][i];
        if (has_next) {
            nB = S.b_ptr(nxt);
#pragma unroll
            for (int h = 0; h < 2; ++h)
#pragma unroll
                for (int i = 0; i < 2; ++i) vn[h][i] = S.a_off(nxt, h * 128 + sRr[i]) + (unsigned)sCc[i] * 2u;
        }
#pragma unroll 1
        for (int t = 0; t < nt; t += 2) {
            const bool last = (t == nt - 2);
            const unsigned k1 = (unsigned)(t + 1) * 128u;
            const unsigned k2 = last ? 0u : (unsigned)(t + 2) * 128u;
            const unsigned a2_00 = (last ? vn[0][0] : va[0][0]) + k2, a2_01 = (last ? vn[0][1] : va[0][1]) + k2;
            const unsigned a2_10 = (last ? vn[1][0] : va[1][0]) + k2, a2_11 = (last ? vn[1][1] : va[1][1]) + k2;
            const char* b2 = (last ? nB : cB) + k2; const char* b3 = b2 + kstep;
            G8_LDB(B0, 0, 0); G8_SCHED; G8_LDA(At, 0, 0); G8_STAGE_A(G8_SA(1, 1), va[1][0] + k1, va[1][1] + k1);
            G8_WAIT_L(8); G8_BAR; G8_WAIT_L(0); G8_MMA(0, 0, At, B0); G8_BAR; G8_SCHED;
            G8_LDB(B1, 0, 1); G8_STAGE_B(G8_SB(0, 0), b2);
            G8_BAR; G8_WAIT_L(0); G8_MMA(0, 1, At, B1); G8_BAR;
            G8_LDA(At, 0, 1); G8_STAGE_A(G8_SA(0, 0), a2_00, a2_01);
            G8_BAR; G8_WAIT_L(0); G8_MMA(1, 0, At, B0); G8_BAR; G8_SCHED;
            G8_STAGE_B(G8_SB(0, 1), b2 + hstepB);
            G8_WAIT_V(6); G8_BAR; G8_MMA(1, 1, At, B1); G8_BAR;
            G8_LDB(B0, 1, 0); G8_SCHED; G8_LDA(At, 1, 0); G8_STAGE_A(G8_SA(0, 1), a2_10, a2_11);
            G8_WAIT_L(8); G8_BAR; G8_WAIT_L(0); G8_MMA(0, 0, At, B0); G8_BAR; G8_SCHED;
            G8_LDB(B1, 1, 1); G8_STAGE_B(G8_SB(1, 0), b3);
            G8_BAR; G8_WAIT_L(0); G8_MMA(0, 1, At, B1); G8_BAR;
            G8_LDA(At, 1, 1); G8_STAGE_A(G8_SA(1, 0), a2_00 + 128u, a2_01 + 128u);
            G8_BAR; G8_WAIT_L(0); G8_MMA(1, 0, At, B0); G8_BAR; G8_SCHED;
            G8_STAGE_B(G8_SB(1, 1), b3 + hstepB);
            G8_WAIT_V(6); G8_BAR; G8_MMA(1, 1, At, B1); G8_BAR;
        }
        E(acc, cur, wr, wc, fr, fq, ep, cb);
        if (!has_next) break;
#pragma unroll
        for (int a = 0; a < 2; ++a)
#pragma unroll
            for (int b = 0; b < 2; ++b)
#pragma unroll
                for (int m = 0; m < 4; ++m)
#pragma unroll
                    for (int n = 0; n < 2; ++n) acc[a][b][m][n] = ACC{};
        cur = nxt; cB = nB; ++ui;
#pragma unroll
        for (int h = 0; h < 2; ++h)
#pragma unroll
            for (int i = 0; i < 2; ++i) va[h][i] = vn[h][i];
    }
    G8_WAIT_V(0);
    if (wr == 0) G8_BAR;
    G8_BAR;
#undef G8_SA
#undef G8_SB
#undef G8_STAGE_A
#undef G8_STAGE_B
#undef G8_LDA
#undef G8_LDB
#undef G8_MMA
#undef G8_WAIT_V
#undef G8_WAIT_L
#undef G8_BAR
#undef G8_SCHED
}
struct G8Plain {
    int nM, nN, Kb, G, c; const char* Bt;
    __device__ __forceinline__ bool next(int i, G8Unit& u) const {
        const int L = (i * 8 + (c & 7)) * (G >> 3) + (c >> 3); if (L >= nM * nN) return false;
        const int nig = 8 * nN, gid = L / nig, fm = gid * 8, gsz = (nM - fm) < 8 ? (nM - fm) : 8;
        u.pm = fm + ((L % nig) % gsz); u.pn = (L % nig) / gsz; u.e = 0; u.ce = 256; u.pre = 0; return true;
    }
    __device__ __forceinline__ unsigned a_off(const G8Unit& u, int row) const { return (unsigned)(u.pm * 256 + row) * (unsigned)Kb; }
    __device__ __forceinline__ const char* b_ptr(const G8Unit& u) const { return Bt + (size_t)u.pn * 256 * Kb; }
};

__device__ __forceinline__ const float* resid_row_in(const Params& p, int tok) {
  return tok < TL ? p.x() + (size_t)tok * DM : p.ctx() + (size_t)(tok - TL) * DM;
}
__device__ __forceinline__ void load_row_comb(const Params& p, int src_layer, int lc, int tok, int lane, const int* pre  , float (&v)[16]) {
  if (src_layer == 0) {
    const float* r = resid_row_in(p, tok);
#pragma unroll
    for (int i = 0; i < 4; ++i) { const float4 a = *(const float4*)(r + lane * 4 + i * 256); v[4 * i] = a.x; v[4 * i + 1] = a.y; v[4 * i + 2] = a.z; v[4 * i + 3] = a.w; }
  } else {
    const u16* r = p.X() + (size_t)tok * DM;
#pragma unroll
    for (int i = 0; i < 4; ++i) { const float4 a = ld4bf(r + lane * 4 + i * 256); v[4 * i] = a.x; v[4 * i + 1] = a.y; v[4 * i + 2] = a.z; v[4 * i + 3] = a.w; }
  }
  if (lc >= 0) {
    const float* g2 = p.mod() + ((size_t)lc * 3 + modv(tok)) * 6144 + 5 * DM;
    float s[16];
#pragma unroll
    for (int i = 0; i < 16; ++i) s[i] = 0.f;
#pragma unroll
    for (int k = 0; k < TOPK; ++k) {
      const int sl = p.tslot()[tok * 4 + k];
      const size_t arow = (size_t)(pre[sl >> 20] + (sl & 0xFFFFF));
      const unsigned char* y = p.yd() + arow * DM;
#pragma unroll
      for (int i = 0; i < 4; ++i) {
        const int w = *(const int*)(y + lane * 4 + i * 256);
        const auto lo = __builtin_amdgcn_cvt_pk_f32_fp8(w, false), hi2 = __builtin_amdgcn_cvt_pk_f32_fp8(w, true);
        s[4 * i] += lo[0]; s[4 * i + 1] += lo[1]; s[4 * i + 2] += hi2[0]; s[4 * i + 3] += hi2[1];
      }
    }
#pragma unroll
    for (int i = 0; i < 4; ++i) {
      const float4 g = *(const float4*)(g2 + lane * 4 + i * 256);
      v[4 * i] += g.x * 0.125f * s[4 * i]; v[4 * i + 1] += g.y * 0.125f * s[4 * i + 1]; v[4 * i + 2] += g.z * 0.125f * s[4 * i + 2]; v[4 * i + 3] += g.w * 0.125f * s[4 * i + 3];
    }
  }
}
__device__ __forceinline__ void expert_prefix(const int* cnt, int* pre) {
  if (ltid() == 0) { int s = 0; for (int e = 0; e < NE; ++e) { pre[e] = s; s += cnt[e]; } pre[NE] = s; }
}

__device__ __forceinline__ float store_row_i8(const float (&y)[16], signed char* __restrict__ h, float* __restrict__ hs_row, int lane) {
  float am = 0.f;
#pragma unroll
  for (int i = 0; i < 16; ++i) am = fmaxf(am, fabsf(y[i]));
  am = wave_max(am);
  const float s = fmaxf(am, 1e-20f) * (1.f / 127.f), inv = 1.f / s;
#pragma unroll
  for (int i = 0; i < 4; ++i) {
    const int q0 = (int)rintf(y[4 * i] * inv), q1 = (int)rintf(y[4 * i + 1] * inv), q2 = (int)rintf(y[4 * i + 2] * inv), q3 = (int)rintf(y[4 * i + 3] * inv);
    *(unsigned*)(h + lane * 4 + i * 256) = (unsigned)(q0 & 255) | ((unsigned)(q1 & 255) << 8) | ((unsigned)(q2 & 255) << 16) | ((unsigned)(q3 & 255) << 24);
  }
  if (lane == 0) *hs_row = s;
  return s;
}
__device__ __forceinline__ void phase_quant_in(const Params& p, int bid, int nb) {
  const int wid = ltid() >> 6, lane = ltid() & 63;
  for (int r = bid * 8 + wid; r < 2 * NIN; r += nb * 8) {
    const float* src = p.btf() + (size_t)r * DM;
    float y[16];
#pragma unroll
    for (int i = 0; i < 4; ++i) { const float4 a = *(const float4*)(src + lane * 4 + i * 256); y[4 * i] = a.x; y[4 * i + 1] = a.y; y[4 * i + 2] = a.z; y[4 * i + 3] = a.w; }
    store_row_i8(y, p.bt_in() + (size_t)r * DM, p.swin() + r, lane);
  }
}
__device__ __forceinline__ void phase_norm1(const Params& p, int layer, int bid, int nb, char* lds) {
  int* pre = (int*)lds;
  const int lc = layer - 1;
  if (lc >= 0) { expert_prefix(p.cnt() + lc * NE, pre); __syncthreads(); }
  const int wid = ltid() >> 6, lane = ltid() & 63;
  const float* gn = p.norm1_g() + layer * DM;
  const int ntok = TT;
  for (int tok = bid * 8 + wid; tok < ntok; tok += nb * 8) {
    float v[16];
    load_row_comb(p, layer == 0 ? 0 : 1, lc, tok, lane, pre, v);
    if (lc >= 0) {
      u16* xr = p.X() + (size_t)tok * DM;
#pragma unroll
      for (int i = 0; i < 4; ++i) *(u32x2*)(xr + lane * 4 + i * 256) = u32x2{cvtpk(v[4 * i], v[4 * i + 1]), cvtpk(v[4 * i + 2], v[4 * i + 3])};
    }
    float ss = 0;
#pragma unroll
    for (int i = 0; i < 16; ++i) ss += v[i] * v[i];
    ss = wave_sum(ss);
    const float rs = rsqrtf(ss * (1.f / DM) + EPS);
    const float* md = p.mod() + ((size_t)layer * 3 + modv(tok)) * 6144;
#pragma unroll
    for (int i = 0; i < 4; ++i) {
      const int c = lane * 4 + i * 256;
      const float4 g = *(const float4*)(gn + c), sh = *(const float4*)(md + c), sc = *(const float4*)(md + DM + c);
      v[4 * i] = v[4 * i] * rs * g.x * (1.f + sc.x) + sh.x; v[4 * i + 1] = v[4 * i + 1] * rs * g.y * (1.f + sc.y) + sh.y;
      v[4 * i + 2] = v[4 * i + 2] * rs * g.z * (1.f + sc.z) + sh.z; v[4 * i + 3] = v[4 * i + 3] * rs * g.w * (1.f + sc.w) + sh.w;
    }
    store_row_i8(v, p.H() + (size_t)tok * DM, p.hs() + tok, lane);
  }
}

struct EpiIn {
  u16* zqkv; u16* zg; u16* zt; const float* hs; const float* sw;
  __device__ __forceinline__ void pre(const G8Unit& u, int wr, int fr, float (&ep)[8], float* cb) const {
    if ((ltid() >> 6) == 0) g8_cload(sw + u.pn * 256, cb);
#pragma unroll
    for (int ai = 0; ai < 2; ++ai)
#pragma unroll
      for (int m = 0; m < 4; ++m) ep[ai * 4 + m] = hs[u.pm * 256 + ai * 128 + wr * 64 + m * 16 + fr];
  }
  __device__ __forceinline__ void operator()(const i32x4 (&acc)[2][2][4][2], const G8Unit& u, int wr, int wc, int fr, int fq, const float (&ep)[8], const float* cb) const {
#pragma unroll
    for (int bj = 0; bj < 2; ++bj) {
      const int c32 = u.pn * 256 + bj * 128 + wc * 32, c0 = c32 + 8 * fq;
      const f32x4 w0 = *(const f32x4*)(cb + bj * 128 + wc * 32 + 8 * fq), w1 = *(const f32x4*)(cb + bj * 128 + wc * 32 + 8 * fq + 4);
#pragma unroll
      for (int ai = 0; ai < 2; ++ai)
#pragma unroll
        for (int m = 0; m < 4; ++m) {
          const int row = u.pm * 256 + ai * 128 + wr * 64 + m * 16 + fr;
          f32x4 a, b;
#pragma unroll
          for (int j = 0; j < 4; ++j) { a[j] = (float)acc[ai][bj][m][0][j] * ep[ai * 4 + m] * w0[j]; b[j] = (float)acc[ai][bj][m][1][j] * ep[ai * 4 + m] * w1[j]; }
          if (c32 < 384) {
            *(u32x4*)(zqkv + (size_t)row * 384 + c0) = u32x4{cvtpk(a[0], a[1]), cvtpk(a[2], a[3]), cvtpk(b[0], b[1]), cvtpk(b[2], b[3])};
          } else if (c32 < 1536) {
            *(u32x4*)(zg + (size_t)row * ZG_W + (c0 - 384)) = u32x4{cvtpk(a[0], a[1]), cvtpk(a[2], a[3]), cvtpk(b[0], b[1]), cvtpk(b[2], b[3])};
          } else {
#pragma unroll
            for (int j = 0; j < 4; ++j) { zt[(size_t)(c0 - 1536 + j) * TT + row] = f2bf(a[j]); zt[(size_t)(c0 - 1536 + 4 + j) * TT + row] = f2bf(b[j]); }
          }
        }
    }
  }
};
__device__ __forceinline__ void phase_gemm_in(const Params& p, int layer, int bid, int nb, char* lds) {
  G8Plain S; S.nM = TT / 256; S.nN = NIN / 256; S.Kb = DM; S.G = nb; S.c = bid; S.Bt = (const char*)(p.bt_in() + (size_t)layer * NIN * DM);
  EpiIn E; E.zqkv = p.zqkv(); E.zg = p.zg(); E.zt = p.zt(); E.hs = p.hs(); E.sw = p.swin() + layer * NIN;
  gemm8_phase<true>(lds, (const char*)p.H(), DM, S, E);
}

__device__ __forceinline__ size_t qkv_row(int tok, int h) {
  const int b = tok < TL ? (tok >> 14) : ((tok - TL) >> 8);
  const int s = tok < TL ? (tok & (SEQ - 1)) : SEQ + ((tok - TL) & (LC - 1));
  return ((size_t)(b * 4 + h)) * SKV + s;
}
struct EpiQkv {
  const u16* zqkv; u16* Q; u16* KV; const float* ropec; const float* ropes; float* rsl;
  unsigned* kmx;
  __device__ __forceinline__ void pre(const G8Unit&, int, int, float (&)[8], float*) const {}
  __device__ __forceinline__ void operator()(const f32x4 (&acc)[2][2][4][2], const G8Unit& u, int wr, int wc, int fr, int fq, const float (&)[8], const float*) const {
    const int tid = ltid();
    {
      const int r = tid >> 1, half = tid & 1;
      const u16* row = zqkv + (size_t)(u.pm * 256 + r) * 384;
      float sq = 0, sk = 0;
#pragma unroll
      for (int i = 0; i < 16; ++i) {
        const u32x4 w = *(const u32x4*)(row + half * 128 + i * 8);
#pragma unroll
        for (int q = 0; q < 4; ++q) { const float a = __uint_as_float(w[q] << 16), b = __uint_as_float(w[q] & 0xFFFF0000u); sq += a * a + b * b; }
      }
#pragma unroll
      for (int i = 0; i < 8; ++i) {
        const u32x4 w = *(const u32x4*)(row + 256 + half * 64 + i * 8);
#pragma unroll
        for (int q = 0; q < 4; ++q) { const float a = __uint_as_float(w[q] << 16), b = __uint_as_float(w[q] & 0xFFFF0000u); sk += a * a + b * b; }
      }
      sq += shx<1>(sq); sk += shx<1>(sk);
      if (half == 0) { rsl[r] = rsqrtf(sq * (1.f / 256.f) + EPS); rsl[256 + r] = rsqrtf(sk * (1.f / 128.f) + EPS); }
    }
    asm volatile("s_waitcnt lgkmcnt(0)" ::: "memory"); __builtin_amdgcn_s_barrier(); __builtin_amdgcn_s_barrier(); asm volatile("" ::: "memory");
    const float* rsp = rsl + (u.pn >= 2 ? 256 : 0);
#pragma unroll
    for (int ai = 0; ai < 2; ++ai)
#pragma unroll
      for (int m = 0; m < 4; ++m) {
        const int rl = ai * 128 + wr * 64 + m * 16 + fr, tok = u.pm * 256 + rl;
        const float rs = rsp[rl] * (u.pn < 2 ? A_QSCALE : 1.f);
        if (u.pn == 1) {
          f32x4 a = acc[ai][0][m][0] * rs, b = acc[ai][0][m][1] * rs;
          f32x4 pa, pb;
#pragma unroll
          for (int j = 0; j < 4; ++j) { pa[j] = shx<32>(a[j]); pb[j] = shx<32>(b[j]); }
          f32x4 ca = {1.f, 1.f, 1.f, 1.f}, cb = ca, sa = {0.f, 0.f, 0.f, 0.f}, sb = sa;
          if (tok < TL) {
            const float* cp = ropec + (size_t)(tok & (SEQ - 1)) * 16 + 8 * (fq & 1); const float* sp = ropes + (size_t)(tok & (SEQ - 1)) * 16 + 8 * (fq & 1);
            ca = *(const f32x4*)cp; cb = *(const f32x4*)(cp + 4); sa = *(const f32x4*)sp; sb = *(const f32x4*)(sp + 4);
          }
          const float sg = fq < 2 ? -1.f : 1.f;
          a = a * ca + pa * sa * sg; b = b * cb + pb * sb * sg;
          *(u32x4*)(Q + qkv_row(tok, wc) * 96 + 64 + 8 * fq) = u32x4{cvtpk(a[0], a[1]), cvtpk(a[2], a[3]), cvtpk(b[0], b[1]), cvtpk(b[2], b[3])};
        } else {
#pragma unroll
          for (int bj = 0; bj < 2; ++bj) {
            const int c = bj * 128 + wc * 32 + 8 * fq, h = c >> 6, d = c & 63;
            const f32x4 a = acc[ai][bj][m][0] * rs, b = acc[ai][bj][m][1] * rs;
            u16* dst = u.pn == 0 ? Q + qkv_row(tok, h) * 96 + d : KV + qkv_row(tok, h) * 160 + (u.pn == 2 ? 0 : 96) + d;
            *(u32x4*)dst = u32x4{cvtpk(a[0], a[1]), cvtpk(a[2], a[3]), cvtpk(b[0], b[1]), cvtpk(b[2], b[3])};
          }
        }
      }
    if (u.pn == 2) {
      const int b = u.pm * 256 < TL ? (u.pm * 256) >> 14 : (u.pm * 256 - TL) >> 8;
#pragma unroll
      for (int bj = 0; bj < 2; ++bj) {
        float mx = 0.f;
#pragma unroll
        for (int ai = 0; ai < 2; ++ai)
#pragma unroll
          for (int m = 0; m < 4; ++m) {
            const float rs = rsp[ai * 128 + wr * 64 + m * 16 + fr];
            const f32x4 a = acc[ai][bj][m][0] * rs, b4 = acc[ai][bj][m][1] * rs;
            float ss = a[0] * a[0] + a[1] * a[1] + a[2] * a[2] + a[3] * a[3] + b4[0] * b4[0] + b4[1] * b4[1] + b4[2] * b4[2] + b4[3] * b4[3];
            ss += shx<16>(ss); ss += shx<32>(ss);
            mx = fmaxf(mx, ss);
          }
        mx = fmaxf(mx, shx<8>(mx)); mx = fmaxf(mx, shx<4>(mx)); mx = fmaxf(mx, shx<2>(mx)); mx = fmaxf(mx, shx<1>(mx));
        if ((ltid() & 63) == 0) atomicMax(kmx + (b * 4 + bj * 2 + (wc >> 1)) * 4 + (wc & 1), __float_as_uint(mx));
      }
    }
  }
};
__device__ __forceinline__ void phase_qkv(const Params& p, int layer, int bid, int nb, char* lds) {
  const int tid = ltid();
  {
    G8Plain S; S.nM = TT / 256; S.nN = 4; S.Kb = 768; S.G = nb; S.c = bid; S.Bt = (const char*)(p.bt_qkv() + (size_t)layer * 1024 * 384);
    EpiQkv E; E.zqkv = p.zqkv(); E.Q = p.Q(); E.KV = p.KV(); E.ropec = p.ropec(); E.ropes = p.ropes(); E.rsl = (float*)(lds + 131072); E.kmx = p.kmx() + layer * 32;
    gemm8_phase<false>(lds, (const char*)p.zqkv(), 768, S, E);
  }
  float krm0 = 0.f, krm1 = 0.f;
  for (int i = bid * NTHR + tid; i < TT * 16; i += nb * NTHR) {
    const int tok = i >> 4, f = i & 15;
    const float x1 = bf2f(p.zg()[(size_t)tok * ZG_W + ZG_KR + f]), x2 = bf2f(p.zg()[(size_t)tok * ZG_W + ZG_KR + 16 + f]);
    float cs = 1.f, sn = 0.f;
    if (tok < TL) { const int tpos = tok & (SEQ - 1); cs = p.ropec()[tpos * 16 + f]; sn = p.ropes()[tpos * 16 + f]; }
    const float y1 = x1 * cs - x2 * sn, y2 = x2 * cs + x1 * sn;
    const u16 o1 = f2bf(y1), o2 = f2bf(y2);
#pragma unroll
    for (int h = 0; h < 4; ++h) { u16* kv = p.KV() + qkv_row(tok, h) * 160 + 64; kv[f] = o1; kv[16 + f] = o2; }
    float ss = y1 * y1 + y2 * y2;
    ss += shx<8>(ss); ss += shx<4>(ss); ss += shx<2>(ss); ss += shx<1>(ss);
    const int b = tok < TL ? (tok >> 14) : ((tok - TL) >> 8);
    if (b == 0) krm0 = fmaxf(krm0, ss); else krm1 = fmaxf(krm1, ss);
  }
  krm0 = wave_max(krm0); krm1 = wave_max(krm1);
  if ((tid & 63) == 0) { atomicMax(p.kmx() + layer * 32 + 0 * 16 + 2, __float_as_uint(krm0)); atomicMax(p.kmx() + layer * 32 + 1 * 16 + 2, __float_as_uint(krm1)); }
}

constexpr int A_KROW = 208;
constexpr int A_TV = 128 * 64 * 2;
constexpr int A_TK = 128 * A_KROW;
constexpr int A_BUF = A_TV + A_TK;
constexpr int A_OFF_W = 3 * A_BUF;
constexpr int ATTN_LDS = A_OFF_W + 8 * 64 * 4;
#define SBAR() __builtin_amdgcn_sched_barrier(0)
__device__ __forceinline__ int crow(int r, int hi) { return (r & 3) + 8 * (r >> 2) + 4 * hi; }

__device__ __forceinline__ void a_partialSM(f32x16& p0) {
#pragma unroll
  for (int r = 0; r < 16; ++r) p0[r] = __builtin_amdgcn_exp2f(p0[r]);
}
__device__ __forceinline__ void a_finishSM(f32x16& p0, f32x16& p1, bf16x8& pa0, bf16x8& pa1, bf16x8& pa2, bf16x8& pa3) {
#pragma unroll
  for (int r = 0; r < 16; ++r) p1[r] = __builtin_amdgcn_exp2f(p1[r]);
#define PK4(P, BASE, OUT) do { unsigned a0 = cvtpk(P[BASE + 0], P[BASE + 1]), a1 = cvtpk(P[BASE + 2], P[BASE + 3]);   \
    unsigned b0 = cvtpk(P[BASE + 4], P[BASE + 5]), b1 = cvtpk(P[BASE + 6], P[BASE + 7]);                              \
    auto r0 = __builtin_amdgcn_permlane32_swap(a0, b0, false, false); auto r1 = __builtin_amdgcn_permlane32_swap(a1, b1, false, false); \
    u32x4 w = {r0[0], r1[0], r0[1], r1[1]}; OUT = *reinterpret_cast<bf16x8*>(&w); } while (0)
  PK4(p0, 0, pa0); PK4(p0, 8, pa1); PK4(p1, 0, pa2); PK4(p1, 8, pa3);
#undef PK4
}
__device__ __forceinline__ void a_qkt(f32x16& p0, f32x16& p1, const char* Ks, const bf16x8* qr, const float mneg, int r32, int hi) {
#pragma unroll
  for (int r = 0; r < 16; ++r) { p0[r] = mneg; p1[r] = mneg; }
#pragma unroll
  for (int d0 = 0; d0 < 6; ++d0) {
    const int cb = (d0 * 16 + hi * 8) * 2;
    const bf16x8 b0 = *reinterpret_cast<const bf16x8*>(Ks + r32 * A_KROW + cb);
    const bf16x8 b1 = *reinterpret_cast<const bf16x8*>(Ks + (32 + r32) * A_KROW + cb);
    p0 = __builtin_amdgcn_mfma_f32_32x32x16_bf16(b0, qr[d0], p0, 0, 0, 0); p1 = __builtin_amdgcn_mfma_f32_32x32x16_bf16(b1, qr[d0], p1, 0, 0, 0);
  }
}
__device__ __forceinline__ int a_v_st(int k, int c) { const int kk = (k & ~0xC) | ((k & 4) << 1) | ((k & 8) >> 1); return ((kk >> 3) * 2 + (c >> 5)) * 512 + ((kk & 7) * 32 + (c & 31)) * 2; }
__device__ __forceinline__ int a_v_rd_base(int lane) { return ((lane & 3) << 3) | (((lane >> 2) & 3) << 6) | (((lane >> 4) & 1) << 5) | (((lane >> 5) & 1) << 8); }
constexpr int a_v_rd_off(int d0, int ks, int half) { return d0 * 512 + ks * 2048 + half * 1024; }
template <int OFF> __device__ __forceinline__ s16x4 a_tr_read(int vb) {
  s16x4 r; asm volatile("ds_read_b64_tr_b16 %0, %1 offset:%2" : "=&v"(r) : "v"(vb), "i"(OFF) : "memory"); return r;
}
template <int D0> __device__ __forceinline__ void a_pv_one(f32x16& od, int vb, bf16x8 pa0, bf16x8 pa1, bf16x8 pa2, bf16x8 pa3) {
  const s16x4 l0 = a_tr_read<a_v_rd_off(D0, 0, 0)>(vb), h0 = a_tr_read<a_v_rd_off(D0, 0, 1)>(vb), l1 = a_tr_read<a_v_rd_off(D0, 1, 0)>(vb), h1 = a_tr_read<a_v_rd_off(D0, 1, 1)>(vb);
  const s16x4 l2 = a_tr_read<a_v_rd_off(D0, 2, 0)>(vb), h2 = a_tr_read<a_v_rd_off(D0, 2, 1)>(vb), l3 = a_tr_read<a_v_rd_off(D0, 3, 0)>(vb), h3 = a_tr_read<a_v_rd_off(D0, 3, 1)>(vb);
  asm volatile("s_waitcnt lgkmcnt(0)" ::: "memory"); SBAR();
#define PK(L, H) (bf16x8){L[0], L[1], L[2], L[3], H[0], H[1], H[2], H[3]}
  od = __builtin_amdgcn_mfma_f32_32x32x16_bf16(pa0, PK(l0, h0), od, 0, 0, 0);
  od = __builtin_amdgcn_mfma_f32_32x32x16_bf16(pa1, PK(l1, h1), od, 0, 0, 0);
  od = __builtin_amdgcn_mfma_f32_32x32x16_bf16(pa2, PK(l2, h2), od, 0, 0, 0);
  od = __builtin_amdgcn_mfma_f32_32x32x16_bf16(pa3, PK(l3, h3), od, 0, 0, 0);
#undef PK
}
__device__ __forceinline__ void a_pv(f32x16* o, int vb, bf16x8 pa0, bf16x8 pa1, bf16x8 pa2, bf16x8 pa3) {
  a_pv_one<0>(o[0], vb, pa0, pa1, pa2, pa3);
  { const bf16x8 ones = {0x3F80, 0x3F80, 0x3F80, 0x3F80, 0x3F80, 0x3F80, 0x3F80, 0x3F80};
    o[2] = __builtin_amdgcn_mfma_f32_32x32x16_bf16(pa0, ones, o[2], 0, 0, 0); o[2] = __builtin_amdgcn_mfma_f32_32x32x16_bf16(pa1, ones, o[2], 0, 0, 0);
    o[2] = __builtin_amdgcn_mfma_f32_32x32x16_bf16(pa2, ones, o[2], 0, 0, 0); o[2] = __builtin_amdgcn_mfma_f32_32x32x16_bf16(pa3, ones, o[2], 0, 0, 0); }
  a_pv_one<1>(o[1], vb, pa0, pa1, pa2, pa3);
}

__device__ __forceinline__ void attn_item(const u16* __restrict__ Qb, const u16* __restrict__ KVh, int seq, float kmax, u16* __restrict__ yout  , char* lds) {
  const int tid = ltid(), wid = tid >> 6, lane = tid & 63, r32 = lane & 31, hi = lane >> 5;
  f32x16 o[3] = {}; bf16x8 qr[6];
  const u16* Qw = Qb + (size_t)(wid * 32 + r32) * 96 + hi * 8;
#pragma unroll
  for (int d0 = 0; d0 < 6; ++d0) qr[d0] = *reinterpret_cast<const bf16x8*>(Qw + d0 * 16);
  float mneg;
  {
    float ss = 0.f;
#pragma unroll
    for (int d0 = 0; d0 < 6; ++d0)
#pragma unroll
      for (int j = 0; j < 8; ++j) { const float v = bf2f((u16)qr[d0][j]); ss += v * v; }
    ss += shx<32>(ss);
    mneg = -sqrtf(ss) * kmax;
  }
  int lw[5];
#pragma unroll
  for (int i = 0; i < 5; ++i) {
    const int g = tid + i * 512, key = g / 20, cc = g % 20;
    lw[i] = cc < 12 ? (A_TV + key * A_KROW + cc * 16) : ((key >> 6) * 8192 + a_v_st(key & 63, (cc - 12) * 8));
  }
  const int vrb = (int)(uintptr_t)lds + a_v_rd_base(lane);
  bf16x8 sg[5];
  const char* gsrc = (const char*)KVh + tid * 16;
#define SLOAD(t) do { const char* s_ = gsrc + (size_t)(t) * 40960; _Pragma("unroll") for (int i = 0; i < 5; ++i) sg[i] = *(const bf16x8*)(s_ + i * 8192); } while (0)
#define SWRITE(bo_) do { _Pragma("unroll") for (int i = 0; i < 5; ++i) *(bf16x8*)(lds + (bo_) + lw[i]) = sg[i]; } while (0)
  f32x16 pA0, pA1, pB0, pB1; bf16x8 pa0, pa1, pa2, pa3; const int NT = seq / 128;
  SLOAD(0); SWRITE(0); if (1 < NT) SLOAD(1);
  __syncthreads();
  int bo = 0;
  {
    if (1 < NT) { SWRITE(A_BUF); if (2 < NT) SLOAD(2); }
    SBAR(); a_qkt(pA0, pA1, lds + bo + A_TV, qr, mneg, r32, hi); a_partialSM(pA0);
    SBAR(); a_qkt(pB0, pB1, lds + bo + A_TV + 64 * A_KROW, qr, mneg, r32, hi);
    a_finishSM(pA0, pA1, pa0, pa1, pa2, pa3); SBAR();
    a_pv(o, vrb + bo, pa0, pa1, pa2, pa3); a_partialSM(pB0);
    __syncthreads();
  }
  for (int t = 1; t < NT; ++t) {
    const int bp = bo;
    bo = bo + A_BUF; if (bo == 3 * A_BUF) bo = 0;
    int bn = bo + A_BUF; if (bn == 3 * A_BUF) bn = 0;
    if (t + 1 < NT) { SWRITE(bn); if (t + 2 < NT) SLOAD(t + 2); }
    SBAR(); a_qkt(pA0, pA1, lds + bo + A_TV, qr, mneg, r32, hi);
    a_finishSM(pB0, pB1, pa0, pa1, pa2, pa3); SBAR();
    a_pv(o, vrb + bp + 8192, pa0, pa1, pa2, pa3); a_partialSM(pA0);
    SBAR(); a_qkt(pB0, pB1, lds + bo + A_TV + 64 * A_KROW, qr, mneg, r32, hi);
    a_finishSM(pA0, pA1, pa0, pa1, pa2, pa3); SBAR();
    a_pv(o, vrb + bo, pa0, pa1, pa2, pa3); a_partialSM(pB0);
    __syncthreads();
  }
  a_finishSM(pB0, pB1, pa0, pa1, pa2, pa3); SBAR();
  a_pv(o, vrb + bo + 8192, pa0, pa1, pa2, pa3);
#pragma unroll
  for (int r = 0; r < 16; ++r) {
    const int orow = crow(r, hi);
    const float rl = __builtin_amdgcn_rcpf(o[2][r]);
    const float v0 = o[0][r] * rl, v1 = o[1][r] * rl;
    float ss = v0 * v0 + v1 * v1;
    ss += shx<16>(ss); ss += shx<8>(ss); ss += shx<4>(ss); ss += shx<2>(ss); ss += shx<1>(ss);
    const float rs = rsqrtf(ss * (1.f / 64.f) + EPS);
    u16* dst = yout + (size_t)(wid * 32 + orow) * DM;
    dst[r32] = f2bf(v0 * rs); dst[32 + r32] = f2bf(v1 * rs);
  }
  __syncthreads();
#undef SLOAD
#undef SWRITE
}

__device__ __forceinline__ void phase_attn(const Params& p, int layer, int bid, int nb, char* lds) {
  const int nitems = 512 + (layer == 0 ? 8 : 0);
  const unsigned* kmx = p.kmx() + layer * 32;
  for (int it = bid; it < nitems; it += nb) {
    int b, h, q0, k0, seq, tok0;
    if (it < 512) { const int pair = it & 7, qb = (it >> 3); h = pair & 3; b = pair >> 2; q0 = qb * 256; k0 = 0; seq = SKV; tok0 = b * SEQ + qb * 256; }
    else { const int i2 = it - 512; h = i2 & 3; b = i2 >> 2; q0 = SEQ; k0 = SEQ; seq = LC; tok0 = TL + b * LC; }
    const size_t base = (size_t)(b * 4 + h) * SKV;
    const float k2 = __uint_as_float(kmx[(b * 4 + h) * 4 + 0]) + __uint_as_float(kmx[(b * 4 + h) * 4 + 1]) + __uint_as_float(kmx[b * 16 + 2]);
    attn_item(p.Q() + (base + q0) * 96, p.KV() + (base + k0) * 160, seq, sqrtf(k2) * 1.02f, p.ymix() + (size_t)tok0 * DM + h * 64, lds);
  }
}

__device__ __forceinline__ float hy_sconv(const u16* __restrict__ row, int t, int Ls, float w0, float w1, float w2, float bb) {
  const float zm = t > 0 ? bf2f(row[t - 1]) : 0.f, z0 = bf2f(row[t]), zp = t + 1 < Ls ? bf2f(row[t + 1]) : 0.f;
  return w0 * zm + w1 * z0 + w2 * zp + bb;
}
__device__ __forceinline__ float2 hy_sconv2(unsigned prv, unsigned cur, unsigned nxt, float w0, float w1, float w2, float bb) {
  const float zm = __uint_as_float(prv & 0xFFFF0000u), z0 = __uint_as_float(cur << 16), z1 = __uint_as_float(cur & 0xFFFF0000u), z2 = __uint_as_float(nxt << 16);
  return make_float2(w0 * zm + w1 * z0 + w2 * z1 + bb, w0 * z0 + w1 * z1 + w2 * z2 + bb);
}
__device__ __forceinline__ void hyena_item(const Params& p, int layer, int b, int ch, char* lds) {
  float2* s = (float2*)lds;
  const int tid = ltid();
  const float* cw = p.hy_conv_w() + (size_t)layer * 3 * 768; const float* cb = p.hy_conv_b() + (size_t)layer * 768;
  const unsigned* r0 = (const unsigned*)(p.zt() + (size_t)(ZT_HY + ch) * TT + (size_t)b * SEQ);
  const unsigned* r1 = (const unsigned*)(p.zt() + (size_t)(ZT_HY + 256 + ch) * TT + (size_t)b * SEQ);
  const unsigned* r2 = (const unsigned*)(p.zt() + (size_t)(ZT_HY + 512 + ch) * TT + (size_t)b * SEQ);
  const float a0 = cw[ch], a1 = cw[768 + ch], a2 = cw[1536 + ch], ab = cb[ch];
  const float b0 = cw[256 + ch], b1 = cw[768 + 256 + ch], b2 = cw[1536 + 256 + ch], bb = cb[256 + ch];
  const float c0 = cw[512 + ch], c1 = cw[768 + 512 + ch], c2 = cw[1536 + 512 + ch], cbb = cb[512 + ch];
  unsigned vgr[16], x0r[16];
#pragma unroll
  for (int hb2 = 0; hb2 < 2; ++hb2) {
    unsigned ld[8][9];
#pragma unroll
    for (int ii = 0; ii < 8; ++ii) {
      const int m = tid + 512 * (hb2 * 8 + ii);
      const int mp = m > 0 ? m - 1 : 0, mn = m + 1 < SEQ / 2 ? m + 1 : m;
      ld[ii][0] = r0[mp]; ld[ii][1] = r0[m]; ld[ii][2] = r0[mn];
      ld[ii][3] = r1[mp]; ld[ii][4] = r1[m]; ld[ii][5] = r1[mn];
      ld[ii][6] = r2[mp]; ld[ii][7] = r2[m]; ld[ii][8] = r2[mn];
    }
#pragma unroll
    for (int ii = 0; ii < 8; ++ii) {
      const int i = hb2 * 8 + ii, m = tid + 512 * i;
      const unsigned mkp = m > 0 ? 0xFFFFFFFFu : 0u, mkn = m + 1 < SEQ / 2 ? 0xFFFFFFFFu : 0u;
      const float2 ux = hy_sconv2(ld[ii][0] & mkp, ld[ii][1], ld[ii][2] & mkn, a0, a1, a2, ab);
      x0r[i] = cvtpk(ux.x, ux.y);
      const float2 u1 = hy_sconv2(ld[ii][3] & mkp, ld[ii][4], ld[ii][5] & mkn, b0, b1, b2, bb);
      const float2 uv = hy_sconv2(ld[ii][6] & mkp, ld[ii][7], ld[ii][8] & mkn, c0, c1, c2, cbb);
      const float2 vgf = make_float2(uv.x * u1.x, uv.y * u1.y);
      vgr[i] = cvtpk(vgf.x, vgf.y);
      s[swz(m)] = vgf;
      s[swz(m + SEQ / 2)] = make_float2(0.f, 0.f);
    }
  }
  __syncthreads();
  fft_fwd(s, p.tw());
  {
    const float4* hs = p.hspec() + ((size_t)layer * 256 + ch) * HSP;
    float4 hv[17];
#pragma unroll
    for (int i = 0; i < 17; ++i) { const int k = tid + 512 * i; hv[i] = hs[k <= FM / 2 ? k : 0]; }
    const float2 twl = p.tw()[tid];
#pragma unroll
    for (int i = 0; i < 17; ++i) {
      const int k = tid + 512 * i;
      if (k <= FM / 2) {
        const int pk = swz(rev7(k)), pm = swz(rev7((FM - k) & (FM - 1)));
        const float2 zk = s[pk], zm = s[pm];
        const float4 h = hv[i];
        const float2 He = make_float2(h.x, h.y), Ho = make_float2(h.z, h.w);
        const float2 Xe = make_float2(0.5f * (zk.x + zm.x), 0.5f * (zk.y - zm.y));
        const float2 Xo = make_float2(0.5f * (zk.y + zm.y), -0.5f * (zk.x - zm.x));
        const float2 twk = cmul(twl, p.tw()[512 * i]);
        const float2 t1 = cmul(twk, cmul(Xo, Ho));
        const float2 e1 = cmul(Xe, He);
        const float2 Ye = make_float2(e1.x + t1.x, e1.y + t1.y);
        const float2 o1 = cmul(Xe, Ho), o2 = cmul(Xo, He);
        const float2 Yo = make_float2(o1.x + o2.x, o1.y + o2.y);
        s[pk] = make_float2(Ye.x - Yo.y, Ye.y + Yo.x);
        if (pm != pk) s[pm] = make_float2(Ye.x + Yo.y, -Ye.y + Yo.x);
      }
    }
  }
  __syncthreads();
  fft_inv(s, p.tw());
  const float hb = p.hy_bias()[layer * 256 + ch];
  unsigned* orow = (unsigned*)(p.hyo() + (size_t)ch * TT + (size_t)b * SEQ);
#pragma unroll
  for (int i = 0; i < 16; ++i) {
    const int m = tid + 512 * i;
    const float2 y = s[swz(m)];
    orow[m] = cvtpk((y.x + __uint_as_float(vgr[i] << 16) * hb) * __uint_as_float(x0r[i] << 16), (y.y + __uint_as_float(vgr[i] & 0xFFFF0000u) * hb) * __uint_as_float(x0r[i] & 0xFFFF0000u));
  }
  __syncthreads();
}
__device__ __forceinline__ void fnet_item(const Params& p, int b, int j, char* lds) {
  float2* s = (float2*)lds;
  const int tid = ltid();
  const u16* rr = p.zt() + (size_t)(ZT_FR + j) * TT + (size_t)b * SEQ;
  const u16* ri = p.zt() + (size_t)(ZT_FI + j) * TT + (size_t)b * SEQ;
  {
    u32x4 vr[4], vi[4];
#pragma unroll
    for (int i = 0; i < 4; ++i) { const int m0 = (tid + 512 * i) * 8; vr[i] = *(const u32x4*)(rr + m0); vi[i] = *(const u32x4*)(ri + m0); }
#pragma unroll
    for (int i = 0; i < 4; ++i) {
      const int m0 = (tid + 512 * i) * 8;
#pragma unroll
      for (int q = 0; q < 4; ++q) {
        s[swz(m0 + 2 * q)] = make_float2(__uint_as_float(vr[i][q] << 16), __uint_as_float(vi[i][q] << 16));
        s[swz(m0 + 2 * q + 1)] = make_float2(__uint_as_float(vr[i][q] & 0xFFFF0000u), __uint_as_float(vi[i][q] & 0xFFFF0000u));
      }
    }
  }
  __syncthreads();
  fft_fwd(s, p.tw());
#ifdef PROBE_FFT
  fft_inv(s, p.tw());
  for (int m = tid; m < FM; m += NTHR) { float2 v = s[m]; v.x *= (1.f / 16384.f); v.y *= (1.f / 16384.f); s[m] = v; }
  __syncthreads();
  fft_fwd(s, p.tw());
#endif
  u16* orow = p.fno() + (size_t)j * TT + (size_t)b * SEQ;
#pragma unroll 8
  for (int k = tid; k < FM; k += NTHR) orow[k] = f2bf(s[swz(rev7(k))].x * (1.f / 128.f));
  __syncthreads();
}
__device__ __forceinline__ void hyena_ctx_item(const Params& p, int b, int ch, char* lds) {
  float* vg = (float*)lds;
  float* x0 = vg + 256;
  float* hf = x0 + 256;
  float* hbk = hf + 256;
  const int tid = ltid();
  const float* cw = p.hy_conv_w(); const float* cb = p.hy_conv_b();
  const size_t off = (size_t)TL + (size_t)b * LC;
  const u16* r0 = p.zt() + (size_t)(ZT_HY + ch) * TT + off;
  const u16* r1 = p.zt() + (size_t)(ZT_HY + 256 + ch) * TT + off;
  const u16* r2 = p.zt() + (size_t)(ZT_HY + 512 + ch) * TT + off;
  if (tid < 256) {
    const int t = tid;
    vg[t] = hy_sconv(r2, t, LC, cw[512 + ch], cw[768 + 512 + ch], cw[1536 + 512 + ch], cb[512 + ch]) *
            hy_sconv(r1, t, LC, cw[256 + ch], cw[768 + 256 + ch], cw[1536 + 256 + ch], cb[256 + ch]);
    x0[t] = hy_sconv(r0, t, LC, cw[ch], cw[768 + ch], cw[1536 + ch], cb[ch]);
    hf[t] = p.hfc()[(size_t)ch * LC + t]; hbk[t] = p.hfc()[(size_t)(256 + ch) * LC + t];
  }
  const float ssq_c = filt_ssq(p.hpart() + (size_t)2 * 256 * 512, ch, (float*)(lds + 8192));
  if (tid < 256) {
    const int t = tid; float y = 0;
    for (int q = 0; q <= t; ++q) y += hf[t - q] * vg[q];
    for (int q = t + 1; q < LC; ++q) y += hbk[q - t] * vg[q];
    y *= rsqrtf(ssq_c);
    p.hyo()[(size_t)ch * TT + off + t] = f2bf((y + vg[t] * p.hy_bias()[ch]) * x0[t]);
  }
  __syncthreads();
}
__device__ __forceinline__ void fnet_ctx_item(const Params& p, int b, int j, char* lds) {
  float* ur = (float*)lds; float* ui = ur + 256; float* cst = ui + 256; float* snt = cst + 256;
  const int tid = ltid();
  const size_t off = (size_t)TL + (size_t)b * LC;
  if (tid < 256) {
    ur[tid] = bf2f(p.zt()[(size_t)(ZT_FR + j) * TT + off + tid]); ui[tid] = bf2f(p.zt()[(size_t)(ZT_FI + j) * TT + off + tid]);
    float sn, cs; sincospif((float)tid / 128.f, &sn, &cs); cst[tid] = cs; snt[tid] = sn;
  }
  __syncthreads();
  if (tid < 256) {
    const int k = tid; float y = 0;
    for (int l = 0; l < 256; ++l) { const int m = (l * k) & 255; y += cst[m] * ur[l] + snt[m] * ui[l]; }
    p.fno()[(size_t)j * TT + off + k] = f2bf(y * 0.0625f);
  }
  __syncthreads();
}
__device__ __forceinline__ void phase_fftmix(const Params& p, int layer, int bid, int nb, char* lds) {
  const int nitems = layer == 0 ? 2048 : 1024;
  for (int it = bid; it < nitems; it += nb) {
    const int k = it & 511, b = k >> 8, c = k & 255;
    if (it < 512) hyena_item(p, layer, b, c, lds);
    else if (it < 1024) fnet_item(p, b, c, lds);
    else if (it < 1536) hyena_ctx_item(p, b, c, lds);
    else fnet_ctx_item(p, b, c, lds);
  }
}
constexpr int GLG = 17, NGRP = 16;
__device__ __forceinline__ int gla_chain_tok(int dir, int b, int n, int i) {
  const int base = n < 4 ? TL + b * LC : b * SEQ, len = n < 4 ? LC : SEQ, m = n < 4 ? n : n - 4;
  return dir == 0 ? base + 64 * m + i : base + (len - 1) - (64 * m + i);
}
__device__ __forceinline__ float logsig16(float x) { return (fminf(x, 0.f) - __logf(1.f + __expf(-fabsf(x)))) * (1.f / 16.f); }
__device__ __forceinline__ float wave_scan_incl(float v, int lane) {
#pragma unroll
  for (int o = 1; o < 64; o <<= 1) { const float t = __shfl_up(v, o, 64); if (lane >= o) v += t; }
  return v;
}
__device__ __forceinline__ void phase_gla_a(const Params& p, int layer, int bid, int nb, char* lds) {
  const int tid = ltid(), wid = tid >> 6, lane = tid & 63, r32 = lane & 31, hi = lane >> 5;
  const float* gb = p.gla_gk_b() + (size_t)layer * 256;
  char* wimg = lds + wid * 12288;
  for (int it = bid; it < 16 * NGRP; it += nb) {
    const int chain = it >> 4, g = it & 15, dir = chain >> 3, b = (chain >> 2) & 1, h = chain & 3;
    const int n0 = g * GLG, n1 = min(n0 + GLG, NCH), nch = n1 - n0;
    char* WT = lds + wid * 13824; char* VT = WT + 4608;
    float* dvl = (float*)(lds + 8 * 13824);
#pragma unroll
    for (int c = 0; c < 3; ++c) {
      const int cl = wid + 8 * c;
      if (cl < nch) {
        const int n = n0 + cl;
        {
          const u16* vbase = p.zg() + ZG_GV + h * 64 + lane;
          u16 vv[64];
#pragma unroll
          for (int i = 0; i < 64; ++i) vv[i] = vbase[(size_t)gla_chain_tok(dir, b, n, i) * ZG_W];
#pragma unroll
          for (int q = 0; q < 8; ++q)
            *(u32x4*)(VT + lane * 144 + q * 16) = u32x4{(unsigned)vv[8 * q] | ((unsigned)vv[8 * q + 1] << 16), (unsigned)vv[8 * q + 2] | ((unsigned)vv[8 * q + 3] << 16),
                                                       (unsigned)vv[8 * q + 4] | ((unsigned)vv[8 * q + 5] << 16), (unsigned)vv[8 * q + 6] | ((unsigned)vv[8 * q + 7] << 16)};
        }
        {
          const int kk = lane & 31, hs = lane >> 5;
          const u16* kb = p.zg() + ZG_GK + h * 32 + kk; const u16* gbp = p.zg() + ZG_GP + dir * 128 + h * 32 + kk;
          const float bias = gb[dir * 128 + h * 32 + kk];
          float bc[32], kf[32];
#pragma unroll
          for (int i = 0; i < 32; ++i) {
            const size_t ro = (size_t)gla_chain_tok(dir, b, n, hs * 32 + i) * ZG_W;
            kf[i] = bf2f(kb[ro]); bc[i] = bf2f(gbp[ro]);
          }
          float run = 0.f;
#pragma unroll
          for (int i = 0; i < 32; ++i) { const float x = bc[i] + bias; run += (fminf(x, 0.f) - __logf(1.f + __expf(-fabsf(x)))) * (1.f / 16.f); bc[i] = run; }
          const float lowtot = __shfl(run, kk, 64);
          const float uptot = __shfl(run, 32 + kk, 64);
          const float bl = lowtot + uptot, off = hs ? lowtot : 0.f;
          unsigned wp[16];
#pragma unroll
          for (int i = 0; i < 16; ++i) wp[i] = cvtpk(kf[2 * i] * __expf(bl - (bc[2 * i] + off)), kf[2 * i + 1] * __expf(bl - (bc[2 * i + 1] + off)));
#pragma unroll
          for (int q = 0; q < 4; ++q) *(u32x4*)(WT + kk * 144 + hs * 64 + q * 16) = u32x4{wp[4 * q], wp[4 * q + 1], wp[4 * q + 2], wp[4 * q + 3]};
          if (hs == 0) dvl[cl * 32 + kk] = __expf(bl);
        }
        asm volatile("s_waitcnt lgkmcnt(0)" ::: "memory");
        f32x16 d0 = {}, d1 = {};
#pragma unroll
        for (int s4 = 0; s4 < 4; ++s4) {
          const bf16x8 af = *(const bf16x8*)(WT + r32 * 144 + (16 * s4 + 8 * hi) * 2);
          const bf16x8 v0 = *(const bf16x8*)(VT + r32 * 144 + (16 * s4 + 8 * hi) * 2);
          const bf16x8 v1 = *(const bf16x8*)(VT + (32 + r32) * 144 + (16 * s4 + 8 * hi) * 2);
          d0 = __builtin_amdgcn_mfma_f32_32x32x16_bf16(af, v0, d0, 0, 0, 0);
          d1 = __builtin_amdgcn_mfma_f32_32x32x16_bf16(af, v1, d1, 0, 0, 0);
        }
        asm volatile("s_waitcnt lgkmcnt(0)" ::: "memory");
        {
          float* dg = p.gds() + ((size_t)chain * NCH + n) * 2048;
#pragma unroll
          for (int r = 0; r < 16; ++r) { dg[crow(r, hi) * 64 + r32] = d0[r]; dg[crow(r, hi) * 64 + 32 + r32] = d1[r]; }
        }
      }
      __builtin_amdgcn_sched_barrier(0);
    }
    __syncthreads();
    {
      const int kk = tid >> 4, v0 = (tid & 15) * 4;
      float st[4] = {0.f, 0.f, 0.f, 0.f}; float dcum = 1.f;
      float* gp0 = p.gds() + ((size_t)chain * NCH + n0) * 2048 + kk * 64 + v0;
      float4 av[GLG];
#pragma unroll
      for (int cl = 0; cl < GLG; ++cl) av[cl] = *(const float4*)(gp0 + (size_t)(cl < nch ? cl : 0) * 2048);
#pragma unroll
      for (int cl = 0; cl < GLG; ++cl) {
        if (cl < nch) {
          const float d = dvl[cl * 32 + kk];
          *(float4*)(gp0 + (size_t)cl * 2048) = make_float4(st[0], st[1], st[2], st[3]);
          if ((tid & 15) == 0) p.gdv()[((size_t)chain * NCH + n0 + cl) * 32 + kk] = dcum;
          st[0] = st[0] * d + av[cl].x; st[1] = st[1] * d + av[cl].y; st[2] = st[2] * d + av[cl].z; st[3] = st[3] * d + av[cl].w;
          dcum *= d;
        }
      }
      float* at = p.gst() + ((size_t)chain * NGRP + g) * 2048 + kk * 64 + v0;
      *(float4*)at = make_float4(st[0], st[1], st[2], st[3]);
      if ((tid & 15) == 0) p.gst()[(size_t)16 * NGRP * 2048 + ((size_t)chain * NGRP + g) * 32 + kk] = dcum;
    }
    __syncthreads();
  }
}

constexpr int GC_QP = 33792, GC_KP = GC_QP + 10240, GC_VT = GC_KP + 10240, GC_ST = GC_VT + 18432, GC_AX = GC_ST + 10240;
__device__ __forceinline__ void phase_gla_c(const Params& p, int layer, int bid, int nb, char* lds) {
  float* gl = (float*)lds;
  float* qraw = gl + 2 * 64 * 33;
  float* kraw = qraw + 64 * 33;
  float* Of = (float*)lds;
  char* Qp = lds + GC_QP;
  char* Kp = lds + GC_KP;
  char* VT = lds + GC_VT;
  char* ST = lds + GC_ST;
  const int tid = ltid(), wid = tid >> 6, lane = tid & 63, r32 = lane & 31, hi = lane >> 5;
  char* Ax = lds + GC_AX + wid * 4608;
  const float* gb = p.gla_gk_b() + (size_t)layer * 256;
  const int pc_lo = layer == 0 ? 0 : 4, npc = NCH - pc_lo, nitem = 8 * npc;
  const int per = (nitem + nb - 1) / nb, q_beg = bid * per, q_end = min(nitem, q_beg + per);
  const int sdir = tid >> 8, sk = (tid >> 3) & 31, sv0 = (tid & 7) * 8;
  float G[8]; int g_cached = -1, bh_cached = -1;
  const int lpos = tid >> 3, lc4 = (tid & 7) * 4;
  u32x2 rq, rk, rg0, rg1, rva, rvb; float4 pl0, pl1; float pdp;
#define GC_ITEM(q_, bh_, pc_, b_, h_, tok0_) const int bh_ = (q_) / npc, pc_ = pc_lo + (q_) % npc, b_ = bh_ >> 2, h_ = bh_ & 3; \
    const int tok0_ = pc_ < 4 ? TL + b_ * LC + pc_ * 64 : b_ * SEQ + (pc_ - 4) * 64
#define GC_LOADRAW(tok0_, h_) do { const u16* zr = p.zg() + (size_t)((tok0_) + lpos) * ZG_W; \
    rq = *(const u32x2*)(zr + ZG_GQ + (h_) * 32 + lc4); rk = *(const u32x2*)(zr + ZG_GK + (h_) * 32 + lc4); \
    rg0 = *(const u32x2*)(zr + ZG_GP + (h_) * 32 + lc4); rg1 = *(const u32x2*)(zr + ZG_GP + 128 + (h_) * 32 + lc4); \
    rva = *(const u32x2*)(zr + ZG_GV + (h_) * 64 + lc4 * 2); rvb = *(const u32x2*)(zr + ZG_GV + (h_) * 64 + lc4 * 2 + 4); } while (0)
#define GC_LOADST(pc_, b_, h_) do { const int chain_ = sdir * 8 + (b_) * 4 + (h_); \
    const int n_ = sdir == 0 ? (pc_) : ((pc_) < 4 ? 3 - (pc_) : 4 + 255 - ((pc_) - 4)); \
    const float* lp_ = p.gds() + ((size_t)chain_ * NCH + n_) * 2048 + sk * 64 + sv0; \
    pl0 = *(const float4*)lp_; pl1 = *(const float4*)(lp_ + 4); pdp = p.gdv()[((size_t)chain_ * NCH + n_) * 32 + sk]; } while (0)
  if (q_beg < q_end) { GC_ITEM(q_beg, bh0, pc0, b0, h0, t00); GC_LOADRAW(t00, h0); GC_LOADST(pc0, b0, h0); }
  for (int qi = q_beg; qi < q_end; ++qi) {
    GC_ITEM(qi, bh, pc, b, h, tok0);
    {
      const int pos = lpos, c4 = lc4;
      const float sc = 0.17677669529663687f;
      qraw[pos * 33 + c4] = BF_LO(rq[0]) * sc; qraw[pos * 33 + c4 + 1] = BF_HI(rq[0]) * sc; qraw[pos * 33 + c4 + 2] = BF_LO(rq[1]) * sc; qraw[pos * 33 + c4 + 3] = BF_HI(rq[1]) * sc;
      kraw[pos * 33 + c4] = BF_LO(rk[0]); kraw[pos * 33 + c4 + 1] = BF_HI(rk[0]); kraw[pos * 33 + c4 + 2] = BF_LO(rk[1]); kraw[pos * 33 + c4 + 3] = BF_HI(rk[1]);
#pragma unroll
      for (int d = 0; d < 2; ++d) {
        const u32x2 rg = d ? rg1 : rg0; const float4 bb = *(const float4*)(gb + d * 128 + h * 32 + c4);
        const int i = d ? 63 - pos : pos;
        float* gd = gl + (d * 64 + i) * 33 + c4;
        gd[0] = logsig16(BF_LO(rg[0]) + bb.x); gd[1] = logsig16(BF_HI(rg[0]) + bb.y); gd[2] = logsig16(BF_LO(rg[1]) + bb.z); gd[3] = logsig16(BF_HI(rg[1]) + bb.w);
      }
#pragma unroll
      for (int j = 0; j < 4; ++j) {
        const unsigned w = j < 2 ? rva[j] : rvb[j - 2]; const int v = c4 * 2 + 2 * j;
        *(u16*)(VT + (0 * 64 + v) * 144 + pos * 2) = (u16)(w & 0xFFFFu); *(u16*)(VT + (1 * 64 + v) * 144 + (63 - pos) * 2) = (u16)(w & 0xFFFFu);
        *(u16*)(VT + (0 * 64 + v + 1) * 144 + pos * 2) = (u16)(w >> 16); *(u16*)(VT + (1 * 64 + v + 1) * 144 + (63 - pos) * 2) = (u16)(w >> 16);
      }
    }
    if (qi + 1 < q_end) { GC_ITEM(qi + 1, bhn, pcn, bn, hn, t0n); GC_LOADRAW(t0n, hn); }
    __syncthreads();
    {
      const int col = tid & 63, d = col >> 5, c = col & 31, part = tid >> 6;
      float* ptot = (float*)(lds + GC_AX);
      float bv[8]; float run = 0.f;
#pragma unroll
      for (int j = 0; j < 8; ++j) { run += gl[(d * 64 + part * 8 + j) * 33 + c]; bv[j] = run; }
      ptot[part * 64 + col] = run;
      __syncthreads();
      float off = 0.f;
#pragma unroll
      for (int q = 0; q < 7; ++q) off += (q < part) ? ptot[q * 64 + col] : 0.f;
#pragma unroll
      for (int j = 0; j < 8; ++j) gl[(d * 64 + part * 8 + j) * 33 + c] = bv[j] + off;
    }
    __syncthreads();
    {
#pragma unroll
      for (int e = 0; e < 2; ++e) {
        const int idx = tid + e * 512, d = idx >> 9, i = (idx >> 3) & 63, c4 = (idx & 7) * 4, pos = d ? 63 - i : i;
        float qo[4], ko[4];
#pragma unroll
        for (int j = 0; j < 4; ++j) {
          const float bi = gl[(d * 64 + i) * 33 + c4 + j], bm = gl[(d * 64 + 31) * 33 + c4 + j];
          qo[j] = qraw[pos * 33 + c4 + j] * __expf(bi - bm); ko[j] = kraw[pos * 33 + c4 + j] * __expf(bm - bi);
        }
        *(u32x2*)(Qp + (d * 64 + i) * 80 + c4 * 2) = u32x2{cvtpk(qo[0], qo[1]), cvtpk(qo[2], qo[3])};
        *(u32x2*)(Kp + (d * 64 + i) * 80 + c4 * 2) = u32x2{cvtpk(ko[0], ko[1]), cvtpk(ko[2], ko[3])};
      }
      const int chain = sdir * 8 + b * 4 + h;
      const int n = sdir == 0 ? pc : (pc < 4 ? 3 - pc : 4 + 255 - (pc - 4)), g = n / GLG;
      if (g != g_cached || bh != bh_cached) {
#pragma unroll
        for (int j = 0; j < 8; ++j) G[j] = 0.f;
        const float* at = p.gst() + (size_t)chain * NGRP * 2048 + sk * 64 + sv0;
        const float* dt = p.gst() + (size_t)16 * NGRP * 2048 + (size_t)chain * NGRP * 32 + sk;
        for (int gg = 0; gg < g; ++gg) {
          const float4 a0 = *(const float4*)(at + (size_t)gg * 2048), a1 = *(const float4*)(at + (size_t)gg * 2048 + 4); const float dd = dt[gg * 32];
          G[0] = G[0] * dd + a0.x; G[1] = G[1] * dd + a0.y; G[2] = G[2] * dd + a0.z; G[3] = G[3] * dd + a0.w;
          G[4] = G[4] * dd + a1.x; G[5] = G[5] * dd + a1.y; G[6] = G[6] * dd + a1.z; G[7] = G[7] * dd + a1.w;
        }
        g_cached = g; bh_cached = bh;
      }
      const float4 l0 = pl0, l1 = pl1; const float dp = pdp;
      const float em = __expf(gl[(sdir * 64 + 31) * 33 + sk]);
      const float sv[8] = {l0.x + dp * G[0], l0.y + dp * G[1], l0.z + dp * G[2], l0.w + dp * G[3], l1.x + dp * G[4], l1.y + dp * G[5], l1.z + dp * G[6], l1.w + dp * G[7]};
      if (qi + 1 < q_end) { GC_ITEM(qi + 1, bhn, pcn, bn, hn, t0n); (void)bhn; (void)t0n; GC_LOADST(pcn, bn, hn); }
#pragma unroll
      for (int j = 0; j < 8; ++j) *(u16*)(ST + (sdir * 64 + sv0 + j) * 80 + sk * 2) = f2bf(sv[j] * em);
    }
    __syncthreads();
    {
      const int d = wid >> 2, ib = (wid >> 1) & 1, vb = wid & 1;
      const char* Qd = Qp + d * 64 * 80; const char* Kd = Kp + d * 64 * 80; const char* Vd = VT + d * 64 * 144; const char* Sd = ST + d * 64 * 80;
      bf16x8 qf[2];
#pragma unroll
      for (int s2 = 0; s2 < 2; ++s2) qf[s2] = *(const bf16x8*)(Qd + (ib * 32 + r32) * 80 + (16 * s2 + 8 * hi) * 2);
#pragma unroll
      for (int jb = 0; jb < 2; ++jb) {
        if (jb <= ib) {
          f32x16 x = {};
#pragma unroll
          for (int s2 = 0; s2 < 2; ++s2) {
            const bf16x8 kf = *(const bf16x8*)(Kd + (jb * 32 + r32) * 80 + (16 * s2 + 8 * hi) * 2);
            x = __builtin_amdgcn_mfma_f32_32x32x16_bf16(qf[s2], kf, x, 0, 0, 0);
          }
#pragma unroll
          for (int r = 0; r < 16; ++r) {
            const int il = crow(r, hi), i = ib * 32 + il, j = jb * 32 + r32;
            *(u16*)(Ax + il * 144 + j * 2) = f2bf(j <= i ? x[r] : 0.f);
          }
        }
      }
      asm volatile("s_waitcnt lgkmcnt(0)" ::: "memory");
      f32x16 o = {};
#pragma unroll
      for (int s4 = 0; s4 < 4; ++s4) {
        if (s4 < 2 * (ib + 1)) {
          const bf16x8 af = *(const bf16x8*)(Ax + r32 * 144 + (16 * s4 + 8 * hi) * 2);
          const bf16x8 vf = *(const bf16x8*)(Vd + (vb * 32 + r32) * 144 + (16 * s4 + 8 * hi) * 2);
          o = __builtin_amdgcn_mfma_f32_32x32x16_bf16(af, vf, o, 0, 0, 0);
        }
      }
#pragma unroll
      for (int s2 = 0; s2 < 2; ++s2) {
        const bf16x8 sf = *(const bf16x8*)(Sd + (vb * 32 + r32) * 80 + (16 * s2 + 8 * hi) * 2);
        o = __builtin_amdgcn_mfma_f32_32x32x16_bf16(qf[s2], sf, o, 0, 0, 0);
      }
#pragma unroll
      for (int r = 0; r < 16; ++r) {
        const int i = ib * 32 + crow(r, hi), pos = d ? 63 - i : i;
        Of[(d * 64 + pos) * 65 + vb * 32 + r32] = o[r];
      }
    }
    __syncthreads();
    {
      const int pos = tid >> 3, v0 = (tid & 7) * 8;
      float r8[8]; float ss = 0.f;
#pragma unroll
      for (int j = 0; j < 8; ++j) { r8[j] = Of[pos * 65 + v0 + j] + Of[(64 + pos) * 65 + v0 + j]; ss += r8[j] * r8[j]; }
      ss += shx<4>(ss); ss += shx<2>(ss); ss += shx<1>(ss);
      const float rs = rsqrtf(ss * (1.f / 64.f) + EPS);
      const u16* og = p.zg() + (size_t)(tok0 + pos) * ZG_W + ZG_OG + h * 64 + v0;
      const float4 g0 = ld4bf(og), g1 = ld4bf(og + 4);
      *(u32x4*)(p.ymix() + (size_t)(tok0 + pos) * DM + 512 + h * 64 + v0) =
          u32x4{cvtpk(r8[0] * rs * silu_f(g0.x), r8[1] * rs * silu_f(g0.y)), cvtpk(r8[2] * rs * silu_f(g0.z), r8[3] * rs * silu_f(g0.w)),
                cvtpk(r8[4] * rs * silu_f(g1.x), r8[5] * rs * silu_f(g1.y)), cvtpk(r8[6] * rs * silu_f(g1.z), r8[7] * rs * silu_f(g1.w))};
    }
    __syncthreads();
  }
}

__device__ __forceinline__ void phase_mix(const Params& p, int layer, int bid, int nb, char* lds) {
  float* part = (float*)lds;
  u16* tile = (u16*)(lds + 4096);
  const int tid = ltid(), wid = tid >> 6, lane = tid & 63;
  const int ntok = layer == 0 ? TT : TL;
  for (int it = bid; it < ntok / 64; it += nb) {
    const int tok0 = it * 64;
    float vh[32], vf[32]; float sh = 0, sf = 0;
#pragma unroll
    for (int c = 0; c < 32; ++c) {
      vh[c] = bf2f(p.hyo()[(size_t)(wid * 32 + c) * TT + tok0 + lane]); vf[c] = bf2f(p.fno()[(size_t)(wid * 32 + c) * TT + tok0 + lane]);
      sh += vh[c] * vh[c]; sf += vf[c] * vf[c];
    }
    part[(0 * 8 + wid) * 64 + lane] = sh; part[(1 * 8 + wid) * 64 + lane] = sf;
    __syncthreads();
    float th = 0, tf = 0;
#pragma unroll
    for (int q = 0; q < 8; ++q) { th += part[(0 * 8 + q) * 64 + lane]; tf += part[(1 * 8 + q) * 64 + lane]; }
    const float rh = rsqrtf(th * (1.f / 256.f) + EPS), rf = rsqrtf(tf * (1.f / 256.f) + EPS);
#pragma unroll
    for (int c = 0; c < 32; ++c) { tile[lane * 520 + wid * 32 + c] = f2bf(vh[c] * rh); tile[lane * 520 + 256 + wid * 32 + c] = f2bf(vf[c] * rf); }
    __syncthreads();
    for (int g = tid; g < 64 * 64; g += NTHR) {
      const int tl = g >> 6, cg = g & 63;
      const u32x4 w = *(const u32x4*)(tile + tl * 520 + cg * 8);
      *(u32x4*)(p.ymix() + (size_t)(tok0 + tl) * DM + (cg < 32 ? 256 + cg * 8 : 768 + (cg - 32) * 8)) = w;
    }
    __syncthreads();
  }
}

struct EpiOut {
  const Params* pp; int layer;
  __device__ __forceinline__ void pre(const G8Unit& u, int, int, float (&)[8], float* cb) const {
    if ((ltid() >> 6) == 0) g8_cload(pp->mod() + ((size_t)layer * 3 + modv(u.pm * 256)) * 6144 + 2 * DM + u.pn * 256, cb);
  }
  __device__ __forceinline__ void operator()(const f32x4 (&acc)[2][2][4][2], const G8Unit& u, int wr, int wc, int fr, int fq, const float (&)[8], const float* cb) const {
    const Params& p = *pp;
#pragma unroll
    for (int bj = 0; bj < 2; ++bj) {
      const int c0 = u.pn * 256 + bj * 128 + wc * 32 + 8 * fq;
      const f32x4 ga = *(const f32x4*)(cb + bj * 128 + wc * 32 + 8 * fq), gb = *(const f32x4*)(cb + bj * 128 + wc * 32 + 8 * fq + 4);
#pragma unroll
      for (int ai = 0; ai < 2; ++ai)
#pragma unroll
        for (int m = 0; m < 4; ++m) {
          const int tok = u.pm * 256 + ai * 128 + wr * 64 + m * 16 + fr;
          u16* xo = p.X() + (size_t)tok * DM + c0;
          f32x4 xa, xb;
          if (layer == 0) { const float* xr = resid_row_in(p, tok) + c0; xa = *(const f32x4*)xr; xb = *(const f32x4*)(xr + 4); }
          else { const u32x4 w = *(const u32x4*)xo;
            xa = f32x4{__uint_as_float(w[0] << 16), __uint_as_float(w[0] & 0xFFFF0000u), __uint_as_float(w[1] << 16), __uint_as_float(w[1] & 0xFFFF0000u)};
            xb = f32x4{__uint_as_float(w[2] << 16), __uint_as_float(w[2] & 0xFFFF0000u), __uint_as_float(w[3] << 16), __uint_as_float(w[3] & 0xFFFF0000u)}; }
          xa = xa + ga * acc[ai][bj][m][0]; xb = xb + gb * acc[ai][bj][m][1];
          *(u32x4*)xo = u32x4{cvtpk(xa[0], xa[1]), cvtpk(xa[2], xa[3]), cvtpk(xb[0], xb[1]), cvtpk(xb[2], xb[3])};
        }
    }
  }
};
__device__ __forceinline__ void phase_gemm_out(const Params& p, int layer, int bid, int nb, char* lds) {
  G8Plain S; S.nM = (layer == 0 ? TT : TL) / 256; S.nN = DM / 256; S.Kb = 2 * DM; S.G = nb; S.c = bid; S.Bt = (const char*)(p.bt_out() + (size_t)layer * DM * DM);
  EpiOut E; E.pp = &p; E.layer = layer;
  gemm8_phase<false>(lds, (const char*)p.ymix(), 2 * DM, S, E);
}

__device__ __forceinline__ void phase_norm2_router(const Params& p, int layer, int bid, int nb, char* lds) {
  float* rwl = (float*)lds;
  int* lcnt = (int*)(lds + 131072);
  int* lbase = lcnt + 32;
  int* ent = lbase + 32;
  float* entw = (float*)(ent + 2 * 640);
  float* ents = entw + 640;
  const int tid = ltid(), wid = tid >> 6, lane = tid & 63;
  const int ntok = layer == 0 ? TT : TL;
  const float* rw = p.router_w() + (size_t)layer * DM * NE;
  for (int i = tid; i < DM * NE / 4; i += NTHR) {
    const int k = i >> 3, q4 = i & 7;
    ((float4*)rwl)[q4 * 1024 + ((k & 3) * 256 + (k >> 2))] = ((const float4*)rw)[i];
  }
  if (tid < 32) lcnt[tid] = 0;
  __syncthreads();
  const float* gn = p.norm2_g() + layer * DM; const float* rb = p.router_b() + layer * NE;
  const int per = (ntok + nb - 1) / nb, t_beg = bid * per, t_end = min(ntok, t_beg + per);
  for (int tok = t_beg + wid; tok < t_end; tok += 8) {
    const u16* xr = p.X() + (size_t)tok * DM;
    float v[16];
#pragma unroll
    for (int i = 0; i < 4; ++i) { const float4 a = ld4bf(xr + lane * 4 + i * 256); v[4 * i] = a.x; v[4 * i + 1] = a.y; v[4 * i + 2] = a.z; v[4 * i + 3] = a.w; }
    float ss = 0;
#pragma unroll
    for (int i = 0; i < 16; ++i) ss += v[i] * v[i];
    ss = wave_sum(ss);
    const float rs = rsqrtf(ss * (1.f / DM) + EPS);
    const float* md = p.mod() + ((size_t)layer * 3 + modv(tok)) * 6144 + 3 * DM;
#pragma unroll
    for (int i = 0; i < 4; ++i) {
      const int c = lane * 4 + i * 256;
      const float4 g = *(const float4*)(gn + c), sh = *(const float4*)(md + c), sc = *(const float4*)(md + DM + c);
      v[4 * i] = v[4 * i] * rs * g.x * (1.f + sc.x) + sh.x; v[4 * i + 1] = v[4 * i + 1] * rs * g.y * (1.f + sc.y) + sh.y;
      v[4 * i + 2] = v[4 * i + 2] * rs * g.z * (1.f + sc.z) + sh.z; v[4 * i + 3] = v[4 * i + 3] * rs * g.w * (1.f + sc.w) + sh.w;
    }
    const float rowsc = store_row_i8(v, p.H() + (size_t)tok * DM, p.hs() + tok, lane);
    float lg[32];
#pragma unroll
    for (int e = 0; e < 32; ++e) lg[e] = 0.f;
#pragma unroll
    for (int i = 0; i < 16; ++i) {
      const float4* wr4 = (const float4*)rwl + ((i & 3) * 256 + (i >> 2) * 64 + lane);
#pragma unroll
      for (int q = 0; q < 8; ++q) { const float4 w = wr4[q * 1024]; lg[4 * q] += v[i] * w.x; lg[4 * q + 1] += v[i] * w.y; lg[4 * q + 2] += v[i] * w.z; lg[4 * q + 3] += v[i] * w.w; }
    }
    float r16[16], r8[8], r4[4], r2[2], lv;
    { const bool up = lane & 32;
#pragma unroll
      for (int e = 0; e < 16; ++e) { const float keep = up ? lg[16 + e] : lg[e], send = up ? lg[e] : lg[16 + e]; r16[e] = keep + shx<32>(send); } }
    { const bool up = lane & 16;
#pragma unroll
      for (int e = 0; e < 8; ++e) { const float keep = up ? r16[8 + e] : r16[e], send = up ? r16[e] : r16[8 + e]; r8[e] = keep + shx<16>(send); } }
    { const bool up = lane & 8;
#pragma unroll
      for (int e = 0; e < 4; ++e) { const float keep = up ? r8[4 + e] : r8[e], send = up ? r8[e] : r8[4 + e]; r4[e] = keep + shx<8>(send); } }
    { const bool up = lane & 4;
#pragma unroll
      for (int e = 0; e < 2; ++e) { const float keep = up ? r4[2 + e] : r4[e], send = up ? r4[e] : r4[2 + e]; r2[e] = keep + shx<4>(send); } }
    { const bool up = lane & 2; const float keep = up ? r2[1] : r2[0], send = up ? r2[0] : r2[1]; lv = keep + shx<2>(send); }
    lv += shx<1>(lv);
    lv += rb[lane >> 1];
    int ids[4]; float vals[4];
#pragma unroll
    for (int k = 0; k < 4; ++k) {
      const float mx = wave_max(lv);
      const unsigned long long bal = __ballot(lv == mx);
      const int win = __ffsll((long long)bal) - 1;
      ids[k] = win >> 1; vals[k] = mx;
      if ((lane >> 1) == ids[k]) lv = -3.4e38f;
    }
    if (lane == 0) {
      const float mx = vals[0];
      float ex[4], sum = 0;
#pragma unroll
      for (int k = 0; k < 4; ++k) { ex[k] = __expf(vals[k] - mx); sum += ex[k]; }
      const float inv = 1.f / sum;
#pragma unroll
      for (int k = 0; k < 4; ++k) {
        const int lp = atomicAdd(&lcnt[ids[k]], 1);
        const int slot = (tok - t_beg) * 4 + k;
        ent[2 * slot] = tok * 4 + k; ent[2 * slot + 1] = (ids[k] << 20) | lp; entw[slot] = ex[k] * inv; ents[slot] = rowsc;
      }
    }
  }
  __syncthreads();
  if (tid < 32) lbase[tid] = atomicAdd(&p.cnt()[layer * NE + tid], lcnt[tid]);
  __syncthreads();
  const int nas = (t_end > t_beg ? (t_end - t_beg) : 0) * 4;
  for (int s = tid; s < nas; s += NTHR) {
    const int tk = ent[2 * s], el = ent[2 * s + 1], e = el >> 20, pos = lbase[e] + (el & 0xFFFFF);
    p.rtok()[(size_t)e * TT + pos] = tk >> 2; p.rw()[(size_t)e * TT + pos] = entw[s]; p.rsc()[(size_t)e * TT + pos] = ents[s];
    p.tslot()[tk] = (e << 20) | pos;
  }
}

struct G8Moe {
  const int* cnt;
  int ntn, Kb, G, c; const char* Bt; size_t bstride;
  const int* rtok;
  __device__ __forceinline__ bool next(int i, G8Unit& u) const {
    const int w = (i * 8 + (c & 7)) * (G >> 3) + (c >> 3); int acc = 0, rows = 0;
    for (int ee = 0; ee < NE; ++ee) {
      const int cc = cnt[ee], tiles = ((cc + 255) >> 8) * ntn;
      if (w < acc + tiles) { const int r = w - acc; u.e = ee; u.pm = r / ntn; u.pn = r % ntn; u.ce = cc; u.pre = rows; return true; }
      acc += tiles; rows += cc;
    }
    return false;
  }
  __device__ __forceinline__ unsigned a_off(const G8Unit& u, int row) const {
    const int r = min(u.pm * 256 + row, u.ce - 1);
    const int arow = rtok ? rtok[(size_t)u.e * TT + r] : u.pre + r;
    return (unsigned)arow * (unsigned)Kb;
  }
  __device__ __forceinline__ const char* b_ptr(const G8Unit& u) const { return Bt + (size_t)u.e * bstride + (size_t)u.pn * 256 * Kb; }
};
struct EpiGu {
  const float* bgl; u16* act; const float* rsc; const float* swl;
  __device__ __forceinline__ void pre(const G8Unit& u, int wr, int fr, float (&ep)[8], float* cb) const {
    if ((ltid() >> 6) == 0) g8_cload(bgl + (size_t)u.e * 2048 + u.pn * 256, cb);
    if ((ltid() >> 6) == 1) g8_cload(swl + (size_t)u.e * 2048 + u.pn * 256, cb + 256);
#pragma unroll
    for (int ai = 0; ai < 2; ++ai)
#pragma unroll
      for (int m = 0; m < 4; ++m) ep[ai * 4 + m] = rsc[(size_t)u.e * TT + min(u.pm * 256 + ai * 128 + wr * 64 + m * 16 + fr, u.ce - 1)];
  }
  __device__ __forceinline__ void operator()(const i32x4 (&acc)[2][2][4][2], const G8Unit& u, int wr, int wc, int fr, int fq, const float (&ep)[8], const float* cb) const {
    const int j0 = u.pn * 128 + wc * 32 + 8 * fq;
    typedef float f2v __attribute__((ext_vector_type(2)));
    const float* bg = cb + 2 * (wc * 32 + 8 * fq);
    f2v bgt[4], bup[4], sg[4], su[4];
#pragma unroll
    for (int q = 0; q < 4; ++q) { const f32x4 t = *(const f32x4*)(bg + 4 * q); bgt[q] = f2v{t[0], t[2]}; bup[q] = f2v{t[1], t[3]}; }
    {
      const float* sp = cb + 256 + wc * 32 + 8 * fq;
      const f32x4 g0 = *(const f32x4*)sp, g1 = *(const f32x4*)(sp + 4), u0 = *(const f32x4*)(sp + 128), u1 = *(const f32x4*)(sp + 132);
      sg[0] = f2v{g0[0], g0[1]}; sg[1] = f2v{g0[2], g0[3]}; sg[2] = f2v{g1[0], g1[1]}; sg[3] = f2v{g1[2], g1[3]};
      su[0] = f2v{u0[0], u0[1]}; su[1] = f2v{u0[2], u0[3]}; su[2] = f2v{u1[0], u1[1]}; su[3] = f2v{u1[2], u1[3]};
    }
    const f2v kexp = f2v{-1.702f * 1.4426950408889634f, -1.702f * 1.4426950408889634f}, one2 = f2v{1.f, 1.f};
#pragma unroll
    for (int ai = 0; ai < 2; ++ai)
#pragma unroll
      for (int m = 0; m < 4; ++m) {
        const int r = u.pm * 256 + ai * 128 + wr * 64 + m * 16 + fr;
        if (r < u.ce) {
          const float sa = ep[ai * 4 + m]; const f2v sa2 = f2v{sa, sa};
          unsigned ow[4];
#pragma unroll
          for (int n = 0; n < 2; ++n)
#pragma unroll
            for (int jp = 0; jp < 2; ++jp) {
              const int q = 2 * n + jp;
              f2v g = f2v{(float)acc[ai][0][m][n][2 * jp], (float)acc[ai][0][m][n][2 * jp + 1]};
              f2v v = f2v{(float)acc[ai][1][m][n][2 * jp], (float)acc[ai][1][m][n][2 * jp + 1]};
              g = (g * sa2) * sg[q] + bgt[q];
              v = (v * sa2) * su[q] + bup[q];
              g = f2v{fminf(g[0], 7.f), fminf(g[1], 7.f)};
              v = f2v{__builtin_amdgcn_fmed3f(v[0], -7.f, 7.f), __builtin_amdgcn_fmed3f(v[1], -7.f, 7.f)};
              const f2v t = g * kexp;
              const f2v d = f2v{__builtin_amdgcn_exp2f(t[0]), __builtin_amdgcn_exp2f(t[1])} + one2;
              const f2v rr = f2v{__builtin_amdgcn_rcpf(d[0]), __builtin_amdgcn_rcpf(d[1])};
              const f2v o = (v * g + g) * rr;
              ow[q] = cvtpk(o[0], o[1]);
            }
          *(u32x4*)(act + (size_t)(u.pre + r) * DFF + j0) = u32x4{ow[0], ow[1], ow[2], ow[3]};
        }
      }
  }
};
struct EpiDn {
  const float* bdl; const float* rw; unsigned char* yd;
  __device__ __forceinline__ void pre(const G8Unit& u, int wr, int fr, float (&ep)[8], float* cb) const {
    if ((ltid() >> 6) == 0) g8_cload(bdl + (size_t)u.e * DM + u.pn * 256, cb);
#pragma unroll
    for (int ai = 0; ai < 2; ++ai)
#pragma unroll
      for (int m = 0; m < 4; ++m) ep[ai * 4 + m] = rw[(size_t)u.e * TT + min(u.pm * 256 + ai * 128 + wr * 64 + m * 16 + fr, u.ce - 1)];
  }
  __device__ __forceinline__ void operator()(const f32x4 (&acc)[2][2][4][2], const G8Unit& u, int wr, int wc, int fr, int fq, const float (&ep)[8], const float* cb) const {
#pragma unroll
    for (int bj = 0; bj < 2; ++bj) {
      const int c0 = u.pn * 256 + bj * 128 + wc * 32 + 8 * fq;
      const f32x4 ba = *(const f32x4*)(cb + bj * 128 + wc * 32 + 8 * fq), bb = *(const f32x4*)(cb + bj * 128 + wc * 32 + 8 * fq + 4);
#pragma unroll
      for (int ai = 0; ai < 2; ++ai)
#pragma unroll
        for (int m = 0; m < 4; ++m) {
          const int r = u.pm * 256 + ai * 128 + wr * 64 + m * 16 + fr;
          if (r < u.ce) {
            const float wgt = ep[ai * 4 + m];
            const float w8 = wgt * 8.f;
            f32x4 a = (acc[ai][bj][m][0] + ba) * w8, b = (acc[ai][bj][m][1] + bb) * w8;
#pragma unroll
            for (int j = 0; j < 4; ++j) { a[j] = fminf(fmaxf(a[j], -440.f), 440.f); b[j] = fminf(fmaxf(b[j], -440.f), 440.f); }
            int w0 = 0, w1 = 0;
            w0 = __builtin_amdgcn_cvt_pk_fp8_f32(a[0], a[1], w0, false); w0 = __builtin_amdgcn_cvt_pk_fp8_f32(a[2], a[3], w0, true);
            w1 = __builtin_amdgcn_cvt_pk_fp8_f32(b[0], b[1], w1, false); w1 = __builtin_amdgcn_cvt_pk_fp8_f32(b[2], b[3], w1, true);
            *(u32x2*)(yd + (size_t)(u.pre + r) * DM + c0) = u32x2{(unsigned)w0, (unsigned)w1};
          }
        }
    }
  }
};
__device__ __forceinline__ void phase_moe_gu(const Params& p, int layer, int bid, int nb, char* lds) {
  int* scnt = (int*)(lds + 131072);
  if (ltid() < NE) scnt[ltid()] = p.cnt()[layer * NE + ltid()];
  __syncthreads();
  G8Moe S; S.cnt = scnt; S.ntn = 8; S.Kb = DM; S.G = nb; S.c = bid; S.Bt = (const char*)(p.bt_gu() + (size_t)layer * NE * 2048 * DM); S.bstride = (size_t)2048 * DM; S.rtok = p.rtok();
  EpiGu E; E.bgl = p.moe_b_gu() + (size_t)layer * NE * 2048; E.act = p.act(); E.rsc = p.rsc(); E.swl = p.swgu() + (size_t)layer * NE * 2048;
  gemm8_phase<true>(lds, (const char*)p.H(), DM, S, E);
}
__device__ __forceinline__ void phase_moe_dn(const Params& p, int layer, int bid, int nb, char* lds) {
  int* scnt = (int*)(lds + 131072);
  if (ltid() < NE) scnt[ltid()] = p.cnt()[layer * NE + ltid()];
  __syncthreads();
  G8Moe S; S.cnt = scnt; S.ntn = 4; S.Kb = 2 * DFF; S.G = nb; S.c = bid; S.Bt = (const char*)(p.bt_dn() + (size_t)layer * NE * DM * DFF); S.bstride = (size_t)DM * DFF * 2; S.rtok = nullptr;
  EpiDn E; E.bdl = p.moe_b_down() + (size_t)layer * NE * DM; E.rw = p.rw(); E.yd = p.yd();
  gemm8_phase<false>(lds, (const char*)p.act(), 2 * DFF, S, E);
}

__device__ __forceinline__ void phase_final(const Params& p, int bid, int nb, char* lds) {
  int* pre = (int*)lds;
  expert_prefix(p.cnt() + NE, pre); __syncthreads();
  const int wid = ltid() >> 6, lane = ltid() & 63;
  for (int tok = bid * 8 + wid; tok < TL; tok += nb * 8) {
    float v[16];
    load_row_comb(p, 1, 1, tok, lane, pre, v);
    float ss = 0;
#pragma unroll
    for (int i = 0; i < 16; ++i) ss += v[i] * v[i];
    ss = wave_sum(ss);
    const float rs = rsqrtf(ss * (1.f / DM) + EPS);
    float* o = p.out() + (size_t)tok * DM;
#pragma unroll
    for (int i = 0; i < 4; ++i) {
      const int c = lane * 4 + i * 256;
      const float4 g = *(const float4*)(p.final_g() + c);
      *(float4*)(o + c) = make_float4(v[4 * i] * rs * g.x, v[4 * i + 1] * rs * g.y, v[4 * i + 2] * rs * g.z, v[4 * i + 3] * rs * g.w);
    }
  }
}

#define XB_TMO      128
#define XB_XCNT(j)  (256  + 64 * (j))
#define XB_XSUB(j)  (1280 + 64 * (j))
#define XB_XGEN(j)  (2304 + 64 * (j))
#define XB_TOP      3328
#define XB_TOPGEN   3392
#define XCD_BAR_WORDS 3456
#define XB_SPIN_CAP (1u << 18)
#define LAS __attribute__((address_space(3)))

__device__ __forceinline__ unsigned xb_ld(unsigned* p)              { return __hip_atomic_load(p, __ATOMIC_RELAXED, __HIP_MEMORY_SCOPE_AGENT); }
__device__ __forceinline__ unsigned xb_add(unsigned* p, unsigned v) { return __hip_atomic_fetch_add(p, v, __ATOMIC_RELAXED, __HIP_MEMORY_SCOPE_AGENT); }
__device__ __forceinline__ unsigned xb_xcc_id() { return (unsigned)__builtin_amdgcn_s_getreg((3 << 11) | 20) & 0xFu; }
#define XB_SPIN(cond, bar) do { unsigned _sp = 0; while (cond) { __builtin_amdgcn_s_sleep(1); \
    if ((++_sp & 255u) == 0u) { if (xb_ld(&(bar)[XB_TMO])) break; if (_sp > XB_SPIN_CAP) { atomicAdd(&(bar)[XB_TMO], 1u); break; } } } } while (0)

struct XcdBarrier {
    unsigned* bar; unsigned x;
    volatile LAS unsigned* st;
};

__device__ __forceinline__ XcdBarrier xcd_barrier_post(unsigned* bar, volatile LAS unsigned* st) {
    XcdBarrier b; b.bar = bar; b.x = xb_xcc_id(); b.st = st;
    if (threadIdx.x == 0) (void)xb_add(&bar[XB_XCNT(b.x)], 1u);
    return b;
}
__device__ __forceinline__ void xcd_barrier_complete(unsigned* bar, unsigned x, unsigned& nloc, unsigned& nx) {
    const unsigned G = gridDim.x * gridDim.y * gridDim.z;
    unsigned sum, cnt, mine, sp = 0u;
    for (;;) {
        sum = 0u; cnt = 0u; mine = 0u;
#pragma unroll
        for (unsigned j = 0; j < 16; ++j) { const unsigned c = xb_ld(&bar[XB_XCNT(j)]); sum += c; cnt += (c > 0u) ? 1u : 0u; mine = (j == x) ? c : mine; }
        if (sum == G) break;
        __builtin_amdgcn_s_sleep(1);
        if ((++sp & 255u) == 0u) { if (xb_ld(&bar[XB_TMO])) break; if (sp > XB_SPIN_CAP) { atomicAdd(&bar[XB_TMO], 1u); break; } }
    }
    nloc = mine > 0u ? mine : 1u; nx = cnt > 0u ? cnt : 1u;
}

__device__ __forceinline__ void xcd_barrier(const XcdBarrier& b) {
    asm volatile("s_waitcnt vmcnt(0)" ::: "memory");
    __syncthreads();
    if (threadIdx.x == 0) {
        unsigned* bar = b.bar;
        __builtin_amdgcn_s_waitcnt(0);
        unsigned nloc = b.st[0], nx = b.st[1];
        if (nloc == 0u) { xcd_barrier_complete(bar, b.x, nloc, nx); b.st[0] = nloc; b.st[1] = nx; }
        const unsigned old = xb_add(&bar[XB_XSUB(b.x)], 1u);
        const unsigned gen = old / nloc;
        if (old + 1u == (gen + 1u) * nloc) {
            __builtin_amdgcn_fence(__ATOMIC_RELEASE, "agent");
            asm volatile("s_waitcnt vmcnt(0)" ::: "memory");
            const unsigned og = xb_add(&bar[XB_TOP], 1u);
            const unsigned tg = og / nx;
            if (og + 1u == (tg + 1u) * nx) xb_add(&bar[XB_TOPGEN], 1u);
            else XB_SPIN(xb_ld(&bar[XB_TOPGEN]) == tg, bar);
            __builtin_amdgcn_fence(__ATOMIC_ACQUIRE, "agent");
            xb_add(&bar[XB_XGEN(b.x)], 1u);
            asm volatile("s_waitcnt vmcnt(0)" ::: "memory");
        } else {
            XB_SPIN(xb_ld(&bar[XB_XGEN(b.x)]) == gen, bar);
            __builtin_amdgcn_fence(__ATOMIC_ACQUIRE, "agent");
            asm volatile("s_waitcnt vmcnt(0)" ::: "memory");
        }
    }
    __syncthreads();
}


constexpr int LDS_MAIN = 147456;
constexpr int LDS_BYTES = LDS_MAIN + 1024;
enum { PH_TABLES = 0, PH_MOD, PH_FOLD, PH_CONVERT, PH_HYMLP, PH_HYFILT, PH_NORM1, PH_GEMM_IN, PH_QKV, PH_ATTN, PH_FFTMIX,
       PH_GLA_A, PH_GLA_B, PH_GLA_C, PH_MIX, PH_GEMM_OUT, PH_NORM2, PH_MOE_GU, PH_MOE_DN, PH_FINAL };

__device__ __forceinline__ Params make_params() {
  const __attribute__((address_space(4))) char* kb = (const __attribute__((address_space(4))) char*)__builtin_amdgcn_kernarg_segment_ptr();
  asm volatile("" : "+s"(kb));
  Params p; p.kb = kb; return p;
}
#ifndef MK_LAUNCHES
#define MK_LAUNCHES 1
#endif
__global__ void __launch_bounds__(NTHR, 2) k_mega(ParamsData pd) {
  extern __shared__ __attribute__((aligned(1024))) char lds[];
  const int bid = blockIdx.x, nb = gridDim.x;
  if (threadIdx.x == 0) *(uint4*)(lds + LDS_MAIN) = make_uint4(0u, 0u, 0u, 0u);
  __syncthreads();
  XcdBarrier bar = xcd_barrier_post(make_params().bar(), (volatile LAS unsigned*)(lds + LDS_MAIN));
#ifndef DBLMASK
#define DBLMASK 0u
#endif
#define RUNPH(bit, call) do { call; if (DBLMASK & (1u << (bit))) { __syncthreads(); call; } } while (0)
  RUNPH(13, phase_tables(make_params(), bid, nb); phase_mod(make_params(), bid, nb, lds); phase_fold(make_params(), bid, nb, lds));
  RUNPH(0, phase_convert(make_params(), bid, nb, lds));
  phase_hy_mlp(make_params(), 0, SEQ, make_params().hfb(), make_params().hpart(), bid, nb, lds);
  phase_hy_mlp(make_params(), 1, SEQ, make_params().hfb() + (size_t)2 * 256 * SEQ, make_params().hpart() + 256 * 512, bid, nb, lds);
  phase_hy_mlp(make_params(), 0, LC, make_params().hfc(), make_params().hpart() + 2 * 256 * 512, bid, nb, lds);
  xcd_barrier(bar);
  RUNPH(2, phase_hy_filtfft(make_params(), bid, nb, lds));
  phase_quant_in(make_params(), bid, nb);
#define MK_LAYER(l) do { \
  phase_norm1(make_params(), l, bid, nb, lds); if ((DBLMASK & (1u << 14)) && l == 0) { __syncthreads(); phase_norm1(make_params(), l, bid, nb, lds); } \
  xcd_barrier(bar); \
  RUNPH(3, phase_gemm_in(make_params(), l, bid, nb, lds)); \
  xcd_barrier(bar); \
  RUNPH(4, phase_qkv(make_params(), l, bid, nb, lds)); \
  RUNPH(5, phase_gla_a(make_params(), l, bid, nb, lds)); \
  RUNPH(7, phase_fftmix(make_params(), l, bid, nb, lds)); \
  xcd_barrier(bar); \
  RUNPH(6, phase_attn(make_params(), l, bid, nb, lds)); \
  RUNPH(9, phase_gla_c(make_params(), l, bid, nb, lds)); \
  RUNPH(10, phase_mix(make_params(), l, bid, nb, lds)); \
  xcd_barrier(bar); \
  phase_gemm_out(make_params(), l, bid, nb, lds); if ((DBLMASK & (1u << 16)) && l == 0) { __syncthreads(); phase_gemm_out(make_params(), l, bid, nb, lds); } \
  xcd_barrier(bar); \
  phase_norm2_router(make_params(), l, bid, nb, lds); \
  xcd_barrier(bar); \
  RUNPH(11, phase_moe_gu(make_params(), l, bid, nb, lds)); \
  xcd_barrier(bar); \
  RUNPH(12, phase_moe_dn(make_params(), l, bid, nb, lds)); \
  xcd_barrier(bar); \
  } while (0)
  MK_LAYER(0);
  MK_LAYER(1);
#undef MK_LAYER
  RUNPH(15, phase_final(make_params(), bid, nb, lds));
}
static size_t carve(char*& cur, size_t bytes) { char* r = cur; cur += (bytes + 1023) & ~(size_t)1023; return (size_t)(uintptr_t)r; }
#define CARVE(T, field, n) p.field = (T*)carve(cur, (size_t)(n) * sizeof(T))

extern "C" void kernel_launch(void* const* d_in, const int* in_sizes, int n_in, void* d_out, int out_size, void* d_ws, size_t ws_size, hipStream_t stream) {
  ParamsData p; memset(&p, 0, sizeof(p));
  const float** ins = (const float**)&p;
  for (int i = 0; i < 34; ++i) ins[i] = (const float*)d_in[i];
  p.out_ = (float*)d_out;
  p.ws_ = (char*)d_ws;
  if (WS_TOTAL > ws_size) { fprintf(stderr, "workspace too small: need %zu have %zu\n", (size_t)WS_TOTAL, ws_size); return; }
  hipMemsetAsync((char*)d_ws + OFF_bar, 0, OFF_mod - OFF_bar, stream);
  static int grid = 0;
  if (!grid) {
    int dev = 0, cus = 0, per_cu = 0;
    hipGetDevice(&dev);
    hipDeviceGetAttribute(&cus, hipDeviceAttributeMultiprocessorCount, dev);
    hipFuncSetAttribute((const void*)k_mega, hipFuncAttributeMaxDynamicSharedMemorySize, LDS_BYTES);
    hipOccupancyMaxActiveBlocksPerMultiprocessor(&per_cu, (const void*)k_mega, NTHR, LDS_BYTES);
    grid = cus * (per_cu < 1 ? per_cu : 1);
    if (grid != 256) fprintf(stderr, "unexpected grid %d (cus %d per_cu %d)\n", grid, cus, per_cu);
  }
  hipLaunchKernelGGL(k_mega, dim3(grid), dim3(NTHR), LDS_BYTES, stream, p);
}
```

```cpp
#include <hip/hip_runtime.h>
#include <hip/hip_bf16.h>
#include <cstdio>
#include <cstdint>
#include <cstring>
#include <cstddef>
#include <type_traits>

typedef unsigned short u16;
using bf16x8 = __attribute__((ext_vector_type(8))) short;
using s16x4  = __attribute__((ext_vector_type(4))) short;
using f32x4  = __attribute__((ext_vector_type(4))) float;
using f32x16 = __attribute__((ext_vector_type(16))) float;
using u32x4  = __attribute__((ext_vector_type(4))) unsigned;
using u32x2  = __attribute__((ext_vector_type(2))) unsigned;

constexpr int DM = 1024, NB = 2, SEQ = 16384, LC = 256;
constexpr int TL = NB * SEQ;
constexpr int TC = NB * LC;
constexpr int TT = TL + TC;
constexpr int NIN = 2816;
constexpr int DIN0 = 2240;
constexpr int NE = 32, TOPK = 4, DFF = 1024;
constexpr int SKV = SEQ + LC;
constexpr int NTHR = 512;
constexpr float EPS = 1e-6f;
constexpr float A_SCALE = 0.10206207261596575f;
constexpr float A_QSCALE = A_SCALE * 1.4426950408889634f;
constexpr int ZG_W = 1152, ZG_GQ = 0, ZG_GK = 128, ZG_KR = 256, ZG_GV = 384, ZG_GP = 640, ZG_OG = 896;
constexpr int ZT_HY = 0, ZT_FR = 768, ZT_FI = 1024, ZT_R = 1280;
constexpr int NCH = 260;
constexpr int FM = 16384;
constexpr int HSP = FM / 2 + 1;

constexpr size_t ws_al(size_t b) { return (b + 1023) & ~(size_t)1023; }
constexpr size_t OFF_bar = 0;
constexpr size_t OFF_cnt = OFF_bar + ws_al((size_t)(4096) * sizeof(unsigned));
constexpr size_t OFF_hssq = OFF_cnt + ws_al((size_t)(64) * sizeof(int));
constexpr size_t OFF_kmx = OFF_hssq + ws_al((size_t)(768) * sizeof(float));
constexpr size_t OFF_mod = OFF_kmx + ws_al((size_t)(128) * sizeof(unsigned));
constexpr size_t OFF_ropec = OFF_mod + ws_al((size_t)(2 * 3 * 6144) * sizeof(float));
constexpr size_t OFF_ropes = OFF_ropec + ws_al((size_t)(SEQ * 16) * sizeof(float));
constexpr size_t OFF_tw = OFF_ropes + ws_al((size_t)(SEQ * 16) * sizeof(float));
constexpr size_t OFF_bt_in = OFF_tw + ws_al((size_t)(FM) * sizeof(float2));
constexpr size_t OFF_bt_qkv = OFF_bt_in + ws_al((size_t)((size_t)2 * NIN * DM) * sizeof(u16));
constexpr size_t OFF_bt_out = OFF_bt_qkv + ws_al((size_t)(2 * 1024 * 384) * sizeof(u16));
constexpr size_t OFF_bt_gu = OFF_bt_out + ws_al((size_t)((size_t)2 * DM * DM) * sizeof(u16));
constexpr size_t OFF_bt_dn = OFF_bt_gu + ws_al((size_t)((size_t)2 * NE * 2048 * DM) * sizeof(u16));
constexpr size_t OFF_hfb = OFF_bt_dn + ws_al((size_t)((size_t)2 * NE * DM * DFF) * sizeof(u16));
constexpr size_t OFF_hfc = OFF_hfb + ws_al((size_t)((size_t)2 * 2 * 256 * SEQ) * sizeof(float));
constexpr size_t OFF_hspec = OFF_hfc + ws_al((size_t)(2 * 256 * LC) * sizeof(float));
constexpr size_t OFF_H = OFF_hspec + ws_al((size_t)((size_t)2 * 256 * HSP) * sizeof(float4));
constexpr size_t OFF_zqkv = OFF_H + ws_al((size_t)((size_t)TT * DM) * sizeof(u16));
constexpr size_t OFF_zg = OFF_zqkv + ws_al((size_t)((size_t)TT * 384) * sizeof(u16));
constexpr size_t OFF_zt = OFF_zg + ws_al((size_t)((size_t)TT * ZG_W) * sizeof(float));
constexpr size_t OFF_Q = OFF_zt + ws_al((size_t)((size_t)ZT_R * TT) * sizeof(float));
constexpr size_t OFF_KV = OFF_Q + ws_al((size_t)((size_t)2 * 4 * SKV * 96) * sizeof(u16));
constexpr size_t OFF_ymix = OFF_KV + ws_al((size_t)((size_t)2 * 4 * SKV * 160) * sizeof(u16));
constexpr size_t OFF_hyo = OFF_ymix + ws_al((size_t)((size_t)TT * DM) * sizeof(u16));
constexpr size_t OFF_fno = OFF_hyo + ws_al((size_t)((size_t)256 * TT) * sizeof(float));
constexpr size_t OFF_glao = OFF_fno + ws_al((size_t)((size_t)256 * TT) * sizeof(float));
constexpr size_t OFF_gds = OFF_glao + ws_al((size_t)((size_t)TT * 256) * sizeof(float));
constexpr size_t OFF_gdv = OFF_gds + ws_al((size_t)((size_t)16 * NCH * 2048) * sizeof(float));
constexpr size_t OFF_gst = OFF_gdv + ws_al((size_t)((size_t)16 * NCH * 32) * sizeof(float));
constexpr size_t OFF_X = OFF_gst + ws_al((size_t)((size_t)16 * NCH * 2048) * sizeof(float));
constexpr size_t OFF_rtok = OFF_X + ws_al((size_t)((size_t)TT * DM) * sizeof(float));
constexpr size_t OFF_rw = OFF_rtok + ws_al((size_t)((size_t)NE * TT) * sizeof(int));
constexpr size_t OFF_tslot = OFF_rw + ws_al((size_t)((size_t)NE * TT) * sizeof(float));
constexpr size_t OFF_act = OFF_tslot + ws_al((size_t)((size_t)TT * 4) * sizeof(int));
constexpr size_t OFF_yd = OFF_act + ws_al((size_t)((size_t)TT * 4 * DFF) * sizeof(u16));
constexpr size_t OFF_swin = OFF_yd + ws_al((size_t)((size_t)TT * 4 * DM) * sizeof(u16));
constexpr size_t OFF_swgu = OFF_swin + ws_al((size_t)(2 * NIN) * sizeof(float));
constexpr size_t OFF_hs = OFF_swgu + ws_al((size_t)(2 * NE * 2048) * sizeof(float));
constexpr size_t OFF_hpart = OFF_hs + ws_al((size_t)(TT) * sizeof(float));
constexpr size_t OFF_rsc = OFF_hpart + ws_al((size_t)(3 * 256 * 512) * sizeof(float));
constexpr size_t WS_TOTAL = OFF_rsc + ws_al((size_t)((size_t)NE * TT) * sizeof(float));
struct ParamsData {
  const float *x_, *c_, *ctx_, *c_ctx_, *ada_w_, *ada_b_, *norm1_g_, *norm2_g_, *w_in_, *mla_q_g_, *mla_w_uq_, *mla_kv_g_, *mla_w_ukv_, *hy_conv_w_, *hy_conv_b_, *hy_w1_, *hy_b1_, *hy_w2_, *hy_b2_, *hy_w3_, *hy_freq_, *hy_bias_, *gla_gk_w_, *gla_gk_b_, *fnet_w_, *mix_g_, *w_out_, *router_w_, *router_b_, *moe_w_gu_, *moe_b_gu_, *moe_w_down_, *moe_b_down_, *final_g_;
  float* out_;
  char* ws_;
};
struct Params {
  const __attribute__((address_space(4))) char* kb;
  template <class T> __device__ __forceinline__ T karg(size_t off) const { return *(const __attribute__((address_space(4))) T*)(kb + off); }
  __device__ __forceinline__ const float* x() const { return karg<const float*>(offsetof(ParamsData, x_)); }
  __device__ __forceinline__ const float* c() const { return karg<const float*>(offsetof(ParamsData, c_)); }
  __device__ __forceinline__ const float* ctx() const { return karg<const float*>(offsetof(ParamsData, ctx_)); }
  __device__ __forceinline__ const float* c_ctx() const { return karg<const float*>(offsetof(ParamsData, c_ctx_)); }
  __device__ __forceinline__ const float* ada_w() const { return karg<const float*>(offsetof(ParamsData, ada_w_)); }
  __device__ __forceinline__ const float* ada_b() const { return karg<const float*>(offsetof(ParamsData, ada_b_)); }
  __device__ __forceinline__ const float* norm1_g() const { return karg<const float*>(offsetof(ParamsData, norm1_g_)); }
  __device__ __forceinline__ const float* norm2_g() const { return karg<const float*>(offsetof(ParamsData, norm2_g_)); }
  __device__ __forceinline__ const float* w_in() const { return karg<const float*>(offsetof(ParamsData, w_in_)); }
  __device__ __forceinline__ const float* mla_q_g() const { return karg<const float*>(offsetof(ParamsData, mla_q_g_)); }
  __device__ __forceinline__ const float* mla_w_uq() const { return karg<const float*>(offsetof(ParamsData, mla_w_uq_)); }
  __device__ __forceinline__ const float* mla_kv_g() const { return karg<const float*>(offsetof(ParamsData, mla_kv_g_)); }
  __device__ __forceinline__ const float* mla_w_ukv() const { return karg<const float*>(offsetof(ParamsData, mla_w_ukv_)); }
  __device__ __forceinline__ const float* hy_conv_w() const { return karg<const float*>(offsetof(ParamsData, hy_conv_w_)); }
  __device__ __forceinline__ const float* hy_conv_b() const { return karg<const float*>(offsetof(ParamsData, hy_conv_b_)); }
  __device__ __forceinline__ const float* hy_w1() const { return karg<const float*>(offsetof(ParamsData, hy_w1_)); }
  __device__ __forceinline__ const float* hy_b1() const { return karg<const float*>(offsetof(ParamsData, hy_b1_)); }
  __device__ __forceinline__ const float* hy_w2() const { return karg<const float*>(offsetof(ParamsData, hy_w2_)); }
  __device__ __forceinline__ const float* hy_b2() const { return karg<const float*>(offsetof(ParamsData, hy_b2_)); }
  __device__ __forceinline__ const float* hy_w3() const { return karg<const float*>(offsetof(ParamsData, hy_w3_)); }
  __device__ __forceinline__ const float* hy_freq() const { return karg<const float*>(offsetof(ParamsData, hy_freq_)); }
  __device__ __forceinline__ const float* hy_bias() const { return karg<const float*>(offsetof(ParamsData, hy_bias_)); }
  __device__ __forceinline__ const float* gla_gk_w() const { return karg<const float*>(offsetof(ParamsData, gla_gk_w_)); }
  __device__ __forceinline__ const float* gla_gk_b() const { return karg<const float*>(offsetof(ParamsData, gla_gk_b_)); }
  __device__ __forceinline__ const float* fnet_w() const { return karg<const float*>(offsetof(ParamsData, fnet_w_)); }
  __device__ __forceinline__ const float* mix_g() const { return karg<const float*>(offsetof(ParamsData, mix_g_)); }
  __device__ __forceinline__ const float* w_out() const { return karg<const float*>(offsetof(ParamsData, w_out_)); }
  __device__ __forceinline__ const float* router_w() const { return karg<const float*>(offsetof(ParamsData, router_w_)); }
  __device__ __forceinline__ const float* router_b() const { return karg<const float*>(offsetof(ParamsData, router_b_)); }
  __device__ __forceinline__ const float* moe_w_gu() const { return karg<const float*>(offsetof(ParamsData, moe_w_gu_)); }
  __device__ __forceinline__ const float* moe_b_gu() const { return karg<const float*>(offsetof(ParamsData, moe_b_gu_)); }
  __device__ __forceinline__ const float* moe_w_down() const { return karg<const float*>(offsetof(ParamsData, moe_w_down_)); }
  __device__ __forceinline__ const float* moe_b_down() const { return karg<const float*>(offsetof(ParamsData, moe_b_down_)); }
  __device__ __forceinline__ const float* final_g() const { return karg<const float*>(offsetof(ParamsData, final_g_)); }
  __device__ __forceinline__ float* out() const { return karg<float*>(offsetof(ParamsData, out_)); }
  __device__ __forceinline__ char* ws() const { return karg<char*>(offsetof(ParamsData, ws_)); }
  __device__ __forceinline__ unsigned* bar() const { return (unsigned*)(ws() + OFF_bar); }
  __device__ __forceinline__ int* cnt() const { return (int*)(ws() + OFF_cnt); }
  __device__ __forceinline__ float* hssq() const { return (float*)(ws() + OFF_hssq); }
  __device__ __forceinline__ unsigned* kmx() const { return (unsigned*)(ws() + OFF_kmx); }
  __device__ __forceinline__ float* mod() const { return (float*)(ws() + OFF_mod); }
  __device__ __forceinline__ float* ropec() const { return (float*)(ws() + OFF_ropec); }
  __device__ __forceinline__ float* ropes() const { return (float*)(ws() + OFF_ropes); }
  __device__ __forceinline__ float2* tw() const { return (float2*)(ws() + OFF_tw); }
  __device__ __forceinline__ signed char* bt_in() const { return (signed char*)(ws() + OFF_bt_in); }
  __device__ __forceinline__ u16* bt_qkv() const { return (u16*)(ws() + OFF_bt_qkv); }
  __device__ __forceinline__ u16* bt_out() const { return (u16*)(ws() + OFF_bt_out); }
  __device__ __forceinline__ signed char* bt_gu() const { return (signed char*)(ws() + OFF_bt_gu); }
  __device__ __forceinline__ u16* bt_dn() const { return (u16*)(ws() + OFF_bt_dn); }
  __device__ __forceinline__ float* hfb() const { return (float*)(ws() + OFF_hfb); }
  __device__ __forceinline__ float* hfc() const { return (float*)(ws() + OFF_hfc); }
  __device__ __forceinline__ float4* hspec() const { return (float4*)(ws() + OFF_hspec); }
  __device__ __forceinline__ signed char* H() const { return (signed char*)(ws() + OFF_H); }
  __device__ __forceinline__ float* hs() const { return (float*)(ws() + OFF_hs); }
  __device__ __forceinline__ float* rsc() const { return (float*)(ws() + OFF_rsc); }
  __device__ __forceinline__ float* hpart() const { return (float*)(ws() + OFF_hpart); }
  __device__ __forceinline__ float* swin() const { return (float*)(ws() + OFF_swin); }
  __device__ __forceinline__ float* swgu() const { return (float*)(ws() + OFF_swgu); }
  __device__ __forceinline__ float* btf() const { return (float*)(ws() + OFF_act); }
  __device__ __forceinline__ u16* zqkv() const { return (u16*)(ws() + OFF_zqkv); }
  __device__ __forceinline__ u16* zg() const { return (u16*)(ws() + OFF_zg); }
  __device__ __forceinline__ u16* zt() const { return (u16*)(ws() + OFF_zt); }
  __device__ __forceinline__ u16* Q() const { return (u16*)(ws() + OFF_Q); }
  __device__ __forceinline__ u16* KV() const { return (u16*)(ws() + OFF_KV); }
  __device__ __forceinline__ u16* ymix() const { return (u16*)(ws() + OFF_ymix); }
  __device__ __forceinline__ u16* hyo() const { return (u16*)(ws() + OFF_hyo); }
  __device__ __forceinline__ u16* fno() const { return (u16*)(ws() + OFF_fno); }
  __device__ __forceinline__ u16* glao() const { return (u16*)(ws() + OFF_glao); }
  __device__ __forceinline__ float* gds() const { return (float*)(ws() + OFF_gds); }
  __device__ __forceinline__ float* gdv() const { return (float*)(ws() + OFF_gdv); }
  __device__ __forceinline__ float* gst() const { return (float*)(ws() + OFF_gst); }
  __device__ __forceinline__ u16* X() const { return (u16*)(ws() + OFF_X); }
  __device__ __forceinline__ int* rtok() const { return (int*)(ws() + OFF_rtok); }
  __device__ __forceinline__ float* rw() const { return (float*)(ws() + OFF_rw); }
  __device__ __forceinline__ int* tslot() const { return (int*)(ws() + OFF_tslot); }
  __device__ __forceinline__ u16* act() const { return (u16*)(ws() + OFF_act); }
  __device__ __forceinline__ unsigned char* yd() const { return (unsigned char*)(ws() + OFF_yd); }
};


__device__ __forceinline__ u16 f2bf(float f) {
  unsigned u = __float_as_uint(f); u += 0x7FFFu + ((u >> 16) & 1u); return (u16)(u >> 16);
}
__device__ __forceinline__ float bf2f(u16 h) { return __uint_as_float(((unsigned)h) << 16); }
__device__ __forceinline__ unsigned cvtpk(float lo, float hi) {
  unsigned r; asm volatile("v_cvt_pk_bf16_f32 %0, %1, %2" : "=v"(r) : "v"(lo), "v"(hi)); return r;
}
#define BF_LO(w) __uint_as_float((w) << 16)
#define BF_HI(w) __uint_as_float((w) & 0xFFFF0000u)
__device__ __forceinline__ float4 ld4bf(const u16* p) { const u32x2 w = *(const u32x2*)p; return make_float4(__uint_as_float(w[0] << 16), __uint_as_float(w[0] & 0xFFFF0000u), __uint_as_float(w[1] << 16), __uint_as_float(w[1] & 0xFFFF0000u)); }
template <int CTRL> __device__ __forceinline__ float dppf(float v) { return __builtin_bit_cast(float, __builtin_amdgcn_update_dpp(0, __builtin_bit_cast(int, v), CTRL, 0xF, 0xF, true)); }
template <int M> __device__ __forceinline__ float shx(float v) {
  if constexpr (M == 1) return dppf<0xB1>(v);
  else if constexpr (M == 2) return dppf<0x4E>(v);
  else if constexpr (M == 4) return dppf<0x1B>(dppf<0x141>(v));
  else if constexpr (M == 8) return dppf<0x141>(dppf<0x140>(v));
  else if constexpr (M == 16) { auto r = __builtin_amdgcn_permlane16_swap(__float_as_uint(v), __float_as_uint(v), false, false);
    return __uint_as_float((__lane_id() & 16) ? r[0] : r[1]); }
  else { auto r = __builtin_amdgcn_permlane32_swap(__float_as_uint(v), __float_as_uint(v), false, false);
    return __uint_as_float((__lane_id() & 32) ? r[0] : r[1]); }
}
__device__ __forceinline__ float wave_sum(float v) {
  v += dppf<0xB1>(v); v += dppf<0x4E>(v); v += dppf<0x141>(v); v += dppf<0x140>(v);
  { auto r = __builtin_amdgcn_permlane16_swap(__float_as_uint(v), __float_as_uint(v), false, false); v = __uint_as_float(r[0]) + __uint_as_float(r[1]); }
  { auto r = __builtin_amdgcn_permlane32_swap(__float_as_uint(v), __float_as_uint(v), false, false); v = __uint_as_float(r[0]) + __uint_as_float(r[1]); }
  return v;
}
__device__ __forceinline__ float wave_max(float v) {
  v = fmaxf(v, dppf<0xB1>(v)); v = fmaxf(v, dppf<0x4E>(v)); v = fmaxf(v, dppf<0x141>(v)); v = fmaxf(v, dppf<0x140>(v));
  { auto r = __builtin_amdgcn_permlane16_swap(__float_as_uint(v), __float_as_uint(v), false, false); v = fmaxf(__uint_as_float(r[0]), __uint_as_float(r[1])); }
  { auto r = __builtin_amdgcn_permlane32_swap(__float_as_uint(v), __float_as_uint(v), false, false); v = fmaxf(__uint_as_float(r[0]), __uint_as_float(r[1])); }
  return v;
}
__device__ __forceinline__ int ltid() { int t = threadIdx.x; asm volatile("" : "+v"(t)); return t; }
__device__ __forceinline__ float silu_f(float x) { return x / (1.f + __expf(-x)); }
__device__ __forceinline__ float2 cmul(float2 a, float2 b) { return make_float2(a.x * b.x - a.y * b.y, a.x * b.y + a.y * b.x); }
__device__ __forceinline__ float2 cmulc(float2 a, float2 b) { return make_float2(a.x * b.x + a.y * b.y, a.y * b.x - a.x * b.y); }
__device__ __forceinline__ int modv(int tok) { return tok < TL ? (tok >> 14) : 2; }
__device__ __forceinline__ void phase_tables(const Params& p, int bid, int nb) {
  const int gt = bid * NTHR + ltid(), gs = nb * NTHR;
  for (int i = gt; i < SEQ * 16; i += gs) {
    const int t = i >> 4, f = i & 15;
    const float pos = (f < 8) ? (float)(t >> 6) : (float)(t & 63);
    const float inv = powf(10000.f, -(float)(f & 7) / 8.f);
    float s, c; sincosf(pos * inv, &s, &c);
    p.ropec()[i] = c; p.ropes()[i] = s;
  }
  for (int i = gt; i < FM; i += gs) {
    float s, c; sincospif((float)i / 8192.f, &s, &c);
    p.tw()[i] = make_float2(c, -s);
  }
}

__device__ __forceinline__ void phase_mod(const Params& p, int bid, int nb, char* lds) {
  float* red = (float*)lds;
  const int tid = ltid(), part = tid >> 6, cl = tid & 63;
  for (int it = bid; it < 2 * 96; it += nb) {
    const int l = it / 96, n = (it % 96) * 64 + cl;
    const float* W = p.ada_w() + (size_t)l * DM * 6144;
    float a0 = 0, a1 = 0, a2 = 0;
    for (int k = part * 128; k < part * 128 + 128; ++k) {
      const float w = W[(size_t)k * 6144 + n];
      a0 += silu_f(p.c()[k]) * w; a1 += silu_f(p.c()[DM + k]) * w; a2 += silu_f(p.c_ctx()[k]) * w;
    }
    red[(part * 3 + 0) * 64 + cl] = a0; red[(part * 3 + 1) * 64 + cl] = a1; red[(part * 3 + 2) * 64 + cl] = a2;
    __syncthreads();
    if (tid < 192) {
      const int v = tid >> 6; float s = 0;
      for (int q = 0; q < 8; ++q) s += red[(q * 3 + v) * 64 + cl];
      p.mod()[((size_t)l * 3 + v) * 6144 + n] = s + p.ada_b()[(size_t)l * 6144 + n];
    }
    __syncthreads();
  }
}

__device__ __forceinline__ void phase_fold(const Params& p, int bid, int nb, char* lds) {
  float* wrow = (float*)lds;
  float* dre = wrow + 2048;
  float* dim_ = dre + 2048;
  float* glr = dim_ + 2048;
  float* cst = glr + 256;
  float* snt = cst + 256;
  const int tid = ltid();
  if (tid < 256) { float sn, cs; sincospif((float)tid / 128.f, &sn, &cs); cst[tid] = cs; snt[tid] = sn; }
  __syncthreads();
  for (int it = bid; it < 2 * DM / 8; it += nb) {
    const int l = it >> 7, k0 = (it & 127) * 8;
    for (int i = tid; i < 8 * 256; i += NTHR) { const int r = i >> 8, c = i & 255; wrow[c * 8 + r] = p.w_in()[((size_t)l * DM + k0 + r) * DIN0 + 1984 + c]; }
    if (tid < 256) { const int r = tid >> 5, c = tid & 31; glr[c * 8 + r] = p.w_in()[((size_t)l * DM + k0 + r) * DIN0 + 1696 + c]; }
    __syncthreads();
    {
      const int kp = tid & 255; const bool im = tid >= 256;
      float acc[8] = {0.f, 0.f, 0.f, 0.f, 0.f, 0.f, 0.f, 0.f};
#pragma unroll 4
      for (int c = 0; c < 256; ++c) {
        const int m = (c * kp) & 255; const float t = im ? -snt[m] : cst[m];
        const float4 w0 = *(const float4*)(wrow + c * 8), w1 = *(const float4*)(wrow + c * 8 + 4);
        acc[0] += w0.x * t; acc[1] += w0.y * t; acc[2] += w0.z * t; acc[3] += w0.w * t; acc[4] += w1.x * t; acc[5] += w1.y * t; acc[6] += w1.z * t; acc[7] += w1.w * t;
      }
      float* d = (im ? dim_ : dre) + kp * 8;
      *(float4*)d = make_float4(acc[0], acc[1], acc[2], acc[3]); *(float4*)(d + 4) = make_float4(acc[4], acc[5], acc[6], acc[7]);
    }
    __syncthreads();
    {
      const int j = tid & 255; const bool im = tid >= 256;
      const float* Wf = p.fnet_w() + (size_t)l * 65536 + j;
      const float* d = im ? dim_ : dre;
      float acc[8] = {0.f, 0.f, 0.f, 0.f, 0.f, 0.f, 0.f, 0.f};
#pragma unroll 8
      for (int kp = 0; kp < 256; ++kp) {
        const float w = Wf[kp * 256];
        const float4 d0 = *(const float4*)(d + kp * 8), d1 = *(const float4*)(d + kp * 8 + 4);
        acc[0] += d0.x * w; acc[1] += d0.y * w; acc[2] += d0.z * w; acc[3] += d0.w * w; acc[4] += d1.x * w; acc[5] += d1.y * w; acc[6] += d1.z * w; acc[7] += d1.w * w;
      }
      float* o = p.btf() + ((size_t)l * NIN + (im ? 2560 : 2304) + j) * DM + k0;
      *(float4*)o = make_float4(acc[0] * 0.0625f, acc[1] * 0.0625f, acc[2] * 0.0625f, acc[3] * 0.0625f);
      *(float4*)(o + 4) = make_float4(acc[4] * 0.0625f, acc[5] * 0.0625f, acc[6] * 0.0625f, acc[7] * 0.0625f);
    }
    if (tid < 256) {
      const int dir = tid >> 7, kk = tid & 127;
      const float* gw = p.gla_gk_w() + ((size_t)l * 2 + dir) * 16 * 128 + kk;
      float acc[8] = {0.f, 0.f, 0.f, 0.f, 0.f, 0.f, 0.f, 0.f};
#pragma unroll
      for (int r16 = 0; r16 < 16; ++r16) {
        const float w = gw[r16 * 128];
        const float4 g0 = *(const float4*)(glr + (dir * 16 + r16) * 8), g1 = *(const float4*)(glr + (dir * 16 + r16) * 8 + 4);
        acc[0] += g0.x * w; acc[1] += g0.y * w; acc[2] += g0.z * w; acc[3] += g0.w * w; acc[4] += g1.x * w; acc[5] += g1.y * w; acc[6] += g1.z * w; acc[7] += g1.w * w;
      }
      float* o = p.btf() + ((size_t)l * NIN + 1024 + tid) * DM + k0;
      *(float4*)o = make_float4(acc[0], acc[1], acc[2], acc[3]); *(float4*)(o + 4) = make_float4(acc[4], acc[5], acc[6], acc[7]);
    }
    __syncthreads();
  }
}

enum { MAP_ID = 0, MAP_IN = 1, MAP_UQ = 2, MAP_UKV = 3, MAP_GU = 4 };
__device__ __forceinline__ int colmap(int mt, int n) {
  switch (mt) {
    case MAP_ID: return n;
    case MAP_IN:
      if (n < 256) return n;
      if (n < 384) return 256 + (n - 256);
      if (n < 512) return 1184 + (n - 384);
      if (n < 640) return 1312 + (n - 512);
      if (n < 672) return 384 + (n - 640);
      if (n < 768) return -1;
      if (n < 1024) return 1440 + (n - 768);
      if (n < 1280) return -2;
      if (n < 1536) return 1728 + (n - 1280);
      if (n < 2304) return 416 + (n - 1536);
      return -2;
    case MAP_UQ:
      if (n < 256) return (n >> 6) * 96 + (n & 63);
      if (n < 384) return ((n - 256) >> 5) * 96 + 64 + ((n - 256) & 31);
      return -1;
    case MAP_UKV:
      if (n < 256) return (n >> 6) * 128 + (n & 63);
      return ((n - 256) >> 6) * 128 + 64 + ((n - 256) & 63);
    default: {
      const int pn = n >> 8, w = n & 255;
      return w < 128 ? 2 * (pn * 128 + w) : 2 * (pn * 128 + w - 128) + 1;
    }
  }
}
__device__ __forceinline__ int invmap(int mt, int sc) {
  if (mt == MAP_ID) return sc;
  if (mt == MAP_GU) { const int j = sc >> 1, t = sc & 1; return (j >> 7) * 256 + t * 128 + (j & 127); }
  if (sc < 384) return sc;
  if (sc < 416) return 640 + (sc - 384);
  if (sc < 1184) return 1536 + (sc - 416);
  if (sc < 1312) return 384 + (sc - 1184);
  if (sc < 1440) return 512 + (sc - 1312);
  if (sc < 1696) return 768 + (sc - 1440);
  if (sc < 1728) return -1;
  if (sc < 1984) return 1280 + (sc - 1728);
  return -1;
}
struct ConvJob { const float* src; void* dst; const float* scale; int ld, K, mt, k0, s0, f32; };
__device__ __forceinline__ void conv_tile_load(const ConvJob& J, int tid, float4 (&v)[4]) {
  const int kk = tid >> 5, s4 = (tid & 31) * 4;
#pragma unroll
  for (int i = 0; i < 4; ++i) {
    v[i] = make_float4(0.f, 0.f, 0.f, 0.f);
    if (J.s0 + s4 < J.ld) v[i] = *(const float4*)(J.src + (size_t)(J.k0 + kk + 16 * i) * J.ld + J.s0 + s4);
  }
}
__device__ __forceinline__ void conv_tile_proc(const ConvJob& J, int tid, const float4 (&v)[4], float* tile  ) {
  {
    const int kk = tid >> 5, s4 = (tid & 31) * 4;
#pragma unroll
    for (int i = 0; i < 4; ++i) {
      const float sc = J.scale ? J.scale[J.k0 + kk + 16 * i] : 1.f;
      float* t = tile + (kk + 16 * i) * 129 + s4;
      t[0] = v[i].x * sc; t[1] = v[i].y * sc; t[2] = v[i].z * sc; t[3] = v[i].w * sc;
    }
  }
  __syncthreads();
#pragma unroll
  for (int h = 0; h < 2; ++h) {
    const int sl = (tid >> 3) + 64 * h, ks = (tid & 7) * 8, sc = J.s0 + sl;
    const int row = sc < J.ld ? invmap(J.mt, sc) : -1;
    if (row >= 0) {
      const float* t = tile + ks * 129 + sl;
      if (J.f32) {
        float* dst = (float*)J.dst + (size_t)row * J.K + J.k0 + ks;
        *(float4*)dst = make_float4(t[0], t[129], t[2 * 129], t[3 * 129]); *(float4*)(dst + 4) = make_float4(t[4 * 129], t[5 * 129], t[6 * 129], t[7 * 129]);
      } else {
        u32x4 w;
        w[0] = cvtpk(t[0], t[129]); w[1] = cvtpk(t[2 * 129], t[3 * 129]); w[2] = cvtpk(t[4 * 129], t[5 * 129]); w[3] = cvtpk(t[6 * 129], t[7 * 129]);
        *(u32x4*)((u16*)J.dst + (size_t)row * J.K + J.k0 + ks) = w;
      }
    }
  }
  __syncthreads();
}
constexpr int CT_IN = 16 * 18, CT_OUT = 16 * 8, CT_DN = NE * 128, CT_L = CT_IN + CT_OUT + CT_DN;
__device__ __forceinline__ void conv_decode(const Params& p, int t, ConvJob& J) {
  const int l = t / CT_L; int r = t % CT_L;
  if (r < CT_IN) { J.src = p.w_in() + (size_t)l * DM * DIN0; J.ld = DIN0; J.K = DM; J.dst = p.btf() + (size_t)l * NIN * DM; J.mt = MAP_IN; J.scale = nullptr; J.k0 = (r / 18) * 64; J.s0 = (r % 18) * 128; J.f32 = 1; return; }
  r -= CT_IN;
  if (r < CT_OUT) { J.src = p.w_out() + (size_t)l * DM * DM; J.ld = DM; J.K = DM; J.dst = p.bt_out() + (size_t)l * DM * DM; J.mt = MAP_ID; J.scale = p.mix_g() + l * DM; J.k0 = (r / 8) * 64; J.s0 = (r % 8) * 128; J.f32 = 0; return; }
  r -= CT_OUT;
  const int e = r >> 7, q = r & 127;
  J.src = p.moe_w_down() + ((size_t)l * NE + e) * DFF * DM; J.ld = DM; J.K = DFF; J.dst = p.bt_dn() + ((size_t)l * NE + e) * DM * DFF; J.mt = MAP_ID; J.scale = nullptr; J.k0 = (q >> 3) * 64; J.s0 = (q & 7) * 128; J.f32 = 0;
}
__device__ __forceinline__ void conv_gu8_load(const float* __restrict__ src  , int s0, int tid, float4 (&v)[16]) {
  const int c4 = (tid & 7) * 4, r0 = tid >> 3;
#pragma unroll
  for (int pss = 0; pss < 16; ++pss) v[pss] = *(const float4*)(src + (size_t)(r0 + 64 * pss) * 2048 + s0 + c4);
}
__device__ __forceinline__ void conv_gu8_proc(const float4 (&v)[16], signed char* __restrict__ dst  , float* __restrict__ sw  ,
                                              int s0, float* tile  , int tid) {
  float* cmax = tile + 1024 * 33;
  {
    const int c4 = (tid & 7) * 4, r0 = tid >> 3;
#pragma unroll
    for (int pss = 0; pss < 16; ++pss) { float* t = tile + (r0 + 64 * pss) * 33 + c4; t[0] = v[pss].x; t[1] = v[pss].y; t[2] = v[pss].z; t[3] = v[pss].w; }
  }
  __syncthreads();
  {
    const int col = tid & 31, part = tid >> 5; float m = 0.f;
#pragma unroll 8
    for (int k = part * 64; k < part * 64 + 64; ++k) m = fmaxf(m, fabsf(tile[k * 33 + col]));
    cmax[part * 32 + col] = m;
  }
  __syncthreads();
  if (tid < 32) {
    float m = 0.f;
#pragma unroll
    for (int q = 0; q < 16; ++q) m = fmaxf(m, cmax[q * 32 + tid]);
    const float sc = fmaxf(m, 1e-20f) * (1.f / 127.f);
    cmax[512 + tid] = sc;
    sw[invmap(MAP_GU, s0 + tid)] = sc;
  }
  __syncthreads();
#pragma unroll
  for (int h = 0; h < 4; ++h) {
    const int g = tid + 512 * h, col = g & 31, k0 = (g >> 5) * 16;
    const float inv = 1.f / cmax[512 + col];
    unsigned w[4];
#pragma unroll
    for (int q = 0; q < 4; ++q) {
      const float* t = tile + (k0 + 4 * q) * 33 + col;
      const int q0 = (int)rintf(t[0] * inv), q1 = (int)rintf(t[33] * inv), q2 = (int)rintf(t[66] * inv), q3 = (int)rintf(t[99] * inv);
      w[q] = (unsigned)(q0 & 255) | ((unsigned)(q1 & 255) << 8) | ((unsigned)(q2 & 255) << 16) | ((unsigned)(q3 & 255) << 24);
    }
    *(u32x4*)(dst + (size_t)invmap(MAP_GU, s0 + col) * DM + k0) = u32x4{w[0], w[1], w[2], w[3]};
  }
  __syncthreads();
}
__device__ __forceinline__ void phase_convert(const Params& p, int bid, int nb, char* lds) {
  float* tile = (float*)lds;
  const int tid = ltid();
  {
    ConvJob J, Jn; float4 v[4], vn[4];
    int t = bid;
    if (t < 2 * CT_L) { conv_decode(p, t, J); conv_tile_load(J, tid, v); }
    for (; t < 2 * CT_L; t += nb) {
      const bool more = t + nb < 2 * CT_L;
      if (more) { conv_decode(p, t + nb, Jn); conv_tile_load(Jn, tid, vn); }
      conv_tile_proc(J, tid, v, tile);
      if (more) { J = Jn;
#pragma unroll
        for (int i = 0; i < 4; ++i) v[i] = vn[i]; }
    }
  }
  {
    float4 v[16], vn[16];
    int t = bid;
    if (t < 2 * NE * 64) conv_gu8_load(p.moe_w_gu() + (size_t)(t >> 6) * DM * 2048, (t & 63) * 32, tid, v);
    for (; t < 2 * NE * 64; t += nb) {
      const bool more = t + nb < 2 * NE * 64; const int tn = t + nb;
      if (more) conv_gu8_load(p.moe_w_gu() + (size_t)(tn >> 6) * DM * 2048, (tn & 63) * 32, tid, vn);
      conv_gu8_proc(v, p.bt_gu() + (size_t)(t >> 6) * 2048 * DM, p.swgu() + (size_t)(t >> 6) * 2048, (t & 63) * 32, tile, tid);
      if (more) {
#pragma unroll
        for (int i = 0; i < 16; ++i) v[i] = vn[i]; }
    }
  }
  for (int l = 0; l < 2; ++l) {
    for (int i = bid * NTHR + tid; i < 96 * DM / 4; i += nb * NTHR) *(float4*)(p.btf() + ((size_t)l * NIN + 672) * DM + (size_t)i * 4) = make_float4(0.f, 0.f, 0.f, 0.f);
    {
      const float* wq = p.mla_w_uq() + (size_t)l * 256 * 384; const float* wkv = p.mla_w_ukv() + (size_t)l * 128 * 512;
      const float* gq = p.mla_q_g() + l * 256; const float* gkv = p.mla_kv_g() + l * 128;
      u16* dst = p.bt_qkv() + (size_t)l * 1024 * 384;
      for (int i = bid * NTHR + ltid(); i < 1024 * 384; i += nb * NTHR) {
        const int n = i / 384, k = i % 384; float v = 0.f;
        if (n < 512) { const int sc = colmap(MAP_UQ, n); if (k < 256 && sc >= 0) v = gq[k] * wq[k * 384 + sc]; }
        else { if (k >= 256) v = gkv[k - 256] * wkv[(k - 256) * 512 + colmap(MAP_UKV, n - 512)]; }
        dst[i] = f2bf(v);
      }
    }
  }
}

__device__ __forceinline__ void phase_hy_mlp(const Params& p, int l, int Lf, float* __restrict__ hout  , float* __restrict__ ssq  ,
                             int bid, int nb, char* lds) {
  float* zf = (float*)lds;
  float* h1 = zf + 64 * 33;
  float* h2 = h1 + 64 * 64;
  const int tid = ltid();
  const float* w1 = p.hy_w1() + (size_t)l * 33 * 64; const float* b1 = p.hy_b1() + l * 64;
  const float* w2 = p.hy_w2() + (size_t)l * 64 * 64; const float* b2 = p.hy_b2() + l * 64;
  const float* w3 = p.hy_w3() + (size_t)l * 64 * 512; const float* fr = p.hy_freq() + l * 64;
  float w3c[64];
#pragma unroll
  for (int k = 0; k < 64; ++k) w3c[k] = w3[k * 512 + tid];
  const int dir = tid >> 8, ch = tid & 255;
  const float maxd = logf(1e-2f) / 0.3f, mind = logf(1e-2f) / 1.5f;
  const float delta = fabsf(mind + (maxd - mind) * (float)ch / 255.f);
  float ssq_acc = 0.f;
  for (int it = bid; it < Lf / 64; it += nb) {
    const int t0 = it * 64;
    for (int i = tid; i < 64 * 33; i += NTHR) {
      const int tt = i / 33, f = i % 33, t = t0 + tt;
      float v;
      if (f == 0) v = (float)t / (float)(Lf - 1);
      else {
        const int j = (f - 1) & 15;
        const float fj = 1e-4f + (float)j * ((15.f - 1e-4f) / 15.f);
        const float w = 6.283185307179586f * (float)t / (float)Lf;
        v = (f <= 16) ? cosf(fj * w) : -sinf(fj * w);
      }
      zf[i] = v;
    }
    __syncthreads();
    {
      const int o = tid & 63, tb = tid >> 6;
      float acc[8];
#pragma unroll
      for (int j = 0; j < 8; ++j) acc[j] = b1[o];
#pragma unroll 3
      for (int f = 0; f < 33; ++f) {
        const float w = w1[f * 64 + o];
#pragma unroll
        for (int j = 0; j < 8; ++j) acc[j] += zf[(tb + 8 * j) * 33 + f] * w;
      }
      const float fo = fr[o];
#pragma unroll
      for (int j = 0; j < 8; ++j) h1[(tb + 8 * j) * 64 + o] = sinf(fo * acc[j]);
    }
    __syncthreads();
    {
      const int o = tid & 63, tb = tid >> 6;
      float acc[8];
#pragma unroll
      for (int j = 0; j < 8; ++j) acc[j] = b2[o];
#pragma unroll 4
      for (int f = 0; f < 64; f += 4) {
        const float wa = w2[f * 64 + o], wb = w2[(f + 1) * 64 + o], wc2 = w2[(f + 2) * 64 + o], wd = w2[(f + 3) * 64 + o];
#pragma unroll
        for (int j = 0; j < 8; ++j) { const float4 hv = *(const float4*)(h1 + (tb + 8 * j) * 64 + f); acc[j] += hv.x * wa + hv.y * wb + hv.z * wc2 + hv.w * wd; }
      }
      const float fo = fr[o];
#pragma unroll
      for (int j = 0; j < 8; ++j) h2[(tb + 8 * j) * 64 + o] = sinf(fo * acc[j]);
    }
    __syncthreads();
    float* orow = hout + ((size_t)dir * 256 + ch) * Lf + t0;
    for (int tq = 0; tq < 16; ++tq) {
      float sv[4];
#pragma unroll
      for (int u = 0; u < 4; ++u) {
        const int tt = tq * 4 + u;
        float s = 0;
#pragma unroll
        for (int k = 0; k < 64; k += 4) { const float4 hv = *(const float4*)(h2 + tt * 64 + k); s += hv.x * w3c[k] + hv.y * w3c[k + 1] + hv.z * w3c[k + 2] + hv.w * w3c[k + 3]; }
        const int t = t0 + tt;
        s *= __expf(-((float)t / (float)(Lf - 1)) * delta);
        if (dir == 0 || t > 0) ssq_acc += s * s;
        sv[u] = s;
      }
      *(float4*)(orow + tq * 4) = make_float4(sv[0], sv[1], sv[2], sv[3]);
    }
    __syncthreads();
  }
  ssq[(size_t)bid * 512 + tid] = ssq_acc;
}

__host__ __device__ constexpr int fx(int p) {
  return ((p >> 12) & 3) ^ (((p >> 10) & 3) << 2) ^ ((p >> 4) & 16) ^ (((p >> 5) & 1) * 5) ^ (((p >> 6) & 1) * 26);
}
__device__ __forceinline__ int swz(int p) { return p ^ fx(p); }
__device__ __forceinline__ int rev7(int k) {
  unsigned r = __brev((unsigned)k) >> 18;
  return (int)(((r & 0x2AAAu) >> 1) | ((r & 0x1555u) << 1));
}
template <int ST, bool INV>
__device__ __forceinline__ void fft_stage(float2* s, const float2* __restrict__ tw, const int tid) {
  constexpr int sh = 12 - 2 * ST, q = 1 << sh, ND = q >= 512 ? q / 512 : 1;
  float2 w1[ND], w2[ND], w3[ND];
  if constexpr (ST < 6) {
#pragma unroll
    for (int d = 0; d < ND; ++d) {
      const int j = q >= 512 ? tid + 512 * d : (tid & (q - 1)), ti = j << (2 * ST);
      w1[d] = tw[ti]; w2[d] = tw[2 * ti]; w3[d] = tw[3 * ti];
    }
  }
  float2 x[8][4];
#pragma unroll
  for (int m = 0; m < 8; ++m) {
    const int u = tid + 512 * m, g = u >> sh, j = u & (q - 1), base = (g << (sh + 2)) + j, xb = fx(base);
    x[m][0] = s[base ^ xb]; x[m][1] = s[(base + q) ^ xb ^ fx(q)]; x[m][2] = s[(base + 2 * q) ^ xb ^ fx(2 * q)]; x[m][3] = s[(base + 3 * q) ^ xb ^ fx(3 * q)];
  }
#pragma unroll
  for (int m = 0; m < 8; ++m) {
    const int u = tid + 512 * m, g = u >> sh, j = u & (q - 1), base = (g << (sh + 2)) + j, xb = fx(base);
    const int i0 = base ^ xb, i1 = (base + q) ^ xb ^ fx(q), i2 = (base + 2 * q) ^ xb ^ fx(2 * q), i3 = (base + 3 * q) ^ xb ^ fx(3 * q);
    const int d = q >= 512 ? (m % ND) : 0;
    if constexpr (!INV) {
      const float2 a0 = x[m][0], a1 = x[m][1], a2 = x[m][2], a3 = x[m][3];
      const float2 b0 = make_float2(a0.x + a2.x, a0.y + a2.y), b1 = make_float2(a0.x - a2.x, a0.y - a2.y);
      const float2 b2 = make_float2(a1.x + a3.x, a1.y + a3.y), b3 = make_float2(a1.x - a3.x, a1.y - a3.y);
      const float2 y1 = make_float2(b1.x + b3.y, b1.y - b3.x), y2 = make_float2(b0.x - b2.x, b0.y - b2.y), y3 = make_float2(b1.x - b3.y, b1.y + b3.x);
      s[i0] = make_float2(b0.x + b2.x, b0.y + b2.y);
      if constexpr (ST < 6) { s[i1] = cmul(y1, w1[d]); s[i2] = cmul(y2, w2[d]); s[i3] = cmul(y3, w3[d]); }
      else { s[i1] = y1; s[i2] = y2; s[i3] = y3; }
    } else {
      float2 t0 = x[m][0], t1 = x[m][1], t2 = x[m][2], t3 = x[m][3];
      if constexpr (ST < 6) { t1 = cmulc(t1, w1[d]); t2 = cmulc(t2, w2[d]); t3 = cmulc(t3, w3[d]); }
      const float2 b0 = make_float2(t0.x + t2.x, t0.y + t2.y), b1 = make_float2(t0.x - t2.x, t0.y - t2.y);
      const float2 b2 = make_float2(t1.x + t3.x, t1.y + t3.y), b3 = make_float2(t1.x - t3.x, t1.y - t3.y);
      s[i0] = make_float2(b0.x + b2.x, b0.y + b2.y);
      s[i1] = make_float2(b1.x - b3.y, b1.y + b3.x);
      s[i2] = make_float2(b0.x - b2.x, b0.y - b2.y);
      s[i3] = make_float2(b1.x + b3.y, b1.y - b3.x);
    }
  }
  __syncthreads();
}
__device__ __forceinline__ void fft_fwd(float2* s, const float2* __restrict__ tw) {
  const int tid = ltid();
  fft_stage<0, false>(s, tw, tid); fft_stage<1, false>(s, tw, tid); fft_stage<2, false>(s, tw, tid); fft_stage<3, false>(s, tw, tid);
  fft_stage<4, false>(s, tw, tid); fft_stage<5, false>(s, tw, tid); fft_stage<6, false>(s, tw, tid);
}
__device__ __forceinline__ void fft_inv(float2* s, const float2* __restrict__ tw) {
  const int tid = ltid();
  fft_stage<6, true>(s, tw, tid); fft_stage<5, true>(s, tw, tid); fft_stage<4, true>(s, tw, tid); fft_stage<3, true>(s, tw, tid);
  fft_stage<2, true>(s, tw, tid); fft_stage<1, true>(s, tw, tid); fft_stage<0, true>(s, tw, tid);
}

__device__ __forceinline__ float filt_ssq(const float* __restrict__ part  , int ch, float* red  ) {
  const int tid = ltid();
  float v = part[(size_t)(tid >> 1) * 512 + (tid & 1) * 256 + ch];
  v = wave_sum(v);
  __syncthreads();
  if ((tid & 63) == 0) red[tid >> 6] = v;
  __syncthreads();
  return ((red[0] + red[1]) + (red[2] + red[3])) + ((red[4] + red[5]) + (red[6] + red[7]));
}
__device__ __forceinline__ void phase_hy_filtfft(const Params& p, int bid, int nb, char* lds) {
  float2* s = (float2*)lds;
  const int tid = ltid();
  for (int it = bid; it < 512; it += nb) {
    const int l = it >> 8, ch = it & 255;
    const float* hf = p.hfb() + (((size_t)l * 2 + 0) * 256 + ch) * SEQ;
    const float* hb = p.hfb() + (((size_t)l * 2 + 1) * 256 + ch) * SEQ;
#pragma unroll 8
    for (int m = tid; m < FM; m += NTHR) {
      const int n0 = 2 * m, n1 = 2 * m + 1;
      const float a = (n0 < SEQ) ? hf[n0] : (n0 == SEQ ? 0.f : hb[2 * SEQ - n0]);
      const float b = (n1 < SEQ) ? hf[n1] : hb[2 * SEQ - n1];
      s[swz(m)] = make_float2(a, b);
    }
    __syncthreads();
    fft_fwd(s, p.tw());
    const float sc = rsqrtf(filt_ssq(p.hpart() + (size_t)l * 256 * 512, ch, (float*)(lds + 139264))) * (1.f / 16384.f);
    float4* out = p.hspec() + ((size_t)l * 256 + ch) * HSP;
#pragma unroll 4
    for (int k = tid; k <= FM / 2; k += NTHR) {
      const float2 zk = s[swz(rev7(k))], zm = s[swz(rev7((FM - k) & (FM - 1)))];
      const float er = 0.5f * (zk.x + zm.x), ei = 0.5f * (zk.y - zm.y);
      const float dr = 0.5f * (zk.x - zm.x), di = 0.5f * (zk.y + zm.y);
      out[k] = make_float4(er * sc, ei * sc, di * sc, -dr * sc);
    }
    __syncthreads();
  }
}
constexpr int G_TILE_B = 256 * 64 * 2;
constexpr int G_STAGE_B = 2 * G_TILE_B;
constexpr int GEMM_LDS = 2 * G_STAGE_B;

__device__ __forceinline__ int lds_byte2(int r, int c) {
  const int st = (r >> 4) * 2 + (c >> 5), ob = (r & 15) * 64 + (c & 31) * 2;
  return st * 1024 + (ob ^ (((ob >> 9) & 1) << 5));
}
__device__ __forceinline__ void stage_rc2(int b, int& R, int& C) {
  const int st = b >> 10, sb = b & 1023, swz = sb ^ (((sb >> 9) & 1) << 5);
  R = (st >> 1) * 16 + (swz >> 6);
  C = (st & 1) * 32 + ((swz & 63) >> 1);
}
__device__ __forceinline__ void gemm_stage_coords(int (&sR)[4], int (&sC)[4]) {
  const int wid = ltid() >> 6, lane = ltid() & 63;
#pragma unroll
  for (int i = 0; i < 4; ++i) stage_rc2(wid * 1024 + i * 8192 + lane * 16, sR[i], sC[i]);
}

#define WAIT_V0() asm volatile("s_waitcnt vmcnt(0)" ::: "memory")

__device__ __forceinline__ void gemm256_core(const u16* const (&ap)[4], const u16* const (&bp)[4], int nt, char* shm, f32x4 (&acc)[8][4]) {
  const int tid = ltid(), wid = tid >> 6, lane = tid & 63, wr = wid >> 2, wc = wid & 3, fr = lane & 15, fq = lane >> 4;
#pragma unroll
  for (int m = 0; m < 8; ++m)
#pragma unroll
    for (int n = 0; n < 4; ++n) acc[m][n] = f32x4{0.f, 0.f, 0.f, 0.f};
#define G_SA(b) (shm + (b) * G_STAGE_B)
#define G_SB(b) (shm + (b) * G_STAGE_B + G_TILE_B)
#define G_STAGE(buf, kt) do { _Pragma("unroll") for (int i = 0; i < 4; ++i) {                                                   \
    __builtin_amdgcn_global_load_lds((const unsigned*)(ap[i] + (kt) * 64), (unsigned*)(G_SA(buf) + wid * 1024 + i * 8192), 16, 0, 0); \
    __builtin_amdgcn_global_load_lds((const unsigned*)(bp[i] + (kt) * 64), (unsigned*)(G_SB(buf) + wid * 1024 + i * 8192), 16, 0, 0); } } while (0)
  G_STAGE(0, 0); WAIT_V0(); __syncthreads();
#pragma unroll 1
  for (int t = 0; t < nt; ++t) {
    const int cur = t & 1;
    if (t + 1 < nt) G_STAGE(cur ^ 1, t + 1);
#pragma unroll
    for (int ks = 0; ks < 2; ++ks) {
      bf16x8 At[8], Bf[4];
#pragma unroll
      for (int m = 0; m < 8; ++m) At[m] = *(const bf16x8*)(G_SA(cur) + lds_byte2(wr * 128 + m * 16 + fr, ks * 32 + fq * 8));
#pragma unroll
      for (int n = 0; n < 4; ++n) Bf[n] = *(const bf16x8*)(G_SB(cur) + lds_byte2(wc * 64 + n * 16 + fr, ks * 32 + fq * 8));
#pragma unroll
      for (int m = 0; m < 8; ++m)
#pragma unroll
        for (int n = 0; n < 4; ++n) acc[m][n] = __builtin_amdgcn_mfma_f32_16x16x32_bf16(At[m], Bf[n], acc[m][n], 0, 0, 0);
      __builtin_amdgcn_sched_barrier(0);
    }
    WAIT_V0(); __syncthreads();
  }
#undef G_STAGE
}

#define LAS3 __attribute__((address_space(3)))
constexpr int G8_HTB = 128 * 64 * 2;
__device__ __forceinline__ int g8_perm32(int rho) { const int n = rho >> 4, i = rho & 15; return 8 * (i >> 2) + 4 * n + (i & 3); }
__device__ __forceinline__ int g8_lds_byte(int r, int c) { const int st = (r >> 4) * 2 + (c >> 5), rr = r & 15, cc = c & 31, ob = rr * 64 + cc * 2; return st * 1024 + (ob ^ (((ob >> 9) & 1) << 5)); }
__device__ __forceinline__ void g8_stage_rc(int b, int& R, int& C) { const int st = b / 1024, sb = b % 1024, swz = sb ^ (((sb >> 9) & 1) << 5); R = (st >> 1) * 16 + swz / 64; C = (st & 1) * 32 + (swz % 64) / 2; }
struct G8Unit { int pm, pn, e, ce, pre; };
__device__ __forceinline__ void g8_cload(const float* __restrict__ src, float* dst) {
  __builtin_amdgcn_global_load_lds((const unsigned*)(src + (ltid() & 63) * 4), (LAS3 unsigned*)dst, 16, 0, 0);
}


template <bool I8> __device__ __forceinline__ typename std::conditional<I8, int __attribute__((ext_vector_type(4))), f32x4>::type
g8_mma(bf16x8 x, bf16x8 y, typename std::conditional<I8, int __attribute__((ext_vector_type(4))), f32x4>::type c) {
  if constexpr (I8) { typedef int v4i __attribute__((ext_vector_type(4))); return __builtin_amdgcn_mfma_i32_16x16x64_i8(*(v4i*)&x, *(v4i*)&y, c, 0, 0, 0); }
  else return __builtin_amdgcn_mfma_f32_16x16x32_bf16(x, y, c, 0, 0, 0);
}
typedef int i32x4 __attribute__((ext_vector_type(4)));
template <bool I8> struct G8Acc { typedef f32x4 T; };
template <> struct G8Acc<true> { typedef i32x4 T; };
template <bool I8, class Sched, class Epi>
__device__ __forceinline__ void gemm8_phase(char* lds_g, const char* Abase, const int Kb, const Sched& S, const Epi& E) {
    typedef typename G8Acc<I8>::T ACC;
    LAS3 unsigned char* lds = (LAS3 unsigned char*)lds_g;
    const int tid = ltid(), wid = __builtin_amdgcn_readfirstlane(tid >> 6), lane = tid & 63, wr = wid >> 2, wc = wid & 3, fr = lane & 15, fq = lane >> 4;
    const int nt = Kb / 128;
    int sRr[2], sCc[2]; unsigned voffB[2];
#pragma unroll
    for (int i = 0; i < 2; ++i) { g8_stage_rc(tid * 16 + i * 8192, sRr[i], sCc[i]); const int Rb = (sRr[i] & ~31) + g8_perm32(sRr[i] & 31); voffB[i] = (unsigned)(Rb * Kb) + (unsigned)sCc[i] * 2u; }
    const size_t kstep = 128;
    const size_t hstepB = (size_t)128 * Kb;
    const unsigned ldsw = (unsigned)wid * 1024u;
    const int aoff = g8_lds_byte(wr * 64 + fr, fq * 8), boff = g8_lds_byte(wc * 32 + fr, fq * 8);
#define G8_SA(b, h) (((b) * 2 + (h)) * G8_HTB)
#define G8_SB(b, h) ((4 + (b) * 2 + (h)) * G8_HTB)
#define G8_STAGE_B(bufoff, gbase) do { _Pragma("unroll") for (int _i = 0; _i < 2; ++_i) \
        __builtin_amdgcn_global_load_lds((const unsigned*)((const char*)(gbase) + voffB[_i]), (LAS3 unsigned*)(lds + (bufoff) + ldsw + _i * 8192), 16, 0, 0); } while (0)
#define G8_STAGE_A(bufoff, o0, o1) do { \
        __builtin_amdgcn_global_load_lds((const unsigned*)(Abase + (o0)), (LAS3 unsigned*)(lds + (bufoff) + ldsw), 16, 0, 0); \
        __builtin_amdgcn_global_load_lds((const unsigned*)(Abase + (o1)), (LAS3 unsigned*)(lds + (bufoff) + ldsw + 8192), 16, 0, 0); } while (0)
#define G8_LDA(dst, b, h) do { _Pragma("unroll") for (int m = 0; m < 4; ++m) _Pragma("unroll") for (int k = 0; k < 2; ++k) dst[m][k] = *(const LAS3 bf16x8*)(lds + G8_SA(b, h) + aoff + m * 2048 + k * 1024); } while (0)
#define G8_LDB(dst, b, h) do { _Pragma("unroll") for (int n = 0; n < 2; ++n) _Pragma("unroll") for (int k = 0; k < 2; ++k) dst[n][k] = *(const LAS3 bf16x8*)(lds + G8_SB(b, h) + boff + n * 2048 + k * 1024); } while (0)
#define G8_MMA(ai, bj, At, Bt) do { __builtin_amdgcn_s_setprio(1); _Pragma("unroll") for (int m = 0; m < 4; ++m) _Pragma("unroll") for (int n = 0; n < 2; ++n) _Pragma("unroll") for (int k = 0; k < 2; ++k) \
        acc[ai][bj][m][n] = g8_mma<I8>(Bt[n][k], At[m][k], acc[ai][bj][m][n]); __builtin_amdgcn_s_setprio(0); } while (0)
#define G8_WAIT_V(n) asm volatile("s_waitcnt vmcnt(" #n ")" ::: "memory")
#define G8_WAIT_L(n) asm volatile("s_waitcnt lgkmcnt(" #n ")" ::: "memory")
#define G8_BAR __builtin_amdgcn_s_barrier()
#define G8_SCHED __builtin_amdgcn_sched_barrier(0)
    G8Unit cur, nxt; int ui = 0;
    if (!S.next(0, cur)) return;
    ACC acc[2][2][4][2];
#pragma unroll
    for (int a = 0; a < 2; ++a)
#pragma unroll
        for (int b = 0; b < 2; ++b)
#pragma unroll
            for (int m = 0; m < 4; ++m)
#pragma unroll
                for (int n = 0; n < 2; ++n) acc[a][b][m][n] = ACC{};
    bf16x8 At[4][2], B0[2][2], B1[2][2];
    float ep[8];
    unsigned va[2][2], vn[2][2];
#pragma unroll
    for (int h = 0; h < 2; ++h)
#pragma unroll
        for (int i = 0; i < 2; ++i) va[h][i] = S.a_off(cur, h * 128 + sRr[i]) + (unsigned)sCc[i] * 2u;
    const char* cB = S.b_ptr(cur);
    G8_STAGE_B(G8_SB(0, 0), cB); G8_STAGE_A(G8_SA(0, 0), va[0][0], va[0][1]); G8_STAGE_B(G8_SB(0, 1), cB + hstepB); G8_STAGE_A(G8_SA(0, 1), va[1][0], va[1][1]);
    if (wr == 1) G8_BAR;
    G8_WAIT_V(4); G8_BAR;
    G8_STAGE_B(G8_SB(1, 0), cB + kstep); G8_STAGE_A(G8_SA(1, 0), va[0][0] + kstep, va[0][1] + kstep); G8_STAGE_B(G8_SB(1, 1), cB + hstepB + kstep);
    G8_WAIT_V(6); G8_BAR;
    for (;;) {
        float* cb = (float*)(lds_g + 136192 + (ui & 1) * 2048);
        E.pre(cur, wr, fr, ep, cb);
        const bool has_next = S.next(ui + 1, nxt);
        const char* nB = cB;
#pragma unroll
        for (int h = 0; h < 2; ++h)
#pragma unroll
            for (int i = 0; i < 2; ++i) vn[h][i] = va[h][i];
        if (has_next) {
            nB = S.b_ptr(nxt);
#pragma unroll
            for (int h = 0; h < 2; ++h)
#pragma unroll
                for (int i = 0; i < 2; ++i) vn[h][i] = S.a_off(nxt, h * 128 + sRr[i]) + (unsigned)sCc[i] * 2u;
        }
#pragma unroll 1
        for (int t = 0; t < nt; t += 2) {
            const bool last = (t == nt - 2);
            const unsigned k1 = (unsigned)(t + 1) * 128u;
            const unsigned k2 = last ? 0u : (unsigned)(t + 2) * 128u;
            const unsigned a2_00 = (last ? vn[0][0] : va[0][0]) + k2, a2_01 = (last ? vn[0][1] : va[0][1]) + k2;
            const unsigned a2_10 = (last ? vn[1][0] : va[1][0]) + k2, a2_11 = (last ? vn[1][1] : va[1][1]) + k2;
            const char* b2 = (last ? nB : cB) + k2; const char* b3 = b2 + kstep;
            G8_LDB(B0, 0, 0); G8_SCHED; G8_LDA(At, 0, 0); G8_STAGE_A(G8_SA(1, 1), va[1][0] + k1, va[1][1] + k1);
            G8_WAIT_L(8); G8_BAR; G8_WAIT_L(0); G8_MMA(0, 0, At, B0); G8_BAR; G8_SCHED;
            G8_LDB(B1, 0, 1); G8_STAGE_B(G8_SB(0, 0), b2);
            G8_BAR; G8_WAIT_L(0); G8_MMA(0, 1, At, B1); G8_BAR;
            G8_LDA(At, 0, 1); G8_STAGE_A(G8_SA(0, 0), a2_00, a2_01);
            G8_BAR; G8_WAIT_L(0); G8_MMA(1, 0, At, B0); G8_BAR; G8_SCHED;
            G8_STAGE_B(G8_SB(0, 1), b2 + hstepB);
            G8_WAIT_V(6); G8_BAR; G8_MMA(1, 1, At, B1); G8_BAR;
            G8_LDB(B0, 1, 0); G8_SCHED; G8_LDA(At, 1, 0); G8_STAGE_A(G8_SA(0, 1), a2_10, a2_11);
            G8_WAIT_L(8); G8_BAR; G8_WAIT_L(0); G8_MMA(0, 0, At, B0); G8_BAR; G8_SCHED;
            G8_LDB(B1, 1, 1); G8_STAGE_B(G8_SB(1, 0), b3);
            G8_BAR; G8_WAIT_L(0); G8_MMA(0, 1, At, B1); G8_BAR;
            G8_LDA(At, 1, 1); G8_STAGE_A(G8_SA(1, 0), a2_00 + 128u, a2_01 + 128u);
            G8_BAR; G8_WAIT_L(0); G8_MMA(1, 0, At, B0); G8_BAR; G8_SCHED;
            G8_STAGE_B(G8_SB(1, 1), b3 + hstepB);
            G8_WAIT_V(6); G8_BAR; G8_MMA(1, 1, At, B1); G8_BAR;
        }
        E(acc, cur, wr, wc, fr, fq, ep, cb);
        if (!has_next) break;
#pragma unroll
        for (int a = 0; a < 2; ++a)
#pragma unroll
            for (int b = 0; b < 2; ++b)
#pragma unroll
                for (int m = 0; m < 4; ++m)
#pragma unroll
                    for (int n = 0; n < 2; ++n) acc[a][b][m][n] = ACC{};
        cur = nxt; cB = nB; ++ui;
#pragma unroll
        for (int h = 0; h < 2; ++h)
#pragma unroll
            for (int i = 0; i < 2; ++i) va[h][i] = vn[h][i];
    }
    G8_WAIT_V(0);
    if (wr == 0) G8_BAR;
    G8_BAR;
#undef G8_SA
#undef G8_SB
#undef G8_STAGE_A
#undef G8_STAGE_B
#undef G8_LDA
#undef G8_LDB
#undef G8_MMA
#undef G8_WAIT_V
#undef G8_WAIT_L
#undef G8_BAR
#undef G8_SCHED
}
struct G8Plain {
    int nM, nN, Kb, G, c; const char* Bt;
    __device__ __forceinline__ bool next(int i, G8Unit& u) const {
        const int L = (i * 8 + (c & 7)) * (G >> 3) + (c >> 3); if (L >= nM * nN) return false;
        const int nig = 8 * nN, gid = L / nig, fm = gid * 8, gsz = (nM - fm) < 8 ? (nM - fm) : 8;
        u.pm = fm + ((L % nig) % gsz); u.pn = (L % nig) / gsz; u.e = 0; u.ce = 256; u.pre = 0; return true;
    }
    __device__ __forceinline__ unsigned a_off(const G8Unit& u, int row) const { return (unsigned)(u.pm * 256 + row) * (unsigned)Kb; }
    __device__ __forceinline__ const char* b_ptr(const G8Unit& u) const { return Bt + (size_t)u.pn * 256 * Kb; }
};

__device__ __forceinline__ const float* resid_row_in(const Params& p, int tok) {
  return tok < TL ? p.x() + (size_t)tok * DM : p.ctx() + (size_t)(tok - TL) * DM;
}
__device__ __forceinline__ void load_row_comb(const Params& p, int src_layer, int lc, int tok, int lane, const int* pre  , float (&v)[16]) {
  if (src_layer == 0) {
    const float* r = resid_row_in(p, tok);
#pragma unroll
    for (int i = 0; i < 4; ++i) { const float4 a = *(const float4*)(r + lane * 4 + i * 256); v[4 * i] = a.x; v[4 * i + 1] = a.y; v[4 * i + 2] = a.z; v[4 * i + 3] = a.w; }
  } else {
    const u16* r = p.X() + (size_t)tok * DM;
#pragma unroll
    for (int i = 0; i < 4; ++i) { const float4 a = ld4bf(r + lane * 4 + i * 256); v[4 * i] = a.x; v[4 * i + 1] = a.y; v[4 * i + 2] = a.z; v[4 * i + 3] = a.w; }
  }
  if (lc >= 0) {
    const float* g2 = p.mod() + ((size_t)lc * 3 + modv(tok)) * 6144 + 5 * DM;
    float s[16];
#pragma unroll
    for (int i = 0; i < 16; ++i) s[i] = 0.f;
#pragma unroll
    for (int k = 0; k < TOPK; ++k) {
      const int sl = p.tslot()[tok * 4 + k];
      const size_t arow = (size_t)(pre[sl >> 20] + (sl & 0xFFFFF));
      const unsigned char* y = p.yd() + arow * DM;
#pragma unroll
      for (int i = 0; i < 4; ++i) {
        const int w = *(const int*)(y + lane * 4 + i * 256);
        const auto lo = __builtin_amdgcn_cvt_pk_f32_fp8(w, false), hi2 = __builtin_amdgcn_cvt_pk_f32_fp8(w, true);
        s[4 * i] += lo[0]; s[4 * i + 1] += lo[1]; s[4 * i + 2] += hi2[0]; s[4 * i + 3] += hi2[1];
      }
    }
#pragma unroll
    for (int i = 0; i < 4; ++i) {
      const float4 g = *(const float4*)(g2 + lane * 4 + i * 256);
      v[4 * i] += g.x * 0.125f * s[4 * i]; v[4 * i + 1] += g.y * 0.125f * s[4 * i + 1]; v[4 * i + 2] += g.z * 0.125f * s[4 * i + 2]; v[4 * i + 3] += g.w * 0.125f * s[4 * i + 3];
    }
  }
}
__device__ __forceinline__ void expert_prefix(const int* cnt, int* pre) {
  if (ltid() == 0) { int s = 0; for (int e = 0; e < NE; ++e) { pre[e] = s; s += cnt[e]; } pre[NE] = s; }
}

__device__ __forceinline__ float store_row_i8(const float (&y)[16], signed char* __restrict__ h, float* __restrict__ hs_row, int lane) {
  float am = 0.f;
#pragma unroll
  for (int i = 0; i < 16; ++i) am = fmaxf(am, fabsf(y[i]));
  am = wave_max(am);
  const float s = fmaxf(am, 1e-20f) * (1.f / 127.f), inv = 1.f / s;
#pragma unroll
  for (int i = 0; i < 4; ++i) {
    const int q0 = (int)rintf(y[4 * i] * inv), q1 = (int)rintf(y[4 * i + 1] * inv), q2 = (int)rintf(y[4 * i + 2] * inv), q3 = (int)rintf(y[4 * i + 3] * inv);
    *(unsigned*)(h + lane * 4 + i * 256) = (unsigned)(q0 & 255) | ((unsigned)(q1 & 255) << 8) | ((unsigned)(q2 & 255) << 16) | ((unsigned)(q3 & 255) << 24);
  }
  if (lane == 0) *hs_row = s;
  return s;
}
__device__ __forceinline__ void phase_quant_in(const Params& p, int bid, int nb) {
  const int wid = ltid() >> 6, lane = ltid() & 63;
  for (int r = bid * 8 + wid; r < 2 * NIN; r += nb * 8) {
    const float* src = p.btf() + (size_t)r * DM;
    float y[16];
#pragma unroll
    for (int i = 0; i < 4; ++i) { const float4 a = *(const float4*)(src + lane * 4 + i * 256); y[4 * i] = a.x; y[4 * i + 1] = a.y; y[4 * i + 2] = a.z; y[4 * i + 3] = a.w; }
    store_row_i8(y, p.bt_in() + (size_t)r * DM, p.swin() + r, lane);
  }
}
__device__ __forceinline__ void phase_norm1(const Params& p, int layer, int bid, int nb, char* lds) {
  int* pre = (int*)lds;
  const int lc = layer - 1;
  if (lc >= 0) { expert_prefix(p.cnt() + lc * NE, pre); __syncthreads(); }
  const int wid = ltid() >> 6, lane = ltid() & 63;
  const float* gn = p.norm1_g() + layer * DM;
  const int ntok = TT;
  for (int tok = bid * 8 + wid; tok < ntok; tok += nb * 8) {
    float v[16];
    load_row_comb(p, layer == 0 ? 0 : 1, lc, tok, lane, pre, v);
    if (lc >= 0) {
      u16* xr = p.X() + (size_t)tok * DM;
#pragma unroll
      for (int i = 0; i < 4; ++i) *(u32x2*)(xr + lane * 4 + i * 256) = u32x2{cvtpk(v[4 * i], v[4 * i + 1]), cvtpk(v[4 * i + 2], v[4 * i + 3])};
    }
    float ss = 0;
#pragma unroll
    for (int i = 0; i < 16; ++i) ss += v[i] * v[i];
    ss = wave_sum(ss);
    const float rs = rsqrtf(ss * (1.f / DM) + EPS);
    const float* md = p.mod() + ((size_t)layer * 3 + modv(tok)) * 6144;
#pragma unroll
    for (int i = 0; i < 4; ++i) {
      const int c = lane * 4 + i * 256;
      const float4 g = *(const float4*)(gn + c), sh = *(const float4*)(md + c), sc = *(const float4*)(md + DM + c);
      v[4 * i] = v[4 * i] * rs * g.x * (1.f + sc.x) + sh.x; v[4 * i + 1] = v[4 * i + 1] * rs * g.y * (1.f + sc.y) + sh.y;
      v[4 * i + 2] = v[4 * i + 2] * rs * g.z * (1.f + sc.z) + sh.z; v[4 * i + 3] = v[4 * i + 3] * rs * g.w * (1.f + sc.w) + sh.w;
    }
    store_row_i8(v, p.H() + (size_t)tok * DM, p.hs() + tok, lane);
  }
}

struct EpiIn {
  u16* zqkv; u16* zg; u16* zt; const float* hs; const float* sw;
  __device__ __forceinline__ void pre(const G8Unit& u, int wr, int fr, float (&ep)[8], float* cb) const {
    if ((ltid() >> 6) == 0) g8_cload(sw + u.pn * 256, cb);
#pragma unroll
    for (int ai = 0; ai < 2; ++ai)
#pragma unroll
      for (int m = 0; m < 4; ++m) ep[ai * 4 + m] = hs[u.pm * 256 + ai * 128 + wr * 64 + m * 16 + fr];
  }
  __device__ __forceinline__ void operator()(const i32x4 (&acc)[2][2][4][2], const G8Unit& u, int wr, int wc, int fr, int fq, const float (&ep)[8], const float* cb) const {
#pragma unroll
    for (int bj = 0; bj < 2; ++bj) {
      const int c32 = u.pn * 256 + bj * 128 + wc * 32, c0 = c32 + 8 * fq;
      const f32x4 w0 = *(const f32x4*)(cb + bj * 128 + wc * 32 + 8 * fq), w1 = *(const f32x4*)(cb + bj * 128 + wc * 32 + 8 * fq + 4);
#pragma unroll
      for (int ai = 0; ai < 2; ++ai)
#pragma unroll
        for (int m = 0; m < 4; ++m) {
          const int row = u.pm * 256 + ai * 128 + wr * 64 + m * 16 + fr;
          f32x4 a, b;
#pragma unroll
          for (int j = 0; j < 4; ++j) { a[j] = (float)acc[ai][bj][m][0][j] * ep[ai * 4 + m] * w0[j]; b[j] = (float)acc[ai][bj][m][1][j] * ep[ai * 4 + m] * w1[j]; }
          if (c32 < 384) {
            *(u32x4*)(zqkv + (size_t)row * 384 + c0) = u32x4{cvtpk(a[0], a[1]), cvtpk(a[2], a[3]), cvtpk(b[0], b[1]), cvtpk(b[2], b[3])};
          } else if (c32 < 1536) {
            *(u32x4*)(zg + (size_t)row * ZG_W + (c0 - 384)) = u32x4{cvtpk(a[0], a[1]), cvtpk(a[2], a[3]), cvtpk(b[0], b[1]), cvtpk(b[2], b[3])};
          } else {
#pragma unroll
            for (int j = 0; j < 4; ++j) { zt[(size_t)(c0 - 1536 + j) * TT + row] = f2bf(a[j]); zt[(size_t)(c0 - 1536 + 4 + j) * TT + row] = f2bf(b[j]); }
          }
        }
    }
  }
};
__device__ __forceinline__ void phase_gemm_in(const Params& p, int layer, int bid, int nb, char* lds) {
  G8Plain S; S.nM = TT / 256; S.nN = NIN / 256; S.Kb = DM; S.G = nb; S.c = bid; S.Bt = (const char*)(p.bt_in() + (size_t)layer * NIN * DM);
  EpiIn E; E.zqkv = p.zqkv(); E.zg = p.zg(); E.zt = p.zt(); E.hs = p.hs(); E.sw = p.swin() + layer * NIN;
  gemm8_phase<true>(lds, (const char*)p.H(), DM, S, E);
}

__device__ __forceinline__ size_t qkv_row(int tok, int h) {
  const int b = tok < TL ? (tok >> 14) : ((tok - TL) >> 8);
  const int s = tok < TL ? (tok & (SEQ - 1)) : SEQ + ((tok - TL) & (LC - 1));
  return ((size_t)(b * 4 + h)) * SKV + s;
}
struct EpiQkv {
  const u16* zqkv; u16* Q; u16* KV; const float* ropec; const float* ropes; float* rsl;
  unsigned* kmx;
  __device__ __forceinline__ void pre(const G8Unit&, int, int, float (&)[8], float*) const {}
  __device__ __forceinline__ void operator()(const f32x4 (&acc)[2][2][4][2], const G8Unit& u, int wr, int wc, int fr, int fq, const float (&)[8], const float*) const {
    const int tid = ltid();
    {
      const int r = tid >> 1, half = tid & 1;
      const u16* row = zqkv + (size_t)(u.pm * 256 + r) * 384;
      float sq = 0, sk = 0;
#pragma unroll
      for (int i = 0; i < 16; ++i) {
        const u32x4 w = *(const u32x4*)(row + half * 128 + i * 8);
#pragma unroll
        for (int q = 0; q < 4; ++q) { const float a = __uint_as_float(w[q] << 16), b = __uint_as_float(w[q] & 0xFFFF0000u); sq += a * a + b * b; }
      }
#pragma unroll
      for (int i = 0; i < 8; ++i) {
        const u32x4 w = *(const u32x4*)(row + 256 + half * 64 + i * 8);
#pragma unroll
        for (int q = 0; q < 4; ++q) { const float a = __uint_as_float(w[q] << 16), b = __uint_as_float(w[q] & 0xFFFF0000u); sk += a * a + b * b; }
      }
      sq += shx<1>(sq); sk += shx<1>(sk);
      if (half == 0) { rsl[r] = rsqrtf(sq * (1.f / 256.f) + EPS); rsl[256 + r] = rsqrtf(sk * (1.f / 128.f) + EPS); }
    }
    asm volatile("s_waitcnt lgkmcnt(0)" ::: "memory"); __builtin_amdgcn_s_barrier(); __builtin_amdgcn_s_barrier(); asm volatile("" ::: "memory");
    const float* rsp = rsl + (u.pn >= 2 ? 256 : 0);
#pragma unroll
    for (int ai = 0; ai < 2; ++ai)
#pragma unroll
      for (int m = 0; m < 4; ++m) {
        const int rl = ai * 128 + wr * 64 + m * 16 + fr, tok = u.pm * 256 + rl;
        const float rs = rsp[rl] * (u.pn < 2 ? A_QSCALE : 1.f);
        if (u.pn == 1) {
          f32x4 a = acc[ai][0][m][0] * rs, b = acc[ai][0][m][1] * rs;
          f32x4 pa, pb;
#pragma unroll
          for (int j = 0; j < 4; ++j) { pa[j] = shx<32>(a[j]); pb[j] = shx<32>(b[j]); }
          f32x4 ca = {1.f, 1.f, 1.f, 1.f}, cb = ca, sa = {0.f, 0.f, 0.f, 0.f}, sb = sa;
          if (tok < TL) {
            const float* cp = ropec + (size_t)(tok & (SEQ - 1)) * 16 + 8 * (fq & 1); const float* sp = ropes + (size_t)(tok & (SEQ - 1)) * 16 + 8 * (fq & 1);
            ca = *(const f32x4*)cp; cb = *(const f32x4*)(cp + 4); sa = *(const f32x4*)sp; sb = *(const f32x4*)(sp + 4);
          }
          const float sg = fq < 2 ? -1.f : 1.f;
          a = a * ca + pa * sa * sg; b = b * cb + pb * sb * sg;
          *(u32x4*)(Q + qkv_row(tok, wc) * 96 + 64 + 8 * fq) = u32x4{cvtpk(a[0], a[1]), cvtpk(a[2], a[3]), cvtpk(b[0], b[1]), cvtpk(b[2], b[3])};
        } else {
#pragma unroll
          for (int bj = 0; bj < 2; ++bj) {
            const int c = bj * 128 + wc * 32 + 8 * fq, h = c >> 6, d = c & 63;
            const f32x4 a = acc[ai][bj][m][0] * rs, b = acc[ai][bj][m][1] * rs;
            u16* dst = u.pn == 0 ? Q + qkv_row(tok, h) * 96 + d : KV + qkv_row(tok, h) * 160 + (u.pn == 2 ? 0 : 96) + d;
            *(u32x4*)dst = u32x4{cvtpk(a[0], a[1]), cvtpk(a[2], a[3]), cvtpk(b[0], b[1]), cvtpk(b[2], b[3])};
          }
        }
      }
    if (u.pn == 2) {
      const int b = u.pm * 256 < TL ? (u.pm * 256) >> 14 : (u.pm * 256 - TL) >> 8;
#pragma unroll
      for (int bj = 0; bj < 2; ++bj) {
        float mx = 0.f;
#pragma unroll
        for (int ai = 0; ai < 2; ++ai)
#pragma unroll
          for (int m = 0; m < 4; ++m) {
            const float rs = rsp[ai * 128 + wr * 64 + m * 16 + fr];
            const f32x4 a = acc[ai][bj][m][0] * rs, b4 = acc[ai][bj][m][1] * rs;
            float ss = a[0] * a[0] + a[1] * a[1] + a[2] * a[2] + a[3] * a[3] + b4[0] * b4[0] + b4[1] * b4[1] + b4[2] * b4[2] + b4[3] * b4[3];
            ss += shx<16>(ss); ss += shx<32>(ss);
            mx = fmaxf(mx, ss);
          }
        mx = fmaxf(mx, shx<8>(mx)); mx = fmaxf(mx, shx<4>(mx)); mx = fmaxf(mx, shx<2>(mx)); mx = fmaxf(mx, shx<1>(mx));
        if ((ltid() & 63) == 0) atomicMax(kmx + (b * 4 + bj * 2 + (wc >> 1)) * 4 + (wc & 1), __float_as_uint(mx));
      }
    }
  }
};
__device__ __forceinline__ void phase_qkv(const Params& p, int layer, int bid, int nb, char* lds) {
  const int tid = ltid();
  {
    G8Plain S; S.nM = TT / 256; S.nN = 4; S.Kb = 768; S.G = nb; S.c = bid; S.Bt = (const char*)(p.bt_qkv() + (size_t)layer * 1024 * 384);
    EpiQkv E; E.zqkv = p.zqkv(); E.Q = p.Q(); E.KV = p.KV(); E.ropec = p.ropec(); E.ropes = p.ropes(); E.rsl = (float*)(lds + 131072); E.kmx = p.kmx() + layer * 32;
    gemm8_phase<false>(lds, (const char*)p.zqkv(), 768, S, E);
  }
  float krm0 = 0.f, krm1 = 0.f;
  for (int i = bid * NTHR + tid; i < TT * 16; i += nb * NTHR) {
    const int tok = i >> 4, f = i & 15;
    const float x1 = bf2f(p.zg()[(size_t)tok * ZG_W + ZG_KR + f]), x2 = bf2f(p.zg()[(size_t)tok * ZG_W + ZG_KR + 16 + f]);
    float cs = 1.f, sn = 0.f;
    if (tok < TL) { const int tpos = tok & (SEQ - 1); cs = p.ropec()[tpos * 16 + f]; sn = p.ropes()[tpos * 16 + f]; }
    const float y1 = x1 * cs - x2 * sn, y2 = x2 * cs + x1 * sn;
    const u16 o1 = f2bf(y1), o2 = f2bf(y2);
#pragma unroll
    for (int h = 0; h < 4; ++h) { u16* kv = p.KV() + qkv_row(tok, h) * 160 + 64; kv[f] = o1; kv[16 + f] = o2; }
    float ss = y1 * y1 + y2 * y2;
    ss += shx<8>(ss); ss += shx<4>(ss); ss += shx<2>(ss); ss += shx<1>(ss);
    const int b = tok < TL ? (tok >> 14) : ((tok - TL) >> 8);
    if (b == 0) krm0 = fmaxf(krm0, ss); else krm1 = fmaxf(krm1, ss);
  }
  krm0 = wave_max(krm0); krm1 = wave_max(krm1);
  if ((tid & 63) == 0) { atomicMax(p.kmx() + layer * 32 + 0 * 16 + 2, __float_as_uint(krm0)); atomicMax(p.kmx() + layer * 32 + 1 * 16 + 2, __float_as_uint(krm1)); }
}

constexpr int A_KROW = 208;
constexpr int A_TV = 128 * 64 * 2;
constexpr int A_TK = 128 * A_KROW;
constexpr int A_BUF = A_TV + A_TK;
constexpr int A_OFF_W = 3 * A_BUF;
constexpr int ATTN_LDS = A_OFF_W + 8 * 64 * 4;
#define SBAR() __builtin_amdgcn_sched_barrier(0)
__device__ __forceinline__ int crow(int r, int hi) { return (r & 3) + 8 * (r >> 2) + 4 * hi; }

__device__ __forceinline__ void a_partialSM(f32x16& p0) {
#pragma unroll
  for (int r = 0; r < 16; ++r) p0[r] = __builtin_amdgcn_exp2f(p0[r]);
}
__device__ __forceinline__ void a_finishSM(f32x16& p0, f32x16& p1, bf16x8& pa0, bf16x8& pa1, bf16x8& pa2, bf16x8& pa3) {
#pragma unroll
  for (int r = 0; r < 16; ++r) p1[r] = __builtin_amdgcn_exp2f(p1[r]);
#define PK4(P, BASE, OUT) do { unsigned a0 = cvtpk(P[BASE + 0], P[BASE + 1]), a1 = cvtpk(P[BASE + 2], P[BASE + 3]);   \
    unsigned b0 = cvtpk(P[BASE + 4], P[BASE + 5]), b1 = cvtpk(P[BASE + 6], P[BASE + 7]);                              \
    auto r0 = __builtin_amdgcn_permlane32_swap(a0, b0, false, false); auto r1 = __builtin_amdgcn_permlane32_swap(a1, b1, false, false); \
    u32x4 w = {r0[0], r1[0], r0[1], r1[1]}; OUT = *reinterpret_cast<bf16x8*>(&w); } while (0)
  PK4(p0, 0, pa0); PK4(p0, 8, pa1); PK4(p1, 0, pa2); PK4(p1, 8, pa3);
#undef PK4
}
__device__ __forceinline__ void a_qkt(f32x16& p0, f32x16& p1, const char* Ks, const bf16x8* qr, const float mneg, int r32, int hi) {
#pragma unroll
  for (int r = 0; r < 16; ++r) { p0[r] = mneg; p1[r] = mneg; }
#pragma unroll
  for (int d0 = 0; d0 < 6; ++d0) {
    const int cb = (d0 * 16 + hi * 8) * 2;
    const bf16x8 b0 = *reinterpret_cast<const bf16x8*>(Ks + r32 * A_KROW + cb);
    const bf16x8 b1 = *reinterpret_cast<const bf16x8*>(Ks + (32 + r32) * A_KROW + cb);
    p0 = __builtin_amdgcn_mfma_f32_32x32x16_bf16(b0, qr[d0], p0, 0, 0, 0); p1 = __builtin_amdgcn_mfma_f32_32x32x16_bf16(b1, qr[d0], p1, 0, 0, 0);
  }
}
__device__ __forceinline__ int a_v_st(int k, int c) { const int kk = (k & ~0xC) | ((k & 4) << 1) | ((k & 8) >> 1); return ((kk >> 3) * 2 + (c >> 5)) * 512 + ((kk & 7) * 32 + (c & 31)) * 2; }
__device__ __forceinline__ int a_v_rd_base(int lane) { return ((lane & 3) << 3) | (((lane >> 2) & 3) << 6) | (((lane >> 4) & 1) << 5) | (((lane >> 5) & 1) << 8); }
constexpr int a_v_rd_off(int d0, int ks, int half) { return d0 * 512 + ks * 2048 + half * 1024; }
template <int OFF> __device__ __forceinline__ s16x4 a_tr_read(int vb) {
  s16x4 r; asm volatile("ds_read_b64_tr_b16 %0, %1 offset:%2" : "=&v"(r) : "v"(vb), "i"(OFF) : "memory"); return r;
}
template <int D0> __device__ __forceinline__ void a_pv_one(f32x16& od, int vb, bf16x8 pa0, bf16x8 pa1, bf16x8 pa2, bf16x8 pa3) {
  const s16x4 l0 = a_tr_read<a_v_rd_off(D0, 0, 0)>(vb), h0 = a_tr_read<a_v_rd_off(D0, 0, 1)>(vb), l1 = a_tr_read<a_v_rd_off(D0, 1, 0)>(vb), h1 = a_tr_read<a_v_rd_off(D0, 1, 1)>(vb);
  const s16x4 l2 = a_tr_read<a_v_rd_off(D0, 2, 0)>(vb), h2 = a_tr_read<a_v_rd_off(D0, 2, 1)>(vb), l3 = a_tr_read<a_v_rd_off(D0, 3, 0)>(vb), h3 = a_tr_read<a_v_rd_off(D0, 3, 1)>(vb);
  asm volatile("s_waitcnt lgkmcnt(0)" ::: "memory"); SBAR();
#define PK(L, H) (bf16x8){L[0], L[1], L[2], L[3], H[0], H[1], H[2], H[3]}
  od = __builtin_amdgcn_mfma_f32_32x32x16_bf16(pa0, PK(l0, h0), od, 0, 0, 0);
  od = __builtin_amdgcn_mfma_f32_32x32x16_bf16(pa1, PK(l1, h1), od, 0, 0, 0);
  od = __builtin_amdgcn_mfma_f32_32x32x16_bf16(pa2, PK(l2, h2), od, 0, 0, 0);
  od = __builtin_amdgcn_mfma_f32_32x32x16_bf16(pa3, PK(l3, h3), od, 0, 0, 0);
#undef PK
}
__device__ __forceinline__ void a_pv(f32x16* o, int vb, bf16x8 pa0, bf16x8 pa1, bf16x8 pa2, bf16x8 pa3) {
  a_pv_one<0>(o[0], vb, pa0, pa1, pa2, pa3);
  { const bf16x8 ones = {0x3F80, 0x3F80, 0x3F80, 0x3F80, 0x3F80, 0x3F80, 0x3F80, 0x3F80};
    o[2] = __builtin_amdgcn_mfma_f32_32x32x16_bf16(pa0, ones, o[2], 0, 0, 0); o[2] = __builtin_amdgcn_mfma_f32_32x32x16_bf16(pa1, ones, o[2], 0, 0, 0);
    o[2] = __builtin_amdgcn_mfma_f32_32x32x16_bf16(pa2, ones, o[2], 0, 0, 0); o[2] = __builtin_amdgcn_mfma_f32_32x32x16_bf16(pa3, ones, o[2], 0, 0, 0); }
  a_pv_one<1>(o[1], vb, pa0, pa1, pa2, pa3);
}

__device__ __forceinline__ void attn_item(const u16* __restrict__ Qb, const u16* __restrict__ KVh, int seq, float kmax, u16* __restrict__ yout  , char* lds) {
  const int tid = ltid(), wid = tid >> 6, lane = tid & 63, r32 = lane & 31, hi = lane >> 5;
  f32x16 o[3] = {}; bf16x8 qr[6];
  const u16* Qw = Qb + (size_t)(wid * 32 + r32) * 96 + hi * 8;
#pragma unroll
  for (int d0 = 0; d0 < 6; ++d0) qr[d0] = *reinterpret_cast<const bf16x8*>(Qw + d0 * 16);
  float mneg;
  {
    float ss = 0.f;
#pragma unroll
    for (int d0 = 0; d0 < 6; ++d0)
#pragma unroll
      for (int j = 0; j < 8; ++j) { const float v = bf2f((u16)qr[d0][j]); ss += v * v; }
    ss += shx<32>(ss);
    mneg = -sqrtf(ss) * kmax;
  }
  int lw[5];
#pragma unroll
  for (int i = 0; i < 5; ++i) {
    const int g = tid + i * 512, key = g / 20, cc = g % 20;
    lw[i] = cc < 12 ? (A_TV + key * A_KROW + cc * 16) : ((key >> 6) * 8192 + a_v_st(key & 63, (cc - 12) * 8));
  }
  const int vrb = (int)(uintptr_t)lds + a_v_rd_base(lane);
  bf16x8 sg[5];
  const char* gsrc = (const char*)KVh + tid * 16;
#define SLOAD(t) do { const char* s_ = gsrc + (size_t)(t) * 40960; _Pragma("unroll") for (int i = 0; i < 5; ++i) sg[i] = *(const bf16x8*)(s_ + i * 8192); } while (0)
#define SWRITE(bo_) do { _Pragma("unroll") for (int i = 0; i < 5; ++i) *(bf16x8*)(lds + (bo_) + lw[i]) = sg[i]; } while (0)
  f32x16 pA0, pA1, pB0, pB1; bf16x8 pa0, pa1, pa2, pa3; const int NT = seq / 128;
  SLOAD(0); SWRITE(0); if (1 < NT) SLOAD(1);
  __syncthreads();
  int bo = 0;
  {
    if (1 < NT) { SWRITE(A_BUF); if (2 < NT) SLOAD(2); }
    SBAR(); a_qkt(pA0, pA1, lds + bo + A_TV, qr, mneg, r32, hi); a_partialSM(pA0);
    SBAR(); a_qkt(pB0, pB1, lds + bo + A_TV + 64 * A_KROW, qr, mneg, r32, hi);
    a_finishSM(pA0, pA1, pa0, pa1, pa2, pa3); SBAR();
    a_pv(o, vrb + bo, pa0, pa1, pa2, pa3); a_partialSM(pB0);
    __syncthreads();
  }
  for (int t = 1; t < NT; ++t) {
    const int bp = bo;
    bo = bo + A_BUF; if (bo == 3 * A_BUF) bo = 0;
    int bn = bo + A_BUF; if (bn == 3 * A_BUF) bn = 0;
    if (t + 1 < NT) { SWRITE(bn); if (t + 2 < NT) SLOAD(t + 2); }
    SBAR(); a_qkt(pA0, pA1, lds + bo + A_TV, qr, mneg, r32, hi);
    a_finishSM(pB0, pB1, pa0, pa1, pa2, pa3); SBAR();
    a_pv(o, vrb + bp + 8192, pa0, pa1, pa2, pa3); a_partialSM(pA0);
    SBAR(); a_qkt(pB0, pB1, lds + bo + A_TV + 64 * A_KROW, qr, mneg, r32, hi);
    a_finishSM(pA0, pA1, pa0, pa1, pa2, pa3); SBAR();
    a_pv(o, vrb + bo, pa0, pa1, pa2, pa3); a_partialSM(pB0);
    __syncthreads();
  }
  a_finishSM(pB0, pB1, pa0, pa1, pa2, pa3); SBAR();
  a_pv(o, vrb + bo + 8192, pa0, pa1, pa2, pa3);
#pragma unroll
  for (int r = 0; r < 16; ++r) {
    const int orow = crow(r, hi);
    const float rl = __builtin_amdgcn_rcpf(o[2][r]);
    const float v0 = o[0][r] * rl, v1 = o[1][r] * rl;
    float ss = v0 * v0 + v1 * v1;
    ss += shx<16>(ss); ss += shx<8>(ss); ss += shx<4>(ss); ss += shx<2>(ss); ss += shx<1>(ss);
    const float rs = rsqrtf(ss * (1.f / 64.f) + EPS);
    u16* dst = yout + (size_t)(wid * 32 + orow) * DM;
    dst[r32] = f2bf(v0 * rs); dst[32 + r32] = f2bf(v1 * rs);
  }
  __syncthreads();
#undef SLOAD
#undef SWRITE
}

__device__ __forceinline__ void phase_attn(const Params& p, int layer, int bid, int nb, char* lds) {
  const int nitems = 512 + (layer == 0 ? 8 : 0);
  const unsigned* kmx = p.kmx() + layer * 32;
  for (int it = bid; it < nitems; it += nb) {
    int b, h, q0, k0, seq, tok0;
    if (it < 512) { const int pair = it & 7, qb = (it >> 3); h = pair & 3; b = pair >> 2; q0 = qb * 256; k0 = 0; seq = SKV; tok0 = b * SEQ + qb * 256; }
    else { const int i2 = it - 512; h = i2 & 3; b = i2 >> 2; q0 = SEQ; k0 = SEQ; seq = LC; tok0 = TL + b * LC; }
    const size_t base = (size_t)(b * 4 + h) * SKV;
    const float k2 = __uint_as_float(kmx[(b * 4 + h) * 4 + 0]) + __uint_as_float(kmx[(b * 4 + h) * 4 + 1]) + __uint_as_float(kmx[b * 16 + 2]);
    attn_item(p.Q() + (base + q0) * 96, p.KV() + (base + k0) * 160, seq, sqrtf(k2) * 1.02f, p.ymix() + (size_t)tok0 * DM + h * 64, lds);
  }
}

__device__ __forceinline__ float hy_sconv(const u16* __restrict__ row, int t, int Ls, float w0, float w1, float w2, float bb) {
  const float zm = t > 0 ? bf2f(row[t - 1]) : 0.f, z0 = bf2f(row[t]), zp = t + 1 < Ls ? bf2f(row[t + 1]) : 0.f;
  return w0 * zm + w1 * z0 + w2 * zp + bb;
}
__device__ __forceinline__ float2 hy_sconv2(unsigned prv, unsigned cur, unsigned nxt, float w0, float w1, float w2, float bb) {
  const float zm = __uint_as_float(prv & 0xFFFF0000u), z0 = __uint_as_float(cur << 16), z1 = __uint_as_float(cur & 0xFFFF0000u), z2 = __uint_as_float(nxt << 16);
  return make_float2(w0 * zm + w1 * z0 + w2 * z1 + bb, w0 * z0 + w1 * z1 + w2 * z2 + bb);
}
__device__ __forceinline__ void hyena_item(const Params& p, int layer, int b, int ch, char* lds) {
  float2* s = (float2*)lds;
  const int tid = ltid();
  const float* cw = p.hy_conv_w() + (size_t)layer * 3 * 768; const float* cb = p.hy_conv_b() + (size_t)layer * 768;
  const unsigned* r0 = (const unsigned*)(p.zt() + (size_t)(ZT_HY + ch) * TT + (size_t)b * SEQ);
  const unsigned* r1 = (const unsigned*)(p.zt() + (size_t)(ZT_HY + 256 + ch) * TT + (size_t)b * SEQ);
  const unsigned* r2 = (const unsigned*)(p.zt() + (size_t)(ZT_HY + 512 + ch) * TT + (size_t)b * SEQ);
  const float a0 = cw[ch], a1 = cw[768 + ch], a2 = cw[1536 + ch], ab = cb[ch];
  const float b0 = cw[256 + ch], b1 = cw[768 + 256 + ch], b2 = cw[1536 + 256 + ch], bb = cb[256 + ch];
  const float c0 = cw[512 + ch], c1 = cw[768 + 512 + ch], c2 = cw[1536 + 512 + ch], cbb = cb[512 + ch];
  unsigned vgr[16], x0r[16];
#pragma unroll
  for (int hb2 = 0; hb2 < 2; ++hb2) {
    unsigned ld[8][9];
#pragma unroll
    for (int ii = 0; ii < 8; ++ii) {
      const int m = tid + 512 * (hb2 * 8 + ii);
      const int mp = m > 0 ? m - 1 : 0, mn = m + 1 < SEQ / 2 ? m + 1 : m;
      ld[ii][0] = r0[mp]; ld[ii][1] = r0[m]; ld[ii][2] = r0[mn];
      ld[ii][3] = r1[mp]; ld[ii][4] = r1[m]; ld[ii][5] = r1[mn];
      ld[ii][6] = r2[mp]; ld[ii][7] = r2[m]; ld[ii][8] = r2[mn];
    }
#pragma unroll
    for (int ii = 0; ii < 8; ++ii) {
      const int i = hb2 * 8 + ii, m = tid + 512 * i;
      const unsigned mkp = m > 0 ? 0xFFFFFFFFu : 0u, mkn = m + 1 < SEQ / 2 ? 0xFFFFFFFFu : 0u;
      const float2 ux = hy_sconv2(ld[ii][0] & mkp, ld[ii][1], ld[ii][2] & mkn, a0, a1, a2, ab);
      x0r[i] = cvtpk(ux.x, ux.y);
      const float2 u1 = hy_sconv2(ld[ii][3] & mkp, ld[ii][4], ld[ii][5] & mkn, b0, b1, b2, bb);
      const float2 uv = hy_sconv2(ld[ii][6] & mkp, ld[ii][7], ld[ii][8] & mkn, c0, c1, c2, cbb);
      const float2 vgf = make_float2(uv.x * u1.x, uv.y * u1.y);
      vgr[i] = cvtpk(vgf.x, vgf.y);
      s[swz(m)] = vgf;
      s[swz(m + SEQ / 2)] = make_float2(0.f, 0.f);
    }
  }
  __syncthreads();
  fft_fwd(s, p.tw());
  {
    const float4* hs = p.hspec() + ((size_t)layer * 256 + ch) * HSP;
    float4 hv[17];
#pragma unroll
    for (int i = 0; i < 17; ++i) { const int k = tid + 512 * i; hv[i] = hs[k <= FM / 2 ? k : 0]; }
    const float2 twl = p.tw()[tid];
#pragma unroll
    for (int i = 0; i < 17; ++i) {
      const int k = tid + 512 * i;
      if (k <= FM / 2) {
        const int pk = swz(rev7(k)), pm = swz(rev7((FM - k) & (FM - 1)));
        const float2 zk = s[pk], zm = s[pm];
        const float4 h = hv[i];
        const float2 He = make_float2(h.x, h.y), Ho = make_float2(h.z, h.w);
        const float2 Xe = make_float2(0.5f * (zk.x + zm.x), 0.5f * (zk.y - zm.y));
        const float2 Xo = make_float2(0.5f * (zk.y + zm.y), -0.5f * (zk.x - zm.x));
        const float2 twk = cmul(twl, p.tw()[512 * i]);
        const float2 t1 = cmul(twk, cmul(Xo, Ho));
        const float2 e1 = cmul(Xe, He);
        const float2 Ye = make_float2(e1.x + t1.x, e1.y + t1.y);
        const float2 o1 = cmul(Xe, Ho), o2 = cmul(Xo, He);
        const float2 Yo = make_float2(o1.x + o2.x, o1.y + o2.y);
        s[pk] = make_float2(Ye.x - Yo.y, Ye.y + Yo.x);
        if (pm != pk) s[pm] = make_float2(Ye.x + Yo.y, -Ye.y + Yo.x);
      }
    }
  }
  __syncthreads();
  fft_inv(s, p.tw());
  const float hb = p.hy_bias()[layer * 256 + ch];
  unsigned* orow = (unsigned*)(p.hyo() + (size_t)ch * TT + (size_t)b * SEQ);
#pragma unroll
  for (int i = 0; i < 16; ++i) {
    const int m = tid + 512 * i;
    const float2 y = s[swz(m)];
    orow[m] = cvtpk((y.x + __uint_as_float(vgr[i] << 16) * hb) * __uint_as_float(x0r[i] << 16), (y.y + __uint_as_float(vgr[i] & 0xFFFF0000u) * hb) * __uint_as_float(x0r[i] & 0xFFFF0000u));
  }
  __syncthreads();
}
__device__ __forceinline__ void fnet_item(const Params& p, int b, int j, char* lds) {
  float2* s = (float2*)lds;
  const int tid = ltid();
  const u16* rr = p.zt() + (size_t)(ZT_FR + j) * TT + (size_t)b * SEQ;
  const u16* ri = p.zt() + (size_t)(ZT_FI + j) * TT + (size_t)b * SEQ;
  {
    u32x4 vr[4], vi[4];
#pragma unroll
    for (int i = 0; i < 4; ++i) { const int m0 = (tid + 512 * i) * 8; vr[i] = *(const u32x4*)(rr + m0); vi[i] = *(const u32x4*)(ri + m0); }
#pragma unroll
    for (int i = 0; i < 4; ++i) {
      const int m0 = (tid + 512 * i) * 8;
#pragma unroll
      for (int q = 0; q < 4; ++q) {
        s[swz(m0 + 2 * q)] = make_float2(__uint_as_float(vr[i][q] << 16), __uint_as_float(vi[i][q] << 16));
        s[swz(m0 + 2 * q + 1)] = make_float2(__uint_as_float(vr[i][q] & 0xFFFF0000u), __uint_as_float(vi[i][q] & 0xFFFF0000u));
      }
    }
  }
  __syncthreads();
  fft_fwd(s, p.tw());
#ifdef PROBE_FFT
  fft_inv(s, p.tw());
  for (int m = tid; m < FM; m += NTHR) { float2 v = s[m]; v.x *= (1.f / 16384.f); v.y *= (1.f / 16384.f); s[m] = v; }
  __syncthreads();
  fft_fwd(s, p.tw());
#endif
  u16* orow = p.fno() + (size_t)j * TT + (size_t)b * SEQ;
#pragma unroll 8
  for (int k = tid; k < FM; k += NTHR) orow[k] = f2bf(s[swz(rev7(k))].x * (1.f / 128.f));
  __syncthreads();
}
__device__ __forceinline__ void hyena_ctx_item(const Params& p, int b, int ch, char* lds) {
  float* vg = (float*)lds;
  float* x0 = vg + 256;
  float* hf = x0 + 256;
  float* hbk = hf + 256;
  const int tid = ltid();
  const float* cw = p.hy_conv_w(); const float* cb = p.hy_conv_b();
  const size_t off = (size_t)TL + (size_t)b * LC;
  const u16* r0 = p.zt() + (size_t)(ZT_HY + ch) * TT + off;
  const u16* r1 = p.zt() + (size_t)(ZT_HY + 256 + ch) * TT + off;
  const u16* r2 = p.zt() + (size_t)(ZT_HY + 512 + ch) * TT + off;
  if (tid < 256) {
    const int t = tid;
    vg[t] = hy_sconv(r2, t, LC, cw[512 + ch], cw[768 + 512 + ch], cw[1536 + 512 + ch], cb[512 + ch]) *
            hy_sconv(r1, t, LC, cw[256 + ch], cw[768 + 256 + ch], cw[1536 + 256 + ch], cb[256 + ch]);
    x0[t] = hy_sconv(r0, t, LC, cw[ch], cw[768 + ch], cw[1536 + ch], cb[ch]);
    hf[t] = p.hfc()[(size_t)ch * LC + t]; hbk[t] = p.hfc()[(size_t)(256 + ch) * LC + t];
  }
  const float ssq_c = filt_ssq(p.hpart() + (size_t)2 * 256 * 512, ch, (float*)(lds + 8192));
  if (tid < 256) {
    const int t = tid; float y = 0;
    for (int q = 0; q <= t; ++q) y += hf[t - q] * vg[q];
    for (int q = t + 1; q < LC; ++q) y += hbk[q - t] * vg[q];
    y *= rsqrtf(ssq_c);
    p.hyo()[(size_t)ch * TT + off + t] = f2bf((y + vg[t] * p.hy_bias()[ch]) * x0[t]);
  }
  __syncthreads();
}
__device__ __forceinline__ void fnet_ctx_item(const Params& p, int b, int j, char* lds) {
  float* ur = (float*)lds; float* ui = ur + 256; float* cst = ui + 256; float* snt = cst + 256;
  const int tid = ltid();
  const size_t off = (size_t)TL + (size_t)b * LC;
  if (tid < 256) {
    ur[tid] = bf2f(p.zt()[(size_t)(ZT_FR + j) * TT + off + tid]); ui[tid] = bf2f(p.zt()[(size_t)(ZT_FI + j) * TT + off + tid]);
    float sn, cs; sincospif((float)tid / 128.f, &sn, &cs); cst[tid] = cs; snt[tid] = sn;
  }
  __syncthreads();
  if (tid < 256) {
    const int k = tid; float y = 0;
    for (int l = 0; l < 256; ++l) { const int m = (l * k) & 255; y += cst[m] * ur[l] + snt[m] * ui[l]; }
    p.fno()[(size_t)j * TT + off + k] = f2bf(y * 0.0625f);
  }
  __syncthreads();
}
__device__ __forceinline__ void phase_fftmix(const Params& p, int layer, int bid, int nb, char* lds) {
  const int nitems = layer == 0 ? 2048 : 1024;
  for (int it = bid; it < nitems; it += nb) {
    const int k = it & 511, b = k >> 8, c = k & 255;
    if (it < 512) hyena_item(p, layer, b, c, lds);
    else if (it < 1024) fnet_item(p, b, c, lds);
    else if (it < 1536) hyena_ctx_item(p, b, c, lds);
    else fnet_ctx_item(p, b, c, lds);
  }
}
constexpr int GLG = 17, NGRP = 16;
__device__ __forceinline__ int gla_chain_tok(int dir, int b, int n, int i) {
  const int base = n < 4 ? TL + b * LC : b * SEQ, len = n < 4 ? LC : SEQ, m = n < 4 ? n : n - 4;
  return dir == 0 ? base + 64 * m + i : base + (len - 1) - (64 * m + i);
}
__device__ __forceinline__ float logsig16(float x) { return (fminf(x, 0.f) - __logf(1.f + __expf(-fabsf(x)))) * (1.f / 16.f); }
__device__ __forceinline__ float wave_scan_incl(float v, int lane) {
#pragma unroll
  for (int o = 1; o < 64; o <<= 1) { const float t = __shfl_up(v, o, 64); if (lane >= o) v += t; }
  return v;
}
__device__ __forceinline__ void phase_gla_a(const Params& p, int layer, int bid, int nb, char* lds) {
  const int tid = ltid(), wid = tid >> 6, lane = tid & 63, r32 = lane & 31, hi = lane >> 5;
  const float* gb = p.gla_gk_b() + (size_t)layer * 256;
  char* wimg = lds + wid * 12288;
  for (int it = bid; it < 16 * NGRP; it += nb) {
    const int chain = it >> 4, g = it & 15, dir = chain >> 3, b = (chain >> 2) & 1, h = chain & 3;
    const int n0 = g * GLG, n1 = min(n0 + GLG, NCH), nch = n1 - n0;
    char* WT = lds + wid * 13824; char* VT = WT + 4608;
    float* dvl = (float*)(lds + 8 * 13824);
#pragma unroll
    for (int c = 0; c < 3; ++c) {
      const int cl = wid + 8 * c;
      if (cl < nch) {
        const int n = n0 + cl;
        {
          const u16* vbase = p.zg() + ZG_GV + h * 64 + lane;
          u16 vv[64];
#pragma unroll
          for (int i = 0; i < 64; ++i) vv[i] = vbase[(size_t)gla_chain_tok(dir, b, n, i) * ZG_W];
#pragma unroll
          for (int q = 0; q < 8; ++q)
            *(u32x4*)(VT + lane * 144 + q * 16) = u32x4{(unsigned)vv[8 * q] | ((unsigned)vv[8 * q + 1] << 16), (unsigned)vv[8 * q + 2] | ((unsigned)vv[8 * q + 3] << 16),
                                                       (unsigned)vv[8 * q + 4] | ((unsigned)vv[8 * q + 5] << 16), (unsigned)vv[8 * q + 6] | ((unsigned)vv[8 * q + 7] << 16)};
        }
        {
          const int kk = lane & 31, hs = lane >> 5;
          const u16* kb = p.zg() + ZG_GK + h * 32 + kk; const u16* gbp = p.zg() + ZG_GP + dir * 128 + h * 32 + kk;
          const float bias = gb[dir * 128 + h * 32 + kk];
          float bc[32], kf[32];
#pragma unroll
          for (int i = 0; i < 32; ++i) {
            const size_t ro = (size_t)gla_chain_tok(dir, b, n, hs * 32 + i) * ZG_W;
            kf[i] = bf2f(kb[ro]); bc[i] = bf2f(gbp[ro]);
          }
          float run = 0.f;
#pragma unroll
          for (int i = 0; i < 32; ++i) { const float x = bc[i] + bias; run += (fminf(x, 0.f) - __logf(1.f + __expf(-fabsf(x)))) * (1.f / 16.f); bc[i] = run; }
          const float lowtot = __shfl(run, kk, 64);
          const float uptot = __shfl(run, 32 + kk, 64);
          const float bl = lowtot + uptot, off = hs ? lowtot : 0.f;
          unsigned wp[16];
#pragma unroll
          for (int i = 0; i < 16; ++i) wp[i] = cvtpk(kf[2 * i] * __expf(bl - (bc[2 * i] + off)), kf[2 * i + 1] * __expf(bl - (bc[2 * i + 1] + off)));
#pragma unroll
          for (int q = 0; q < 4; ++q) *(u32x4*)(WT + kk * 144 + hs * 64 + q * 16) = u32x4{wp[4 * q], wp[4 * q + 1], wp[4 * q + 2], wp[4 * q + 3]};
          if (hs == 0) dvl[cl * 32 + kk] = __expf(bl);
        }
        asm volatile("s_waitcnt lgkmcnt(0)" ::: "memory");
        f32x16 d0 = {}, d1 = {};
#pragma unroll
        for (int s4 = 0; s4 < 4; ++s4) {
          const bf16x8 af = *(const bf16x8*)(WT + r32 * 144 + (16 * s4 + 8 * hi) * 2);
          const bf16x8 v0 = *(const bf16x8*)(VT + r32 * 144 + (16 * s4 + 8 * hi) * 2);
          const bf16x8 v1 = *(const bf16x8*)(VT + (32 + r32) * 144 + (16 * s4 + 8 * hi) * 2);
          d0 = __builtin_amdgcn_mfma_f32_32x32x16_bf16(af, v0, d0, 0, 0, 0);
          d1 = __builtin_amdgcn_mfma_f32_32x32x16_bf16(af, v1, d1, 0, 0, 0);
        }
        asm volatile("s_waitcnt lgkmcnt(0)" ::: "memory");
        {
          float* dg = p.gds() + ((size_t)chain * NCH + n) * 2048;
#pragma unroll
          for (int r = 0; r < 16; ++r) { dg[crow(r, hi) * 64 + r32] = d0[r]; dg[crow(r, hi) * 64 + 32 + r32] = d1[r]; }
        }
      }
      __builtin_amdgcn_sched_barrier(0);
    }
    __syncthreads();
    {
      const int kk = tid >> 4, v0 = (tid & 15) * 4;
      float st[4] = {0.f, 0.f, 0.f, 0.f}; float dcum = 1.f;
      float* gp0 = p.gds() + ((size_t)chain * NCH + n0) * 2048 + kk * 64 + v0;
      float4 av[GLG];
#pragma unroll
      for (int cl = 0; cl < GLG; ++cl) av[cl] = *(const float4*)(gp0 + (size_t)(cl < nch ? cl : 0) * 2048);
#pragma unroll
      for (int cl = 0; cl < GLG; ++cl) {
        if (cl < nch) {
          const float d = dvl[cl * 32 + kk];
          *(float4*)(gp0 + (size_t)cl * 2048) = make_float4(st[0], st[1], st[2], st[3]);
          if ((tid & 15) == 0) p.gdv()[((size_t)chain * NCH + n0 + cl) * 32 + kk] = dcum;
          st[0] = st[0] * d + av[cl].x; st[1] = st[1] * d + av[cl].y; st[2] = st[2] * d + av[cl].z; st[3] = st[3] * d + av[cl].w;
          dcum *= d;
        }
      }
      float* at = p.gst() + ((size_t)chain * NGRP + g) * 2048 + kk * 64 + v0;
      *(float4*)at = make_float4(st[0], st[1], st[2], st[3]);
      if ((tid & 15) == 0) p.gst()[(size_t)16 * NGRP * 2048 + ((size_t)chain * NGRP + g) * 32 + kk] = dcum;
    }
    __syncthreads();
  }
}

constexpr int GC_QP = 33792, GC_KP = GC_QP + 10240, GC_VT = GC_KP + 10240, GC_ST = GC_VT + 18432, GC_AX = GC_ST + 10240;
__device__ __forceinline__ void phase_gla_c(const Params& p, int layer, int bid, int nb, char* lds) {
  float* gl = (float*)lds;
  float* qraw = gl + 2 * 64 * 33;
  float* kraw = qraw + 64 * 33;
  float* Of = (float*)lds;
  char* Qp = lds + GC_QP;
  char* Kp = lds + GC_KP;
  char* VT = lds + GC_VT;
  char* ST = lds + GC_ST;
  const int tid = ltid(), wid = tid >> 6, lane = tid & 63, r32 = lane & 31, hi = lane >> 5;
  char* Ax = lds + GC_AX + wid * 4608;
  const float* gb = p.gla_gk_b() + (size_t)layer * 256;
  const int pc_lo = layer == 0 ? 0 : 4, npc = NCH - pc_lo, nitem = 8 * npc;
  const int per = (nitem + nb - 1) / nb, q_beg = bid * per, q_end = min(nitem, q_beg + per);
  const int sdir = tid >> 8, sk = (tid >> 3) & 31, sv0 = (tid & 7) * 8;
  float G[8]; int g_cached = -1, bh_cached = -1;
  const int lpos = tid >> 3, lc4 = (tid & 7) * 4;
  u32x2 rq, rk, rg0, rg1, rva, rvb; float4 pl0, pl1; float pdp;
#define GC_ITEM(q_, bh_, pc_, b_, h_, tok0_) const int bh_ = (q_) / npc, pc_ = pc_lo + (q_) % npc, b_ = bh_ >> 2, h_ = bh_ & 3; \
    const int tok0_ = pc_ < 4 ? TL + b_ * LC + pc_ * 64 : b_ * SEQ + (pc_ - 4) * 64
#define GC_LOADRAW(tok0_, h_) do { const u16* zr = p.zg() + (size_t)((tok0_) + lpos) * ZG_W; \
    rq = *(const u32x2*)(zr + ZG_GQ + (h_) * 32 + lc4); rk = *(const u32x2*)(zr + ZG_GK + (h_) * 32 + lc4); \
    rg0 = *(const u32x2*)(zr + ZG_GP + (h_) * 32 + lc4); rg1 = *(const u32x2*)(zr + ZG_GP + 128 + (h_) * 32 + lc4); \
    rva = *(const u32x2*)(zr + ZG_GV + (h_) * 64 + lc4 * 2); rvb = *(const u32x2*)(zr + ZG_GV + (h_) * 64 + lc4 * 2 + 4); } while (0)
#define GC_LOADST(pc_, b_, h_) do { const int chain_ = sdir * 8 + (b_) * 4 + (h_); \
    const int n_ = sdir == 0 ? (pc_) : ((pc_) < 4 ? 3 - (pc_) : 4 + 255 - ((pc_) - 4)); \
    const float* lp_ = p.gds() + ((size_t)chain_ * NCH + n_) * 2048 + sk * 64 + sv0; \
    pl0 = *(const float4*)lp_; pl1 = *(const float4*)(lp_ + 4); pdp = p.gdv()[((size_t)chain_ * NCH + n_) * 32 + sk]; } while (0)
  if (q_beg < q_end) { GC_ITEM(q_beg, bh0, pc0, b0, h0, t00); GC_LOADRAW(t00, h0); GC_LOADST(pc0, b0, h0); }
  for (int qi = q_beg; qi < q_end; ++qi) {
    GC_ITEM(qi, bh, pc, b, h, tok0);
    {
      const int pos = lpos, c4 = lc4;
      const float sc = 0.17677669529663687f;
      qraw[pos * 33 + c4] = BF_LO(rq[0]) * sc; qraw[pos * 33 + c4 + 1] = BF_HI(rq[0]) * sc; qraw[pos * 33 + c4 + 2] = BF_LO(rq[1]) * sc; qraw[pos * 33 + c4 + 3] = BF_HI(rq[1]) * sc;
      kraw[pos * 33 + c4] = BF_LO(rk[0]); kraw[pos * 33 + c4 + 1] = BF_HI(rk[0]); kraw[pos * 33 + c4 + 2] = BF_LO(rk[1]); kraw[pos * 33 + c4 + 3] = BF_HI(rk[1]);
#pragma unroll
      for (int d = 0; d < 2; ++d) {
        const u32x2 rg = d ? rg1 : rg0; const float4 bb = *(const float4*)(gb + d * 128 + h * 32 + c4);
        const int i = d ? 63 - pos : pos;
        float* gd = gl + (d * 64 + i) * 33 + c4;
        gd[0] = logsig16(BF_LO(rg[0]) + bb.x); gd[1] = logsig16(BF_HI(rg[0]) + bb.y); gd[2] = logsig16(BF_LO(rg[1]) + bb.z); gd[3] = logsig16(BF_HI(rg[1]) + bb.w);
      }
#pragma unroll
      for (int j = 0; j < 4; ++j) {
        const unsigned w = j < 2 ? rva[j] : rvb[j - 2]; const int v = c4 * 2 + 2 * j;
        *(u16*)(VT + (0 * 64 + v) * 144 + pos * 2) = (u16)(w & 0xFFFFu); *(u16*)(VT + (1 * 64 + v) * 144 + (63 - pos) * 2) = (u16)(w & 0xFFFFu);
        *(u16*)(VT + (0 * 64 + v + 1) * 144 + pos * 2) = (u16)(w >> 16); *(u16*)(VT + (1 * 64 + v + 1) * 144 + (63 - pos) * 2) = (u16)(w >> 16);
      }
    }
    if (qi + 1 < q_end) { GC_ITEM(qi + 1, bhn, pcn, bn, hn, t0n); GC_LOADRAW(t0n, hn); }
    __syncthreads();
    {
      const int col = tid & 63, d = col >> 5, c = col & 31, part = tid >> 6;
      float* ptot = (float*)(lds + GC_AX);
      float bv[8]; float run = 0.f;
#pragma unroll
      for (int j = 0; j < 8; ++j) { run += gl[(d * 64 + part * 8 + j) * 33 + c]; bv[j] = run; }
      ptot[part * 64 + col] = run;
      __syncthreads();
      float off = 0.f;
#pragma unroll
      for (int q = 0; q < 7; ++q) off += (q < part) ? ptot[q * 64 + col] : 0.f;
#pragma unroll
      for (int j = 0; j < 8; ++j) gl[(d * 64 + part * 8 + j) * 33 + c] = bv[j] + off;
    }
    __syncthreads();
    {
#pragma unroll
      for (int e = 0; e < 2; ++e) {
        const int idx = tid + e * 512, d = idx >> 9, i = (idx >> 3) & 63, c4 = (idx & 7) * 4, pos = d ? 63 - i : i;
        float qo[4], ko[4];
#pragma unroll
        for (int j = 0; j < 4; ++j) {
          const float bi = gl[(d * 64 + i) * 33 + c4 + j], bm = gl[(d * 64 + 31) * 33 + c4 + j];
          qo[j] = qraw[pos * 33 + c4 + j] * __expf(bi - bm); ko[j] = kraw[pos * 33 + c4 + j] * __expf(bm - bi);
        }
        *(u32x2*)(Qp + (d * 64 + i) * 80 + c4 * 2) = u32x2{cvtpk(qo[0], qo[1]), cvtpk(qo[2], qo[3])};
        *(u32x2*)(Kp + (d * 64 + i) * 80 + c4 * 2) = u32x2{cvtpk(ko[0], ko[1]), cvtpk(ko[2], ko[3])};
      }
      const int chain = sdir * 8 + b * 4 + h;
      const int n = sdir == 0 ? pc : (pc < 4 ? 3 - pc : 4 + 255 - (pc - 4)), g = n / GLG;
      if (g != g_cached || bh != bh_cached) {
#pragma unroll
        for (int j = 0; j < 8; ++j) G[j] = 0.f;
        const float* at = p.gst() + (size_t)chain * NGRP * 2048 + sk * 64 + sv0;
        const float* dt = p.gst() + (size_t)16 * NGRP * 2048 + (size_t)chain * NGRP * 32 + sk;
        for (int gg = 0; gg < g; ++gg) {
          const float4 a0 = *(const float4*)(at + (size_t)gg * 2048), a1 = *(const float4*)(at + (size_t)gg * 2048 + 4); const float dd = dt[gg * 32];
          G[0] = G[0] * dd + a0.x; G[1] = G[1] * dd + a0.y; G[2] = G[2] * dd + a0.z; G[3] = G[3] * dd + a0.w;
          G[4] = G[4] * dd + a1.x; G[5] = G[5] * dd + a1.y; G[6] = G[6] * dd + a1.z; G[7] = G[7] * dd + a1.w;
        }
        g_cached = g; bh_cached = bh;
      }
      const float4 l0 = pl0, l1 = pl1; const float dp = pdp;
      const float em = __expf(gl[(sdir * 64 + 31) * 33 + sk]);
      const float sv[8] = {l0.x + dp * G[0], l0.y + dp * G[1], l0.z + dp * G[2], l0.w + dp * G[3], l1.x + dp * G[4], l1.y + dp * G[5], l1.z + dp * G[6], l1.w + dp * G[7]};
      if (qi + 1 < q_end) { GC_ITEM(qi + 1, bhn, pcn, bn, hn, t0n); (void)bhn; (void)t0n; GC_LOADST(pcn, bn, hn); }
#pragma unroll
      for (int j = 0; j < 8; ++j) *(u16*)(ST + (sdir * 64 + sv0 + j) * 80 + sk * 2) = f2bf(sv[j] * em);
    }
    __syncthreads();
    {
      const int d = wid >> 2, ib = (wid >> 1) & 1, vb = wid & 1;
      const char* Qd = Qp + d * 64 * 80; const char* Kd = Kp + d * 64 * 80; const char* Vd = VT + d * 64 * 144; const char* Sd = ST + d * 64 * 80;
      bf16x8 qf[2];
#pragma unroll
      for (int s2 = 0; s2 < 2; ++s2) qf[s2] = *(const bf16x8*)(Qd + (ib * 32 + r32) * 80 + (16 * s2 + 8 * hi) * 2);
#pragma unroll
      for (int jb = 0; jb < 2; ++jb) {
        if (jb <= ib) {
          f32x16 x = {};
#pragma unroll
          for (int s2 = 0; s2 < 2; ++s2) {
            const bf16x8 kf = *(const bf16x8*)(Kd + (jb * 32 + r32) * 80 + (16 * s2 + 8 * hi) * 2);
            x = __builtin_amdgcn_mfma_f32_32x32x16_bf16(qf[s2], kf, x, 0, 0, 0);
          }
#pragma unroll
          for (int r = 0; r < 16; ++r) {
            const int il = crow(r, hi), i = ib * 32 + il, j = jb * 32 + r32;
            *(u16*)(Ax + il * 144 + j * 2) = f2bf(j <= i ? x[r] : 0.f);
          }
        }
      }
      asm volatile("s_waitcnt lgkmcnt(0)" ::: "memory");
      f32x16 o = {};
#pragma unroll
      for (int s4 = 0; s4 < 4; ++s4) {
        if (s4 < 2 * (ib + 1)) {
          const bf16x8 af = *(const bf16x8*)(Ax + r32 * 144 + (16 * s4 + 8 * hi) * 2);
          const bf16x8 vf = *(const bf16x8*)(Vd + (vb * 32 + r32) * 144 + (16 * s4 + 8 * hi) * 2);
          o = __builtin_amdgcn_mfma_f32_32x32x16_bf16(af, vf, o, 0, 0, 0);
        }
      }
#pragma unroll
      for (int s2 = 0; s2 < 2; ++s2) {
        const bf16x8 sf = *(const bf16x8*)(Sd + (vb * 32 + r32) * 80 + (16 * s2 + 8 * hi) * 2);
        o = __builtin_amdgcn_mfma_f32_32x32x16_bf16(qf[s2], sf, o, 0, 0, 0);
      }
#pragma unroll
      for (int r = 0; r < 16; ++r) {
        const int i = ib * 32 + crow(r, hi), pos = d ? 63 - i : i;
        Of[(d * 64 + pos) * 65 + vb * 32 + r32] = o[r];
      }
    }
    __syncthreads();
    {
      const int pos = tid >> 3, v0 = (tid & 7) * 8;
      float r8[8]; float ss = 0.f;
#pragma unroll
      for (int j = 0; j < 8; ++j) { r8[j] = Of[pos * 65 + v0 + j] + Of[(64 + pos) * 65 + v0 + j]; ss += r8[j] * r8[j]; }
      ss += shx<4>(ss); ss += shx<2>(ss); ss += shx<1>(ss);
      const float rs = rsqrtf(ss * (1.f / 64.f) + EPS);
      const u16* og = p.zg() + (size_t)(tok0 + pos) * ZG_W + ZG_OG + h * 64 + v0;
      const float4 g0 = ld4bf(og), g1 = ld4bf(og + 4);
      *(u32x4*)(p.ymix() + (size_t)(tok0 + pos) * DM + 512 + h * 64 + v0) =
          u32x4{cvtpk(r8[0] * rs * silu_f(g0.x), r8[1] * rs * silu_f(g0.y)), cvtpk(r8[2] * rs * silu_f(g0.z), r8[3] * rs * silu_f(g0.w)),
                cvtpk(r8[4] * rs * silu_f(g1.x), r8[5] * rs * silu_f(g1.y)), cvtpk(r8[6] * rs * silu_f(g1.z), r8[7] * rs * silu_f(g1.w))};
    }
    __syncthreads();
  }
}

__device__ __forceinline__ void phase_mix(const Params& p, int layer, int bid, int nb, char* lds) {
  float* part = (float*)lds;
  u16* tile = (u16*)(lds + 4096);
  const int tid = ltid(), wid = tid >> 6, lane = tid & 63;
  const int ntok = layer == 0 ? TT : TL;
  for (int it = bid; it < ntok / 64; it += nb) {
    const int tok0 = it * 64;
    float vh[32], vf[32]; float sh = 0, sf = 0;
#pragma unroll
    for (int c = 0; c < 32; ++c) {
      vh[c] = bf2f(p.hyo()[(size_t)(wid * 32 + c) * TT + tok0 + lane]); vf[c] = bf2f(p.fno()[(size_t)(wid * 32 + c) * TT + tok0 + lane]);
      sh += vh[c] * vh[c]; sf += vf[c] * vf[c];
    }
    part[(0 * 8 + wid) * 64 + lane] = sh; part[(1 * 8 + wid) * 64 + lane] = sf;
    __syncthreads();
    float th = 0, tf = 0;
#pragma unroll
    for (int q = 0; q < 8; ++q) { th += part[(0 * 8 + q) * 64 + lane]; tf += part[(1 * 8 + q) * 64 + lane]; }
    const float rh = rsqrtf(th * (1.f / 256.f) + EPS), rf = rsqrtf(tf * (1.f / 256.f) + EPS);
#pragma unroll
    for (int c = 0; c < 32; ++c) { tile[lane * 520 + wid * 32 + c] = f2bf(vh[c] * rh); tile[lane * 520 + 256 + wid * 32 + c] = f2bf(vf[c] * rf); }
    __syncthreads();
    for (int g = tid; g < 64 * 64; g += NTHR) {
      const int tl = g >> 6, cg = g & 63;
      const u32x4 w = *(const u32x4*)(tile + tl * 520 + cg * 8);
      *(u32x4*)(p.ymix() + (size_t)(tok0 + tl) * DM + (cg < 32 ? 256 + cg * 8 : 768 + (cg - 32) * 8)) = w;
    }
    __syncthreads();
  }
}

struct EpiOut {
  const Params* pp; int layer;
  __device__ __forceinline__ void pre(const G8Unit& u, int, int, float (&)[8], float* cb) const {
    if ((ltid() >> 6) == 0) g8_cload(pp->mod() + ((size_t)layer * 3 + modv(u.pm * 256)) * 6144 + 2 * DM + u.pn * 256, cb);
  }
  __device__ __forceinline__ void operator()(const f32x4 (&acc)[2][2][4][2], const G8Unit& u, int wr, int wc, int fr, int fq, const float (&)[8], const float* cb) const {
    const Params& p = *pp;
#pragma unroll
    for (int bj = 0; bj < 2; ++bj) {
      const int c0 = u.pn * 256 + bj * 128 + wc * 32 + 8 * fq;
      const f32x4 ga = *(const f32x4*)(cb + bj * 128 + wc * 32 + 8 * fq), gb = *(const f32x4*)(cb + bj * 128 + wc * 32 + 8 * fq + 4);
#pragma unroll
      for (int ai = 0; ai < 2; ++ai)
#pragma unroll
        for (int m = 0; m < 4; ++m) {
          const int tok = u.pm * 256 + ai * 128 + wr * 64 + m * 16 + fr;
          u16* xo = p.X() + (size_t)tok * DM + c0;
          f32x4 xa, xb;
          if (layer == 0) { const float* xr = resid_row_in(p, tok) + c0; xa = *(const f32x4*)xr; xb = *(const f32x4*)(xr + 4); }
          else { const u32x4 w = *(const u32x4*)xo;
            xa = f32x4{__uint_as_float(w[0] << 16), __uint_as_float(w[0] & 0xFFFF0000u), __uint_as_float(w[1] << 16), __uint_as_float(w[1] & 0xFFFF0000u)};
            xb = f32x4{__uint_as_float(w[2] << 16), __uint_as_float(w[2] & 0xFFFF0000u), __uint_as_float(w[3] << 16), __uint_as_float(w[3] & 0xFFFF0000u)}; }
          xa = xa + ga * acc[ai][bj][m][0]; xb = xb + gb * acc[ai][bj][m][1];
          *(u32x4*)xo = u32x4{cvtpk(xa[0], xa[1]), cvtpk(xa[2], xa[3]), cvtpk(xb[0], xb[1]), cvtpk(xb[2], xb[3])};
        }
    }
  }
};
__device__ __forceinline__ void phase_gemm_out(const Params& p, int layer, int bid, int nb, char* lds) {
  G8Plain S; S.nM = (layer == 0 ? TT : TL) / 256; S.nN = DM / 256; S.Kb = 2 * DM; S.G = nb; S.c = bid; S.Bt = (const char*)(p.bt_out() + (size_t)layer * DM * DM);
  EpiOut E; E.pp = &p; E.layer = layer;
  gemm8_phase<false>(lds, (const char*)p.ymix(), 2 * DM, S, E);
}

__device__ __forceinline__ void phase_norm2_router(const Params& p, int layer, int bid, int nb, char* lds) {
  float* rwl = (float*)lds;
  int* lcnt = (int*)(lds + 131072);
  int* lbase = lcnt + 32;
  int* ent = lbase + 32;
  float* entw = (float*)(ent + 2 * 640);
  float* ents = entw + 640;
  const int tid = ltid(), wid = tid >> 6, lane = tid & 63;
  const int ntok = layer == 0 ? TT : TL;
  const float* rw = p.router_w() + (size_t)layer * DM * NE;
  for (int i = tid; i < DM * NE / 4; i += NTHR) {
    const int k = i >> 3, q4 = i & 7;
    ((float4*)rwl)[q4 * 1024 + ((k & 3) * 256 + (k >> 2))] = ((const float4*)rw)[i];
  }
  if (tid < 32) lcnt[tid] = 0;
  __syncthreads();
  const float* gn = p.norm2_g() + layer * DM; const float* rb = p.router_b() + layer * NE;
  const int per = (ntok + nb - 1) / nb, t_beg = bid * per, t_end = min(ntok, t_beg + per);
  for (int tok = t_beg + wid; tok < t_end; tok += 8) {
    const u16* xr = p.X() + (size_t)tok * DM;
    float v[16];
#pragma unroll
    for (int i = 0; i < 4; ++i) { const float4 a = ld4bf(xr + lane * 4 + i * 256); v[4 * i] = a.x; v[4 * i + 1] = a.y; v[4 * i + 2] = a.z; v[4 * i + 3] = a.w; }
    float ss = 0;
#pragma unroll
    for (int i = 0; i < 16; ++i) ss += v[i] * v[i];
    ss = wave_sum(ss);
    const float rs = rsqrtf(ss * (1.f / DM) + EPS);
    const float* md = p.mod() + ((size_t)layer * 3 + modv(tok)) * 6144 + 3 * DM;
#pragma unroll
    for (int i = 0; i < 4; ++i) {
      const int c = lane * 4 + i * 256;
      const float4 g = *(const float4*)(gn + c), sh = *(const float4*)(md + c), sc = *(const float4*)(md + DM + c);
      v[4 * i] = v[4 * i] * rs * g.x * (1.f + sc.x) + sh.x; v[4 * i + 1] = v[4 * i + 1] * rs * g.y * (1.f + sc.y) + sh.y;
      v[4 * i + 2] = v[4 * i + 2] * rs * g.z * (1.f + sc.z) + sh.z; v[4 * i + 3] = v[4 * i + 3] * rs * g.w * (1.f + sc.w) + sh.w;
    }
    const float rowsc = store_row_i8(v, p.H() + (size_t)tok * DM, p.hs() + tok, lane);
    float lg[32];
#pragma unroll
    for (int e = 0; e < 32; ++e) lg[e] = 0.f;
#pragma unroll
    for (int i = 0; i < 16; ++i) {
      const float4* wr4 = (const float4*)rwl + ((i & 3) * 256 + (i >> 2) * 64 + lane);
#pragma unroll
      for (int q = 0; q < 8; ++q) { const float4 w = wr4[q * 1024]; lg[4 * q] += v[i] * w.x; lg[4 * q + 1] += v[i] * w.y; lg[4 * q + 2] += v[i] * w.z; lg[4 * q + 3] += v[i] * w.w; }
    }
    float r16[16], r8[8], r4[4], r2[2], lv;
    { const bool up = lane & 32;
#pragma unroll
      for (int e = 0; e < 16; ++e) { const float keep = up ? lg[16 + e] : lg[e], send = up ? lg[e] : lg[16 + e]; r16[e] = keep + shx<32>(send); } }
    { const bool up = lane & 16;
#pragma unroll
      for (int e = 0; e < 8; ++e) { const float keep = up ? r16[8 + e] : r16[e], send = up ? r16[e] : r16[8 + e]; r8[e] = keep + shx<16>(send); } }
    { const bool up = lane & 8;
#pragma unroll
      for (int e = 0; e < 4; ++e) { const float keep = up ? r8[4 + e] : r8[e], send = up ? r8[e] : r8[4 + e]; r4[e] = keep + shx<8>(send); } }
    { const bool up = lane & 4;
#pragma unroll
      for (int e = 0; e < 2; ++e) { const float keep = up ? r4[2 + e] : r4[e], send = up ? r4[e] : r4[2 + e]; r2[e] = keep + shx<4>(send); } }
    { const bool up = lane & 2; const float keep = up ? r2[1] : r2[0], send = up ? r2[0] : r2[1]; lv = keep + shx<2>(send); }
    lv += shx<1>(lv);
    lv += rb[lane >> 1];
    int ids[4]; float vals[4];
#pragma unroll
    for (int k = 0; k < 4; ++k) {
      const float mx = wave_max(lv);
      const unsigned long long bal = __ballot(lv == mx);
      const int win = __ffsll((long long)bal) - 1;
      ids[k] = win >> 1; vals[k] = mx;
      if ((lane >> 1) == ids[k]) lv = -3.4e38f;
    }
    if (lane == 0) {
      const float mx = vals[0];
      float ex[4], sum = 0;
#pragma unroll
      for (int k = 0; k < 4; ++k) { ex[k] = __expf(vals[k] - mx); sum += ex[k]; }
      const float inv = 1.f / sum;
#pragma unroll
      for (int k = 0; k < 4; ++k) {
        const int lp = atomicAdd(&lcnt[ids[k]], 1);
        const int slot = (tok - t_beg) * 4 + k;
        ent[2 * slot] = tok * 4 + k; ent[2 * slot + 1] = (ids[k] << 20) | lp; entw[slot] = ex[k] * inv; ents[slot] = rowsc;
      }
    }
  }
  __syncthreads();
  if (tid < 32) lbase[tid] = atomicAdd(&p.cnt()[layer * NE + tid], lcnt[tid]);
  __syncthreads();
  const int nas = (t_end > t_beg ? (t_end - t_beg) : 0) * 4;
  for (int s = tid; s < nas; s += NTHR) {
    const int tk = ent[2 * s], el = ent[2 * s + 1], e = el >> 20, pos = lbase[e] + (el & 0xFFFFF);
    p.rtok()[(size_t)e * TT + pos] = tk >> 2; p.rw()[(size_t)e * TT + pos] = entw[s]; p.rsc()[(size_t)e * TT + pos] = ents[s];
    p.tslot()[tk] = (e << 20) | pos;
  }
}

struct G8Moe {
  const int* cnt;
  int ntn, Kb, G, c; const char* Bt; size_t bstride;
  const int* rtok;
  __device__ __forceinline__ bool next(int i, G8Unit& u) const {
    const int w = (i * 8 + (c & 7)) * (G >> 3) + (c >> 3); int acc = 0, rows = 0;
    for (int ee = 0; ee < NE; ++ee) {
      const int cc = cnt[ee], tiles = ((cc + 255) >> 8) * ntn;
      if (w < acc + tiles) { const int r = w - acc; u.e = ee; u.pm = r / ntn; u.pn = r % ntn; u.ce = cc; u.pre = rows; return true; }
      acc += tiles; rows += cc;
    }
    return false;
  }
  __device__ __forceinline__ unsigned a_off(const G8Unit& u, int row) const {
    const int r = min(u.pm * 256 + row, u.ce - 1);
    const int arow = rtok ? rtok[(size_t)u.e * TT + r] : u.pre + r;
    return (unsigned)arow * (unsigned)Kb;
  }
  __device__ __forceinline__ const char* b_ptr(const G8Unit& u) const { return Bt + (size_t)u.e * bstride + (size_t)u.pn * 256 * Kb; }
};
struct EpiGu {
  const float* bgl; u16* act; const float* rsc; const float* swl;
  __device__ __forceinline__ void pre(const G8Unit& u, int wr, int fr, float (&ep)[8], float* cb) const {
    if ((ltid() >> 6) == 0) g8_cload(bgl + (size_t)u.e * 2048 + u.pn * 256, cb);
    if ((ltid() >> 6) == 1) g8_cload(swl + (size_t)u.e * 2048 + u.pn * 256, cb + 256);
#pragma unroll
    for (int ai = 0; ai < 2; ++ai)
#pragma unroll
      for (int m = 0; m < 4; ++m) ep[ai * 4 + m] = rsc[(size_t)u.e * TT + min(u.pm * 256 + ai * 128 + wr * 64 + m * 16 + fr, u.ce - 1)];
  }
  __device__ __forceinline__ void operator()(const i32x4 (&acc)[2][2][4][2], const G8Unit& u, int wr, int wc, int fr, int fq, const float (&ep)[8], const float* cb) const {
    const int j0 = u.pn * 128 + wc * 32 + 8 * fq;
    typedef float f2v __attribute__((ext_vector_type(2)));
    const float* bg = cb + 2 * (wc * 32 + 8 * fq);
    f2v bgt[4], bup[4], sg[4], su[4];
#pragma unroll
    for (int q = 0; q < 4; ++q) { const f32x4 t = *(const f32x4*)(bg + 4 * q); bgt[q] = f2v{t[0], t[2]}; bup[q] = f2v{t[1], t[3]}; asm volatile("" : "+v"(bgt[q]), "+v"(bup[q])); }
    {
      const float* sp = cb + 256 + wc * 32 + 8 * fq;
      const f32x4 g0 = *(const f32x4*)sp, g1 = *(const f32x4*)(sp + 4), u0 = *(const f32x4*)(sp + 128), u1 = *(const f32x4*)(sp + 132);
      sg[0] = f2v{g0[0], g0[1]}; sg[1] = f2v{g0[2], g0[3]}; sg[2] = f2v{g1[0], g1[1]}; sg[3] = f2v{g1[2], g1[3]};
      su[0] = f2v{u0[0], u0[1]}; su[1] = f2v{u0[2], u0[3]}; su[2] = f2v{u1[0], u1[1]}; su[3] = f2v{u1[2], u1[3]};
    }
    const f2v kexp = f2v{-1.702f * 1.4426950408889634f, -1.702f * 1.4426950408889634f}, one2 = f2v{1.f, 1.f};
#pragma unroll
    for (int ai = 0; ai < 2; ++ai)
#pragma unroll
      for (int m = 0; m < 4; ++m) {
        const int r = u.pm * 256 + ai * 128 + wr * 64 + m * 16 + fr;
        if (r < u.ce) {
          const float sa = ep[ai * 4 + m]; const f2v sa2 = f2v{sa, sa};
          unsigned ow[4];
#pragma unroll
          for (int n = 0; n < 2; ++n)
#pragma unroll
            for (int jp = 0; jp < 2; ++jp) {
              const int q = 2 * n + jp;
              f2v g = f2v{(float)acc[ai][0][m][n][2 * jp], (float)acc[ai][0][m][n][2 * jp + 1]};
              f2v v = f2v{(float)acc[ai][1][m][n][2 * jp], (float)acc[ai][1][m][n][2 * jp + 1]};
              g = (g * sa2) * sg[q] + bgt[q];
              v = (v * sa2) * su[q] + bup[q];
              g = f2v{fminf(g[0], 7.f), fminf(g[1], 7.f)};
              v = f2v{__builtin_amdgcn_fmed3f(v[0], -7.f, 7.f), __builtin_amdgcn_fmed3f(v[1], -7.f, 7.f)};
              const f2v t = g * kexp;
              const f2v d = f2v{__builtin_amdgcn_exp2f(t[0]), __builtin_amdgcn_exp2f(t[1])} + one2;
              const f2v rr = f2v{__builtin_amdgcn_rcpf(d[0]), __builtin_amdgcn_rcpf(d[1])};
              const f2v o = (v * g + g) * rr;
              ow[q] = cvtpk(o[0], o[1]);
            }
          *(u32x4*)(act + (size_t)(u.pre + r) * DFF + j0) = u32x4{ow[0], ow[1], ow[2], ow[3]};
        }
      }
  }
};
struct EpiDn {
  const float* bdl; const float* rw; unsigned char* yd;
  __device__ __forceinline__ void pre(const G8Unit& u, int wr, int fr, float (&ep)[8], float* cb) const {
    if ((ltid() >> 6) == 0) g8_cload(bdl + (size_t)u.e * DM + u.pn * 256, cb);
#pragma unroll
    for (int ai = 0; ai < 2; ++ai)
#pragma unroll
      for (int m = 0; m < 4; ++m) ep[ai * 4 + m] = rw[(size_t)u.e * TT + min(u.pm * 256 + ai * 128 + wr * 64 + m * 16 + fr, u.ce - 1)];
  }
  __device__ __forceinline__ void operator()(const f32x4 (&acc)[2][2][4][2], const G8Unit& u, int wr, int wc, int fr, int fq, const float (&ep)[8], const float* cb) const {
#pragma unroll
    for (int bj = 0; bj < 2; ++bj) {
      const int c0 = u.pn * 256 + bj * 128 + wc * 32 + 8 * fq;
      const f32x4 ba = *(const f32x4*)(cb + bj * 128 + wc * 32 + 8 * fq), bb = *(const f32x4*)(cb + bj * 128 + wc * 32 + 8 * fq + 4);
#pragma unroll
      for (int ai = 0; ai < 2; ++ai)
#pragma unroll
        for (int m = 0; m < 4; ++m) {
          const int r = u.pm * 256 + ai * 128 + wr * 64 + m * 16 + fr;
          if (r < u.ce) {
            const float wgt = ep[ai * 4 + m];
            const float w8 = wgt * 8.f;
            f32x4 a = (acc[ai][bj][m][0] + ba) * w8, b = (acc[ai][bj][m][1] + bb) * w8;
#pragma unroll
            for (int j = 0; j < 4; ++j) { a[j] = fminf(fmaxf(a[j], -440.f), 440.f); b[j] = fminf(fmaxf(b[j], -440.f), 440.f); }
            int w0 = 0, w1 = 0;
            w0 = __builtin_amdgcn_cvt_pk_fp8_f32(a[0], a[1], w0, false); w0 = __builtin_amdgcn_cvt_pk_fp8_f32(a[2], a[3], w0, true);
            w1 = __builtin_amdgcn_cvt_pk_fp8_f32(b[0], b[1], w1, false); w1 = __builtin_amdgcn_cvt_pk_fp8_f32(b[2], b[3], w1, true);
            *(u32x2*)(yd + (size_t)(u.pre + r) * DM + c0) = u32x2{(unsigned)w0, (unsigned)w1};
          }
        }
    }
  }
};
__device__ __forceinline__ void phase_moe_gu(const Params& p, int layer, int bid, int nb, char* lds) {
  int* scnt = (int*)(lds + 131072);
  if (ltid() < NE) scnt[ltid()] = p.cnt()[layer * NE + ltid()];
  __syncthreads();
  G8Moe S; S.cnt = scnt; S.ntn = 8; S.Kb = DM; S.G = nb; S.c = bid; S.Bt = (const char*)(p.bt_gu() + (size_t)layer * NE * 2048 * DM); S.bstride = (size_t)2048 * DM; S.rtok = p.rtok();
  EpiGu E; E.bgl = p.moe_b_gu() + (size_t)layer * NE * 2048; E.act = p.act(); E.rsc = p.rsc(); E.swl = p.swgu() + (size_t)layer * NE * 2048;
  gemm8_phase<true>(lds, (const char*)p.H(), DM, S, E);
}
__device__ __forceinline__ void phase_moe_dn(const Params& p, int layer, int bid, int nb, char* lds) {
  int* scnt = (int*)(lds + 131072);
  if (ltid() < NE) scnt[ltid()] = p.cnt()[layer * NE + ltid()];
  __syncthreads();
  G8Moe S; S.cnt = scnt; S.ntn = 4; S.Kb = 2 * DFF; S.G = nb; S.c = bid; S.Bt = (const char*)(p.bt_dn() + (size_t)layer * NE * DM * DFF); S.bstride = (size_t)DM * DFF * 2; S.rtok = nullptr;
  EpiDn E; E.bdl = p.moe_b_down() + (size_t)layer * NE * DM; E.rw = p.rw(); E.yd = p.yd();
  gemm8_phase<false>(lds, (const char*)p.act(), 2 * DFF, S, E);
}

__device__ __forceinline__ void phase_final(const Params& p, int bid, int nb, char* lds) {
  int* pre = (int*)lds;
  expert_prefix(p.cnt() + NE, pre); __syncthreads();
  const int wid = ltid() >> 6, lane = ltid() & 63;
  for (int tok = bid * 8 + wid; tok < TL; tok += nb * 8) {
    float v[16];
    load_row_comb(p, 1, 1, tok, lane, pre, v);
    float ss = 0;
#pragma unroll
    for (int i = 0; i < 16; ++i) ss += v[i] * v[i];
    ss = wave_sum(ss);
    const float rs = rsqrtf(ss * (1.f / DM) + EPS);
    float* o = p.out() + (size_t)tok * DM;
#pragma unroll
    for (int i = 0; i < 4; ++i) {
      const int c = lane * 4 + i * 256;
      const float4 g = *(const float4*)(p.final_g() + c);
      *(float4*)(o + c) = make_float4(v[4 * i] * rs * g.x, v[4 * i + 1] * rs * g.y, v[4 * i + 2] * rs * g.z, v[4 * i + 3] * rs * g.w);
    }
  }
}

#define XB_TMO      128
#define XB_XCNT(j)  (256  + 64 * (j))
#define XB_XSUB(j)  (1280 + 64 * (j))
#define XB_XGEN(j)  (2304 + 64 * (j))
#define XB_TOP      3328
#define XB_TOPGEN   3392
#define XCD_BAR_WORDS 3456
#define XB_SPIN_CAP (1u << 18)
#define LAS __attribute__((address_space(3)))

__device__ __forceinline__ unsigned xb_ld(unsigned* p)              { return __hip_atomic_load(p, __ATOMIC_RELAXED, __HIP_MEMORY_SCOPE_AGENT); }
__device__ __forceinline__ unsigned xb_add(unsigned* p, unsigned v) { return __hip_atomic_fetch_add(p, v, __ATOMIC_RELAXED, __HIP_MEMORY_SCOPE_AGENT); }
__device__ __forceinline__ unsigned xb_xcc_id() { return (unsigned)__builtin_amdgcn_s_getreg((3 << 11) | 20) & 0xFu; }
#define XB_SPIN(cond, bar) do { unsigned _sp = 0; while (cond) { __builtin_amdgcn_s_sleep(1); \
    if ((++_sp & 255u) == 0u) { if (xb_ld(&(bar)[XB_TMO])) break; if (_sp > XB_SPIN_CAP) { atomicAdd(&(bar)[XB_TMO], 1u); break; } } } } while (0)

struct XcdBarrier {
    unsigned* bar; unsigned x;
    volatile LAS unsigned* st;
};

__device__ __forceinline__ XcdBarrier xcd_barrier_post(unsigned* bar, volatile LAS unsigned* st) {
    XcdBarrier b; b.bar = bar; b.x = xb_xcc_id(); b.st = st;
    if (threadIdx.x == 0) (void)xb_add(&bar[XB_XCNT(b.x)], 1u);
    return b;
}
__device__ __forceinline__ void xcd_barrier_complete(unsigned* bar, unsigned x, unsigned& nloc, unsigned& nx) {
    const unsigned G = gridDim.x * gridDim.y * gridDim.z;
    unsigned sum, cnt, mine, sp = 0u;
    for (;;) {
        sum = 0u; cnt = 0u; mine = 0u;
#pragma unroll
        for (unsigned j = 0; j < 16; ++j) { const unsigned c = xb_ld(&bar[XB_XCNT(j)]); sum += c; cnt += (c > 0u) ? 1u : 0u; mine = (j == x) ? c : mine; }
        if (sum == G) break;
        __builtin_amdgcn_s_sleep(1);
        if ((++sp & 255u) == 0u) { if (xb_ld(&bar[XB_TMO])) break; if (sp > XB_SPIN_CAP) { atomicAdd(&bar[XB_TMO], 1u); break; } }
    }
    nloc = mine > 0u ? mine : 1u; nx = cnt > 0u ? cnt : 1u;
}

__device__ __forceinline__ void xcd_barrier(const XcdBarrier& b) {
    asm volatile("s_waitcnt vmcnt(0)" ::: "memory");
    __syncthreads();
    if (threadIdx.x == 0) {
        unsigned* bar = b.bar;
        __builtin_amdgcn_s_waitcnt(0);
        unsigned nloc = b.st[0], nx = b.st[1];
        if (nloc == 0u) { xcd_barrier_complete(bar, b.x, nloc, nx); b.st[0] = nloc; b.st[1] = nx; }
        const unsigned old = xb_add(&bar[XB_XSUB(b.x)], 1u);
        const unsigned gen = old / nloc;
        if (old + 1u == (gen + 1u) * nloc) {
            __builtin_amdgcn_fence(__ATOMIC_RELEASE, "agent");
            asm volatile("s_waitcnt vmcnt(0)" ::: "memory");
            const unsigned og = xb_add(&bar[XB_TOP], 1u);
            const unsigned tg = og / nx;
            if (og + 1u == (tg + 1u) * nx) xb_add(&bar[XB_TOPGEN], 1u);
            else XB_SPIN(xb_ld(&bar[XB_TOPGEN]) == tg, bar);
            __builtin_amdgcn_fence(__ATOMIC_ACQUIRE, "agent");
            xb_add(&bar[XB_XGEN(b.x)], 1u);
            asm volatile("s_waitcnt vmcnt(0)" ::: "memory");
        } else {
            XB_SPIN(xb_ld(&bar[XB_XGEN(b.x)]) == gen, bar);
            __builtin_amdgcn_fence(__ATOMIC_ACQUIRE, "agent");
            asm volatile("s_waitcnt vmcnt(0)" ::: "memory");
        }
    }
    __syncthreads();
}


constexpr int LDS_MAIN = 147456;
constexpr int LDS_BYTES = LDS_MAIN + 1024;
enum { PH_TABLES = 0, PH_MOD, PH_FOLD, PH_CONVERT, PH_HYMLP, PH_HYFILT, PH_NORM1, PH_GEMM_IN, PH_QKV, PH_ATTN, PH_FFTMIX,
       PH_GLA_A, PH_GLA_B, PH_GLA_C, PH_MIX, PH_GEMM_OUT, PH_NORM2, PH_MOE_GU, PH_MOE_DN, PH_FINAL };

__device__ __forceinline__ Params make_params() {
  const __attribute__((address_space(4))) char* kb = (const __attribute__((address_space(4))) char*)__builtin_amdgcn_kernarg_segment_ptr();
  asm volatile("" : "+s"(kb));
  Params p; p.kb = kb; return p;
}
#ifndef MK_LAUNCHES
#define MK_LAUNCHES 1
#endif
__global__ void __launch_bounds__(NTHR, 2) k_mega(ParamsData pd) {
  extern __shared__ __attribute__((aligned(1024))) char lds[];
  const int bid = blockIdx.x, nb = gridDim.x;
  if (threadIdx.x == 0) *(uint4*)(lds + LDS_MAIN) = make_uint4(0u, 0u, 0u, 0u);
  __syncthreads();
  XcdBarrier bar = xcd_barrier_post(make_params().bar(), (volatile LAS unsigned*)(lds + LDS_MAIN));
#ifndef DBLMASK
#define DBLMASK 0u
#endif
#define RUNPH(bit, call) do { call; if (DBLMASK & (1u << (bit))) { __syncthreads(); call; } } while (0)
  RUNPH(13, phase_tables(make_params(), bid, nb); phase_mod(make_params(), bid, nb, lds); phase_fold(make_params(), bid, nb, lds));
  RUNPH(0, phase_convert(make_params(), bid, nb, lds));
  phase_hy_mlp(make_params(), 0, SEQ, make_params().hfb(), make_params().hpart(), bid, nb, lds);
  phase_hy_mlp(make_params(), 1, SEQ, make_params().hfb() + (size_t)2 * 256 * SEQ, make_params().hpart() + 256 * 512, bid, nb, lds);
  phase_hy_mlp(make_params(), 0, LC, make_params().hfc(), make_params().hpart() + 2 * 256 * 512, bid, nb, lds);
  xcd_barrier(bar);
  RUNPH(2, phase_hy_filtfft(make_params(), bid, nb, lds));
  phase_quant_in(make_params(), bid, nb);
#define MK_LAYER(l) do { \
  phase_norm1(make_params(), l, bid, nb, lds); if ((DBLMASK & (1u << 14)) && l == 0) { __syncthreads(); phase_norm1(make_params(), l, bid, nb, lds); } \
  xcd_barrier(bar); \
  RUNPH(3, phase_gemm_in(make_params(), l, bid, nb, lds)); \
  xcd_barrier(bar); \
  RUNPH(4, phase_qkv(make_params(), l, bid, nb, lds)); \
  RUNPH(5, phase_gla_a(make_params(), l, bid, nb, lds)); \
  RUNPH(7, phase_fftmix(make_params(), l, bid, nb, lds)); \
  xcd_barrier(bar); \
  RUNPH(6, phase_attn(make_params(), l, bid, nb, lds)); \
  RUNPH(9, phase_gla_c(make_params(), l, bid, nb, lds)); \
  RUNPH(10, phase_mix(make_params(), l, bid, nb, lds)); \
  xcd_barrier(bar); \
  phase_gemm_out(make_params(), l, bid, nb, lds); if ((DBLMASK & (1u << 16)) && l == 0) { __syncthreads(); phase_gemm_out(make_params(), l, bid, nb, lds); } \
  xcd_barrier(bar); \
  phase_norm2_router(make_params(), l, bid, nb, lds); \
  xcd_barrier(bar); \
  RUNPH(11, phase_moe_gu(make_params(), l, bid, nb, lds)); \
  xcd_barrier(bar); \
  RUNPH(12, phase_moe_dn(make_params(), l, bid, nb, lds)); \
  xcd_barrier(bar); \
  } while (0)
  MK_LAYER(0);
  MK_LAYER(1);
#undef MK_LAYER
  RUNPH(15, phase_final(make_params(), bid, nb, lds));
}
static size_t carve(char*& cur, size_t bytes) { char* r = cur; cur += (bytes + 1023) & ~(size_t)1023; return (size_t)(uintptr_t)r; }
#define CARVE(T, field, n) p.field = (T*)carve(cur, (size_t)(n) * sizeof(T))

extern "C" void kernel_launch(void* const* d_in, const int* in_sizes, int n_in, void* d_out, int out_size, void* d_ws, size_t ws_size, hipStream_t stream) {
  ParamsData p; memset(&p, 0, sizeof(p));
  const float** ins = (const float**)&p;
  for (int i = 0; i < 34; ++i) ins[i] = (const float*)d_in[i];
  p.out_ = (float*)d_out;
  p.ws_ = (char*)d_ws;
  if (WS_TOTAL > ws_size) { fprintf(stderr, "workspace too small: need %zu have %zu\n", (size_t)WS_TOTAL, ws_size); return; }
  hipMemsetAsync((char*)d_ws + OFF_bar, 0, OFF_mod - OFF_bar, stream);
  static int grid = 0;
  if (!grid) {
    int dev = 0, cus = 0, per_cu = 0;
    hipGetDevice(&dev);
    hipDeviceGetAttribute(&cus, hipDeviceAttributeMultiprocessorCount, dev);
    hipFuncSetAttribute((const void*)k_mega, hipFuncAttributeMaxDynamicSharedMemorySize, LDS_BYTES);
    hipOccupancyMaxActiveBlocksPerMultiprocessor(&per_cu, (const void*)k_mega, NTHR, LDS_BYTES);
    grid = cus * (per_cu < 1 ? per_cu : 1);
    if (grid != 256) fprintf(stderr, "unexpected grid %d (cus %d per_cu %d)\n", grid, cus, per_cu);
  }
  hipLaunchKernelGGL(k_mega, dim3(grid), dim3(NTHR), LDS_BYTES, stream, p);
}
```

```cpp
#include <hip/hip_runtime.h>
#include <hip/hip_bf16.h>
#include <cstdio>
#include <cstdint>
#include <cstring>
#include <cstddef>
#include <type_traits>

typedef unsigned short u16;
using bf16x8 = __attribute__((ext_vector_type(8))) short;
using s16x4  = __attribute__((ext_vector_type(4))) short;
using f32x4  = __attribute__((ext_vector_type(4))) float;
using f32x16 = __attribute__((ext_vector_type(16))) float;
using u32x4  = __attribute__((ext_vector_type(4))) unsigned;
using u32x2  = __attribute__((ext_vector_type(2))) unsigned;

constexpr int DM = 1024, NB = 2, SEQ = 16384, LC = 256;
constexpr int TL = NB * SEQ;
constexpr int TC = NB * LC;
constexpr int TT = TL + TC;
constexpr int NIN = 2816;
constexpr int DIN0 = 2240;
constexpr int NE = 32, TOPK = 4, DFF = 1024;
constexpr int SKV = SEQ + LC;
constexpr int NTHR = 512;
constexpr float EPS = 1e-6f;
constexpr float A_SCALE = 0.10206207261596575f;
constexpr float A_QSCALE = A_SCALE * 1.4426950408889634f;
constexpr int ZG_W = 1152, ZG_GQ = 0, ZG_GK = 128, ZG_KR = 256, ZG_GV = 384, ZG_GP = 640, ZG_OG = 896;
constexpr int ZT_HY = 0, ZT_FR = 768, ZT_FI = 1024, ZT_R = 1280;
constexpr int NCH = 260;
constexpr int FM = 16384;
constexpr int HSP = FM / 2 + 1;

constexpr size_t ws_al(size_t b) { return (b + 1023) & ~(size_t)1023; }
constexpr size_t OFF_bar = 0;
constexpr size_t OFF_cnt = OFF_bar + ws_al((size_t)(4096) * sizeof(unsigned));
constexpr size_t OFF_hssq = OFF_cnt + ws_al((size_t)(64) * sizeof(int));
constexpr size_t OFF_kmx = OFF_hssq + ws_al((size_t)(768) * sizeof(float));
constexpr size_t OFF_mod = OFF_kmx + ws_al((size_t)(128) * sizeof(unsigned));
constexpr size_t OFF_ropec = OFF_mod + ws_al((size_t)(2 * 3 * 6144) * sizeof(float));
constexpr size_t OFF_ropes = OFF_ropec + ws_al((size_t)(SEQ * 16) * sizeof(float));
constexpr size_t OFF_tw = OFF_ropes + ws_al((size_t)(SEQ * 16) * sizeof(float));
constexpr size_t OFF_bt_in = OFF_tw + ws_al((size_t)(FM) * sizeof(float2));
constexpr size_t OFF_bt_qkv = OFF_bt_in + ws_al((size_t)((size_t)2 * NIN * DM) * sizeof(u16));
constexpr size_t OFF_bt_out = OFF_bt_qkv + ws_al((size_t)(2 * 1024 * 384) * sizeof(u16));
constexpr size_t OFF_bt_gu = OFF_bt_out + ws_al((size_t)((size_t)2 * DM * DM) * sizeof(u16));
constexpr size_t OFF_bt_dn = OFF_bt_gu + ws_al((size_t)((size_t)2 * NE * 2048 * DM) * sizeof(u16));
constexpr size_t OFF_hfb = OFF_bt_dn + ws_al((size_t)((size_t)2 * NE * DM * DFF) * sizeof(u16));
constexpr size_t OFF_hfc = OFF_hfb + ws_al((size_t)((size_t)2 * 2 * 256 * SEQ) * sizeof(float));
constexpr size_t OFF_hspec = OFF_hfc + ws_al((size_t)(2 * 256 * LC) * sizeof(float));
constexpr size_t OFF_H = OFF_hspec + ws_al((size_t)((size_t)2 * 256 * HSP) * sizeof(float4));
constexpr size_t OFF_zqkv = OFF_H + ws_al((size_t)((size_t)TT * DM) * sizeof(u16));
constexpr size_t OFF_zg = OFF_zqkv + ws_al((size_t)((size_t)TT * 384) * sizeof(u16));
constexpr size_t OFF_zt = OFF_zg + ws_al((size_t)((size_t)TT * ZG_W) * sizeof(float));
constexpr size_t OFF_Q = OFF_zt + ws_al((size_t)((size_t)ZT_R * TT) * sizeof(float));
constexpr size_t OFF_KV = OFF_Q + ws_al((size_t)((size_t)2 * 4 * SKV * 96) * sizeof(u16));
constexpr size_t OFF_ymix = OFF_KV + ws_al((size_t)((size_t)2 * 4 * SKV * 160) * sizeof(u16));
constexpr size_t OFF_hyo = OFF_ymix + ws_al((size_t)((size_t)TT * DM) * sizeof(u16));
constexpr size_t OFF_fno = OFF_hyo + ws_al((size_t)((size_t)256 * TT) * sizeof(float));
constexpr size_t OFF_glao = OFF_fno + ws_al((size_t)((size_t)256 * TT) * sizeof(float));
constexpr size_t OFF_gds = OFF_glao + ws_al((size_t)((size_t)TT * 256) * sizeof(float));
constexpr size_t OFF_gdv = OFF_gds + ws_al((size_t)((size_t)16 * NCH * 2048) * sizeof(float));
constexpr size_t OFF_gst = OFF_gdv + ws_al((size_t)((size_t)16 * NCH * 32) * sizeof(float));
constexpr size_t OFF_X = OFF_gst + ws_al((size_t)((size_t)16 * NCH * 2048) * sizeof(float));
constexpr size_t OFF_rtok = OFF_X + ws_al((size_t)((size_t)TT * DM) * sizeof(float));
constexpr size_t OFF_rw = OFF_rtok + ws_al((size_t)((size_t)NE * TT) * sizeof(int));
constexpr size_t OFF_tslot = OFF_rw + ws_al((size_t)((size_t)NE * TT) * sizeof(float));
constexpr size_t OFF_act = OFF_tslot + ws_al((size_t)((size_t)TT * 4) * sizeof(int));
constexpr size_t OFF_yd = OFF_act + ws_al((size_t)((size_t)TT * 4 * DFF) * sizeof(u16));
constexpr size_t OFF_swin = OFF_yd + ws_al((size_t)((size_t)TT * 4 * DM) * sizeof(u16));
constexpr size_t OFF_swgu = OFF_swin + ws_al((size_t)(2 * NIN) * sizeof(float));
constexpr size_t OFF_hs = OFF_swgu + ws_al((size_t)(2 * NE * 2048) * sizeof(float));
constexpr size_t OFF_hpart = OFF_hs + ws_al((size_t)(TT) * sizeof(float));
constexpr size_t OFF_rsc = OFF_hpart + ws_al((size_t)(3 * 256 * 512) * sizeof(float));
constexpr size_t WS_TOTAL = OFF_rsc + ws_al((size_t)((size_t)NE * TT) * sizeof(float));
struct ParamsData {
  const float *x_, *c_, *ctx_, *c_ctx_, *ada_w_, *ada_b_, *norm1_g_, *norm2_g_, *w_in_, *mla_q_g_, *mla_w_uq_, *mla_kv_g_, *mla_w_ukv_, *hy_conv_w_, *hy_conv_b_, *hy_w1_, *hy_b1_, *hy_w2_, *hy_b2_, *hy_w3_, *hy_freq_, *hy_bias_, *gla_gk_w_, *gla_gk_b_, *fnet_w_, *mix_g_, *w_out_, *router_w_, *router_b_, *moe_w_gu_, *moe_b_gu_, *moe_w_down_, *moe_b_down_, *final_g_;
  float* out_;
  char* ws_;
};
struct Params {
  const __attribute__((address_space(4))) char* kb;
  template <class T> __device__ __forceinline__ T karg(size_t off) const { return *(const __attribute__((address_space(4))) T*)(kb + off); }
  __device__ __forceinline__ const float* x() const { return karg<const float*>(offsetof(ParamsData, x_)); }
  __device__ __forceinline__ const float* c() const { return karg<const float*>(offsetof(ParamsData, c_)); }
  __device__ __forceinline__ const float* ctx() const { return karg<const float*>(offsetof(ParamsData, ctx_)); }
  __device__ __forceinline__ const float* c_ctx() const { return karg<const float*>(offsetof(ParamsData, c_ctx_)); }
  __device__ __forceinline__ const float* ada_w() const { return karg<const float*>(offsetof(ParamsData, ada_w_)); }
  __device__ __forceinline__ const float* ada_b() const { return karg<const float*>(offsetof(ParamsData, ada_b_)); }
  __device__ __forceinline__ const float* norm1_g() const { return karg<const float*>(offsetof(ParamsData, norm1_g_)); }
  __device__ __forceinline__ const float* norm2_g() const { return karg<const float*>(offsetof(ParamsData, norm2_g_)); }
  __device__ __forceinline__ const float* w_in() const { return karg<const float*>(offsetof(ParamsData, w_in_)); }
  __device__ __forceinline__ const float* mla_q_g() const { return karg<const float*>(offsetof(ParamsData, mla_q_g_)); }
  __device__ __forceinline__ const float* mla_w_uq() const { return karg<const float*>(offsetof(ParamsData, mla_w_uq_)); }
  __device__ __forceinline__ const float* mla_kv_g() const { return karg<const float*>(offsetof(ParamsData, mla_kv_g_)); }
  __device__ __forceinline__ const float* mla_w_ukv() const { return karg<const float*>(offsetof(ParamsData, mla_w_ukv_)); }
  __device__ __forceinline__ const float* hy_conv_w() const { return karg<const float*>(offsetof(ParamsData, hy_conv_w_)); }
  __device__ __forceinline__ const float* hy_conv_b() const { return karg<const float*>(offsetof(ParamsData, hy_conv_b_)); }
  __device__ __forceinline__ const float* hy_w1() const { return karg<const float*>(offsetof(ParamsData, hy_w1_)); }
  __device__ __forceinline__ const float* hy_b1() const { return karg<const float*>(offsetof(ParamsData, hy_b1_)); }
  __device__ __forceinline__ const float* hy_w2() const { return karg<const float*>(offsetof(ParamsData, hy_w2_)); }
  __device__ __forceinline__ const float* hy_b2() const { return karg<const float*>(offsetof(ParamsData, hy_b2_)); }
  __device__ __forceinline__ const float* hy_w3() const { return karg<const float*>(offsetof(ParamsData, hy_w3_)); }
  __device__ __forceinline__ const float* hy_freq() const { return karg<const float*>(offsetof(ParamsData, hy_freq_)); }
  __device__ __forceinline__ const float* hy_bias() const { return karg<const float*>(offsetof(ParamsData, hy_bias_)); }
  __device__ __forceinline__ const float* gla_gk_w() const { return karg<const float*>(offsetof(ParamsData, gla_gk_w_)); }
  __device__ __forceinline__ const float* gla_gk_b() const { return karg<const float*>(offsetof(ParamsData, gla_gk_b_)); }
  __device__ __forceinline__ const float* fnet_w() const { return karg<const float*>(offsetof(ParamsData, fnet_w_)); }
  __device__ __forceinline__ const float* mix_g() const { return karg<const float*>(offsetof(ParamsData, mix_g_)); }
  __device__ __forceinline__ const float* w_out() const { return karg<const float*>(offsetof(ParamsData, w_out_)); }
  __device__ __forceinline__ const float* router_w() const { return karg<const float*>(offsetof(ParamsData, router_w_)); }
  __device__ __forceinline__ const float* router_b() const { return karg<const float*>(offsetof(ParamsData, router_b_)); }
  __device__ __forceinline__ const float* moe_w_gu() const { return karg<const float*>(offsetof(ParamsData, moe_w_gu_)); }
  __device__ __forceinline__ const float* moe_b_gu() const { return karg<const float*>(offsetof(ParamsData, moe_b_gu_)); }
  __device__ __forceinline__ const float* moe_w_down() const { return karg<const float*>(offsetof(ParamsData, moe_w_down_)); }
  __device__ __forceinline__ const float* moe_b_down() const { return karg<const float*>(offsetof(ParamsData, moe_b_down_)); }
  __device__ __forceinline__ const float* final_g() const { return karg<const float*>(offsetof(ParamsData, final_g_)); }
  __device__ __forceinline__ float* out() const { return karg<float*>(offsetof(ParamsData, out_)); }
  __device__ __forceinline__ char* ws() const { return karg<char*>(offsetof(ParamsData, ws_)); }
  __device__ __forceinline__ unsigned* bar() const { return (unsigned*)(ws() + OFF_bar); }
  __device__ __forceinline__ int* cnt() const { return (int*)(ws() + OFF_cnt); }
  __device__ __forceinline__ float* hssq() const { return (float*)(ws() + OFF_hssq); }
  __device__ __forceinline__ unsigned* kmx() const { return (unsigned*)(ws() + OFF_kmx); }
  __device__ __forceinline__ float* mod() const { return (float*)(ws() + OFF_mod); }
  __device__ __forceinline__ float* ropec() const { return (float*)(ws() + OFF_ropec); }
  __device__ __forceinline__ float* ropes() const { return (float*)(ws() + OFF_ropes); }
  __device__ __forceinline__ float2* tw() const { return (float2*)(ws() + OFF_tw); }
  __device__ __forceinline__ signed char* bt_in() const { return (signed char*)(ws() + OFF_bt_in); }
  __device__ __forceinline__ u16* bt_qkv() const { return (u16*)(ws() + OFF_bt_qkv); }
  __device__ __forceinline__ u16* bt_out() const { return (u16*)(ws() + OFF_bt_out); }
  __device__ __forceinline__ signed char* bt_gu() const { return (signed char*)(ws() + OFF_bt_gu); }
  __device__ __forceinline__ u16* bt_dn() const { return (u16*)(ws() + OFF_bt_dn); }
  __device__ __forceinline__ float* hfb() const { return (float*)(ws() + OFF_hfb); }
  __device__ __forceinline__ float* hfc() const { return (float*)(ws() + OFF_hfc); }
  __device__ __forceinline__ float4* hspec() const { return (float4*)(ws() + OFF_hspec); }
  __device__ __forceinline__ signed char* H() const { return (signed char*)(ws() + OFF_H); }
  __device__ __forceinline__ float* hs() const { return (float*)(ws() + OFF_hs); }
  __device__ __forceinline__ float* rsc() const { return (float*)(ws() + OFF_rsc); }
  __device__ __forceinline__ float* hpart() const { return (float*)(ws() + OFF_hpart); }
  __device__ __forceinline__ float* swin() const { return (float*)(ws() + OFF_swin); }
  __device__ __forceinline__ float* swgu() const { return (float*)(ws() + OFF_swgu); }
  __device__ __forceinline__ float* btf() const { return (float*)(ws() + OFF_act); }
  __device__ __forceinline__ u16* zqkv() const { return (u16*)(ws() + OFF_zqkv); }
  __device__ __forceinline__ u16* zg() const { return (u16*)(ws() + OFF_zg); }
  __device__ __forceinline__ u16* zt() const { return (u16*)(ws() + OFF_zt); }
  __device__ __forceinline__ u16* Q() const { return (u16*)(ws() + OFF_Q); }
  __device__ __forceinline__ u16* KV() const { return (u16*)(ws() + OFF_KV); }
  __device__ __forceinline__ u16* ymix() const { return (u16*)(ws() + OFF_ymix); }
  __device__ __forceinline__ u16* hyo() const { return (u16*)(ws() + OFF_hyo); }
  __device__ __forceinline__ u16* fno() const { return (u16*)(ws() + OFF_fno); }
  __device__ __forceinline__ u16* glao() const { return (u16*)(ws() + OFF_glao); }
  __device__ __forceinline__ float* gds() const { return (float*)(ws() + OFF_gds); }
  __device__ __forceinline__ float* gdv() const { return (float*)(ws() + OFF_gdv); }
  __device__ __forceinline__ float* gst() const { return (float*)(ws() + OFF_gst); }
  __device__ __forceinline__ u16* X() const { return (u16*)(ws() + OFF_X); }
  __device__ __forceinline__ int* rtok() const { return (int*)(ws() + OFF_rtok); }
  __device__ __forceinline__ float* rw() const { return (float*)(ws() + OFF_rw); }
  __device__ __forceinline__ int* tslot() const { return (int*)(ws() + OFF_tslot); }
  __device__ __forceinline__ u16* act() const { return (u16*)(ws() + OFF_act); }
  __device__ __forceinline__ unsigned char* yd() const { return (unsigned char*)(ws() + OFF_yd); }
};


__device__ __forceinline__ u16 f2bf(float f) {
  unsigned u = __float_as_uint(f); u += 0x7FFFu + ((u >> 16) & 1u); return (u16)(u >> 16);
}
__device__ __forceinline__ float bf2f(u16 h) { return __uint_as_float(((unsigned)h) << 16); }
__device__ __forceinline__ unsigned cvtpk(float lo, float hi) {
  unsigned r; asm volatile("v_cvt_pk_bf16_f32 %0, %1, %2" : "=v"(r) : "v"(lo), "v"(hi)); return r;
}
#define BF_LO(w) __uint_as_float((w) << 16)
#define BF_HI(w) __uint_as_float((w) & 0xFFFF0000u)
__device__ __forceinline__ float4 ld4bf(const u16* p) { const u32x2 w = *(const u32x2*)p; return make_float4(__uint_as_float(w[0] << 16), __uint_as_float(w[0] & 0xFFFF0000u), __uint_as_float(w[1] << 16), __uint_as_float(w[1] & 0xFFFF0000u)); }
template <int CTRL> __device__ __forceinline__ float dppf(float v) { return __builtin_bit_cast(float, __builtin_amdgcn_update_dpp(0, __builtin_bit_cast(int, v), CTRL, 0xF, 0xF, true)); }
template <int M> __device__ __forceinline__ float shx(float v) {
  if constexpr (M == 1) return dppf<0xB1>(v);
  else if constexpr (M == 2) return dppf<0x4E>(v);
  else if constexpr (M == 4) return dppf<0x1B>(dppf<0x141>(v));
  else if constexpr (M == 8) return dppf<0x141>(dppf<0x140>(v));
  else if constexpr (M == 16) { auto r = __builtin_amdgcn_permlane16_swap(__float_as_uint(v), __float_as_uint(v), false, false);
    return __uint_as_float((__lane_id() & 16) ? r[0] : r[1]); }
  else { auto r = __builtin_amdgcn_permlane32_swap(__float_as_uint(v), __float_as_uint(v), false, false);
    return __uint_as_float((__lane_id() & 32) ? r[0] : r[1]); }
}
__device__ __forceinline__ float wave_sum(float v) {
  v += dppf<0xB1>(v); v += dppf<0x4E>(v); v += dppf<0x141>(v); v += dppf<0x140>(v);
  { auto r = __builtin_amdgcn_permlane16_swap(__float_as_uint(v), __float_as_uint(v), false, false); v = __uint_as_float(r[0]) + __uint_as_float(r[1]); }
  { auto r = __builtin_amdgcn_permlane32_swap(__float_as_uint(v), __float_as_uint(v), false, false); v = __uint_as_float(r[0]) + __uint_as_float(r[1]); }
  return v;
}
__device__ __forceinline__ float wave_max(float v) {
  v = fmaxf(v, dppf<0xB1>(v)); v = fmaxf(v, dppf<0x4E>(v)); v = fmaxf(v, dppf<0x141>(v)); v = fmaxf(v, dppf<0x140>(v));
  { auto r = __builtin_amdgcn_permlane16_swap(__float_as_uint(v), __float_as_uint(v), false, false); v = fmaxf(__uint_as_float(r[0]), __uint_as_float(r[1])); }
  { auto r = __builtin_amdgcn_permlane32_swap(__float_as_uint(v), __float_as_uint(v), false, false); v = fmaxf(__uint_as_float(r[0]), __uint_as_float(r[1])); }
  return v;
}
__device__ __forceinline__ int ltid() { int t = threadIdx.x; asm volatile("" : "+v"(t)); return t; }
__device__ __forceinline__ float silu_f(float x) { return x / (1.f + __expf(-x)); }
__device__ __forceinline__ float2 cmul(float2 a, float2 b) { return make_float2(a.x * b.x - a.y * b.y, a.x * b.y + a.y * b.x); }
__device__ __forceinline__ float2 cmulc(float2 a, float2 b) { return make_float2(a.x * b.x + a.y * b.y, a.y * b.x - a.x * b.y); }
__device__ __forceinline__ int modv(int tok) { return tok < TL ? (tok >> 14) : 2; }
__device__ __forceinline__ void phase_tables(const Params& p, int bid, int nb) {
  const int gt = bid * NTHR + ltid(), gs = nb * NTHR;
  for (int i = gt; i < SEQ * 16; i += gs) {
    const int t = i >> 4, f = i & 15;
    const float pos = (f < 8) ? (float)(t >> 6) : (float)(t & 63);
    const float inv = powf(10000.f, -(float)(f & 7) / 8.f);
    float s, c; sincosf(pos * inv, &s, &c);
    p.ropec()[i] = c; p.ropes()[i] = s;
  }
  for (int i = gt; i < FM; i += gs) {
    float s, c; sincospif((float)i / 8192.f, &s, &c);
    p.tw()[i] = make_float2(c, -s);
  }
}

__device__ __forceinline__ void phase_mod(const Params& p, int bid, int nb, char* lds) {
  float* red = (float*)lds;
  const int tid = ltid(), part = tid >> 6, cl = tid & 63;
  for (int it = bid; it < 2 * 96; it += nb) {
    const int l = it / 96, n = (it % 96) * 64 + cl;
    const float* W = p.ada_w() + (size_t)l * DM * 6144;
    float a0 = 0, a1 = 0, a2 = 0;
    for (int k = part * 128; k < part * 128 + 128; ++k) {
      const float w = W[(size_t)k * 6144 + n];
      a0 += silu_f(p.c()[k]) * w; a1 += silu_f(p.c()[DM + k]) * w; a2 += silu_f(p.c_ctx()[k]) * w;
    }
    red[(part * 3 + 0) * 64 + cl] = a0; red[(part * 3 + 1) * 64 + cl] = a1; red[(part * 3 + 2) * 64 + cl] = a2;
    __syncthreads();
    if (tid < 192) {
      const int v = tid >> 6; float s = 0;
      for (int q = 0; q < 8; ++q) s += red[(q * 3 + v) * 64 + cl];
      p.mod()[((size_t)l * 3 + v) * 6144 + n] = s + p.ada_b()[(size_t)l * 6144 + n];
    }
    __syncthreads();
  }
}

__device__ __forceinline__ void phase_fold(const Params& p, int bid, int nb, char* lds) {
  float* wrow = (float*)lds;
  float* dre = wrow + 2048;
  float* dim_ = dre + 2048;
  float* glr = dim_ + 2048;
  float* cst = glr + 256;
  float* snt = cst + 256;
  const int tid = ltid();
  if (tid < 256) { float sn, cs; sincospif((float)tid / 128.f, &sn, &cs); cst[tid] = cs; snt[tid] = sn; }
  __syncthreads();
  for (int it = bid; it < 2 * DM / 8; it += nb) {
    const int l = it >> 7, k0 = (it & 127) * 8;
    for (int i = tid; i < 8 * 256; i += NTHR) { const int r = i >> 8, c = i & 255; wrow[c * 8 + r] = p.w_in()[((size_t)l * DM + k0 + r) * DIN0 + 1984 + c]; }
    if (tid < 256) { const int r = tid >> 5, c = tid & 31; glr[c * 8 + r] = p.w_in()[((size_t)l * DM + k0 + r) * DIN0 + 1696 + c]; }
    __syncthreads();
    {
      const int kp = tid & 255; const bool im = tid >= 256;
      float acc[8] = {0.f, 0.f, 0.f, 0.f, 0.f, 0.f, 0.f, 0.f};
#pragma unroll 4
      for (int c = 0; c < 256; ++c) {
        const int m = (c * kp) & 255; const float t = im ? -snt[m] : cst[m];
        const float4 w0 = *(const float4*)(wrow + c * 8), w1 = *(const float4*)(wrow + c * 8 + 4);
        acc[0] += w0.x * t; acc[1] += w0.y * t; acc[2] += w0.z * t; acc[3] += w0.w * t; acc[4] += w1.x * t; acc[5] += w1.y * t; acc[6] += w1.z * t; acc[7] += w1.w * t;
      }
      float* d = (im ? dim_ : dre) + kp * 8;
      *(float4*)d = make_float4(acc[0], acc[1], acc[2], acc[3]); *(float4*)(d + 4) = make_float4(acc[4], acc[5], acc[6], acc[7]);
    }
    __syncthreads();
    {
      const int j = tid & 255; const bool im = tid >= 256;
      const float* Wf = p.fnet_w() + (size_t)l * 65536 + j;
      const float* d = im ? dim_ : dre;
      float acc[8] = {0.f, 0.f, 0.f, 0.f, 0.f, 0.f, 0.f, 0.f};
#pragma unroll 8
      for (int kp = 0; kp < 256; ++kp) {
        const float w = Wf[kp * 256];
        const float4 d0 = *(const float4*)(d + kp * 8), d1 = *(const float4*)(d + kp * 8 + 4);
        acc[0] += d0.x * w; acc[1] += d0.y * w; acc[2] += d0.z * w; acc[3] += d0.w * w; acc[4] += d1.x * w; acc[5] += d1.y * w; acc[6] += d1.z * w; acc[7] += d1.w * w;
      }
      float* o = p.btf() + ((size_t)l * NIN + (im ? 2560 : 2304) + j) * DM + k0;
      *(float4*)o = make_float4(acc[0] * 0.0625f, acc[1] * 0.0625f, acc[2] * 0.0625f, acc[3] * 0.0625f);
      *(float4*)(o + 4) = make_float4(acc[4] * 0.0625f, acc[5] * 0.0625f, acc[6] * 0.0625f, acc[7] * 0.0625f);
    }
    if (tid < 256) {
      const int dir = tid >> 7, kk = tid & 127;
      const float* gw = p.gla_gk_w() + ((size_t)l * 2 + dir) * 16 * 128 + kk;
      float acc[8] = {0.f, 0.f, 0.f, 0.f, 0.f, 0.f, 0.f, 0.f};
#pragma unroll
      for (int r16 = 0; r16 < 16; ++r16) {
        const float w = gw[r16 * 128];
        const float4 g0 = *(const float4*)(glr + (dir * 16 + r16) * 8), g1 = *(const float4*)(glr + (dir * 16 + r16) * 8 + 4);
        acc[0] += g0.x * w; acc[1] += g0.y * w; acc[2] += g0.z * w; acc[3] += g0.w * w; acc[4] += g1.x * w; acc[5] += g1.y * w; acc[6] += g1.z * w; acc[7] += g1.w * w;
      }
      float* o = p.btf() + ((size_t)l * NIN + 1024 + tid) * DM + k0;
      *(float4*)o = make_float4(acc[0], acc[1], acc[2], acc[3]); *(float4*)(o + 4) = make_float4(acc[4], acc[5], acc[6], acc[7]);
    }
    __syncthreads();
  }
}

enum { MAP_ID = 0, MAP_IN = 1, MAP_UQ = 2, MAP_UKV = 3, MAP_GU = 4 };
__device__ __forceinline__ int colmap(int mt, int n) {
  switch (mt) {
    case MAP_ID: return n;
    case MAP_IN:
      if (n < 256) return n;
      if (n < 384) return 256 + (n - 256);
      if (n < 512) return 1184 + (n - 384);
      if (n < 640) return 1312 + (n - 512);
      if (n < 672) return 384 + (n - 640);
      if (n < 768) return -1;
      if (n < 1024) return 1440 + (n - 768);
      if (n < 1280) return -2;
      if (n < 1536) return 1728 + (n - 1280);
      if (n < 2304) return 416 + (n - 1536);
      return -2;
    case MAP_UQ:
      if (n < 256) return (n >> 6) * 96 + (n & 63);
      if (n < 384) return ((n - 256) >> 5) * 96 + 64 + ((n - 256) & 31);
      return -1;
    case MAP_UKV:
      if (n < 256) return (n >> 6) * 128 + (n & 63);
      return ((n - 256) >> 6) * 128 + 64 + ((n - 256) & 63);
    default: {
      const int pn = n >> 8, w = n & 255;
      return w < 128 ? 2 * (pn * 128 + w) : 2 * (pn * 128 + w - 128) + 1;
    }
  }
}
__device__ __forceinline__ int invmap(int mt, int sc) {
  if (mt == MAP_ID) return sc;
  if (mt == MAP_GU) { const int j = sc >> 1, t = sc & 1; return (j >> 7) * 256 + t * 128 + (j & 127); }
  if (sc < 384) return sc;
  if (sc < 416) return 640 + (sc - 384);
  if (sc < 1184) return 1536 + (sc - 416);
  if (sc < 1312) return 384 + (sc - 1184);
  if (sc < 1440) return 512 + (sc - 1312);
  if (sc < 1696) return 768 + (sc - 1440);
  if (sc < 1728) return -1;
  if (sc < 1984) return 1280 + (sc - 1728);
  return -1;
}
struct ConvJob { const float* src; void* dst; const float* scale; int ld, K, mt, k0, s0, f32; };
__device__ __forceinline__ void conv_tile_load(const ConvJob& J, int tid, float4 (&v)[4]) {
  const int kk = tid >> 5, s4 = (tid & 31) * 4;
#pragma unroll
  for (int i = 0; i < 4; ++i) {
    v[i] = make_float4(0.f, 0.f, 0.f, 0.f);
    if (J.s0 + s4 < J.ld) v[i] = *(const float4*)(J.src + (size_t)(J.k0 + kk + 16 * i) * J.ld + J.s0 + s4);
  }
}
__device__ __forceinline__ void conv_tile_proc(const ConvJob& J, int tid, const float4 (&v)[4], float* tile  ) {
  {
    const int kk = tid >> 5, s4 = (tid & 31) * 4;
#pragma unroll
    for (int i = 0; i < 4; ++i) {
      const float sc = J.scale ? J.scale[J.k0 + kk + 16 * i] : 1.f;
      float* t = tile + (kk + 16 * i) * 129 + s4;
      t[0] = v[i].x * sc; t[1] = v[i].y * sc; t[2] = v[i].z * sc; t[3] = v[i].w * sc;
    }
  }
  __syncthreads();
#pragma unroll
  for (int h = 0; h < 2; ++h) {
    const int sl = (tid >> 3) + 64 * h, ks = (tid & 7) * 8, sc = J.s0 + sl;
    const int row = sc < J.ld ? invmap(J.mt, sc) : -1;
    if (row >= 0) {
      const float* t = tile + ks * 129 + sl;
      if (J.f32) {
        float* dst = (float*)J.dst + (size_t)row * J.K + J.k0 + ks;
        *(float4*)dst = make_float4(t[0], t[129], t[2 * 129], t[3 * 129]); *(float4*)(dst + 4) = make_float4(t[4 * 129], t[5 * 129], t[6 * 129], t[7 * 129]);
      } else {
        u32x4 w;
        w[0] = cvtpk(t[0], t[129]); w[1] = cvtpk(t[2 * 129], t[3 * 129]); w[2] = cvtpk(t[4 * 129], t[5 * 129]); w[3] = cvtpk(t[6 * 129], t[7 * 129]);
        *(u32x4*)((u16*)J.dst + (size_t)row * J.K + J.k0 + ks) = w;
      }
    }
  }
  __syncthreads();
}
constexpr int CT_IN = 16 * 18, CT_OUT = 16 * 8, CT_DN = NE * 128, CT_L = CT_IN + CT_OUT + CT_DN;
__device__ __forceinline__ void conv_decode(const Params& p, int t, ConvJob& J) {
  const int l = t / CT_L; int r = t % CT_L;
  if (r < CT_IN) { J.src = p.w_in() + (size_t)l * DM * DIN0; J.ld = DIN0; J.K = DM; J.dst = p.btf() + (size_t)l * NIN * DM; J.mt = MAP_IN; J.scale = nullptr; J.k0 = (r / 18) * 64; J.s0 = (r % 18) * 128; J.f32 = 1; return; }
  r -= CT_IN;
  if (r < CT_OUT) { J.src = p.w_out() + (size_t)l * DM * DM; J.ld = DM; J.K = DM; J.dst = p.bt_out() + (size_t)l * DM * DM; J.mt = MAP_ID; J.scale = p.mix_g() + l * DM; J.k0 = (r / 8) * 64; J.s0 = (r % 8) * 128; J.f32 = 0; return; }
  r -= CT_OUT;
  const int e = r >> 7, q = r & 127;
  J.src = p.moe_w_down() + ((size_t)l * NE + e) * DFF * DM; J.ld = DM; J.K = DFF; J.dst = p.bt_dn() + ((size_t)l * NE + e) * DM * DFF; J.mt = MAP_ID; J.scale = nullptr; J.k0 = (q >> 3) * 64; J.s0 = (q & 7) * 128; J.f32 = 0;
}
__device__ __forceinline__ void conv_gu8_load(const float* __restrict__ src  , int s0, int tid, float4 (&v)[16]) {
  const int c4 = (tid & 7) * 4, r0 = tid >> 3;
#pragma unroll
  for (int pss = 0; pss < 16; ++pss) v[pss] = *(const float4*)(src + (size_t)(r0 + 64 * pss) * 2048 + s0 + c4);
}
__device__ __forceinline__ void conv_gu8_proc(const float4 (&v)[16], signed char* __restrict__ dst  , float* __restrict__ sw  ,
                                              int s0, float* tile  , int tid) {
  float* cmax = tile + 1024 * 33;
  {
    const int c4 = (tid & 7) * 4, r0 = tid >> 3;
#pragma unroll
    for (int pss = 0; pss < 16; ++pss) { float* t = tile + (r0 + 64 * pss) * 33 + c4; t[0] = v[pss].x; t[1] = v[pss].y; t[2] = v[pss].z; t[3] = v[pss].w; }
  }
  __syncthreads();
  {
    const int col = tid & 31, part = tid >> 5; float m = 0.f;
#pragma unroll 8
    for (int k = part * 64; k < part * 64 + 64; ++k) m = fmaxf(m, fabsf(tile[k * 33 + col]));
    cmax[part * 32 + col] = m;
  }
  __syncthreads();
  if (tid < 32) {
    float m = 0.f;
#pragma unroll
    for (int q = 0; q < 16; ++q) m = fmaxf(m, cmax[q * 32 + tid]);
    const float sc = fmaxf(m, 1e-20f) * (1.f / 127.f);
    cmax[512 + tid] = sc;
    sw[invmap(MAP_GU, s0 + tid)] = sc;
  }
  __syncthreads();
#pragma unroll
  for (int h = 0; h < 4; ++h) {
    const int g = tid + 512 * h, col = g & 31, k0 = (g >> 5) * 16;
    const float inv = 1.f / cmax[512 + col];
    unsigned w[4];
#pragma unroll
    for (int q = 0; q < 4; ++q) {
      const float* t = tile + (k0 + 4 * q) * 33 + col;
      const int q0 = (int)rintf(t[0] * inv), q1 = (int)rintf(t[33] * inv), q2 = (int)rintf(t[66] * inv), q3 = (int)rintf(t[99] * inv);
      w[q] = (unsigned)(q0 & 255) | ((unsigned)(q1 & 255) << 8) | ((unsigned)(q2 & 255) << 16) | ((unsigned)(q3 & 255) << 24);
    }
    *(u32x4*)(dst + (size_t)invmap(MAP_GU, s0 + col) * DM + k0) = u32x4{w[0], w[1], w[2], w[3]};
  }
  __syncthreads();
}
__device__ __forceinline__ void phase_convert(const Params& p, int bid, int nb, char* lds) {
  float* tile = (float*)lds;
  const int tid = ltid();
  {
    ConvJob J, Jn; float4 v[4], vn[4];
    int t = bid;
    if (t < 2 * CT_L) { conv_decode(p, t, J); conv_tile_load(J, tid, v); }
    for (; t < 2 * CT_L; t += nb) {
      const bool more = t + nb < 2 * CT_L;
      if (more) { conv_decode(p, t + nb, Jn); conv_tile_load(Jn, tid, vn); }
      conv_tile_proc(J, tid, v, tile);
      if (more) { J = Jn;
#pragma unroll
        for (int i = 0; i < 4; ++i) v[i] = vn[i]; }
    }
  }
  {
    float4 v[16], vn[16];
    int t = bid;
    if (t < 2 * NE * 64) conv_gu8_load(p.moe_w_gu() + (size_t)(t >> 6) * DM * 2048, (t & 63) * 32, tid, v);
    for (; t < 2 * NE * 64; t += nb) {
      const bool more = t + nb < 2 * NE * 64; const int tn = t + nb;
      if (more) conv_gu8_load(p.moe_w_gu() + (size_t)(tn >> 6) * DM * 2048, (tn & 63) * 32, tid, vn);
      conv_gu8_proc(v, p.bt_gu() + (size_t)(t >> 6) * 2048 * DM, p.swgu() + (size_t)(t >> 6) * 2048, (t & 63) * 32, tile, tid);
      if (more) {
#pragma unroll
        for (int i = 0; i < 16; ++i) v[i] = vn[i]; }
    }
  }
  for (int l = 0; l < 2; ++l) {
    for (int i = bid * NTHR + tid; i < 96 * DM / 4; i += nb * NTHR) *(float4*)(p.btf() + ((size_t)l * NIN + 672) * DM + (size_t)i * 4) = make_float4(0.f, 0.f, 0.f, 0.f);
    {
      const float* wq = p.mla_w_uq() + (size_t)l * 256 * 384; const float* wkv = p.mla_w_ukv() + (size_t)l * 128 * 512;
      const float* gq = p.mla_q_g() + l * 256; const float* gkv = p.mla_kv_g() + l * 128;
      u16* dst = p.bt_qkv() + (size_t)l * 1024 * 384;
      for (int i = bid * NTHR + ltid(); i < 1024 * 384; i += nb * NTHR) {
        const int n = i / 384, k = i % 384; float v = 0.f;
        if (n < 512) { const int sc = colmap(MAP_UQ, n); if (k < 256 && sc >= 0) v = gq[k] * wq[k * 384 + sc]; }
        else { if (k >= 256) v = gkv[k - 256] * wkv[(k - 256) * 512 + colmap(MAP_UKV, n - 512)]; }
        dst[i] = f2bf(v);
      }
    }
  }
}

__device__ __forceinline__ void phase_hy_mlp(const Params& p, int l, int Lf, float* __restrict__ hout  , float* __restrict__ ssq  ,
                             int bid, int nb, char* lds) {
  float* zf = (float*)lds;
  float* h1 = zf + 64 * 33;
  float* h2 = h1 + 64 * 64;
  const int tid = ltid();
  const float* w1 = p.hy_w1() + (size_t)l * 33 * 64; const float* b1 = p.hy_b1() + l * 64;
  const float* w2 = p.hy_w2() + (size_t)l * 64 * 64; const float* b2 = p.hy_b2() + l * 64;
  const float* w3 = p.hy_w3() + (size_t)l * 64 * 512; const float* fr = p.hy_freq() + l * 64;
  float w3c[64];
#pragma unroll
  for (int k = 0; k < 64; ++k) w3c[k] = w3[k * 512 + tid];
  const int dir = tid >> 8, ch = tid & 255;
  const float maxd = logf(1e-2f) / 0.3f, mind = logf(1e-2f) / 1.5f;
  const float delta = fabsf(mind + (maxd - mind) * (float)ch / 255.f);
  float ssq_acc = 0.f;
  for (int it = bid; it < Lf / 64; it += nb) {
    const int t0 = it * 64;
    for (int i = tid; i < 64 * 33; i += NTHR) {
      const int tt = i / 33, f = i % 33, t = t0 + tt;
      float v;
      if (f == 0) v = (float)t / (float)(Lf - 1);
      else {
        const int j = (f - 1) & 15;
        const float fj = 1e-4f + (float)j * ((15.f - 1e-4f) / 15.f);
        const float w = 6.283185307179586f * (float)t / (float)Lf;
        v = (f <= 16) ? cosf(fj * w) : -sinf(fj * w);
      }
      zf[i] = v;
    }
    __syncthreads();
    {
      const int o = tid & 63, tb = tid >> 6;
      float acc[8];
#pragma unroll
      for (int j = 0; j < 8; ++j) acc[j] = b1[o];
#pragma unroll 3
      for (int f = 0; f < 33; ++f) {
        const float w = w1[f * 64 + o];
#pragma unroll
        for (int j = 0; j < 8; ++j) acc[j] += zf[(tb + 8 * j) * 33 + f] * w;
      }
      const float fo = fr[o];
#pragma unroll
      for (int j = 0; j < 8; ++j) h1[(tb + 8 * j) * 64 + o] = sinf(fo * acc[j]);
    }
    __syncthreads();
    {
      const int o = tid & 63, tb = tid >> 6;
      float acc[8];
#pragma unroll
      for (int j = 0; j < 8; ++j) acc[j] = b2[o];
#pragma unroll 4
      for (int f = 0; f < 64; f += 4) {
        const float wa = w2[f * 64 + o], wb = w2[(f + 1) * 64 + o], wc2 = w2[(f + 2) * 64 + o], wd = w2[(f + 3) * 64 + o];
#pragma unroll
        for (int j = 0; j < 8; ++j) { const float4 hv = *(const float4*)(h1 + (tb + 8 * j) * 64 + f); acc[j] += hv.x * wa + hv.y * wb + hv.z * wc2 + hv.w * wd; }
      }
      const float fo = fr[o];
#pragma unroll
      for (int j = 0; j < 8; ++j) h2[(tb + 8 * j) * 64 + o] = sinf(fo * acc[j]);
    }
    __syncthreads();
    float* orow = hout + ((size_t)dir * 256 + ch) * Lf + t0;
    for (int tq = 0; tq < 16; ++tq) {
      float sv[4];
#pragma unroll
      for (int u = 0; u < 4; ++u) {
        const int tt = tq * 4 + u;
        float s = 0;
#pragma unroll
        for (int k = 0; k < 64; k += 4) { const float4 hv = *(const float4*)(h2 + tt * 64 + k); s += hv.x * w3c[k] + hv.y * w3c[k + 1] + hv.z * w3c[k + 2] + hv.w * w3c[k + 3]; }
        const int t = t0 + tt;
        s *= __expf(-((float)t / (float)(Lf - 1)) * delta);
        if (dir == 0 || t > 0) ssq_acc += s * s;
        sv[u] = s;
      }
      *(float4*)(orow + tq * 4) = make_float4(sv[0], sv[1], sv[2], sv[3]);
    }
    __syncthreads();
  }
  ssq[(size_t)bid * 512 + tid] = ssq_acc;
}

__host__ __device__ constexpr int fx(int p) {
  return ((p >> 12) & 3) ^ (((p >> 10) & 3) << 2) ^ ((p >> 4) & 16) ^ (((p >> 5) & 1) * 5) ^ (((p >> 6) & 1) * 26);
}
__device__ __forceinline__ int swz(int p) { return p ^ fx(p); }
__device__ __forceinline__ int rev7(int k) {
  unsigned r = __brev((unsigned)k) >> 18;
  return (int)(((r & 0x2AAAu) >> 1) | ((r & 0x1555u) << 1));
}
template <int ST, bool INV>
__device__ __forceinline__ void fft_stage(float2* s, const float2* __restrict__ tw, const int tid) {
  constexpr int sh = 12 - 2 * ST, q = 1 << sh, ND = q >= 512 ? q / 512 : 1;
  float2 w1[ND], w2[ND], w3[ND];
  if constexpr (ST < 6) {
#pragma unroll
    for (int d = 0; d < ND; ++d) {
      const int j = q >= 512 ? tid + 512 * d : (tid & (q - 1)), ti = j << (2 * ST);
      w1[d] = tw[ti]; w2[d] = tw[2 * ti]; w3[d] = tw[3 * ti];
    }
  }
  float2 x[8][4];
#pragma unroll
  for (int m = 0; m < 8; ++m) {
    const int u = tid + 512 * m, g = u >> sh, j = u & (q - 1), base = (g << (sh + 2)) + j, xb = fx(base);
    x[m][0] = s[base ^ xb]; x[m][1] = s[(base + q) ^ xb ^ fx(q)]; x[m][2] = s[(base + 2 * q) ^ xb ^ fx(2 * q)]; x[m][3] = s[(base + 3 * q) ^ xb ^ fx(3 * q)];
  }
#pragma unroll
  for (int m = 0; m < 8; ++m) {
    const int u = tid + 512 * m, g = u >> sh, j = u & (q - 1), base = (g << (sh + 2)) + j, xb = fx(base);
    const int i0 = base ^ xb, i1 = (base + q) ^ xb ^ fx(q), i2 = (base + 2 * q) ^ xb ^ fx(2 * q), i3 = (base + 3 * q) ^ xb ^ fx(3 * q);
    const int d = q >= 512 ? (m % ND) : 0;
    if constexpr (!INV) {
      const float2 a0 = x[m][0], a1 = x[m][1], a2 = x[m][2], a3 = x[m][3];
      const float2 b0 = make_float2(a0.x + a2.x, a0.y + a2.y), b1 = make_float2(a0.x - a2.x, a0.y - a2.y);
      const float2 b2 = make_float2(a1.x + a3.x, a1.y + a3.y), b3 = make_float2(a1.x - a3.x, a1.y - a3.y);
      const float2 y1 = make_float2(b1.x + b3.y, b1.y - b3.x), y2 = make_float2(b0.x - b2.x, b0.y - b2.y), y3 = make_float2(b1.x - b3.y, b1.y + b3.x);
      s[i0] = make_float2(b0.x + b2.x, b0.y + b2.y);
      if constexpr (ST < 6) { s[i1] = cmul(y1, w1[d]); s[i2] = cmul(y2, w2[d]); s[i3] = cmul(y3, w3[d]); }
      else { s[i1] = y1; s[i2] = y2; s[i3] = y3; }
    } else {
      float2 t0 = x[m][0], t1 = x[m][1], t2 = x[m][2], t3 = x[m][3];
      if constexpr (ST < 6) { t1 = cmulc(t1, w1[d]); t2 = cmulc(t2, w2[d]); t3 = cmulc(t3, w3[d]); }
      const float2 b0 = make_float2(t0.x + t2.x, t0.y + t2.y), b1 = make_float2(t0.x - t2.x, t0.y - t2.y);
      const float2 b2 = make_float2(t1.x + t3.x, t1.y + t3.y), b3 = make_float2(t1.x - t3.x, t1.y - t3.y);
      s[i0] = make_float2(b0.x + b2.x, b0.y + b2.y);
      s[i1] = make_float2(b1.x - b3.y, b1.y + b3.x);
      s[i2] = make_float2(b0.x - b2.x, b0.y - b2.y);
      s[i3] = make_float2(b1.x + b3.y, b1.y - b3.x);
    }
  }
  __syncthreads();
}
__device__ __forceinline__ void fft_fwd(float2* s, const float2* __restrict__ tw) {
  const int tid = ltid();
  fft_stage<0, false>(s, tw, tid); fft_stage<1, false>(s, tw, tid); fft_stage<2, false>(s, tw, tid); fft_stage<3, false>(s, tw, tid);
  fft_stage<4, false>(s, tw, tid); fft_stage<5, false>(s, tw, tid); fft_stage<6, false>(s, tw, tid);
}
__device__ __forceinline__ void fft_inv(float2* s, const float2* __restrict__ tw) {
  const int tid = ltid();
  fft_stage<6, true>(s, tw, tid); fft_stage<5, true>(s, tw, tid); fft_stage<4, true>(s, tw, tid); fft_stage<3, true>(s, tw, tid);
  fft_stage<2, true>(s, tw, tid); fft_stage<1, true>(s, tw, tid); fft_stage<0, true>(s, tw, tid);
}

__device__ __forceinline__ float filt_ssq(const float* __restrict__ part  , int ch, float* red  ) {
  const int tid = ltid();
  float v = part[(size_t)(tid >> 1) * 512 + (tid & 1) * 256 + ch];
  v = wave_sum(v);
  __syncthreads();
  if ((tid & 63) == 0) red[tid >> 6] = v;
  __syncthreads();
  return ((red[0] + red[1]) + (red[2] + red[3])) + ((red[4] + red[5]) + (red[6] + red[7]));
}
__device__ __forceinline__ void phase_hy_filtfft(const Params& p, int bid, int nb, char* lds) {
  float2* s = (float2*)lds;
  const int tid = ltid();
  for (int it = bid; it < 512; it += nb) {
    const int l = it >> 8, ch = it & 255;
    const float* hf = p.hfb() + (((size_t)l * 2 + 0) * 256 + ch) * SEQ;
    const float* hb = p.hfb() + (((size_t)l * 2 + 1) * 256 + ch) * SEQ;
#pragma unroll 8
    for (int m = tid; m < FM; m += NTHR) {
      const int n0 = 2 * m, n1 = 2 * m + 1;
      const float a = (n0 < SEQ) ? hf[n0] : (n0 == SEQ ? 0.f : hb[2 * SEQ - n0]);
      const float b = (n1 < SEQ) ? hf[n1] : hb[2 * SEQ - n1];
      s[swz(m)] = make_float2(a, b);
    }
    __syncthreads();
    fft_fwd(s, p.tw());
    const float sc = rsqrtf(filt_ssq(p.hpart() + (size_t)l * 256 * 512, ch, (float*)(lds + 139264))) * (1.f / 16384.f);
    float4* out = p.hspec() + ((size_t)l * 256 + ch) * HSP;
#pragma unroll 4
    for (int k = tid; k <= FM / 2; k += NTHR) {
      const float2 zk = s[swz(rev7(k))], zm = s[swz(rev7((FM - k) & (FM - 1)))];
      const float er = 0.5f * (zk.x + zm.x), ei = 0.5f * (zk.y - zm.y);
      const float dr = 0.5f * (zk.x - zm.x), di = 0.5f * (zk.y + zm.y);
      out[k] = make_float4(er * sc, ei * sc, di * sc, -dr * sc);
    }
    __syncthreads();
  }
}
constexpr int G_TILE_B = 256 * 64 * 2;
constexpr int G_STAGE_B = 2 * G_TILE_B;
constexpr int GEMM_LDS = 2 * G_STAGE_B;

__device__ __forceinline__ int lds_byte2(int r, int c) {
  const int st = (r >> 4) * 2 + (c >> 5), ob = (r & 15) * 64 + (c & 31) * 2;
  return st * 1024 + (ob ^ (((ob >> 9) & 1) << 5));
}
__device__ __forceinline__ void stage_rc2(int b, int& R, int& C) {
  const int st = b >> 10, sb = b & 1023, swz = sb ^ (((sb >> 9) & 1) << 5);
  R = (st >> 1) * 16 + (swz >> 6);
  C = (st & 1) * 32 + ((swz & 63) >> 1);
}
__device__ __forceinline__ void gemm_stage_coords(int (&sR)[4], int (&sC)[4]) {
  const int wid = ltid() >> 6, lane = ltid() & 63;
#pragma unroll
  for (int i = 0; i < 4; ++i) stage_rc2(wid * 1024 + i * 8192 + lane * 16, sR[i], sC[i]);
}

#define WAIT_V0() asm volatile("s_waitcnt vmcnt(0)" ::: "memory")

__device__ __forceinline__ void gemm256_core(const u16* const (&ap)[4], const u16* const (&bp)[4], int nt, char* shm, f32x4 (&acc)[8][4]) {
  const int tid = ltid(), wid = tid >> 6, lane = tid & 63, wr = wid >> 2, wc = wid & 3, fr = lane & 15, fq = lane >> 4;
#pragma unroll
  for (int m = 0; m < 8; ++m)
#pragma unroll
    for (int n = 0; n < 4; ++n) acc[m][n] = f32x4{0.f, 0.f, 0.f, 0.f};
#define G_SA(b) (shm + (b) * G_STAGE_B)
#define G_SB(b) (shm + (b) * G_STAGE_B + G_TILE_B)
#define G_STAGE(buf, kt) do { _Pragma("unroll") for (int i = 0; i < 4; ++i) {                                                   \
    __builtin_amdgcn_global_load_lds((const unsigned*)(ap[i] + (kt) * 64), (unsigned*)(G_SA(buf) + wid * 1024 + i * 8192), 16, 0, 0); \
    __builtin_amdgcn_global_load_lds((const unsigned*)(bp[i] + (kt) * 64), (unsigned*)(G_SB(buf) + wid * 1024 + i * 8192), 16, 0, 0); } } while (0)
  G_STAGE(0, 0); WAIT_V0(); __syncthreads();
#pragma unroll 1
  for (int t = 0; t < nt; ++t) {
    const int cur = t & 1;
    if (t + 1 < nt) G_STAGE(cur ^ 1, t + 1);
#pragma unroll
    for (int ks = 0; ks < 2; ++ks) {
      bf16x8 At[8], Bf[4];
#pragma unroll
      for (int m = 0; m < 8; ++m) At[m] = *(const bf16x8*)(G_SA(cur) + lds_byte2(wr * 128 + m * 16 + fr, ks * 32 + fq * 8));
#pragma unroll
      for (int n = 0; n < 4; ++n) Bf[n] = *(const bf16x8*)(G_SB(cur) + lds_byte2(wc * 64 + n * 16 + fr, ks * 32 + fq * 8));
#pragma unroll
      for (int m = 0; m < 8; ++m)
#pragma unroll
        for (int n = 0; n < 4; ++n) acc[m][n] = __builtin_amdgcn_mfma_f32_16x16x32_bf16(At[m], Bf[n], acc[m][n], 0, 0, 0);
      __builtin_amdgcn_sched_barrier(0);
    }
    WAIT_V0(); __syncthreads();
  }
#undef G_STAGE
}

#define LAS3 __attribute__((address_space(3)))
constexpr int G8_HTB = 128 * 64 * 2;
__device__ __forceinline__ int g8_perm32(int rho) { const int n = rho >> 4, i = rho & 15; return 8 * (i >> 2) + 4 * n + (i & 3); }
__device__ __forceinline__ int g8_lds_byte(int r, int c) { const int st = (r >> 4) * 2 + (c >> 5), rr = r & 15, cc = c & 31, ob = rr * 64 + cc * 2; return st * 1024 + (ob ^ (((ob >> 9) & 1) << 5)); }
__device__ __forceinline__ void g8_stage_rc(int b, int& R, int& C) { const int st = b / 1024, sb = b % 1024, swz = sb ^ (((sb >> 9) & 1) << 5); R = (st >> 1) * 16 + swz / 64; C = (st & 1) * 32 + (swz % 64) / 2; }
struct G8Unit { int pm, pn, e, ce, pre, ab; };
__device__ __forceinline__ void g8_cload(const float* __restrict__ src, float* dst) {
  __builtin_amdgcn_global_load_lds((const unsigned*)(src + (ltid() & 63) * 4), (LAS3 unsigned*)dst, 16, 0, 0);
}


template <bool I8> __device__ __forceinline__ typename std::conditional<I8, int __attribute__((ext_vector_type(4))), f32x4>::type
g8_mma(bf16x8 x, bf16x8 y, typename std::conditional<I8, int __attribute__((ext_vector_type(4))), f32x4>::type c) {
  if constexpr (I8) { typedef int v4i __attribute__((ext_vector_type(4))); return __builtin_amdgcn_mfma_i32_16x16x64_i8(*(v4i*)&x, *(v4i*)&y, c, 0, 0, 0); }
  else return __builtin_amdgcn_mfma_f32_16x16x32_bf16(x, y, c, 0, 0, 0);
}
typedef int i32x4 __attribute__((ext_vector_type(4)));
template <bool I8> struct G8Acc { typedef f32x4 T; };
template <> struct G8Acc<true> { typedef i32x4 T; };
template <bool I8, class Sched, class Epi>
__device__ __forceinline__ void gemm8_phase(char* lds_g, const char* Abase, const int Kb, const Sched& S, const Epi& E) {
    typedef typename G8Acc<I8>::T ACC;
    LAS3 unsigned char* lds = (LAS3 unsigned char*)lds_g;
    const int tid = ltid(), wid = __builtin_amdgcn_readfirstlane(tid >> 6), lane = tid & 63, wr = wid >> 2, wc = wid & 3, fr = lane & 15, fq = lane >> 4;
    const int nt = Kb / 128;
    int sRr[2], sCc[2]; unsigned voffB[2];
#pragma unroll
    for (int i = 0; i < 2; ++i) { g8_stage_rc(tid * 16 + i * 8192, sRr[i], sCc[i]); const int Rb = (sRr[i] & ~31) + g8_perm32(sRr[i] & 31); voffB[i] = (unsigned)(Rb * Kb) + (unsigned)sCc[i] * 2u; }
    const size_t kstep = 128;
    const size_t hstepB = (size_t)128 * Kb;
    const unsigned ldsw = (unsigned)wid * 1024u;
    const int aoff = g8_lds_byte(wr * 64 + fr, fq * 8), boff = g8_lds_byte(wc * 32 + fr, fq * 8);
#define G8_SA(b, h) (((b) * 2 + (h)) * G8_HTB)
#define G8_SB(b, h) ((4 + (b) * 2 + (h)) * G8_HTB)
#define G8_STAGE_B(bufoff, gbase) do { _Pragma("unroll") for (int _i = 0; _i < 2; ++_i) \
        __builtin_amdgcn_global_load_lds((const unsigned*)((const char*)(gbase) + voffB[_i]), (LAS3 unsigned*)(lds + (bufoff) + ldsw + _i * 8192), 16, 0, 0); } while (0)
#define G8_STAGE_A(bufoff, o0, o1) do { \
        __builtin_amdgcn_global_load_lds((const unsigned*)(Abase + (o0)), (LAS3 unsigned*)(lds + (bufoff) + ldsw), 16, 0, 0); \
        __builtin_amdgcn_global_load_lds((const unsigned*)(Abase + (o1)), (LAS3 unsigned*)(lds + (bufoff) + ldsw + 8192), 16, 0, 0); } while (0)
#define G8_LDA(dst, b, h) do { _Pragma("unroll") for (int m = 0; m < 4; ++m) _Pragma("unroll") for (int k = 0; k < 2; ++k) dst[m][k] = *(const LAS3 bf16x8*)(lds + G8_SA(b, h) + aoff + m * 2048 + k * 1024); } while (0)
#define G8_LDB(dst, b, h) do { _Pragma("unroll") for (int n = 0; n < 2; ++n) _Pragma("unroll") for (int k = 0; k < 2; ++k) dst[n][k] = *(const LAS3 bf16x8*)(lds + G8_SB(b, h) + boff + n * 2048 + k * 1024); } while (0)
#define G8_MMA(ai, bj, At, Bt) do { __builtin_amdgcn_s_setprio(1); _Pragma("unroll") for (int m = 0; m < 4; ++m) _Pragma("unroll") for (int n = 0; n < 2; ++n) _Pragma("unroll") for (int k = 0; k < 2; ++k) \
        acc[ai][bj][m][n] = g8_mma<I8>(Bt[n][k], At[m][k], acc[ai][bj][m][n]); __builtin_amdgcn_s_setprio(0); } while (0)
#define G8_WAIT_V(n) asm volatile("s_waitcnt vmcnt(" #n ")" ::: "memory")
#define G8_WAIT_L(n) asm volatile("s_waitcnt lgkmcnt(" #n ")" ::: "memory")
#define G8_BAR __builtin_amdgcn_s_barrier()
#define G8_SCHED __builtin_amdgcn_sched_barrier(0)
    G8Unit cur, nxt; int ui = 0;
    cur.e = 0; cur.pre = 0; cur.ab = 0;
    if (!S.next(0, cur, cur)) return;
    ACC acc[2][2][4][2];
#pragma unroll
    for (int a = 0; a < 2; ++a)
#pragma unroll
        for (int b = 0; b < 2; ++b)
#pragma unroll
            for (int m = 0; m < 4; ++m)
#pragma unroll
                for (int n = 0; n < 2; ++n) acc[a][b][m][n] = ACC{};
    bf16x8 At[4][2], B0[2][2], B1[2][2];
    float ep[8];
    unsigned va[2][2], vn[2][2];
#pragma unroll
    for (int h = 0; h < 2; ++h)
#pragma unroll
        for (int i = 0; i < 2; ++i) va[h][i] = S.a_off(cur, h * 128 + sRr[i]) + (unsigned)sCc[i] * 2u;
    const char* cB = S.b_ptr(cur);
    G8_STAGE_B(G8_SB(0, 0), cB); G8_STAGE_A(G8_SA(0, 0), va[0][0], va[0][1]); G8_STAGE_B(G8_SB(0, 1), cB + hstepB); G8_STAGE_A(G8_SA(0, 1), va[1][0], va[1][1]);
    if (wr == 1) G8_BAR;
    G8_WAIT_V(4); G8_BAR;
    G8_STAGE_B(G8_SB(1, 0), cB + kstep); G8_STAGE_A(G8_SA(1, 0), va[0][0] + kstep, va[0][1] + kstep); G8_STAGE_B(G8_SB(1, 1), cB + hstepB + kstep);
    G8_WAIT_V(6); G8_BAR;
    for (;;) {
        float* cb = (float*)(lds_g + 136192 + (ui & 1) * 2048);
        E.pre(cur, wr, fr, ep, cb);
        const bool has_next = S.next(ui + 1, nxt, cur);
        const char* nB = cB;
#pragma unroll
        for (int h = 0; h < 2; ++h)
#pragma unroll
            for (int i = 0; i < 2; ++i) vn[h][i] = va[h][i];
        if (has_next) {
            nB = S.b_ptr(nxt);
#pragma unroll
            for (int h = 0; h < 2; ++h)
#pragma unroll
                for (int i = 0; i < 2; ++i) vn[h][i] = S.a_off(nxt, h * 128 + sRr[i]) + (unsigned)sCc[i] * 2u;
        }
#pragma unroll 1
        for (int t = 0; t < nt; t += 2) {
            const bool last = (t == nt - 2);
            const unsigned k1 = (unsigned)(t + 1) * 128u;
            const unsigned k2 = last ? 0u : (unsigned)(t + 2) * 128u;
            const unsigned a2_00 = (last ? vn[0][0] : va[0][0]) + k2, a2_01 = (last ? vn[0][1] : va[0][1]) + k2;
            const unsigned a2_10 = (last ? vn[1][0] : va[1][0]) + k2, a2_11 = (last ? vn[1][1] : va[1][1]) + k2;
            const char* b2 = (last ? nB : cB) + k2; const char* b3 = b2 + kstep;
            G8_LDB(B0, 0, 0); G8_SCHED; G8_LDA(At, 0, 0); G8_STAGE_A(G8_SA(1, 1), va[1][0] + k1, va[1][1] + k1);
            G8_WAIT_L(8); G8_BAR; G8_WAIT_L(0); G8_MMA(0, 0, At, B0); G8_BAR; G8_SCHED;
            G8_LDB(B1, 0, 1); G8_STAGE_B(G8_SB(0, 0), b2);
            G8_BAR; G8_WAIT_L(0); G8_MMA(0, 1, At, B1); G8_BAR;
            G8_LDA(At, 0, 1); G8_STAGE_A(G8_SA(0, 0), a2_00, a2_01);
            G8_BAR; G8_WAIT_L(0); G8_MMA(1, 0, At, B0); G8_BAR; G8_SCHED;
            G8_STAGE_B(G8_SB(0, 1), b2 + hstepB);
            G8_WAIT_V(6); G8_BAR; G8_MMA(1, 1, At, B1); G8_BAR;
            G8_LDB(B0, 1, 0); G8_SCHED; G8_LDA(At, 1, 0); G8_STAGE_A(G8_SA(0, 1), a2_10, a2_11);
            G8_WAIT_L(8); G8_BAR; G8_WAIT_L(0); G8_MMA(0, 0, At, B0); G8_BAR; G8_SCHED;
            G8_LDB(B1, 1, 1); G8_STAGE_B(G8_SB(1, 0), b3);
            G8_BAR; G8_WAIT_L(0); G8_MMA(0, 1, At, B1); G8_BAR;
            G8_LDA(At, 1, 1); G8_STAGE_A(G8_SA(1, 0), a2_00 + 128u, a2_01 + 128u);
            G8_BAR; G8_WAIT_L(0); G8_MMA(1, 0, At, B0); G8_BAR; G8_SCHED;
            G8_STAGE_B(G8_SB(1, 1), b3 + hstepB);
            G8_WAIT_V(6); G8_BAR; G8_MMA(1, 1, At, B1); G8_BAR;
        }
        E(acc, cur, wr, wc, fr, fq, ep, cb);
        if (!has_next) break;
#pragma unroll
        for (int a = 0; a < 2; ++a)
#pragma unroll
            for (int b = 0; b < 2; ++b)
#pragma unroll
                for (int m = 0; m < 4; ++m)
#pragma unroll
                    for (int n = 0; n < 2; ++n) acc[a][b][m][n] = ACC{};
        cur = nxt; cB = nB; ++ui;
#pragma unroll
        for (int h = 0; h < 2; ++h)
#pragma unroll
            for (int i = 0; i < 2; ++i) va[h][i] = vn[h][i];
    }
    G8_WAIT_V(0);
    if (wr == 0) G8_BAR;
    G8_BAR;
#undef G8_SA
#undef G8_SB
#undef G8_STAGE_A
#undef G8_STAGE_B
#undef G8_LDA
#undef G8_LDB
#undef G8_MMA
#undef G8_WAIT_V
#undef G8_WAIT_L
#undef G8_BAR
#undef G8_SCHED
}
struct G8Plain {
    int nM, nN, Kb, G, c; const char* Bt;
    __device__ __forceinline__ bool next(int i, G8Unit& u, const G8Unit&) const {
        const int L = (i * 8 + (c & 7)) * (G >> 3) + (c >> 3); if (L >= nM * nN) return false;
        const int nig = 8 * nN, gid = L / nig, fm = gid * 8, gsz = (nM - fm) < 8 ? (nM - fm) : 8;
        u.pm = fm + ((L % nig) % gsz); u.pn = (L % nig) / gsz; u.e = 0; u.ce = 256; u.pre = 0; return true;
    }
    __device__ __forceinline__ unsigned a_off(const G8Unit& u, int row) const { return (unsigned)(u.pm * 256 + row) * (unsigned)Kb; }
    __device__ __forceinline__ const char* b_ptr(const G8Unit& u) const { return Bt + (size_t)u.pn * 256 * Kb; }
};

__device__ __forceinline__ const float* resid_row_in(const Params& p, int tok) {
  return tok < TL ? p.x() + (size_t)tok * DM : p.ctx() + (size_t)(tok - TL) * DM;
}
__device__ __forceinline__ void load_row_comb(const Params& p, int src_layer, int lc, int tok, int lane, const int* pre  , float (&v)[16]) {
  if (src_layer == 0) {
    const float* r = resid_row_in(p, tok);
#pragma unroll
    for (int i = 0; i < 4; ++i) { const float4 a = *(const float4*)(r + lane * 4 + i * 256); v[4 * i] = a.x; v[4 * i + 1] = a.y; v[4 * i + 2] = a.z; v[4 * i + 3] = a.w; }
  } else {
    const u16* r = p.X() + (size_t)tok * DM;
#pragma unroll
    for (int i = 0; i < 4; ++i) { const float4 a = ld4bf(r + lane * 4 + i * 256); v[4 * i] = a.x; v[4 * i + 1] = a.y; v[4 * i + 2] = a.z; v[4 * i + 3] = a.w; }
  }
  if (lc >= 0) {
    const float* g2 = p.mod() + ((size_t)lc * 3 + modv(tok)) * 6144 + 5 * DM;
    float s[16];
#pragma unroll
    for (int i = 0; i < 16; ++i) s[i] = 0.f;
#pragma unroll
    for (int k = 0; k < TOPK; ++k) {
      const int sl = p.tslot()[tok * 4 + k];
      const size_t arow = (size_t)(pre[sl >> 20] + (sl & 0xFFFFF));
      const unsigned char* y = p.yd() + arow * DM;
#pragma unroll
      for (int i = 0; i < 4; ++i) {
        const int w = *(const int*)(y + lane * 4 + i * 256);
        const auto lo = __builtin_amdgcn_cvt_pk_f32_fp8(w, false), hi2 = __builtin_amdgcn_cvt_pk_f32_fp8(w, true);
        s[4 * i] += lo[0]; s[4 * i + 1] += lo[1]; s[4 * i + 2] += hi2[0]; s[4 * i + 3] += hi2[1];
      }
    }
#pragma unroll
    for (int i = 0; i < 4; ++i) {
      const float4 g = *(const float4*)(g2 + lane * 4 + i * 256);
      v[4 * i] += g.x * 0.125f * s[4 * i]; v[4 * i + 1] += g.y * 0.125f * s[4 * i + 1]; v[4 * i + 2] += g.z * 0.125f * s[4 * i + 2]; v[4 * i + 3] += g.w * 0.125f * s[4 * i + 3];
    }
  }
}
__device__ __forceinline__ void expert_prefix(const int* cnt, int* pre) {
  if (ltid() == 0) { int s = 0; for (int e = 0; e < NE; ++e) { pre[e] = s; s += cnt[e]; } pre[NE] = s; }
}

__device__ __forceinline__ float store_row_i8(const float (&y)[16], signed char* __restrict__ h, float* __restrict__ hs_row, int lane) {
  float am = 0.f;
#pragma unroll
  for (int i = 0; i < 16; ++i) am = fmaxf(am, fabsf(y[i]));
  am = wave_max(am);
  const float s = fmaxf(am, 1e-20f) * (1.f / 127.f), inv = 1.f / s;
#pragma unroll
  for (int i = 0; i < 4; ++i) {
    const int q0 = (int)rintf(y[4 * i] * inv), q1 = (int)rintf(y[4 * i + 1] * inv), q2 = (int)rintf(y[4 * i + 2] * inv), q3 = (int)rintf(y[4 * i + 3] * inv);
    *(unsigned*)(h + lane * 4 + i * 256) = (unsigned)(q0 & 255) | ((unsigned)(q1 & 255) << 8) | ((unsigned)(q2 & 255) << 16) | ((unsigned)(q3 & 255) << 24);
  }
  if (lane == 0) *hs_row = s;
  return s;
}
__device__ __forceinline__ void phase_quant_in(const Params& p, int bid, int nb) {
  const int wid = ltid() >> 6, lane = ltid() & 63;
  for (int r = bid * 8 + wid; r < 2 * NIN; r += nb * 8) {
    const float* src = p.btf() + (size_t)r * DM;
    float y[16];
#pragma unroll
    for (int i = 0; i < 4; ++i) { const float4 a = *(const float4*)(src + lane * 4 + i * 256); y[4 * i] = a.x; y[4 * i + 1] = a.y; y[4 * i + 2] = a.z; y[4 * i + 3] = a.w; }
    store_row_i8(y, p.bt_in() + (size_t)r * DM, p.swin() + r, lane);
  }
}
__device__ __forceinline__ void phase_norm1(const Params& p, int layer, int bid, int nb, char* lds) {
  int* pre = (int*)lds;
  const int lc = layer - 1;
  if (lc >= 0) { expert_prefix(p.cnt() + lc * NE, pre); __syncthreads(); }
  const int wid = ltid() >> 6, lane = ltid() & 63;
  const float* gn = p.norm1_g() + layer * DM;
  const int ntok = TT;
  for (int tok = bid * 8 + wid; tok < ntok; tok += nb * 8) {
    float v[16];
    load_row_comb(p, layer == 0 ? 0 : 1, lc, tok, lane, pre, v);
    if (lc >= 0) {
      u16* xr = p.X() + (size_t)tok * DM;
#pragma unroll
      for (int i = 0; i < 4; ++i) *(u32x2*)(xr + lane * 4 + i * 256) = u32x2{cvtpk(v[4 * i], v[4 * i + 1]), cvtpk(v[4 * i + 2], v[4 * i + 3])};
    }
    float ss = 0;
#pragma unroll
    for (int i = 0; i < 16; ++i) ss += v[i] * v[i];
    ss = wave_sum(ss);
    const float rs = rsqrtf(ss * (1.f / DM) + EPS);
    const float* md = p.mod() + ((size_t)layer * 3 + modv(tok)) * 6144;
#pragma unroll
    for (int i = 0; i < 4; ++i) {
      const int c = lane * 4 + i * 256;
      const float4 g = *(const float4*)(gn + c), sh = *(const float4*)(md + c), sc = *(const float4*)(md + DM + c);
      v[4 * i] = v[4 * i] * rs * g.x * (1.f + sc.x) + sh.x; v[4 * i + 1] = v[4 * i + 1] * rs * g.y * (1.f + sc.y) + sh.y;
      v[4 * i + 2] = v[4 * i + 2] * rs * g.z * (1.f + sc.z) + sh.z; v[4 * i + 3] = v[4 * i + 3] * rs * g.w * (1.f + sc.w) + sh.w;
    }
    store_row_i8(v, p.H() + (size_t)tok * DM, p.hs() + tok, lane);
  }
}

struct EpiIn {
  u16* zqkv; u16* zg; u16* zt; const float* hs; const float* sw;
  __device__ __forceinline__ void pre(const G8Unit& u, int wr, int fr, float (&ep)[8], float* cb) const {
    if ((ltid() >> 6) == 0) g8_cload(sw + u.pn * 256, cb);
#pragma unroll
    for (int ai = 0; ai < 2; ++ai)
#pragma unroll
      for (int m = 0; m < 4; ++m) ep[ai * 4 + m] = hs[u.pm * 256 + ai * 128 + wr * 64 + m * 16 + fr];
  }
  __device__ __forceinline__ void operator()(const i32x4 (&acc)[2][2][4][2], const G8Unit& u, int wr, int wc, int fr, int fq, const float (&ep)[8], const float* cb) const {
#pragma unroll
    for (int bj = 0; bj < 2; ++bj) {
      const int c32 = u.pn * 256 + bj * 128 + wc * 32, c0 = c32 + 8 * fq;
      const f32x4 w0 = *(const f32x4*)(cb + bj * 128 + wc * 32 + 8 * fq), w1 = *(const f32x4*)(cb + bj * 128 + wc * 32 + 8 * fq + 4);
#pragma unroll
      for (int ai = 0; ai < 2; ++ai)
#pragma unroll
        for (int m = 0; m < 4; ++m) {
          const int row = u.pm * 256 + ai * 128 + wr * 64 + m * 16 + fr;
          f32x4 a, b;
#pragma unroll
          for (int j = 0; j < 4; ++j) { a[j] = (float)acc[ai][bj][m][0][j] * ep[ai * 4 + m] * w0[j]; b[j] = (float)acc[ai][bj][m][1][j] * ep[ai * 4 + m] * w1[j]; }
          if (c32 < 384) {
            *(u32x4*)(zqkv + (size_t)row * 384 + c0) = u32x4{cvtpk(a[0], a[1]), cvtpk(a[2], a[3]), cvtpk(b[0], b[1]), cvtpk(b[2], b[3])};
          } else if (c32 < 1536) {
            *(u32x4*)(zg + (size_t)row * ZG_W + (c0 - 384)) = u32x4{cvtpk(a[0], a[1]), cvtpk(a[2], a[3]), cvtpk(b[0], b[1]), cvtpk(b[2], b[3])};
          } else {
#pragma unroll
            for (int j = 0; j < 4; ++j) { zt[(size_t)(c0 - 1536 + j) * TT + row] = f2bf(a[j]); zt[(size_t)(c0 - 1536 + 4 + j) * TT + row] = f2bf(b[j]); }
          }
        }
    }
  }
};
__device__ __forceinline__ void phase_gemm_in(const Params& p, int layer, int bid, int nb, char* lds) {
  G8Plain S; S.nM = TT / 256; S.nN = NIN / 256; S.Kb = DM; S.G = nb; S.c = bid; S.Bt = (const char*)(p.bt_in() + (size_t)layer * NIN * DM);
  EpiIn E; E.zqkv = p.zqkv(); E.zg = p.zg(); E.zt = p.zt(); E.hs = p.hs(); E.sw = p.swin() + layer * NIN;
  gemm8_phase<true>(lds, (const char*)p.H(), DM, S, E);
}

__device__ __forceinline__ size_t qkv_row(int tok, int h) {
  const int b = tok < TL ? (tok >> 14) : ((tok - TL) >> 8);
  const int s = tok < TL ? (tok & (SEQ - 1)) : SEQ + ((tok - TL) & (LC - 1));
  return ((size_t)(b * 4 + h)) * SKV + s;
}
struct EpiQkv {
  const u16* zqkv; u16* Q; u16* KV; const float* ropec; const float* ropes; float* rsl;
  unsigned* kmx;
  __device__ __forceinline__ void pre(const G8Unit&, int, int, float (&)[8], float*) const {}
  __device__ __forceinline__ void operator()(const f32x4 (&acc)[2][2][4][2], const G8Unit& u, int wr, int wc, int fr, int fq, const float (&)[8], const float*) const {
    const int tid = ltid();
    {
      const int r = tid >> 1, half = tid & 1;
      const u16* row = zqkv + (size_t)(u.pm * 256 + r) * 384;
      float sq = 0, sk = 0;
#pragma unroll
      for (int i = 0; i < 16; ++i) {
        const u32x4 w = *(const u32x4*)(row + half * 128 + i * 8);
#pragma unroll
        for (int q = 0; q < 4; ++q) { const float a = __uint_as_float(w[q] << 16), b = __uint_as_float(w[q] & 0xFFFF0000u); sq += a * a + b * b; }
      }
#pragma unroll
      for (int i = 0; i < 8; ++i) {
        const u32x4 w = *(const u32x4*)(row + 256 + half * 64 + i * 8);
#pragma unroll
        for (int q = 0; q < 4; ++q) { const float a = __uint_as_float(w[q] << 16), b = __uint_as_float(w[q] & 0xFFFF0000u); sk += a * a + b * b; }
      }
      sq += shx<1>(sq); sk += shx<1>(sk);
      if (half == 0) { rsl[r] = rsqrtf(sq * (1.f / 256.f) + EPS); rsl[256 + r] = rsqrtf(sk * (1.f / 128.f) + EPS); }
    }
    asm volatile("s_waitcnt lgkmcnt(0)" ::: "memory"); __builtin_amdgcn_s_barrier(); __builtin_amdgcn_s_barrier(); asm volatile("" ::: "memory");
    const float* rsp = rsl + (u.pn >= 2 ? 256 : 0);
#pragma unroll
    for (int ai = 0; ai < 2; ++ai)
#pragma unroll
      for (int m = 0; m < 4; ++m) {
        const int rl = ai * 128 + wr * 64 + m * 16 + fr, tok = u.pm * 256 + rl;
        const float rs = rsp[rl] * (u.pn < 2 ? A_QSCALE : 1.f);
        if (u.pn == 1) {
          f32x4 a = acc[ai][0][m][0] * rs, b = acc[ai][0][m][1] * rs;
          f32x4 pa, pb;
#pragma unroll
          for (int j = 0; j < 4; ++j) { pa[j] = shx<32>(a[j]); pb[j] = shx<32>(b[j]); }
          f32x4 ca = {1.f, 1.f, 1.f, 1.f}, cb = ca, sa = {0.f, 0.f, 0.f, 0.f}, sb = sa;
          if (tok < TL) {
            const float* cp = ropec + (size_t)(tok & (SEQ - 1)) * 16 + 8 * (fq & 1); const float* sp = ropes + (size_t)(tok & (SEQ - 1)) * 16 + 8 * (fq & 1);
            ca = *(const f32x4*)cp; cb = *(const f32x4*)(cp + 4); sa = *(const f32x4*)sp; sb = *(const f32x4*)(sp + 4);
          }
          const float sg = fq < 2 ? -1.f : 1.f;
          a = a * ca + pa * sa * sg; b = b * cb + pb * sb * sg;
          *(u32x4*)(Q + qkv_row(tok, wc) * 96 + 64 + 8 * fq) = u32x4{cvtpk(a[0], a[1]), cvtpk(a[2], a[3]), cvtpk(b[0], b[1]), cvtpk(b[2], b[3])};
        } else {
#pragma unroll
          for (int bj = 0; bj < 2; ++bj) {
            const int c = bj * 128 + wc * 32 + 8 * fq, h = c >> 6, d = c & 63;
            const f32x4 a = acc[ai][bj][m][0] * rs, b = acc[ai][bj][m][1] * rs;
            u16* dst = u.pn == 0 ? Q + qkv_row(tok, h) * 96 + d : KV + qkv_row(tok, h) * 160 + (u.pn == 2 ? 0 : 96) + d;
            *(u32x4*)dst = u32x4{cvtpk(a[0], a[1]), cvtpk(a[2], a[3]), cvtpk(b[0], b[1]), cvtpk(b[2], b[3])};
          }
        }
      }
    if (u.pn == 2) {
      const int b = u.pm * 256 < TL ? (u.pm * 256) >> 14 : (u.pm * 256 - TL) >> 8;
#pragma unroll
      for (int bj = 0; bj < 2; ++bj) {
        float mx = 0.f;
#pragma unroll
        for (int ai = 0; ai < 2; ++ai)
#pragma unroll
          for (int m = 0; m < 4; ++m) {
            const float rs = rsp[ai * 128 + wr * 64 + m * 16 + fr];
            const f32x4 a = acc[ai][bj][m][0] * rs, b4 = acc[ai][bj][m][1] * rs;
            float ss = a[0] * a[0] + a[1] * a[1] + a[2] * a[2] + a[3] * a[3] + b4[0] * b4[0] + b4[1] * b4[1] + b4[2] * b4[2] + b4[3] * b4[3];
            ss += shx<16>(ss); ss += shx<32>(ss);
            mx = fmaxf(mx, ss);
          }
        mx = fmaxf(mx, shx<8>(mx)); mx = fmaxf(mx, shx<4>(mx)); mx = fmaxf(mx, shx<2>(mx)); mx = fmaxf(mx, shx<1>(mx));
        if ((ltid() & 63) == 0) atomicMax(kmx + (b * 4 + bj * 2 + (wc >> 1)) * 4 + (wc & 1), __float_as_uint(mx));
      }
    }
  }
};
__device__ __forceinline__ void phase_qkv(const Params& p, int layer, int bid, int nb, char* lds) {
  const int tid = ltid();
  {
    G8Plain S; S.nM = TT / 256; S.nN = 4; S.Kb = 768; S.G = nb; S.c = bid; S.Bt = (const char*)(p.bt_qkv() + (size_t)layer * 1024 * 384);
    EpiQkv E; E.zqkv = p.zqkv(); E.Q = p.Q(); E.KV = p.KV(); E.ropec = p.ropec(); E.ropes = p.ropes(); E.rsl = (float*)(lds + 131072); E.kmx = p.kmx() + layer * 32;
    gemm8_phase<false>(lds, (const char*)p.zqkv(), 768, S, E);
  }
  float krm0 = 0.f, krm1 = 0.f;
  for (int i = bid * NTHR + tid; i < TT * 16; i += nb * NTHR) {
    const int tok = i >> 4, f = i & 15;
    const float x1 = bf2f(p.zg()[(size_t)tok * ZG_W + ZG_KR + f]), x2 = bf2f(p.zg()[(size_t)tok * ZG_W + ZG_KR + 16 + f]);
    float cs = 1.f, sn = 0.f;
    if (tok < TL) { const int tpos = tok & (SEQ - 1); cs = p.ropec()[tpos * 16 + f]; sn = p.ropes()[tpos * 16 + f]; }
    const float y1 = x1 * cs - x2 * sn, y2 = x2 * cs + x1 * sn;
    const u16 o1 = f2bf(y1), o2 = f2bf(y2);
#pragma unroll
    for (int h = 0; h < 4; ++h) { u16* kv = p.KV() + qkv_row(tok, h) * 160 + 64; kv[f] = o1; kv[16 + f] = o2; }
    float ss = y1 * y1 + y2 * y2;
    ss += shx<8>(ss); ss += shx<4>(ss); ss += shx<2>(ss); ss += shx<1>(ss);
    const int b = tok < TL ? (tok >> 14) : ((tok - TL) >> 8);
    if (b == 0) krm0 = fmaxf(krm0, ss); else krm1 = fmaxf(krm1, ss);
  }
  krm0 = wave_max(krm0); krm1 = wave_max(krm1);
  if ((tid & 63) == 0) { atomicMax(p.kmx() + layer * 32 + 0 * 16 + 2, __float_as_uint(krm0)); atomicMax(p.kmx() + layer * 32 + 1 * 16 + 2, __float_as_uint(krm1)); }
}

constexpr int A_KROW = 208;
constexpr int A_TV = 128 * 64 * 2;
constexpr int A_TK = 128 * A_KROW;
constexpr int A_BUF = A_TV + A_TK;
constexpr int A_OFF_W = 3 * A_BUF;
constexpr int ATTN_LDS = A_OFF_W + 8 * 64 * 4;
#define SBAR() __builtin_amdgcn_sched_barrier(0)
__device__ __forceinline__ int crow(int r, int hi) { return (r & 3) + 8 * (r >> 2) + 4 * hi; }

__device__ __forceinline__ void a_partialSM(f32x16& p0) {
#pragma unroll
  for (int r = 0; r < 16; ++r) p0[r] = __builtin_amdgcn_exp2f(p0[r]);
}
__device__ __forceinline__ void a_finishSM(f32x16& p0, f32x16& p1, bf16x8& pa0, bf16x8& pa1, bf16x8& pa2, bf16x8& pa3) {
#pragma unroll
  for (int r = 0; r < 16; ++r) p1[r] = __builtin_amdgcn_exp2f(p1[r]);
#define PK4(P, BASE, OUT) do { unsigned a0 = cvtpk(P[BASE + 0], P[BASE + 1]), a1 = cvtpk(P[BASE + 2], P[BASE + 3]);   \
    unsigned b0 = cvtpk(P[BASE + 4], P[BASE + 5]), b1 = cvtpk(P[BASE + 6], P[BASE + 7]);                              \
    auto r0 = __builtin_amdgcn_permlane32_swap(a0, b0, false, false); auto r1 = __builtin_amdgcn_permlane32_swap(a1, b1, false, false); \
    u32x4 w = {r0[0], r1[0], r0[1], r1[1]}; OUT = *reinterpret_cast<bf16x8*>(&w); } while (0)
  PK4(p0, 0, pa0); PK4(p0, 8, pa1); PK4(p1, 0, pa2); PK4(p1, 8, pa3);
#undef PK4
}
__device__ __forceinline__ void a_qkt(f32x16& p0, f32x16& p1, const char* Ks, const bf16x8* qr, const float mneg, int r32, int hi) {
#pragma unroll
  for (int r = 0; r < 16; ++r) { p0[r] = mneg; p1[r] = mneg; }
#pragma unroll
  for (int d0 = 0; d0 < 6; ++d0) {
    const int cb = (d0 * 16 + hi * 8) * 2;
    const bf16x8 b0 = *reinterpret_cast<const bf16x8*>(Ks + r32 * A_KROW + cb);
    const bf16x8 b1 = *reinterpret_cast<const bf16x8*>(Ks + (32 + r32) * A_KROW + cb);
    p0 = __builtin_amdgcn_mfma_f32_32x32x16_bf16(b0, qr[d0], p0, 0, 0, 0); p1 = __builtin_amdgcn_mfma_f32_32x32x16_bf16(b1, qr[d0], p1, 0, 0, 0);
  }
}
__device__ __forceinline__ int a_v_st(int k, int c) { const int kk = (k & ~0xC) | ((k & 4) << 1) | ((k & 8) >> 1); return ((kk >> 3) * 2 + (c >> 5)) * 512 + ((kk & 7) * 32 + (c & 31)) * 2; }
__device__ __forceinline__ int a_v_rd_base(int lane) { return ((lane & 3) << 3) | (((lane >> 2) & 3) << 6) | (((lane >> 4) & 1) << 5) | (((lane >> 5) & 1) << 8); }
constexpr int a_v_rd_off(int d0, int ks, int half) { return d0 * 512 + ks * 2048 + half * 1024; }
template <int OFF> __device__ __forceinline__ s16x4 a_tr_read(int vb) {
  s16x4 r; asm volatile("ds_read_b64_tr_b16 %0, %1 offset:%2" : "=&v"(r) : "v"(vb), "i"(OFF) : "memory"); return r;
}
template <int D0> __device__ __forceinline__ void a_pv_one(f32x16& od, int vb, bf16x8 pa0, bf16x8 pa1, bf16x8 pa2, bf16x8 pa3) {
  const s16x4 l0 = a_tr_read<a_v_rd_off(D0, 0, 0)>(vb), h0 = a_tr_read<a_v_rd_off(D0, 0, 1)>(vb), l1 = a_tr_read<a_v_rd_off(D0, 1, 0)>(vb), h1 = a_tr_read<a_v_rd_off(D0, 1, 1)>(vb);
  const s16x4 l2 = a_tr_read<a_v_rd_off(D0, 2, 0)>(vb), h2 = a_tr_read<a_v_rd_off(D0, 2, 1)>(vb), l3 = a_tr_read<a_v_rd_off(D0, 3, 0)>(vb), h3 = a_tr_read<a_v_rd_off(D0, 3, 1)>(vb);
  asm volatile("s_waitcnt lgkmcnt(0)" ::: "memory"); SBAR();
#define PK(L, H) (bf16x8){L[0], L[1], L[2], L[3], H[0], H[1], H[2], H[3]}
  od = __builtin_amdgcn_mfma_f32_32x32x16_bf16(pa0, PK(l0, h0), od, 0, 0, 0);
  od = __builtin_amdgcn_mfma_f32_32x32x16_bf16(pa1, PK(l1, h1), od, 0, 0, 0);
  od = __builtin_amdgcn_mfma_f32_32x32x16_bf16(pa2, PK(l2, h2), od, 0, 0, 0);
  od = __builtin_amdgcn_mfma_f32_32x32x16_bf16(pa3, PK(l3, h3), od, 0, 0, 0);
#undef PK
}
__device__ __forceinline__ void a_pv(f32x16* o, int vb, bf16x8 pa0, bf16x8 pa1, bf16x8 pa2, bf16x8 pa3) {
  a_pv_one<0>(o[0], vb, pa0, pa1, pa2, pa3);
  { const bf16x8 ones = {0x3F80, 0x3F80, 0x3F80, 0x3F80, 0x3F80, 0x3F80, 0x3F80, 0x3F80};
    o[2] = __builtin_amdgcn_mfma_f32_32x32x16_bf16(pa0, ones, o[2], 0, 0, 0); o[2] = __builtin_amdgcn_mfma_f32_32x32x16_bf16(pa1, ones, o[2], 0, 0, 0);
    o[2] = __builtin_amdgcn_mfma_f32_32x32x16_bf16(pa2, ones, o[2], 0, 0, 0); o[2] = __builtin_amdgcn_mfma_f32_32x32x16_bf16(pa3, ones, o[2], 0, 0, 0); }
  a_pv_one<1>(o[1], vb, pa0, pa1, pa2, pa3);
}

__device__ __forceinline__ void attn_item(const u16* __restrict__ Qb, const u16* __restrict__ KVh, int seq, float kmax, u16* __restrict__ yout  , char* lds) {
  const int tid = ltid(), wid = tid >> 6, lane = tid & 63, r32 = lane & 31, hi = lane >> 5;
  f32x16 o[3] = {}; bf16x8 qr[6];
  const u16* Qw = Qb + (size_t)(wid * 32 + r32) * 96 + hi * 8;
#pragma unroll
  for (int d0 = 0; d0 < 6; ++d0) qr[d0] = *reinterpret_cast<const bf16x8*>(Qw + d0 * 16);
  float mneg;
  {
    float ss = 0.f;
#pragma unroll
    for (int d0 = 0; d0 < 6; ++d0)
#pragma unroll
      for (int j = 0; j < 8; ++j) { const float v = bf2f((u16)qr[d0][j]); ss += v * v; }
    ss += shx<32>(ss);
    mneg = -sqrtf(ss) * kmax;
  }
  int lw[5];
#pragma unroll
  for (int i = 0; i < 5; ++i) {
    const int g = tid + i * 512, key = g / 20, cc = g % 20;
    lw[i] = cc < 12 ? (A_TV + key * A_KROW + cc * 16) : ((key >> 6) * 8192 + a_v_st(key & 63, (cc - 12) * 8));
  }
  const int vrb = (int)(uintptr_t)lds + a_v_rd_base(lane);
  bf16x8 sg[5];
  const char* gsrc = (const char*)KVh + tid * 16;
#define SLOAD(t) do { const char* s_ = gsrc + (size_t)(t) * 40960; _Pragma("unroll") for (int i = 0; i < 5; ++i) sg[i] = *(const bf16x8*)(s_ + i * 8192); } while (0)
#define SWRITE(bo_) do { _Pragma("unroll") for (int i = 0; i < 5; ++i) *(bf16x8*)(lds + (bo_) + lw[i]) = sg[i]; } while (0)
  f32x16 pA0, pA1, pB0, pB1; bf16x8 pa0, pa1, pa2, pa3; const int NT = seq / 128;
  SLOAD(0); SWRITE(0); if (1 < NT) SLOAD(1);
  __syncthreads();
  int bo = 0;
  {
    if (1 < NT) { SWRITE(A_BUF); if (2 < NT) SLOAD(2); }
    SBAR(); a_qkt(pA0, pA1, lds + bo + A_TV, qr, mneg, r32, hi); a_partialSM(pA0);
    SBAR(); a_qkt(pB0, pB1, lds + bo + A_TV + 64 * A_KROW, qr, mneg, r32, hi);
    a_finishSM(pA0, pA1, pa0, pa1, pa2, pa3); SBAR();
    a_pv(o, vrb + bo, pa0, pa1, pa2, pa3); a_partialSM(pB0);
    __syncthreads();
  }
  for (int t = 1; t < NT; ++t) {
    const int bp = bo;
    bo = bo + A_BUF; if (bo == 3 * A_BUF) bo = 0;
    int bn = bo + A_BUF; if (bn == 3 * A_BUF) bn = 0;
    if (t + 1 < NT) { SWRITE(bn); if (t + 2 < NT) SLOAD(t + 2); }
    SBAR(); a_qkt(pA0, pA1, lds + bo + A_TV, qr, mneg, r32, hi);
    a_finishSM(pB0, pB1, pa0, pa1, pa2, pa3); SBAR();
    a_pv(o, vrb + bp + 8192, pa0, pa1, pa2, pa3); a_partialSM(pA0);
    SBAR(); a_qkt(pB0, pB1, lds + bo + A_TV + 64 * A_KROW, qr, mneg, r32, hi);
    a_finishSM(pA0, pA1, pa0, pa1, pa2, pa3); SBAR();
    a_pv(o, vrb + bo, pa0, pa1, pa2, pa3); a_partialSM(pB0);
    __syncthreads();
  }
  a_finishSM(pB0, pB1, pa0, pa1, pa2, pa3); SBAR();
  a_pv(o, vrb + bo + 8192, pa0, pa1, pa2, pa3);
#pragma unroll
  for (int r = 0; r < 16; ++r) {
    const int orow = crow(r, hi);
    const float rl = __builtin_amdgcn_rcpf(o[2][r]);
    const float v0 = o[0][r] * rl, v1 = o[1][r] * rl;
    float ss = v0 * v0 + v1 * v1;
    ss += shx<16>(ss); ss += shx<8>(ss); ss += shx<4>(ss); ss += shx<2>(ss); ss += shx<1>(ss);
    const float rs = rsqrtf(ss * (1.f / 64.f) + EPS);
    u16* dst = yout + (size_t)(wid * 32 + orow) * DM;
    dst[r32] = f2bf(v0 * rs); dst[32 + r32] = f2bf(v1 * rs);
  }
  __syncthreads();
#undef SLOAD
#undef SWRITE
}

__device__ __forceinline__ void phase_attn(const Params& p, int layer, int bid, int nb, char* lds) {
  const int nitems = 512 + (layer == 0 ? 8 : 0);
  const unsigned* kmx = p.kmx() + layer * 32;
  for (int it = bid; it < nitems; it += nb) {
    int b, h, q0, k0, seq, tok0;
    if (it < 512) { const int pair = it & 7, qb = (it >> 3); h = pair & 3; b = pair >> 2; q0 = qb * 256; k0 = 0; seq = SKV; tok0 = b * SEQ + qb * 256; }
    else { const int i2 = it - 512; h = i2 & 3; b = i2 >> 2; q0 = SEQ; k0 = SEQ; seq = LC; tok0 = TL + b * LC; }
    const size_t base = (size_t)(b * 4 + h) * SKV;
    const float k2 = __uint_as_float(kmx[(b * 4 + h) * 4 + 0]) + __uint_as_float(kmx[(b * 4 + h) * 4 + 1]) + __uint_as_float(kmx[b * 16 + 2]);
    attn_item(p.Q() + (base + q0) * 96, p.KV() + (base + k0) * 160, seq, sqrtf(k2) * 1.02f, p.ymix() + (size_t)tok0 * DM + h * 64, lds);
  }
}

__device__ __forceinline__ float hy_sconv(const u16* __restrict__ row, int t, int Ls, float w0, float w1, float w2, float bb) {
  const float zm = t > 0 ? bf2f(row[t - 1]) : 0.f, z0 = bf2f(row[t]), zp = t + 1 < Ls ? bf2f(row[t + 1]) : 0.f;
  return w0 * zm + w1 * z0 + w2 * zp + bb;
}
__device__ __forceinline__ float2 hy_sconv2(unsigned prv, unsigned cur, unsigned nxt, float w0, float w1, float w2, float bb) {
  const float zm = __uint_as_float(prv & 0xFFFF0000u), z0 = __uint_as_float(cur << 16), z1 = __uint_as_float(cur & 0xFFFF0000u), z2 = __uint_as_float(nxt << 16);
  return make_float2(w0 * zm + w1 * z0 + w2 * z1 + bb, w0 * z0 + w1 * z1 + w2 * z2 + bb);
}
__device__ __forceinline__ void hyena_item(const Params& p, int layer, int b, int ch, char* lds) {
  float2* s = (float2*)lds;
  const int tid = ltid();
  const float* cw = p.hy_conv_w() + (size_t)layer * 3 * 768; const float* cb = p.hy_conv_b() + (size_t)layer * 768;
  const unsigned* r0 = (const unsigned*)(p.zt() + (size_t)(ZT_HY + ch) * TT + (size_t)b * SEQ);
  const unsigned* r1 = (const unsigned*)(p.zt() + (size_t)(ZT_HY + 256 + ch) * TT + (size_t)b * SEQ);
  const unsigned* r2 = (const unsigned*)(p.zt() + (size_t)(ZT_HY + 512 + ch) * TT + (size_t)b * SEQ);
  const float a0 = cw[ch], a1 = cw[768 + ch], a2 = cw[1536 + ch], ab = cb[ch];
  const float b0 = cw[256 + ch], b1 = cw[768 + 256 + ch], b2 = cw[1536 + 256 + ch], bb = cb[256 + ch];
  const float c0 = cw[512 + ch], c1 = cw[768 + 512 + ch], c2 = cw[1536 + 512 + ch], cbb = cb[512 + ch];
  unsigned vgr[16], x0r[16];
#pragma unroll
  for (int hb2 = 0; hb2 < 2; ++hb2) {
    unsigned ld[8][9];
#pragma unroll
    for (int ii = 0; ii < 8; ++ii) {
      const int m = tid + 512 * (hb2 * 8 + ii);
      const int mp = m > 0 ? m - 1 : 0, mn = m + 1 < SEQ / 2 ? m + 1 : m;
      ld[ii][0] = r0[mp]; ld[ii][1] = r0[m]; ld[ii][2] = r0[mn];
      ld[ii][3] = r1[mp]; ld[ii][4] = r1[m]; ld[ii][5] = r1[mn];
      ld[ii][6] = r2[mp]; ld[ii][7] = r2[m]; ld[ii][8] = r2[mn];
    }
#pragma unroll
    for (int ii = 0; ii < 8; ++ii) {
      const int i = hb2 * 8 + ii, m = tid + 512 * i;
      const unsigned mkp = m > 0 ? 0xFFFFFFFFu : 0u, mkn = m + 1 < SEQ / 2 ? 0xFFFFFFFFu : 0u;
      const float2 ux = hy_sconv2(ld[ii][0] & mkp, ld[ii][1], ld[ii][2] & mkn, a0, a1, a2, ab);
      x0r[i] = cvtpk(ux.x, ux.y);
      const float2 u1 = hy_sconv2(ld[ii][3] & mkp, ld[ii][4], ld[ii][5] & mkn, b0, b1, b2, bb);
      const float2 uv = hy_sconv2(ld[ii][6] & mkp, ld[ii][7], ld[ii][8] & mkn, c0, c1, c2, cbb);
      const float2 vgf = make_float2(uv.x * u1.x, uv.y * u1.y);
      vgr[i] = cvtpk(vgf.x, vgf.y);
      s[swz(m)] = vgf;
      s[swz(m + SEQ / 2)] = make_float2(0.f, 0.f);
    }
  }
  __syncthreads();
  fft_fwd(s, p.tw());
  {
    const float4* hs = p.hspec() + ((size_t)layer * 256 + ch) * HSP;
    float4 hv[17];
#pragma unroll
    for (int i = 0; i < 17; ++i) { const int k = tid + 512 * i; hv[i] = hs[k <= FM / 2 ? k : 0]; }
    const float2 twl = p.tw()[tid];
#pragma unroll
    for (int i = 0; i < 17; ++i) {
      const int k = tid + 512 * i;
      if (k <= FM / 2) {
        const int pk = swz(rev7(k)), pm = swz(rev7((FM - k) & (FM - 1)));
        const float2 zk = s[pk], zm = s[pm];
        const float4 h = hv[i];
        const float2 He = make_float2(h.x, h.y), Ho = make_float2(h.z, h.w);
        const float2 Xe = make_float2(0.5f * (zk.x + zm.x), 0.5f * (zk.y - zm.y));
        const float2 Xo = make_float2(0.5f * (zk.y + zm.y), -0.5f * (zk.x - zm.x));
        const float2 twk = cmul(twl, p.tw()[512 * i]);
        const float2 t1 = cmul(twk, cmul(Xo, Ho));
        const float2 e1 = cmul(Xe, He);
        const float2 Ye = make_float2(e1.x + t1.x, e1.y + t1.y);
        const float2 o1 = cmul(Xe, Ho), o2 = cmul(Xo, He);
        const float2 Yo = make_float2(o1.x + o2.x, o1.y + o2.y);
        s[pk] = make_float2(Ye.x - Yo.y, Ye.y + Yo.x);
        if (pm != pk) s[pm] = make_float2(Ye.x + Yo.y, -Ye.y + Yo.x);
      }
    }
  }
  __syncthreads();
  fft_inv(s, p.tw());
  const float hb = p.hy_bias()[layer * 256 + ch];
  unsigned* orow = (unsigned*)(p.hyo() + (size_t)ch * TT + (size_t)b * SEQ);
#pragma unroll
  for (int i = 0; i < 16; ++i) {
    const int m = tid + 512 * i;
    const float2 y = s[swz(m)];
    orow[m] = cvtpk((y.x + __uint_as_float(vgr[i] << 16) * hb) * __uint_as_float(x0r[i] << 16), (y.y + __uint_as_float(vgr[i] & 0xFFFF0000u) * hb) * __uint_as_float(x0r[i] & 0xFFFF0000u));
  }
  __syncthreads();
}
__device__ __forceinline__ void fnet_item(const Params& p, int b, int j, char* lds) {
  float2* s = (float2*)lds;
  const int tid = ltid();
  const u16* rr = p.zt() + (size_t)(ZT_FR + j) * TT + (size_t)b * SEQ;
  const u16* ri = p.zt() + (size_t)(ZT_FI + j) * TT + (size_t)b * SEQ;
  {
    u32x4 vr[4], vi[4];
#pragma unroll
    for (int i = 0; i < 4; ++i) { const int m0 = (tid + 512 * i) * 8; vr[i] = *(const u32x4*)(rr + m0); vi[i] = *(const u32x4*)(ri + m0); }
#pragma unroll
    for (int i = 0; i < 4; ++i) {
      const int m0 = (tid + 512 * i) * 8;
#pragma unroll
      for (int q = 0; q < 4; ++q) {
        s[swz(m0 + 2 * q)] = make_float2(__uint_as_float(vr[i][q] << 16), __uint_as_float(vi[i][q] << 16));
        s[swz(m0 + 2 * q + 1)] = make_float2(__uint_as_float(vr[i][q] & 0xFFFF0000u), __uint_as_float(vi[i][q] & 0xFFFF0000u));
      }
    }
  }
  __syncthreads();
  fft_fwd(s, p.tw());
#ifdef PROBE_FFT
  fft_inv(s, p.tw());
  for (int m = tid; m < FM; m += NTHR) { float2 v = s[m]; v.x *= (1.f / 16384.f); v.y *= (1.f / 16384.f); s[m] = v; }
  __syncthreads();
  fft_fwd(s, p.tw());
#endif
  u16* orow = p.fno() + (size_t)j * TT + (size_t)b * SEQ;
#pragma unroll 8
  for (int k = tid; k < FM; k += NTHR) orow[k] = f2bf(s[swz(rev7(k))].x * (1.f / 128.f));
  __syncthreads();
}
__device__ __forceinline__ void hyena_ctx_item(const Params& p, int b, int ch, char* lds) {
  float* vg = (float*)lds;
  float* x0 = vg + 256;
  float* hf = x0 + 256;
  float* hbk = hf + 256;
  const int tid = ltid();
  const float* cw = p.hy_conv_w(); const float* cb = p.hy_conv_b();
  const size_t off = (size_t)TL + (size_t)b * LC;
  const u16* r0 = p.zt() + (size_t)(ZT_HY + ch) * TT + off;
  const u16* r1 = p.zt() + (size_t)(ZT_HY + 256 + ch) * TT + off;
  const u16* r2 = p.zt() + (size_t)(ZT_HY + 512 + ch) * TT + off;
  if (tid < 256) {
    const int t = tid;
    vg[t] = hy_sconv(r2, t, LC, cw[512 + ch], cw[768 + 512 + ch], cw[1536 + 512 + ch], cb[512 + ch]) *
            hy_sconv(r1, t, LC, cw[256 + ch], cw[768 + 256 + ch], cw[1536 + 256 + ch], cb[256 + ch]);
    x0[t] = hy_sconv(r0, t, LC, cw[ch], cw[768 + ch], cw[1536 + ch], cb[ch]);
    hf[t] = p.hfc()[(size_t)ch * LC + t]; hbk[t] = p.hfc()[(size_t)(256 + ch) * LC + t];
  }
  const float ssq_c = filt_ssq(p.hpart() + (size_t)2 * 256 * 512, ch, (float*)(lds + 8192));
  if (tid < 256) {
    const int t = tid; float y = 0;
    for (int q = 0; q <= t; ++q) y += hf[t - q] * vg[q];
    for (int q = t + 1; q < LC; ++q) y += hbk[q - t] * vg[q];
    y *= rsqrtf(ssq_c);
    p.hyo()[(size_t)ch * TT + off + t] = f2bf((y + vg[t] * p.hy_bias()[ch]) * x0[t]);
  }
  __syncthreads();
}
__device__ __forceinline__ void fnet_ctx_item(const Params& p, int b, int j, char* lds) {
  float* ur = (float*)lds; float* ui = ur + 256; float* cst = ui + 256; float* snt = cst + 256;
  const int tid = ltid();
  const size_t off = (size_t)TL + (size_t)b * LC;
  if (tid < 256) {
    ur[tid] = bf2f(p.zt()[(size_t)(ZT_FR + j) * TT + off + tid]); ui[tid] = bf2f(p.zt()[(size_t)(ZT_FI + j) * TT + off + tid]);
    float sn, cs; sincospif((float)tid / 128.f, &sn, &cs); cst[tid] = cs; snt[tid] = sn;
  }
  __syncthreads();
  if (tid < 256) {
    const int k = tid; float y = 0;
    for (int l = 0; l < 256; ++l) { const int m = (l * k) & 255; y += cst[m] * ur[l] + snt[m] * ui[l]; }
    p.fno()[(size_t)j * TT + off + k] = f2bf(y * 0.0625f);
  }
  __syncthreads();
}
__device__ __forceinline__ void phase_fftmix(const Params& p, int layer, int bid, int nb, char* lds) {
  const int nitems = layer == 0 ? 2048 : 1024;
  for (int it = bid; it < nitems; it += nb) {
    const int k = it & 511, b = k >> 8, c = k & 255;
    if (it < 512) hyena_item(p, layer, b, c, lds);
    else if (it < 1024) fnet_item(p, b, c, lds);
    else if (it < 1536) hyena_ctx_item(p, b, c, lds);
    else fnet_ctx_item(p, b, c, lds);
  }
}
constexpr int GLG = 17, NGRP = 16;
__device__ __forceinline__ int gla_chain_tok(int dir, int b, int n, int i) {
  const int base = n < 4 ? TL + b * LC : b * SEQ, len = n < 4 ? LC : SEQ, m = n < 4 ? n : n - 4;
  return dir == 0 ? base + 64 * m + i : base + (len - 1) - (64 * m + i);
}
__device__ __forceinline__ float logsig16(float x) { return (fminf(x, 0.f) - __logf(1.f + __expf(-fabsf(x)))) * (1.f / 16.f); }
__device__ __forceinline__ float wave_scan_incl(float v, int lane) {
#pragma unroll
  for (int o = 1; o < 64; o <<= 1) { const float t = __shfl_up(v, o, 64); if (lane >= o) v += t; }
  return v;
}
__device__ __forceinline__ void phase_gla_a(const Params& p, int layer, int bid, int nb, char* lds) {
  const int tid = ltid(), wid = tid >> 6, lane = tid & 63, r32 = lane & 31, hi = lane >> 5;
  const float* gb = p.gla_gk_b() + (size_t)layer * 256;
  char* wimg = lds + wid * 12288;
  for (int it = bid; it < 16 * NGRP; it += nb) {
    const int chain = it >> 4, g = it & 15, dir = chain >> 3, b = (chain >> 2) & 1, h = chain & 3;
    const int n0 = g * GLG, n1 = min(n0 + GLG, NCH), nch = n1 - n0;
    char* WT = lds + wid * 13824; char* VT = WT + 4608;
    float* dvl = (float*)(lds + 8 * 13824);
#pragma unroll
    for (int c = 0; c < 3; ++c) {
      const int cl = wid + 8 * c;
      if (cl < nch) {
        const int n = n0 + cl;
        {
          const u16* vbase = p.zg() + ZG_GV + h * 64 + lane;
          u16 vv[64];
#pragma unroll
          for (int i = 0; i < 64; ++i) vv[i] = vbase[(size_t)gla_chain_tok(dir, b, n, i) * ZG_W];
#pragma unroll
          for (int q = 0; q < 8; ++q)
            *(u32x4*)(VT + lane * 144 + q * 16) = u32x4{(unsigned)vv[8 * q] | ((unsigned)vv[8 * q + 1] << 16), (unsigned)vv[8 * q + 2] | ((unsigned)vv[8 * q + 3] << 16),
                                                       (unsigned)vv[8 * q + 4] | ((unsigned)vv[8 * q + 5] << 16), (unsigned)vv[8 * q + 6] | ((unsigned)vv[8 * q + 7] << 16)};
        }
        {
          const int kk = lane & 31, hs = lane >> 5;
          const u16* kb = p.zg() + ZG_GK + h * 32 + kk; const u16* gbp = p.zg() + ZG_GP + dir * 128 + h * 32 + kk;
          const float bias = gb[dir * 128 + h * 32 + kk];
          float bc[32], kf[32];
#pragma unroll
          for (int i = 0; i < 32; ++i) {
            const size_t ro = (size_t)gla_chain_tok(dir, b, n, hs * 32 + i) * ZG_W;
            kf[i] = bf2f(kb[ro]); bc[i] = bf2f(gbp[ro]);
          }
          float run = 0.f;
#pragma unroll
          for (int i = 0; i < 32; ++i) { const float x = bc[i] + bias; run += (fminf(x, 0.f) - __logf(1.f + __expf(-fabsf(x)))) * (1.f / 16.f); bc[i] = run; }
          const float lowtot = __shfl(run, kk, 64);
          const float uptot = __shfl(run, 32 + kk, 64);
          const float bl = lowtot + uptot, off = hs ? lowtot : 0.f;
          unsigned wp[16];
#pragma unroll
          for (int i = 0; i < 16; ++i) wp[i] = cvtpk(kf[2 * i] * __expf(bl - (bc[2 * i] + off)), kf[2 * i + 1] * __expf(bl - (bc[2 * i + 1] + off)));
#pragma unroll
          for (int q = 0; q < 4; ++q) *(u32x4*)(WT + kk * 144 + hs * 64 + q * 16) = u32x4{wp[4 * q], wp[4 * q + 1], wp[4 * q + 2], wp[4 * q + 3]};
          if (hs == 0) dvl[cl * 32 + kk] = __expf(bl);
        }
        asm volatile("s_waitcnt lgkmcnt(0)" ::: "memory");
        f32x16 d0 = {}, d1 = {};
#pragma unroll
        for (int s4 = 0; s4 < 4; ++s4) {
          const bf16x8 af = *(const bf16x8*)(WT + r32 * 144 + (16 * s4 + 8 * hi) * 2);
          const bf16x8 v0 = *(const bf16x8*)(VT + r32 * 144 + (16 * s4 + 8 * hi) * 2);
          const bf16x8 v1 = *(const bf16x8*)(VT + (32 + r32) * 144 + (16 * s4 + 8 * hi) * 2);
          d0 = __builtin_amdgcn_mfma_f32_32x32x16_bf16(af, v0, d0, 0, 0, 0);
          d1 = __builtin_amdgcn_mfma_f32_32x32x16_bf16(af, v1, d1, 0, 0, 0);
        }
        asm volatile("s_waitcnt lgkmcnt(0)" ::: "memory");
        {
          float* dg = p.gds() + ((size_t)chain * NCH + n) * 2048;
#pragma unroll
          for (int r = 0; r < 16; ++r) { dg[crow(r, hi) * 64 + r32] = d0[r]; dg[crow(r, hi) * 64 + 32 + r32] = d1[r]; }
        }
      }
      __builtin_amdgcn_sched_barrier(0);
    }
    __syncthreads();
    {
      const int kk = tid >> 4, v0 = (tid & 15) * 4;
      float st[4] = {0.f, 0.f, 0.f, 0.f}; float dcum = 1.f;
      float* gp0 = p.gds() + ((size_t)chain * NCH + n0) * 2048 + kk * 64 + v0;
      float4 av[GLG];
#pragma unroll
      for (int cl = 0; cl < GLG; ++cl) av[cl] = *(const float4*)(gp0 + (size_t)(cl < nch ? cl : 0) * 2048);
#pragma unroll
      for (int cl = 0; cl < GLG; ++cl) {
        if (cl < nch) {
          const float d = dvl[cl * 32 + kk];
          *(float4*)(gp0 + (size_t)cl * 2048) = make_float4(st[0], st[1], st[2], st[3]);
          if ((tid & 15) == 0) p.gdv()[((size_t)chain * NCH + n0 + cl) * 32 + kk] = dcum;
          st[0] = st[0] * d + av[cl].x; st[1] = st[1] * d + av[cl].y; st[2] = st[2] * d + av[cl].z; st[3] = st[3] * d + av[cl].w;
          dcum *= d;
        }
      }
      float* at = p.gst() + ((size_t)chain * NGRP + g) * 2048 + kk * 64 + v0;
      *(float4*)at = make_float4(st[0], st[1], st[2], st[3]);
      if ((tid & 15) == 0) p.gst()[(size_t)16 * NGRP * 2048 + ((size_t)chain * NGRP + g) * 32 + kk] = dcum;
    }
    __syncthreads();
  }
}

constexpr int GC_QP = 33792, GC_KP = GC_QP + 10240, GC_VT = GC_KP + 10240, GC_ST = GC_VT + 18432, GC_AX = GC_ST + 10240;
__device__ __forceinline__ void phase_gla_c(const Params& p, int layer, int bid, int nb, char* lds) {
  float* gl = (float*)lds;
  float* qraw = gl + 2 * 64 * 33;
  float* kraw = qraw + 64 * 33;
  float* Of = (float*)lds;
  char* Qp = lds + GC_QP;
  char* Kp = lds + GC_KP;
  char* VT = lds + GC_VT;
  char* ST = lds + GC_ST;
  const int tid = ltid(), wid = tid >> 6, lane = tid & 63, r32 = lane & 31, hi = lane >> 5;
  char* Ax = lds + GC_AX + wid * 4608;
  const float* gb = p.gla_gk_b() + (size_t)layer * 256;
  const int pc_lo = layer == 0 ? 0 : 4, npc = NCH - pc_lo, nitem = 8 * npc;
  const int per = (nitem + nb - 1) / nb, q_beg = bid * per, q_end = min(nitem, q_beg + per);
  const int sdir = tid >> 8, sk = (tid >> 3) & 31, sv0 = (tid & 7) * 8;
  float G[8]; int g_cached = -1, bh_cached = -1;
  const int lpos = tid >> 3, lc4 = (tid & 7) * 4;
  u32x2 rq, rk, rg0, rg1, rva, rvb; float4 pl0, pl1; float pdp;
#define GC_ITEM(q_, bh_, pc_, b_, h_, tok0_) const int bh_ = (q_) / npc, pc_ = pc_lo + (q_) % npc, b_ = bh_ >> 2, h_ = bh_ & 3; \
    const int tok0_ = pc_ < 4 ? TL + b_ * LC + pc_ * 64 : b_ * SEQ + (pc_ - 4) * 64
#define GC_LOADRAW(tok0_, h_) do { const u16* zr = p.zg() + (size_t)((tok0_) + lpos) * ZG_W; \
    rq = *(const u32x2*)(zr + ZG_GQ + (h_) * 32 + lc4); rk = *(const u32x2*)(zr + ZG_GK + (h_) * 32 + lc4); \
    rg0 = *(const u32x2*)(zr + ZG_GP + (h_) * 32 + lc4); rg1 = *(const u32x2*)(zr + ZG_GP + 128 + (h_) * 32 + lc4); \
    rva = *(const u32x2*)(zr + ZG_GV + (h_) * 64 + lc4 * 2); rvb = *(const u32x2*)(zr + ZG_GV + (h_) * 64 + lc4 * 2 + 4); } while (0)
#define GC_LOADST(pc_, b_, h_) do { const int chain_ = sdir * 8 + (b_) * 4 + (h_); \
    const int n_ = sdir == 0 ? (pc_) : ((pc_) < 4 ? 3 - (pc_) : 4 + 255 - ((pc_) - 4)); \
    const float* lp_ = p.gds() + ((size_t)chain_ * NCH + n_) * 2048 + sk * 64 + sv0; \
    pl0 = *(const float4*)lp_; pl1 = *(const float4*)(lp_ + 4); pdp = p.gdv()[((size_t)chain_ * NCH + n_) * 32 + sk]; } while (0)
  if (q_beg < q_end) { GC_ITEM(q_beg, bh0, pc0, b0, h0, t00); GC_LOADRAW(t00, h0); GC_LOADST(pc0, b0, h0); }
  for (int qi = q_beg; qi < q_end; ++qi) {
    GC_ITEM(qi, bh, pc, b, h, tok0);
    {
      const int pos = lpos, c4 = lc4;
      const float sc = 0.17677669529663687f;
      qraw[pos * 33 + c4] = BF_LO(rq[0]) * sc; qraw[pos * 33 + c4 + 1] = BF_HI(rq[0]) * sc; qraw[pos * 33 + c4 + 2] = BF_LO(rq[1]) * sc; qraw[pos * 33 + c4 + 3] = BF_HI(rq[1]) * sc;
      kraw[pos * 33 + c4] = BF_LO(rk[0]); kraw[pos * 33 + c4 + 1] = BF_HI(rk[0]); kraw[pos * 33 + c4 + 2] = BF_LO(rk[1]); kraw[pos * 33 + c4 + 3] = BF_HI(rk[1]);
#pragma unroll
      for (int d = 0; d < 2; ++d) {
        const u32x2 rg = d ? rg1 : rg0; const float4 bb = *(const float4*)(gb + d * 128 + h * 32 + c4);
        const int i = d ? 63 - pos : pos;
        float* gd = gl + (d * 64 + i) * 33 + c4;
        gd[0] = logsig16(BF_LO(rg[0]) + bb.x); gd[1] = logsig16(BF_HI(rg[0]) + bb.y); gd[2] = logsig16(BF_LO(rg[1]) + bb.z); gd[3] = logsig16(BF_HI(rg[1]) + bb.w);
      }
#pragma unroll
      for (int j = 0; j < 4; ++j) {
        const unsigned w = j < 2 ? rva[j] : rvb[j - 2]; const int v = c4 * 2 + 2 * j;
        *(u16*)(VT + (0 * 64 + v) * 144 + pos * 2) = (u16)(w & 0xFFFFu); *(u16*)(VT + (1 * 64 + v) * 144 + (63 - pos) * 2) = (u16)(w & 0xFFFFu);
        *(u16*)(VT + (0 * 64 + v + 1) * 144 + pos * 2) = (u16)(w >> 16); *(u16*)(VT + (1 * 64 + v + 1) * 144 + (63 - pos) * 2) = (u16)(w >> 16);
      }
    }
    if (qi + 1 < q_end) { GC_ITEM(qi + 1, bhn, pcn, bn, hn, t0n); GC_LOADRAW(t0n, hn); }
    __syncthreads();
    {
      const int col = tid & 63, d = col >> 5, c = col & 31, part = tid >> 6;
      float* ptot = (float*)(lds + GC_AX);
      float bv[8]; float run = 0.f;
#pragma unroll
      for (int j = 0; j < 8; ++j) { run += gl[(d * 64 + part * 8 + j) * 33 + c]; bv[j] = run; }
      ptot[part * 64 + col] = run;
      __syncthreads();
      float off = 0.f;
#pragma unroll
      for (int q = 0; q < 7; ++q) off += (q < part) ? ptot[q * 64 + col] : 0.f;
#pragma unroll
      for (int j = 0; j < 8; ++j) gl[(d * 64 + part * 8 + j) * 33 + c] = bv[j] + off;
    }
    __syncthreads();
    {
#pragma unroll
      for (int e = 0; e < 2; ++e) {
        const int idx = tid + e * 512, d = idx >> 9, i = (idx >> 3) & 63, c4 = (idx & 7) * 4, pos = d ? 63 - i : i;
        float qo[4], ko[4];
#pragma unroll
        for (int j = 0; j < 4; ++j) {
          const float bi = gl[(d * 64 + i) * 33 + c4 + j], bm = gl[(d * 64 + 31) * 33 + c4 + j];
          qo[j] = qraw[pos * 33 + c4 + j] * __expf(bi - bm); ko[j] = kraw[pos * 33 + c4 + j] * __expf(bm - bi);
        }
        *(u32x2*)(Qp + (d * 64 + i) * 80 + c4 * 2) = u32x2{cvtpk(qo[0], qo[1]), cvtpk(qo[2], qo[3])};
        *(u32x2*)(Kp + (d * 64 + i) * 80 + c4 * 2) = u32x2{cvtpk(ko[0], ko[1]), cvtpk(ko[2], ko[3])};
      }
      const int chain = sdir * 8 + b * 4 + h;
      const int n = sdir == 0 ? pc : (pc < 4 ? 3 - pc : 4 + 255 - (pc - 4)), g = n / GLG;
      if (g != g_cached || bh != bh_cached) {
#pragma unroll
        for (int j = 0; j < 8; ++j) G[j] = 0.f;
        const float* at = p.gst() + (size_t)chain * NGRP * 2048 + sk * 64 + sv0;
        const float* dt = p.gst() + (size_t)16 * NGRP * 2048 + (size_t)chain * NGRP * 32 + sk;
        for (int gg = 0; gg < g; ++gg) {
          const float4 a0 = *(const float4*)(at + (size_t)gg * 2048), a1 = *(const float4*)(at + (size_t)gg * 2048 + 4); const float dd = dt[gg * 32];
          G[0] = G[0] * dd + a0.x; G[1] = G[1] * dd + a0.y; G[2] = G[2] * dd + a0.z; G[3] = G[3] * dd + a0.w;
          G[4] = G[4] * dd + a1.x; G[5] = G[5] * dd + a1.y; G[6] = G[6] * dd + a1.z; G[7] = G[7] * dd + a1.w;
        }
        g_cached = g; bh_cached = bh;
      }
      const float4 l0 = pl0, l1 = pl1; const float dp = pdp;
      const float em = __expf(gl[(sdir * 64 + 31) * 33 + sk]);
      const float sv[8] = {l0.x + dp * G[0], l0.y + dp * G[1], l0.z + dp * G[2], l0.w + dp * G[3], l1.x + dp * G[4], l1.y + dp * G[5], l1.z + dp * G[6], l1.w + dp * G[7]};
      if (qi + 1 < q_end) { GC_ITEM(qi + 1, bhn, pcn, bn, hn, t0n); (void)bhn; (void)t0n; GC_LOADST(pcn, bn, hn); }
#pragma unroll
      for (int j = 0; j < 8; ++j) *(u16*)(ST + (sdir * 64 + sv0 + j) * 80 + sk * 2) = f2bf(sv[j] * em);
    }
    __syncthreads();
    {
      const int d = wid >> 2, ib = (wid >> 1) & 1, vb = wid & 1;
      const char* Qd = Qp + d * 64 * 80; const char* Kd = Kp + d * 64 * 80; const char* Vd = VT + d * 64 * 144; const char* Sd = ST + d * 64 * 80;
      bf16x8 qf[2];
#pragma unroll
      for (int s2 = 0; s2 < 2; ++s2) qf[s2] = *(const bf16x8*)(Qd + (ib * 32 + r32) * 80 + (16 * s2 + 8 * hi) * 2);
#pragma unroll
      for (int jb = 0; jb < 2; ++jb) {
        if (jb <= ib) {
          f32x16 x = {};
#pragma unroll
          for (int s2 = 0; s2 < 2; ++s2) {
            const bf16x8 kf = *(const bf16x8*)(Kd + (jb * 32 + r32) * 80 + (16 * s2 + 8 * hi) * 2);
            x = __builtin_amdgcn_mfma_f32_32x32x16_bf16(qf[s2], kf, x, 0, 0, 0);
          }
#pragma unroll
          for (int r = 0; r < 16; ++r) {
            const int il = crow(r, hi), i = ib * 32 + il, j = jb * 32 + r32;
            *(u16*)(Ax + il * 144 + j * 2) = f2bf(j <= i ? x[r] : 0.f);
          }
        }
      }
      asm volatile("s_waitcnt lgkmcnt(0)" ::: "memory");
      f32x16 o = {};
#pragma unroll
      for (int s4 = 0; s4 < 4; ++s4) {
        if (s4 < 2 * (ib + 1)) {
          const bf16x8 af = *(const bf16x8*)(Ax + r32 * 144 + (16 * s4 + 8 * hi) * 2);
          const bf16x8 vf = *(const bf16x8*)(Vd + (vb * 32 + r32) * 144 + (16 * s4 + 8 * hi) * 2);
          o = __builtin_amdgcn_mfma_f32_32x32x16_bf16(af, vf, o, 0, 0, 0);
        }
      }
#pragma unroll
      for (int s2 = 0; s2 < 2; ++s2) {
        const bf16x8 sf = *(const bf16x8*)(Sd + (vb * 32 + r32) * 80 + (16 * s2 + 8 * hi) * 2);
        o = __builtin_amdgcn_mfma_f32_32x32x16_bf16(qf[s2], sf, o, 0, 0, 0);
      }
#pragma unroll
      for (int r = 0; r < 16; ++r) {
        const int i = ib * 32 + crow(r, hi), pos = d ? 63 - i : i;
        Of[(d * 64 + pos) * 65 + vb * 32 + r32] = o[r];
      }
    }
    __syncthreads();
    {
      const int pos = tid >> 3, v0 = (tid & 7) * 8;
      float r8[8]; float ss = 0.f;
#pragma unroll
      for (int j = 0; j < 8; ++j) { r8[j] = Of[pos * 65 + v0 + j] + Of[(64 + pos) * 65 + v0 + j]; ss += r8[j] * r8[j]; }
      ss += shx<4>(ss); ss += shx<2>(ss); ss += shx<1>(ss);
      const float rs = rsqrtf(ss * (1.f / 64.f) + EPS);
      const u16* og = p.zg() + (size_t)(tok0 + pos) * ZG_W + ZG_OG + h * 64 + v0;
      const float4 g0 = ld4bf(og), g1 = ld4bf(og + 4);
      *(u32x4*)(p.ymix() + (size_t)(tok0 + pos) * DM + 512 + h * 64 + v0) =
          u32x4{cvtpk(r8[0] * rs * silu_f(g0.x), r8[1] * rs * silu_f(g0.y)), cvtpk(r8[2] * rs * silu_f(g0.z), r8[3] * rs * silu_f(g0.w)),
                cvtpk(r8[4] * rs * silu_f(g1.x), r8[5] * rs * silu_f(g1.y)), cvtpk(r8[6] * rs * silu_f(g1.z), r8[7] * rs * silu_f(g1.w))};
    }
    __syncthreads();
  }
}

__device__ __forceinline__ void phase_mix(const Params& p, int layer, int bid, int nb, char* lds) {
  float* part = (float*)lds;
  u16* tile = (u16*)(lds + 4096);
  const int tid = ltid(), wid = tid >> 6, lane = tid & 63;
  const int ntok = layer == 0 ? TT : TL;
  for (int it = bid; it < ntok / 64; it += nb) {
    const int tok0 = it * 64;
    float vh[32], vf[32]; float sh = 0, sf = 0;
#pragma unroll
    for (int c = 0; c < 32; ++c) {
      vh[c] = bf2f(p.hyo()[(size_t)(wid * 32 + c) * TT + tok0 + lane]); vf[c] = bf2f(p.fno()[(size_t)(wid * 32 + c) * TT + tok0 + lane]);
      sh += vh[c] * vh[c]; sf += vf[c] * vf[c];
    }
    part[(0 * 8 + wid) * 64 + lane] = sh; part[(1 * 8 + wid) * 64 + lane] = sf;
    __syncthreads();
    float th = 0, tf = 0;
#pragma unroll
    for (int q = 0; q < 8; ++q) { th += part[(0 * 8 + q) * 64 + lane]; tf += part[(1 * 8 + q) * 64 + lane]; }
    const float rh = rsqrtf(th * (1.f / 256.f) + EPS), rf = rsqrtf(tf * (1.f / 256.f) + EPS);
#pragma unroll
    for (int c = 0; c < 32; ++c) { tile[lane * 520 + wid * 32 + c] = f2bf(vh[c] * rh); tile[lane * 520 + 256 + wid * 32 + c] = f2bf(vf[c] * rf); }
    __syncthreads();
    for (int g = tid; g < 64 * 64; g += NTHR) {
      const int tl = g >> 6, cg = g & 63;
      const u32x4 w = *(const u32x4*)(tile + tl * 520 + cg * 8);
      *(u32x4*)(p.ymix() + (size_t)(tok0 + tl) * DM + (cg < 32 ? 256 + cg * 8 : 768 + (cg - 32) * 8)) = w;
    }
    __syncthreads();
  }
}

struct EpiOut {
  const Params* pp; int layer;
  __device__ __forceinline__ void pre(const G8Unit& u, int, int, float (&)[8], float* cb) const {
    if ((ltid() >> 6) == 0) g8_cload(pp->mod() + ((size_t)layer * 3 + modv(u.pm * 256)) * 6144 + 2 * DM + u.pn * 256, cb);
  }
  __device__ __forceinline__ void operator()(const f32x4 (&acc)[2][2][4][2], const G8Unit& u, int wr, int wc, int fr, int fq, const float (&)[8], const float* cb) const {
    const Params& p = *pp;
#pragma unroll
    for (int bj = 0; bj < 2; ++bj) {
      const int c0 = u.pn * 256 + bj * 128 + wc * 32 + 8 * fq;
      const f32x4 ga = *(const f32x4*)(cb + bj * 128 + wc * 32 + 8 * fq), gb = *(const f32x4*)(cb + bj * 128 + wc * 32 + 8 * fq + 4);
#pragma unroll
      for (int ai = 0; ai < 2; ++ai)
#pragma unroll
        for (int m = 0; m < 4; ++m) {
          const int tok = u.pm * 256 + ai * 128 + wr * 64 + m * 16 + fr;
          u16* xo = p.X() + (size_t)tok * DM + c0;
          f32x4 xa, xb;
          if (layer == 0) { const float* xr = resid_row_in(p, tok) + c0; xa = *(const f32x4*)xr; xb = *(const f32x4*)(xr + 4); }
          else { const u32x4 w = *(const u32x4*)xo;
            xa = f32x4{__uint_as_float(w[0] << 16), __uint_as_float(w[0] & 0xFFFF0000u), __uint_as_float(w[1] << 16), __uint_as_float(w[1] & 0xFFFF0000u)};
            xb = f32x4{__uint_as_float(w[2] << 16), __uint_as_float(w[2] & 0xFFFF0000u), __uint_as_float(w[3] << 16), __uint_as_float(w[3] & 0xFFFF0000u)}; }
          xa = xa + ga * acc[ai][bj][m][0]; xb = xb + gb * acc[ai][bj][m][1];
          *(u32x4*)xo = u32x4{cvtpk(xa[0], xa[1]), cvtpk(xa[2], xa[3]), cvtpk(xb[0], xb[1]), cvtpk(xb[2], xb[3])};
        }
    }
  }
};
__device__ __forceinline__ void phase_gemm_out(const Params& p, int layer, int bid, int nb, char* lds) {
  G8Plain S; S.nM = (layer == 0 ? TT : TL) / 256; S.nN = DM / 256; S.Kb = 2 * DM; S.G = nb; S.c = bid; S.Bt = (const char*)(p.bt_out() + (size_t)layer * DM * DM);
  EpiOut E; E.pp = &p; E.layer = layer;
  gemm8_phase<false>(lds, (const char*)p.ymix(), 2 * DM, S, E);
}

__device__ __forceinline__ void phase_norm2_router(const Params& p, int layer, int bid, int nb, char* lds) {
  float* rwl = (float*)lds;
  int* lcnt = (int*)(lds + 131072);
  int* lbase = lcnt + 32;
  int* ent = lbase + 32;
  float* entw = (float*)(ent + 2 * 640);
  float* ents = entw + 640;
  const int tid = ltid(), wid = tid >> 6, lane = tid & 63;
  const int ntok = layer == 0 ? TT : TL;
  const float* rw = p.router_w() + (size_t)layer * DM * NE;
  for (int i = tid; i < DM * NE / 4; i += NTHR) {
    const int k = i >> 3, q4 = i & 7;
    ((float4*)rwl)[q4 * 1024 + ((k & 3) * 256 + (k >> 2))] = ((const float4*)rw)[i];
  }
  if (tid < 32) lcnt[tid] = 0;
  __syncthreads();
  const float* gn = p.norm2_g() + layer * DM; const float* rb = p.router_b() + layer * NE;
  const int per = (ntok + nb - 1) / nb, t_beg = bid * per, t_end = min(ntok, t_beg + per);
  for (int tok = t_beg + wid; tok < t_end; tok += 8) {
    const u16* xr = p.X() + (size_t)tok * DM;
    float v[16];
#pragma unroll
    for (int i = 0; i < 4; ++i) { const float4 a = ld4bf(xr + lane * 4 + i * 256); v[4 * i] = a.x; v[4 * i + 1] = a.y; v[4 * i + 2] = a.z; v[4 * i + 3] = a.w; }
    float ss = 0;
#pragma unroll
    for (int i = 0; i < 16; ++i) ss += v[i] * v[i];
    ss = wave_sum(ss);
    const float rs = rsqrtf(ss * (1.f / DM) + EPS);
    const float* md = p.mod() + ((size_t)layer * 3 + modv(tok)) * 6144 + 3 * DM;
#pragma unroll
    for (int i = 0; i < 4; ++i) {
      const int c = lane * 4 + i * 256;
      const float4 g = *(const float4*)(gn + c), sh = *(const float4*)(md + c), sc = *(const float4*)(md + DM + c);
      v[4 * i] = v[4 * i] * rs * g.x * (1.f + sc.x) + sh.x; v[4 * i + 1] = v[4 * i + 1] * rs * g.y * (1.f + sc.y) + sh.y;
      v[4 * i + 2] = v[4 * i + 2] * rs * g.z * (1.f + sc.z) + sh.z; v[4 * i + 3] = v[4 * i + 3] * rs * g.w * (1.f + sc.w) + sh.w;
    }
    const float rowsc = store_row_i8(v, p.H() + (size_t)tok * DM, p.hs() + tok, lane);
    float lg[32];
#pragma unroll
    for (int e = 0; e < 32; ++e) lg[e] = 0.f;
#pragma unroll
    for (int i = 0; i < 16; ++i) {
      const float4* wr4 = (const float4*)rwl + ((i & 3) * 256 + (i >> 2) * 64 + lane);
#pragma unroll
      for (int q = 0; q < 8; ++q) { const float4 w = wr4[q * 1024]; lg[4 * q] += v[i] * w.x; lg[4 * q + 1] += v[i] * w.y; lg[4 * q + 2] += v[i] * w.z; lg[4 * q + 3] += v[i] * w.w; }
    }
    float r16[16], r8[8], r4[4], r2[2], lv;
    { const bool up = lane & 32;
#pragma unroll
      for (int e = 0; e < 16; ++e) { const float keep = up ? lg[16 + e] : lg[e], send = up ? lg[e] : lg[16 + e]; r16[e] = keep + shx<32>(send); } }
    { const bool up = lane & 16;
#pragma unroll
      for (int e = 0; e < 8; ++e) { const float keep = up ? r16[8 + e] : r16[e], send = up ? r16[e] : r16[8 + e]; r8[e] = keep + shx<16>(send); } }
    { const bool up = lane & 8;
#pragma unroll
      for (int e = 0; e < 4; ++e) { const float keep = up ? r8[4 + e] : r8[e], send = up ? r8[e] : r8[4 + e]; r4[e] = keep + shx<8>(send); } }
    { const bool up = lane & 4;
#pragma unroll
      for (int e = 0; e < 2; ++e) { const float keep = up ? r4[2 + e] : r4[e], send = up ? r4[e] : r4[2 + e]; r2[e] = keep + shx<4>(send); } }
    { const bool up = lane & 2; const float keep = up ? r2[1] : r2[0], send = up ? r2[0] : r2[1]; lv = keep + shx<2>(send); }
    lv += shx<1>(lv);
    lv += rb[lane >> 1];
    int ids[4]; float vals[4];
#pragma unroll
    for (int k = 0; k < 4; ++k) {
      const float mx = wave_max(lv);
      const unsigned long long bal = __ballot(lv == mx);
      const int win = __ffsll((long long)bal) - 1;
      ids[k] = win >> 1; vals[k] = mx;
      if ((lane >> 1) == ids[k]) lv = -3.4e38f;
    }
    if (lane == 0) {
      const float mx = vals[0];
      float ex[4], sum = 0;
#pragma unroll
      for (int k = 0; k < 4; ++k) { ex[k] = __expf(vals[k] - mx); sum += ex[k]; }
      const float inv = 1.f / sum;
#pragma unroll
      for (int k = 0; k < 4; ++k) {
        const int lp = atomicAdd(&lcnt[ids[k]], 1);
        const int slot = (tok - t_beg) * 4 + k;
        ent[2 * slot] = tok * 4 + k; ent[2 * slot + 1] = (ids[k] << 20) | lp; entw[slot] = ex[k] * inv; ents[slot] = rowsc;
      }
    }
  }
  __syncthreads();
  if (tid < 32) lbase[tid] = atomicAdd(&p.cnt()[layer * NE + tid], lcnt[tid]);
  __syncthreads();
  const int nas = (t_end > t_beg ? (t_end - t_beg) : 0) * 4;
  for (int s = tid; s < nas; s += NTHR) {
    const int tk = ent[2 * s], el = ent[2 * s + 1], e = el >> 20, pos = lbase[e] + (el & 0xFFFFF);
    p.rtok()[(size_t)e * TT + pos] = tk >> 2; p.rw()[(size_t)e * TT + pos] = entw[s]; p.rsc()[(size_t)e * TT + pos] = ents[s];
    p.tslot()[tk] = (e << 20) | pos;
  }
}

struct G8Moe {
  const int* cnt;
  int ntn, Kb, G, c; const char* Bt; size_t bstride;
  const int* rtok;
  __device__ __forceinline__ bool next(int i, G8Unit& u, const G8Unit& from) const {
    const int w = (i * 8 + (c & 7)) * (G >> 3) + (c >> 3);
    int acc = from.ab, rows = from.pre;
    for (int ee = from.e; ee < NE; ++ee) {
      const int cc = cnt[ee], tiles = ((cc + 255) >> 8) * ntn;
      if (w < acc + tiles) { const int r = w - acc; u.e = ee; u.pm = r / ntn; u.pn = r % ntn; u.ce = cc; u.pre = rows; u.ab = acc; return true; }
      acc += tiles; rows += cc;
    }
    return false;
  }
  __device__ __forceinline__ unsigned a_off(const G8Unit& u, int row) const {
    const int r = min(u.pm * 256 + row, u.ce - 1);
    const int arow = rtok ? rtok[(size_t)u.e * TT + r] : u.pre + r;
    return (unsigned)arow * (unsigned)Kb;
  }
  __device__ __forceinline__ const char* b_ptr(const G8Unit& u) const { return Bt + (size_t)u.e * bstride + (size_t)u.pn * 256 * Kb; }
};
struct EpiGu {
  const float* bgl; u16* act; const float* rsc; const float* swl;
  __device__ __forceinline__ void pre(const G8Unit& u, int wr, int fr, float (&ep)[8], float* cb) const {
    if ((ltid() >> 6) == 0) g8_cload(bgl + (size_t)u.e * 2048 + u.pn * 256, cb);
    if ((ltid() >> 6) == 1) g8_cload(swl + (size_t)u.e * 2048 + u.pn * 256, cb + 256);
#pragma unroll
    for (int ai = 0; ai < 2; ++ai)
#pragma unroll
      for (int m = 0; m < 4; ++m) ep[ai * 4 + m] = rsc[(size_t)u.e * TT + min(u.pm * 256 + ai * 128 + wr * 64 + m * 16 + fr, u.ce - 1)];
  }
  __device__ __forceinline__ void operator()(const i32x4 (&acc)[2][2][4][2], const G8Unit& u, int wr, int wc, int fr, int fq, const float (&ep)[8], const float* cb) const {
    const int j0 = u.pn * 128 + wc * 32 + 8 * fq;
    typedef float f2v __attribute__((ext_vector_type(2)));
    const float* bg = cb + 2 * (wc * 32 + 8 * fq);
    f2v bgt[4], bup[4], sg[4], su[4];
#pragma unroll
    for (int q = 0; q < 4; ++q) { const f32x4 t = *(const f32x4*)(bg + 4 * q); bgt[q] = f2v{t[0], t[2]}; bup[q] = f2v{t[1], t[3]}; asm volatile("" : "+v"(bgt[q]), "+v"(bup[q])); }
    {
      const float* sp = cb + 256 + wc * 32 + 8 * fq;
      const f32x4 g0 = *(const f32x4*)sp, g1 = *(const f32x4*)(sp + 4), u0 = *(const f32x4*)(sp + 128), u1 = *(const f32x4*)(sp + 132);
      sg[0] = f2v{g0[0], g0[1]}; sg[1] = f2v{g0[2], g0[3]}; sg[2] = f2v{g1[0], g1[1]}; sg[3] = f2v{g1[2], g1[3]};
      su[0] = f2v{u0[0], u0[1]}; su[1] = f2v{u0[2], u0[3]}; su[2] = f2v{u1[0], u1[1]}; su[3] = f2v{u1[2], u1[3]};
    }
    const f2v kexp = f2v{-1.702f * 1.4426950408889634f, -1.702f * 1.4426950408889634f}, one2 = f2v{1.f, 1.f};
#pragma unroll
    for (int ai = 0; ai < 2; ++ai)
#pragma unroll
      for (int m = 0; m < 4; ++m) {
        const int r = u.pm * 256 + ai * 128 + wr * 64 + m * 16 + fr;
        if (r < u.ce) {
          const float sa = ep[ai * 4 + m]; const f2v sa2 = f2v{sa, sa};
          unsigned ow[4];
#pragma unroll
          for (int n = 0; n < 2; ++n)
#pragma unroll
            for (int jp = 0; jp < 2; ++jp) {
              const int q = 2 * n + jp;
              f2v g = f2v{(float)acc[ai][0][m][n][2 * jp], (float)acc[ai][0][m][n][2 * jp + 1]};
              f2v v = f2v{(float)acc[ai][1][m][n][2 * jp], (float)acc[ai][1][m][n][2 * jp + 1]};
              g = (g * sa2) * sg[q] + bgt[q];
              v = (v * sa2) * su[q] + bup[q];
              g = f2v{fminf(g[0], 7.f), fminf(g[1], 7.f)};
              v = f2v{__builtin_amdgcn_fmed3f(v[0], -7.f, 7.f), __builtin_amdgcn_fmed3f(v[1], -7.f, 7.f)};
              const f2v t = g * kexp;
              const f2v d = f2v{__builtin_amdgcn_exp2f(t[0]), __builtin_amdgcn_exp2f(t[1])} + one2;
              const f2v rr = f2v{__builtin_amdgcn_rcpf(d[0]), __builtin_amdgcn_rcpf(d[1])};
              const f2v o = (v * g + g) * rr;
              ow[q] = cvtpk(o[0], o[1]);
            }
          *(u32x4*)(act + (size_t)(u.pre + r) * DFF + j0) = u32x4{ow[0], ow[1], ow[2], ow[3]};
        }
      }
  }
};
struct EpiDn {
  const float* bdl; const float* rw; unsigned char* yd;
  __device__ __forceinline__ void pre(const G8Unit& u, int wr, int fr, float (&ep)[8], float* cb) const {
    if ((ltid() >> 6) == 0) g8_cload(bdl + (size_t)u.e * DM + u.pn * 256, cb);
#pragma unroll
    for (int ai = 0; ai < 2; ++ai)
#pragma unroll
      for (int m = 0; m < 4; ++m) ep[ai * 4 + m] = rw[(size_t)u.e * TT + min(u.pm * 256 + ai * 128 + wr * 64 + m * 16 + fr, u.ce - 1)];
  }
  __device__ __forceinline__ void operator()(const f32x4 (&acc)[2][2][4][2], const G8Unit& u, int wr, int wc, int fr, int fq, const float (&ep)[8], const float* cb) const {
#pragma unroll
    for (int bj = 0; bj < 2; ++bj) {
      const int c0 = u.pn * 256 + bj * 128 + wc * 32 + 8 * fq;
      const f32x4 ba = *(const f32x4*)(cb + bj * 128 + wc * 32 + 8 * fq), bb = *(const f32x4*)(cb + bj * 128 + wc * 32 + 8 * fq + 4);
#pragma unroll
      for (int ai = 0; ai < 2; ++ai)
#pragma unroll
        for (int m = 0; m < 4; ++m) {
          const int r = u.pm * 256 + ai * 128 + wr * 64 + m * 16 + fr;
          if (r < u.ce) {
            const float wgt = ep[ai * 4 + m];
            const float w8 = wgt * 8.f;
            f32x4 a = (acc[ai][bj][m][0] + ba) * w8, b = (acc[ai][bj][m][1] + bb) * w8;
#pragma unroll
            for (int j = 0; j < 4; ++j) { a[j] = fminf(fmaxf(a[j], -440.f), 440.f); b[j] = fminf(fmaxf(b[j], -440.f), 440.f); }
            int w0 = 0, w1 = 0;
            w0 = __builtin_amdgcn_cvt_pk_fp8_f32(a[0], a[1], w0, false); w0 = __builtin_amdgcn_cvt_pk_fp8_f32(a[2], a[3], w0, true);
            w1 = __builtin_amdgcn_cvt_pk_fp8_f32(b[0], b[1], w1, false); w1 = __builtin_amdgcn_cvt_pk_fp8_f32(b[2], b[3], w1, true);
            *(u32x2*)(yd + (size_t)(u.pre + r) * DM + c0) = u32x2{(unsigned)w0, (unsigned)w1};
          }
        }
    }
  }
};
__device__ __forceinline__ void phase_moe_gu(const Params& p, int layer, int bid, int nb, char* lds) {
  int* scnt = (int*)(lds + 131072);
  if (ltid() < NE) scnt[ltid()] = p.cnt()[layer * NE + ltid()];
  __syncthreads();
  G8Moe S; S.cnt = scnt; S.ntn = 8; S.Kb = DM; S.G = nb; S.c = bid; S.Bt = (const char*)(p.bt_gu() + (size_t)layer * NE * 2048 * DM); S.bstride = (size_t)2048 * DM; S.rtok = p.rtok();
  EpiGu E; E.bgl = p.moe_b_gu() + (size_t)layer * NE * 2048; E.act = p.act(); E.rsc = p.rsc(); E.swl = p.swgu() + (size_t)layer * NE * 2048;
  gemm8_phase<true>(lds, (const char*)p.H(), DM, S, E);
}
__device__ __forceinline__ void phase_moe_dn(const Params& p, int layer, int bid, int nb, char* lds) {
  int* scnt = (int*)(lds + 131072);
  if (ltid() < NE) scnt[ltid()] = p.cnt()[layer * NE + ltid()];
  __syncthreads();
  G8Moe S; S.cnt = scnt; S.ntn = 4; S.Kb = 2 * DFF; S.G = nb; S.c = bid; S.Bt = (const char*)(p.bt_dn() + (size_t)layer * NE * DM * DFF); S.bstride = (size_t)DM * DFF * 2; S.rtok = nullptr;
  EpiDn E; E.bdl = p.moe_b_down() + (size_t)layer * NE * DM; E.rw = p.rw(); E.yd = p.yd();
  gemm8_phase<false>(lds, (const char*)p.act(), 2 * DFF, S, E);
}

__device__ __forceinline__ void phase_final(const Params& p, int bid, int nb, char* lds) {
  int* pre = (int*)lds;
  expert_prefix(p.cnt() + NE, pre); __syncthreads();
  const int wid = ltid() >> 6, lane = ltid() & 63;
  for (int tok = bid * 8 + wid; tok < TL; tok += nb * 8) {
    float v[16];
    load_row_comb(p, 1, 1, tok, lane, pre, v);
    float ss = 0;
#pragma unroll
    for (int i = 0; i < 16; ++i) ss += v[i] * v[i];
    ss = wave_sum(ss);
    const float rs = rsqrtf(ss * (1.f / DM) + EPS);
    float* o = p.out() + (size_t)tok * DM;
#pragma unroll
    for (int i = 0; i < 4; ++i) {
      const int c = lane * 4 + i * 256;
      const float4 g = *(const float4*)(p.final_g() + c);
      *(float4*)(o + c) = make_float4(v[4 * i] * rs * g.x, v[4 * i + 1] * rs * g.y, v[4 * i + 2] * rs * g.z, v[4 * i + 3] * rs * g.w);
    }
  }
}

#define XB_TMO      128
#define XB_XCNT(j)  (256  + 64 * (j))
#define XB_XSUB(j)  (1280 + 64 * (j))
#define XB_XGEN(j)  (2304 + 64 * (j))
#define XB_TOP      3328
#define XB_TOPGEN   3392
#define XCD_BAR_WORDS 3456
#define XB_SPIN_CAP (1u << 18)
#define LAS __attribute__((address_space(3)))

__device__ __forceinline__ unsigned xb_ld(unsigned* p)              { return __hip_atomic_load(p, __ATOMIC_RELAXED, __HIP_MEMORY_SCOPE_AGENT); }
__device__ __forceinline__ unsigned xb_add(unsigned* p, unsigned v) { return __hip_atomic_fetch_add(p, v, __ATOMIC_RELAXED, __HIP_MEMORY_SCOPE_AGENT); }
__device__ __forceinline__ unsigned xb_xcc_id() { return (unsigned)__builtin_amdgcn_s_getreg((3 << 11) | 20) & 0xFu; }
#define XB_SPIN(cond, bar) do { unsigned _sp = 0; while (cond) { __builtin_amdgcn_s_sleep(1); \
    if ((++_sp & 255u) == 0u) { if (xb_ld(&(bar)[XB_TMO])) break; if (_sp > XB_SPIN_CAP) { atomicAdd(&(bar)[XB_TMO], 1u); break; } } } } while (0)

struct XcdBarrier {
    unsigned* bar; unsigned x;
    volatile LAS unsigned* st;
};

__device__ __forceinline__ XcdBarrier xcd_barrier_post(unsigned* bar, volatile LAS unsigned* st) {
    XcdBarrier b; b.bar = bar; b.x = xb_xcc_id(); b.st = st;
    if (threadIdx.x == 0) (void)xb_add(&bar[XB_XCNT(b.x)], 1u);
    return b;
}
__device__ __forceinline__ void xcd_barrier_complete(unsigned* bar, unsigned x, unsigned& nloc, unsigned& nx) {
    const unsigned G = gridDim.x * gridDim.y * gridDim.z;
    unsigned sum, cnt, mine, sp = 0u;
    for (;;) {
        sum = 0u; cnt = 0u; mine = 0u;
#pragma unroll
        for (unsigned j = 0; j < 16; ++j) { const unsigned c = xb_ld(&bar[XB_XCNT(j)]); sum += c; cnt += (c > 0u) ? 1u : 0u; mine = (j == x) ? c : mine; }
        if (sum == G) break;
        __builtin_amdgcn_s_sleep(1);
        if ((++sp & 255u) == 0u) { if (xb_ld(&bar[XB_TMO])) break; if (sp > XB_SPIN_CAP) { atomicAdd(&bar[XB_TMO], 1u); break; } }
    }
    nloc = mine > 0u ? mine : 1u; nx = cnt > 0u ? cnt : 1u;
}

__device__ __forceinline__ void xcd_barrier(const XcdBarrier& b) {
    asm volatile("s_waitcnt vmcnt(0)" ::: "memory");
    __syncthreads();
    if (threadIdx.x == 0) {
        unsigned* bar = b.bar;
        __builtin_amdgcn_s_waitcnt(0);
        unsigned nloc = b.st[0], nx = b.st[1];
        if (nloc == 0u) { xcd_barrier_complete(bar, b.x, nloc, nx); b.st[0] = nloc; b.st[1] = nx; }
        const unsigned old = xb_add(&bar[XB_XSUB(b.x)], 1u);
        const unsigned gen = old / nloc;
        if (old + 1u == (gen + 1u) * nloc) {
            __builtin_amdgcn_fence(__ATOMIC_RELEASE, "agent");
            asm volatile("s_waitcnt vmcnt(0)" ::: "memory");
            const unsigned og = xb_add(&bar[XB_TOP], 1u);
            const unsigned tg = og / nx;
            if (og + 1u == (tg + 1u) * nx) xb_add(&bar[XB_TOPGEN], 1u);
            else XB_SPIN(xb_ld(&bar[XB_TOPGEN]) == tg, bar);
            __builtin_amdgcn_fence(__ATOMIC_ACQUIRE, "agent");
            xb_add(&bar[XB_XGEN(b.x)], 1u);
            asm volatile("s_waitcnt vmcnt(0)" ::: "memory");
        } else {
            XB_SPIN(xb_ld(&bar[XB_XGEN(b.x)]) == gen, bar);
            __builtin_amdgcn_fence(__ATOMIC_ACQUIRE, "agent");
            asm volatile("s_waitcnt vmcnt(0)" ::: "memory");
        }
    }
    __syncthreads();
}


constexpr int LDS_MAIN = 147456;
constexpr int LDS_BYTES = LDS_MAIN + 1024;
enum { PH_TABLES = 0, PH_MOD, PH_FOLD, PH_CONVERT, PH_HYMLP, PH_HYFILT, PH_NORM1, PH_GEMM_IN, PH_QKV, PH_ATTN, PH_FFTMIX,
       PH_GLA_A, PH_GLA_B, PH_GLA_C, PH_MIX, PH_GEMM_OUT, PH_NORM2, PH_MOE_GU, PH_MOE_DN, PH_FINAL };

__device__ __forceinline__ Params make_params() {
  const __attribute__((address_space(4))) char* kb = (const __attribute__((address_space(4))) char*)__builtin_amdgcn_kernarg_segment_ptr();
  asm volatile("" : "+s"(kb));
  Params p; p.kb = kb; return p;
}
#ifndef MK_LAUNCHES
#define MK_LAUNCHES 1
#endif
__global__ void __launch_bounds__(NTHR, 2) k_mega(ParamsData pd) {
  extern __shared__ __attribute__((aligned(1024))) char lds[];
  const int bid = blockIdx.x, nb = gridDim.x;
  if (threadIdx.x == 0) *(uint4*)(lds + LDS_MAIN) = make_uint4(0u, 0u, 0u, 0u);
  __syncthreads();
  XcdBarrier bar = xcd_barrier_post(make_params().bar(), (volatile LAS unsigned*)(lds + LDS_MAIN));
#ifndef DBLMASK
#define DBLMASK 0u
#endif
#define RUNPH(bit, call) do { call; if (DBLMASK & (1u << (bit))) { __syncthreads(); call; } } while (0)
  RUNPH(13, phase_tables(make_params(), bid, nb); phase_mod(make_params(), bid, nb, lds); phase_fold(make_params(), bid, nb, lds));
  RUNPH(0, phase_convert(make_params(), bid, nb, lds));
  phase_hy_mlp(make_params(), 0, SEQ, make_params().hfb(), make_params().hpart(), bid, nb, lds);
  phase_hy_mlp(make_params(), 1, SEQ, make_params().hfb() + (size_t)2 * 256 * SEQ, make_params().hpart() + 256 * 512, bid, nb, lds);
  phase_hy_mlp(make_params(), 0, LC, make_params().hfc(), make_params().hpart() + 2 * 256 * 512, bid, nb, lds);
  xcd_barrier(bar);
  RUNPH(2, phase_hy_filtfft(make_params(), bid, nb, lds));
  phase_quant_in(make_params(), bid, nb);
#define MK_LAYER(l) do { \
  phase_norm1(make_params(), l, bid, nb, lds); if ((DBLMASK & (1u << 14)) && l == 0) { __syncthreads(); phase_norm1(make_params(), l, bid, nb, lds); } \
  xcd_barrier(bar); \
  RUNPH(3, phase_gemm_in(make_params(), l, bid, nb, lds)); \
  xcd_barrier(bar); \
  RUNPH(4, phase_qkv(make_params(), l, bid, nb, lds)); \
  RUNPH(5, phase_gla_a(make_params(), l, bid, nb, lds)); \
  RUNPH(7, phase_fftmix(make_params(), l, bid, nb, lds)); \
  xcd_barrier(bar); \
  RUNPH(6, phase_attn(make_params(), l, bid, nb, lds)); \
  RUNPH(9, phase_gla_c(make_params(), l, bid, nb, lds)); \
  RUNPH(10, phase_mix(make_params(), l, bid, nb, lds)); \
  xcd_barrier(bar); \
  phase_gemm_out(make_params(), l, bid, nb, lds); if ((DBLMASK & (1u << 16)) && l == 0) { __syncthreads(); phase_gemm_out(make_params(), l, bid, nb, lds); } \
  xcd_barrier(bar); \
  phase_norm2_router(make_params(), l, bid, nb, lds); \
  xcd_barrier(bar); \
  RUNPH(11, phase_moe_gu(make_params(), l, bid, nb, lds)); \
  xcd_barrier(bar); \
  RUNPH(12, phase_moe_dn(make_params(), l, bid, nb, lds)); \
  xcd_barrier(bar); \
  } while (0)
  MK_LAYER(0);
  MK_LAYER(1);
#undef MK_LAYER
  RUNPH(15, phase_final(make_params(), bid, nb, lds));
}
static size_t carve(char*& cur, size_t bytes) { char* r = cur; cur += (bytes + 1023) & ~(size_t)1023; return (size_t)(uintptr_t)r; }
#define CARVE(T, field, n) p.field = (T*)carve(cur, (size_t)(n) * sizeof(T))

extern "C" void kernel_launch(void* const* d_in, const int* in_sizes, int n_in, void* d_out, int out_size, void* d_ws, size_t ws_size, hipStream_t stream) {
  ParamsData p; memset(&p, 0, sizeof(p));
  const float** ins = (const float**)&p;
  for (int i = 0; i < 34; ++i) ins[i] = (const float*)d_in[i];
  p.out_ = (float*)d_out;
  p.ws_ = (char*)d_ws;
  if (WS_TOTAL > ws_size) { fprintf(stderr, "workspace too small: need %zu have %zu\n", (size_t)WS_TOTAL, ws_size); return; }
  hipMemsetAsync((char*)d_ws + OFF_bar, 0, OFF_mod - OFF_bar, stream);
  static int grid = 0;
  if (!grid) {
    int dev = 0, cus = 0, per_cu = 0;
    hipGetDevice(&dev);
    hipDeviceGetAttribute(&cus, hipDeviceAttributeMultiprocessorCount, dev);
    hipFuncSetAttribute((const void*)k_mega, hipFuncAttributeMaxDynamicSharedMemorySize, LDS_BYTES);
    hipOccupancyMaxActiveBlocksPerMultiprocessor(&per_cu, (const void*)k_mega, NTHR, LDS_BYTES);
    grid = cus * (per_cu < 1 ? per_cu : 1);
    if (grid != 256) fprintf(stderr, "unexpected grid %d (cus %d per_cu %d)\n", grid, cus, per_cu);
  }
  hipLaunchKernelGGL(k_mega, dim3(grid), dim3(NTHR), LDS_BYTES, stream, p);
}
```

```cpp
#include <hip/hip_runtime.h>
#include <hip/hip_bf16.h>
#include <cstdio>
#include <cstdint>
#include <cstring>
#include <cstddef>
#include <type_traits>

typedef unsigned short u16;
using bf16x8 = __attribute__((ext_vector_type(8))) short;
using s16x4  = __attribute__((ext_vector_type(4))) short;
using f32x4  = __attribute__((ext_vector_type(4))) float;
using f32x16 = __attribute__((ext_vector_type(16))) float;
using u32x4  = __attribute__((ext_vector_type(4))) unsigned;
using u32x2  = __attribute__((ext_vector_type(2))) unsigned;

constexpr int DM = 1024, NB = 2, SEQ = 16384, LC = 256;
constexpr int TL = NB * SEQ;
constexpr int TC = NB * LC;
constexpr int TT = TL + TC;
constexpr int NIN = 2816;
constexpr int DIN0 = 2240;
constexpr int NE = 32, TOPK = 4, DFF = 1024;
constexpr int SKV = SEQ + LC;
constexpr int NTHR = 512;
constexpr float EPS = 1e-6f;
constexpr float A_SCALE = 0.10206207261596575f;
constexpr float A_QSCALE = A_SCALE * 1.4426950408889634f;
constexpr int ZG_W = 1152, ZG_GQ = 0, ZG_GK = 128, ZG_KR = 256, ZG_GV = 384, ZG_GP = 640, ZG_OG = 896;
constexpr int ZT_HY = 0, ZT_FR = 768, ZT_FI = 1024, ZT_R = 1280;
constexpr int NCH = 260;
constexpr int FM = 16384;
constexpr int HSP = FM / 2 + 1;

constexpr size_t ws_al(size_t b) { return (b + 1023) & ~(size_t)1023; }
constexpr size_t OFF_bar = 0;
constexpr size_t OFF_cnt = OFF_bar + ws_al((size_t)(4096) * sizeof(unsigned));
constexpr size_t OFF_hssq = OFF_cnt + ws_al((size_t)(64) * sizeof(int));
constexpr size_t OFF_kmx = OFF_hssq + ws_al((size_t)(768) * sizeof(float));
constexpr size_t OFF_mod = OFF_kmx + ws_al((size_t)(128) * sizeof(unsigned));
constexpr size_t OFF_ropec = OFF_mod + ws_al((size_t)(2 * 3 * 6144) * sizeof(float));
constexpr size_t OFF_ropes = OFF_ropec + ws_al((size_t)(SEQ * 16) * sizeof(float));
constexpr size_t OFF_tw = OFF_ropes + ws_al((size_t)(SEQ * 16) * sizeof(float));
constexpr size_t OFF_bt_in = OFF_tw + ws_al((size_t)(FM) * sizeof(float2));
constexpr size_t OFF_bt_qkv = OFF_bt_in + ws_al((size_t)((size_t)2 * NIN * DM) * sizeof(u16));
constexpr size_t OFF_bt_out = OFF_bt_qkv + ws_al((size_t)(2 * 1024 * 384) * sizeof(u16));
constexpr size_t OFF_bt_gu = OFF_bt_out + ws_al((size_t)((size_t)2 * DM * DM) * sizeof(u16));
constexpr size_t OFF_bt_dn = OFF_bt_gu + ws_al((size_t)((size_t)2 * NE * 2048 * DM) * sizeof(u16));
constexpr size_t OFF_hfb = OFF_bt_dn + ws_al((size_t)((size_t)2 * NE * DM * DFF) * sizeof(u16));
constexpr size_t OFF_hfc = OFF_hfb + ws_al((size_t)((size_t)2 * 2 * 256 * SEQ) * sizeof(float));
constexpr size_t OFF_hspec = OFF_hfc + ws_al((size_t)(2 * 256 * LC) * sizeof(float));
constexpr size_t OFF_H = OFF_hspec + ws_al((size_t)((size_t)2 * 256 * HSP) * sizeof(float4));
constexpr size_t OFF_zqkv = OFF_H + ws_al((size_t)((size_t)TT * DM) * sizeof(u16));
constexpr size_t OFF_zg = OFF_zqkv + ws_al((size_t)((size_t)TT * 384) * sizeof(u16));
constexpr size_t OFF_zt = OFF_zg + ws_al((size_t)((size_t)TT * ZG_W) * sizeof(float));
constexpr size_t OFF_Q = OFF_zt + ws_al((size_t)((size_t)ZT_R * TT) * sizeof(float));
constexpr size_t OFF_KV = OFF_Q + ws_al((size_t)((size_t)2 * 4 * SKV * 96) * sizeof(u16));
constexpr size_t OFF_ymix = OFF_KV + ws_al((size_t)((size_t)2 * 4 * SKV * 160) * sizeof(u16));
constexpr size_t OFF_hyo = OFF_ymix + ws_al((size_t)((size_t)TT * DM) * sizeof(u16));
constexpr size_t OFF_fno = OFF_hyo + ws_al((size_t)((size_t)256 * TT) * sizeof(float));
constexpr size_t OFF_glao = OFF_fno + ws_al((size_t)((size_t)256 * TT) * sizeof(float));
constexpr size_t OFF_gds = OFF_glao + ws_al((size_t)((size_t)TT * 256) * sizeof(float));
constexpr size_t OFF_gdv = OFF_gds + ws_al((size_t)((size_t)16 * NCH * 2048) * sizeof(float));
constexpr size_t OFF_gst = OFF_gdv + ws_al((size_t)((size_t)16 * NCH * 32) * sizeof(float));
constexpr size_t OFF_X = OFF_gst + ws_al((size_t)((size_t)16 * NCH * 2048) * sizeof(float));
constexpr size_t OFF_rtok = OFF_X + ws_al((size_t)((size_t)TT * DM) * sizeof(float));
constexpr size_t OFF_rw = OFF_rtok + ws_al((size_t)((size_t)NE * TT) * sizeof(int));
constexpr size_t OFF_tslot = OFF_rw + ws_al((size_t)((size_t)NE * TT) * sizeof(float));
constexpr size_t OFF_act = OFF_tslot + ws_al((size_t)((size_t)TT * 4) * sizeof(int));
constexpr size_t OFF_yd = OFF_act + ws_al((size_t)((size_t)TT * 4 * DFF) * sizeof(u16));
constexpr size_t OFF_swin = OFF_yd + ws_al((size_t)((size_t)TT * 4 * DM) * sizeof(u16));
constexpr size_t OFF_swgu = OFF_swin + ws_al((size_t)(2 * NIN) * sizeof(float));
constexpr size_t OFF_hs = OFF_swgu + ws_al((size_t)(2 * NE * 2048) * sizeof(float));
constexpr size_t OFF_hpart = OFF_hs + ws_al((size_t)(TT) * sizeof(float));
constexpr size_t OFF_rsc = OFF_hpart + ws_al((size_t)(3 * 256 * 512) * sizeof(float));
constexpr size_t WS_TOTAL = OFF_rsc + ws_al((size_t)((size_t)NE * TT) * sizeof(float));
struct ParamsData {
  const float *x_, *c_, *ctx_, *c_ctx_, *ada_w_, *ada_b_, *norm1_g_, *norm2_g_, *w_in_, *mla_q_g_, *mla_w_uq_, *mla_kv_g_, *mla_w_ukv_, *hy_conv_w_, *hy_conv_b_, *hy_w1_, *hy_b1_, *hy_w2_, *hy_b2_, *hy_w3_, *hy_freq_, *hy_bias_, *gla_gk_w_, *gla_gk_b_, *fnet_w_, *mix_g_, *w_out_, *router_w_, *router_b_, *moe_w_gu_, *moe_b_gu_, *moe_w_down_, *moe_b_down_, *final_g_;
  float* out_;
  char* ws_;
};
struct Params {
  const __attribute__((address_space(4))) char* kb;
  template <class T> __device__ __forceinline__ T karg(size_t off) const { return *(const __attribute__((address_space(4))) T*)(kb + off); }
  __device__ __forceinline__ const float* x() const { return karg<const float*>(offsetof(ParamsData, x_)); }
  __device__ __forceinline__ const float* c() const { return karg<const float*>(offsetof(ParamsData, c_)); }
  __device__ __forceinline__ const float* ctx() const { return karg<const float*>(offsetof(ParamsData, ctx_)); }
  __device__ __forceinline__ const float* c_ctx() const { return karg<const float*>(offsetof(ParamsData, c_ctx_)); }
  __device__ __forceinline__ const float* ada_w() const { return karg<const float*>(offsetof(ParamsData, ada_w_)); }
  __device__ __forceinline__ const float* ada_b() const { return karg<const float*>(offsetof(ParamsData, ada_b_)); }
  __device__ __forceinline__ const float* norm1_g() const { return karg<const float*>(offsetof(ParamsData, norm1_g_)); }
  __device__ __forceinline__ const float* norm2_g() const { return karg<const float*>(offsetof(ParamsData, norm2_g_)); }
  __device__ __forceinline__ const float* w_in() const { return karg<const float*>(offsetof(ParamsData, w_in_)); }
  __device__ __forceinline__ const float* mla_q_g() const { return karg<const float*>(offsetof(ParamsData, mla_q_g_)); }
  __device__ __forceinline__ const float* mla_w_uq() const { return karg<const float*>(offsetof(ParamsData, mla_w_uq_)); }
  __device__ __forceinline__ const float* mla_kv_g() const { return karg<const float*>(offsetof(ParamsData, mla_kv_g_)); }
  __device__ __forceinline__ const float* mla_w_ukv() const { return karg<const float*>(offsetof(ParamsData, mla_w_ukv_)); }
  __device__ __forceinline__ const float* hy_conv_w() const { return karg<const float*>(offsetof(ParamsData, hy_conv_w_)); }
  __device__ __forceinline__ const float* hy_conv_b() const { return karg<const float*>(offsetof(ParamsData, hy_conv_b_)); }
  __device__ __forceinline__ const float* hy_w1() const { return karg<const float*>(offsetof(ParamsData, hy_w1_)); }
  __device__ __forceinline__ const float* hy_b1() const { return karg<const float*>(offsetof(ParamsData, hy_b1_)); }
  __device__ __forceinline__ const float* hy_w2() const { return karg<const float*>(offsetof(ParamsData, hy_w2_)); }
  __device__ __forceinline__ const float* hy_b2() const { return karg<const float*>(offsetof(ParamsData, hy_b2_)); }
  __device__ __forceinline__ const float* hy_w3() const { return karg<const float*>(offsetof(ParamsData, hy_w3_)); }
  __device__ __forceinline__ const float* hy_freq() const { return karg<const float*>(offsetof(ParamsData, hy_freq_)); }
  __device__ __forceinline__ const float* hy_bias() const { return karg<const float*>(offsetof(ParamsData, hy_bias_)); }
  __device__ __forceinline__ const float* gla_gk_w() const { return karg<const float*>(offsetof(ParamsData, gla_gk_w_)); }
  __device__ __forceinline__ const float* gla_gk_b() const { return karg<const float*>(offsetof(ParamsData, gla_gk_b_)); }
  __device__ __forceinline__ const float* fnet_w() const { return karg<const float*>(offsetof(ParamsData, fnet_w_)); }
  __device__ __forceinline__ const float* mix_g() const { return karg<const float*>(offsetof(ParamsData, mix_g_)); }
  __device__ __forceinline__ const float* w_out() const { return karg<const float*>(offsetof(ParamsData, w_out_)); }
  __device__ __forceinline__ const float* router_w() const { return karg<const float*>(offsetof(ParamsData, router_w_)); }
  __device__ __forceinline__ const float* router_b() const { return karg<const float*>(offsetof(ParamsData, router_b_)); }
  __device__ __forceinline__ const float* moe_w_gu() const { return karg<const float*>(offsetof(ParamsData, moe_w_gu_)); }
  __device__ __forceinline__ const float* moe_b_gu() const { return karg<const float*>(offsetof(ParamsData, moe_b_gu_)); }
  __device__ __forceinline__ const float* moe_w_down() const { return karg<const float*>(offsetof(ParamsData, moe_w_down_)); }
  __device__ __forceinline__ const float* moe_b_down() const { return karg<const float*>(offsetof(ParamsData, moe_b_down_)); }
  __device__ __forceinline__ const float* final_g() const { return karg<const float*>(offsetof(ParamsData, final_g_)); }
  __device__ __forceinline__ float* out() const { return karg<float*>(offsetof(ParamsData, out_)); }
  __device__ __forceinline__ char* ws() const { return karg<char*>(offsetof(ParamsData, ws_)); }
  __device__ __forceinline__ unsigned* bar() const { return (unsigned*)(ws() + OFF_bar); }
  __device__ __forceinline__ int* cnt() const { return (int*)(ws() + OFF_cnt); }
  __device__ __forceinline__ float* hssq() const { return (float*)(ws() + OFF_hssq); }
  __device__ __forceinline__ unsigned* kmx() const { return (unsigned*)(ws() + OFF_kmx); }
  __device__ __forceinline__ float* mod() const { return (float*)(ws() + OFF_mod); }
  __device__ __forceinline__ float* ropec() const { return (float*)(ws() + OFF_ropec); }
  __device__ __forceinline__ float* ropes() const { return (float*)(ws() + OFF_ropes); }
  __device__ __forceinline__ float2* tw() const { return (float2*)(ws() + OFF_tw); }
  __device__ __forceinline__ signed char* bt_in() const { return (signed char*)(ws() + OFF_bt_in); }
  __device__ __forceinline__ u16* bt_qkv() const { return (u16*)(ws() + OFF_bt_qkv); }
  __device__ __forceinline__ u16* bt_out() const { return (u16*)(ws() + OFF_bt_out); }
  __device__ __forceinline__ signed char* bt_gu() const { return (signed char*)(ws() + OFF_bt_gu); }
  __device__ __forceinline__ u16* bt_dn() const { return (u16*)(ws() + OFF_bt_dn); }
  __device__ __forceinline__ float* hfb() const { return (float*)(ws() + OFF_hfb); }
  __device__ __forceinline__ float* hfc() const { return (float*)(ws() + OFF_hfc); }
  __device__ __forceinline__ float4* hspec() const { return (float4*)(ws() + OFF_hspec); }
  __device__ __forceinline__ signed char* H() const { return (signed char*)(ws() + OFF_H); }
  __device__ __forceinline__ float* hs() const { return (float*)(ws() + OFF_hs); }
  __device__ __forceinline__ float* rsc() const { return (float*)(ws() + OFF_rsc); }
  __device__ __forceinline__ float* hpart() const { return (float*)(ws() + OFF_hpart); }
  __device__ __forceinline__ float* swin() const { return (float*)(ws() + OFF_swin); }
  __device__ __forceinline__ float* swgu() const { return (float*)(ws() + OFF_swgu); }
  __device__ __forceinline__ float* btf() const { return (float*)(ws() + OFF_act); }
  __device__ __forceinline__ u16* zqkv() const { return (u16*)(ws() + OFF_zqkv); }
  __device__ __forceinline__ u16* zg() const { return (u16*)(ws() + OFF_zg); }
  __device__ __forceinline__ u16* zt() const { return (u16*)(ws() + OFF_zt); }
  __device__ __forceinline__ u16* Q() const { return (u16*)(ws() + OFF_Q); }
  __device__ __forceinline__ u16* KV() const { return (u16*)(ws() + OFF_KV); }
  __device__ __forceinline__ u16* ymix() const { return (u16*)(ws() + OFF_ymix); }
  __device__ __forceinline__ u16* hyo() const { return (u16*)(ws() + OFF_hyo); }
  __device__ __forceinline__ u16* fno() const { return (u16*)(ws() + OFF_fno); }
  __device__ __forceinline__ u16* glao() const { return (u16*)(ws() + OFF_glao); }
  __device__ __forceinline__ float* gds() const { return (float*)(ws() + OFF_gds); }
  __device__ __forceinline__ float* gdv() const { return (float*)(ws() + OFF_gdv); }
  __device__ __forceinline__ float* gst() const { return (float*)(ws() + OFF_gst); }
  __device__ __forceinline__ u16* X() const { return (u16*)(ws() + OFF_X); }
  __device__ __forceinline__ int* rtok() const { return (int*)(ws() + OFF_rtok); }
  __device__ __forceinline__ float* rw() const { return (float*)(ws() + OFF_rw); }
  __device__ __forceinline__ int* tslot() const { return (int*)(ws() + OFF_tslot); }
  __device__ __forceinline__ u16* act() const { return (u16*)(ws() + OFF_act); }
  __device__ __forceinline__ unsigned char* yd() const { return (unsigned char*)(ws() + OFF_yd); }
};


__device__ __forceinline__ u16 f2bf(float f) {
  unsigned u = __float_as_uint(f); u += 0x7FFFu + ((u >> 16) & 1u); return (u16)(u >> 16);
}
__device__ __forceinline__ float bf2f(u16 h) { return __uint_as_float(((unsigned)h) << 16); }
__device__ __forceinline__ unsigned cvtpk(float lo, float hi) {
  unsigned r; asm volatile("v_cvt_pk_bf16_f32 %0, %1, %2" : "=v"(r) : "v"(lo), "v"(hi)); return r;
}
#define BF_LO(w) __uint_as_float((w) << 16)
#define BF_HI(w) __uint_as_float((w) & 0xFFFF0000u)
__device__ __forceinline__ float4 ld4bf(const u16* p) { const u32x2 w = *(const u32x2*)p; return make_float4(__uint_as_float(w[0] << 16), __uint_as_float(w[0] & 0xFFFF0000u), __uint_as_float(w[1] << 16), __uint_as_float(w[1] & 0xFFFF0000u)); }
template <int CTRL> __device__ __forceinline__ float dppf(float v) { return __builtin_bit_cast(float, __builtin_amdgcn_update_dpp(0, __builtin_bit_cast(int, v), CTRL, 0xF, 0xF, true)); }
template <int M> __device__ __forceinline__ float shx(float v) {
  if constexpr (M == 1) return dppf<0xB1>(v);
  else if constexpr (M == 2) return dppf<0x4E>(v);
  else if constexpr (M == 4) return dppf<0x1B>(dppf<0x141>(v));
  else if constexpr (M == 8) return dppf<0x141>(dppf<0x140>(v));
  else if constexpr (M == 16) { auto r = __builtin_amdgcn_permlane16_swap(__float_as_uint(v), __float_as_uint(v), false, false);
    return __uint_as_float((__lane_id() & 16) ? r[0] : r[1]); }
  else { auto r = __builtin_amdgcn_permlane32_swap(__float_as_uint(v), __float_as_uint(v), false, false);
    return __uint_as_float((__lane_id() & 32) ? r[0] : r[1]); }
}
__device__ __forceinline__ float wave_sum(float v) {
  v += dppf<0xB1>(v); v += dppf<0x4E>(v); v += dppf<0x141>(v); v += dppf<0x140>(v);
  { auto r = __builtin_amdgcn_permlane16_swap(__float_as_uint(v), __float_as_uint(v), false, false); v = __uint_as_float(r[0]) + __uint_as_float(r[1]); }
  { auto r = __builtin_amdgcn_permlane32_swap(__float_as_uint(v), __float_as_uint(v), false, false); v = __uint_as_float(r[0]) + __uint_as_float(r[1]); }
  return v;
}
__device__ __forceinline__ float wave_max(float v) {
  v = fmaxf(v, dppf<0xB1>(v)); v = fmaxf(v, dppf<0x4E>(v)); v = fmaxf(v, dppf<0x141>(v)); v = fmaxf(v, dppf<0x140>(v));
  { auto r = __builtin_amdgcn_permlane16_swap(__float_as_uint(v), __float_as_uint(v), false, false); v = fmaxf(__uint_as_float(r[0]), __uint_as_float(r[1])); }
  { auto r = __builtin_amdgcn_permlane32_swap(__float_as_uint(v), __float_as_uint(v), false, false); v = fmaxf(__uint_as_float(r[0]), __uint_as_float(r[1])); }
  return v;
}
__device__ __forceinline__ int ltid() { int t = threadIdx.x; asm volatile("" : "+v"(t)); return t; }
__device__ __forceinline__ float silu_f(float x) { return x / (1.f + __expf(-x)); }
__device__ __forceinline__ float2 cmul(float2 a, float2 b) { return make_float2(a.x * b.x - a.y * b.y, a.x * b.y + a.y * b.x); }
__device__ __forceinline__ float2 cmulc(float2 a, float2 b) { return make_float2(a.x * b.x + a.y * b.y, a.y * b.x - a.x * b.y); }
__device__ __forceinline__ int modv(int tok) { return tok < TL ? (tok >> 14) : 2; }
__device__ __forceinline__ void phase_tables(const Params& p, int bid, int nb) {
  const int gt = bid * NTHR + ltid(), gs = nb * NTHR;
  for (int i = gt; i < SEQ * 16; i += gs) {
    const int t = i >> 4, f = i & 15;
    const float pos = (f < 8) ? (float)(t >> 6) : (float)(t & 63);
    const float inv = powf(10000.f, -(float)(f & 7) / 8.f);
    float s, c; sincosf(pos * inv, &s, &c);
    p.ropec()[i] = c; p.ropes()[i] = s;
  }
  for (int i = gt; i < FM; i += gs) {
    float s, c; sincospif((float)i / 8192.f, &s, &c);
    p.tw()[i] = make_float2(c, -s);
  }
}

__device__ __forceinline__ void phase_mod(const Params& p, int bid, int nb, char* lds) {
  float* red = (float*)lds;
  const int tid = ltid(), part = tid >> 6, cl = tid & 63;
  for (int it = bid; it < 2 * 96; it += nb) {
    const int l = it / 96, n = (it % 96) * 64 + cl;
    const float* W = p.ada_w() + (size_t)l * DM * 6144;
    float a0 = 0, a1 = 0, a2 = 0;
    for (int k = part * 128; k < part * 128 + 128; ++k) {
      const float w = W[(size_t)k * 6144 + n];
      a0 += silu_f(p.c()[k]) * w; a1 += silu_f(p.c()[DM + k]) * w; a2 += silu_f(p.c_ctx()[k]) * w;
    }
    red[(part * 3 + 0) * 64 + cl] = a0; red[(part * 3 + 1) * 64 + cl] = a1; red[(part * 3 + 2) * 64 + cl] = a2;
    __syncthreads();
    if (tid < 192) {
      const int v = tid >> 6; float s = 0;
      for (int q = 0; q < 8; ++q) s += red[(q * 3 + v) * 64 + cl];
      p.mod()[((size_t)l * 3 + v) * 6144 + n] = s + p.ada_b()[(size_t)l * 6144 + n];
    }
    __syncthreads();
  }
}

__device__ __forceinline__ void phase_fold(const Params& p, int bid, int nb, char* lds) {
  float* wrow = (float*)lds;
  float* dre = wrow + 2048;
  float* dim_ = dre + 2048;
  float* glr = dim_ + 2048;
  float* cst = glr + 256;
  float* snt = cst + 256;
  const int tid = ltid();
  if (tid < 256) { float sn, cs; sincospif((float)tid / 128.f, &sn, &cs); cst[tid] = cs; snt[tid] = sn; }
  __syncthreads();
  for (int it = bid; it < 2 * DM / 8; it += nb) {
    const int l = it >> 7, k0 = (it & 127) * 8;
    for (int i = tid; i < 8 * 256; i += NTHR) { const int r = i >> 8, c = i & 255; wrow[c * 8 + r] = p.w_in()[((size_t)l * DM + k0 + r) * DIN0 + 1984 + c]; }
    if (tid < 256) { const int r = tid >> 5, c = tid & 31; glr[c * 8 + r] = p.w_in()[((size_t)l * DM + k0 + r) * DIN0 + 1696 + c]; }
    __syncthreads();
    {
      const int kp = tid & 255; const bool im = tid >= 256;
      float acc[8] = {0.f, 0.f, 0.f, 0.f, 0.f, 0.f, 0.f, 0.f};
#pragma unroll 4
      for (int c = 0; c < 256; ++c) {
        const int m = (c * kp) & 255; const float t = im ? -snt[m] : cst[m];
        const float4 w0 = *(const float4*)(wrow + c * 8), w1 = *(const float4*)(wrow + c * 8 + 4);
        acc[0] += w0.x * t; acc[1] += w0.y * t; acc[2] += w0.z * t; acc[3] += w0.w * t; acc[4] += w1.x * t; acc[5] += w1.y * t; acc[6] += w1.z * t; acc[7] += w1.w * t;
      }
      float* d = (im ? dim_ : dre) + kp * 8;
      *(float4*)d = make_float4(acc[0], acc[1], acc[2], acc[3]); *(float4*)(d + 4) = make_float4(acc[4], acc[5], acc[6], acc[7]);
    }
    __syncthreads();
    {
      const int j = tid & 255; const bool im = tid >= 256;
      const float* Wf = p.fnet_w() + (size_t)l * 65536 + j;
      const float* d = im ? dim_ : dre;
      float acc[8] = {0.f, 0.f, 0.f, 0.f, 0.f, 0.f, 0.f, 0.f};
#pragma unroll 8
      for (int kp = 0; kp < 256; ++kp) {
        const float w = Wf[kp * 256];
        const float4 d0 = *(const float4*)(d + kp * 8), d1 = *(const float4*)(d + kp * 8 + 4);
        acc[0] += d0.x * w; acc[1] += d0.y * w; acc[2] += d0.z * w; acc[3] += d0.w * w; acc[4] += d1.x * w; acc[5] += d1.y * w; acc[6] += d1.z * w; acc[7] += d1.w * w;
      }
      float* o = p.btf() + ((size_t)l * NIN + (im ? 2560 : 2304) + j) * DM + k0;
      *(float4*)o = make_float4(acc[0] * 0.0625f, acc[1] * 0.0625f, acc[2] * 0.0625f, acc[3] * 0.0625f);
      *(float4*)(o + 4) = make_float4(acc[4] * 0.0625f, acc[5] * 0.0625f, acc[6] * 0.0625f, acc[7] * 0.0625f);
    }
    if (tid < 256) {
      const int dir = tid >> 7, kk = tid & 127;
      const float* gw = p.gla_gk_w() + ((size_t)l * 2 + dir) * 16 * 128 + kk;
      float acc[8] = {0.f, 0.f, 0.f, 0.f, 0.f, 0.f, 0.f, 0.f};
#pragma unroll
      for (int r16 = 0; r16 < 16; ++r16) {
        const float w = gw[r16 * 128];
        const float4 g0 = *(const float4*)(glr + (dir * 16 + r16) * 8), g1 = *(const float4*)(glr + (dir * 16 + r16) * 8 + 4);
        acc[0] += g0.x * w; acc[1] += g0.y * w; acc[2] += g0.z * w; acc[3] += g0.w * w; acc[4] += g1.x * w; acc[5] += g1.y * w; acc[6] += g1.z * w; acc[7] += g1.w * w;
      }
      float* o = p.btf() + ((size_t)l * NIN + 1024 + tid) * DM + k0;
      *(float4*)o = make_float4(acc[0], acc[1], acc[2], acc[3]); *(float4*)(o + 4) = make_float4(acc[4], acc[5], acc[6], acc[7]);
    }
    __syncthreads();
  }
}

enum { MAP_ID = 0, MAP_IN = 1, MAP_UQ = 2, MAP_UKV = 3, MAP_GU = 4 };
__device__ __forceinline__ int colmap(int mt, int n) {
  switch (mt) {
    case MAP_ID: return n;
    case MAP_IN:
      if (n < 256) return n;
      if (n < 384) return 256 + (n - 256);
      if (n < 512) return 1184 + (n - 384);
      if (n < 640) return 1312 + (n - 512);
      if (n < 672) return 384 + (n - 640);
      if (n < 768) return -1;
      if (n < 1024) return 1440 + (n - 768);
      if (n < 1280) return -2;
      if (n < 1536) return 1728 + (n - 1280);
      if (n < 2304) return 416 + (n - 1536);
      return -2;
    case MAP_UQ:
      if (n < 256) return (n >> 6) * 96 + (n & 63);
      if (n < 384) return ((n - 256) >> 5) * 96 + 64 + ((n - 256) & 31);
      return -1;
    case MAP_UKV:
      if (n < 256) return (n >> 6) * 128 + (n & 63);
      return ((n - 256) >> 6) * 128 + 64 + ((n - 256) & 63);
    default: {
      const int pn = n >> 8, w = n & 255;
      return w < 128 ? 2 * (pn * 128 + w) : 2 * (pn * 128 + w - 128) + 1;
    }
  }
}
__device__ __forceinline__ int invmap(int mt, int sc) {
  if (mt == MAP_ID) return sc;
  if (mt == MAP_GU) { const int j = sc >> 1, t = sc & 1; return (j >> 7) * 256 + t * 128 + (j & 127); }
  if (sc < 384) return sc;
  if (sc < 416) return 640 + (sc - 384);
  if (sc < 1184) return 1536 + (sc - 416);
  if (sc < 1312) return 384 + (sc - 1184);
  if (sc < 1440) return 512 + (sc - 1312);
  if (sc < 1696) return 768 + (sc - 1440);
  if (sc < 1728) return -1;
  if (sc < 1984) return 1280 + (sc - 1728);
  return -1;
}
struct ConvJob { const float* src; void* dst; const float* scale; int ld, K, mt, k0, s0, f32; };
__device__ __forceinline__ void conv_tile_load(const ConvJob& J, int tid, float4 (&v)[4]) {
  const int kk = tid >> 5, s4 = (tid & 31) * 4;
#pragma unroll
  for (int i = 0; i < 4; ++i) {
    v[i] = make_float4(0.f, 0.f, 0.f, 0.f);
    if (J.s0 + s4 < J.ld) v[i] = *(const float4*)(J.src + (size_t)(J.k0 + kk + 16 * i) * J.ld + J.s0 + s4);
  }
}
__device__ __forceinline__ void conv_tile_proc(const ConvJob& J, int tid, const float4 (&v)[4], float* tile  ) {
  {
    const int kk = tid >> 5, s4 = (tid & 31) * 4;
#pragma unroll
    for (int i = 0; i < 4; ++i) {
      const float sc = J.scale ? J.scale[J.k0 + kk + 16 * i] : 1.f;
      float* t = tile + (kk + 16 * i) * 129 + s4;
      t[0] = v[i].x * sc; t[1] = v[i].y * sc; t[2] = v[i].z * sc; t[3] = v[i].w * sc;
    }
  }
  __syncthreads();
#pragma unroll
  for (int h = 0; h < 2; ++h) {
    const int sl = (tid >> 3) + 64 * h, ks = (tid & 7) * 8, sc = J.s0 + sl;
    const int row = sc < J.ld ? invmap(J.mt, sc) : -1;
    if (row >= 0) {
      const float* t = tile + ks * 129 + sl;
      if (J.f32) {
        float* dst = (float*)J.dst + (size_t)row * J.K + J.k0 + ks;
        *(float4*)dst = make_float4(t[0], t[129], t[2 * 129], t[3 * 129]); *(float4*)(dst + 4) = make_float4(t[4 * 129], t[5 * 129], t[6 * 129], t[7 * 129]);
      } else {
        u32x4 w;
        w[0] = cvtpk(t[0], t[129]); w[1] = cvtpk(t[2 * 129], t[3 * 129]); w[2] = cvtpk(t[4 * 129], t[5 * 129]); w[3] = cvtpk(t[6 * 129], t[7 * 129]);
        *(u32x4*)((u16*)J.dst + (size_t)row * J.K + J.k0 + ks) = w;
      }
    }
  }
  __syncthreads();
}
constexpr int CT_IN = 16 * 18, CT_OUT = 16 * 8, CT_DN = NE * 128, CT_L = CT_IN + CT_OUT + CT_DN;
__device__ __forceinline__ void conv_decode(const Params& p, int t, ConvJob& J) {
  const int l = t / CT_L; int r = t % CT_L;
  if (r < CT_IN) { J.src = p.w_in() + (size_t)l * DM * DIN0; J.ld = DIN0; J.K = DM; J.dst = p.btf() + (size_t)l * NIN * DM; J.mt = MAP_IN; J.scale = nullptr; J.k0 = (r / 18) * 64; J.s0 = (r % 18) * 128; J.f32 = 1; return; }
  r -= CT_IN;
  if (r < CT_OUT) { J.src = p.w_out() + (size_t)l * DM * DM; J.ld = DM; J.K = DM; J.dst = p.bt_out() + (size_t)l * DM * DM; J.mt = MAP_ID; J.scale = p.mix_g() + l * DM; J.k0 = (r / 8) * 64; J.s0 = (r % 8) * 128; J.f32 = 0; return; }
  r -= CT_OUT;
  const int e = r >> 7, q = r & 127;
  J.src = p.moe_w_down() + ((size_t)l * NE + e) * DFF * DM; J.ld = DM; J.K = DFF; J.dst = p.bt_dn() + ((size_t)l * NE + e) * DM * DFF; J.mt = MAP_ID; J.scale = nullptr; J.k0 = (q >> 3) * 64; J.s0 = (q & 7) * 128; J.f32 = 0;
}
__device__ __forceinline__ void conv_gu8_load(const float* __restrict__ src  , int s0, int tid, float4 (&v)[16]) {
  const int c4 = (tid & 7) * 4, r0 = tid >> 3;
#pragma unroll
  for (int pss = 0; pss < 16; ++pss) v[pss] = *(const float4*)(src + (size_t)(r0 + 64 * pss) * 2048 + s0 + c4);
}
__device__ __forceinline__ void conv_gu8_proc(const float4 (&v)[16], signed char* __restrict__ dst  , float* __restrict__ sw  ,
                                              int s0, float* tile  , int tid) {
  float* cmax = tile + 1024 * 33;
  {
    const int c4 = (tid & 7) * 4, r0 = tid >> 3;
#pragma unroll
    for (int pss = 0; pss < 16; ++pss) { float* t = tile + (r0 + 64 * pss) * 33 + c4; t[0] = v[pss].x; t[1] = v[pss].y; t[2] = v[pss].z; t[3] = v[pss].w; }
  }
  __syncthreads();
  {
    const int col = tid & 31, part = tid >> 5; float m = 0.f;
#pragma unroll 8
    for (int k = part * 64; k < part * 64 + 64; ++k) m = fmaxf(m, fabsf(tile[k * 33 + col]));
    cmax[part * 32 + col] = m;
  }
  __syncthreads();
  if (tid < 32) {
    float m = 0.f;
#pragma unroll
    for (int q = 0; q < 16; ++q) m = fmaxf(m, cmax[q * 32 + tid]);
    const float sc = fmaxf(m, 1e-20f) * (1.f / 127.f);
    cmax[512 + tid] = sc;
    sw[invmap(MAP_GU, s0 + tid)] = sc;
  }
  __syncthreads();
#pragma unroll
  for (int h = 0; h < 4; ++h) {
    const int g = tid + 512 * h, col = g & 31, k0 = (g >> 5) * 16;
    const float inv = 1.f / cmax[512 + col];
    unsigned w[4];
#pragma unroll
    for (int q = 0; q < 4; ++q) {
      const float* t = tile + (k0 + 4 * q) * 33 + col;
      const int q0 = (int)rintf(t[0] * inv), q1 = (int)rintf(t[33] * inv), q2 = (int)rintf(t[66] * inv), q3 = (int)rintf(t[99] * inv);
      w[q] = (unsigned)(q0 & 255) | ((unsigned)(q1 & 255) << 8) | ((unsigned)(q2 & 255) << 16) | ((unsigned)(q3 & 255) << 24);
    }
    *(u32x4*)(dst + (size_t)invmap(MAP_GU, s0 + col) * DM + k0) = u32x4{w[0], w[1], w[2], w[3]};
  }
  __syncthreads();
}
__device__ __forceinline__ void phase_convert(const Params& p, int bid, int nb, char* lds) {
  float* tile = (float*)lds;
  const int tid = ltid();
  {
    ConvJob J, Jn; float4 v[4], vn[4];
    int t = bid;
    if (t < 2 * CT_L) { conv_decode(p, t, J); conv_tile_load(J, tid, v); }
    for (; t < 2 * CT_L; t += nb) {
      const bool more = t + nb < 2 * CT_L;
      if (more) { conv_decode(p, t + nb, Jn); conv_tile_load(Jn, tid, vn); }
      conv_tile_proc(J, tid, v, tile);
      if (more) { J = Jn;
#pragma unroll
        for (int i = 0; i < 4; ++i) v[i] = vn[i]; }
    }
  }
  {
    float4 v[16], vn[16];
    int t = bid;
    if (t < 2 * NE * 64) conv_gu8_load(p.moe_w_gu() + (size_t)(t >> 6) * DM * 2048, (t & 63) * 32, tid, v);
    for (; t < 2 * NE * 64; t += nb) {
      const bool more = t + nb < 2 * NE * 64; const int tn = t + nb;
      if (more) conv_gu8_load(p.moe_w_gu() + (size_t)(tn >> 6) * DM * 2048, (tn & 63) * 32, tid, vn);
      conv_gu8_proc(v, p.bt_gu() + (size_t)(t >> 6) * 2048 * DM, p.swgu() + (size_t)(t >> 6) * 2048, (t & 63) * 32, tile, tid);
      if (more) {
#pragma unroll
        for (int i = 0; i < 16; ++i) v[i] = vn[i]; }
    }
  }
  for (int l = 0; l < 2; ++l) {
    for (int i = bid * NTHR + tid; i < 96 * DM / 4; i += nb * NTHR) *(float4*)(p.btf() + ((size_t)l * NIN + 672) * DM + (size_t)i * 4) = make_float4(0.f, 0.f, 0.f, 0.f);
    {
      const float* wq = p.mla_w_uq() + (size_t)l * 256 * 384; const float* wkv = p.mla_w_ukv() + (size_t)l * 128 * 512;
      const float* gq = p.mla_q_g() + l * 256; const float* gkv = p.mla_kv_g() + l * 128;
      u16* dst = p.bt_qkv() + (size_t)l * 1024 * 384;
      for (int i = bid * NTHR + ltid(); i < 1024 * 384; i += nb * NTHR) {
        const int n = i / 384, k = i % 384; float v = 0.f;
        if (n < 512) { const int sc = colmap(MAP_UQ, n); if (k < 256 && sc >= 0) v = gq[k] * wq[k * 384 + sc]; }
        else { if (k >= 256) v = gkv[k - 256] * wkv[(k - 256) * 512 + colmap(MAP_UKV, n - 512)]; }
        dst[i] = f2bf(v);
      }
    }
  }
}

__device__ __forceinline__ void phase_hy_mlp(const Params& p, int l, int Lf, float* __restrict__ hout  , float* __restrict__ ssq  ,
                             int bid, int nb, char* lds) {
  float* zf = (float*)lds;
  float* h1 = zf + 64 * 33;
  float* h2 = h1 + 64 * 64;
  const int tid = ltid();
  const float* w1 = p.hy_w1() + (size_t)l * 33 * 64; const float* b1 = p.hy_b1() + l * 64;
  const float* w2 = p.hy_w2() + (size_t)l * 64 * 64; const float* b2 = p.hy_b2() + l * 64;
  const float* w3 = p.hy_w3() + (size_t)l * 64 * 512; const float* fr = p.hy_freq() + l * 64;
  float w3c[64];
#pragma unroll
  for (int k = 0; k < 64; ++k) w3c[k] = w3[k * 512 + tid];
  const int dir = tid >> 8, ch = tid & 255;
  const float maxd = logf(1e-2f) / 0.3f, mind = logf(1e-2f) / 1.5f;
  const float delta = fabsf(mind + (maxd - mind) * (float)ch / 255.f);
  float ssq_acc = 0.f;
  for (int it = bid; it < Lf / 64; it += nb) {
    const int t0 = it * 64;
    for (int i = tid; i < 64 * 33; i += NTHR) {
      const int tt = i / 33, f = i % 33, t = t0 + tt;
      float v;
      if (f == 0) v = (float)t / (float)(Lf - 1);
      else {
        const int j = (f - 1) & 15;
        const float fj = 1e-4f + (float)j * ((15.f - 1e-4f) / 15.f);
        const float w = 6.283185307179586f * (float)t / (float)Lf;
        v = (f <= 16) ? cosf(fj * w) : -sinf(fj * w);
      }
      zf[i] = v;
    }
    __syncthreads();
    {
      const int o = tid & 63, tb = tid >> 6;
      float acc[8];
#pragma unroll
      for (int j = 0; j < 8; ++j) acc[j] = b1[o];
#pragma unroll 3
      for (int f = 0; f < 33; ++f) {
        const float w = w1[f * 64 + o];
#pragma unroll
        for (int j = 0; j < 8; ++j) acc[j] += zf[(tb + 8 * j) * 33 + f] * w;
      }
      const float fo = fr[o];
#pragma unroll
      for (int j = 0; j < 8; ++j) h1[(tb + 8 * j) * 64 + o] = sinf(fo * acc[j]);
    }
    __syncthreads();
    {
      const int o = tid & 63, tb = tid >> 6;
      float acc[8];
#pragma unroll
      for (int j = 0; j < 8; ++j) acc[j] = b2[o];
#pragma unroll 4
      for (int f = 0; f < 64; f += 4) {
        const float wa = w2[f * 64 + o], wb = w2[(f + 1) * 64 + o], wc2 = w2[(f + 2) * 64 + o], wd = w2[(f + 3) * 64 + o];
#pragma unroll
        for (int j = 0; j < 8; ++j) { const float4 hv = *(const float4*)(h1 + (tb + 8 * j) * 64 + f); acc[j] += hv.x * wa + hv.y * wb + hv.z * wc2 + hv.w * wd; }
      }
      const float fo = fr[o];
#pragma unroll
      for (int j = 0; j < 8; ++j) h2[(tb + 8 * j) * 64 + o] = sinf(fo * acc[j]);
    }
    __syncthreads();
    float* orow = hout + ((size_t)dir * 256 + ch) * Lf + t0;
    for (int tq = 0; tq < 16; ++tq) {
      float sv[4];
#pragma unroll
      for (int u = 0; u < 4; ++u) {
        const int tt = tq * 4 + u;
        float s = 0;
#pragma unroll
        for (int k = 0; k < 64; k += 4) { const float4 hv = *(const float4*)(h2 + tt * 64 + k); s += hv.x * w3c[k] + hv.y * w3c[k + 1] + hv.z * w3c[k + 2] + hv.w * w3c[k + 3]; }
        const int t = t0 + tt;
        s *= __expf(-((float)t / (float)(Lf - 1)) * delta);
        if (dir == 0 || t > 0) ssq_acc += s * s;
        sv[u] = s;
      }
      *(float4*)(orow + tq * 4) = make_float4(sv[0], sv[1], sv[2], sv[3]);
    }
    __syncthreads();
  }
  ssq[(size_t)bid * 512 + tid] = ssq_acc;
}

__host__ __device__ constexpr int fx(int p) {
  return ((p >> 12) & 3) ^ (((p >> 10) & 3) << 2) ^ ((p >> 4) & 16) ^ (((p >> 5) & 1) * 5) ^ (((p >> 6) & 1) * 26);
}
__device__ __forceinline__ int swz(int p) { return p ^ fx(p); }
__device__ __forceinline__ int rev7(int k) {
  unsigned r = __brev((unsigned)k) >> 18;
  return (int)(((r & 0x2AAAu) >> 1) | ((r & 0x1555u) << 1));
}
template <int ST, bool INV>
__device__ __forceinline__ void fft_stage(float2* s, const float2* __restrict__ tw, const int tid) {
  constexpr int sh = 12 - 2 * ST, q = 1 << sh, ND = q >= 512 ? q / 512 : 1;
  float2 w1[ND], w2[ND], w3[ND];
  if constexpr (ST < 6) {
#pragma unroll
    for (int d = 0; d < ND; ++d) {
      const int j = q >= 512 ? tid + 512 * d : (tid & (q - 1)), ti = j << (2 * ST);
      w1[d] = tw[ti]; w2[d] = tw[2 * ti]; w3[d] = tw[3 * ti];
    }
  }
  float2 x[8][4];
#pragma unroll
  for (int m = 0; m < 8; ++m) {
    const int u = tid + 512 * m, g = u >> sh, j = u & (q - 1), base = (g << (sh + 2)) + j, xb = fx(base);
    x[m][0] = s[base ^ xb]; x[m][1] = s[(base + q) ^ xb ^ fx(q)]; x[m][2] = s[(base + 2 * q) ^ xb ^ fx(2 * q)]; x[m][3] = s[(base + 3 * q) ^ xb ^ fx(3 * q)];
  }
#pragma unroll
  for (int m = 0; m < 8; ++m) {
    const int u = tid + 512 * m, g = u >> sh, j = u & (q - 1), base = (g << (sh + 2)) + j, xb = fx(base);
    const int i0 = base ^ xb, i1 = (base + q) ^ xb ^ fx(q), i2 = (base + 2 * q) ^ xb ^ fx(2 * q), i3 = (base + 3 * q) ^ xb ^ fx(3 * q);
    const int d = q >= 512 ? (m % ND) : 0;
    if constexpr (!INV) {
      const float2 a0 = x[m][0], a1 = x[m][1], a2 = x[m][2], a3 = x[m][3];
      const float2 b0 = make_float2(a0.x + a2.x, a0.y + a2.y), b1 = make_float2(a0.x - a2.x, a0.y - a2.y);
      const float2 b2 = make_float2(a1.x + a3.x, a1.y + a3.y), b3 = make_float2(a1.x - a3.x, a1.y - a3.y);
      const float2 y1 = make_float2(b1.x + b3.y, b1.y - b3.x), y2 = make_float2(b0.x - b2.x, b0.y - b2.y), y3 = make_float2(b1.x - b3.y, b1.y + b3.x);
      s[i0] = make_float2(b0.x + b2.x, b0.y + b2.y);
      if constexpr (ST < 6) { s[i1] = cmul(y1, w1[d]); s[i2] = cmul(y2, w2[d]); s[i3] = cmul(y3, w3[d]); }
      else { s[i1] = y1; s[i2] = y2; s[i3] = y3; }
    } else {
      float2 t0 = x[m][0], t1 = x[m][1], t2 = x[m][2], t3 = x[m][3];
      if constexpr (ST < 6) { t1 = cmulc(t1, w1[d]); t2 = cmulc(t2, w2[d]); t3 = cmulc(t3, w3[d]); }
      const float2 b0 = make_float2(t0.x + t2.x, t0.y + t2.y), b1 = make_float2(t0.x - t2.x, t0.y - t2.y);
      const float2 b2 = make_float2(t1.x + t3.x, t1.y + t3.y), b3 = make_float2(t1.x - t3.x, t1.y - t3.y);
      s[i0] = make_float2(b0.x + b2.x, b0.y + b2.y);
      s[i1] = make_float2(b1.x - b3.y, b1.y + b3.x);
      s[i2] = make_float2(b0.x - b2.x, b0.y - b2.y);
      s[i3] = make_float2(b1.x + b3.y, b1.y - b3.x);
    }
  }
  __syncthreads();
}
__device__ __forceinline__ void fft_fwd(float2* s, const float2* __restrict__ tw) {
  const int tid = ltid();
  fft_stage<0, false>(s, tw, tid); fft_stage<1, false>(s, tw, tid); fft_stage<2, false>(s, tw, tid); fft_stage<3, false>(s, tw, tid);
  fft_stage<4, false>(s, tw, tid); fft_stage<5, false>(s, tw, tid); fft_stage<6, false>(s, tw, tid);
}
__device__ __forceinline__ void fft_inv(float2* s, const float2* __restrict__ tw) {
  const int tid = ltid();
  fft_stage<6, true>(s, tw, tid); fft_stage<5, true>(s, tw, tid); fft_stage<4, true>(s, tw, tid); fft_stage<3, true>(s, tw, tid);
  fft_stage<2, true>(s, tw, tid); fft_stage<1, true>(s, tw, tid); fft_stage<0, true>(s, tw, tid);
}

__device__ __forceinline__ float filt_ssq(const float* __restrict__ part  , int ch, float* red  ) {
  const int tid = ltid();
  float v = part[(size_t)(tid >> 1) * 512 + (tid & 1) * 256 + ch];
  v = wave_sum(v);
  __syncthreads();
  if ((tid & 63) == 0) red[tid >> 6] = v;
  __syncthreads();
  return ((red[0] + red[1]) + (red[2] + red[3])) + ((red[4] + red[5]) + (red[6] + red[7]));
}
__device__ __forceinline__ void phase_hy_filtfft(const Params& p, int bid, int nb, char* lds) {
  float2* s = (float2*)lds;
  const int tid = ltid();
  for (int it = bid; it < 512; it += nb) {
    const int l = it >> 8, ch = it & 255;
    const float* hf = p.hfb() + (((size_t)l * 2 + 0) * 256 + ch) * SEQ;
    const float* hb = p.hfb() + (((size_t)l * 2 + 1) * 256 + ch) * SEQ;
#pragma unroll 8
    for (int m = tid; m < FM; m += NTHR) {
      const int n0 = 2 * m, n1 = 2 * m + 1;
      const float a = (n0 < SEQ) ? hf[n0] : (n0 == SEQ ? 0.f : hb[2 * SEQ - n0]);
      const float b = (n1 < SEQ) ? hf[n1] : hb[2 * SEQ - n1];
      s[swz(m)] = make_float2(a, b);
    }
    __syncthreads();
    fft_fwd(s, p.tw());
    const float sc = rsqrtf(filt_ssq(p.hpart() + (size_t)l * 256 * 512, ch, (float*)(lds + 139264))) * (1.f / 16384.f);
    float4* out = p.hspec() + ((size_t)l * 256 + ch) * HSP;
#pragma unroll 4
    for (int k = tid; k <= FM / 2; k += NTHR) {
      const float2 zk = s[swz(rev7(k))], zm = s[swz(rev7((FM - k) & (FM - 1)))];
      const float er = 0.5f * (zk.x + zm.x), ei = 0.5f * (zk.y - zm.y);
      const float dr = 0.5f * (zk.x - zm.x), di = 0.5f * (zk.y + zm.y);
      out[k] = make_float4(er * sc, ei * sc, di * sc, -dr * sc);
    }
    __syncthreads();
  }
}
constexpr int G_TILE_B = 256 * 64 * 2;
constexpr int G_STAGE_B = 2 * G_TILE_B;
constexpr int GEMM_LDS = 2 * G_STAGE_B;

__device__ __forceinline__ int lds_byte2(int r, int c) {
  const int st = (r >> 4) * 2 + (c >> 5), ob = (r & 15) * 64 + (c & 31) * 2;
  return st * 1024 + (ob ^ (((ob >> 9) & 1) << 5));
}
__device__ __forceinline__ void stage_rc2(int b, int& R, int& C) {
  const int st = b >> 10, sb = b & 1023, swz = sb ^ (((sb >> 9) & 1) << 5);
  R = (st >> 1) * 16 + (swz >> 6);
  C = (st & 1) * 32 + ((swz & 63) >> 1);
}
__device__ __forceinline__ void gemm_stage_coords(int (&sR)[4], int (&sC)[4]) {
  const int wid = ltid() >> 6, lane = ltid() & 63;
#pragma unroll
  for (int i = 0; i < 4; ++i) stage_rc2(wid * 1024 + i * 8192 + lane * 16, sR[i], sC[i]);
}

#define WAIT_V0() asm volatile("s_waitcnt vmcnt(0)" ::: "memory")

__device__ __forceinline__ void gemm256_core(const u16* const (&ap)[4], const u16* const (&bp)[4], int nt, char* shm, f32x4 (&acc)[8][4]) {
  const int tid = ltid(), wid = tid >> 6, lane = tid & 63, wr = wid >> 2, wc = wid & 3, fr = lane & 15, fq = lane >> 4;
#pragma unroll
  for (int m = 0; m < 8; ++m)
#pragma unroll
    for (int n = 0; n < 4; ++n) acc[m][n] = f32x4{0.f, 0.f, 0.f, 0.f};
#define G_SA(b) (shm + (b) * G_STAGE_B)
#define G_SB(b) (shm + (b) * G_STAGE_B + G_TILE_B)
#define G_STAGE(buf, kt) do { _Pragma("unroll") for (int i = 0; i < 4; ++i) {                                                   \
    __builtin_amdgcn_global_load_lds((const unsigned*)(ap[i] + (kt) * 64), (unsigned*)(G_SA(buf) + wid * 1024 + i * 8192), 16, 0, 0); \
    __builtin_amdgcn_global_load_lds((const unsigned*)(bp[i] + (kt) * 64), (unsigned*)(G_SB(buf) + wid * 1024 + i * 8192), 16, 0, 0); } } while (0)
  G_STAGE(0, 0); WAIT_V0(); __syncthreads();
#pragma unroll 1
  for (int t = 0; t < nt; ++t) {
    const int cur = t & 1;
    if (t + 1 < nt) G_STAGE(cur ^ 1, t + 1);
#pragma unroll
    for (int ks = 0; ks < 2; ++ks) {
      bf16x8 At[8], Bf[4];
#pragma unroll
      for (int m = 0; m < 8; ++m) At[m] = *(const bf16x8*)(G_SA(cur) + lds_byte2(wr * 128 + m * 16 + fr, ks * 32 + fq * 8));
#pragma unroll
      for (int n = 0; n < 4; ++n) Bf[n] = *(const bf16x8*)(G_SB(cur) + lds_byte2(wc * 64 + n * 16 + fr, ks * 32 + fq * 8));
#pragma unroll
      for (int m = 0; m < 8; ++m)
#pragma unroll
        for (int n = 0; n < 4; ++n) acc[m][n] = __builtin_amdgcn_mfma_f32_16x16x32_bf16(At[m], Bf[n], acc[m][n], 0, 0, 0);
      __builtin_amdgcn_sched_barrier(0);
    }
    WAIT_V0(); __syncthreads();
  }
#undef G_STAGE
}

#define LAS3 __attribute__((address_space(3)))
constexpr int G8_HTB = 128 * 64 * 2;
__device__ __forceinline__ int g8_perm32(int rho) { const int n = rho >> 4, i = rho & 15; return 8 * (i >> 2) + 4 * n + (i & 3); }
__device__ __forceinline__ int g8_lds_byte(int r, int c) { const int st = (r >> 4) * 2 + (c >> 5), rr = r & 15, cc = c & 31, ob = rr * 64 + cc * 2; return st * 1024 + (ob ^ (((ob >> 9) & 1) << 5)); }
__device__ __forceinline__ void g8_stage_rc(int b, int& R, int& C) { const int st = b / 1024, sb = b % 1024, swz = sb ^ (((sb >> 9) & 1) << 5); R = (st >> 1) * 16 + swz / 64; C = (st & 1) * 32 + (swz % 64) / 2; }
struct G8Unit { int pm, pn, e, ce, pre, ab; };
__device__ __forceinline__ void g8_cload(const float* __restrict__ src, float* dst) {
  __builtin_amdgcn_global_load_lds((const unsigned*)(src + (ltid() & 63) * 4), (LAS3 unsigned*)dst, 16, 0, 0);
}


template <bool I8> __device__ __forceinline__ typename std::conditional<I8, int __attribute__((ext_vector_type(4))), f32x4>::type
g8_mma(bf16x8 x, bf16x8 y, typename std::conditional<I8, int __attribute__((ext_vector_type(4))), f32x4>::type c) {
  if constexpr (I8) { typedef int v4i __attribute__((ext_vector_type(4))); return __builtin_amdgcn_mfma_i32_16x16x64_i8(*(v4i*)&x, *(v4i*)&y, c, 0, 0, 0); }
  else return __builtin_amdgcn_mfma_f32_16x16x32_bf16(x, y, c, 0, 0, 0);
}
typedef int i32x4 __attribute__((ext_vector_type(4)));
template <bool I8> struct G8Acc { typedef f32x4 T; };
template <> struct G8Acc<true> { typedef i32x4 T; };
template <bool I8, class Sched, class Epi>
__device__ __forceinline__ void gemm8_phase(char* lds_g, const char* Abase, const int Kb, const Sched& S, const Epi& E) {
    typedef typename G8Acc<I8>::T ACC;
    LAS3 unsigned char* lds = (LAS3 unsigned char*)lds_g;
    const int tid = ltid(), wid = __builtin_amdgcn_readfirstlane(tid >> 6), lane = tid & 63, wr = wid >> 2, wc = wid & 3, fr = lane & 15, fq = lane >> 4;
    const int nt = Kb / 128;
    int sRr[2], sCc[2]; unsigned voffB[2];
#pragma unroll
    for (int i = 0; i < 2; ++i) { g8_stage_rc(tid * 16 + i * 8192, sRr[i], sCc[i]); const int Rb = (sRr[i] & ~31) + g8_perm32(sRr[i] & 31); voffB[i] = (unsigned)(Rb * Kb) + (unsigned)sCc[i] * 2u; }
    const size_t kstep = 128;
    const size_t hstepB = (size_t)128 * Kb;
    const unsigned ldsw = (unsigned)wid * 1024u;
    const int aoff = g8_lds_byte(wr * 64 + fr, fq * 8), boff = g8_lds_byte(wc * 32 + fr, fq * 8);
#define G8_SA(b, h) (((b) * 2 + (h)) * G8_HTB)
#define G8_SB(b, h) ((4 + (b) * 2 + (h)) * G8_HTB)
#define G8_STAGE_B(bufoff, gbase) do { _Pragma("unroll") for (int _i = 0; _i < 2; ++_i) \
        __builtin_amdgcn_global_load_lds((const unsigned*)((const char*)(gbase) + voffB[_i]), (LAS3 unsigned*)(lds + (bufoff) + ldsw + _i * 8192), 16, 0, 0); } while (0)
#define G8_STAGE_A(bufoff, o0, o1) do { \
        __builtin_amdgcn_global_load_lds((const unsigned*)(Abase + (o0)), (LAS3 unsigned*)(lds + (bufoff) + ldsw), 16, 0, 0); \
        __builtin_amdgcn_global_load_lds((const unsigned*)(Abase + (o1)), (LAS3 unsigned*)(lds + (bufoff) + ldsw + 8192), 16, 0, 0); } while (0)
#define G8_LDA(dst, b, h) do { _Pragma("unroll") for (int m = 0; m < 4; ++m) _Pragma("unroll") for (int k = 0; k < 2; ++k) dst[m][k] = *(const LAS3 bf16x8*)(lds + G8_SA(b, h) + aoff + m * 2048 + k * 1024); } while (0)
#define G8_LDB(dst, b, h) do { _Pragma("unroll") for (int n = 0; n < 2; ++n) _Pragma("unroll") for (int k = 0; k < 2; ++k) dst[n][k] = *(const LAS3 bf16x8*)(lds + G8_SB(b, h) + boff + n * 2048 + k * 1024); } while (0)
#define G8_MMA(ai, bj, At, Bt) do { __builtin_amdgcn_s_setprio(1); _Pragma("unroll") for (int m = 0; m < 4; ++m) _Pragma("unroll") for (int n = 0; n < 2; ++n) _Pragma("unroll") for (int k = 0; k < 2; ++k) \
        acc[ai][bj][m][n] = g8_mma<I8>(Bt[n][k], At[m][k], acc[ai][bj][m][n]); __builtin_amdgcn_s_setprio(0); } while (0)
#define G8_WAIT_V(n) asm volatile("s_waitcnt vmcnt(" #n ")" ::: "memory")
#define G8_WAIT_L(n) asm volatile("s_waitcnt lgkmcnt(" #n ")" ::: "memory")
#define G8_BAR __builtin_amdgcn_s_barrier()
#define G8_SCHED __builtin_amdgcn_sched_barrier(0)
    G8Unit cur, nxt, nn; int ui = 0;
    cur.e = 0; cur.pre = 0; cur.ab = 0;
    if (!S.next(0, cur, cur)) return;
    ACC acc[2][2][4][2];
#pragma unroll
    for (int a = 0; a < 2; ++a)
#pragma unroll
        for (int b = 0; b < 2; ++b)
#pragma unroll
            for (int m = 0; m < 4; ++m)
#pragma unroll
                for (int n = 0; n < 2; ++n) acc[a][b][m][n] = ACC{};
    bf16x8 At[4][2], B0[2][2], B1[2][2];
    float ep[8];
    unsigned va[2][2], vn[2][2];
#pragma unroll
    for (int h = 0; h < 2; ++h)
#pragma unroll
        for (int i = 0; i < 2; ++i) va[h][i] = S.a_off(cur, h * 128 + sRr[i]) + (unsigned)sCc[i] * 2u;
    const char* cB = S.b_ptr(cur);
    G8_STAGE_B(G8_SB(0, 0), cB); G8_STAGE_A(G8_SA(0, 0), va[0][0], va[0][1]); G8_STAGE_B(G8_SB(0, 1), cB + hstepB); G8_STAGE_A(G8_SA(0, 1), va[1][0], va[1][1]);
    if (wr == 1) G8_BAR;
    G8_WAIT_V(4); G8_BAR;
    G8_STAGE_B(G8_SB(1, 0), cB + kstep); G8_STAGE_A(G8_SA(1, 0), va[0][0] + kstep, va[0][1] + kstep); G8_STAGE_B(G8_SB(1, 1), cB + hstepB + kstep);
    G8_WAIT_V(6); G8_BAR;
    bool has_next = S.next(1, nxt, cur);
    const char* nB = cB;
#pragma unroll
    for (int h = 0; h < 2; ++h)
#pragma unroll
        for (int i = 0; i < 2; ++i) vn[h][i] = va[h][i];
    if (has_next) {
        nB = S.b_ptr(nxt);
#pragma unroll
        for (int h = 0; h < 2; ++h)
#pragma unroll
            for (int i = 0; i < 2; ++i) vn[h][i] = S.a_off(nxt, h * 128 + sRr[i]) + (unsigned)sCc[i] * 2u;
    }
    for (;;) {
        float* cb = (float*)(lds_g + 136192 + (ui & 1) * 2048);
        E.pre(cur, wr, fr, ep, cb);
#pragma unroll 1
        for (int t = 0; t < nt; t += 2) {
            const bool last = (t == nt - 2);
            const unsigned k1 = (unsigned)(t + 1) * 128u;
            const unsigned k2 = last ? 0u : (unsigned)(t + 2) * 128u;
            const unsigned a2_00 = (last ? vn[0][0] : va[0][0]) + k2, a2_01 = (last ? vn[0][1] : va[0][1]) + k2;
            const unsigned a2_10 = (last ? vn[1][0] : va[1][0]) + k2, a2_11 = (last ? vn[1][1] : va[1][1]) + k2;
            const char* b2 = (last ? nB : cB) + k2; const char* b3 = b2 + kstep;
            G8_LDB(B0, 0, 0); G8_SCHED; G8_LDA(At, 0, 0); G8_STAGE_A(G8_SA(1, 1), va[1][0] + k1, va[1][1] + k1);
            G8_WAIT_L(8); G8_BAR; G8_WAIT_L(0); G8_MMA(0, 0, At, B0); G8_BAR; G8_SCHED;
            G8_LDB(B1, 0, 1); G8_STAGE_B(G8_SB(0, 0), b2);
            G8_BAR; G8_WAIT_L(0); G8_MMA(0, 1, At, B1); G8_BAR;
            G8_LDA(At, 0, 1); G8_STAGE_A(G8_SA(0, 0), a2_00, a2_01);
            G8_BAR; G8_WAIT_L(0); G8_MMA(1, 0, At, B0); G8_BAR; G8_SCHED;
            G8_STAGE_B(G8_SB(0, 1), b2 + hstepB);
            G8_WAIT_V(6);
            asm volatile("" :: "v"(ep[0]), "v"(ep[1]), "v"(ep[2]), "v"(ep[3]), "v"(ep[4]), "v"(ep[5]), "v"(ep[6]), "v"(ep[7]));
            G8_BAR; G8_MMA(1, 1, At, B1); G8_BAR;
            G8_LDB(B0, 1, 0); G8_SCHED; G8_LDA(At, 1, 0); G8_STAGE_A(G8_SA(0, 1), a2_10, a2_11);
            G8_WAIT_L(8); G8_BAR; G8_WAIT_L(0); G8_MMA(0, 0, At, B0); G8_BAR; G8_SCHED;
            G8_LDB(B1, 1, 1); G8_STAGE_B(G8_SB(1, 0), b3);
            G8_BAR; G8_WAIT_L(0); G8_MMA(0, 1, At, B1); G8_BAR;
            G8_LDA(At, 1, 1); G8_STAGE_A(G8_SA(1, 0), a2_00 + 128u, a2_01 + 128u);
            G8_BAR; G8_WAIT_L(0); G8_MMA(1, 0, At, B0); G8_BAR; G8_SCHED;
            G8_STAGE_B(G8_SB(1, 1), b3 + hstepB);
            G8_WAIT_V(6); G8_BAR; G8_MMA(1, 1, At, B1); G8_BAR;
        }
        bool has_nn = false; int raw[2][2] = {{0, 0}, {0, 0}};
        if (has_next) {
            has_nn = S.next(ui + 2, nn, nxt);
            if (has_nn) {
#pragma unroll
                for (int h = 0; h < 2; ++h)
#pragma unroll
                    for (int i = 0; i < 2; ++i) raw[h][i] = S.a_row(nn, h * 128 + sRr[i]);
            }
        }
        E(acc, cur, wr, wc, fr, fq, ep, cb);
        if (!has_next) break;
#pragma unroll
        for (int a = 0; a < 2; ++a)
#pragma unroll
            for (int b = 0; b < 2; ++b)
#pragma unroll
                for (int m = 0; m < 4; ++m)
#pragma unroll
                    for (int n = 0; n < 2; ++n) acc[a][b][m][n] = ACC{};
        cur = nxt; cB = nB; ++ui;
#pragma unroll
        for (int h = 0; h < 2; ++h)
#pragma unroll
            for (int i = 0; i < 2; ++i) va[h][i] = vn[h][i];
        has_next = has_nn;
        if (has_nn) {
            nxt = nn; nB = S.b_ptr(nn);
#pragma unroll
            for (int h = 0; h < 2; ++h)
#pragma unroll
                for (int i = 0; i < 2; ++i) { asm volatile("" : "+v"(raw[h][i]));
                    vn[h][i] = (unsigned)raw[h][i] * (unsigned)Kb + (unsigned)sCc[i] * 2u; }
        }
    }
    G8_WAIT_V(0);
    if (wr == 0) G8_BAR;
    G8_BAR;
#undef G8_SA
#undef G8_SB
#undef G8_STAGE_A
#undef G8_STAGE_B
#undef G8_LDA
#undef G8_LDB
#undef G8_MMA
#undef G8_WAIT_V
#undef G8_WAIT_L
#undef G8_BAR
#undef G8_SCHED
}
struct G8Plain {
    int nM, nN, Kb, G, c; const char* Bt;
    __device__ __forceinline__ bool next(int i, G8Unit& u, const G8Unit&) const {
        const int L = (i * 8 + (c & 7)) * (G >> 3) + (c >> 3); if (L >= nM * nN) return false;
        const int nig = 8 * nN, gid = L / nig, fm = gid * 8, gsz = (nM - fm) < 8 ? (nM - fm) : 8;
        u.pm = fm + ((L % nig) % gsz); u.pn = (L % nig) / gsz; u.e = 0; u.ce = 256; u.pre = 0; return true;
    }
    __device__ __forceinline__ int a_row(const G8Unit& u, int row) const { return u.pm * 256 + row; }
    __device__ __forceinline__ unsigned a_off(const G8Unit& u, int row) const { return (unsigned)a_row(u, row) * (unsigned)Kb; }
    __device__ __forceinline__ const char* b_ptr(const G8Unit& u) const { return Bt + (size_t)u.pn * 256 * Kb; }
};

__device__ __forceinline__ const float* resid_row_in(const Params& p, int tok) {
  return tok < TL ? p.x() + (size_t)tok * DM : p.ctx() + (size_t)(tok - TL) * DM;
}
__device__ __forceinline__ void load_row_comb(const Params& p, int src_layer, int lc, int tok, int lane, const int* pre  , float (&v)[16]) {
  if (src_layer == 0) {
    const float* r = resid_row_in(p, tok);
#pragma unroll
    for (int i = 0; i < 4; ++i) { const float4 a = *(const float4*)(r + lane * 4 + i * 256); v[4 * i] = a.x; v[4 * i + 1] = a.y; v[4 * i + 2] = a.z; v[4 * i + 3] = a.w; }
  } else {
    const u16* r = p.X() + (size_t)tok * DM;
#pragma unroll
    for (int i = 0; i < 4; ++i) { const float4 a = ld4bf(r + lane * 4 + i * 256); v[4 * i] = a.x; v[4 * i + 1] = a.y; v[4 * i + 2] = a.z; v[4 * i + 3] = a.w; }
  }
  if (lc >= 0) {
    const float* g2 = p.mod() + ((size_t)lc * 3 + modv(tok)) * 6144 + 5 * DM;
    float s[16];
#pragma unroll
    for (int i = 0; i < 16; ++i) s[i] = 0.f;
#pragma unroll
    for (int k = 0; k < TOPK; ++k) {
      const int sl = p.tslot()[tok * 4 + k];
      const size_t arow = (size_t)(pre[sl >> 20] + (sl & 0xFFFFF));
      const unsigned char* y = p.yd() + arow * DM;
#pragma unroll
      for (int i = 0; i < 4; ++i) {
        const int w = *(const int*)(y + lane * 4 + i * 256);
        const auto lo = __builtin_amdgcn_cvt_pk_f32_fp8(w, false), hi2 = __builtin_amdgcn_cvt_pk_f32_fp8(w, true);
        s[4 * i] += lo[0]; s[4 * i + 1] += lo[1]; s[4 * i + 2] += hi2[0]; s[4 * i + 3] += hi2[1];
      }
    }
#pragma unroll
    for (int i = 0; i < 4; ++i) {
      const float4 g = *(const float4*)(g2 + lane * 4 + i * 256);
      v[4 * i] += g.x * 0.125f * s[4 * i]; v[4 * i + 1] += g.y * 0.125f * s[4 * i + 1]; v[4 * i + 2] += g.z * 0.125f * s[4 * i + 2]; v[4 * i + 3] += g.w * 0.125f * s[4 * i + 3];
    }
  }
}
__device__ __forceinline__ void expert_prefix(const int* cnt, int* pre) {
  if (ltid() == 0) { int s = 0; for (int e = 0; e < NE; ++e) { pre[e] = s; s += cnt[e]; } pre[NE] = s; }
}

__device__ __forceinline__ float store_row_i8(const float (&y)[16], signed char* __restrict__ h, float* __restrict__ hs_row, int lane) {
  float am = 0.f;
#pragma unroll
  for (int i = 0; i < 16; ++i) am = fmaxf(am, fabsf(y[i]));
  am = wave_max(am);
  const float s = fmaxf(am, 1e-20f) * (1.f / 127.f), inv = 1.f / s;
#pragma unroll
  for (int i = 0; i < 4; ++i) {
    const int q0 = (int)rintf(y[4 * i] * inv), q1 = (int)rintf(y[4 * i + 1] * inv), q2 = (int)rintf(y[4 * i + 2] * inv), q3 = (int)rintf(y[4 * i + 3] * inv);
    *(unsigned*)(h + lane * 4 + i * 256) = (unsigned)(q0 & 255) | ((unsigned)(q1 & 255) << 8) | ((unsigned)(q2 & 255) << 16) | ((unsigned)(q3 & 255) << 24);
  }
  if (lane == 0) *hs_row = s;
  return s;
}
__device__ __forceinline__ void phase_quant_in(const Params& p, int bid, int nb) {
  const int wid = ltid() >> 6, lane = ltid() & 63;
  for (int r = bid * 8 + wid; r < 2 * NIN; r += nb * 8) {
    const float* src = p.btf() + (size_t)r * DM;
    float y[16];
#pragma unroll
    for (int i = 0; i < 4; ++i) { const float4 a = *(const float4*)(src + lane * 4 + i * 256); y[4 * i] = a.x; y[4 * i + 1] = a.y; y[4 * i + 2] = a.z; y[4 * i + 3] = a.w; }
    store_row_i8(y, p.bt_in() + (size_t)r * DM, p.swin() + r, lane);
  }
}
__device__ __forceinline__ void phase_norm1(const Params& p, int layer, int bid, int nb, char* lds) {
  int* pre = (int*)lds;
  const int lc = layer - 1;
  if (lc >= 0) { expert_prefix(p.cnt() + lc * NE, pre); __syncthreads(); }
  const int wid = ltid() >> 6, lane = ltid() & 63;
  const float* gn = p.norm1_g() + layer * DM;
  const int ntok = TT;
  for (int tok = bid * 8 + wid; tok < ntok; tok += nb * 8) {
    float v[16];
    load_row_comb(p, layer == 0 ? 0 : 1, lc, tok, lane, pre, v);
    if (lc >= 0) {
      u16* xr = p.X() + (size_t)tok * DM;
#pragma unroll
      for (int i = 0; i < 4; ++i) *(u32x2*)(xr + lane * 4 + i * 256) = u32x2{cvtpk(v[4 * i], v[4 * i + 1]), cvtpk(v[4 * i + 2], v[4 * i + 3])};
    }
    float ss = 0;
#pragma unroll
    for (int i = 0; i < 16; ++i) ss += v[i] * v[i];
    ss = wave_sum(ss);
    const float rs = rsqrtf(ss * (1.f / DM) + EPS);
    const float* md = p.mod() + ((size_t)layer * 3 + modv(tok)) * 6144;
#pragma unroll
    for (int i = 0; i < 4; ++i) {
      const int c = lane * 4 + i * 256;
      const float4 g = *(const float4*)(gn + c), sh = *(const float4*)(md + c), sc = *(const float4*)(md + DM + c);
      v[4 * i] = v[4 * i] * rs * g.x * (1.f + sc.x) + sh.x; v[4 * i + 1] = v[4 * i + 1] * rs * g.y * (1.f + sc.y) + sh.y;
      v[4 * i + 2] = v[4 * i + 2] * rs * g.z * (1.f + sc.z) + sh.z; v[4 * i + 3] = v[4 * i + 3] * rs * g.w * (1.f + sc.w) + sh.w;
    }
    store_row_i8(v, p.H() + (size_t)tok * DM, p.hs() + tok, lane);
  }
}

struct EpiIn {
  u16* zqkv; u16* zg; u16* zt; const float* hs; const float* sw;
  __device__ __forceinline__ void pre(const G8Unit& u, int wr, int fr, float (&ep)[8], float* cb) const {
    if ((ltid() >> 6) == 0) g8_cload(sw + u.pn * 256, cb);
#pragma unroll
    for (int ai = 0; ai < 2; ++ai)
#pragma unroll
      for (int m = 0; m < 4; ++m) ep[ai * 4 + m] = hs[u.pm * 256 + ai * 128 + wr * 64 + m * 16 + fr];
  }
  __device__ __forceinline__ void operator()(const i32x4 (&acc)[2][2][4][2], const G8Unit& u, int wr, int wc, int fr, int fq, const float (&ep)[8], const float* cb) const {
#pragma unroll
    for (int bj = 0; bj < 2; ++bj) {
      const int c32 = u.pn * 256 + bj * 128 + wc * 32, c0 = c32 + 8 * fq;
      const f32x4 w0 = *(const f32x4*)(cb + bj * 128 + wc * 32 + 8 * fq), w1 = *(const f32x4*)(cb + bj * 128 + wc * 32 + 8 * fq + 4);
#pragma unroll
      for (int ai = 0; ai < 2; ++ai)
#pragma unroll
        for (int m = 0; m < 4; ++m) {
          const int row = u.pm * 256 + ai * 128 + wr * 64 + m * 16 + fr;
          f32x4 a, b;
#pragma unroll
          for (int j = 0; j < 4; ++j) { a[j] = (float)acc[ai][bj][m][0][j] * ep[ai * 4 + m] * w0[j]; b[j] = (float)acc[ai][bj][m][1][j] * ep[ai * 4 + m] * w1[j]; }
          if (c32 < 384) {
            *(u32x4*)(zqkv + (size_t)row * 384 + c0) = u32x4{cvtpk(a[0], a[1]), cvtpk(a[2], a[3]), cvtpk(b[0], b[1]), cvtpk(b[2], b[3])};
          } else if (c32 < 1536) {
            *(u32x4*)(zg + (size_t)row * ZG_W + (c0 - 384)) = u32x4{cvtpk(a[0], a[1]), cvtpk(a[2], a[3]), cvtpk(b[0], b[1]), cvtpk(b[2], b[3])};
          } else {
#pragma unroll
            for (int j = 0; j < 4; ++j) { zt[(size_t)(c0 - 1536 + j) * TT + row] = f2bf(a[j]); zt[(size_t)(c0 - 1536 + 4 + j) * TT + row] = f2bf(b[j]); }
          }
        }
    }
  }
};
__device__ __forceinline__ void phase_gemm_in(const Params& p, int layer, int bid, int nb, char* lds) {
  G8Plain S; S.nM = TT / 256; S.nN = NIN / 256; S.Kb = DM; S.G = nb; S.c = bid; S.Bt = (const char*)(p.bt_in() + (size_t)layer * NIN * DM);
  EpiIn E; E.zqkv = p.zqkv(); E.zg = p.zg(); E.zt = p.zt(); E.hs = p.hs(); E.sw = p.swin() + layer * NIN;
  gemm8_phase<true>(lds, (const char*)p.H(), DM, S, E);
}

__device__ __forceinline__ size_t qkv_row(int tok, int h) {
  const int b = tok < TL ? (tok >> 14) : ((tok - TL) >> 8);
  const int s = tok < TL ? (tok & (SEQ - 1)) : SEQ + ((tok - TL) & (LC - 1));
  return ((size_t)(b * 4 + h)) * SKV + s;
}
struct EpiQkv {
  const u16* zqkv; u16* Q; u16* KV; const float* ropec; const float* ropes; float* rsl;
  unsigned* kmx;
  __device__ __forceinline__ void pre(const G8Unit&, int, int, float (&)[8], float*) const {}
  __device__ __forceinline__ void operator()(const f32x4 (&acc)[2][2][4][2], const G8Unit& u, int wr, int wc, int fr, int fq, const float (&)[8], const float*) const {
    const int tid = ltid();
    {
      const int r = tid >> 1, half = tid & 1;
      const u16* row = zqkv + (size_t)(u.pm * 256 + r) * 384;
      float sq = 0, sk = 0;
#pragma unroll
      for (int i = 0; i < 16; ++i) {
        const u32x4 w = *(const u32x4*)(row + half * 128 + i * 8);
#pragma unroll
        for (int q = 0; q < 4; ++q) { const float a = __uint_as_float(w[q] << 16), b = __uint_as_float(w[q] & 0xFFFF0000u); sq += a * a + b * b; }
      }
#pragma unroll
      for (int i = 0; i < 8; ++i) {
        const u32x4 w = *(const u32x4*)(row + 256 + half * 64 + i * 8);
#pragma unroll
        for (int q = 0; q < 4; ++q) { const float a = __uint_as_float(w[q] << 16), b = __uint_as_float(w[q] & 0xFFFF0000u); sk += a * a + b * b; }
      }
      sq += shx<1>(sq); sk += shx<1>(sk);
      if (half == 0) { rsl[r] = rsqrtf(sq * (1.f / 256.f) + EPS); rsl[256 + r] = rsqrtf(sk * (1.f / 128.f) + EPS); }
    }
    asm volatile("s_waitcnt lgkmcnt(0)" ::: "memory"); __builtin_amdgcn_s_barrier(); __builtin_amdgcn_s_barrier(); asm volatile("" ::: "memory");
    const float* rsp = rsl + (u.pn >= 2 ? 256 : 0);
#pragma unroll
    for (int ai = 0; ai < 2; ++ai)
#pragma unroll
      for (int m = 0; m < 4; ++m) {
        const int rl = ai * 128 + wr * 64 + m * 16 + fr, tok = u.pm * 256 + rl;
        const float rs = rsp[rl] * (u.pn < 2 ? A_QSCALE : 1.f);
        if (u.pn == 1) {
          f32x4 a = acc[ai][0][m][0] * rs, b = acc[ai][0][m][1] * rs;
          f32x4 pa, pb;
#pragma unroll
          for (int j = 0; j < 4; ++j) { pa[j] = shx<32>(a[j]); pb[j] = shx<32>(b[j]); }
          f32x4 ca = {1.f, 1.f, 1.f, 1.f}, cb = ca, sa = {0.f, 0.f, 0.f, 0.f}, sb = sa;
          if (tok < TL) {
            const float* cp = ropec + (size_t)(tok & (SEQ - 1)) * 16 + 8 * (fq & 1); const float* sp = ropes + (size_t)(tok & (SEQ - 1)) * 16 + 8 * (fq & 1);
            ca = *(const f32x4*)cp; cb = *(const f32x4*)(cp + 4); sa = *(const f32x4*)sp; sb = *(const f32x4*)(sp + 4);
          }
          const float sg = fq < 2 ? -1.f : 1.f;
          a = a * ca + pa * sa * sg; b = b * cb + pb * sb * sg;
          *(u32x4*)(Q + qkv_row(tok, wc) * 96 + 64 + 8 * fq) = u32x4{cvtpk(a[0], a[1]), cvtpk(a[2], a[3]), cvtpk(b[0], b[1]), cvtpk(b[2], b[3])};
        } else {
#pragma unroll
          for (int bj = 0; bj < 2; ++bj) {
            const int c = bj * 128 + wc * 32 + 8 * fq, h = c >> 6, d = c & 63;
            const f32x4 a = acc[ai][bj][m][0] * rs, b = acc[ai][bj][m][1] * rs;
            u16* dst = u.pn == 0 ? Q + qkv_row(tok, h) * 96 + d : KV + qkv_row(tok, h) * 160 + (u.pn == 2 ? 0 : 96) + d;
            *(u32x4*)dst = u32x4{cvtpk(a[0], a[1]), cvtpk(a[2], a[3]), cvtpk(b[0], b[1]), cvtpk(b[2], b[3])};
          }
        }
      }
    if (u.pn == 2) {
      const int b = u.pm * 256 < TL ? (u.pm * 256) >> 14 : (u.pm * 256 - TL) >> 8;
#pragma unroll
      for (int bj = 0; bj < 2; ++bj) {
        float mx = 0.f;
#pragma unroll
        for (int ai = 0; ai < 2; ++ai)
#pragma unroll
          for (int m = 0; m < 4; ++m) {
            const float rs = rsp[ai * 128 + wr * 64 + m * 16 + fr];
            const f32x4 a = acc[ai][bj][m][0] * rs, b4 = acc[ai][bj][m][1] * rs;
            float ss = a[0] * a[0] + a[1] * a[1] + a[2] * a[2] + a[3] * a[3] + b4[0] * b4[0] + b4[1] * b4[1] + b4[2] * b4[2] + b4[3] * b4[3];
            ss += shx<16>(ss); ss += shx<32>(ss);
            mx = fmaxf(mx, ss);
          }
        mx = fmaxf(mx, shx<8>(mx)); mx = fmaxf(mx, shx<4>(mx)); mx = fmaxf(mx, shx<2>(mx)); mx = fmaxf(mx, shx<1>(mx));
        if ((ltid() & 63) == 0) atomicMax(kmx + (b * 4 + bj * 2 + (wc >> 1)) * 4 + (wc & 1), __float_as_uint(mx));
      }
    }
  }
};
__device__ __forceinline__ void phase_qkv(const Params& p, int layer, int bid, int nb, char* lds) {
  const int tid = ltid();
  {
    G8Plain S; S.nM = TT / 256; S.nN = 4; S.Kb = 768; S.G = nb; S.c = bid; S.Bt = (const char*)(p.bt_qkv() + (size_t)layer * 1024 * 384);
    EpiQkv E; E.zqkv = p.zqkv(); E.Q = p.Q(); E.KV = p.KV(); E.ropec = p.ropec(); E.ropes = p.ropes(); E.rsl = (float*)(lds + 131072); E.kmx = p.kmx() + layer * 32;
    gemm8_phase<false>(lds, (const char*)p.zqkv(), 768, S, E);
  }
  float krm0 = 0.f, krm1 = 0.f;
  for (int i = bid * NTHR + tid; i < TT * 16; i += nb * NTHR) {
    const int tok = i >> 4, f = i & 15;
    const float x1 = bf2f(p.zg()[(size_t)tok * ZG_W + ZG_KR + f]), x2 = bf2f(p.zg()[(size_t)tok * ZG_W + ZG_KR + 16 + f]);
    float cs = 1.f, sn = 0.f;
    if (tok < TL) { const int tpos = tok & (SEQ - 1); cs = p.ropec()[tpos * 16 + f]; sn = p.ropes()[tpos * 16 + f]; }
    const float y1 = x1 * cs - x2 * sn, y2 = x2 * cs + x1 * sn;
    const u16 o1 = f2bf(y1), o2 = f2bf(y2);
#pragma unroll
    for (int h = 0; h < 4; ++h) { u16* kv = p.KV() + qkv_row(tok, h) * 160 + 64; kv[f] = o1; kv[16 + f] = o2; }
    float ss = y1 * y1 + y2 * y2;
    ss += shx<8>(ss); ss += shx<4>(ss); ss += shx<2>(ss); ss += shx<1>(ss);
    const int b = tok < TL ? (tok >> 14) : ((tok - TL) >> 8);
    if (b == 0) krm0 = fmaxf(krm0, ss); else krm1 = fmaxf(krm1, ss);
  }
  krm0 = wave_max(krm0); krm1 = wave_max(krm1);
  if ((tid & 63) == 0) { atomicMax(p.kmx() + layer * 32 + 0 * 16 + 2, __float_as_uint(krm0)); atomicMax(p.kmx() + layer * 32 + 1 * 16 + 2, __float_as_uint(krm1)); }
}

constexpr int A_KROW = 208;
constexpr int A_TV = 128 * 64 * 2;
constexpr int A_TK = 128 * A_KROW;
constexpr int A_BUF = A_TV + A_TK;
constexpr int A_OFF_W = 3 * A_BUF;
constexpr int ATTN_LDS = A_OFF_W + 8 * 64 * 4;
#define SBAR() __builtin_amdgcn_sched_barrier(0)
__device__ __forceinline__ int crow(int r, int hi) { return (r & 3) + 8 * (r >> 2) + 4 * hi; }

__device__ __forceinline__ void a_partialSM(f32x16& p0) {
#pragma unroll
  for (int r = 0; r < 16; ++r) p0[r] = __builtin_amdgcn_exp2f(p0[r]);
}
__device__ __forceinline__ void a_finishSM(f32x16& p0, f32x16& p1, bf16x8& pa0, bf16x8& pa1, bf16x8& pa2, bf16x8& pa3) {
#pragma unroll
  for (int r = 0; r < 16; ++r) p1[r] = __builtin_amdgcn_exp2f(p1[r]);
#define PK4(P, BASE, OUT) do { unsigned a0 = cvtpk(P[BASE + 0], P[BASE + 1]), a1 = cvtpk(P[BASE + 2], P[BASE + 3]);   \
    unsigned b0 = cvtpk(P[BASE + 4], P[BASE + 5]), b1 = cvtpk(P[BASE + 6], P[BASE + 7]);                              \
    auto r0 = __builtin_amdgcn_permlane32_swap(a0, b0, false, false); auto r1 = __builtin_amdgcn_permlane32_swap(a1, b1, false, false); \
    u32x4 w = {r0[0], r1[0], r0[1], r1[1]}; OUT = *reinterpret_cast<bf16x8*>(&w); } while (0)
  PK4(p0, 0, pa0); PK4(p0, 8, pa1); PK4(p1, 0, pa2); PK4(p1, 8, pa3);
#undef PK4
}
__device__ __forceinline__ void a_qkt(f32x16& p0, f32x16& p1, const char* Ks, const bf16x8* qr, const float mneg, int r32, int hi) {
#pragma unroll
  for (int r = 0; r < 16; ++r) { p0[r] = mneg; p1[r] = mneg; }
#pragma unroll
  for (int d0 = 0; d0 < 6; ++d0) {
    const int cb = (d0 * 16 + hi * 8) * 2;
    const bf16x8 b0 = *reinterpret_cast<const bf16x8*>(Ks + r32 * A_KROW + cb);
    const bf16x8 b1 = *reinterpret_cast<const bf16x8*>(Ks + (32 + r32) * A_KROW + cb);
    p0 = __builtin_amdgcn_mfma_f32_32x32x16_bf16(b0, qr[d0], p0, 0, 0, 0); p1 = __builtin_amdgcn_mfma_f32_32x32x16_bf16(b1, qr[d0], p1, 0, 0, 0);
  }
}
__device__ __forceinline__ int a_v_st(int k, int c) { const int kk = (k & ~0xC) | ((k & 4) << 1) | ((k & 8) >> 1); return ((kk >> 3) * 2 + (c >> 5)) * 512 + ((kk & 7) * 32 + (c & 31)) * 2; }
__device__ __forceinline__ int a_v_rd_base(int lane) { return ((lane & 3) << 3) | (((lane >> 2) & 3) << 6) | (((lane >> 4) & 1) << 5) | (((lane >> 5) & 1) << 8); }
constexpr int a_v_rd_off(int d0, int ks, int half) { return d0 * 512 + ks * 2048 + half * 1024; }
template <int OFF> __device__ __forceinline__ s16x4 a_tr_read(int vb) {
  s16x4 r; asm volatile("ds_read_b64_tr_b16 %0, %1 offset:%2" : "=&v"(r) : "v"(vb), "i"(OFF) : "memory"); return r;
}
template <int D0> __device__ __forceinline__ void a_pv_one(f32x16& od, int vb, bf16x8 pa0, bf16x8 pa1, bf16x8 pa2, bf16x8 pa3) {
  const s16x4 l0 = a_tr_read<a_v_rd_off(D0, 0, 0)>(vb), h0 = a_tr_read<a_v_rd_off(D0, 0, 1)>(vb), l1 = a_tr_read<a_v_rd_off(D0, 1, 0)>(vb), h1 = a_tr_read<a_v_rd_off(D0, 1, 1)>(vb);
  const s16x4 l2 = a_tr_read<a_v_rd_off(D0, 2, 0)>(vb), h2 = a_tr_read<a_v_rd_off(D0, 2, 1)>(vb), l3 = a_tr_read<a_v_rd_off(D0, 3, 0)>(vb), h3 = a_tr_read<a_v_rd_off(D0, 3, 1)>(vb);
  asm volatile("s_waitcnt lgkmcnt(0)" ::: "memory"); SBAR();
#define PK(L, H) (bf16x8){L[0], L[1], L[2], L[3], H[0], H[1], H[2], H[3]}
  od = __builtin_amdgcn_mfma_f32_32x32x16_bf16(pa0, PK(l0, h0), od, 0, 0, 0);
  od = __builtin_amdgcn_mfma_f32_32x32x16_bf16(pa1, PK(l1, h1), od, 0, 0, 0);
  od = __builtin_amdgcn_mfma_f32_32x32x16_bf16(pa2, PK(l2, h2), od, 0, 0, 0);
  od = __builtin_amdgcn_mfma_f32_32x32x16_bf16(pa3, PK(l3, h3), od, 0, 0, 0);
#undef PK
}
__device__ __forceinline__ void a_pv(f32x16* o, int vb, bf16x8 pa0, bf16x8 pa1, bf16x8 pa2, bf16x8 pa3) {
  a_pv_one<0>(o[0], vb, pa0, pa1, pa2, pa3);
  { const bf16x8 ones = {0x3F80, 0x3F80, 0x3F80, 0x3F80, 0x3F80, 0x3F80, 0x3F80, 0x3F80};
    o[2] = __builtin_amdgcn_mfma_f32_32x32x16_bf16(pa0, ones, o[2], 0, 0, 0); o[2] = __builtin_amdgcn_mfma_f32_32x32x16_bf16(pa1, ones, o[2], 0, 0, 0);
    o[2] = __builtin_amdgcn_mfma_f32_32x32x16_bf16(pa2, ones, o[2], 0, 0, 0); o[2] = __builtin_amdgcn_mfma_f32_32x32x16_bf16(pa3, ones, o[2], 0, 0, 0); }
  a_pv_one<1>(o[1], vb, pa0, pa1, pa2, pa3);
}

__device__ __forceinline__ void attn_item(const u16* __restrict__ Qb, const u16* __restrict__ KVh, int seq, float kmax, u16* __restrict__ yout  , char* lds) {
  const int tid = ltid(), wid = tid >> 6, lane = tid & 63, r32 = lane & 31, hi = lane >> 5;
  f32x16 o[3] = {}; bf16x8 qr[6];
  const u16* Qw = Qb + (size_t)(wid * 32 + r32) * 96 + hi * 8;
#pragma unroll
  for (int d0 = 0; d0 < 6; ++d0) qr[d0] = *reinterpret_cast<const bf16x8*>(Qw + d0 * 16);
  float mneg;
  {
    float ss = 0.f;
#pragma unroll
    for (int d0 = 0; d0 < 6; ++d0)
#pragma unroll
      for (int j = 0; j < 8; ++j) { const float v = bf2f((u16)qr[d0][j]); ss += v * v; }
    ss += shx<32>(ss);
    mneg = -sqrtf(ss) * kmax;
  }
  int lw[5];
#pragma unroll
  for (int i = 0; i < 5; ++i) {
    const int g = tid + i * 512, key = g / 20, cc = g % 20;
    lw[i] = cc < 12 ? (A_TV + key * A_KROW + cc * 16) : ((key >> 6) * 8192 + a_v_st(key & 63, (cc - 12) * 8));
  }
  const int vrb = (int)(uintptr_t)lds + a_v_rd_base(lane);
  bf16x8 sg[5];
  const char* gsrc = (const char*)KVh + tid * 16;
#define SLOAD(t) do { const char* s_ = gsrc + (size_t)(t) * 40960; _Pragma("unroll") for (int i = 0; i < 5; ++i) sg[i] = *(const bf16x8*)(s_ + i * 8192); } while (0)
#define SWRITE(bo_) do { _Pragma("unroll") for (int i = 0; i < 5; ++i) *(bf16x8*)(lds + (bo_) + lw[i]) = sg[i]; } while (0)
  f32x16 pA0, pA1, pB0, pB1; bf16x8 pa0, pa1, pa2, pa3; const int NT = seq / 128;
  SLOAD(0); SWRITE(0); if (1 < NT) SLOAD(1);
  __syncthreads();
  int bo = 0;
  {
    if (1 < NT) { SWRITE(A_BUF); if (2 < NT) SLOAD(2); }
    SBAR(); a_qkt(pA0, pA1, lds + bo + A_TV, qr, mneg, r32, hi); a_partialSM(pA0);
    SBAR(); a_qkt(pB0, pB1, lds + bo + A_TV + 64 * A_KROW, qr, mneg, r32, hi);
    a_finishSM(pA0, pA1, pa0, pa1, pa2, pa3); SBAR();
    a_pv(o, vrb + bo, pa0, pa1, pa2, pa3); a_partialSM(pB0);
    __syncthreads();
  }
  for (int t = 1; t < NT; ++t) {
    const int bp = bo;
    bo = bo + A_BUF; if (bo == 3 * A_BUF) bo = 0;
    int bn = bo + A_BUF; if (bn == 3 * A_BUF) bn = 0;
    if (t + 1 < NT) { SWRITE(bn); if (t + 2 < NT) SLOAD(t + 2); }
    SBAR(); a_qkt(pA0, pA1, lds + bo + A_TV, qr, mneg, r32, hi);
    a_finishSM(pB0, pB1, pa0, pa1, pa2, pa3); SBAR();
    a_pv(o, vrb + bp + 8192, pa0, pa1, pa2, pa3); a_partialSM(pA0);
    SBAR(); a_qkt(pB0, pB1, lds + bo + A_TV + 64 * A_KROW, qr, mneg, r32, hi);
    a_finishSM(pA0, pA1, pa0, pa1, pa2, pa3); SBAR();
    a_pv(o, vrb + bo, pa0, pa1, pa2, pa3); a_partialSM(pB0);
    __syncthreads();
  }
  a_finishSM(pB0, pB1, pa0, pa1, pa2, pa3); SBAR();
  a_pv(o, vrb + bo + 8192, pa0, pa1, pa2, pa3);
#pragma unroll
  for (int r = 0; r < 16; ++r) {
    const int orow = crow(r, hi);
    const float rl = __builtin_amdgcn_rcpf(o[2][r]);
    const float v0 = o[0][r] * rl, v1 = o[1][r] * rl;
    float ss = v0 * v0 + v1 * v1;
    ss += shx<16>(ss); ss += shx<8>(ss); ss += shx<4>(ss); ss += shx<2>(ss); ss += shx<1>(ss);
    const float rs = rsqrtf(ss * (1.f / 64.f) + EPS);
    u16* dst = yout + (size_t)(wid * 32 + orow) * DM;
    dst[r32] = f2bf(v0 * rs); dst[32 + r32] = f2bf(v1 * rs);
  }
  __syncthreads();
#undef SLOAD
#undef SWRITE
}

__device__ __forceinline__ void phase_attn(const Params& p, int layer, int bid, int nb, char* lds) {
  const int nitems = 512 + (layer == 0 ? 8 : 0);
  const unsigned* kmx = p.kmx() + layer * 32;
  for (int it = bid; it < nitems; it += nb) {
    int b, h, q0, k0, seq, tok0;
    if (it < 512) { const int pair = it & 7, qb = (it >> 3); h = pair & 3; b = pair >> 2; q0 = qb * 256; k0 = 0; seq = SKV; tok0 = b * SEQ + qb * 256; }
    else { const int i2 = it - 512; h = i2 & 3; b = i2 >> 2; q0 = SEQ; k0 = SEQ; seq = LC; tok0 = TL + b * LC; }
    const size_t base = (size_t)(b * 4 + h) * SKV;
    const float k2 = __uint_as_float(kmx[(b * 4 + h) * 4 + 0]) + __uint_as_float(kmx[(b * 4 + h) * 4 + 1]) + __uint_as_float(kmx[b * 16 + 2]);
    attn_item(p.Q() + (base + q0) * 96, p.KV() + (base + k0) * 160, seq, sqrtf(k2) * 1.02f, p.ymix() + (size_t)tok0 * DM + h * 64, lds);
  }
}

__device__ __forceinline__ float hy_sconv(const u16* __restrict__ row, int t, int Ls, float w0, float w1, float w2, float bb) {
  const float zm = t > 0 ? bf2f(row[t - 1]) : 0.f, z0 = bf2f(row[t]), zp = t + 1 < Ls ? bf2f(row[t + 1]) : 0.f;
  return w0 * zm + w1 * z0 + w2 * zp + bb;
}
__device__ __forceinline__ float2 hy_sconv2(unsigned prv, unsigned cur, unsigned nxt, float w0, float w1, float w2, float bb) {
  const float zm = __uint_as_float(prv & 0xFFFF0000u), z0 = __uint_as_float(cur << 16), z1 = __uint_as_float(cur & 0xFFFF0000u), z2 = __uint_as_float(nxt << 16);
  return make_float2(w0 * zm + w1 * z0 + w2 * z1 + bb, w0 * z0 + w1 * z1 + w2 * z2 + bb);
}
__device__ __forceinline__ void hyena_item(const Params& p, int layer, int b, int ch, char* lds) {
  float2* s = (float2*)lds;
  const int tid = ltid();
  const float* cw = p.hy_conv_w() + (size_t)layer * 3 * 768; const float* cb = p.hy_conv_b() + (size_t)layer * 768;
  const unsigned* r0 = (const unsigned*)(p.zt() + (size_t)(ZT_HY + ch) * TT + (size_t)b * SEQ);
  const unsigned* r1 = (const unsigned*)(p.zt() + (size_t)(ZT_HY + 256 + ch) * TT + (size_t)b * SEQ);
  const unsigned* r2 = (const unsigned*)(p.zt() + (size_t)(ZT_HY + 512 + ch) * TT + (size_t)b * SEQ);
  const float a0 = cw[ch], a1 = cw[768 + ch], a2 = cw[1536 + ch], ab = cb[ch];
  const float b0 = cw[256 + ch], b1 = cw[768 + 256 + ch], b2 = cw[1536 + 256 + ch], bb = cb[256 + ch];
  const float c0 = cw[512 + ch], c1 = cw[768 + 512 + ch], c2 = cw[1536 + 512 + ch], cbb = cb[512 + ch];
  unsigned vgr[16], x0r[16];
#pragma unroll
  for (int hb2 = 0; hb2 < 2; ++hb2) {
    unsigned ld[8][9];
#pragma unroll
    for (int ii = 0; ii < 8; ++ii) {
      const int m = tid + 512 * (hb2 * 8 + ii);
      const int mp = m > 0 ? m - 1 : 0, mn = m + 1 < SEQ / 2 ? m + 1 : m;
      ld[ii][0] = r0[mp]; ld[ii][1] = r0[m]; ld[ii][2] = r0[mn];
      ld[ii][3] = r1[mp]; ld[ii][4] = r1[m]; ld[ii][5] = r1[mn];
      ld[ii][6] = r2[mp]; ld[ii][7] = r2[m]; ld[ii][8] = r2[mn];
    }
#pragma unroll
    for (int ii = 0; ii < 8; ++ii) {
      const int i = hb2 * 8 + ii, m = tid + 512 * i;
      const unsigned mkp = m > 0 ? 0xFFFFFFFFu : 0u, mkn = m + 1 < SEQ / 2 ? 0xFFFFFFFFu : 0u;
      const float2 ux = hy_sconv2(ld[ii][0] & mkp, ld[ii][1], ld[ii][2] & mkn, a0, a1, a2, ab);
      x0r[i] = cvtpk(ux.x, ux.y);
      const float2 u1 = hy_sconv2(ld[ii][3] & mkp, ld[ii][4], ld[ii][5] & mkn, b0, b1, b2, bb);
      const float2 uv = hy_sconv2(ld[ii][6] & mkp, ld[ii][7], ld[ii][8] & mkn, c0, c1, c2, cbb);
      const float2 vgf = make_float2(uv.x * u1.x, uv.y * u1.y);
      vgr[i] = cvtpk(vgf.x, vgf.y);
      s[swz(m)] = vgf;
      s[swz(m + SEQ / 2)] = make_float2(0.f, 0.f);
    }
  }
  __syncthreads();
  fft_fwd(s, p.tw());
  {
    const float4* hs = p.hspec() + ((size_t)layer * 256 + ch) * HSP;
    float4 hv[17];
#pragma unroll
    for (int i = 0; i < 17; ++i) { const int k = tid + 512 * i; hv[i] = hs[k <= FM / 2 ? k : 0]; }
    const float2 twl = p.tw()[tid];
#pragma unroll
    for (int i = 0; i < 17; ++i) {
      const int k = tid + 512 * i;
      if (k <= FM / 2) {
        const int pk = swz(rev7(k)), pm = swz(rev7((FM - k) & (FM - 1)));
        const float2 zk = s[pk], zm = s[pm];
        const float4 h = hv[i];
        const float2 He = make_float2(h.x, h.y), Ho = make_float2(h.z, h.w);
        const float2 Xe = make_float2(0.5f * (zk.x + zm.x), 0.5f * (zk.y - zm.y));
        const float2 Xo = make_float2(0.5f * (zk.y + zm.y), -0.5f * (zk.x - zm.x));
        const float2 twk = cmul(twl, p.tw()[512 * i]);
        const float2 t1 = cmul(twk, cmul(Xo, Ho));
        const float2 e1 = cmul(Xe, He);
        const float2 Ye = make_float2(e1.x + t1.x, e1.y + t1.y);
        const float2 o1 = cmul(Xe, Ho), o2 = cmul(Xo, He);
        const float2 Yo = make_float2(o1.x + o2.x, o1.y + o2.y);
        s[pk] = make_float2(Ye.x - Yo.y, Ye.y + Yo.x);
        if (pm != pk) s[pm] = make_float2(Ye.x + Yo.y, -Ye.y + Yo.x);
      }
    }
  }
  __syncthreads();
  fft_inv(s, p.tw());
  const float hb = p.hy_bias()[layer * 256 + ch];
  unsigned* orow = (unsigned*)(p.hyo() + (size_t)ch * TT + (size_t)b * SEQ);
#pragma unroll
  for (int i = 0; i < 16; ++i) {
    const int m = tid + 512 * i;
    const float2 y = s[swz(m)];
    orow[m] = cvtpk((y.x + __uint_as_float(vgr[i] << 16) * hb) * __uint_as_float(x0r[i] << 16), (y.y + __uint_as_float(vgr[i] & 0xFFFF0000u) * hb) * __uint_as_float(x0r[i] & 0xFFFF0000u));
  }
  __syncthreads();
}
__device__ __forceinline__ void fnet_item(const Params& p, int b, int j, char* lds) {
  float2* s = (float2*)lds;
  const int tid = ltid();
  const u16* rr = p.zt() + (size_t)(ZT_FR + j) * TT + (size_t)b * SEQ;
  const u16* ri = p.zt() + (size_t)(ZT_FI + j) * TT + (size_t)b * SEQ;
  {
    u32x4 vr[4], vi[4];
#pragma unroll
    for (int i = 0; i < 4; ++i) { const int m0 = (tid + 512 * i) * 8; vr[i] = *(const u32x4*)(rr + m0); vi[i] = *(const u32x4*)(ri + m0); }
#pragma unroll
    for (int i = 0; i < 4; ++i) {
      const int m0 = (tid + 512 * i) * 8;
#pragma unroll
      for (int q = 0; q < 4; ++q) {
        s[swz(m0 + 2 * q)] = make_float2(__uint_as_float(vr[i][q] << 16), __uint_as_float(vi[i][q] << 16));
        s[swz(m0 + 2 * q + 1)] = make_float2(__uint_as_float(vr[i][q] & 0xFFFF0000u), __uint_as_float(vi[i][q] & 0xFFFF0000u));
      }
    }
  }
  __syncthreads();
  fft_fwd(s, p.tw());
#ifdef PROBE_FFT
  fft_inv(s, p.tw());
  for (int m = tid; m < FM; m += NTHR) { float2 v = s[m]; v.x *= (1.f / 16384.f); v.y *= (1.f / 16384.f); s[m] = v; }
  __syncthreads();
  fft_fwd(s, p.tw());
#endif
  u16* orow = p.fno() + (size_t)j * TT + (size_t)b * SEQ;
#pragma unroll 8
  for (int k = tid; k < FM; k += NTHR) orow[k] = f2bf(s[swz(rev7(k))].x * (1.f / 128.f));
  __syncthreads();
}
__device__ __forceinline__ void hyena_ctx_item(const Params& p, int b, int ch, char* lds) {
  float* vg = (float*)lds;
  float* x0 = vg + 256;
  float* hf = x0 + 256;
  float* hbk = hf + 256;
  const int tid = ltid();
  const float* cw = p.hy_conv_w(); const float* cb = p.hy_conv_b();
  const size_t off = (size_t)TL + (size_t)b * LC;
  const u16* r0 = p.zt() + (size_t)(ZT_HY + ch) * TT + off;
  const u16* r1 = p.zt() + (size_t)(ZT_HY + 256 + ch) * TT + off;
  const u16* r2 = p.zt() + (size_t)(ZT_HY + 512 + ch) * TT + off;
  if (tid < 256) {
    const int t = tid;
    vg[t] = hy_sconv(r2, t, LC, cw[512 + ch], cw[768 + 512 + ch], cw[1536 + 512 + ch], cb[512 + ch]) *
            hy_sconv(r1, t, LC, cw[256 + ch], cw[768 + 256 + ch], cw[1536 + 256 + ch], cb[256 + ch]);
    x0[t] = hy_sconv(r0, t, LC, cw[ch], cw[768 + ch], cw[1536 + ch], cb[ch]);
    hf[t] = p.hfc()[(size_t)ch * LC + t]; hbk[t] = p.hfc()[(size_t)(256 + ch) * LC + t];
  }
  const float ssq_c = filt_ssq(p.hpart() + (size_t)2 * 256 * 512, ch, (float*)(lds + 8192));
  if (tid < 256) {
    const int t = tid; float y = 0;
    for (int q = 0; q <= t; ++q) y += hf[t - q] * vg[q];
    for (int q = t + 1; q < LC; ++q) y += hbk[q - t] * vg[q];
    y *= rsqrtf(ssq_c);
    p.hyo()[(size_t)ch * TT + off + t] = f2bf((y + vg[t] * p.hy_bias()[ch]) * x0[t]);
  }
  __syncthreads();
}
__device__ __forceinline__ void fnet_ctx_item(const Params& p, int b, int j, char* lds) {
  float* ur = (float*)lds; float* ui = ur + 256; float* cst = ui + 256; float* snt = cst + 256;
  const int tid = ltid();
  const size_t off = (size_t)TL + (size_t)b * LC;
  if (tid < 256) {
    ur[tid] = bf2f(p.zt()[(size_t)(ZT_FR + j) * TT + off + tid]); ui[tid] = bf2f(p.zt()[(size_t)(ZT_FI + j) * TT + off + tid]);
    float sn, cs; sincospif((float)tid / 128.f, &sn, &cs); cst[tid] = cs; snt[tid] = sn;
  }
  __syncthreads();
  if (tid < 256) {
    const int k = tid; float y = 0;
    for (int l = 0; l < 256; ++l) { const int m = (l * k) & 255; y += cst[m] * ur[l] + snt[m] * ui[l]; }
    p.fno()[(size_t)j * TT + off + k] = f2bf(y * 0.0625f);
  }
  __syncthreads();
}
__device__ __forceinline__ void phase_fftmix(const Params& p, int layer, int bid, int nb, char* lds) {
  const int nitems = layer == 0 ? 2048 : 1024;
  for (int it = bid; it < nitems; it += nb) {
    const int k = it & 511, b = k >> 8, c = k & 255;
    if (it < 512) hyena_item(p, layer, b, c, lds);
    else if (it < 1024) fnet_item(p, b, c, lds);
    else if (it < 1536) hyena_ctx_item(p, b, c, lds);
    else fnet_ctx_item(p, b, c, lds);
  }
}
constexpr int GLG = 17, NGRP = 16;
__device__ __forceinline__ int gla_chain_tok(int dir, int b, int n, int i) {
  const int base = n < 4 ? TL + b * LC : b * SEQ, len = n < 4 ? LC : SEQ, m = n < 4 ? n : n - 4;
  return dir == 0 ? base + 64 * m + i : base + (len - 1) - (64 * m + i);
}
__device__ __forceinline__ float logsig16(float x) { return (fminf(x, 0.f) - __logf(1.f + __expf(-fabsf(x)))) * (1.f / 16.f); }
__device__ __forceinline__ float wave_scan_incl(float v, int lane) {
#pragma unroll
  for (int o = 1; o < 64; o <<= 1) { const float t = __shfl_up(v, o, 64); if (lane >= o) v += t; }
  return v;
}
__device__ __forceinline__ void phase_gla_a(const Params& p, int layer, int bid, int nb, char* lds) {
  const int tid = ltid(), wid = tid >> 6, lane = tid & 63, r32 = lane & 31, hi = lane >> 5;
  const float* gb = p.gla_gk_b() + (size_t)layer * 256;
  char* wimg = lds + wid * 12288;
  for (int it = bid; it < 16 * NGRP; it += nb) {
    const int chain = it >> 4, g = it & 15, dir = chain >> 3, b = (chain >> 2) & 1, h = chain & 3;
    const int n0 = g * GLG, n1 = min(n0 + GLG, NCH), nch = n1 - n0;
    char* WT = lds + wid * 13824; char* VT = WT + 4608;
    float* dvl = (float*)(lds + 8 * 13824);
#pragma unroll
    for (int c = 0; c < 3; ++c) {
      const int cl = wid + 8 * c;
      if (cl < nch) {
        const int n = n0 + cl;
        {
          const u16* vbase = p.zg() + ZG_GV + h * 64 + lane;
          u16 vv[64];
#pragma unroll
          for (int i = 0; i < 64; ++i) vv[i] = vbase[(size_t)gla_chain_tok(dir, b, n, i) * ZG_W];
#pragma unroll
          for (int q = 0; q < 8; ++q)
            *(u32x4*)(VT + lane * 144 + q * 16) = u32x4{(unsigned)vv[8 * q] | ((unsigned)vv[8 * q + 1] << 16), (unsigned)vv[8 * q + 2] | ((unsigned)vv[8 * q + 3] << 16),
                                                       (unsigned)vv[8 * q + 4] | ((unsigned)vv[8 * q + 5] << 16), (unsigned)vv[8 * q + 6] | ((unsigned)vv[8 * q + 7] << 16)};
        }
        {
          const int kk = lane & 31, hs = lane >> 5;
          const u16* kb = p.zg() + ZG_GK + h * 32 + kk; const u16* gbp = p.zg() + ZG_GP + dir * 128 + h * 32 + kk;
          const float bias = gb[dir * 128 + h * 32 + kk];
          float bc[32], kf[32];
#pragma unroll
          for (int i = 0; i < 32; ++i) {
            const size_t ro = (size_t)gla_chain_tok(dir, b, n, hs * 32 + i) * ZG_W;
            kf[i] = bf2f(kb[ro]); bc[i] = bf2f(gbp[ro]);
          }
          float run = 0.f;
#pragma unroll
          for (int i = 0; i < 32; ++i) { const float x = bc[i] + bias; run += (fminf(x, 0.f) - __logf(1.f + __expf(-fabsf(x)))) * (1.f / 16.f); bc[i] = run; }
          const float lowtot = __shfl(run, kk, 64);
          const float uptot = __shfl(run, 32 + kk, 64);
          const float bl = lowtot + uptot, off = hs ? lowtot : 0.f;
          unsigned wp[16];
#pragma unroll
          for (int i = 0; i < 16; ++i) wp[i] = cvtpk(kf[2 * i] * __expf(bl - (bc[2 * i] + off)), kf[2 * i + 1] * __expf(bl - (bc[2 * i + 1] + off)));
#pragma unroll
          for (int q = 0; q < 4; ++q) *(u32x4*)(WT + kk * 144 + hs * 64 + q * 16) = u32x4{wp[4 * q], wp[4 * q + 1], wp[4 * q + 2], wp[4 * q + 3]};
          if (hs == 0) dvl[cl * 32 + kk] = __expf(bl);
        }
        asm volatile("s_waitcnt lgkmcnt(0)" ::: "memory");
        f32x16 d0 = {}, d1 = {};
#pragma unroll
        for (int s4 = 0; s4 < 4; ++s4) {
          const bf16x8 af = *(const bf16x8*)(WT + r32 * 144 + (16 * s4 + 8 * hi) * 2);
          const bf16x8 v0 = *(const bf16x8*)(VT + r32 * 144 + (16 * s4 + 8 * hi) * 2);
          const bf16x8 v1 = *(const bf16x8*)(VT + (32 + r32) * 144 + (16 * s4 + 8 * hi) * 2);
          d0 = __builtin_amdgcn_mfma_f32_32x32x16_bf16(af, v0, d0, 0, 0, 0);
          d1 = __builtin_amdgcn_mfma_f32_32x32x16_bf16(af, v1, d1, 0, 0, 0);
        }
        asm volatile("s_waitcnt lgkmcnt(0)" ::: "memory");
        {
          float* dg = p.gds() + ((size_t)chain * NCH + n) * 2048;
#pragma unroll
          for (int r = 0; r < 16; ++r) { dg[crow(r, hi) * 64 + r32] = d0[r]; dg[crow(r, hi) * 64 + 32 + r32] = d1[r]; }
        }
      }
      __builtin_amdgcn_sched_barrier(0);
    }
    __syncthreads();
    {
      const int kk = tid >> 4, v0 = (tid & 15) * 4;
      float st[4] = {0.f, 0.f, 0.f, 0.f}; float dcum = 1.f;
      float* gp0 = p.gds() + ((size_t)chain * NCH + n0) * 2048 + kk * 64 + v0;
      float4 av[GLG];
#pragma unroll
      for (int cl = 0; cl < GLG; ++cl) av[cl] = *(const float4*)(gp0 + (size_t)(cl < nch ? cl : 0) * 2048);
#pragma unroll
      for (int cl = 0; cl < GLG; ++cl) {
        if (cl < nch) {
          const float d = dvl[cl * 32 + kk];
          *(float4*)(gp0 + (size_t)cl * 2048) = make_float4(st[0], st[1], st[2], st[3]);
          if ((tid & 15) == 0) p.gdv()[((size_t)chain * NCH + n0 + cl) * 32 + kk] = dcum;
          st[0] = st[0] * d + av[cl].x; st[1] = st[1] * d + av[cl].y; st[2] = st[2] * d + av[cl].z; st[3] = st[3] * d + av[cl].w;
          dcum *= d;
        }
      }
      float* at = p.gst() + ((size_t)chain * NGRP + g) * 2048 + kk * 64 + v0;
      *(float4*)at = make_float4(st[0], st[1], st[2], st[3]);
      if ((tid & 15) == 0) p.gst()[(size_t)16 * NGRP * 2048 + ((size_t)chain * NGRP + g) * 32 + kk] = dcum;
    }
    __syncthreads();
  }
}

constexpr int GC_QP = 33792, GC_KP = GC_QP + 10240, GC_VT = GC_KP + 10240, GC_ST = GC_VT + 18432, GC_AX = GC_ST + 10240;
__device__ __forceinline__ void phase_gla_c(const Params& p, int layer, int bid, int nb, char* lds) {
  float* gl = (float*)lds;
  float* qraw = gl + 2 * 64 * 33;
  float* kraw = qraw + 64 * 33;
  float* Of = (float*)lds;
  char* Qp = lds + GC_QP;
  char* Kp = lds + GC_KP;
  char* VT = lds + GC_VT;
  char* ST = lds + GC_ST;
  const int tid = ltid(), wid = tid >> 6, lane = tid & 63, r32 = lane & 31, hi = lane >> 5;
  char* Ax = lds + GC_AX + wid * 4608;
  const float* gb = p.gla_gk_b() + (size_t)layer * 256;
  const int pc_lo = layer == 0 ? 0 : 4, npc = NCH - pc_lo, nitem = 8 * npc;
  const int per = (nitem + nb - 1) / nb, q_beg = bid * per, q_end = min(nitem, q_beg + per);
  const int sdir = tid >> 8, sk = (tid >> 3) & 31, sv0 = (tid & 7) * 8;
  float G[8]; int g_cached = -1, bh_cached = -1;
  const int lpos = tid >> 3, lc4 = (tid & 7) * 4;
  u32x2 rq, rk, rg0, rg1, rva, rvb; float4 pl0, pl1; float pdp;
#define GC_ITEM(q_, bh_, pc_, b_, h_, tok0_) const int bh_ = (q_) / npc, pc_ = pc_lo + (q_) % npc, b_ = bh_ >> 2, h_ = bh_ & 3; \
    const int tok0_ = pc_ < 4 ? TL + b_ * LC + pc_ * 64 : b_ * SEQ + (pc_ - 4) * 64
#define GC_LOADRAW(tok0_, h_) do { const u16* zr = p.zg() + (size_t)((tok0_) + lpos) * ZG_W; \
    rq = *(const u32x2*)(zr + ZG_GQ + (h_) * 32 + lc4); rk = *(const u32x2*)(zr + ZG_GK + (h_) * 32 + lc4); \
    rg0 = *(const u32x2*)(zr + ZG_GP + (h_) * 32 + lc4); rg1 = *(const u32x2*)(zr + ZG_GP + 128 + (h_) * 32 + lc4); \
    rva = *(const u32x2*)(zr + ZG_GV + (h_) * 64 + lc4 * 2); rvb = *(const u32x2*)(zr + ZG_GV + (h_) * 64 + lc4 * 2 + 4); } while (0)
#define GC_LOADST(pc_, b_, h_) do { const int chain_ = sdir * 8 + (b_) * 4 + (h_); \
    const int n_ = sdir == 0 ? (pc_) : ((pc_) < 4 ? 3 - (pc_) : 4 + 255 - ((pc_) - 4)); \
    const float* lp_ = p.gds() + ((size_t)chain_ * NCH + n_) * 2048 + sk * 64 + sv0; \
    pl0 = *(const float4*)lp_; pl1 = *(const float4*)(lp_ + 4); pdp = p.gdv()[((size_t)chain_ * NCH + n_) * 32 + sk]; } while (0)
  if (q_beg < q_end) { GC_ITEM(q_beg, bh0, pc0, b0, h0, t00); GC_LOADRAW(t00, h0); GC_LOADST(pc0, b0, h0); }
  for (int qi = q_beg; qi < q_end; ++qi) {
    GC_ITEM(qi, bh, pc, b, h, tok0);
    {
      const int pos = lpos, c4 = lc4;
      const float sc = 0.17677669529663687f;
      qraw[pos * 33 + c4] = BF_LO(rq[0]) * sc; qraw[pos * 33 + c4 + 1] = BF_HI(rq[0]) * sc; qraw[pos * 33 + c4 + 2] = BF_LO(rq[1]) * sc; qraw[pos * 33 + c4 + 3] = BF_HI(rq[1]) * sc;
      kraw[pos * 33 + c4] = BF_LO(rk[0]); kraw[pos * 33 + c4 + 1] = BF_HI(rk[0]); kraw[pos * 33 + c4 + 2] = BF_LO(rk[1]); kraw[pos * 33 + c4 + 3] = BF_HI(rk[1]);
#pragma unroll
      for (int d = 0; d < 2; ++d) {
        const u32x2 rg = d ? rg1 : rg0; const float4 bb = *(const float4*)(gb + d * 128 + h * 32 + c4);
        const int i = d ? 63 - pos : pos;
        float* gd = gl + (d * 64 + i) * 33 + c4;
        gd[0] = logsig16(BF_LO(rg[0]) + bb.x); gd[1] = logsig16(BF_HI(rg[0]) + bb.y); gd[2] = logsig16(BF_LO(rg[1]) + bb.z); gd[3] = logsig16(BF_HI(rg[1]) + bb.w);
      }
#pragma unroll
      for (int j = 0; j < 4; ++j) {
        const unsigned w = j < 2 ? rva[j] : rvb[j - 2]; const int v = c4 * 2 + 2 * j;
        *(u16*)(VT + (0 * 64 + v) * 144 + pos * 2) = (u16)(w & 0xFFFFu); *(u16*)(VT + (1 * 64 + v) * 144 + (63 - pos) * 2) = (u16)(w & 0xFFFFu);
        *(u16*)(VT + (0 * 64 + v + 1) * 144 + pos * 2) = (u16)(w >> 16); *(u16*)(VT + (1 * 64 + v + 1) * 144 + (63 - pos) * 2) = (u16)(w >> 16);
      }
    }
    if (qi + 1 < q_end) { GC_ITEM(qi + 1, bhn, pcn, bn, hn, t0n); GC_LOADRAW(t0n, hn); }
    __syncthreads();
    {
      const int col = tid & 63, d = col >> 5, c = col & 31, part = tid >> 6;
      float* ptot = (float*)(lds + GC_AX);
      float bv[8]; float run = 0.f;
#pragma unroll
      for (int j = 0; j < 8; ++j) { run += gl[(d * 64 + part * 8 + j) * 33 + c]; bv[j] = run; }
      ptot[part * 64 + col] = run;
      __syncthreads();
      float off = 0.f;
#pragma unroll
      for (int q = 0; q < 7; ++q) off += (q < part) ? ptot[q * 64 + col] : 0.f;
#pragma unroll
      for (int j = 0; j < 8; ++j) gl[(d * 64 + part * 8 + j) * 33 + c] = bv[j] + off;
    }
    __syncthreads();
    {
#pragma unroll
      for (int e = 0; e < 2; ++e) {
        const int idx = tid + e * 512, d = idx >> 9, i = (idx >> 3) & 63, c4 = (idx & 7) * 4, pos = d ? 63 - i : i;
        float qo[4], ko[4];
#pragma unroll
        for (int j = 0; j < 4; ++j) {
          const float bi = gl[(d * 64 + i) * 33 + c4 + j], bm = gl[(d * 64 + 31) * 33 + c4 + j];
          qo[j] = qraw[pos * 33 + c4 + j] * __expf(bi - bm); ko[j] = kraw[pos * 33 + c4 + j] * __expf(bm - bi);
        }
        *(u32x2*)(Qp + (d * 64 + i) * 80 + c4 * 2) = u32x2{cvtpk(qo[0], qo[1]), cvtpk(qo[2], qo[3])};
        *(u32x2*)(Kp + (d * 64 + i) * 80 + c4 * 2) = u32x2{cvtpk(ko[0], ko[1]), cvtpk(ko[2], ko[3])};
      }
      const int chain = sdir * 8 + b * 4 + h;
      const int n = sdir == 0 ? pc : (pc < 4 ? 3 - pc : 4 + 255 - (pc - 4)), g = n / GLG;
      if (g != g_cached || bh != bh_cached) {
#pragma unroll
        for (int j = 0; j < 8; ++j) G[j] = 0.f;
        const float* at = p.gst() + (size_t)chain * NGRP * 2048 + sk * 64 + sv0;
        const float* dt = p.gst() + (size_t)16 * NGRP * 2048 + (size_t)chain * NGRP * 32 + sk;
        for (int gg = 0; gg < g; ++gg) {
          const float4 a0 = *(const float4*)(at + (size_t)gg * 2048), a1 = *(const float4*)(at + (size_t)gg * 2048 + 4); const float dd = dt[gg * 32];
          G[0] = G[0] * dd + a0.x; G[1] = G[1] * dd + a0.y; G[2] = G[2] * dd + a0.z; G[3] = G[3] * dd + a0.w;
          G[4] = G[4] * dd + a1.x; G[5] = G[5] * dd + a1.y; G[6] = G[6] * dd + a1.z; G[7] = G[7] * dd + a1.w;
        }
        g_cached = g; bh_cached = bh;
      }
      const float4 l0 = pl0, l1 = pl1; const float dp = pdp;
      const float em = __expf(gl[(sdir * 64 + 31) * 33 + sk]);
      const float sv[8] = {l0.x + dp * G[0], l0.y + dp * G[1], l0.z + dp * G[2], l0.w + dp * G[3], l1.x + dp * G[4], l1.y + dp * G[5], l1.z + dp * G[6], l1.w + dp * G[7]};
      if (qi + 1 < q_end) { GC_ITEM(qi + 1, bhn, pcn, bn, hn, t0n); (void)bhn; (void)t0n; GC_LOADST(pcn, bn, hn); }
#pragma unroll
      for (int j = 0; j < 8; ++j) *(u16*)(ST + (sdir * 64 + sv0 + j) * 80 + sk * 2) = f2bf(sv[j] * em);
    }
    __syncthreads();
    {
      const int d = wid >> 2, ib = (wid >> 1) & 1, vb = wid & 1;
      const char* Qd = Qp + d * 64 * 80; const char* Kd = Kp + d * 64 * 80; const char* Vd = VT + d * 64 * 144; const char* Sd = ST + d * 64 * 80;
      bf16x8 qf[2];
#pragma unroll
      for (int s2 = 0; s2 < 2; ++s2) qf[s2] = *(const bf16x8*)(Qd + (ib * 32 + r32) * 80 + (16 * s2 + 8 * hi) * 2);
#pragma unroll
      for (int jb = 0; jb < 2; ++jb) {
        if (jb <= ib) {
          f32x16 x = {};
#pragma unroll
          for (int s2 = 0; s2 < 2; ++s2) {
            const bf16x8 kf = *(const bf16x8*)(Kd + (jb * 32 + r32) * 80 + (16 * s2 + 8 * hi) * 2);
            x = __builtin_amdgcn_mfma_f32_32x32x16_bf16(qf[s2], kf, x, 0, 0, 0);
          }
#pragma unroll
          for (int r = 0; r < 16; ++r) {
            const int il = crow(r, hi), i = ib * 32 + il, j = jb * 32 + r32;
            *(u16*)(Ax + il * 144 + j * 2) = f2bf(j <= i ? x[r] : 0.f);
          }
        }
      }
      asm volatile("s_waitcnt lgkmcnt(0)" ::: "memory");
      f32x16 o = {};
#pragma unroll
      for (int s4 = 0; s4 < 4; ++s4) {
        if (s4 < 2 * (ib + 1)) {
          const bf16x8 af = *(const bf16x8*)(Ax + r32 * 144 + (16 * s4 + 8 * hi) * 2);
          const bf16x8 vf = *(const bf16x8*)(Vd + (vb * 32 + r32) * 144 + (16 * s4 + 8 * hi) * 2);
          o = __builtin_amdgcn_mfma_f32_32x32x16_bf16(af, vf, o, 0, 0, 0);
        }
      }
#pragma unroll
      for (int s2 = 0; s2 < 2; ++s2) {
        const bf16x8 sf = *(const bf16x8*)(Sd + (vb * 32 + r32) * 80 + (16 * s2 + 8 * hi) * 2);
        o = __builtin_amdgcn_mfma_f32_32x32x16_bf16(qf[s2], sf, o, 0, 0, 0);
      }
#pragma unroll
      for (int r = 0; r < 16; ++r) {
        const int i = ib * 32 + crow(r, hi), pos = d ? 63 - i : i;
        Of[(d * 64 + pos) * 65 + vb * 32 + r32] = o[r];
      }
    }
    __syncthreads();
    {
      const int pos = tid >> 3, v0 = (tid & 7) * 8;
      float r8[8]; float ss = 0.f;
#pragma unroll
      for (int j = 0; j < 8; ++j) { r8[j] = Of[pos * 65 + v0 + j] + Of[(64 + pos) * 65 + v0 + j]; ss += r8[j] * r8[j]; }
      ss += shx<4>(ss); ss += shx<2>(ss); ss += shx<1>(ss);
      const float rs = rsqrtf(ss * (1.f / 64.f) + EPS);
      const u16* og = p.zg() + (size_t)(tok0 + pos) * ZG_W + ZG_OG + h * 64 + v0;
      const float4 g0 = ld4bf(og), g1 = ld4bf(og + 4);
      *(u32x4*)(p.ymix() + (size_t)(tok0 + pos) * DM + 512 + h * 64 + v0) =
          u32x4{cvtpk(r8[0] * rs * silu_f(g0.x), r8[1] * rs * silu_f(g0.y)), cvtpk(r8[2] * rs * silu_f(g0.z), r8[3] * rs * silu_f(g0.w)),
                cvtpk(r8[4] * rs * silu_f(g1.x), r8[5] * rs * silu_f(g1.y)), cvtpk(r8[6] * rs * silu_f(g1.z), r8[7] * rs * silu_f(g1.w))};
    }
    __syncthreads();
  }
}

__device__ __forceinline__ void phase_mix(const Params& p, int layer, int bid, int nb, char* lds) {
  float* part = (float*)lds;
  u16* tile = (u16*)(lds + 4096);
  const int tid = ltid(), wid = tid >> 6, lane = tid & 63;
  const int ntok = layer == 0 ? TT : TL;
  for (int it = bid; it < ntok / 64; it += nb) {
    const int tok0 = it * 64;
    float vh[32], vf[32]; float sh = 0, sf = 0;
#pragma unroll
    for (int c = 0; c < 32; ++c) {
      vh[c] = bf2f(p.hyo()[(size_t)(wid * 32 + c) * TT + tok0 + lane]); vf[c] = bf2f(p.fno()[(size_t)(wid * 32 + c) * TT + tok0 + lane]);
      sh += vh[c] * vh[c]; sf += vf[c] * vf[c];
    }
    part[(0 * 8 + wid) * 64 + lane] = sh; part[(1 * 8 + wid) * 64 + lane] = sf;
    __syncthreads();
    float th = 0, tf = 0;
#pragma unroll
    for (int q = 0; q < 8; ++q) { th += part[(0 * 8 + q) * 64 + lane]; tf += part[(1 * 8 + q) * 64 + lane]; }
    const float rh = rsqrtf(th * (1.f / 256.f) + EPS), rf = rsqrtf(tf * (1.f / 256.f) + EPS);
#pragma unroll
    for (int c = 0; c < 32; ++c) { tile[lane * 520 + wid * 32 + c] = f2bf(vh[c] * rh); tile[lane * 520 + 256 + wid * 32 + c] = f2bf(vf[c] * rf); }
    __syncthreads();
    for (int g = tid; g < 64 * 64; g += NTHR) {
      const int tl = g >> 6, cg = g & 63;
      const u32x4 w = *(const u32x4*)(tile + tl * 520 + cg * 8);
      *(u32x4*)(p.ymix() + (size_t)(tok0 + tl) * DM + (cg < 32 ? 256 + cg * 8 : 768 + (cg - 32) * 8)) = w;
    }
    __syncthreads();
  }
}

struct EpiOut {
  const Params* pp; int layer;
  __device__ __forceinline__ void pre(const G8Unit& u, int, int, float (&)[8], float* cb) const {
    if ((ltid() >> 6) == 0) g8_cload(pp->mod() + ((size_t)layer * 3 + modv(u.pm * 256)) * 6144 + 2 * DM + u.pn * 256, cb);
  }
  __device__ __forceinline__ void operator()(const f32x4 (&acc)[2][2][4][2], const G8Unit& u, int wr, int wc, int fr, int fq, const float (&)[8], const float* cb) const {
    const Params& p = *pp;
#pragma unroll
    for (int bj = 0; bj < 2; ++bj) {
      const int c0 = u.pn * 256 + bj * 128 + wc * 32 + 8 * fq;
      const f32x4 ga = *(const f32x4*)(cb + bj * 128 + wc * 32 + 8 * fq), gb = *(const f32x4*)(cb + bj * 128 + wc * 32 + 8 * fq + 4);
#pragma unroll
      for (int ai = 0; ai < 2; ++ai)
#pragma unroll
        for (int m = 0; m < 4; ++m) {
          const int tok = u.pm * 256 + ai * 128 + wr * 64 + m * 16 + fr;
          u16* xo = p.X() + (size_t)tok * DM + c0;
          f32x4 xa, xb;
          if (layer == 0) { const float* xr = resid_row_in(p, tok) + c0; xa = *(const f32x4*)xr; xb = *(const f32x4*)(xr + 4); }
          else { const u32x4 w = *(const u32x4*)xo;
            xa = f32x4{__uint_as_float(w[0] << 16), __uint_as_float(w[0] & 0xFFFF0000u), __uint_as_float(w[1] << 16), __uint_as_float(w[1] & 0xFFFF0000u)};
            xb = f32x4{__uint_as_float(w[2] << 16), __uint_as_float(w[2] & 0xFFFF0000u), __uint_as_float(w[3] << 16), __uint_as_float(w[3] & 0xFFFF0000u)}; }
          xa = xa + ga * acc[ai][bj][m][0]; xb = xb + gb * acc[ai][bj][m][1];
          *(u32x4*)xo = u32x4{cvtpk(xa[0], xa[1]), cvtpk(xa[2], xa[3]), cvtpk(xb[0], xb[1]), cvtpk(xb[2], xb[3])};
        }
    }
  }
};
__device__ __forceinline__ void phase_gemm_out(const Params& p, int layer, int bid, int nb, char* lds) {
  G8Plain S; S.nM = (layer == 0 ? TT : TL) / 256; S.nN = DM / 256; S.Kb = 2 * DM; S.G = nb; S.c = bid; S.Bt = (const char*)(p.bt_out() + (size_t)layer * DM * DM);
  EpiOut E; E.pp = &p; E.layer = layer;
  gemm8_phase<false>(lds, (const char*)p.ymix(), 2 * DM, S, E);
}

__device__ __forceinline__ void phase_norm2_router(const Params& p, int layer, int bid, int nb, char* lds) {
  float* rwl = (float*)lds;
  int* lcnt = (int*)(lds + 131072);
  int* lbase = lcnt + 32;
  int* ent = lbase + 32;
  float* entw = (float*)(ent + 2 * 640);
  float* ents = entw + 640;
  const int tid = ltid(), wid = tid >> 6, lane = tid & 63;
  const int ntok = layer == 0 ? TT : TL;
  const float* rw = p.router_w() + (size_t)layer * DM * NE;
  for (int i = tid; i < DM * NE / 4; i += NTHR) {
    const int k = i >> 3, q4 = i & 7;
    ((float4*)rwl)[q4 * 1024 + ((k & 3) * 256 + (k >> 2))] = ((const float4*)rw)[i];
  }
  if (tid < 32) lcnt[tid] = 0;
  __syncthreads();
  const float* gn = p.norm2_g() + layer * DM; const float* rb = p.router_b() + layer * NE;
  const int per = (ntok + nb - 1) / nb, t_beg = bid * per, t_end = min(ntok, t_beg + per);
  for (int tok = t_beg + wid; tok < t_end; tok += 8) {
    const u16* xr = p.X() + (size_t)tok * DM;
    float v[16];
#pragma unroll
    for (int i = 0; i < 4; ++i) { const float4 a = ld4bf(xr + lane * 4 + i * 256); v[4 * i] = a.x; v[4 * i + 1] = a.y; v[4 * i + 2] = a.z; v[4 * i + 3] = a.w; }
    float ss = 0;
#pragma unroll
    for (int i = 0; i < 16; ++i) ss += v[i] * v[i];
    ss = wave_sum(ss);
    const float rs = rsqrtf(ss * (1.f / DM) + EPS);
    const float* md = p.mod() + ((size_t)layer * 3 + modv(tok)) * 6144 + 3 * DM;
#pragma unroll
    for (int i = 0; i < 4; ++i) {
      const int c = lane * 4 + i * 256;
      const float4 g = *(const float4*)(gn + c), sh = *(const float4*)(md + c), sc = *(const float4*)(md + DM + c);
      v[4 * i] = v[4 * i] * rs * g.x * (1.f + sc.x) + sh.x; v[4 * i + 1] = v[4 * i + 1] * rs * g.y * (1.f + sc.y) + sh.y;
      v[4 * i + 2] = v[4 * i + 2] * rs * g.z * (1.f + sc.z) + sh.z; v[4 * i + 3] = v[4 * i + 3] * rs * g.w * (1.f + sc.w) + sh.w;
    }
    const float rowsc = store_row_i8(v, p.H() + (size_t)tok * DM, p.hs() + tok, lane);
    float lg[32];
#pragma unroll
    for (int e = 0; e < 32; ++e) lg[e] = 0.f;
#pragma unroll
    for (int i = 0; i < 16; ++i) {
      const float4* wr4 = (const float4*)rwl + ((i & 3) * 256 + (i >> 2) * 64 + lane);
#pragma unroll
      for (int q = 0; q < 8; ++q) { const float4 w = wr4[q * 1024]; lg[4 * q] += v[i] * w.x; lg[4 * q + 1] += v[i] * w.y; lg[4 * q + 2] += v[i] * w.z; lg[4 * q + 3] += v[i] * w.w; }
    }
    float r16[16], r8[8], r4[4], r2[2], lv;
    { const bool up = lane & 32;
#pragma unroll
      for (int e = 0; e < 16; ++e) { const float keep = up ? lg[16 + e] : lg[e], send = up ? lg[e] : lg[16 + e]; r16[e] = keep + shx<32>(send); } }
    { const bool up = lane & 16;
#pragma unroll
      for (int e = 0; e < 8; ++e) { const float keep = up ? r16[8 + e] : r16[e], send = up ? r16[e] : r16[8 + e]; r8[e] = keep + shx<16>(send); } }
    { const bool up = lane & 8;
#pragma unroll
      for (int e = 0; e < 4; ++e) { const float keep = up ? r8[4 + e] : r8[e], send = up ? r8[e] : r8[4 + e]; r4[e] = keep + shx<8>(send); } }
    { const bool up = lane & 4;
#pragma unroll
      for (int e = 0; e < 2; ++e) { const float keep = up ? r4[2 + e] : r4[e], send = up ? r4[e] : r4[2 + e]; r2[e] = keep + shx<4>(send); } }
    { const bool up = lane & 2; const float keep = up ? r2[1] : r2[0], send = up ? r2[0] : r2[1]; lv = keep + shx<2>(send); }
    lv += shx<1>(lv);
    lv += rb[lane >> 1];
    int ids[4]; float vals[4];
#pragma unroll
    for (int k = 0; k < 4; ++k) {
      const float mx = wave_max(lv);
      const unsigned long long bal = __ballot(lv == mx);
      const int win = __ffsll((long long)bal) - 1;
      ids[k] = win >> 1; vals[k] = mx;
      if ((lane >> 1) == ids[k]) lv = -3.4e38f;
    }
    if (lane == 0) {
      const float mx = vals[0];
      float ex[4], sum = 0;
#pragma unroll
      for (int k = 0; k < 4; ++k) { ex[k] = __expf(vals[k] - mx); sum += ex[k]; }
      const float inv = 1.f / sum;
#pragma unroll
      for (int k = 0; k < 4; ++k) {
        const int lp = atomicAdd(&lcnt[ids[k]], 1);
        const int slot = (tok - t_beg) * 4 + k;
        ent[2 * slot] = tok * 4 + k; ent[2 * slot + 1] = (ids[k] << 20) | lp; entw[slot] = ex[k] * inv; ents[slot] = rowsc;
      }
    }
  }
  __syncthreads();
  if (tid < 32) lbase[tid] = atomicAdd(&p.cnt()[layer * NE + tid], lcnt[tid]);
  __syncthreads();
  const int nas = (t_end > t_beg ? (t_end - t_beg) : 0) * 4;
  for (int s = tid; s < nas; s += NTHR) {
    const int tk = ent[2 * s], el = ent[2 * s + 1], e = el >> 20, pos = lbase[e] + (el & 0xFFFFF);
    p.rtok()[(size_t)e * TT + pos] = tk >> 2; p.rw()[(size_t)e * TT + pos] = entw[s]; p.rsc()[(size_t)e * TT + pos] = ents[s];
    p.tslot()[tk] = (e << 20) | pos;
  }
}

struct G8Moe {
  const int* cnt;
  int ntn, Kb, G, c; const char* Bt; size_t bstride;
  const int* rtok;
  __device__ __forceinline__ bool next(int i, G8Unit& u, const G8Unit& from) const {
    const int w = (i * 8 + (c & 7)) * (G >> 3) + (c >> 3);
    int acc = from.ab, rows = from.pre;
    for (int ee = from.e; ee < NE; ++ee) {
      const int cc = cnt[ee], tiles = ((cc + 255) >> 8) * ntn;
      if (w < acc + tiles) { const int r = w - acc; u.e = ee; u.pm = r / ntn; u.pn = r % ntn; u.ce = cc; u.pre = rows; u.ab = acc; return true; }
      acc += tiles; rows += cc;
    }
    return false;
  }
  __device__ __forceinline__ int a_row(const G8Unit& u, int row) const {
    const int r = min(u.pm * 256 + row, u.ce - 1);
    return rtok ? rtok[(size_t)u.e * TT + r] : u.pre + r;
  }
  __device__ __forceinline__ unsigned a_off(const G8Unit& u, int row) const { return (unsigned)a_row(u, row) * (unsigned)Kb; }
  __device__ __forceinline__ const char* b_ptr(const G8Unit& u) const { return Bt + (size_t)u.e * bstride + (size_t)u.pn * 256 * Kb; }
};
struct EpiGu {
  const float* bgl; u16* act; const float* rsc; const float* swl;
  __device__ __forceinline__ void pre(const G8Unit& u, int wr, int fr, float (&ep)[8], float* cb) const {
    if ((ltid() >> 6) == 0) g8_cload(bgl + (size_t)u.e * 2048 + u.pn * 256, cb);
    if ((ltid() >> 6) == 1) g8_cload(swl + (size_t)u.e * 2048 + u.pn * 256, cb + 256);
#pragma unroll
    for (int ai = 0; ai < 2; ++ai)
#pragma unroll
      for (int m = 0; m < 4; ++m) ep[ai * 4 + m] = rsc[(size_t)u.e * TT + min(u.pm * 256 + ai * 128 + wr * 64 + m * 16 + fr, u.ce - 1)];
  }
  __device__ __forceinline__ void operator()(const i32x4 (&acc)[2][2][4][2], const G8Unit& u, int wr, int wc, int fr, int fq, const float (&ep)[8], const float* cb) const {
    const int j0 = u.pn * 128 + wc * 32 + 8 * fq;
    typedef float f2v __attribute__((ext_vector_type(2)));
    const float* bg = cb + 2 * (wc * 32 + 8 * fq);
    f2v bgt[4], bup[4], sg[4], su[4];
#pragma unroll
    for (int q = 0; q < 4; ++q) { const f32x4 t = *(const f32x4*)(bg + 4 * q); bgt[q] = f2v{t[0], t[2]}; bup[q] = f2v{t[1], t[3]}; asm volatile("" : "+v"(bgt[q]), "+v"(bup[q])); }
    {
      const float* sp = cb + 256 + wc * 32 + 8 * fq;
      const f32x4 g0 = *(const f32x4*)sp, g1 = *(const f32x4*)(sp + 4), u0 = *(const f32x4*)(sp + 128), u1 = *(const f32x4*)(sp + 132);
      sg[0] = f2v{g0[0], g0[1]}; sg[1] = f2v{g0[2], g0[3]}; sg[2] = f2v{g1[0], g1[1]}; sg[3] = f2v{g1[2], g1[3]};
      su[0] = f2v{u0[0], u0[1]}; su[1] = f2v{u0[2], u0[3]}; su[2] = f2v{u1[0], u1[1]}; su[3] = f2v{u1[2], u1[3]};
    }
    const f2v kexp = f2v{-1.702f * 1.4426950408889634f, -1.702f * 1.4426950408889634f}, one2 = f2v{1.f, 1.f};
#pragma unroll
    for (int ai = 0; ai < 2; ++ai)
#pragma unroll
      for (int m = 0; m < 4; ++m) {
        const int r = u.pm * 256 + ai * 128 + wr * 64 + m * 16 + fr;
        if (r < u.ce) {
          const float sa = ep[ai * 4 + m]; const f2v sa2 = f2v{sa, sa};
          unsigned ow[4];
#pragma unroll
          for (int n = 0; n < 2; ++n)
#pragma unroll
            for (int jp = 0; jp < 2; ++jp) {
              const int q = 2 * n + jp;
              f2v g = f2v{(float)acc[ai][0][m][n][2 * jp], (float)acc[ai][0][m][n][2 * jp + 1]};
              f2v v = f2v{(float)acc[ai][1][m][n][2 * jp], (float)acc[ai][1][m][n][2 * jp + 1]};
              g = (g * sa2) * sg[q] + bgt[q];
              v = (v * sa2) * su[q] + bup[q];
              g = f2v{fminf(g[0], 7.f), fminf(g[1], 7.f)};
              v = f2v{__builtin_amdgcn_fmed3f(v[0], -7.f, 7.f), __builtin_amdgcn_fmed3f(v[1], -7.f, 7.f)};
              const f2v t = g * kexp;
              const f2v d = f2v{__builtin_amdgcn_exp2f(t[0]), __builtin_amdgcn_exp2f(t[1])} + one2;
              const f2v rr = f2v{__builtin_amdgcn_rcpf(d[0]), __builtin_amdgcn_rcpf(d[1])};
              const f2v o = (v * g + g) * rr;
              ow[q] = cvtpk(o[0], o[1]);
            }
          *(u32x4*)(act + (size_t)(u.pre + r) * DFF + j0) = u32x4{ow[0], ow[1], ow[2], ow[3]};
        }
      }
  }
};
struct EpiDn {
  const float* bdl; const float* rw; unsigned char* yd;
  __device__ __forceinline__ void pre(const G8Unit& u, int wr, int fr, float (&ep)[8], float* cb) const {
    if ((ltid() >> 6) == 0) g8_cload(bdl + (size_t)u.e * DM + u.pn * 256, cb);
#pragma unroll
    for (int ai = 0; ai < 2; ++ai)
#pragma unroll
      for (int m = 0; m < 4; ++m) ep[ai * 4 + m] = rw[(size_t)u.e * TT + min(u.pm * 256 + ai * 128 + wr * 64 + m * 16 + fr, u.ce - 1)];
  }
  __device__ __forceinline__ void operator()(const f32x4 (&acc)[2][2][4][2], const G8Unit& u, int wr, int wc, int fr, int fq, const float (&ep)[8], const float* cb) const {
#pragma unroll
    for (int bj = 0; bj < 2; ++bj) {
      const int c0 = u.pn * 256 + bj * 128 + wc * 32 + 8 * fq;
      const f32x4 ba = *(const f32x4*)(cb + bj * 128 + wc * 32 + 8 * fq), bb = *(const f32x4*)(cb + bj * 128 + wc * 32 + 8 * fq + 4);
#pragma unroll
      for (int ai = 0; ai < 2; ++ai)
#pragma unroll
        for (int m = 0; m < 4; ++m) {
          const int r = u.pm * 256 + ai * 128 + wr * 64 + m * 16 + fr;
          if (r < u.ce) {
            const float wgt = ep[ai * 4 + m];
            const float w8 = wgt * 8.f;
            f32x4 a = (acc[ai][bj][m][0] + ba) * w8, b = (acc[ai][bj][m][1] + bb) * w8;
#pragma unroll
            for (int j = 0; j < 4; ++j) { a[j] = fminf(fmaxf(a[j], -440.f), 440.f); b[j] = fminf(fmaxf(b[j], -440.f), 440.f); }
            int w0 = 0, w1 = 0;
            w0 = __builtin_amdgcn_cvt_pk_fp8_f32(a[0], a[1], w0, false); w0 = __builtin_amdgcn_cvt_pk_fp8_f32(a[2], a[3], w0, true);
            w1 = __builtin_amdgcn_cvt_pk_fp8_f32(b[0], b[1], w1, false); w1 = __builtin_amdgcn_cvt_pk_fp8_f32(b[2], b[3], w1, true);
            *(u32x2*)(yd + (size_t)(u.pre + r) * DM + c0) = u32x2{(unsigned)w0, (unsigned)w1};
          }
        }
    }
  }
};
__device__ __forceinline__ void phase_moe_gu(const Params& p, int layer, int bid, int nb, char* lds) {
  int* scnt = (int*)(lds + 131072);
  if (ltid() < NE) scnt[ltid()] = p.cnt()[layer * NE + ltid()];
  __syncthreads();
  G8Moe S; S.cnt = scnt; S.ntn = 8; S.Kb = DM; S.G = nb; S.c = bid; S.Bt = (const char*)(p.bt_gu() + (size_t)layer * NE * 2048 * DM); S.bstride = (size_t)2048 * DM; S.rtok = p.rtok();
  EpiGu E; E.bgl = p.moe_b_gu() + (size_t)layer * NE * 2048; E.act = p.act(); E.rsc = p.rsc(); E.swl = p.swgu() + (size_t)layer * NE * 2048;
  gemm8_phase<true>(lds, (const char*)p.H(), DM, S, E);
}
__device__ __forceinline__ void phase_moe_dn(const Params& p, int layer, int bid, int nb, char* lds) {
  int* scnt = (int*)(lds + 131072);
  if (ltid() < NE) scnt[ltid()] = p.cnt()[layer * NE + ltid()];
  __syncthreads();
  G8Moe S; S.cnt = scnt; S.ntn = 4; S.Kb = 2 * DFF; S.G = nb; S.c = bid; S.Bt = (const char*)(p.bt_dn() + (size_t)layer * NE * DM * DFF); S.bstride = (size_t)DM * DFF * 2; S.rtok = nullptr;
  EpiDn E; E.bdl = p.moe_b_down() + (size_t)layer * NE * DM; E.rw = p.rw(); E.yd = p.yd();
  gemm8_phase<false>(lds, (const char*)p.act(), 2 * DFF, S, E);
}

__device__ __forceinline__ void phase_final(const Params& p, int bid, int nb, char* lds) {
  int* pre = (int*)lds;
  expert_prefix(p.cnt() + NE, pre); __syncthreads();
  const int wid = ltid() >> 6, lane = ltid() & 63;
  for (int tok = bid * 8 + wid; tok < TL; tok += nb * 8) {
    float v[16];
    load_row_comb(p, 1, 1, tok, lane, pre, v);
    float ss = 0;
#pragma unroll
    for (int i = 0; i < 16; ++i) ss += v[i] * v[i];
    ss = wave_sum(ss);
    const float rs = rsqrtf(ss * (1.f / DM) + EPS);
    float* o = p.out() + (size_t)tok * DM;
#pragma unroll
    for (int i = 0; i < 4; ++i) {
      const int c = lane * 4 + i * 256;
      const float4 g = *(const float4*)(p.final_g() + c);
      *(float4*)(o + c) = make_float4(v[4 * i] * rs * g.x, v[4 * i + 1] * rs * g.y, v[4 * i + 2] * rs * g.z, v[4 * i + 3] * rs * g.w);
    }
  }
}

#define XB_TMO      128
#define XB_XCNT(j)  (256  + 64 * (j))
#define XB_XSUB(j)  (1280 + 64 * (j))
#define XB_XGEN(j)  (2304 + 64 * (j))
#define XB_TOP      3328
#define XB_TOPGEN   3392
#define XCD_BAR_WORDS 3456
#define XB_SPIN_CAP (1u << 18)
#define LAS __attribute__((address_space(3)))

__device__ __forceinline__ unsigned xb_ld(unsigned* p)              { return __hip_atomic_load(p, __ATOMIC_RELAXED, __HIP_MEMORY_SCOPE_AGENT); }
__device__ __forceinline__ unsigned xb_add(unsigned* p, unsigned v) { return __hip_atomic_fetch_add(p, v, __ATOMIC_RELAXED, __HIP_MEMORY_SCOPE_AGENT); }
__device__ __forceinline__ unsigned xb_xcc_id() { return (unsigned)__builtin_amdgcn_s_getreg((3 << 11) | 20) & 0xFu; }
#define XB_SPIN(cond, bar) do { unsigned _sp = 0; while (cond) { __builtin_amdgcn_s_sleep(1); \
    if ((++_sp & 255u) == 0u) { if (xb_ld(&(bar)[XB_TMO])) break; if (_sp > XB_SPIN_CAP) { atomicAdd(&(bar)[XB_TMO], 1u); break; } } } } while (0)

struct XcdBarrier {
    unsigned* bar; unsigned x;
    volatile LAS unsigned* st;
};

__device__ __forceinline__ XcdBarrier xcd_barrier_post(unsigned* bar, volatile LAS unsigned* st) {
    XcdBarrier b; b.bar = bar; b.x = xb_xcc_id(); b.st = st;
    if (threadIdx.x == 0) (void)xb_add(&bar[XB_XCNT(b.x)], 1u);
    return b;
}
__device__ __forceinline__ void xcd_barrier_complete(unsigned* bar, unsigned x, unsigned& nloc, unsigned& nx) {
    const unsigned G = gridDim.x * gridDim.y * gridDim.z;
    unsigned sum, cnt, mine, sp = 0u;
    for (;;) {
        sum = 0u; cnt = 0u; mine = 0u;
#pragma unroll
        for (unsigned j = 0; j < 16; ++j) { const unsigned c = xb_ld(&bar[XB_XCNT(j)]); sum += c; cnt += (c > 0u) ? 1u : 0u; mine = (j == x) ? c : mine; }
        if (sum == G) break;
        __builtin_amdgcn_s_sleep(1);
        if ((++sp & 255u) == 0u) { if (xb_ld(&bar[XB_TMO])) break; if (sp > XB_SPIN_CAP) { atomicAdd(&bar[XB_TMO], 1u); break; } }
    }
    nloc = mine > 0u ? mine : 1u; nx = cnt > 0u ? cnt : 1u;
}

__device__ __forceinline__ void xcd_barrier(const XcdBarrier& b) {
    asm volatile("s_waitcnt vmcnt(0)" ::: "memory");
    __syncthreads();
    if (threadIdx.x == 0) {
        unsigned* bar = b.bar;
        __builtin_amdgcn_s_waitcnt(0);
        unsigned nloc = b.st[0], nx = b.st[1];
        if (nloc == 0u) { xcd_barrier_complete(bar, b.x, nloc, nx); b.st[0] = nloc; b.st[1] = nx; }
        const unsigned old = xb_add(&bar[XB_XSUB(b.x)], 1u);
        const unsigned gen = old / nloc;
        if (old + 1u == (gen + 1u) * nloc) {
            __builtin_amdgcn_fence(__ATOMIC_RELEASE, "agent");
            asm volatile("s_waitcnt vmcnt(0)" ::: "memory");
            const unsigned og = xb_add(&bar[XB_TOP], 1u);
            const unsigned tg = og / nx;
            if (og + 1u == (tg + 1u) * nx) xb_add(&bar[XB_TOPGEN], 1u);
            else XB_SPIN(xb_ld(&bar[XB_TOPGEN]) == tg, bar);
            __builtin_amdgcn_fence(__ATOMIC_ACQUIRE, "agent");
            xb_add(&bar[XB_XGEN(b.x)], 1u);
            asm volatile("s_waitcnt vmcnt(0)" ::: "memory");
        } else {
            XB_SPIN(xb_ld(&bar[XB_XGEN(b.x)]) == gen, bar);
            __builtin_amdgcn_fence(__ATOMIC_ACQUIRE, "agent");
            asm volatile("s_waitcnt vmcnt(0)" ::: "memory");
        }
    }
    __syncthreads();
}


constexpr int LDS_MAIN = 147456;
constexpr int LDS_BYTES = LDS_MAIN + 1024;
enum { PH_TABLES = 0, PH_MOD, PH_FOLD, PH_CONVERT, PH_HYMLP, PH_HYFILT, PH_NORM1, PH_GEMM_IN, PH_QKV, PH_ATTN, PH_FFTMIX,
       PH_GLA_A, PH_GLA_B, PH_GLA_C, PH_MIX, PH_GEMM_OUT, PH_NORM2, PH_MOE_GU, PH_MOE_DN, PH_FINAL };

__device__ __forceinline__ Params make_params() {
  const __attribute__((address_space(4))) char* kb = (const __attribute__((address_space(4))) char*)__builtin_amdgcn_kernarg_segment_ptr();
  asm volatile("" : "+s"(kb));
  Params p; p.kb = kb; return p;
}
#ifndef MK_LAUNCHES
#define MK_LAUNCHES 1
#endif
__global__ void __launch_bounds__(NTHR, 2) k_mega(ParamsData pd) {
  extern __shared__ __attribute__((aligned(1024))) char lds[];
  const int bid = blockIdx.x, nb = gridDim.x;
  if (threadIdx.x == 0) *(uint4*)(lds + LDS_MAIN) = make_uint4(0u, 0u, 0u, 0u);
  __syncthreads();
  XcdBarrier bar = xcd_barrier_post(make_params().bar(), (volatile LAS unsigned*)(lds + LDS_MAIN));
#ifndef DBLMASK
#define DBLMASK 0u
#endif
#define RUNPH(bit, call) do { call; if (DBLMASK & (1u << (bit))) { __syncthreads(); call; } } while (0)
  RUNPH(13, phase_tables(make_params(), bid, nb); phase_mod(make_params(), bid, nb, lds); phase_fold(make_params(), bid, nb, lds));
  RUNPH(0, phase_convert(make_params(), bid, nb, lds));
  phase_hy_mlp(make_params(), 0, SEQ, make_params().hfb(), make_params().hpart(), bid, nb, lds);
  phase_hy_mlp(make_params(), 1, SEQ, make_params().hfb() + (size_t)2 * 256 * SEQ, make_params().hpart() + 256 * 512, bid, nb, lds);
  phase_hy_mlp(make_params(), 0, LC, make_params().hfc(), make_params().hpart() + 2 * 256 * 512, bid, nb, lds);
  xcd_barrier(bar);
  RUNPH(2, phase_hy_filtfft(make_params(), bid, nb, lds));
  phase_quant_in(make_params(), bid, nb);
#define MK_LAYER(l) do { \
  phase_norm1(make_params(), l, bid, nb, lds); if ((DBLMASK & (1u << 14)) && l == 0) { __syncthreads(); phase_norm1(make_params(), l, bid, nb, lds); } \
  xcd_barrier(bar); \
  RUNPH(3, phase_gemm_in(make_params(), l, bid, nb, lds)); \
  xcd_barrier(bar); \
  RUNPH(4, phase_qkv(make_params(), l, bid, nb, lds)); \
  RUNPH(5, phase_gla_a(make_params(), l, bid, nb, lds)); \
  RUNPH(7, phase_fftmix(make_params(), l, bid, nb, lds)); \
  xcd_barrier(bar); \
  RUNPH(6, phase_attn(make_params(), l, bid, nb, lds)); \
  RUNPH(9, phase_gla_c(make_params(), l, bid, nb, lds)); \
  RUNPH(10, phase_mix(make_params(), l, bid, nb, lds)); \
  xcd_barrier(bar); \
  phase_gemm_out(make_params(), l, bid, nb, lds); if ((DBLMASK & (1u << 16)) && l == 0) { __syncthreads(); phase_gemm_out(make_params(), l, bid, nb, lds); } \
  xcd_barrier(bar); \
  phase_norm2_router(make_params(), l, bid, nb, lds); \
  xcd_barrier(bar); \
  RUNPH(11, phase_moe_gu(make_params(), l, bid, nb, lds)); \
  xcd_barrier(bar); \
  RUNPH(12, phase_moe_dn(make_params(), l, bid, nb, lds)); \
  xcd_barrier(bar); \
  } while (0)
  MK_LAYER(0);
  MK_LAYER(1);
#undef MK_LAYER
  RUNPH(15, phase_final(make_params(), bid, nb, lds));
}
static size_t carve(char*& cur, size_t bytes) { char* r = cur; cur += (bytes + 1023) & ~(size_t)1023; return (size_t)(uintptr_t)r; }
#define CARVE(T, field, n) p.field = (T*)carve(cur, (size_t)(n) * sizeof(T))

extern "C" void kernel_launch(void* const* d_in, const int* in_sizes, int n_in, void* d_out, int out_size, void* d_ws, size_t ws_size, hipStream_t stream) {
  ParamsData p; memset(&p, 0, sizeof(p));
  const float** ins = (const float**)&p;
  for (int i = 0; i < 34; ++i) ins[i] = (const float*)d_in[i];
  p.out_ = (float*)d_out;
  p.ws_ = (char*)d_ws;
  if (WS_TOTAL > ws_size) { fprintf(stderr, "workspace too small: need %zu have %zu\n", (size_t)WS_TOTAL, ws_size); return; }
  hipMemsetAsync((char*)d_ws + OFF_bar, 0, OFF_mod - OFF_bar, stream);
  static int grid = 0;
  if (!grid) {
    int dev = 0, cus = 0, per_cu = 0;
    hipGetDevice(&dev);
    hipDeviceGetAttribute(&cus, hipDeviceAttributeMultiprocessorCount, dev);
    hipFuncSetAttribute((const void*)k_mega, hipFuncAttributeMaxDynamicSharedMemorySize, LDS_BYTES);
    hipOccupancyMaxActiveBlocksPerMultiprocessor(&per_cu, (const void*)k_mega, NTHR, LDS_BYTES);
    grid = cus * (per_cu < 1 ? per_cu : 1);
    if (grid != 256) fprintf(stderr, "unexpected grid %d (cus %d per_cu %d)\n", grid, cus, per_cu);
  }
  hipLaunchKernelGGL(k_mega, dim3(grid), dim3(NTHR), LDS_BYTES, stream, p);
}
```

```cpp
#include <hip/hip_runtime.h>
#include <hip/hip_bf16.h>
#include <cstdio>
#include <cstdint>
#include <cstring>
#include <cstddef>
#include <type_traits>

typedef unsigned short u16;
using bf16x8 = __attribute__((ext_vector_type(8))) short;
using s16x4  = __attribute__((ext_vector_type(4))) short;
using f32x4  = __attribute__((ext_vector_type(4))) float;
using f32x16 = __attribute__((ext_vector_type(16))) float;
using u32x4  = __attribute__((ext_vector_type(4))) unsigned;
using u32x2  = __attribute__((ext_vector_type(2))) unsigned;

constexpr int DM = 1024, NB = 2, SEQ = 16384, LC = 256;
constexpr int TL = NB * SEQ;
constexpr int TC = NB * LC;
constexpr int TT = TL + TC;
constexpr int NIN = 2816;
constexpr int DIN0 = 2240;
constexpr int NE = 32, TOPK = 4, DFF = 1024;
constexpr int SKV = SEQ + LC;
constexpr int NTHR = 512;
constexpr float EPS = 1e-6f;
constexpr float A_SCALE = 0.10206207261596575f;
constexpr float A_QSCALE = A_SCALE * 1.4426950408889634f;
constexpr int ZG_W = 1152, ZG_GQ = 0, ZG_GK = 128, ZG_KR = 256, ZG_GV = 384, ZG_GP = 640, ZG_OG = 896;
constexpr int ZT_HY = 0, ZT_FR = 768, ZT_FI = 1024, ZT_R = 1280;
constexpr int NCH = 260;
constexpr int FM = 16384;
constexpr int HSP = FM / 2 + 1;

constexpr size_t ws_al(size_t b) { return (b + 1023) & ~(size_t)1023; }
constexpr size_t OFF_bar = 0;
constexpr size_t OFF_cnt = OFF_bar + ws_al((size_t)(4096) * sizeof(unsigned));
constexpr size_t OFF_hssq = OFF_cnt + ws_al((size_t)(64) * sizeof(int));
constexpr size_t OFF_kmx = OFF_hssq + ws_al((size_t)(768) * sizeof(float));
constexpr size_t OFF_mod = OFF_kmx + ws_al((size_t)(128) * sizeof(unsigned));
constexpr size_t OFF_ropec = OFF_mod + ws_al((size_t)(2 * 3 * 6144) * sizeof(float));
constexpr size_t OFF_ropes = OFF_ropec + ws_al((size_t)(SEQ * 16) * sizeof(float));
constexpr size_t OFF_tw = OFF_ropes + ws_al((size_t)(SEQ * 16) * sizeof(float));
constexpr size_t OFF_bt_in = OFF_tw + ws_al((size_t)(FM) * sizeof(float2));
constexpr size_t OFF_bt_qkv = OFF_bt_in + ws_al((size_t)((size_t)2 * NIN * DM) * sizeof(u16));
constexpr size_t OFF_bt_out = OFF_bt_qkv + ws_al((size_t)(2 * 1024 * 384) * sizeof(u16));
constexpr size_t OFF_bt_gu = OFF_bt_out + ws_al((size_t)((size_t)2 * DM * DM) * sizeof(u16));
constexpr size_t OFF_bt_dn = OFF_bt_gu + ws_al((size_t)((size_t)2 * NE * 2048 * DM) * sizeof(u16));
constexpr size_t OFF_hfb = OFF_bt_dn + ws_al((size_t)((size_t)2 * NE * DM * DFF) * sizeof(u16));
constexpr size_t OFF_hfc = OFF_hfb + ws_al((size_t)((size_t)2 * 2 * 256 * SEQ) * sizeof(float));
constexpr size_t OFF_hspec = OFF_hfc + ws_al((size_t)(2 * 256 * LC) * sizeof(float));
constexpr size_t OFF_H = OFF_hspec + ws_al((size_t)((size_t)2 * 256 * HSP) * sizeof(float4));
constexpr size_t OFF_zqkv = OFF_H + ws_al((size_t)((size_t)TT * DM) * sizeof(u16));
constexpr size_t OFF_zg = OFF_zqkv + ws_al((size_t)((size_t)TT * 384) * sizeof(u16));
constexpr size_t OFF_zt = OFF_zg + ws_al((size_t)((size_t)TT * ZG_W) * sizeof(float));
constexpr size_t OFF_Q = OFF_zt + ws_al((size_t)((size_t)ZT_R * TT) * sizeof(float));
constexpr size_t OFF_KV = OFF_Q + ws_al((size_t)((size_t)2 * 4 * SKV * 96) * sizeof(u16));
constexpr size_t OFF_ymix = OFF_KV + ws_al((size_t)((size_t)2 * 4 * SKV * 160) * sizeof(u16));
constexpr size_t OFF_hyo = OFF_ymix + ws_al((size_t)((size_t)TT * DM) * sizeof(u16));
constexpr size_t OFF_fno = OFF_hyo + ws_al((size_t)((size_t)256 * TT) * sizeof(float));
constexpr size_t OFF_glao = OFF_fno + ws_al((size_t)((size_t)256 * TT) * sizeof(float));
constexpr size_t OFF_gds = OFF_glao + ws_al((size_t)((size_t)TT * 256) * sizeof(float));
constexpr size_t OFF_gdv = OFF_gds + ws_al((size_t)((size_t)16 * NCH * 2048) * sizeof(float));
constexpr size_t OFF_gst = OFF_gdv + ws_al((size_t)((size_t)16 * NCH * 32) * sizeof(float));
constexpr size_t OFF_X = OFF_gst + ws_al((size_t)((size_t)16 * NCH * 2048) * sizeof(float));
constexpr size_t OFF_rtok = OFF_X + ws_al((size_t)((size_t)TT * DM) * sizeof(float));
constexpr size_t OFF_rw = OFF_rtok + ws_al((size_t)((size_t)NE * TT) * sizeof(int));
constexpr size_t OFF_tslot = OFF_rw + ws_al((size_t)((size_t)NE * TT) * sizeof(float));
constexpr size_t OFF_act = OFF_tslot + ws_al((size_t)((size_t)TT * 4) * sizeof(int));
constexpr size_t OFF_yd = OFF_act + ws_al((size_t)((size_t)TT * 4 * DFF) * sizeof(u16));
constexpr size_t OFF_swin = OFF_yd + ws_al((size_t)((size_t)TT * 4 * DM) * sizeof(u16));
constexpr size_t OFF_swgu = OFF_swin + ws_al((size_t)(2 * NIN) * sizeof(float));
constexpr size_t OFF_hs = OFF_swgu + ws_al((size_t)(2 * NE * 2048) * sizeof(float));
constexpr size_t OFF_hpart = OFF_hs + ws_al((size_t)(TT) * sizeof(float));
constexpr size_t OFF_rsc = OFF_hpart + ws_al((size_t)(3 * 256 * 512) * sizeof(float));
constexpr size_t WS_TOTAL = OFF_rsc + ws_al((size_t)((size_t)NE * TT) * sizeof(float));
struct ParamsData {
  const float *x_, *c_, *ctx_, *c_ctx_, *ada_w_, *ada_b_, *norm1_g_, *norm2_g_, *w_in_, *mla_q_g_, *mla_w_uq_, *mla_kv_g_, *mla_w_ukv_, *hy_conv_w_, *hy_conv_b_, *hy_w1_, *hy_b1_, *hy_w2_, *hy_b2_, *hy_w3_, *hy_freq_, *hy_bias_, *gla_gk_w_, *gla_gk_b_, *fnet_w_, *mix_g_, *w_out_, *router_w_, *router_b_, *moe_w_gu_, *moe_b_gu_, *moe_w_down_, *moe_b_down_, *final_g_;
  float* out_;
  char* ws_;
};
struct Params {
  const __attribute__((address_space(4))) char* kb;
  template <class T> __device__ __forceinline__ T karg(size_t off) const { return *(const __attribute__((address_space(4))) T*)(kb + off); }
  __device__ __forceinline__ const float* x() const { return karg<const float*>(offsetof(ParamsData, x_)); }
  __device__ __forceinline__ const float* c() const { return karg<const float*>(offsetof(ParamsData, c_)); }
  __device__ __forceinline__ const float* ctx() const { return karg<const float*>(offsetof(ParamsData, ctx_)); }
  __device__ __forceinline__ const float* c_ctx() const { return karg<const float*>(offsetof(ParamsData, c_ctx_)); }
  __device__ __forceinline__ const float* ada_w() const { return karg<const float*>(offsetof(ParamsData, ada_w_)); }
  __device__ __forceinline__ const float* ada_b() const { return karg<const float*>(offsetof(ParamsData, ada_b_)); }
  __device__ __forceinline__ const float* norm1_g() const { return karg<const float*>(offsetof(ParamsData, norm1_g_)); }
  __device__ __forceinline__ const float* norm2_g() const { return karg<const float*>(offsetof(ParamsData, norm2_g_)); }
  __device__ __forceinline__ const float* w_in() const { return karg<const float*>(offsetof(ParamsData, w_in_)); }
  __device__ __forceinline__ const float* mla_q_g() const { return karg<const float*>(offsetof(ParamsData, mla_q_g_)); }
  __device__ __forceinline__ const float* mla_w_uq() const { return karg<const float*>(offsetof(ParamsData, mla_w_uq_)); }
  __device__ __forceinline__ const float* mla_kv_g() const { return karg<const float*>(offsetof(ParamsData, mla_kv_g_)); }
  __device__ __forceinline__ const float* mla_w_ukv() const { return karg<const float*>(offsetof(ParamsData, mla_w_ukv_)); }
  __device__ __forceinline__ const float* hy_conv_w() const { return karg<const float*>(offsetof(ParamsData, hy_conv_w_)); }
  __device__ __forceinline__ const float* hy_conv_b() const { return karg<const float*>(offsetof(ParamsData, hy_conv_b_)); }
  __device__ __forceinline__ const float* hy_w1() const { return karg<const float*>(offsetof(ParamsData, hy_w1_)); }
  __device__ __forceinline__ const float* hy_b1() const { return karg<const float*>(offsetof(ParamsData, hy_b1_)); }
  __device__ __forceinline__ const float* hy_w2() const { return karg<const float*>(offsetof(ParamsData, hy_w2_)); }
  __device__ __forceinline__ const float* hy_b2() const { return karg<const float*>(offsetof(ParamsData, hy_b2_)); }
  __device__ __forceinline__ const float* hy_w3() const { return karg<const float*>(offsetof(ParamsData, hy_w3_)); }
  __device__ __forceinline__ const float* hy_freq() const { return karg<const float*>(offsetof(ParamsData, hy_freq_)); }
  __device__ __forceinline__ const float* hy_bias() const { return karg<const float*>(offsetof(ParamsData, hy_bias_)); }
  __device__ __forceinline__ const float* gla_gk_w() const { return karg<const float*>(offsetof(ParamsData, gla_gk_w_)); }
  __device__ __forceinline__ const float* gla_gk_b() const { return karg<const float*>(offsetof(ParamsData, gla_gk_b_)); }
  __device__ __forceinline__ const float* fnet_w() const { return karg<const float*>(offsetof(ParamsData, fnet_w_)); }
  __device__ __forceinline__ const float* mix_g() const { return karg<const float*>(offsetof(ParamsData, mix_g_)); }
  __device__ __forceinline__ const float* w_out() const { return karg<const float*>(offsetof(ParamsData, w_out_)); }
  __device__ __forceinline__ const float* router_w() const { return karg<const float*>(offsetof(ParamsData, router_w_)); }
  __device__ __forceinline__ const float* router_b() const { return karg<const float*>(offsetof(ParamsData, router_b_)); }
  __device__ __forceinline__ const float* moe_w_gu() const { return karg<const float*>(offsetof(ParamsData, moe_w_gu_)); }
  __device__ __forceinline__ const float* moe_b_gu() const { return karg<const float*>(offsetof(ParamsData, moe_b_gu_)); }
  __device__ __forceinline__ const float* moe_w_down() const { return karg<const float*>(offsetof(ParamsData, moe_w_down_)); }
  __device__ __forceinline__ const float* moe_b_down() const { return karg<const float*>(offsetof(ParamsData, moe_b_down_)); }
  __device__ __forceinline__ const float* final_g() const { return karg<const float*>(offsetof(ParamsData, final_g_)); }
  __device__ __forceinline__ float* out() const { return karg<float*>(offsetof(ParamsData, out_)); }
  __device__ __forceinline__ char* ws() const { return karg<char*>(offsetof(ParamsData, ws_)); }
  __device__ __forceinline__ unsigned* bar() const { return (unsigned*)(ws() + OFF_bar); }
  __device__ __forceinline__ int* cnt() const { return (int*)(ws() + OFF_cnt); }
  __device__ __forceinline__ float* hssq() const { return (float*)(ws() + OFF_hssq); }
  __device__ __forceinline__ unsigned* kmx() const { return (unsigned*)(ws() + OFF_kmx); }
  __device__ __forceinline__ float* mod() const { return (float*)(ws() + OFF_mod); }
  __device__ __forceinline__ float* ropec() const { return (float*)(ws() + OFF_ropec); }
  __device__ __forceinline__ float* ropes() const { return (float*)(ws() + OFF_ropes); }
  __device__ __forceinline__ float2* tw() const { return (float2*)(ws() + OFF_tw); }
  __device__ __forceinline__ signed char* bt_in() const { return (signed char*)(ws() + OFF_bt_in); }
  __device__ __forceinline__ u16* bt_qkv() const { return (u16*)(ws() + OFF_bt_qkv); }
  __device__ __forceinline__ u16* bt_out() const { return (u16*)(ws() + OFF_bt_out); }
  __device__ __forceinline__ signed char* bt_gu() const { return (signed char*)(ws() + OFF_bt_gu); }
  __device__ __forceinline__ u16* bt_dn() const { return (u16*)(ws() + OFF_bt_dn); }
  __device__ __forceinline__ float* hfb() const { return (float*)(ws() + OFF_hfb); }
  __device__ __forceinline__ float* hfc() const { return (float*)(ws() + OFF_hfc); }
  __device__ __forceinline__ float4* hspec() const { return (float4*)(ws() + OFF_hspec); }
  __device__ __forceinline__ signed char* H() const { return (signed char*)(ws() + OFF_H); }
  __device__ __forceinline__ float* hs() const { return (float*)(ws() + OFF_hs); }
  __device__ __forceinline__ float* rsc() const { return (float*)(ws() + OFF_rsc); }
  __device__ __forceinline__ float* hpart() const { return (float*)(ws() + OFF_hpart); }
  __device__ __forceinline__ float* swin() const { return (float*)(ws() + OFF_swin); }
  __device__ __forceinline__ float* swgu() const { return (float*)(ws() + OFF_swgu); }
  __device__ __forceinline__ float* btf() const { return (float*)(ws() + OFF_act); }
  __device__ __forceinline__ u16* zqkv() const { return (u16*)(ws() + OFF_zqkv); }
  __device__ __forceinline__ u16* zg() const { return (u16*)(ws() + OFF_zg); }
  __device__ __forceinline__ u16* zt() const { return (u16*)(ws() + OFF_zt); }
  __device__ __forceinline__ u16* Q() const { return (u16*)(ws() + OFF_Q); }
  __device__ __forceinline__ u16* KV() const { return (u16*)(ws() + OFF_KV); }
  __device__ __forceinline__ u16* ymix() const { return (u16*)(ws() + OFF_ymix); }
  __device__ __forceinline__ u16* hyo() const { return (u16*)(ws() + OFF_hyo); }
  __device__ __forceinline__ u16* fno() const { return (u16*)(ws() + OFF_fno); }
  __device__ __forceinline__ u16* glao() const { return (u16*)(ws() + OFF_glao); }
  __device__ __forceinline__ float* gds() const { return (float*)(ws() + OFF_gds); }
  __device__ __forceinline__ float* gdv() const { return (float*)(ws() + OFF_gdv); }
  __device__ __forceinline__ float* gst() const { return (float*)(ws() + OFF_gst); }
  __device__ __forceinline__ u16* X() const { return (u16*)(ws() + OFF_X); }
  __device__ __forceinline__ int* rtok() const { return (int*)(ws() + OFF_rtok); }
  __device__ __forceinline__ float* rw() const { return (float*)(ws() + OFF_rw); }
  __device__ __forceinline__ int* tslot() const { return (int*)(ws() + OFF_tslot); }
  __device__ __forceinline__ u16* act() const { return (u16*)(ws() + OFF_act); }
  __device__ __forceinline__ unsigned char* yd() const { return (unsigned char*)(ws() + OFF_yd); }
};


__device__ __forceinline__ u16 f2bf(float f) {
  unsigned u = __float_as_uint(f); u += 0x7FFFu + ((u >> 16) & 1u); return (u16)(u >> 16);
}
__device__ __forceinline__ float bf2f(u16 h) { return __uint_as_float(((unsigned)h) << 16); }
__device__ __forceinline__ unsigned cvtpk(float lo, float hi) {
  unsigned r; asm volatile("v_cvt_pk_bf16_f32 %0, %1, %2" : "=v"(r) : "v"(lo), "v"(hi)); return r;
}
#define BF_LO(w) __uint_as_float((w) << 16)
#define BF_HI(w) __uint_as_float((w) & 0xFFFF0000u)
__device__ __forceinline__ float4 ld4bf(const u16* p) { const u32x2 w = *(const u32x2*)p; return make_float4(__uint_as_float(w[0] << 16), __uint_as_float(w[0] & 0xFFFF0000u), __uint_as_float(w[1] << 16), __uint_as_float(w[1] & 0xFFFF0000u)); }
template <int CTRL> __device__ __forceinline__ float dppf(float v) { return __builtin_bit_cast(float, __builtin_amdgcn_update_dpp(0, __builtin_bit_cast(int, v), CTRL, 0xF, 0xF, true)); }
template <int M> __device__ __forceinline__ float shx(float v) {
  if constexpr (M == 1) return dppf<0xB1>(v);
  else if constexpr (M == 2) return dppf<0x4E>(v);
  else if constexpr (M == 4) return dppf<0x1B>(dppf<0x141>(v));
  else if constexpr (M == 8) return dppf<0x141>(dppf<0x140>(v));
  else if constexpr (M == 16) { auto r = __builtin_amdgcn_permlane16_swap(__float_as_uint(v), __float_as_uint(v), false, false);
    return __uint_as_float((__lane_id() & 16) ? r[0] : r[1]); }
  else { auto r = __builtin_amdgcn_permlane32_swap(__float_as_uint(v), __float_as_uint(v), false, false);
    return __uint_as_float((__lane_id() & 32) ? r[0] : r[1]); }
}
__device__ __forceinline__ float wave_sum(float v) {
  v += dppf<0xB1>(v); v += dppf<0x4E>(v); v += dppf<0x141>(v); v += dppf<0x140>(v);
  { auto r = __builtin_amdgcn_permlane16_swap(__float_as_uint(v), __float_as_uint(v), false, false); v = __uint_as_float(r[0]) + __uint_as_float(r[1]); }
  { auto r = __builtin_amdgcn_permlane32_swap(__float_as_uint(v), __float_as_uint(v), false, false); v = __uint_as_float(r[0]) + __uint_as_float(r[1]); }
  return v;
}
__device__ __forceinline__ float wave_max(float v) {
  v = fmaxf(v, dppf<0xB1>(v)); v = fmaxf(v, dppf<0x4E>(v)); v = fmaxf(v, dppf<0x141>(v)); v = fmaxf(v, dppf<0x140>(v));
  { auto r = __builtin_amdgcn_permlane16_swap(__float_as_uint(v), __float_as_uint(v), false, false); v = fmaxf(__uint_as_float(r[0]), __uint_as_float(r[1])); }
  { auto r = __builtin_amdgcn_permlane32_swap(__float_as_uint(v), __float_as_uint(v), false, false); v = fmaxf(__uint_as_float(r[0]), __uint_as_float(r[1])); }
  return v;
}
__device__ __forceinline__ int ltid() { int t = threadIdx.x; asm volatile("" : "+v"(t)); return t; }
__device__ __forceinline__ float silu_f(float x) { return x / (1.f + __expf(-x)); }
__device__ __forceinline__ float2 cmul(float2 a, float2 b) { return make_float2(a.x * b.x - a.y * b.y, a.x * b.y + a.y * b.x); }
__device__ __forceinline__ float2 cmulc(float2 a, float2 b) { return make_float2(a.x * b.x + a.y * b.y, a.y * b.x - a.x * b.y); }
__device__ __forceinline__ int modv(int tok) { return tok < TL ? (tok >> 14) : 2; }
__device__ __forceinline__ void phase_tables(const Params& p, int bid, int nb) {
  const int gt = bid * NTHR + ltid(), gs = nb * NTHR;
  for (int i = gt; i < SEQ * 16; i += gs) {
    const int t = i >> 4, f = i & 15;
    const float pos = (f < 8) ? (float)(t >> 6) : (float)(t & 63);
    const float inv = powf(10000.f, -(float)(f & 7) / 8.f);
    float s, c; sincosf(pos * inv, &s, &c);
    p.ropec()[i] = c; p.ropes()[i] = s;
  }
  for (int i = gt; i < FM; i += gs) {
    float s, c; sincospif((float)i / 8192.f, &s, &c);
    p.tw()[i] = make_float2(c, -s);
  }
}

__device__ __forceinline__ void phase_mod(const Params& p, int bid, int nb, char* lds) {
  float* red = (float*)lds;
  const int tid = ltid(), part = tid >> 6, cl = tid & 63;
  for (int it = bid; it < 2 * 96; it += nb) {
    const int l = it / 96, n = (it % 96) * 64 + cl;
    const float* W = p.ada_w() + (size_t)l * DM * 6144;
    float a0 = 0, a1 = 0, a2 = 0;
    for (int k = part * 128; k < part * 128 + 128; ++k) {
      const float w = W[(size_t)k * 6144 + n];
      a0 += silu_f(p.c()[k]) * w; a1 += silu_f(p.c()[DM + k]) * w; a2 += silu_f(p.c_ctx()[k]) * w;
    }
    red[(part * 3 + 0) * 64 + cl] = a0; red[(part * 3 + 1) * 64 + cl] = a1; red[(part * 3 + 2) * 64 + cl] = a2;
    __syncthreads();
    if (tid < 192) {
      const int v = tid >> 6; float s = 0;
      for (int q = 0; q < 8; ++q) s += red[(q * 3 + v) * 64 + cl];
      p.mod()[((size_t)l * 3 + v) * 6144 + n] = s + p.ada_b()[(size_t)l * 6144 + n];
    }
    __syncthreads();
  }
}

__device__ __forceinline__ void phase_fold(const Params& p, int bid, int nb, char* lds) {
  float* wrow = (float*)lds;
  float* dre = wrow + 2048;
  float* dim_ = dre + 2048;
  float* glr = dim_ + 2048;
  float* cst = glr + 256;
  float* snt = cst + 256;
  const int tid = ltid();
  if (tid < 256) { float sn, cs; sincospif((float)tid / 128.f, &sn, &cs); cst[tid] = cs; snt[tid] = sn; }
  __syncthreads();
  for (int it = bid; it < 2 * DM / 8; it += nb) {
    const int l = it >> 7, k0 = (it & 127) * 8;
    for (int i = tid; i < 8 * 256; i += NTHR) { const int r = i >> 8, c = i & 255; wrow[c * 8 + r] = p.w_in()[((size_t)l * DM + k0 + r) * DIN0 + 1984 + c]; }
    if (tid < 256) { const int r = tid >> 5, c = tid & 31; glr[c * 8 + r] = p.w_in()[((size_t)l * DM + k0 + r) * DIN0 + 1696 + c]; }
    __syncthreads();
    {
      const int kp = tid & 255; const bool im = tid >= 256;
      float acc[8] = {0.f, 0.f, 0.f, 0.f, 0.f, 0.f, 0.f, 0.f};
#pragma unroll 4
      for (int c = 0; c < 256; ++c) {
        const int m = (c * kp) & 255; const float t = im ? -snt[m] : cst[m];
        const float4 w0 = *(const float4*)(wrow + c * 8), w1 = *(const float4*)(wrow + c * 8 + 4);
        acc[0] += w0.x * t; acc[1] += w0.y * t; acc[2] += w0.z * t; acc[3] += w0.w * t; acc[4] += w1.x * t; acc[5] += w1.y * t; acc[6] += w1.z * t; acc[7] += w1.w * t;
      }
      float* d = (im ? dim_ : dre) + kp * 8;
      *(float4*)d = make_float4(acc[0], acc[1], acc[2], acc[3]); *(float4*)(d + 4) = make_float4(acc[4], acc[5], acc[6], acc[7]);
    }
    __syncthreads();
    {
      const int j = tid & 255; const bool im = tid >= 256;
      const float* Wf = p.fnet_w() + (size_t)l * 65536 + j;
      const float* d = im ? dim_ : dre;
      float acc[8] = {0.f, 0.f, 0.f, 0.f, 0.f, 0.f, 0.f, 0.f};
#pragma unroll 8
      for (int kp = 0; kp < 256; ++kp) {
        const float w = Wf[kp * 256];
        const float4 d0 = *(const float4*)(d + kp * 8), d1 = *(const float4*)(d + kp * 8 + 4);
        acc[0] += d0.x * w; acc[1] += d0.y * w; acc[2] += d0.z * w; acc[3] += d0.w * w; acc[4] += d1.x * w; acc[5] += d1.y * w; acc[6] += d1.z * w; acc[7] += d1.w * w;
      }
      float* o = p.btf() + ((size_t)l * NIN + (im ? 2560 : 2304) + j) * DM + k0;
      *(float4*)o = make_float4(acc[0] * 0.0625f, acc[1] * 0.0625f, acc[2] * 0.0625f, acc[3] * 0.0625f);
      *(float4*)(o + 4) = make_float4(acc[4] * 0.0625f, acc[5] * 0.0625f, acc[6] * 0.0625f, acc[7] * 0.0625f);
    }
    if (tid < 256) {
      const int dir = tid >> 7, kk = tid & 127;
      const float* gw = p.gla_gk_w() + ((size_t)l * 2 + dir) * 16 * 128 + kk;
      float acc[8] = {0.f, 0.f, 0.f, 0.f, 0.f, 0.f, 0.f, 0.f};
#pragma unroll
      for (int r16 = 0; r16 < 16; ++r16) {
        const float w = gw[r16 * 128];
        const float4 g0 = *(const float4*)(glr + (dir * 16 + r16) * 8), g1 = *(const float4*)(glr + (dir * 16 + r16) * 8 + 4);
        acc[0] += g0.x * w; acc[1] += g0.y * w; acc[2] += g0.z * w; acc[3] += g0.w * w; acc[4] += g1.x * w; acc[5] += g1.y * w; acc[6] += g1.z * w; acc[7] += g1.w * w;
      }
      float* o = p.btf() + ((size_t)l * NIN + 1024 + tid) * DM + k0;
      *(float4*)o = make_float4(acc[0], acc[1], acc[2], acc[3]); *(float4*)(o + 4) = make_float4(acc[4], acc[5], acc[6], acc[7]);
    }
    __syncthreads();
  }
}

enum { MAP_ID = 0, MAP_IN = 1, MAP_UQ = 2, MAP_UKV = 3, MAP_GU = 4 };
__device__ __forceinline__ int colmap(int mt, int n) {
  switch (mt) {
    case MAP_ID: return n;
    case MAP_IN:
      if (n < 256) return n;
      if (n < 384) return 256 + (n - 256);
      if (n < 512) return 1184 + (n - 384);
      if (n < 640) return 1312 + (n - 512);
      if (n < 672) return 384 + (n - 640);
      if (n < 768) return -1;
      if (n < 1024) return 1440 + (n - 768);
      if (n < 1280) return -2;
      if (n < 1536) return 1728 + (n - 1280);
      if (n < 2304) return 416 + (n - 1536);
      return -2;
    case MAP_UQ:
      if (n < 256) return (n >> 6) * 96 + (n & 63);
      if (n < 384) return ((n - 256) >> 5) * 96 + 64 + ((n - 256) & 31);
      return -1;
    case MAP_UKV:
      if (n < 256) return (n >> 6) * 128 + (n & 63);
      return ((n - 256) >> 6) * 128 + 64 + ((n - 256) & 63);
    default: {
      const int pn = n >> 8, w = n & 255;
      return w < 128 ? 2 * (pn * 128 + w) : 2 * (pn * 128 + w - 128) + 1;
    }
  }
}
__device__ __forceinline__ int invmap(int mt, int sc) {
  if (mt == MAP_ID) return sc;
  if (mt == MAP_GU) { const int j = sc >> 1, t = sc & 1; return (j >> 7) * 256 + t * 128 + (j & 127); }
  if (sc < 384) return sc;
  if (sc < 416) return 640 + (sc - 384);
  if (sc < 1184) return 1536 + (sc - 416);
  if (sc < 1312) return 384 + (sc - 1184);
  if (sc < 1440) return 512 + (sc - 1312);
  if (sc < 1696) return 768 + (sc - 1440);
  if (sc < 1728) return -1;
  if (sc < 1984) return 1280 + (sc - 1728);
  return -1;
}
struct ConvJob { const float* src; void* dst; const float* scale; int ld, K, mt, k0, s0, f32; };
__device__ __forceinline__ void conv_tile_load(const ConvJob& J, int tid, float4 (&v)[4]) {
  const int kk = tid >> 5, s4 = (tid & 31) * 4;
#pragma unroll
  for (int i = 0; i < 4; ++i) {
    v[i] = make_float4(0.f, 0.f, 0.f, 0.f);
    if (J.s0 + s4 < J.ld) v[i] = *(const float4*)(J.src + (size_t)(J.k0 + kk + 16 * i) * J.ld + J.s0 + s4);
  }
}
__device__ __forceinline__ void conv_tile_proc(const ConvJob& J, int tid, const float4 (&v)[4], float* tile  ) {
  {
    const int kk = tid >> 5, s4 = (tid & 31) * 4;
#pragma unroll
    for (int i = 0; i < 4; ++i) {
      const float sc = J.scale ? J.scale[J.k0 + kk + 16 * i] : 1.f;
      float* t = tile + (kk + 16 * i) * 129 + s4;
      t[0] = v[i].x * sc; t[1] = v[i].y * sc; t[2] = v[i].z * sc; t[3] = v[i].w * sc;
    }
  }
  __syncthreads();
#pragma unroll
  for (int h = 0; h < 2; ++h) {
    const int sl = (tid >> 3) + 64 * h, ks = (tid & 7) * 8, sc = J.s0 + sl;
    const int row = sc < J.ld ? invmap(J.mt, sc) : -1;
    if (row >= 0) {
      const float* t = tile + ks * 129 + sl;
      if (J.f32) {
        float* dst = (float*)J.dst + (size_t)row * J.K + J.k0 + ks;
        *(float4*)dst = make_float4(t[0], t[129], t[2 * 129], t[3 * 129]); *(float4*)(dst + 4) = make_float4(t[4 * 129], t[5 * 129], t[6 * 129], t[7 * 129]);
      } else {
        u32x4 w;
        w[0] = cvtpk(t[0], t[129]); w[1] = cvtpk(t[2 * 129], t[3 * 129]); w[2] = cvtpk(t[4 * 129], t[5 * 129]); w[3] = cvtpk(t[6 * 129], t[7 * 129]);
        *(u32x4*)((u16*)J.dst + (size_t)row * J.K + J.k0 + ks) = w;
      }
    }
  }
  __syncthreads();
}
constexpr int CT_IN = 16 * 18, CT_OUT = 16 * 8, CT_DN = NE * 128, CT_L = CT_IN + CT_OUT + CT_DN;
__device__ __forceinline__ void conv_decode(const Params& p, int t, ConvJob& J) {
  const int l = t / CT_L; int r = t % CT_L;
  if (r < CT_IN) { J.src = p.w_in() + (size_t)l * DM * DIN0; J.ld = DIN0; J.K = DM; J.dst = p.btf() + (size_t)l * NIN * DM; J.mt = MAP_IN; J.scale = nullptr; J.k0 = (r / 18) * 64; J.s0 = (r % 18) * 128; J.f32 = 1; return; }
  r -= CT_IN;
  if (r < CT_OUT) { J.src = p.w_out() + (size_t)l * DM * DM; J.ld = DM; J.K = DM; J.dst = p.bt_out() + (size_t)l * DM * DM; J.mt = MAP_ID; J.scale = p.mix_g() + l * DM; J.k0 = (r / 8) * 64; J.s0 = (r % 8) * 128; J.f32 = 0; return; }
  r -= CT_OUT;
  const int e = r >> 7, q = r & 127;
  J.src = p.moe_w_down() + ((size_t)l * NE + e) * DFF * DM; J.ld = DM; J.K = DFF; J.dst = p.bt_dn() + ((size_t)l * NE + e) * DM * DFF; J.mt = MAP_ID; J.scale = nullptr; J.k0 = (q >> 3) * 64; J.s0 = (q & 7) * 128; J.f32 = 0;
}
__device__ __forceinline__ void conv_gu8_load(const float* __restrict__ src  , int s0, int tid, float4 (&v)[16]) {
  const int c4 = (tid & 7) * 4, r0 = tid >> 3;
#pragma unroll
  for (int pss = 0; pss < 16; ++pss) v[pss] = *(const float4*)(src + (size_t)(r0 + 64 * pss) * 2048 + s0 + c4);
}
__device__ __forceinline__ void conv_gu8_proc(const float4 (&v)[16], signed char* __restrict__ dst  , float* __restrict__ sw  ,
                                              int s0, float* tile  , int tid) {
  float* cmax = tile + 1024 * 33;
  {
    const int c4 = (tid & 7) * 4, r0 = tid >> 3;
#pragma unroll
    for (int pss = 0; pss < 16; ++pss) { float* t = tile + (r0 + 64 * pss) * 33 + c4; t[0] = v[pss].x; t[1] = v[pss].y; t[2] = v[pss].z; t[3] = v[pss].w; }
  }
  __syncthreads();
  {
    const int col = tid & 31, part = tid >> 5; float m = 0.f;
#pragma unroll 8
    for (int k = part * 64; k < part * 64 + 64; ++k) m = fmaxf(m, fabsf(tile[k * 33 + col]));
    cmax[part * 32 + col] = m;
  }
  __syncthreads();
  if (tid < 32) {
    float m = 0.f;
#pragma unroll
    for (int q = 0; q < 16; ++q) m = fmaxf(m, cmax[q * 32 + tid]);
    const float sc = fmaxf(m, 1e-20f) * (1.f / 127.f);
    cmax[512 + tid] = sc;
    sw[invmap(MAP_GU, s0 + tid)] = sc;
  }
  __syncthreads();
#pragma unroll
  for (int h = 0; h < 4; ++h) {
    const int g = tid + 512 * h, col = g & 31, k0 = (g >> 5) * 16;
    const float inv = 1.f / cmax[512 + col];
    unsigned w[4];
#pragma unroll
    for (int q = 0; q < 4; ++q) {
      const float* t = tile + (k0 + 4 * q) * 33 + col;
      const int q0 = (int)rintf(t[0] * inv), q1 = (int)rintf(t[33] * inv), q2 = (int)rintf(t[66] * inv), q3 = (int)rintf(t[99] * inv);
      w[q] = (unsigned)(q0 & 255) | ((unsigned)(q1 & 255) << 8) | ((unsigned)(q2 & 255) << 16) | ((unsigned)(q3 & 255) << 24);
    }
    *(u32x4*)(dst + (size_t)invmap(MAP_GU, s0 + col) * DM + k0) = u32x4{w[0], w[1], w[2], w[3]};
  }
  __syncthreads();
}
__device__ __forceinline__ void phase_convert(const Params& p, int bid, int nb, char* lds) {
  float* tile = (float*)lds;
  const int tid = ltid();
  {
    ConvJob J, Jn; float4 v[4], vn[4];
    int t = bid;
    if (t < 2 * CT_L) { conv_decode(p, t, J); conv_tile_load(J, tid, v); }
    for (; t < 2 * CT_L; t += nb) {
      const bool more = t + nb < 2 * CT_L;
      if (more) { conv_decode(p, t + nb, Jn); conv_tile_load(Jn, tid, vn); }
      conv_tile_proc(J, tid, v, tile);
      if (more) { J = Jn;
#pragma unroll
        for (int i = 0; i < 4; ++i) v[i] = vn[i]; }
    }
  }
  {
    float4 v[16], vn[16];
    int t = bid;
    if (t < 2 * NE * 64) conv_gu8_load(p.moe_w_gu() + (size_t)(t >> 6) * DM * 2048, (t & 63) * 32, tid, v);
    for (; t < 2 * NE * 64; t += nb) {
      const bool more = t + nb < 2 * NE * 64; const int tn = t + nb;
      if (more) conv_gu8_load(p.moe_w_gu() + (size_t)(tn >> 6) * DM * 2048, (tn & 63) * 32, tid, vn);
      conv_gu8_proc(v, p.bt_gu() + (size_t)(t >> 6) * 2048 * DM, p.swgu() + (size_t)(t >> 6) * 2048, (t & 63) * 32, tile, tid);
      if (more) {
#pragma unroll
        for (int i = 0; i < 16; ++i) v[i] = vn[i]; }
    }
  }
  for (int l = 0; l < 2; ++l) {
    for (int i = bid * NTHR + tid; i < 96 * DM / 4; i += nb * NTHR) *(float4*)(p.btf() + ((size_t)l * NIN + 672) * DM + (size_t)i * 4) = make_float4(0.f, 0.f, 0.f, 0.f);
    {
      const float* wq = p.mla_w_uq() + (size_t)l * 256 * 384; const float* wkv = p.mla_w_ukv() + (size_t)l * 128 * 512;
      const float* gq = p.mla_q_g() + l * 256; const float* gkv = p.mla_kv_g() + l * 128;
      u16* dst = p.bt_qkv() + (size_t)l * 1024 * 384;
      for (int i = bid * NTHR + ltid(); i < 1024 * 384; i += nb * NTHR) {
        const int n = i / 384, k = i % 384; float v = 0.f;
        if (n < 512) { const int sc = colmap(MAP_UQ, n); if (k < 256 && sc >= 0) v = gq[k] * wq[k * 384 + sc]; }
        else { if (k >= 256) v = gkv[k - 256] * wkv[(k - 256) * 512 + colmap(MAP_UKV, n - 512)]; }
        dst[i] = f2bf(v);
      }
    }
  }
}

__device__ __forceinline__ void phase_hy_mlp(const Params& p, int l, int Lf, float* __restrict__ hout  , float* __restrict__ ssq  ,
                             int bid, int nb, char* lds) {
  float* zf = (float*)lds;
  float* h1 = zf + 64 * 33;
  float* h2 = h1 + 64 * 64;
  const int tid = ltid();
  const float* w1 = p.hy_w1() + (size_t)l * 33 * 64; const float* b1 = p.hy_b1() + l * 64;
  const float* w2 = p.hy_w2() + (size_t)l * 64 * 64; const float* b2 = p.hy_b2() + l * 64;
  const float* w3 = p.hy_w3() + (size_t)l * 64 * 512; const float* fr = p.hy_freq() + l * 64;
  float w3c[64];
#pragma unroll
  for (int k = 0; k < 64; ++k) w3c[k] = w3[k * 512 + tid];
  const int dir = tid >> 8, ch = tid & 255;
  const float maxd = logf(1e-2f) / 0.3f, mind = logf(1e-2f) / 1.5f;
  const float delta = fabsf(mind + (maxd - mind) * (float)ch / 255.f);
  float ssq_acc = 0.f;
  for (int it = bid; it < Lf / 64; it += nb) {
    const int t0 = it * 64;
    for (int i = tid; i < 64 * 33; i += NTHR) {
      const int tt = i / 33, f = i % 33, t = t0 + tt;
      float v;
      if (f == 0) v = (float)t / (float)(Lf - 1);
      else {
        const int j = (f - 1) & 15;
        const float fj = 1e-4f + (float)j * ((15.f - 1e-4f) / 15.f);
        const float w = 6.283185307179586f * (float)t / (float)Lf;
        v = (f <= 16) ? cosf(fj * w) : -sinf(fj * w);
      }
      zf[i] = v;
    }
    __syncthreads();
    {
      const int o = tid & 63, tb = tid >> 6;
      float acc[8];
#pragma unroll
      for (int j = 0; j < 8; ++j) acc[j] = b1[o];
#pragma unroll 3
      for (int f = 0; f < 33; ++f) {
        const float w = w1[f * 64 + o];
#pragma unroll
        for (int j = 0; j < 8; ++j) acc[j] += zf[(tb + 8 * j) * 33 + f] * w;
      }
      const float fo = fr[o];
#pragma unroll
      for (int j = 0; j < 8; ++j) h1[(tb + 8 * j) * 64 + o] = sinf(fo * acc[j]);
    }
    __syncthreads();
    {
      const int o = tid & 63, tb = tid >> 6;
      float acc[8];
#pragma unroll
      for (int j = 0; j < 8; ++j) acc[j] = b2[o];
#pragma unroll 4
      for (int f = 0; f < 64; f += 4) {
        const float wa = w2[f * 64 + o], wb = w2[(f + 1) * 64 + o], wc2 = w2[(f + 2) * 64 + o], wd = w2[(f + 3) * 64 + o];
#pragma unroll
        for (int j = 0; j < 8; ++j) { const float4 hv = *(const float4*)(h1 + (tb + 8 * j) * 64 + f); acc[j] += hv.x * wa + hv.y * wb + hv.z * wc2 + hv.w * wd; }
      }
      const float fo = fr[o];
#pragma unroll
      for (int j = 0; j < 8; ++j) h2[(tb + 8 * j) * 64 + o] = sinf(fo * acc[j]);
    }
    __syncthreads();
    float* orow = hout + ((size_t)dir * 256 + ch) * Lf + t0;
    for (int tq = 0; tq < 16; ++tq) {
      float sv[4];
#pragma unroll
      for (int u = 0; u < 4; ++u) {
        const int tt = tq * 4 + u;
        float s = 0;
#pragma unroll
        for (int k = 0; k < 64; k += 4) { const float4 hv = *(const float4*)(h2 + tt * 64 + k); s += hv.x * w3c[k] + hv.y * w3c[k + 1] + hv.z * w3c[k + 2] + hv.w * w3c[k + 3]; }
        const int t = t0 + tt;
        s *= __expf(-((float)t / (float)(Lf - 1)) * delta);
        if (dir == 0 || t > 0) ssq_acc += s * s;
        sv[u] = s;
      }
      *(float4*)(orow + tq * 4) = make_float4(sv[0], sv[1], sv[2], sv[3]);
    }
    __syncthreads();
  }
  ssq[(size_t)bid * 512 + tid] = ssq_acc;
}

__host__ __device__ constexpr int fx(int p) {
  return ((p >> 12) & 3) ^ (((p >> 10) & 3) << 2) ^ ((p >> 4) & 16) ^ (((p >> 5) & 1) * 5) ^ (((p >> 6) & 1) * 26);
}
__device__ __forceinline__ int swz(int p) { return p ^ fx(p); }
__device__ __forceinline__ int rev7(int k) {
  unsigned r = __brev((unsigned)k) >> 18;
  return (int)(((r & 0x2AAAu) >> 1) | ((r & 0x1555u) << 1));
}
template <int ST, bool INV>
__device__ __forceinline__ void fft_stage(float2* s, const float2* __restrict__ tw, const int tid) {
  constexpr int sh = 12 - 2 * ST, q = 1 << sh, ND = q >= 512 ? q / 512 : 1;
  float2 w1[ND], w2[ND], w3[ND];
  if constexpr (ST < 6) {
#pragma unroll
    for (int d = 0; d < ND; ++d) {
      const int j = q >= 512 ? tid + 512 * d : (tid & (q - 1)), ti = j << (2 * ST);
      w1[d] = tw[ti]; w2[d] = tw[2 * ti]; w3[d] = tw[3 * ti];
    }
  }
  float2 x[8][4];
#pragma unroll
  for (int m = 0; m < 8; ++m) {
    const int u = tid + 512 * m, g = u >> sh, j = u & (q - 1), base = (g << (sh + 2)) + j, xb = fx(base);
    x[m][0] = s[base ^ xb]; x[m][1] = s[(base + q) ^ xb ^ fx(q)]; x[m][2] = s[(base + 2 * q) ^ xb ^ fx(2 * q)]; x[m][3] = s[(base + 3 * q) ^ xb ^ fx(3 * q)];
  }
#pragma unroll
  for (int m = 0; m < 8; ++m) {
    const int u = tid + 512 * m, g = u >> sh, j = u & (q - 1), base = (g << (sh + 2)) + j, xb = fx(base);
    const int i0 = base ^ xb, i1 = (base + q) ^ xb ^ fx(q), i2 = (base + 2 * q) ^ xb ^ fx(2 * q), i3 = (base + 3 * q) ^ xb ^ fx(3 * q);
    const int d = q >= 512 ? (m % ND) : 0;
    if constexpr (!INV) {
      const float2 a0 = x[m][0], a1 = x[m][1], a2 = x[m][2], a3 = x[m][3];
      const float2 b0 = make_float2(a0.x + a2.x, a0.y + a2.y), b1 = make_float2(a0.x - a2.x, a0.y - a2.y);
      const float2 b2 = make_float2(a1.x + a3.x, a1.y + a3.y), b3 = make_float2(a1.x - a3.x, a1.y - a3.y);
      const float2 y1 = make_float2(b1.x + b3.y, b1.y - b3.x), y2 = make_float2(b0.x - b2.x, b0.y - b2.y), y3 = make_float2(b1.x - b3.y, b1.y + b3.x);
      s[i0] = make_float2(b0.x + b2.x, b0.y + b2.y);
      if constexpr (ST < 6) { s[i1] = cmul(y1, w1[d]); s[i2] = cmul(y2, w2[d]); s[i3] = cmul(y3, w3[d]); }
      else { s[i1] = y1; s[i2] = y2; s[i3] = y3; }
    } else {
      float2 t0 = x[m][0], t1 = x[m][1], t2 = x[m][2], t3 = x[m][3];
      if constexpr (ST < 6) { t1 = cmulc(t1, w1[d]); t2 = cmulc(t2, w2[d]); t3 = cmulc(t3, w3[d]); }
      const float2 b0 = make_float2(t0.x + t2.x, t0.y + t2.y), b1 = make_float2(t0.x - t2.x, t0.y - t2.y);
      const float2 b2 = make_float2(t1.x + t3.x, t1.y + t3.y), b3 = make_float2(t1.x - t3.x, t1.y - t3.y);
      s[i0] = make_float2(b0.x + b2.x, b0.y + b2.y);
      s[i1] = make_float2(b1.x - b3.y, b1.y + b3.x);
      s[i2] = make_float2(b0.x - b2.x, b0.y - b2.y);
      s[i3] = make_float2(b1.x + b3.y, b1.y - b3.x);
    }
  }
  __syncthreads();
}
__device__ __forceinline__ void fft_fwd(float2* s, const float2* __restrict__ tw) {
  const int tid = ltid();
  fft_stage<0, false>(s, tw, tid); fft_stage<1, false>(s, tw, tid); fft_stage<2, false>(s, tw, tid); fft_stage<3, false>(s, tw, tid);
  fft_stage<4, false>(s, tw, tid); fft_stage<5, false>(s, tw, tid); fft_stage<6, false>(s, tw, tid);
}
__device__ __forceinline__ void fft_inv(float2* s, const float2* __restrict__ tw) {
  const int tid = ltid();
  fft_stage<6, true>(s, tw, tid); fft_stage<5, true>(s, tw, tid); fft_stage<4, true>(s, tw, tid); fft_stage<3, true>(s, tw, tid);
  fft_stage<2, true>(s, tw, tid); fft_stage<1, true>(s, tw, tid); fft_stage<0, true>(s, tw, tid);
}

__device__ __forceinline__ float filt_ssq(const float* __restrict__ part  , int ch, float* red  ) {
  const int tid = ltid();
  float v = part[(size_t)(tid >> 1) * 512 + (tid & 1) * 256 + ch];
  v = wave_sum(v);
  __syncthreads();
  if ((tid & 63) == 0) red[tid >> 6] = v;
  __syncthreads();
  return ((red[0] + red[1]) + (red[2] + red[3])) + ((red[4] + red[5]) + (red[6] + red[7]));
}
__device__ __forceinline__ void phase_hy_filtfft(const Params& p, int bid, int nb, char* lds) {
  float2* s = (float2*)lds;
  const int tid = ltid();
  for (int it = bid; it < 512; it += nb) {
    const int l = it >> 8, ch = it & 255;
    const float* hf = p.hfb() + (((size_t)l * 2 + 0) * 256 + ch) * SEQ;
    const float* hb = p.hfb() + (((size_t)l * 2 + 1) * 256 + ch) * SEQ;
#pragma unroll 8
    for (int m = tid; m < FM; m += NTHR) {
      const int n0 = 2 * m, n1 = 2 * m + 1;
      const float a = (n0 < SEQ) ? hf[n0] : (n0 == SEQ ? 0.f : hb[2 * SEQ - n0]);
      const float b = (n1 < SEQ) ? hf[n1] : hb[2 * SEQ - n1];
      s[swz(m)] = make_float2(a, b);
    }
    __syncthreads();
    fft_fwd(s, p.tw());
    const float sc = rsqrtf(filt_ssq(p.hpart() + (size_t)l * 256 * 512, ch, (float*)(lds + 139264))) * (1.f / 16384.f);
    float4* out = p.hspec() + ((size_t)l * 256 + ch) * HSP;
#pragma unroll 4
    for (int k = tid; k <= FM / 2; k += NTHR) {
      const float2 zk = s[swz(rev7(k))], zm = s[swz(rev7((FM - k) & (FM - 1)))];
      const float er = 0.5f * (zk.x + zm.x), ei = 0.5f * (zk.y - zm.y);
      const float dr = 0.5f * (zk.x - zm.x), di = 0.5f * (zk.y + zm.y);
      out[k] = make_float4(er * sc, ei * sc, di * sc, -dr * sc);
    }
    __syncthreads();
  }
}
constexpr int G_TILE_B = 256 * 64 * 2;
constexpr int G_STAGE_B = 2 * G_TILE_B;
constexpr int GEMM_LDS = 2 * G_STAGE_B;

__device__ __forceinline__ int lds_byte2(int r, int c) {
  const int st = (r >> 4) * 2 + (c >> 5), ob = (r & 15) * 64 + (c & 31) * 2;
  return st * 1024 + (ob ^ (((ob >> 9) & 1) << 5));
}
__device__ __forceinline__ void stage_rc2(int b, int& R, int& C) {
  const int st = b >> 10, sb = b & 1023, swz = sb ^ (((sb >> 9) & 1) << 5);
  R = (st >> 1) * 16 + (swz >> 6);
  C = (st & 1) * 32 + ((swz & 63) >> 1);
}
__device__ __forceinline__ void gemm_stage_coords(int (&sR)[4], int (&sC)[4]) {
  const int wid = ltid() >> 6, lane = ltid() & 63;
#pragma unroll
  for (int i = 0; i < 4; ++i) stage_rc2(wid * 1024 + i * 8192 + lane * 16, sR[i], sC[i]);
}

#define WAIT_V0() asm volatile("s_waitcnt vmcnt(0)" ::: "memory")

__device__ __forceinline__ void gemm256_core(const u16* const (&ap)[4], const u16* const (&bp)[4], int nt, char* shm, f32x4 (&acc)[8][4]) {
  const int tid = ltid(), wid = tid >> 6, lane = tid & 63, wr = wid >> 2, wc = wid & 3, fr = lane & 15, fq = lane >> 4;
#pragma unroll
  for (int m = 0; m < 8; ++m)
#pragma unroll
    for (int n = 0; n < 4; ++n) acc[m][n] = f32x4{0.f, 0.f, 0.f, 0.f};
#define G_SA(b) (shm + (b) * G_STAGE_B)
#define G_SB(b) (shm + (b) * G_STAGE_B + G_TILE_B)
#define G_STAGE(buf, kt) do { _Pragma("unroll") for (int i = 0; i < 4; ++i) {                                                   \
    __builtin_amdgcn_global_load_lds((const unsigned*)(ap[i] + (kt) * 64), (unsigned*)(G_SA(buf) + wid * 1024 + i * 8192), 16, 0, 0); \
    __builtin_amdgcn_global_load_lds((const unsigned*)(bp[i] + (kt) * 64), (unsigned*)(G_SB(buf) + wid * 1024 + i * 8192), 16, 0, 0); } } while (0)
  G_STAGE(0, 0); WAIT_V0(); __syncthreads();
#pragma unroll 1
  for (int t = 0; t < nt; ++t) {
    const int cur = t & 1;
    if (t + 1 < nt) G_STAGE(cur ^ 1, t + 1);
#pragma unroll
    for (int ks = 0; ks < 2; ++ks) {
      bf16x8 At[8], Bf[4];
#pragma unroll
      for (int m = 0; m < 8; ++m) At[m] = *(const bf16x8*)(G_SA(cur) + lds_byte2(wr * 128 + m * 16 + fr, ks * 32 + fq * 8));
#pragma unroll
      for (int n = 0; n < 4; ++n) Bf[n] = *(const bf16x8*)(G_SB(cur) + lds_byte2(wc * 64 + n * 16 + fr, ks * 32 + fq * 8));
#pragma unroll
      for (int m = 0; m < 8; ++m)
#pragma unroll
        for (int n = 0; n < 4; ++n) acc[m][n] = __builtin_amdgcn_mfma_f32_16x16x32_bf16(At[m], Bf[n], acc[m][n], 0, 0, 0);
      __builtin_amdgcn_sched_barrier(0);
    }
    WAIT_V0(); __syncthreads();
  }
#undef G_STAGE
}

#define LAS3 __attribute__((address_space(3)))
constexpr int G8_HTB = 128 * 64 * 2;
__device__ __forceinline__ int g8_perm32(int rho) { const int n = rho >> 4, i = rho & 15; return 8 * (i >> 2) + 4 * n + (i & 3); }
__device__ __forceinline__ int g8_lds_byte(int r, int c) { const int st = (r >> 4) * 2 + (c >> 5), rr = r & 15, cc = c & 31, ob = rr * 64 + cc * 2; return st * 1024 + (ob ^ (((ob >> 9) & 1) << 5)); }
__device__ __forceinline__ void g8_stage_rc(int b, int& R, int& C) { const int st = b / 1024, sb = b % 1024, swz = sb ^ (((sb >> 9) & 1) << 5); R = (st >> 1) * 16 + swz / 64; C = (st & 1) * 32 + (swz % 64) / 2; }
struct G8Unit { int pm, pn, e, ce, pre, ab; };
__device__ __forceinline__ void g8_cload(const float* __restrict__ src, float* dst) {
  __builtin_amdgcn_global_load_lds((const unsigned*)(src + (ltid() & 63) * 4), (LAS3 unsigned*)dst, 16, 0, 0);
}


template <bool I8> __device__ __forceinline__ typename std::conditional<I8, int __attribute__((ext_vector_type(4))), f32x4>::type
g8_mma(bf16x8 x, bf16x8 y, typename std::conditional<I8, int __attribute__((ext_vector_type(4))), f32x4>::type c) {
  if constexpr (I8) { typedef int v4i __attribute__((ext_vector_type(4))); return __builtin_amdgcn_mfma_i32_16x16x64_i8(*(v4i*)&x, *(v4i*)&y, c, 0, 0, 0); }
  else return __builtin_amdgcn_mfma_f32_16x16x32_bf16(x, y, c, 0, 0, 0);
}
typedef int i32x4 __attribute__((ext_vector_type(4)));
template <bool I8> struct G8Acc { typedef f32x4 T; };
template <> struct G8Acc<true> { typedef i32x4 T; };
template <bool I8, class Sched, class Epi>
__device__ __forceinline__ void gemm8_phase(char* lds_g, const char* Abase, const int Kb, const Sched& S, const Epi& E) {
    typedef typename G8Acc<I8>::T ACC;
    LAS3 unsigned char* lds = (LAS3 unsigned char*)lds_g;
    const int tid = ltid(), wid = __builtin_amdgcn_readfirstlane(tid >> 6), lane = tid & 63, wr = wid >> 2, wc = wid & 3, fr = lane & 15, fq = lane >> 4;
    const int nt = Kb / 128;
    int sRr[2], sCc[2]; unsigned voffB[2];
#pragma unroll
    for (int i = 0; i < 2; ++i) { g8_stage_rc(tid * 16 + i * 8192, sRr[i], sCc[i]); const int Rb = (sRr[i] & ~31) + g8_perm32(sRr[i] & 31); voffB[i] = (unsigned)(Rb * Kb) + (unsigned)sCc[i] * 2u; }
    const size_t kstep = 128;
    const size_t hstepB = (size_t)128 * Kb;
    const unsigned ldsw = (unsigned)wid * 1024u;
    const int aoff = g8_lds_byte(wr * 64 + fr, fq * 8), boff = g8_lds_byte(wc * 32 + fr, fq * 8);
#define G8_SA(b, h) (((b) * 2 + (h)) * G8_HTB)
#define G8_SB(b, h) ((4 + (b) * 2 + (h)) * G8_HTB)
#define G8_STAGE_B(bufoff, gbase) do { _Pragma("unroll") for (int _i = 0; _i < 2; ++_i) \
        __builtin_amdgcn_global_load_lds((const unsigned*)((const char*)(gbase) + voffB[_i]), (LAS3 unsigned*)(lds + (bufoff) + ldsw + _i * 8192), 16, 0, 0); } while (0)
#define G8_STAGE_A(bufoff, o0, o1) do { \
        __builtin_amdgcn_global_load_lds((const unsigned*)(Abase + (o0)), (LAS3 unsigned*)(lds + (bufoff) + ldsw), 16, 0, 0); \
        __builtin_amdgcn_global_load_lds((const unsigned*)(Abase + (o1)), (LAS3 unsigned*)(lds + (bufoff) + ldsw + 8192), 16, 0, 0); } while (0)
#define G8_LDA(dst, b, h) do { _Pragma("unroll") for (int m = 0; m < 4; ++m) _Pragma("unroll") for (int k = 0; k < 2; ++k) dst[m][k] = *(const LAS3 bf16x8*)(lds + G8_SA(b, h) + aoff + m * 2048 + k * 1024); } while (0)
#define G8_LDB(dst, b, h) do { _Pragma("unroll") for (int n = 0; n < 2; ++n) _Pragma("unroll") for (int k = 0; k < 2; ++k) dst[n][k] = *(const LAS3 bf16x8*)(lds + G8_SB(b, h) + boff + n * 2048 + k * 1024); } while (0)
#define G8_MMA(ai, bj, At, Bt) do { __builtin_amdgcn_s_setprio(1); _Pragma("unroll") for (int m = 0; m < 4; ++m) _Pragma("unroll") for (int n = 0; n < 2; ++n) _Pragma("unroll") for (int k = 0; k < 2; ++k) \
        acc[ai][bj][m][n] = g8_mma<I8>(Bt[n][k], At[m][k], acc[ai][bj][m][n]); __builtin_amdgcn_s_setprio(0); } while (0)
#define G8_WAIT_V(n) asm volatile("s_waitcnt vmcnt(" #n ")" ::: "memory")
#define G8_WAIT_L(n) asm volatile("s_waitcnt lgkmcnt(" #n ")" ::: "memory")
#define G8_BAR __builtin_amdgcn_s_barrier()
#define G8_SCHED __builtin_amdgcn_sched_barrier(0)
    G8Unit cur, nxt; int ui = 0;
    cur.e = 0; cur.pre = 0; cur.ab = 0;
    if (!S.next(0, cur, cur)) return;
    ACC acc[2][2][4][2];
#pragma unroll
    for (int a = 0; a < 2; ++a)
#pragma unroll
        for (int b = 0; b < 2; ++b)
#pragma unroll
            for (int m = 0; m < 4; ++m)
#pragma unroll
                for (int n = 0; n < 2; ++n) acc[a][b][m][n] = ACC{};
    bf16x8 At[4][2], B0[2][2], B1[2][2];
    float ep[8];
    unsigned va[2][2], vn[2][2];
#pragma unroll
    for (int h = 0; h < 2; ++h)
#pragma unroll
        for (int i = 0; i < 2; ++i) va[h][i] = S.a_off(cur, h * 128 + sRr[i]) + (unsigned)sCc[i] * 2u;
    const char* cB = S.b_ptr(cur);
    G8_STAGE_B(G8_SB(0, 0), cB); G8_STAGE_A(G8_SA(0, 0), va[0][0], va[0][1]); G8_STAGE_B(G8_SB(0, 1), cB + hstepB); G8_STAGE_A(G8_SA(0, 1), va[1][0], va[1][1]);
    if (wr == 1) G8_BAR;
    G8_WAIT_V(4); G8_BAR;
    G8_STAGE_B(G8_SB(1, 0), cB + kstep); G8_STAGE_A(G8_SA(1, 0), va[0][0] + kstep, va[0][1] + kstep); G8_STAGE_B(G8_SB(1, 1), cB + hstepB + kstep);
    G8_WAIT_V(6); G8_BAR;
    for (;;) {
        float* cb = (float*)(lds_g + 136192 + (ui & 1) * 3072);
        const int* rt = (const int*)(lds_g + 142336 + (ui & 1) * 1024);
        E.pre(cur, wr, fr, ep, cb);
        const bool has_next = S.next(ui + 1, nxt, cur);
        const char* nB = cB;
#pragma unroll
        for (int h = 0; h < 2; ++h)
#pragma unroll
            for (int i = 0; i < 2; ++i) vn[h][i] = va[h][i];
        int rlim = 0;
        if (has_next) {
            nB = S.b_ptr(nxt);
            if constexpr (Sched::GATHER) {
                if ((tid >> 6) == 3) S.rows_to_lds(nxt, (int*)rt);
                rlim = nxt.ce - 1 - nxt.pm * 256;
            } else {
#pragma unroll
                for (int h = 0; h < 2; ++h)
#pragma unroll
                    for (int i = 0; i < 2; ++i) vn[h][i] = S.a_off(nxt, h * 128 + sRr[i]) + (unsigned)sCc[i] * 2u;
            }
        }
#pragma unroll 1
        for (int t = 0; t < nt; t += 2) {
            const bool last = (t == nt - 2);
            const unsigned k1 = (unsigned)(t + 1) * 128u;
            const unsigned k2 = last ? 0u : (unsigned)(t + 2) * 128u;
            if constexpr (Sched::GATHER) {
                if (has_next) {
#pragma unroll
                    for (int h = 0; h < 2; ++h)
#pragma unroll
                        for (int i = 0; i < 2; ++i) vn[h][i] = (unsigned)rt[min(h * 128 + sRr[i], rlim)] * (unsigned)Kb + (unsigned)sCc[i] * 2u;
                }
            }
            const unsigned a2_00 = (last ? vn[0][0] : va[0][0]) + k2, a2_01 = (last ? vn[0][1] : va[0][1]) + k2;
            const unsigned a2_10 = (last ? vn[1][0] : va[1][0]) + k2, a2_11 = (last ? vn[1][1] : va[1][1]) + k2;
            const char* b2 = (last ? nB : cB) + k2; const char* b3 = b2 + kstep;
            G8_LDB(B0, 0, 0); G8_SCHED; G8_LDA(At, 0, 0); G8_STAGE_A(G8_SA(1, 1), va[1][0] + k1, va[1][1] + k1);
            G8_WAIT_L(8); G8_BAR; G8_WAIT_L(0); G8_MMA(0, 0, At, B0); G8_BAR; G8_SCHED;
            G8_LDB(B1, 0, 1); G8_STAGE_B(G8_SB(0, 0), b2);
            G8_BAR; G8_WAIT_L(0); G8_MMA(0, 1, At, B1); G8_BAR;
            G8_LDA(At, 0, 1); G8_STAGE_A(G8_SA(0, 0), a2_00, a2_01);
            G8_BAR; G8_WAIT_L(0); G8_MMA(1, 0, At, B0); G8_BAR; G8_SCHED;
            G8_STAGE_B(G8_SB(0, 1), b2 + hstepB);
            G8_WAIT_V(6); G8_BAR; G8_MMA(1, 1, At, B1); G8_BAR;
            G8_LDB(B0, 1, 0); G8_SCHED; G8_LDA(At, 1, 0); G8_STAGE_A(G8_SA(0, 1), a2_10, a2_11);
            G8_WAIT_L(8); G8_BAR; G8_WAIT_L(0); G8_MMA(0, 0, At, B0); G8_BAR; G8_SCHED;
            G8_LDB(B1, 1, 1); G8_STAGE_B(G8_SB(1, 0), b3);
            G8_BAR; G8_WAIT_L(0); G8_MMA(0, 1, At, B1); G8_BAR;
            G8_LDA(At, 1, 1); G8_STAGE_A(G8_SA(1, 0), a2_00 + 128u, a2_01 + 128u);
            G8_BAR; G8_WAIT_L(0); G8_MMA(1, 0, At, B0); G8_BAR; G8_SCHED;
            G8_STAGE_B(G8_SB(1, 1), b3 + hstepB);
            G8_WAIT_V(6); G8_BAR; G8_MMA(1, 1, At, B1); G8_BAR;
        }
        E(acc, cur, wr, wc, fr, fq, ep, cb);
        if (!has_next) break;
#pragma unroll
        for (int a = 0; a < 2; ++a)
#pragma unroll
            for (int b = 0; b < 2; ++b)
#pragma unroll
                for (int m = 0; m < 4; ++m)
#pragma unroll
                    for (int n = 0; n < 2; ++n) acc[a][b][m][n] = ACC{};
        cur = nxt; cB = nB; ++ui;
#pragma unroll
        for (int h = 0; h < 2; ++h)
#pragma unroll
            for (int i = 0; i < 2; ++i) va[h][i] = vn[h][i];
    }
    G8_WAIT_V(0);
    if (wr == 0) G8_BAR;
    G8_BAR;
#undef G8_SA
#undef G8_SB
#undef G8_STAGE_A
#undef G8_STAGE_B
#undef G8_LDA
#undef G8_LDB
#undef G8_MMA
#undef G8_WAIT_V
#undef G8_WAIT_L
#undef G8_BAR
#undef G8_SCHED
}
struct G8Plain {
    static constexpr bool GATHER = false;
    int nM, nN, Kb, G, c; const char* Bt;
    __device__ __forceinline__ bool next(int i, G8Unit& u, const G8Unit&) const {
        const int L = (i * 8 + (c & 7)) * (G >> 3) + (c >> 3); if (L >= nM * nN) return false;
        const int nig = 8 * nN, gid = L / nig, fm = gid * 8, gsz = (nM - fm) < 8 ? (nM - fm) : 8;
        u.pm = fm + ((L % nig) % gsz); u.pn = (L % nig) / gsz; u.e = 0; u.ce = 256; u.pre = 0; return true;
    }
    __device__ __forceinline__ int a_row(const G8Unit& u, int row) const { return u.pm * 256 + row; }
    __device__ __forceinline__ unsigned a_off(const G8Unit& u, int row) const { return (unsigned)a_row(u, row) * (unsigned)Kb; }
    __device__ __forceinline__ const char* b_ptr(const G8Unit& u) const { return Bt + (size_t)u.pn * 256 * Kb; }
};

__device__ __forceinline__ const float* resid_row_in(const Params& p, int tok) {
  return tok < TL ? p.x() + (size_t)tok * DM : p.ctx() + (size_t)(tok - TL) * DM;
}
__device__ __forceinline__ void load_row_comb(const Params& p, int src_layer, int lc, int tok, int lane, const int* pre  , float (&v)[16]) {
  if (src_layer == 0) {
    const float* r = resid_row_in(p, tok);
#pragma unroll
    for (int i = 0; i < 4; ++i) { const float4 a = *(const float4*)(r + lane * 4 + i * 256); v[4 * i] = a.x; v[4 * i + 1] = a.y; v[4 * i + 2] = a.z; v[4 * i + 3] = a.w; }
  } else {
    const u16* r = p.X() + (size_t)tok * DM;
#pragma unroll
    for (int i = 0; i < 4; ++i) { const float4 a = ld4bf(r + lane * 4 + i * 256); v[4 * i] = a.x; v[4 * i + 1] = a.y; v[4 * i + 2] = a.z; v[4 * i + 3] = a.w; }
  }
  if (lc >= 0) {
    const float* g2 = p.mod() + ((size_t)lc * 3 + modv(tok)) * 6144 + 5 * DM;
    float s[16];
#pragma unroll
    for (int i = 0; i < 16; ++i) s[i] = 0.f;
#pragma unroll
    for (int k = 0; k < TOPK; ++k) {
      const int sl = p.tslot()[tok * 4 + k];
      const size_t arow = (size_t)(pre[sl >> 20] + (sl & 0xFFFFF));
      const unsigned char* y = p.yd() + arow * DM;
#pragma unroll
      for (int i = 0; i < 4; ++i) {
        const int w = *(const int*)(y + lane * 4 + i * 256);
        const auto lo = __builtin_amdgcn_cvt_pk_f32_fp8(w, false), hi2 = __builtin_amdgcn_cvt_pk_f32_fp8(w, true);
        s[4 * i] += lo[0]; s[4 * i + 1] += lo[1]; s[4 * i + 2] += hi2[0]; s[4 * i + 3] += hi2[1];
      }
    }
#pragma unroll
    for (int i = 0; i < 4; ++i) {
      const float4 g = *(const float4*)(g2 + lane * 4 + i * 256);
      v[4 * i] += g.x * 0.125f * s[4 * i]; v[4 * i + 1] += g.y * 0.125f * s[4 * i + 1]; v[4 * i + 2] += g.z * 0.125f * s[4 * i + 2]; v[4 * i + 3] += g.w * 0.125f * s[4 * i + 3];
    }
  }
}
__device__ __forceinline__ void expert_prefix(const int* cnt, int* pre) {
  if (ltid() == 0) { int s = 0; for (int e = 0; e < NE; ++e) { pre[e] = s; s += cnt[e]; } pre[NE] = s; }
}

__device__ __forceinline__ float store_row_i8(const float (&y)[16], signed char* __restrict__ h, float* __restrict__ hs_row, int lane) {
  float am = 0.f;
#pragma unroll
  for (int i = 0; i < 16; ++i) am = fmaxf(am, fabsf(y[i]));
  am = wave_max(am);
  const float s = fmaxf(am, 1e-20f) * (1.f / 127.f), inv = 1.f / s;
#pragma unroll
  for (int i = 0; i < 4; ++i) {
    const int q0 = (int)rintf(y[4 * i] * inv), q1 = (int)rintf(y[4 * i + 1] * inv), q2 = (int)rintf(y[4 * i + 2] * inv), q3 = (int)rintf(y[4 * i + 3] * inv);
    *(unsigned*)(h + lane * 4 + i * 256) = (unsigned)(q0 & 255) | ((unsigned)(q1 & 255) << 8) | ((unsigned)(q2 & 255) << 16) | ((unsigned)(q3 & 255) << 24);
  }
  if (lane == 0) *hs_row = s;
  return s;
}
__device__ __forceinline__ void phase_quant_in(const Params& p, int bid, int nb) {
  const int wid = ltid() >> 6, lane = ltid() & 63;
  for (int r = bid * 8 + wid; r < 2 * NIN; r += nb * 8) {
    const float* src = p.btf() + (size_t)r * DM;
    float y[16];
#pragma unroll
    for (int i = 0; i < 4; ++i) { const float4 a = *(const float4*)(src + lane * 4 + i * 256); y[4 * i] = a.x; y[4 * i + 1] = a.y; y[4 * i + 2] = a.z; y[4 * i + 3] = a.w; }
    store_row_i8(y, p.bt_in() + (size_t)r * DM, p.swin() + r, lane);
  }
}
__device__ __forceinline__ void phase_norm1(const Params& p, int layer, int bid, int nb, char* lds) {
  int* pre = (int*)lds;
  const int lc = layer - 1;
  if (lc >= 0) { expert_prefix(p.cnt() + lc * NE, pre); __syncthreads(); }
  const int wid = ltid() >> 6, lane = ltid() & 63;
  const float* gn = p.norm1_g() + layer * DM;
  const int ntok = TT;
  for (int tok = bid * 8 + wid; tok < ntok; tok += nb * 8) {
    float v[16];
    load_row_comb(p, layer == 0 ? 0 : 1, lc, tok, lane, pre, v);
    if (lc >= 0) {
      u16* xr = p.X() + (size_t)tok * DM;
#pragma unroll
      for (int i = 0; i < 4; ++i) *(u32x2*)(xr + lane * 4 + i * 256) = u32x2{cvtpk(v[4 * i], v[4 * i + 1]), cvtpk(v[4 * i + 2], v[4 * i + 3])};
    }
    float ss = 0;
#pragma unroll
    for (int i = 0; i < 16; ++i) ss += v[i] * v[i];
    ss = wave_sum(ss);
    const float rs = rsqrtf(ss * (1.f / DM) + EPS);
    const float* md = p.mod() + ((size_t)layer * 3 + modv(tok)) * 6144;
#pragma unroll
    for (int i = 0; i < 4; ++i) {
      const int c = lane * 4 + i * 256;
      const float4 g = *(const float4*)(gn + c), sh = *(const float4*)(md + c), sc = *(const float4*)(md + DM + c);
      v[4 * i] = v[4 * i] * rs * g.x * (1.f + sc.x) + sh.x; v[4 * i + 1] = v[4 * i + 1] * rs * g.y * (1.f + sc.y) + sh.y;
      v[4 * i + 2] = v[4 * i + 2] * rs * g.z * (1.f + sc.z) + sh.z; v[4 * i + 3] = v[4 * i + 3] * rs * g.w * (1.f + sc.w) + sh.w;
    }
    store_row_i8(v, p.H() + (size_t)tok * DM, p.hs() + tok, lane);
  }
}

struct EpiIn {
  u16* zqkv; u16* zg; u16* zt; const float* hs; const float* sw;
  __device__ __forceinline__ void pre(const G8Unit& u, int wr, int fr, float (&ep)[8], float* cb) const {
    if ((ltid() >> 6) == 0) g8_cload(sw + u.pn * 256, cb);
    if ((ltid() >> 6) == 2) g8_cload(hs + u.pm * 256, cb + 512);
  }
  __device__ __forceinline__ void operator()(const i32x4 (&acc)[2][2][4][2], const G8Unit& u, int wr, int wc, int fr, int fq, const float (&ep)[8], const float* cb) const {
#pragma unroll
    for (int bj = 0; bj < 2; ++bj) {
      const int c32 = u.pn * 256 + bj * 128 + wc * 32, c0 = c32 + 8 * fq;
      const f32x4 w0 = *(const f32x4*)(cb + bj * 128 + wc * 32 + 8 * fq), w1 = *(const f32x4*)(cb + bj * 128 + wc * 32 + 8 * fq + 4);
#pragma unroll
      for (int ai = 0; ai < 2; ++ai)
#pragma unroll
        for (int m = 0; m < 4; ++m) {
          const int row = u.pm * 256 + ai * 128 + wr * 64 + m * 16 + fr;
          const float sa = cb[512 + ai * 128 + wr * 64 + m * 16 + fr];
          f32x4 a, b;
#pragma unroll
          for (int j = 0; j < 4; ++j) { a[j] = (float)acc[ai][bj][m][0][j] * sa * w0[j]; b[j] = (float)acc[ai][bj][m][1][j] * sa * w1[j]; }
          if (c32 < 384) {
            *(u32x4*)(zqkv + (size_t)row * 384 + c0) = u32x4{cvtpk(a[0], a[1]), cvtpk(a[2], a[3]), cvtpk(b[0], b[1]), cvtpk(b[2], b[3])};
          } else if (c32 < 1536) {
            *(u32x4*)(zg + (size_t)row * ZG_W + (c0 - 384)) = u32x4{cvtpk(a[0], a[1]), cvtpk(a[2], a[3]), cvtpk(b[0], b[1]), cvtpk(b[2], b[3])};
          } else {
#pragma unroll
            for (int j = 0; j < 4; ++j) { zt[(size_t)(c0 - 1536 + j) * TT + row] = f2bf(a[j]); zt[(size_t)(c0 - 1536 + 4 + j) * TT + row] = f2bf(b[j]); }
          }
        }
    }
  }
};
__device__ __forceinline__ void phase_gemm_in(const Params& p, int layer, int bid, int nb, char* lds) {
  G8Plain S; S.nM = TT / 256; S.nN = NIN / 256; S.Kb = DM; S.G = nb; S.c = bid; S.Bt = (const char*)(p.bt_in() + (size_t)layer * NIN * DM);
  EpiIn E; E.zqkv = p.zqkv(); E.zg = p.zg(); E.zt = p.zt(); E.hs = p.hs(); E.sw = p.swin() + layer * NIN;
  gemm8_phase<true>(lds, (const char*)p.H(), DM, S, E);
}

__device__ __forceinline__ size_t qkv_row(int tok, int h) {
  const int b = tok < TL ? (tok >> 14) : ((tok - TL) >> 8);
  const int s = tok < TL ? (tok & (SEQ - 1)) : SEQ + ((tok - TL) & (LC - 1));
  return ((size_t)(b * 4 + h)) * SKV + s;
}
struct EpiQkv {
  const u16* zqkv; u16* Q; u16* KV; const float* ropec; const float* ropes; float* rsl;
  unsigned* kmx;
  __device__ __forceinline__ void pre(const G8Unit&, int, int, float (&)[8], float*) const {}
  __device__ __forceinline__ void operator()(const f32x4 (&acc)[2][2][4][2], const G8Unit& u, int wr, int wc, int fr, int fq, const float (&)[8], const float*) const {
    const int tid = ltid();
    {
      const int r = tid >> 1, half = tid & 1;
      const u16* row = zqkv + (size_t)(u.pm * 256 + r) * 384;
      float sq = 0, sk = 0;
#pragma unroll
      for (int i = 0; i < 16; ++i) {
        const u32x4 w = *(const u32x4*)(row + half * 128 + i * 8);
#pragma unroll
        for (int q = 0; q < 4; ++q) { const float a = __uint_as_float(w[q] << 16), b = __uint_as_float(w[q] & 0xFFFF0000u); sq += a * a + b * b; }
      }
#pragma unroll
      for (int i = 0; i < 8; ++i) {
        const u32x4 w = *(const u32x4*)(row + 256 + half * 64 + i * 8);
#pragma unroll
        for (int q = 0; q < 4; ++q) { const float a = __uint_as_float(w[q] << 16), b = __uint_as_float(w[q] & 0xFFFF0000u); sk += a * a + b * b; }
      }
      sq += shx<1>(sq); sk += shx<1>(sk);
      if (half == 0) { rsl[r] = rsqrtf(sq * (1.f / 256.f) + EPS); rsl[256 + r] = rsqrtf(sk * (1.f / 128.f) + EPS); }
    }
    asm volatile("s_waitcnt lgkmcnt(0)" ::: "memory"); __builtin_amdgcn_s_barrier(); __builtin_amdgcn_s_barrier(); asm volatile("" ::: "memory");
    const float* rsp = rsl + (u.pn >= 2 ? 256 : 0);
#pragma unroll
    for (int ai = 0; ai < 2; ++ai)
#pragma unroll
      for (int m = 0; m < 4; ++m) {
        const int rl = ai * 128 + wr * 64 + m * 16 + fr, tok = u.pm * 256 + rl;
        const float rs = rsp[rl] * (u.pn < 2 ? A_QSCALE : 1.f);
        if (u.pn == 1) {
          f32x4 a = acc[ai][0][m][0] * rs, b = acc[ai][0][m][1] * rs;
          f32x4 pa, pb;
#pragma unroll
          for (int j = 0; j < 4; ++j) { pa[j] = shx<32>(a[j]); pb[j] = shx<32>(b[j]); }
          f32x4 ca = {1.f, 1.f, 1.f, 1.f}, cb = ca, sa = {0.f, 0.f, 0.f, 0.f}, sb = sa;
          if (tok < TL) {
            const float* cp = ropec + (size_t)(tok & (SEQ - 1)) * 16 + 8 * (fq & 1); const float* sp = ropes + (size_t)(tok & (SEQ - 1)) * 16 + 8 * (fq & 1);
            ca = *(const f32x4*)cp; cb = *(const f32x4*)(cp + 4); sa = *(const f32x4*)sp; sb = *(const f32x4*)(sp + 4);
          }
          const float sg = fq < 2 ? -1.f : 1.f;
          a = a * ca + pa * sa * sg; b = b * cb + pb * sb * sg;
          *(u32x4*)(Q + qkv_row(tok, wc) * 96 + 64 + 8 * fq) = u32x4{cvtpk(a[0], a[1]), cvtpk(a[2], a[3]), cvtpk(b[0], b[1]), cvtpk(b[2], b[3])};
        } else {
#pragma unroll
          for (int bj = 0; bj < 2; ++bj) {
            const int c = bj * 128 + wc * 32 + 8 * fq, h = c >> 6, d = c & 63;
            const f32x4 a = acc[ai][bj][m][0] * rs, b = acc[ai][bj][m][1] * rs;
            u16* dst = u.pn == 0 ? Q + qkv_row(tok, h) * 96 + d : KV + qkv_row(tok, h) * 160 + (u.pn == 2 ? 0 : 96) + d;
            *(u32x4*)dst = u32x4{cvtpk(a[0], a[1]), cvtpk(a[2], a[3]), cvtpk(b[0], b[1]), cvtpk(b[2], b[3])};
          }
        }
      }
    if (u.pn == 2) {
      const int b = u.pm * 256 < TL ? (u.pm * 256) >> 14 : (u.pm * 256 - TL) >> 8;
#pragma unroll
      for (int bj = 0; bj < 2; ++bj) {
        float mx = 0.f;
#pragma unroll
        for (int ai = 0; ai < 2; ++ai)
#pragma unroll
          for (int m = 0; m < 4; ++m) {
            const float rs = rsp[ai * 128 + wr * 64 + m * 16 + fr];
            const f32x4 a = acc[ai][bj][m][0] * rs, b4 = acc[ai][bj][m][1] * rs;
            float ss = a[0] * a[0] + a[1] * a[1] + a[2] * a[2] + a[3] * a[3] + b4[0] * b4[0] + b4[1] * b4[1] + b4[2] * b4[2] + b4[3] * b4[3];
            ss += shx<16>(ss); ss += shx<32>(ss);
            mx = fmaxf(mx, ss);
          }
        mx = fmaxf(mx, shx<8>(mx)); mx = fmaxf(mx, shx<4>(mx)); mx = fmaxf(mx, shx<2>(mx)); mx = fmaxf(mx, shx<1>(mx));
        if ((ltid() & 63) == 0) atomicMax(kmx + (b * 4 + bj * 2 + (wc >> 1)) * 4 + (wc & 1), __float_as_uint(mx));
      }
    }
  }
};
__device__ __forceinline__ void phase_qkv(const Params& p, int layer, int bid, int nb, char* lds) {
  const int tid = ltid();
  {
    G8Plain S; S.nM = TT / 256; S.nN = 4; S.Kb = 768; S.G = nb; S.c = bid; S.Bt = (const char*)(p.bt_qkv() + (size_t)layer * 1024 * 384);
    EpiQkv E; E.zqkv = p.zqkv(); E.Q = p.Q(); E.KV = p.KV(); E.ropec = p.ropec(); E.ropes = p.ropes(); E.rsl = (float*)(lds + 131072); E.kmx = p.kmx() + layer * 32;
    gemm8_phase<false>(lds, (const char*)p.zqkv(), 768, S, E);
  }
  float krm0 = 0.f, krm1 = 0.f;
  for (int i = bid * NTHR + tid; i < TT * 16; i += nb * NTHR) {
    const int tok = i >> 4, f = i & 15;
    const float x1 = bf2f(p.zg()[(size_t)tok * ZG_W + ZG_KR + f]), x2 = bf2f(p.zg()[(size_t)tok * ZG_W + ZG_KR + 16 + f]);
    float cs = 1.f, sn = 0.f;
    if (tok < TL) { const int tpos = tok & (SEQ - 1); cs = p.ropec()[tpos * 16 + f]; sn = p.ropes()[tpos * 16 + f]; }
    const float y1 = x1 * cs - x2 * sn, y2 = x2 * cs + x1 * sn;
    const u16 o1 = f2bf(y1), o2 = f2bf(y2);
#pragma unroll
    for (int h = 0; h < 4; ++h) { u16* kv = p.KV() + qkv_row(tok, h) * 160 + 64; kv[f] = o1; kv[16 + f] = o2; }
    float ss = y1 * y1 + y2 * y2;
    ss += shx<8>(ss); ss += shx<4>(ss); ss += shx<2>(ss); ss += shx<1>(ss);
    const int b = tok < TL ? (tok >> 14) : ((tok - TL) >> 8);
    if (b == 0) krm0 = fmaxf(krm0, ss); else krm1 = fmaxf(krm1, ss);
  }
  krm0 = wave_max(krm0); krm1 = wave_max(krm1);
  if ((tid & 63) == 0) { atomicMax(p.kmx() + layer * 32 + 0 * 16 + 2, __float_as_uint(krm0)); atomicMax(p.kmx() + layer * 32 + 1 * 16 + 2, __float_as_uint(krm1)); }
}

constexpr int A_KROW = 208;
constexpr int A_TV = 128 * 64 * 2;
constexpr int A_TK = 128 * A_KROW;
constexpr int A_BUF = A_TV + A_TK;
constexpr int A_OFF_W = 3 * A_BUF;
constexpr int ATTN_LDS = A_OFF_W + 8 * 64 * 4;
#define SBAR() __builtin_amdgcn_sched_barrier(0)
__device__ __forceinline__ int crow(int r, int hi) { return (r & 3) + 8 * (r >> 2) + 4 * hi; }

__device__ __forceinline__ void a_partialSM(f32x16& p0) {
#pragma unroll
  for (int r = 0; r < 16; ++r) p0[r] = __builtin_amdgcn_exp2f(p0[r]);
}
__device__ __forceinline__ void a_finishSM(f32x16& p0, f32x16& p1, bf16x8& pa0, bf16x8& pa1, bf16x8& pa2, bf16x8& pa3) {
#pragma unroll
  for (int r = 0; r < 16; ++r) p1[r] = __builtin_amdgcn_exp2f(p1[r]);
#define PK4(P, BASE, OUT) do { unsigned a0 = cvtpk(P[BASE + 0], P[BASE + 1]), a1 = cvtpk(P[BASE + 2], P[BASE + 3]);   \
    unsigned b0 = cvtpk(P[BASE + 4], P[BASE + 5]), b1 = cvtpk(P[BASE + 6], P[BASE + 7]);                              \
    auto r0 = __builtin_amdgcn_permlane32_swap(a0, b0, false, false); auto r1 = __builtin_amdgcn_permlane32_swap(a1, b1, false, false); \
    u32x4 w = {r0[0], r1[0], r0[1], r1[1]}; OUT = *reinterpret_cast<bf16x8*>(&w); } while (0)
  PK4(p0, 0, pa0); PK4(p0, 8, pa1); PK4(p1, 0, pa2); PK4(p1, 8, pa3);
#undef PK4
}
__device__ __forceinline__ void a_qkt(f32x16& p0, f32x16& p1, const char* Ks, const bf16x8* qr, const float mneg, int r32, int hi) {
#pragma unroll
  for (int r = 0; r < 16; ++r) { p0[r] = mneg; p1[r] = mneg; }
#pragma unroll
  for (int d0 = 0; d0 < 6; ++d0) {
    const int cb = (d0 * 16 + hi * 8) * 2;
    const bf16x8 b0 = *reinterpret_cast<const bf16x8*>(Ks + r32 * A_KROW + cb);
    const bf16x8 b1 = *reinterpret_cast<const bf16x8*>(Ks + (32 + r32) * A_KROW + cb);
    p0 = __builtin_amdgcn_mfma_f32_32x32x16_bf16(b0, qr[d0], p0, 0, 0, 0); p1 = __builtin_amdgcn_mfma_f32_32x32x16_bf16(b1, qr[d0], p1, 0, 0, 0);
  }
}
__device__ __forceinline__ int a_v_st(int k, int c) { const int kk = (k & ~0xC) | ((k & 4) << 1) | ((k & 8) >> 1); return ((kk >> 3) * 2 + (c >> 5)) * 512 + ((kk & 7) * 32 + (c & 31)) * 2; }
__device__ __forceinline__ int a_v_rd_base(int lane) { return ((lane & 3) << 3) | (((lane >> 2) & 3) << 6) | (((lane >> 4) & 1) << 5) | (((lane >> 5) & 1) << 8); }
constexpr int a_v_rd_off(int d0, int ks, int half) { return d0 * 512 + ks * 2048 + half * 1024; }
template <int OFF> __device__ __forceinline__ s16x4 a_tr_read(int vb) {
  s16x4 r; asm volatile("ds_read_b64_tr_b16 %0, %1 offset:%2" : "=&v"(r) : "v"(vb), "i"(OFF) : "memory"); return r;
}
template <int D0> __device__ __forceinline__ void a_pv_one(f32x16& od, int vb, bf16x8 pa0, bf16x8 pa1, bf16x8 pa2, bf16x8 pa3) {
  const s16x4 l0 = a_tr_read<a_v_rd_off(D0, 0, 0)>(vb), h0 = a_tr_read<a_v_rd_off(D0, 0, 1)>(vb), l1 = a_tr_read<a_v_rd_off(D0, 1, 0)>(vb), h1 = a_tr_read<a_v_rd_off(D0, 1, 1)>(vb);
  const s16x4 l2 = a_tr_read<a_v_rd_off(D0, 2, 0)>(vb), h2 = a_tr_read<a_v_rd_off(D0, 2, 1)>(vb), l3 = a_tr_read<a_v_rd_off(D0, 3, 0)>(vb), h3 = a_tr_read<a_v_rd_off(D0, 3, 1)>(vb);
  asm volatile("s_waitcnt lgkmcnt(0)" ::: "memory"); SBAR();
#define PK(L, H) (bf16x8){L[0], L[1], L[2], L[3], H[0], H[1], H[2], H[3]}
  od = __builtin_amdgcn_mfma_f32_32x32x16_bf16(pa0, PK(l0, h0), od, 0, 0, 0);
  od = __builtin_amdgcn_mfma_f32_32x32x16_bf16(pa1, PK(l1, h1), od, 0, 0, 0);
  od = __builtin_amdgcn_mfma_f32_32x32x16_bf16(pa2, PK(l2, h2), od, 0, 0, 0);
  od = __builtin_amdgcn_mfma_f32_32x32x16_bf16(pa3, PK(l3, h3), od, 0, 0, 0);
#undef PK
}
__device__ __forceinline__ void a_pv(f32x16* o, int vb, bf16x8 pa0, bf16x8 pa1, bf16x8 pa2, bf16x8 pa3) {
  a_pv_one<0>(o[0], vb, pa0, pa1, pa2, pa3);
  { const bf16x8 ones = {0x3F80, 0x3F80, 0x3F80, 0x3F80, 0x3F80, 0x3F80, 0x3F80, 0x3F80};
    o[2] = __builtin_amdgcn_mfma_f32_32x32x16_bf16(pa0, ones, o[2], 0, 0, 0); o[2] = __builtin_amdgcn_mfma_f32_32x32x16_bf16(pa1, ones, o[2], 0, 0, 0);
    o[2] = __builtin_amdgcn_mfma_f32_32x32x16_bf16(pa2, ones, o[2], 0, 0, 0); o[2] = __builtin_amdgcn_mfma_f32_32x32x16_bf16(pa3, ones, o[2], 0, 0, 0); }
  a_pv_one<1>(o[1], vb, pa0, pa1, pa2, pa3);
}

__device__ __forceinline__ void attn_item(const u16* __restrict__ Qb, const u16* __restrict__ KVh, int seq, float kmax, u16* __restrict__ yout  , char* lds) {
  const int tid = ltid(), wid = tid >> 6, lane = tid & 63, r32 = lane & 31, hi = lane >> 5;
  f32x16 o[3] = {}; bf16x8 qr[6];
  const u16* Qw = Qb + (size_t)(wid * 32 + r32) * 96 + hi * 8;
#pragma unroll
  for (int d0 = 0; d0 < 6; ++d0) qr[d0] = *reinterpret_cast<const bf16x8*>(Qw + d0 * 16);
  float mneg;
  {
    float ss = 0.f;
#pragma unroll
    for (int d0 = 0; d0 < 6; ++d0)
#pragma unroll
      for (int j = 0; j < 8; ++j) { const float v = bf2f((u16)qr[d0][j]); ss += v * v; }
    ss += shx<32>(ss);
    mneg = -sqrtf(ss) * kmax;
  }
  int lw[5];
#pragma unroll
  for (int i = 0; i < 5; ++i) {
    const int g = tid + i * 512, key = g / 20, cc = g % 20;
    lw[i] = cc < 12 ? (A_TV + key * A_KROW + cc * 16) : ((key >> 6) * 8192 + a_v_st(key & 63, (cc - 12) * 8));
  }
  const int vrb = (int)(uintptr_t)lds + a_v_rd_base(lane);
  bf16x8 sg[5];
  const char* gsrc = (const char*)KVh + tid * 16;
#define SLOAD(t) do { const char* s_ = gsrc + (size_t)(t) * 40960; _Pragma("unroll") for (int i = 0; i < 5; ++i) sg[i] = *(const bf16x8*)(s_ + i * 8192); } while (0)
#define SWRITE(bo_) do { _Pragma("unroll") for (int i = 0; i < 5; ++i) *(bf16x8*)(lds + (bo_) + lw[i]) = sg[i]; } while (0)
  f32x16 pA0, pA1, pB0, pB1; bf16x8 pa0, pa1, pa2, pa3; const int NT = seq / 128;
  SLOAD(0); SWRITE(0); if (1 < NT) SLOAD(1);
  __syncthreads();
  int bo = 0;
  {
    if (1 < NT) { SWRITE(A_BUF); if (2 < NT) SLOAD(2); }
    SBAR(); a_qkt(pA0, pA1, lds + bo + A_TV, qr, mneg, r32, hi); a_partialSM(pA0);
    SBAR(); a_qkt(pB0, pB1, lds + bo + A_TV + 64 * A_KROW, qr, mneg, r32, hi);
    a_finishSM(pA0, pA1, pa0, pa1, pa2, pa3); SBAR();
    a_pv(o, vrb + bo, pa0, pa1, pa2, pa3); a_partialSM(pB0);
    __syncthreads();
  }
  for (int t = 1; t < NT; ++t) {
    const int bp = bo;
    bo = bo + A_BUF; if (bo == 3 * A_BUF) bo = 0;
    int bn = bo + A_BUF; if (bn == 3 * A_BUF) bn = 0;
    if (t + 1 < NT) { SWRITE(bn); if (t + 2 < NT) SLOAD(t + 2); }
    SBAR(); a_qkt(pA0, pA1, lds + bo + A_TV, qr, mneg, r32, hi);
    a_finishSM(pB0, pB1, pa0, pa1, pa2, pa3); SBAR();
    a_pv(o, vrb + bp + 8192, pa0, pa1, pa2, pa3); a_partialSM(pA0);
    SBAR(); a_qkt(pB0, pB1, lds + bo + A_TV + 64 * A_KROW, qr, mneg, r32, hi);
    a_finishSM(pA0, pA1, pa0, pa1, pa2, pa3); SBAR();
    a_pv(o, vrb + bo, pa0, pa1, pa2, pa3); a_partialSM(pB0);
    __syncthreads();
  }
  a_finishSM(pB0, pB1, pa0, pa1, pa2, pa3); SBAR();
  a_pv(o, vrb + bo + 8192, pa0, pa1, pa2, pa3);
#pragma unroll
  for (int r = 0; r < 16; ++r) {
    const int orow = crow(r, hi);
    const float rl = __builtin_amdgcn_rcpf(o[2][r]);
    const float v0 = o[0][r] * rl, v1 = o[1][r] * rl;
    float ss = v0 * v0 + v1 * v1;
    ss += shx<16>(ss); ss += shx<8>(ss); ss += shx<4>(ss); ss += shx<2>(ss); ss += shx<1>(ss);
    const float rs = rsqrtf(ss * (1.f / 64.f) + EPS);
    u16* dst = yout + (size_t)(wid * 32 + orow) * DM;
    dst[r32] = f2bf(v0 * rs); dst[32 + r32] = f2bf(v1 * rs);
  }
  __syncthreads();
#undef SLOAD
#undef SWRITE
}

__device__ __forceinline__ void phase_attn(const Params& p, int layer, int bid, int nb, char* lds) {
  const int nitems = 512 + (layer == 0 ? 8 : 0);
  const unsigned* kmx = p.kmx() + layer * 32;
  for (int it = bid; it < nitems; it += nb) {
    int b, h, q0, k0, seq, tok0;
    if (it < 512) { const int pair = it & 7, qb = (it >> 3); h = pair & 3; b = pair >> 2; q0 = qb * 256; k0 = 0; seq = SKV; tok0 = b * SEQ + qb * 256; }
    else { const int i2 = it - 512; h = i2 & 3; b = i2 >> 2; q0 = SEQ; k0 = SEQ; seq = LC; tok0 = TL + b * LC; }
    const size_t base = (size_t)(b * 4 + h) * SKV;
    const float k2 = __uint_as_float(kmx[(b * 4 + h) * 4 + 0]) + __uint_as_float(kmx[(b * 4 + h) * 4 + 1]) + __uint_as_float(kmx[b * 16 + 2]);
    attn_item(p.Q() + (base + q0) * 96, p.KV() + (base + k0) * 160, seq, sqrtf(k2) * 1.02f, p.ymix() + (size_t)tok0 * DM + h * 64, lds);
  }
}

__device__ __forceinline__ float hy_sconv(const u16* __restrict__ row, int t, int Ls, float w0, float w1, float w2, float bb) {
  const float zm = t > 0 ? bf2f(row[t - 1]) : 0.f, z0 = bf2f(row[t]), zp = t + 1 < Ls ? bf2f(row[t + 1]) : 0.f;
  return w0 * zm + w1 * z0 + w2 * zp + bb;
}
__device__ __forceinline__ float2 hy_sconv2(unsigned prv, unsigned cur, unsigned nxt, float w0, float w1, float w2, float bb) {
  const float zm = __uint_as_float(prv & 0xFFFF0000u), z0 = __uint_as_float(cur << 16), z1 = __uint_as_float(cur & 0xFFFF0000u), z2 = __uint_as_float(nxt << 16);
  return make_float2(w0 * zm + w1 * z0 + w2 * z1 + bb, w0 * z0 + w1 * z1 + w2 * z2 + bb);
}
__device__ __forceinline__ void hyena_item(const Params& p, int layer, int b, int ch, char* lds) {
  float2* s = (float2*)lds;
  const int tid = ltid();
  const float* cw = p.hy_conv_w() + (size_t)layer * 3 * 768; const float* cb = p.hy_conv_b() + (size_t)layer * 768;
  const unsigned* r0 = (const unsigned*)(p.zt() + (size_t)(ZT_HY + ch) * TT + (size_t)b * SEQ);
  const unsigned* r1 = (const unsigned*)(p.zt() + (size_t)(ZT_HY + 256 + ch) * TT + (size_t)b * SEQ);
  const unsigned* r2 = (const unsigned*)(p.zt() + (size_t)(ZT_HY + 512 + ch) * TT + (size_t)b * SEQ);
  const float a0 = cw[ch], a1 = cw[768 + ch], a2 = cw[1536 + ch], ab = cb[ch];
  const float b0 = cw[256 + ch], b1 = cw[768 + 256 + ch], b2 = cw[1536 + 256 + ch], bb = cb[256 + ch];
  const float c0 = cw[512 + ch], c1 = cw[768 + 512 + ch], c2 = cw[1536 + 512 + ch], cbb = cb[512 + ch];
  unsigned vgr[16], x0r[16];
#pragma unroll
  for (int hb2 = 0; hb2 < 2; ++hb2) {
    unsigned ld[8][9];
#pragma unroll
    for (int ii = 0; ii < 8; ++ii) {
      const int m = tid + 512 * (hb2 * 8 + ii);
      const int mp = m > 0 ? m - 1 : 0, mn = m + 1 < SEQ / 2 ? m + 1 : m;
      ld[ii][0] = r0[mp]; ld[ii][1] = r0[m]; ld[ii][2] = r0[mn];
      ld[ii][3] = r1[mp]; ld[ii][4] = r1[m]; ld[ii][5] = r1[mn];
      ld[ii][6] = r2[mp]; ld[ii][7] = r2[m]; ld[ii][8] = r2[mn];
    }
#pragma unroll
    for (int ii = 0; ii < 8; ++ii) {
      const int i = hb2 * 8 + ii, m = tid + 512 * i;
      const unsigned mkp = m > 0 ? 0xFFFFFFFFu : 0u, mkn = m + 1 < SEQ / 2 ? 0xFFFFFFFFu : 0u;
      const float2 ux = hy_sconv2(ld[ii][0] & mkp, ld[ii][1], ld[ii][2] & mkn, a0, a1, a2, ab);
      x0r[i] = cvtpk(ux.x, ux.y);
      const float2 u1 = hy_sconv2(ld[ii][3] & mkp, ld[ii][4], ld[ii][5] & mkn, b0, b1, b2, bb);
      const float2 uv = hy_sconv2(ld[ii][6] & mkp, ld[ii][7], ld[ii][8] & mkn, c0, c1, c2, cbb);
      const float2 vgf = make_float2(uv.x * u1.x, uv.y * u1.y);
      vgr[i] = cvtpk(vgf.x, vgf.y);
      s[swz(m)] = vgf;
      s[swz(m + SEQ / 2)] = make_float2(0.f, 0.f);
    }
  }
  __syncthreads();
  fft_fwd(s, p.tw());
  {
    const float4* hs = p.hspec() + ((size_t)layer * 256 + ch) * HSP;
    float4 hv[17];
#pragma unroll
    for (int i = 0; i < 17; ++i) { const int k = tid + 512 * i; hv[i] = hs[k <= FM / 2 ? k : 0]; }
    const float2 twl = p.tw()[tid];
#pragma unroll
    for (int i = 0; i < 17; ++i) {
      const int k = tid + 512 * i;
      if (k <= FM / 2) {
        const int pk = swz(rev7(k)), pm = swz(rev7((FM - k) & (FM - 1)));
        const float2 zk = s[pk], zm = s[pm];
        const float4 h = hv[i];
        const float2 He = make_float2(h.x, h.y), Ho = make_float2(h.z, h.w);
        const float2 Xe = make_float2(0.5f * (zk.x + zm.x), 0.5f * (zk.y - zm.y));
        const float2 Xo = make_float2(0.5f * (zk.y + zm.y), -0.5f * (zk.x - zm.x));
        const float2 twk = cmul(twl, p.tw()[512 * i]);
        const float2 t1 = cmul(twk, cmul(Xo, Ho));
        const float2 e1 = cmul(Xe, He);
        const float2 Ye = make_float2(e1.x + t1.x, e1.y + t1.y);
        const float2 o1 = cmul(Xe, Ho), o2 = cmul(Xo, He);
        const float2 Yo = make_float2(o1.x + o2.x, o1.y + o2.y);
        s[pk] = make_float2(Ye.x - Yo.y, Ye.y + Yo.x);
        if (pm != pk) s[pm] = make_float2(Ye.x + Yo.y, -Ye.y + Yo.x);
      }
    }
  }
  __syncthreads();
  fft_inv(s, p.tw());
  const float hb = p.hy_bias()[layer * 256 + ch];
  unsigned* orow = (unsigned*)(p.hyo() + (size_t)ch * TT + (size_t)b * SEQ);
#pragma unroll
  for (int i = 0; i < 16; ++i) {
    const int m = tid + 512 * i;
    const float2 y = s[swz(m)];
    orow[m] = cvtpk((y.x + __uint_as_float(vgr[i] << 16) * hb) * __uint_as_float(x0r[i] << 16), (y.y + __uint_as_float(vgr[i] & 0xFFFF0000u) * hb) * __uint_as_float(x0r[i] & 0xFFFF0000u));
  }
  __syncthreads();
}
__device__ __forceinline__ void fnet_item(const Params& p, int b, int j, char* lds) {
  float2* s = (float2*)lds;
  const int tid = ltid();
  const u16* rr = p.zt() + (size_t)(ZT_FR + j) * TT + (size_t)b * SEQ;
  const u16* ri = p.zt() + (size_t)(ZT_FI + j) * TT + (size_t)b * SEQ;
  {
    u32x4 vr[4], vi[4];
#pragma unroll
    for (int i = 0; i < 4; ++i) { const int m0 = (tid + 512 * i) * 8; vr[i] = *(const u32x4*)(rr + m0); vi[i] = *(const u32x4*)(ri + m0); }
#pragma unroll
    for (int i = 0; i < 4; ++i) {
      const int m0 = (tid + 512 * i) * 8;
#pragma unroll
      for (int q = 0; q < 4; ++q) {
        s[swz(m0 + 2 * q)] = make_float2(__uint_as_float(vr[i][q] << 16), __uint_as_float(vi[i][q] << 16));
        s[swz(m0 + 2 * q + 1)] = make_float2(__uint_as_float(vr[i][q] & 0xFFFF0000u), __uint_as_float(vi[i][q] & 0xFFFF0000u));
      }
    }
  }
  __syncthreads();
  fft_fwd(s, p.tw());
#ifdef PROBE_FFT
  fft_inv(s, p.tw());
  for (int m = tid; m < FM; m += NTHR) { float2 v = s[m]; v.x *= (1.f / 16384.f); v.y *= (1.f / 16384.f); s[m] = v; }
  __syncthreads();
  fft_fwd(s, p.tw());
#endif
  u16* orow = p.fno() + (size_t)j * TT + (size_t)b * SEQ;
#pragma unroll 8
  for (int k = tid; k < FM; k += NTHR) orow[k] = f2bf(s[swz(rev7(k))].x * (1.f / 128.f));
  __syncthreads();
}
__device__ __forceinline__ void hyena_ctx_item(const Params& p, int b, int ch, char* lds) {
  float* vg = (float*)lds;
  float* x0 = vg + 256;
  float* hf = x0 + 256;
  float* hbk = hf + 256;
  const int tid = ltid();
  const float* cw = p.hy_conv_w(); const float* cb = p.hy_conv_b();
  const size_t off = (size_t)TL + (size_t)b * LC;
  const u16* r0 = p.zt() + (size_t)(ZT_HY + ch) * TT + off;
  const u16* r1 = p.zt() + (size_t)(ZT_HY + 256 + ch) * TT + off;
  const u16* r2 = p.zt() + (size_t)(ZT_HY + 512 + ch) * TT + off;
  if (tid < 256) {
    const int t = tid;
    vg[t] = hy_sconv(r2, t, LC, cw[512 + ch], cw[768 + 512 + ch], cw[1536 + 512 + ch], cb[512 + ch]) *
            hy_sconv(r1, t, LC, cw[256 + ch], cw[768 + 256 + ch], cw[1536 + 256 + ch], cb[256 + ch]);
    x0[t] = hy_sconv(r0, t, LC, cw[ch], cw[768 + ch], cw[1536 + ch], cb[ch]);
    hf[t] = p.hfc()[(size_t)ch * LC + t]; hbk[t] = p.hfc()[(size_t)(256 + ch) * LC + t];
  }
  const float ssq_c = filt_ssq(p.hpart() + (size_t)2 * 256 * 512, ch, (float*)(lds + 8192));
  if (tid < 256) {
    const int t = tid; float y = 0;
    for (int q = 0; q <= t; ++q) y += hf[t - q] * vg[q];
    for (int q = t + 1; q < LC; ++q) y += hbk[q - t] * vg[q];
    y *= rsqrtf(ssq_c);
    p.hyo()[(size_t)ch * TT + off + t] = f2bf((y + vg[t] * p.hy_bias()[ch]) * x0[t]);
  }
  __syncthreads();
}
__device__ __forceinline__ void fnet_ctx_item(const Params& p, int b, int j, char* lds) {
  float* ur = (float*)lds; float* ui = ur + 256; float* cst = ui + 256; float* snt = cst + 256;
  const int tid = ltid();
  const size_t off = (size_t)TL + (size_t)b * LC;
  if (tid < 256) {
    ur[tid] = bf2f(p.zt()[(size_t)(ZT_FR + j) * TT + off + tid]); ui[tid] = bf2f(p.zt()[(size_t)(ZT_FI + j) * TT + off + tid]);
    float sn, cs; sincospif((float)tid / 128.f, &sn, &cs); cst[tid] = cs; snt[tid] = sn;
  }
  __syncthreads();
  if (tid < 256) {
    const int k = tid; float y = 0;
    for (int l = 0; l < 256; ++l) { const int m = (l * k) & 255; y += cst[m] * ur[l] + snt[m] * ui[l]; }
    p.fno()[(size_t)j * TT + off + k] = f2bf(y * 0.0625f);
  }
  __syncthreads();
}
__device__ __forceinline__ void phase_fftmix(const Params& p, int layer, int bid, int nb, char* lds) {
  const int nitems = layer == 0 ? 2048 : 1024;
  for (int it = bid; it < nitems; it += nb) {
    const int k = it & 511, b = k >> 8, c = k & 255;
    if (it < 512) hyena_item(p, layer, b, c, lds);
    else if (it < 1024) fnet_item(p, b, c, lds);
    else if (it < 1536) hyena_ctx_item(p, b, c, lds);
    else fnet_ctx_item(p, b, c, lds);
  }
}
constexpr int GLG = 17, NGRP = 16;
__device__ __forceinline__ int gla_chain_tok(int dir, int b, int n, int i) {
  const int base = n < 4 ? TL + b * LC : b * SEQ, len = n < 4 ? LC : SEQ, m = n < 4 ? n : n - 4;
  return dir == 0 ? base + 64 * m + i : base + (len - 1) - (64 * m + i);
}
__device__ __forceinline__ float logsig16(float x) { return (fminf(x, 0.f) - __logf(1.f + __expf(-fabsf(x)))) * (1.f / 16.f); }
__device__ __forceinline__ float wave_scan_incl(float v, int lane) {
#pragma unroll
  for (int o = 1; o < 64; o <<= 1) { const float t = __shfl_up(v, o, 64); if (lane >= o) v += t; }
  return v;
}
__device__ __forceinline__ void phase_gla_a(const Params& p, int layer, int bid, int nb, char* lds) {
  const int tid = ltid(), wid = tid >> 6, lane = tid & 63, r32 = lane & 31, hi = lane >> 5;
  const float* gb = p.gla_gk_b() + (size_t)layer * 256;
  char* wimg = lds + wid * 12288;
  for (int it = bid; it < 16 * NGRP; it += nb) {
    const int chain = it >> 4, g = it & 15, dir = chain >> 3, b = (chain >> 2) & 1, h = chain & 3;
    const int n0 = g * GLG, n1 = min(n0 + GLG, NCH), nch = n1 - n0;
    char* WT = lds + wid * 13824; char* VT = WT + 4608;
    float* dvl = (float*)(lds + 8 * 13824);
#pragma unroll
    for (int c = 0; c < 3; ++c) {
      const int cl = wid + 8 * c;
      if (cl < nch) {
        const int n = n0 + cl;
        {
          const u16* vbase = p.zg() + ZG_GV + h * 64 + lane;
          u16 vv[64];
#pragma unroll
          for (int i = 0; i < 64; ++i) vv[i] = vbase[(size_t)gla_chain_tok(dir, b, n, i) * ZG_W];
#pragma unroll
          for (int q = 0; q < 8; ++q)
            *(u32x4*)(VT + lane * 144 + q * 16) = u32x4{(unsigned)vv[8 * q] | ((unsigned)vv[8 * q + 1] << 16), (unsigned)vv[8 * q + 2] | ((unsigned)vv[8 * q + 3] << 16),
                                                       (unsigned)vv[8 * q + 4] | ((unsigned)vv[8 * q + 5] << 16), (unsigned)vv[8 * q + 6] | ((unsigned)vv[8 * q + 7] << 16)};
        }
        {
          const int kk = lane & 31, hs = lane >> 5;
          const u16* kb = p.zg() + ZG_GK + h * 32 + kk; const u16* gbp = p.zg() + ZG_GP + dir * 128 + h * 32 + kk;
          const float bias = gb[dir * 128 + h * 32 + kk];
          float bc[32], kf[32];
#pragma unroll
          for (int i = 0; i < 32; ++i) {
            const size_t ro = (size_t)gla_chain_tok(dir, b, n, hs * 32 + i) * ZG_W;
            kf[i] = bf2f(kb[ro]); bc[i] = bf2f(gbp[ro]);
          }
          float run = 0.f;
#pragma unroll
          for (int i = 0; i < 32; ++i) { const float x = bc[i] + bias; run += (fminf(x, 0.f) - __logf(1.f + __expf(-fabsf(x)))) * (1.f / 16.f); bc[i] = run; }
          const float lowtot = __shfl(run, kk, 64);
          const float uptot = __shfl(run, 32 + kk, 64);
          const float bl = lowtot + uptot, off = hs ? lowtot : 0.f;
          unsigned wp[16];
#pragma unroll
          for (int i = 0; i < 16; ++i) wp[i] = cvtpk(kf[2 * i] * __expf(bl - (bc[2 * i] + off)), kf[2 * i + 1] * __expf(bl - (bc[2 * i + 1] + off)));
#pragma unroll
          for (int q = 0; q < 4; ++q) *(u32x4*)(WT + kk * 144 + hs * 64 + q * 16) = u32x4{wp[4 * q], wp[4 * q + 1], wp[4 * q + 2], wp[4 * q + 3]};
          if (hs == 0) dvl[cl * 32 + kk] = __expf(bl);
        }
        asm volatile("s_waitcnt lgkmcnt(0)" ::: "memory");
        f32x16 d0 = {}, d1 = {};
#pragma unroll
        for (int s4 = 0; s4 < 4; ++s4) {
          const bf16x8 af = *(const bf16x8*)(WT + r32 * 144 + (16 * s4 + 8 * hi) * 2);
          const bf16x8 v0 = *(const bf16x8*)(VT + r32 * 144 + (16 * s4 + 8 * hi) * 2);
          const bf16x8 v1 = *(const bf16x8*)(VT + (32 + r32) * 144 + (16 * s4 + 8 * hi) * 2);
          d0 = __builtin_amdgcn_mfma_f32_32x32x16_bf16(af, v0, d0, 0, 0, 0);
          d1 = __builtin_amdgcn_mfma_f32_32x32x16_bf16(af, v1, d1, 0, 0, 0);
        }
        asm volatile("s_waitcnt lgkmcnt(0)" ::: "memory");
        {
          float* dg = p.gds() + ((size_t)chain * NCH + n) * 2048;
#pragma unroll
          for (int r = 0; r < 16; ++r) { dg[crow(r, hi) * 64 + r32] = d0[r]; dg[crow(r, hi) * 64 + 32 + r32] = d1[r]; }
        }
      }
      __builtin_amdgcn_sched_barrier(0);
    }
    __syncthreads();
    {
      const int kk = tid >> 4, v0 = (tid & 15) * 4;
      float st[4] = {0.f, 0.f, 0.f, 0.f}; float dcum = 1.f;
      float* gp0 = p.gds() + ((size_t)chain * NCH + n0) * 2048 + kk * 64 + v0;
      float4 av[GLG];
#pragma unroll
      for (int cl = 0; cl < GLG; ++cl) av[cl] = *(const float4*)(gp0 + (size_t)(cl < nch ? cl : 0) * 2048);
#pragma unroll
      for (int cl = 0; cl < GLG; ++cl) {
        if (cl < nch) {
          const float d = dvl[cl * 32 + kk];
          *(float4*)(gp0 + (size_t)cl * 2048) = make_float4(st[0], st[1], st[2], st[3]);
          if ((tid & 15) == 0) p.gdv()[((size_t)chain * NCH + n0 + cl) * 32 + kk] = dcum;
          st[0] = st[0] * d + av[cl].x; st[1] = st[1] * d + av[cl].y; st[2] = st[2] * d + av[cl].z; st[3] = st[3] * d + av[cl].w;
          dcum *= d;
        }
      }
      float* at = p.gst() + ((size_t)chain * NGRP + g) * 2048 + kk * 64 + v0;
      *(float4*)at = make_float4(st[0], st[1], st[2], st[3]);
      if ((tid & 15) == 0) p.gst()[(size_t)16 * NGRP * 2048 + ((size_t)chain * NGRP + g) * 32 + kk] = dcum;
    }
    __syncthreads();
  }
}

constexpr int GC_QP = 33792, GC_KP = GC_QP + 10240, GC_VT = GC_KP + 10240, GC_ST = GC_VT + 18432, GC_AX = GC_ST + 10240;
__device__ __forceinline__ void phase_gla_c(const Params& p, int layer, int bid, int nb, char* lds) {
  float* gl = (float*)lds;
  float* qraw = gl + 2 * 64 * 33;
  float* kraw = qraw + 64 * 33;
  float* Of = (float*)lds;
  char* Qp = lds + GC_QP;
  char* Kp = lds + GC_KP;
  char* VT = lds + GC_VT;
  char* ST = lds + GC_ST;
  const int tid = ltid(), wid = tid >> 6, lane = tid & 63, r32 = lane & 31, hi = lane >> 5;
  char* Ax = lds + GC_AX + wid * 4608;
  const float* gb = p.gla_gk_b() + (size_t)layer * 256;
  const int pc_lo = layer == 0 ? 0 : 4, npc = NCH - pc_lo, nitem = 8 * npc;
  const int per = (nitem + nb - 1) / nb, q_beg = bid * per, q_end = min(nitem, q_beg + per);
  const int sdir = tid >> 8, sk = (tid >> 3) & 31, sv0 = (tid & 7) * 8;
  float G[8]; int g_cached = -1, bh_cached = -1;
  const int lpos = tid >> 3, lc4 = (tid & 7) * 4;
  u32x2 rq, rk, rg0, rg1, rva, rvb; float4 pl0, pl1; float pdp;
#define GC_ITEM(q_, bh_, pc_, b_, h_, tok0_) const int bh_ = (q_) / npc, pc_ = pc_lo + (q_) % npc, b_ = bh_ >> 2, h_ = bh_ & 3; \
    const int tok0_ = pc_ < 4 ? TL + b_ * LC + pc_ * 64 : b_ * SEQ + (pc_ - 4) * 64
#define GC_LOADRAW(tok0_, h_) do { const u16* zr = p.zg() + (size_t)((tok0_) + lpos) * ZG_W; \
    rq = *(const u32x2*)(zr + ZG_GQ + (h_) * 32 + lc4); rk = *(const u32x2*)(zr + ZG_GK + (h_) * 32 + lc4); \
    rg0 = *(const u32x2*)(zr + ZG_GP + (h_) * 32 + lc4); rg1 = *(const u32x2*)(zr + ZG_GP + 128 + (h_) * 32 + lc4); \
    rva = *(const u32x2*)(zr + ZG_GV + (h_) * 64 + lc4 * 2); rvb = *(const u32x2*)(zr + ZG_GV + (h_) * 64 + lc4 * 2 + 4); } while (0)
#define GC_LOADST(pc_, b_, h_) do { const int chain_ = sdir * 8 + (b_) * 4 + (h_); \
    const int n_ = sdir == 0 ? (pc_) : ((pc_) < 4 ? 3 - (pc_) : 4 + 255 - ((pc_) - 4)); \
    const float* lp_ = p.gds() + ((size_t)chain_ * NCH + n_) * 2048 + sk * 64 + sv0; \
    pl0 = *(const float4*)lp_; pl1 = *(const float4*)(lp_ + 4); pdp = p.gdv()[((size_t)chain_ * NCH + n_) * 32 + sk]; } while (0)
  if (q_beg < q_end) { GC_ITEM(q_beg, bh0, pc0, b0, h0, t00); GC_LOADRAW(t00, h0); GC_LOADST(pc0, b0, h0); }
  for (int qi = q_beg; qi < q_end; ++qi) {
    GC_ITEM(qi, bh, pc, b, h, tok0);
    {
      const int pos = lpos, c4 = lc4;
      const float sc = 0.17677669529663687f;
      qraw[pos * 33 + c4] = BF_LO(rq[0]) * sc; qraw[pos * 33 + c4 + 1] = BF_HI(rq[0]) * sc; qraw[pos * 33 + c4 + 2] = BF_LO(rq[1]) * sc; qraw[pos * 33 + c4 + 3] = BF_HI(rq[1]) * sc;
      kraw[pos * 33 + c4] = BF_LO(rk[0]); kraw[pos * 33 + c4 + 1] = BF_HI(rk[0]); kraw[pos * 33 + c4 + 2] = BF_LO(rk[1]); kraw[pos * 33 + c4 + 3] = BF_HI(rk[1]);
#pragma unroll
      for (int d = 0; d < 2; ++d) {
        const u32x2 rg = d ? rg1 : rg0; const float4 bb = *(const float4*)(gb + d * 128 + h * 32 + c4);
        const int i = d ? 63 - pos : pos;
        float* gd = gl + (d * 64 + i) * 33 + c4;
        gd[0] = logsig16(BF_LO(rg[0]) + bb.x); gd[1] = logsig16(BF_HI(rg[0]) + bb.y); gd[2] = logsig16(BF_LO(rg[1]) + bb.z); gd[3] = logsig16(BF_HI(rg[1]) + bb.w);
      }
#pragma unroll
      for (int j = 0; j < 4; ++j) {
        const unsigned w = j < 2 ? rva[j] : rvb[j - 2]; const int v = c4 * 2 + 2 * j;
        *(u16*)(VT + (0 * 64 + v) * 144 + pos * 2) = (u16)(w & 0xFFFFu); *(u16*)(VT + (1 * 64 + v) * 144 + (63 - pos) * 2) = (u16)(w & 0xFFFFu);
        *(u16*)(VT + (0 * 64 + v + 1) * 144 + pos * 2) = (u16)(w >> 16); *(u16*)(VT + (1 * 64 + v + 1) * 144 + (63 - pos) * 2) = (u16)(w >> 16);
      }
    }
    if (qi + 1 < q_end) { GC_ITEM(qi + 1, bhn, pcn, bn, hn, t0n); GC_LOADRAW(t0n, hn); }
    __syncthreads();
    {
      const int col = tid & 63, d = col >> 5, c = col & 31, part = tid >> 6;
      float* ptot = (float*)(lds + GC_AX);
      float bv[8]; float run = 0.f;
#pragma unroll
      for (int j = 0; j < 8; ++j) { run += gl[(d * 64 + part * 8 + j) * 33 + c]; bv[j] = run; }
      ptot[part * 64 + col] = run;
      __syncthreads();
      float off = 0.f;
#pragma unroll
      for (int q = 0; q < 7; ++q) off += (q < part) ? ptot[q * 64 + col] : 0.f;
#pragma unroll
      for (int j = 0; j < 8; ++j) gl[(d * 64 + part * 8 + j) * 33 + c] = bv[j] + off;
    }
    __syncthreads();
    {
#pragma unroll
      for (int e = 0; e < 2; ++e) {
        const int idx = tid + e * 512, d = idx >> 9, i = (idx >> 3) & 63, c4 = (idx & 7) * 4, pos = d ? 63 - i : i;
        float qo[4], ko[4];
#pragma unroll
        for (int j = 0; j < 4; ++j) {
          const float bi = gl[(d * 64 + i) * 33 + c4 + j], bm = gl[(d * 64 + 31) * 33 + c4 + j];
          qo[j] = qraw[pos * 33 + c4 + j] * __expf(bi - bm); ko[j] = kraw[pos * 33 + c4 + j] * __expf(bm - bi);
        }
        *(u32x2*)(Qp + (d * 64 + i) * 80 + c4 * 2) = u32x2{cvtpk(qo[0], qo[1]), cvtpk(qo[2], qo[3])};
        *(u32x2*)(Kp + (d * 64 + i) * 80 + c4 * 2) = u32x2{cvtpk(ko[0], ko[1]), cvtpk(ko[2], ko[3])};
      }
      const int chain = sdir * 8 + b * 4 + h;
      const int n = sdir == 0 ? pc : (pc < 4 ? 3 - pc : 4 + 255 - (pc - 4)), g = n / GLG;
      if (g != g_cached || bh != bh_cached) {
#pragma unroll
        for (int j = 0; j < 8; ++j) G[j] = 0.f;
        const float* at = p.gst() + (size_t)chain * NGRP * 2048 + sk * 64 + sv0;
        const float* dt = p.gst() + (size_t)16 * NGRP * 2048 + (size_t)chain * NGRP * 32 + sk;
        for (int gg = 0; gg < g; ++gg) {
          const float4 a0 = *(const float4*)(at + (size_t)gg * 2048), a1 = *(const float4*)(at + (size_t)gg * 2048 + 4); const float dd = dt[gg * 32];
          G[0] = G[0] * dd + a0.x; G[1] = G[1] * dd + a0.y; G[2] = G[2] * dd + a0.z; G[3] = G[3] * dd + a0.w;
          G[4] = G[4] * dd + a1.x; G[5] = G[5] * dd + a1.y; G[6] = G[6] * dd + a1.z; G[7] = G[7] * dd + a1.w;
        }
        g_cached = g; bh_cached = bh;
      }
      const float4 l0 = pl0, l1 = pl1; const float dp = pdp;
      const float em = __expf(gl[(sdir * 64 + 31) * 33 + sk]);
      const float sv[8] = {l0.x + dp * G[0], l0.y + dp * G[1], l0.z + dp * G[2], l0.w + dp * G[3], l1.x + dp * G[4], l1.y + dp * G[5], l1.z + dp * G[6], l1.w + dp * G[7]};
      if (qi + 1 < q_end) { GC_ITEM(qi + 1, bhn, pcn, bn, hn, t0n); (void)bhn; (void)t0n; GC_LOADST(pcn, bn, hn); }
#pragma unroll
      for (int j = 0; j < 8; ++j) *(u16*)(ST + (sdir * 64 + sv0 + j) * 80 + sk * 2) = f2bf(sv[j] * em);
    }
    __syncthreads();
    {
      const int d = wid >> 2, ib = (wid >> 1) & 1, vb = wid & 1;
      const char* Qd = Qp + d * 64 * 80; const char* Kd = Kp + d * 64 * 80; const char* Vd = VT + d * 64 * 144; const char* Sd = ST + d * 64 * 80;
      bf16x8 qf[2];
#pragma unroll
      for (int s2 = 0; s2 < 2; ++s2) qf[s2] = *(const bf16x8*)(Qd + (ib * 32 + r32) * 80 + (16 * s2 + 8 * hi) * 2);
#pragma unroll
      for (int jb = 0; jb < 2; ++jb) {
        if (jb <= ib) {
          f32x16 x = {};
#pragma unroll
          for (int s2 = 0; s2 < 2; ++s2) {
            const bf16x8 kf = *(const bf16x8*)(Kd + (jb * 32 + r32) * 80 + (16 * s2 + 8 * hi) * 2);
            x = __builtin_amdgcn_mfma_f32_32x32x16_bf16(qf[s2], kf, x, 0, 0, 0);
          }
#pragma unroll
          for (int r = 0; r < 16; ++r) {
            const int il = crow(r, hi), i = ib * 32 + il, j = jb * 32 + r32;
            *(u16*)(Ax + il * 144 + j * 2) = f2bf(j <= i ? x[r] : 0.f);
          }
        }
      }
      asm volatile("s_waitcnt lgkmcnt(0)" ::: "memory");
      f32x16 o = {};
#pragma unroll
      for (int s4 = 0; s4 < 4; ++s4) {
        if (s4 < 2 * (ib + 1)) {
          const bf16x8 af = *(const bf16x8*)(Ax + r32 * 144 + (16 * s4 + 8 * hi) * 2);
          const bf16x8 vf = *(const bf16x8*)(Vd + (vb * 32 + r32) * 144 + (16 * s4 + 8 * hi) * 2);
          o = __builtin_amdgcn_mfma_f32_32x32x16_bf16(af, vf, o, 0, 0, 0);
        }
      }
#pragma unroll
      for (int s2 = 0; s2 < 2; ++s2) {
        const bf16x8 sf = *(const bf16x8*)(Sd + (vb * 32 + r32) * 80 + (16 * s2 + 8 * hi) * 2);
        o = __builtin_amdgcn_mfma_f32_32x32x16_bf16(qf[s2], sf, o, 0, 0, 0);
      }
#pragma unroll
      for (int r = 0; r < 16; ++r) {
        const int i = ib * 32 + crow(r, hi), pos = d ? 63 - i : i;
        Of[(d * 64 + pos) * 65 + vb * 32 + r32] = o[r];
      }
    }
    __syncthreads();
    {
      const int pos = tid >> 3, v0 = (tid & 7) * 8;
      float r8[8]; float ss = 0.f;
#pragma unroll
      for (int j = 0; j < 8; ++j) { r8[j] = Of[pos * 65 + v0 + j] + Of[(64 + pos) * 65 + v0 + j]; ss += r8[j] * r8[j]; }
      ss += shx<4>(ss); ss += shx<2>(ss); ss += shx<1>(ss);
      const float rs = rsqrtf(ss * (1.f / 64.f) + EPS);
      const u16* og = p.zg() + (size_t)(tok0 + pos) * ZG_W + ZG_OG + h * 64 + v0;
      const float4 g0 = ld4bf(og), g1 = ld4bf(og + 4);
      *(u32x4*)(p.ymix() + (size_t)(tok0 + pos) * DM + 512 + h * 64 + v0) =
          u32x4{cvtpk(r8[0] * rs * silu_f(g0.x), r8[1] * rs * silu_f(g0.y)), cvtpk(r8[2] * rs * silu_f(g0.z), r8[3] * rs * silu_f(g0.w)),
                cvtpk(r8[4] * rs * silu_f(g1.x), r8[5] * rs * silu_f(g1.y)), cvtpk(r8[6] * rs * silu_f(g1.z), r8[7] * rs * silu_f(g1.w))};
    }
    __syncthreads();
  }
}

__device__ __forceinline__ void phase_mix(const Params& p, int layer, int bid, int nb, char* lds) {
  float* part = (float*)lds;
  u16* tile = (u16*)(lds + 4096);
  const int tid = ltid(), wid = tid >> 6, lane = tid & 63;
  const int ntok = layer == 0 ? TT : TL;
  for (int it = bid; it < ntok / 64; it += nb) {
    const int tok0 = it * 64;
    float vh[32], vf[32]; float sh = 0, sf = 0;
#pragma unroll
    for (int c = 0; c < 32; ++c) {
      vh[c] = bf2f(p.hyo()[(size_t)(wid * 32 + c) * TT + tok0 + lane]); vf[c] = bf2f(p.fno()[(size_t)(wid * 32 + c) * TT + tok0 + lane]);
      sh += vh[c] * vh[c]; sf += vf[c] * vf[c];
    }
    part[(0 * 8 + wid) * 64 + lane] = sh; part[(1 * 8 + wid) * 64 + lane] = sf;
    __syncthreads();
    float th = 0, tf = 0;
#pragma unroll
    for (int q = 0; q < 8; ++q) { th += part[(0 * 8 + q) * 64 + lane]; tf += part[(1 * 8 + q) * 64 + lane]; }
    const float rh = rsqrtf(th * (1.f / 256.f) + EPS), rf = rsqrtf(tf * (1.f / 256.f) + EPS);
#pragma unroll
    for (int c = 0; c < 32; ++c) { tile[lane * 520 + wid * 32 + c] = f2bf(vh[c] * rh); tile[lane * 520 + 256 + wid * 32 + c] = f2bf(vf[c] * rf); }
    __syncthreads();
    for (int g = tid; g < 64 * 64; g += NTHR) {
      const int tl = g >> 6, cg = g & 63;
      const u32x4 w = *(const u32x4*)(tile + tl * 520 + cg * 8);
      *(u32x4*)(p.ymix() + (size_t)(tok0 + tl) * DM + (cg < 32 ? 256 + cg * 8 : 768 + (cg - 32) * 8)) = w;
    }
    __syncthreads();
  }
}

struct EpiOut {
  const Params* pp; int layer;
  __device__ __forceinline__ void pre(const G8Unit& u, int, int, float (&)[8], float* cb) const {
    if ((ltid() >> 6) == 0) g8_cload(pp->mod() + ((size_t)layer * 3 + modv(u.pm * 256)) * 6144 + 2 * DM + u.pn * 256, cb);
  }
  __device__ __forceinline__ void operator()(const f32x4 (&acc)[2][2][4][2], const G8Unit& u, int wr, int wc, int fr, int fq, const float (&)[8], const float* cb) const {
    const Params& p = *pp;
#pragma unroll
    for (int bj = 0; bj < 2; ++bj) {
      const int c0 = u.pn * 256 + bj * 128 + wc * 32 + 8 * fq;
      const f32x4 ga = *(const f32x4*)(cb + bj * 128 + wc * 32 + 8 * fq), gb = *(const f32x4*)(cb + bj * 128 + wc * 32 + 8 * fq + 4);
#pragma unroll
      for (int ai = 0; ai < 2; ++ai)
#pragma unroll
        for (int m = 0; m < 4; ++m) {
          const int tok = u.pm * 256 + ai * 128 + wr * 64 + m * 16 + fr;
          u16* xo = p.X() + (size_t)tok * DM + c0;
          f32x4 xa, xb;
          if (layer == 0) { const float* xr = resid_row_in(p, tok) + c0; xa = *(const f32x4*)xr; xb = *(const f32x4*)(xr + 4); }
          else { const u32x4 w = *(const u32x4*)xo;
            xa = f32x4{__uint_as_float(w[0] << 16), __uint_as_float(w[0] & 0xFFFF0000u), __uint_as_float(w[1] << 16), __uint_as_float(w[1] & 0xFFFF0000u)};
            xb = f32x4{__uint_as_float(w[2] << 16), __uint_as_float(w[2] & 0xFFFF0000u), __uint_as_float(w[3] << 16), __uint_as_float(w[3] & 0xFFFF0000u)}; }
          xa = xa + ga * acc[ai][bj][m][0]; xb = xb + gb * acc[ai][bj][m][1];
          *(u32x4*)xo = u32x4{cvtpk(xa[0], xa[1]), cvtpk(xa[2], xa[3]), cvtpk(xb[0], xb[1]), cvtpk(xb[2], xb[3])};
        }
    }
  }
};
__device__ __forceinline__ void phase_gemm_out(const Params& p, int layer, int bid, int nb, char* lds) {
  G8Plain S; S.nM = (layer == 0 ? TT : TL) / 256; S.nN = DM / 256; S.Kb = 2 * DM; S.G = nb; S.c = bid; S.Bt = (const char*)(p.bt_out() + (size_t)layer * DM * DM);
  EpiOut E; E.pp = &p; E.layer = layer;
  gemm8_phase<false>(lds, (const char*)p.ymix(), 2 * DM, S, E);
}

__device__ __forceinline__ void phase_norm2_router(const Params& p, int layer, int bid, int nb, char* lds) {
  float* rwl = (float*)lds;
  int* lcnt = (int*)(lds + 131072);
  int* lbase = lcnt + 32;
  int* ent = lbase + 32;
  float* entw = (float*)(ent + 2 * 640);
  float* ents = entw + 640;
  const int tid = ltid(), wid = tid >> 6, lane = tid & 63;
  const int ntok = layer == 0 ? TT : TL;
  const float* rw = p.router_w() + (size_t)layer * DM * NE;
  for (int i = tid; i < DM * NE / 4; i += NTHR) {
    const int k = i >> 3, q4 = i & 7;
    ((float4*)rwl)[q4 * 1024 + ((k & 3) * 256 + (k >> 2))] = ((const float4*)rw)[i];
  }
  if (tid < 32) lcnt[tid] = 0;
  __syncthreads();
  const float* gn = p.norm2_g() + layer * DM; const float* rb = p.router_b() + layer * NE;
  const int per = (ntok + nb - 1) / nb, t_beg = bid * per, t_end = min(ntok, t_beg + per);
  for (int tok = t_beg + wid; tok < t_end; tok += 8) {
    const u16* xr = p.X() + (size_t)tok * DM;
    float v[16];
#pragma unroll
    for (int i = 0; i < 4; ++i) { const float4 a = ld4bf(xr + lane * 4 + i * 256); v[4 * i] = a.x; v[4 * i + 1] = a.y; v[4 * i + 2] = a.z; v[4 * i + 3] = a.w; }
    float ss = 0;
#pragma unroll
    for (int i = 0; i < 16; ++i) ss += v[i] * v[i];
    ss = wave_sum(ss);
    const float rs = rsqrtf(ss * (1.f / DM) + EPS);
    const float* md = p.mod() + ((size_t)layer * 3 + modv(tok)) * 6144 + 3 * DM;
#pragma unroll
    for (int i = 0; i < 4; ++i) {
      const int c = lane * 4 + i * 256;
      const float4 g = *(const float4*)(gn + c), sh = *(const float4*)(md + c), sc = *(const float4*)(md + DM + c);
      v[4 * i] = v[4 * i] * rs * g.x * (1.f + sc.x) + sh.x; v[4 * i + 1] = v[4 * i + 1] * rs * g.y * (1.f + sc.y) + sh.y;
      v[4 * i + 2] = v[4 * i + 2] * rs * g.z * (1.f + sc.z) + sh.z; v[4 * i + 3] = v[4 * i + 3] * rs * g.w * (1.f + sc.w) + sh.w;
    }
    const float rowsc = store_row_i8(v, p.H() + (size_t)tok * DM, p.hs() + tok, lane);
    float lg[32];
#pragma unroll
    for (int e = 0; e < 32; ++e) lg[e] = 0.f;
#pragma unroll
    for (int i = 0; i < 16; ++i) {
      const float4* wr4 = (const float4*)rwl + ((i & 3) * 256 + (i >> 2) * 64 + lane);
#pragma unroll
      for (int q = 0; q < 8; ++q) { const float4 w = wr4[q * 1024]; lg[4 * q] += v[i] * w.x; lg[4 * q + 1] += v[i] * w.y; lg[4 * q + 2] += v[i] * w.z; lg[4 * q + 3] += v[i] * w.w; }
    }
    float r16[16], r8[8], r4[4], r2[2], lv;
    { const bool up = lane & 32;
#pragma unroll
      for (int e = 0; e < 16; ++e) { const float keep = up ? lg[16 + e] : lg[e], send = up ? lg[e] : lg[16 + e]; r16[e] = keep + shx<32>(send); } }
    { const bool up = lane & 16;
#pragma unroll
      for (int e = 0; e < 8; ++e) { const float keep = up ? r16[8 + e] : r16[e], send = up ? r16[e] : r16[8 + e]; r8[e] = keep + shx<16>(send); } }
    { const bool up = lane & 8;
#pragma unroll
      for (int e = 0; e < 4; ++e) { const float keep = up ? r8[4 + e] : r8[e], send = up ? r8[e] : r8[4 + e]; r4[e] = keep + shx<8>(send); } }
    { const bool up = lane & 4;
#pragma unroll
      for (int e = 0; e < 2; ++e) { const float keep = up ? r4[2 + e] : r4[e], send = up ? r4[e] : r4[2 + e]; r2[e] = keep + shx<4>(send); } }
    { const bool up = lane & 2; const float keep = up ? r2[1] : r2[0], send = up ? r2[0] : r2[1]; lv = keep + shx<2>(send); }
    lv += shx<1>(lv);
    lv += rb[lane >> 1];
    int ids[4]; float vals[4];
#pragma unroll
    for (int k = 0; k < 4; ++k) {
      const float mx = wave_max(lv);
      const unsigned long long bal = __ballot(lv == mx);
      const int win = __ffsll((long long)bal) - 1;
      ids[k] = win >> 1; vals[k] = mx;
      if ((lane >> 1) == ids[k]) lv = -3.4e38f;
    }
    if (lane == 0) {
      const float mx = vals[0];
      float ex[4], sum = 0;
#pragma unroll
      for (int k = 0; k < 4; ++k) { ex[k] = __expf(vals[k] - mx); sum += ex[k]; }
      const float inv = 1.f / sum;
#pragma unroll
      for (int k = 0; k < 4; ++k) {
        const int lp = atomicAdd(&lcnt[ids[k]], 1);
        const int slot = (tok - t_beg) * 4 + k;
        ent[2 * slot] = tok * 4 + k; ent[2 * slot + 1] = (ids[k] << 20) | lp; entw[slot] = ex[k] * inv; ents[slot] = rowsc;
      }
    }
  }
  __syncthreads();
  if (tid < 32) lbase[tid] = atomicAdd(&p.cnt()[layer * NE + tid], lcnt[tid]);
  __syncthreads();
  const int nas = (t_end > t_beg ? (t_end - t_beg) : 0) * 4;
  for (int s = tid; s < nas; s += NTHR) {
    const int tk = ent[2 * s], el = ent[2 * s + 1], e = el >> 20, pos = lbase[e] + (el & 0xFFFFF);
    p.rtok()[(size_t)e * TT + pos] = tk >> 2; p.rw()[(size_t)e * TT + pos] = entw[s]; p.rsc()[(size_t)e * TT + pos] = ents[s];
    p.tslot()[tk] = (e << 20) | pos;
  }
}

template <bool GATH> struct G8MoeT {
  static constexpr bool GATHER = GATH;
  __device__ __forceinline__ void rows_to_lds(const G8Unit& u, int* dst) const {
    __builtin_amdgcn_global_load_lds((const unsigned*)(rtok + (size_t)u.e * TT + u.pm * 256 + (ltid() & 63) * 4), (LAS3 unsigned*)dst, 16, 0, 0);
  }
  const int* cnt;
  int ntn, Kb, G, c; const char* Bt; size_t bstride;
  const int* rtok;
  __device__ __forceinline__ bool next(int i, G8Unit& u, const G8Unit& from) const {
    const int w = (i * 8 + (c & 7)) * (G >> 3) + (c >> 3);
    int acc = from.ab, rows = from.pre;
    for (int ee = from.e; ee < NE; ++ee) {
      const int cc = cnt[ee], tiles = ((cc + 255) >> 8) * ntn;
      if (w < acc + tiles) { const int r = w - acc; u.e = ee; u.pm = r / ntn; u.pn = r % ntn; u.ce = cc; u.pre = rows; u.ab = acc; return true; }
      acc += tiles; rows += cc;
    }
    return false;
  }
  __device__ __forceinline__ int a_row(const G8Unit& u, int row) const {
    const int r = min(u.pm * 256 + row, u.ce - 1);
    return rtok ? rtok[(size_t)u.e * TT + r] : u.pre + r;
  }
  __device__ __forceinline__ unsigned a_off(const G8Unit& u, int row) const { return (unsigned)a_row(u, row) * (unsigned)Kb; }
  __device__ __forceinline__ const char* b_ptr(const G8Unit& u) const { return Bt + (size_t)u.e * bstride + (size_t)u.pn * 256 * Kb; }
};
struct EpiGu {
  const float* bgl; u16* act; const float* rsc; const float* swl;
  __device__ __forceinline__ void pre(const G8Unit& u, int wr, int fr, float (&ep)[8], float* cb) const {
    if ((ltid() >> 6) == 0) g8_cload(bgl + (size_t)u.e * 2048 + u.pn * 256, cb);
    if ((ltid() >> 6) == 1) g8_cload(swl + (size_t)u.e * 2048 + u.pn * 256, cb + 256);
    if ((ltid() >> 6) == 2) g8_cload(rsc + (size_t)u.e * TT + u.pm * 256, cb + 512);
  }
  __device__ __forceinline__ void operator()(const i32x4 (&acc)[2][2][4][2], const G8Unit& u, int wr, int wc, int fr, int fq, const float (&ep)[8], const float* cb) const {
    const int j0 = u.pn * 128 + wc * 32 + 8 * fq;
    typedef float f2v __attribute__((ext_vector_type(2)));
    const float* bg = cb + 2 * (wc * 32 + 8 * fq);
    f2v bgt[4], bup[4], sg[4], su[4];
#pragma unroll
    for (int q = 0; q < 4; ++q) { const f32x4 t = *(const f32x4*)(bg + 4 * q); bgt[q] = f2v{t[0], t[2]}; bup[q] = f2v{t[1], t[3]}; asm volatile("" : "+v"(bgt[q]), "+v"(bup[q])); }
    {
      const float* sp = cb + 256 + wc * 32 + 8 * fq;
      const f32x4 g0 = *(const f32x4*)sp, g1 = *(const f32x4*)(sp + 4), u0 = *(const f32x4*)(sp + 128), u1 = *(const f32x4*)(sp + 132);
      sg[0] = f2v{g0[0], g0[1]}; sg[1] = f2v{g0[2], g0[3]}; sg[2] = f2v{g1[0], g1[1]}; sg[3] = f2v{g1[2], g1[3]};
      su[0] = f2v{u0[0], u0[1]}; su[1] = f2v{u0[2], u0[3]}; su[2] = f2v{u1[0], u1[1]}; su[3] = f2v{u1[2], u1[3]};
    }
    const f2v kexp = f2v{-1.702f * 1.4426950408889634f, -1.702f * 1.4426950408889634f}, one2 = f2v{1.f, 1.f};
#pragma unroll
    for (int ai = 0; ai < 2; ++ai)
#pragma unroll
      for (int m = 0; m < 4; ++m) {
        const int r = u.pm * 256 + ai * 128 + wr * 64 + m * 16 + fr;
        if (r < u.ce) {
          const float sa = cb[512 + ai * 128 + wr * 64 + m * 16 + fr]; const f2v sa2 = f2v{sa, sa};
          unsigned ow[4];
#pragma unroll
          for (int n = 0; n < 2; ++n)
#pragma unroll
            for (int jp = 0; jp < 2; ++jp) {
              const int q = 2 * n + jp;
              f2v g = f2v{(float)acc[ai][0][m][n][2 * jp], (float)acc[ai][0][m][n][2 * jp + 1]};
              f2v v = f2v{(float)acc[ai][1][m][n][2 * jp], (float)acc[ai][1][m][n][2 * jp + 1]};
              g = (g * sa2) * sg[q] + bgt[q];
              v = (v * sa2) * su[q] + bup[q];
              g = f2v{fminf(g[0], 7.f), fminf(g[1], 7.f)};
              v = f2v{__builtin_amdgcn_fmed3f(v[0], -7.f, 7.f), __builtin_amdgcn_fmed3f(v[1], -7.f, 7.f)};
              const f2v t = g * kexp;
              const f2v d = f2v{__builtin_amdgcn_exp2f(t[0]), __builtin_amdgcn_exp2f(t[1])} + one2;
              const f2v rr = f2v{__builtin_amdgcn_rcpf(d[0]), __builtin_amdgcn_rcpf(d[1])};
              const f2v o = (v * g + g) * rr;
              ow[q] = cvtpk(o[0], o[1]);
            }
          *(u32x4*)(act + (size_t)(u.pre + r) * DFF + j0) = u32x4{ow[0], ow[1], ow[2], ow[3]};
        }
      }
  }
};
struct EpiDn {
  const float* bdl; const float* rw; unsigned char* yd;
  __device__ __forceinline__ void pre(const G8Unit& u, int wr, int fr, float (&ep)[8], float* cb) const {
    if ((ltid() >> 6) == 0) g8_cload(bdl + (size_t)u.e * DM + u.pn * 256, cb);
    if ((ltid() >> 6) == 2) g8_cload(rw + (size_t)u.e * TT + u.pm * 256, cb + 512);
  }
  __device__ __forceinline__ void operator()(const f32x4 (&acc)[2][2][4][2], const G8Unit& u, int wr, int wc, int fr, int fq, const float (&ep)[8], const float* cb) const {
#pragma unroll
    for (int bj = 0; bj < 2; ++bj) {
      const int c0 = u.pn * 256 + bj * 128 + wc * 32 + 8 * fq;
      const f32x4 ba = *(const f32x4*)(cb + bj * 128 + wc * 32 + 8 * fq), bb = *(const f32x4*)(cb + bj * 128 + wc * 32 + 8 * fq + 4);
#pragma unroll
      for (int ai = 0; ai < 2; ++ai)
#pragma unroll
        for (int m = 0; m < 4; ++m) {
          const int r = u.pm * 256 + ai * 128 + wr * 64 + m * 16 + fr;
          if (r < u.ce) {
            const float wgt = cb[512 + ai * 128 + wr * 64 + m * 16 + fr];
            const float w8 = wgt * 8.f;
            f32x4 a = (acc[ai][bj][m][0] + ba) * w8, b = (acc[ai][bj][m][1] + bb) * w8;
#pragma unroll
            for (int j = 0; j < 4; ++j) { a[j] = fminf(fmaxf(a[j], -440.f), 440.f); b[j] = fminf(fmaxf(b[j], -440.f), 440.f); }
            int w0 = 0, w1 = 0;
            w0 = __builtin_amdgcn_cvt_pk_fp8_f32(a[0], a[1], w0, false); w0 = __builtin_amdgcn_cvt_pk_fp8_f32(a[2], a[3], w0, true);
            w1 = __builtin_amdgcn_cvt_pk_fp8_f32(b[0], b[1], w1, false); w1 = __builtin_amdgcn_cvt_pk_fp8_f32(b[2], b[3], w1, true);
            *(u32x2*)(yd + (size_t)(u.pre + r) * DM + c0) = u32x2{(unsigned)w0, (unsigned)w1};
          }
        }
    }
  }
};
__device__ __forceinline__ void phase_moe_gu(const Params& p, int layer, int bid, int nb, char* lds) {
  int* scnt = (int*)(lds + 131072);
  if (ltid() < NE) scnt[ltid()] = p.cnt()[layer * NE + ltid()];
  __syncthreads();
  G8MoeT<true> S; S.cnt = scnt; S.ntn = 8; S.Kb = DM; S.G = nb; S.c = bid; S.Bt = (const char*)(p.bt_gu() + (size_t)layer * NE * 2048 * DM); S.bstride = (size_t)2048 * DM; S.rtok = p.rtok();
  EpiGu E; E.bgl = p.moe_b_gu() + (size_t)layer * NE * 2048; E.act = p.act(); E.rsc = p.rsc(); E.swl = p.swgu() + (size_t)layer * NE * 2048;
  gemm8_phase<true>(lds, (const char*)p.H(), DM, S, E);
}
__device__ __forceinline__ void phase_moe_dn(const Params& p, int layer, int bid, int nb, char* lds) {
  int* scnt = (int*)(lds + 131072);
  if (ltid() < NE) scnt[ltid()] = p.cnt()[layer * NE + ltid()];
  __syncthreads();
  G8MoeT<false> S; S.cnt = scnt; S.ntn = 4; S.Kb = 2 * DFF; S.G = nb; S.c = bid; S.Bt = (const char*)(p.bt_dn() + (size_t)layer * NE * DM * DFF); S.bstride = (size_t)DM * DFF * 2; S.rtok = nullptr;
  EpiDn E; E.bdl = p.moe_b_down() + (size_t)layer * NE * DM; E.rw = p.rw(); E.yd = p.yd();
  gemm8_phase<false>(lds, (const char*)p.act(), 2 * DFF, S, E);
}

__device__ __forceinline__ void phase_final(const Params& p, int bid, int nb, char* lds) {
  int* pre = (int*)lds;
  expert_prefix(p.cnt() + NE, pre); __syncthreads();
  const int wid = ltid() >> 6, lane = ltid() & 63;
  for (int tok = bid * 8 + wid; tok < TL; tok += nb * 8) {
    float v[16];
    load_row_comb(p, 1, 1, tok, lane, pre, v);
    float ss = 0;
#pragma unroll
    for (int i = 0; i < 16; ++i) ss += v[i] * v[i];
    ss = wave_sum(ss);
    const float rs = rsqrtf(ss * (1.f / DM) + EPS);
    float* o = p.out() + (size_t)tok * DM;
#pragma unroll
    for (int i = 0; i < 4; ++i) {
      const int c = lane * 4 + i * 256;
      const float4 g = *(const float4*)(p.final_g() + c);
      *(float4*)(o + c) = make_float4(v[4 * i] * rs * g.x, v[4 * i + 1] * rs * g.y, v[4 * i + 2] * rs * g.z, v[4 * i + 3] * rs * g.w);
    }
  }
}

#define XB_TMO      128
#define XB_XCNT(j)  (256  + 64 * (j))
#define XB_XSUB(j)  (1280 + 64 * (j))
#define XB_XGEN(j)  (2304 + 64 * (j))
#define XB_TOP      3328
#define XB_TOPGEN   3392
#define XCD_BAR_WORDS 3456
#define XB_SPIN_CAP (1u << 18)
#define LAS __attribute__((address_space(3)))

__device__ __forceinline__ unsigned xb_ld(unsigned* p)              { return __hip_atomic_load(p, __ATOMIC_RELAXED, __HIP_MEMORY_SCOPE_AGENT); }
__device__ __forceinline__ unsigned xb_add(unsigned* p, unsigned v) { return __hip_atomic_fetch_add(p, v, __ATOMIC_RELAXED, __HIP_MEMORY_SCOPE_AGENT); }
__device__ __forceinline__ unsigned xb_xcc_id() { return (unsigned)__builtin_amdgcn_s_getreg((3 << 11) | 20) & 0xFu; }
#define XB_SPIN(cond, bar) do { unsigned _sp = 0; while (cond) { __builtin_amdgcn_s_sleep(1); \
    if ((++_sp & 255u) == 0u) { if (xb_ld(&(bar)[XB_TMO])) break; if (_sp > XB_SPIN_CAP) { atomicAdd(&(bar)[XB_TMO], 1u); break; } } } } while (0)

struct XcdBarrier {
    unsigned* bar; unsigned x;
    volatile LAS unsigned* st;
};

__device__ __forceinline__ XcdBarrier xcd_barrier_post(unsigned* bar, volatile LAS unsigned* st) {
    XcdBarrier b; b.bar = bar; b.x = xb_xcc_id(); b.st = st;
    if (threadIdx.x == 0) (void)xb_add(&bar[XB_XCNT(b.x)], 1u);
    return b;
}
__device__ __forceinline__ void xcd_barrier_complete(unsigned* bar, unsigned x, unsigned& nloc, unsigned& nx) {
    const unsigned G = gridDim.x * gridDim.y * gridDim.z;
    unsigned sum, cnt, mine, sp = 0u;
    for (;;) {
        sum = 0u; cnt = 0u; mine = 0u;
#pragma unroll
        for (unsigned j = 0; j < 16; ++j) { const unsigned c = xb_ld(&bar[XB_XCNT(j)]); sum += c; cnt += (c > 0u) ? 1u : 0u; mine = (j == x) ? c : mine; }
        if (sum == G) break;
        __builtin_amdgcn_s_sleep(1);
        if ((++sp & 255u) == 0u) { if (xb_ld(&bar[XB_TMO])) break; if (sp > XB_SPIN_CAP) { atomicAdd(&bar[XB_TMO], 1u); break; } }
    }
    nloc = mine > 0u ? mine : 1u; nx = cnt > 0u ? cnt : 1u;
}

__device__ __forceinline__ void xcd_barrier(const XcdBarrier& b) {
    asm volatile("s_waitcnt vmcnt(0)" ::: "memory");
    __syncthreads();
    if (threadIdx.x == 0) {
        unsigned* bar = b.bar;
        __builtin_amdgcn_s_waitcnt(0);
        unsigned nloc = b.st[0], nx = b.st[1];
        if (nloc == 0u) { xcd_barrier_complete(bar, b.x, nloc, nx); b.st[0] = nloc; b.st[1] = nx; }
        const unsigned old = xb_add(&bar[XB_XSUB(b.x)], 1u);
        const unsigned gen = old / nloc;
        if (old + 1u == (gen + 1u) * nloc) {
            __builtin_amdgcn_fence(__ATOMIC_RELEASE, "agent");
            asm volatile("s_waitcnt vmcnt(0)" ::: "memory");
            const unsigned og = xb_add(&bar[XB_TOP], 1u);
            const unsigned tg = og / nx;
            if (og + 1u == (tg + 1u) * nx) xb_add(&bar[XB_TOPGEN], 1u);
            else XB_SPIN(xb_ld(&bar[XB_TOPGEN]) == tg, bar);
            __builtin_amdgcn_fence(__ATOMIC_ACQUIRE, "agent");
            xb_add(&bar[XB_XGEN(b.x)], 1u);
            asm volatile("s_waitcnt vmcnt(0)" ::: "memory");
        } else {
            XB_SPIN(xb_ld(&bar[XB_XGEN(b.x)]) == gen, bar);
            __builtin_amdgcn_fence(__ATOMIC_ACQUIRE, "agent");
            asm volatile("s_waitcnt vmcnt(0)" ::: "memory");
        }
    }
    __syncthreads();
}


constexpr int LDS_MAIN = 147456;
constexpr int LDS_BYTES = LDS_MAIN + 1024;
enum { PH_TABLES = 0, PH_MOD, PH_FOLD, PH_CONVERT, PH_HYMLP, PH_HYFILT, PH_NORM1, PH_GEMM_IN, PH_QKV, PH_ATTN, PH_FFTMIX,
       PH_GLA_A, PH_GLA_B, PH_GLA_C, PH_MIX, PH_GEMM_OUT, PH_NORM2, PH_MOE_GU, PH_MOE_DN, PH_FINAL };

__device__ __forceinline__ Params make_params() {
  const __attribute__((address_space(4))) char* kb = (const __attribute__((address_space(4))) char*)__builtin_amdgcn_kernarg_segment_ptr();
  asm volatile("" : "+s"(kb));
  Params p; p.kb = kb; return p;
}
#ifndef MK_LAUNCHES
#define MK_LAUNCHES 1
#endif
__global__ void __launch_bounds__(NTHR, 2) k_mega(ParamsData pd) {
  extern __shared__ __attribute__((aligned(1024))) char lds[];
  const int bid = blockIdx.x, nb = gridDim.x;
  if (threadIdx.x == 0) *(uint4*)(lds + LDS_MAIN) = make_uint4(0u, 0u, 0u, 0u);
  __syncthreads();
  XcdBarrier bar = xcd_barrier_post(make_params().bar(), (volatile LAS unsigned*)(lds + LDS_MAIN));
#ifndef DBLMASK
#define DBLMASK 0u
#endif
#define RUNPH(bit, call) do { call; if (DBLMASK & (1u << (bit))) { __syncthreads(); call; } } while (0)
  RUNPH(13, phase_tables(make_params(), bid, nb); phase_mod(make_params(), bid, nb, lds); phase_fold(make_params(), bid, nb, lds));
  RUNPH(0, phase_convert(make_params(), bid, nb, lds));
  phase_hy_mlp(make_params(), 0, SEQ, make_params().hfb(), make_params().hpart(), bid, nb, lds);
  phase_hy_mlp(make_params(), 1, SEQ, make_params().hfb() + (size_t)2 * 256 * SEQ, make_params().hpart() + 256 * 512, bid, nb, lds);
  phase_hy_mlp(make_params(), 0, LC, make_params().hfc(), make_params().hpart() + 2 * 256 * 512, bid, nb, lds);
  xcd_barrier(bar);
  RUNPH(2, phase_hy_filtfft(make_params(), bid, nb, lds));
  phase_quant_in(make_params(), bid, nb);
#define MK_LAYER(l) do { \
  phase_norm1(make_params(), l, bid, nb, lds); if ((DBLMASK & (1u << 14)) && l == 0) { __syncthreads(); phase_norm1(make_params(), l, bid, nb, lds); } \
  xcd_barrier(bar); \
  RUNPH(3, phase_gemm_in(make_params(), l, bid, nb, lds)); \
  xcd_barrier(bar); \
  RUNPH(4, phase_qkv(make_params(), l, bid, nb, lds)); \
  RUNPH(5, phase_gla_a(make_params(), l, bid, nb, lds)); \
  RUNPH(7, phase_fftmix(make_params(), l, bid, nb, lds)); \
  xcd_barrier(bar); \
  RUNPH(6, phase_attn(make_params(), l, bid, nb, lds)); \
  RUNPH(9, phase_gla_c(make_params(), l, bid, nb, lds)); \
  RUNPH(10, phase_mix(make_params(), l, bid, nb, lds)); \
  xcd_barrier(bar); \
  phase_gemm_out(make_params(), l, bid, nb, lds); if ((DBLMASK & (1u << 16)) && l == 0) { __syncthreads(); phase_gemm_out(make_params(), l, bid, nb, lds); } \
  xcd_barrier(bar); \
  phase_norm2_router(make_params(), l, bid, nb, lds); \
  xcd_barrier(bar); \
  RUNPH(11, phase_moe_gu(make_params(), l, bid, nb, lds)); \
  xcd_barrier(bar); \
  RUNPH(12, phase_moe_dn(make_params(), l, bid, nb, lds)); \
  xcd_barrier(bar); \
  } while (0)
  MK_LAYER(0);
  MK_LAYER(1);
#undef MK_LAYER
  RUNPH(15, phase_final(make_params(), bid, nb, lds));
}
static size_t carve(char*& cur, size_t bytes) { char* r = cur; cur += (bytes + 1023) & ~(size_t)1023; return (size_t)(uintptr_t)r; }
#define CARVE(T, field, n) p.field = (T*)carve(cur, (size_t)(n) * sizeof(T))

extern "C" void kernel_launch(void* const* d_in, const int* in_sizes, int n_in, void* d_out, int out_size, void* d_ws, size_t ws_size, hipStream_t stream) {
  ParamsData p; memset(&p, 0, sizeof(p));
  const float** ins = (const float**)&p;
  for (int i = 0; i < 34; ++i) ins[i] = (const float*)d_in[i];
  p.out_ = (float*)d_out;
  p.ws_ = (char*)d_ws;
  if (WS_TOTAL > ws_size) { fprintf(stderr, "workspace too small: need %zu have %zu\n", (size_t)WS_TOTAL, ws_size); return; }
  hipMemsetAsync((char*)d_ws + OFF_bar, 0, OFF_mod - OFF_bar, stream);
  static int grid = 0;
  if (!grid) {
    int dev = 0, cus = 0, per_cu = 0;
    hipGetDevice(&dev);
    hipDeviceGetAttribute(&cus, hipDeviceAttributeMultiprocessorCount, dev);
    hipFuncSetAttribute((const void*)k_mega, hipFuncAttributeMaxDynamicSharedMemorySize, LDS_BYTES);
    hipOccupancyMaxActiveBlocksPerMultiprocessor(&per_cu, (const void*)k_mega, NTHR, LDS_BYTES);
    grid = cus * (per_cu < 1 ? per_cu : 1);
    if (grid != 256) fprintf(stderr, "unexpected grid %d (cus %d per_cu %d)\n", grid, cus, per_cu);
  }
  hipLaunchKernelGGL(k_mega, dim3(grid), dim3(NTHR), LDS_BYTES, stream, p);
}
```

```cpp
#include <hip/hip_runtime.h>
#include <hip/hip_bf16.h>
#include <cstdio>
#include <cstdint>
#include <cstring>
#include <cstddef>
#include <type_traits>

typedef unsigned short u16;
using bf16x8 = __attribute__((ext_vector_type(8))) short;
using s16x4  = __attribute__((ext_vector_type(4))) short;
using f32x4  = __attribute__((ext_vector_type(4))) float;
using f32x16 = __attribute__((ext_vector_type(16))) float;
using u32x4  = __attribute__((ext_vector_type(4))) unsigned;
using u32x2  = __attribute__((ext_vector_type(2))) unsigned;

constexpr int DM = 1024, NB = 2, SEQ = 16384, LC = 256;
constexpr int TL = NB * SEQ;
constexpr int TC = NB * LC;
constexpr int TT = TL + TC;
constexpr int NIN = 2816;
constexpr int DIN0 = 2240;
constexpr int NE = 32, TOPK = 4, DFF = 1024;
constexpr int SKV = SEQ + LC;
constexpr int NTHR = 512;
constexpr float EPS = 1e-6f;
constexpr float A_SCALE = 0.10206207261596575f;
constexpr float A_QSCALE = A_SCALE * 1.4426950408889634f;
constexpr int ZG_W = 1152, ZG_GQ = 0, ZG_GK = 128, ZG_KR = 256, ZG_GV = 384, ZG_GP = 640, ZG_OG = 896;
constexpr int ZT_HY = 0, ZT_FR = 768, ZT_FI = 1024, ZT_R = 1280;
constexpr int NCH = 260;
constexpr int FM = 16384;
constexpr int HSP = FM / 2 + 1;

constexpr size_t ws_al(size_t b) { return (b + 1023) & ~(size_t)1023; }
constexpr size_t OFF_bar = 0;
constexpr size_t OFF_cnt = OFF_bar + ws_al((size_t)(4096) * sizeof(unsigned));
constexpr size_t OFF_hssq = OFF_cnt + ws_al((size_t)(64) * sizeof(int));
constexpr size_t OFF_kmx = OFF_hssq + ws_al((size_t)(768) * sizeof(float));
constexpr size_t OFF_mod = OFF_kmx + ws_al((size_t)(128) * sizeof(unsigned));
constexpr size_t OFF_ropec = OFF_mod + ws_al((size_t)(2 * 3 * 6144) * sizeof(float));
constexpr size_t OFF_ropes = OFF_ropec + ws_al((size_t)(SEQ * 16) * sizeof(float));
constexpr size_t OFF_tw = OFF_ropes + ws_al((size_t)(SEQ * 16) * sizeof(float));
constexpr size_t OFF_bt_in = OFF_tw + ws_al((size_t)(FM) * sizeof(float2));
constexpr size_t OFF_bt_qkv = OFF_bt_in + ws_al((size_t)((size_t)2 * NIN * DM) * sizeof(u16));
constexpr size_t OFF_bt_out = OFF_bt_qkv + ws_al((size_t)(2 * 1024 * 384) * sizeof(u16));
constexpr size_t OFF_bt_gu = OFF_bt_out + ws_al((size_t)((size_t)2 * DM * DM) * sizeof(u16));
constexpr size_t OFF_bt_dn = OFF_bt_gu + ws_al((size_t)((size_t)2 * NE * 2048 * DM) * sizeof(u16));
constexpr size_t OFF_hfb = OFF_bt_dn + ws_al((size_t)((size_t)2 * NE * DM * DFF) * sizeof(u16));
constexpr size_t OFF_hfc = OFF_hfb + ws_al((size_t)((size_t)2 * 2 * 256 * SEQ) * sizeof(float));
constexpr size_t OFF_hspec = OFF_hfc + ws_al((size_t)(2 * 256 * LC) * sizeof(float));
constexpr size_t OFF_H = OFF_hspec + ws_al((size_t)((size_t)2 * 256 * HSP) * sizeof(float4));
constexpr size_t OFF_zqkv = OFF_H + ws_al((size_t)((size_t)TT * DM) * sizeof(u16));
constexpr size_t OFF_zg = OFF_zqkv + ws_al((size_t)((size_t)TT * 384) * sizeof(u16));
constexpr size_t OFF_zt = OFF_zg + ws_al((size_t)((size_t)TT * ZG_W) * sizeof(float));
constexpr size_t OFF_Q = OFF_zt + ws_al((size_t)((size_t)ZT_R * TT) * sizeof(float));
constexpr size_t OFF_KV = OFF_Q + ws_al((size_t)((size_t)2 * 4 * SKV * 96) * sizeof(u16));
constexpr size_t OFF_ymix = OFF_KV + ws_al((size_t)((size_t)2 * 4 * SKV * 160) * sizeof(u16));
constexpr size_t OFF_hyo = OFF_ymix + ws_al((size_t)((size_t)TT * DM) * sizeof(u16));
constexpr size_t OFF_fno = OFF_hyo + ws_al((size_t)((size_t)256 * TT) * sizeof(float));
constexpr size_t OFF_glao = OFF_fno + ws_al((size_t)((size_t)256 * TT) * sizeof(float));
constexpr size_t OFF_gds = OFF_glao + ws_al((size_t)((size_t)TT * 256) * sizeof(float));
constexpr size_t OFF_gdv = OFF_gds + ws_al((size_t)((size_t)16 * NCH * 2048) * sizeof(float));
constexpr size_t OFF_gst = OFF_gdv + ws_al((size_t)((size_t)16 * NCH * 32) * sizeof(float));
constexpr size_t OFF_X = OFF_gst + ws_al((size_t)((size_t)16 * NCH * 2048) * sizeof(float));
constexpr size_t OFF_rtok = OFF_X + ws_al((size_t)((size_t)TT * DM) * sizeof(float));
constexpr size_t OFF_rw = OFF_rtok + ws_al((size_t)((size_t)NE * TT) * sizeof(int));
constexpr size_t OFF_tslot = OFF_rw + ws_al((size_t)((size_t)NE * TT) * sizeof(float));
constexpr size_t OFF_act = OFF_tslot + ws_al((size_t)((size_t)TT * 4) * sizeof(int));
constexpr size_t OFF_yd = OFF_act + ws_al((size_t)((size_t)TT * 4 * DFF) * sizeof(u16));
constexpr size_t OFF_swin = OFF_yd + ws_al((size_t)((size_t)TT * 4 * DM) * sizeof(u16));
constexpr size_t OFF_swgu = OFF_swin + ws_al((size_t)(2 * NIN) * sizeof(float));
constexpr size_t OFF_hs = OFF_swgu + ws_al((size_t)(2 * NE * 2048) * sizeof(float));
constexpr size_t OFF_hpart = OFF_hs + ws_al((size_t)(TT) * sizeof(float));
constexpr size_t OFF_rsc = OFF_hpart + ws_al((size_t)(3 * 256 * 512) * sizeof(float));
constexpr size_t WS_TOTAL = OFF_rsc + ws_al((size_t)((size_t)NE * TT) * sizeof(float));
struct ParamsData {
  const float *x_, *c_, *ctx_, *c_ctx_, *ada_w_, *ada_b_, *norm1_g_, *norm2_g_, *w_in_, *mla_q_g_, *mla_w_uq_, *mla_kv_g_, *mla_w_ukv_, *hy_conv_w_, *hy_conv_b_, *hy_w1_, *hy_b1_, *hy_w2_, *hy_b2_, *hy_w3_, *hy_freq_, *hy_bias_, *gla_gk_w_, *gla_gk_b_, *fnet_w_, *mix_g_, *w_out_, *router_w_, *router_b_, *moe_w_gu_, *moe_b_gu_, *moe_w_down_, *moe_b_down_, *final_g_;
  float* out_;
  char* ws_;
};
struct Params {
  const __attribute__((address_space(4))) char* kb;
  template <class T> __device__ __forceinline__ T karg(size_t off) const { return *(const __attribute__((address_space(4))) T*)(kb + off); }
  __device__ __forceinline__ const float* x() const { return karg<const float*>(offsetof(ParamsData, x_)); }
  __device__ __forceinline__ const float* c() const { return karg<const float*>(offsetof(ParamsData, c_)); }
  __device__ __forceinline__ const float* ctx() const { return karg<const float*>(offsetof(ParamsData, ctx_)); }
  __device__ __forceinline__ const float* c_ctx() const { return karg<const float*>(offsetof(ParamsData, c_ctx_)); }
  __device__ __forceinline__ const float* ada_w() const { return karg<const float*>(offsetof(ParamsData, ada_w_)); }
  __device__ __forceinline__ const float* ada_b() const { return karg<const float*>(offsetof(ParamsData, ada_b_)); }
  __device__ __forceinline__ const float* norm1_g() const { return karg<const float*>(offsetof(ParamsData, norm1_g_)); }
  __device__ __forceinline__ const float* norm2_g() const { return karg<const float*>(offsetof(ParamsData, norm2_g_)); }
  __device__ __forceinline__ const float* w_in() const { return karg<const float*>(offsetof(ParamsData, w_in_)); }
  __device__ __forceinline__ const float* mla_q_g() const { return karg<const float*>(offsetof(ParamsData, mla_q_g_)); }
  __device__ __forceinline__ const float* mla_w_uq() const { return karg<const float*>(offsetof(ParamsData, mla_w_uq_)); }
  __device__ __forceinline__ const float* mla_kv_g() const { return karg<const float*>(offsetof(ParamsData, mla_kv_g_)); }
  __device__ __forceinline__ const float* mla_w_ukv() const { return karg<const float*>(offsetof(ParamsData, mla_w_ukv_)); }
  __device__ __forceinline__ const float* hy_conv_w() const { return karg<const float*>(offsetof(ParamsData, hy_conv_w_)); }
  __device__ __forceinline__ const float* hy_conv_b() const { return karg<const float*>(offsetof(ParamsData, hy_conv_b_)); }
  __device__ __forceinline__ const float* hy_w1() const { return karg<const float*>(offsetof(ParamsData, hy_w1_)); }
  __device__ __forceinline__ const float* hy_b1() const { return karg<const float*>(offsetof(ParamsData, hy_b1_)); }
  __device__ __forceinline__ const float* hy_w2() const { return karg<const float*>(offsetof(ParamsData, hy_w2_)); }
  __device__ __forceinline__ const float* hy_b2() const { return karg<const float*>(offsetof(ParamsData, hy_b2_)); }
  __device__ __forceinline__ const float* hy_w3() const { return karg<const float*>(offsetof(ParamsData, hy_w3_)); }
  __device__ __forceinline__ const float* hy_freq() const { return karg<const float*>(offsetof(ParamsData, hy_freq_)); }
  __device__ __forceinline__ const float* hy_bias() const { return karg<const float*>(offsetof(ParamsData, hy_bias_)); }
  __device__ __forceinline__ const float* gla_gk_w() const { return karg<const float*>(offsetof(ParamsData, gla_gk_w_)); }
  __device__ __forceinline__ const float* gla_gk_b() const { return karg<const float*>(offsetof(ParamsData, gla_gk_b_)); }
  __device__ __forceinline__ const float* fnet_w() const { return karg<const float*>(offsetof(ParamsData, fnet_w_)); }
  __device__ __forceinline__ const float* mix_g() const { return karg<const float*>(offsetof(ParamsData, mix_g_)); }
  __device__ __forceinline__ const float* w_out() const { return karg<const float*>(offsetof(ParamsData, w_out_)); }
  __device__ __forceinline__ const float* router_w() const { return karg<const float*>(offsetof(ParamsData, router_w_)); }
  __device__ __forceinline__ const float* router_b() const { return karg<const float*>(offsetof(ParamsData, router_b_)); }
  __device__ __forceinline__ const float* moe_w_gu() const { return karg<const float*>(offsetof(ParamsData, moe_w_gu_)); }
  __device__ __forceinline__ const float* moe_b_gu() const { return karg<const float*>(offsetof(ParamsData, moe_b_gu_)); }
  __device__ __forceinline__ const float* moe_w_down() const { return karg<const float*>(offsetof(ParamsData, moe_w_down_)); }
  __device__ __forceinline__ const float* moe_b_down() const { return karg<const float*>(offsetof(ParamsData, moe_b_down_)); }
  __device__ __forceinline__ const float* final_g() const { return karg<const float*>(offsetof(ParamsData, final_g_)); }
  __device__ __forceinline__ float* out() const { return karg<float*>(offsetof(ParamsData, out_)); }
  __device__ __forceinline__ char* ws() const { return karg<char*>(offsetof(ParamsData, ws_)); }
  __device__ __forceinline__ unsigned* bar() const { return (unsigned*)(ws() + OFF_bar); }
  __device__ __forceinline__ int* cnt() const { return (int*)(ws() + OFF_cnt); }
  __device__ __forceinline__ float* hssq() const { return (float*)(ws() + OFF_hssq); }
  __device__ __forceinline__ unsigned* kmx() const { return (unsigned*)(ws() + OFF_kmx); }
  __device__ __forceinline__ float* mod() const { return (float*)(ws() + OFF_mod); }
  __device__ __forceinline__ float* ropec() const { return (float*)(ws() + OFF_ropec); }
  __device__ __forceinline__ float* ropes() const { return (float*)(ws() + OFF_ropes); }
  __device__ __forceinline__ float2* tw() const { return (float2*)(ws() + OFF_tw); }
  __device__ __forceinline__ signed char* bt_in() const { return (signed char*)(ws() + OFF_bt_in); }
  __device__ __forceinline__ u16* bt_qkv() const { return (u16*)(ws() + OFF_bt_qkv); }
  __device__ __forceinline__ u16* bt_out() const { return (u16*)(ws() + OFF_bt_out); }
  __device__ __forceinline__ signed char* bt_gu() const { return (signed char*)(ws() + OFF_bt_gu); }
  __device__ __forceinline__ u16* bt_dn() const { return (u16*)(ws() + OFF_bt_dn); }
  __device__ __forceinline__ float* hfb() const { return (float*)(ws() + OFF_hfb); }
  __device__ __forceinline__ float* hfc() const { return (float*)(ws() + OFF_hfc); }
  __device__ __forceinline__ float4* hspec() const { return (float4*)(ws() + OFF_hspec); }
  __device__ __forceinline__ signed char* H() const { return (signed char*)(ws() + OFF_H); }
  __device__ __forceinline__ float* hs() const { return (float*)(ws() + OFF_hs); }
  __device__ __forceinline__ float* rsc() const { return (float*)(ws() + OFF_rsc); }
  __device__ __forceinline__ float* hpart() const { return (float*)(ws() + OFF_hpart); }
  __device__ __forceinline__ float* swin() const { return (float*)(ws() + OFF_swin); }
  __device__ __forceinline__ float* swgu() const { return (float*)(ws() + OFF_swgu); }
  __device__ __forceinline__ float* btf() const { return (float*)(ws() + OFF_act); }
  __device__ __forceinline__ u16* zqkv() const { return (u16*)(ws() + OFF_zqkv); }
  __device__ __forceinline__ u16* zg() const { return (u16*)(ws() + OFF_zg); }
  __device__ __forceinline__ u16* zt() const { return (u16*)(ws() + OFF_zt); }
  __device__ __forceinline__ u16* Q() const { return (u16*)(ws() + OFF_Q); }
  __device__ __forceinline__ u16* KV() const { return (u16*)(ws() + OFF_KV); }
  __device__ __forceinline__ u16* ymix() const { return (u16*)(ws() + OFF_ymix); }
  __device__ __forceinline__ u16* hyo() const { return (u16*)(ws() + OFF_hyo); }
  __device__ __forceinline__ u16* fno() const { return (u16*)(ws() + OFF_fno); }
  __device__ __forceinline__ u16* glao() const { return (u16*)(ws() + OFF_glao); }
  __device__ __forceinline__ float* gds() const { return (float*)(ws() + OFF_gds); }
  __device__ __forceinline__ float* gdv() const { return (float*)(ws() + OFF_gdv); }
  __device__ __forceinline__ float* gst() const { return (float*)(ws() + OFF_gst); }
  __device__ __forceinline__ u16* X() const { return (u16*)(ws() + OFF_X); }
  __device__ __forceinline__ int* rtok() const { return (int*)(ws() + OFF_rtok); }
  __device__ __forceinline__ float* rw() const { return (float*)(ws() + OFF_rw); }
  __device__ __forceinline__ int* tslot() const { return (int*)(ws() + OFF_tslot); }
  __device__ __forceinline__ u16* act() const { return (u16*)(ws() + OFF_act); }
  __device__ __forceinline__ unsigned char* yd() const { return (unsigned char*)(ws() + OFF_yd); }
};


__device__ __forceinline__ u16 f2bf(float f) {
  unsigned u = __float_as_uint(f); u += 0x7FFFu + ((u >> 16) & 1u); return (u16)(u >> 16);
}
__device__ __forceinline__ float bf2f(u16 h) { return __uint_as_float(((unsigned)h) << 16); }
__device__ __forceinline__ unsigned cvtpk(float lo, float hi) {
  unsigned r; asm volatile("v_cvt_pk_bf16_f32 %0, %1, %2" : "=v"(r) : "v"(lo), "v"(hi)); return r;
}
#define BF_LO(w) __uint_as_float((w) << 16)
#define BF_HI(w) __uint_as_float((w) & 0xFFFF0000u)
__device__ __forceinline__ float4 ld4bf(const u16* p) { const u32x2 w = *(const u32x2*)p; return make_float4(__uint_as_float(w[0] << 16), __uint_as_float(w[0] & 0xFFFF0000u), __uint_as_float(w[1] << 16), __uint_as_float(w[1] & 0xFFFF0000u)); }
template <int CTRL> __device__ __forceinline__ float dppf(float v) { return __builtin_bit_cast(float, __builtin_amdgcn_update_dpp(0, __builtin_bit_cast(int, v), CTRL, 0xF, 0xF, true)); }
template <int M> __device__ __forceinline__ float shx(float v) {
  if constexpr (M == 1) return dppf<0xB1>(v);
  else if constexpr (M == 2) return dppf<0x4E>(v);
  else if constexpr (M == 4) return dppf<0x1B>(dppf<0x141>(v));
  else if constexpr (M == 8) return dppf<0x141>(dppf<0x140>(v));
  else if constexpr (M == 16) { auto r = __builtin_amdgcn_permlane16_swap(__float_as_uint(v), __float_as_uint(v), false, false);
    return __uint_as_float((__lane_id() & 16) ? r[0] : r[1]); }
  else { auto r = __builtin_amdgcn_permlane32_swap(__float_as_uint(v), __float_as_uint(v), false, false);
    return __uint_as_float((__lane_id() & 32) ? r[0] : r[1]); }
}
__device__ __forceinline__ float wave_sum(float v) {
  v += dppf<0xB1>(v); v += dppf<0x4E>(v); v += dppf<0x141>(v); v += dppf<0x140>(v);
  { auto r = __builtin_amdgcn_permlane16_swap(__float_as_uint(v), __float_as_uint(v), false, false); v = __uint_as_float(r[0]) + __uint_as_float(r[1]); }
  { auto r = __builtin_amdgcn_permlane32_swap(__float_as_uint(v), __float_as_uint(v), false, false); v = __uint_as_float(r[0]) + __uint_as_float(r[1]); }
  return v;
}
__device__ __forceinline__ float wave_max(float v) {
  v = fmaxf(v, dppf<0xB1>(v)); v = fmaxf(v, dppf<0x4E>(v)); v = fmaxf(v, dppf<0x141>(v)); v = fmaxf(v, dppf<0x140>(v));
  { auto r = __builtin_amdgcn_permlane16_swap(__float_as_uint(v), __float_as_uint(v), false, false); v = fmaxf(__uint_as_float(r[0]), __uint_as_float(r[1])); }
  { auto r = __builtin_amdgcn_permlane32_swap(__float_as_uint(v), __float_as_uint(v), false, false); v = fmaxf(__uint_as_float(r[0]), __uint_as_float(r[1])); }
  return v;
}
__device__ __forceinline__ int ltid() { int t = threadIdx.x; asm volatile("" : "+v"(t)); return t; }
__device__ __forceinline__ float silu_f(float x) { return x / (1.f + __expf(-x)); }
__device__ __forceinline__ float2 cmul(float2 a, float2 b) { return make_float2(a.x * b.x - a.y * b.y, a.x * b.y + a.y * b.x); }
__device__ __forceinline__ float2 cmulc(float2 a, float2 b) { return make_float2(a.x * b.x + a.y * b.y, a.y * b.x - a.x * b.y); }
__device__ __forceinline__ int modv(int tok) { return tok < TL ? (tok >> 14) : 2; }
__device__ __forceinline__ void phase_tables(const Params& p, int bid, int nb) {
  const int gt = bid * NTHR + ltid(), gs = nb * NTHR;
  for (int i = gt; i < SEQ * 16; i += gs) {
    const int t = i >> 4, f = i & 15;
    const float pos = (f < 8) ? (float)(t >> 6) : (float)(t & 63);
    const float inv = powf(10000.f, -(float)(f & 7) / 8.f);
    float s, c; sincosf(pos * inv, &s, &c);
    p.ropec()[i] = c; p.ropes()[i] = s;
  }
  for (int i = gt; i < FM; i += gs) {
    float s, c; sincospif((float)i / 8192.f, &s, &c);
    p.tw()[i] = make_float2(c, -s);
  }
}

__device__ __forceinline__ void phase_mod(const Params& p, int bid, int nb, char* lds) {
  float* red = (float*)lds;
  const int tid = ltid(), part = tid >> 6, cl = tid & 63;
  for (int it = bid; it < 2 * 96; it += nb) {
    const int l = it / 96, n = (it % 96) * 64 + cl;
    const float* W = p.ada_w() + (size_t)l * DM * 6144;
    float a0 = 0, a1 = 0, a2 = 0;
    for (int k = part * 128; k < part * 128 + 128; ++k) {
      const float w = W[(size_t)k * 6144 + n];
      a0 += silu_f(p.c()[k]) * w; a1 += silu_f(p.c()[DM + k]) * w; a2 += silu_f(p.c_ctx()[k]) * w;
    }
    red[(part * 3 + 0) * 64 + cl] = a0; red[(part * 3 + 1) * 64 + cl] = a1; red[(part * 3 + 2) * 64 + cl] = a2;
    __syncthreads();
    if (tid < 192) {
      const int v = tid >> 6; float s = 0;
      for (int q = 0; q < 8; ++q) s += red[(q * 3 + v) * 64 + cl];
      p.mod()[((size_t)l * 3 + v) * 6144 + n] = s + p.ada_b()[(size_t)l * 6144 + n];
    }
    __syncthreads();
  }
}

__device__ __forceinline__ void phase_fold(const Params& p, int bid, int nb, char* lds) {
  float* wrow = (float*)lds;
  float* dre = wrow + 2048;
  float* dim_ = dre + 2048;
  float* glr = dim_ + 2048;
  float* cst = glr + 256;
  float* snt = cst + 256;
  const int tid = ltid();
  if (tid < 256) { float sn, cs; sincospif((float)tid / 128.f, &sn, &cs); cst[tid] = cs; snt[tid] = sn; }
  __syncthreads();
  for (int it = bid; it < 2 * DM / 8; it += nb) {
    const int l = it >> 7, k0 = (it & 127) * 8;
    for (int i = tid; i < 8 * 256; i += NTHR) { const int r = i >> 8, c = i & 255; wrow[c * 8 + r] = p.w_in()[((size_t)l * DM + k0 + r) * DIN0 + 1984 + c]; }
    if (tid < 256) { const int r = tid >> 5, c = tid & 31; glr[c * 8 + r] = p.w_in()[((size_t)l * DM + k0 + r) * DIN0 + 1696 + c]; }
    __syncthreads();
    {
      const int kp = tid & 255; const bool im = tid >= 256;
      float acc[8] = {0.f, 0.f, 0.f, 0.f, 0.f, 0.f, 0.f, 0.f};
#pragma unroll 4
      for (int c = 0; c < 256; ++c) {
        const int m = (c * kp) & 255; const float t = im ? -snt[m] : cst[m];
        const float4 w0 = *(const float4*)(wrow + c * 8), w1 = *(const float4*)(wrow + c * 8 + 4);
        acc[0] += w0.x * t; acc[1] += w0.y * t; acc[2] += w0.z * t; acc[3] += w0.w * t; acc[4] += w1.x * t; acc[5] += w1.y * t; acc[6] += w1.z * t; acc[7] += w1.w * t;
      }
      float* d = (im ? dim_ : dre) + kp * 8;
      *(float4*)d = make_float4(acc[0], acc[1], acc[2], acc[3]); *(float4*)(d + 4) = make_float4(acc[4], acc[5], acc[6], acc[7]);
    }
    __syncthreads();
    {
      const int j = tid & 255; const bool im = tid >= 256;
      const float* Wf = p.fnet_w() + (size_t)l * 65536 + j;
      const float* d = im ? dim_ : dre;
      float acc[8] = {0.f, 0.f, 0.f, 0.f, 0.f, 0.f, 0.f, 0.f};
#pragma unroll 8
      for (int kp = 0; kp < 256; ++kp) {
        const float w = Wf[kp * 256];
        const float4 d0 = *(const float4*)(d + kp * 8), d1 = *(const float4*)(d + kp * 8 + 4);
        acc[0] += d0.x * w; acc[1] += d0.y * w; acc[2] += d0.z * w; acc[3] += d0.w * w; acc[4] += d1.x * w; acc[5] += d1.y * w; acc[6] += d1.z * w; acc[7] += d1.w * w;
      }
      float* o = p.btf() + ((size_t)l * NIN + (im ? 2560 : 2304) + j) * DM + k0;
      *(float4*)o = make_float4(acc[0] * 0.0625f, acc[1] * 0.0625f, acc[2] * 0.0625f, acc[3] * 0.0625f);
      *(float4*)(o + 4) = make_float4(acc[4] * 0.0625f, acc[5] * 0.0625f, acc[6] * 0.0625f, acc[7] * 0.0625f);
    }
    if (tid < 256) {
      const int dir = tid >> 7, kk = tid & 127;
      const float* gw = p.gla_gk_w() + ((size_t)l * 2 + dir) * 16 * 128 + kk;
      float acc[8] = {0.f, 0.f, 0.f, 0.f, 0.f, 0.f, 0.f, 0.f};
#pragma unroll
      for (int r16 = 0; r16 < 16; ++r16) {
        const float w = gw[r16 * 128];
        const float4 g0 = *(const float4*)(glr + (dir * 16 + r16) * 8), g1 = *(const float4*)(glr + (dir * 16 + r16) * 8 + 4);
        acc[0] += g0.x * w; acc[1] += g0.y * w; acc[2] += g0.z * w; acc[3] += g0.w * w; acc[4] += g1.x * w; acc[5] += g1.y * w; acc[6] += g1.z * w; acc[7] += g1.w * w;
      }
      float* o = p.btf() + ((size_t)l * NIN + 1024 + tid) * DM + k0;
      *(float4*)o = make_float4(acc[0], acc[1], acc[2], acc[3]); *(float4*)(o + 4) = make_float4(acc[4], acc[5], acc[6], acc[7]);
    }
    __syncthreads();
  }
}

enum { MAP_ID = 0, MAP_IN = 1, MAP_UQ = 2, MAP_UKV = 3, MAP_GU = 4 };
__device__ __forceinline__ int colmap(int mt, int n) {
  switch (mt) {
    case MAP_ID: return n;
    case MAP_IN:
      if (n < 256) return n;
      if (n < 384) return 256 + (n - 256);
      if (n < 512) return 1184 + (n - 384);
      if (n < 640) return 1312 + (n - 512);
      if (n < 672) return 384 + (n - 640);
      if (n < 768) return -1;
      if (n < 1024) return 1440 + (n - 768);
      if (n < 1280) return -2;
      if (n < 1536) return 1728 + (n - 1280);
      if (n < 2304) return 416 + (n - 1536);
      return -2;
    case MAP_UQ:
      if (n < 256) return (n >> 6) * 96 + (n & 63);
      if (n < 384) return ((n - 256) >> 5) * 96 + 64 + ((n - 256) & 31);
      return -1;
    case MAP_UKV:
      if (n < 256) return (n >> 6) * 128 + (n & 63);
      return ((n - 256) >> 6) * 128 + 64 + ((n - 256) & 63);
    default: {
      const int pn = n >> 8, w = n & 255;
      return w < 128 ? 2 * (pn * 128 + w) : 2 * (pn * 128 + w - 128) + 1;
    }
  }
}
__device__ __forceinline__ int invmap(int mt, int sc) {
  if (mt == MAP_ID) return sc;
  if (mt == MAP_GU) { const int j = sc >> 1, t = sc & 1; return (j >> 7) * 256 + t * 128 + (j & 127); }
  if (sc < 384) return sc;
  if (sc < 416) return 640 + (sc - 384);
  if (sc < 1184) return 1536 + (sc - 416);
  if (sc < 1312) return 384 + (sc - 1184);
  if (sc < 1440) return 512 + (sc - 1312);
  if (sc < 1696) return 768 + (sc - 1440);
  if (sc < 1728) return -1;
  if (sc < 1984) return 1280 + (sc - 1728);
  return -1;
}
struct ConvJob { const float* src; void* dst; const float* scale; int ld, K, mt, k0, s0, f32; };
__device__ __forceinline__ void conv_tile_load(const ConvJob& J, int tid, float4 (&v)[4]) {
  const int kk = tid >> 5, s4 = (tid & 31) * 4;
#pragma unroll
  for (int i = 0; i < 4; ++i) {
    v[i] = make_float4(0.f, 0.f, 0.f, 0.f);
    if (J.s0 + s4 < J.ld) v[i] = *(const float4*)(J.src + (size_t)(J.k0 + kk + 16 * i) * J.ld + J.s0 + s4);
  }
}
__device__ __forceinline__ void conv_tile_proc(const ConvJob& J, int tid, const float4 (&v)[4], float* tile  ) {
  {
    const int kk = tid >> 5, s4 = (tid & 31) * 4;
#pragma unroll
    for (int i = 0; i < 4; ++i) {
      const float sc = J.scale ? J.scale[J.k0 + kk + 16 * i] : 1.f;
      float* t = tile + (kk + 16 * i) * 129 + s4;
      t[0] = v[i].x * sc; t[1] = v[i].y * sc; t[2] = v[i].z * sc; t[3] = v[i].w * sc;
    }
  }
  __syncthreads();
#pragma unroll
  for (int h = 0; h < 2; ++h) {
    const int sl = (tid >> 3) + 64 * h, ks = (tid & 7) * 8, sc = J.s0 + sl;
    const int row = sc < J.ld ? invmap(J.mt, sc) : -1;
    if (row >= 0) {
      const float* t = tile + ks * 129 + sl;
      if (J.f32) {
        float* dst = (float*)J.dst + (size_t)row * J.K + J.k0 + ks;
        *(float4*)dst = make_float4(t[0], t[129], t[2 * 129], t[3 * 129]); *(float4*)(dst + 4) = make_float4(t[4 * 129], t[5 * 129], t[6 * 129], t[7 * 129]);
      } else {
        u32x4 w;
        w[0] = cvtpk(t[0], t[129]); w[1] = cvtpk(t[2 * 129], t[3 * 129]); w[2] = cvtpk(t[4 * 129], t[5 * 129]); w[3] = cvtpk(t[6 * 129], t[7 * 129]);
        *(u32x4*)((u16*)J.dst + (size_t)row * J.K + J.k0 + ks) = w;
      }
    }
  }
  __syncthreads();
}
constexpr int CT_IN = 16 * 18, CT_OUT = 16 * 8, CT_DN = NE * 128, CT_L = CT_IN + CT_OUT + CT_DN;
__device__ __forceinline__ void conv_decode(const Params& p, int t, ConvJob& J) {
  const int l = t / CT_L; int r = t % CT_L;
  if (r < CT_IN) { J.src = p.w_in() + (size_t)l * DM * DIN0; J.ld = DIN0; J.K = DM; J.dst = p.btf() + (size_t)l * NIN * DM; J.mt = MAP_IN; J.scale = nullptr; J.k0 = (r / 18) * 64; J.s0 = (r % 18) * 128; J.f32 = 1; return; }
  r -= CT_IN;
  if (r < CT_OUT) { J.src = p.w_out() + (size_t)l * DM * DM; J.ld = DM; J.K = DM; J.dst = p.bt_out() + (size_t)l * DM * DM; J.mt = MAP_ID; J.scale = p.mix_g() + l * DM; J.k0 = (r / 8) * 64; J.s0 = (r % 8) * 128; J.f32 = 0; return; }
  r -= CT_OUT;
  const int e = r >> 7, q = r & 127;
  J.src = p.moe_w_down() + ((size_t)l * NE + e) * DFF * DM; J.ld = DM; J.K = DFF; J.dst = p.bt_dn() + ((size_t)l * NE + e) * DM * DFF; J.mt = MAP_ID; J.scale = nullptr; J.k0 = (q >> 3) * 64; J.s0 = (q & 7) * 128; J.f32 = 0;
}
__device__ __forceinline__ void conv_gu8_load(const float* __restrict__ src  , int s0, int tid, float4 (&v)[16]) {
  const int c4 = (tid & 7) * 4, r0 = tid >> 3;
#pragma unroll
  for (int pss = 0; pss < 16; ++pss) v[pss] = *(const float4*)(src + (size_t)(r0 + 64 * pss) * 2048 + s0 + c4);
}
__device__ __forceinline__ void conv_gu8_proc(const float4 (&v)[16], signed char* __restrict__ dst  , float* __restrict__ sw  ,
                                              int s0, float* tile  , int tid) {
  float* cmax = tile + 1024 * 33;
  {
    const int c4 = (tid & 7) * 4, r0 = tid >> 3;
#pragma unroll
    for (int pss = 0; pss < 16; ++pss) { float* t = tile + (r0 + 64 * pss) * 33 + c4; t[0] = v[pss].x; t[1] = v[pss].y; t[2] = v[pss].z; t[3] = v[pss].w; }
  }
  __syncthreads();
  {
    const int col = tid & 31, part = tid >> 5; float m = 0.f;
#pragma unroll 8
    for (int k = part * 64; k < part * 64 + 64; ++k) m = fmaxf(m, fabsf(tile[k * 33 + col]));
    cmax[part * 32 + col] = m;
  }
  __syncthreads();
  if (tid < 32) {
    float m = 0.f;
#pragma unroll
    for (int q = 0; q < 16; ++q) m = fmaxf(m, cmax[q * 32 + tid]);
    const float sc = fmaxf(m, 1e-20f) * (1.f / 127.f);
    cmax[512 + tid] = sc;
    sw[invmap(MAP_GU, s0 + tid)] = sc;
  }
  __syncthreads();
#pragma unroll
  for (int h = 0; h < 4; ++h) {
    const int g = tid + 512 * h, col = g & 31, k0 = (g >> 5) * 16;
    const float inv = 1.f / cmax[512 + col];
    unsigned w[4];
#pragma unroll
    for (int q = 0; q < 4; ++q) {
      const float* t = tile + (k0 + 4 * q) * 33 + col;
      const int q0 = (int)rintf(t[0] * inv), q1 = (int)rintf(t[33] * inv), q2 = (int)rintf(t[66] * inv), q3 = (int)rintf(t[99] * inv);
      w[q] = (unsigned)(q0 & 255) | ((unsigned)(q1 & 255) << 8) | ((unsigned)(q2 & 255) << 16) | ((unsigned)(q3 & 255) << 24);
    }
    *(u32x4*)(dst + (size_t)invmap(MAP_GU, s0 + col) * DM + k0) = u32x4{w[0], w[1], w[2], w[3]};
  }
  __syncthreads();
}
__device__ __forceinline__ void phase_convert(const Params& p, int bid, int nb, char* lds) {
  float* tile = (float*)lds;
  const int tid = ltid();
  {
    ConvJob J, Jn; float4 v[4], vn[4];
    int t = bid;
    if (t < 2 * CT_L) { conv_decode(p, t, J); conv_tile_load(J, tid, v); }
    for (; t < 2 * CT_L; t += nb) {
      const bool more = t + nb < 2 * CT_L;
      if (more) { conv_decode(p, t + nb, Jn); conv_tile_load(Jn, tid, vn); }
      conv_tile_proc(J, tid, v, tile);
      if (more) { J = Jn;
#pragma unroll
        for (int i = 0; i < 4; ++i) v[i] = vn[i]; }
    }
  }
  {
    float4 v[16], vn[16];
    int t = bid;
    if (t < 2 * NE * 64) conv_gu8_load(p.moe_w_gu() + (size_t)(t >> 6) * DM * 2048, (t & 63) * 32, tid, v);
    for (; t < 2 * NE * 64; t += nb) {
      const bool more = t + nb < 2 * NE * 64; const int tn = t + nb;
      if (more) conv_gu8_load(p.moe_w_gu() + (size_t)(tn >> 6) * DM * 2048, (tn & 63) * 32, tid, vn);
      conv_gu8_proc(v, p.bt_gu() + (size_t)(t >> 6) * 2048 * DM, p.swgu() + (size_t)(t >> 6) * 2048, (t & 63) * 32, tile, tid);
      if (more) {
#pragma unroll
        for (int i = 0; i < 16; ++i) v[i] = vn[i]; }
    }
  }
  for (int l = 0; l < 2; ++l) {
    for (int i = bid * NTHR + tid; i < 96 * DM / 4; i += nb * NTHR) *(float4*)(p.btf() + ((size_t)l * NIN + 672) * DM + (size_t)i * 4) = make_float4(0.f, 0.f, 0.f, 0.f);
    {
      const float* wq = p.mla_w_uq() + (size_t)l * 256 * 384; const float* wkv = p.mla_w_ukv() + (size_t)l * 128 * 512;
      const float* gq = p.mla_q_g() + l * 256; const float* gkv = p.mla_kv_g() + l * 128;
      u16* dst = p.bt_qkv() + (size_t)l * 1024 * 384;
      for (int i = bid * NTHR + ltid(); i < 1024 * 384; i += nb * NTHR) {
        const int n = i / 384, k = i % 384; float v = 0.f;
        if (n < 512) { const int sc = colmap(MAP_UQ, n); if (k < 256 && sc >= 0) v = gq[k] * wq[k * 384 + sc]; }
        else { if (k >= 256) v = gkv[k - 256] * wkv[(k - 256) * 512 + colmap(MAP_UKV, n - 512)]; }
        dst[i] = f2bf(v);
      }
    }
  }
}

__device__ __forceinline__ void phase_hy_mlp(const Params& p, int l, int Lf, float* __restrict__ hout  , float* __restrict__ ssq  ,
                             int bid, int nb, char* lds) {
  float* zf = (float*)lds;
  float* h1 = zf + 64 * 33;
  float* h2 = h1 + 64 * 64;
  const int tid = ltid();
  const float* w1 = p.hy_w1() + (size_t)l * 33 * 64; const float* b1 = p.hy_b1() + l * 64;
  const float* w2 = p.hy_w2() + (size_t)l * 64 * 64; const float* b2 = p.hy_b2() + l * 64;
  const float* w3 = p.hy_w3() + (size_t)l * 64 * 512; const float* fr = p.hy_freq() + l * 64;
  float w3c[64];
#pragma unroll
  for (int k = 0; k < 64; ++k) w3c[k] = w3[k * 512 + tid];
  const int dir = tid >> 8, ch = tid & 255;
  const float maxd = logf(1e-2f) / 0.3f, mind = logf(1e-2f) / 1.5f;
  const float delta = fabsf(mind + (maxd - mind) * (float)ch / 255.f);
  float ssq_acc = 0.f;
  for (int it = bid; it < Lf / 64; it += nb) {
    const int t0 = it * 64;
    for (int i = tid; i < 64 * 33; i += NTHR) {
      const int tt = i / 33, f = i % 33, t = t0 + tt;
      float v;
      if (f == 0) v = (float)t / (float)(Lf - 1);
      else {
        const int j = (f - 1) & 15;
        const float fj = 1e-4f + (float)j * ((15.f - 1e-4f) / 15.f);
        const float w = 6.283185307179586f * (float)t / (float)Lf;
        v = (f <= 16) ? cosf(fj * w) : -sinf(fj * w);
      }
      zf[i] = v;
    }
    __syncthreads();
    {
      const int o = tid & 63, tb = tid >> 6;
      float acc[8];
#pragma unroll
      for (int j = 0; j < 8; ++j) acc[j] = b1[o];
#pragma unroll 3
      for (int f = 0; f < 33; ++f) {
        const float w = w1[f * 64 + o];
#pragma unroll
        for (int j = 0; j < 8; ++j) acc[j] += zf[(tb + 8 * j) * 33 + f] * w;
      }
      const float fo = fr[o];
#pragma unroll
      for (int j = 0; j < 8; ++j) h1[(tb + 8 * j) * 64 + o] = sinf(fo * acc[j]);
    }
    __syncthreads();
    {
      const int o = tid & 63, tb = tid >> 6;
      float acc[8];
#pragma unroll
      for (int j = 0; j < 8; ++j) acc[j] = b2[o];
#pragma unroll 4
      for (int f = 0; f < 64; f += 4) {
        const float wa = w2[f * 64 + o], wb = w2[(f + 1) * 64 + o], wc2 = w2[(f + 2) * 64 + o], wd = w2[(f + 3) * 64 + o];
#pragma unroll
        for (int j = 0; j < 8; ++j) { const float4 hv = *(const float4*)(h1 + (tb + 8 * j) * 64 + f); acc[j] += hv.x * wa + hv.y * wb + hv.z * wc2 + hv.w * wd; }
      }
      const float fo = fr[o];
#pragma unroll
      for (int j = 0; j < 8; ++j) h2[(tb + 8 * j) * 64 + o] = sinf(fo * acc[j]);
    }
    __syncthreads();
    float* orow = hout + ((size_t)dir * 256 + ch) * Lf + t0;
    for (int tq = 0; tq < 16; ++tq) {
      float sv[4];
#pragma unroll
      for (int u = 0; u < 4; ++u) {
        const int tt = tq * 4 + u;
        float s = 0;
#pragma unroll
        for (int k = 0; k < 64; k += 4) { const float4 hv = *(const float4*)(h2 + tt * 64 + k); s += hv.x * w3c[k] + hv.y * w3c[k + 1] + hv.z * w3c[k + 2] + hv.w * w3c[k + 3]; }
        const int t = t0 + tt;
        s *= __expf(-((float)t / (float)(Lf - 1)) * delta);
        if (dir == 0 || t > 0) ssq_acc += s * s;
        sv[u] = s;
      }
      *(float4*)(orow + tq * 4) = make_float4(sv[0], sv[1], sv[2], sv[3]);
    }
    __syncthreads();
  }
  ssq[(size_t)bid * 512 + tid] = ssq_acc;
}

__host__ __device__ constexpr int fx(int p) {
  return ((p >> 12) & 3) ^ (((p >> 10) & 3) << 2) ^ ((p >> 4) & 16) ^ (((p >> 5) & 1) * 5) ^ (((p >> 6) & 1) * 26);
}
__device__ __forceinline__ int swz(int p) { return p ^ fx(p); }
__device__ __forceinline__ int rev7(int k) {
  unsigned r = __brev((unsigned)k) >> 18;
  return (int)(((r & 0x2AAAu) >> 1) | ((r & 0x1555u) << 1));
}
template <int ST, bool INV>
__device__ __forceinline__ void fft_stage(float2* s, const float2* __restrict__ tw, const int tid) {
  constexpr int sh = 12 - 2 * ST, q = 1 << sh, ND = q >= 512 ? q / 512 : 1;
  float2 w1[ND], w2[ND], w3[ND];
  if constexpr (ST < 6) {
#pragma unroll
    for (int d = 0; d < ND; ++d) {
      const int j = q >= 512 ? tid + 512 * d : (tid & (q - 1)), ti = j << (2 * ST);
      w1[d] = tw[ti]; w2[d] = tw[2 * ti]; w3[d] = tw[3 * ti];
    }
  }
  float2 x[8][4];
#pragma unroll
  for (int m = 0; m < 8; ++m) {
    const int u = tid + 512 * m, g = u >> sh, j = u & (q - 1), base = (g << (sh + 2)) + j, xb = fx(base);
    x[m][0] = s[base ^ xb]; x[m][1] = s[(base + q) ^ xb ^ fx(q)]; x[m][2] = s[(base + 2 * q) ^ xb ^ fx(2 * q)]; x[m][3] = s[(base + 3 * q) ^ xb ^ fx(3 * q)];
  }
#pragma unroll
  for (int m = 0; m < 8; ++m) {
    const int u = tid + 512 * m, g = u >> sh, j = u & (q - 1), base = (g << (sh + 2)) + j, xb = fx(base);
    const int i0 = base ^ xb, i1 = (base + q) ^ xb ^ fx(q), i2 = (base + 2 * q) ^ xb ^ fx(2 * q), i3 = (base + 3 * q) ^ xb ^ fx(3 * q);
    const int d = q >= 512 ? (m % ND) : 0;
    if constexpr (!INV) {
      const float2 a0 = x[m][0], a1 = x[m][1], a2 = x[m][2], a3 = x[m][3];
      const float2 b0 = make_float2(a0.x + a2.x, a0.y + a2.y), b1 = make_float2(a0.x - a2.x, a0.y - a2.y);
      const float2 b2 = make_float2(a1.x + a3.x, a1.y + a3.y), b3 = make_float2(a1.x - a3.x, a1.y - a3.y);
      const float2 y1 = make_float2(b1.x + b3.y, b1.y - b3.x), y2 = make_float2(b0.x - b2.x, b0.y - b2.y), y3 = make_float2(b1.x - b3.y, b1.y + b3.x);
      s[i0] = make_float2(b0.x + b2.x, b0.y + b2.y);
      if constexpr (ST < 6) { s[i1] = cmul(y1, w1[d]); s[i2] = cmul(y2, w2[d]); s[i3] = cmul(y3, w3[d]); }
      else { s[i1] = y1; s[i2] = y2; s[i3] = y3; }
    } else {
      float2 t0 = x[m][0], t1 = x[m][1], t2 = x[m][2], t3 = x[m][3];
      if constexpr (ST < 6) { t1 = cmulc(t1, w1[d]); t2 = cmulc(t2, w2[d]); t3 = cmulc(t3, w3[d]); }
      const float2 b0 = make_float2(t0.x + t2.x, t0.y + t2.y), b1 = make_float2(t0.x - t2.x, t0.y - t2.y);
      const float2 b2 = make_float2(t1.x + t3.x, t1.y + t3.y), b3 = make_float2(t1.x - t3.x, t1.y - t3.y);
      s[i0] = make_float2(b0.x + b2.x, b0.y + b2.y);
      s[i1] = make_float2(b1.x - b3.y, b1.y + b3.x);
      s[i2] = make_float2(b0.x - b2.x, b0.y - b2.y);
      s[i3] = make_float2(b1.x + b3.y, b1.y - b3.x);
    }
  }
  __syncthreads();
}
__device__ __forceinline__ void fft_fwd(float2* s, const float2* __restrict__ tw) {
  const int tid = ltid();
  fft_stage<0, false>(s, tw, tid); fft_stage<1, false>(s, tw, tid); fft_stage<2, false>(s, tw, tid); fft_stage<3, false>(s, tw, tid);
  fft_stage<4, false>(s, tw, tid); fft_stage<5, false>(s, tw, tid); fft_stage<6, false>(s, tw, tid);
}
__device__ __forceinline__ void fft_inv(float2* s, const float2* __restrict__ tw) {
  const int tid = ltid();
  fft_stage<6, true>(s, tw, tid); fft_stage<5, true>(s, tw, tid); fft_stage<4, true>(s, tw, tid); fft_stage<3, true>(s, tw, tid);
  fft_stage<2, true>(s, tw, tid); fft_stage<1, true>(s, tw, tid); fft_stage<0, true>(s, tw, tid);
}

__device__ __forceinline__ float filt_ssq(const float* __restrict__ part  , int ch, float* red  ) {
  const int tid = ltid();
  float v = part[(size_t)(tid >> 1) * 512 + (tid & 1) * 256 + ch];
  v = wave_sum(v);
  __syncthreads();
  if ((tid & 63) == 0) red[tid >> 6] = v;
  __syncthreads();
  return ((red[0] + red[1]) + (red[2] + red[3])) + ((red[4] + red[5]) + (red[6] + red[7]));
}
__device__ __forceinline__ void phase_hy_filtfft(const Params& p, int bid, int nb, char* lds) {
  float2* s = (float2*)lds;
  const int tid = ltid();
  for (int it = bid; it < 512; it += nb) {
    const int l = it >> 8, ch = it & 255;
    const float* hf = p.hfb() + (((size_t)l * 2 + 0) * 256 + ch) * SEQ;
    const float* hb = p.hfb() + (((size_t)l * 2 + 1) * 256 + ch) * SEQ;
#pragma unroll 8
    for (int m = tid; m < FM; m += NTHR) {
      const int n0 = 2 * m, n1 = 2 * m + 1;
      const float a = (n0 < SEQ) ? hf[n0] : (n0 == SEQ ? 0.f : hb[2 * SEQ - n0]);
      const float b = (n1 < SEQ) ? hf[n1] : hb[2 * SEQ - n1];
      s[swz(m)] = make_float2(a, b);
    }
    __syncthreads();
    fft_fwd(s, p.tw());
    const float sc = rsqrtf(filt_ssq(p.hpart() + (size_t)l * 256 * 512, ch, (float*)(lds + 139264))) * (1.f / 16384.f);
    float4* out = p.hspec() + ((size_t)l * 256 + ch) * HSP;
#pragma unroll 4
    for (int k = tid; k <= FM / 2; k += NTHR) {
      const float2 zk = s[swz(rev7(k))], zm = s[swz(rev7((FM - k) & (FM - 1)))];
      const float er = 0.5f * (zk.x + zm.x), ei = 0.5f * (zk.y - zm.y);
      const float dr = 0.5f * (zk.x - zm.x), di = 0.5f * (zk.y + zm.y);
      out[k] = make_float4(er * sc, ei * sc, di * sc, -dr * sc);
    }
    __syncthreads();
  }
}
constexpr int G_TILE_B = 256 * 64 * 2;
constexpr int G_STAGE_B = 2 * G_TILE_B;
constexpr int GEMM_LDS = 2 * G_STAGE_B;

__device__ __forceinline__ int lds_byte2(int r, int c) {
  const int st = (r >> 4) * 2 + (c >> 5), ob = (r & 15) * 64 + (c & 31) * 2;
  return st * 1024 + (ob ^ (((ob >> 9) & 1) << 5));
}
__device__ __forceinline__ void stage_rc2(int b, int& R, int& C) {
  const int st = b >> 10, sb = b & 1023, swz = sb ^ (((sb >> 9) & 1) << 5);
  R = (st >> 1) * 16 + (swz >> 6);
  C = (st & 1) * 32 + ((swz & 63) >> 1);
}
__device__ __forceinline__ void gemm_stage_coords(int (&sR)[4], int (&sC)[4]) {
  const int wid = ltid() >> 6, lane = ltid() & 63;
#pragma unroll
  for (int i = 0; i < 4; ++i) stage_rc2(wid * 1024 + i * 8192 + lane * 16, sR[i], sC[i]);
}

#define WAIT_V0() asm volatile("s_waitcnt vmcnt(0)" ::: "memory")

__device__ __forceinline__ void gemm256_core(const u16* const (&ap)[4], const u16* const (&bp)[4], int nt, char* shm, f32x4 (&acc)[8][4]) {
  const int tid = ltid(), wid = tid >> 6, lane = tid & 63, wr = wid >> 2, wc = wid & 3, fr = lane & 15, fq = lane >> 4;
#pragma unroll
  for (int m = 0; m < 8; ++m)
#pragma unroll
    for (int n = 0; n < 4; ++n) acc[m][n] = f32x4{0.f, 0.f, 0.f, 0.f};
#define G_SA(b) (shm + (b) * G_STAGE_B)
#define G_SB(b) (shm + (b) * G_STAGE_B + G_TILE_B)
#define G_STAGE(buf, kt) do { _Pragma("unroll") for (int i = 0; i < 4; ++i) {                                                   \
    __builtin_amdgcn_global_load_lds((const unsigned*)(ap[i] + (kt) * 64), (unsigned*)(G_SA(buf) + wid * 1024 + i * 8192), 16, 0, 0); \
    __builtin_amdgcn_global_load_lds((const unsigned*)(bp[i] + (kt) * 64), (unsigned*)(G_SB(buf) + wid * 1024 + i * 8192), 16, 0, 0); } } while (0)
  G_STAGE(0, 0); WAIT_V0(); __syncthreads();
#pragma unroll 1
  for (int t = 0; t < nt; ++t) {
    const int cur = t & 1;
    if (t + 1 < nt) G_STAGE(cur ^ 1, t + 1);
#pragma unroll
    for (int ks = 0; ks < 2; ++ks) {
      bf16x8 At[8], Bf[4];
#pragma unroll
      for (int m = 0; m < 8; ++m) At[m] = *(const bf16x8*)(G_SA(cur) + lds_byte2(wr * 128 + m * 16 + fr, ks * 32 + fq * 8));
#pragma unroll
      for (int n = 0; n < 4; ++n) Bf[n] = *(const bf16x8*)(G_SB(cur) + lds_byte2(wc * 64 + n * 16 + fr, ks * 32 + fq * 8));
#pragma unroll
      for (int m = 0; m < 8; ++m)
#pragma unroll
        for (int n = 0; n < 4; ++n) acc[m][n] = __builtin_amdgcn_mfma_f32_16x16x32_bf16(At[m], Bf[n], acc[m][n], 0, 0, 0);
      __builtin_amdgcn_sched_barrier(0);
    }
    WAIT_V0(); __syncthreads();
  }
#undef G_STAGE
}

#define LAS3 __attribute__((address_space(3)))
constexpr int G8_HTB = 128 * 64 * 2;
__device__ __forceinline__ int g8_perm32(int rho) { const int n = rho >> 4, i = rho & 15; return 8 * (i >> 2) + 4 * n + (i & 3); }
__device__ __forceinline__ int g8_lds_byte(int r, int c) { const int st = (r >> 4) * 2 + (c >> 5), rr = r & 15, cc = c & 31, ob = rr * 64 + cc * 2; return st * 1024 + (ob ^ (((ob >> 9) & 1) << 5)); }
__device__ __forceinline__ void g8_stage_rc(int b, int& R, int& C) { const int st = b / 1024, sb = b % 1024, swz = sb ^ (((sb >> 9) & 1) << 5); R = (st >> 1) * 16 + swz / 64; C = (st & 1) * 32 + (swz % 64) / 2; }
struct G8Unit { int pm, pn, e, ce, pre, ab; };
__device__ __forceinline__ void g8_cload(const float* __restrict__ src, float* dst) {
  __builtin_amdgcn_global_load_lds((const unsigned*)(src + (ltid() & 63) * 4), (LAS3 unsigned*)dst, 16, 0, 0);
}


template <bool I8> __device__ __forceinline__ typename std::conditional<I8, int __attribute__((ext_vector_type(4))), f32x4>::type
g8_mma(bf16x8 x, bf16x8 y, typename std::conditional<I8, int __attribute__((ext_vector_type(4))), f32x4>::type c) {
  if constexpr (I8) { typedef int v4i __attribute__((ext_vector_type(4))); return __builtin_amdgcn_mfma_i32_16x16x64_i8(*(v4i*)&x, *(v4i*)&y, c, 0, 0, 0); }
  else return __builtin_amdgcn_mfma_f32_16x16x32_bf16(x, y, c, 0, 0, 0);
}
typedef int i32x4 __attribute__((ext_vector_type(4)));
template <bool I8> struct G8Acc { typedef f32x4 T; };
template <> struct G8Acc<true> { typedef i32x4 T; };
template <bool I8, class Sched, class Epi>
__device__ __forceinline__ void gemm8_phase(char* lds_g, const char* Abase, const int Kb, const Sched& S, const Epi& E) {
    typedef typename G8Acc<I8>::T ACC;
    LAS3 unsigned char* lds = (LAS3 unsigned char*)lds_g;
    const int tid = ltid(), wid = __builtin_amdgcn_readfirstlane(tid >> 6), lane = tid & 63, wr = wid >> 2, wc = wid & 3, fr = lane & 15, fq = lane >> 4;
    const int nt = Kb / 128;
    int sRr[2], sCc[2]; unsigned voffB[2];
#pragma unroll
    for (int i = 0; i < 2; ++i) { g8_stage_rc(tid * 16 + i * 8192, sRr[i], sCc[i]); const int Rb = (sRr[i] & ~31) + g8_perm32(sRr[i] & 31); voffB[i] = (unsigned)(Rb * Kb) + (unsigned)sCc[i] * 2u; }
    const size_t kstep = 128;
    const size_t hstepB = (size_t)128 * Kb;
    const unsigned ldsw = (unsigned)wid * 1024u;
    const int aoff = g8_lds_byte(wr * 64 + fr, fq * 8), boff = g8_lds_byte(wc * 32 + fr, fq * 8);
#define G8_SA(b, h) (((b) * 2 + (h)) * G8_HTB)
#define G8_SB(b, h) ((4 + (b) * 2 + (h)) * G8_HTB)
#define G8_STAGE_B(bufoff, gbase) do { _Pragma("unroll") for (int _i = 0; _i < 2; ++_i) \
        __builtin_amdgcn_global_load_lds((const unsigned*)((const char*)(gbase) + voffB[_i]), (LAS3 unsigned*)(lds + (bufoff) + ldsw + _i * 8192), 16, 0, 0); } while (0)
#define G8_STAGE_A(bufoff, o0, o1) do { \
        __builtin_amdgcn_global_load_lds((const unsigned*)(Abase + (o0)), (LAS3 unsigned*)(lds + (bufoff) + ldsw), 16, 0, 0); \
        __builtin_amdgcn_global_load_lds((const unsigned*)(Abase + (o1)), (LAS3 unsigned*)(lds + (bufoff) + ldsw + 8192), 16, 0, 0); } while (0)
#define G8_LDA(dst, b, h) do { _Pragma("unroll") for (int m = 0; m < 4; ++m) _Pragma("unroll") for (int k = 0; k < 2; ++k) dst[m][k] = *(const LAS3 bf16x8*)(lds + G8_SA(b, h) + aoff + m * 2048 + k * 1024); } while (0)
#define G8_LDB(dst, b, h) do { _Pragma("unroll") for (int n = 0; n < 2; ++n) _Pragma("unroll") for (int k = 0; k < 2; ++k) dst[n][k] = *(const LAS3 bf16x8*)(lds + G8_SB(b, h) + boff + n * 2048 + k * 1024); } while (0)
#define G8_MMA(ai, bj, At, Bt) do { __builtin_amdgcn_s_setprio(1); _Pragma("unroll") for (int m = 0; m < 4; ++m) _Pragma("unroll") for (int n = 0; n < 2; ++n) _Pragma("unroll") for (int k = 0; k < 2; ++k) \
        acc[ai][bj][m][n] = g8_mma<I8>(Bt[n][k], At[m][k], acc[ai][bj][m][n]); __builtin_amdgcn_s_setprio(0); } while (0)
#define G8_WAIT_V(n) asm volatile("s_waitcnt vmcnt(" #n ")" ::: "memory")
#define G8_WAIT_L(n) asm volatile("s_waitcnt lgkmcnt(" #n ")" ::: "memory")
#define G8_BAR __builtin_amdgcn_s_barrier()
#define G8_SCHED __builtin_amdgcn_sched_barrier(0)
    G8Unit cur, nxt; int ui = 0;
    cur.e = 0; cur.pre = 0; cur.ab = 0;
    if (!S.next(0, cur, cur)) return;
    ACC acc[2][2][4][2];
#pragma unroll
    for (int a = 0; a < 2; ++a)
#pragma unroll
        for (int b = 0; b < 2; ++b)
#pragma unroll
            for (int m = 0; m < 4; ++m)
#pragma unroll
                for (int n = 0; n < 2; ++n) acc[a][b][m][n] = ACC{};
    bf16x8 At[4][2], B0[2][2], B1[2][2];
    float ep[8];
    unsigned va[2][2], vn[2][2];
#pragma unroll
    for (int h = 0; h < 2; ++h)
#pragma unroll
        for (int i = 0; i < 2; ++i) va[h][i] = S.a_off(cur, h * 128 + sRr[i]) + (unsigned)sCc[i] * 2u;
    const char* cB = S.b_ptr(cur);
    G8_STAGE_B(G8_SB(0, 0), cB); G8_STAGE_A(G8_SA(0, 0), va[0][0], va[0][1]); G8_STAGE_B(G8_SB(0, 1), cB + hstepB); G8_STAGE_A(G8_SA(0, 1), va[1][0], va[1][1]);
    if (wr == 1) G8_BAR;
    G8_WAIT_V(4); G8_BAR;
    G8_STAGE_B(G8_SB(1, 0), cB + kstep); G8_STAGE_A(G8_SA(1, 0), va[0][0] + kstep, va[0][1] + kstep); G8_STAGE_B(G8_SB(1, 1), cB + hstepB + kstep);
    G8_WAIT_V(6); G8_BAR;
    for (;;) {
        float* cb = (float*)(lds_g + 136192 + (ui & 1) * 3072);
        const int* rt = (const int*)(lds_g + 142336 + (ui & 1) * 1024);
        E.pre(cur, wr, fr, ep, cb);
        const bool has_next = S.next(ui + 1, nxt, cur);
        const char* nB = cB;
#pragma unroll
        for (int h = 0; h < 2; ++h)
#pragma unroll
            for (int i = 0; i < 2; ++i) vn[h][i] = va[h][i];
        int rlim = 0;
        if (has_next) {
            nB = S.b_ptr(nxt);
            if constexpr (Sched::GATHER) {
                if ((tid >> 6) == 3) S.rows_to_lds(nxt, (int*)rt);
                rlim = nxt.ce - 1 - nxt.pm * 256;
            } else {
#pragma unroll
                for (int h = 0; h < 2; ++h)
#pragma unroll
                    for (int i = 0; i < 2; ++i) vn[h][i] = S.a_off(nxt, h * 128 + sRr[i]) + (unsigned)sCc[i] * 2u;
            }
        }
#pragma unroll 1
        for (int t = 0; t < nt; t += 2) {
            const bool last = (t == nt - 2);
            const unsigned k1 = (unsigned)(t + 1) * 128u;
            const unsigned k2 = last ? 0u : (unsigned)(t + 2) * 128u;
            if constexpr (Sched::GATHER) {
                if (has_next) {
#pragma unroll
                    for (int h = 0; h < 2; ++h)
#pragma unroll
                        for (int i = 0; i < 2; ++i) vn[h][i] = (unsigned)rt[min(h * 128 + sRr[i], rlim)] * (unsigned)Kb + (unsigned)sCc[i] * 2u;
                }
            }
            const unsigned a2_00 = (last ? vn[0][0] : va[0][0]) + k2, a2_01 = (last ? vn[0][1] : va[0][1]) + k2;
            const unsigned a2_10 = (last ? vn[1][0] : va[1][0]) + k2, a2_11 = (last ? vn[1][1] : va[1][1]) + k2;
            const char* b2 = (last ? nB : cB) + k2; const char* b3 = b2 + kstep;
            G8_LDB(B0, 0, 0); G8_SCHED; G8_LDA(At, 0, 0); G8_STAGE_A(G8_SA(1, 1), va[1][0] + k1, va[1][1] + k1);
            G8_WAIT_L(8); G8_BAR; G8_WAIT_L(0); G8_MMA(0, 0, At, B0); G8_BAR; G8_SCHED;
            G8_LDB(B1, 0, 1); G8_STAGE_B(G8_SB(0, 0), b2);
            G8_BAR; G8_WAIT_L(0); G8_MMA(0, 1, At, B1); G8_BAR;
            G8_LDA(At, 0, 1); G8_STAGE_A(G8_SA(0, 0), a2_00, a2_01);
            G8_BAR; G8_WAIT_L(0); G8_MMA(1, 0, At, B0); G8_BAR; G8_SCHED;
            G8_STAGE_B(G8_SB(0, 1), b2 + hstepB);
            G8_WAIT_V(6); G8_BAR; G8_MMA(1, 1, At, B1); G8_BAR;
            G8_LDB(B0, 1, 0); G8_SCHED; G8_LDA(At, 1, 0); G8_STAGE_A(G8_SA(0, 1), a2_10, a2_11);
            G8_WAIT_L(8); G8_BAR; G8_WAIT_L(0); G8_MMA(0, 0, At, B0); G8_BAR; G8_SCHED;
            G8_LDB(B1, 1, 1); G8_STAGE_B(G8_SB(1, 0), b3);
            G8_BAR; G8_WAIT_L(0); G8_MMA(0, 1, At, B1); G8_BAR;
            G8_LDA(At, 1, 1); G8_STAGE_A(G8_SA(1, 0), a2_00 + 128u, a2_01 + 128u);
            G8_BAR; G8_WAIT_L(0); G8_MMA(1, 0, At, B0); G8_BAR; G8_SCHED;
            G8_STAGE_B(G8_SB(1, 1), b3 + hstepB);
            G8_WAIT_V(6); G8_BAR; G8_MMA(1, 1, At, B1); G8_BAR;
        }
        E(acc, cur, wr, wc, fr, fq, ep, cb);
        if (!has_next) break;
#pragma unroll
        for (int a = 0; a < 2; ++a)
#pragma unroll
            for (int b = 0; b < 2; ++b)
#pragma unroll
                for (int m = 0; m < 4; ++m)
#pragma unroll
                    for (int n = 0; n < 2; ++n) acc[a][b][m][n] = ACC{};
        cur = nxt; cB = nB; ++ui;
#pragma unroll
        for (int h = 0; h < 2; ++h)
#pragma unroll
            for (int i = 0; i < 2; ++i) va[h][i] = vn[h][i];
    }
    G8_WAIT_V(0);
    if (wr == 0) G8_BAR;
    G8_BAR;
#undef G8_SA
#undef G8_SB
#undef G8_STAGE_A
#undef G8_STAGE_B
#undef G8_LDA
#undef G8_LDB
#undef G8_MMA
#undef G8_WAIT_V
#undef G8_WAIT_L
#undef G8_BAR
#undef G8_SCHED
}
struct G8Plain {
    static constexpr bool GATHER = false;
    int nM, nN, Kb, G, c; const char* Bt;
    __device__ __forceinline__ bool next(int i, G8Unit& u, const G8Unit&) const {
        const int L = (i * 8 + (c & 7)) * (G >> 3) + (c >> 3); if (L >= nM * nN) return false;
        const int nig = 8 * nN, gid = L / nig, fm = gid * 8, gsz = (nM - fm) < 8 ? (nM - fm) : 8;
        u.pm = fm + ((L % nig) % gsz); u.pn = (L % nig) / gsz; u.e = 0; u.ce = 256; u.pre = 0; return true;
    }
    __device__ __forceinline__ int a_row(const G8Unit& u, int row) const { return u.pm * 256 + row; }
    __device__ __forceinline__ unsigned a_off(const G8Unit& u, int row) const { return (unsigned)a_row(u, row) * (unsigned)Kb; }
    __device__ __forceinline__ const char* b_ptr(const G8Unit& u) const { return Bt + (size_t)u.pn * 256 * Kb; }
};

__device__ __forceinline__ const float* resid_row_in(const Params& p, int tok) {
  return tok < TL ? p.x() + (size_t)tok * DM : p.ctx() + (size_t)(tok - TL) * DM;
}
__device__ __forceinline__ void load_row_comb(const Params& p, int src_layer, int lc, int tok, int lane, const int* pre  , float (&v)[16]) {
  if (src_layer == 0) {
    const float* r = resid_row_in(p, tok);
#pragma unroll
    for (int i = 0; i < 4; ++i) { const float4 a = *(const float4*)(r + lane * 4 + i * 256); v[4 * i] = a.x; v[4 * i + 1] = a.y; v[4 * i + 2] = a.z; v[4 * i + 3] = a.w; }
  } else {
    const u16* r = p.X() + (size_t)tok * DM;
#pragma unroll
    for (int i = 0; i < 4; ++i) { const float4 a = ld4bf(r + lane * 4 + i * 256); v[4 * i] = a.x; v[4 * i + 1] = a.y; v[4 * i + 2] = a.z; v[4 * i + 3] = a.w; }
  }
  if (lc >= 0) {
    const float* g2 = p.mod() + ((size_t)lc * 3 + modv(tok)) * 6144 + 5 * DM;
    float s[16];
#pragma unroll
    for (int i = 0; i < 16; ++i) s[i] = 0.f;
#pragma unroll
    for (int k = 0; k < TOPK; ++k) {
      const int sl = p.tslot()[tok * 4 + k];
      const size_t arow = (size_t)(pre[sl >> 20] + (sl & 0xFFFFF));
      const unsigned char* y = p.yd() + arow * DM;
#pragma unroll
      for (int i = 0; i < 4; ++i) {
        const int w = *(const int*)(y + lane * 4 + i * 256);
        const auto lo = __builtin_amdgcn_cvt_pk_f32_fp8(w, false), hi2 = __builtin_amdgcn_cvt_pk_f32_fp8(w, true);
        s[4 * i] += lo[0]; s[4 * i + 1] += lo[1]; s[4 * i + 2] += hi2[0]; s[4 * i + 3] += hi2[1];
      }
    }
#pragma unroll
    for (int i = 0; i < 4; ++i) {
      const float4 g = *(const float4*)(g2 + lane * 4 + i * 256);
      v[4 * i] += g.x * 0.125f * s[4 * i]; v[4 * i + 1] += g.y * 0.125f * s[4 * i + 1]; v[4 * i + 2] += g.z * 0.125f * s[4 * i + 2]; v[4 * i + 3] += g.w * 0.125f * s[4 * i + 3];
    }
  }
}
__device__ __forceinline__ void expert_prefix(const int* cnt, int* pre) {
  if (ltid() == 0) { int s = 0; for (int e = 0; e < NE; ++e) { pre[e] = s; s += cnt[e]; } pre[NE] = s; }
}

__device__ __forceinline__ float store_row_i8(const float (&y)[16], signed char* __restrict__ h, float* __restrict__ hs_row, int lane) {
  float am = 0.f;
#pragma unroll
  for (int i = 0; i < 16; ++i) am = fmaxf(am, fabsf(y[i]));
  am = wave_max(am);
  const float s = fmaxf(am, 1e-20f) * (1.f / 127.f), inv = 1.f / s;
#pragma unroll
  for (int i = 0; i < 4; ++i) {
    const int q0 = (int)rintf(y[4 * i] * inv), q1 = (int)rintf(y[4 * i + 1] * inv), q2 = (int)rintf(y[4 * i + 2] * inv), q3 = (int)rintf(y[4 * i + 3] * inv);
    *(unsigned*)(h + lane * 4 + i * 256) = (unsigned)(q0 & 255) | ((unsigned)(q1 & 255) << 8) | ((unsigned)(q2 & 255) << 16) | ((unsigned)(q3 & 255) << 24);
  }
  if (lane == 0) *hs_row = s;
  return s;
}
__device__ __forceinline__ void phase_quant_in(const Params& p, int bid, int nb) {
  const int wid = ltid() >> 6, lane = ltid() & 63;
  for (int r = bid * 8 + wid; r < 2 * NIN; r += nb * 8) {
    const float* src = p.btf() + (size_t)r * DM;
    float y[16];
#pragma unroll
    for (int i = 0; i < 4; ++i) { const float4 a = *(const float4*)(src + lane * 4 + i * 256); y[4 * i] = a.x; y[4 * i + 1] = a.y; y[4 * i + 2] = a.z; y[4 * i + 3] = a.w; }
    store_row_i8(y, p.bt_in() + (size_t)r * DM, p.swin() + r, lane);
  }
}
__device__ __forceinline__ void phase_norm1(const Params& p, int layer, int bid, int nb, char* lds) {
  int* pre = (int*)lds;
  const int lc = layer - 1;
  if (lc >= 0) { expert_prefix(p.cnt() + lc * NE, pre); __syncthreads(); }
  const int wid = ltid() >> 6, lane = ltid() & 63;
  const float* gn = p.norm1_g() + layer * DM;
  const int ntok = TT;
  for (int tok = bid * 8 + wid; tok < ntok; tok += nb * 8) {
    float v[16];
    load_row_comb(p, layer == 0 ? 0 : 1, lc, tok, lane, pre, v);
    if (lc >= 0) {
      u16* xr = p.X() + (size_t)tok * DM;
#pragma unroll
      for (int i = 0; i < 4; ++i) *(u32x2*)(xr + lane * 4 + i * 256) = u32x2{cvtpk(v[4 * i], v[4 * i + 1]), cvtpk(v[4 * i + 2], v[4 * i + 3])};
    }
    float ss = 0;
#pragma unroll
    for (int i = 0; i < 16; ++i) ss += v[i] * v[i];
    ss = wave_sum(ss);
    const float rs = rsqrtf(ss * (1.f / DM) + EPS);
    const float* md = p.mod() + ((size_t)layer * 3 + modv(tok)) * 6144;
#pragma unroll
    for (int i = 0; i < 4; ++i) {
      const int c = lane * 4 + i * 256;
      const float4 g = *(const float4*)(gn + c), sh = *(const float4*)(md + c), sc = *(const float4*)(md + DM + c);
      v[4 * i] = v[4 * i] * rs * g.x * (1.f + sc.x) + sh.x; v[4 * i + 1] = v[4 * i + 1] * rs * g.y * (1.f + sc.y) + sh.y;
      v[4 * i + 2] = v[4 * i + 2] * rs * g.z * (1.f + sc.z) + sh.z; v[4 * i + 3] = v[4 * i + 3] * rs * g.w * (1.f + sc.w) + sh.w;
    }
    store_row_i8(v, p.H() + (size_t)tok * DM, p.hs() + tok, lane);
  }
}

struct EpiIn {
  u16* zqkv; u16* zg; u16* zt; const float* hs; const float* sw;
  __device__ __forceinline__ void pre(const G8Unit& u, int wr, int fr, float (&ep)[8], float* cb) const {
    if ((ltid() >> 6) == 0) g8_cload(sw + u.pn * 256, cb);
    if ((ltid() >> 6) == 2) g8_cload(hs + u.pm * 256, cb + 512);
  }
  __device__ __forceinline__ void operator()(const i32x4 (&acc)[2][2][4][2], const G8Unit& u, int wr, int wc, int fr, int fq, const float (&ep)[8], const float* cb) const {
#pragma unroll
    for (int bj = 0; bj < 2; ++bj) {
      const int c32 = u.pn * 256 + bj * 128 + wc * 32, c0 = c32 + 8 * fq;
      const f32x4 w0 = *(const f32x4*)(cb + bj * 128 + wc * 32 + 8 * fq), w1 = *(const f32x4*)(cb + bj * 128 + wc * 32 + 8 * fq + 4);
#pragma unroll
      for (int ai = 0; ai < 2; ++ai)
#pragma unroll
        for (int m = 0; m < 4; ++m) {
          const int row = u.pm * 256 + ai * 128 + wr * 64 + m * 16 + fr;
          const float sa = cb[512 + ai * 128 + wr * 64 + m * 16 + fr];
          f32x4 a, b;
#pragma unroll
          for (int j = 0; j < 4; ++j) { a[j] = (float)acc[ai][bj][m][0][j] * sa * w0[j]; b[j] = (float)acc[ai][bj][m][1][j] * sa * w1[j]; }
          if (c32 < 384) {
            *(u32x4*)(zqkv + (size_t)row * 384 + c0) = u32x4{cvtpk(a[0], a[1]), cvtpk(a[2], a[3]), cvtpk(b[0], b[1]), cvtpk(b[2], b[3])};
          } else if (c32 < 1536) {
            *(u32x4*)(zg + (size_t)row * ZG_W + (c0 - 384)) = u32x4{cvtpk(a[0], a[1]), cvtpk(a[2], a[3]), cvtpk(b[0], b[1]), cvtpk(b[2], b[3])};
          } else {
#pragma unroll
            for (int j = 0; j < 4; ++j) { zt[(size_t)(c0 - 1536 + j) * TT + row] = f2bf(a[j]); zt[(size_t)(c0 - 1536 + 4 + j) * TT + row] = f2bf(b[j]); }
          }
        }
    }
  }
};
__device__ __forceinline__ void phase_gemm_in(const Params& p, int layer, int bid, int nb, char* lds) {
  G8Plain S; S.nM = TT / 256; S.nN = NIN / 256; S.Kb = DM; S.G = nb; S.c = bid; S.Bt = (const char*)(p.bt_in() + (size_t)layer * NIN * DM);
  EpiIn E; E.zqkv = p.zqkv(); E.zg = p.zg(); E.zt = p.zt(); E.hs = p.hs(); E.sw = p.swin() + layer * NIN;
  gemm8_phase<true>(lds, (const char*)p.H(), DM, S, E);
}

__device__ __forceinline__ size_t qkv_row(int tok, int h) {
  const int b = tok < TL ? (tok >> 14) : ((tok - TL) >> 8);
  const int s = tok < TL ? (tok & (SEQ - 1)) : SEQ + ((tok - TL) & (LC - 1));
  return ((size_t)(b * 4 + h)) * SKV + s;
}
struct EpiQkv {
  const u16* zqkv; u16* Q; u16* KV; const float* ropec; const float* ropes; float* rsl;
  unsigned* kmx;
  __device__ __forceinline__ void pre(const G8Unit&, int, int, float (&)[8], float*) const {}
  __device__ __forceinline__ void operator()(const f32x4 (&acc)[2][2][4][2], const G8Unit& u, int wr, int wc, int fr, int fq, const float (&)[8], const float*) const {
    const int tid = ltid();
    {
      const int r = tid >> 1, half = tid & 1;
      const u16* row = zqkv + (size_t)(u.pm * 256 + r) * 384;
      float sq = 0, sk = 0;
#pragma unroll
      for (int i = 0; i < 16; ++i) {
        const u32x4 w = *(const u32x4*)(row + half * 128 + i * 8);
#pragma unroll
        for (int q = 0; q < 4; ++q) { const float a = __uint_as_float(w[q] << 16), b = __uint_as_float(w[q] & 0xFFFF0000u); sq += a * a + b * b; }
      }
#pragma unroll
      for (int i = 0; i < 8; ++i) {
        const u32x4 w = *(const u32x4*)(row + 256 + half * 64 + i * 8);
#pragma unroll
        for (int q = 0; q < 4; ++q) { const float a = __uint_as_float(w[q] << 16), b = __uint_as_float(w[q] & 0xFFFF0000u); sk += a * a + b * b; }
      }
      sq += shx<1>(sq); sk += shx<1>(sk);
      if (half == 0) { rsl[r] = rsqrtf(sq * (1.f / 256.f) + EPS); rsl[256 + r] = rsqrtf(sk * (1.f / 128.f) + EPS); }
    }
    asm volatile("s_waitcnt lgkmcnt(0)" ::: "memory"); __builtin_amdgcn_s_barrier(); __builtin_amdgcn_s_barrier(); asm volatile("" ::: "memory");
    const float* rsp = rsl + (u.pn >= 2 ? 256 : 0);
#pragma unroll
    for (int ai = 0; ai < 2; ++ai)
#pragma unroll
      for (int m = 0; m < 4; ++m) {
        const int rl = ai * 128 + wr * 64 + m * 16 + fr, tok = u.pm * 256 + rl;
        const float rs = rsp[rl] * (u.pn < 2 ? A_QSCALE : 1.f);
        if (u.pn == 1) {
          f32x4 a = acc[ai][0][m][0] * rs, b = acc[ai][0][m][1] * rs;
          f32x4 pa, pb;
#pragma unroll
          for (int j = 0; j < 4; ++j) { pa[j] = shx<32>(a[j]); pb[j] = shx<32>(b[j]); }
          f32x4 ca = {1.f, 1.f, 1.f, 1.f}, cb = ca, sa = {0.f, 0.f, 0.f, 0.f}, sb = sa;
          if (tok < TL) {
            const float* cp = ropec + (size_t)(tok & (SEQ - 1)) * 16 + 8 * (fq & 1); const float* sp = ropes + (size_t)(tok & (SEQ - 1)) * 16 + 8 * (fq & 1);
            ca = *(const f32x4*)cp; cb = *(const f32x4*)(cp + 4); sa = *(const f32x4*)sp; sb = *(const f32x4*)(sp + 4);
          }
          const float sg = fq < 2 ? -1.f : 1.f;
          a = a * ca + pa * sa * sg; b = b * cb + pb * sb * sg;
          *(u32x4*)(Q + qkv_row(tok, wc) * 96 + 64 + 8 * fq) = u32x4{cvtpk(a[0], a[1]), cvtpk(a[2], a[3]), cvtpk(b[0], b[1]), cvtpk(b[2], b[3])};
        } else {
#pragma unroll
          for (int bj = 0; bj < 2; ++bj) {
            const int c = bj * 128 + wc * 32 + 8 * fq, h = c >> 6, d = c & 63;
            const f32x4 a = acc[ai][bj][m][0] * rs, b = acc[ai][bj][m][1] * rs;
            u16* dst = u.pn == 0 ? Q + qkv_row(tok, h) * 96 + d : KV + qkv_row(tok, h) * 160 + (u.pn == 2 ? 0 : 96) + d;
            *(u32x4*)dst = u32x4{cvtpk(a[0], a[1]), cvtpk(a[2], a[3]), cvtpk(b[0], b[1]), cvtpk(b[2], b[3])};
          }
        }
      }
    if (u.pn == 2) {
      const int b = u.pm * 256 < TL ? (u.pm * 256) >> 14 : (u.pm * 256 - TL) >> 8;
#pragma unroll
      for (int bj = 0; bj < 2; ++bj) {
        float mx = 0.f;
#pragma unroll
        for (int ai = 0; ai < 2; ++ai)
#pragma unroll
          for (int m = 0; m < 4; ++m) {
            const float rs = rsp[ai * 128 + wr * 64 + m * 16 + fr];
            const f32x4 a = acc[ai][bj][m][0] * rs, b4 = acc[ai][bj][m][1] * rs;
            float ss = a[0] * a[0] + a[1] * a[1] + a[2] * a[2] + a[3] * a[3] + b4[0] * b4[0] + b4[1] * b4[1] + b4[2] * b4[2] + b4[3] * b4[3];
            ss += shx<16>(ss); ss += shx<32>(ss);
            mx = fmaxf(mx, ss);
          }
        mx = fmaxf(mx, shx<8>(mx)); mx = fmaxf(mx, shx<4>(mx)); mx = fmaxf(mx, shx<2>(mx)); mx = fmaxf(mx, shx<1>(mx));
        if ((ltid() & 63) == 0) atomicMax(kmx + (b * 4 + bj * 2 + (wc >> 1)) * 4 + (wc & 1), __float_as_uint(mx));
      }
    }
  }
};
__device__ __forceinline__ void phase_qkv(const Params& p, int layer, int bid, int nb, char* lds) {
  const int tid = ltid();
  {
    G8Plain S; S.nM = TT / 256; S.nN = 4; S.Kb = 768; S.G = nb; S.c = bid; S.Bt = (const char*)(p.bt_qkv() + (size_t)layer * 1024 * 384);
    EpiQkv E; E.zqkv = p.zqkv(); E.Q = p.Q(); E.KV = p.KV(); E.ropec = p.ropec(); E.ropes = p.ropes(); E.rsl = (float*)(lds + 131072); E.kmx = p.kmx() + layer * 32;
    gemm8_phase<false>(lds, (const char*)p.zqkv(), 768, S, E);
  }
  float krm0 = 0.f, krm1 = 0.f;
  for (int i = bid * NTHR + tid; i < TT * 16; i += nb * NTHR) {
    const int tok = i >> 4, f = i & 15;
    const float x1 = bf2f(p.zg()[(size_t)tok * ZG_W + ZG_KR + f]), x2 = bf2f(p.zg()[(size_t)tok * ZG_W + ZG_KR + 16 + f]);
    float cs = 1.f, sn = 0.f;
    if (tok < TL) { const int tpos = tok & (SEQ - 1); cs = p.ropec()[tpos * 16 + f]; sn = p.ropes()[tpos * 16 + f]; }
    const float y1 = x1 * cs - x2 * sn, y2 = x2 * cs + x1 * sn;
    const u16 o1 = f2bf(y1), o2 = f2bf(y2);
#pragma unroll
    for (int h = 0; h < 4; ++h) { u16* kv = p.KV() + qkv_row(tok, h) * 160 + 64; kv[f] = o1; kv[16 + f] = o2; }
    float ss = y1 * y1 + y2 * y2;
    ss += shx<8>(ss); ss += shx<4>(ss); ss += shx<2>(ss); ss += shx<1>(ss);
    const int b = tok < TL ? (tok >> 14) : ((tok - TL) >> 8);
    if (b == 0) krm0 = fmaxf(krm0, ss); else krm1 = fmaxf(krm1, ss);
  }
  krm0 = wave_max(krm0); krm1 = wave_max(krm1);
  if ((tid & 63) == 0) { atomicMax(p.kmx() + layer * 32 + 0 * 16 + 2, __float_as_uint(krm0)); atomicMax(p.kmx() + layer * 32 + 1 * 16 + 2, __float_as_uint(krm1)); }
}

constexpr int A_KROW = 208;
constexpr int A_TV = 128 * 64 * 2;
constexpr int A_TK = 128 * A_KROW;
constexpr int A_BUF = A_TV + A_TK;
constexpr int A_OFF_W = 3 * A_BUF;
constexpr int ATTN_LDS = A_OFF_W + 8 * 64 * 4;
#define SBAR() __builtin_amdgcn_sched_barrier(0)
__device__ __forceinline__ int crow(int r, int hi) { return (r & 3) + 8 * (r >> 2) + 4 * hi; }

__device__ __forceinline__ void a_partialSM(f32x16& p0) {
#pragma unroll
  for (int r = 0; r < 16; ++r) p0[r] = __builtin_amdgcn_exp2f(p0[r]);
}
__device__ __forceinline__ void a_finishSM(f32x16& p0, f32x16& p1, bf16x8& pa0, bf16x8& pa1, bf16x8& pa2, bf16x8& pa3) {
#pragma unroll
  for (int r = 0; r < 16; ++r) p1[r] = __builtin_amdgcn_exp2f(p1[r]);
#define PK4(P, BASE, OUT) do { unsigned a0 = cvtpk(P[BASE + 0], P[BASE + 1]), a1 = cvtpk(P[BASE + 2], P[BASE + 3]);   \
    unsigned b0 = cvtpk(P[BASE + 4], P[BASE + 5]), b1 = cvtpk(P[BASE + 6], P[BASE + 7]);                              \
    auto r0 = __builtin_amdgcn_permlane32_swap(a0, b0, false, false); auto r1 = __builtin_amdgcn_permlane32_swap(a1, b1, false, false); \
    u32x4 w = {r0[0], r1[0], r0[1], r1[1]}; OUT = *reinterpret_cast<bf16x8*>(&w); } while (0)
  PK4(p0, 0, pa0); PK4(p0, 8, pa1); PK4(p1, 0, pa2); PK4(p1, 8, pa3);
#undef PK4
}
__device__ __forceinline__ void a_qkt(f32x16& p0, f32x16& p1, const char* Ks, const bf16x8* qr, const float mneg, int r32, int hi) {
#pragma unroll
  for (int r = 0; r < 16; ++r) { p0[r] = mneg; p1[r] = mneg; }
#pragma unroll
  for (int d0 = 0; d0 < 6; ++d0) {
    const int cb = (d0 * 16 + hi * 8) * 2;
    const bf16x8 b0 = *reinterpret_cast<const bf16x8*>(Ks + r32 * A_KROW + cb);
    const bf16x8 b1 = *reinterpret_cast<const bf16x8*>(Ks + (32 + r32) * A_KROW + cb);
    p0 = __builtin_amdgcn_mfma_f32_32x32x16_bf16(b0, qr[d0], p0, 0, 0, 0); p1 = __builtin_amdgcn_mfma_f32_32x32x16_bf16(b1, qr[d0], p1, 0, 0, 0);
  }
}
__device__ __forceinline__ int a_v_st(int k, int c) { const int kk = (k & ~0xC) | ((k & 4) << 1) | ((k & 8) >> 1); return ((kk >> 3) * 2 + (c >> 5)) * 512 + ((kk & 7) * 32 + (c & 31)) * 2; }
__device__ __forceinline__ int a_v_rd_base(int lane) { return ((lane & 3) << 3) | (((lane >> 2) & 3) << 6) | (((lane >> 4) & 1) << 5) | (((lane >> 5) & 1) << 8); }
constexpr int a_v_rd_off(int d0, int ks, int half) { return d0 * 512 + ks * 2048 + half * 1024; }
template <int OFF> __device__ __forceinline__ s16x4 a_tr_read(int vb) {
  s16x4 r; asm volatile("ds_read_b64_tr_b16 %0, %1 offset:%2" : "=&v"(r) : "v"(vb), "i"(OFF) : "memory"); return r;
}
template <int D0> __device__ __forceinline__ void a_pv_one(f32x16& od, int vb, bf16x8 pa0, bf16x8 pa1, bf16x8 pa2, bf16x8 pa3) {
  const s16x4 l0 = a_tr_read<a_v_rd_off(D0, 0, 0)>(vb), h0 = a_tr_read<a_v_rd_off(D0, 0, 1)>(vb), l1 = a_tr_read<a_v_rd_off(D0, 1, 0)>(vb), h1 = a_tr_read<a_v_rd_off(D0, 1, 1)>(vb);
  const s16x4 l2 = a_tr_read<a_v_rd_off(D0, 2, 0)>(vb), h2 = a_tr_read<a_v_rd_off(D0, 2, 1)>(vb), l3 = a_tr_read<a_v_rd_off(D0, 3, 0)>(vb), h3 = a_tr_read<a_v_rd_off(D0, 3, 1)>(vb);
  asm volatile("s_waitcnt lgkmcnt(0)" ::: "memory"); SBAR();
#define PK(L, H) (bf16x8){L[0], L[1], L[2], L[3], H[0], H[1], H[2], H[3]}
  od = __builtin_amdgcn_mfma_f32_32x32x16_bf16(pa0, PK(l0, h0), od, 0, 0, 0);
  od = __builtin_amdgcn_mfma_f32_32x32x16_bf16(pa1, PK(l1, h1), od, 0, 0, 0);
  od = __builtin_amdgcn_mfma_f32_32x32x16_bf16(pa2, PK(l2, h2), od, 0, 0, 0);
  od = __builtin_amdgcn_mfma_f32_32x32x16_bf16(pa3, PK(l3, h3), od, 0, 0, 0);
#undef PK
}
__device__ __forceinline__ void a_pv(f32x16* o, int vb, bf16x8 pa0, bf16x8 pa1, bf16x8 pa2, bf16x8 pa3) {
  a_pv_one<0>(o[0], vb, pa0, pa1, pa2, pa3);
  { const bf16x8 ones = {0x3F80, 0x3F80, 0x3F80, 0x3F80, 0x3F80, 0x3F80, 0x3F80, 0x3F80};
    o[2] = __builtin_amdgcn_mfma_f32_32x32x16_bf16(pa0, ones, o[2], 0, 0, 0); o[2] = __builtin_amdgcn_mfma_f32_32x32x16_bf16(pa1, ones, o[2], 0, 0, 0);
    o[2] = __builtin_amdgcn_mfma_f32_32x32x16_bf16(pa2, ones, o[2], 0, 0, 0); o[2] = __builtin_amdgcn_mfma_f32_32x32x16_bf16(pa3, ones, o[2], 0, 0, 0); }
  a_pv_one<1>(o[1], vb, pa0, pa1, pa2, pa3);
}

__device__ __forceinline__ void attn_item(const u16* __restrict__ Qb, const u16* __restrict__ KVh, int seq, float kmax, u16* __restrict__ yout  , char* lds) {
  const int tid = ltid(), wid = tid >> 6, lane = tid & 63, r32 = lane & 31, hi = lane >> 5;
  f32x16 o[3] = {}; bf16x8 qr[6];
  const u16* Qw = Qb + (size_t)(wid * 32 + r32) * 96 + hi * 8;
#pragma unroll
  for (int d0 = 0; d0 < 6; ++d0) qr[d0] = *reinterpret_cast<const bf16x8*>(Qw + d0 * 16);
  float mneg;
  {
    float ss = 0.f;
#pragma unroll
    for (int d0 = 0; d0 < 6; ++d0)
#pragma unroll
      for (int j = 0; j < 8; ++j) { const float v = bf2f((u16)qr[d0][j]); ss += v * v; }
    ss += shx<32>(ss);
    mneg = -sqrtf(ss) * kmax;
  }
  int lw[5];
#pragma unroll
  for (int i = 0; i < 5; ++i) {
    const int g = tid + i * 512, key = g / 20, cc = g % 20;
    lw[i] = cc < 12 ? (A_TV + key * A_KROW + cc * 16) : ((key >> 6) * 8192 + a_v_st(key & 63, (cc - 12) * 8));
  }
  const int vrb = (int)(uintptr_t)lds + a_v_rd_base(lane);
  bf16x8 sg[5];
  const char* gsrc = (const char*)KVh + tid * 16;
#define SLOAD(t) do { const char* s_ = gsrc + (size_t)(t) * 40960; _Pragma("unroll") for (int i = 0; i < 5; ++i) sg[i] = *(const bf16x8*)(s_ + i * 8192); } while (0)
#define SWRITE(bo_) do { _Pragma("unroll") for (int i = 0; i < 5; ++i) *(bf16x8*)(lds + (bo_) + lw[i]) = sg[i]; } while (0)
  f32x16 pA0, pA1, pB0, pB1; bf16x8 pa0, pa1, pa2, pa3; const int NT = seq / 128;
  SLOAD(0); SWRITE(0); if (1 < NT) SLOAD(1);
  __syncthreads();
  int bo = 0;
  {
    if (1 < NT) { SWRITE(A_BUF); if (2 < NT) SLOAD(2); }
    SBAR(); a_qkt(pA0, pA1, lds + bo + A_TV, qr, mneg, r32, hi); a_partialSM(pA0);
    SBAR(); a_qkt(pB0, pB1, lds + bo + A_TV + 64 * A_KROW, qr, mneg, r32, hi);
    a_finishSM(pA0, pA1, pa0, pa1, pa2, pa3); SBAR();
    a_pv(o, vrb + bo, pa0, pa1, pa2, pa3); a_partialSM(pB0);
    __syncthreads();
  }
  for (int t = 1; t < NT; ++t) {
    const int bp = bo;
    bo = bo + A_BUF; if (bo == 3 * A_BUF) bo = 0;
    int bn = bo + A_BUF; if (bn == 3 * A_BUF) bn = 0;
    if (t + 1 < NT) { SWRITE(bn); if (t + 2 < NT) SLOAD(t + 2); }
    SBAR(); a_qkt(pA0, pA1, lds + bo + A_TV, qr, mneg, r32, hi);
    a_finishSM(pB0, pB1, pa0, pa1, pa2, pa3); SBAR();
    a_pv(o, vrb + bp + 8192, pa0, pa1, pa2, pa3); a_partialSM(pA0);
    SBAR(); a_qkt(pB0, pB1, lds + bo + A_TV + 64 * A_KROW, qr, mneg, r32, hi);
    a_finishSM(pA0, pA1, pa0, pa1, pa2, pa3); SBAR();
    a_pv(o, vrb + bo, pa0, pa1, pa2, pa3); a_partialSM(pB0);
    __syncthreads();
  }
  a_finishSM(pB0, pB1, pa0, pa1, pa2, pa3); SBAR();
  a_pv(o, vrb + bo + 8192, pa0, pa1, pa2, pa3);
#pragma unroll
  for (int r = 0; r < 16; ++r) {
    const int orow = crow(r, hi);
    const float rl = __builtin_amdgcn_rcpf(o[2][r]);
    const float v0 = o[0][r] * rl, v1 = o[1][r] * rl;
    float ss = v0 * v0 + v1 * v1;
    ss += shx<16>(ss); ss += shx<8>(ss); ss += shx<4>(ss); ss += shx<2>(ss); ss += shx<1>(ss);
    const float rs = rsqrtf(ss * (1.f / 64.f) + EPS);
    u16* dst = yout + (size_t)(wid * 32 + orow) * DM;
    dst[r32] = f2bf(v0 * rs); dst[32 + r32] = f2bf(v1 * rs);
  }
  __syncthreads();
#undef SLOAD
#undef SWRITE
}

__device__ __forceinline__ void phase_attn(const Params& p, int layer, int bid, int nb, char* lds) {
  const int nitems = 512 + (layer == 0 ? 8 : 0);
  const unsigned* kmx = p.kmx() + layer * 32;
  for (int it = bid; it < nitems; it += nb) {
    int b, h, q0, k0, seq, tok0;
    if (it < 512) { const int pair = it & 7, qb = (it >> 3); h = pair & 3; b = pair >> 2; q0 = qb * 256; k0 = 0; seq = SKV; tok0 = b * SEQ + qb * 256; }
    else { const int i2 = it - 512; h = i2 & 3; b = i2 >> 2; q0 = SEQ; k0 = SEQ; seq = LC; tok0 = TL + b * LC; }
    const size_t base = (size_t)(b * 4 + h) * SKV;
    const float k2 = __uint_as_float(kmx[(b * 4 + h) * 4 + 0]) + __uint_as_float(kmx[(b * 4 + h) * 4 + 1]) + __uint_as_float(kmx[b * 16 + 2]);
    attn_item(p.Q() + (base + q0) * 96, p.KV() + (base + k0) * 160, seq, sqrtf(k2) * 1.02f, p.ymix() + (size_t)tok0 * DM + h * 64, lds);
  }
}

__device__ __forceinline__ float hy_sconv(const u16* __restrict__ row, int t, int Ls, float w0, float w1, float w2, float bb) {
  const float zm = t > 0 ? bf2f(row[t - 1]) : 0.f, z0 = bf2f(row[t]), zp = t + 1 < Ls ? bf2f(row[t + 1]) : 0.f;
  return w0 * zm + w1 * z0 + w2 * zp + bb;
}
__device__ __forceinline__ float2 hy_sconv2(unsigned prv, unsigned cur, unsigned nxt, float w0, float w1, float w2, float bb) {
  const float zm = __uint_as_float(prv & 0xFFFF0000u), z0 = __uint_as_float(cur << 16), z1 = __uint_as_float(cur & 0xFFFF0000u), z2 = __uint_as_float(nxt << 16);
  return make_float2(w0 * zm + w1 * z0 + w2 * z1 + bb, w0 * z0 + w1 * z1 + w2 * z2 + bb);
}
__device__ __forceinline__ void hyena_item(const Params& p, int layer, int b, int ch, char* lds) {
  float2* s = (float2*)lds;
  const int tid = ltid();
  const float* cw = p.hy_conv_w() + (size_t)layer * 3 * 768; const float* cb = p.hy_conv_b() + (size_t)layer * 768;
  const unsigned* r0 = (const unsigned*)(p.zt() + (size_t)(ZT_HY + ch) * TT + (size_t)b * SEQ);
  const unsigned* r1 = (const unsigned*)(p.zt() + (size_t)(ZT_HY + 256 + ch) * TT + (size_t)b * SEQ);
  const unsigned* r2 = (const unsigned*)(p.zt() + (size_t)(ZT_HY + 512 + ch) * TT + (size_t)b * SEQ);
  const float a0 = cw[ch], a1 = cw[768 + ch], a2 = cw[1536 + ch], ab = cb[ch];
  const float b0 = cw[256 + ch], b1 = cw[768 + 256 + ch], b2 = cw[1536 + 256 + ch], bb = cb[256 + ch];
  const float c0 = cw[512 + ch], c1 = cw[768 + 512 + ch], c2 = cw[1536 + 512 + ch], cbb = cb[512 + ch];
  unsigned vgr[16], x0r[16];
#pragma unroll
  for (int hb2 = 0; hb2 < 2; ++hb2) {
    unsigned ld[8][9];
#pragma unroll
    for (int ii = 0; ii < 8; ++ii) {
      const int m = tid + 512 * (hb2 * 8 + ii);
      const int mp = m > 0 ? m - 1 : 0, mn = m + 1 < SEQ / 2 ? m + 1 : m;
      ld[ii][0] = r0[mp]; ld[ii][1] = r0[m]; ld[ii][2] = r0[mn];
      ld[ii][3] = r1[mp]; ld[ii][4] = r1[m]; ld[ii][5] = r1[mn];
      ld[ii][6] = r2[mp]; ld[ii][7] = r2[m]; ld[ii][8] = r2[mn];
    }
#pragma unroll
    for (int ii = 0; ii < 8; ++ii) {
      const int i = hb2 * 8 + ii, m = tid + 512 * i;
      const unsigned mkp = m > 0 ? 0xFFFFFFFFu : 0u, mkn = m + 1 < SEQ / 2 ? 0xFFFFFFFFu : 0u;
      const float2 ux = hy_sconv2(ld[ii][0] & mkp, ld[ii][1], ld[ii][2] & mkn, a0, a1, a2, ab);
      x0r[i] = cvtpk(ux.x, ux.y);
      const float2 u1 = hy_sconv2(ld[ii][3] & mkp, ld[ii][4], ld[ii][5] & mkn, b0, b1, b2, bb);
      const float2 uv = hy_sconv2(ld[ii][6] & mkp, ld[ii][7], ld[ii][8] & mkn, c0, c1, c2, cbb);
      const float2 vgf = make_float2(uv.x * u1.x, uv.y * u1.y);
      vgr[i] = cvtpk(vgf.x, vgf.y);
      s[swz(m)] = vgf;
      s[swz(m + SEQ / 2)] = make_float2(0.f, 0.f);
    }
  }
  __syncthreads();
  fft_fwd(s, p.tw());
  {
    const float4* hs = p.hspec() + ((size_t)layer * 256 + ch) * HSP;
    float4 hv[17];
#pragma unroll
    for (int i = 0; i < 17; ++i) { const int k = tid + 512 * i; hv[i] = hs[k <= FM / 2 ? k : 0]; }
    const float2 twl = p.tw()[tid];
#pragma unroll
    for (int i = 0; i < 17; ++i) {
      const int k = tid + 512 * i;
      if (k <= FM / 2) {
        const int pk = swz(rev7(k)), pm = swz(rev7((FM - k) & (FM - 1)));
        const float2 zk = s[pk], zm = s[pm];
        const float4 h = hv[i];
        const float2 He = make_float2(h.x, h.y), Ho = make_float2(h.z, h.w);
        const float2 Xe = make_float2(0.5f * (zk.x + zm.x), 0.5f * (zk.y - zm.y));
        const float2 Xo = make_float2(0.5f * (zk.y + zm.y), -0.5f * (zk.x - zm.x));
        const float2 twk = cmul(twl, p.tw()[512 * i]);
        const float2 t1 = cmul(twk, cmul(Xo, Ho));
        const float2 e1 = cmul(Xe, He);
        const float2 Ye = make_float2(e1.x + t1.x, e1.y + t1.y);
        const float2 o1 = cmul(Xe, Ho), o2 = cmul(Xo, He);
        const float2 Yo = make_float2(o1.x + o2.x, o1.y + o2.y);
        s[pk] = make_float2(Ye.x - Yo.y, Ye.y + Yo.x);
        if (pm != pk) s[pm] = make_float2(Ye.x + Yo.y, -Ye.y + Yo.x);
      }
    }
  }
  __syncthreads();
  fft_inv(s, p.tw());
  const float hb = p.hy_bias()[layer * 256 + ch];
  unsigned* orow = (unsigned*)(p.hyo() + (size_t)ch * TT + (size_t)b * SEQ);
#pragma unroll
  for (int i = 0; i < 16; ++i) {
    const int m = tid + 512 * i;
    const float2 y = s[swz(m)];
    orow[m] = cvtpk((y.x + __uint_as_float(vgr[i] << 16) * hb) * __uint_as_float(x0r[i] << 16), (y.y + __uint_as_float(vgr[i] & 0xFFFF0000u) * hb) * __uint_as_float(x0r[i] & 0xFFFF0000u));
  }
  __syncthreads();
}
__device__ __forceinline__ void fnet_item(const Params& p, int b, int j, char* lds) {
  float2* s = (float2*)lds;
  const int tid = ltid();
  const u16* rr = p.zt() + (size_t)(ZT_FR + j) * TT + (size_t)b * SEQ;
  const u16* ri = p.zt() + (size_t)(ZT_FI + j) * TT + (size_t)b * SEQ;
  {
    u32x4 vr[4], vi[4];
#pragma unroll
    for (int i = 0; i < 4; ++i) { const int m0 = (tid + 512 * i) * 8; vr[i] = *(const u32x4*)(rr + m0); vi[i] = *(const u32x4*)(ri + m0); }
#pragma unroll
    for (int i = 0; i < 4; ++i) {
      const int m0 = (tid + 512 * i) * 8;
#pragma unroll
      for (int q = 0; q < 4; ++q) {
        s[swz(m0 + 2 * q)] = make_float2(__uint_as_float(vr[i][q] << 16), __uint_as_float(vi[i][q] << 16));
        s[swz(m0 + 2 * q + 1)] = make_float2(__uint_as_float(vr[i][q] & 0xFFFF0000u), __uint_as_float(vi[i][q] & 0xFFFF0000u));
      }
    }
  }
  __syncthreads();
  fft_fwd(s, p.tw());
#ifdef PROBE_FFT
  fft_inv(s, p.tw());
  for (int m = tid; m < FM; m += NTHR) { float2 v = s[m]; v.x *= (1.f / 16384.f); v.y *= (1.f / 16384.f); s[m] = v; }
  __syncthreads();
  fft_fwd(s, p.tw());
#endif
  u16* orow = p.fno() + (size_t)j * TT + (size_t)b * SEQ;
#pragma unroll 8
  for (int k = tid; k < FM; k += NTHR) orow[k] = f2bf(s[swz(rev7(k))].x * (1.f / 128.f));
  __syncthreads();
}
__device__ __forceinline__ void hyena_ctx_item(const Params& p, int b, int ch, char* lds) {
  float* vg = (float*)lds;
  float* x0 = vg + 256;
  float* hf = x0 + 256;
  float* hbk = hf + 256;
  const int tid = ltid();
  const float* cw = p.hy_conv_w(); const float* cb = p.hy_conv_b();
  const size_t off = (size_t)TL + (size_t)b * LC;
  const u16* r0 = p.zt() + (size_t)(ZT_HY + ch) * TT + off;
  const u16* r1 = p.zt() + (size_t)(ZT_HY + 256 + ch) * TT + off;
  const u16* r2 = p.zt() + (size_t)(ZT_HY + 512 + ch) * TT + off;
  if (tid < 256) {
    const int t = tid;
    vg[t] = hy_sconv(r2, t, LC, cw[512 + ch], cw[768 + 512 + ch], cw[1536 + 512 + ch], cb[512 + ch]) *
            hy_sconv(r1, t, LC, cw[256 + ch], cw[768 + 256 + ch], cw[1536 + 256 + ch], cb[256 + ch]);
    x0[t] = hy_sconv(r0, t, LC, cw[ch], cw[768 + ch], cw[1536 + ch], cb[ch]);
    hf[t] = p.hfc()[(size_t)ch * LC + t]; hbk[t] = p.hfc()[(size_t)(256 + ch) * LC + t];
  }
  const float ssq_c = filt_ssq(p.hpart() + (size_t)2 * 256 * 512, ch, (float*)(lds + 8192));
  if (tid < 256) {
    const int t = tid; float y = 0;
    for (int q = 0; q <= t; ++q) y += hf[t - q] * vg[q];
    for (int q = t + 1; q < LC; ++q) y += hbk[q - t] * vg[q];
    y *= rsqrtf(ssq_c);
    p.hyo()[(size_t)ch * TT + off + t] = f2bf((y + vg[t] * p.hy_bias()[ch]) * x0[t]);
  }
  __syncthreads();
}
__device__ __forceinline__ void fnet_ctx_item(const Params& p, int b, int j, char* lds) {
  float* ur = (float*)lds; float* ui = ur + 256; float* cst = ui + 256; float* snt = cst + 256;
  const int tid = ltid();
  const size_t off = (size_t)TL + (size_t)b * LC;
  if (tid < 256) {
    ur[tid] = bf2f(p.zt()[(size_t)(ZT_FR + j) * TT + off + tid]); ui[tid] = bf2f(p.zt()[(size_t)(ZT_FI + j) * TT + off + tid]);
    float sn, cs; sincospif((float)tid / 128.f, &sn, &cs); cst[tid] = cs; snt[tid] = sn;
  }
  __syncthreads();
  if (tid < 256) {
    const int k = tid; float y = 0;
    for (int l = 0; l < 256; ++l) { const int m = (l * k) & 255; y += cst[m] * ur[l] + snt[m] * ui[l]; }
    p.fno()[(size_t)j * TT + off + k] = f2bf(y * 0.0625f);
  }
  __syncthreads();
}
__device__ __forceinline__ void phase_fftmix(const Params& p, int layer, int bid, int nb, char* lds) {
  const int nitems = layer == 0 ? 2048 : 1024;
  for (int it = bid; it < nitems; it += nb) {
    const int k = it & 511, b = k >> 8, c = k & 255;
    if (it < 512) hyena_item(p, layer, b, c, lds);
    else if (it < 1024) fnet_item(p, b, c, lds);
    else if (it < 1536) hyena_ctx_item(p, b, c, lds);
    else fnet_ctx_item(p, b, c, lds);
  }
}
constexpr int GLG = 17, NGRP = 16;
__device__ __forceinline__ int gla_chain_tok(int dir, int b, int n, int i) {
  const int base = n < 4 ? TL + b * LC : b * SEQ, len = n < 4 ? LC : SEQ, m = n < 4 ? n : n - 4;
  return dir == 0 ? base + 64 * m + i : base + (len - 1) - (64 * m + i);
}
__device__ __forceinline__ float logsig16(float x) { return (fminf(x, 0.f) - __logf(1.f + __expf(-fabsf(x)))) * (1.f / 16.f); }
__device__ __forceinline__ float wave_scan_incl(float v, int lane) {
#pragma unroll
  for (int o = 1; o < 64; o <<= 1) { const float t = __shfl_up(v, o, 64); if (lane >= o) v += t; }
  return v;
}
__device__ __forceinline__ void phase_gla_a(const Params& p, int layer, int bid, int nb, char* lds) {
  const int tid = ltid(), wid = tid >> 6, lane = tid & 63, r32 = lane & 31, hi = lane >> 5;
  const float* gb = p.gla_gk_b() + (size_t)layer * 256;
  char* wimg = lds + wid * 12288;
  for (int it = bid; it < 16 * NGRP; it += nb) {
    const int chain = it >> 4, g = it & 15, dir = chain >> 3, b = (chain >> 2) & 1, h = chain & 3;
    const int n0 = g * GLG, n1 = min(n0 + GLG, NCH), nch = n1 - n0;
    char* WT = lds + wid * 13824; char* VT = WT + 4608;
    float* dvl = (float*)(lds + 8 * 13824);
#pragma unroll
    for (int c = 0; c < 3; ++c) {
      const int cl = wid + 8 * c;
      if (cl < nch) {
        const int n = n0 + cl;
        {
          const u16* vbase = p.zg() + ZG_GV + h * 64 + lane;
          u16 vv[64];
#pragma unroll
          for (int i = 0; i < 64; ++i) vv[i] = vbase[(size_t)gla_chain_tok(dir, b, n, i) * ZG_W];
#pragma unroll
          for (int q = 0; q < 8; ++q)
            *(u32x4*)(VT + lane * 144 + q * 16) = u32x4{(unsigned)vv[8 * q] | ((unsigned)vv[8 * q + 1] << 16), (unsigned)vv[8 * q + 2] | ((unsigned)vv[8 * q + 3] << 16),
                                                       (unsigned)vv[8 * q + 4] | ((unsigned)vv[8 * q + 5] << 16), (unsigned)vv[8 * q + 6] | ((unsigned)vv[8 * q + 7] << 16)};
        }
        {
          const int kk = lane & 31, hs = lane >> 5;
          const u16* kb = p.zg() + ZG_GK + h * 32 + kk; const u16* gbp = p.zg() + ZG_GP + dir * 128 + h * 32 + kk;
          const float bias = gb[dir * 128 + h * 32 + kk];
          float bc[32], kf[32];
#pragma unroll
          for (int i = 0; i < 32; ++i) {
            const size_t ro = (size_t)gla_chain_tok(dir, b, n, hs * 32 + i) * ZG_W;
            kf[i] = bf2f(kb[ro]); bc[i] = bf2f(gbp[ro]);
          }
          float run = 0.f;
#pragma unroll
          for (int i = 0; i < 32; ++i) { const float x = bc[i] + bias; run += (fminf(x, 0.f) - __logf(1.f + __expf(-fabsf(x)))) * (1.f / 16.f); bc[i] = run; }
          const float lowtot = __shfl(run, kk, 64);
          const float uptot = __shfl(run, 32 + kk, 64);
          const float bl = lowtot + uptot, off = hs ? lowtot : 0.f;
          unsigned wp[16];
#pragma unroll
          for (int i = 0; i < 16; ++i) wp[i] = cvtpk(kf[2 * i] * __expf(bl - (bc[2 * i] + off)), kf[2 * i + 1] * __expf(bl - (bc[2 * i + 1] + off)));
#pragma unroll
          for (int q = 0; q < 4; ++q) *(u32x4*)(WT + kk * 144 + hs * 64 + q * 16) = u32x4{wp[4 * q], wp[4 * q + 1], wp[4 * q + 2], wp[4 * q + 3]};
          if (hs == 0) dvl[cl * 32 + kk] = __expf(bl);
        }
        asm volatile("s_waitcnt lgkmcnt(0)" ::: "memory");
        f32x16 d0 = {}, d1 = {};
#pragma unroll
        for (int s4 = 0; s4 < 4; ++s4) {
          const bf16x8 af = *(const bf16x8*)(WT + r32 * 144 + (16 * s4 + 8 * hi) * 2);
          const bf16x8 v0 = *(const bf16x8*)(VT + r32 * 144 + (16 * s4 + 8 * hi) * 2);
          const bf16x8 v1 = *(const bf16x8*)(VT + (32 + r32) * 144 + (16 * s4 + 8 * hi) * 2);
          d0 = __builtin_amdgcn_mfma_f32_32x32x16_bf16(af, v0, d0, 0, 0, 0);
          d1 = __builtin_amdgcn_mfma_f32_32x32x16_bf16(af, v1, d1, 0, 0, 0);
        }
        asm volatile("s_waitcnt lgkmcnt(0)" ::: "memory");
        {
          float* dg = p.gds() + ((size_t)chain * NCH + n) * 2048;
#pragma unroll
          for (int r = 0; r < 16; ++r) { dg[crow(r, hi) * 64 + r32] = d0[r]; dg[crow(r, hi) * 64 + 32 + r32] = d1[r]; }
        }
      }
      __builtin_amdgcn_sched_barrier(0);
    }
    __syncthreads();
    {
      const int kk = tid >> 4, v0 = (tid & 15) * 4;
      float st[4] = {0.f, 0.f, 0.f, 0.f}; float dcum = 1.f;
      float* gp0 = p.gds() + ((size_t)chain * NCH + n0) * 2048 + kk * 64 + v0;
      float4 av[GLG];
#pragma unroll
      for (int cl = 0; cl < GLG; ++cl) av[cl] = *(const float4*)(gp0 + (size_t)(cl < nch ? cl : 0) * 2048);
#pragma unroll
      for (int cl = 0; cl < GLG; ++cl) {
        if (cl < nch) {
          const float d = dvl[cl * 32 + kk];
          *(float4*)(gp0 + (size_t)cl * 2048) = make_float4(st[0], st[1], st[2], st[3]);
          if ((tid & 15) == 0) p.gdv()[((size_t)chain * NCH + n0 + cl) * 32 + kk] = dcum;
          st[0] = st[0] * d + av[cl].x; st[1] = st[1] * d + av[cl].y; st[2] = st[2] * d + av[cl].z; st[3] = st[3] * d + av[cl].w;
          dcum *= d;
        }
      }
      float* at = p.gst() + ((size_t)chain * NGRP + g) * 2048 + kk * 64 + v0;
      *(float4*)at = make_float4(st[0], st[1], st[2], st[3]);
      if ((tid & 15) == 0) p.gst()[(size_t)16 * NGRP * 2048 + ((size_t)chain * NGRP + g) * 32 + kk] = dcum;
    }
    __syncthreads();
  }
}

constexpr int GC_QP = 33792, GC_KP = GC_QP + 10240, GC_VT = GC_KP + 10240, GC_ST = GC_VT + 18432, GC_AX = GC_ST + 10240;
__device__ __forceinline__ void phase_gla_c(const Params& p, int layer, int bid, int nb, char* lds) {
  float* gl = (float*)lds;
  float* qraw = gl + 2 * 64 * 33;
  float* kraw = qraw + 64 * 33;
  float* Of = (float*)lds;
  char* Qp = lds + GC_QP;
  char* Kp = lds + GC_KP;
  char* VT = lds + GC_VT;
  char* ST = lds + GC_ST;
  const int tid = ltid(), wid = tid >> 6, lane = tid & 63, r32 = lane & 31, hi = lane >> 5;
  char* Ax = lds + GC_AX + wid * 4608;
  const float* gb = p.gla_gk_b() + (size_t)layer * 256;
  const int pc_lo = layer == 0 ? 0 : 4, npc = NCH - pc_lo, nitem = 8 * npc;
  const int per = (nitem + nb - 1) / nb, q_beg = bid * per, q_end = min(nitem, q_beg + per);
  const int sdir = tid >> 8, sk = (tid >> 3) & 31, sv0 = (tid & 7) * 8;
  float G[8]; int g_cached = -1, bh_cached = -1;
  const int lpos = tid >> 3, lc4 = (tid & 7) * 4;
  u32x2 rq, rk, rg0, rg1, rva, rvb; float4 pl0, pl1; float pdp;
#define GC_ITEM(q_, bh_, pc_, b_, h_, tok0_) const int bh_ = (q_) / npc, pc_ = pc_lo + (q_) % npc, b_ = bh_ >> 2, h_ = bh_ & 3; \
    const int tok0_ = pc_ < 4 ? TL + b_ * LC + pc_ * 64 : b_ * SEQ + (pc_ - 4) * 64
#define GC_LOADRAW(tok0_, h_) do { const u16* zr = p.zg() + (size_t)((tok0_) + lpos) * ZG_W; \
    rq = *(const u32x2*)(zr + ZG_GQ + (h_) * 32 + lc4); rk = *(const u32x2*)(zr + ZG_GK + (h_) * 32 + lc4); \
    rg0 = *(const u32x2*)(zr + ZG_GP + (h_) * 32 + lc4); rg1 = *(const u32x2*)(zr + ZG_GP + 128 + (h_) * 32 + lc4); \
    rva = *(const u32x2*)(zr + ZG_GV + (h_) * 64 + lc4 * 2); rvb = *(const u32x2*)(zr + ZG_GV + (h_) * 64 + lc4 * 2 + 4); } while (0)
#define GC_LOADST(pc_, b_, h_) do { const int chain_ = sdir * 8 + (b_) * 4 + (h_); \
    const int n_ = sdir == 0 ? (pc_) : ((pc_) < 4 ? 3 - (pc_) : 4 + 255 - ((pc_) - 4)); \
    const float* lp_ = p.gds() + ((size_t)chain_ * NCH + n_) * 2048 + sk * 64 + sv0; \
    pl0 = *(const float4*)lp_; pl1 = *(const float4*)(lp_ + 4); pdp = p.gdv()[((size_t)chain_ * NCH + n_) * 32 + sk]; } while (0)
  if (q_beg < q_end) { GC_ITEM(q_beg, bh0, pc0, b0, h0, t00); GC_LOADRAW(t00, h0); GC_LOADST(pc0, b0, h0); }
  for (int qi = q_beg; qi < q_end; ++qi) {
    GC_ITEM(qi, bh, pc, b, h, tok0);
    {
      const int pos = lpos, c4 = lc4;
      const float sc = 0.17677669529663687f;
      qraw[pos * 33 + c4] = BF_LO(rq[0]) * sc; qraw[pos * 33 + c4 + 1] = BF_HI(rq[0]) * sc; qraw[pos * 33 + c4 + 2] = BF_LO(rq[1]) * sc; qraw[pos * 33 + c4 + 3] = BF_HI(rq[1]) * sc;
      kraw[pos * 33 + c4] = BF_LO(rk[0]); kraw[pos * 33 + c4 + 1] = BF_HI(rk[0]); kraw[pos * 33 + c4 + 2] = BF_LO(rk[1]); kraw[pos * 33 + c4 + 3] = BF_HI(rk[1]);
#pragma unroll
      for (int d = 0; d < 2; ++d) {
        const u32x2 rg = d ? rg1 : rg0; const float4 bb = *(const float4*)(gb + d * 128 + h * 32 + c4);
        const int i = d ? 63 - pos : pos;
        float* gd = gl + (d * 64 + i) * 33 + c4;
        gd[0] = logsig16(BF_LO(rg[0]) + bb.x); gd[1] = logsig16(BF_HI(rg[0]) + bb.y); gd[2] = logsig16(BF_LO(rg[1]) + bb.z); gd[3] = logsig16(BF_HI(rg[1]) + bb.w);
      }
#pragma unroll
      for (int j = 0; j < 4; ++j) {
        const unsigned w = j < 2 ? rva[j] : rvb[j - 2]; const int v = c4 * 2 + 2 * j;
        *(u16*)(VT + (0 * 64 + v) * 144 + pos * 2) = (u16)(w & 0xFFFFu); *(u16*)(VT + (1 * 64 + v) * 144 + (63 - pos) * 2) = (u16)(w & 0xFFFFu);
        *(u16*)(VT + (0 * 64 + v + 1) * 144 + pos * 2) = (u16)(w >> 16); *(u16*)(VT + (1 * 64 + v + 1) * 144 + (63 - pos) * 2) = (u16)(w >> 16);
      }
    }
    if (qi + 1 < q_end) { GC_ITEM(qi + 1, bhn, pcn, bn, hn, t0n); GC_LOADRAW(t0n, hn); }
    __syncthreads();
    {
      const int col = tid & 63, d = col >> 5, c = col & 31, part = tid >> 6;
      float* ptot = (float*)(lds + GC_AX);
      float bv[8]; float run = 0.f;
#pragma unroll
      for (int j = 0; j < 8; ++j) { run += gl[(d * 64 + part * 8 + j) * 33 + c]; bv[j] = run; }
      ptot[part * 64 + col] = run;
      __syncthreads();
      float off = 0.f;
#pragma unroll
      for (int q = 0; q < 7; ++q) off += (q < part) ? ptot[q * 64 + col] : 0.f;
#pragma unroll
      for (int j = 0; j < 8; ++j) gl[(d * 64 + part * 8 + j) * 33 + c] = bv[j] + off;
    }
    __syncthreads();
    {
#pragma unroll
      for (int e = 0; e < 2; ++e) {
        const int idx = tid + e * 512, d = idx >> 9, i = (idx >> 3) & 63, c4 = (idx & 7) * 4, pos = d ? 63 - i : i;
        float qo[4], ko[4];
#pragma unroll
        for (int j = 0; j < 4; ++j) {
          const float bi = gl[(d * 64 + i) * 33 + c4 + j], bm = gl[(d * 64 + 31) * 33 + c4 + j];
          qo[j] = qraw[pos * 33 + c4 + j] * __expf(bi - bm); ko[j] = kraw[pos * 33 + c4 + j] * __expf(bm - bi);
        }
        *(u32x2*)(Qp + (d * 64 + i) * 80 + c4 * 2) = u32x2{cvtpk(qo[0], qo[1]), cvtpk(qo[2], qo[3])};
        *(u32x2*)(Kp + (d * 64 + i) * 80 + c4 * 2) = u32x2{cvtpk(ko[0], ko[1]), cvtpk(ko[2], ko[3])};
      }
      const int chain = sdir * 8 + b * 4 + h;
      const int n = sdir == 0 ? pc : (pc < 4 ? 3 - pc : 4 + 255 - (pc - 4)), g = n / GLG;
      if (g != g_cached || bh != bh_cached) {
#pragma unroll
        for (int j = 0; j < 8; ++j) G[j] = 0.f;
        const float* at = p.gst() + (size_t)chain * NGRP * 2048 + sk * 64 + sv0;
        const float* dt = p.gst() + (size_t)16 * NGRP * 2048 + (size_t)chain * NGRP * 32 + sk;
        for (int gg = 0; gg < g; ++gg) {
          const float4 a0 = *(const float4*)(at + (size_t)gg * 2048), a1 = *(const float4*)(at + (size_t)gg * 2048 + 4); const float dd = dt[gg * 32];
          G[0] = G[0] * dd + a0.x; G[1] = G[1] * dd + a0.y; G[2] = G[2] * dd + a0.z; G[3] = G[3] * dd + a0.w;
          G[4] = G[4] * dd + a1.x; G[5] = G[5] * dd + a1.y; G[6] = G[6] * dd + a1.z; G[7] = G[7] * dd + a1.w;
        }
        g_cached = g; bh_cached = bh;
      }
      const float4 l0 = pl0, l1 = pl1; const float dp = pdp;
      const float em = __expf(gl[(sdir * 64 + 31) * 33 + sk]);
      const float sv[8] = {l0.x + dp * G[0], l0.y + dp * G[1], l0.z + dp * G[2], l0.w + dp * G[3], l1.x + dp * G[4], l1.y + dp * G[5], l1.z + dp * G[6], l1.w + dp * G[7]};
      if (qi + 1 < q_end) { GC_ITEM(qi + 1, bhn, pcn, bn, hn, t0n); (void)bhn; (void)t0n; GC_LOADST(pcn, bn, hn); }
#pragma unroll
      for (int j = 0; j < 8; ++j) *(u16*)(ST + (sdir * 64 + sv0 + j) * 80 + sk * 2) = f2bf(sv[j] * em);
    }
    __syncthreads();
    {
      const int d = wid >> 2, ib = (wid >> 1) & 1, vb = wid & 1;
      const char* Qd = Qp + d * 64 * 80; const char* Kd = Kp + d * 64 * 80; const char* Vd = VT + d * 64 * 144; const char* Sd = ST + d * 64 * 80;
      bf16x8 qf[2];
#pragma unroll
      for (int s2 = 0; s2 < 2; ++s2) qf[s2] = *(const bf16x8*)(Qd + (ib * 32 + r32) * 80 + (16 * s2 + 8 * hi) * 2);
#pragma unroll
      for (int jb = 0; jb < 2; ++jb) {
        if (jb <= ib) {
          f32x16 x = {};
#pragma unroll
          for (int s2 = 0; s2 < 2; ++s2) {
            const bf16x8 kf = *(const bf16x8*)(Kd + (jb * 32 + r32) * 80 + (16 * s2 + 8 * hi) * 2);
            x = __builtin_amdgcn_mfma_f32_32x32x16_bf16(qf[s2], kf, x, 0, 0, 0);
          }
#pragma unroll
          for (int r = 0; r < 16; ++r) {
            const int il = crow(r, hi), i = ib * 32 + il, j = jb * 32 + r32;
            *(u16*)(Ax + il * 144 + j * 2) = f2bf(j <= i ? x[r] : 0.f);
          }
        }
      }
      asm volatile("s_waitcnt lgkmcnt(0)" ::: "memory");
      f32x16 o = {};
#pragma unroll
      for (int s4 = 0; s4 < 4; ++s4) {
        if (s4 < 2 * (ib + 1)) {
          const bf16x8 af = *(const bf16x8*)(Ax + r32 * 144 + (16 * s4 + 8 * hi) * 2);
          const bf16x8 vf = *(const bf16x8*)(Vd + (vb * 32 + r32) * 144 + (16 * s4 + 8 * hi) * 2);
          o = __builtin_amdgcn_mfma_f32_32x32x16_bf16(af, vf, o, 0, 0, 0);
        }
      }
#pragma unroll
      for (int s2 = 0; s2 < 2; ++s2) {
        const bf16x8 sf = *(const bf16x8*)(Sd + (vb * 32 + r32) * 80 + (16 * s2 + 8 * hi) * 2);
        o = __builtin_amdgcn_mfma_f32_32x32x16_bf16(qf[s2], sf, o, 0, 0, 0);
      }
#pragma unroll
      for (int r = 0; r < 16; ++r) {
        const int i = ib * 32 + crow(r, hi), pos = d ? 63 - i : i;
        Of[(d * 64 + pos) * 65 + vb * 32 + r32] = o[r];
      }
    }
    __syncthreads();
    {
      const int pos = tid >> 3, v0 = (tid & 7) * 8;
      float r8[8]; float ss = 0.f;
#pragma unroll
      for (int j = 0; j < 8; ++j) { r8[j] = Of[pos * 65 + v0 + j] + Of[(64 + pos) * 65 + v0 + j]; ss += r8[j] * r8[j]; }
      ss += shx<4>(ss); ss += shx<2>(ss); ss += shx<1>(ss);
      const float rs = rsqrtf(ss * (1.f / 64.f) + EPS);
      const u16* og = p.zg() + (size_t)(tok0 + pos) * ZG_W + ZG_OG + h * 64 + v0;
      const float4 g0 = ld4bf(og), g1 = ld4bf(og + 4);
      *(u32x4*)(p.ymix() + (size_t)(tok0 + pos) * DM + 512 + h * 64 + v0) =
          u32x4{cvtpk(r8[0] * rs * silu_f(g0.x), r8[1] * rs * silu_f(g0.y)), cvtpk(r8[2] * rs * silu_f(g0.z), r8[3] * rs * silu_f(g0.w)),
                cvtpk(r8[4] * rs * silu_f(g1.x), r8[5] * rs * silu_f(g1.y)), cvtpk(r8[6] * rs * silu_f(g1.z), r8[7] * rs * silu_f(g1.w))};
    }
    __syncthreads();
  }
}

__device__ __forceinline__ void phase_mix(const Params& p, int layer, int bid, int nb, char* lds) {
  float* part = (float*)lds;
  u16* tile = (u16*)(lds + 4096);
  const int tid = ltid(), wid = tid >> 6, lane = tid & 63;
  const int ntok = layer == 0 ? TT : TL;
  for (int it = bid; it < ntok / 64; it += nb) {
    const int tok0 = it * 64;
    float vh[32], vf[32]; float sh = 0, sf = 0;
#pragma unroll
    for (int c = 0; c < 32; ++c) {
      vh[c] = bf2f(p.hyo()[(size_t)(wid * 32 + c) * TT + tok0 + lane]); vf[c] = bf2f(p.fno()[(size_t)(wid * 32 + c) * TT + tok0 + lane]);
      sh += vh[c] * vh[c]; sf += vf[c] * vf[c];
    }
    part[(0 * 8 + wid) * 64 + lane] = sh; part[(1 * 8 + wid) * 64 + lane] = sf;
    __syncthreads();
    float th = 0, tf = 0;
#pragma unroll
    for (int q = 0; q < 8; ++q) { th += part[(0 * 8 + q) * 64 + lane]; tf += part[(1 * 8 + q) * 64 + lane]; }
    const float rh = rsqrtf(th * (1.f / 256.f) + EPS), rf = rsqrtf(tf * (1.f / 256.f) + EPS);
#pragma unroll
    for (int c = 0; c < 32; ++c) { tile[lane * 520 + wid * 32 + c] = f2bf(vh[c] * rh); tile[lane * 520 + 256 + wid * 32 + c] = f2bf(vf[c] * rf); }
    __syncthreads();
    for (int g = tid; g < 64 * 64; g += NTHR) {
      const int tl = g >> 6, cg = g & 63;
      const u32x4 w = *(const u32x4*)(tile + tl * 520 + cg * 8);
      *(u32x4*)(p.ymix() + (size_t)(tok0 + tl) * DM + (cg < 32 ? 256 + cg * 8 : 768 + (cg - 32) * 8)) = w;
    }
    __syncthreads();
  }
}

struct EpiOut {
  const Params* pp; int layer;
  __device__ __forceinline__ void pre(const G8Unit& u, int, int, float (&)[8], float* cb) const {
    if ((ltid() >> 6) == 0) g8_cload(pp->mod() + ((size_t)layer * 3 + modv(u.pm * 256)) * 6144 + 2 * DM + u.pn * 256, cb);
  }
  __device__ __forceinline__ void operator()(const f32x4 (&acc)[2][2][4][2], const G8Unit& u, int wr, int wc, int fr, int fq, const float (&)[8], const float* cb) const {
    const Params& p = *pp;
#pragma unroll
    for (int bj = 0; bj < 2; ++bj) {
      const int c0 = u.pn * 256 + bj * 128 + wc * 32 + 8 * fq;
      const f32x4 ga = *(const f32x4*)(cb + bj * 128 + wc * 32 + 8 * fq), gb = *(const f32x4*)(cb + bj * 128 + wc * 32 + 8 * fq + 4);
#pragma unroll
      for (int ai = 0; ai < 2; ++ai) {
      if (layer == 0) {
        f32x4 xa[4], xb[4];
#pragma unroll
        for (int q = 0; q < 4; ++q) {
          const int tok = u.pm * 256 + ai * 128 + wr * 64 + q * 16 + fr;
          const float* xr = resid_row_in(p, tok) + c0; xa[q] = *(const f32x4*)xr; xb[q] = *(const f32x4*)(xr + 4);
        }
#pragma unroll
        for (int q = 0; q < 4; ++q) {
          const int tok = u.pm * 256 + ai * 128 + wr * 64 + q * 16 + fr;
          const f32x4 ya = xa[q] + ga * acc[ai][bj][q][0], yb = xb[q] + gb * acc[ai][bj][q][1];
          *(u32x4*)(p.X() + (size_t)tok * DM + c0) = u32x4{cvtpk(ya[0], ya[1]), cvtpk(ya[2], ya[3]), cvtpk(yb[0], yb[1]), cvtpk(yb[2], yb[3])};
        }
      } else {
        u32x4 w[4];
#pragma unroll
        for (int q = 0; q < 4; ++q) {
          const int tok = u.pm * 256 + ai * 128 + wr * 64 + q * 16 + fr;
          w[q] = *(const u32x4*)(p.X() + (size_t)tok * DM + c0);
        }
#pragma unroll
        for (int q = 0; q < 4; ++q) {
          const int tok = u.pm * 256 + ai * 128 + wr * 64 + q * 16 + fr;
          const f32x4 xa = f32x4{__uint_as_float(w[q][0] << 16), __uint_as_float(w[q][0] & 0xFFFF0000u), __uint_as_float(w[q][1] << 16), __uint_as_float(w[q][1] & 0xFFFF0000u)};
          const f32x4 xb = f32x4{__uint_as_float(w[q][2] << 16), __uint_as_float(w[q][2] & 0xFFFF0000u), __uint_as_float(w[q][3] << 16), __uint_as_float(w[q][3] & 0xFFFF0000u)};
          const f32x4 ya = xa + ga * acc[ai][bj][q][0], yb = xb + gb * acc[ai][bj][q][1];
          *(u32x4*)(p.X() + (size_t)tok * DM + c0) = u32x4{cvtpk(ya[0], ya[1]), cvtpk(ya[2], ya[3]), cvtpk(yb[0], yb[1]), cvtpk(yb[2], yb[3])};
        }
      }
      }
    }
  }
};
__device__ __forceinline__ void phase_gemm_out(const Params& p, int layer, int bid, int nb, char* lds) {
  G8Plain S; S.nM = (layer == 0 ? TT : TL) / 256; S.nN = DM / 256; S.Kb = 2 * DM; S.G = nb; S.c = bid; S.Bt = (const char*)(p.bt_out() + (size_t)layer * DM * DM);
  EpiOut E; E.pp = &p; E.layer = layer;
  gemm8_phase<false>(lds, (const char*)p.ymix(), 2 * DM, S, E);
}

__device__ __forceinline__ void phase_norm2_router(const Params& p, int layer, int bid, int nb, char* lds) {
  float* rwl = (float*)lds;
  int* lcnt = (int*)(lds + 131072);
  int* lbase = lcnt + 32;
  int* ent = lbase + 32;
  float* entw = (float*)(ent + 2 * 640);
  float* ents = entw + 640;
  const int tid = ltid(), wid = tid >> 6, lane = tid & 63;
  const int ntok = layer == 0 ? TT : TL;
  const float* rw = p.router_w() + (size_t)layer * DM * NE;
  for (int i = tid; i < DM * NE / 4; i += NTHR) {
    const int k = i >> 3, q4 = i & 7;
    ((float4*)rwl)[q4 * 1024 + ((k & 3) * 256 + (k >> 2))] = ((const float4*)rw)[i];
  }
  if (tid < 32) lcnt[tid] = 0;
  __syncthreads();
  const float* gn = p.norm2_g() + layer * DM; const float* rb = p.router_b() + layer * NE;
  const int per = (ntok + nb - 1) / nb, t_beg = bid * per, t_end = min(ntok, t_beg + per);
  for (int tok = t_beg + wid; tok < t_end; tok += 8) {
    const u16* xr = p.X() + (size_t)tok * DM;
    float v[16];
#pragma unroll
    for (int i = 0; i < 4; ++i) { const float4 a = ld4bf(xr + lane * 4 + i * 256); v[4 * i] = a.x; v[4 * i + 1] = a.y; v[4 * i + 2] = a.z; v[4 * i + 3] = a.w; }
    float ss = 0;
#pragma unroll
    for (int i = 0; i < 16; ++i) ss += v[i] * v[i];
    ss = wave_sum(ss);
    const float rs = rsqrtf(ss * (1.f / DM) + EPS);
    const float* md = p.mod() + ((size_t)layer * 3 + modv(tok)) * 6144 + 3 * DM;
#pragma unroll
    for (int i = 0; i < 4; ++i) {
      const int c = lane * 4 + i * 256;
      const float4 g = *(const float4*)(gn + c), sh = *(const float4*)(md + c), sc = *(const float4*)(md + DM + c);
      v[4 * i] = v[4 * i] * rs * g.x * (1.f + sc.x) + sh.x; v[4 * i + 1] = v[4 * i + 1] * rs * g.y * (1.f + sc.y) + sh.y;
      v[4 * i + 2] = v[4 * i + 2] * rs * g.z * (1.f + sc.z) + sh.z; v[4 * i + 3] = v[4 * i + 3] * rs * g.w * (1.f + sc.w) + sh.w;
    }
    const float rowsc = store_row_i8(v, p.H() + (size_t)tok * DM, p.hs() + tok, lane);
    float lg[32];
#pragma unroll
    for (int e = 0; e < 32; ++e) lg[e] = 0.f;
#pragma unroll
    for (int i = 0; i < 16; ++i) {
      const float4* wr4 = (const float4*)rwl + ((i & 3) * 256 + (i >> 2) * 64 + lane);
#pragma unroll
      for (int q = 0; q < 8; ++q) { const float4 w = wr4[q * 1024]; lg[4 * q] += v[i] * w.x; lg[4 * q + 1] += v[i] * w.y; lg[4 * q + 2] += v[i] * w.z; lg[4 * q + 3] += v[i] * w.w; }
    }
    float r16[16], r8[8], r4[4], r2[2], lv;
    { const bool up = lane & 32;
#pragma unroll
      for (int e = 0; e < 16; ++e) { const float keep = up ? lg[16 + e] : lg[e], send = up ? lg[e] : lg[16 + e]; r16[e] = keep + shx<32>(send); } }
    { const bool up = lane & 16;
#pragma unroll
      for (int e = 0; e < 8; ++e) { const float keep = up ? r16[8 + e] : r16[e], send = up ? r16[e] : r16[8 + e]; r8[e] = keep + shx<16>(send); } }
    { const bool up = lane & 8;
#pragma unroll
      for (int e = 0; e < 4; ++e) { const float keep = up ? r8[4 + e] : r8[e], send = up ? r8[e] : r8[4 + e]; r4[e] = keep + shx<8>(send); } }
    { const bool up = lane & 4;
#pragma unroll
      for (int e = 0; e < 2; ++e) { const float keep = up ? r4[2 + e] : r4[e], send = up ? r4[e] : r4[2 + e]; r2[e] = keep + shx<4>(send); } }
    { const bool up = lane & 2; const float keep = up ? r2[1] : r2[0], send = up ? r2[0] : r2[1]; lv = keep + shx<2>(send); }
    lv += shx<1>(lv);
    lv += rb[lane >> 1];
    int ids[4]; float vals[4];
#pragma unroll
    for (int k = 0; k < 4; ++k) {
      const float mx = wave_max(lv);
      const unsigned long long bal = __ballot(lv == mx);
      const int win = __ffsll((long long)bal) - 1;
      ids[k] = win >> 1; vals[k] = mx;
      if ((lane >> 1) == ids[k]) lv = -3.4e38f;
    }
    if (lane == 0) {
      const float mx = vals[0];
      float ex[4], sum = 0;
#pragma unroll
      for (int k = 0; k < 4; ++k) { ex[k] = __expf(vals[k] - mx); sum += ex[k]; }
      const float inv = 1.f / sum;
#pragma unroll
      for (int k = 0; k < 4; ++k) {
        const int lp = atomicAdd(&lcnt[ids[k]], 1);
        const int slot = (tok - t_beg) * 4 + k;
        ent[2 * slot] = tok * 4 + k; ent[2 * slot + 1] = (ids[k] << 20) | lp; entw[slot] = ex[k] * inv; ents[slot] = rowsc;
      }
    }
  }
  __syncthreads();
  if (tid < 32) lbase[tid] = atomicAdd(&p.cnt()[layer * NE + tid], lcnt[tid]);
  __syncthreads();
  const int nas = (t_end > t_beg ? (t_end - t_beg) : 0) * 4;
  for (int s = tid; s < nas; s += NTHR) {
    const int tk = ent[2 * s], el = ent[2 * s + 1], e = el >> 20, pos = lbase[e] + (el & 0xFFFFF);
    p.rtok()[(size_t)e * TT + pos] = tk >> 2; p.rw()[(size_t)e * TT + pos] = entw[s]; p.rsc()[(size_t)e * TT + pos] = ents[s];
    p.tslot()[tk] = (e << 20) | pos;
  }
}

template <bool GATH> struct G8MoeT {
  static constexpr bool GATHER = GATH;
  __device__ __forceinline__ void rows_to_lds(const G8Unit& u, int* dst) const {
    __builtin_amdgcn_global_load_lds((const unsigned*)(rtok + (size_t)u.e * TT + u.pm * 256 + (ltid() & 63) * 4), (LAS3 unsigned*)dst, 16, 0, 0);
  }
  const int* cnt;
  int ntn, Kb, G, c; const char* Bt; size_t bstride;
  const int* rtok;
  __device__ __forceinline__ bool next(int i, G8Unit& u, const G8Unit& from) const {
    const int w = (i * 8 + (c & 7)) * (G >> 3) + (c >> 3);
    int acc = from.ab, rows = from.pre;
    for (int ee = from.e; ee < NE; ++ee) {
      const int cc = cnt[ee], tiles = ((cc + 255) >> 8) * ntn;
      if (w < acc + tiles) { const int r = w - acc; u.e = ee; u.pm = r / ntn; u.pn = r % ntn; u.ce = cc; u.pre = rows; u.ab = acc; return true; }
      acc += tiles; rows += cc;
    }
    return false;
  }
  __device__ __forceinline__ int a_row(const G8Unit& u, int row) const {
    const int r = min(u.pm * 256 + row, u.ce - 1);
    return rtok ? rtok[(size_t)u.e * TT + r] : u.pre + r;
  }
  __device__ __forceinline__ unsigned a_off(const G8Unit& u, int row) const { return (unsigned)a_row(u, row) * (unsigned)Kb; }
  __device__ __forceinline__ const char* b_ptr(const G8Unit& u) const { return Bt + (size_t)u.e * bstride + (size_t)u.pn * 256 * Kb; }
};
struct EpiGu {
  const float* bgl; u16* act; const float* rsc; const float* swl;
  __device__ __forceinline__ void pre(const G8Unit& u, int wr, int fr, float (&ep)[8], float* cb) const {
    if ((ltid() >> 6) == 0) g8_cload(bgl + (size_t)u.e * 2048 + u.pn * 256, cb);
    if ((ltid() >> 6) == 1) g8_cload(swl + (size_t)u.e * 2048 + u.pn * 256, cb + 256);
    if ((ltid() >> 6) == 2) g8_cload(rsc + (size_t)u.e * TT + u.pm * 256, cb + 512);
  }
  __device__ __forceinline__ void operator()(const i32x4 (&acc)[2][2][4][2], const G8Unit& u, int wr, int wc, int fr, int fq, const float (&ep)[8], const float* cb) const {
    const int j0 = u.pn * 128 + wc * 32 + 8 * fq;
    typedef float f2v __attribute__((ext_vector_type(2)));
    const float* bg = cb + 2 * (wc * 32 + 8 * fq);
    f2v bgt[4], bup[4], sg[4], su[4];
#pragma unroll
    for (int q = 0; q < 4; ++q) { const f32x4 t = *(const f32x4*)(bg + 4 * q); bgt[q] = f2v{t[0], t[2]}; bup[q] = f2v{t[1], t[3]}; asm volatile("" : "+v"(bgt[q]), "+v"(bup[q])); }
    {
      const float* sp = cb + 256 + wc * 32 + 8 * fq;
      const f32x4 g0 = *(const f32x4*)sp, g1 = *(const f32x4*)(sp + 4), u0 = *(const f32x4*)(sp + 128), u1 = *(const f32x4*)(sp + 132);
      sg[0] = f2v{g0[0], g0[1]}; sg[1] = f2v{g0[2], g0[3]}; sg[2] = f2v{g1[0], g1[1]}; sg[3] = f2v{g1[2], g1[3]};
      su[0] = f2v{u0[0], u0[1]}; su[1] = f2v{u0[2], u0[3]}; su[2] = f2v{u1[0], u1[1]}; su[3] = f2v{u1[2], u1[3]};
    }
    const f2v kexp = f2v{-1.702f * 1.4426950408889634f, -1.702f * 1.4426950408889634f}, one2 = f2v{1.f, 1.f};
#pragma unroll
    for (int ai = 0; ai < 2; ++ai)
#pragma unroll
      for (int m = 0; m < 4; ++m) {
        const int r = u.pm * 256 + ai * 128 + wr * 64 + m * 16 + fr;
        if (r < u.ce) {
          const float sa = cb[512 + ai * 128 + wr * 64 + m * 16 + fr]; const f2v sa2 = f2v{sa, sa};
          unsigned ow[4];
#pragma unroll
          for (int n = 0; n < 2; ++n)
#pragma unroll
            for (int jp = 0; jp < 2; ++jp) {
              const int q = 2 * n + jp;
              f2v g = f2v{(float)acc[ai][0][m][n][2 * jp], (float)acc[ai][0][m][n][2 * jp + 1]};
              f2v v = f2v{(float)acc[ai][1][m][n][2 * jp], (float)acc[ai][1][m][n][2 * jp + 1]};
              g = (g * sa2) * sg[q] + bgt[q];
              v = (v * sa2) * su[q] + bup[q];
              g = f2v{fminf(g[0], 7.f), fminf(g[1], 7.f)};
              v = f2v{__builtin_amdgcn_fmed3f(v[0], -7.f, 7.f), __builtin_amdgcn_fmed3f(v[1], -7.f, 7.f)};
              const f2v t = g * kexp;
              const f2v d = f2v{__builtin_amdgcn_exp2f(t[0]), __builtin_amdgcn_exp2f(t[1])} + one2;
              const f2v rr = f2v{__builtin_amdgcn_rcpf(d[0]), __builtin_amdgcn_rcpf(d[1])};
              const f2v o = (v * g + g) * rr;
              ow[q] = cvtpk(o[0], o[1]);
            }
          *(u32x4*)(act + (size_t)(u.pre + r) * DFF + j0) = u32x4{ow[0], ow[1], ow[2], ow[3]};
        }
      }
  }
};
struct EpiDn {
  const float* bdl; const float* rw; unsigned char* yd;
  __device__ __forceinline__ void pre(const G8Unit& u, int wr, int fr, float (&ep)[8], float* cb) const {
    if ((ltid() >> 6) == 0) g8_cload(bdl + (size_t)u.e * DM + u.pn * 256, cb);
    if ((ltid() >> 6) == 2) g8_cload(rw + (size_t)u.e * TT + u.pm * 256, cb + 512);
  }
  __device__ __forceinline__ void operator()(const f32x4 (&acc)[2][2][4][2], const G8Unit& u, int wr, int wc, int fr, int fq, const float (&ep)[8], const float* cb) const {
#pragma unroll
    for (int bj = 0; bj < 2; ++bj) {
      const int c0 = u.pn * 256 + bj * 128 + wc * 32 + 8 * fq;
      const f32x4 ba = *(const f32x4*)(cb + bj * 128 + wc * 32 + 8 * fq), bb = *(const f32x4*)(cb + bj * 128 + wc * 32 + 8 * fq + 4);
#pragma unroll
      for (int ai = 0; ai < 2; ++ai)
#pragma unroll
        for (int m = 0; m < 4; ++m) {
          const int r = u.pm * 256 + ai * 128 + wr * 64 + m * 16 + fr;
          if (r < u.ce) {
            const float wgt = cb[512 + ai * 128 + wr * 64 + m * 16 + fr];
            const float w8 = wgt * 8.f;
            f32x4 a = (acc[ai][bj][m][0] + ba) * w8, b = (acc[ai][bj][m][1] + bb) * w8;
#pragma unroll
            for (int j = 0; j < 4; ++j) { a[j] = fminf(fmaxf(a[j], -440.f), 440.f); b[j] = fminf(fmaxf(b[j], -440.f), 440.f); }
            int w0 = 0, w1 = 0;
            w0 = __builtin_amdgcn_cvt_pk_fp8_f32(a[0], a[1], w0, false); w0 = __builtin_amdgcn_cvt_pk_fp8_f32(a[2], a[3], w0, true);
            w1 = __builtin_amdgcn_cvt_pk_fp8_f32(b[0], b[1], w1, false); w1 = __builtin_amdgcn_cvt_pk_fp8_f32(b[2], b[3], w1, true);
            *(u32x2*)(yd + (size_t)(u.pre + r) * DM + c0) = u32x2{(unsigned)w0, (unsigned)w1};
          }
        }
    }
  }
};
__device__ __forceinline__ void phase_moe_gu(const Params& p, int layer, int bid, int nb, char* lds) {
  int* scnt = (int*)(lds + 131072);
  if (ltid() < NE) scnt[ltid()] = p.cnt()[layer * NE + ltid()];
  __syncthreads();
  G8MoeT<true> S; S.cnt = scnt; S.ntn = 8; S.Kb = DM; S.G = nb; S.c = bid; S.Bt = (const char*)(p.bt_gu() + (size_t)layer * NE * 2048 * DM); S.bstride = (size_t)2048 * DM; S.rtok = p.rtok();
  EpiGu E; E.bgl = p.moe_b_gu() + (size_t)layer * NE * 2048; E.act = p.act(); E.rsc = p.rsc(); E.swl = p.swgu() + (size_t)layer * NE * 2048;
  gemm8_phase<true>(lds, (const char*)p.H(), DM, S, E);
}
__device__ __forceinline__ void phase_moe_dn(const Params& p, int layer, int bid, int nb, char* lds) {
  int* scnt = (int*)(lds + 131072);
  if (ltid() < NE) scnt[ltid()] = p.cnt()[layer * NE + ltid()];
  __syncthreads();
  G8MoeT<false> S; S.cnt = scnt; S.ntn = 4; S.Kb = 2 * DFF; S.G = nb; S.c = bid; S.Bt = (const char*)(p.bt_dn() + (size_t)layer * NE * DM * DFF); S.bstride = (size_t)DM * DFF * 2; S.rtok = nullptr;
  EpiDn E; E.bdl = p.moe_b_down() + (size_t)layer * NE * DM; E.rw = p.rw(); E.yd = p.yd();
  gemm8_phase<false>(lds, (const char*)p.act(), 2 * DFF, S, E);
}

__device__ __forceinline__ void phase_final(const Params& p, int bid, int nb, char* lds) {
  int* pre = (int*)lds;
  expert_prefix(p.cnt() + NE, pre); __syncthreads();
  const int wid = ltid() >> 6, lane = ltid() & 63;
  for (int tok = bid * 8 + wid; tok < TL; tok += nb * 8) {
    float v[16];
    load_row_comb(p, 1, 1, tok, lane, pre, v);
    float ss = 0;
#pragma unroll
    for (int i = 0; i < 16; ++i) ss += v[i] * v[i];
    ss = wave_sum(ss);
    const float rs = rsqrtf(ss * (1.f / DM) + EPS);
    float* o = p.out() + (size_t)tok * DM;
#pragma unroll
    for (int i = 0; i < 4; ++i) {
      const int c = lane * 4 + i * 256;
      const float4 g = *(const float4*)(p.final_g() + c);
      *(float4*)(o + c) = make_float4(v[4 * i] * rs * g.x, v[4 * i + 1] * rs * g.y, v[4 * i + 2] * rs * g.z, v[4 * i + 3] * rs * g.w);
    }
  }
}

#define XB_TMO      128
#define XB_XCNT(j)  (256  + 64 * (j))
#define XB_XSUB(j)  (1280 + 64 * (j))
#define XB_XGEN(j)  (2304 + 64 * (j))
#define XB_TOP      3328
#define XB_TOPGEN   3392
#define XCD_BAR_WORDS 3456
#define XB_SPIN_CAP (1u << 18)
#define LAS __attribute__((address_space(3)))

__device__ __forceinline__ unsigned xb_ld(unsigned* p)              { return __hip_atomic_load(p, __ATOMIC_RELAXED, __HIP_MEMORY_SCOPE_AGENT); }
__device__ __forceinline__ unsigned xb_add(unsigned* p, unsigned v) { return __hip_atomic_fetch_add(p, v, __ATOMIC_RELAXED, __HIP_MEMORY_SCOPE_AGENT); }
__device__ __forceinline__ unsigned xb_xcc_id() { return (unsigned)__builtin_amdgcn_s_getreg((3 << 11) | 20) & 0xFu; }
#define XB_SPIN(cond, bar) do { unsigned _sp = 0; while (cond) { __builtin_amdgcn_s_sleep(1); \
    if ((++_sp & 255u) == 0u) { if (xb_ld(&(bar)[XB_TMO])) break; if (_sp > XB_SPIN_CAP) { atomicAdd(&(bar)[XB_TMO], 1u); break; } } } } while (0)

struct XcdBarrier {
    unsigned* bar; unsigned x;
    volatile LAS unsigned* st;
};

__device__ __forceinline__ XcdBarrier xcd_barrier_post(unsigned* bar, volatile LAS unsigned* st) {
    XcdBarrier b; b.bar = bar; b.x = xb_xcc_id(); b.st = st;
    if (threadIdx.x == 0) (void)xb_add(&bar[XB_XCNT(b.x)], 1u);
    return b;
}
__device__ __forceinline__ void xcd_barrier_complete(unsigned* bar, unsigned x, unsigned& nloc, unsigned& nx) {
    const unsigned G = gridDim.x * gridDim.y * gridDim.z;
    unsigned sum, cnt, mine, sp = 0u;
    for (;;) {
        sum = 0u; cnt = 0u; mine = 0u;
#pragma unroll
        for (unsigned j = 0; j < 16; ++j) { const unsigned c = xb_ld(&bar[XB_XCNT(j)]); sum += c; cnt += (c > 0u) ? 1u : 0u; mine = (j == x) ? c : mine; }
        if (sum == G) break;
        __builtin_amdgcn_s_sleep(1);
        if ((++sp & 255u) == 0u) { if (xb_ld(&bar[XB_TMO])) break; if (sp > XB_SPIN_CAP) { atomicAdd(&bar[XB_TMO], 1u); break; } }
    }
    nloc = mine > 0u ? mine : 1u; nx = cnt > 0u ? cnt : 1u;
}

__device__ __forceinline__ void xcd_barrier(const XcdBarrier& b) {
    asm volatile("s_waitcnt vmcnt(0)" ::: "memory");
    __syncthreads();
    if (threadIdx.x == 0) {
        unsigned* bar = b.bar;
        __builtin_amdgcn_s_waitcnt(0);
        unsigned nloc = b.st[0], nx = b.st[1];
        if (nloc == 0u) { xcd_barrier_complete(bar, b.x, nloc, nx); b.st[0] = nloc; b.st[1] = nx; }
        const unsigned old = xb_add(&bar[XB_XSUB(b.x)], 1u);
        const unsigned gen = old / nloc;
        if (old + 1u == (gen + 1u) * nloc) {
            __builtin_amdgcn_fence(__ATOMIC_RELEASE, "agent");
            asm volatile("s_waitcnt vmcnt(0)" ::: "memory");
            const unsigned og = xb_add(&bar[XB_TOP], 1u);
            const unsigned tg = og / nx;
            if (og + 1u == (tg + 1u) * nx) xb_add(&bar[XB_TOPGEN], 1u);
            else XB_SPIN(xb_ld(&bar[XB_TOPGEN]) == tg, bar);
            __builtin_amdgcn_fence(__ATOMIC_ACQUIRE, "agent");
            xb_add(&bar[XB_XGEN(b.x)], 1u);
            asm volatile("s_waitcnt vmcnt(0)" ::: "memory");
        } else {
            XB_SPIN(xb_ld(&bar[XB_XGEN(b.x)]) == gen, bar);
            __builtin_amdgcn_fence(__ATOMIC_ACQUIRE, "agent");
            asm volatile("s_waitcnt vmcnt(0)" ::: "memory");
        }
    }
    __syncthreads();
}


constexpr int LDS_MAIN = 147456;
constexpr int LDS_BYTES = LDS_MAIN + 1024;
enum { PH_TABLES = 0, PH_MOD, PH_FOLD, PH_CONVERT, PH_HYMLP, PH_HYFILT, PH_NORM1, PH_GEMM_IN, PH_QKV, PH_ATTN, PH_FFTMIX,
       PH_GLA_A, PH_GLA_B, PH_GLA_C, PH_MIX, PH_GEMM_OUT, PH_NORM2, PH_MOE_GU, PH_MOE_DN, PH_FINAL };

__device__ __forceinline__ Params make_params() {
  const __attribute__((address_space(4))) char* kb = (const __attribute__((address_space(4))) char*)__builtin_amdgcn_kernarg_segment_ptr();
  asm volatile("" : "+s"(kb));
  Params p; p.kb = kb; return p;
}
#ifndef MK_LAUNCHES
#define MK_LAUNCHES 1
#endif
__global__ void __launch_bounds__(NTHR, 2) k_mega(ParamsData pd) {
  extern __shared__ __attribute__((aligned(1024))) char lds[];
  const int bid = blockIdx.x, nb = gridDim.x;
  if (threadIdx.x == 0) *(uint4*)(lds + LDS_MAIN) = make_uint4(0u, 0u, 0u, 0u);
  __syncthreads();
  XcdBarrier bar = xcd_barrier_post(make_params().bar(), (volatile LAS unsigned*)(lds + LDS_MAIN));
#ifndef DBLMASK
#define DBLMASK 0u
#endif
#define RUNPH(bit, call) do { call; if (DBLMASK & (1u << (bit))) { __syncthreads(); call; } } while (0)
  RUNPH(13, phase_tables(make_params(), bid, nb); phase_mod(make_params(), bid, nb, lds); phase_fold(make_params(), bid, nb, lds));
  RUNPH(0, phase_convert(make_params(), bid, nb, lds));
  phase_hy_mlp(make_params(), 0, SEQ, make_params().hfb(), make_params().hpart(), bid, nb, lds);
  phase_hy_mlp(make_params(), 1, SEQ, make_params().hfb() + (size_t)2 * 256 * SEQ, make_params().hpart() + 256 * 512, bid, nb, lds);
  phase_hy_mlp(make_params(), 0, LC, make_params().hfc(), make_params().hpart() + 2 * 256 * 512, bid, nb, lds);
  xcd_barrier(bar);
  RUNPH(2, phase_hy_filtfft(make_params(), bid, nb, lds));
  phase_quant_in(make_params(), bid, nb);
#define MK_LAYER(l) do { \
  phase_norm1(make_params(), l, bid, nb, lds); if ((DBLMASK & (1u << 14)) && l == 0) { __syncthreads(); phase_norm1(make_params(), l, bid, nb, lds); } \
  xcd_barrier(bar); \
  RUNPH(3, phase_gemm_in(make_params(), l, bid, nb, lds)); \
  xcd_barrier(bar); \
  RUNPH(4, phase_qkv(make_params(), l, bid, nb, lds)); \
  RUNPH(5, phase_gla_a(make_params(), l, bid, nb, lds)); \
  RUNPH(7, phase_fftmix(make_params(), l, bid, nb, lds)); \
  xcd_barrier(bar); \
  RUNPH(6, phase_attn(make_params(), l, bid, nb, lds)); \
  RUNPH(9, phase_gla_c(make_params(), l, bid, nb, lds)); \
  RUNPH(10, phase_mix(make_params(), l, bid, nb, lds)); \
  xcd_barrier(bar); \
  phase_gemm_out(make_params(), l, bid, nb, lds); if ((DBLMASK & (1u << 16)) && l == 0) { __syncthreads(); phase_gemm_out(make_params(), l, bid, nb, lds); } \
  xcd_barrier(bar); \
  phase_norm2_router(make_params(), l, bid, nb, lds); \
  xcd_barrier(bar); \
  RUNPH(11, phase_moe_gu(make_params(), l, bid, nb, lds)); \
  xcd_barrier(bar); \
  RUNPH(12, phase_moe_dn(make_params(), l, bid, nb, lds)); \
  xcd_barrier(bar); \
  } while (0)
  MK_LAYER(0);
  MK_LAYER(1);
#undef MK_LAYER
  RUNPH(15, phase_final(make_params(), bid, nb, lds));
}
static size_t carve(char*& cur, size_t bytes) { char* r = cur; cur += (bytes + 1023) & ~(size_t)1023; return (size_t)(uintptr_t)r; }
#define CARVE(T, field, n) p.field = (T*)carve(cur, (size_t)(n) * sizeof(T))

extern "C" void kernel_launch(void* const* d_in, const int* in_sizes, int n_in, void* d_out, int out_size, void* d_ws, size_t ws_size, hipStream_t stream) {
  ParamsData p; memset(&p, 0, sizeof(p));
  const float** ins = (const float**)&p;
  for (int i = 0; i < 34; ++i) ins[i] = (const float*)d_in[i];
  p.out_ = (float*)d_out;
  p.ws_ = (char*)d_ws;
  if (WS_TOTAL > ws_size) { fprintf(stderr, "workspace too small: need %zu have %zu\n", (size_t)WS_TOTAL, ws_size); return; }
  hipMemsetAsync((char*)d_ws + OFF_bar, 0, OFF_mod - OFF_bar, stream);
  static int grid = 0;
  if (!grid) {
    int dev = 0, cus = 0, per_cu = 0;
    hipGetDevice(&dev);
    hipDeviceGetAttribute(&cus, hipDeviceAttributeMultiprocessorCount, dev);
    hipFuncSetAttribute((const void*)k_mega, hipFuncAttributeMaxDynamicSharedMemorySize, LDS_BYTES);
    hipOccupancyMaxActiveBlocksPerMultiprocessor(&per_cu, (const void*)k_mega, NTHR, LDS_BYTES);
    grid = cus * (per_cu < 1 ? per_cu : 1);
    if (grid != 256) fprintf(stderr, "unexpected grid %d (cus %d per_cu %d)\n", grid, cus, per_cu);
  }
  hipLaunchKernelGGL(k_mega, dim3(grid), dim3(NTHR), LDS_BYTES, stream, p);
}
```

```cpp
#include <hip/hip_runtime.h>
#include <hip/hip_bf16.h>
#include <cstdio>
#include <cstdint>
#include <cstring>
#include <cstddef>
#include <type_traits>

typedef unsigned short u16;
using bf16x8 = __attribute__((ext_vector_type(8))) short;
using s16x4  = __attribute__((ext_vector_type(4))) short;
using f32x4  = __attribute__((ext_vector_type(4))) float;
using f32x16 = __attribute__((ext_vector_type(16))) float;
using u32x4  = __attribute__((ext_vector_type(4))) unsigned;
using u32x2  = __attribute__((ext_vector_type(2))) unsigned;

constexpr int DM = 1024, NB = 2, SEQ = 16384, LC = 256;
constexpr int TL = NB * SEQ;
constexpr int TC = NB * LC;
constexpr int TT = TL + TC;
constexpr int NIN = 2816;
constexpr int DIN0 = 2240;
constexpr int NE = 32, TOPK = 4, DFF = 1024;
constexpr int SKV = SEQ + LC;
constexpr int NTHR = 512;
constexpr float EPS = 1e-6f;
constexpr float A_SCALE = 0.10206207261596575f;
constexpr float A_QSCALE = A_SCALE * 1.4426950408889634f;
constexpr int ZG_W = 1152, ZG_GQ = 0, ZG_GK = 128, ZG_KR = 256, ZG_GV = 384, ZG_GP = 640, ZG_OG = 896;
constexpr int ZT_HY = 0, ZT_FR = 768, ZT_FI = 1024, ZT_R = 1280;
constexpr int NCH = 260;
constexpr int FM = 16384;
constexpr int HSP = FM / 2 + 1;

constexpr size_t ws_al(size_t b) { return (b + 1023) & ~(size_t)1023; }
constexpr size_t OFF_bar = 0;
constexpr size_t OFF_cnt = OFF_bar + ws_al((size_t)(4096) * sizeof(unsigned));
constexpr size_t OFF_hssq = OFF_cnt + ws_al((size_t)(64) * sizeof(int));
constexpr size_t OFF_kmx = OFF_hssq + ws_al((size_t)(768) * sizeof(float));
constexpr size_t OFF_mod = OFF_kmx + ws_al((size_t)(128) * sizeof(unsigned));
constexpr size_t OFF_ropec = OFF_mod + ws_al((size_t)(2 * 3 * 6144) * sizeof(float));
constexpr size_t OFF_ropes = OFF_ropec + ws_al((size_t)(SEQ * 16) * sizeof(float));
constexpr size_t OFF_tw = OFF_ropes + ws_al((size_t)(SEQ * 16) * sizeof(float));
constexpr size_t OFF_bt_in = OFF_tw + ws_al((size_t)(FM) * sizeof(float2));
constexpr size_t OFF_bt_qkv = OFF_bt_in + ws_al((size_t)((size_t)2 * NIN * DM) * sizeof(u16));
constexpr size_t OFF_bt_out = OFF_bt_qkv + ws_al((size_t)(2 * 1024 * 384) * sizeof(u16));
constexpr size_t OFF_bt_gu = OFF_bt_out + ws_al((size_t)((size_t)2 * DM * DM) * sizeof(u16));
constexpr size_t OFF_bt_dn = OFF_bt_gu + ws_al((size_t)((size_t)2 * NE * 2048 * DM) * sizeof(u16));
constexpr size_t OFF_hfb = OFF_bt_dn + ws_al((size_t)((size_t)2 * NE * DM * DFF) * sizeof(u16));
constexpr size_t OFF_hfc = OFF_hfb + ws_al((size_t)((size_t)2 * 2 * 256 * SEQ) * sizeof(float));
constexpr size_t OFF_hspec = OFF_hfc + ws_al((size_t)(2 * 256 * LC) * sizeof(float));
constexpr size_t OFF_H = OFF_hspec + ws_al((size_t)((size_t)2 * 256 * HSP) * sizeof(float4));
constexpr size_t OFF_zqkv = OFF_H + ws_al((size_t)((size_t)TT * DM) * sizeof(u16));
constexpr size_t OFF_zg = OFF_zqkv + ws_al((size_t)((size_t)TT * 384) * sizeof(u16));
constexpr size_t OFF_zt = OFF_zg + ws_al((size_t)((size_t)TT * ZG_W) * sizeof(float));
constexpr size_t OFF_Q = OFF_zt + ws_al((size_t)((size_t)ZT_R * TT) * sizeof(float));
constexpr size_t OFF_KV = OFF_Q + ws_al((size_t)((size_t)2 * 4 * SKV * 96) * sizeof(u16));
constexpr size_t OFF_ymix = OFF_KV + ws_al((size_t)((size_t)2 * 4 * SKV * 160) * sizeof(u16));
constexpr size_t OFF_hyo = OFF_ymix + ws_al((size_t)((size_t)TT * DM) * sizeof(u16));
constexpr size_t OFF_fno = OFF_hyo + ws_al((size_t)((size_t)256 * TT) * sizeof(float));
constexpr size_t OFF_glao = OFF_fno + ws_al((size_t)((size_t)256 * TT) * sizeof(float));
constexpr size_t OFF_gds = OFF_glao + ws_al((size_t)((size_t)TT * 256) * sizeof(float));
constexpr size_t OFF_gdv = OFF_gds + ws_al((size_t)((size_t)16 * NCH * 2048) * sizeof(float));
constexpr size_t OFF_gst = OFF_gdv + ws_al((size_t)((size_t)16 * NCH * 32) * sizeof(float));
constexpr size_t OFF_X = OFF_gst + ws_al((size_t)((size_t)16 * NCH * 2048) * sizeof(float));
constexpr size_t OFF_rtok = OFF_X + ws_al((size_t)((size_t)TT * DM) * sizeof(float));
constexpr size_t OFF_rw = OFF_rtok + ws_al((size_t)((size_t)NE * TT) * sizeof(int));
constexpr size_t OFF_tslot = OFF_rw + ws_al((size_t)((size_t)NE * TT) * sizeof(float));
constexpr size_t OFF_act = OFF_tslot + ws_al((size_t)((size_t)TT * 4) * sizeof(int));
constexpr size_t OFF_yd = OFF_act + ws_al((size_t)((size_t)TT * 4 * DFF) * sizeof(u16));
constexpr size_t OFF_swin = OFF_yd + ws_al((size_t)((size_t)TT * 4 * DM) * sizeof(u16));
constexpr size_t OFF_swgu = OFF_swin + ws_al((size_t)(2 * NIN) * sizeof(float));
constexpr size_t OFF_hs = OFF_swgu + ws_al((size_t)(2 * NE * 2048) * sizeof(float));
constexpr size_t OFF_hpart = OFF_hs + ws_al((size_t)(TT) * sizeof(float));
constexpr size_t OFF_rsc = OFF_hpart + ws_al((size_t)(3 * 256 * 512) * sizeof(float));
constexpr size_t WS_TOTAL = OFF_rsc + ws_al((size_t)((size_t)NE * TT) * sizeof(float));
struct ParamsData {
  const float *x_, *c_, *ctx_, *c_ctx_, *ada_w_, *ada_b_, *norm1_g_, *norm2_g_, *w_in_, *mla_q_g_, *mla_w_uq_, *mla_kv_g_, *mla_w_ukv_, *hy_conv_w_, *hy_conv_b_, *hy_w1_, *hy_b1_, *hy_w2_, *hy_b2_, *hy_w3_, *hy_freq_, *hy_bias_, *gla_gk_w_, *gla_gk_b_, *fnet_w_, *mix_g_, *w_out_, *router_w_, *router_b_, *moe_w_gu_, *moe_b_gu_, *moe_w_down_, *moe_b_down_, *final_g_;
  float* out_;
  char* ws_;
};
struct Params {
  const __attribute__((address_space(4))) char* kb;
  template <class T> __device__ __forceinline__ T karg(size_t off) const { return *(const __attribute__((address_space(4))) T*)(kb + off); }
  __device__ __forceinline__ const float* x() const { return karg<const float*>(offsetof(ParamsData, x_)); }
  __device__ __forceinline__ const float* c() const { return karg<const float*>(offsetof(ParamsData, c_)); }
  __device__ __forceinline__ const float* ctx() const { return karg<const float*>(offsetof(ParamsData, ctx_)); }
  __device__ __forceinline__ const float* c_ctx() const { return karg<const float*>(offsetof(ParamsData, c_ctx_)); }
  __device__ __forceinline__ const float* ada_w() const { return karg<const float*>(offsetof(ParamsData, ada_w_)); }
  __device__ __forceinline__ const float* ada_b() const { return karg<const float*>(offsetof(ParamsData, ada_b_)); }
  __device__ __forceinline__ const float* norm1_g() const { return karg<const float*>(offsetof(ParamsData, norm1_g_)); }
  __device__ __forceinline__ const float* norm2_g() const { return karg<const float*>(offsetof(ParamsData, norm2_g_)); }
  __device__ __forceinline__ const float* w_in() const { return karg<const float*>(offsetof(ParamsData, w_in_)); }
  __device__ __forceinline__ const float* mla_q_g() const { return karg<const float*>(offsetof(ParamsData, mla_q_g_)); }
  __device__ __forceinline__ const float* mla_w_uq() const { return karg<const float*>(offsetof(ParamsData, mla_w_uq_)); }
  __device__ __forceinline__ const float* mla_kv_g() const { return karg<const float*>(offsetof(ParamsData, mla_kv_g_)); }
  __device__ __forceinline__ const float* mla_w_ukv() const { return karg<const float*>(offsetof(ParamsData, mla_w_ukv_)); }
  __device__ __forceinline__ const float* hy_conv_w() const { return karg<const float*>(offsetof(ParamsData, hy_conv_w_)); }
  __device__ __forceinline__ const float* hy_conv_b() const { return karg<const float*>(offsetof(ParamsData, hy_conv_b_)); }
  __device__ __forceinline__ const float* hy_w1() const { return karg<const float*>(offsetof(ParamsData, hy_w1_)); }
  __device__ __forceinline__ const float* hy_b1() const { return karg<const float*>(offsetof(ParamsData, hy_b1_)); }
  __device__ __forceinline__ const float* hy_w2() const { return karg<const float*>(offsetof(ParamsData, hy_w2_)); }
  __device__ __forceinline__ const float* hy_b2() const { return karg<const float*>(offsetof(ParamsData, hy_b2_)); }
  __device__ __forceinline__ const float* hy_w3() const { return karg<const float*>(offsetof(ParamsData, hy_w3_)); }
  __device__ __forceinline__ const float* hy_freq() const { return karg<const float*>(offsetof(ParamsData, hy_freq_)); }
  __device__ __forceinline__ const float* hy_bias() const { return karg<const float*>(offsetof(ParamsData, hy_bias_)); }
  __device__ __forceinline__ const float* gla_gk_w() const { return karg<const float*>(offsetof(ParamsData, gla_gk_w_)); }
  __device__ __forceinline__ const float* gla_gk_b() const { return karg<const float*>(offsetof(ParamsData, gla_gk_b_)); }
  __device__ __forceinline__ const float* fnet_w() const { return karg<const float*>(offsetof(ParamsData, fnet_w_)); }
  __device__ __forceinline__ const float* mix_g() const { return karg<const float*>(offsetof(ParamsData, mix_g_)); }
  __device__ __forceinline__ const float* w_out() const { return karg<const float*>(offsetof(ParamsData, w_out_)); }
  __device__ __forceinline__ const float* router_w() const { return karg<const float*>(offsetof(ParamsData, router_w_)); }
  __device__ __forceinline__ const float* router_b() const { return karg<const float*>(offsetof(ParamsData, router_b_)); }
  __device__ __forceinline__ const float* moe_w_gu() const { return karg<const float*>(offsetof(ParamsData, moe_w_gu_)); }
  __device__ __forceinline__ const float* moe_b_gu() const { return karg<const float*>(offsetof(ParamsData, moe_b_gu_)); }
  __device__ __forceinline__ const float* moe_w_down() const { return karg<const float*>(offsetof(ParamsData, moe_w_down_)); }
  __device__ __forceinline__ const float* moe_b_down() const { return karg<const float*>(offsetof(ParamsData, moe_b_down_)); }
  __device__ __forceinline__ const float* final_g() const { return karg<const float*>(offsetof(ParamsData, final_g_)); }
  __device__ __forceinline__ float* out() const { return karg<float*>(offsetof(ParamsData, out_)); }
  __device__ __forceinline__ char* ws() const { return karg<char*>(offsetof(ParamsData, ws_)); }
  __device__ __forceinline__ unsigned* bar() const { return (unsigned*)(ws() + OFF_bar); }
  __device__ __forceinline__ int* cnt() const { return (int*)(ws() + OFF_cnt); }
  __device__ __forceinline__ float* hssq() const { return (float*)(ws() + OFF_hssq); }
  __device__ __forceinline__ unsigned* kmx() const { return (unsigned*)(ws() + OFF_kmx); }
  __device__ __forceinline__ float* mod() const { return (float*)(ws() + OFF_mod); }
  __device__ __forceinline__ float* ropec() const { return (float*)(ws() + OFF_ropec); }
  __device__ __forceinline__ float* ropes() const { return (float*)(ws() + OFF_ropes); }
  __device__ __forceinline__ float2* tw() const { return (float2*)(ws() + OFF_tw); }
  __device__ __forceinline__ signed char* bt_in() const { return (signed char*)(ws() + OFF_bt_in); }
  __device__ __forceinline__ u16* bt_qkv() const { return (u16*)(ws() + OFF_bt_qkv); }
  __device__ __forceinline__ u16* bt_out() const { return (u16*)(ws() + OFF_bt_out); }
  __device__ __forceinline__ signed char* bt_gu() const { return (signed char*)(ws() + OFF_bt_gu); }
  __device__ __forceinline__ u16* bt_dn() const { return (u16*)(ws() + OFF_bt_dn); }
  __device__ __forceinline__ float* hfb() const { return (float*)(ws() + OFF_hfb); }
  __device__ __forceinline__ float* hfc() const { return (float*)(ws() + OFF_hfc); }
  __device__ __forceinline__ float4* hspec() const { return (float4*)(ws() + OFF_hspec); }
  __device__ __forceinline__ signed char* H() const { return (signed char*)(ws() + OFF_H); }
  __device__ __forceinline__ float* hs() const { return (float*)(ws() + OFF_hs); }
  __device__ __forceinline__ float* rsc() const { return (float*)(ws() + OFF_rsc); }
  __device__ __forceinline__ float* hpart() const { return (float*)(ws() + OFF_hpart); }
  __device__ __forceinline__ float* swin() const { return (float*)(ws() + OFF_swin); }
  __device__ __forceinline__ float* swgu() const { return (float*)(ws() + OFF_swgu); }
  __device__ __forceinline__ float* btf() const { return (float*)(ws() + OFF_act); }
  __device__ __forceinline__ u16* zqkv() const { return (u16*)(ws() + OFF_zqkv); }
  __device__ __forceinline__ u16* zg() const { return (u16*)(ws() + OFF_zg); }
  __device__ __forceinline__ u16* zt() const { return (u16*)(ws() + OFF_zt); }
  __device__ __forceinline__ u16* Q() const { return (u16*)(ws() + OFF_Q); }
  __device__ __forceinline__ u16* KV() const { return (u16*)(ws() + OFF_KV); }
  __device__ __forceinline__ u16* ymix() const { return (u16*)(ws() + OFF_ymix); }
  __device__ __forceinline__ u16* hyo() const { return (u16*)(ws() + OFF_hyo); }
  __device__ __forceinline__ u16* fno() const { return (u16*)(ws() + OFF_fno); }
  __device__ __forceinline__ u16* glao() const { return (u16*)(ws() + OFF_glao); }
  __device__ __forceinline__ float* gds() const { return (float*)(ws() + OFF_gds); }
  __device__ __forceinline__ float* gdv() const { return (float*)(ws() + OFF_gdv); }
  __device__ __forceinline__ float* gst() const { return (float*)(ws() + OFF_gst); }
  __device__ __forceinline__ u16* X() const { return (u16*)(ws() + OFF_X); }
  __device__ __forceinline__ int* rtok() const { return (int*)(ws() + OFF_rtok); }
  __device__ __forceinline__ float* rw() const { return (float*)(ws() + OFF_rw); }
  __device__ __forceinline__ int* tslot() const { return (int*)(ws() + OFF_tslot); }
  __device__ __forceinline__ u16* act() const { return (u16*)(ws() + OFF_act); }
  __device__ __forceinline__ unsigned char* yd() const { return (unsigned char*)(ws() + OFF_yd); }
};


__device__ __forceinline__ u16 f2bf(float f) {
  unsigned u = __float_as_uint(f); u += 0x7FFFu + ((u >> 16) & 1u); return (u16)(u >> 16);
}
__device__ __forceinline__ float bf2f(u16 h) { return __uint_as_float(((unsigned)h) << 16); }
__device__ __forceinline__ unsigned cvtpk(float lo, float hi) {
  unsigned r; asm volatile("v_cvt_pk_bf16_f32 %0, %1, %2" : "=v"(r) : "v"(lo), "v"(hi)); return r;
}
#define BF_LO(w) __uint_as_float((w) << 16)
#define BF_HI(w) __uint_as_float((w) & 0xFFFF0000u)
__device__ __forceinline__ float4 ld4bf(const u16* p) { const u32x2 w = *(const u32x2*)p; return make_float4(__uint_as_float(w[0] << 16), __uint_as_float(w[0] & 0xFFFF0000u), __uint_as_float(w[1] << 16), __uint_as_float(w[1] & 0xFFFF0000u)); }
template <int CTRL> __device__ __forceinline__ float dppf(float v) { return __builtin_bit_cast(float, __builtin_amdgcn_update_dpp(0, __builtin_bit_cast(int, v), CTRL, 0xF, 0xF, true)); }
template <int M> __device__ __forceinline__ float shx(float v) {
  if constexpr (M == 1) return dppf<0xB1>(v);
  else if constexpr (M == 2) return dppf<0x4E>(v);
  else if constexpr (M == 4) return dppf<0x1B>(dppf<0x141>(v));
  else if constexpr (M == 8) return dppf<0x141>(dppf<0x140>(v));
  else if constexpr (M == 16) { auto r = __builtin_amdgcn_permlane16_swap(__float_as_uint(v), __float_as_uint(v), false, false);
    return __uint_as_float((__lane_id() & 16) ? r[0] : r[1]); }
  else { auto r = __builtin_amdgcn_permlane32_swap(__float_as_uint(v), __float_as_uint(v), false, false);
    return __uint_as_float((__lane_id() & 32) ? r[0] : r[1]); }
}
__device__ __forceinline__ float wave_sum(float v) {
  v += dppf<0xB1>(v); v += dppf<0x4E>(v); v += dppf<0x141>(v); v += dppf<0x140>(v);
  { auto r = __builtin_amdgcn_permlane16_swap(__float_as_uint(v), __float_as_uint(v), false, false); v = __uint_as_float(r[0]) + __uint_as_float(r[1]); }
  { auto r = __builtin_amdgcn_permlane32_swap(__float_as_uint(v), __float_as_uint(v), false, false); v = __uint_as_float(r[0]) + __uint_as_float(r[1]); }
  return v;
}
__device__ __forceinline__ float wave_max(float v) {
  v = fmaxf(v, dppf<0xB1>(v)); v = fmaxf(v, dppf<0x4E>(v)); v = fmaxf(v, dppf<0x141>(v)); v = fmaxf(v, dppf<0x140>(v));
  { auto r = __builtin_amdgcn_permlane16_swap(__float_as_uint(v), __float_as_uint(v), false, false); v = fmaxf(__uint_as_float(r[0]), __uint_as_float(r[1])); }
  { auto r = __builtin_amdgcn_permlane32_swap(__float_as_uint(v), __float_as_uint(v), false, false); v = fmaxf(__uint_as_float(r[0]), __uint_as_float(r[1])); }
  return v;
}
__device__ __forceinline__ int ltid() { int t = threadIdx.x; asm volatile("" : "+v"(t)); return t; }
__device__ __forceinline__ float silu_f(float x) { return x / (1.f + __expf(-x)); }
__device__ __forceinline__ float2 cmul(float2 a, float2 b) { return make_float2(a.x * b.x - a.y * b.y, a.x * b.y + a.y * b.x); }
__device__ __forceinline__ float2 cmulc(float2 a, float2 b) { return make_float2(a.x * b.x + a.y * b.y, a.y * b.x - a.x * b.y); }
__device__ __forceinline__ int modv(int tok) { return tok < TL ? (tok >> 14) : 2; }
__device__ __forceinline__ void phase_tables(const Params& p, int bid, int nb) {
  const int gt = bid * NTHR + ltid(), gs = nb * NTHR;
  for (int i = gt; i < SEQ * 16; i += gs) {
    const int t = i >> 4, f = i & 15;
    const float pos = (f < 8) ? (float)(t >> 6) : (float)(t & 63);
    const float inv = powf(10000.f, -(float)(f & 7) / 8.f);
    float s, c; sincosf(pos * inv, &s, &c);
    p.ropec()[i] = c; p.ropes()[i] = s;
  }
  for (int i = gt; i < FM; i += gs) {
    float s, c; sincospif((float)i / 8192.f, &s, &c);
    p.tw()[i] = make_float2(c, -s);
  }
}

__device__ __forceinline__ void phase_mod(const Params& p, int bid, int nb, char* lds) {
  float* red = (float*)lds;
  const int tid = ltid(), part = tid >> 6, cl = tid & 63;
  for (int it = bid; it < 2 * 96; it += nb) {
    const int l = it / 96, n = (it % 96) * 64 + cl;
    const float* W = p.ada_w() + (size_t)l * DM * 6144;
    float a0 = 0, a1 = 0, a2 = 0;
    for (int k = part * 128; k < part * 128 + 128; ++k) {
      const float w = W[(size_t)k * 6144 + n];
      a0 += silu_f(p.c()[k]) * w; a1 += silu_f(p.c()[DM + k]) * w; a2 += silu_f(p.c_ctx()[k]) * w;
    }
    red[(part * 3 + 0) * 64 + cl] = a0; red[(part * 3 + 1) * 64 + cl] = a1; red[(part * 3 + 2) * 64 + cl] = a2;
    __syncthreads();
    if (tid < 192) {
      const int v = tid >> 6; float s = 0;
      for (int q = 0; q < 8; ++q) s += red[(q * 3 + v) * 64 + cl];
      p.mod()[((size_t)l * 3 + v) * 6144 + n] = s + p.ada_b()[(size_t)l * 6144 + n];
    }
    __syncthreads();
  }
}

__device__ __forceinline__ void phase_fold(const Params& p, int bid, int nb, char* lds) {
  float* wrow = (float*)lds;
  float* dre = wrow + 2048;
  float* dim_ = dre + 2048;
  float* glr = dim_ + 2048;
  float* cst = glr + 256;
  float* snt = cst + 256;
  const int tid = ltid();
  if (tid < 256) { float sn, cs; sincospif((float)tid / 128.f, &sn, &cs); cst[tid] = cs; snt[tid] = sn; }
  __syncthreads();
  for (int it = bid; it < 2 * DM / 8; it += nb) {
    const int l = it >> 7, k0 = (it & 127) * 8;
    for (int i = tid; i < 8 * 256; i += NTHR) { const int r = i >> 8, c = i & 255; wrow[c * 8 + r] = p.w_in()[((size_t)l * DM + k0 + r) * DIN0 + 1984 + c]; }
    if (tid < 256) { const int r = tid >> 5, c = tid & 31; glr[c * 8 + r] = p.w_in()[((size_t)l * DM + k0 + r) * DIN0 + 1696 + c]; }
    __syncthreads();
    {
      const int kp = tid & 255; const bool im = tid >= 256;
      float acc[8] = {0.f, 0.f, 0.f, 0.f, 0.f, 0.f, 0.f, 0.f};
#pragma unroll 4
      for (int c = 0; c < 256; ++c) {
        const int m = (c * kp) & 255; const float t = im ? -snt[m] : cst[m];
        const float4 w0 = *(const float4*)(wrow + c * 8), w1 = *(const float4*)(wrow + c * 8 + 4);
        acc[0] += w0.x * t; acc[1] += w0.y * t; acc[2] += w0.z * t; acc[3] += w0.w * t; acc[4] += w1.x * t; acc[5] += w1.y * t; acc[6] += w1.z * t; acc[7] += w1.w * t;
      }
      float* d = (im ? dim_ : dre) + kp * 8;
      *(float4*)d = make_float4(acc[0], acc[1], acc[2], acc[3]); *(float4*)(d + 4) = make_float4(acc[4], acc[5], acc[6], acc[7]);
    }
    __syncthreads();
    {
      const int j = tid & 255; const bool im = tid >= 256;
      const float* Wf = p.fnet_w() + (size_t)l * 65536 + j;
      const float* d = im ? dim_ : dre;
      float acc[8] = {0.f, 0.f, 0.f, 0.f, 0.f, 0.f, 0.f, 0.f};
#pragma unroll 8
      for (int kp = 0; kp < 256; ++kp) {
        const float w = Wf[kp * 256];
        const float4 d0 = *(const float4*)(d + kp * 8), d1 = *(const float4*)(d + kp * 8 + 4);
        acc[0] += d0.x * w; acc[1] += d0.y * w; acc[2] += d0.z * w; acc[3] += d0.w * w; acc[4] += d1.x * w; acc[5] += d1.y * w; acc[6] += d1.z * w; acc[7] += d1.w * w;
      }
      float* o = p.btf() + ((size_t)l * NIN + (im ? 2560 : 2304) + j) * DM + k0;
      *(float4*)o = make_float4(acc[0] * 0.0625f, acc[1] * 0.0625f, acc[2] * 0.0625f, acc[3] * 0.0625f);
      *(float4*)(o + 4) = make_float4(acc[4] * 0.0625f, acc[5] * 0.0625f, acc[6] * 0.0625f, acc[7] * 0.0625f);
    }
    if (tid < 256) {
      const int dir = tid >> 7, kk = tid & 127;
      const float* gw = p.gla_gk_w() + ((size_t)l * 2 + dir) * 16 * 128 + kk;
      float acc[8] = {0.f, 0.f, 0.f, 0.f, 0.f, 0.f, 0.f, 0.f};
#pragma unroll
      for (int r16 = 0; r16 < 16; ++r16) {
        const float w = gw[r16 * 128];
        const float4 g0 = *(const float4*)(glr + (dir * 16 + r16) * 8), g1 = *(const float4*)(glr + (dir * 16 + r16) * 8 + 4);
        acc[0] += g0.x * w; acc[1] += g0.y * w; acc[2] += g0.z * w; acc[3] += g0.w * w; acc[4] += g1.x * w; acc[5] += g1.y * w; acc[6] += g1.z * w; acc[7] += g1.w * w;
      }
      float* o = p.btf() + ((size_t)l * NIN + 1024 + tid) * DM + k0;
      *(float4*)o = make_float4(acc[0], acc[1], acc[2], acc[3]); *(float4*)(o + 4) = make_float4(acc[4], acc[5], acc[6], acc[7]);
    }
    __syncthreads();
  }
}

enum { MAP_ID = 0, MAP_IN = 1, MAP_UQ = 2, MAP_UKV = 3, MAP_GU = 4 };
__device__ __forceinline__ int colmap(int mt, int n) {
  switch (mt) {
    case MAP_ID: return n;
    case MAP_IN:
      if (n < 256) return n;
      if (n < 384) return 256 + (n - 256);
      if (n < 512) return 1184 + (n - 384);
      if (n < 640) return 1312 + (n - 512);
      if (n < 672) return 384 + (n - 640);
      if (n < 768) return -1;
      if (n < 1024) return 1440 + (n - 768);
      if (n < 1280) return -2;
      if (n < 1536) return 1728 + (n - 1280);
      if (n < 2304) return 416 + (n - 1536);
      return -2;
    case MAP_UQ:
      if (n < 256) return (n >> 6) * 96 + (n & 63);
      if (n < 384) return ((n - 256) >> 5) * 96 + 64 + ((n - 256) & 31);
      return -1;
    case MAP_UKV:
      if (n < 256) return (n >> 6) * 128 + (n & 63);
      return ((n - 256) >> 6) * 128 + 64 + ((n - 256) & 63);
    default: {
      const int pn = n >> 8, w = n & 255;
      return w < 128 ? 2 * (pn * 128 + w) : 2 * (pn * 128 + w - 128) + 1;
    }
  }
}
__device__ __forceinline__ int invmap(int mt, int sc) {
  if (mt == MAP_ID) return sc;
  if (mt == MAP_GU) { const int j = sc >> 1, t = sc & 1; return (j >> 7) * 256 + t * 128 + (j & 127); }
  if (sc < 384) return sc;
  if (sc < 416) return 640 + (sc - 384);
  if (sc < 1184) return 1536 + (sc - 416);
  if (sc < 1312) return 384 + (sc - 1184);
  if (sc < 1440) return 512 + (sc - 1312);
  if (sc < 1696) return 768 + (sc - 1440);
  if (sc < 1728) return -1;
  if (sc < 1984) return 1280 + (sc - 1728);
  return -1;
}
struct ConvJob { const float* src; void* dst; const float* scale; int ld, K, mt, k0, s0, f32; };
__device__ __forceinline__ void conv_tile_load(const ConvJob& J, int tid, float4 (&v)[4]) {
  const int kk = tid >> 5, s4 = (tid & 31) * 4;
#pragma unroll
  for (int i = 0; i < 4; ++i) {
    v[i] = make_float4(0.f, 0.f, 0.f, 0.f);
    if (J.s0 + s4 < J.ld) v[i] = *(const float4*)(J.src + (size_t)(J.k0 + kk + 16 * i) * J.ld + J.s0 + s4);
  }
}
__device__ __forceinline__ void conv_tile_proc(const ConvJob& J, int tid, const float4 (&v)[4], float* tile  ) {
  {
    const int kk = tid >> 5, s4 = (tid & 31) * 4;
#pragma unroll
    for (int i = 0; i < 4; ++i) {
      const float sc = J.scale ? J.scale[J.k0 + kk + 16 * i] : 1.f;
      float* t = tile + (kk + 16 * i) * 129 + s4;
      t[0] = v[i].x * sc; t[1] = v[i].y * sc; t[2] = v[i].z * sc; t[3] = v[i].w * sc;
    }
  }
  __syncthreads();
#pragma unroll
  for (int h = 0; h < 2; ++h) {
    const int sl = (tid >> 3) + 64 * h, ks = (tid & 7) * 8, sc = J.s0 + sl;
    const int row = sc < J.ld ? invmap(J.mt, sc) : -1;
    if (row >= 0) {
      const float* t = tile + ks * 129 + sl;
      if (J.f32) {
        float* dst = (float*)J.dst + (size_t)row * J.K + J.k0 + ks;
        *(float4*)dst = make_float4(t[0], t[129], t[2 * 129], t[3 * 129]); *(float4*)(dst + 4) = make_float4(t[4 * 129], t[5 * 129], t[6 * 129], t[7 * 129]);
      } else {
        u32x4 w;
        w[0] = cvtpk(t[0], t[129]); w[1] = cvtpk(t[2 * 129], t[3 * 129]); w[2] = cvtpk(t[4 * 129], t[5 * 129]); w[3] = cvtpk(t[6 * 129], t[7 * 129]);
        *(u32x4*)((u16*)J.dst + (size_t)row * J.K + J.k0 + ks) = w;
      }
    }
  }
  __syncthreads();
}
constexpr int CT_IN = 16 * 18, CT_OUT = 16 * 8, CT_DN = NE * 128, CT_L = CT_IN + CT_OUT + CT_DN;
constexpr int CT_DEF0 = CT_L + CT_IN + CT_OUT, CT_NDEF = CT_DN, CT_NDEF_C = 8 * 248, CT_TAILCAP = 12;
__device__ __forceinline__ int conv_tmap(int t) { return t < CT_DEF0 ? t : t + CT_NDEF; }
__device__ __forceinline__ void conv_decode(const Params& p, int t, ConvJob& J) {
  const int l = t / CT_L; int r = t % CT_L;
  if (r < CT_IN) { J.src = p.w_in() + (size_t)l * DM * DIN0; J.ld = DIN0; J.K = DM; J.dst = p.btf() + (size_t)l * NIN * DM; J.mt = MAP_IN; J.scale = nullptr; J.k0 = (r / 18) * 64; J.s0 = (r % 18) * 128; J.f32 = 1; return; }
  r -= CT_IN;
  if (r < CT_OUT) { J.src = p.w_out() + (size_t)l * DM * DM; J.ld = DM; J.K = DM; J.dst = p.bt_out() + (size_t)l * DM * DM; J.mt = MAP_ID; J.scale = p.mix_g() + l * DM; J.k0 = (r / 8) * 64; J.s0 = (r % 8) * 128; J.f32 = 0; return; }
  r -= CT_OUT;
  const int e = r >> 7, q = r & 127;
  J.src = p.moe_w_down() + ((size_t)l * NE + e) * DFF * DM; J.ld = DM; J.K = DFF; J.dst = p.bt_dn() + ((size_t)l * NE + e) * DM * DFF; J.mt = MAP_ID; J.scale = nullptr; J.k0 = (q >> 3) * 64; J.s0 = (q & 7) * 128; J.f32 = 0;
}
__device__ __forceinline__ void conv_gu8_load(const float* __restrict__ src  , int s0, int tid, float4 (&v)[16]) {
  const int c4 = (tid & 7) * 4, r0 = tid >> 3;
#pragma unroll
  for (int pss = 0; pss < 16; ++pss) v[pss] = *(const float4*)(src + (size_t)(r0 + 64 * pss) * 2048 + s0 + c4);
}
__device__ __forceinline__ void conv_gu8_proc(const float4 (&v)[16], signed char* __restrict__ dst  , float* __restrict__ sw  ,
                                              int s0, float* tile  , int tid) {
  float* cmax = tile + 1024 * 33;
  {
    const int c4 = (tid & 7) * 4, r0 = tid >> 3;
#pragma unroll
    for (int pss = 0; pss < 16; ++pss) { float* t = tile + (r0 + 64 * pss) * 33 + c4; t[0] = v[pss].x; t[1] = v[pss].y; t[2] = v[pss].z; t[3] = v[pss].w; }
  }
  __syncthreads();
  {
    const int col = tid & 31, part = tid >> 5; float m = 0.f;
#pragma unroll 8
    for (int k = part * 64; k < part * 64 + 64; ++k) m = fmaxf(m, fabsf(tile[k * 33 + col]));
    cmax[part * 32 + col] = m;
  }
  __syncthreads();
  if (tid < 32) {
    float m = 0.f;
#pragma unroll
    for (int q = 0; q < 16; ++q) m = fmaxf(m, cmax[q * 32 + tid]);
    const float sc = fmaxf(m, 1e-20f) * (1.f / 127.f);
    cmax[512 + tid] = sc;
    sw[invmap(MAP_GU, s0 + tid)] = sc;
  }
  __syncthreads();
#pragma unroll
  for (int h = 0; h < 4; ++h) {
    const int g = tid + 512 * h, col = g & 31, k0 = (g >> 5) * 16;
    const float inv = 1.f / cmax[512 + col];
    unsigned w[4];
#pragma unroll
    for (int q = 0; q < 4; ++q) {
      const float* t = tile + (k0 + 4 * q) * 33 + col;
      const int q0 = (int)rintf(t[0] * inv), q1 = (int)rintf(t[33] * inv), q2 = (int)rintf(t[66] * inv), q3 = (int)rintf(t[99] * inv);
      w[q] = (unsigned)(q0 & 255) | ((unsigned)(q1 & 255) << 8) | ((unsigned)(q2 & 255) << 16) | ((unsigned)(q3 & 255) << 24);
    }
    *(u32x4*)(dst + (size_t)invmap(MAP_GU, s0 + col) * DM + k0) = u32x4{w[0], w[1], w[2], w[3]};
  }
  __syncthreads();
}
__device__ __forceinline__ void gu8_deferred(const Params& p, int bid_, int k0, int nk, int kx, int gemm_slot, char* lds) {
  int bid;
  if (gemm_slot) { if ((bid_ & 7) == 0 && bid_ < 64) return; bid = bid_ - min((bid_ + 7) >> 3, 8) + 8; }
  else { if (bid_ < 8) return; bid = bid_; }
  float* tile = (float*)lds; const int tid = ltid();
  __syncthreads();
  float4 v[16], vn[16];
  const int ntot = nk + (kx >= 0 ? 1 : 0);
  int j = 0, sidx = k0 * 248 + (bid - 8);
  if (sidx < NE * 64) { const int t = NE * 64 + sidx; conv_gu8_load(p.moe_w_gu() + (size_t)(t >> 6) * DM * 2048, (t & 63) * 32, tid, v); }
  while (j < ntot && sidx < NE * 64) {
    const int jn = j + 1, sn = (jn < nk ? k0 + jn : kx) * 248 + (bid - 8);
    const bool more = jn < ntot && sn < NE * 64;
    if (more) { const int tn = NE * 64 + sn; conv_gu8_load(p.moe_w_gu() + (size_t)(tn >> 6) * DM * 2048, (tn & 63) * 32, tid, vn); }
    const int t = NE * 64 + sidx;
    conv_gu8_proc(v, p.bt_gu() + (size_t)(t >> 6) * 2048 * DM, p.swgu() + (size_t)(t >> 6) * 2048, (t & 63) * 32, tile, tid);
    if (more) {
#pragma unroll
      for (int i = 0; i < 16; ++i) v[i] = vn[i]; }
    j = jn; sidx = more ? sn : NE * 64;
  }
}
__device__ __forceinline__ void dn_deferred(const Params& p, int bid_, char* lds) {
  if ((bid_ & 7) == 0 && bid_ < 64) return;
  const int rank = bid_ - min((bid_ + 7) >> 3, 8);
  float* tile = (float*)lds; const int tid = ltid();
  __syncthreads();
  ConvJob J, Jn; float4 v[4], vn[4];
  conv_decode(p, CT_DEF0 + rank, J); conv_tile_load(J, tid, v);
  for (int j = 0; j < 8; ++j) {
    const bool more = j + 1 < 8;
    if (more) { conv_decode(p, CT_DEF0 + rank + 248 * (j + 1), Jn); conv_tile_load(Jn, tid, vn); }
    conv_tile_proc(J, tid, v, tile);
    if (more) { J = Jn;
#pragma unroll
      for (int i = 0; i < 4; ++i) v[i] = vn[i]; }
  }
}
__device__ __forceinline__ void conv_tiles_strided(const Params& p, int first, int start, int step, int nmax, int count, char* lds) {
  float* tile = (float*)lds; const int tid = ltid();
  __syncthreads();
  ConvJob J, Jn; float4 v[4], vn[4];
  int idx = start, n = 0;
  if (idx < count && n < nmax) { conv_decode(p, first + idx, J); conv_tile_load(J, tid, v); }
  while (idx < count && n < nmax) {
    const int nx = idx + step; const bool more = nx < count && n + 1 < nmax;
    if (more) { conv_decode(p, first + nx, Jn); conv_tile_load(Jn, tid, vn); }
    conv_tile_proc(J, tid, v, tile);
    if (more) { J = Jn;
#pragma unroll
      for (int i = 0; i < 4; ++i) v[i] = vn[i]; }
    idx = nx; ++n;
  }
}
__device__ __forceinline__ int dn_tail_rem(const Params& p) {
  int U = 0;
  for (int e = 0; e < NE; ++e) U += ((p.cnt()[e] + 255) >> 8) * 4;
  const int R = (U + 255) >> 8;
  return U - ((R - 1) << 8);
}
__device__ __forceinline__ void dn_tail_fill(const Params& p, int bid, char* lds) {
  const int rem = dn_tail_rem(p), off = (bid & 7) * 32 + (bid >> 3), E = 256 - rem;
  if (off < rem) return;
  conv_tiles_strided(p, CT_DEF0 + CT_NDEF_C, off - rem, E, CT_TAILCAP, CT_DN - CT_NDEF_C, lds);
}
constexpr int IN_REM = (TT / 256) * (NIN / 256) - 5 * 256, IN_EARLY = 256 - IN_REM, IN_CAP = 4;
__device__ __forceinline__ void dn_tail_rest_in(const Params& p, int bid, char* lds) {
  const int off = (bid & 7) * 32 + (bid >> 3);
  if (off < IN_REM) return;
  const int rem = dn_tail_rem(p), E = 256 - rem, T = CT_DN - CT_NDEF_C;
  const int done = min(E * CT_TAILCAP, T);
  conv_tiles_strided(p, CT_DEF0 + CT_NDEF_C, done + (off - IN_REM), IN_EARLY, IN_CAP, T, lds);
}
__device__ __forceinline__ void dn_tail_rest(const Params& p, int bid, int nb, char* lds) {
  const int rem = dn_tail_rem(p), E = 256 - rem, T = CT_DN - CT_NDEF_C;
  const int done = min(min(E * CT_TAILCAP, T) + IN_EARLY * IN_CAP, T);
  conv_tiles_strided(p, CT_DEF0 + CT_NDEF_C, done + bid, nb, 1 << 20, T, lds);
}
__device__ __forceinline__ void phase_convert(const Params& p, int bid, int nb, char* lds) {
  float* tile = (float*)lds;
  const int tid = ltid();
  {
    ConvJob J, Jn; float4 v[4], vn[4];
    int t = bid;
    constexpr int NT = 2 * CT_L - CT_NDEF;
    if (t < NT) { conv_decode(p, conv_tmap(t), J); conv_tile_load(J, tid, v); }
    for (; t < NT; t += nb) {
      const bool more = t + nb < NT;
      if (more) { conv_decode(p, conv_tmap(t + nb), Jn); conv_tile_load(Jn, tid, vn); }
      conv_tile_proc(J, tid, v, tile);
      if (more) { J = Jn;
#pragma unroll
        for (int i = 0; i < 4; ++i) v[i] = vn[i]; }
    }
  }
  {
    float4 v[16], vn[16];
    int t = bid;
    if (t < NE * 64) conv_gu8_load(p.moe_w_gu() + (size_t)(t >> 6) * DM * 2048, (t & 63) * 32, tid, v);
    for (; t < NE * 64; t += nb) {
      const bool more = t + nb < NE * 64; const int tn = t + nb;
      if (more) conv_gu8_load(p.moe_w_gu() + (size_t)(tn >> 6) * DM * 2048, (tn & 63) * 32, tid, vn);
      conv_gu8_proc(v, p.bt_gu() + (size_t)(t >> 6) * 2048 * DM, p.swgu() + (size_t)(t >> 6) * 2048, (t & 63) * 32, tile, tid);
      if (more) {
#pragma unroll
        for (int i = 0; i < 16; ++i) v[i] = vn[i]; }
    }
  }
  for (int l = 0; l < 2; ++l) {
    for (int i = bid * NTHR + tid; i < 96 * DM / 4; i += nb * NTHR) *(float4*)(p.btf() + ((size_t)l * NIN + 672) * DM + (size_t)i * 4) = make_float4(0.f, 0.f, 0.f, 0.f);
    {
      const float* wq = p.mla_w_uq() + (size_t)l * 256 * 384; const float* wkv = p.mla_w_ukv() + (size_t)l * 128 * 512;
      const float* gq = p.mla_q_g() + l * 256; const float* gkv = p.mla_kv_g() + l * 128;
      u16* dst = p.bt_qkv() + (size_t)l * 1024 * 384;
      for (int i = bid * NTHR + ltid(); i < 1024 * 384; i += nb * NTHR) {
        const int n = i / 384, k = i % 384; float v = 0.f;
        if (n < 512) { const int sc = colmap(MAP_UQ, n); if (k < 256 && sc >= 0) v = gq[k] * wq[k * 384 + sc]; }
        else { if (k >= 256) v = gkv[k - 256] * wkv[(k - 256) * 512 + colmap(MAP_UKV, n - 512)]; }
        dst[i] = f2bf(v);
      }
    }
  }
}

__device__ __forceinline__ void phase_hy_mlp(const Params& p, int l, int Lf, float* __restrict__ hout  , float* __restrict__ ssq  ,
                             int bid, int nb, char* lds, const int nsplit = 1) {
  float* zf = (float*)lds;
  float* h1 = zf + 64 * 33;
  float* h2 = h1 + 64 * 64;
  const int tid = ltid();
  const float* w1 = p.hy_w1() + (size_t)l * 33 * 64; const float* b1 = p.hy_b1() + l * 64;
  const float* w2 = p.hy_w2() + (size_t)l * 64 * 64; const float* b2 = p.hy_b2() + l * 64;
  const float* w3 = p.hy_w3() + (size_t)l * 64 * 512; const float* fr = p.hy_freq() + l * 64;
  typedef float f2m __attribute__((ext_vector_type(2)));
  f2m w3p[32];
#pragma unroll
  for (int k = 0; k < 32; ++k) w3p[k] = f2m{w3[(2 * k) * 512 + tid], w3[(2 * k + 1) * 512 + tid]};
  const int dir = tid >> 8, ch = tid & 255;
  const float maxd = logf(1e-2f) / 0.3f, mind = logf(1e-2f) / 1.5f;
  const float delta = fabsf(mind + (maxd - mind) * (float)ch / 255.f);
  float ssq_acc = 0.f;
  for (int it = bid; it < (Lf / 64) * nsplit; it += nb) {
    const int t0 = (it / nsplit) * 64, tq0 = (it % nsplit) * (16 / nsplit), tq1 = tq0 + 16 / nsplit;
    for (int i = tid; i < 64 * 33; i += NTHR) {
      const int tt = i / 33, f = i % 33, t = t0 + tt;
      float v;
      if (f == 0) v = (float)t / (float)(Lf - 1);
      else {
        const int j = (f - 1) & 15;
        const float fj = 1e-4f + (float)j * ((15.f - 1e-4f) / 15.f);
        const float w = 6.283185307179586f * (float)t / (float)Lf;
        v = (f <= 16) ? cosf(fj * w) : -sinf(fj * w);
      }
      zf[i] = v;
    }
    __syncthreads();
    {
      const int o = tid & 63, tb = tid >> 6;
      float acc[8];
#pragma unroll
      for (int j = 0; j < 8; ++j) acc[j] = b1[o];
#pragma unroll 3
      for (int f = 0; f < 33; ++f) {
        const float w = w1[f * 64 + o];
#pragma unroll
        for (int j = 0; j < 8; ++j) acc[j] += zf[(tb + 8 * j) * 33 + f] * w;
      }
      const float fo = fr[o];
#pragma unroll
      for (int j = 0; j < 8; ++j) h1[(tb + 8 * j) * 64 + o] = sinf(fo * acc[j]);
    }
    __syncthreads();
    {
      const int o = tid & 63, tb = tid >> 6;
      f2m acc[8];
#pragma unroll
      for (int j = 0; j < 8; ++j) acc[j] = f2m{b2[o], 0.f};
#pragma unroll 4
      for (int f = 0; f < 64; f += 4) {
        const f2m wab = f2m{w2[f * 64 + o], w2[(f + 1) * 64 + o]}, wcd = f2m{w2[(f + 2) * 64 + o], w2[(f + 3) * 64 + o]};
#pragma unroll
        for (int j = 0; j < 8; ++j) { const float4 hv = *(const float4*)(h1 + (tb + 8 * j) * 64 + f); acc[j] += f2m{hv.x, hv.y} * wab; acc[j] += f2m{hv.z, hv.w} * wcd; }
      }
      const float fo = fr[o];
#pragma unroll
      for (int j = 0; j < 8; ++j) h2[(tb + 8 * j) * 64 + o] = sinf(fo * (acc[j][0] + acc[j][1]));
    }
    __syncthreads();
    float* orow = hout + ((size_t)dir * 256 + ch) * Lf + t0;
    for (int tq = tq0; tq < tq1; ++tq) {
      float sv[4];
#pragma unroll
      for (int u = 0; u < 4; ++u) {
        const int tt = tq * 4 + u;
        f2m s2 = f2m{0.f, 0.f};
#pragma unroll
        for (int k = 0; k < 64; k += 4) { const float4 hv = *(const float4*)(h2 + tt * 64 + k); s2 += f2m{hv.x, hv.y} * w3p[k >> 1]; s2 += f2m{hv.z, hv.w} * w3p[(k >> 1) + 1]; }
        float s = s2[0] + s2[1];
        const int t = t0 + tt;
        s *= __expf(-((float)t / (float)(Lf - 1)) * delta);
        if (dir == 0 || t > 0) ssq_acc += s * s;
        sv[u] = s;
      }
      *(float4*)(orow + tq * 4) = make_float4(sv[0], sv[1], sv[2], sv[3]);
    }
    __syncthreads();
  }
  ssq[(size_t)bid * 512 + tid] = ssq_acc;
}

__host__ __device__ constexpr int fx(int p) {
  return ((p >> 12) & 3) ^ (((p >> 10) & 3) << 2) ^ ((p >> 4) & 16) ^ (((p >> 5) & 1) * 5) ^ (((p >> 6) & 1) * 26);
}
__device__ __forceinline__ int swz(int p) { return p ^ fx(p); }
__device__ __forceinline__ int rev7(int k) {
  unsigned r = __brev((unsigned)k) >> 18;
  return (int)(((r & 0x2AAAu) >> 1) | ((r & 0x1555u) << 1));
}
template <int ST, bool INV>
__device__ __forceinline__ void fft_stage(float2* s, const float2* __restrict__ tw, const int tid) {
  constexpr int sh = 12 - 2 * ST, q = 1 << sh, ND = q >= 512 ? q / 512 : 1;
  float2 w1[ND], w2[ND], w3[ND];
  if constexpr (ST < 6) {
#pragma unroll
    for (int d = 0; d < ND; ++d) {
      const int j = q >= 512 ? tid + 512 * d : (tid & (q - 1)), ti = j << (2 * ST);
      w1[d] = tw[ti]; w2[d] = tw[2 * ti]; w3[d] = tw[3 * ti];
    }
  }
  float2 x[8][4];
#pragma unroll
  for (int m = 0; m < 8; ++m) {
    const int u = tid + 512 * m, g = u >> sh, j = u & (q - 1), base = (g << (sh + 2)) + j, xb = fx(base);
    x[m][0] = s[base ^ xb]; x[m][1] = s[(base + q) ^ xb ^ fx(q)]; x[m][2] = s[(base + 2 * q) ^ xb ^ fx(2 * q)]; x[m][3] = s[(base + 3 * q) ^ xb ^ fx(3 * q)];
  }
#pragma unroll
  for (int m = 0; m < 8; ++m) {
    const int u = tid + 512 * m, g = u >> sh, j = u & (q - 1), base = (g << (sh + 2)) + j, xb = fx(base);
    const int i0 = base ^ xb, i1 = (base + q) ^ xb ^ fx(q), i2 = (base + 2 * q) ^ xb ^ fx(2 * q), i3 = (base + 3 * q) ^ xb ^ fx(3 * q);
    const int d = q >= 512 ? (m % ND) : 0;
    if constexpr (!INV) {
      const float2 a0 = x[m][0], a1 = x[m][1], a2 = x[m][2], a3 = x[m][3];
      const float2 b0 = make_float2(a0.x + a2.x, a0.y + a2.y), b1 = make_float2(a0.x - a2.x, a0.y - a2.y);
      const float2 b2 = make_float2(a1.x + a3.x, a1.y + a3.y), b3 = make_float2(a1.x - a3.x, a1.y - a3.y);
      const float2 y1 = make_float2(b1.x + b3.y, b1.y - b3.x), y2 = make_float2(b0.x - b2.x, b0.y - b2.y), y3 = make_float2(b1.x - b3.y, b1.y + b3.x);
      s[i0] = make_float2(b0.x + b2.x, b0.y + b2.y);
      if constexpr (ST < 6) { s[i1] = cmul(y1, w1[d]); s[i2] = cmul(y2, w2[d]); s[i3] = cmul(y3, w3[d]); }
      else { s[i1] = y1; s[i2] = y2; s[i3] = y3; }
    } else {
      float2 t0 = x[m][0], t1 = x[m][1], t2 = x[m][2], t3 = x[m][3];
      if constexpr (ST < 6) { t1 = cmulc(t1, w1[d]); t2 = cmulc(t2, w2[d]); t3 = cmulc(t3, w3[d]); }
      const float2 b0 = make_float2(t0.x + t2.x, t0.y + t2.y), b1 = make_float2(t0.x - t2.x, t0.y - t2.y);
      const float2 b2 = make_float2(t1.x + t3.x, t1.y + t3.y), b3 = make_float2(t1.x - t3.x, t1.y - t3.y);
      s[i0] = make_float2(b0.x + b2.x, b0.y + b2.y);
      s[i1] = make_float2(b1.x - b3.y, b1.y + b3.x);
      s[i2] = make_float2(b0.x - b2.x, b0.y - b2.y);
      s[i3] = make_float2(b1.x + b3.y, b1.y - b3.x);
    }
  }
  __syncthreads();
}
__device__ __forceinline__ void fft_fwd(float2* s, const float2* __restrict__ tw) {
  const int tid = ltid();
  fft_stage<0, false>(s, tw, tid); fft_stage<1, false>(s, tw, tid); fft_stage<2, false>(s, tw, tid); fft_stage<3, false>(s, tw, tid);
  fft_stage<4, false>(s, tw, tid); fft_stage<5, false>(s, tw, tid); fft_stage<6, false>(s, tw, tid);
}
__device__ __forceinline__ void fft_inv(float2* s, const float2* __restrict__ tw) {
  const int tid = ltid();
  fft_stage<6, true>(s, tw, tid); fft_stage<5, true>(s, tw, tid); fft_stage<4, true>(s, tw, tid); fft_stage<3, true>(s, tw, tid);
  fft_stage<2, true>(s, tw, tid); fft_stage<1, true>(s, tw, tid); fft_stage<0, true>(s, tw, tid);
}

__device__ __forceinline__ float filt_ssq(const float* __restrict__ part  , int ch, float* red  ) {
  const int tid = ltid();
  float v = part[(size_t)(tid >> 1) * 512 + (tid & 1) * 256 + ch];
  v = wave_sum(v);
  __syncthreads();
  if ((tid & 63) == 0) red[tid >> 6] = v;
  __syncthreads();
  return ((red[0] + red[1]) + (red[2] + red[3])) + ((red[4] + red[5]) + (red[6] + red[7]));
}
__device__ __forceinline__ void phase_hy_filtfft(const Params& p, int bid, int nb, char* lds) {
  float2* s = (float2*)lds;
  const int tid = ltid();
  for (int it = bid; it < 512; it += nb) {
    const int l = it >> 8, ch = it & 255;
    const float* hf = p.hfb() + (((size_t)l * 2 + 0) * 256 + ch) * SEQ;
    const float* hb = p.hfb() + (((size_t)l * 2 + 1) * 256 + ch) * SEQ;
#pragma unroll 8
    for (int m = tid; m < FM; m += NTHR) {
      const int n0 = 2 * m, n1 = 2 * m + 1;
      const float a = (n0 < SEQ) ? hf[n0] : (n0 == SEQ ? 0.f : hb[2 * SEQ - n0]);
      const float b = (n1 < SEQ) ? hf[n1] : hb[2 * SEQ - n1];
      s[swz(m)] = make_float2(a, b);
    }
    __syncthreads();
    fft_fwd(s, p.tw());
    const float sc = rsqrtf(filt_ssq(p.hpart() + (size_t)l * 256 * 512, ch, (float*)(lds + 139264))) * (1.f / 16384.f);
    float4* out = p.hspec() + ((size_t)l * 256 + ch) * HSP;
#pragma unroll 4
    for (int k = tid; k <= FM / 2; k += NTHR) {
      const float2 zk = s[swz(rev7(k))], zm = s[swz(rev7((FM - k) & (FM - 1)))];
      const float er = 0.5f * (zk.x + zm.x), ei = 0.5f * (zk.y - zm.y);
      const float dr = 0.5f * (zk.x - zm.x), di = 0.5f * (zk.y + zm.y);
      out[k] = make_float4(er * sc, ei * sc, di * sc, -dr * sc);
    }
    __syncthreads();
  }
}
constexpr int G_TILE_B = 256 * 64 * 2;
constexpr int G_STAGE_B = 2 * G_TILE_B;
constexpr int GEMM_LDS = 2 * G_STAGE_B;

__device__ __forceinline__ int lds_byte2(int r, int c) {
  const int st = (r >> 4) * 2 + (c >> 5), ob = (r & 15) * 64 + (c & 31) * 2;
  return st * 1024 + (ob ^ (((ob >> 9) & 1) << 5));
}
__device__ __forceinline__ void stage_rc2(int b, int& R, int& C) {
  const int st = b >> 10, sb = b & 1023, swz = sb ^ (((sb >> 9) & 1) << 5);
  R = (st >> 1) * 16 + (swz >> 6);
  C = (st & 1) * 32 + ((swz & 63) >> 1);
}
__device__ __forceinline__ void gemm_stage_coords(int (&sR)[4], int (&sC)[4]) {
  const int wid = ltid() >> 6, lane = ltid() & 63;
#pragma unroll
  for (int i = 0; i < 4; ++i) stage_rc2(wid * 1024 + i * 8192 + lane * 16, sR[i], sC[i]);
}

#define WAIT_V0() asm volatile("s_waitcnt vmcnt(0)" ::: "memory")

__device__ __forceinline__ void gemm256_core(const u16* const (&ap)[4], const u16* const (&bp)[4], int nt, char* shm, f32x4 (&acc)[8][4]) {
  const int tid = ltid(), wid = tid >> 6, lane = tid & 63, wr = wid >> 2, wc = wid & 3, fr = lane & 15, fq = lane >> 4;
#pragma unroll
  for (int m = 0; m < 8; ++m)
#pragma unroll
    for (int n = 0; n < 4; ++n) acc[m][n] = f32x4{0.f, 0.f, 0.f, 0.f};
#define G_SA(b) (shm + (b) * G_STAGE_B)
#define G_SB(b) (shm + (b) * G_STAGE_B + G_TILE_B)
#define G_STAGE(buf, kt) do { _Pragma("unroll") for (int i = 0; i < 4; ++i) {                                                   \
    __builtin_amdgcn_global_load_lds((const unsigned*)(ap[i] + (kt) * 64), (unsigned*)(G_SA(buf) + wid * 1024 + i * 8192), 16, 0, 0); \
    __builtin_amdgcn_global_load_lds((const unsigned*)(bp[i] + (kt) * 64), (unsigned*)(G_SB(buf) + wid * 1024 + i * 8192), 16, 0, 0); } } while (0)
  G_STAGE(0, 0); WAIT_V0(); __syncthreads();
#pragma unroll 1
  for (int t = 0; t < nt; ++t) {
    const int cur = t & 1;
    if (t + 1 < nt) G_STAGE(cur ^ 1, t + 1);
#pragma unroll
    for (int ks = 0; ks < 2; ++ks) {
      bf16x8 At[8], Bf[4];
#pragma unroll
      for (int m = 0; m < 8; ++m) At[m] = *(const bf16x8*)(G_SA(cur) + lds_byte2(wr * 128 + m * 16 + fr, ks * 32 + fq * 8));
#pragma unroll
      for (int n = 0; n < 4; ++n) Bf[n] = *(const bf16x8*)(G_SB(cur) + lds_byte2(wc * 64 + n * 16 + fr, ks * 32 + fq * 8));
#pragma unroll
      for (int m = 0; m < 8; ++m)
#pragma unroll
        for (int n = 0; n < 4; ++n) acc[m][n] = __builtin_amdgcn_mfma_f32_16x16x32_bf16(At[m], Bf[n], acc[m][n], 0, 0, 0);
      __builtin_amdgcn_sched_barrier(0);
    }
    WAIT_V0(); __syncthreads();
  }
#undef G_STAGE
}

#define LAS3 __attribute__((address_space(3)))
constexpr int G8_HTB = 128 * 64 * 2;
__device__ __forceinline__ int g8_perm32(int rho) { const int n = rho >> 4, i = rho & 15; return 8 * (i >> 2) + 4 * n + (i & 3); }
__device__ __forceinline__ int g8_lds_byte(int r, int c) { const int st = (r >> 4) * 2 + (c >> 5), rr = r & 15, cc = c & 31, ob = rr * 64 + cc * 2; return st * 1024 + (ob ^ (((ob >> 9) & 1) << 5)); }
__device__ __forceinline__ void g8_stage_rc(int b, int& R, int& C) { const int st = b / 1024, sb = b % 1024, swz = sb ^ (((sb >> 9) & 1) << 5); R = (st >> 1) * 16 + swz / 64; C = (st & 1) * 32 + (swz % 64) / 2; }
struct G8Unit { int pm, pn, e, ce, pre, ab; };
__device__ __forceinline__ void g8_cload(const float* __restrict__ src, float* dst) {
  __builtin_amdgcn_global_load_lds((const unsigned*)(src + (ltid() & 63) * 4), (LAS3 unsigned*)dst, 16, 0, 0);
}


template <bool I8> __device__ __forceinline__ typename std::conditional<I8, int __attribute__((ext_vector_type(4))), f32x4>::type
g8_mma(bf16x8 x, bf16x8 y, typename std::conditional<I8, int __attribute__((ext_vector_type(4))), f32x4>::type c) {
  if constexpr (I8) { typedef int v4i __attribute__((ext_vector_type(4))); return __builtin_amdgcn_mfma_i32_16x16x64_i8(*(v4i*)&x, *(v4i*)&y, c, 0, 0, 0); }
  else return __builtin_amdgcn_mfma_f32_16x16x32_bf16(x, y, c, 0, 0, 0);
}
typedef int i32x4 __attribute__((ext_vector_type(4)));
template <bool I8> struct G8Acc { typedef f32x4 T; };
template <> struct G8Acc<true> { typedef i32x4 T; };
template <bool I8, class Sched, class Epi>
__device__ __forceinline__ void gemm8_phase(char* lds_g, const char* Abase, const int Kb, const Sched& S, const Epi& E) {
    typedef typename G8Acc<I8>::T ACC;
    LAS3 unsigned char* lds = (LAS3 unsigned char*)lds_g;
    const int tid = ltid(), wid = __builtin_amdgcn_readfirstlane(tid >> 6), lane = tid & 63, wr = wid >> 2, wc = wid & 3, fr = lane & 15, fq = lane >> 4;
    const int nt = Kb / 128;
    int sRr[2], sCc[2]; unsigned voffB[2];
#pragma unroll
    for (int i = 0; i < 2; ++i) { g8_stage_rc(tid * 16 + i * 8192, sRr[i], sCc[i]); const int Rb = (sRr[i] & ~31) + g8_perm32(sRr[i] & 31); voffB[i] = (unsigned)(Rb * Kb) + (unsigned)sCc[i] * 2u; }
    const size_t kstep = 128;
    const size_t hstepB = (size_t)128 * Kb;
    const unsigned ldsw = (unsigned)wid * 1024u;
    const int aoff = g8_lds_byte(wr * 64 + fr, fq * 8), boff = g8_lds_byte(wc * 32 + fr, fq * 8);
#define G8_SA(b, h) (((b) * 2 + (h)) * G8_HTB)
#define G8_SB(b, h) ((4 + (b) * 2 + (h)) * G8_HTB)
#define G8_STAGE_B(bufoff, gbase) do { _Pragma("unroll") for (int _i = 0; _i < 2; ++_i) \
        __builtin_amdgcn_global_load_lds((const unsigned*)((const char*)(gbase) + voffB[_i]), (LAS3 unsigned*)(lds + (bufoff) + ldsw + _i * 8192), 16, 0, 0); } while (0)
#define G8_STAGE_A(bufoff, o0, o1) do { \
        __builtin_amdgcn_global_load_lds((const unsigned*)(Abase + (o0)), (LAS3 unsigned*)(lds + (bufoff) + ldsw), 16, 0, 0); \
        __builtin_amdgcn_global_load_lds((const unsigned*)(Abase + (o1)), (LAS3 unsigned*)(lds + (bufoff) + ldsw + 8192), 16, 0, 0); } while (0)
#define G8_LDA(dst, b, h) do { _Pragma("unroll") for (int m = 0; m < 4; ++m) _Pragma("unroll") for (int k = 0; k < 2; ++k) dst[m][k] = *(const LAS3 bf16x8*)(lds + G8_SA(b, h) + aoff + m * 2048 + k * 1024); } while (0)
#define G8_LDB(dst, b, h) do { _Pragma("unroll") for (int n = 0; n < 2; ++n) _Pragma("unroll") for (int k = 0; k < 2; ++k) dst[n][k] = *(const LAS3 bf16x8*)(lds + G8_SB(b, h) + boff + n * 2048 + k * 1024); } while (0)
#define G8_MMA(ai, bj, At, Bt) do { __builtin_amdgcn_s_setprio(1); _Pragma("unroll") for (int m = 0; m < 4; ++m) _Pragma("unroll") for (int n = 0; n < 2; ++n) _Pragma("unroll") for (int k = 0; k < 2; ++k) \
        acc[ai][bj][m][n] = g8_mma<I8>(Bt[n][k], At[m][k], acc[ai][bj][m][n]); __builtin_amdgcn_s_setprio(0); } while (0)
#define G8_WAIT_V(n) asm volatile("s_waitcnt vmcnt(" #n ")" ::: "memory")
#define G8_WAIT_L(n) asm volatile("s_waitcnt lgkmcnt(" #n ")" ::: "memory")
#define G8_BAR __builtin_amdgcn_s_barrier()
#define G8_SCHED __builtin_amdgcn_sched_barrier(0)
    G8Unit cur, nxt; int ui = 0;
    cur.e = 0; cur.pre = 0; cur.ab = 0;
    if (!S.next(0, cur, cur)) return;
    ACC acc[2][2][4][2];
#pragma unroll
    for (int a = 0; a < 2; ++a)
#pragma unroll
        for (int b = 0; b < 2; ++b)
#pragma unroll
            for (int m = 0; m < 4; ++m)
#pragma unroll
                for (int n = 0; n < 2; ++n) acc[a][b][m][n] = ACC{};
    bf16x8 At[4][2], B0[2][2], B1[2][2];
    float ep[8];
    unsigned va[2][2], vn[2][2];
#pragma unroll
    for (int h = 0; h < 2; ++h)
#pragma unroll
        for (int i = 0; i < 2; ++i) va[h][i] = S.a_off(cur, h * 128 + sRr[i]) + (unsigned)sCc[i] * 2u;
    const char* cB = S.b_ptr(cur);
    G8_STAGE_B(G8_SB(0, 0), cB); G8_STAGE_A(G8_SA(0, 0), va[0][0], va[0][1]); G8_STAGE_B(G8_SB(0, 1), cB + hstepB); G8_STAGE_A(G8_SA(0, 1), va[1][0], va[1][1]);
    if (wr == 1) G8_BAR;
    G8_WAIT_V(4); G8_BAR;
    G8_STAGE_B(G8_SB(1, 0), cB + kstep); G8_STAGE_A(G8_SA(1, 0), va[0][0] + kstep, va[0][1] + kstep); G8_STAGE_B(G8_SB(1, 1), cB + hstepB + kstep);
    G8_WAIT_V(6); G8_BAR;
    for (;;) {
        float* cb = (float*)(lds_g + 136192 + (ui & 1) * 3072);
        const int* rt = (const int*)(lds_g + 142336 + (ui & 1) * 1024);
        E.pre(cur, wr, fr, ep, cb);
        const bool has_next = S.next(ui + 1, nxt, cur);
        const char* nB = cB;
#pragma unroll
        for (int h = 0; h < 2; ++h)
#pragma unroll
            for (int i = 0; i < 2; ++i) vn[h][i] = va[h][i];
        int rlim = 0;
        if (has_next) {
            nB = S.b_ptr(nxt);
            if constexpr (Sched::GATHER) {
                if ((tid >> 6) == 3) S.rows_to_lds(nxt, (int*)rt);
                rlim = nxt.ce - 1 - nxt.pm * 256;
            } else {
#pragma unroll
                for (int h = 0; h < 2; ++h)
#pragma unroll
                    for (int i = 0; i < 2; ++i) vn[h][i] = S.a_off(nxt, h * 128 + sRr[i]) + (unsigned)sCc[i] * 2u;
            }
        }
#pragma unroll 1
        for (int t = 0; t < nt; t += 2) {
            const bool last = (t == nt - 2);
            const unsigned k1 = (unsigned)(t + 1) * 128u;
            const unsigned k2 = last ? 0u : (unsigned)(t + 2) * 128u;
            if constexpr (Sched::GATHER) {
                if (has_next) {
#pragma unroll
                    for (int h = 0; h < 2; ++h)
#pragma unroll
                        for (int i = 0; i < 2; ++i) vn[h][i] = (unsigned)rt[min(h * 128 + sRr[i], rlim)] * (unsigned)Kb + (unsigned)sCc[i] * 2u;
                }
            }
            const unsigned a2_00 = (last ? vn[0][0] : va[0][0]) + k2, a2_01 = (last ? vn[0][1] : va[0][1]) + k2;
            const unsigned a2_10 = (last ? vn[1][0] : va[1][0]) + k2, a2_11 = (last ? vn[1][1] : va[1][1]) + k2;
            const char* b2 = (last ? nB : cB) + k2; const char* b3 = b2 + kstep;
            G8_LDB(B0, 0, 0); G8_SCHED; G8_LDA(At, 0, 0); G8_STAGE_A(G8_SA(1, 1), va[1][0] + k1, va[1][1] + k1);
            G8_WAIT_L(8); G8_BAR; G8_WAIT_L(0); G8_MMA(0, 0, At, B0); G8_BAR; G8_SCHED;
            G8_LDB(B1, 0, 1); G8_STAGE_B(G8_SB(0, 0), b2);
            G8_BAR; G8_WAIT_L(0); G8_MMA(0, 1, At, B1); G8_BAR;
            G8_LDA(At, 0, 1); G8_STAGE_A(G8_SA(0, 0), a2_00, a2_01);
            G8_BAR; G8_WAIT_L(0); G8_MMA(1, 0, At, B0); G8_BAR; G8_SCHED;
            G8_STAGE_B(G8_SB(0, 1), b2 + hstepB);
            G8_WAIT_V(6); G8_BAR; G8_MMA(1, 1, At, B1); G8_BAR;
            G8_LDB(B0, 1, 0); G8_SCHED; G8_LDA(At, 1, 0); G8_STAGE_A(G8_SA(0, 1), a2_10, a2_11);
            G8_WAIT_L(8); G8_BAR; G8_WAIT_L(0); G8_MMA(0, 0, At, B0); G8_BAR; G8_SCHED;
            G8_LDB(B1, 1, 1); G8_STAGE_B(G8_SB(1, 0), b3);
            G8_BAR; G8_WAIT_L(0); G8_MMA(0, 1, At, B1); G8_BAR;
            G8_LDA(At, 1, 1); G8_STAGE_A(G8_SA(1, 0), a2_00 + 128u, a2_01 + 128u);
            G8_BAR; G8_WAIT_L(0); G8_MMA(1, 0, At, B0); G8_BAR; G8_SCHED;
            G8_STAGE_B(G8_SB(1, 1), b3 + hstepB);
            G8_WAIT_V(6); G8_BAR; G8_MMA(1, 1, At, B1); G8_BAR;
        }
        E(acc, cur, wr, wc, fr, fq, ep, cb);
        if (!has_next) break;
#pragma unroll
        for (int a = 0; a < 2; ++a)
#pragma unroll
            for (int b = 0; b < 2; ++b)
#pragma unroll
                for (int m = 0; m < 4; ++m)
#pragma unroll
                    for (int n = 0; n < 2; ++n) acc[a][b][m][n] = ACC{};
        cur = nxt; cB = nB; ++ui;
#pragma unroll
        for (int h = 0; h < 2; ++h)
#pragma unroll
            for (int i = 0; i < 2; ++i) va[h][i] = vn[h][i];
    }
    G8_WAIT_V(0);
    if (wr == 0) G8_BAR;
    G8_BAR;
#undef G8_SA
#undef G8_SB
#undef G8_STAGE_A
#undef G8_STAGE_B
#undef G8_LDA
#undef G8_LDB
#undef G8_MMA
#undef G8_WAIT_V
#undef G8_WAIT_L
#undef G8_BAR
#undef G8_SCHED
}
struct G8Plain {
    static constexpr bool GATHER = false;
    int nM, nN, Kb, G, c; const char* Bt;
    __device__ __forceinline__ bool next(int i, G8Unit& u, const G8Unit&) const {
        const int L = (i * 8 + (c & 7)) * (G >> 3) + (c >> 3); if (L >= nM * nN) return false;
        const int nig = 8 * nN, gid = L / nig, fm = gid * 8, gsz = (nM - fm) < 8 ? (nM - fm) : 8;
        u.pm = fm + ((L % nig) % gsz); u.pn = (L % nig) / gsz; u.e = 0; u.ce = 256; u.pre = 0; return true;
    }
    __device__ __forceinline__ int a_row(const G8Unit& u, int row) const { return u.pm * 256 + row; }
    __device__ __forceinline__ unsigned a_off(const G8Unit& u, int row) const { return (unsigned)a_row(u, row) * (unsigned)Kb; }
    __device__ __forceinline__ const char* b_ptr(const G8Unit& u) const { return Bt + (size_t)u.pn * 256 * Kb; }
};

__device__ __forceinline__ const float* resid_row_in(const Params& p, int tok) {
  return tok < TL ? p.x() + (size_t)tok * DM : p.ctx() + (size_t)(tok - TL) * DM;
}
__device__ __forceinline__ void load_row_comb(const Params& p, int src_layer, int lc, int tok, int lane, const int* pre  , float (&v)[16]) {
  if (src_layer == 0) {
    const float* r = resid_row_in(p, tok);
#pragma unroll
    for (int i = 0; i < 4; ++i) { const float4 a = *(const float4*)(r + lane * 4 + i * 256); v[4 * i] = a.x; v[4 * i + 1] = a.y; v[4 * i + 2] = a.z; v[4 * i + 3] = a.w; }
  } else {
    const u16* r = p.X() + (size_t)tok * DM;
#pragma unroll
    for (int i = 0; i < 4; ++i) { const float4 a = ld4bf(r + lane * 4 + i * 256); v[4 * i] = a.x; v[4 * i + 1] = a.y; v[4 * i + 2] = a.z; v[4 * i + 3] = a.w; }
  }
  if (lc >= 0) {
    const float* g2 = p.mod() + ((size_t)lc * 3 + modv(tok)) * 6144 + 5 * DM;
    float s[16];
#pragma unroll
    for (int i = 0; i < 16; ++i) s[i] = 0.f;
#pragma unroll
    for (int k = 0; k < TOPK; ++k) {
      const int sl = p.tslot()[tok * 4 + k];
      const size_t arow = (size_t)(pre[sl >> 20] + (sl & 0xFFFFF));
      const unsigned char* y = p.yd() + arow * DM;
#pragma unroll
      for (int i = 0; i < 4; ++i) {
        const int w = *(const int*)(y + lane * 4 + i * 256);
        const auto lo = __builtin_amdgcn_cvt_pk_f32_fp8(w, false), hi2 = __builtin_amdgcn_cvt_pk_f32_fp8(w, true);
        s[4 * i] += lo[0]; s[4 * i + 1] += lo[1]; s[4 * i + 2] += hi2[0]; s[4 * i + 3] += hi2[1];
      }
    }
#pragma unroll
    for (int i = 0; i < 4; ++i) {
      const float4 g = *(const float4*)(g2 + lane * 4 + i * 256);
      v[4 * i] += g.x * 0.125f * s[4 * i]; v[4 * i + 1] += g.y * 0.125f * s[4 * i + 1]; v[4 * i + 2] += g.z * 0.125f * s[4 * i + 2]; v[4 * i + 3] += g.w * 0.125f * s[4 * i + 3];
    }
  }
}
__device__ __forceinline__ void expert_prefix(const int* cnt, int* pre) {
  if (ltid() == 0) { int s = 0; for (int e = 0; e < NE; ++e) { pre[e] = s; s += cnt[e]; } pre[NE] = s; }
}

__device__ __forceinline__ float store_row_i8(const float (&y)[16], signed char* __restrict__ h, float* __restrict__ hs_row, int lane) {
  float am = 0.f;
#pragma unroll
  for (int i = 0; i < 16; ++i) am = fmaxf(am, fabsf(y[i]));
  am = wave_max(am);
  const float s = fmaxf(am, 1e-20f) * (1.f / 127.f), inv = 1.f / s;
#pragma unroll
  for (int i = 0; i < 4; ++i) {
    const int q0 = (int)rintf(y[4 * i] * inv), q1 = (int)rintf(y[4 * i + 1] * inv), q2 = (int)rintf(y[4 * i + 2] * inv), q3 = (int)rintf(y[4 * i + 3] * inv);
    *(unsigned*)(h + lane * 4 + i * 256) = (unsigned)(q0 & 255) | ((unsigned)(q1 & 255) << 8) | ((unsigned)(q2 & 255) << 16) | ((unsigned)(q3 & 255) << 24);
  }
  if (lane == 0) *hs_row = s;
  return s;
}
__device__ __forceinline__ void phase_quant_in(const Params& p, int bid, int nb) {
  const int wid = ltid() >> 6, lane = ltid() & 63;
  for (int r = bid * 8 + wid; r < 2 * NIN; r += nb * 8) {
    const float* src = p.btf() + (size_t)r * DM;
    float y[16];
#pragma unroll
    for (int i = 0; i < 4; ++i) { const float4 a = *(const float4*)(src + lane * 4 + i * 256); y[4 * i] = a.x; y[4 * i + 1] = a.y; y[4 * i + 2] = a.z; y[4 * i + 3] = a.w; }
    store_row_i8(y, p.bt_in() + (size_t)r * DM, p.swin() + r, lane);
  }
}
__device__ __forceinline__ void phase_norm1(const Params& p, int layer, int bid, int nb, char* lds) {
  int* pre = (int*)lds;
  const int lc = layer - 1;
  if (lc >= 0) { expert_prefix(p.cnt() + lc * NE, pre); __syncthreads(); }
  const int wid = ltid() >> 6, lane = ltid() & 63;
  const float* gn = p.norm1_g() + layer * DM;
  const int ntok = TT;
  for (int tok = bid * 8 + wid; tok < ntok; tok += nb * 8) {
    float v[16];
    load_row_comb(p, layer == 0 ? 0 : 1, lc, tok, lane, pre, v);
    if (lc >= 0) {
      u16* xr = p.X() + (size_t)tok * DM;
#pragma unroll
      for (int i = 0; i < 4; ++i) *(u32x2*)(xr + lane * 4 + i * 256) = u32x2{cvtpk(v[4 * i], v[4 * i + 1]), cvtpk(v[4 * i + 2], v[4 * i + 3])};
    }
    float ss = 0;
#pragma unroll
    for (int i = 0; i < 16; ++i) ss += v[i] * v[i];
    ss = wave_sum(ss);
    const float rs = rsqrtf(ss * (1.f / DM) + EPS);
    const float* md = p.mod() + ((size_t)layer * 3 + modv(tok)) * 6144;
#pragma unroll
    for (int i = 0; i < 4; ++i) {
      const int c = lane * 4 + i * 256;
      const float4 g = *(const float4*)(gn + c), sh = *(const float4*)(md + c), sc = *(const float4*)(md + DM + c);
      v[4 * i] = v[4 * i] * rs * g.x * (1.f + sc.x) + sh.x; v[4 * i + 1] = v[4 * i + 1] * rs * g.y * (1.f + sc.y) + sh.y;
      v[4 * i + 2] = v[4 * i + 2] * rs * g.z * (1.f + sc.z) + sh.z; v[4 * i + 3] = v[4 * i + 3] * rs * g.w * (1.f + sc.w) + sh.w;
    }
    store_row_i8(v, p.H() + (size_t)tok * DM, p.hs() + tok, lane);
  }
}

struct EpiIn {
  u16* zqkv; u16* zg; u16* zt; const float* hs; const float* sw;
  __device__ __forceinline__ void pre(const G8Unit& u, int wr, int fr, float (&ep)[8], float* cb) const {
    if ((ltid() >> 6) == 0) g8_cload(sw + u.pn * 256, cb);
    if ((ltid() >> 6) == 2) g8_cload(hs + u.pm * 256, cb + 512);
  }
  __device__ __forceinline__ void operator()(const i32x4 (&acc)[2][2][4][2], const G8Unit& u, int wr, int wc, int fr, int fq, const float (&ep)[8], const float* cb) const {
#pragma unroll
    for (int bj = 0; bj < 2; ++bj) {
      const int c32 = u.pn * 256 + bj * 128 + wc * 32, c0 = c32 + 8 * fq;
      const f32x4 w0 = *(const f32x4*)(cb + bj * 128 + wc * 32 + 8 * fq), w1 = *(const f32x4*)(cb + bj * 128 + wc * 32 + 8 * fq + 4);
#pragma unroll
      for (int ai = 0; ai < 2; ++ai)
#pragma unroll
        for (int m = 0; m < 4; ++m) {
          const int row = u.pm * 256 + ai * 128 + wr * 64 + m * 16 + fr;
          const float sa = cb[512 + ai * 128 + wr * 64 + m * 16 + fr];
          f32x4 a, b;
#pragma unroll
          for (int j = 0; j < 4; ++j) { a[j] = (float)acc[ai][bj][m][0][j] * sa * w0[j]; b[j] = (float)acc[ai][bj][m][1][j] * sa * w1[j]; }
          if (c32 < 384) {
            *(u32x4*)(zqkv + (size_t)row * 384 + c0) = u32x4{cvtpk(a[0], a[1]), cvtpk(a[2], a[3]), cvtpk(b[0], b[1]), cvtpk(b[2], b[3])};
          } else if (c32 < 1536) {
            *(u32x4*)(zg + (size_t)row * ZG_W + (c0 - 384)) = u32x4{cvtpk(a[0], a[1]), cvtpk(a[2], a[3]), cvtpk(b[0], b[1]), cvtpk(b[2], b[3])};
          } else {
            const bool o1 = fr & 1, o2 = fr & 2, o4 = fr & 4;
            unsigned w[4], x[2][2];
#pragma unroll
            for (int j = 0; j < 4; ++j) {
              const float rcv = shx<1>(o1 ? a[j] : b[j]);
              w[j] = cvtpk(o1 ? rcv : a[j], o1 ? b[j] : rcv);
            }
#pragma unroll
            for (int j = 0; j < 2; ++j) {
              const unsigned rcv = __float_as_uint(shx<2>(__uint_as_float(o2 ? w[j] : w[2 + j])));
              x[j][0] = o2 ? rcv : w[j]; x[j][1] = o2 ? w[2 + j] : rcv;
            }
            const unsigned r0 = __float_as_uint(shx<4>(__uint_as_float(o4 ? x[0][0] : x[1][0]))), r1 = __float_as_uint(shx<4>(__uint_as_float(o4 ? x[0][1] : x[1][1])));
            const u32x4 out = o4 ? u32x4{r0, r1, x[1][0], x[1][1]} : u32x4{x[0][0], x[0][1], r0, r1};
            const int cidx = (o1 ? 4 : 0) + (o2 ? 2 : 0) + (o4 ? 1 : 0);
            *(u32x4*)(zt + (size_t)(c0 - 1536 + cidx) * TT + (row & ~7)) = out;
          }
        }
    }
  }
};
__device__ __forceinline__ void phase_gemm_in(const Params& p, int layer, int bid, int nb, char* lds) {
  G8Plain S; S.nM = TT / 256; S.nN = NIN / 256; S.Kb = DM; S.G = nb; S.c = bid; S.Bt = (const char*)(p.bt_in() + (size_t)layer * NIN * DM);
  EpiIn E; E.zqkv = p.zqkv(); E.zg = p.zg(); E.zt = p.zt(); E.hs = p.hs(); E.sw = p.swin() + layer * NIN;
  gemm8_phase<true>(lds, (const char*)p.H(), DM, S, E);
}

__device__ __forceinline__ size_t qkv_row(int tok, int h) {
  const int b = tok < TL ? (tok >> 14) : ((tok - TL) >> 8);
  const int s = tok < TL ? (tok & (SEQ - 1)) : SEQ + ((tok - TL) & (LC - 1));
  return ((size_t)(b * 4 + h)) * SKV + s;
}
struct EpiQkv {
  const u16* zqkv; u16* Q; u16* KV; const float* ropec; const float* ropes; float* rsl;
  unsigned* kmx;
  __device__ __forceinline__ void pre(const G8Unit&, int, int, float (&)[8], float*) const {}
  __device__ __forceinline__ void operator()(const f32x4 (&acc)[2][2][4][2], const G8Unit& u, int wr, int wc, int fr, int fq, const float (&)[8], const float*) const {
    const int tid = ltid();
    {
      const int r = tid >> 1, half = tid & 1;
      const u16* row = zqkv + (size_t)(u.pm * 256 + r) * 384;
      float sq = 0, sk = 0;
#pragma unroll
      for (int i = 0; i < 16; ++i) {
        const u32x4 w = *(const u32x4*)(row + half * 128 + i * 8);
#pragma unroll
        for (int q = 0; q < 4; ++q) { const float a = __uint_as_float(w[q] << 16), b = __uint_as_float(w[q] & 0xFFFF0000u); sq += a * a + b * b; }
      }
#pragma unroll
      for (int i = 0; i < 8; ++i) {
        const u32x4 w = *(const u32x4*)(row + 256 + half * 64 + i * 8);
#pragma unroll
        for (int q = 0; q < 4; ++q) { const float a = __uint_as_float(w[q] << 16), b = __uint_as_float(w[q] & 0xFFFF0000u); sk += a * a + b * b; }
      }
      sq += shx<1>(sq); sk += shx<1>(sk);
      if (half == 0) { rsl[r] = rsqrtf(sq * (1.f / 256.f) + EPS); rsl[256 + r] = rsqrtf(sk * (1.f / 128.f) + EPS); }
    }
    asm volatile("s_waitcnt lgkmcnt(0)" ::: "memory"); __builtin_amdgcn_s_barrier(); __builtin_amdgcn_s_barrier(); asm volatile("" ::: "memory");
    const float* rsp = rsl + (u.pn >= 2 ? 256 : 0);
#pragma unroll
    for (int ai = 0; ai < 2; ++ai)
#pragma unroll
      for (int m = 0; m < 4; ++m) {
        const int rl = ai * 128 + wr * 64 + m * 16 + fr, tok = u.pm * 256 + rl;
        const float rs = rsp[rl] * (u.pn < 2 ? A_QSCALE : 1.f);
        if (u.pn == 1) {
          f32x4 a = acc[ai][0][m][0] * rs, b = acc[ai][0][m][1] * rs;
          f32x4 pa, pb;
#pragma unroll
          for (int j = 0; j < 4; ++j) { pa[j] = shx<32>(a[j]); pb[j] = shx<32>(b[j]); }
          f32x4 ca = {1.f, 1.f, 1.f, 1.f}, cb = ca, sa = {0.f, 0.f, 0.f, 0.f}, sb = sa;
          if (tok < TL) {
            const float* cp = ropec + (size_t)(tok & (SEQ - 1)) * 16 + 8 * (fq & 1); const float* sp = ropes + (size_t)(tok & (SEQ - 1)) * 16 + 8 * (fq & 1);
            ca = *(const f32x4*)cp; cb = *(const f32x4*)(cp + 4); sa = *(const f32x4*)sp; sb = *(const f32x4*)(sp + 4);
          }
          const float sg = fq < 2 ? -1.f : 1.f;
          a = a * ca + pa * sa * sg; b = b * cb + pb * sb * sg;
          *(u32x4*)(Q + qkv_row(tok, wc) * 96 + 64 + 8 * fq) = u32x4{cvtpk(a[0], a[1]), cvtpk(a[2], a[3]), cvtpk(b[0], b[1]), cvtpk(b[2], b[3])};
        } else {
#pragma unroll
          for (int bj = 0; bj < 2; ++bj) {
            const int c = bj * 128 + wc * 32 + 8 * fq, h = c >> 6, d = c & 63;
            const f32x4 a = acc[ai][bj][m][0] * rs, b = acc[ai][bj][m][1] * rs;
            u16* dst = u.pn == 0 ? Q + qkv_row(tok, h) * 96 + d : KV + qkv_row(tok, h) * 160 + (u.pn == 2 ? 0 : 96) + d;
            *(u32x4*)dst = u32x4{cvtpk(a[0], a[1]), cvtpk(a[2], a[3]), cvtpk(b[0], b[1]), cvtpk(b[2], b[3])};
          }
        }
      }
    if (u.pn == 2) {
      const int b = u.pm * 256 < TL ? (u.pm * 256) >> 14 : (u.pm * 256 - TL) >> 8;
#pragma unroll
      for (int bj = 0; bj < 2; ++bj) {
        float mx = 0.f;
#pragma unroll
        for (int ai = 0; ai < 2; ++ai)
#pragma unroll
          for (int m = 0; m < 4; ++m) {
            const float rs = rsp[ai * 128 + wr * 64 + m * 16 + fr];
            const f32x4 a = acc[ai][bj][m][0] * rs, b4 = acc[ai][bj][m][1] * rs;
            float ss = a[0] * a[0] + a[1] * a[1] + a[2] * a[2] + a[3] * a[3] + b4[0] * b4[0] + b4[1] * b4[1] + b4[2] * b4[2] + b4[3] * b4[3];
            ss += shx<16>(ss); ss += shx<32>(ss);
            mx = fmaxf(mx, ss);
          }
        mx = fmaxf(mx, shx<8>(mx)); mx = fmaxf(mx, shx<4>(mx)); mx = fmaxf(mx, shx<2>(mx)); mx = fmaxf(mx, shx<1>(mx));
        if ((ltid() & 63) == 0) atomicMax(kmx + (b * 4 + bj * 2 + (wc >> 1)) * 4 + (wc & 1), __float_as_uint(mx));
      }
    }
  }
};
__device__ __forceinline__ void phase_qkv(const Params& p, int layer, int bid, int nb, char* lds) {
  const int tid = ltid();
  {
    G8Plain S; S.nM = TT / 256; S.nN = 4; S.Kb = 768; S.G = nb; S.c = bid; S.Bt = (const char*)(p.bt_qkv() + (size_t)layer * 1024 * 384);
    EpiQkv E; E.zqkv = p.zqkv(); E.Q = p.Q(); E.KV = p.KV(); E.ropec = p.ropec(); E.ropes = p.ropes(); E.rsl = (float*)(lds + 131072); E.kmx = p.kmx() + layer * 32;
    gemm8_phase<false>(lds, (const char*)p.zqkv(), 768, S, E);
  }
  float krm0 = 0.f, krm1 = 0.f;
  for (int i = bid * NTHR + tid; i < TT * 16; i += nb * NTHR) {
    const int tok = i >> 4, f = i & 15;
    const float x1 = bf2f(p.zg()[(size_t)tok * ZG_W + ZG_KR + f]), x2 = bf2f(p.zg()[(size_t)tok * ZG_W + ZG_KR + 16 + f]);
    float cs = 1.f, sn = 0.f;
    if (tok < TL) { const int tpos = tok & (SEQ - 1); cs = p.ropec()[tpos * 16 + f]; sn = p.ropes()[tpos * 16 + f]; }
    const float y1 = x1 * cs - x2 * sn, y2 = x2 * cs + x1 * sn;
    const u16 o1 = f2bf(y1), o2 = f2bf(y2);
#pragma unroll
    for (int h = 0; h < 4; ++h) { u16* kv = p.KV() + qkv_row(tok, h) * 160 + 64; kv[f] = o1; kv[16 + f] = o2; }
    float ss = y1 * y1 + y2 * y2;
    ss += shx<8>(ss); ss += shx<4>(ss); ss += shx<2>(ss); ss += shx<1>(ss);
    const int b = tok < TL ? (tok >> 14) : ((tok - TL) >> 8);
    if (b == 0) krm0 = fmaxf(krm0, ss); else krm1 = fmaxf(krm1, ss);
  }
  krm0 = wave_max(krm0); krm1 = wave_max(krm1);
  if ((tid & 63) == 0) { atomicMax(p.kmx() + layer * 32 + 0 * 16 + 2, __float_as_uint(krm0)); atomicMax(p.kmx() + layer * 32 + 1 * 16 + 2, __float_as_uint(krm1)); }
}

constexpr int A_KROW = 208;
constexpr int A_TV = 128 * 64 * 2;
constexpr int A_TK = 128 * A_KROW;
constexpr int A_BUF = A_TV + A_TK;
constexpr int A_OFF_W = 3 * A_BUF;
constexpr int ATTN_LDS = A_OFF_W + 8 * 64 * 4;
#define SBAR() __builtin_amdgcn_sched_barrier(0)
__device__ __forceinline__ int crow(int r, int hi) { return (r & 3) + 8 * (r >> 2) + 4 * hi; }

__device__ __forceinline__ void a_partialSM(f32x16& p0) {
#pragma unroll
  for (int r = 0; r < 16; ++r) p0[r] = __builtin_amdgcn_exp2f(p0[r]);
}
typedef float a_f2 __attribute__((ext_vector_type(2)));
__device__ __forceinline__ void a_finishSM(f32x16& p0, f32x16& p1, a_f2& ls, bf16x8& pa0, bf16x8& pa1, bf16x8& pa2, bf16x8& pa3) {
#pragma unroll
  for (int r = 0; r < 16; ++r) p1[r] = __builtin_amdgcn_exp2f(p1[r]);
#pragma unroll
  for (int r = 0; r < 16; r += 2) { ls += a_f2{p0[r], p0[r + 1]}; ls += a_f2{p1[r], p1[r + 1]}; }
#define PK4(P, BASE, OUT) do { unsigned a0 = cvtpk(P[BASE + 0], P[BASE + 1]), a1 = cvtpk(P[BASE + 2], P[BASE + 3]);   \
    unsigned b0 = cvtpk(P[BASE + 4], P[BASE + 5]), b1 = cvtpk(P[BASE + 6], P[BASE + 7]);                              \
    auto r0 = __builtin_amdgcn_permlane32_swap(a0, b0, false, false); auto r1 = __builtin_amdgcn_permlane32_swap(a1, b1, false, false); \
    u32x4 w = {r0[0], r1[0], r0[1], r1[1]}; OUT = *reinterpret_cast<bf16x8*>(&w); } while (0)
  PK4(p0, 0, pa0); PK4(p0, 8, pa1); PK4(p1, 0, pa2); PK4(p1, 8, pa3);
#undef PK4
}
__device__ __forceinline__ void a_qkt(f32x16& p0, f32x16& p1, const char* Ks, const bf16x8* qr, const float mneg, int r32, int hi) {
#pragma unroll
  for (int r = 0; r < 16; ++r) { p0[r] = mneg; p1[r] = mneg; }
#pragma unroll
  for (int d0 = 0; d0 < 6; ++d0) {
    const int cb = (d0 * 16 + hi * 8) * 2;
    const bf16x8 b0 = *reinterpret_cast<const bf16x8*>(Ks + r32 * A_KROW + cb);
    const bf16x8 b1 = *reinterpret_cast<const bf16x8*>(Ks + (32 + r32) * A_KROW + cb);
    p0 = __builtin_amdgcn_mfma_f32_32x32x16_bf16(b0, qr[d0], p0, 0, 0, 0); p1 = __builtin_amdgcn_mfma_f32_32x32x16_bf16(b1, qr[d0], p1, 0, 0, 0);
  }
}
__device__ __forceinline__ int a_v_st(int k, int c) { const int kk = (k & ~0xC) | ((k & 4) << 1) | ((k & 8) >> 1); return ((kk >> 3) * 2 + (c >> 5)) * 512 + ((kk & 7) * 32 + (c & 31)) * 2; }
__device__ __forceinline__ int a_v_rd_base(int lane) { return ((lane & 3) << 3) | (((lane >> 2) & 3) << 6) | (((lane >> 4) & 1) << 5) | (((lane >> 5) & 1) << 8); }
constexpr int a_v_rd_off(int d0, int ks, int half) { return d0 * 512 + ks * 2048 + half * 1024; }
template <int OFF> __device__ __forceinline__ s16x4 a_tr_read(int vb) {
  s16x4 r; asm volatile("ds_read_b64_tr_b16 %0, %1 offset:%2" : "=&v"(r) : "v"(vb), "i"(OFF) : "memory"); return r;
}
template <int D0> __device__ __forceinline__ void a_pv_one(f32x16& od, int vb, bf16x8 pa0, bf16x8 pa1, bf16x8 pa2, bf16x8 pa3) {
  const s16x4 l0 = a_tr_read<a_v_rd_off(D0, 0, 0)>(vb), h0 = a_tr_read<a_v_rd_off(D0, 0, 1)>(vb), l1 = a_tr_read<a_v_rd_off(D0, 1, 0)>(vb), h1 = a_tr_read<a_v_rd_off(D0, 1, 1)>(vb);
  const s16x4 l2 = a_tr_read<a_v_rd_off(D0, 2, 0)>(vb), h2 = a_tr_read<a_v_rd_off(D0, 2, 1)>(vb), l3 = a_tr_read<a_v_rd_off(D0, 3, 0)>(vb), h3 = a_tr_read<a_v_rd_off(D0, 3, 1)>(vb);
  asm volatile("s_waitcnt lgkmcnt(0)" ::: "memory"); SBAR();
#define PK(L, H) (bf16x8){L[0], L[1], L[2], L[3], H[0], H[1], H[2], H[3]}
  od = __builtin_amdgcn_mfma_f32_32x32x16_bf16(pa0, PK(l0, h0), od, 0, 0, 0);
  od = __builtin_amdgcn_mfma_f32_32x32x16_bf16(pa1, PK(l1, h1), od, 0, 0, 0);
  od = __builtin_amdgcn_mfma_f32_32x32x16_bf16(pa2, PK(l2, h2), od, 0, 0, 0);
  od = __builtin_amdgcn_mfma_f32_32x32x16_bf16(pa3, PK(l3, h3), od, 0, 0, 0);
#undef PK
}
__device__ __forceinline__ void a_pv(f32x16* o, int vb, bf16x8 pa0, bf16x8 pa1, bf16x8 pa2, bf16x8 pa3) {
  a_pv_one<0>(o[0], vb, pa0, pa1, pa2, pa3); a_pv_one<1>(o[1], vb, pa0, pa1, pa2, pa3);
}

__device__ __forceinline__ void attn_item(const u16* __restrict__ Qb, const u16* __restrict__ KVh, int seq, float kmax, u16* __restrict__ yout  , char* lds) {
  const int tid = ltid(), wid = tid >> 6, lane = tid & 63, r32 = lane & 31, hi = lane >> 5;
  f32x16 o[2] = {}; bf16x8 qr[6]; a_f2 ls = {0.f, 0.f};
  const u16* Qw = Qb + (size_t)(wid * 32 + r32) * 96 + hi * 8;
#pragma unroll
  for (int d0 = 0; d0 < 6; ++d0) qr[d0] = *reinterpret_cast<const bf16x8*>(Qw + d0 * 16);
  float mneg;
  {
    float ss = 0.f;
#pragma unroll
    for (int d0 = 0; d0 < 6; ++d0)
#pragma unroll
      for (int j = 0; j < 8; ++j) { const float v = bf2f((u16)qr[d0][j]); ss += v * v; }
    ss += shx<32>(ss);
    mneg = -sqrtf(ss) * kmax;
  }
  int lw[5];
#pragma unroll
  for (int i = 0; i < 5; ++i) {
    const int g = tid + i * 512, key = g / 20, cc = g % 20;
    lw[i] = cc < 12 ? (A_TV + key * A_KROW + cc * 16) : ((key >> 6) * 8192 + a_v_st(key & 63, (cc - 12) * 8));
  }
  const int vrb = (int)(uintptr_t)lds + a_v_rd_base(lane);
  bf16x8 sg[5];
  const char* gsrc = (const char*)KVh + tid * 16;
#define SLOAD(t) do { const char* s_ = gsrc + (size_t)(t) * 40960; _Pragma("unroll") for (int i = 0; i < 5; ++i) sg[i] = *(const bf16x8*)(s_ + i * 8192); } while (0)
#define SWRITE(bo_) do { _Pragma("unroll") for (int i = 0; i < 5; ++i) *(bf16x8*)(lds + (bo_) + lw[i]) = sg[i]; } while (0)
  f32x16 pA0, pA1, pB0, pB1; bf16x8 pa0, pa1, pa2, pa3; const int NT = seq / 128;
  SLOAD(0); SWRITE(0); if (1 < NT) SLOAD(1);
  __syncthreads();
  int bo = 0;
  {
    if (1 < NT) { SWRITE(A_BUF); if (2 < NT) SLOAD(2); }
    SBAR(); a_qkt(pA0, pA1, lds + bo + A_TV, qr, mneg, r32, hi); a_partialSM(pA0);
    SBAR(); a_qkt(pB0, pB1, lds + bo + A_TV + 64 * A_KROW, qr, mneg, r32, hi);
    a_finishSM(pA0, pA1, ls, pa0, pa1, pa2, pa3); SBAR();
    a_pv(o, vrb + bo, pa0, pa1, pa2, pa3); a_partialSM(pB0);
    __syncthreads();
  }
  for (int t = 1; t < NT; ++t) {
    const int bp = bo;
    bo = bo + A_BUF; if (bo == 3 * A_BUF) bo = 0;
    int bn = bo + A_BUF; if (bn == 3 * A_BUF) bn = 0;
    if (t + 1 < NT) { SWRITE(bn); if (t + 2 < NT) SLOAD(t + 2); }
    SBAR(); a_qkt(pA0, pA1, lds + bo + A_TV, qr, mneg, r32, hi);
    a_finishSM(pB0, pB1, ls, pa0, pa1, pa2, pa3); SBAR();
    a_pv(o, vrb + bp + 8192, pa0, pa1, pa2, pa3); a_partialSM(pA0);
    SBAR(); a_qkt(pB0, pB1, lds + bo + A_TV + 64 * A_KROW, qr, mneg, r32, hi);
    a_finishSM(pA0, pA1, ls, pa0, pa1, pa2, pa3); SBAR();
    a_pv(o, vrb + bo, pa0, pa1, pa2, pa3); a_partialSM(pB0);
    __syncthreads();
  }
  a_finishSM(pB0, pB1, ls, pa0, pa1, pa2, pa3); SBAR();
  a_pv(o, vrb + bo + 8192, pa0, pa1, pa2, pa3);
  float* li_l = (float*)(lds + A_OFF_W) + wid * 64;
  { float l = ls[0] + ls[1]; l += shx<32>(l); if (hi == 0) li_l[r32] = l; asm volatile("s_waitcnt lgkmcnt(0)" ::: "memory"); }
#pragma unroll
  for (int r = 0; r < 16; ++r) {
    const int orow = crow(r, hi);
    const float rl = __builtin_amdgcn_rcpf(li_l[orow]);
    const float v0 = o[0][r] * rl, v1 = o[1][r] * rl;
    float ss = v0 * v0 + v1 * v1;
    ss += shx<16>(ss); ss += shx<8>(ss); ss += shx<4>(ss); ss += shx<2>(ss); ss += shx<1>(ss);
    const float rs = rsqrtf(ss * (1.f / 64.f) + EPS);
    u16* dst = yout + (size_t)(wid * 32 + orow) * DM;
    dst[r32] = f2bf(v0 * rs); dst[32 + r32] = f2bf(v1 * rs);
  }
  __syncthreads();
#undef SLOAD
#undef SWRITE
}

__device__ __forceinline__ void phase_attn(const Params& p, int layer, int bid, int nb, char* lds) {
  const int nitems = 512 + (layer == 0 ? 8 : 0);
  const unsigned* kmx = p.kmx() + layer * 32;
  for (int it = bid; it < nitems; it += nb) {
    int b, h, q0, k0, seq, tok0;
    if (it < 512) { const int pair = it & 7, qb = (it >> 3); h = pair & 3; b = pair >> 2; q0 = qb * 256; k0 = 0; seq = SKV; tok0 = b * SEQ + qb * 256; }
    else { const int i2 = it - 512; h = i2 & 3; b = i2 >> 2; q0 = SEQ; k0 = SEQ; seq = LC; tok0 = TL + b * LC; }
    const size_t base = (size_t)(b * 4 + h) * SKV;
    const float k2 = __uint_as_float(kmx[(b * 4 + h) * 4 + 0]) + __uint_as_float(kmx[(b * 4 + h) * 4 + 1]) + __uint_as_float(kmx[b * 16 + 2]);
    attn_item(p.Q() + (base + q0) * 96, p.KV() + (base + k0) * 160, seq, sqrtf(k2) * 1.02f, p.ymix() + (size_t)tok0 * DM + h * 64, lds);
  }
}

__device__ __forceinline__ float hy_sconv(const u16* __restrict__ row, int t, int Ls, float w0, float w1, float w2, float bb) {
  const float zm = t > 0 ? bf2f(row[t - 1]) : 0.f, z0 = bf2f(row[t]), zp = t + 1 < Ls ? bf2f(row[t + 1]) : 0.f;
  return w0 * zm + w1 * z0 + w2 * zp + bb;
}
__device__ __forceinline__ float2 hy_sconv2(unsigned prv, unsigned cur, unsigned nxt, float w0, float w1, float w2, float bb) {
  const float zm = __uint_as_float(prv & 0xFFFF0000u), z0 = __uint_as_float(cur << 16), z1 = __uint_as_float(cur & 0xFFFF0000u), z2 = __uint_as_float(nxt << 16);
  return make_float2(w0 * zm + w1 * z0 + w2 * z1 + bb, w0 * z0 + w1 * z1 + w2 * z2 + bb);
}
__device__ __forceinline__ void hyena_item(const Params& p, int layer, int b, int ch, char* lds) {
  float2* s = (float2*)lds;
  const int tid = ltid();
  const float* cw = p.hy_conv_w() + (size_t)layer * 3 * 768; const float* cb = p.hy_conv_b() + (size_t)layer * 768;
  const unsigned* r0 = (const unsigned*)(p.zt() + (size_t)(ZT_HY + ch) * TT + (size_t)b * SEQ);
  const unsigned* r1 = (const unsigned*)(p.zt() + (size_t)(ZT_HY + 256 + ch) * TT + (size_t)b * SEQ);
  const unsigned* r2 = (const unsigned*)(p.zt() + (size_t)(ZT_HY + 512 + ch) * TT + (size_t)b * SEQ);
  const float a0 = cw[ch], a1 = cw[768 + ch], a2 = cw[1536 + ch], ab = cb[ch];
  const float b0 = cw[256 + ch], b1 = cw[768 + 256 + ch], b2 = cw[1536 + 256 + ch], bb = cb[256 + ch];
  const float c0 = cw[512 + ch], c1 = cw[768 + 512 + ch], c2 = cw[1536 + 512 + ch], cbb = cb[512 + ch];
  unsigned vgr[16], x0r[16];
#pragma unroll
  for (int hb2 = 0; hb2 < 2; ++hb2) {
    unsigned ld[8][9];
#pragma unroll
    for (int ii = 0; ii < 8; ++ii) {
      const int m = tid + 512 * (hb2 * 8 + ii);
      const int mp = m > 0 ? m - 1 : 0, mn = m + 1 < SEQ / 2 ? m + 1 : m;
      ld[ii][0] = r0[mp]; ld[ii][1] = r0[m]; ld[ii][2] = r0[mn];
      ld[ii][3] = r1[mp]; ld[ii][4] = r1[m]; ld[ii][5] = r1[mn];
      ld[ii][6] = r2[mp]; ld[ii][7] = r2[m]; ld[ii][8] = r2[mn];
    }
#pragma unroll
    for (int ii = 0; ii < 8; ++ii) {
      const int i = hb2 * 8 + ii, m = tid + 512 * i;
      const unsigned mkp = m > 0 ? 0xFFFFFFFFu : 0u, mkn = m + 1 < SEQ / 2 ? 0xFFFFFFFFu : 0u;
      const float2 ux = hy_sconv2(ld[ii][0] & mkp, ld[ii][1], ld[ii][2] & mkn, a0, a1, a2, ab);
      x0r[i] = cvtpk(ux.x, ux.y);
      const float2 u1 = hy_sconv2(ld[ii][3] & mkp, ld[ii][4], ld[ii][5] & mkn, b0, b1, b2, bb);
      const float2 uv = hy_sconv2(ld[ii][6] & mkp, ld[ii][7], ld[ii][8] & mkn, c0, c1, c2, cbb);
      const float2 vgf = make_float2(uv.x * u1.x, uv.y * u1.y);
      vgr[i] = cvtpk(vgf.x, vgf.y);
      s[swz(m)] = vgf;
      s[swz(m + SEQ / 2)] = make_float2(0.f, 0.f);
    }
  }
  __syncthreads();
  fft_fwd(s, p.tw());
  {
    const float4* hs = p.hspec() + ((size_t)layer * 256 + ch) * HSP;
    float4 hv[17];
#pragma unroll
    for (int i = 0; i < 17; ++i) { const int k = tid + 512 * i; hv[i] = hs[k <= FM / 2 ? k : 0]; }
    const float2 twl = p.tw()[tid];
#pragma unroll
    for (int i = 0; i < 17; ++i) {
      const int k = tid + 512 * i;
      if (k <= FM / 2) {
        const int pk = swz(rev7(k)), pm = swz(rev7((FM - k) & (FM - 1)));
        const float2 zk = s[pk], zm = s[pm];
        const float4 h = hv[i];
        const float2 He = make_float2(h.x, h.y), Ho = make_float2(h.z, h.w);
        const float2 Xe = make_float2(0.5f * (zk.x + zm.x), 0.5f * (zk.y - zm.y));
        const float2 Xo = make_float2(0.5f * (zk.y + zm.y), -0.5f * (zk.x - zm.x));
        const float2 twk = cmul(twl, p.tw()[512 * i]);
        const float2 t1 = cmul(twk, cmul(Xo, Ho));
        const float2 e1 = cmul(Xe, He);
        const float2 Ye = make_float2(e1.x + t1.x, e1.y + t1.y);
        const float2 o1 = cmul(Xe, Ho), o2 = cmul(Xo, He);
        const float2 Yo = make_float2(o1.x + o2.x, o1.y + o2.y);
        s[pk] = make_float2(Ye.x - Yo.y, Ye.y + Yo.x);
        if (pm != pk) s[pm] = make_float2(Ye.x + Yo.y, -Ye.y + Yo.x);
      }
    }
  }
  __syncthreads();
  fft_inv(s, p.tw());
  const float hb = p.hy_bias()[layer * 256 + ch];
  unsigned* orow = (unsigned*)(p.hyo() + (size_t)ch * TT + (size_t)b * SEQ);
#pragma unroll
  for (int i = 0; i < 16; ++i) {
    const int m = tid + 512 * i;
    const float2 y = s[swz(m)];
    orow[m] = cvtpk((y.x + __uint_as_float(vgr[i] << 16) * hb) * __uint_as_float(x0r[i] << 16), (y.y + __uint_as_float(vgr[i] & 0xFFFF0000u) * hb) * __uint_as_float(x0r[i] & 0xFFFF0000u));
  }
  __syncthreads();
}
__device__ __forceinline__ void fnet_item(const Params& p, int b, int j, char* lds) {
  float2* s = (float2*)lds;
  const int tid = ltid();
  const u16* rr = p.zt() + (size_t)(ZT_FR + j) * TT + (size_t)b * SEQ;
  const u16* ri = p.zt() + (size_t)(ZT_FI + j) * TT + (size_t)b * SEQ;
  {
    u32x4 vr[4], vi[4];
#pragma unroll
    for (int i = 0; i < 4; ++i) { const int m0 = (tid + 512 * i) * 8; vr[i] = *(const u32x4*)(rr + m0); vi[i] = *(const u32x4*)(ri + m0); }
#pragma unroll
    for (int i = 0; i < 4; ++i) {
      const int m0 = (tid + 512 * i) * 8;
#pragma unroll
      for (int q = 0; q < 4; ++q) {
        s[swz(m0 + 2 * q)] = make_float2(__uint_as_float(vr[i][q] << 16), __uint_as_float(vi[i][q] << 16));
        s[swz(m0 + 2 * q + 1)] = make_float2(__uint_as_float(vr[i][q] & 0xFFFF0000u), __uint_as_float(vi[i][q] & 0xFFFF0000u));
      }
    }
  }
  __syncthreads();
  fft_fwd(s, p.tw());
#ifdef PROBE_FFT
  fft_inv(s, p.tw());
  for (int m = tid; m < FM; m += NTHR) { float2 v = s[m]; v.x *= (1.f / 16384.f); v.y *= (1.f / 16384.f); s[m] = v; }
  __syncthreads();
  fft_fwd(s, p.tw());
#endif
  u16* orow = p.fno() + (size_t)j * TT + (size_t)b * SEQ;
#pragma unroll 8
  for (int k = tid; k < FM; k += NTHR) orow[k] = f2bf(s[swz(rev7(k))].x * (1.f / 128.f));
  __syncthreads();
}
__device__ __forceinline__ void hyena_ctx_pair(const Params& p, int ch, char* lds) {
  const int tid = ltid(), b = tid >> 8, t = tid & 255;
  float* vg = (float*)(lds + b * 4096);
  float* x0 = vg + 256;
  float* hf = x0 + 256;
  float* hbk = hf + 256;
  const float* cw = p.hy_conv_w(); const float* cb = p.hy_conv_b();
  const size_t off = (size_t)TL + (size_t)b * LC;
  const u16* r0 = p.zt() + (size_t)(ZT_HY + ch) * TT + off;
  const u16* r1 = p.zt() + (size_t)(ZT_HY + 256 + ch) * TT + off;
  const u16* r2 = p.zt() + (size_t)(ZT_HY + 512 + ch) * TT + off;
  vg[t] = hy_sconv(r2, t, LC, cw[512 + ch], cw[768 + 512 + ch], cw[1536 + 512 + ch], cb[512 + ch]) *
          hy_sconv(r1, t, LC, cw[256 + ch], cw[768 + 256 + ch], cw[1536 + 256 + ch], cb[256 + ch]);
  x0[t] = hy_sconv(r0, t, LC, cw[ch], cw[768 + ch], cw[1536 + ch], cb[ch]);
  hf[t] = p.hfc()[(size_t)ch * LC + t]; hbk[t] = p.hfc()[(size_t)(256 + ch) * LC + t];
  const float ssq_c = filt_ssq(p.hpart() + (size_t)2 * 256 * 512, ch, (float*)(lds + 8192));
  {
    float y = 0;
    for (int q = 0; q <= t; ++q) y += hf[t - q] * vg[q];
    for (int q = t + 1; q < LC; ++q) y += hbk[q - t] * vg[q];
    y *= rsqrtf(ssq_c);
    p.hyo()[(size_t)ch * TT + off + t] = f2bf((y + vg[t] * p.hy_bias()[ch]) * x0[t]);
  }
  __syncthreads();
}
__device__ __forceinline__ void fnet_ctx_pair(const Params& p, int j, char* lds) {
  const int tid = ltid(), b = tid >> 8, k = tid & 255;
  float* ur = (float*)(lds + b * 4096); float* ui = ur + 256; float* cst = ui + 256; float* snt = cst + 256;
  const size_t off = (size_t)TL + (size_t)b * LC;
  ur[k] = bf2f(p.zt()[(size_t)(ZT_FR + j) * TT + off + k]); ui[k] = bf2f(p.zt()[(size_t)(ZT_FI + j) * TT + off + k]);
  { float sn, cs; sincospif((float)k / 128.f, &sn, &cs); cst[k] = cs; snt[k] = sn; }
  __syncthreads();
  {
    float y = 0;
    for (int l = 0; l < 256; ++l) { const int m = (l * k) & 255; y += cst[m] * ur[l] + snt[m] * ui[l]; }
    p.fno()[(size_t)j * TT + off + k] = f2bf(y * 0.0625f);
  }
  __syncthreads();
}
__device__ __forceinline__ void phase_fftmix(const Params& p, int layer, int bid, int nb, char* lds) {
  for (int it = bid; it < 1024; it += nb) {
    const int k = it & 511, b = k >> 8, c = k & 255;
    if (it < 512) hyena_item(p, layer, b, c, lds);
    else fnet_item(p, b, c, lds);
  }
  if (layer == 0) {
    for (int c = bid; c < 256; c += nb) { hyena_ctx_pair(p, c, lds); fnet_ctx_pair(p, c, lds); }
  }
}
constexpr int GLG = 17, NGRP = 16;
__device__ __forceinline__ int gla_chain_tok(int dir, int b, int n, int i) {
  const int base = n < 4 ? TL + b * LC : b * SEQ, len = n < 4 ? LC : SEQ, m = n < 4 ? n : n - 4;
  return dir == 0 ? base + 64 * m + i : base + (len - 1) - (64 * m + i);
}
__device__ __forceinline__ float logsig16(float x) { return (fminf(x, 0.f) - __logf(1.f + __expf(-fabsf(x)))) * (1.f / 16.f); }
__device__ __forceinline__ float wave_scan_incl(float v, int lane) {
#pragma unroll
  for (int o = 1; o < 64; o <<= 1) { const float t = __shfl_up(v, o, 64); if (lane >= o) v += t; }
  return v;
}
__device__ __forceinline__ void phase_gla_a(const Params& p, int layer, int bid, int nb, char* lds) {
  const int tid = ltid(), wid = tid >> 6, lane = tid & 63, r32 = lane & 31, hi = lane >> 5;
  const float* gb = p.gla_gk_b() + (size_t)layer * 256;
  char* wimg = lds + wid * 12288;
  for (int it = bid; it < 16 * NGRP; it += nb) {
    const int chain = it >> 4, g = it & 15, dir = chain >> 3, b = (chain >> 2) & 1, h = chain & 3;
    const int n0 = g * GLG, n1 = min(n0 + GLG, NCH), nch = n1 - n0;
    char* WT = lds + wid * 13824; char* VT = WT + 4608;
    float* dvl = (float*)(lds + 8 * 13824);
#pragma unroll
    for (int c = 0; c < 3; ++c) {
      const int cl = wid + 8 * c;
      if (cl < nch) {
        const int n = n0 + cl;
        {
          const u16* vbase = p.zg() + ZG_GV + h * 64 + lane;
          u16 vv[64];
#pragma unroll
          for (int i = 0; i < 64; ++i) vv[i] = vbase[(size_t)gla_chain_tok(dir, b, n, i) * ZG_W];
#pragma unroll
          for (int q = 0; q < 8; ++q)
            *(u32x4*)(VT + lane * 144 + q * 16) = u32x4{(unsigned)vv[8 * q] | ((unsigned)vv[8 * q + 1] << 16), (unsigned)vv[8 * q + 2] | ((unsigned)vv[8 * q + 3] << 16),
                                                       (unsigned)vv[8 * q + 4] | ((unsigned)vv[8 * q + 5] << 16), (unsigned)vv[8 * q + 6] | ((unsigned)vv[8 * q + 7] << 16)};
        }
        {
          const int kk = lane & 31, hs = lane >> 5;
          const u16* kb = p.zg() + ZG_GK + h * 32 + kk; const u16* gbp = p.zg() + ZG_GP + dir * 128 + h * 32 + kk;
          const float bias = gb[dir * 128 + h * 32 + kk];
          float bc[32], kf[32];
#pragma unroll
          for (int i = 0; i < 32; ++i) {
            const size_t ro = (size_t)gla_chain_tok(dir, b, n, hs * 32 + i) * ZG_W;
            kf[i] = bf2f(kb[ro]); bc[i] = bf2f(gbp[ro]);
          }
          float run = 0.f;
#pragma unroll
          for (int i = 0; i < 32; ++i) { const float x = bc[i] + bias; run += (fminf(x, 0.f) - __logf(1.f + __expf(-fabsf(x)))) * (1.f / 16.f); bc[i] = run; }
          const float lowtot = __shfl(run, kk, 64);
          const float uptot = __shfl(run, 32 + kk, 64);
          const float bl = lowtot + uptot, off = hs ? lowtot : 0.f;
          unsigned wp[16];
#pragma unroll
          for (int i = 0; i < 16; ++i) wp[i] = cvtpk(kf[2 * i] * __expf(bl - (bc[2 * i] + off)), kf[2 * i + 1] * __expf(bl - (bc[2 * i + 1] + off)));
#pragma unroll
          for (int q = 0; q < 4; ++q) *(u32x4*)(WT + kk * 144 + hs * 64 + q * 16) = u32x4{wp[4 * q], wp[4 * q + 1], wp[4 * q + 2], wp[4 * q + 3]};
          if (hs == 0) dvl[cl * 32 + kk] = __expf(bl);
        }
        asm volatile("s_waitcnt lgkmcnt(0)" ::: "memory");
        f32x16 d0 = {}, d1 = {};
#pragma unroll
        for (int s4 = 0; s4 < 4; ++s4) {
          const bf16x8 af = *(const bf16x8*)(WT + r32 * 144 + (16 * s4 + 8 * hi) * 2);
          const bf16x8 v0 = *(const bf16x8*)(VT + r32 * 144 + (16 * s4 + 8 * hi) * 2);
          const bf16x8 v1 = *(const bf16x8*)(VT + (32 + r32) * 144 + (16 * s4 + 8 * hi) * 2);
          d0 = __builtin_amdgcn_mfma_f32_32x32x16_bf16(af, v0, d0, 0, 0, 0);
          d1 = __builtin_amdgcn_mfma_f32_32x32x16_bf16(af, v1, d1, 0, 0, 0);
        }
        asm volatile("s_waitcnt lgkmcnt(0)" ::: "memory");
        {
          float* dg = p.gds() + ((size_t)chain * NCH + n) * 2048;
#pragma unroll
          for (int r = 0; r < 16; ++r) { dg[crow(r, hi) * 64 + r32] = d0[r]; dg[crow(r, hi) * 64 + 32 + r32] = d1[r]; }
        }
      }
      __builtin_amdgcn_sched_barrier(0);
    }
    __syncthreads();
    {
      const int kk = tid >> 4, v0 = (tid & 15) * 4;
      float st[4] = {0.f, 0.f, 0.f, 0.f}; float dcum = 1.f;
      float* gp0 = p.gds() + ((size_t)chain * NCH + n0) * 2048 + kk * 64 + v0;
      float4 av[GLG];
#pragma unroll
      for (int cl = 0; cl < GLG; ++cl) av[cl] = *(const float4*)(gp0 + (size_t)(cl < nch ? cl : 0) * 2048);
#pragma unroll
      for (int cl = 0; cl < GLG; ++cl) {
        if (cl < nch) {
          const float d = dvl[cl * 32 + kk];
          *(float4*)(gp0 + (size_t)cl * 2048) = make_float4(st[0], st[1], st[2], st[3]);
          if ((tid & 15) == 0) p.gdv()[((size_t)chain * NCH + n0 + cl) * 32 + kk] = dcum;
          st[0] = st[0] * d + av[cl].x; st[1] = st[1] * d + av[cl].y; st[2] = st[2] * d + av[cl].z; st[3] = st[3] * d + av[cl].w;
          dcum *= d;
        }
      }
      float* at = p.gst() + ((size_t)chain * NGRP + g) * 2048 + kk * 64 + v0;
      *(float4*)at = make_float4(st[0], st[1], st[2], st[3]);
      if ((tid & 15) == 0) p.gst()[(size_t)16 * NGRP * 2048 + ((size_t)chain * NGRP + g) * 32 + kk] = dcum;
    }
    __syncthreads();
  }
}

constexpr int GC_QP = 33792, GC_KP = GC_QP + 10240, GC_VT = GC_KP + 10240, GC_ST = GC_VT + 18432, GC_AX = GC_ST + 10240;
__device__ __forceinline__ void phase_gla_c(const Params& p, int layer, int bid, int nb, char* lds) {
  float* gl = (float*)lds;
  float* qraw = gl + 2 * 64 * 33;
  float* kraw = qraw + 64 * 33;
  float* Of = (float*)lds;
  char* Qp = lds + GC_QP;
  char* Kp = lds + GC_KP;
  char* VT = lds + GC_VT;
  char* ST = lds + GC_ST;
  const int tid = ltid(), wid = tid >> 6, lane = tid & 63, r32 = lane & 31, hi = lane >> 5;
  char* Ax = lds + GC_AX + wid * 4608;
  const float* gb = p.gla_gk_b() + (size_t)layer * 256;
  const int pc_lo = layer == 0 ? 0 : 4, npc = NCH - pc_lo, nitem = 8 * npc;
  const int per = (nitem + nb - 1) / nb, q_beg = bid * per, q_end = min(nitem, q_beg + per);
  const int sdir = tid >> 8, sk = (tid >> 3) & 31, sv0 = (tid & 7) * 8;
  float G[8]; int g_cached = -1, bh_cached = -1;
  const int lpos = tid >> 3, lc4 = (tid & 7) * 4;
  u32x2 rq, rk, rg0, rg1, rva, rvb; float4 pl0, pl1; float pdp;
#define GC_ITEM(q_, bh_, pc_, b_, h_, tok0_) const int bh_ = (q_) / npc, pc_ = pc_lo + (q_) % npc, b_ = bh_ >> 2, h_ = bh_ & 3; \
    const int tok0_ = pc_ < 4 ? TL + b_ * LC + pc_ * 64 : b_ * SEQ + (pc_ - 4) * 64
#define GC_LOADRAW(tok0_, h_) do { const u16* zr = p.zg() + (size_t)((tok0_) + lpos) * ZG_W; \
    rq = *(const u32x2*)(zr + ZG_GQ + (h_) * 32 + lc4); rk = *(const u32x2*)(zr + ZG_GK + (h_) * 32 + lc4); \
    rg0 = *(const u32x2*)(zr + ZG_GP + (h_) * 32 + lc4); rg1 = *(const u32x2*)(zr + ZG_GP + 128 + (h_) * 32 + lc4); \
    rva = *(const u32x2*)(zr + ZG_GV + (h_) * 64 + lc4 * 2); rvb = *(const u32x2*)(zr + ZG_GV + (h_) * 64 + lc4 * 2 + 4); } while (0)
#define GC_LOADST(pc_, b_, h_) do { const int chain_ = sdir * 8 + (b_) * 4 + (h_); \
    const int n_ = sdir == 0 ? (pc_) : ((pc_) < 4 ? 3 - (pc_) : 4 + 255 - ((pc_) - 4)); \
    const float* lp_ = p.gds() + ((size_t)chain_ * NCH + n_) * 2048 + sk * 64 + sv0; \
    pl0 = *(const float4*)lp_; pl1 = *(const float4*)(lp_ + 4); pdp = p.gdv()[((size_t)chain_ * NCH + n_) * 32 + sk]; } while (0)
  if (q_beg < q_end) { GC_ITEM(q_beg, bh0, pc0, b0, h0, t00); GC_LOADRAW(t00, h0); GC_LOADST(pc0, b0, h0); }
  for (int qi = q_beg; qi < q_end; ++qi) {
    GC_ITEM(qi, bh, pc, b, h, tok0);
    {
      const int pos = lpos, c4 = lc4;
      const float sc = 0.17677669529663687f;
      qraw[pos * 33 + c4] = BF_LO(rq[0]) * sc; qraw[pos * 33 + c4 + 1] = BF_HI(rq[0]) * sc; qraw[pos * 33 + c4 + 2] = BF_LO(rq[1]) * sc; qraw[pos * 33 + c4 + 3] = BF_HI(rq[1]) * sc;
      kraw[pos * 33 + c4] = BF_LO(rk[0]); kraw[pos * 33 + c4 + 1] = BF_HI(rk[0]); kraw[pos * 33 + c4 + 2] = BF_LO(rk[1]); kraw[pos * 33 + c4 + 3] = BF_HI(rk[1]);
#pragma unroll
      for (int d = 0; d < 2; ++d) {
        const u32x2 rg = d ? rg1 : rg0; const float4 bb = *(const float4*)(gb + d * 128 + h * 32 + c4);
        const int i = d ? 63 - pos : pos;
        float* gd = gl + (d * 64 + i) * 33 + c4;
        gd[0] = logsig16(BF_LO(rg[0]) + bb.x); gd[1] = logsig16(BF_HI(rg[0]) + bb.y); gd[2] = logsig16(BF_LO(rg[1]) + bb.z); gd[3] = logsig16(BF_HI(rg[1]) + bb.w);
      }
#pragma unroll
      for (int j = 0; j < 4; ++j) {
        const unsigned w = j < 2 ? rva[j] : rvb[j - 2]; const int v = c4 * 2 + 2 * j;
        *(u16*)(VT + (0 * 64 + v) * 144 + pos * 2) = (u16)(w & 0xFFFFu); *(u16*)(VT + (1 * 64 + v) * 144 + (63 - pos) * 2) = (u16)(w & 0xFFFFu);
        *(u16*)(VT + (0 * 64 + v + 1) * 144 + pos * 2) = (u16)(w >> 16); *(u16*)(VT + (1 * 64 + v + 1) * 144 + (63 - pos) * 2) = (u16)(w >> 16);
      }
    }
    if (qi + 1 < q_end) { GC_ITEM(qi + 1, bhn, pcn, bn, hn, t0n); GC_LOADRAW(t0n, hn); }
    __syncthreads();
    {
      const int col = tid & 63, d = col >> 5, c = col & 31, part = tid >> 6;
      float* ptot = (float*)(lds + GC_AX);
      float bv[8]; float run = 0.f;
#pragma unroll
      for (int j = 0; j < 8; ++j) { run += gl[(d * 64 + part * 8 + j) * 33 + c]; bv[j] = run; }
      ptot[part * 64 + col] = run;
      __syncthreads();
      float off = 0.f;
#pragma unroll
      for (int q = 0; q < 7; ++q) off += (q < part) ? ptot[q * 64 + col] : 0.f;
#pragma unroll
      for (int j = 0; j < 8; ++j) gl[(d * 64 + part * 8 + j) * 33 + c] = bv[j] + off;
    }
    __syncthreads();
    {
#pragma unroll
      for (int e = 0; e < 2; ++e) {
        const int idx = tid + e * 512, d = idx >> 9, i = (idx >> 3) & 63, c4 = (idx & 7) * 4, pos = d ? 63 - i : i;
        float qo[4], ko[4];
#pragma unroll
        for (int j = 0; j < 4; ++j) {
          const float bi = gl[(d * 64 + i) * 33 + c4 + j], bm = gl[(d * 64 + 31) * 33 + c4 + j];
          qo[j] = qraw[pos * 33 + c4 + j] * __expf(bi - bm); ko[j] = kraw[pos * 33 + c4 + j] * __expf(bm - bi);
        }
        *(u32x2*)(Qp + (d * 64 + i) * 80 + c4 * 2) = u32x2{cvtpk(qo[0], qo[1]), cvtpk(qo[2], qo[3])};
        *(u32x2*)(Kp + (d * 64 + i) * 80 + c4 * 2) = u32x2{cvtpk(ko[0], ko[1]), cvtpk(ko[2], ko[3])};
      }
      const int chain = sdir * 8 + b * 4 + h;
      const int n = sdir == 0 ? pc : (pc < 4 ? 3 - pc : 4 + 255 - (pc - 4)), g = n / GLG;
      if (g != g_cached || bh != bh_cached) {
#pragma unroll
        for (int j = 0; j < 8; ++j) G[j] = 0.f;
        const float* at = p.gst() + (size_t)chain * NGRP * 2048 + sk * 64 + sv0;
        const float* dt = p.gst() + (size_t)16 * NGRP * 2048 + (size_t)chain * NGRP * 32 + sk;
        for (int gg = 0; gg < g; ++gg) {
          const float4 a0 = *(const float4*)(at + (size_t)gg * 2048), a1 = *(const float4*)(at + (size_t)gg * 2048 + 4); const float dd = dt[gg * 32];
          G[0] = G[0] * dd + a0.x; G[1] = G[1] * dd + a0.y; G[2] = G[2] * dd + a0.z; G[3] = G[3] * dd + a0.w;
          G[4] = G[4] * dd + a1.x; G[5] = G[5] * dd + a1.y; G[6] = G[6] * dd + a1.z; G[7] = G[7] * dd + a1.w;
        }
        g_cached = g; bh_cached = bh;
      }
      const float4 l0 = pl0, l1 = pl1; const float dp = pdp;
      const float em = __expf(gl[(sdir * 64 + 31) * 33 + sk]);
      const float sv[8] = {l0.x + dp * G[0], l0.y + dp * G[1], l0.z + dp * G[2], l0.w + dp * G[3], l1.x + dp * G[4], l1.y + dp * G[5], l1.z + dp * G[6], l1.w + dp * G[7]};
      if (qi + 1 < q_end) { GC_ITEM(qi + 1, bhn, pcn, bn, hn, t0n); (void)bhn; (void)t0n; GC_LOADST(pcn, bn, hn); }
#pragma unroll
      for (int j = 0; j < 8; ++j) *(u16*)(ST + (sdir * 64 + sv0 + j) * 80 + sk * 2) = f2bf(sv[j] * em);
    }
    __syncthreads();
    {
      const int d = wid >> 2, ib = (wid >> 1) & 1, vb = wid & 1;
      const char* Qd = Qp + d * 64 * 80; const char* Kd = Kp + d * 64 * 80; const char* Vd = VT + d * 64 * 144; const char* Sd = ST + d * 64 * 80;
      bf16x8 qf[2];
#pragma unroll
      for (int s2 = 0; s2 < 2; ++s2) qf[s2] = *(const bf16x8*)(Qd + (ib * 32 + r32) * 80 + (16 * s2 + 8 * hi) * 2);
#pragma unroll
      for (int jb = 0; jb < 2; ++jb) {
        if (jb <= ib) {
          f32x16 x = {};
#pragma unroll
          for (int s2 = 0; s2 < 2; ++s2) {
            const bf16x8 kf = *(const bf16x8*)(Kd + (jb * 32 + r32) * 80 + (16 * s2 + 8 * hi) * 2);
            x = __builtin_amdgcn_mfma_f32_32x32x16_bf16(qf[s2], kf, x, 0, 0, 0);
          }
#pragma unroll
          for (int r = 0; r < 16; ++r) {
            const int il = crow(r, hi), i = ib * 32 + il, j = jb * 32 + r32;
            *(u16*)(Ax + il * 144 + j * 2) = f2bf(j <= i ? x[r] : 0.f);
          }
        }
      }
      asm volatile("s_waitcnt lgkmcnt(0)" ::: "memory");
      f32x16 o = {};
#pragma unroll
      for (int s4 = 0; s4 < 4; ++s4) {
        if (s4 < 2 * (ib + 1)) {
          const bf16x8 af = *(const bf16x8*)(Ax + r32 * 144 + (16 * s4 + 8 * hi) * 2);
          const bf16x8 vf = *(const bf16x8*)(Vd + (vb * 32 + r32) * 144 + (16 * s4 + 8 * hi) * 2);
          o = __builtin_amdgcn_mfma_f32_32x32x16_bf16(af, vf, o, 0, 0, 0);
        }
      }
#pragma unroll
      for (int s2 = 0; s2 < 2; ++s2) {
        const bf16x8 sf = *(const bf16x8*)(Sd + (vb * 32 + r32) * 80 + (16 * s2 + 8 * hi) * 2);
        o = __builtin_amdgcn_mfma_f32_32x32x16_bf16(qf[s2], sf, o, 0, 0, 0);
      }
#pragma unroll
      for (int r = 0; r < 16; ++r) {
        const int i = ib * 32 + crow(r, hi), pos = d ? 63 - i : i;
        Of[(d * 64 + pos) * 65 + vb * 32 + r32] = o[r];
      }
    }
    __syncthreads();
    {
      const int pos = tid >> 3, v0 = (tid & 7) * 8;
      float r8[8]; float ss = 0.f;
#pragma unroll
      for (int j = 0; j < 8; ++j) { r8[j] = Of[pos * 65 + v0 + j] + Of[(64 + pos) * 65 + v0 + j]; ss += r8[j] * r8[j]; }
      ss += shx<4>(ss); ss += shx<2>(ss); ss += shx<1>(ss);
      const float rs = rsqrtf(ss * (1.f / 64.f) + EPS);
      const u16* og = p.zg() + (size_t)(tok0 + pos) * ZG_W + ZG_OG + h * 64 + v0;
      const float4 g0 = ld4bf(og), g1 = ld4bf(og + 4);
      *(u32x4*)(p.ymix() + (size_t)(tok0 + pos) * DM + 512 + h * 64 + v0) =
          u32x4{cvtpk(r8[0] * rs * silu_f(g0.x), r8[1] * rs * silu_f(g0.y)), cvtpk(r8[2] * rs * silu_f(g0.z), r8[3] * rs * silu_f(g0.w)),
                cvtpk(r8[4] * rs * silu_f(g1.x), r8[5] * rs * silu_f(g1.y)), cvtpk(r8[6] * rs * silu_f(g1.z), r8[7] * rs * silu_f(g1.w))};
    }
    __syncthreads();
  }
}

__device__ __forceinline__ void phase_mix(const Params& p, int layer, int bid, int nb, char* lds) {
  float* part = (float*)lds;
  u16* tile = (u16*)(lds + 4096);
  const int tid = ltid(), wid = tid >> 6, lane = tid & 63;
  const int ntok = layer == 0 ? TT : TL;
  for (int it = bid; it < ntok / 64; it += nb) {
    const int tok0 = it * 64;
    float vh[32], vf[32]; float sh = 0, sf = 0;
#pragma unroll
    for (int c = 0; c < 32; ++c) {
      vh[c] = bf2f(p.hyo()[(size_t)(wid * 32 + c) * TT + tok0 + lane]); vf[c] = bf2f(p.fno()[(size_t)(wid * 32 + c) * TT + tok0 + lane]);
      sh += vh[c] * vh[c]; sf += vf[c] * vf[c];
    }
    part[(0 * 8 + wid) * 64 + lane] = sh; part[(1 * 8 + wid) * 64 + lane] = sf;
    __syncthreads();
    float th = 0, tf = 0;
#pragma unroll
    for (int q = 0; q < 8; ++q) { th += part[(0 * 8 + q) * 64 + lane]; tf += part[(1 * 8 + q) * 64 + lane]; }
    const float rh = rsqrtf(th * (1.f / 256.f) + EPS), rf = rsqrtf(tf * (1.f / 256.f) + EPS);
#pragma unroll
    for (int c = 0; c < 32; ++c) { tile[lane * 520 + wid * 32 + c] = f2bf(vh[c] * rh); tile[lane * 520 + 256 + wid * 32 + c] = f2bf(vf[c] * rf); }
    __syncthreads();
    for (int g = tid; g < 64 * 64; g += NTHR) {
      const int tl = g >> 6, cg = g & 63;
      const u32x4 w = *(const u32x4*)(tile + tl * 520 + cg * 8);
      *(u32x4*)(p.ymix() + (size_t)(tok0 + tl) * DM + (cg < 32 ? 256 + cg * 8 : 768 + (cg - 32) * 8)) = w;
    }
    __syncthreads();
  }
}

struct EpiOut {
  const Params* pp; int layer;
  __device__ __forceinline__ void pre(const G8Unit& u, int, int, float (&)[8], float* cb) const {
    if ((ltid() >> 6) == 0) g8_cload(pp->mod() + ((size_t)layer * 3 + modv(u.pm * 256)) * 6144 + 2 * DM + u.pn * 256, cb);
  }
  __device__ __forceinline__ void operator()(const f32x4 (&acc)[2][2][4][2], const G8Unit& u, int wr, int wc, int fr, int fq, const float (&)[8], const float* cb) const {
    const Params& p = *pp;
#pragma unroll
    for (int bj = 0; bj < 2; ++bj) {
      const int c0 = u.pn * 256 + bj * 128 + wc * 32 + 8 * fq;
      const f32x4 ga = *(const f32x4*)(cb + bj * 128 + wc * 32 + 8 * fq), gb = *(const f32x4*)(cb + bj * 128 + wc * 32 + 8 * fq + 4);
#pragma unroll
      for (int ai = 0; ai < 2; ++ai) {
      if (layer == 0) {
        f32x4 xa[4], xb[4];
#pragma unroll
        for (int q = 0; q < 4; ++q) {
          const int tok = u.pm * 256 + ai * 128 + wr * 64 + q * 16 + fr;
          const float* xr = resid_row_in(p, tok) + c0; xa[q] = *(const f32x4*)xr; xb[q] = *(const f32x4*)(xr + 4);
        }
#pragma unroll
        for (int q = 0; q < 4; ++q) {
          const int tok = u.pm * 256 + ai * 128 + wr * 64 + q * 16 + fr;
          const f32x4 ya = xa[q] + ga * acc[ai][bj][q][0], yb = xb[q] + gb * acc[ai][bj][q][1];
          *(u32x4*)(p.X() + (size_t)tok * DM + c0) = u32x4{cvtpk(ya[0], ya[1]), cvtpk(ya[2], ya[3]), cvtpk(yb[0], yb[1]), cvtpk(yb[2], yb[3])};
        }
      } else {
        u32x4 w[4];
#pragma unroll
        for (int q = 0; q < 4; ++q) {
          const int tok = u.pm * 256 + ai * 128 + wr * 64 + q * 16 + fr;
          w[q] = *(const u32x4*)(p.X() + (size_t)tok * DM + c0);
        }
#pragma unroll
        for (int q = 0; q < 4; ++q) {
          const int tok = u.pm * 256 + ai * 128 + wr * 64 + q * 16 + fr;
          const f32x4 xa = f32x4{__uint_as_float(w[q][0] << 16), __uint_as_float(w[q][0] & 0xFFFF0000u), __uint_as_float(w[q][1] << 16), __uint_as_float(w[q][1] & 0xFFFF0000u)};
          const f32x4 xb = f32x4{__uint_as_float(w[q][2] << 16), __uint_as_float(w[q][2] & 0xFFFF0000u), __uint_as_float(w[q][3] << 16), __uint_as_float(w[q][3] & 0xFFFF0000u)};
          const f32x4 ya = xa + ga * acc[ai][bj][q][0], yb = xb + gb * acc[ai][bj][q][1];
          *(u32x4*)(p.X() + (size_t)tok * DM + c0) = u32x4{cvtpk(ya[0], ya[1]), cvtpk(ya[2], ya[3]), cvtpk(yb[0], yb[1]), cvtpk(yb[2], yb[3])};
        }
      }
      }
    }
  }
};
__device__ __forceinline__ void phase_gemm_out(const Params& p, int layer, int bid, int nb, char* lds) {
  G8Plain S; S.nM = (layer == 0 ? TT : TL) / 256; S.nN = DM / 256; S.Kb = 2 * DM; S.G = nb; S.c = bid; S.Bt = (const char*)(p.bt_out() + (size_t)layer * DM * DM);
  EpiOut E; E.pp = &p; E.layer = layer;
  gemm8_phase<false>(lds, (const char*)p.ymix(), 2 * DM, S, E);
}

__device__ __forceinline__ void phase_norm2_router(const Params& p, int layer, int bid, int nb, char* lds) {
  float* rwl = (float*)lds;
  int* lcnt = (int*)(lds + 131072);
  int* lbase = lcnt + 32;
  int* ent = lbase + 32;
  float* entw = (float*)(ent + 2 * 640);
  float* ents = entw + 640;
  const int tid = ltid(), wid = tid >> 6, lane = tid & 63;
  const int ntok = layer == 0 ? TT : TL;
  const float* rw = p.router_w() + (size_t)layer * DM * NE;
  for (int i = tid; i < DM * NE / 4; i += NTHR) {
    const int k = i >> 3, q4 = i & 7;
    ((float4*)rwl)[q4 * 1024 + ((k & 3) * 256 + (k >> 2))] = ((const float4*)rw)[i];
  }
  if (tid < 32) lcnt[tid] = 0;
  __syncthreads();
  const float* gn = p.norm2_g() + layer * DM; const float* rb = p.router_b() + layer * NE;
  const int per = (ntok + nb - 1) / nb, t_beg = bid * per, t_end = min(ntok, t_beg + per);
  auto prep = [&](int tok, float (&v)[16]) __attribute__((always_inline)) -> float {
    const u16* xr = p.X() + (size_t)tok * DM;
#pragma unroll
    for (int i = 0; i < 4; ++i) { const float4 a = ld4bf(xr + lane * 4 + i * 256); v[4 * i] = a.x; v[4 * i + 1] = a.y; v[4 * i + 2] = a.z; v[4 * i + 3] = a.w; }
    float ss = 0;
#pragma unroll
    for (int i = 0; i < 16; ++i) ss += v[i] * v[i];
    ss = wave_sum(ss);
    const float rs = rsqrtf(ss * (1.f / DM) + EPS);
    const float* md = p.mod() + ((size_t)layer * 3 + modv(tok)) * 6144 + 3 * DM;
#pragma unroll
    for (int i = 0; i < 4; ++i) {
      const int c = lane * 4 + i * 256;
      const float4 g = *(const float4*)(gn + c), sh = *(const float4*)(md + c), sc = *(const float4*)(md + DM + c);
      v[4 * i] = v[4 * i] * rs * g.x * (1.f + sc.x) + sh.x; v[4 * i + 1] = v[4 * i + 1] * rs * g.y * (1.f + sc.y) + sh.y;
      v[4 * i + 2] = v[4 * i + 2] * rs * g.z * (1.f + sc.z) + sh.z; v[4 * i + 3] = v[4 * i + 3] * rs * g.w * (1.f + sc.w) + sh.w;
    }
    return store_row_i8(v, p.H() + (size_t)tok * DM, p.hs() + tok, lane);
  };
  auto post = [&](const float (&lg)[32], int tok, float rowsc) __attribute__((always_inline)) {
    float r16[16], r8[8], r4[4], r2[2], lv;
    { const bool up = lane & 32;
#pragma unroll
      for (int e = 0; e < 16; ++e) { const float keep = up ? lg[16 + e] : lg[e], send = up ? lg[e] : lg[16 + e]; r16[e] = keep + shx<32>(send); } }
    { const bool up = lane & 16;
#pragma unroll
      for (int e = 0; e < 8; ++e) { const float keep = up ? r16[8 + e] : r16[e], send = up ? r16[e] : r16[8 + e]; r8[e] = keep + shx<16>(send); } }
    { const bool up = lane & 8;
#pragma unroll
      for (int e = 0; e < 4; ++e) { const float keep = up ? r8[4 + e] : r8[e], send = up ? r8[e] : r8[4 + e]; r4[e] = keep + shx<8>(send); } }
    { const bool up = lane & 4;
#pragma unroll
      for (int e = 0; e < 2; ++e) { const float keep = up ? r4[2 + e] : r4[e], send = up ? r4[e] : r4[2 + e]; r2[e] = keep + shx<4>(send); } }
    { const bool up = lane & 2; const float keep = up ? r2[1] : r2[0], send = up ? r2[0] : r2[1]; lv = keep + shx<2>(send); }
    lv += shx<1>(lv);
    lv += rb[lane >> 1];
    int ids[4]; float vals[4];
#pragma unroll
    for (int k = 0; k < 4; ++k) {
      const float mx = wave_max(lv);
      const unsigned long long bal = __ballot(lv == mx);
      const int win = __ffsll((long long)bal) - 1;
      ids[k] = win >> 1; vals[k] = mx;
      if ((lane >> 1) == ids[k]) lv = -3.4e38f;
    }
    if (lane == 0) {
      const float mx = vals[0];
      float ex[4], sum = 0;
#pragma unroll
      for (int k = 0; k < 4; ++k) { ex[k] = __expf(vals[k] - mx); sum += ex[k]; }
      const float inv = 1.f / sum;
#pragma unroll
      for (int k = 0; k < 4; ++k) {
        const int lp = atomicAdd(&lcnt[ids[k]], 1);
        const int slot = (tok - t_beg) * 4 + k;
        ent[2 * slot] = tok * 4 + k; ent[2 * slot + 1] = (ids[k] << 20) | lp; entw[slot] = ex[k] * inv; ents[slot] = rowsc;
      }
    }
  };
  for (int tok0 = t_beg + wid; tok0 < t_end; tok0 += 16) {
    const int tok1 = tok0 + 8; const bool has1 = tok1 < t_end;
    float va[16], vb[16];
    const float rsa = prep(tok0, va);
    const float rsb = prep(has1 ? tok1 : tok0, vb);
    typedef float f2r __attribute__((ext_vector_type(2)));
    f2r ab[16], l2[32];
#pragma unroll
    for (int i = 0; i < 16; ++i) ab[i] = f2r{va[i], vb[i]};
#pragma unroll
    for (int e = 0; e < 32; ++e) l2[e] = f2r{0.f, 0.f};
#pragma unroll
    for (int i = 0; i < 16; ++i) {
      const float4* wr4 = (const float4*)rwl + ((i & 3) * 256 + (i >> 2) * 64 + lane);
#pragma unroll
      for (int q = 0; q < 8; ++q) {
        const float4 w = wr4[q * 1024];
        l2[4 * q] += ab[i] * f2r{w.x, w.x}; l2[4 * q + 1] += ab[i] * f2r{w.y, w.y}; l2[4 * q + 2] += ab[i] * f2r{w.z, w.z}; l2[4 * q + 3] += ab[i] * f2r{w.w, w.w};
      }
    }
    float la[32], lb[32];
#pragma unroll
    for (int e = 0; e < 32; ++e) { la[e] = l2[e][0]; lb[e] = l2[e][1]; }
    post(la, tok0, rsa);
    if (has1) post(lb, tok1, rsb);
  }
  __syncthreads();
  if (tid < 32) lbase[tid] = atomicAdd(&p.cnt()[layer * NE + tid], lcnt[tid]);
  __syncthreads();
  const int nas = (t_end > t_beg ? (t_end - t_beg) : 0) * 4;
  for (int s = tid; s < nas; s += NTHR) {
    const int tk = ent[2 * s], el = ent[2 * s + 1], e = el >> 20, pos = lbase[e] + (el & 0xFFFFF);
    p.rtok()[(size_t)e * TT + pos] = tk >> 2; p.rw()[(size_t)e * TT + pos] = entw[s]; p.rsc()[(size_t)e * TT + pos] = ents[s];
    p.tslot()[tk] = (e << 20) | pos;
  }
}

template <bool GATH> struct G8MoeT {
  static constexpr bool GATHER = GATH;
  __device__ __forceinline__ void rows_to_lds(const G8Unit& u, int* dst) const {
    __builtin_amdgcn_global_load_lds((const unsigned*)(rtok + (size_t)u.e * TT + u.pm * 256 + (ltid() & 63) * 4), (LAS3 unsigned*)dst, 16, 0, 0);
  }
  const int* cnt;
  int ntn, Kb, G, c; const char* Bt; size_t bstride;
  const int* rtok;
  __device__ __forceinline__ bool next(int i, G8Unit& u, const G8Unit& from) const {
    const int w = (i * 8 + (c & 7)) * (G >> 3) + (c >> 3);
    int acc = from.ab, rows = from.pre;
    for (int ee = from.e; ee < NE; ++ee) {
      const int cc = cnt[ee], tiles = ((cc + 255) >> 8) * ntn;
      if (w < acc + tiles) { const int r = w - acc; u.e = ee; u.pm = r / ntn; u.pn = r % ntn; u.ce = cc; u.pre = rows; u.ab = acc; return true; }
      acc += tiles; rows += cc;
    }
    return false;
  }
  __device__ __forceinline__ int a_row(const G8Unit& u, int row) const {
    const int r = min(u.pm * 256 + row, u.ce - 1);
    return rtok ? rtok[(size_t)u.e * TT + r] : u.pre + r;
  }
  __device__ __forceinline__ unsigned a_off(const G8Unit& u, int row) const { return (unsigned)a_row(u, row) * (unsigned)Kb; }
  __device__ __forceinline__ const char* b_ptr(const G8Unit& u) const { return Bt + (size_t)u.e * bstride + (size_t)u.pn * 256 * Kb; }
};
struct EpiGu {
  const float* bgl; u16* act; const float* rsc; const float* swl;
  __device__ __forceinline__ void pre(const G8Unit& u, int wr, int fr, float (&ep)[8], float* cb) const {
    if ((ltid() >> 6) == 0) g8_cload(bgl + (size_t)u.e * 2048 + u.pn * 256, cb);
    if ((ltid() >> 6) == 1) g8_cload(swl + (size_t)u.e * 2048 + u.pn * 256, cb + 256);
    if ((ltid() >> 6) == 2) g8_cload(rsc + (size_t)u.e * TT + u.pm * 256, cb + 512);
  }
  __device__ __forceinline__ void operator()(const i32x4 (&acc)[2][2][4][2], const G8Unit& u, int wr, int wc, int fr, int fq, const float (&ep)[8], const float* cb) const {
    const int j0 = u.pn * 128 + wc * 32 + 8 * fq;
    typedef float f2v __attribute__((ext_vector_type(2)));
    const float* bg = cb + 2 * (wc * 32 + 8 * fq);
    f2v bgt[4], bup[4], sg[4], su[4];
#pragma unroll
    for (int q = 0; q < 4; ++q) { const f32x4 t = *(const f32x4*)(bg + 4 * q); bgt[q] = f2v{t[0], t[2]}; bup[q] = f2v{t[1], t[3]}; asm volatile("" : "+v"(bgt[q]), "+v"(bup[q])); }
    {
      const float* sp = cb + 256 + wc * 32 + 8 * fq;
      const f32x4 g0 = *(const f32x4*)sp, g1 = *(const f32x4*)(sp + 4), u0 = *(const f32x4*)(sp + 128), u1 = *(const f32x4*)(sp + 132);
      sg[0] = f2v{g0[0], g0[1]}; sg[1] = f2v{g0[2], g0[3]}; sg[2] = f2v{g1[0], g1[1]}; sg[3] = f2v{g1[2], g1[3]};
      su[0] = f2v{u0[0], u0[1]}; su[1] = f2v{u0[2], u0[3]}; su[2] = f2v{u1[0], u1[1]}; su[3] = f2v{u1[2], u1[3]};
    }
    const f2v kexp = f2v{-1.702f * 1.4426950408889634f, -1.702f * 1.4426950408889634f}, one2 = f2v{1.f, 1.f};
#pragma unroll
    for (int ai = 0; ai < 2; ++ai)
#pragma unroll
      for (int m = 0; m < 4; ++m) {
        const int r = u.pm * 256 + ai * 128 + wr * 64 + m * 16 + fr;
        if (r < u.ce) {
          const float sa = cb[512 + ai * 128 + wr * 64 + m * 16 + fr]; const f2v sa2 = f2v{sa, sa};
          unsigned ow[4];
#pragma unroll
          for (int n = 0; n < 2; ++n)
#pragma unroll
            for (int jp = 0; jp < 2; ++jp) {
              const int q = 2 * n + jp;
              f2v g = f2v{(float)acc[ai][0][m][n][2 * jp], (float)acc[ai][0][m][n][2 * jp + 1]};
              f2v v = f2v{(float)acc[ai][1][m][n][2 * jp], (float)acc[ai][1][m][n][2 * jp + 1]};
              g = (g * sa2) * sg[q] + bgt[q];
              v = (v * sa2) * su[q] + bup[q];
              g = f2v{fminf(g[0], 7.f), fminf(g[1], 7.f)};
              v = f2v{__builtin_amdgcn_fmed3f(v[0], -7.f, 7.f), __builtin_amdgcn_fmed3f(v[1], -7.f, 7.f)};
              const f2v t = g * kexp;
              const f2v d = f2v{__builtin_amdgcn_exp2f(t[0]), __builtin_amdgcn_exp2f(t[1])} + one2;
              const f2v rr = f2v{__builtin_amdgcn_rcpf(d[0]), __builtin_amdgcn_rcpf(d[1])};
              const f2v o = (v * g + g) * rr;
              ow[q] = cvtpk(o[0], o[1]);
            }
          *(u32x4*)(act + (size_t)(u.pre + r) * DFF + j0) = u32x4{ow[0], ow[1], ow[2], ow[3]};
        }
      }
  }
};
struct EpiDn {
  const float* bdl; const float* rw; unsigned char* yd;
  __device__ __forceinline__ void pre(const G8Unit& u, int wr, int fr, float (&ep)[8], float* cb) const {
    if ((ltid() >> 6) == 0) g8_cload(bdl + (size_t)u.e * DM + u.pn * 256, cb);
    if ((ltid() >> 6) == 2) g8_cload(rw + (size_t)u.e * TT + u.pm * 256, cb + 512);
  }
  __device__ __forceinline__ void operator()(const f32x4 (&acc)[2][2][4][2], const G8Unit& u, int wr, int wc, int fr, int fq, const float (&ep)[8], const float* cb) const {
#pragma unroll
    for (int bj = 0; bj < 2; ++bj) {
      const int c0 = u.pn * 256 + bj * 128 + wc * 32 + 8 * fq;
      const f32x4 ba = *(const f32x4*)(cb + bj * 128 + wc * 32 + 8 * fq), bb = *(const f32x4*)(cb + bj * 128 + wc * 32 + 8 * fq + 4);
#pragma unroll
      for (int ai = 0; ai < 2; ++ai)
#pragma unroll
        for (int m = 0; m < 4; ++m) {
          const int r = u.pm * 256 + ai * 128 + wr * 64 + m * 16 + fr;
          if (r < u.ce) {
            const float wgt = cb[512 + ai * 128 + wr * 64 + m * 16 + fr];
            const float w8 = wgt * 8.f;
            f32x4 a = (acc[ai][bj][m][0] + ba) * w8, b = (acc[ai][bj][m][1] + bb) * w8;
#pragma unroll
            for (int j = 0; j < 4; ++j) { a[j] = fminf(fmaxf(a[j], -440.f), 440.f); b[j] = fminf(fmaxf(b[j], -440.f), 440.f); }
            int w0 = 0, w1 = 0;
            w0 = __builtin_amdgcn_cvt_pk_fp8_f32(a[0], a[1], w0, false); w0 = __builtin_amdgcn_cvt_pk_fp8_f32(a[2], a[3], w0, true);
            w1 = __builtin_amdgcn_cvt_pk_fp8_f32(b[0], b[1], w1, false); w1 = __builtin_amdgcn_cvt_pk_fp8_f32(b[2], b[3], w1, true);
            *(u32x2*)(yd + (size_t)(u.pre + r) * DM + c0) = u32x2{(unsigned)w0, (unsigned)w1};
          }
        }
    }
  }
};
__device__ __forceinline__ void phase_moe_gu(const Params& p, int layer, int bid, int nb, char* lds) {
  int* scnt = (int*)(lds + 131072);
  if (ltid() < NE) scnt[ltid()] = p.cnt()[layer * NE + ltid()];
  __syncthreads();
  G8MoeT<true> S; S.cnt = scnt; S.ntn = 8; S.Kb = DM; S.G = nb; S.c = bid; S.Bt = (const char*)(p.bt_gu() + (size_t)layer * NE * 2048 * DM); S.bstride = (size_t)2048 * DM; S.rtok = p.rtok();
  EpiGu E; E.bgl = p.moe_b_gu() + (size_t)layer * NE * 2048; E.act = p.act(); E.rsc = p.rsc(); E.swl = p.swgu() + (size_t)layer * NE * 2048;
  gemm8_phase<true>(lds, (const char*)p.H(), DM, S, E);
}
__device__ __forceinline__ void phase_moe_dn(const Params& p, int layer, int bid, int nb, char* lds) {
  int* scnt = (int*)(lds + 131072);
  if (ltid() < NE) scnt[ltid()] = p.cnt()[layer * NE + ltid()];
  __syncthreads();
  G8MoeT<false> S; S.cnt = scnt; S.ntn = 4; S.Kb = 2 * DFF; S.G = nb; S.c = bid; S.Bt = (const char*)(p.bt_dn() + (size_t)layer * NE * DM * DFF); S.bstride = (size_t)DM * DFF * 2; S.rtok = nullptr;
  EpiDn E; E.bdl = p.moe_b_down() + (size_t)layer * NE * DM; E.rw = p.rw(); E.yd = p.yd();
  gemm8_phase<false>(lds, (const char*)p.act(), 2 * DFF, S, E);
}

__device__ __forceinline__ void phase_final(const Params& p, int bid, int nb, char* lds) {
  int* pre = (int*)lds;
  expert_prefix(p.cnt() + NE, pre); __syncthreads();
  const int wid = ltid() >> 6, lane = ltid() & 63;
  for (int tok = bid * 8 + wid; tok < TL; tok += nb * 8) {
    float v[16];
    load_row_comb(p, 1, 1, tok, lane, pre, v);
    float ss = 0;
#pragma unroll
    for (int i = 0; i < 16; ++i) ss += v[i] * v[i];
    ss = wave_sum(ss);
    const float rs = rsqrtf(ss * (1.f / DM) + EPS);
    float* o = p.out() + (size_t)tok * DM;
#pragma unroll
    for (int i = 0; i < 4; ++i) {
      const int c = lane * 4 + i * 256;
      const float4 g = *(const float4*)(p.final_g() + c);
      *(float4*)(o + c) = make_float4(v[4 * i] * rs * g.x, v[4 * i + 1] * rs * g.y, v[4 * i + 2] * rs * g.z, v[4 * i + 3] * rs * g.w);
    }
  }
}

#define XB_TMO      128
#define XB_XCNT(j)  (256  + 64 * (j))
#define XB_XSUB(j)  (1280 + 64 * (j))
#define XB_XGEN(j)  (2304 + 64 * (j))
#define XB_TOP      3328
#define XB_TOPGEN   3392
#define XCD_BAR_WORDS 3456
#define XB_SPIN_CAP (1u << 18)
#define LAS __attribute__((address_space(3)))

__device__ __forceinline__ unsigned xb_ld(unsigned* p)              { return __hip_atomic_load(p, __ATOMIC_RELAXED, __HIP_MEMORY_SCOPE_AGENT); }
__device__ __forceinline__ unsigned xb_add(unsigned* p, unsigned v) { return __hip_atomic_fetch_add(p, v, __ATOMIC_RELAXED, __HIP_MEMORY_SCOPE_AGENT); }
__device__ __forceinline__ unsigned xb_xcc_id() { return (unsigned)__builtin_amdgcn_s_getreg((3 << 11) | 20) & 0xFu; }
#define XB_SPIN(cond, bar) do { unsigned _sp = 0; while (cond) { __builtin_amdgcn_s_sleep(1); \
    if ((++_sp & 255u) == 0u) { if (xb_ld(&(bar)[XB_TMO])) break; if (_sp > XB_SPIN_CAP) { atomicAdd(&(bar)[XB_TMO], 1u); break; } } } } while (0)

struct XcdBarrier {
    unsigned* bar; unsigned x;
    volatile LAS unsigned* st;
};

__device__ __forceinline__ XcdBarrier xcd_barrier_post(unsigned* bar, volatile LAS unsigned* st) {
    XcdBarrier b; b.bar = bar; b.x = xb_xcc_id(); b.st = st;
    if (threadIdx.x == 0) (void)xb_add(&bar[XB_XCNT(b.x)], 1u);
    return b;
}
__device__ __forceinline__ void xcd_barrier_complete(unsigned* bar, unsigned x, unsigned& nloc, unsigned& nx) {
    const unsigned G = gridDim.x * gridDim.y * gridDim.z;
    unsigned sum, cnt, mine, sp = 0u;
    for (;;) {
        sum = 0u; cnt = 0u; mine = 0u;
#pragma unroll
        for (unsigned j = 0; j < 16; ++j) { const unsigned c = xb_ld(&bar[XB_XCNT(j)]); sum += c; cnt += (c > 0u) ? 1u : 0u; mine = (j == x) ? c : mine; }
        if (sum == G) break;
        __builtin_amdgcn_s_sleep(1);
        if ((++sp & 255u) == 0u) { if (xb_ld(&bar[XB_TMO])) break; if (sp > XB_SPIN_CAP) { atomicAdd(&bar[XB_TMO], 1u); break; } }
    }
    nloc = mine > 0u ? mine : 1u; nx = cnt > 0u ? cnt : 1u;
}

__device__ __forceinline__ void xcd_barrier(const XcdBarrier& b) {
    asm volatile("s_waitcnt vmcnt(0)" ::: "memory");
    __syncthreads();
    if (threadIdx.x == 0) {
        unsigned* bar = b.bar;
        __builtin_amdgcn_s_waitcnt(0);
        unsigned nloc = b.st[0], nx = b.st[1];
        if (nloc == 0u) { xcd_barrier_complete(bar, b.x, nloc, nx); b.st[0] = nloc; b.st[1] = nx; }
        const unsigned old = xb_add(&bar[XB_XSUB(b.x)], 1u);
        const unsigned gen = old / nloc;
        if (old + 1u == (gen + 1u) * nloc) {
            __builtin_amdgcn_fence(__ATOMIC_RELEASE, "agent");
            asm volatile("s_waitcnt vmcnt(0)" ::: "memory");
            const unsigned og = xb_add(&bar[XB_TOP], 1u);
            const unsigned tg = og / nx;
            if (og + 1u == (tg + 1u) * nx) xb_add(&bar[XB_TOPGEN], 1u);
            else XB_SPIN(xb_ld(&bar[XB_TOPGEN]) == tg, bar);
            __builtin_amdgcn_fence(__ATOMIC_ACQUIRE, "agent");
            xb_add(&bar[XB_XGEN(b.x)], 1u);
            asm volatile("s_waitcnt vmcnt(0)" ::: "memory");
        } else {
            XB_SPIN(xb_ld(&bar[XB_XGEN(b.x)]) == gen, bar);
            __builtin_amdgcn_fence(__ATOMIC_ACQUIRE, "agent");
            asm volatile("s_waitcnt vmcnt(0)" ::: "memory");
        }
    }
    __syncthreads();
}


constexpr int LDS_MAIN = 147456;
constexpr int LDS_BYTES = LDS_MAIN + 1024;
enum { PH_TABLES = 0, PH_MOD, PH_FOLD, PH_CONVERT, PH_HYMLP, PH_HYFILT, PH_NORM1, PH_GEMM_IN, PH_QKV, PH_ATTN, PH_FFTMIX,
       PH_GLA_A, PH_GLA_B, PH_GLA_C, PH_MIX, PH_GEMM_OUT, PH_NORM2, PH_MOE_GU, PH_MOE_DN, PH_FINAL };

__device__ __forceinline__ Params make_params() {
  const __attribute__((address_space(4))) char* kb = (const __attribute__((address_space(4))) char*)__builtin_amdgcn_kernarg_segment_ptr();
  asm volatile("" : "+s"(kb));
  Params p; p.kb = kb; return p;
}
#ifndef MK_LAUNCHES
#define MK_LAUNCHES 1
#endif
__global__ void __launch_bounds__(NTHR, 2) k_mega(ParamsData pd) {
  extern __shared__ __attribute__((aligned(1024))) char lds[];
  const int bid = blockIdx.x, nb = gridDim.x;
  if (threadIdx.x == 0) *(uint4*)(lds + LDS_MAIN) = make_uint4(0u, 0u, 0u, 0u);
  __syncthreads();
  XcdBarrier bar = xcd_barrier_post(make_params().bar(), (volatile LAS unsigned*)(lds + LDS_MAIN));
#ifndef DBLMASK
#define DBLMASK 0u
#endif
#define RUNPH(bit, call) do { call; if (DBLMASK & (1u << (bit))) { __syncthreads(); call; } } while (0)
  RUNPH(13, phase_tables(make_params(), bid, nb); phase_mod(make_params(), bid, nb, lds); phase_fold(make_params(), bid, nb, lds));
  RUNPH(0, phase_convert(make_params(), bid, nb, lds));
  phase_hy_mlp(make_params(), 0, SEQ, make_params().hfb(), make_params().hpart(), bid, nb, lds);
  phase_hy_mlp(make_params(), 1, SEQ, make_params().hfb() + (size_t)2 * 256 * SEQ, make_params().hpart() + 256 * 512, bid, nb, lds);
  phase_hy_mlp(make_params(), 0, LC, make_params().hfc(), make_params().hpart() + 2 * 256 * 512, bid, nb, lds, 4);
  xcd_barrier(bar);
  RUNPH(2, phase_hy_filtfft(make_params(), bid, nb, lds));
  phase_quant_in(make_params(), bid, nb);
#define MK_LAYER(l) do { \
  phase_norm1(make_params(), l, bid, nb, lds); if ((DBLMASK & (1u << 14)) && l == 0) { __syncthreads(); phase_norm1(make_params(), l, bid, nb, lds); } \
  xcd_barrier(bar); \
  RUNPH(3, phase_gemm_in(make_params(), l, bid, nb, lds)); \
  if (l == 1) dn_tail_rest_in(make_params(), bid, lds); \
  xcd_barrier(bar); \
  RUNPH(4, phase_qkv(make_params(), l, bid, nb, lds)); \
  RUNPH(5, phase_gla_a(make_params(), l, bid, nb, lds)); \
  RUNPH(7, phase_fftmix(make_params(), l, bid, nb, lds)); \
  if (l == 0) gu8_deferred(make_params(), bid, 0, 2, -1, 1, lds); else { gu8_deferred(make_params(), bid, 6, 2, -1, 1, lds); dn_tail_rest(make_params(), bid, nb, lds); } \
  xcd_barrier(bar); \
  RUNPH(6, phase_attn(make_params(), l, bid, nb, lds)); \
  RUNPH(9, phase_gla_c(make_params(), l, bid, nb, lds)); \
  RUNPH(10, phase_mix(make_params(), l, bid, nb, lds)); \
  if (l == 0) gu8_deferred(make_params(), bid, 2, 2, -1, 0, lds); \
  xcd_barrier(bar); \
  phase_gemm_out(make_params(), l, bid, nb, lds); if ((DBLMASK & (1u << 16)) && l == 0) { __syncthreads(); phase_gemm_out(make_params(), l, bid, nb, lds); } \
  if (l == 0) { gu8_deferred(make_params(), bid, 4, 2, 8, 1, lds); dn_deferred(make_params(), bid, lds); } \
  xcd_barrier(bar); \
  phase_norm2_router(make_params(), l, bid, nb, lds); \
  xcd_barrier(bar); \
  RUNPH(11, phase_moe_gu(make_params(), l, bid, nb, lds)); \
  xcd_barrier(bar); \
  RUNPH(12, phase_moe_dn(make_params(), l, bid, nb, lds)); \
  if (l == 0) dn_tail_fill(make_params(), bid, lds); \
  xcd_barrier(bar); \
  } while (0)
  MK_LAYER(0);
  MK_LAYER(1);
#undef MK_LAYER
  RUNPH(15, phase_final(make_params(), bid, nb, lds));
}
static size_t carve(char*& cur, size_t bytes) { char* r = cur; cur += (bytes + 1023) & ~(size_t)1023; return (size_t)(uintptr_t)r; }
#define CARVE(T, field, n) p.field = (T*)carve(cur, (size_t)(n) * sizeof(T))

extern "C" void kernel_launch(void* const* d_in, const int* in_sizes, int n_in, void* d_out, int out_size, void* d_ws, size_t ws_size, hipStream_t stream) {
  ParamsData p; memset(&p, 0, sizeof(p));
  const float** ins = (const float**)&p;
  for (int i = 0; i < 34; ++i) ins[i] = (const float*)d_in[i];
  p.out_ = (float*)d_out;
  p.ws_ = (char*)d_ws;
  if (WS_TOTAL > ws_size) { fprintf(stderr, "workspace too small: need %zu have %zu\n", (size_t)WS_TOTAL, ws_size); return; }
  hipMemsetAsync((char*)d_ws + OFF_bar, 0, OFF_mod - OFF_bar, stream);
  static int grid = 0;
  if (!grid) {
    int dev = 0, cus = 0, per_cu = 0;
    hipGetDevice(&dev);
    hipDeviceGetAttribute(&cus, hipDeviceAttributeMultiprocessorCount, dev);
    hipFuncSetAttribute((const void*)k_mega, hipFuncAttributeMaxDynamicSharedMemorySize, LDS_BYTES);
    hipOccupancyMaxActiveBlocksPerMultiprocessor(&per_cu, (const void*)k_mega, NTHR, LDS_BYTES);
    grid = cus * (per_cu < 1 ? per_cu : 1);
    if (grid != 256) fprintf(stderr, "unexpected grid %d (cus %d per_cu %d)\n", grid, cus, per_cu);
  }
  hipLaunchKernelGGL(k_mega, dim3(grid), dim3(NTHR), LDS_BYTES, stream, p);
}
```
